# Optimizing an MI355X kernel written in HIP

```python
import jax, jax.numpy as jnp
from jax import lax
import numpy as np


D_MODEL = 1024
BATCH = 16
SEQ = 2048
DEPTH = 1

N_META = 16
GLA_WIDTH = D_MODEL // 2
GLA_HEADS = 4
GLA_DV = GLA_WIDTH // GLA_HEADS
GLA_DK = GLA_DV // 2
GLA_KEY = GLA_HEADS * GLA_DK
GLA_GATE_RANK = 16
GLA_TAU = 16.0
GLA_CHUNK = 64
RWKV_WIDTH = D_MODEL - GLA_WIDTH
RWKV_HEAD = 64
RWKV_HEADS = RWKV_WIDTH // RWKV_HEAD
RWKV_W_RANK = 64
RWKV_A_RANK = 64
RWKV_G_RANK = 128
MIX_WIDTH = GLA_WIDTH + RWKV_WIDTH
GLA_SIZES = (GLA_KEY, GLA_KEY, GLA_WIDTH, GLA_WIDTH, GLA_GATE_RANK)
RWKV_SIZES = (RWKV_WIDTH, RWKV_WIDTH, RWKV_WIDTH, RWKV_W_RANK, RWKV_A_RANK, RWKV_G_RANK)
GLA_IN = sum(GLA_SIZES)
RWKV_IN = sum(RWKV_SIZES)
IN_WIDTH = GLA_IN + RWKV_IN
N_EXPERTS = 32
TOP_K = 4
D_FF = D_MODEL
SWIGLU_ALPHA = 1.702
SWIGLU_LIMIT = 7.0
MOE_BLOCK = 256
DEEPNORM_ALPHA = (2.0 * DEPTH) ** 0.25
DEEPNORM_BETA = (8.0 * DEPTH) ** -0.25
LN_EPS = 1e-5
RWKV_LN_EPS = 64e-5
RMS_EPS = 1e-6

kernel_name = 'hybrid_gla_rwkv7_moe_deepnorm'


def split_cols(t, sizes):
    idx = np.cumsum(sizes)[:-1].tolist()
    return jnp.split(t, idx, axis=-1)


def layer_norm(x, g, b, eps=LN_EPS):
    xf = x.astype(jnp.float32)
    mu = jnp.mean(xf, axis=-1, keepdims=True)
    var = jnp.mean(jnp.square(xf - mu), axis=-1, keepdims=True)
    y = (xf - mu) * lax.rsqrt(var + eps)
    return (y * g.astype(jnp.float32) + b.astype(jnp.float32)).astype(x.dtype)


def gla_mixer(q, k, v, g, gk_low, gk_w2, gk_b, norm_g):
    Bn, L, _ = q.shape
    pad = (-N_META) % GLA_CHUNK
    Lp = L + pad
    nc = Lp // GLA_CHUNK
    f32 = jnp.float32
    lg = jax.nn.log_sigmoid(gk_low.astype(f32) @ gk_w2.astype(f32) + gk_b.astype(f32)) / GLA_TAU

    def chunks(t, d):
        t = t.astype(f32).reshape(Bn, L, GLA_HEADS, d)
        t = jnp.pad(t, ((0, 0), (pad, 0), (0, 0), (0, 0)))
        return t.reshape(Bn, nc, GLA_CHUNK, GLA_HEADS, d).transpose(1, 0, 3, 2, 4)

    qc = chunks(q, GLA_DK) * (GLA_DK ** -0.5)
    kc = chunks(k, GLA_DK)
    vc = chunks(v, GLA_DV)
    lgc = chunks(lg, GLA_DK)
    causal = jnp.tril(jnp.ones((GLA_CHUNK, GLA_CHUNK), dtype=bool))

    def step(S, inp):
        q_c, k_c, v_c, lg_c = inp
        bc = jnp.cumsum(lg_c, axis=2)
        diff = bc[:, :, :, None, :] - bc[:, :, None, :, :]
        diff = jnp.where(causal[:, :, None], diff, -jnp.inf)
        A = jnp.sum(q_c[:, :, :, None, :] * k_c[:, :, None, :, :] * jnp.exp(diff), axis=-1)
        o = jnp.einsum('bhts,bhse->bhte', A, v_c) + jnp.einsum('bhtd,bhde->bhte', q_c * jnp.exp(bc), S)
        b_last = bc[:, :, -1:, :]
        S = jnp.exp(b_last[:, :, 0, :])[..., None] * S + jnp.einsum('bhsd,bhse->bhde', k_c * jnp.exp(b_last - bc), v_c)
        return S, o

    S0 = jnp.zeros((Bn, GLA_HEADS, GLA_DK, GLA_DV), f32)
    _, o = lax.scan(step, S0, (qc, kc, vc, lgc))
    o = o.transpose(1, 0, 3, 2, 4).reshape(Bn, Lp, GLA_HEADS, GLA_DV)[:, pad:]
    o = o * lax.rsqrt(jnp.mean(o * o, axis=-1, keepdims=True) + RMS_EPS) * norm_g.astype(f32)
    return o.reshape(Bn, L, GLA_WIDTH) * jax.nn.silu(g.astype(f32))


def rwkv7_mixer(p, mu, w0, w2, a0, a2, g2, k_k, k_a, r_k, ln_g, ln_b):
    Bn, L, _ = p.shape
    f32 = jnp.float32
    p = p.astype(f32)
    prev = jnp.pad(p, ((0, 0), (1, 0), (0, 0)))[:, :L]
    p = p + (prev - p) * mu.astype(f32)
    r, k, v, w_low, a_low, g_low = split_cols(p, RWKV_SIZES)
    w = -jax.nn.softplus(-(w0.astype(f32) + jnp.tanh(w_low) @ w2.astype(f32))) - 0.5
    decay = jnp.exp(-jnp.exp(w))
    a = jax.nn.sigmoid(a0.astype(f32) + a_low @ a2.astype(f32))
    g = jax.nn.sigmoid(g_low) @ g2.astype(f32)

    def heads(t):
        return t.reshape(Bn, L, RWKV_HEADS, RWKV_HEAD)

    kk = heads(k * k_k.astype(f32))
    kk = kk / jnp.maximum(jnp.sqrt(jnp.sum(kk * kk, axis=-1, keepdims=True)), 1e-12)
    k = k * (1.0 + (a - 1.0) * k_a.astype(f32))
    r_h, k_h, v_h, w_h, a_h = heads(r), heads(k), heads(v), heads(decay), heads(a)

    def step(S, inp):
        r_t, w_t, k_t, v_t, kk_t, a_t = inp
        sa = jnp.einsum('bhij,bhj->bhi', S, -kk_t)
        S = S * w_t[:, :, None, :] + sa[..., None] * (kk_t * a_t)[:, :, None, :] + v_t[..., None] * k_t[:, :, None, :]
        return S, jnp.einsum('bhij,bhj->bhi', S, r_t)

    S0 = jnp.zeros((Bn, RWKV_HEADS, RWKV_HEAD, RWKV_HEAD), f32)
    xs = (jnp.moveaxis(r_h, 1, 0), jnp.moveaxis(w_h, 1, 0), jnp.moveaxis(k_h, 1, 0),
          jnp.moveaxis(v_h, 1, 0), jnp.moveaxis(kk, 1, 0), jnp.moveaxis(a_h, 1, 0))
    _, y = lax.scan(step, S0, xs)
    y = jnp.moveaxis(y, 0, 1)
    mean = jnp.mean(y, axis=-1, keepdims=True)
    var = jnp.mean(jnp.square(y - mean), axis=-1, keepdims=True)
    y = (y - mean) * lax.rsqrt(var + RWKV_LN_EPS)
    y = y * ln_g.astype(f32).reshape(RWKV_HEADS, RWKV_HEAD) + ln_b.astype(f32).reshape(RWKV_HEADS, RWKV_HEAD)
    y = y + jnp.sum(r_h * k_h * r_k.astype(f32), axis=-1, keepdims=True) * v_h
    return y.reshape(Bn, L, RWKV_WIDTH) * g


def moe_ffn(h, router_w, router_b, w_up, b_up, w_down, b_down):
    Bn, L, D = h.shape
    T = Bn * L
    TK = T * TOP_K
    xt = h.reshape(T, D)
    logits = xt.astype(jnp.float32) @ router_w.astype(jnp.float32) + router_b.astype(jnp.float32)
    top_logits, top_idx = lax.top_k(logits, TOP_K)
    gates = jax.nn.softmax(top_logits, axis=-1).astype(h.dtype)
    flat_e = top_idx.reshape(-1).astype(jnp.int32)
    flat_tok = jnp.arange(TK, dtype=jnp.int32) // TOP_K
    order = jnp.argsort(flat_e, stable=True)
    sorted_e = flat_e[order]
    counts = jnp.bincount(flat_e, length=N_EXPERTS).astype(jnp.int32)
    padded = (counts + MOE_BLOCK - 1) // MOE_BLOCK * MOE_BLOCK
    ends_p = jnp.cumsum(padded)
    starts_p = ends_p - padded
    starts = jnp.cumsum(counts) - counts
    rank = jnp.arange(TK, dtype=jnp.int32) - starts[sorted_e]
    dest = starts_p[sorted_e] + rank
    nb = -(-TK // MOE_BLOCK) + N_EXPERTS
    slot_tok = jnp.full((nb * MOE_BLOCK,), T, jnp.int32).at[dest].set(flat_tok[order])
    slot_gate = jnp.zeros((nb * MOE_BLOCK,), h.dtype).at[dest].set(gates.reshape(-1)[order])
    block_start = jnp.arange(nb, dtype=jnp.int32) * MOE_BLOCK
    block_e = jnp.minimum(jnp.searchsorted(ends_p, block_start, side='right'), N_EXPERTS - 1)
    x_pad = jnp.concatenate([xt, jnp.zeros((1, D), xt.dtype)], axis=0)

    def expert_block(args):
        tok, e = args
        xb = x_pad[tok]
        u = xb @ w_up[e] + b_up[e]
        x_glu = jnp.minimum(u[:, 0::2], SWIGLU_LIMIT)
        x_lin = jnp.clip(u[:, 1::2], -SWIGLU_LIMIT, SWIGLU_LIMIT)
        act = x_glu * jax.nn.sigmoid(SWIGLU_ALPHA * x_glu) * (x_lin + 1.0)
        return act @ w_down[e] + b_down[e]

    y = lax.map(expert_block, (slot_tok.reshape(nb, MOE_BLOCK), block_e))
    y = y.reshape(-1, D) * slot_gate[:, None]
    out = jnp.zeros((T + 1, D), h.dtype).at[slot_tok].add(y.astype(h.dtype))[:T]
    return out.reshape(Bn, L, D)


def setup_inputs(seed: int = 0) -> dict:
    key = jax.random.key(seed)
    ks = iter(jax.random.split(key, 40))
    f32 = jnp.float32

    def nrm(shape, scale):
        return scale * jax.random.normal(next(ks), shape, f32)

    x = jax.random.normal(next(ks), (BATCH, SEQ, D_MODEL), f32)
    meta = nrm((N_META, D_MODEL), 1.0)
    ln_in_g = 1.0 + nrm((D_MODEL,), 0.02)
    ln_in_b = nrm((D_MODEL,), 0.02)
    w_in = nrm((DEPTH, D_MODEL, IN_WIDTH), D_MODEL ** -0.5)
    gla_gk_w2 = nrm((DEPTH, GLA_GATE_RANK, GLA_KEY), GLA_GATE_RANK ** -0.5)
    gla_gk_b = nrm((DEPTH, GLA_KEY), 0.1)
    gla_norm_g = 1.0 + nrm((DEPTH, GLA_DV), 0.02)
    rwkv_mu = jax.random.uniform(next(ks), (DEPTH, RWKV_IN), f32)
    n = jnp.arange(RWKV_WIDTH, dtype=f32) / (RWKV_WIDTH - 1)
    rwkv_w0 = (-6.5 + 5.0 * n ** 0.85)[None, :] + nrm((DEPTH, RWKV_WIDTH), 0.05)
    rwkv_w2 = nrm((DEPTH, RWKV_W_RANK, RWKV_WIDTH), 0.5 * RWKV_W_RANK ** -0.5)
    rwkv_a0 = nrm((DEPTH, RWKV_WIDTH), 0.1)
    rwkv_a2 = nrm((DEPTH, RWKV_A_RANK, RWKV_WIDTH), 0.5 * RWKV_A_RANK ** -0.5)
    rwkv_g2 = nrm((DEPTH, RWKV_G_RANK, RWKV_WIDTH), RWKV_G_RANK ** -0.5)
    rwkv_k_k = 0.85 + nrm((DEPTH, RWKV_WIDTH), 0.02)
    rwkv_k_a = 1.0 + nrm((DEPTH, RWKV_WIDTH), 0.02)
    rwkv_r_k = nrm((DEPTH, RWKV_HEADS, RWKV_HEAD), 0.1)
    rwkv_ln_g = 1.0 + nrm((DEPTH, RWKV_WIDTH), 0.02)
    rwkv_ln_b = nrm((DEPTH, RWKV_WIDTH), 0.02)
    w_out = nrm((DEPTH, MIX_WIDTH, D_MODEL), DEEPNORM_BETA * MIX_WIDTH ** -0.5)
    ln1_g = 1.0 + nrm((DEPTH, D_MODEL), 0.02)
    ln1_b = nrm((DEPTH, D_MODEL), 0.02)
    router_w = nrm((DEPTH, D_MODEL, N_EXPERTS), D_MODEL ** -0.5)
    router_b = nrm((DEPTH, N_EXPERTS), 0.01)
    exp_w_up = nrm((DEPTH, N_EXPERTS, D_MODEL, 2 * D_FF), D_MODEL ** -0.5)
    exp_b_up = nrm((DEPTH, N_EXPERTS, 2 * D_FF), 0.01)
    exp_w_down = nrm((DEPTH, N_EXPERTS, D_FF, D_MODEL), DEEPNORM_BETA * D_FF ** -0.5)
    exp_b_down = nrm((DEPTH, N_EXPERTS, D_MODEL), 0.01)
    ln2_g = 1.0 + nrm((DEPTH, D_MODEL), 0.02)
    ln2_b = nrm((DEPTH, D_MODEL), 0.02)
    return {'x': x, 'meta': meta, 'ln_in_g': ln_in_g, 'ln_in_b': ln_in_b, 'w_in': w_in,
            'gla_gk_w2': gla_gk_w2, 'gla_gk_b': gla_gk_b, 'gla_norm_g': gla_norm_g,
            'rwkv_mu': rwkv_mu, 'rwkv_w0': rwkv_w0, 'rwkv_w2': rwkv_w2, 'rwkv_a0': rwkv_a0,
            'rwkv_a2': rwkv_a2, 'rwkv_g2': rwkv_g2, 'rwkv_k_k': rwkv_k_k, 'rwkv_k_a': rwkv_k_a,
            'rwkv_r_k': rwkv_r_k, 'rwkv_ln_g': rwkv_ln_g, 'rwkv_ln_b': rwkv_ln_b, 'w_out': w_out,
            'ln1_g': ln1_g, 'ln1_b': ln1_b, 'router_w': router_w, 'router_b': router_b,
            'exp_w_up': exp_w_up, 'exp_b_up': exp_b_up, 'exp_w_down': exp_w_down, 'exp_b_down': exp_b_down,
            'ln2_g': ln2_g, 'ln2_b': ln2_b}


def reference(x, meta, ln_in_g, ln_in_b, w_in, gla_gk_w2, gla_gk_b, gla_norm_g,
              rwkv_mu, rwkv_w0, rwkv_w2, rwkv_a0, rwkv_a2, rwkv_g2, rwkv_k_k, rwkv_k_a,
              rwkv_r_k, rwkv_ln_g, rwkv_ln_b, w_out, ln1_g, ln1_b, router_w, router_b,
              exp_w_up, exp_b_up, exp_w_down, exp_b_down, ln2_g, ln2_b):
    Bn = x.shape[0]
    meta_b = jnp.broadcast_to(meta[None].astype(x.dtype), (Bn, N_META, D_MODEL))
    h = jnp.concatenate([meta_b, x], axis=1)
    h = layer_norm(h, ln_in_g, ln_in_b)
    for l in range(DEPTH):
        proj = h @ w_in[l]
        q, k, v, g, gk_low = split_cols(proj[..., :GLA_IN], GLA_SIZES)
        y_gla = gla_mixer(q, k, v, g, gk_low, gla_gk_w2[l], gla_gk_b[l], gla_norm_g[l])
        y_rwkv = rwkv7_mixer(proj[..., GLA_IN:], rwkv_mu[l], rwkv_w0[l], rwkv_w2[l], rwkv_a0[l],
                             rwkv_a2[l], rwkv_g2[l], rwkv_k_k[l], rwkv_k_a[l], rwkv_r_k[l],
                             rwkv_ln_g[l], rwkv_ln_b[l])
        mix = jnp.concatenate([y_gla, y_rwkv], axis=-1).astype(h.dtype) @ w_out[l]
        h = layer_norm(DEEPNORM_ALPHA * h + mix, ln1_g[l], ln1_b[l])
        ffn = moe_ffn(h, router_w[l], router_b[l], exp_w_up[l], exp_b_up[l], exp_w_down[l], exp_b_down[l])
        h = layer_norm(DEEPNORM_ALPHA * h + ffn, ln2_g[l], ln2_b[l])
    return h[:, N_META:]
```

```cpp
#include <hip/hip_runtime.h>
#include <cstdio>
#include <cstdint>
#include <cmath>
namespace pg8 {
#define PG8_LAS __attribute__((address_space(3)))
typedef unsigned short bf16_t;
typedef short bf16x8 __attribute__((ext_vector_type(8)));
typedef float f32x4 __attribute__((ext_vector_type(4)));
typedef unsigned u32x4 __attribute__((ext_vector_type(4)));
constexpr int BM = 256, BK = 64, HALF = 128, HTB = HALF * BK * 2  , STAGE_BYTES = 8 * HTB, NXCD = 8, WGM = 8;

__host__ __device__ __forceinline__ int lds_byte(int r, int c) { const int st = (r >> 4) * 2 + (c >> 5), rr = r & 15, cc = c & 31, ob = rr * 64 + cc * 2; return st * 1024 + (ob ^ (((ob >> 9) & 1) << 5)); }
__host__ __device__ __forceinline__ void stage_rc(int b, int& R, int& C) { const int st = b / 1024, sb = b % 1024, swz = sb ^ (((sb >> 9) & 1) << 5); R = (st >> 1) * 16 + swz / 64; C = (st & 1) * 32 + (swz % 64) / 2; }
__host__ __device__ __forceinline__ int perm32(int rho) { const int n = rho >> 4, i = rho & 15; return 8 * (i >> 2) + 4 * n + (i & 3); }

struct Unit { int pm, pn; };
struct Gemm { const bf16_t* A; const bf16_t* Bt; int M, N, K; };

struct StaticOrder {
    int nM, nN, nwg, G, c;
    __host__ __device__ void init(int M, int N, int G_, int c_) { nM = M / BM; nN = N / BM; nwg = nM * nN; G = G_; c = c_; }
    __host__ __device__ bool next(int i, Unit& u) const {
        const long L = (long)i * G + c; if (L >= nwg) return false;
        int wgid = (int)L; { const int q = nwg / NXCD, r = nwg % NXCD, xcd = wgid % NXCD, off = wgid / NXCD; wgid = (xcd < r ? xcd * (q + 1) : r * (q + 1) + (xcd - r) * q) + off; }
        const int nig = WGM * nN, gid = wgid / nig, fm = gid * WGM, gsz = (nM - fm) < WGM ? (nM - fm) : WGM;
        u.pm = fm + ((wgid % nig) % gsz); u.pn = (wgid % nig) / gsz; return true;
    }
    __device__ __forceinline__ void a_ready(const Unit&) const {}
    __device__ __forceinline__ void done(const Unit&) const {}
};


__device__ __forceinline__ unsigned cvt_pk_bf16(float lo, float hi) { unsigned r; asm volatile("v_cvt_pk_bf16_f32 %0, %1, %2" : "=v"(r) : "v"(lo), "v"(hi)); return r; }
typedef unsigned u32x2 __attribute__((ext_vector_type(2)));

struct EpiBf16Plain {
    static constexpr bool PERM = true, AFTER_DRAIN = false;
    bf16_t* O; int ldc;
    __device__ __forceinline__ void operator()(const f32x4 (&acc)[2][2][4][2], const Unit& u, int wr, int wc, int fr, int fq) const {
        const int row0 = u.pm * BM + wr * 64 + fr, col0 = u.pn * BM + wc * 32 + 8 * fq;
#pragma unroll
        for (int ai = 0; ai < 2; ++ai)
#pragma unroll
            for (int m = 0; m < 4; ++m) { bf16_t* rowp = O + (size_t)(row0 + ai * HALF + m * 16) * ldc + col0;
#pragma unroll
                for (int bj = 0; bj < 2; ++bj) { const f32x4 v0 = acc[ai][bj][m][0], v1 = acc[ai][bj][m][1];
                    u32x4 w; w.x = cvt_pk_bf16(v0[0], v0[1]); w.y = cvt_pk_bf16(v0[2], v0[3]); w.z = cvt_pk_bf16(v1[0], v1[1]); w.w = cvt_pk_bf16(v1[2], v1[3]);
                    *(u32x4*)(rowp + bj * HALF) = w; } }
    }
};

struct EpiResid {
    static constexpr bool PERM = false, AFTER_DRAIN = false;
    float* S1; const float* x; const float* stats; const float* g; const float* bta; float alpha;
    __device__ __forceinline__ void operator()(const f32x4 (&acc)[2][2][4][2], const Unit& u, int wr, int wc, int fr, int fq) const {
        const int row0 = u.pm * BM + wr * 64 + fr, col0 = u.pn * BM + wc * 32 + 4 * fq;
#pragma unroll
        for (int bj = 0; bj < 2; ++bj)
#pragma unroll
            for (int n = 0; n < 2; ++n) { const int c = col0 + bj * HALF + n * 16;
                const f32x4 gv = *(const f32x4*)(g + c) * alpha, bv = *(const f32x4*)(bta + c) * alpha;
#pragma unroll
                for (int ai = 0; ai < 2; ++ai)
#pragma unroll
                    for (int m = 0; m < 4; ++m) { const int r = row0 + ai * HALF + m * 16;
                        const float mean = stats[2 * r], rstd = stats[2 * r + 1];
                        const f32x4 xv = *(const f32x4*)(x + (size_t)r * 1024 + c);
                        *(f32x4*)(S1 + (size_t)r * 1024 + c) = ((xv - mean) * rstd) * gv + bv + acc[ai][bj][m][n]; } }
    }
};

__device__ __forceinline__ float swiglu1(float glu, float lin) {
    const float xg = fminf(glu, 7.0f), xl = fminf(fmaxf(lin, -7.0f), 7.0f);
    const float sg = __builtin_amdgcn_rcpf(1.0f + __expf(-1.702f * xg));
    return xg * sg * (xl + 1.0f);
}
struct EpiSwiglu {
    static constexpr bool PERM = true, AFTER_DRAIN = false;
    bf16_t* ACT; const float* bup;
    __device__ __forceinline__ void operator()(const f32x4 (&acc)[2][2][4][2], const Unit& u, int wr, int wc, int fr, int fq) const {
        const int e = u.pn >> 3, pn = u.pn & 7;
        const int row0 = u.pm * BM + wr * 64 + fr, ucol0 = pn * BM + wc * 32 + 8 * fq, acol0 = ucol0 >> 1;
        f32x4 bv[2][2];
#pragma unroll
        for (int bj = 0; bj < 2; ++bj)
#pragma unroll
            for (int n = 0; n < 2; ++n) bv[bj][n] = *(const f32x4*)(bup + (size_t)e * 2048 + ucol0 + bj * HALF + 4 * n);
#pragma unroll
        for (int ai = 0; ai < 2; ++ai)
#pragma unroll
            for (int m = 0; m < 4; ++m) { bf16_t* rowp = ACT + (size_t)(row0 + ai * HALF + m * 16) * 1024 + acol0;
#pragma unroll
                for (int bj = 0; bj < 2; ++bj) { const f32x4 v0 = acc[ai][bj][m][0] + bv[bj][0], v1 = acc[ai][bj][m][1] + bv[bj][1];
                    u32x2 w; w.x = cvt_pk_bf16(swiglu1(v0[0], v0[1]), swiglu1(v0[2], v0[3])); w.y = cvt_pk_bf16(swiglu1(v1[0], v1[1]), swiglu1(v1[2], v1[3]));
                    *(u32x2*)(rowp + bj * (HALF / 2)) = w; } }
    }
};
struct EpiDown {
    static constexpr bool PERM = true, AFTER_DRAIN = false;
    bf16_t* YS; const float* bdn;
    __device__ __forceinline__ void operator()(const f32x4 (&acc)[2][2][4][2], const Unit& u, int wr, int wc, int fr, int fq) const {
        const int e = u.pn >> 2, pn = u.pn & 3;
        const int row0 = u.pm * BM + wr * 64 + fr, col0 = pn * BM + wc * 32 + 8 * fq;
        f32x4 bv[2][2];
#pragma unroll
        for (int bj = 0; bj < 2; ++bj)
#pragma unroll
            for (int n = 0; n < 2; ++n) bv[bj][n] = *(const f32x4*)(bdn + (size_t)e * 1024 + col0 + bj * HALF + 4 * n);
#pragma unroll
        for (int ai = 0; ai < 2; ++ai)
#pragma unroll
            for (int m = 0; m < 4; ++m) { bf16_t* rowp = YS + (size_t)(row0 + ai * HALF + m * 16) * 1024 + col0;
#pragma unroll
                for (int bj = 0; bj < 2; ++bj) { const f32x4 v0 = acc[ai][bj][m][0] + bv[bj][0], v1 = acc[ai][bj][m][1] + bv[bj][1];
                    u32x4 w; w.x = cvt_pk_bf16(v0[0], v0[1]); w.y = cvt_pk_bf16(v0[2], v0[3]); w.z = cvt_pk_bf16(v1[0], v1[1]); w.w = cvt_pk_bf16(v1[2], v1[3]);
                    *(u32x4*)(rowp + bj * HALF) = w; } }
    }
};
struct TableOrder {
    const PG8_LAS int* tab; int n;
    __device__ __forceinline__ bool next(int i, Unit& u) const {
        if (i >= n) return false;
        u.pm = __builtin_amdgcn_readfirstlane(tab[2 * i]); u.pn = __builtin_amdgcn_readfirstlane(tab[2 * i + 1]); return true;
    }
    __device__ __forceinline__ void a_ready(const Unit&) const {}
    __device__ __forceinline__ void done(const Unit&) const {}
};

template <class Epi, class Sched, bool ALIGN_EPI = false, bool SP2 = false>
__device__ __forceinline__ void gemm_phase(PG8_LAS unsigned char* lds, const Gemm g, const Sched& S, const Epi& E, const int tid) {
    const int wid = __builtin_amdgcn_readfirstlane(tid >> 6), lane = tid & 63, wr = wid >> 2, wc = wid & 3, fr = lane & 15, fq = lane >> 4;
    const int K = g.K, nt = K / BK;
    unsigned voffA[2], voffB[2];
#pragma unroll
    for (int i = 0; i < 2; ++i) { int R, C; stage_rc(tid * 16 + i * 8192, R, C); const int Rb = Epi::PERM ? ((R & ~31) + perm32(R & 31)) : R;
        voffA[i] = (unsigned)(R * K + C) * 2u; voffB[i] = (unsigned)(Rb * K + C) * 2u; }
    const size_t kstep = (size_t)(BK * 2);
    const size_t hstep = (size_t)HALF * K * 2;
    const size_t tstep = 2 * hstep;
    const unsigned ldsw = (unsigned)wid * 1024u;
    const int aoff = lds_byte(wr * 64 + fr, fq * 8), boff = lds_byte(wc * 32 + fr, fq * 8);
#define PG8_SA(b, h) (((b) * 2 + (h)) * HTB)
#define PG8_SB(b, h) ((4 + (b) * 2 + (h)) * HTB)
#define PG8_STAGE(bufoff, gbase, voff) do { _Pragma("unroll") for (int _i = 0; _i < 2; ++_i) \
        __builtin_amdgcn_global_load_lds((const unsigned*)((const char*)(gbase) + (voff)[_i]), (PG8_LAS unsigned*)(lds + (bufoff) + ldsw + _i * 8192), 16, 0, 0); } while (0)
#define PG8_LDA(dst, b, h) do { _Pragma("unroll") for (int m = 0; m < 4; ++m) _Pragma("unroll") for (int k = 0; k < 2; ++k) dst[m][k] = *(const PG8_LAS bf16x8*)(lds + PG8_SA(b, h) + aoff + m * 2048 + k * 1024); } while (0)
#define PG8_LDB(dst, b, h) do { _Pragma("unroll") for (int n = 0; n < 2; ++n) _Pragma("unroll") for (int k = 0; k < 2; ++k) dst[n][k] = *(const PG8_LAS bf16x8*)(lds + PG8_SB(b, h) + boff + n * 2048 + k * 1024); } while (0)
#define PG8_MMA(ai, bj, At, Bt) do { __builtin_amdgcn_s_setprio(1); _Pragma("unroll") for (int m = 0; m < 4; ++m) _Pragma("unroll") for (int n = 0; n < 2; ++n) _Pragma("unroll") for (int k = 0; k < 2; ++k) \
        acc[ai][bj][m][n] = __builtin_amdgcn_mfma_f32_16x16x32_bf16(Bt[n][k], At[m][k], acc[ai][bj][m][n], 0, 0, 0); __builtin_amdgcn_s_setprio(0); } while (0)
#define PG8_WAIT_V(n) asm volatile("s_waitcnt vmcnt(" #n ")" ::: "memory")
#define PG8_WAIT_L(n) asm volatile("s_waitcnt lgkmcnt(" #n ")" ::: "memory")
#define PG8_BAR __builtin_amdgcn_s_barrier()
#define PG8_SCHED __builtin_amdgcn_sched_barrier(0)
    Unit cur, nxt; int ui = 0;
    if (!S.next(0, cur)) return;
    f32x4 acc[2][2][4][2];
#pragma unroll
    for (int a = 0; a < 2; ++a)
#pragma unroll
        for (int b = 0; b < 2; ++b)
#pragma unroll
            for (int m = 0; m < 4; ++m)
#pragma unroll
                for (int n = 0; n < 2; ++n) acc[a][b][m][n] = (f32x4){0.f, 0.f, 0.f, 0.f};
    bf16x8 At[4][2], B0[2][2], B1[2][2];
    const char* cA = (const char*)g.A + (size_t)cur.pm * tstep; const char* cB = (const char*)g.Bt + (size_t)cur.pn * tstep;
    S.a_ready(cur);
    if constexpr (SP2) {
        PG8_STAGE(PG8_SB(0, 0), cB, voffB); PG8_STAGE(PG8_SB(0, 1), cB + hstep, voffB); PG8_STAGE(PG8_SA(0, 0), cA, voffA); PG8_STAGE(PG8_SA(0, 1), cA + hstep, voffA);
        if (wr == 1) PG8_BAR;
        PG8_WAIT_V(2); PG8_BAR;
        PG8_STAGE(PG8_SB(1, 0), cB + kstep, voffB); PG8_STAGE(PG8_SA(1, 0), cA + kstep, voffA); PG8_STAGE(PG8_SB(1, 1), cB + hstep + kstep, voffB);
        PG8_WAIT_V(6); PG8_BAR;
    } else {
        PG8_STAGE(PG8_SB(0, 0), cB, voffB); PG8_STAGE(PG8_SA(0, 0), cA, voffA); PG8_STAGE(PG8_SB(0, 1), cB + hstep, voffB); PG8_STAGE(PG8_SA(0, 1), cA + hstep, voffA);
        if (wr == 1) PG8_BAR;
        PG8_WAIT_V(4); PG8_BAR;
        PG8_STAGE(PG8_SB(1, 0), cB + kstep, voffB); PG8_STAGE(PG8_SA(1, 0), cA + kstep, voffA); PG8_STAGE(PG8_SB(1, 1), cB + hstep + kstep, voffB);
        PG8_WAIT_V(6); PG8_BAR;
    }
    for (;;) {
        const bool has_next = S.next(ui + 1, nxt);
        const char* nA = has_next ? (const char*)g.A + (size_t)nxt.pm * tstep : cA; const char* nB = has_next ? (const char*)g.Bt + (size_t)nxt.pn * tstep : cB;
        for (int t = 0; t < nt; t += 2) {
            const bool last = (t == nt - 2);
            const char* a1 = cA + (size_t)(t + 1) * kstep;
            const char* a2 = last ? nA : cA + (size_t)(t + 2) * kstep; const char* b2 = last ? nB : cB + (size_t)(t + 2) * kstep;
            const char* a3 = a2 + kstep; const char* b3 = b2 + kstep;
            if (last && has_next) S.a_ready(nxt);
            if constexpr (SP2) {
            PG8_LDB(B0, 0, 0); PG8_LDB(B1, 0, 1); PG8_SCHED; PG8_LDA(At, 0, 0); PG8_STAGE(PG8_SA(1, 1), a1 + hstep, voffA);
            PG8_WAIT_V(8); PG8_WAIT_L(0); PG8_BAR; PG8_MMA(0, 0, At, B0); PG8_MMA(0, 1, At, B1); PG8_BAR; PG8_SCHED;
            PG8_LDA(At, 0, 1); PG8_STAGE(PG8_SB(0, 0), b2, voffB); PG8_STAGE(PG8_SB(0, 1), b2 + hstep, voffB); PG8_STAGE(PG8_SA(0, 0), a2, voffA);
            PG8_WAIT_V(8); PG8_WAIT_L(0); PG8_BAR; PG8_MMA(1, 0, At, B0); PG8_MMA(1, 1, At, B1); PG8_BAR; PG8_SCHED;
            PG8_LDB(B0, 1, 0); PG8_LDB(B1, 1, 1); PG8_SCHED; PG8_LDA(At, 1, 0); PG8_STAGE(PG8_SA(0, 1), a2 + hstep, voffA);
            PG8_WAIT_V(8); PG8_WAIT_L(0); PG8_BAR; PG8_MMA(0, 0, At, B0); PG8_MMA(0, 1, At, B1); PG8_BAR; PG8_SCHED;
            PG8_LDA(At, 1, 1); PG8_STAGE(PG8_SB(1, 0), b3, voffB); PG8_STAGE(PG8_SB(1, 1), b3 + hstep, voffB); PG8_STAGE(PG8_SA(1, 0), a3, voffA);
            PG8_WAIT_V(8); PG8_WAIT_L(0); PG8_BAR; PG8_MMA(1, 0, At, B0); PG8_MMA(1, 1, At, B1); PG8_BAR; PG8_SCHED;
            } else {
            PG8_LDB(B0, 0, 0); PG8_SCHED; PG8_LDA(At, 0, 0); PG8_STAGE(PG8_SA(1, 1), a1 + hstep, voffA);
            PG8_WAIT_L(8); PG8_BAR; PG8_WAIT_L(0); PG8_MMA(0, 0, At, B0); PG8_BAR; PG8_SCHED;
            PG8_LDB(B1, 0, 1); PG8_STAGE(PG8_SB(0, 0), b2, voffB);
            PG8_BAR; PG8_WAIT_L(0); PG8_MMA(0, 1, At, B1); PG8_BAR;
            PG8_LDA(At, 0, 1); PG8_STAGE(PG8_SA(0, 0), a2, voffA);
            PG8_BAR; PG8_WAIT_L(0); PG8_MMA(1, 0, At, B0); PG8_BAR; PG8_SCHED;
            PG8_STAGE(PG8_SB(0, 1), b2 + hstep, voffB);
            PG8_WAIT_V(6); PG8_BAR; PG8_MMA(1, 1, At, B1); PG8_BAR;
            PG8_LDB(B0, 1, 0); PG8_SCHED; PG8_LDA(At, 1, 0); PG8_STAGE(PG8_SA(0, 1), a2 + hstep, voffA);
            PG8_WAIT_L(8); PG8_BAR; PG8_WAIT_L(0); PG8_MMA(0, 0, At, B0); PG8_BAR; PG8_SCHED;
            PG8_LDB(B1, 1, 1); PG8_STAGE(PG8_SB(1, 0), b3, voffB);
            PG8_BAR; PG8_WAIT_L(0); PG8_MMA(0, 1, At, B1); PG8_BAR;
            PG8_LDA(At, 1, 1); PG8_STAGE(PG8_SA(1, 0), a3, voffA);
            PG8_BAR; PG8_WAIT_L(0); PG8_MMA(1, 0, At, B0); PG8_BAR; PG8_SCHED;
            PG8_STAGE(PG8_SB(1, 1), b3 + hstep, voffB);
            PG8_WAIT_V(6); PG8_BAR; PG8_MMA(1, 1, At, B1); PG8_BAR;
            }
        }
        if constexpr (ALIGN_EPI) { if (wr == 0) PG8_BAR; }
        if constexpr (!Epi::AFTER_DRAIN) { E(acc, cur, wr, wc, fr, fq); S.done(cur); }
        if (!has_next) break;
#pragma unroll
        for (int a = 0; a < 2; ++a)
#pragma unroll
            for (int b = 0; b < 2; ++b)
#pragma unroll
                for (int m = 0; m < 4; ++m)
#pragma unroll
                    for (int n = 0; n < 2; ++n) acc[a][b][m][n] = (f32x4){0.f, 0.f, 0.f, 0.f};
        cur = nxt; cA = nA; cB = nB; ++ui;
        if constexpr (ALIGN_EPI) { if (wr == 1) PG8_BAR; }
    }
    PG8_WAIT_V(0);
    if constexpr (!ALIGN_EPI) { if (wr == 0) PG8_BAR; }
    PG8_BAR;
    if constexpr (Epi::AFTER_DRAIN) { E.fused(acc, cur, wr, wc, fr, fq, lds, wid, lane); S.done(cur); }
#undef PG8_SA
#undef PG8_SB
#undef PG8_STAGE
#undef PG8_LDA
#undef PG8_LDB
#undef PG8_MMA
#undef PG8_WAIT_V
#undef PG8_WAIT_L
#undef PG8_BAR
#undef PG8_SCHED
}
}

constexpr int NB = 16, SEQ = 2048, D = 1024, NMETA = 16;
constexpr int MX = NB * SEQ;
constexpr int INW = 3344, PW = 3584;
constexpr int GQ = 0, GK = 256, GV = 512, GG = 1024, GKL = 1536;
constexpr int RW0 = 1552;
constexpr int RR = RW0, RK = RW0 + 512, RV = RW0 + 1024, RWL = RW0 + 1536, RAL = RW0 + 1600, RGL = RW0 + 1664;
constexpr int NE = 32, TOPK = 4;
constexpr int NCH = 33;
constexpr float ALPHA = 1.189207115002721f;
constexpr int NWAVES = 8, NTHR = 512;

constexpr size_t MiB = 1u << 20;
constexpr size_t WS_CTL = 0, CTL_ZERO_BYTES = 1 * MiB;
constexpr size_t WS_STATS = 1 * MiB;
constexpr size_t WS_TOPI  = WS_STATS + 256 * 1024;
constexpr size_t WS_GATE  = WS_TOPI + 512 * 1024;
constexpr size_t WS_RANK  = WS_GATE + 512 * 1024;
constexpr size_t WS_TSLOT = WS_RANK + 512 * 1024;
constexpr size_t WS_BON   = WS_TSLOT + 512 * 1024;
constexpr size_t WS_PROJM = WS_BON + 1 * MiB;
constexpr size_t WS_OPSM  = WS_PROJM + 256 * 1024;
constexpr size_t WS_DL    = WS_OPSM + 256 * 1024;
constexpr size_t WS_W2T   = WS_DL + 1 * MiB;
constexpr size_t WS_A2T   = WS_W2T + 64 * 1024;
constexpr size_t WS_G2T   = WS_A2T + 64 * 1024;
constexpr size_t WS_TILEE = WS_G2T + 128 * 1024;
constexpr size_t WS_WIN   = 8 * MiB;
constexpr size_t WS_WOUT  = 15 * MiB;
static_assert(WS_TILEE + 4096 <= WS_WIN, "table region");
constexpr size_t WS_A0    = 20 * MiB;
constexpr size_t WS_YMIX  = WS_A0;
constexpr size_t WS_PROJ  = 84 * MiB;
constexpr size_t WS_OPS   = 308 * MiB;
constexpr size_t WS_GUS   = 692 * MiB;
constexpr size_t WS_YRAW  = 758 * MiB;
constexpr size_t WS_GR    = 822 * MiB;
constexpr size_t WS_WUP   = 84 * MiB;
constexpr size_t WS_WDN   = 212 * MiB;
constexpr size_t WS_S1    = 276 * MiB;
constexpr size_t WS_H1    = 404 * MiB;
constexpr size_t WS_XS    = 468 * MiB;
constexpr size_t WS_YS    = WS_XS;
constexpr size_t WS_ACT   = 740 * MiB;
constexpr size_t WS_END   = 1012 * MiB;
constexpr int CW_BAR = 4096;
constexpr int CW_CNT = 16384;

constexpr int RING_BYTES = 131072;
constexpr int LDS_BYTES = 147456;
constexpr int TAB_OFF = 132096;
constexpr int MISC_OFF = LDS_BYTES - 512;

#define LAS __attribute__((address_space(3)))
typedef unsigned short bf16;
typedef unsigned v4u __attribute__((ext_vector_type(4)));
typedef unsigned v2u __attribute__((ext_vector_type(2)));
typedef float f32x4 __attribute__((ext_vector_type(4)));
typedef short bf16x8 __attribute__((ext_vector_type(8)));
#define LDS_WAIT() asm volatile("s_waitcnt lgkmcnt(0)" ::: "memory")
__device__ __forceinline__ float bflo(unsigned w) { return __uint_as_float(w << 16); }
__device__ __forceinline__ float bfhi(unsigned w) { return __uint_as_float(w & 0xffff0000u); }
__device__ __forceinline__ unsigned f2bf(float f) { unsigned u = __float_as_uint(f); return (u + 0x7fffu + ((u >> 16) & 1u)) >> 16; }
__device__ __forceinline__ unsigned pk2(float lo, float hi) { return f2bf(lo) | (f2bf(hi) << 16); }
__device__ __forceinline__ float wave_sum(float v) {
#pragma unroll
    for (int o = 1; o < 64; o <<= 1) v += __shfl_xor(v, o);
    return v;
}
__device__ __forceinline__ float softplus_f(float x) { return fmaxf(x, 0.f) + log1pf(expf(-fabsf(x))); }
__device__ __forceinline__ float logsigmoid_f(float x) { return fminf(x, 0.f) - log1pf(expf(-fabsf(x))); }
__device__ __forceinline__ float sigmoid_f(float x) { return 1.f / (1.f + expf(-x)); }
template <int CTRL> __device__ __forceinline__ float dppf(float x) { return __int_as_float(__builtin_amdgcn_update_dpp(0, __float_as_int(x), CTRL, 0xF, 0xF, true)); }
__device__ __forceinline__ float red8(float x) {
    x += dppf<0xB1>(x); x += dppf<0x4E>(x); x += dppf<0x141>(x); return x;
}
__device__ __forceinline__ f32x4 mfma16(bf16x8 a, bf16x8 b, f32x4 c) { return __builtin_amdgcn_mfma_f32_16x16x32_bf16(a, b, c, 0, 0, 0); }
__device__ __forceinline__ unsigned ld_agent(const unsigned* p) { return __hip_atomic_load(p, __ATOMIC_RELAXED, __HIP_MEMORY_SCOPE_AGENT); }

#define XB_TMO      128
#define XB_XCNT(j)  (256  + 64 * (j))
#define XB_XSUB(j)  (1280 + 64 * (j))
#define XB_XGEN(j)  (2304 + 64 * (j))
#define XB_TOP      3328
#define XB_TOPGEN   3392
#define XCD_BAR_WORDS 3456
#define XB_SPIN_CAP (1u << 18)
__device__ __forceinline__ unsigned xb_ld(unsigned* p)              { return __hip_atomic_load(p, __ATOMIC_RELAXED, __HIP_MEMORY_SCOPE_AGENT); }
__device__ __forceinline__ unsigned xb_add(unsigned* p, unsigned v) { return __hip_atomic_fetch_add(p, v, __ATOMIC_RELAXED, __HIP_MEMORY_SCOPE_AGENT); }
__device__ __forceinline__ unsigned xb_xcc_id() { return (unsigned)__builtin_amdgcn_s_getreg((3 << 11) | 20) & 0xFu; }
#define XB_SPIN(cond, bar) do { unsigned _sp = 0; while (cond) { __builtin_amdgcn_s_sleep(1); \
    if ((++_sp & 255u) == 0u) { if (xb_ld(&(bar)[XB_TMO])) break; if (_sp > XB_SPIN_CAP) { atomicAdd(&(bar)[XB_TMO], 1u); break; } } } } while (0)
struct XcdBarrier { unsigned* bar; unsigned x; volatile LAS unsigned* st; };
__device__ __forceinline__ XcdBarrier xcd_barrier_post(unsigned* bar, volatile LAS unsigned* st, bool leader) {
    XcdBarrier b; b.bar = bar; b.x = xb_xcc_id(); b.st = st;
    if (leader) (void)xb_add(&bar[XB_XCNT(b.x)], 1u);
    return b;
}
__device__ __forceinline__ void xcd_barrier_complete(unsigned* bar, unsigned x, unsigned& nloc, unsigned& nx) {
    const unsigned G = gridDim.x * gridDim.y * gridDim.z;
    unsigned sum, cnt, mine, sp = 0u;
    for (;;) {
        sum = 0u; cnt = 0u; mine = 0u;
#pragma unroll
        for (unsigned j = 0; j < 16; ++j) { const unsigned c = xb_ld(&bar[XB_XCNT(j)]); sum += c; cnt += (c > 0u) ? 1u : 0u; mine = (j == x) ? c : mine; }
        if (sum == G) break;
        __builtin_amdgcn_s_sleep(1);
        if ((++sp & 255u) == 0u) { if (xb_ld(&bar[XB_TMO])) break; if (sp > XB_SPIN_CAP) { atomicAdd(&bar[XB_TMO], 1u); break; } }
    }
    nloc = mine > 0u ? mine : 1u; nx = cnt > 0u ? cnt : 1u;
}
__device__ __forceinline__ void xcd_barrier(const XcdBarrier& b, bool leader) {
    asm volatile("s_waitcnt vmcnt(0)" ::: "memory");
    __syncthreads();
    if (leader) {
        unsigned* bar = b.bar;
        __builtin_amdgcn_s_waitcnt(0);
        unsigned nloc = b.st[0], nx = b.st[1];
        if (nloc == 0u) { xcd_barrier_complete(bar, b.x, nloc, nx); b.st[0] = nloc; b.st[1] = nx; }
        const unsigned old = xb_add(&bar[XB_XSUB(b.x)], 1u);
        const unsigned gen = old / nloc;
        if (old + 1u == (gen + 1u) * nloc) {
            __builtin_amdgcn_fence(__ATOMIC_RELEASE, "agent");
            asm volatile("s_waitcnt vmcnt(0)" ::: "memory");
            const unsigned og = xb_add(&bar[XB_TOP], 1u);
            const unsigned tg = og / nx;
            if (og + 1u == (tg + 1u) * nx) xb_add(&bar[XB_TOPGEN], 1u);
            else XB_SPIN(xb_ld(&bar[XB_TOPGEN]) == tg, bar);
            __builtin_amdgcn_fence(__ATOMIC_ACQUIRE, "agent");
            xb_add(&bar[XB_XGEN(b.x)], 1u);
            asm volatile("s_waitcnt vmcnt(0)" ::: "memory");
        } else {
            XB_SPIN(xb_ld(&bar[XB_XGEN(b.x)]) == gen, bar);
            __builtin_amdgcn_fence(__ATOMIC_ACQUIRE, "agent");
            asm volatile("s_waitcnt vmcnt(0)" ::: "memory");
        }
    }
    __syncthreads();
}

struct Args { const float* in[30]; float* out; unsigned char* ws; };
enum { I_X = 0, I_META, I_LNIN_G, I_LNIN_B, I_WIN, I_GKW2, I_GKB, I_GNORM, I_MU, I_W0, I_W2, I_A0, I_A2, I_G2, I_KK, I_KA, I_RK, I_RLNG, I_RLNB, I_WOUT,
       I_LN1G, I_LN1B, I_RTW, I_RTB, I_WUP, I_BUP, I_WDN, I_BDN, I_LN2G, I_LN2B };
struct Frame { LAS unsigned char* lds; int tid, lane, wave, blk, G; };
__device__ __forceinline__ int lane_id() { int l = (int)__builtin_amdgcn_mbcnt_hi(~0u, __builtin_amdgcn_mbcnt_lo(~0u, 0u)); asm volatile("" : "+v"(l)); return l; }
__device__ __forceinline__ Frame mkframe(LAS unsigned char* lds, int wave) { Frame F; F.lds = lds; F.wave = wave; F.lane = lane_id(); F.tid = wave * 64 + F.lane; F.blk = blockIdx.x; F.G = gridDim.x; return F; }

__device__ __forceinline__ void transpose_item(const float* W, int K, int N, int nblk, bf16* WT, LAS float* scr, int item, int lane) {
    const int kb = item / nblk, nb = item - kb * nblk, k0 = 64 * kb, n0 = 32 * nb;
    const int nn = n0 + (lane & 31); const bool ok = nn < N;
#pragma unroll 8
    for (int i = 0; i < 32; ++i) { const int kk = 2 * i + (lane >> 5); scr[kk * 33 + (lane & 31)] = ok ? W[(size_t)(k0 + kk) * N + nn] : 0.f; }
    LDS_WAIT();
    const int c = lane & 7;
#pragma unroll
    for (int j = 0; j < 4; ++j) { const int n = (lane >> 3) + 8 * j; const LAS float* s = scr + (8 * c) * 33 + n;
        v4u o; o.x = pk2(s[0 * 33], s[1 * 33]); o.y = pk2(s[2 * 33], s[3 * 33]); o.z = pk2(s[4 * 33], s[5 * 33]); o.w = pk2(s[6 * 33], s[7 * 33]);
        *(v4u*)(WT + (size_t)(n0 + n) * K + k0 + 8 * c) = o; }
    LDS_WAIT();
}

__device__ __forceinline__ void phase0(const Args& a, const Frame& F) {
    unsigned char* ws = a.ws;
    const int gw = F.blk * NWAVES + F.wave, NGW = F.G * NWAVES;
    for (int cgp = F.blk; cgp < 53; cgp += F.G) {
        LAS float* HM = (LAS float*)F.lds;
        LAS float* PART = (LAS float*)(F.lds + 65536);
        for (int rr = 0; rr < 2; ++rr) {
            const int row = 2 * F.wave + rr; const f32x4* xr = (const f32x4*)(a.in[I_META] + row * D) + F.lane;
            f32x4 v[4]; float s = 0.f;
#pragma unroll
            for (int j = 0; j < 4; ++j) { v[j] = xr[64 * j]; s += (v[j].x + v[j].y) + (v[j].z + v[j].w); }
            const float mean = wave_sum(s) * (1.f / D); float s2 = 0.f;
#pragma unroll
            for (int j = 0; j < 4; ++j) { v[j] = v[j] - mean; s2 += (v[j].x * v[j].x + v[j].y * v[j].y) + (v[j].z * v[j].z + v[j].w * v[j].w); }
            const float rstd = 1.f / sqrtf(wave_sum(s2) * (1.f / D) + 1e-5f);
#pragma unroll
            for (int j = 0; j < 4; ++j) { const int col = 4 * (F.lane + 64 * j);
                const f32x4 gv = *(const f32x4*)(a.in[I_LNIN_G] + col), bv = *(const f32x4*)(a.in[I_LNIN_B] + col);
                const f32x4 y = v[j] * rstd * gv + bv;
                HM[(col + 0) * 16 + row] = y.x; HM[(col + 1) * 16 + row] = y.y; HM[(col + 2) * 16 + row] = y.z; HM[(col + 3) * 16 + row] = y.w; }
        }
        __syncthreads();
        const int col = cgp * 64 + F.lane; const bool ok = col < INW;
        float acc[16];
#pragma unroll
        for (int r = 0; r < 16; ++r) acc[r] = 0.f;
        const float* wp = a.in[I_WIN];
        for (int k = F.wave * 128; k < F.wave * 128 + 128; ++k) {
            const float wv = ok ? wp[(size_t)k * INW + col] : 0.f;
            const LAS f32x4* h = (const LAS f32x4*)(HM + k * 16);
#pragma unroll
            for (int q = 0; q < 4; ++q) { const f32x4 hv = h[q]; acc[4 * q + 0] += hv.x * wv; acc[4 * q + 1] += hv.y * wv; acc[4 * q + 2] += hv.z * wv; acc[4 * q + 3] += hv.w * wv; }
        }
#pragma unroll
        for (int r = 0; r < 16; ++r) PART[(F.wave * 16 + r) * 64 + F.lane] = acc[r];
        __syncthreads();
        float* PROJM = (float*)(ws + WS_PROJM);
        for (int o = F.tid; o < 1024; o += NTHR) { const int r = o >> 6, l = o & 63; float s = 0.f;
#pragma unroll
            for (int w = 0; w < 8; ++w) s += PART[(w * 16 + r) * 64 + l];
            PROJM[r * PW + cgp * 64 + l] = s; }
        __syncthreads();
    }
    {
        LAS float* scr = (LAS float*)(F.lds + F.wave * 16384);
        constexpr int I_IN = 16 * (PW / 32), I_OUT = 16 * 32;
        for (int it = gw; it < I_IN + I_OUT; it += NGW) {
            if (it < I_IN) transpose_item(a.in[I_WIN], D, INW, PW / 32, (bf16*)(ws + WS_WIN), scr, it, F.lane);
            else transpose_item(a.in[I_WOUT], D, D, 32, (bf16*)(ws + WS_WOUT), scr, it - I_IN, F.lane);
        }
    }
    {
        bf16* W2T = (bf16*)(ws + WS_W2T); bf16* A2T = (bf16*)(ws + WS_A2T); bf16* G2T = (bf16*)(ws + WS_G2T);
        for (int i = F.blk * NTHR + F.tid; i < 131072; i += F.G * NTHR) {
            if (i < 32768) { const int n = i >> 6, k = i & 63; W2T[i] = (bf16)f2bf(a.in[I_W2][k * 512 + n]); }
            else if (i < 65536) { const int j = i - 32768, n = j >> 6, k = j & 63; A2T[j] = (bf16)f2bf(a.in[I_A2][k * 512 + n]); }
            else { const int j = i - 65536, n = j >> 7, k = j & 127; G2T[j] = (bf16)f2bf(a.in[I_G2][k * 512 + n]); }
        }
    }
    {
        bf16* A0 = (bf16*)(ws + WS_A0); float* ST = (float*)(ws + WS_STATS);
        for (int m = gw; m < MX; m += NGW) {
            const f32x4* xr = (const f32x4*)(a.in[I_X] + (size_t)m * D) + F.lane;
            f32x4 v[4]; float s = 0.f;
#pragma unroll
            for (int j = 0; j < 4; ++j) { v[j] = xr[64 * j]; s += (v[j].x + v[j].y) + (v[j].z + v[j].w); }
            const float mean = wave_sum(s) * (1.f / D); float s2 = 0.f;
#pragma unroll
            for (int j = 0; j < 4; ++j) { v[j] = v[j] - mean; s2 += (v[j].x * v[j].x + v[j].y * v[j].y) + (v[j].z * v[j].z + v[j].w * v[j].w); }
            const float rstd = 1.f / sqrtf(wave_sum(s2) * (1.f / D) + 1e-5f);
#pragma unroll
            for (int j = 0; j < 4; ++j) { const int col = 4 * (F.lane + 64 * j);
                const f32x4 gv = *(const f32x4*)(a.in[I_LNIN_G] + col), bv = *(const f32x4*)(a.in[I_LNIN_B] + col);
                const f32x4 y = v[j] * rstd * gv + bv;
                v2u o; o.x = pk2(y.x, y.y); o.y = pk2(y.z, y.w);
                *(v2u*)(A0 + (size_t)m * D + col) = o; }
            if (F.lane == 0) { ST[2 * m] = mean; ST[2 * m + 1] = rstd; }
        }
    }
}

__device__ __forceinline__ f32x4 ldp4(const bf16* PROJ, const float* PROJM, int b, int vp, int col) {
    f32x4 r = {0.f, 0.f, 0.f, 0.f};
    if (vp >= NMETA) { const v2u w = *(const v2u*)(PROJ + (size_t)(b * SEQ + vp - NMETA) * PW + col); r.x = bflo(w.x); r.y = bfhi(w.x); r.z = bflo(w.y); r.w = bfhi(w.y); }
    else if (vp >= 0) { r = *(const f32x4*)(PROJM + vp * PW + col); }
    return r;
}

__device__ __forceinline__ void rwkv_prep_unit(const Args& a, const Frame& F, int b, int vp0, int ntok) {
    unsigned char* ws = a.ws;
    const bf16* PROJ = (const bf16*)(ws + WS_PROJ); const float* PROJM = (const float*)(ws + WS_PROJM);
    const bf16* W2T = (const bf16*)(ws + WS_W2T); const bf16* A2T = (const bf16*)(ws + WS_A2T); const bf16* G2T = (const bf16*)(ws + WS_G2T);
    float* OPS = (float*)(ws + WS_OPS); float* OPSM = (float*)(ws + WS_OPSM); bf16* GR = (bf16*)(ws + WS_GR); float* BON = (float*)(ws + WS_BON);
    const float* mu = a.in[I_MU];
    constexpr int LRP = 264;
    LAS bf16* LR = (LAS bf16*)F.lds;
    {
        const int cg = F.tid & 31, tr = F.tid >> 5;
        const int col = RWL + 8 * cg;
        const f32x4 m0 = *(const f32x4*)(mu + 1536 + 8 * cg), m1 = *(const f32x4*)(mu + 1536 + 8 * cg + 4);
#pragma unroll
        for (int i = 0; i < 4; ++i) {
            const int row = 4 * tr + i;
            if (row < ntok) {
                const int vp = vp0 + row;
                const f32x4 c0 = ldp4(PROJ, PROJM, b, vp, col), c1 = ldp4(PROJ, PROJM, b, vp, col + 4);
                const f32x4 p0 = ldp4(PROJ, PROJM, b, vp - 1, col), p1 = ldp4(PROJ, PROJM, b, vp - 1, col + 4);
                float v[8];
                v[0] = c0.x + (p0.x - c0.x) * m0.x; v[1] = c0.y + (p0.y - c0.y) * m0.y; v[2] = c0.z + (p0.z - c0.z) * m0.z; v[3] = c0.w + (p0.w - c0.w) * m0.w;
                v[4] = c1.x + (p1.x - c1.x) * m1.x; v[5] = c1.y + (p1.y - c1.y) * m1.y; v[6] = c1.z + (p1.z - c1.z) * m1.z; v[7] = c1.w + (p1.w - c1.w) * m1.w;
#pragma unroll
                for (int q = 0; q < 8; ++q) { if (cg < 8) v[q] = tanhf(v[q]); else if (cg >= 16) v[q] = sigmoid_f(v[q]); }
                v4u o; o.x = pk2(v[0], v[1]); o.y = pk2(v[2], v[3]); o.z = pk2(v[4], v[5]); o.w = pk2(v[6], v[7]);
                *(LAS v4u*)(LR + row * LRP + 8 * cg) = o;
            }
        }
    }
    __syncthreads();
    const int rt = F.wave & 3, hg = F.wave >> 2, fr = F.lane & 15, fq = F.lane >> 4;
    if (rt * 16 < ntok) {
        const int trow = rt * 16 + fr, vp = vp0 + trow;
        const LAS bf16* lrow = LR + trow * LRP + 8 * fq;
        for (int hh = 0; hh < 4; ++hh) {
            const int h = hg * 4 + hh;
            f32x4 aw[4], aa[4], ag[4];
#pragma unroll
            for (int ct = 0; ct < 4; ++ct) {
                aw[ct] = (f32x4){0.f, 0.f, 0.f, 0.f}; aa[ct] = aw[ct]; ag[ct] = aw[ct];
                const int n = h * 64 + ct * 16 + fr;
#pragma unroll
                for (int ks = 0; ks < 2; ++ks) {
                    aw[ct] = mfma16(*(const bf16x8*)(W2T + (size_t)n * 64 + ks * 32 + 8 * fq), *(const LAS bf16x8*)(lrow + ks * 32), aw[ct]);
                    aa[ct] = mfma16(*(const bf16x8*)(A2T + (size_t)n * 64 + ks * 32 + 8 * fq), *(const LAS bf16x8*)(lrow + 64 + ks * 32), aa[ct]);
                }
#pragma unroll
                for (int ks = 0; ks < 4; ++ks)
                    ag[ct] = mfma16(*(const bf16x8*)(G2T + (size_t)n * 128 + ks * 32 + 8 * fq), *(const LAS bf16x8*)(lrow + 128 + ks * 32), ag[ct]);
            }
            float kkr[4][4], asg[4][4];
            float ssq = 0.f, bon = 0.f;
            float* op;
            if (vp >= NMETA) op = OPS + ((size_t)(b * 8 + h) * SEQ + (vp - NMETA)) * 384;
            else op = OPSM + (size_t)(h * 16 + vp) * 384;
#pragma unroll
            for (int ct = 0; ct < 4; ++ct) {
                const int j = ct * 16 + 4 * fq, jc = h * 64 + j;
                const f32x4 rc = ldp4(PROJ, PROJM, b, vp, RR + jc), rp = ldp4(PROJ, PROJM, b, vp - 1, RR + jc), mr = *(const f32x4*)(mu + jc);
                const f32x4 kc = ldp4(PROJ, PROJM, b, vp, RK + jc), kp = ldp4(PROJ, PROJM, b, vp - 1, RK + jc), mk = *(const f32x4*)(mu + 512 + jc);
                const f32x4 vc = ldp4(PROJ, PROJM, b, vp, RV + jc), vpv = ldp4(PROJ, PROJM, b, vp - 1, RV + jc), mv = *(const f32x4*)(mu + 1024 + jc);
                const f32x4 rs = rc + (rp - rc) * mr, ks_ = kc + (kp - kc) * mk, vs = vc + (vpv - vc) * mv;
                const f32x4 w0v = *(const f32x4*)(a.in[I_W0] + jc), a0v = *(const f32x4*)(a.in[I_A0] + jc);
                const f32x4 kkw = *(const f32x4*)(a.in[I_KK] + jc), kaw = *(const f32x4*)(a.in[I_KA] + jc), rkw = *(const f32x4*)(a.in[I_RK] + jc);
                f32x4 o0, o3;
#pragma unroll
                for (int i = 0; i < 4; ++i) {
                    const float u = w0v[i] + aw[ct][i];
                    const float wl = -softplus_f(-u) - 0.5f;
                    o0[i] = expf(-expf(wl));
                    const float as_ = sigmoid_f(a0v[i] + aa[ct][i]);
                    asg[ct][i] = as_;
                    const float kraw = ks_[i];
                    const float kk = kraw * kkw[i];
                    kkr[ct][i] = kk; ssq += kk * kk;
                    const float km = kraw * (1.f + (as_ - 1.f) * kaw[i]);
                    o3[i] = km;
                    bon += rs[i] * km * rkw[i];
                }
                *(f32x4*)(op + 0 * 64 + j) = o0; *(f32x4*)(op + 3 * 64 + j) = o3; *(f32x4*)(op + 4 * 64 + j) = rs; *(f32x4*)(op + 5 * 64 + j) = vs;
                if (vp >= NMETA) { const size_t m = (size_t)b * SEQ + (vp - NMETA);
                    v2u g; g.x = pk2(ag[ct][0], ag[ct][1]); g.y = pk2(ag[ct][2], ag[ct][3]);
                    *(v2u*)(GR + m * 512 + h * 64 + j) = g; }
            }
            ssq += __shfl_xor(ssq, 16); ssq += __shfl_xor(ssq, 32);
            bon += __shfl_xor(bon, 16); bon += __shfl_xor(bon, 32);
            const float inv = 1.f / fmaxf(sqrtf(ssq), 1e-12f);
#pragma unroll
            for (int ct = 0; ct < 4; ++ct) {
                const int j = ct * 16 + 4 * fq;
                f32x4 o1, o2;
#pragma unroll
                for (int i = 0; i < 4; ++i) { const float kn = kkr[ct][i] * inv; o1[i] = -kn; o2[i] = kn * asg[ct][i]; }
                *(f32x4*)(op + 1 * 64 + j) = o1; *(f32x4*)(op + 2 * 64 + j) = o2;
            }
            if (vp >= NMETA && fq == 0) BON[((size_t)b * SEQ + (vp - NMETA)) * 8 + h] = bon;
        }
    }
    __syncthreads();
}

constexpr int BCP = 65;
__device__ __forceinline__ void gla_bc(const Args& a, const Frame& F, int b, int h, int vp0, int ntok) {
    const bf16* PROJ = (const bf16*)(a.ws + WS_PROJ); const float* PROJM = (const float*)(a.ws + WS_PROJM);
    LAS float* GKLs = (LAS float*)F.lds; LAS float* BC = (LAS float*)(F.lds + 4096);
    if (F.tid < 256) { const int t = F.tid >> 2, q = F.tid & 3;
        f32x4 v = {0.f, 0.f, 0.f, 0.f}; if (t < ntok) v = ldp4(PROJ, PROJM, b, vp0 + t, GKL + 4 * q);
        *(LAS f32x4*)(GKLs + t * 16 + 4 * q) = v; }
    __syncthreads();
    {
        const int d = F.tid & 63, tg = F.tid >> 6;
        float wc[16];
#pragma unroll
        for (int r = 0; r < 16; ++r) wc[r] = a.in[I_GKW2][r * 256 + h * 64 + d];
        const float gb = a.in[I_GKB][h * 64 + d];
#pragma unroll
        for (int i = 0; i < 8; ++i) { const int t = tg * 8 + i; float z = gb;
            const LAS f32x4* g4 = (const LAS f32x4*)(GKLs + t * 16);
#pragma unroll
            for (int q = 0; q < 4; ++q) { const f32x4 gv = g4[q]; z += gv.x * wc[4 * q] + gv.y * wc[4 * q + 1] + gv.z * wc[4 * q + 2] + gv.w * wc[4 * q + 3]; }
            BC[t * BCP + d] = (t < ntok) ? logsigmoid_f(z) * (1.f / 16.f) : 0.f; }
    }
    __syncthreads();
    if (F.tid < 64) { float run = 0.f;
#pragma unroll 8
        for (int t = 0; t < 64; ++t) { run += BC[t * BCP + F.tid]; BC[t * BCP + F.tid] = run; } }
    __syncthreads();
}

__device__ __forceinline__ void gla_g1_unit(const Args& a, const Frame& F, int b, int h, int c) {
    const bf16* PROJ = (const bf16*)(a.ws + WS_PROJ); const float* PROJM = (const float*)(a.ws + WS_PROJM);
    float* GUS = (float*)(a.ws + WS_GUS); float* DL = (float*)(a.ws + WS_DL);
    const int ntok = (c == 0) ? NMETA : 64, vp0 = (c == 0) ? 0 : NMETA + 64 * (c - 1);
    gla_bc(a, F, b, h, vp0, ntok);
    LAS float* BC = (LAS float*)(F.lds + 4096);
    constexpr int TP = 72;
    LAS bf16* KT = (LAS bf16*)(F.lds + 24576);
    LAS bf16* VT = (LAS bf16*)(F.lds + 24576 + 64 * TP * 2);
    {
        const int t = F.tid >> 3, q = F.tid & 7;
        const float* bl = nullptr; (void)bl;
#pragma unroll
        for (int half = 0; half < 2; ++half) {
            const int d0 = 8 * q + 4 * half;
            f32x4 kv = {0.f, 0.f, 0.f, 0.f}; if (t < ntok) kv = ldp4(PROJ, PROJM, b, vp0 + t, GK + h * 64 + d0);
#pragma unroll
            for (int i = 0; i < 4; ++i) { const int d = d0 + i; const float e = (t < ntok) ? expf(BC[(ntok - 1) * BCP + d] - BC[t * BCP + d]) : 0.f;
                KT[d * TP + t] = (bf16)f2bf(kv[i] * e); }
        }
#pragma unroll
        for (int qq = 0; qq < 4; ++qq) {
            const int e0 = 16 * q + 4 * qq;
            f32x4 vv = {0.f, 0.f, 0.f, 0.f}; if (t < ntok) vv = ldp4(PROJ, PROJM, b, vp0 + t, GV + h * 128 + e0);
#pragma unroll
            for (int i = 0; i < 4; ++i) VT[(e0 + i) * TP + t] = (bf16)f2bf(vv[i]);
        }
    }
    __syncthreads();
    {
        const int rt = F.wave & 3, ch = F.wave >> 2, fr = F.lane & 15, fq = F.lane >> 4;
        float* up = GUS + ((size_t)((b * 4 + h) * NCH + c) * 64 + rt * 16 + fr) * 128;
#pragma unroll
        for (int cc = 0; cc < 4; ++cc) { const int ct = ch * 4 + cc;
            f32x4 acc = {0.f, 0.f, 0.f, 0.f};
#pragma unroll
            for (int ks = 0; ks < 2; ++ks)
                acc = mfma16(*(const LAS bf16x8*)(VT + (ct * 16 + fr) * TP + ks * 32 + 8 * fq), *(const LAS bf16x8*)(KT + (rt * 16 + fr) * TP + ks * 32 + 8 * fq), acc);
            *(f32x4*)(up + ct * 16 + 4 * fq) = acc; }
        if (F.tid < 64) DL[(size_t)((b * 4 + h) * NCH + c) * 64 + F.tid] = expf(BC[(ntok - 1) * BCP + F.tid]);
    }
    __syncthreads();
}

__device__ __forceinline__ void phase2(const Args& a, const Frame& F) {
    if (F.blk == 0) rwkv_prep_unit(a, F, 0, 0, NMETA);
    for (int u = F.blk; u < NB * 32; u += F.G) rwkv_prep_unit(a, F, u >> 5, NMETA + 64 * (u & 31), 64);
    for (int u = F.blk; u < NB * 4 * 32; u += F.G) { const int c = u & 31, bh = u >> 5; gla_g1_unit(a, F, bh >> 2, bh & 3, c); }
}

__device__ __forceinline__ void rwkv_scan_unit(const Args& a, const Frame& F, int bh) {
    const float* OPS = (const float*)(a.ws + WS_OPS); const float* OPSM = (const float*)(a.ws + WS_OPSM); float* YRAW = (float*)(a.ws + WS_YRAW);
    const int b = bh >> 3, h = bh & 7;
    constexpr int TS = 16, CHF = TS * 384;
    LAS float* buf0 = (LAS float*)F.lds; LAS float* buf1 = buf0 + CHF;
    const int r = F.lane >> 3, c = F.lane & 7, row = 8 * F.wave + r;
    float S[8];
#pragma unroll
    for (int q = 0; q < 8; ++q) S[q] = 0.f;
    const float* opsx = OPS + (size_t)bh * SEQ * 384;
    f32x4 st[3];
    { const f32x4* src = (const f32x4*)(OPSM + (size_t)h * 16 * 384);
#pragma unroll
      for (int j = 0; j < 3; ++j) st[j] = src[F.tid + NTHR * j];
#pragma unroll
      for (int j = 0; j < 3; ++j) ((LAS f32x4*)buf0)[F.tid + NTHR * j] = st[j]; }
    __syncthreads();
    constexpr int NCHK = 1 + SEQ / TS;
    float ykeep = 0.f;
    float* yp = YRAW + ((size_t)b * SEQ + c) * 512 + h * 64 + row;
#pragma nounroll
    for (int ch = 0; ch < NCHK; ++ch) {
        LAS float* cur = (ch & 1) ? buf1 : buf0; LAS float* nxt = (ch & 1) ? buf0 : buf1;
        if (ch + 1 < NCHK) { const f32x4* src = (const f32x4*)(opsx + (size_t)ch * CHF);
#pragma unroll
            for (int j = 0; j < 3; ++j) st[j] = src[F.tid + NTHR * j]; }
#pragma nounroll
        for (int g8 = 0; g8 < 2; ++g8) {
            const LAS float* cb = cur + g8 * (8 * 384);
#pragma unroll
            for (int s = 0; s < 8; ++s) {
                const LAS float* o = cb + s * 384 + 8 * c;
                const f32x4 w0 = *(const LAS f32x4*)(o), w1 = *(const LAS f32x4*)(o + 4);
                const f32x4 a0 = *(const LAS f32x4*)(o + 64), a1 = *(const LAS f32x4*)(o + 68);
                const f32x4 b0 = *(const LAS f32x4*)(o + 128), b1 = *(const LAS f32x4*)(o + 132);
                const f32x4 k0 = *(const LAS f32x4*)(o + 192), k1 = *(const LAS f32x4*)(o + 196);
                const f32x4 r0 = *(const LAS f32x4*)(o + 256), r1 = *(const LAS f32x4*)(o + 260);
                const float v = cb[s * 384 + 320 + row];
                float p = (S[0] * a0.x + S[1] * a0.y) + (S[2] * a0.z + S[3] * a0.w) + ((S[4] * a1.x + S[5] * a1.y) + (S[6] * a1.z + S[7] * a1.w));
                p = red8(p);
                S[0] = S[0] * w0.x + (p * b0.x + v * k0.x); S[1] = S[1] * w0.y + (p * b0.y + v * k0.y); S[2] = S[2] * w0.z + (p * b0.z + v * k0.z); S[3] = S[3] * w0.w + (p * b0.w + v * k0.w);
                S[4] = S[4] * w1.x + (p * b1.x + v * k1.x); S[5] = S[5] * w1.y + (p * b1.y + v * k1.y); S[6] = S[6] * w1.z + (p * b1.z + v * k1.z); S[7] = S[7] * w1.w + (p * b1.w + v * k1.w);
                float y = (S[0] * r0.x + S[1] * r0.y) + (S[2] * r0.z + S[3] * r0.w) + ((S[4] * r1.x + S[5] * r1.y) + (S[6] * r1.z + S[7] * r1.w));
                y = red8(y);
                if (c == s) ykeep = y;
            }
            if (ch > 0) { *yp = ykeep; yp += 8 * 512; }
        }
        if (ch + 1 < NCHK) {
#pragma unroll
            for (int j = 0; j < 3; ++j) ((LAS f32x4*)nxt)[F.tid + NTHR * j] = st[j]; }
        __syncthreads();
    }
}
__device__ __forceinline__ void gla_scan_unit(const Args& a, const Frame& F, int j) {
    float* GUS = (float*)(a.ws + WS_GUS); const float* DL = (const float*)(a.ws + WS_DL);
    const int bh = j >> 1, half = j & 1;
    const int d = 32 * half + (F.tid >> 4), e0 = (F.tid & 15) * 8;
    float* base = GUS + (size_t)bh * NCH * 8192 + d * 128 + e0;
    const float* dl = DL + (size_t)bh * NCH * 64 + d;
    f32x4 s0 = {0.f, 0.f, 0.f, 0.f}, s1 = s0;
    f32x4 u0 = *(const f32x4*)(base), u1 = *(const f32x4*)(base + 4); float dc = dl[0];
    for (int c = 0; c < NCH - 1; ++c) {
        f32x4 n0 = u0, n1 = u1; float dn = dc;
        if (c + 1 < NCH - 1) { n0 = *(const f32x4*)(base + (size_t)(c + 1) * 8192); n1 = *(const f32x4*)(base + (size_t)(c + 1) * 8192 + 4); dn = dl[(c + 1) * 64]; }
        *(f32x4*)(base + (size_t)c * 8192) = s0; *(f32x4*)(base + (size_t)c * 8192 + 4) = s1;
        s0 = s0 * dc + u0; s1 = s1 * dc + u1;
        u0 = n0; u1 = n1; dc = dn;
    }
    *(f32x4*)(base + (size_t)(NCH - 1) * 8192) = s0; *(f32x4*)(base + (size_t)(NCH - 1) * 8192 + 4) = s1;
}
__device__ __forceinline__ void phase3(const Args& a, const Frame& F) {
    for (int u = F.blk; u < 256; u += F.G) { if (u < 128) rwkv_scan_unit(a, F, u); else gla_scan_unit(a, F, u - 128); }
}

__device__ __forceinline__ void gla_g3_unit(const Args& a, const Frame& F, int b, int h, int c) {
    const bf16* PROJ = (const bf16*)(a.ws + WS_PROJ); const float* PROJM = (const float*)(a.ws + WS_PROJM);
    const float* GUS = (const float*)(a.ws + WS_GUS); bf16* YMIX = (bf16*)(a.ws + WS_YMIX);
    const int vp0 = NMETA + 64 * (c - 1);
    gla_bc(a, F, b, h, vp0, 64);
    LAS float* BC = (LAS float*)(F.lds + 4096);
    constexpr int TP = 72;
    LAS bf16* QT = (LAS bf16*)(F.lds + 24576);
    LAS bf16* KL = QT + 64 * TP;
    LAS bf16* AT = KL + 64 * TP;
    LAS bf16* VT = AT + 64 * TP;
    LAS bf16* ST = VT + 128 * TP;
    LAS float* RS = (LAS float*)(ST + 128 * TP);
    {
        const int t = F.tid >> 3, q = F.tid & 7;
        const f32x4 q0 = ldp4(PROJ, PROJM, b, vp0 + t, GQ + h * 64 + 8 * q), q1 = ldp4(PROJ, PROJM, b, vp0 + t, GQ + h * 64 + 8 * q + 4);
        const f32x4 k0 = ldp4(PROJ, PROJM, b, vp0 + t, GK + h * 64 + 8 * q), k1 = ldp4(PROJ, PROJM, b, vp0 + t, GK + h * 64 + 8 * q + 4);
        float qv[8] = {q0.x, q0.y, q0.z, q0.w, q1.x, q1.y, q1.z, q1.w}, kv[8] = {k0.x, k0.y, k0.z, k0.w, k1.x, k1.y, k1.z, k1.w};
#pragma unroll
        for (int i = 0; i < 8; ++i) { const float bcv = BC[t * BCP + 8 * q + i]; qv[i] *= expf(bcv) * 0.125f; kv[i] *= expf(-bcv); }
        v4u o; o.x = pk2(qv[0], qv[1]); o.y = pk2(qv[2], qv[3]); o.z = pk2(qv[4], qv[5]); o.w = pk2(qv[6], qv[7]);
        *(LAS v4u*)(QT + t * TP + 8 * q) = o;
        o.x = pk2(kv[0], kv[1]); o.y = pk2(kv[2], kv[3]); o.z = pk2(kv[4], kv[5]); o.w = pk2(kv[6], kv[7]);
        *(LAS v4u*)(KL + t * TP + 8 * q) = o;
#pragma unroll
        for (int qq = 0; qq < 4; ++qq) {
            const int e0 = 16 * q + 4 * qq;
            const f32x4 vv = ldp4(PROJ, PROJM, b, vp0 + t, GV + h * 128 + e0);
#pragma unroll
            for (int i = 0; i < 4; ++i) VT[(e0 + i) * TP + t] = (bf16)f2bf(vv[i]);
            const f32x4 sv = *(const f32x4*)(GUS + ((size_t)((b * 4 + h) * NCH + c) * 64 + t) * 128 + e0);
#pragma unroll
            for (int i = 0; i < 4; ++i) ST[(e0 + i) * TP + t] = (bf16)f2bf(sv[i]);
        }
    }
    __syncthreads();
    const int rt = F.wave & 3, wh = F.wave >> 2, fr = F.lane & 15, fq = F.lane >> 4;
    const int trow = rt * 16 + fr;
    {
#pragma unroll
        for (int cc = 0; cc < 2; ++cc) { const int ct = 2 * wh + cc;
            f32x4 acc = {0.f, 0.f, 0.f, 0.f};
#pragma unroll
            for (int ks = 0; ks < 2; ++ks)
                acc = mfma16(*(const LAS bf16x8*)(KL + (ct * 16 + fr) * TP + ks * 32 + 8 * fq), *(const LAS bf16x8*)(QT + trow * TP + ks * 32 + 8 * fq), acc);
            const int s0 = ct * 16 + 4 * fq;
#pragma unroll
            for (int i = 0; i < 4; ++i) if (s0 + i > trow) acc[i] = 0.f;
            v2u o; o.x = pk2(acc[0], acc[1]); o.y = pk2(acc[2], acc[3]);
            *(LAS v2u*)(AT + trow * TP + s0) = o; }
    }
    __syncthreads();
    f32x4 oacc[4]; float ssq = 0.f;
#pragma unroll
    for (int cc = 0; cc < 4; ++cc) { const int ct = wh * 4 + cc;
        f32x4 acc = {0.f, 0.f, 0.f, 0.f};
#pragma unroll
        for (int ks = 0; ks < 2; ++ks) {
            acc = mfma16(*(const LAS bf16x8*)(VT + (ct * 16 + fr) * TP + ks * 32 + 8 * fq), *(const LAS bf16x8*)(AT + trow * TP + ks * 32 + 8 * fq), acc);
            acc = mfma16(*(const LAS bf16x8*)(ST + (ct * 16 + fr) * TP + ks * 32 + 8 * fq), *(const LAS bf16x8*)(QT + trow * TP + ks * 32 + 8 * fq), acc);
        }
        oacc[cc] = acc; ssq += (acc[0] * acc[0] + acc[1] * acc[1]) + (acc[2] * acc[2] + acc[3] * acc[3]); }
    ssq += __shfl_xor(ssq, 16); ssq += __shfl_xor(ssq, 32);
    if (fq == 0) RS[wh * 64 + trow] = ssq;
    __syncthreads();
    {
        const float tot = RS[trow] + RS[64 + trow];
        const float rstd = 1.f / sqrtf(tot * (1.f / 128.f) + 1e-6f);
        const size_t m = (size_t)b * SEQ + (vp0 - NMETA) + trow;
#pragma unroll
        for (int cc = 0; cc < 4; ++cc) { const int e0 = (wh * 4 + cc) * 16 + 4 * fq;
            const f32x4 gv = ldp4(PROJ, PROJM, b, vp0 + trow, GG + h * 128 + e0);
            const f32x4 ng = *(const f32x4*)(a.in[I_GNORM] + e0);
            float y[4];
#pragma unroll
            for (int i = 0; i < 4; ++i) { const float gi = gv[i]; y[i] = oacc[cc][i] * rstd * ng[i] * (gi * sigmoid_f(gi)); }
            v2u o; o.x = pk2(y[0], y[1]); o.y = pk2(y[2], y[3]);
            *(v2u*)(YMIX + m * D + h * 128 + e0) = o; }
    }
    __syncthreads();
}
__device__ __forceinline__ void rwkv_epi_token(const Args& a, const Frame& F, int m) {
    const float* YRAW = (const float*)(a.ws + WS_YRAW); const float* OPS = (const float*)(a.ws + WS_OPS); const bf16* GR = (const bf16*)(a.ws + WS_GR);
    const float* BON = (const float*)(a.ws + WS_BON); bf16* YMIX = (bf16*)(a.ws + WS_YMIX);
    const int b = m >> 11, t = m & 2047, h = F.lane >> 3, sub = F.lane & 7, ch = h * 64 + 8 * sub;
    const f32x4 y0 = *(const f32x4*)(YRAW + (size_t)m * 512 + ch), y1 = *(const f32x4*)(YRAW + (size_t)m * 512 + ch + 4);
    float y[8] = {y0.x, y0.y, y0.z, y0.w, y1.x, y1.y, y1.z, y1.w};
    float s = 0.f;
#pragma unroll
    for (int i = 0; i < 8; ++i) s += y[i];
    s += __shfl_xor(s, 1); s += __shfl_xor(s, 2); s += __shfl_xor(s, 4);
    const float mean = s * (1.f / 64.f); float q = 0.f;
#pragma unroll
    for (int i = 0; i < 8; ++i) { y[i] -= mean; q += y[i] * y[i]; }
    q += __shfl_xor(q, 1); q += __shfl_xor(q, 2); q += __shfl_xor(q, 4);
    const float rstd = 1.f / sqrtf(q * (1.f / 64.f) + 64e-5f);
    const float* vp = OPS + ((size_t)(b * 8 + h) * SEQ + t) * 384 + 5 * 64 + 8 * sub;
    const f32x4 v0 = *(const f32x4*)(vp), v1 = *(const f32x4*)(vp + 4);
    const float vv[8] = {v0.x, v0.y, v0.z, v0.w, v1.x, v1.y, v1.z, v1.w};
    const float bon = BON[(size_t)m * 8 + h];
    const v4u gw = *(const v4u*)(GR + (size_t)m * 512 + ch);
    const float g[8] = {bflo(gw.x), bfhi(gw.x), bflo(gw.y), bfhi(gw.y), bflo(gw.z), bfhi(gw.z), bflo(gw.w), bfhi(gw.w)};
    const f32x4 lg0 = *(const f32x4*)(a.in[I_RLNG] + ch), lg1 = *(const f32x4*)(a.in[I_RLNG] + ch + 4), lb0 = *(const f32x4*)(a.in[I_RLNB] + ch), lb1 = *(const f32x4*)(a.in[I_RLNB] + ch + 4);
    const float lgv[8] = {lg0.x, lg0.y, lg0.z, lg0.w, lg1.x, lg1.y, lg1.z, lg1.w}, lbv[8] = {lb0.x, lb0.y, lb0.z, lb0.w, lb1.x, lb1.y, lb1.z, lb1.w};
    float o[8];
#pragma unroll
    for (int i = 0; i < 8; ++i) o[i] = ((y[i] * rstd) * lgv[i] + lbv[i] + bon * vv[i]) * g[i];
    v4u w; w.x = pk2(o[0], o[1]); w.y = pk2(o[2], o[3]); w.z = pk2(o[4], o[5]); w.w = pk2(o[6], o[7]);
    *(v4u*)(YMIX + (size_t)m * D + 512 + ch) = w;
}
__device__ __forceinline__ void phase4(const Args& a, const Frame& F) {
    const int gw = F.blk * NWAVES + F.wave, NGW = F.G * NWAVES;
    for (int m = gw; m < MX; m += NGW) rwkv_epi_token(a, F, m);
    for (int u = F.blk; u < NB * 4 * 32; u += F.G) { const int c = 1 + (u & 31), bh = u >> 5; gla_g3_unit(a, F, bh >> 2, bh & 3, c); }
}

__device__ __forceinline__ int eidx_of(int L) { return 16 * (L & 1) + 8 * ((L >> 1) & 1) + 4 * ((L >> 2) & 1) + 2 * ((L >> 3) & 1) + ((L >> 4) & 1); }
__device__ __forceinline__ void phase6(const Args& a, const Frame& F) {
    unsigned char* ws = a.ws;
    const int gw = F.blk * NWAVES + F.wave, NGW = F.G * NWAVES;
    {
        LAS float* scr = (LAS float*)(F.lds + F.wave * 16384);
        constexpr int I_UP = 16 * 64, I_DN = 16 * 32;
        for (int it = gw; it < NE * (I_UP + I_DN); it += NGW) {
            if (it < NE * I_UP) { const int e = it / I_UP, r = it - e * I_UP;
                transpose_item(a.in[I_WUP] + (size_t)e * D * 2048, D, 2048, 64, (bf16*)(ws + WS_WUP) + (size_t)e * 2048 * D, scr, r, F.lane); }
            else { const int it2 = it - NE * I_UP, e = it2 / I_DN, r = it2 - e * I_DN;
                transpose_item(a.in[I_WDN] + (size_t)e * D * D, D, D, 32, (bf16*)(ws + WS_WDN) + (size_t)e * D * D, scr, r, F.lane); }
        }
    }
    __syncthreads();
    constexpr int RWP = 1028;
    LAS float* rwT = (LAS float*)F.lds;
    LAS int* hist = (LAS int*)(F.lds + 32 * RWP * 4);
    for (int i = F.tid; i < D * NE; i += NTHR) { const int c = i >> 5, e = i & 31; rwT[e * RWP + c] = a.in[I_RTW][i]; }
    const float* S1 = (const float*)(ws + WS_S1); bf16* H1 = (bf16*)(ws + WS_H1);
    int* TOPI = (int*)(ws + WS_TOPI); float* GATE = (float*)(ws + WS_GATE); int* RANK = (int*)(ws + WS_RANK);
    unsigned* CNT = (unsigned*)(ws + WS_CTL) + CW_CNT;
    for (int rb = F.blk; rb < MX / 128; rb += F.G) {
        if (F.tid < 64) hist[F.tid] = 0;
        __syncthreads();
        int my_e = 0;
        for (int i = 0; i < 16; ++i) {
            const int m = rb * 128 + F.wave * 16 + i;
            const f32x4* xr = (const f32x4*)(S1 + (size_t)m * D) + F.lane;
            f32x4 v[4]; float s = 0.f;
#pragma unroll
            for (int j = 0; j < 4; ++j) { v[j] = xr[64 * j]; s += (v[j].x + v[j].y) + (v[j].z + v[j].w); }
            const float mean = wave_sum(s) * (1.f / D); float s2 = 0.f;
#pragma unroll
            for (int j = 0; j < 4; ++j) { v[j] = v[j] - mean; s2 += (v[j].x * v[j].x + v[j].y * v[j].y) + (v[j].z * v[j].z + v[j].w * v[j].w); }
            const float rstd = 1.f / sqrtf(wave_sum(s2) * (1.f / D) + 1e-5f);
#pragma unroll
            for (int j = 0; j < 4; ++j) { const int col = 4 * (F.lane + 64 * j);
                const f32x4 gv = *(const f32x4*)(a.in[I_LN1G] + col), bv = *(const f32x4*)(a.in[I_LN1B] + col);
                v[j] = v[j] * rstd * gv + bv;
                v2u o; o.x = pk2(v[j].x, v[j].y); o.y = pk2(v[j].z, v[j].w);
                *(v2u*)(H1 + (size_t)m * D + col) = o; }
            float p[32];
#pragma unroll
            for (int e = 0; e < 32; ++e) { float acc = 0.f;
#pragma unroll
                for (int j = 0; j < 4; ++j) { const f32x4 w = *(const LAS f32x4*)(rwT + e * RWP + 4 * (F.lane + 64 * j)); acc += (v[j].x * w.x + v[j].y * w.y) + (v[j].z * w.z + v[j].w * w.w); }
                p[e] = acc; if ((e & 3) == 3) __builtin_amdgcn_sched_barrier(0); }
#define TR_STAGE(n, dmask) _Pragma("unroll") for (int i2 = 0; i2 < (n) / 2; ++i2) { const bool up = (F.lane & (dmask)) != 0; const float keep = up ? p[i2 + (n) / 2] : p[i2]; const float send = up ? p[i2] : p[i2 + (n) / 2]; p[i2] = keep + __shfl_xor(send, (dmask)); }
            TR_STAGE(32, 1) TR_STAGE(16, 2) TR_STAGE(8, 4) TR_STAGE(4, 8) TR_STAGE(2, 16)
#undef TR_STAGE
            const int eidx = eidx_of(F.lane);
            const float logit = p[0] + __shfl_xor(p[0], 32) + a.in[I_RTB][eidx];
            int rank = 0;
#pragma unroll
            for (int j = 0; j < 32; ++j) { const float lj = __int_as_float(__builtin_amdgcn_readlane(__float_as_int(logit), j)); const int ej = eidx_of(j);
                rank += (lj > logit || (lj == logit && ej < eidx)) ? 1 : 0; }
            int ek[4]; float lk[4];
#pragma unroll
            for (int k = 0; k < 4; ++k) { const unsigned long long mk = __ballot(rank == k) & 0xffffffffull; const int src = __builtin_amdgcn_readfirstlane((int)__builtin_ctzll(mk | (1ull << 63)));
                ek[k] = eidx_of(src); lk[k] = __int_as_float(__builtin_amdgcn_readlane(__float_as_int(logit), src)); }
            const float e0 = 1.f, e1 = expf(lk[1] - lk[0]), e2 = expf(lk[2] - lk[0]), e3 = expf(lk[3] - lk[0]);
            const float inv = 1.f / (e0 + e1 + e2 + e3);
            if (F.lane < 4) { const int k = F.lane; const int ee = k == 0 ? ek[0] : k == 1 ? ek[1] : k == 2 ? ek[2] : ek[3]; const float gg = (k == 0 ? e0 : k == 1 ? e1 : k == 2 ? e2 : e3) * inv;
                TOPI[(size_t)m * 4 + k] = ee; GATE[(size_t)m * 4 + k] = gg; }
            if ((F.lane >> 2) == i) { const int k = F.lane & 3; my_e = k == 0 ? ek[0] : k == 1 ? ek[1] : k == 2 ? ek[2] : ek[3]; }
        }
        const int lrank = __hip_atomic_fetch_add(&hist[my_e], 1, __ATOMIC_RELAXED, __HIP_MEMORY_SCOPE_WORKGROUP);
        __syncthreads();
        if (F.tid < 32) hist[32 + F.tid] = (int)__hip_atomic_fetch_add(CNT + 64 * F.tid, (unsigned)hist[F.tid], __ATOMIC_RELAXED, __HIP_MEMORY_SCOPE_AGENT);
        __syncthreads();
        RANK[((size_t)rb * 128 + F.wave * 16 + (F.lane >> 2)) * 4 + (F.lane & 3)] = hist[32 + my_e] + lrank;
        __syncthreads();
    }
}

__device__ __forceinline__ void phase7(const Args& a, const Frame& F) {
    unsigned char* ws = a.ws;
    LAS int* starts = (LAS int*)F.lds;
    unsigned* CNT = (unsigned*)(ws + WS_CTL) + CW_CNT;
    int* TILEE = (int*)(ws + WS_TILEE);
    if (F.tid < 32) { const int cnt = (int)ld_agent(CNT + 64 * F.tid); starts[32 + F.tid] = (cnt + 255) & ~255; }
    __syncthreads();
    if (F.tid == 0) { int run = 0; for (int e = 0; e < 32; ++e) { starts[e] = run; run += starts[32 + e]; }
        if (F.blk == 0) { TILEE[1023] = run >> 8; for (int e = 0; e < 32; ++e) for (int tl = starts[e] >> 8; tl < (starts[e] + starts[32 + e]) >> 8; ++tl) TILEE[tl] = e; } }
    __syncthreads();
    const int* TOPI = (const int*)(ws + WS_TOPI); const int* RANK = (const int*)(ws + WS_RANK); int* TSLOT = (int*)(ws + WS_TSLOT);
    const bf16* H1 = (const bf16*)(ws + WS_H1); bf16* XS = (bf16*)(ws + WS_XS);
    const int gw = F.blk * NWAVES + F.wave, NGW = F.G * NWAVES;
    for (int q = gw; q < MX * 4; q += NGW) {
        const int m = q >> 2;
        const int e = TOPI[q], rk = RANK[q];
        const int slot = starts[e] + rk;
        if (F.lane == 0) TSLOT[q] = slot;
        const v4u* src = (const v4u*)(H1 + (size_t)m * D); v4u* dst = (v4u*)(XS + (size_t)slot * D);
        dst[F.lane] = src[F.lane]; dst[F.lane + 64] = src[F.lane + 64];
    }
}
__device__ __forceinline__ int moe_fill_table(const Args& a, const Frame& F, int nN, int RM) {
    LAS int* tab = (LAS int*)(F.lds + TAB_OFF);
    const unsigned* TILEE = (const unsigned*)(a.ws + WS_TILEE);
    if (F.tid == 0) {
        const int NT = (int)ld_agent(TILEE + 1023);
        const int x = F.blk & 7, j = F.blk >> 3; int n = 0;
        for (int i = 0; i < 64; ++i) { const int s = i * 8 + x, pm = s * RM + j / nN; if (pm >= NT) break;
            const int e = (int)ld_agent(TILEE + pm); tab[2 * n] = pm; tab[2 * n + 1] = e * nN + (j % nN); ++n; }
        tab[128] = n;
    }
    __syncthreads();
    return __builtin_amdgcn_readfirstlane(tab[128]);
}

__device__ __forceinline__ void phase10(const Args& a, const Frame& F) {
    unsigned char* ws = a.ws;
    const bf16* H1 = (const bf16*)(ws + WS_H1); const bf16* YS = (const bf16*)(ws + WS_YS);
    const int* TSLOT = (const int*)(ws + WS_TSLOT); const float* GATE = (const float*)(ws + WS_GATE);
    const int gw = F.blk * NWAVES + F.wave, NGW = F.G * NWAVES;
    for (int m = gw; m < MX; m += NGW) {
        float s[16];
#pragma unroll
        for (int j = 0; j < 2; ++j) { const v4u w = *(const v4u*)(H1 + (size_t)m * D + 8 * F.lane + 512 * j);
            s[8 * j + 0] = ALPHA * bflo(w.x); s[8 * j + 1] = ALPHA * bfhi(w.x); s[8 * j + 2] = ALPHA * bflo(w.y); s[8 * j + 3] = ALPHA * bfhi(w.y);
            s[8 * j + 4] = ALPHA * bflo(w.z); s[8 * j + 5] = ALPHA * bfhi(w.z); s[8 * j + 6] = ALPHA * bflo(w.w); s[8 * j + 7] = ALPHA * bfhi(w.w); }
#pragma unroll
        for (int k = 0; k < 4; ++k) { const int slot = TSLOT[(size_t)m * 4 + k]; const float g = GATE[(size_t)m * 4 + k];
#pragma unroll
            for (int j = 0; j < 2; ++j) { const v4u w = *(const v4u*)(YS + (size_t)slot * D + 8 * F.lane + 512 * j);
                s[8 * j + 0] += g * bflo(w.x); s[8 * j + 1] += g * bfhi(w.x); s[8 * j + 2] += g * bflo(w.y); s[8 * j + 3] += g * bfhi(w.y);
                s[8 * j + 4] += g * bflo(w.z); s[8 * j + 5] += g * bfhi(w.z); s[8 * j + 6] += g * bflo(w.w); s[8 * j + 7] += g * bfhi(w.w); } }
        float t = 0.f;
#pragma unroll
        for (int i = 0; i < 16; ++i) t += s[i];
        const float mean = wave_sum(t) * (1.f / D); float q = 0.f;
#pragma unroll
        for (int i = 0; i < 16; ++i) { s[i] -= mean; q += s[i] * s[i]; }
        const float rstd = 1.f / sqrtf(wave_sum(q) * (1.f / D) + 1e-5f);
#pragma unroll
        for (int j = 0; j < 2; ++j) { const int col = 8 * F.lane + 512 * j;
#pragma unroll
            for (int hh = 0; hh < 2; ++hh) { const f32x4 gv = *(const f32x4*)(a.in[I_LN2G] + col + 4 * hh), bv = *(const f32x4*)(a.in[I_LN2B] + col + 4 * hh);
                f32x4 o; o.x = s[8 * j + 4 * hh + 0] * rstd * gv.x + bv.x; o.y = s[8 * j + 4 * hh + 1] * rstd * gv.y + bv.y; o.z = s[8 * j + 4 * hh + 2] * rstd * gv.z + bv.z; o.w = s[8 * j + 4 * hh + 3] * rstd * gv.w + bv.w;
                *(f32x4*)(a.out + (size_t)m * D + col + 4 * hh) = o; } }
    }
}

template <int LO, int HI>
__global__ void __launch_bounds__(NTHR, 2) fwd(Args a) {
    extern __shared__ __attribute__((aligned(16))) unsigned char lds_raw[];
    LAS unsigned char* lds = (LAS unsigned char*)lds_raw;
    const int wave = __builtin_amdgcn_readfirstlane((int)(threadIdx.x >> 6));
    volatile LAS unsigned* MISC = (volatile LAS unsigned*)(lds + MISC_OFF);
    if (wave == 0) MISC[lane_id()] = 0u;
    __syncthreads();
    unsigned* ctl = (unsigned*)(a.ws + WS_CTL);
    XcdBarrier bar; bar.bar = ctl + CW_BAR; bar.x = 0; bar.st = nullptr;
    if constexpr (HI - LO > 1) bar = xcd_barrier_post(ctl + CW_BAR, MISC + 8, wave == 0 && lane_id() == 0);
#define PH(k) if constexpr (LO <= (k) && (k) < HI)
#define SEAM(k) if constexpr (LO <= (k) && (k) + 1 < HI) xcd_barrier(bar, wave == 0 && lane_id() == 0)
    PH(0) { const Frame F = mkframe(lds, wave); phase0(a, F); } SEAM(0);
    PH(1) { const Frame F = mkframe(lds, wave);
            pg8::Gemm g{(const pg8::bf16_t*)(a.ws + WS_A0), (const pg8::bf16_t*)(a.ws + WS_WIN), MX, PW, D}; pg8::StaticOrder S; S.init(MX, PW, F.G, F.blk);
            pg8::EpiBf16Plain E{(pg8::bf16_t*)(a.ws + WS_PROJ), PW};
            pg8::gemm_phase<pg8::EpiBf16Plain, pg8::StaticOrder, true, true>(F.lds, g, S, E, F.tid); } SEAM(1);
    PH(2) { const Frame F = mkframe(lds, wave); phase2(a, F); } SEAM(2);
    PH(3) { const Frame F = mkframe(lds, wave); phase3(a, F); } SEAM(3);
    PH(4) { const Frame F = mkframe(lds, wave); phase4(a, F); } SEAM(4);
    PH(5) { const Frame F = mkframe(lds, wave);
            pg8::Gemm g{(const pg8::bf16_t*)(a.ws + WS_YMIX), (const pg8::bf16_t*)(a.ws + WS_WOUT), MX, D, D}; pg8::StaticOrder S; S.init(MX, D, F.G, F.blk);
            pg8::EpiResid E{(float*)(a.ws + WS_S1), a.in[I_X], (const float*)(a.ws + WS_STATS), a.in[I_LNIN_G], a.in[I_LNIN_B], ALPHA};
            pg8::gemm_phase<pg8::EpiResid, pg8::StaticOrder, true, true>(F.lds, g, S, E, F.tid); } SEAM(5);
    PH(6) { const Frame F = mkframe(lds, wave); phase6(a, F); } SEAM(6);
    PH(7) { const Frame F = mkframe(lds, wave); phase7(a, F); } SEAM(7);
    PH(8) { const Frame F = mkframe(lds, wave); const int n = moe_fill_table(a, F, 8, 4);
            pg8::Gemm g{(const pg8::bf16_t*)(a.ws + WS_XS), (const pg8::bf16_t*)(a.ws + WS_WUP), 0, 0, D}; pg8::TableOrder S{(const LAS int*)(F.lds + TAB_OFF), n};
            pg8::EpiSwiglu E{(pg8::bf16_t*)(a.ws + WS_ACT), a.in[I_BUP]};
            pg8::gemm_phase<pg8::EpiSwiglu, pg8::TableOrder, true, true>(F.lds, g, S, E, F.tid); } SEAM(8);
    PH(9) { const Frame F = mkframe(lds, wave); const int n = moe_fill_table(a, F, 4, 8);
            pg8::Gemm g{(const pg8::bf16_t*)(a.ws + WS_ACT), (const pg8::bf16_t*)(a.ws + WS_WDN), 0, 0, D}; pg8::TableOrder S{(const LAS int*)(F.lds + TAB_OFF), n};
            pg8::EpiDown E{(pg8::bf16_t*)(a.ws + WS_YS), a.in[I_BDN]};
            pg8::gemm_phase<pg8::EpiDown, pg8::TableOrder, true, true>(F.lds, g, S, E, F.tid); } SEAM(9);
    PH(10) { const Frame F = mkframe(lds, wave); phase10(a, F); }
#undef PH
#undef SEAM
}

#ifndef MK_SINGLE
#define MK_SINGLE 1
#endif
template <int LO, int HI> static void launch_range(const Args& a, int grid, hipStream_t stream) {
    static bool attr = false;
    if (!attr) { (void)hipFuncSetAttribute((const void*)fwd<LO, HI>, hipFuncAttributeMaxDynamicSharedMemorySize, LDS_BYTES); attr = true; }
    hipLaunchKernelGGL((fwd<LO, HI>), dim3(grid), dim3(NTHR), LDS_BYTES, stream, a);
}
extern "C" void kernel_launch(void* const* d_in, const int* in_sizes, int n_in, void* d_out, int out_size, void* d_ws, size_t ws_size, hipStream_t stream) {
    if (n_in != 30 || ws_size < WS_END) { fprintf(stderr, "kernel_launch: unexpected inputs (n_in %d, ws %zu)\n", n_in, ws_size); return; }
    const int grid = 256;
    (void)hipMemsetAsync((char*)d_ws + WS_CTL, 0, CTL_ZERO_BYTES, stream);
    Args a{};
    for (int i = 0; i < 30; ++i) a.in[i] = (const float*)d_in[i];
    a.out = (float*)d_out; a.ws = (unsigned char*)d_ws;
#if MK_SINGLE
    launch_range<0, 11>(a, grid, stream);
#else
    launch_range<0, 1>(a, grid, stream); launch_range<1, 2>(a, grid, stream); launch_range<2, 3>(a, grid, stream); launch_range<3, 4>(a, grid, stream);
    launch_range<4, 5>(a, grid, stream); launch_range<5, 6>(a, grid, stream); launch_range<6, 7>(a, grid, stream); launch_range<7, 8>(a, grid, stream);
    launch_range<8, 9>(a, grid, stream); launch_range<9, 10>(a, grid, stream); launch_range<10, 11>(a, grid, stream);
#endif
}
```

```cpp
#include <hip/hip_runtime.h>
#include <cstdio>
#include <cstdint>
#include <cmath>
namespace pg8 {
#define PG8_LAS __attribute__((address_space(3)))
typedef unsigned short bf16_t;
typedef short bf16x8 __attribute__((ext_vector_type(8)));
typedef float f32x4 __attribute__((ext_vector_type(4)));
typedef unsigned u32x4 __attribute__((ext_vector_type(4)));
constexpr int BM = 256, BK = 64, HALF = 128, HTB = HALF * BK * 2  , STAGE_BYTES = 8 * HTB, NXCD = 8, WGM = 8;

__host__ __device__ __forceinline__ int lds_byte(int r, int c) { const int st = (r >> 4) * 2 + (c >> 5), rr = r & 15, cc = c & 31, ob = rr * 64 + cc * 2; return st * 1024 + (ob ^ (((ob >> 9) & 1) << 5)); }
__host__ __device__ __forceinline__ void stage_rc(int b, int& R, int& C) { const int st = b / 1024, sb = b % 1024, swz = sb ^ (((sb >> 9) & 1) << 5); R = (st >> 1) * 16 + swz / 64; C = (st & 1) * 32 + (swz % 64) / 2; }
__host__ __device__ __forceinline__ int perm32(int rho) { const int n = rho >> 4, i = rho & 15; return 8 * (i >> 2) + 4 * n + (i & 3); }

struct Unit { int pm, pn; };
struct Gemm { const bf16_t* A; const bf16_t* Bt; int M, N, K; };

struct StaticOrder {
    int nM, nN, nwg, G, c;
    __host__ __device__ void init(int M, int N, int G_, int c_) { nM = M / BM; nN = N / BM; nwg = nM * nN; G = G_; c = c_; }
    __host__ __device__ bool next(int i, Unit& u) const {
        const long L = (long)i * G + c; if (L >= nwg) return false;
        int wgid = (int)L; { const int q = nwg / NXCD, r = nwg % NXCD, xcd = wgid % NXCD, off = wgid / NXCD; wgid = (xcd < r ? xcd * (q + 1) : r * (q + 1) + (xcd - r) * q) + off; }
        const int nig = WGM * nN, gid = wgid / nig, fm = gid * WGM, gsz = (nM - fm) < WGM ? (nM - fm) : WGM;
        u.pm = fm + ((wgid % nig) % gsz); u.pn = (wgid % nig) / gsz; return true;
    }
    __device__ __forceinline__ void a_ready(const Unit&) const {}
    __device__ __forceinline__ void done(const Unit&) const {}
};


__device__ __forceinline__ unsigned cvt_pk_bf16(float lo, float hi) { unsigned r; asm volatile("v_cvt_pk_bf16_f32 %0, %1, %2" : "=v"(r) : "v"(lo), "v"(hi)); return r; }
typedef unsigned u32x2 __attribute__((ext_vector_type(2)));

struct EpiBf16Plain {
    static constexpr bool PERM = true, AFTER_DRAIN = false;
    bf16_t* O; int ldc;
    __device__ __forceinline__ void operator()(const f32x4 (&acc)[2][2][4][2], const Unit& u, int wr, int wc, int fr, int fq) const {
        const int row0 = u.pm * BM + wr * 64 + fr, col0 = u.pn * BM + wc * 32 + 8 * fq;
#pragma unroll
        for (int ai = 0; ai < 2; ++ai)
#pragma unroll
            for (int m = 0; m < 4; ++m) { bf16_t* rowp = O + (size_t)(row0 + ai * HALF + m * 16) * ldc + col0;
#pragma unroll
                for (int bj = 0; bj < 2; ++bj) { const f32x4 v0 = acc[ai][bj][m][0], v1 = acc[ai][bj][m][1];
                    u32x4 w; w.x = cvt_pk_bf16(v0[0], v0[1]); w.y = cvt_pk_bf16(v0[2], v0[3]); w.z = cvt_pk_bf16(v1[0], v1[1]); w.w = cvt_pk_bf16(v1[2], v1[3]);
                    *(u32x4*)(rowp + bj * HALF) = w; } }
    }
};

struct EpiResid {
    static constexpr bool PERM = false, AFTER_DRAIN = false;
    float* S1; const float* x; const float* stats; const float* g; const float* bta; float alpha;
    __device__ __forceinline__ void operator()(const f32x4 (&acc)[2][2][4][2], const Unit& u, int wr, int wc, int fr, int fq) const {
        const int row0 = u.pm * BM + wr * 64 + fr, col0 = u.pn * BM + wc * 32 + 4 * fq;
#pragma unroll
        for (int bj = 0; bj < 2; ++bj)
#pragma unroll
            for (int n = 0; n < 2; ++n) { const int c = col0 + bj * HALF + n * 16;
                const f32x4 gv = *(const f32x4*)(g + c) * alpha, bv = *(const f32x4*)(bta + c) * alpha;
#pragma unroll
                for (int ai = 0; ai < 2; ++ai)
#pragma unroll
                    for (int m = 0; m < 4; ++m) { const int r = row0 + ai * HALF + m * 16;
                        const float mean = stats[2 * r], rstd = stats[2 * r + 1];
                        const f32x4 xv = *(const f32x4*)(x + (size_t)r * 1024 + c);
                        *(f32x4*)(S1 + (size_t)r * 1024 + c) = ((xv - mean) * rstd) * gv + bv + acc[ai][bj][m][n]; } }
    }
};

__device__ __forceinline__ float swiglu1(float glu, float lin) {
    const float xg = fminf(glu, 7.0f), xl = fminf(fmaxf(lin, -7.0f), 7.0f);
    const float sg = __builtin_amdgcn_rcpf(1.0f + __expf(-1.702f * xg));
    return xg * sg * (xl + 1.0f);
}
struct EpiSwiglu {
    static constexpr bool PERM = true, AFTER_DRAIN = false;
    bf16_t* ACT; const float* bup;
    __device__ __forceinline__ void operator()(const f32x4 (&acc)[2][2][4][2], const Unit& u, int wr, int wc, int fr, int fq) const {
        const int e = u.pn >> 3, pn = u.pn & 7;
        const int row0 = u.pm * BM + wr * 64 + fr, ucol0 = pn * BM + wc * 32 + 8 * fq, acol0 = ucol0 >> 1;
        f32x4 bv[2][2];
#pragma unroll
        for (int bj = 0; bj < 2; ++bj)
#pragma unroll
            for (int n = 0; n < 2; ++n) bv[bj][n] = *(const f32x4*)(bup + (size_t)e * 2048 + ucol0 + bj * HALF + 4 * n);
#pragma unroll
        for (int ai = 0; ai < 2; ++ai)
#pragma unroll
            for (int m = 0; m < 4; ++m) { bf16_t* rowp = ACT + (size_t)(row0 + ai * HALF + m * 16) * 1024 + acol0;
#pragma unroll
                for (int bj = 0; bj < 2; ++bj) { const f32x4 v0 = acc[ai][bj][m][0] + bv[bj][0], v1 = acc[ai][bj][m][1] + bv[bj][1];
                    u32x2 w; w.x = cvt_pk_bf16(swiglu1(v0[0], v0[1]), swiglu1(v0[2], v0[3])); w.y = cvt_pk_bf16(swiglu1(v1[0], v1[1]), swiglu1(v1[2], v1[3]));
                    *(u32x2*)(rowp + bj * (HALF / 2)) = w; } }
    }
};
struct EpiDown {
    static constexpr bool PERM = true, AFTER_DRAIN = false;
    bf16_t* YS; const float* bdn;
    __device__ __forceinline__ void operator()(const f32x4 (&acc)[2][2][4][2], const Unit& u, int wr, int wc, int fr, int fq) const {
        const int e = u.pn >> 2, pn = u.pn & 3;
        const int row0 = u.pm * BM + wr * 64 + fr, col0 = pn * BM + wc * 32 + 8 * fq;
        f32x4 bv[2][2];
#pragma unroll
        for (int bj = 0; bj < 2; ++bj)
#pragma unroll
            for (int n = 0; n < 2; ++n) bv[bj][n] = *(const f32x4*)(bdn + (size_t)e * 1024 + col0 + bj * HALF + 4 * n);
#pragma unroll
        for (int ai = 0; ai < 2; ++ai)
#pragma unroll
            for (int m = 0; m < 4; ++m) { bf16_t* rowp = YS + (size_t)(row0 + ai * HALF + m * 16) * 1024 + col0;
#pragma unroll
                for (int bj = 0; bj < 2; ++bj) { const f32x4 v0 = acc[ai][bj][m][0] + bv[bj][0], v1 = acc[ai][bj][m][1] + bv[bj][1];
                    u32x4 w; w.x = cvt_pk_bf16(v0[0], v0[1]); w.y = cvt_pk_bf16(v0[2], v0[3]); w.z = cvt_pk_bf16(v1[0], v1[1]); w.w = cvt_pk_bf16(v1[2], v1[3]);
                    *(u32x4*)(rowp + bj * HALF) = w; } }
    }
};
struct TableOrder {
    const PG8_LAS int* tab; int n;
    __device__ __forceinline__ bool next(int i, Unit& u) const {
        if (i >= n) return false;
        u.pm = __builtin_amdgcn_readfirstlane(tab[2 * i]); u.pn = __builtin_amdgcn_readfirstlane(tab[2 * i + 1]); return true;
    }
    __device__ __forceinline__ void a_ready(const Unit&) const {}
    __device__ __forceinline__ void done(const Unit&) const {}
};

template <class Epi, class Sched, bool ALIGN_EPI = false, bool SP2 = false>
__device__ __forceinline__ void gemm_phase(PG8_LAS unsigned char* lds, const Gemm g, const Sched& S, const Epi& E, const int tid) {
    const int wid = __builtin_amdgcn_readfirstlane(tid >> 6), lane = tid & 63, wr = wid >> 2, wc = wid & 3, fr = lane & 15, fq = lane >> 4;
    const int K = g.K, nt = K / BK;
    unsigned voffA[2], voffB[2];
#pragma unroll
    for (int i = 0; i < 2; ++i) { int R, C; stage_rc(tid * 16 + i * 8192, R, C); const int Rb = Epi::PERM ? ((R & ~31) + perm32(R & 31)) : R;
        voffA[i] = (unsigned)(R * K + C) * 2u; voffB[i] = (unsigned)(Rb * K + C) * 2u; }
    const size_t kstep = (size_t)(BK * 2);
    const size_t hstep = (size_t)HALF * K * 2;
    const size_t tstep = 2 * hstep;
    const unsigned ldsw = (unsigned)wid * 1024u;
    const int aoff = lds_byte(wr * 64 + fr, fq * 8), boff = lds_byte(wc * 32 + fr, fq * 8);
#define PG8_SA(b, h) (((b) * 2 + (h)) * HTB)
#define PG8_SB(b, h) ((4 + (b) * 2 + (h)) * HTB)
#define PG8_STAGE(bufoff, gbase, voff) do { _Pragma("unroll") for (int _i = 0; _i < 2; ++_i) \
        __builtin_amdgcn_global_load_lds((const unsigned*)((const char*)(gbase) + (voff)[_i]), (PG8_LAS unsigned*)(lds + (bufoff) + ldsw + _i * 8192), 16, 0, 0); } while (0)
#define PG8_LDA(dst, b, h) do { _Pragma("unroll") for (int m = 0; m < 4; ++m) _Pragma("unroll") for (int k = 0; k < 2; ++k) dst[m][k] = *(const PG8_LAS bf16x8*)(lds + PG8_SA(b, h) + aoff + m * 2048 + k * 1024); } while (0)
#define PG8_LDB(dst, b, h) do { _Pragma("unroll") for (int n = 0; n < 2; ++n) _Pragma("unroll") for (int k = 0; k < 2; ++k) dst[n][k] = *(const PG8_LAS bf16x8*)(lds + PG8_SB(b, h) + boff + n * 2048 + k * 1024); } while (0)
#define PG8_MMA(ai, bj, At, Bt) do { __builtin_amdgcn_s_setprio(1); _Pragma("unroll") for (int m = 0; m < 4; ++m) _Pragma("unroll") for (int n = 0; n < 2; ++n) _Pragma("unroll") for (int k = 0; k < 2; ++k) \
        acc[ai][bj][m][n] = __builtin_amdgcn_mfma_f32_16x16x32_bf16(Bt[n][k], At[m][k], acc[ai][bj][m][n], 0, 0, 0); __builtin_amdgcn_s_setprio(0); } while (0)
#define PG8_WAIT_V(n) asm volatile("s_waitcnt vmcnt(" #n ")" ::: "memory")
#define PG8_WAIT_L(n) asm volatile("s_waitcnt lgkmcnt(" #n ")" ::: "memory")
#define PG8_BAR __builtin_amdgcn_s_barrier()
#define PG8_SCHED __builtin_amdgcn_sched_barrier(0)
    Unit cur, nxt; int ui = 0;
    if (!S.next(0, cur)) return;
    f32x4 acc[2][2][4][2];
#pragma unroll
    for (int a = 0; a < 2; ++a)
#pragma unroll
        for (int b = 0; b < 2; ++b)
#pragma unroll
            for (int m = 0; m < 4; ++m)
#pragma unroll
                for (int n = 0; n < 2; ++n) acc[a][b][m][n] = (f32x4){0.f, 0.f, 0.f, 0.f};
    bf16x8 At[4][2], B0[2][2], B1[2][2];
    const char* cA = (const char*)g.A + (size_t)cur.pm * tstep; const char* cB = (const char*)g.Bt + (size_t)cur.pn * tstep;
    S.a_ready(cur);
    if constexpr (SP2) {
        PG8_STAGE(PG8_SB(0, 0), cB, voffB); PG8_STAGE(PG8_SB(0, 1), cB + hstep, voffB); PG8_STAGE(PG8_SA(0, 0), cA, voffA); PG8_STAGE(PG8_SA(0, 1), cA + hstep, voffA);
        if (wr == 1) PG8_BAR;
        PG8_WAIT_V(2); PG8_BAR;
        PG8_STAGE(PG8_SB(1, 0), cB + kstep, voffB); PG8_STAGE(PG8_SA(1, 0), cA + kstep, voffA); PG8_STAGE(PG8_SB(1, 1), cB + hstep + kstep, voffB);
        PG8_WAIT_V(6); PG8_BAR;
    } else {
        PG8_STAGE(PG8_SB(0, 0), cB, voffB); PG8_STAGE(PG8_SA(0, 0), cA, voffA); PG8_STAGE(PG8_SB(0, 1), cB + hstep, voffB); PG8_STAGE(PG8_SA(0, 1), cA + hstep, voffA);
        if (wr == 1) PG8_BAR;
        PG8_WAIT_V(4); PG8_BAR;
        PG8_STAGE(PG8_SB(1, 0), cB + kstep, voffB); PG8_STAGE(PG8_SA(1, 0), cA + kstep, voffA); PG8_STAGE(PG8_SB(1, 1), cB + hstep + kstep, voffB);
        PG8_WAIT_V(6); PG8_BAR;
    }
    for (;;) {
        const bool has_next = S.next(ui + 1, nxt);
        const char* nA = has_next ? (const char*)g.A + (size_t)nxt.pm * tstep : cA; const char* nB = has_next ? (const char*)g.Bt + (size_t)nxt.pn * tstep : cB;
        for (int t = 0; t < nt; t += 2) {
            const bool last = (t == nt - 2);
            const char* a1 = cA + (size_t)(t + 1) * kstep;
            const char* a2 = last ? nA : cA + (size_t)(t + 2) * kstep; const char* b2 = last ? nB : cB + (size_t)(t + 2) * kstep;
            const char* a3 = a2 + kstep; const char* b3 = b2 + kstep;
            if (last && has_next) S.a_ready(nxt);
            if constexpr (SP2) {
            PG8_LDB(B0, 0, 0); PG8_LDB(B1, 0, 1); PG8_SCHED; PG8_LDA(At, 0, 0); PG8_STAGE(PG8_SA(1, 1), a1 + hstep, voffA);
            PG8_WAIT_V(8); PG8_WAIT_L(0); PG8_BAR; PG8_MMA(0, 0, At, B0); PG8_MMA(0, 1, At, B1); PG8_BAR; PG8_SCHED;
            PG8_LDA(At, 0, 1); PG8_STAGE(PG8_SB(0, 0), b2, voffB); PG8_STAGE(PG8_SB(0, 1), b2 + hstep, voffB); PG8_STAGE(PG8_SA(0, 0), a2, voffA);
            PG8_WAIT_V(8); PG8_WAIT_L(0); PG8_BAR; PG8_MMA(1, 0, At, B0); PG8_MMA(1, 1, At, B1); PG8_BAR; PG8_SCHED;
            PG8_LDB(B0, 1, 0); PG8_LDB(B1, 1, 1); PG8_SCHED; PG8_LDA(At, 1, 0); PG8_STAGE(PG8_SA(0, 1), a2 + hstep, voffA);
            PG8_WAIT_V(8); PG8_WAIT_L(0); PG8_BAR; PG8_MMA(0, 0, At, B0); PG8_MMA(0, 1, At, B1); PG8_BAR; PG8_SCHED;
            PG8_LDA(At, 1, 1); PG8_STAGE(PG8_SB(1, 0), b3, voffB); PG8_STAGE(PG8_SB(1, 1), b3 + hstep, voffB); PG8_STAGE(PG8_SA(1, 0), a3, voffA);
            PG8_WAIT_V(8); PG8_WAIT_L(0); PG8_BAR; PG8_MMA(1, 0, At, B0); PG8_MMA(1, 1, At, B1); PG8_BAR; PG8_SCHED;
            } else {
            PG8_LDB(B0, 0, 0); PG8_SCHED; PG8_LDA(At, 0, 0); PG8_STAGE(PG8_SA(1, 1), a1 + hstep, voffA);
            PG8_WAIT_L(8); PG8_BAR; PG8_WAIT_L(0); PG8_MMA(0, 0, At, B0); PG8_BAR; PG8_SCHED;
            PG8_LDB(B1, 0, 1); PG8_STAGE(PG8_SB(0, 0), b2, voffB);
            PG8_BAR; PG8_WAIT_L(0); PG8_MMA(0, 1, At, B1); PG8_BAR;
            PG8_LDA(At, 0, 1); PG8_STAGE(PG8_SA(0, 0), a2, voffA);
            PG8_BAR; PG8_WAIT_L(0); PG8_MMA(1, 0, At, B0); PG8_BAR; PG8_SCHED;
            PG8_STAGE(PG8_SB(0, 1), b2 + hstep, voffB);
            PG8_WAIT_V(6); PG8_BAR; PG8_MMA(1, 1, At, B1); PG8_BAR;
            PG8_LDB(B0, 1, 0); PG8_SCHED; PG8_LDA(At, 1, 0); PG8_STAGE(PG8_SA(0, 1), a2 + hstep, voffA);
            PG8_WAIT_L(8); PG8_BAR; PG8_WAIT_L(0); PG8_MMA(0, 0, At, B0); PG8_BAR; PG8_SCHED;
            PG8_LDB(B1, 1, 1); PG8_STAGE(PG8_SB(1, 0), b3, voffB);
            PG8_BAR; PG8_WAIT_L(0); PG8_MMA(0, 1, At, B1); PG8_BAR;
            PG8_LDA(At, 1, 1); PG8_STAGE(PG8_SA(1, 0), a3, voffA);
            PG8_BAR; PG8_WAIT_L(0); PG8_MMA(1, 0, At, B0); PG8_BAR; PG8_SCHED;
            PG8_STAGE(PG8_SB(1, 1), b3 + hstep, voffB);
            PG8_WAIT_V(6); PG8_BAR; PG8_MMA(1, 1, At, B1); PG8_BAR;
            }
        }
        if constexpr (ALIGN_EPI) { if (wr == 0) PG8_BAR; }
        if constexpr (!Epi::AFTER_DRAIN) { E(acc, cur, wr, wc, fr, fq); S.done(cur); }
        if (!has_next) break;
#pragma unroll
        for (int a = 0; a < 2; ++a)
#pragma unroll
            for (int b = 0; b < 2; ++b)
#pragma unroll
                for (int m = 0; m < 4; ++m)
#pragma unroll
                    for (int n = 0; n < 2; ++n) acc[a][b][m][n] = (f32x4){0.f, 0.f, 0.f, 0.f};
        cur = nxt; cA = nA; cB = nB; ++ui;
        if constexpr (ALIGN_EPI) { if (wr == 1) PG8_BAR; }
    }
    PG8_WAIT_V(0);
    if constexpr (!ALIGN_EPI) { if (wr == 0) PG8_BAR; }
    PG8_BAR;
    if constexpr (Epi::AFTER_DRAIN) { E.fused(acc, cur, wr, wc, fr, fq, lds, wid, lane); S.done(cur); }
#undef PG8_SA
#undef PG8_SB
#undef PG8_STAGE
#undef PG8_LDA
#undef PG8_LDB
#undef PG8_MMA
#undef PG8_WAIT_V
#undef PG8_WAIT_L
#undef PG8_BAR
#undef PG8_SCHED
}
}

#ifndef REP_MASK
#define REP_MASK 0
#endif
#define NREP(k) (1 + ((REP_MASK >> (k)) & 1))

constexpr int NB = 16, SEQ = 2048, D = 1024, NMETA = 16;
constexpr int MX = NB * SEQ;
constexpr int INW = 3344, PW = 3584;
constexpr int GQ = 0, GK = 256, GV = 512, GG = 1024, GKL = 1536;
constexpr int RW0 = 1552;
constexpr int RR = RW0, RK = RW0 + 512, RV = RW0 + 1024, RWL = RW0 + 1536, RAL = RW0 + 1600, RGL = RW0 + 1664;
constexpr int NE = 32, TOPK = 4;
constexpr int NCH = 33;
constexpr float ALPHA = 1.189207115002721f;
constexpr int NWAVES = 8, NTHR = 512;

constexpr size_t MiB = 1u << 20;
constexpr size_t WS_CTL = 0, CTL_ZERO_BYTES = 1 * MiB;
constexpr size_t WS_STATS = 1 * MiB;
constexpr size_t WS_TOPI  = WS_STATS + 256 * 1024;
constexpr size_t WS_GATE  = WS_TOPI + 512 * 1024;
constexpr size_t WS_RANK  = WS_GATE + 512 * 1024;
constexpr size_t WS_TSLOT = WS_RANK + 512 * 1024;
constexpr size_t WS_BON   = WS_TSLOT + 512 * 1024;
constexpr size_t WS_PROJM = WS_BON + 1 * MiB;
constexpr size_t WS_OPSM  = WS_PROJM + 256 * 1024;
constexpr size_t WS_DL    = WS_OPSM + 256 * 1024;
constexpr size_t WS_W2T   = WS_DL + 1 * MiB;
constexpr size_t WS_A2T   = WS_W2T + 64 * 1024;
constexpr size_t WS_G2T   = WS_A2T + 64 * 1024;
constexpr size_t WS_TILEE = WS_G2T + 128 * 1024;
constexpr size_t WS_WIN   = 8 * MiB;
constexpr size_t WS_WOUT  = 15 * MiB;
static_assert(WS_TILEE + 4096 <= WS_WIN, "table region");
constexpr size_t WS_A0    = 20 * MiB;
constexpr size_t WS_YMIX  = WS_A0;
constexpr size_t WS_PROJ  = 84 * MiB;
constexpr size_t WS_R1    = 308 * MiB;
constexpr size_t WS_GAM   = 520 * MiB;
constexpr size_t WS_GUS   = 692 * MiB;
constexpr size_t WS_WUP   = 84 * MiB;
constexpr size_t WS_WDN   = 212 * MiB;
constexpr size_t WS_S1    = 276 * MiB;
constexpr size_t WS_H1    = 404 * MiB;
constexpr size_t WS_XS    = 468 * MiB;
constexpr size_t WS_YS    = WS_XS;
constexpr size_t WS_ACT   = 740 * MiB;
constexpr size_t WS_END   = 1012 * MiB;
constexpr int CW_BAR = 4096;
constexpr int CW_CNT = 16384;

constexpr int RING_BYTES = 131072;
constexpr int LDS_BYTES = 147456;
constexpr int TAB_OFF = 132096;
constexpr int MISC_OFF = LDS_BYTES - 512;

#define LAS __attribute__((address_space(3)))
typedef unsigned short bf16;
typedef unsigned v4u __attribute__((ext_vector_type(4)));
typedef unsigned v2u __attribute__((ext_vector_type(2)));
typedef float f32x4 __attribute__((ext_vector_type(4)));
typedef short bf16x8 __attribute__((ext_vector_type(8)));
#define LDS_WAIT() asm volatile("s_waitcnt lgkmcnt(0)" ::: "memory")
__device__ __forceinline__ float bflo(unsigned w) { return __uint_as_float(w << 16); }
__device__ __forceinline__ float bfhi(unsigned w) { return __uint_as_float(w & 0xffff0000u); }
__device__ __forceinline__ unsigned f2bf(float f) { unsigned u = __float_as_uint(f); return (u + 0x7fffu + ((u >> 16) & 1u)) >> 16; }
__device__ __forceinline__ unsigned pk2(float lo, float hi) { return f2bf(lo) | (f2bf(hi) << 16); }
__device__ __forceinline__ float wave_sum(float v) {
#pragma unroll
    for (int o = 1; o < 64; o <<= 1) v += __shfl_xor(v, o);
    return v;
}
__device__ __forceinline__ float softplus_f(float x) { return fmaxf(x, 0.f) + log1pf(expf(-fabsf(x))); }
__device__ __forceinline__ float logsigmoid_f(float x) { return fminf(x, 0.f) - log1pf(expf(-fabsf(x))); }
__device__ __forceinline__ float sigmoid_f(float x) { return 1.f / (1.f + expf(-x)); }
__device__ __forceinline__ float fexp(float x) { return __builtin_amdgcn_exp2f(x * 1.4426950408889634f); }
__device__ __forceinline__ float flog(float x) { return __builtin_amdgcn_logf(x) * 0.6931471805599453f; }
__device__ __forceinline__ float fsigmoid(float x) { return __builtin_amdgcn_rcpf(1.f + fexp(-x)); }
__device__ __forceinline__ float ftanh(float x) { return 2.f * fsigmoid(2.f * x) - 1.f; }
__device__ __forceinline__ float fsoftplus(float x) { return fmaxf(x, 0.f) + flog(1.f + fexp(-fabsf(x))); }
__device__ __forceinline__ float flogsigmoid(float x) { return fminf(x, 0.f) - flog(1.f + fexp(-fabsf(x))); }
template <int CTRL> __device__ __forceinline__ float dppf(float x) { return __int_as_float(__builtin_amdgcn_update_dpp(0, __float_as_int(x), CTRL, 0xF, 0xF, true)); }
__device__ __forceinline__ float red8(float x) {
    x += dppf<0xB1>(x); x += dppf<0x4E>(x); x += dppf<0x141>(x); return x;
}
__device__ __forceinline__ f32x4 mfma16(bf16x8 a, bf16x8 b, f32x4 c) { return __builtin_amdgcn_mfma_f32_16x16x32_bf16(a, b, c, 0, 0, 0); }
__device__ __forceinline__ unsigned ld_agent(const unsigned* p) { return __hip_atomic_load(p, __ATOMIC_RELAXED, __HIP_MEMORY_SCOPE_AGENT); }

#define XB_TMO      128
#define XB_XCNT(j)  (256  + 64 * (j))
#define XB_XSUB(j)  (1280 + 64 * (j))
#define XB_XGEN(j)  (2304 + 64 * (j))
#define XB_TOP      3328
#define XB_TOPGEN   3392
#define XCD_BAR_WORDS 3456
#define XB_SPIN_CAP (1u << 18)
__device__ __forceinline__ unsigned xb_ld(unsigned* p)              { return __hip_atomic_load(p, __ATOMIC_RELAXED, __HIP_MEMORY_SCOPE_AGENT); }
__device__ __forceinline__ unsigned xb_add(unsigned* p, unsigned v) { return __hip_atomic_fetch_add(p, v, __ATOMIC_RELAXED, __HIP_MEMORY_SCOPE_AGENT); }
__device__ __forceinline__ unsigned xb_xcc_id() { return (unsigned)__builtin_amdgcn_s_getreg((3 << 11) | 20) & 0xFu; }
#define XB_SPIN(cond, bar) do { unsigned _sp = 0; while (cond) { __builtin_amdgcn_s_sleep(1); \
    if ((++_sp & 255u) == 0u) { if (xb_ld(&(bar)[XB_TMO])) break; if (_sp > XB_SPIN_CAP) { atomicAdd(&(bar)[XB_TMO], 1u); break; } } } } while (0)
struct XcdBarrier { unsigned* bar; unsigned x; volatile LAS unsigned* st; };
__device__ __forceinline__ XcdBarrier xcd_barrier_post(unsigned* bar, volatile LAS unsigned* st, bool leader) {
    XcdBarrier b; b.bar = bar; b.x = xb_xcc_id(); b.st = st;
    if (leader) (void)xb_add(&bar[XB_XCNT(b.x)], 1u);
    return b;
}
__device__ __forceinline__ void xcd_barrier_complete(unsigned* bar, unsigned x, unsigned& nloc, unsigned& nx) {
    const unsigned G = gridDim.x * gridDim.y * gridDim.z;
    unsigned sum, cnt, mine, sp = 0u;
    for (;;) {
        sum = 0u; cnt = 0u; mine = 0u;
#pragma unroll
        for (unsigned j = 0; j < 16; ++j) { const unsigned c = xb_ld(&bar[XB_XCNT(j)]); sum += c; cnt += (c > 0u) ? 1u : 0u; mine = (j == x) ? c : mine; }
        if (sum == G) break;
        __builtin_amdgcn_s_sleep(1);
        if ((++sp & 255u) == 0u) { if (xb_ld(&bar[XB_TMO])) break; if (sp > XB_SPIN_CAP) { atomicAdd(&bar[XB_TMO], 1u); break; } }
    }
    nloc = mine > 0u ? mine : 1u; nx = cnt > 0u ? cnt : 1u;
}
__device__ __forceinline__ void xcd_barrier(const XcdBarrier& b, bool leader) {
    asm volatile("s_waitcnt vmcnt(0)" ::: "memory");
    __syncthreads();
    if (leader) {
        unsigned* bar = b.bar;
        __builtin_amdgcn_s_waitcnt(0);
        unsigned nloc = b.st[0], nx = b.st[1];
        if (nloc == 0u) { xcd_barrier_complete(bar, b.x, nloc, nx); b.st[0] = nloc; b.st[1] = nx; }
        const unsigned old = xb_add(&bar[XB_XSUB(b.x)], 1u);
        const unsigned gen = old / nloc;
        if (old + 1u == (gen + 1u) * nloc) {
            __builtin_amdgcn_fence(__ATOMIC_RELEASE, "agent");
            asm volatile("s_waitcnt vmcnt(0)" ::: "memory");
            const unsigned og = xb_add(&bar[XB_TOP], 1u);
            const unsigned tg = og / nx;
            if (og + 1u == (tg + 1u) * nx) xb_add(&bar[XB_TOPGEN], 1u);
            else XB_SPIN(xb_ld(&bar[XB_TOPGEN]) == tg, bar);
            __builtin_amdgcn_fence(__ATOMIC_ACQUIRE, "agent");
            xb_add(&bar[XB_XGEN(b.x)], 1u);
            asm volatile("s_waitcnt vmcnt(0)" ::: "memory");
        } else {
            XB_SPIN(xb_ld(&bar[XB_XGEN(b.x)]) == gen, bar);
            __builtin_amdgcn_fence(__ATOMIC_ACQUIRE, "agent");
            asm volatile("s_waitcnt vmcnt(0)" ::: "memory");
        }
    }
    __syncthreads();
}

struct Args { const float* in[30]; float* out; unsigned char* ws; };
enum { I_X = 0, I_META, I_LNIN_G, I_LNIN_B, I_WIN, I_GKW2, I_GKB, I_GNORM, I_MU, I_W0, I_W2, I_A0, I_A2, I_G2, I_KK, I_KA, I_RK, I_RLNG, I_RLNB, I_WOUT,
       I_LN1G, I_LN1B, I_RTW, I_RTB, I_WUP, I_BUP, I_WDN, I_BDN, I_LN2G, I_LN2B };
struct Frame { LAS unsigned char* lds; int tid, lane, wave, blk, G; };
__device__ __forceinline__ int lane_id() { int l = (int)__builtin_amdgcn_mbcnt_hi(~0u, __builtin_amdgcn_mbcnt_lo(~0u, 0u)); asm volatile("" : "+v"(l)); return l; }
__device__ __forceinline__ Frame mkframe(LAS unsigned char* lds, int wave) { Frame F; F.lds = lds; F.wave = wave; F.lane = lane_id(); F.tid = wave * 64 + F.lane; F.blk = blockIdx.x; F.G = gridDim.x; return F; }

__device__ __forceinline__ void transpose_item(const float* W, int K, int N, int nblk, bf16* WT, LAS float* scr, int item, int lane) {
    const int kb = item / nblk, nb = item - kb * nblk, k0 = 64 * kb, n0 = 32 * nb;
    const int nn = n0 + (lane & 31); const bool ok = nn < N;
#pragma unroll 8
    for (int i = 0; i < 32; ++i) { const int kk = 2 * i + (lane >> 5); scr[kk * 33 + (lane & 31)] = ok ? W[(size_t)(k0 + kk) * N + nn] : 0.f; }
    LDS_WAIT();
    const int c = lane & 7;
#pragma unroll
    for (int j = 0; j < 4; ++j) { const int n = (lane >> 3) + 8 * j; const LAS float* s = scr + (8 * c) * 33 + n;
        v4u o; o.x = pk2(s[0 * 33], s[1 * 33]); o.y = pk2(s[2 * 33], s[3 * 33]); o.z = pk2(s[4 * 33], s[5 * 33]); o.w = pk2(s[6 * 33], s[7 * 33]);
        *(v4u*)(WT + (size_t)(n0 + n) * K + k0 + 8 * c) = o; }
    LDS_WAIT();
}

__device__ __forceinline__ void phase0(const Args& a, const Frame& F) {
    unsigned char* ws = a.ws;
    const int gw = F.blk * NWAVES + F.wave, NGW = F.G * NWAVES;
    for (int cgp = F.blk; cgp < 53; cgp += F.G) {
        LAS float* HM = (LAS float*)F.lds;
        LAS float* PART = (LAS float*)(F.lds + 65536);
        for (int rr = 0; rr < 2; ++rr) {
            const int row = 2 * F.wave + rr; const f32x4* xr = (const f32x4*)(a.in[I_META] + row * D) + F.lane;
            f32x4 v[4]; float s = 0.f;
#pragma unroll
            for (int j = 0; j < 4; ++j) { v[j] = xr[64 * j]; s += (v[j].x + v[j].y) + (v[j].z + v[j].w); }
            const float mean = wave_sum(s) * (1.f / D); float s2 = 0.f;
#pragma unroll
            for (int j = 0; j < 4; ++j) { v[j] = v[j] - mean; s2 += (v[j].x * v[j].x + v[j].y * v[j].y) + (v[j].z * v[j].z + v[j].w * v[j].w); }
            const float rstd = 1.f / sqrtf(wave_sum(s2) * (1.f / D) + 1e-5f);
#pragma unroll
            for (int j = 0; j < 4; ++j) { const int col = 4 * (F.lane + 64 * j);
                const f32x4 gv = *(const f32x4*)(a.in[I_LNIN_G] + col), bv = *(const f32x4*)(a.in[I_LNIN_B] + col);
                const f32x4 y = v[j] * rstd * gv + bv;
                HM[(col + 0) * 16 + row] = y.x; HM[(col + 1) * 16 + row] = y.y; HM[(col + 2) * 16 + row] = y.z; HM[(col + 3) * 16 + row] = y.w; }
        }
        __syncthreads();
        const int col = cgp * 64 + F.lane; const bool ok = col < INW;
        float acc[16];
#pragma unroll
        for (int r = 0; r < 16; ++r) acc[r] = 0.f;
        const float* wp = a.in[I_WIN];
        for (int k = F.wave * 128; k < F.wave * 128 + 128; ++k) {
            const float wv = ok ? wp[(size_t)k * INW + col] : 0.f;
            const LAS f32x4* h = (const LAS f32x4*)(HM + k * 16);
#pragma unroll
            for (int q = 0; q < 4; ++q) { const f32x4 hv = h[q]; acc[4 * q + 0] += hv.x * wv; acc[4 * q + 1] += hv.y * wv; acc[4 * q + 2] += hv.z * wv; acc[4 * q + 3] += hv.w * wv; }
        }
#pragma unroll
        for (int r = 0; r < 16; ++r) PART[(F.wave * 16 + r) * 64 + F.lane] = acc[r];
        __syncthreads();
        float* PROJM = (float*)(ws + WS_PROJM);
        for (int o = F.tid; o < 1024; o += NTHR) { const int r = o >> 6, l = o & 63; float s = 0.f;
#pragma unroll
            for (int w = 0; w < 8; ++w) s += PART[(w * 16 + r) * 64 + l];
            PROJM[r * PW + cgp * 64 + l] = s; }
        __syncthreads();
    }
    {
        LAS float* scr = (LAS float*)(F.lds + F.wave * 16384);
        constexpr int I_IN = 16 * (PW / 32), I_OUT = 16 * 32;
        for (int it = gw; it < I_IN + I_OUT; it += NGW) {
            if (it < I_IN) transpose_item(a.in[I_WIN], D, INW, PW / 32, (bf16*)(ws + WS_WIN), scr, it, F.lane);
            else transpose_item(a.in[I_WOUT], D, D, 32, (bf16*)(ws + WS_WOUT), scr, it - I_IN, F.lane);
        }
    }
    {
        bf16* W2T = (bf16*)(ws + WS_W2T); bf16* A2T = (bf16*)(ws + WS_A2T); bf16* G2T = (bf16*)(ws + WS_G2T);
        for (int i = F.blk * NTHR + F.tid; i < 131072; i += F.G * NTHR) {
            if (i < 32768) { const int n = i >> 6, k = i & 63; W2T[i] = (bf16)f2bf(a.in[I_W2][k * 512 + n]); }
            else if (i < 65536) { const int j = i - 32768, n = j >> 6, k = j & 63; A2T[j] = (bf16)f2bf(a.in[I_A2][k * 512 + n]); }
            else { const int j = i - 65536, n = j >> 7, k = j & 127; G2T[j] = (bf16)f2bf(a.in[I_G2][k * 512 + n]); }
        }
    }
    {
        bf16* A0 = (bf16*)(ws + WS_A0); float* ST = (float*)(ws + WS_STATS);
        for (int m = gw; m < MX; m += NGW) {
            const f32x4* xr = (const f32x4*)(a.in[I_X] + (size_t)m * D) + F.lane;
            f32x4 v[4]; float s = 0.f;
#pragma unroll
            for (int j = 0; j < 4; ++j) { v[j] = xr[64 * j]; s += (v[j].x + v[j].y) + (v[j].z + v[j].w); }
            const float mean = wave_sum(s) * (1.f / D); float s2 = 0.f;
#pragma unroll
            for (int j = 0; j < 4; ++j) { v[j] = v[j] - mean; s2 += (v[j].x * v[j].x + v[j].y * v[j].y) + (v[j].z * v[j].z + v[j].w * v[j].w); }
            const float rstd = 1.f / sqrtf(wave_sum(s2) * (1.f / D) + 1e-5f);
#pragma unroll
            for (int j = 0; j < 4; ++j) { const int col = 4 * (F.lane + 64 * j);
                const f32x4 gv = *(const f32x4*)(a.in[I_LNIN_G] + col), bv = *(const f32x4*)(a.in[I_LNIN_B] + col);
                const f32x4 y = v[j] * rstd * gv + bv;
                v2u o; o.x = pk2(y.x, y.y); o.y = pk2(y.z, y.w);
                *(v2u*)(A0 + (size_t)m * D + col) = o; }
            if (F.lane == 0) { ST[2 * m] = mean; ST[2 * m + 1] = rstd; }
        }
    }
}

__device__ __forceinline__ f32x4 ldp4(const bf16* PROJ, const float* PROJM, int b, int vp, int col) {
    f32x4 r = {0.f, 0.f, 0.f, 0.f};
    if (vp >= NMETA) { const v2u w = *(const v2u*)(PROJ + (size_t)(b * SEQ + vp - NMETA) * PW + col); r.x = bflo(w.x); r.y = bfhi(w.x); r.z = bflo(w.y); r.w = bfhi(w.y); }
    else if (vp >= 0) { r = *(const f32x4*)(PROJM + vp * PW + col); }
    return r;
}

constexpr int R1_STRIDE = 49152;
constexpr int TP = 72;
constexpr int L1_SLOT = 64 * TP * 2;
constexpr int L1_LC = 13 * L1_SLOT;
constexpr int L1_XCH = L1_LC + 64 * 65 * 4;
constexpr int L1_LR = 8 * L1_SLOT;
__device__ __forceinline__ v2u pack4(f32x4 v) { v2u o; o.x = pk2(v[0], v[1]); o.y = pk2(v[2], v[3]); return o; }
__device__ __forceinline__ f32x4 tile_mm(const LAS bf16* A, const LAS bf16* Bt, int rt, int ct, int fr, int fq, f32x4 acc) {
#pragma unroll
    for (int ks = 0; ks < 2; ++ks)
        acc = mfma16(*(const LAS bf16x8*)(Bt + (ct * 16 + fr) * TP + ks * 32 + 8 * fq), *(const LAS bf16x8*)(A + (rt * 16 + fr) * TP + ks * 32 + 8 * fq), acc);
    return acc;
}
__device__ __forceinline__ void tile_st(LAS bf16* O, int rt, int ct, int fr, int fq, f32x4 v) { *(LAS v2u*)(O + (rt * 16 + fr) * TP + ct * 16 + 4 * fq) = pack4(v); }
#define L1S(n) ((LAS bf16*)(F.lds + (n) * L1_SLOT))

__device__ __forceinline__ void rwkv_l1_unit(const Args& a, const Frame& F, int b, int h, int c) {
    unsigned char* ws = a.ws;
    const bf16* PROJ = (const bf16*)(ws + WS_PROJ); const float* PROJM = (const float*)(ws + WS_PROJM);
    const bf16* W2T = (const bf16*)(ws + WS_W2T); const bf16* A2T = (const bf16*)(ws + WS_A2T); const bf16* G2T = (const bf16*)(ws + WS_G2T);
    const int unit = (b * 8 + h) * NCH + c;
    unsigned char* r1 = ws + WS_R1 + (size_t)unit * R1_STRIDE;
    float* GAM = (float*)(ws + WS_GAM) + (size_t)unit * 64;
    const float* mu = a.in[I_MU];
    const int vp0 = (c == 0) ? -48 : NMETA + 64 * (c - 1);
    constexpr int LRP = 264;
    LAS bf16* LR = (LAS bf16*)(F.lds + L1_LR);
    LAS float* LC = (LAS float*)(F.lds + L1_LC);
    LAS float* XCH = (LAS float*)(F.lds + L1_XCH);
    {
        const int cg = F.tid & 31, tr = F.tid >> 5;
        const int col = RWL + 8 * cg;
        const f32x4 m0 = *(const f32x4*)(mu + 1536 + 8 * cg), m1 = *(const f32x4*)(mu + 1536 + 8 * cg + 4);
#pragma unroll
        for (int i = 0; i < 4; ++i) {
            const int row = 4 * tr + i, vp = vp0 + row;
            const f32x4 c0 = ldp4(PROJ, PROJM, b, vp, col), c1 = ldp4(PROJ, PROJM, b, vp, col + 4);
            const f32x4 p0 = ldp4(PROJ, PROJM, b, vp - 1, col), p1 = ldp4(PROJ, PROJM, b, vp - 1, col + 4);
            float v[8];
            v[0] = c0.x + (p0.x - c0.x) * m0.x; v[1] = c0.y + (p0.y - c0.y) * m0.y; v[2] = c0.z + (p0.z - c0.z) * m0.z; v[3] = c0.w + (p0.w - c0.w) * m0.w;
            v[4] = c1.x + (p1.x - c1.x) * m1.x; v[5] = c1.y + (p1.y - c1.y) * m1.y; v[6] = c1.z + (p1.z - c1.z) * m1.z; v[7] = c1.w + (p1.w - c1.w) * m1.w;
#pragma unroll
            for (int q = 0; q < 8; ++q) { if (cg < 8) v[q] = ftanh(v[q]); else if (cg >= 16) v[q] = fsigmoid(v[q]); }
            v4u o; o.x = pk2(v[0], v[1]); o.y = pk2(v[2], v[3]); o.z = pk2(v[4], v[5]); o.w = pk2(v[6], v[7]);
            *(LAS v4u*)(LR + row * LRP + 8 * cg) = o;
        }
    }
    __syncthreads();
    const int rt = F.wave & 3, cp = F.wave >> 2, fr = F.lane & 15, fq = F.lane >> 4;
    const int t = rt * 16 + fr, vp = vp0 + t;
    const bool valid = vp >= 0;
    float lwv[2][4], asg[2][4], kkr[2][4], kmd[2][4], rrv[2][4], vvv[2][4];
    float ssq = 0.f, bon = 0.f;
    {
        const LAS bf16* lrow = LR + t * LRP + 8 * fq;
#pragma unroll
        for (int cc = 0; cc < 2; ++cc) {
            const int ct = 2 * cp + cc, j = ct * 16 + 4 * fq, jc = h * 64 + j, n = h * 64 + ct * 16 + fr;
            f32x4 aw = {0.f, 0.f, 0.f, 0.f}, aa = aw, ag = aw;
#pragma unroll
            for (int ks = 0; ks < 2; ++ks) {
                aw = mfma16(*(const bf16x8*)(W2T + (size_t)n * 64 + ks * 32 + 8 * fq), *(const LAS bf16x8*)(lrow + ks * 32), aw);
                aa = mfma16(*(const bf16x8*)(A2T + (size_t)n * 64 + ks * 32 + 8 * fq), *(const LAS bf16x8*)(lrow + 64 + ks * 32), aa);
            }
#pragma unroll
            for (int ks = 0; ks < 4; ++ks)
                ag = mfma16(*(const bf16x8*)(G2T + (size_t)n * 128 + ks * 32 + 8 * fq), *(const LAS bf16x8*)(lrow + 128 + ks * 32), ag);
            const f32x4 rc = ldp4(PROJ, PROJM, b, vp, RR + jc), rp = ldp4(PROJ, PROJM, b, vp - 1, RR + jc), mr = *(const f32x4*)(mu + jc);
            const f32x4 kc = ldp4(PROJ, PROJM, b, vp, RK + jc), kp = ldp4(PROJ, PROJM, b, vp - 1, RK + jc), mk = *(const f32x4*)(mu + 512 + jc);
            const f32x4 vc = ldp4(PROJ, PROJM, b, vp, RV + jc), vpv = ldp4(PROJ, PROJM, b, vp - 1, RV + jc), mv = *(const f32x4*)(mu + 1024 + jc);
            const f32x4 rs = rc + (rp - rc) * mr, ks_ = kc + (kp - kc) * mk, vs = vc + (vpv - vc) * mv;
            const f32x4 w0v = *(const f32x4*)(a.in[I_W0] + jc), a0v = *(const f32x4*)(a.in[I_A0] + jc);
            const f32x4 kkw = *(const f32x4*)(a.in[I_KK] + jc), kaw = *(const f32x4*)(a.in[I_KA] + jc), rkw = *(const f32x4*)(a.in[I_RK] + jc);
#pragma unroll
            for (int i = 0; i < 4; ++i) {
                const float u = w0v[i] + aw[i];
                const float wl = -fsoftplus(-u) - 0.5f;
                lwv[cc][i] = valid ? -fexp(wl) : 0.f;
                const float as_ = fsigmoid(a0v[i] + aa[i]);
                asg[cc][i] = as_;
                const float kraw = ks_[i], kk = kraw * kkw[i];
                kkr[cc][i] = kk; ssq += kk * kk;
                const float km = kraw * (1.f + (as_ - 1.f) * kaw[i]);
                kmd[cc][i] = km; rrv[cc][i] = rs[i]; vvv[cc][i] = vs[i];
                bon += rs[i] * km * rkw[i];
                LC[t * 65 + j + i] = lwv[cc][i];
            }
            *(v2u*)(r1 + 4 * 8192 + (size_t)(t * 64 + j) * 2) = pack4(ag);
        }
        ssq += __shfl_xor(ssq, 16); ssq += __shfl_xor(ssq, 32);
        bon += __shfl_xor(bon, 16); bon += __shfl_xor(bon, 32);
        if (fq == 0) { XCH[(cp * 64 + t) * 2] = ssq; XCH[(cp * 64 + t) * 2 + 1] = bon; }
    }
    __syncthreads();
    if (F.tid < 64) { float run = 0.f;
#pragma unroll 8
        for (int tt = 0; tt < 64; ++tt) { run += LC[tt * 65 + F.tid]; LC[tt * 65 + F.tid] = run; } }
    const float ssq_t = XCH[t * 2] + XCH[(64 + t) * 2], bon_t = XCH[t * 2 + 1] + XCH[(64 + t) * 2 + 1];
    const float inv = 1.f / fmaxf(sqrtf(ssq_t), 1e-12f);
    __syncthreads();
    f32x4 rtil[2];
    {
#pragma unroll
        for (int cc = 0; cc < 2; ++cc) {
            const int j = (2 * cp + cc) * 16 + 4 * fq;
            f32x4 At, Bt, Kt, Bh, Kh, bvv;
#pragma unroll
            for (int i = 0; i < 4; ++i) {
                const float Lc = LC[t * 65 + j + i], LcC = LC[63 * 65 + j + i];
                const float kn = kkr[cc][i] * inv, av = -kn, bv = kn * asg[cc][i], km = kmd[cc][i];
                const float eA = fexp(Lc - lwv[cc][i]), eR = fexp(Lc), eB = fexp(-Lc), eH = fexp(LcC - Lc);
                At[i] = av * eA; rtil[cc][i] = rrv[cc][i] * eR; Bt[i] = bv * eB; Kt[i] = km * eB; Bh[i] = bv * eH; Kh[i] = km * eH;
                bvv[i] = bon_t * vvv[cc][i];
                if (t == 63) GAM[j + i] = fexp(LcC);
            }
            *(LAS v2u*)(L1S(0) + t * TP + j) = pack4(Bt); *(LAS v2u*)(L1S(1) + t * TP + j) = pack4(Kt);
            *(LAS v2u*)(L1S(2) + t * TP + j) = pack4(At); *(LAS v2u*)(L1S(3) + t * TP + j) = pack4(rtil[cc]);
#pragma unroll
            for (int i = 0; i < 4; ++i) {
                L1S(4)[(j + i) * TP + t] = (bf16)f2bf(At[i]); L1S(5)[(j + i) * TP + t] = (bf16)f2bf(Bh[i]);
                L1S(6)[(j + i) * TP + t] = (bf16)f2bf(Kh[i]); L1S(7)[(j + i) * TP + t] = (bf16)f2bf(vvv[cc][i]);
            }
            *(v2u*)(r1 + 5 * 8192 + (size_t)(t * 64 + j) * 2) = pack4(bvv);
        }
    }
    __syncthreads();
    f32x4 Pt[2];
    const int mrow = rt * 16 + fr;
#pragma unroll
    for (int cc = 0; cc < 2; ++cc) {
        const int ct = 2 * cp + cc, n0 = ct * 16 + 4 * fq;
        const f32x4 z = {0.f, 0.f, 0.f, 0.f};
        f32x4 Lv = tile_mm(L1S(2), L1S(0), rt, ct, fr, fq, z), Nv = tile_mm(L1S(0), L1S(2), rt, ct, fr, fq, z), Mv = tile_mm(L1S(1), L1S(2), rt, ct, fr, fq, z);
        f32x4 Bv = tile_mm(L1S(3), L1S(0), rt, ct, fr, fq, z), Kv = tile_mm(L1S(3), L1S(1), rt, ct, fr, fq, z);
#pragma unroll
        for (int i = 0; i < 4; ++i) { const int n = n0 + i;
            if (!(n < mrow)) Lv[i] = 0.f; if (!(mrow < n)) { Nv[i] = 0.f; Mv[i] = 0.f; } if (!(n <= mrow)) { Bv[i] = 0.f; Kv[i] = 0.f; }
            Pt[cc][i] = Lv[i] + ((n == mrow) ? 1.f : 0.f); }
        tile_st(L1S(8), rt, ct, fr, fq, Lv); tile_st(L1S(9), rt, ct, fr, fq, Nv); tile_st(L1S(10), rt, ct, fr, fq, Mv);
        tile_st(L1S(11), rt, ct, fr, fq, Bv); tile_st(L1S(12), rt, ct, fr, fq, Kv);
    }
    __syncthreads();
#pragma unroll
    for (int st = 1; st <= 5; ++st) {
        LAS bf16* Xl = (st & 1) ? L1S(8) : L1S(0); LAS bf16* Xn = (st & 1) ? L1S(9) : L1S(1);
        LAS bf16* Yl = (st & 1) ? L1S(0) : L1S(8); LAS bf16* Yn = (st & 1) ? L1S(1) : L1S(9);
        const f32x4 z = {0.f, 0.f, 0.f, 0.f};
#pragma unroll
        for (int cc = 0; cc < 2; ++cc) { const int ct = 2 * cp + cc;
            tile_st(Yl, rt, ct, fr, fq, tile_mm(Xl, Xn, rt, ct, fr, fq, z)); tile_st(Yn, rt, ct, fr, fq, tile_mm(Xn, Xl, rt, ct, fr, fq, z));
            tile_st(L1S(2), rt, ct, fr, fq, Pt[cc]); }
        __syncthreads();
#pragma unroll
        for (int cc = 0; cc < 2; ++cc) Pt[cc] = tile_mm(L1S(2), Yn, rt, 2 * cp + cc, fr, fq, Pt[cc]);
        __syncthreads();
    }
#pragma unroll
    for (int cc = 0; cc < 2; ++cc) tile_st(L1S(2), rt, 2 * cp + cc, fr, fq, Pt[cc]);
    __syncthreads();
    {
        const f32x4 z = {0.f, 0.f, 0.f, 0.f};
#pragma unroll
        for (int cc = 0; cc < 2; ++cc) { const int ct = 2 * cp + cc;
            tile_st(L1S(8), rt, ct, fr, fq, tile_mm(L1S(2), L1S(10), rt, ct, fr, fq, z)); tile_st(L1S(9), rt, ct, fr, fq, tile_mm(L1S(4), L1S(2), rt, ct, fr, fq, z)); }
    }
    __syncthreads();
    {
        const f32x4 z = {0.f, 0.f, 0.f, 0.f};
#pragma unroll
        for (int cc = 0; cc < 2; ++cc) { const int ct = 2 * cp + cc; tile_st(L1S(0), rt, ct, fr, fq, tile_mm(L1S(7), L1S(8), rt, ct, fr, fq, z)); }
    }
    __syncthreads();
    {
        const f32x4 z = {0.f, 0.f, 0.f, 0.f};
#pragma unroll
        for (int cc = 0; cc < 2; ++cc) { const int ct = 2 * cp + cc; const size_t eo = (size_t)(mrow * 64 + ct * 16 + 4 * fq) * 2;
            const f32x4 gp = tile_mm(L1S(5), L1S(9), rt, ct, fr, fq, z);
            const f32x4 hh = tile_mm(L1S(7), L1S(6), rt, ct, fr, fq, tile_mm(L1S(0), L1S(5), rt, ct, fr, fq, z));
            const f32x4 rh = tile_mm(L1S(11), L1S(9), rt, ct, fr, fq, rtil[cc]);
            const f32x4 yl = tile_mm(L1S(12), L1S(7), rt, ct, fr, fq, tile_mm(L1S(11), L1S(0), rt, ct, fr, fq, z));
            *(v2u*)(r1 + 0 * 8192 + eo) = pack4(gp); *(v2u*)(r1 + 1 * 8192 + eo) = pack4(hh);
            *(v2u*)(r1 + 2 * 8192 + eo) = pack4(rh); *(v2u*)(r1 + 3 * 8192 + eo) = pack4(yl); }
    }
    __syncthreads();
}

constexpr int BCP = 65;
__device__ __forceinline__ void gla_bc(const Args& a, const Frame& F, int b, int h, int vp0, int ntok) {
    const bf16* PROJ = (const bf16*)(a.ws + WS_PROJ); const float* PROJM = (const float*)(a.ws + WS_PROJM);
    LAS float* GKLs = (LAS float*)F.lds; LAS float* BC = (LAS float*)(F.lds + 4096);
    if (F.tid < 256) { const int t = F.tid >> 2, q = F.tid & 3;
        f32x4 v = {0.f, 0.f, 0.f, 0.f}; if (t < ntok) v = ldp4(PROJ, PROJM, b, vp0 + t, GKL + 4 * q);
        *(LAS f32x4*)(GKLs + t * 16 + 4 * q) = v; }
    __syncthreads();
    {
        const int d = F.tid & 63, tg = F.tid >> 6;
        float wc[16];
#pragma unroll
        for (int r = 0; r < 16; ++r) wc[r] = a.in[I_GKW2][r * 256 + h * 64 + d];
        const float gb = a.in[I_GKB][h * 64 + d];
#pragma unroll
        for (int i = 0; i < 8; ++i) { const int t = tg * 8 + i; float z = gb;
            const LAS f32x4* g4 = (const LAS f32x4*)(GKLs + t * 16);
#pragma unroll
            for (int q = 0; q < 4; ++q) { const f32x4 gv = g4[q]; z += gv.x * wc[4 * q] + gv.y * wc[4 * q + 1] + gv.z * wc[4 * q + 2] + gv.w * wc[4 * q + 3]; }
            BC[t * BCP + d] = (t < ntok) ? flogsigmoid(z) * (1.f / 16.f) : 0.f; }
    }
    __syncthreads();
    if (F.tid < 64) { float run = 0.f;
#pragma unroll 8
        for (int t = 0; t < 64; ++t) { run += BC[t * BCP + F.tid]; BC[t * BCP + F.tid] = run; } }
    __syncthreads();
}

__device__ __forceinline__ void gla_g1_unit(const Args& a, const Frame& F, int b, int h, int c) {
    const bf16* PROJ = (const bf16*)(a.ws + WS_PROJ); const float* PROJM = (const float*)(a.ws + WS_PROJM);
    float* GUS = (float*)(a.ws + WS_GUS); float* DL = (float*)(a.ws + WS_DL);
    const int ntok = (c == 0) ? NMETA : 64, vp0 = (c == 0) ? 0 : NMETA + 64 * (c - 1);
    gla_bc(a, F, b, h, vp0, ntok);
    LAS float* BC = (LAS float*)(F.lds + 4096);
    LAS bf16* KT = (LAS bf16*)(F.lds + 24576);
    LAS bf16* VT = (LAS bf16*)(F.lds + 24576 + 64 * TP * 2);
    {
        const int t = F.tid >> 3, q = F.tid & 7;
        const float* bl = nullptr; (void)bl;
#pragma unroll
        for (int half = 0; half < 2; ++half) {
            const int d0 = 8 * q + 4 * half;
            f32x4 kv = {0.f, 0.f, 0.f, 0.f}; if (t < ntok) kv = ldp4(PROJ, PROJM, b, vp0 + t, GK + h * 64 + d0);
#pragma unroll
            for (int i = 0; i < 4; ++i) { const int d = d0 + i; const float e = (t < ntok) ? fexp(BC[(ntok - 1) * BCP + d] - BC[t * BCP + d]) : 0.f;
                KT[d * TP + t] = (bf16)f2bf(kv[i] * e); }
        }
#pragma unroll
        for (int qq = 0; qq < 4; ++qq) {
            const int e0 = 16 * q + 4 * qq;
            f32x4 vv = {0.f, 0.f, 0.f, 0.f}; if (t < ntok) vv = ldp4(PROJ, PROJM, b, vp0 + t, GV + h * 128 + e0);
#pragma unroll
            for (int i = 0; i < 4; ++i) VT[(e0 + i) * TP + t] = (bf16)f2bf(vv[i]);
        }
    }
    __syncthreads();
    {
        const int rt = F.wave & 3, ch = F.wave >> 2, fr = F.lane & 15, fq = F.lane >> 4;
        float* up = GUS + ((size_t)((b * 4 + h) * NCH + c) * 64 + rt * 16 + fr) * 128;
#pragma unroll
        for (int cc = 0; cc < 4; ++cc) { const int ct = ch * 4 + cc;
            f32x4 acc = {0.f, 0.f, 0.f, 0.f};
#pragma unroll
            for (int ks = 0; ks < 2; ++ks)
                acc = mfma16(*(const LAS bf16x8*)(VT + (ct * 16 + fr) * TP + ks * 32 + 8 * fq), *(const LAS bf16x8*)(KT + (rt * 16 + fr) * TP + ks * 32 + 8 * fq), acc);
            *(f32x4*)(up + ct * 16 + 4 * fq) = acc; }
        if (F.tid < 64) DL[(size_t)((b * 4 + h) * NCH + c) * 64 + F.tid] = fexp(BC[(ntok - 1) * BCP + F.tid]);
    }
    __syncthreads();
}

__device__ __forceinline__ void phase2(const Args& a, const Frame& F) {
    for (int u = F.blk; u < NB * 8 * NCH; u += F.G) { const int c = u % NCH, bh = u / NCH; rwkv_l1_unit(a, F, bh >> 3, bh & 7, c); }
    for (int u = F.blk; u < NB * 4 * 32; u += F.G) { const int c = u & 31, bh = u >> 5; gla_g1_unit(a, F, bh >> 2, bh & 3, c); }
}

__device__ __forceinline__ void rwkv_l2_unit(const Args& a, const Frame& F, int bh) {
    unsigned char* ws = a.ws;
    const int b = bh >> 3, h = bh & 7;
    bf16* YMIX = (bf16*)(ws + WS_YMIX);
    LAS bf16* Sb0 = (LAS bf16*)F.lds; LAS bf16* Sb1 = Sb0 + 64 * TP;
    const int fr = F.lane & 15, fq = F.lane >> 4;
    const bool ywave = F.wave < 4;
    const int rt = F.wave & 3;
    f32x4 Sm[4];
#pragma unroll
    for (int ct = 0; ct < 4; ++ct) Sm[ct] = (f32x4){0.f, 0.f, 0.f, 0.f};
    if (!ywave) {
#pragma unroll
        for (int ct = 0; ct < 4; ++ct) *(LAS v2u*)(Sb0 + (rt * 16 + fr) * TP + ct * 16 + 4 * fq) = (v2u){0u, 0u};
    }
    __syncthreads();
#pragma nounroll
    for (int c = 0; c < NCH; ++c) {
        const int unit = bh * NCH + c;
        const unsigned char* r1 = ws + WS_R1 + (size_t)unit * R1_STRIDE;
        const LAS bf16* Sc = (c & 1) ? Sb1 : Sb0; LAS bf16* Sn = (c & 1) ? Sb0 : Sb1;
        if (ywave) {
            if (c >= 1) {
                const bf16* RhT = (const bf16*)(r1 + 2 * 8192); const bf16* YlT = (const bf16*)(r1 + 3 * 8192);
                const bf16* GV = (const bf16*)(r1 + 4 * 8192); const bf16* BV = (const bf16*)(r1 + 5 * 8192);
                const int t = rt * 16 + fr;
                const bf16x8 af0 = *(const bf16x8*)(RhT + t * 64 + 8 * fq), af1 = *(const bf16x8*)(RhT + t * 64 + 32 + 8 * fq);
                f32x4 y[4]; float s = 0.f;
#pragma unroll
                for (int ct = 0; ct < 4; ++ct) {
                    const v2u yl = *(const v2u*)(YlT + t * 64 + ct * 16 + 4 * fq);
                    f32x4 acc = {bflo(yl.x), bfhi(yl.x), bflo(yl.y), bfhi(yl.y)};
                    acc = mfma16(*(const LAS bf16x8*)(Sc + (ct * 16 + fr) * TP + 8 * fq), af0, acc);
                    acc = mfma16(*(const LAS bf16x8*)(Sc + (ct * 16 + fr) * TP + 32 + 8 * fq), af1, acc);
                    y[ct] = acc; s += (acc[0] + acc[1]) + (acc[2] + acc[3]);
                }
                s += __shfl_xor(s, 16); s += __shfl_xor(s, 32);
                const float mean = s * (1.f / 64.f); float q = 0.f;
#pragma unroll
                for (int ct = 0; ct < 4; ++ct) { y[ct] = y[ct] - mean; q += (y[ct][0] * y[ct][0] + y[ct][1] * y[ct][1]) + (y[ct][2] * y[ct][2] + y[ct][3] * y[ct][3]); }
                q += __shfl_xor(q, 16); q += __shfl_xor(q, 32);
                const float rstd = 1.f / sqrtf(q * (1.f / 64.f) + 64e-5f);
                const size_t m = (size_t)b * SEQ + 64 * (c - 1) + t;
#pragma unroll
                for (int ct = 0; ct < 4; ++ct) { const int i0 = ct * 16 + 4 * fq;
                    const f32x4 lg = *(const f32x4*)(a.in[I_RLNG] + h * 64 + i0), lb = *(const f32x4*)(a.in[I_RLNB] + h * 64 + i0);
                    const v2u gw = *(const v2u*)(GV + t * 64 + i0), bw = *(const v2u*)(BV + t * 64 + i0);
                    const f32x4 g = {bflo(gw.x), bfhi(gw.x), bflo(gw.y), bfhi(gw.y)}, bv = {bflo(bw.x), bfhi(bw.x), bflo(bw.y), bfhi(bw.y)};
                    const f32x4 o = (y[ct] * rstd * lg + lb + bv) * g;
                    *(v2u*)(YMIX + m * D + 512 + h * 64 + i0) = pack4(o); }
            }
        } else if (c + 1 < NCH) {
            const bf16* GpT = (const bf16*)(r1); const bf16* Hm = (const bf16*)(r1 + 8192);
            const float* GAM = (const float*)(ws + WS_GAM) + (size_t)unit * 64;
            const int i = rt * 16 + fr;
            const bf16x8 af0 = *(const LAS bf16x8*)(Sc + i * TP + 8 * fq), af1 = *(const LAS bf16x8*)(Sc + i * TP + 32 + 8 * fq);
#pragma unroll
            for (int ct = 0; ct < 4; ++ct) { const int j0 = ct * 16 + 4 * fq;
                const v2u hw = *(const v2u*)(Hm + i * 64 + j0); const f32x4 gm = *(const f32x4*)(GAM + j0);
                f32x4 acc = {bflo(hw.x), bfhi(hw.x), bflo(hw.y), bfhi(hw.y)};
                acc = mfma16(*(const bf16x8*)(GpT + (ct * 16 + fr) * 64 + 8 * fq), af0, acc);
                acc = mfma16(*(const bf16x8*)(GpT + (ct * 16 + fr) * 64 + 32 + 8 * fq), af1, acc);
                Sm[ct] = Sm[ct] * gm + acc;
                *(LAS v2u*)(Sn + i * TP + j0) = pack4(Sm[ct]); }
        }
        __syncthreads();
    }
}
__device__ __forceinline__ void gla_scan_unit(const Args& a, const Frame& F, int j) {
    float* GUS = (float*)(a.ws + WS_GUS); const float* DL = (const float*)(a.ws + WS_DL);
    const int bh = j >> 1, half = j & 1;
    const int d = 32 * half + (F.tid >> 4), e0 = (F.tid & 15) * 8;
    float* base = GUS + (size_t)bh * NCH * 8192 + d * 128 + e0;
    const float* dl = DL + (size_t)bh * NCH * 64 + d;
    f32x4 s0 = {0.f, 0.f, 0.f, 0.f}, s1 = s0;
    f32x4 u0 = *(const f32x4*)(base), u1 = *(const f32x4*)(base + 4); float dc = dl[0];
    for (int c = 0; c < NCH - 1; ++c) {
        f32x4 n0 = u0, n1 = u1; float dn = dc;
        if (c + 1 < NCH - 1) { n0 = *(const f32x4*)(base + (size_t)(c + 1) * 8192); n1 = *(const f32x4*)(base + (size_t)(c + 1) * 8192 + 4); dn = dl[(c + 1) * 64]; }
        *(f32x4*)(base + (size_t)c * 8192) = s0; *(f32x4*)(base + (size_t)c * 8192 + 4) = s1;
        s0 = s0 * dc + u0; s1 = s1 * dc + u1;
        u0 = n0; u1 = n1; dc = dn;
    }
    *(f32x4*)(base + (size_t)(NCH - 1) * 8192) = s0; *(f32x4*)(base + (size_t)(NCH - 1) * 8192 + 4) = s1;
}
__device__ __forceinline__ void phase3(const Args& a, const Frame& F) {
    for (int u = F.blk; u < 256; u += F.G) { if (u < 128) { for (int rep_ = 0; rep_ < NREP(3); ++rep_) rwkv_l2_unit(a, F, u); } else gla_scan_unit(a, F, u - 128); }
}

__device__ __forceinline__ void gla_g3_unit(const Args& a, const Frame& F, int b, int h, int c) {
    const bf16* PROJ = (const bf16*)(a.ws + WS_PROJ); const float* PROJM = (const float*)(a.ws + WS_PROJM);
    const float* GUS = (const float*)(a.ws + WS_GUS); bf16* YMIX = (bf16*)(a.ws + WS_YMIX);
    const int vp0 = NMETA + 64 * (c - 1);
    gla_bc(a, F, b, h, vp0, 64);
    LAS float* BC = (LAS float*)(F.lds + 4096);
    LAS bf16* QT = (LAS bf16*)(F.lds + 24576);
    LAS bf16* KL = QT + 64 * TP;
    LAS bf16* AT = KL + 64 * TP;
    LAS bf16* VT = AT + 64 * TP;
    LAS bf16* ST = VT + 128 * TP;
    LAS float* RS = (LAS float*)(ST + 128 * TP);
    {
        const int t = F.tid >> 3, q = F.tid & 7;
        const f32x4 q0 = ldp4(PROJ, PROJM, b, vp0 + t, GQ + h * 64 + 8 * q), q1 = ldp4(PROJ, PROJM, b, vp0 + t, GQ + h * 64 + 8 * q + 4);
        const f32x4 k0 = ldp4(PROJ, PROJM, b, vp0 + t, GK + h * 64 + 8 * q), k1 = ldp4(PROJ, PROJM, b, vp0 + t, GK + h * 64 + 8 * q + 4);
        float qv[8] = {q0.x, q0.y, q0.z, q0.w, q1.x, q1.y, q1.z, q1.w}, kv[8] = {k0.x, k0.y, k0.z, k0.w, k1.x, k1.y, k1.z, k1.w};
#pragma unroll
        for (int i = 0; i < 8; ++i) { const float bcv = BC[t * BCP + 8 * q + i]; qv[i] *= fexp(bcv) * 0.125f; kv[i] *= fexp(-bcv); }
        v4u o; o.x = pk2(qv[0], qv[1]); o.y = pk2(qv[2], qv[3]); o.z = pk2(qv[4], qv[5]); o.w = pk2(qv[6], qv[7]);
        *(LAS v4u*)(QT + t * TP + 8 * q) = o;
        o.x = pk2(kv[0], kv[1]); o.y = pk2(kv[2], kv[3]); o.z = pk2(kv[4], kv[5]); o.w = pk2(kv[6], kv[7]);
        *(LAS v4u*)(KL + t * TP + 8 * q) = o;
#pragma unroll
        for (int qq = 0; qq < 4; ++qq) {
            const int e0 = 16 * q + 4 * qq;
            const f32x4 vv = ldp4(PROJ, PROJM, b, vp0 + t, GV + h * 128 + e0);
#pragma unroll
            for (int i = 0; i < 4; ++i) VT[(e0 + i) * TP + t] = (bf16)f2bf(vv[i]);
            const f32x4 sv = *(const f32x4*)(GUS + ((size_t)((b * 4 + h) * NCH + c) * 64 + t) * 128 + e0);
#pragma unroll
            for (int i = 0; i < 4; ++i) ST[(e0 + i) * TP + t] = (bf16)f2bf(sv[i]);
        }
    }
    __syncthreads();
    const int rt = F.wave & 3, wh = F.wave >> 2, fr = F.lane & 15, fq = F.lane >> 4;
    const int trow = rt * 16 + fr;
    {
#pragma unroll
        for (int cc = 0; cc < 2; ++cc) { const int ct = 2 * wh + cc;
            f32x4 acc = {0.f, 0.f, 0.f, 0.f};
#pragma unroll
            for (int ks = 0; ks < 2; ++ks)
                acc = mfma16(*(const LAS bf16x8*)(KL + (ct * 16 + fr) * TP + ks * 32 + 8 * fq), *(const LAS bf16x8*)(QT + trow * TP + ks * 32 + 8 * fq), acc);
            const int s0 = ct * 16 + 4 * fq;
#pragma unroll
            for (int i = 0; i < 4; ++i) if (s0 + i > trow) acc[i] = 0.f;
            v2u o; o.x = pk2(acc[0], acc[1]); o.y = pk2(acc[2], acc[3]);
            *(LAS v2u*)(AT + trow * TP + s0) = o; }
    }
    __syncthreads();
    f32x4 oacc[4]; float ssq = 0.f;
#pragma unroll
    for (int cc = 0; cc < 4; ++cc) { const int ct = wh * 4 + cc;
        f32x4 acc = {0.f, 0.f, 0.f, 0.f};
#pragma unroll
        for (int ks = 0; ks < 2; ++ks) {
            acc = mfma16(*(const LAS bf16x8*)(VT + (ct * 16 + fr) * TP + ks * 32 + 8 * fq), *(const LAS bf16x8*)(AT + trow * TP + ks * 32 + 8 * fq), acc);
            acc = mfma16(*(const LAS bf16x8*)(ST + (ct * 16 + fr) * TP + ks * 32 + 8 * fq), *(const LAS bf16x8*)(QT + trow * TP + ks * 32 + 8 * fq), acc);
        }
        oacc[cc] = acc; ssq += (acc[0] * acc[0] + acc[1] * acc[1]) + (acc[2] * acc[2] + acc[3] * acc[3]); }
    ssq += __shfl_xor(ssq, 16); ssq += __shfl_xor(ssq, 32);
    if (fq == 0) RS[wh * 64 + trow] = ssq;
    __syncthreads();
    {
        const float tot = RS[trow] + RS[64 + trow];
        const float rstd = 1.f / sqrtf(tot * (1.f / 128.f) + 1e-6f);
        const size_t m = (size_t)b * SEQ + (vp0 - NMETA) + trow;
#pragma unroll
        for (int cc = 0; cc < 4; ++cc) { const int e0 = (wh * 4 + cc) * 16 + 4 * fq;
            const f32x4 gv = ldp4(PROJ, PROJM, b, vp0 + trow, GG + h * 128 + e0);
            const f32x4 ng = *(const f32x4*)(a.in[I_GNORM] + e0);
            float y[4];
#pragma unroll
            for (int i = 0; i < 4; ++i) { const float gi = gv[i]; y[i] = oacc[cc][i] * rstd * ng[i] * (gi * fsigmoid(gi)); }
            v2u o; o.x = pk2(y[0], y[1]); o.y = pk2(y[2], y[3]);
            *(v2u*)(YMIX + m * D + h * 128 + e0) = o; }
    }
    __syncthreads();
}
__device__ __forceinline__ void phase4(const Args& a, const Frame& F) {
    for (int u = F.blk; u < NB * 4 * 32; u += F.G) { const int c = 1 + (u & 31), bh = u >> 5; gla_g3_unit(a, F, bh >> 2, bh & 3, c); }
}

__device__ __forceinline__ int eidx_of(int L) { return 16 * (L & 1) + 8 * ((L >> 1) & 1) + 4 * ((L >> 2) & 1) + 2 * ((L >> 3) & 1) + ((L >> 4) & 1); }
__device__ __forceinline__ void phase6(const Args& a, const Frame& F) {
    unsigned char* ws = a.ws;
    const int gw = F.blk * NWAVES + F.wave, NGW = F.G * NWAVES;
    for (int rep_ = 0; rep_ < NREP(6); ++rep_) {
        LAS float* scr = (LAS float*)(F.lds + F.wave * 16384);
        constexpr int I_UP = 16 * 64, I_DN = 16 * 32;
        for (int it = gw; it < NE * (I_UP + I_DN); it += NGW) {
            if (it < NE * I_UP) { const int e = it / I_UP, r = it - e * I_UP;
                transpose_item(a.in[I_WUP] + (size_t)e * D * 2048, D, 2048, 64, (bf16*)(ws + WS_WUP) + (size_t)e * 2048 * D, scr, r, F.lane); }
            else { const int it2 = it - NE * I_UP, e = it2 / I_DN, r = it2 - e * I_DN;
                transpose_item(a.in[I_WDN] + (size_t)e * D * D, D, D, 32, (bf16*)(ws + WS_WDN) + (size_t)e * D * D, scr, r, F.lane); }
        }
    }
    __syncthreads();
    constexpr int RWP = 1028;
    LAS float* rwT = (LAS float*)F.lds;
    LAS int* hist = (LAS int*)(F.lds + 32 * RWP * 4);
    for (int i = F.tid; i < D * NE; i += NTHR) { const int c = i >> 5, e = i & 31; rwT[e * RWP + c] = a.in[I_RTW][i]; }
    const float* S1 = (const float*)(ws + WS_S1); bf16* H1 = (bf16*)(ws + WS_H1);
    int* TOPI = (int*)(ws + WS_TOPI); float* GATE = (float*)(ws + WS_GATE); int* RANK = (int*)(ws + WS_RANK);
    unsigned* CNT = (unsigned*)(ws + WS_CTL) + CW_CNT;
    for (int rb = F.blk; rb < MX / 128; rb += F.G) {
        if (F.tid < 64) hist[F.tid] = 0;
        __syncthreads();
        int my_e = 0;
        for (int i = 0; i < 16; ++i) {
            const int m = rb * 128 + F.wave * 16 + i;
            const f32x4* xr = (const f32x4*)(S1 + (size_t)m * D) + F.lane;
            f32x4 v[4]; float s = 0.f;
#pragma unroll
            for (int j = 0; j < 4; ++j) { v[j] = xr[64 * j]; s += (v[j].x + v[j].y) + (v[j].z + v[j].w); }
            const float mean = wave_sum(s) * (1.f / D); float s2 = 0.f;
#pragma unroll
            for (int j = 0; j < 4; ++j) { v[j] = v[j] - mean; s2 += (v[j].x * v[j].x + v[j].y * v[j].y) + (v[j].z * v[j].z + v[j].w * v[j].w); }
            const float rstd = 1.f / sqrtf(wave_sum(s2) * (1.f / D) + 1e-5f);
#pragma unroll
            for (int j = 0; j < 4; ++j) { const int col = 4 * (F.lane + 64 * j);
                const f32x4 gv = *(const f32x4*)(a.in[I_LN1G] + col), bv = *(const f32x4*)(a.in[I_LN1B] + col);
                v[j] = v[j] * rstd * gv + bv;
                v2u o; o.x = pk2(v[j].x, v[j].y); o.y = pk2(v[j].z, v[j].w);
                *(v2u*)(H1 + (size_t)m * D + col) = o; }
            float p[32];
#pragma unroll
            for (int e = 0; e < 32; ++e) { float acc = 0.f;
#pragma unroll
                for (int j = 0; j < 4; ++j) { const f32x4 w = *(const LAS f32x4*)(rwT + e * RWP + 4 * (F.lane + 64 * j)); acc += (v[j].x * w.x + v[j].y * w.y) + (v[j].z * w.z + v[j].w * w.w); }
                p[e] = acc; if ((e & 3) == 3) __builtin_amdgcn_sched_barrier(0); }
#define TR_STAGE(n, dmask) _Pragma("unroll") for (int i2 = 0; i2 < (n) / 2; ++i2) { const bool up = (F.lane & (dmask)) != 0; const float keep = up ? p[i2 + (n) / 2] : p[i2]; const float send = up ? p[i2] : p[i2 + (n) / 2]; p[i2] = keep + __shfl_xor(send, (dmask)); }
            TR_STAGE(32, 1) TR_STAGE(16, 2) TR_STAGE(8, 4) TR_STAGE(4, 8) TR_STAGE(2, 16)
#undef TR_STAGE
            const int eidx = eidx_of(F.lane);
            const float logit = p[0] + __shfl_xor(p[0], 32) + a.in[I_RTB][eidx];
            int rank = 0;
#pragma unroll
            for (int j = 0; j < 32; ++j) { const float lj = __int_as_float(__builtin_amdgcn_readlane(__float_as_int(logit), j)); const int ej = eidx_of(j);
                rank += (lj > logit || (lj == logit && ej < eidx)) ? 1 : 0; }
            int ek[4]; float lk[4];
#pragma unroll
            for (int k = 0; k < 4; ++k) { const unsigned long long mk = __ballot(rank == k) & 0xffffffffull; const int src = __builtin_amdgcn_readfirstlane((int)__builtin_ctzll(mk | (1ull << 63)));
                ek[k] = eidx_of(src); lk[k] = __int_as_float(__builtin_amdgcn_readlane(__float_as_int(logit), src)); }
            const float e0 = 1.f, e1 = expf(lk[1] - lk[0]), e2 = expf(lk[2] - lk[0]), e3 = expf(lk[3] - lk[0]);
            const float inv = 1.f / (e0 + e1 + e2 + e3);
            if (F.lane < 4) { const int k = F.lane; const int ee = k == 0 ? ek[0] : k == 1 ? ek[1] : k == 2 ? ek[2] : ek[3]; const float gg = (k == 0 ? e0 : k == 1 ? e1 : k == 2 ? e2 : e3) * inv;
                TOPI[(size_t)m * 4 + k] = ee; GATE[(size_t)m * 4 + k] = gg; }
            if ((F.lane >> 2) == i) { const int k = F.lane & 3; my_e = k == 0 ? ek[0] : k == 1 ? ek[1] : k == 2 ? ek[2] : ek[3]; }
        }
        const int lrank = __hip_atomic_fetch_add(&hist[my_e], 1, __ATOMIC_RELAXED, __HIP_MEMORY_SCOPE_WORKGROUP);
        __syncthreads();
        if (F.tid < 32) hist[32 + F.tid] = (int)__hip_atomic_fetch_add(CNT + 64 * F.tid, (unsigned)hist[F.tid], __ATOMIC_RELAXED, __HIP_MEMORY_SCOPE_AGENT);
        __syncthreads();
        RANK[((size_t)rb * 128 + F.wave * 16 + (F.lane >> 2)) * 4 + (F.lane & 3)] = hist[32 + my_e] + lrank;
        __syncthreads();
    }
}

__device__ __forceinline__ void phase7(const Args& a, const Frame& F) {
    unsigned char* ws = a.ws;
    LAS int* starts = (LAS int*)F.lds;
    unsigned* CNT = (unsigned*)(ws + WS_CTL) + CW_CNT;
    int* TILEE = (int*)(ws + WS_TILEE);
    if (F.tid < 32) { const int cnt = (int)ld_agent(CNT + 64 * F.tid); starts[32 + F.tid] = (cnt + 255) & ~255; }
    __syncthreads();
    if (F.tid == 0) { int run = 0; for (int e = 0; e < 32; ++e) { starts[e] = run; run += starts[32 + e]; }
        if (F.blk == 0) { TILEE[1023] = run >> 8; for (int e = 0; e < 32; ++e) for (int tl = starts[e] >> 8; tl < (starts[e] + starts[32 + e]) >> 8; ++tl) TILEE[tl] = e; } }
    __syncthreads();
    const int* TOPI = (const int*)(ws + WS_TOPI); const int* RANK = (const int*)(ws + WS_RANK); int* TSLOT = (int*)(ws + WS_TSLOT);
    const bf16* H1 = (const bf16*)(ws + WS_H1); bf16* XS = (bf16*)(ws + WS_XS);
    const int gw = F.blk * NWAVES + F.wave, NGW = F.G * NWAVES;
    for (int q = gw; q < MX * 4; q += NGW) {
        const int m = q >> 2;
        const int e = TOPI[q], rk = RANK[q];
        const int slot = starts[e] + rk;
        if (F.lane == 0) TSLOT[q] = slot;
        const v4u* src = (const v4u*)(H1 + (size_t)m * D); v4u* dst = (v4u*)(XS + (size_t)slot * D);
        dst[F.lane] = src[F.lane]; dst[F.lane + 64] = src[F.lane + 64];
    }
}
__device__ __forceinline__ int moe_fill_table(const Args& a, const Frame& F, int nN, int RM) {
    LAS int* tab = (LAS int*)(F.lds + TAB_OFF);
    const unsigned* TILEE = (const unsigned*)(a.ws + WS_TILEE);
    if (F.tid == 0) {
        const int NT = (int)ld_agent(TILEE + 1023);
        const int x = F.blk & 7, j = F.blk >> 3; int n = 0;
        for (int i = 0; i < 64; ++i) { const int s = i * 8 + x, pm = s * RM + j / nN; if (pm >= NT) break;
            const int e = (int)ld_agent(TILEE + pm); tab[2 * n] = pm; tab[2 * n + 1] = e * nN + (j % nN); ++n; }
        tab[128] = n;
    }
    __syncthreads();
    return __builtin_amdgcn_readfirstlane(tab[128]);
}

__device__ __forceinline__ void phase10(const Args& a, const Frame& F) {
    unsigned char* ws = a.ws;
    const bf16* H1 = (const bf16*)(ws + WS_H1); const bf16* YS = (const bf16*)(ws + WS_YS);
    const int* TSLOT = (const int*)(ws + WS_TSLOT); const float* GATE = (const float*)(ws + WS_GATE);
    const int gw = F.blk * NWAVES + F.wave, NGW = F.G * NWAVES;
    for (int m = gw; m < MX; m += NGW) {
        float s[16];
#pragma unroll
        for (int j = 0; j < 2; ++j) { const v4u w = *(const v4u*)(H1 + (size_t)m * D + 8 * F.lane + 512 * j);
            s[8 * j + 0] = ALPHA * bflo(w.x); s[8 * j + 1] = ALPHA * bfhi(w.x); s[8 * j + 2] = ALPHA * bflo(w.y); s[8 * j + 3] = ALPHA * bfhi(w.y);
            s[8 * j + 4] = ALPHA * bflo(w.z); s[8 * j + 5] = ALPHA * bfhi(w.z); s[8 * j + 6] = ALPHA * bflo(w.w); s[8 * j + 7] = ALPHA * bfhi(w.w); }
#pragma unroll
        for (int k = 0; k < 4; ++k) { const int slot = TSLOT[(size_t)m * 4 + k]; const float g = GATE[(size_t)m * 4 + k];
#pragma unroll
            for (int j = 0; j < 2; ++j) { const v4u w = *(const v4u*)(YS + (size_t)slot * D + 8 * F.lane + 512 * j);
                s[8 * j + 0] += g * bflo(w.x); s[8 * j + 1] += g * bfhi(w.x); s[8 * j + 2] += g * bflo(w.y); s[8 * j + 3] += g * bfhi(w.y);
                s[8 * j + 4] += g * bflo(w.z); s[8 * j + 5] += g * bfhi(w.z); s[8 * j + 6] += g * bflo(w.w); s[8 * j + 7] += g * bfhi(w.w); } }
        float t = 0.f;
#pragma unroll
        for (int i = 0; i < 16; ++i) t += s[i];
        const float mean = wave_sum(t) * (1.f / D); float q = 0.f;
#pragma unroll
        for (int i = 0; i < 16; ++i) { s[i] -= mean; q += s[i] * s[i]; }
        const float rstd = 1.f / sqrtf(wave_sum(q) * (1.f / D) + 1e-5f);
#pragma unroll
        for (int j = 0; j < 2; ++j) { const int col = 8 * F.lane + 512 * j;
#pragma unroll
            for (int hh = 0; hh < 2; ++hh) { const f32x4 gv = *(const f32x4*)(a.in[I_LN2G] + col + 4 * hh), bv = *(const f32x4*)(a.in[I_LN2B] + col + 4 * hh);
                f32x4 o; o.x = s[8 * j + 4 * hh + 0] * rstd * gv.x + bv.x; o.y = s[8 * j + 4 * hh + 1] * rstd * gv.y + bv.y; o.z = s[8 * j + 4 * hh + 2] * rstd * gv.z + bv.z; o.w = s[8 * j + 4 * hh + 3] * rstd * gv.w + bv.w;
                *(f32x4*)(a.out + (size_t)m * D + col + 4 * hh) = o; } }
    }
}

template <int LO, int HI>
__global__ void __launch_bounds__(NTHR, 2) fwd(Args a) {
    extern __shared__ __attribute__((aligned(16))) unsigned char lds_raw[];
    LAS unsigned char* lds = (LAS unsigned char*)lds_raw;
    const int wave = __builtin_amdgcn_readfirstlane((int)(threadIdx.x >> 6));
    volatile LAS unsigned* MISC = (volatile LAS unsigned*)(lds + MISC_OFF);
    if (wave == 0) MISC[lane_id()] = 0u;
    __syncthreads();
    unsigned* ctl = (unsigned*)(a.ws + WS_CTL);
    XcdBarrier bar; bar.bar = ctl + CW_BAR; bar.x = 0; bar.st = nullptr;
    if constexpr (HI - LO > 1) bar = xcd_barrier_post(ctl + CW_BAR, MISC + 8, wave == 0 && lane_id() == 0);
#define PH(k) if constexpr (LO <= (k) && (k) < HI)
#define SEAM(k) if constexpr (LO <= (k) && (k) + 1 < HI) xcd_barrier(bar, wave == 0 && lane_id() == 0)
    PH(0) for (int rep_ = 0; rep_ < NREP(0); ++rep_) { const Frame F = mkframe(lds, wave); phase0(a, F); } SEAM(0);
    PH(1) for (int rep_ = 0; rep_ < NREP(1); ++rep_) { const Frame F = mkframe(lds, wave);
            pg8::Gemm g{(const pg8::bf16_t*)(a.ws + WS_A0), (const pg8::bf16_t*)(a.ws + WS_WIN), MX, PW, D}; pg8::StaticOrder S; S.init(MX, PW, F.G, F.blk);
            pg8::EpiBf16Plain E{(pg8::bf16_t*)(a.ws + WS_PROJ), PW};
            pg8::gemm_phase<pg8::EpiBf16Plain, pg8::StaticOrder, true, true>(F.lds, g, S, E, F.tid); } SEAM(1);
    PH(2) for (int rep_ = 0; rep_ < NREP(2); ++rep_) { const Frame F = mkframe(lds, wave); phase2(a, F); } SEAM(2);
    PH(3) { const Frame F = mkframe(lds, wave); phase3(a, F); } SEAM(3);
    PH(4) for (int rep_ = 0; rep_ < NREP(4); ++rep_) { const Frame F = mkframe(lds, wave); phase4(a, F); } SEAM(4);
    PH(5) for (int rep_ = 0; rep_ < NREP(5); ++rep_) { const Frame F = mkframe(lds, wave);
            pg8::Gemm g{(const pg8::bf16_t*)(a.ws + WS_YMIX), (const pg8::bf16_t*)(a.ws + WS_WOUT), MX, D, D}; pg8::StaticOrder S; S.init(MX, D, F.G, F.blk);
            pg8::EpiResid E{(float*)(a.ws + WS_S1), a.in[I_X], (const float*)(a.ws + WS_STATS), a.in[I_LNIN_G], a.in[I_LNIN_B], ALPHA};
            pg8::gemm_phase<pg8::EpiResid, pg8::StaticOrder, true, true>(F.lds, g, S, E, F.tid); } SEAM(5);
    PH(6) { const Frame F = mkframe(lds, wave); phase6(a, F); } SEAM(6);
    PH(7) for (int rep_ = 0; rep_ < NREP(7); ++rep_) { const Frame F = mkframe(lds, wave); phase7(a, F); } SEAM(7);
    PH(8) for (int rep_ = 0; rep_ < NREP(8); ++rep_) { const Frame F = mkframe(lds, wave); const int n = moe_fill_table(a, F, 8, 4);
            pg8::Gemm g{(const pg8::bf16_t*)(a.ws + WS_XS), (const pg8::bf16_t*)(a.ws + WS_WUP), 0, 0, D}; pg8::TableOrder S{(const LAS int*)(F.lds + TAB_OFF), n};
            pg8::EpiSwiglu E{(pg8::bf16_t*)(a.ws + WS_ACT), a.in[I_BUP]};
            pg8::gemm_phase<pg8::EpiSwiglu, pg8::TableOrder, true, true>(F.lds, g, S, E, F.tid); } SEAM(8);
    PH(9) for (int rep_ = 0; rep_ < NREP(9); ++rep_) { const Frame F = mkframe(lds, wave); const int n = moe_fill_table(a, F, 4, 8);
            pg8::Gemm g{(const pg8::bf16_t*)(a.ws + WS_ACT), (const pg8::bf16_t*)(a.ws + WS_WDN), 0, 0, D}; pg8::TableOrder S{(const LAS int*)(F.lds + TAB_OFF), n};
            pg8::EpiDown E{(pg8::bf16_t*)(a.ws + WS_YS), a.in[I_BDN]};
            pg8::gemm_phase<pg8::EpiDown, pg8::TableOrder, true, true>(F.lds, g, S, E, F.tid); } SEAM(9);
    PH(10) for (int rep_ = 0; rep_ < NREP(10); ++rep_) { const Frame F = mkframe(lds, wave); phase10(a, F); }
#undef PH
#undef SEAM
}

#ifndef MK_SINGLE
#define MK_SINGLE 1
#endif
template <int LO, int HI> static void launch_range(const Args& a, int grid, hipStream_t stream) {
    static bool attr = false;
    if (!attr) { (void)hipFuncSetAttribute((const void*)fwd<LO, HI>, hipFuncAttributeMaxDynamicSharedMemorySize, LDS_BYTES); attr = true; }
    hipLaunchKernelGGL((fwd<LO, HI>), dim3(grid), dim3(NTHR), LDS_BYTES, stream, a);
}
extern "C" void kernel_launch(void* const* d_in, const int* in_sizes, int n_in, void* d_out, int out_size, void* d_ws, size_t ws_size, hipStream_t stream) {
    if (n_in != 30 || ws_size < WS_END) { fprintf(stderr, "kernel_launch: unexpected inputs (n_in %d, ws %zu)\n", n_in, ws_size); return; }
    const int grid = 256;
    (void)hipMemsetAsync((char*)d_ws + WS_CTL, 0, CTL_ZERO_BYTES, stream);
    Args a{};
    for (int i = 0; i < 30; ++i) a.in[i] = (const float*)d_in[i];
    a.out = (float*)d_out; a.ws = (unsigned char*)d_ws;
#if MK_SINGLE
    launch_range<0, 11>(a, grid, stream);
#else
    launch_range<0, 1>(a, grid, stream); launch_range<1, 2>(a, grid, stream); launch_range<2, 3>(a, grid, stream); launch_range<3, 4>(a, grid, stream);
    launch_range<4, 5>(a, grid, stream); launch_range<5, 6>(a, grid, stream); launch_range<6, 7>(a, grid, stream); launch_range<7, 8>(a, grid, stream);
    launch_range<8, 9>(a, grid, stream); launch_range<9, 10>(a, grid, stream); launch_range<10, 11>(a, grid, stream);
#endif
}
```

```cpp
#include <hip/hip_runtime.h>
#include <cstdio>
#include <cstdint>
#include <cmath>
namespace pg8 {
#define PG8_LAS __attribute__((address_space(3)))
typedef unsigned short bf16_t;
typedef short bf16x8 __attribute__((ext_vector_type(8)));
typedef float f32x4 __attribute__((ext_vector_type(4)));
typedef unsigned u32x4 __attribute__((ext_vector_type(4)));
constexpr int BM = 256, BK = 64, HALF = 128, HTB = HALF * BK * 2  , STAGE_BYTES = 8 * HTB, NXCD = 8, WGM = 8;

__host__ __device__ __forceinline__ int lds_byte(int r, int c) { const int st = (r >> 4) * 2 + (c >> 5), rr = r & 15, cc = c & 31, ob = rr * 64 + cc * 2; return st * 1024 + (ob ^ (((ob >> 9) & 1) << 5)); }
__host__ __device__ __forceinline__ void stage_rc(int b, int& R, int& C) { const int st = b / 1024, sb = b % 1024, swz = sb ^ (((sb >> 9) & 1) << 5); R = (st >> 1) * 16 + swz / 64; C = (st & 1) * 32 + (swz % 64) / 2; }
__host__ __device__ __forceinline__ int perm32(int rho) { const int n = rho >> 4, i = rho & 15; return 8 * (i >> 2) + 4 * n + (i & 3); }

struct Unit { int pm, pn; };
struct Gemm { const bf16_t* A; const bf16_t* Bt; int M, N, K; };

struct StaticOrder {
    int nM, nN, nwg, G, c;
    __host__ __device__ void init(int M, int N, int G_, int c_) { nM = M / BM; nN = N / BM; nwg = nM * nN; G = G_; c = c_; }
    __host__ __device__ bool next(int i, Unit& u) const {
        const long L = (long)i * G + c; if (L >= nwg) return false;
        int wgid = (int)L; { const int q = nwg / NXCD, r = nwg % NXCD, xcd = wgid % NXCD, off = wgid / NXCD; wgid = (xcd < r ? xcd * (q + 1) : r * (q + 1) + (xcd - r) * q) + off; }
        const int nig = WGM * nN, gid = wgid / nig, fm = gid * WGM, gsz = (nM - fm) < WGM ? (nM - fm) : WGM;
        u.pm = fm + ((wgid % nig) % gsz); u.pn = (wgid % nig) / gsz; return true;
    }
    __device__ __forceinline__ void a_ready(const Unit&) const {}
    __device__ __forceinline__ void done(const Unit&) const {}
};


__device__ __forceinline__ unsigned cvt_pk_bf16(float lo, float hi) { unsigned r; asm volatile("v_cvt_pk_bf16_f32 %0, %1, %2" : "=v"(r) : "v"(lo), "v"(hi)); return r; }
typedef unsigned u32x2 __attribute__((ext_vector_type(2)));

struct EpiBf16Plain {
    static constexpr bool PERM = true, AFTER_DRAIN = false;
    bf16_t* O; int ldc;
    __device__ __forceinline__ void operator()(const f32x4 (&acc)[2][2][4][2], const Unit& u, int wr, int wc, int fr, int fq) const {
        const int row0 = u.pm * BM + wr * 64 + fr, col0 = u.pn * BM + wc * 32 + 8 * fq;
#pragma unroll
        for (int ai = 0; ai < 2; ++ai)
#pragma unroll
            for (int m = 0; m < 4; ++m) { bf16_t* rowp = O + (size_t)(row0 + ai * HALF + m * 16) * ldc + col0;
#pragma unroll
                for (int bj = 0; bj < 2; ++bj) { const f32x4 v0 = acc[ai][bj][m][0], v1 = acc[ai][bj][m][1];
                    u32x4 w; w.x = cvt_pk_bf16(v0[0], v0[1]); w.y = cvt_pk_bf16(v0[2], v0[3]); w.z = cvt_pk_bf16(v1[0], v1[1]); w.w = cvt_pk_bf16(v1[2], v1[3]);
                    *(u32x4*)(rowp + bj * HALF) = w; } }
    }
};

struct EpiResid {
    static constexpr bool PERM = false, AFTER_DRAIN = false;
    float* S1; const float* x; const float* stats; const float* g; const float* bta; float alpha;
    __device__ __forceinline__ void operator()(const f32x4 (&acc)[2][2][4][2], const Unit& u, int wr, int wc, int fr, int fq) const {
        const int row0 = u.pm * BM + wr * 64 + fr, col0 = u.pn * BM + wc * 32 + 4 * fq;
#pragma unroll
        for (int bj = 0; bj < 2; ++bj)
#pragma unroll
            for (int n = 0; n < 2; ++n) { const int c = col0 + bj * HALF + n * 16;
                const f32x4 gv = *(const f32x4*)(g + c) * alpha, bv = *(const f32x4*)(bta + c) * alpha;
#pragma unroll
                for (int ai = 0; ai < 2; ++ai)
#pragma unroll
                    for (int m = 0; m < 4; ++m) { const int r = row0 + ai * HALF + m * 16;
                        const float mean = stats[2 * r], rstd = stats[2 * r + 1];
                        const f32x4 xv = *(const f32x4*)(x + (size_t)r * 1024 + c);
                        *(f32x4*)(S1 + (size_t)r * 1024 + c) = ((xv - mean) * rstd) * gv + bv + acc[ai][bj][m][n]; } }
    }
};

__device__ __forceinline__ float swiglu1(float glu, float lin) {
    const float xg = fminf(glu, 7.0f), xl = fminf(fmaxf(lin, -7.0f), 7.0f);
    const float sg = __builtin_amdgcn_rcpf(1.0f + __expf(-1.702f * xg));
    return xg * sg * (xl + 1.0f);
}
struct EpiSwiglu {
    static constexpr bool PERM = true, AFTER_DRAIN = false;
    bf16_t* ACT; const float* bup;
    __device__ __forceinline__ void operator()(const f32x4 (&acc)[2][2][4][2], const Unit& u, int wr, int wc, int fr, int fq) const {
        const int e = u.pn >> 3, pn = u.pn & 7;
        const int row0 = u.pm * BM + wr * 64 + fr, ucol0 = pn * BM + wc * 32 + 8 * fq, acol0 = ucol0 >> 1;
        f32x4 bv[2][2];
#pragma unroll
        for (int bj = 0; bj < 2; ++bj)
#pragma unroll
            for (int n = 0; n < 2; ++n) bv[bj][n] = *(const f32x4*)(bup + (size_t)e * 2048 + ucol0 + bj * HALF + 4 * n);
#pragma unroll
        for (int ai = 0; ai < 2; ++ai)
#pragma unroll
            for (int m = 0; m < 4; ++m) { bf16_t* rowp = ACT + (size_t)(row0 + ai * HALF + m * 16) * 1024 + acol0;
#pragma unroll
                for (int bj = 0; bj < 2; ++bj) { const f32x4 v0 = acc[ai][bj][m][0] + bv[bj][0], v1 = acc[ai][bj][m][1] + bv[bj][1];
                    u32x2 w; w.x = cvt_pk_bf16(swiglu1(v0[0], v0[1]), swiglu1(v0[2], v0[3])); w.y = cvt_pk_bf16(swiglu1(v1[0], v1[1]), swiglu1(v1[2], v1[3]));
                    *(u32x2*)(rowp + bj * (HALF / 2)) = w; } }
    }
};
struct EpiDown {
    static constexpr bool PERM = true, AFTER_DRAIN = false;
    bf16_t* YS; const float* bdn;
    __device__ __forceinline__ void operator()(const f32x4 (&acc)[2][2][4][2], const Unit& u, int wr, int wc, int fr, int fq) const {
        const int e = u.pn >> 2, pn = u.pn & 3;
        const int row0 = u.pm * BM + wr * 64 + fr, col0 = pn * BM + wc * 32 + 8 * fq;
        f32x4 bv[2][2];
#pragma unroll
        for (int bj = 0; bj < 2; ++bj)
#pragma unroll
            for (int n = 0; n < 2; ++n) bv[bj][n] = *(const f32x4*)(bdn + (size_t)e * 1024 + col0 + bj * HALF + 4 * n);
#pragma unroll
        for (int ai = 0; ai < 2; ++ai)
#pragma unroll
            for (int m = 0; m < 4; ++m) { bf16_t* rowp = YS + (size_t)(row0 + ai * HALF + m * 16) * 1024 + col0;
#pragma unroll
                for (int bj = 0; bj < 2; ++bj) { const f32x4 v0 = acc[ai][bj][m][0] + bv[bj][0], v1 = acc[ai][bj][m][1] + bv[bj][1];
                    u32x4 w; w.x = cvt_pk_bf16(v0[0], v0[1]); w.y = cvt_pk_bf16(v0[2], v0[3]); w.z = cvt_pk_bf16(v1[0], v1[1]); w.w = cvt_pk_bf16(v1[2], v1[3]);
                    *(u32x4*)(rowp + bj * HALF) = w; } }
    }
};
struct TableOrder {
    const PG8_LAS int* tab; int n;
    __device__ __forceinline__ bool next(int i, Unit& u) const {
        if (i >= n) return false;
        u.pm = __builtin_amdgcn_readfirstlane(tab[2 * i]); u.pn = __builtin_amdgcn_readfirstlane(tab[2 * i + 1]); return true;
    }
    __device__ __forceinline__ void a_ready(const Unit&) const {}
    __device__ __forceinline__ void done(const Unit&) const {}
};

template <class Epi, class Sched, bool ALIGN_EPI = false, bool SP2 = false>
__device__ __forceinline__ void gemm_phase(PG8_LAS unsigned char* lds, const Gemm g, const Sched& S, const Epi& E, const int tid) {
    const int wid = __builtin_amdgcn_readfirstlane(tid >> 6), lane = tid & 63, wr = wid >> 2, wc = wid & 3, fr = lane & 15, fq = lane >> 4;
    const int K = g.K, nt = K / BK;
    unsigned voffA[2], voffB[2];
#pragma unroll
    for (int i = 0; i < 2; ++i) { int R, C; stage_rc(tid * 16 + i * 8192, R, C); const int Rb = Epi::PERM ? ((R & ~31) + perm32(R & 31)) : R;
        voffA[i] = (unsigned)(R * K + C) * 2u; voffB[i] = (unsigned)(Rb * K + C) * 2u; }
    const size_t kstep = (size_t)(BK * 2);
    const size_t hstep = (size_t)HALF * K * 2;
    const size_t tstep = 2 * hstep;
    const unsigned ldsw = (unsigned)wid * 1024u;
    const int aoff = lds_byte(wr * 64 + fr, fq * 8), boff = lds_byte(wc * 32 + fr, fq * 8);
#define PG8_SA(b, h) (((b) * 2 + (h)) * HTB)
#define PG8_SB(b, h) ((4 + (b) * 2 + (h)) * HTB)
#define PG8_STAGE(bufoff, gbase, voff) do { _Pragma("unroll") for (int _i = 0; _i < 2; ++_i) \
        __builtin_amdgcn_global_load_lds((const unsigned*)((const char*)(gbase) + (voff)[_i]), (PG8_LAS unsigned*)(lds + (bufoff) + ldsw + _i * 8192), 16, 0, 0); } while (0)
#define PG8_LDA(dst, b, h) do { _Pragma("unroll") for (int m = 0; m < 4; ++m) _Pragma("unroll") for (int k = 0; k < 2; ++k) dst[m][k] = *(const PG8_LAS bf16x8*)(lds + PG8_SA(b, h) + aoff + m * 2048 + k * 1024); } while (0)
#define PG8_LDB(dst, b, h) do { _Pragma("unroll") for (int n = 0; n < 2; ++n) _Pragma("unroll") for (int k = 0; k < 2; ++k) dst[n][k] = *(const PG8_LAS bf16x8*)(lds + PG8_SB(b, h) + boff + n * 2048 + k * 1024); } while (0)
#define PG8_MMA(ai, bj, At, Bt) do { __builtin_amdgcn_s_setprio(1); _Pragma("unroll") for (int m = 0; m < 4; ++m) _Pragma("unroll") for (int n = 0; n < 2; ++n) _Pragma("unroll") for (int k = 0; k < 2; ++k) \
        acc[ai][bj][m][n] = __builtin_amdgcn_mfma_f32_16x16x32_bf16(Bt[n][k], At[m][k], acc[ai][bj][m][n], 0, 0, 0); __builtin_amdgcn_s_setprio(0); } while (0)
#define PG8_WAIT_V(n) asm volatile("s_waitcnt vmcnt(" #n ")" ::: "memory")
#define PG8_WAIT_L(n) asm volatile("s_waitcnt lgkmcnt(" #n ")" ::: "memory")
#define PG8_BAR __builtin_amdgcn_s_barrier()
#define PG8_SCHED __builtin_amdgcn_sched_barrier(0)
    Unit cur, nxt; int ui = 0;
    if (!S.next(0, cur)) return;
    f32x4 acc[2][2][4][2];
#pragma unroll
    for (int a = 0; a < 2; ++a)
#pragma unroll
        for (int b = 0; b < 2; ++b)
#pragma unroll
            for (int m = 0; m < 4; ++m)
#pragma unroll
                for (int n = 0; n < 2; ++n) acc[a][b][m][n] = (f32x4){0.f, 0.f, 0.f, 0.f};
    bf16x8 At[4][2], B0[2][2], B1[2][2];
    const char* cA = (const char*)g.A + (size_t)cur.pm * tstep; const char* cB = (const char*)g.Bt + (size_t)cur.pn * tstep;
    S.a_ready(cur);
    if constexpr (SP2) {
        PG8_STAGE(PG8_SB(0, 0), cB, voffB); PG8_STAGE(PG8_SB(0, 1), cB + hstep, voffB); PG8_STAGE(PG8_SA(0, 0), cA, voffA); PG8_STAGE(PG8_SA(0, 1), cA + hstep, voffA);
        if (wr == 1) PG8_BAR;
        PG8_WAIT_V(2); PG8_BAR;
        PG8_STAGE(PG8_SB(1, 0), cB + kstep, voffB); PG8_STAGE(PG8_SA(1, 0), cA + kstep, voffA); PG8_STAGE(PG8_SB(1, 1), cB + hstep + kstep, voffB);
        PG8_WAIT_V(6); PG8_BAR;
    } else {
        PG8_STAGE(PG8_SB(0, 0), cB, voffB); PG8_STAGE(PG8_SA(0, 0), cA, voffA); PG8_STAGE(PG8_SB(0, 1), cB + hstep, voffB); PG8_STAGE(PG8_SA(0, 1), cA + hstep, voffA);
        if (wr == 1) PG8_BAR;
        PG8_WAIT_V(4); PG8_BAR;
        PG8_STAGE(PG8_SB(1, 0), cB + kstep, voffB); PG8_STAGE(PG8_SA(1, 0), cA + kstep, voffA); PG8_STAGE(PG8_SB(1, 1), cB + hstep + kstep, voffB);
        PG8_WAIT_V(6); PG8_BAR;
    }
    for (;;) {
        const bool has_next = S.next(ui + 1, nxt);
        const char* nA = has_next ? (const char*)g.A + (size_t)nxt.pm * tstep : cA; const char* nB = has_next ? (const char*)g.Bt + (size_t)nxt.pn * tstep : cB;
        for (int t = 0; t < nt; t += 2) {
            const bool last = (t == nt - 2);
            const char* a1 = cA + (size_t)(t + 1) * kstep;
            const char* a2 = last ? nA : cA + (size_t)(t + 2) * kstep; const char* b2 = last ? nB : cB + (size_t)(t + 2) * kstep;
            const char* a3 = a2 + kstep; const char* b3 = b2 + kstep;
            if (last && has_next) S.a_ready(nxt);
            if constexpr (SP2) {
            PG8_LDB(B0, 0, 0); PG8_LDB(B1, 0, 1); PG8_SCHED; PG8_LDA(At, 0, 0); PG8_STAGE(PG8_SA(1, 1), a1 + hstep, voffA);
            PG8_WAIT_V(8); PG8_WAIT_L(0); PG8_BAR; PG8_MMA(0, 0, At, B0); PG8_MMA(0, 1, At, B1); PG8_BAR; PG8_SCHED;
            PG8_LDA(At, 0, 1); PG8_STAGE(PG8_SB(0, 0), b2, voffB); PG8_STAGE(PG8_SB(0, 1), b2 + hstep, voffB); PG8_STAGE(PG8_SA(0, 0), a2, voffA);
            PG8_WAIT_V(8); PG8_WAIT_L(0); PG8_BAR; PG8_MMA(1, 0, At, B0); PG8_MMA(1, 1, At, B1); PG8_BAR; PG8_SCHED;
            PG8_LDB(B0, 1, 0); PG8_LDB(B1, 1, 1); PG8_SCHED; PG8_LDA(At, 1, 0); PG8_STAGE(PG8_SA(0, 1), a2 + hstep, voffA);
            PG8_WAIT_V(8); PG8_WAIT_L(0); PG8_BAR; PG8_MMA(0, 0, At, B0); PG8_MMA(0, 1, At, B1); PG8_BAR; PG8_SCHED;
            PG8_LDA(At, 1, 1); PG8_STAGE(PG8_SB(1, 0), b3, voffB); PG8_STAGE(PG8_SB(1, 1), b3 + hstep, voffB); PG8_STAGE(PG8_SA(1, 0), a3, voffA);
            PG8_WAIT_V(8); PG8_WAIT_L(0); PG8_BAR; PG8_MMA(1, 0, At, B0); PG8_MMA(1, 1, At, B1); PG8_BAR; PG8_SCHED;
            } else {
            PG8_LDB(B0, 0, 0); PG8_SCHED; PG8_LDA(At, 0, 0); PG8_STAGE(PG8_SA(1, 1), a1 + hstep, voffA);
            PG8_WAIT_L(8); PG8_BAR; PG8_WAIT_L(0); PG8_MMA(0, 0, At, B0); PG8_BAR; PG8_SCHED;
            PG8_LDB(B1, 0, 1); PG8_STAGE(PG8_SB(0, 0), b2, voffB);
            PG8_BAR; PG8_WAIT_L(0); PG8_MMA(0, 1, At, B1); PG8_BAR;
            PG8_LDA(At, 0, 1); PG8_STAGE(PG8_SA(0, 0), a2, voffA);
            PG8_BAR; PG8_WAIT_L(0); PG8_MMA(1, 0, At, B0); PG8_BAR; PG8_SCHED;
            PG8_STAGE(PG8_SB(0, 1), b2 + hstep, voffB);
            PG8_WAIT_V(6); PG8_BAR; PG8_MMA(1, 1, At, B1); PG8_BAR;
            PG8_LDB(B0, 1, 0); PG8_SCHED; PG8_LDA(At, 1, 0); PG8_STAGE(PG8_SA(0, 1), a2 + hstep, voffA);
            PG8_WAIT_L(8); PG8_BAR; PG8_WAIT_L(0); PG8_MMA(0, 0, At, B0); PG8_BAR; PG8_SCHED;
            PG8_LDB(B1, 1, 1); PG8_STAGE(PG8_SB(1, 0), b3, voffB);
            PG8_BAR; PG8_WAIT_L(0); PG8_MMA(0, 1, At, B1); PG8_BAR;
            PG8_LDA(At, 1, 1); PG8_STAGE(PG8_SA(1, 0), a3, voffA);
            PG8_BAR; PG8_WAIT_L(0); PG8_MMA(1, 0, At, B0); PG8_BAR; PG8_SCHED;
            PG8_STAGE(PG8_SB(1, 1), b3 + hstep, voffB);
            PG8_WAIT_V(6); PG8_BAR; PG8_MMA(1, 1, At, B1); PG8_BAR;
            }
        }
        if constexpr (ALIGN_EPI) { if (wr == 0) PG8_BAR; }
        if constexpr (!Epi::AFTER_DRAIN) { E(acc, cur, wr, wc, fr, fq); S.done(cur); }
        if (!has_next) break;
#pragma unroll
        for (int a = 0; a < 2; ++a)
#pragma unroll
            for (int b = 0; b < 2; ++b)
#pragma unroll
                for (int m = 0; m < 4; ++m)
#pragma unroll
                    for (int n = 0; n < 2; ++n) acc[a][b][m][n] = (f32x4){0.f, 0.f, 0.f, 0.f};
        cur = nxt; cA = nA; cB = nB; ++ui;
        if constexpr (ALIGN_EPI) { if (wr == 1) PG8_BAR; }
    }
    PG8_WAIT_V(0);
    if constexpr (!ALIGN_EPI) { if (wr == 0) PG8_BAR; }
    PG8_BAR;
    if constexpr (Epi::AFTER_DRAIN) { E.fused(acc, cur, wr, wc, fr, fq, lds, wid, lane); S.done(cur); }
#undef PG8_SA
#undef PG8_SB
#undef PG8_STAGE
#undef PG8_LDA
#undef PG8_LDB
#undef PG8_MMA
#undef PG8_WAIT_V
#undef PG8_WAIT_L
#undef PG8_BAR
#undef PG8_SCHED
}
}

#ifndef REP_MASK
#define REP_MASK 0
#endif
#define NREP(k) (1 + ((REP_MASK >> (k)) & 1))

constexpr int NB = 16, SEQ = 2048, D = 1024, NMETA = 16;
constexpr int MX = NB * SEQ;
constexpr int INW = 3344, PW = 3584;
constexpr int GQ = 0, GK = 256, GV = 512, GG = 1024, GKL = 1536;
constexpr int RW0 = 1552;
constexpr int RR = RW0, RK = RW0 + 512, RV = RW0 + 1024, RWL = RW0 + 1536, RAL = RW0 + 1600, RGL = RW0 + 1664;
constexpr int NE = 32, TOPK = 4;
constexpr int NCH = 33;
constexpr float ALPHA = 1.189207115002721f;
constexpr int NWAVES = 8, NTHR = 512;

constexpr size_t MiB = 1u << 20;
constexpr size_t WS_CTL = 0, CTL_ZERO_BYTES = 1 * MiB;
constexpr size_t WS_STATS = 1 * MiB;
constexpr size_t WS_TOPI  = WS_STATS + 256 * 1024;
constexpr size_t WS_GATE  = WS_TOPI + 512 * 1024;
constexpr size_t WS_RANK  = WS_GATE + 512 * 1024;
constexpr size_t WS_TSLOT = WS_RANK + 512 * 1024;
constexpr size_t WS_BON   = WS_TSLOT + 512 * 1024;
constexpr size_t WS_PROJM = WS_BON + 1 * MiB;
constexpr size_t WS_OPSM  = WS_PROJM + 256 * 1024;
constexpr size_t WS_DL    = WS_OPSM + 256 * 1024;
constexpr size_t WS_W2T   = WS_DL + 1 * MiB;
constexpr size_t WS_A2T   = WS_W2T + 64 * 1024;
constexpr size_t WS_G2T   = WS_A2T + 64 * 1024;
constexpr size_t WS_TILEE = WS_G2T + 128 * 1024;
constexpr size_t WS_WIN   = 8 * MiB;
constexpr size_t WS_WOUT  = 15 * MiB;
static_assert(WS_TILEE + 4096 <= WS_WIN, "table region");
constexpr size_t WS_A0    = 20 * MiB;
constexpr size_t WS_YMIX  = WS_A0;
constexpr size_t WS_PROJ  = 84 * MiB;
constexpr size_t WS_R1    = 308 * MiB;
constexpr size_t WS_GAM   = 520 * MiB;
constexpr size_t WS_GUS   = 692 * MiB;
constexpr size_t WS_H1    = 20 * MiB;
constexpr size_t WS_XS    = 84 * MiB;
constexpr size_t WS_YS    = WS_XS;
constexpr size_t WS_ACT   = 356 * MiB;
constexpr size_t WS_S1    = 628 * MiB;
constexpr size_t WS_WUP   = 758 * MiB;
constexpr size_t WS_WDN   = 886 * MiB;
constexpr size_t WS_END   = 950 * MiB;
constexpr int CW_BAR = 4096;
constexpr int CW_CNT = 16384;
constexpr int CW_QH = 20480;

constexpr int RING_BYTES = 131072;
constexpr int LDS_BYTES = 147456;
constexpr int TAB_OFF = 132096;
constexpr int MISC_OFF = LDS_BYTES - 512;

#define LAS __attribute__((address_space(3)))
typedef unsigned short bf16;
typedef unsigned v4u __attribute__((ext_vector_type(4)));
typedef unsigned v2u __attribute__((ext_vector_type(2)));
typedef float f32x4 __attribute__((ext_vector_type(4)));
typedef short bf16x8 __attribute__((ext_vector_type(8)));
#define LDS_WAIT() asm volatile("s_waitcnt lgkmcnt(0)" ::: "memory")
__device__ __forceinline__ float bflo(unsigned w) { return __uint_as_float(w << 16); }
__device__ __forceinline__ float bfhi(unsigned w) { return __uint_as_float(w & 0xffff0000u); }
__device__ __forceinline__ unsigned f2bf(float f) { unsigned u = __float_as_uint(f); return (u + 0x7fffu + ((u >> 16) & 1u)) >> 16; }
__device__ __forceinline__ unsigned pk2(float lo, float hi) { return f2bf(lo) | (f2bf(hi) << 16); }
__device__ __forceinline__ float wave_sum(float v) {
#pragma unroll
    for (int o = 1; o < 64; o <<= 1) v += __shfl_xor(v, o);
    return v;
}
__device__ __forceinline__ float softplus_f(float x) { return fmaxf(x, 0.f) + log1pf(expf(-fabsf(x))); }
__device__ __forceinline__ float logsigmoid_f(float x) { return fminf(x, 0.f) - log1pf(expf(-fabsf(x))); }
__device__ __forceinline__ float sigmoid_f(float x) { return 1.f / (1.f + expf(-x)); }
__device__ __forceinline__ float fexp(float x) { return __builtin_amdgcn_exp2f(x * 1.4426950408889634f); }
__device__ __forceinline__ float flog(float x) { return __builtin_amdgcn_logf(x) * 0.6931471805599453f; }
__device__ __forceinline__ float fsigmoid(float x) { return __builtin_amdgcn_rcpf(1.f + fexp(-x)); }
__device__ __forceinline__ float ftanh(float x) { return 2.f * fsigmoid(2.f * x) - 1.f; }
__device__ __forceinline__ float fsoftplus(float x) { return fmaxf(x, 0.f) + flog(1.f + fexp(-fabsf(x))); }
__device__ __forceinline__ float flogsigmoid(float x) { return fminf(x, 0.f) - flog(1.f + fexp(-fabsf(x))); }
template <int CTRL> __device__ __forceinline__ float dppf(float x) { return __int_as_float(__builtin_amdgcn_update_dpp(0, __float_as_int(x), CTRL, 0xF, 0xF, true)); }
__device__ __forceinline__ float red8(float x) {
    x += dppf<0xB1>(x); x += dppf<0x4E>(x); x += dppf<0x141>(x); return x;
}
__device__ __forceinline__ f32x4 mfma16(bf16x8 a, bf16x8 b, f32x4 c) { return __builtin_amdgcn_mfma_f32_16x16x32_bf16(a, b, c, 0, 0, 0); }
__device__ __forceinline__ unsigned ld_agent(const unsigned* p) { return __hip_atomic_load(p, __ATOMIC_RELAXED, __HIP_MEMORY_SCOPE_AGENT); }

#define XB_TMO      128
#define XB_XCNT(j)  (256  + 64 * (j))
#define XB_XSUB(j)  (1280 + 64 * (j))
#define XB_XGEN(j)  (2304 + 64 * (j))
#define XB_TOP      3328
#define XB_TOPGEN   3392
#define XCD_BAR_WORDS 3456
#define XB_SPIN_CAP (1u << 18)
__device__ __forceinline__ unsigned xb_ld(unsigned* p)              { return __hip_atomic_load(p, __ATOMIC_RELAXED, __HIP_MEMORY_SCOPE_AGENT); }
__device__ __forceinline__ unsigned xb_add(unsigned* p, unsigned v) { return __hip_atomic_fetch_add(p, v, __ATOMIC_RELAXED, __HIP_MEMORY_SCOPE_AGENT); }
__device__ __forceinline__ unsigned xb_xcc_id() { return (unsigned)__builtin_amdgcn_s_getreg((3 << 11) | 20) & 0xFu; }
#define XB_SPIN(cond, bar) do { unsigned _sp = 0; while (cond) { __builtin_amdgcn_s_sleep(1); \
    if ((++_sp & 255u) == 0u) { if (xb_ld(&(bar)[XB_TMO])) break; if (_sp > XB_SPIN_CAP) { atomicAdd(&(bar)[XB_TMO], 1u); break; } } } } while (0)
struct XcdBarrier { unsigned* bar; unsigned x; volatile LAS unsigned* st; };
__device__ __forceinline__ XcdBarrier xcd_barrier_post(unsigned* bar, volatile LAS unsigned* st, bool leader) {
    XcdBarrier b; b.bar = bar; b.x = xb_xcc_id(); b.st = st;
    if (leader) (void)xb_add(&bar[XB_XCNT(b.x)], 1u);
    return b;
}
__device__ __forceinline__ void xcd_barrier_complete(unsigned* bar, unsigned x, unsigned& nloc, unsigned& nx) {
    const unsigned G = gridDim.x * gridDim.y * gridDim.z;
    unsigned sum, cnt, mine, sp = 0u;
    for (;;) {
        sum = 0u; cnt = 0u; mine = 0u;
#pragma unroll
        for (unsigned j = 0; j < 16; ++j) { const unsigned c = xb_ld(&bar[XB_XCNT(j)]); sum += c; cnt += (c > 0u) ? 1u : 0u; mine = (j == x) ? c : mine; }
        if (sum == G) break;
        __builtin_amdgcn_s_sleep(1);
        if ((++sp & 255u) == 0u) { if (xb_ld(&bar[XB_TMO])) break; if (sp > XB_SPIN_CAP) { atomicAdd(&bar[XB_TMO], 1u); break; } }
    }
    nloc = mine > 0u ? mine : 1u; nx = cnt > 0u ? cnt : 1u;
}
__device__ __forceinline__ void xcd_barrier(const XcdBarrier& b, bool leader) {
    asm volatile("s_waitcnt vmcnt(0)" ::: "memory");
    __syncthreads();
    if (leader) {
        unsigned* bar = b.bar;
        __builtin_amdgcn_s_waitcnt(0);
        unsigned nloc = b.st[0], nx = b.st[1];
        if (nloc == 0u) { xcd_barrier_complete(bar, b.x, nloc, nx); b.st[0] = nloc; b.st[1] = nx; }
        const unsigned old = xb_add(&bar[XB_XSUB(b.x)], 1u);
        const unsigned gen = old / nloc;
        if (old + 1u == (gen + 1u) * nloc) {
            __builtin_amdgcn_fence(__ATOMIC_RELEASE, "agent");
            asm volatile("s_waitcnt vmcnt(0)" ::: "memory");
            const unsigned og = xb_add(&bar[XB_TOP], 1u);
            const unsigned tg = og / nx;
            if (og + 1u == (tg + 1u) * nx) xb_add(&bar[XB_TOPGEN], 1u);
            else XB_SPIN(xb_ld(&bar[XB_TOPGEN]) == tg, bar);
            __builtin_amdgcn_fence(__ATOMIC_ACQUIRE, "agent");
            xb_add(&bar[XB_XGEN(b.x)], 1u);
            asm volatile("s_waitcnt vmcnt(0)" ::: "memory");
        } else {
            XB_SPIN(xb_ld(&bar[XB_XGEN(b.x)]) == gen, bar);
            __builtin_amdgcn_fence(__ATOMIC_ACQUIRE, "agent");
            asm volatile("s_waitcnt vmcnt(0)" ::: "memory");
        }
    }
    __syncthreads();
}

struct Args { const float* in[30]; float* out; unsigned char* ws; };
enum { I_X = 0, I_META, I_LNIN_G, I_LNIN_B, I_WIN, I_GKW2, I_GKB, I_GNORM, I_MU, I_W0, I_W2, I_A0, I_A2, I_G2, I_KK, I_KA, I_RK, I_RLNG, I_RLNB, I_WOUT,
       I_LN1G, I_LN1B, I_RTW, I_RTB, I_WUP, I_BUP, I_WDN, I_BDN, I_LN2G, I_LN2B };
struct Frame { LAS unsigned char* lds; int tid, lane, wave, blk, G; };
__device__ __forceinline__ int lane_id() { int l = (int)__builtin_amdgcn_mbcnt_hi(~0u, __builtin_amdgcn_mbcnt_lo(~0u, 0u)); asm volatile("" : "+v"(l)); return l; }
__device__ __forceinline__ Frame mkframe(LAS unsigned char* lds, int wave) { Frame F; F.lds = lds; F.wave = wave; F.lane = lane_id(); F.tid = wave * 64 + F.lane; F.blk = blockIdx.x; F.G = gridDim.x; return F; }

__device__ __forceinline__ void transpose_item(const float* W, int K, int N, int nblk, bf16* WT, LAS float* scr, int item, int lane) {
    const int kb = item / nblk, nb = item - kb * nblk, k0 = 64 * kb, n0 = 32 * nb;
    const int nn = n0 + (lane & 31); const bool ok = nn < N;
#pragma unroll 8
    for (int i = 0; i < 32; ++i) { const int kk = 2 * i + (lane >> 5); scr[kk * 33 + (lane & 31)] = ok ? W[(size_t)(k0 + kk) * N + nn] : 0.f; }
    LDS_WAIT();
    const int c = lane & 7;
#pragma unroll
    for (int j = 0; j < 4; ++j) { const int n = (lane >> 3) + 8 * j; const LAS float* s = scr + (8 * c) * 33 + n;
        v4u o; o.x = pk2(s[0 * 33], s[1 * 33]); o.y = pk2(s[2 * 33], s[3 * 33]); o.z = pk2(s[4 * 33], s[5 * 33]); o.w = pk2(s[6 * 33], s[7 * 33]);
        *(v4u*)(WT + (size_t)(n0 + n) * K + k0 + 8 * c) = o; }
    LDS_WAIT();
}

__device__ __forceinline__ void transpose_item64(const float* W, int K, int N, bf16* WT, LAS float* scr, int item, int lane) {
    const int nblk = N >> 6, kb = item / nblk, nb = item - kb * nblk, k0 = 64 * kb, n0 = 64 * nb;
    const int r4 = lane >> 4, c4 = lane & 15;
    f32x4 v[16];
#pragma unroll
    for (int i = 0; i < 16; ++i) v[i] = *(const f32x4*)(W + (size_t)(k0 + 4 * i + r4) * N + n0 + 4 * c4);
#pragma unroll
    for (int i = 0; i < 16; ++i) *(LAS f32x4*)(scr + (4 * i + r4) * 68 + 4 * c4) = v[i];
    LDS_WAIT();
    bf16* orow = WT + (size_t)(n0 + lane) * K + k0;
#pragma unroll
    for (int g = 0; g < 8; ++g) { const LAS float* s = scr + (8 * g) * 68 + lane;
        v4u o; o.x = pk2(s[0 * 68], s[1 * 68]); o.y = pk2(s[2 * 68], s[3 * 68]); o.z = pk2(s[4 * 68], s[5 * 68]); o.w = pk2(s[6 * 68], s[7 * 68]);
        *(v4u*)(orow + 8 * g) = o; }
    LDS_WAIT();
}
__device__ __forceinline__ void convert_expert_weights(const Args& a, const Frame& F) {
    unsigned char* ws = a.ws;
    LAS float* scr = (LAS float*)(F.lds + F.wave * 17408);
    unsigned* QH = (unsigned*)(ws + WS_CTL) + CW_QH;
    constexpr int I_UP = 16 * 32, I_DN = 16 * 16, NIT = NE * (I_UP + I_DN);
    for (;;) {
        unsigned base = 0;
        if (F.lane == 0) base = __hip_atomic_fetch_add(QH, 8u, __ATOMIC_RELAXED, __HIP_MEMORY_SCOPE_AGENT);
        base = (unsigned)__builtin_amdgcn_readfirstlane((int)base);
        if (base >= (unsigned)NIT) break;
        for (int it = (int)base; it < (int)base + 8; ++it) {
            if (it < NE * I_UP) { const int e = it / I_UP, r = it - e * I_UP;
                transpose_item64(a.in[I_WUP] + (size_t)e * D * 2048, D, 2048, (bf16*)(ws + WS_WUP) + (size_t)e * 2048 * D, scr, r, F.lane); }
            else { const int it2 = it - NE * I_UP, e = it2 / I_DN, r = it2 - e * I_DN;
                transpose_item64(a.in[I_WDN] + (size_t)e * D * D, D, D, (bf16*)(ws + WS_WDN) + (size_t)e * D * D, scr, r, F.lane); }
        }
    }
}

__device__ __forceinline__ void phase0(const Args& a, const Frame& F) {
    unsigned char* ws = a.ws;
    const int gw = F.blk * NWAVES + F.wave, NGW = F.G * NWAVES;
    for (int cgp = F.blk; cgp < 53; cgp += F.G) {
        LAS float* HM = (LAS float*)F.lds;
        LAS float* PART = (LAS float*)(F.lds + 65536);
        for (int rr = 0; rr < 2; ++rr) {
            const int row = 2 * F.wave + rr; const f32x4* xr = (const f32x4*)(a.in[I_META] + row * D) + F.lane;
            f32x4 v[4]; float s = 0.f;
#pragma unroll
            for (int j = 0; j < 4; ++j) { v[j] = xr[64 * j]; s += (v[j].x + v[j].y) + (v[j].z + v[j].w); }
            const float mean = wave_sum(s) * (1.f / D); float s2 = 0.f;
#pragma unroll
            for (int j = 0; j < 4; ++j) { v[j] = v[j] - mean; s2 += (v[j].x * v[j].x + v[j].y * v[j].y) + (v[j].z * v[j].z + v[j].w * v[j].w); }
            const float rstd = 1.f / sqrtf(wave_sum(s2) * (1.f / D) + 1e-5f);
#pragma unroll
            for (int j = 0; j < 4; ++j) { const int col = 4 * (F.lane + 64 * j);
                const f32x4 gv = *(const f32x4*)(a.in[I_LNIN_G] + col), bv = *(const f32x4*)(a.in[I_LNIN_B] + col);
                const f32x4 y = v[j] * rstd * gv + bv;
                HM[(col + 0) * 16 + row] = y.x; HM[(col + 1) * 16 + row] = y.y; HM[(col + 2) * 16 + row] = y.z; HM[(col + 3) * 16 + row] = y.w; }
        }
        __syncthreads();
        const int col = cgp * 64 + F.lane; const bool ok = col < INW;
        float acc[16];
#pragma unroll
        for (int r = 0; r < 16; ++r) acc[r] = 0.f;
        const float* wp = a.in[I_WIN];
        for (int k = F.wave * 128; k < F.wave * 128 + 128; ++k) {
            const float wv = ok ? wp[(size_t)k * INW + col] : 0.f;
            const LAS f32x4* h = (const LAS f32x4*)(HM + k * 16);
#pragma unroll
            for (int q = 0; q < 4; ++q) { const f32x4 hv = h[q]; acc[4 * q + 0] += hv.x * wv; acc[4 * q + 1] += hv.y * wv; acc[4 * q + 2] += hv.z * wv; acc[4 * q + 3] += hv.w * wv; }
        }
#pragma unroll
        for (int r = 0; r < 16; ++r) PART[(F.wave * 16 + r) * 64 + F.lane] = acc[r];
        __syncthreads();
        bf16* PROJM = (bf16*)(ws + WS_PROJM);
        for (int o = F.tid; o < 1024; o += NTHR) { const int r = o >> 6, l = o & 63; float s = 0.f;
#pragma unroll
            for (int w = 0; w < 8; ++w) s += PART[(w * 16 + r) * 64 + l];
            PROJM[r * PW + cgp * 64 + l] = (bf16)f2bf(s); }
        if (F.tid < 64) PROJM[NMETA * PW + cgp * 64 + F.tid] = 0;
        __syncthreads();
    }
    {
        LAS float* scr = (LAS float*)(F.lds + F.wave * 16384);
        constexpr int I_IN = 16 * (PW / 32), I_OUT = 16 * 32;
        for (int it = gw; it < I_IN + I_OUT; it += NGW) {
            if (it < I_IN) transpose_item(a.in[I_WIN], D, INW, PW / 32, (bf16*)(ws + WS_WIN), scr, it, F.lane);
            else transpose_item(a.in[I_WOUT], D, D, 32, (bf16*)(ws + WS_WOUT), scr, it - I_IN, F.lane);
        }
    }
    {
        bf16* W2T = (bf16*)(ws + WS_W2T); bf16* A2T = (bf16*)(ws + WS_A2T); bf16* G2T = (bf16*)(ws + WS_G2T);
        for (int i = F.blk * NTHR + F.tid; i < 131072; i += F.G * NTHR) {
            if (i < 32768) { const int n = i >> 6, k = i & 63; W2T[i] = (bf16)f2bf(a.in[I_W2][k * 512 + n]); }
            else if (i < 65536) { const int j = i - 32768, n = j >> 6, k = j & 63; A2T[j] = (bf16)f2bf(a.in[I_A2][k * 512 + n]); }
            else { const int j = i - 65536, n = j >> 7, k = j & 127; G2T[j] = (bf16)f2bf(a.in[I_G2][k * 512 + n]); }
        }
    }
    {
        bf16* A0 = (bf16*)(ws + WS_A0); float* ST = (float*)(ws + WS_STATS);
        for (int m = gw; m < MX; m += NGW) {
            const f32x4* xr = (const f32x4*)(a.in[I_X] + (size_t)m * D) + F.lane;
            f32x4 v[4]; float s = 0.f;
#pragma unroll
            for (int j = 0; j < 4; ++j) { v[j] = xr[64 * j]; s += (v[j].x + v[j].y) + (v[j].z + v[j].w); }
            const float mean = wave_sum(s) * (1.f / D); float s2 = 0.f;
#pragma unroll
            for (int j = 0; j < 4; ++j) { v[j] = v[j] - mean; s2 += (v[j].x * v[j].x + v[j].y * v[j].y) + (v[j].z * v[j].z + v[j].w * v[j].w); }
            const float rstd = 1.f / sqrtf(wave_sum(s2) * (1.f / D) + 1e-5f);
#pragma unroll
            for (int j = 0; j < 4; ++j) { const int col = 4 * (F.lane + 64 * j);
                const f32x4 gv = *(const f32x4*)(a.in[I_LNIN_G] + col), bv = *(const f32x4*)(a.in[I_LNIN_B] + col);
                const f32x4 y = v[j] * rstd * gv + bv;
                v2u o; o.x = pk2(y.x, y.y); o.y = pk2(y.z, y.w);
                *(v2u*)(A0 + (size_t)m * D + col) = o; }
            if (F.lane == 0) { ST[2 * m] = mean; ST[2 * m + 1] = rstd; }
        }
    }
}

__device__ __forceinline__ const bf16* prow(const bf16* PROJ, const bf16* PROJM, int b, int vp) {
    const bf16* px = PROJ + (size_t)(b * SEQ + (vp >= NMETA ? vp - NMETA : 0)) * PW;
    const bf16* pm = PROJM + (size_t)(vp < 0 ? NMETA : (vp < NMETA ? vp : 0)) * PW;
    return vp >= NMETA ? px : pm;
}
__device__ __forceinline__ f32x4 ldp4(const bf16* PROJ, const bf16* PROJM, int b, int vp, int col) {
    const v2u w = *(const v2u*)(prow(PROJ, PROJM, b, vp) + col);
    return (f32x4){bflo(w.x), bfhi(w.x), bflo(w.y), bfhi(w.y)};
}

constexpr int R1_STRIDE = 49152;
constexpr int TP = 80;
constexpr int L1_SLOT = 64 * TP * 2;
constexpr int L1_LC = 12 * L1_SLOT;
constexpr int L1_XCH = L1_LC + 64 * 65 * 4;
constexpr int L1_LR = 8 * L1_SLOT;
__device__ __forceinline__ v2u pack4(f32x4 v) { v2u o; o.x = pk2(v[0], v[1]); o.y = pk2(v[2], v[3]); return o; }
__device__ __forceinline__ f32x4 tile_mm(const LAS bf16* A, const LAS bf16* Bt, int rt, int ct, int fr, int fq, f32x4 acc) {
#pragma unroll
    for (int ks = 0; ks < 2; ++ks)
        acc = mfma16(*(const LAS bf16x8*)(Bt + (ct * 16 + fr) * TP + ks * 32 + 8 * fq), *(const LAS bf16x8*)(A + (rt * 16 + fr) * TP + ks * 32 + 8 * fq), acc);
    return acc;
}
__device__ __forceinline__ void tile_st(LAS bf16* O, int rt, int ct, int fr, int fq, f32x4 v) { *(LAS v2u*)(O + (rt * 16 + fr) * TP + ct * 16 + 4 * fq) = pack4(v); }
#define L1S(n) ((LAS bf16*)(F.lds + (n) * L1_SLOT))

__device__ __forceinline__ void rwkv_l1_unit(const Args& a, const Frame& F, int b, int h, int c) {
    unsigned char* ws = a.ws;
    const bf16* PROJ = (const bf16*)(ws + WS_PROJ); const bf16* PROJM = (const bf16*)(ws + WS_PROJM);
    const bf16* W2T = (const bf16*)(ws + WS_W2T); const bf16* A2T = (const bf16*)(ws + WS_A2T); const bf16* G2T = (const bf16*)(ws + WS_G2T);
    const int unit = (b * 8 + h) * NCH + c;
    unsigned char* r1 = ws + WS_R1 + (size_t)unit * R1_STRIDE;
    float* GAM = (float*)(ws + WS_GAM) + (size_t)unit * 64;
    const float* mu = a.in[I_MU];
    const int vp0 = (c == 0) ? -48 : NMETA + 64 * (c - 1);
    constexpr int LRP = 264;
    LAS bf16* LR = (LAS bf16*)(F.lds + L1_LR);
    LAS float* LC = (LAS float*)(F.lds + L1_LC);
    LAS float* XCH = (LAS float*)(F.lds + L1_XCH);
    {
        const int cg = F.tid & 31, tr = F.tid >> 5;
        const int col = RWL + 8 * cg;
        const f32x4 m0 = *(const f32x4*)(mu + 1536 + 8 * cg), m1 = *(const f32x4*)(mu + 1536 + 8 * cg + 4);
#pragma unroll
        for (int i = 0; i < 4; ++i) {
            const int row = 4 * tr + i, vp = vp0 + row;
            const f32x4 c0 = ldp4(PROJ, PROJM, b, vp, col), c1 = ldp4(PROJ, PROJM, b, vp, col + 4);
            const f32x4 p0 = ldp4(PROJ, PROJM, b, vp - 1, col), p1 = ldp4(PROJ, PROJM, b, vp - 1, col + 4);
            float v[8];
            v[0] = c0.x + (p0.x - c0.x) * m0.x; v[1] = c0.y + (p0.y - c0.y) * m0.y; v[2] = c0.z + (p0.z - c0.z) * m0.z; v[3] = c0.w + (p0.w - c0.w) * m0.w;
            v[4] = c1.x + (p1.x - c1.x) * m1.x; v[5] = c1.y + (p1.y - c1.y) * m1.y; v[6] = c1.z + (p1.z - c1.z) * m1.z; v[7] = c1.w + (p1.w - c1.w) * m1.w;
#pragma unroll
            for (int q = 0; q < 8; ++q) { if (cg < 8) v[q] = ftanh(v[q]); else if (cg >= 16) v[q] = fsigmoid(v[q]); }
            v4u o; o.x = pk2(v[0], v[1]); o.y = pk2(v[2], v[3]); o.z = pk2(v[4], v[5]); o.w = pk2(v[6], v[7]);
            *(LAS v4u*)(LR + row * LRP + 8 * cg) = o;
        }
    }
    __syncthreads();
    const int rt = F.wave & 3, cp = F.wave >> 2, fr = F.lane & 15, fq = F.lane >> 4;
    const int t = rt * 16 + fr, vp = vp0 + t;
    const bool valid = vp >= 0;
    float lwv[2][4], asg[2][4], kkr[2][4], kmd[2][4], rrv[2][4], vvv[2][4];
    float ssq = 0.f, bon = 0.f;
    {
        const LAS bf16* lrow = LR + t * LRP + 8 * fq;
#pragma unroll
        for (int cc = 0; cc < 2; ++cc) {
            const int ct = 2 * cp + cc, j = ct * 16 + 4 * fq, jc = h * 64 + j, n = h * 64 + ct * 16 + fr;
            f32x4 aw = {0.f, 0.f, 0.f, 0.f}, aa = aw, ag = aw;
#pragma unroll
            for (int ks = 0; ks < 2; ++ks) {
                aw = mfma16(*(const bf16x8*)(W2T + (size_t)n * 64 + ks * 32 + 8 * fq), *(const LAS bf16x8*)(lrow + ks * 32), aw);
                aa = mfma16(*(const bf16x8*)(A2T + (size_t)n * 64 + ks * 32 + 8 * fq), *(const LAS bf16x8*)(lrow + 64 + ks * 32), aa);
            }
#pragma unroll
            for (int ks = 0; ks < 4; ++ks)
                ag = mfma16(*(const bf16x8*)(G2T + (size_t)n * 128 + ks * 32 + 8 * fq), *(const LAS bf16x8*)(lrow + 128 + ks * 32), ag);
            const f32x4 rc = ldp4(PROJ, PROJM, b, vp, RR + jc), rp = ldp4(PROJ, PROJM, b, vp - 1, RR + jc), mr = *(const f32x4*)(mu + jc);
            const f32x4 kc = ldp4(PROJ, PROJM, b, vp, RK + jc), kp = ldp4(PROJ, PROJM, b, vp - 1, RK + jc), mk = *(const f32x4*)(mu + 512 + jc);
            const f32x4 vc = ldp4(PROJ, PROJM, b, vp, RV + jc), vpv = ldp4(PROJ, PROJM, b, vp - 1, RV + jc), mv = *(const f32x4*)(mu + 1024 + jc);
            const f32x4 rs = rc + (rp - rc) * mr, ks_ = kc + (kp - kc) * mk, vs = vc + (vpv - vc) * mv;
            const f32x4 w0v = *(const f32x4*)(a.in[I_W0] + jc), a0v = *(const f32x4*)(a.in[I_A0] + jc);
            const f32x4 kkw = *(const f32x4*)(a.in[I_KK] + jc), kaw = *(const f32x4*)(a.in[I_KA] + jc), rkw = *(const f32x4*)(a.in[I_RK] + jc);
#pragma unroll
            for (int i = 0; i < 4; ++i) {
                const float u = w0v[i] + aw[i];
                const float wl = -fsoftplus(-u) - 0.5f;
                lwv[cc][i] = valid ? -fexp(wl) : 0.f;
                const float as_ = fsigmoid(a0v[i] + aa[i]);
                asg[cc][i] = as_;
                const float kraw = ks_[i], kk = kraw * kkw[i];
                kkr[cc][i] = kk; ssq += kk * kk;
                const float km = kraw * (1.f + (as_ - 1.f) * kaw[i]);
                kmd[cc][i] = km; rrv[cc][i] = rs[i]; vvv[cc][i] = vs[i];
                bon += rs[i] * km * rkw[i];
                LC[t * 65 + j + i] = lwv[cc][i];
            }
            *(v2u*)(r1 + 4 * 8192 + (size_t)(t * 64 + j) * 2) = pack4(ag);
        }
        ssq += __shfl_xor(ssq, 16); ssq += __shfl_xor(ssq, 32);
        bon += __shfl_xor(bon, 16); bon += __shfl_xor(bon, 32);
        if (fq == 0) { XCH[(cp * 64 + t) * 2] = ssq; XCH[(cp * 64 + t) * 2 + 1] = bon; }
    }
    __syncthreads();
    const float ssq_t = XCH[t * 2] + XCH[(64 + t) * 2], bon_t = XCH[t * 2 + 1] + XCH[(64 + t) * 2 + 1];
    const float inv = 1.f / fmaxf(sqrtf(ssq_t), 1e-12f);
    {
        LAS float* SEG = XCH + 256;
        const int jj = F.tid & 63, sg = F.tid >> 6;
        float cv[8];
#pragma unroll
        for (int i = 0; i < 8; ++i) cv[i] = LC[(sg * 8 + i) * 65 + jj];
#pragma unroll
        for (int i = 1; i < 8; ++i) cv[i] += cv[i - 1];
        SEG[sg * 64 + jj] = cv[7];
        __syncthreads();
        float pre = 0.f;
#pragma unroll
        for (int s2 = 0; s2 < 7; ++s2) pre += (s2 < sg) ? SEG[s2 * 64 + jj] : 0.f;
#pragma unroll
        for (int i = 0; i < 8; ++i) LC[(sg * 8 + i) * 65 + jj] = cv[i] + pre;
    }
    __syncthreads();
    f32x4 rtil[2];
    {
#pragma unroll
        for (int cc = 0; cc < 2; ++cc) {
            const int j = (2 * cp + cc) * 16 + 4 * fq;
            f32x4 At, Bt, Kt, Bh, Kh, bvv;
#pragma unroll
            for (int i = 0; i < 4; ++i) {
                const float Lc = LC[t * 65 + j + i], LcC = LC[63 * 65 + j + i];
                const float kn = kkr[cc][i] * inv, av = -kn, bv = kn * asg[cc][i], km = kmd[cc][i];
                const float eA = fexp(Lc - lwv[cc][i]), eR = fexp(Lc), eB = fexp(-Lc), eH = fexp(LcC - Lc);
                At[i] = av * eA; rtil[cc][i] = rrv[cc][i] * eR; Bt[i] = bv * eB; Kt[i] = km * eB; Bh[i] = bv * eH; Kh[i] = km * eH;
                bvv[i] = bon_t * vvv[cc][i];
                if (t == 63) GAM[j + i] = fexp(LcC);
            }
            *(LAS v2u*)(L1S(0) + t * TP + j) = pack4(Bt); *(LAS v2u*)(L1S(1) + t * TP + j) = pack4(Kt);
            *(LAS v2u*)(L1S(2) + t * TP + j) = pack4(At); *(LAS v2u*)(L1S(3) + t * TP + j) = pack4(rtil[cc]);
#pragma unroll
            for (int i = 0; i < 4; ++i) {
                L1S(4)[(j + i) * TP + t] = (bf16)f2bf(At[i]); L1S(5)[(j + i) * TP + t] = (bf16)f2bf(Bh[i]);
                L1S(6)[(j + i) * TP + t] = (bf16)f2bf(Kh[i]); L1S(7)[(j + i) * TP + t] = (bf16)f2bf(vvv[cc][i]);
            }
            *(v2u*)(r1 + 5 * 8192 + (size_t)(t * 64 + j) * 2) = pack4(bvv);
        }
    }
    __syncthreads();
    f32x4 Pt[2];
    const int mrow = rt * 16 + fr;
#pragma unroll
    for (int cc = 0; cc < 2; ++cc) {
        const int ct = 2 * cp + cc, n0 = ct * 16 + 4 * fq;
        const f32x4 z = {0.f, 0.f, 0.f, 0.f};
        f32x4 Lv = tile_mm(L1S(2), L1S(0), rt, ct, fr, fq, z), Nv = tile_mm(L1S(0), L1S(2), rt, ct, fr, fq, z), Mv = tile_mm(L1S(1), L1S(2), rt, ct, fr, fq, z);
        f32x4 Bv = tile_mm(L1S(3), L1S(0), rt, ct, fr, fq, z), Kv = tile_mm(L1S(3), L1S(1), rt, ct, fr, fq, z);
#pragma unroll
        for (int i = 0; i < 4; ++i) { const int n = n0 + i;
            if (!(n < mrow)) Lv[i] = 0.f; if (!(mrow < n)) { Nv[i] = 0.f; Mv[i] = 0.f; } if (!(n <= mrow)) { Bv[i] = 0.f; Kv[i] = 0.f; }
            Pt[cc][i] = Lv[i] + ((n == mrow) ? 1.f : 0.f); }
        tile_st(L1S(8), rt, ct, fr, fq, Lv); tile_st(L1S(9), rt, ct, fr, fq, Nv); tile_st(L1S(10), rt, ct, fr, fq, Mv);
        tile_st(L1S(11), rt, ct, fr, fq, Bv); tile_st(L1S(12), rt, ct, fr, fq, Kv);
    }
    __syncthreads();
#pragma unroll
    for (int st = 1; st <= 5; ++st) {
        LAS bf16* Xl = (st & 1) ? L1S(8) : L1S(0); LAS bf16* Xn = (st & 1) ? L1S(9) : L1S(1);
        LAS bf16* Yl = (st & 1) ? L1S(0) : L1S(8); LAS bf16* Yn = (st & 1) ? L1S(1) : L1S(9);
        const f32x4 z = {0.f, 0.f, 0.f, 0.f};
#pragma unroll
        for (int cc = 0; cc < 2; ++cc) { const int ct = 2 * cp + cc;
            tile_st(Yl, rt, ct, fr, fq, tile_mm(Xl, Xn, rt, ct, fr, fq, z)); tile_st(Yn, rt, ct, fr, fq, tile_mm(Xn, Xl, rt, ct, fr, fq, z));
            tile_st(L1S(2), rt, ct, fr, fq, Pt[cc]); }
        __syncthreads();
#pragma unroll
        for (int cc = 0; cc < 2; ++cc) Pt[cc] = tile_mm(L1S(2), Yn, rt, 2 * cp + cc, fr, fq, Pt[cc]);
        __syncthreads();
    }
#pragma unroll
    for (int cc = 0; cc < 2; ++cc) tile_st(L1S(2), rt, 2 * cp + cc, fr, fq, Pt[cc]);
    __syncthreads();
    {
        const f32x4 z = {0.f, 0.f, 0.f, 0.f};
#pragma unroll
        for (int cc = 0; cc < 2; ++cc) { const int ct = 2 * cp + cc;
            tile_st(L1S(8), rt, ct, fr, fq, tile_mm(L1S(2), L1S(10), rt, ct, fr, fq, z)); tile_st(L1S(9), rt, ct, fr, fq, tile_mm(L1S(4), L1S(2), rt, ct, fr, fq, z)); }
    }
    __syncthreads();
    {
        const f32x4 z = {0.f, 0.f, 0.f, 0.f};
#pragma unroll
        for (int cc = 0; cc < 2; ++cc) { const int ct = 2 * cp + cc; tile_st(L1S(0), rt, ct, fr, fq, tile_mm(L1S(7), L1S(8), rt, ct, fr, fq, z)); }
    }
    __syncthreads();
    {
        const f32x4 z = {0.f, 0.f, 0.f, 0.f};
#pragma unroll
        for (int cc = 0; cc < 2; ++cc) { const int ct = 2 * cp + cc; const size_t eo = (size_t)(mrow * 64 + ct * 16 + 4 * fq) * 2;
            const f32x4 gp = tile_mm(L1S(5), L1S(9), rt, ct, fr, fq, z);
            const f32x4 hh = tile_mm(L1S(7), L1S(6), rt, ct, fr, fq, tile_mm(L1S(0), L1S(5), rt, ct, fr, fq, z));
            const f32x4 rh = tile_mm(L1S(11), L1S(9), rt, ct, fr, fq, rtil[cc]);
            const f32x4 yl = tile_mm(L1S(12), L1S(7), rt, ct, fr, fq, tile_mm(L1S(11), L1S(0), rt, ct, fr, fq, z));
            *(v2u*)(r1 + 0 * 8192 + eo) = pack4(gp); *(v2u*)(r1 + 1 * 8192 + eo) = pack4(hh);
            *(v2u*)(r1 + 2 * 8192 + eo) = pack4(rh); *(v2u*)(r1 + 3 * 8192 + eo) = pack4(yl); }
    }
    __syncthreads();
}

constexpr int BCP = 65;
__device__ __forceinline__ void gla_bc(const Args& a, const Frame& F, int b, int h, int vp0, int ntok) {
    const bf16* PROJ = (const bf16*)(a.ws + WS_PROJ); const bf16* PROJM = (const bf16*)(a.ws + WS_PROJM);
    LAS float* GKLs = (LAS float*)F.lds; LAS float* BC = (LAS float*)(F.lds + 4096);
    if (F.tid < 256) { const int t = F.tid >> 2, q = F.tid & 3;
        const f32x4 v = ldp4(PROJ, PROJM, b, (t < ntok) ? vp0 + t : -1, GKL + 4 * q);
        *(LAS f32x4*)(GKLs + t * 16 + 4 * q) = v; }
    __syncthreads();
    {
        const int d = F.tid & 63, tg = F.tid >> 6;
        float wc[16];
#pragma unroll
        for (int r = 0; r < 16; ++r) wc[r] = a.in[I_GKW2][r * 256 + h * 64 + d];
        const float gb = a.in[I_GKB][h * 64 + d];
#pragma unroll
        for (int i = 0; i < 8; ++i) { const int t = tg * 8 + i; float z = gb;
            const LAS f32x4* g4 = (const LAS f32x4*)(GKLs + t * 16);
#pragma unroll
            for (int q = 0; q < 4; ++q) { const f32x4 gv = g4[q]; z += gv.x * wc[4 * q] + gv.y * wc[4 * q + 1] + gv.z * wc[4 * q + 2] + gv.w * wc[4 * q + 3]; }
            BC[t * BCP + d] = (t < ntok) ? flogsigmoid(z) * (1.f / 16.f) : 0.f; }
    }
    __syncthreads();
    if (F.tid < 64) { float run = 0.f;
#pragma unroll 8
        for (int t = 0; t < 64; ++t) { run += BC[t * BCP + F.tid]; BC[t * BCP + F.tid] = run; } }
    __syncthreads();
}

__device__ __forceinline__ void gla_g1_unit(const Args& a, const Frame& F, int b, int h, int c) {
    const bf16* PROJ = (const bf16*)(a.ws + WS_PROJ); const bf16* PROJM = (const bf16*)(a.ws + WS_PROJM);
    float* GUS = (float*)(a.ws + WS_GUS); float* DL = (float*)(a.ws + WS_DL);
    const int ntok = (c == 0) ? NMETA : 64, vp0 = (c == 0) ? 0 : NMETA + 64 * (c - 1);
    gla_bc(a, F, b, h, vp0, ntok);
    LAS float* BC = (LAS float*)(F.lds + 4096);
    LAS bf16* KT = (LAS bf16*)(F.lds + 24576);
    LAS bf16* VT = (LAS bf16*)(F.lds + 24576 + 64 * TP * 2);
    {
        const int t = F.tid >> 3, q = F.tid & 7;
        const float* bl = nullptr; (void)bl;
#pragma unroll
        for (int half = 0; half < 2; ++half) {
            const int d0 = 8 * q + 4 * half;
            const f32x4 kv = ldp4(PROJ, PROJM, b, (t < ntok) ? vp0 + t : -1, GK + h * 64 + d0);
#pragma unroll
            for (int i = 0; i < 4; ++i) { const int d = d0 + i; const float e = (t < ntok) ? fexp(BC[(ntok - 1) * BCP + d] - BC[t * BCP + d]) : 0.f;
                KT[d * TP + t] = (bf16)f2bf(kv[i] * e); }
        }
#pragma unroll
        for (int qq = 0; qq < 4; ++qq) {
            const int e0 = 16 * q + 4 * qq;
            const f32x4 vv = ldp4(PROJ, PROJM, b, (t < ntok) ? vp0 + t : -1, GV + h * 128 + e0);
#pragma unroll
            for (int i = 0; i < 4; ++i) VT[(e0 + i) * TP + t] = (bf16)f2bf(vv[i]);
        }
    }
    __syncthreads();
    {
        const int rt = F.wave & 3, ch = F.wave >> 2, fr = F.lane & 15, fq = F.lane >> 4;
        float* up = GUS + ((size_t)((b * 4 + h) * NCH + c) * 64 + rt * 16 + fr) * 128;
#pragma unroll
        for (int cc = 0; cc < 4; ++cc) { const int ct = ch * 4 + cc;
            f32x4 acc = {0.f, 0.f, 0.f, 0.f};
#pragma unroll
            for (int ks = 0; ks < 2; ++ks)
                acc = mfma16(*(const LAS bf16x8*)(VT + (ct * 16 + fr) * TP + ks * 32 + 8 * fq), *(const LAS bf16x8*)(KT + (rt * 16 + fr) * TP + ks * 32 + 8 * fq), acc);
            *(f32x4*)(up + ct * 16 + 4 * fq) = acc; }
        if (F.tid < 64) DL[(size_t)((b * 4 + h) * NCH + c) * 64 + F.tid] = fexp(BC[(ntok - 1) * BCP + F.tid]);
    }
    __syncthreads();
}

__device__ __forceinline__ void phase2(const Args& a, const Frame& F) {
    for (int u = F.blk; u < NB * 8 * NCH; u += F.G) { const int c = u % NCH, bh = u / NCH; rwkv_l1_unit(a, F, bh >> 3, bh & 7, c); }
    for (int u = F.blk; u < NB * 4 * 32; u += F.G) { const int c = u & 31, bh = u >> 5; gla_g1_unit(a, F, bh >> 2, bh & 3, c); }
}

__device__ __forceinline__ void rwkv_l2_unit(const Args& a, const Frame& F, int bh) {
    unsigned char* ws = a.ws;
    const int b = bh >> 3, h = bh & 7;
    LAS bf16* Sb0 = (LAS bf16*)F.lds; LAS bf16* Sb1 = Sb0 + 64 * TP;
    const int fr = F.lane & 15, fq = F.lane >> 4;
    const int rt = F.wave & 3;
    const int row = rt * 16 + fr;
    const unsigned char* r1b = ws + WS_R1 + (size_t)bh * NCH * R1_STRIDE + (size_t)(row * 64 + 4 * fq) * 2;
    if (F.wave < 4) {
        bf16* yout = (bf16*)(ws + WS_YMIX) + ((size_t)b * SEQ + row) * D + 512 + h * 64 + 4 * fq;
        f32x4 lg[4], lb[4];
#pragma unroll
        for (int ct = 0; ct < 4; ++ct) { lg[ct] = *(const f32x4*)(a.in[I_RLNG] + h * 64 + ct * 16 + 4 * fq); lb[ct] = *(const f32x4*)(a.in[I_RLNB] + h * 64 + ct * 16 + 4 * fq); }
        bf16x8 fa0, fa1; v2u q0[4], q1[4], q2[4];
#define Y_FETCH(cn) do { const unsigned char* r1 = r1b + (size_t)(cn) * R1_STRIDE; \
            fa0 = *(const bf16x8*)(r1 + 2 * 8192 + 8 * fq); fa1 = *(const bf16x8*)(r1 + 2 * 8192 + 64 + 8 * fq); \
            _Pragma("unroll") for (int ct = 0; ct < 4; ++ct) { q0[ct] = *(const v2u*)(r1 + 3 * 8192 + ct * 32); q1[ct] = *(const v2u*)(r1 + 4 * 8192 + ct * 32); q2[ct] = *(const v2u*)(r1 + 5 * 8192 + ct * 32); } } while (0)
        Y_FETCH(1);
        __syncthreads();
        __syncthreads();
#pragma nounroll
        for (int c = 1; c < NCH; ++c) {
            const LAS bf16* Sc = (c & 1) ? Sb1 : Sb0;
            const bf16x8 af0 = fa0, af1 = fa1; v2u yl[4], gw[4], bw[4];
#pragma unroll
            for (int ct = 0; ct < 4; ++ct) { yl[ct] = q0[ct]; gw[ct] = q1[ct]; bw[ct] = q2[ct]; }
            if (c + 1 < NCH) Y_FETCH(c + 1);
            f32x4 y[4]; float s = 0.f;
#pragma unroll
            for (int ct = 0; ct < 4; ++ct) {
                f32x4 acc = {bflo(yl[ct].x), bfhi(yl[ct].x), bflo(yl[ct].y), bfhi(yl[ct].y)};
                acc = mfma16(*(const LAS bf16x8*)(Sc + (ct * 16 + fr) * TP + 8 * fq), af0, acc);
                acc = mfma16(*(const LAS bf16x8*)(Sc + (ct * 16 + fr) * TP + 32 + 8 * fq), af1, acc);
                y[ct] = acc; s += (acc[0] + acc[1]) + (acc[2] + acc[3]);
            }
            s += __shfl_xor(s, 16); s += __shfl_xor(s, 32);
            const float mean = s * (1.f / 64.f); float q = 0.f;
#pragma unroll
            for (int ct = 0; ct < 4; ++ct) { y[ct] = y[ct] - mean; q += (y[ct][0] * y[ct][0] + y[ct][1] * y[ct][1]) + (y[ct][2] * y[ct][2] + y[ct][3] * y[ct][3]); }
            q += __shfl_xor(q, 16); q += __shfl_xor(q, 32);
            const float rstd = 1.f / sqrtf(q * (1.f / 64.f) + 64e-5f);
#pragma unroll
            for (int ct = 0; ct < 4; ++ct) {
                const f32x4 g = {bflo(gw[ct].x), bfhi(gw[ct].x), bflo(gw[ct].y), bfhi(gw[ct].y)}, bv = {bflo(bw[ct].x), bfhi(bw[ct].x), bflo(bw[ct].y), bfhi(bw[ct].y)};
                const f32x4 o = (y[ct] * rstd * lg[ct] + lb[ct] + bv) * g;
                *(v2u*)(yout + ct * 16) = pack4(o); }
            yout += (size_t)64 * D;
            __syncthreads();
        }
#undef Y_FETCH
    } else {
        f32x4 Sm[4];
#pragma unroll
        for (int ct = 0; ct < 4; ++ct) { Sm[ct] = (f32x4){0.f, 0.f, 0.f, 0.f}; *(LAS v2u*)(Sb0 + row * TP + ct * 16 + 4 * fq) = (v2u){0u, 0u}; }
        const float* gamb = (const float*)(ws + WS_GAM) + (size_t)bh * NCH * 64 + 4 * fq;
        const unsigned char* gpb = ws + WS_R1 + (size_t)bh * NCH * R1_STRIDE + (size_t)(fr * 64 + 8 * fq) * 2;
        bf16x8 fg[8]; v2u hq[4]; f32x4 gm[4];
#define S_FETCH(cn) do { const unsigned char* r1 = r1b + (size_t)(cn) * R1_STRIDE; const unsigned char* gp = gpb + (size_t)(cn) * R1_STRIDE; \
            _Pragma("unroll") for (int ct = 0; ct < 4; ++ct) { fg[2 * ct] = *(const bf16x8*)(gp + ct * 2048); fg[2 * ct + 1] = *(const bf16x8*)(gp + ct * 2048 + 64); \
                hq[ct] = *(const v2u*)(r1 + 8192 + ct * 32); gm[ct] = *(const f32x4*)(gamb + (size_t)(cn) * 64 + ct * 16); } } while (0)
        S_FETCH(0);
        __syncthreads();
#pragma nounroll
        for (int c = 0; c < NCH - 1; ++c) {
            const LAS bf16* Sc = (c & 1) ? Sb1 : Sb0; LAS bf16* Sn = (c & 1) ? Sb0 : Sb1;
            bf16x8 g8[8]; v2u hw[4]; f32x4 gmc[4];
#pragma unroll
            for (int ct = 0; ct < 4; ++ct) { g8[2 * ct] = fg[2 * ct]; g8[2 * ct + 1] = fg[2 * ct + 1]; hw[ct] = hq[ct]; gmc[ct] = gm[ct]; }
            if (c + 2 < NCH) S_FETCH(c + 1);
            const bf16x8 af0 = *(const LAS bf16x8*)(Sc + row * TP + 8 * fq), af1 = *(const LAS bf16x8*)(Sc + row * TP + 32 + 8 * fq);
#pragma unroll
            for (int ct = 0; ct < 4; ++ct) {
                f32x4 acc = {bflo(hw[ct].x), bfhi(hw[ct].x), bflo(hw[ct].y), bfhi(hw[ct].y)};
                acc = mfma16(g8[2 * ct], af0, acc);
                acc = mfma16(g8[2 * ct + 1], af1, acc);
                Sm[ct] = Sm[ct] * gmc[ct] + acc;
                *(LAS v2u*)(Sn + row * TP + ct * 16 + 4 * fq) = pack4(Sm[ct]); }
            __syncthreads();
        }
        __syncthreads();
#undef S_FETCH
    }
}
__device__ __forceinline__ void gla_scan_unit(const Args& a, const Frame& F, int j) {
    float* GUS = (float*)(a.ws + WS_GUS); const float* DL = (const float*)(a.ws + WS_DL);
    const int bh = j >> 1, half = j & 1;
    const int d = 32 * half + (F.tid >> 4), e0 = (F.tid & 15) * 8;
    float* base = GUS + (size_t)bh * NCH * 8192 + d * 128 + e0;
    const float* dl = DL + (size_t)bh * NCH * 64 + d;
    f32x4 s0 = {0.f, 0.f, 0.f, 0.f}, s1 = s0;
    f32x4 u0 = *(const f32x4*)(base), u1 = *(const f32x4*)(base + 4); float dc = dl[0];
    for (int c = 0; c < NCH - 1; ++c) {
        f32x4 n0 = u0, n1 = u1; float dn = dc;
        if (c + 1 < NCH - 1) { n0 = *(const f32x4*)(base + (size_t)(c + 1) * 8192); n1 = *(const f32x4*)(base + (size_t)(c + 1) * 8192 + 4); dn = dl[(c + 1) * 64]; }
        *(f32x4*)(base + (size_t)c * 8192) = s0; *(f32x4*)(base + (size_t)c * 8192 + 4) = s1;
        s0 = s0 * dc + u0; s1 = s1 * dc + u1;
        u0 = n0; u1 = n1; dc = dn;
    }
    *(f32x4*)(base + (size_t)(NCH - 1) * 8192) = s0; *(f32x4*)(base + (size_t)(NCH - 1) * 8192 + 4) = s1;
}
__device__ __forceinline__ void phase3(const Args& a, const Frame& F) {
    for (int u = F.blk; u < 256; u += F.G) { if (u < 128) { for (int rep_ = 0; rep_ < NREP(3); ++rep_) rwkv_l2_unit(a, F, u); } else gla_scan_unit(a, F, u - 128); }
    __syncthreads();
    convert_expert_weights(a, F);
}

__device__ __forceinline__ void gla_g3_unit(const Args& a, const Frame& F, int b, int h, int c) {
    const bf16* PROJ = (const bf16*)(a.ws + WS_PROJ); const bf16* PROJM = (const bf16*)(a.ws + WS_PROJM);
    const float* GUS = (const float*)(a.ws + WS_GUS); bf16* YMIX = (bf16*)(a.ws + WS_YMIX);
    const int vp0 = NMETA + 64 * (c - 1);
    gla_bc(a, F, b, h, vp0, 64);
    LAS float* BC = (LAS float*)(F.lds + 4096);
    LAS bf16* QT = (LAS bf16*)(F.lds + 24576);
    LAS bf16* KL = QT + 64 * TP;
    LAS bf16* AT = KL + 64 * TP;
    LAS bf16* VT = AT + 64 * TP;
    LAS bf16* ST = VT + 128 * TP;
    LAS float* RS = (LAS float*)(ST + 128 * TP);
    {
        const int t = F.tid >> 3, q = F.tid & 7;
        const f32x4 q0 = ldp4(PROJ, PROJM, b, vp0 + t, GQ + h * 64 + 8 * q), q1 = ldp4(PROJ, PROJM, b, vp0 + t, GQ + h * 64 + 8 * q + 4);
        const f32x4 k0 = ldp4(PROJ, PROJM, b, vp0 + t, GK + h * 64 + 8 * q), k1 = ldp4(PROJ, PROJM, b, vp0 + t, GK + h * 64 + 8 * q + 4);
        float qv[8] = {q0.x, q0.y, q0.z, q0.w, q1.x, q1.y, q1.z, q1.w}, kv[8] = {k0.x, k0.y, k0.z, k0.w, k1.x, k1.y, k1.z, k1.w};
#pragma unroll
        for (int i = 0; i < 8; ++i) { const float bcv = BC[t * BCP + 8 * q + i]; qv[i] *= fexp(bcv) * 0.125f; kv[i] *= fexp(-bcv); }
        v4u o; o.x = pk2(qv[0], qv[1]); o.y = pk2(qv[2], qv[3]); o.z = pk2(qv[4], qv[5]); o.w = pk2(qv[6], qv[7]);
        *(LAS v4u*)(QT + t * TP + 8 * q) = o;
        o.x = pk2(kv[0], kv[1]); o.y = pk2(kv[2], kv[3]); o.z = pk2(kv[4], kv[5]); o.w = pk2(kv[6], kv[7]);
        *(LAS v4u*)(KL + t * TP + 8 * q) = o;
#pragma unroll
        for (int qq = 0; qq < 4; ++qq) {
            const int e0 = 16 * q + 4 * qq;
            const f32x4 vv = ldp4(PROJ, PROJM, b, vp0 + t, GV + h * 128 + e0);
#pragma unroll
            for (int i = 0; i < 4; ++i) VT[(e0 + i) * TP + t] = (bf16)f2bf(vv[i]);
            const f32x4 sv = *(const f32x4*)(GUS + ((size_t)((b * 4 + h) * NCH + c) * 64 + t) * 128 + e0);
#pragma unroll
            for (int i = 0; i < 4; ++i) ST[(e0 + i) * TP + t] = (bf16)f2bf(sv[i]);
        }
    }
    __syncthreads();
    const int rt = F.wave & 3, wh = F.wave >> 2, fr = F.lane & 15, fq = F.lane >> 4;
    const int trow = rt * 16 + fr;
    {
#pragma unroll
        for (int cc = 0; cc < 2; ++cc) { const int ct = 2 * wh + cc;
            f32x4 acc = {0.f, 0.f, 0.f, 0.f};
#pragma unroll
            for (int ks = 0; ks < 2; ++ks)
                acc = mfma16(*(const LAS bf16x8*)(KL + (ct * 16 + fr) * TP + ks * 32 + 8 * fq), *(const LAS bf16x8*)(QT + trow * TP + ks * 32 + 8 * fq), acc);
            const int s0 = ct * 16 + 4 * fq;
#pragma unroll
            for (int i = 0; i < 4; ++i) if (s0 + i > trow) acc[i] = 0.f;
            v2u o; o.x = pk2(acc[0], acc[1]); o.y = pk2(acc[2], acc[3]);
            *(LAS v2u*)(AT + trow * TP + s0) = o; }
    }
    __syncthreads();
    f32x4 oacc[4]; float ssq = 0.f;
#pragma unroll
    for (int cc = 0; cc < 4; ++cc) { const int ct = wh * 4 + cc;
        f32x4 acc = {0.f, 0.f, 0.f, 0.f};
#pragma unroll
        for (int ks = 0; ks < 2; ++ks) {
            acc = mfma16(*(const LAS bf16x8*)(VT + (ct * 16 + fr) * TP + ks * 32 + 8 * fq), *(const LAS bf16x8*)(AT + trow * TP + ks * 32 + 8 * fq), acc);
            acc = mfma16(*(const LAS bf16x8*)(ST + (ct * 16 + fr) * TP + ks * 32 + 8 * fq), *(const LAS bf16x8*)(QT + trow * TP + ks * 32 + 8 * fq), acc);
        }
        oacc[cc] = acc; ssq += (acc[0] * acc[0] + acc[1] * acc[1]) + (acc[2] * acc[2] + acc[3] * acc[3]); }
    ssq += __shfl_xor(ssq, 16); ssq += __shfl_xor(ssq, 32);
    if (fq == 0) RS[wh * 64 + trow] = ssq;
    __syncthreads();
    {
        const float tot = RS[trow] + RS[64 + trow];
        const float rstd = 1.f / sqrtf(tot * (1.f / 128.f) + 1e-6f);
        const size_t m = (size_t)b * SEQ + (vp0 - NMETA) + trow;
#pragma unroll
        for (int cc = 0; cc < 4; ++cc) { const int e0 = (wh * 4 + cc) * 16 + 4 * fq;
            const f32x4 gv = ldp4(PROJ, PROJM, b, vp0 + trow, GG + h * 128 + e0);
            const f32x4 ng = *(const f32x4*)(a.in[I_GNORM] + e0);
            float y[4];
#pragma unroll
            for (int i = 0; i < 4; ++i) { const float gi = gv[i]; y[i] = oacc[cc][i] * rstd * ng[i] * (gi * fsigmoid(gi)); }
            v2u o; o.x = pk2(y[0], y[1]); o.y = pk2(y[2], y[3]);
            *(v2u*)(YMIX + m * D + h * 128 + e0) = o; }
    }
    __syncthreads();
}
__device__ __forceinline__ void phase4(const Args& a, const Frame& F) {
    for (int u = F.blk; u < NB * 4 * 32; u += F.G) { const int c = 1 + (u & 31), bh = u >> 5; gla_g3_unit(a, F, bh >> 2, bh & 3, c); }
}

__device__ __forceinline__ int eidx_of(int L) { return 16 * (L & 1) + 8 * ((L >> 1) & 1) + 4 * ((L >> 2) & 1) + 2 * ((L >> 3) & 1) + ((L >> 4) & 1); }
__device__ __forceinline__ void phase6(const Args& a, const Frame& F) {
    unsigned char* ws = a.ws;
    const int gw = F.blk * NWAVES + F.wave, NGW = F.G * NWAVES;
    constexpr int RWP = 1028;
    LAS float* rwT = (LAS float*)F.lds;
    LAS int* hist = (LAS int*)(F.lds + 32 * RWP * 4);
    for (int i = F.tid; i < D * NE; i += NTHR) { const int c = i >> 5, e = i & 31; rwT[e * RWP + c] = a.in[I_RTW][i]; }
    const float* S1 = (const float*)(ws + WS_S1); bf16* H1 = (bf16*)(ws + WS_H1);
    int* TOPI = (int*)(ws + WS_TOPI); float* GATE = (float*)(ws + WS_GATE); int* RANK = (int*)(ws + WS_RANK);
    unsigned* CNT = (unsigned*)(ws + WS_CTL) + CW_CNT;
    for (int rb = F.blk; rb < MX / 128; rb += F.G) {
        if (F.tid < 64) hist[F.tid] = 0;
        __syncthreads();
        int my_e = 0;
        for (int i = 0; i < 16; ++i) {
            const int m = rb * 128 + F.wave * 16 + i;
            const f32x4* xr = (const f32x4*)(S1 + (size_t)m * D) + F.lane;
            f32x4 v[4]; float s = 0.f;
#pragma unroll
            for (int j = 0; j < 4; ++j) { v[j] = xr[64 * j]; s += (v[j].x + v[j].y) + (v[j].z + v[j].w); }
            const float mean = wave_sum(s) * (1.f / D); float s2 = 0.f;
#pragma unroll
            for (int j = 0; j < 4; ++j) { v[j] = v[j] - mean; s2 += (v[j].x * v[j].x + v[j].y * v[j].y) + (v[j].z * v[j].z + v[j].w * v[j].w); }
            const float rstd = 1.f / sqrtf(wave_sum(s2) * (1.f / D) + 1e-5f);
#pragma unroll
            for (int j = 0; j < 4; ++j) { const int col = 4 * (F.lane + 64 * j);
                const f32x4 gv = *(const f32x4*)(a.in[I_LN1G] + col), bv = *(const f32x4*)(a.in[I_LN1B] + col);
                v[j] = v[j] * rstd * gv + bv;
                v2u o; o.x = pk2(v[j].x, v[j].y); o.y = pk2(v[j].z, v[j].w);
                *(v2u*)(H1 + (size_t)m * D + col) = o; }
            float p[32];
#pragma unroll
            for (int e = 0; e < 32; ++e) { float acc = 0.f;
#pragma unroll
                for (int j = 0; j < 4; ++j) { const f32x4 w = *(const LAS f32x4*)(rwT + e * RWP + 4 * (F.lane + 64 * j)); acc += (v[j].x * w.x + v[j].y * w.y) + (v[j].z * w.z + v[j].w * w.w); }
                p[e] = acc; if ((e & 3) == 3) __builtin_amdgcn_sched_barrier(0); }
#define TR_STAGE(n, dmask) _Pragma("unroll") for (int i2 = 0; i2 < (n) / 2; ++i2) { const bool up = (F.lane & (dmask)) != 0; const float keep = up ? p[i2 + (n) / 2] : p[i2]; const float send = up ? p[i2] : p[i2 + (n) / 2]; p[i2] = keep + __shfl_xor(send, (dmask)); }
            TR_STAGE(32, 1) TR_STAGE(16, 2) TR_STAGE(8, 4) TR_STAGE(4, 8) TR_STAGE(2, 16)
#undef TR_STAGE
            const int eidx = eidx_of(F.lane);
            const float logit = p[0] + __shfl_xor(p[0], 32) + a.in[I_RTB][eidx];
            int rank = 0;
#pragma unroll
            for (int j = 0; j < 32; ++j) { const float lj = __int_as_float(__builtin_amdgcn_readlane(__float_as_int(logit), j)); const int ej = eidx_of(j);
                rank += (lj > logit || (lj == logit && ej < eidx)) ? 1 : 0; }
            int ek[4]; float lk[4];
#pragma unroll
            for (int k = 0; k < 4; ++k) { const unsigned long long mk = __ballot(rank == k) & 0xffffffffull; const int src = __builtin_amdgcn_readfirstlane((int)__builtin_ctzll(mk | (1ull << 63)));
                ek[k] = eidx_of(src); lk[k] = __int_as_float(__builtin_amdgcn_readlane(__float_as_int(logit), src)); }
            const float e0 = 1.f, e1 = expf(lk[1] - lk[0]), e2 = expf(lk[2] - lk[0]), e3 = expf(lk[3] - lk[0]);
            const float inv = 1.f / (e0 + e1 + e2 + e3);
            if (F.lane < 4) { const int k = F.lane; const int ee = k == 0 ? ek[0] : k == 1 ? ek[1] : k == 2 ? ek[2] : ek[3]; const float gg = (k == 0 ? e0 : k == 1 ? e1 : k == 2 ? e2 : e3) * inv;
                TOPI[(size_t)m * 4 + k] = ee; GATE[(size_t)m * 4 + k] = gg; }
            if ((F.lane >> 2) == i) { const int k = F.lane & 3; my_e = k == 0 ? ek[0] : k == 1 ? ek[1] : k == 2 ? ek[2] : ek[3]; }
        }
        const int lrank = __hip_atomic_fetch_add(&hist[my_e], 1, __ATOMIC_RELAXED, __HIP_MEMORY_SCOPE_WORKGROUP);
        __syncthreads();
        if (F.tid < 32) hist[32 + F.tid] = (int)__hip_atomic_fetch_add(CNT + 64 * F.tid, (unsigned)hist[F.tid], __ATOMIC_RELAXED, __HIP_MEMORY_SCOPE_AGENT);
        __syncthreads();
        RANK[((size_t)rb * 128 + F.wave * 16 + (F.lane >> 2)) * 4 + (F.lane & 3)] = hist[32 + my_e] + lrank;
        __syncthreads();
    }
}

__device__ __forceinline__ void phase7(const Args& a, const Frame& F) {
    unsigned char* ws = a.ws;
    LAS int* starts = (LAS int*)F.lds;
    unsigned* CNT = (unsigned*)(ws + WS_CTL) + CW_CNT;
    int* TILEE = (int*)(ws + WS_TILEE);
    if (F.tid < 32) { const int cnt = (int)ld_agent(CNT + 64 * F.tid); starts[32 + F.tid] = (cnt + 255) & ~255; }
    __syncthreads();
    if (F.tid == 0) { int run = 0; for (int e = 0; e < 32; ++e) { starts[e] = run; run += starts[32 + e]; }
        if (F.blk == 0) { TILEE[1023] = run >> 8; for (int e = 0; e < 32; ++e) for (int tl = starts[e] >> 8; tl < (starts[e] + starts[32 + e]) >> 8; ++tl) TILEE[tl] = e; } }
    __syncthreads();
    const int* TOPI = (const int*)(ws + WS_TOPI); const int* RANK = (const int*)(ws + WS_RANK); int* TSLOT = (int*)(ws + WS_TSLOT);
    const bf16* H1 = (const bf16*)(ws + WS_H1); bf16* XS = (bf16*)(ws + WS_XS);
    const int gw = F.blk * NWAVES + F.wave, NGW = F.G * NWAVES;
    for (int q = gw; q < MX * 4; q += NGW) {
        const int m = q >> 2;
        const int e = TOPI[q], rk = RANK[q];
        const int slot = starts[e] + rk;
        if (F.lane == 0) TSLOT[q] = slot;
        const v4u* src = (const v4u*)(H1 + (size_t)m * D); v4u* dst = (v4u*)(XS + (size_t)slot * D);
        dst[F.lane] = src[F.lane]; dst[F.lane + 64] = src[F.lane + 64];
    }
}
__device__ __forceinline__ int moe_fill_table(const Args& a, const Frame& F, int nN, int RM) {
    LAS int* tab = (LAS int*)(F.lds + TAB_OFF);
    const unsigned* TILEE = (const unsigned*)(a.ws + WS_TILEE);
    if (F.tid == 0) {
        const int NT = (int)ld_agent(TILEE + 1023);
        const int x = F.blk & 7, j = F.blk >> 3; int n = 0;
        for (int i = 0; i < 64; ++i) { const int s = i * 8 + x, pm = s * RM + j / nN; if (pm >= NT) break;
            const int e = (int)ld_agent(TILEE + pm); tab[2 * n] = pm; tab[2 * n + 1] = e * nN + (j % nN); ++n; }
        tab[128] = n;
    }
    __syncthreads();
    return __builtin_amdgcn_readfirstlane(tab[128]);
}

__device__ __forceinline__ void phase10(const Args& a, const Frame& F) {
    unsigned char* ws = a.ws;
    const bf16* H1 = (const bf16*)(ws + WS_H1); const bf16* YS = (const bf16*)(ws + WS_YS);
    const int* TSLOT = (const int*)(ws + WS_TSLOT); const float* GATE = (const float*)(ws + WS_GATE);
    const int gw = F.blk * NWAVES + F.wave, NGW = F.G * NWAVES;
    for (int m = gw; m < MX; m += NGW) {
        float s[16];
#pragma unroll
        for (int j = 0; j < 2; ++j) { const v4u w = *(const v4u*)(H1 + (size_t)m * D + 8 * F.lane + 512 * j);
            s[8 * j + 0] = ALPHA * bflo(w.x); s[8 * j + 1] = ALPHA * bfhi(w.x); s[8 * j + 2] = ALPHA * bflo(w.y); s[8 * j + 3] = ALPHA * bfhi(w.y);
            s[8 * j + 4] = ALPHA * bflo(w.z); s[8 * j + 5] = ALPHA * bfhi(w.z); s[8 * j + 6] = ALPHA * bflo(w.w); s[8 * j + 7] = ALPHA * bfhi(w.w); }
#pragma unroll
        for (int k = 0; k < 4; ++k) { const int slot = TSLOT[(size_t)m * 4 + k]; const float g = GATE[(size_t)m * 4 + k];
#pragma unroll
            for (int j = 0; j < 2; ++j) { const v4u w = *(const v4u*)(YS + (size_t)slot * D + 8 * F.lane + 512 * j);
                s[8 * j + 0] += g * bflo(w.x); s[8 * j + 1] += g * bfhi(w.x); s[8 * j + 2] += g * bflo(w.y); s[8 * j + 3] += g * bfhi(w.y);
                s[8 * j + 4] += g * bflo(w.z); s[8 * j + 5] += g * bfhi(w.z); s[8 * j + 6] += g * bflo(w.w); s[8 * j + 7] += g * bfhi(w.w); } }
        float t = 0.f;
#pragma unroll
        for (int i = 0; i < 16; ++i) t += s[i];
        const float mean = wave_sum(t) * (1.f / D); float q = 0.f;
#pragma unroll
        for (int i = 0; i < 16; ++i) { s[i] -= mean; q += s[i] * s[i]; }
        const float rstd = 1.f / sqrtf(wave_sum(q) * (1.f / D) + 1e-5f);
#pragma unroll
        for (int j = 0; j < 2; ++j) { const int col = 8 * F.lane + 512 * j;
#pragma unroll
            for (int hh = 0; hh < 2; ++hh) { const f32x4 gv = *(const f32x4*)(a.in[I_LN2G] + col + 4 * hh), bv = *(const f32x4*)(a.in[I_LN2B] + col + 4 * hh);
                f32x4 o; o.x = s[8 * j + 4 * hh + 0] * rstd * gv.x + bv.x; o.y = s[8 * j + 4 * hh + 1] * rstd * gv.y + bv.y; o.z = s[8 * j + 4 * hh + 2] * rstd * gv.z + bv.z; o.w = s[8 * j + 4 * hh + 3] * rstd * gv.w + bv.w;
                *(f32x4*)(a.out + (size_t)m * D + col + 4 * hh) = o; } }
    }
}

template <int LO, int HI>
__global__ void __launch_bounds__(NTHR, 2) fwd(Args a) {
    extern __shared__ __attribute__((aligned(16))) unsigned char lds_raw[];
    LAS unsigned char* lds = (LAS unsigned char*)lds_raw;
    const int wave = __builtin_amdgcn_readfirstlane((int)(threadIdx.x >> 6));
    volatile LAS unsigned* MISC = (volatile LAS unsigned*)(lds + MISC_OFF);
    if (wave == 0) MISC[lane_id()] = 0u;
    __syncthreads();
    unsigned* ctl = (unsigned*)(a.ws + WS_CTL);
    XcdBarrier bar; bar.bar = ctl + CW_BAR; bar.x = 0; bar.st = nullptr;
    if constexpr (HI - LO > 1) bar = xcd_barrier_post(ctl + CW_BAR, MISC + 8, wave == 0 && lane_id() == 0);
#define PH(k) if constexpr (LO <= (k) && (k) < HI)
#define SEAM(k) if constexpr (LO <= (k) && (k) + 1 < HI) xcd_barrier(bar, wave == 0 && lane_id() == 0)
    PH(0) for (int rep_ = 0; rep_ < NREP(0); ++rep_) { const Frame F = mkframe(lds, wave); phase0(a, F); } SEAM(0);
    PH(1) for (int rep_ = 0; rep_ < NREP(1); ++rep_) { const Frame F = mkframe(lds, wave);
            pg8::Gemm g{(const pg8::bf16_t*)(a.ws + WS_A0), (const pg8::bf16_t*)(a.ws + WS_WIN), MX, PW, D}; pg8::StaticOrder S; S.init(MX, PW, F.G, F.blk);
            pg8::EpiBf16Plain E{(pg8::bf16_t*)(a.ws + WS_PROJ), PW};
            pg8::gemm_phase<pg8::EpiBf16Plain, pg8::StaticOrder, true, true>(F.lds, g, S, E, F.tid); } SEAM(1);
    PH(2) for (int rep_ = 0; rep_ < NREP(2); ++rep_) { const Frame F = mkframe(lds, wave); phase2(a, F); } SEAM(2);
    PH(3) { const Frame F = mkframe(lds, wave); phase3(a, F); } SEAM(3);
    PH(4) for (int rep_ = 0; rep_ < NREP(4); ++rep_) { const Frame F = mkframe(lds, wave); phase4(a, F); } SEAM(4);
    PH(5) for (int rep_ = 0; rep_ < NREP(5); ++rep_) { const Frame F = mkframe(lds, wave);
            pg8::Gemm g{(const pg8::bf16_t*)(a.ws + WS_YMIX), (const pg8::bf16_t*)(a.ws + WS_WOUT), MX, D, D}; pg8::StaticOrder S; S.init(MX, D, F.G, F.blk);
            pg8::EpiResid E{(float*)(a.ws + WS_S1), a.in[I_X], (const float*)(a.ws + WS_STATS), a.in[I_LNIN_G], a.in[I_LNIN_B], ALPHA};
            pg8::gemm_phase<pg8::EpiResid, pg8::StaticOrder, true, true>(F.lds, g, S, E, F.tid); } SEAM(5);
    PH(6) { const Frame F = mkframe(lds, wave); phase6(a, F); } SEAM(6);
    PH(7) for (int rep_ = 0; rep_ < NREP(7); ++rep_) { const Frame F = mkframe(lds, wave); phase7(a, F); } SEAM(7);
    PH(8) for (int rep_ = 0; rep_ < NREP(8); ++rep_) { const Frame F = mkframe(lds, wave); const int n = moe_fill_table(a, F, 8, 4);
            pg8::Gemm g{(const pg8::bf16_t*)(a.ws + WS_XS), (const pg8::bf16_t*)(a.ws + WS_WUP), 0, 0, D}; pg8::TableOrder S{(const LAS int*)(F.lds + TAB_OFF), n};
            pg8::EpiSwiglu E{(pg8::bf16_t*)(a.ws + WS_ACT), a.in[I_BUP]};
            pg8::gemm_phase<pg8::EpiSwiglu, pg8::TableOrder, true, true>(F.lds, g, S, E, F.tid); } SEAM(8);
    PH(9) for (int rep_ = 0; rep_ < NREP(9); ++rep_) { const Frame F = mkframe(lds, wave); const int n = moe_fill_table(a, F, 4, 8);
            pg8::Gemm g{(const pg8::bf16_t*)(a.ws + WS_ACT), (const pg8::bf16_t*)(a.ws + WS_WDN), 0, 0, D}; pg8::TableOrder S{(const LAS int*)(F.lds + TAB_OFF), n};
            pg8::EpiDown E{(pg8::bf16_t*)(a.ws + WS_YS), a.in[I_BDN]};
            pg8::gemm_phase<pg8::EpiDown, pg8::TableOrder, true, true>(F.lds, g, S, E, F.tid); } SEAM(9);
    PH(10) for (int rep_ = 0; rep_ < NREP(10); ++rep_) { const Frame F = mkframe(lds, wave); phase10(a, F); }
#undef PH
#undef SEAM
}

#ifndef MK_SINGLE
#define MK_SINGLE 1
#endif
template <int LO, int HI> static void launch_range(const Args& a, int grid, hipStream_t stream) {
    static bool attr = false;
    if (!attr) { (void)hipFuncSetAttribute((const void*)fwd<LO, HI>, hipFuncAttributeMaxDynamicSharedMemorySize, LDS_BYTES); attr = true; }
    hipLaunchKernelGGL((fwd<LO, HI>), dim3(grid), dim3(NTHR), LDS_BYTES, stream, a);
}
extern "C" void kernel_launch(void* const* d_in, const int* in_sizes, int n_in, void* d_out, int out_size, void* d_ws, size_t ws_size, hipStream_t stream) {
    if (n_in != 30 || ws_size < WS_END) { fprintf(stderr, "kernel_launch: unexpected inputs (n_in %d, ws %zu)\n", n_in, ws_size); return; }
    const int grid = 256;
    (void)hipMemsetAsync((char*)d_ws + WS_CTL, 0, CTL_ZERO_BYTES, stream);
    Args a{};
    for (int i = 0; i < 30; ++i) a.in[i] = (const float*)d_in[i];
    a.out = (float*)d_out; a.ws = (unsigned char*)d_ws;
#if MK_SINGLE
    launch_range<0, 11>(a, grid, stream);
#else
    launch_range<0, 1>(a, grid, stream); launch_range<1, 2>(a, grid, stream); launch_range<2, 3>(a, grid, stream); launch_range<3, 4>(a, grid, stream);
    launch_range<4, 5>(a, grid, stream); launch_range<5, 6>(a, grid, stream); launch_range<6, 7>(a, grid, stream); launch_range<7, 8>(a, grid, stream);
    launch_range<8, 9>(a, grid, stream); launch_range<9, 10>(a, grid, stream); launch_range<10, 11>(a, grid, stream);
#endif
}
```

```cpp
#include <hip/hip_runtime.h>
#include <cstdio>
#include <cstdint>
#include <cmath>
namespace pg8 {
#define PG8_LAS __attribute__((address_space(3)))
typedef unsigned short bf16_t;
typedef short bf16x8 __attribute__((ext_vector_type(8)));
typedef float f32x4 __attribute__((ext_vector_type(4)));
typedef unsigned u32x4 __attribute__((ext_vector_type(4)));
constexpr int BM = 256, BK = 64, HALF = 128, HTB = HALF * BK * 2  , STAGE_BYTES = 8 * HTB, NXCD = 8, WGM = 8;

__host__ __device__ __forceinline__ int lds_byte(int r, int c) { const int st = (r >> 4) * 2 + (c >> 5), rr = r & 15, cc = c & 31, ob = rr * 64 + cc * 2; return st * 1024 + (ob ^ (((ob >> 9) & 1) << 5)); }
__host__ __device__ __forceinline__ void stage_rc(int b, int& R, int& C) { const int st = b / 1024, sb = b % 1024, swz = sb ^ (((sb >> 9) & 1) << 5); R = (st >> 1) * 16 + swz / 64; C = (st & 1) * 32 + (swz % 64) / 2; }
__host__ __device__ __forceinline__ int perm32(int rho) { const int n = rho >> 4, i = rho & 15; return 8 * (i >> 2) + 4 * n + (i & 3); }

struct Unit { int pm, pn; };
struct Gemm { const bf16_t* A; const bf16_t* Bt; int M, N, K; };

struct StaticOrder {
    int nM, nN, nwg, G, c;
    __host__ __device__ void init(int M, int N, int G_, int c_) { nM = M / BM; nN = N / BM; nwg = nM * nN; G = G_; c = c_; }
    __host__ __device__ bool next(int i, Unit& u) const {
        const long L = (long)i * G + c; if (L >= nwg) return false;
        int wgid = (int)L; { const int q = nwg / NXCD, r = nwg % NXCD, xcd = wgid % NXCD, off = wgid / NXCD; wgid = (xcd < r ? xcd * (q + 1) : r * (q + 1) + (xcd - r) * q) + off; }
        const int nig = WGM * nN, gid = wgid / nig, fm = gid * WGM, gsz = (nM - fm) < WGM ? (nM - fm) : WGM;
        u.pm = fm + ((wgid % nig) % gsz); u.pn = (wgid % nig) / gsz; return true;
    }
    __device__ __forceinline__ void a_ready(const Unit&) const {}
    __device__ __forceinline__ void done(const Unit&) const {}
};


__device__ __forceinline__ unsigned cvt_pk_bf16(float lo, float hi) { unsigned r; asm volatile("v_cvt_pk_bf16_f32 %0, %1, %2" : "=v"(r) : "v"(lo), "v"(hi)); return r; }
typedef unsigned u32x2 __attribute__((ext_vector_type(2)));

struct EpiBf16Plain {
    static constexpr bool PERM = true, AFTER_DRAIN = false;
    bf16_t* O; int ldc;
    __device__ __forceinline__ void operator()(const f32x4 (&acc)[2][2][4][2], const Unit& u, int wr, int wc, int fr, int fq) const {
        const int row0 = u.pm * BM + wr * 64 + fr, col0 = u.pn * BM + wc * 32 + 8 * fq;
#pragma unroll
        for (int ai = 0; ai < 2; ++ai)
#pragma unroll
            for (int m = 0; m < 4; ++m) { bf16_t* rowp = O + (size_t)(row0 + ai * HALF + m * 16) * ldc + col0;
#pragma unroll
                for (int bj = 0; bj < 2; ++bj) { const f32x4 v0 = acc[ai][bj][m][0], v1 = acc[ai][bj][m][1];
                    u32x4 w; w.x = cvt_pk_bf16(v0[0], v0[1]); w.y = cvt_pk_bf16(v0[2], v0[3]); w.z = cvt_pk_bf16(v1[0], v1[1]); w.w = cvt_pk_bf16(v1[2], v1[3]);
                    *(u32x4*)(rowp + bj * HALF) = w; } }
    }
};

struct EpiResid {
    static constexpr bool PERM = false, AFTER_DRAIN = false;
    float* S1; const float* x; const float* stats; const float* g; const float* bta; float alpha;
    __device__ __forceinline__ void operator()(const f32x4 (&acc)[2][2][4][2], const Unit& u, int wr, int wc, int fr, int fq) const {
        const int row0 = u.pm * BM + wr * 64 + fr, col0 = u.pn * BM + wc * 32 + 4 * fq;
#pragma unroll
        for (int bj = 0; bj < 2; ++bj)
#pragma unroll
            for (int n = 0; n < 2; ++n) { const int c = col0 + bj * HALF + n * 16;
                const f32x4 gv = *(const f32x4*)(g + c) * alpha, bv = *(const f32x4*)(bta + c) * alpha;
#pragma unroll
                for (int ai = 0; ai < 2; ++ai)
#pragma unroll
                    for (int m = 0; m < 4; ++m) { const int r = row0 + ai * HALF + m * 16;
                        const float mean = stats[2 * r], rstd = stats[2 * r + 1];
                        const f32x4 xv = *(const f32x4*)(x + (size_t)r * 1024 + c);
                        *(f32x4*)(S1 + (size_t)r * 1024 + c) = ((xv - mean) * rstd) * gv + bv + acc[ai][bj][m][n]; } }
    }
};

__device__ __forceinline__ float swiglu1(float glu, float lin) {
    const float xg = fminf(glu, 7.0f), xl = fminf(fmaxf(lin, -7.0f), 7.0f);
    const float sg = __builtin_amdgcn_rcpf(1.0f + __expf(-1.702f * xg));
    return xg * sg * (xl + 1.0f);
}
struct EpiSwiglu {
    static constexpr bool PERM = true, AFTER_DRAIN = false;
    bf16_t* ACT; const float* bup;
    __device__ __forceinline__ void operator()(const f32x4 (&acc)[2][2][4][2], const Unit& u, int wr, int wc, int fr, int fq) const {
        const int e = u.pn >> 3, pn = u.pn & 7;
        const int row0 = u.pm * BM + wr * 64 + fr, ucol0 = pn * BM + wc * 32 + 8 * fq, acol0 = ucol0 >> 1;
        f32x4 bv[2][2];
#pragma unroll
        for (int bj = 0; bj < 2; ++bj)
#pragma unroll
            for (int n = 0; n < 2; ++n) bv[bj][n] = *(const f32x4*)(bup + (size_t)e * 2048 + ucol0 + bj * HALF + 4 * n);
#pragma unroll
        for (int ai = 0; ai < 2; ++ai)
#pragma unroll
            for (int m = 0; m < 4; ++m) { bf16_t* rowp = ACT + (size_t)(row0 + ai * HALF + m * 16) * 1024 + acol0;
#pragma unroll
                for (int bj = 0; bj < 2; ++bj) { const f32x4 v0 = acc[ai][bj][m][0] + bv[bj][0], v1 = acc[ai][bj][m][1] + bv[bj][1];
                    u32x2 w; w.x = cvt_pk_bf16(swiglu1(v0[0], v0[1]), swiglu1(v0[2], v0[3])); w.y = cvt_pk_bf16(swiglu1(v1[0], v1[1]), swiglu1(v1[2], v1[3]));
                    *(u32x2*)(rowp + bj * (HALF / 2)) = w; } }
    }
};
struct EpiDown {
    static constexpr bool PERM = true, AFTER_DRAIN = false;
    bf16_t* YS; const float* bdn;
    __device__ __forceinline__ void operator()(const f32x4 (&acc)[2][2][4][2], const Unit& u, int wr, int wc, int fr, int fq) const {
        const int e = u.pn >> 2, pn = u.pn & 3;
        const int row0 = u.pm * BM + wr * 64 + fr, col0 = pn * BM + wc * 32 + 8 * fq;
        f32x4 bv[2][2];
#pragma unroll
        for (int bj = 0; bj < 2; ++bj)
#pragma unroll
            for (int n = 0; n < 2; ++n) bv[bj][n] = *(const f32x4*)(bdn + (size_t)e * 1024 + col0 + bj * HALF + 4 * n);
#pragma unroll
        for (int ai = 0; ai < 2; ++ai)
#pragma unroll
            for (int m = 0; m < 4; ++m) { bf16_t* rowp = YS + (size_t)(row0 + ai * HALF + m * 16) * 1024 + col0;
#pragma unroll
                for (int bj = 0; bj < 2; ++bj) { const f32x4 v0 = acc[ai][bj][m][0] + bv[bj][0], v1 = acc[ai][bj][m][1] + bv[bj][1];
                    u32x4 w; w.x = cvt_pk_bf16(v0[0], v0[1]); w.y = cvt_pk_bf16(v0[2], v0[3]); w.z = cvt_pk_bf16(v1[0], v1[1]); w.w = cvt_pk_bf16(v1[2], v1[3]);
                    *(u32x4*)(rowp + bj * HALF) = w; } }
    }
};
struct TableOrder {
    const PG8_LAS int* tab; int n;
    __device__ __forceinline__ bool next(int i, Unit& u) const {
        if (i >= n) return false;
        u.pm = __builtin_amdgcn_readfirstlane(tab[2 * i]); u.pn = __builtin_amdgcn_readfirstlane(tab[2 * i + 1]); return true;
    }
    __device__ __forceinline__ void a_ready(const Unit&) const {}
    __device__ __forceinline__ void done(const Unit&) const {}
};

template <class Epi, class Sched, bool ALIGN_EPI = false, bool SP2 = false>
__device__ __forceinline__ void gemm_phase(PG8_LAS unsigned char* lds, const Gemm g, const Sched& S, const Epi& E, const int tid) {
    const int wid = __builtin_amdgcn_readfirstlane(tid >> 6), lane = tid & 63, wr = wid >> 2, wc = wid & 3, fr = lane & 15, fq = lane >> 4;
    const int K = g.K, nt = K / BK;
    unsigned voffA[2], voffB[2];
#pragma unroll
    for (int i = 0; i < 2; ++i) { int R, C; stage_rc(tid * 16 + i * 8192, R, C); const int Rb = Epi::PERM ? ((R & ~31) + perm32(R & 31)) : R;
        voffA[i] = (unsigned)(R * K + C) * 2u; voffB[i] = (unsigned)(Rb * K + C) * 2u; }
    const size_t kstep = (size_t)(BK * 2);
    const size_t hstep = (size_t)HALF * K * 2;
    const size_t tstep = 2 * hstep;
    const unsigned ldsw = (unsigned)wid * 1024u;
    const int aoff = lds_byte(wr * 64 + fr, fq * 8), boff = lds_byte(wc * 32 + fr, fq * 8);
#define PG8_SA(b, h) (((b) * 2 + (h)) * HTB)
#define PG8_SB(b, h) ((4 + (b) * 2 + (h)) * HTB)
#define PG8_STAGE(bufoff, gbase, voff) do { _Pragma("unroll") for (int _i = 0; _i < 2; ++_i) \
        __builtin_amdgcn_global_load_lds((const unsigned*)((const char*)(gbase) + (voff)[_i]), (PG8_LAS unsigned*)(lds + (bufoff) + ldsw + _i * 8192), 16, 0, 0); } while (0)
#define PG8_LDA(dst, b, h) do { _Pragma("unroll") for (int m = 0; m < 4; ++m) _Pragma("unroll") for (int k = 0; k < 2; ++k) dst[m][k] = *(const PG8_LAS bf16x8*)(lds + PG8_SA(b, h) + aoff + m * 2048 + k * 1024); } while (0)
#define PG8_LDB(dst, b, h) do { _Pragma("unroll") for (int n = 0; n < 2; ++n) _Pragma("unroll") for (int k = 0; k < 2; ++k) dst[n][k] = *(const PG8_LAS bf16x8*)(lds + PG8_SB(b, h) + boff + n * 2048 + k * 1024); } while (0)
#define PG8_MMA(ai, bj, At, Bt) do { __builtin_amdgcn_s_setprio(1); _Pragma("unroll") for (int m = 0; m < 4; ++m) _Pragma("unroll") for (int n = 0; n < 2; ++n) _Pragma("unroll") for (int k = 0; k < 2; ++k) \
        acc[ai][bj][m][n] = __builtin_amdgcn_mfma_f32_16x16x32_bf16(Bt[n][k], At[m][k], acc[ai][bj][m][n], 0, 0, 0); __builtin_amdgcn_s_setprio(0); } while (0)
#define PG8_WAIT_V(n) asm volatile("s_waitcnt vmcnt(" #n ")" ::: "memory")
#define PG8_WAIT_L(n) asm volatile("s_waitcnt lgkmcnt(" #n ")" ::: "memory")
#define PG8_BAR __builtin_amdgcn_s_barrier()
#define PG8_SCHED __builtin_amdgcn_sched_barrier(0)
    Unit cur, nxt; int ui = 0;
    if (!S.next(0, cur)) return;
    f32x4 acc[2][2][4][2];
#pragma unroll
    for (int a = 0; a < 2; ++a)
#pragma unroll
        for (int b = 0; b < 2; ++b)
#pragma unroll
            for (int m = 0; m < 4; ++m)
#pragma unroll
                for (int n = 0; n < 2; ++n) acc[a][b][m][n] = (f32x4){0.f, 0.f, 0.f, 0.f};
    bf16x8 At[4][2], B0[2][2], B1[2][2];
    const char* cA = (const char*)g.A + (size_t)cur.pm * tstep; const char* cB = (const char*)g.Bt + (size_t)cur.pn * tstep;
    S.a_ready(cur);
    if constexpr (SP2) {
        PG8_STAGE(PG8_SB(0, 0), cB, voffB); PG8_STAGE(PG8_SB(0, 1), cB + hstep, voffB); PG8_STAGE(PG8_SA(0, 0), cA, voffA); PG8_STAGE(PG8_SA(0, 1), cA + hstep, voffA);
        if (wr == 1) PG8_BAR;
        PG8_WAIT_V(2); PG8_BAR;
        PG8_STAGE(PG8_SB(1, 0), cB + kstep, voffB); PG8_STAGE(PG8_SA(1, 0), cA + kstep, voffA); PG8_STAGE(PG8_SB(1, 1), cB + hstep + kstep, voffB);
        PG8_WAIT_V(6); PG8_BAR;
    } else {
        PG8_STAGE(PG8_SB(0, 0), cB, voffB); PG8_STAGE(PG8_SA(0, 0), cA, voffA); PG8_STAGE(PG8_SB(0, 1), cB + hstep, voffB); PG8_STAGE(PG8_SA(0, 1), cA + hstep, voffA);
        if (wr == 1) PG8_BAR;
        PG8_WAIT_V(4); PG8_BAR;
        PG8_STAGE(PG8_SB(1, 0), cB + kstep, voffB); PG8_STAGE(PG8_SA(1, 0), cA + kstep, voffA); PG8_STAGE(PG8_SB(1, 1), cB + hstep + kstep, voffB);
        PG8_WAIT_V(6); PG8_BAR;
    }
    for (;;) {
        const bool has_next = S.next(ui + 1, nxt);
        const char* nA = has_next ? (const char*)g.A + (size_t)nxt.pm * tstep : cA; const char* nB = has_next ? (const char*)g.Bt + (size_t)nxt.pn * tstep : cB;
        for (int t = 0; t < nt; t += 2) {
            const bool last = (t == nt - 2);
            const char* a1 = cA + (size_t)(t + 1) * kstep;
            const char* a2 = last ? nA : cA + (size_t)(t + 2) * kstep; const char* b2 = last ? nB : cB + (size_t)(t + 2) * kstep;
            const char* a3 = a2 + kstep; const char* b3 = b2 + kstep;
            if (last && has_next) S.a_ready(nxt);
            if constexpr (SP2) {
            PG8_LDB(B0, 0, 0); PG8_LDB(B1, 0, 1); PG8_SCHED; PG8_LDA(At, 0, 0); PG8_STAGE(PG8_SA(1, 1), a1 + hstep, voffA);
            PG8_WAIT_V(8); PG8_WAIT_L(0); PG8_BAR; PG8_MMA(0, 0, At, B0); PG8_MMA(0, 1, At, B1); PG8_BAR; PG8_SCHED;
            PG8_LDA(At, 0, 1); PG8_STAGE(PG8_SB(0, 0), b2, voffB); PG8_STAGE(PG8_SB(0, 1), b2 + hstep, voffB); PG8_STAGE(PG8_SA(0, 0), a2, voffA);
            PG8_WAIT_V(8); PG8_WAIT_L(0); PG8_BAR; PG8_MMA(1, 0, At, B0); PG8_MMA(1, 1, At, B1); PG8_BAR; PG8_SCHED;
            PG8_LDB(B0, 1, 0); PG8_LDB(B1, 1, 1); PG8_SCHED; PG8_LDA(At, 1, 0); PG8_STAGE(PG8_SA(0, 1), a2 + hstep, voffA);
            PG8_WAIT_V(8); PG8_WAIT_L(0); PG8_BAR; PG8_MMA(0, 0, At, B0); PG8_MMA(0, 1, At, B1); PG8_BAR; PG8_SCHED;
            PG8_LDA(At, 1, 1); PG8_STAGE(PG8_SB(1, 0), b3, voffB); PG8_STAGE(PG8_SB(1, 1), b3 + hstep, voffB); PG8_STAGE(PG8_SA(1, 0), a3, voffA);
            PG8_WAIT_V(8); PG8_WAIT_L(0); PG8_BAR; PG8_MMA(1, 0, At, B0); PG8_MMA(1, 1, At, B1); PG8_BAR; PG8_SCHED;
            } else {
            PG8_LDB(B0, 0, 0); PG8_SCHED; PG8_LDA(At, 0, 0); PG8_STAGE(PG8_SA(1, 1), a1 + hstep, voffA);
            PG8_WAIT_L(8); PG8_BAR; PG8_WAIT_L(0); PG8_MMA(0, 0, At, B0); PG8_BAR; PG8_SCHED;
            PG8_LDB(B1, 0, 1); PG8_STAGE(PG8_SB(0, 0), b2, voffB);
            PG8_BAR; PG8_WAIT_L(0); PG8_MMA(0, 1, At, B1); PG8_BAR;
            PG8_LDA(At, 0, 1); PG8_STAGE(PG8_SA(0, 0), a2, voffA);
            PG8_BAR; PG8_WAIT_L(0); PG8_MMA(1, 0, At, B0); PG8_BAR; PG8_SCHED;
            PG8_STAGE(PG8_SB(0, 1), b2 + hstep, voffB);
            PG8_WAIT_V(6); PG8_BAR; PG8_MMA(1, 1, At, B1); PG8_BAR;
            PG8_LDB(B0, 1, 0); PG8_SCHED; PG8_LDA(At, 1, 0); PG8_STAGE(PG8_SA(0, 1), a2 + hstep, voffA);
            PG8_WAIT_L(8); PG8_BAR; PG8_WAIT_L(0); PG8_MMA(0, 0, At, B0); PG8_BAR; PG8_SCHED;
            PG8_LDB(B1, 1, 1); PG8_STAGE(PG8_SB(1, 0), b3, voffB);
            PG8_BAR; PG8_WAIT_L(0); PG8_MMA(0, 1, At, B1); PG8_BAR;
            PG8_LDA(At, 1, 1); PG8_STAGE(PG8_SA(1, 0), a3, voffA);
            PG8_BAR; PG8_WAIT_L(0); PG8_MMA(1, 0, At, B0); PG8_BAR; PG8_SCHED;
            PG8_STAGE(PG8_SB(1, 1), b3 + hstep, voffB);
            PG8_WAIT_V(6); PG8_BAR; PG8_MMA(1, 1, At, B1); PG8_BAR;
            }
        }
        if constexpr (ALIGN_EPI) { if (wr == 0) PG8_BAR; }
        if constexpr (!Epi::AFTER_DRAIN) { E(acc, cur, wr, wc, fr, fq); S.done(cur); }
        if (!has_next) break;
#pragma unroll
        for (int a = 0; a < 2; ++a)
#pragma unroll
            for (int b = 0; b < 2; ++b)
#pragma unroll
                for (int m = 0; m < 4; ++m)
#pragma unroll
                    for (int n = 0; n < 2; ++n) acc[a][b][m][n] = (f32x4){0.f, 0.f, 0.f, 0.f};
        cur = nxt; cA = nA; cB = nB; ++ui;
        if constexpr (ALIGN_EPI) { if (wr == 1) PG8_BAR; }
    }
    PG8_WAIT_V(0);
    if constexpr (!ALIGN_EPI) { if (wr == 0) PG8_BAR; }
    PG8_BAR;
    if constexpr (Epi::AFTER_DRAIN) { E.fused(acc, cur, wr, wc, fr, fq, lds, wid, lane); S.done(cur); }
#undef PG8_SA
#undef PG8_SB
#undef PG8_STAGE
#undef PG8_LDA
#undef PG8_LDB
#undef PG8_MMA
#undef PG8_WAIT_V
#undef PG8_WAIT_L
#undef PG8_BAR
#undef PG8_SCHED
}
template <class Epi, class Sched, bool ALIGN_EPI = false, bool SP2 = false>
__device__ __forceinline__ void gemm_phase_g(PG8_LAS unsigned char* lds, const Gemm g, const Sched& S, const Epi& E, const int tid, const int* rowmap) {
    const int wid = __builtin_amdgcn_readfirstlane(tid >> 6), lane = tid & 63, wr = wid >> 2, wc = wid & 3, fr = lane & 15, fq = lane >> 4;
    const int K = g.K, nt = K / BK;
    unsigned voffB[2], cv0[2], cv1[2], nv0[2], nv1[2]; int RA[2], CA[2];
#pragma unroll
    for (int i = 0; i < 2; ++i) { int R, C; stage_rc(tid * 16 + i * 8192, R, C); const int Rb = Epi::PERM ? ((R & ~31) + perm32(R & 31)) : R;
        RA[i] = R; CA[i] = C; voffB[i] = (unsigned)(Rb * K + C) * 2u; }
    const size_t kstep = (size_t)(BK * 2);
    const size_t hstep = (size_t)HALF * K * 2;
    const size_t tstep = 2 * hstep;
    const unsigned ldsw = (unsigned)wid * 1024u;
    const int aoff = lds_byte(wr * 64 + fr, fq * 8), boff = lds_byte(wc * 32 + fr, fq * 8);
#define PG8_SA(b, h) (((b) * 2 + (h)) * HTB)
#define PG8_SB(b, h) ((4 + (b) * 2 + (h)) * HTB)
#define PG8_STAGE(bufoff, gbase, voff) do { _Pragma("unroll") for (int _i = 0; _i < 2; ++_i) \
        __builtin_amdgcn_global_load_lds((const unsigned*)((const char*)(gbase) + (voff)[_i]), (PG8_LAS unsigned*)(lds + (bufoff) + ldsw + _i * 8192), 16, 0, 0); } while (0)
#define PG8_LDA(dst, b, h) do { _Pragma("unroll") for (int m = 0; m < 4; ++m) _Pragma("unroll") for (int k = 0; k < 2; ++k) dst[m][k] = *(const PG8_LAS bf16x8*)(lds + PG8_SA(b, h) + aoff + m * 2048 + k * 1024); } while (0)
#define PG8_LDB(dst, b, h) do { _Pragma("unroll") for (int n = 0; n < 2; ++n) _Pragma("unroll") for (int k = 0; k < 2; ++k) dst[n][k] = *(const PG8_LAS bf16x8*)(lds + PG8_SB(b, h) + boff + n * 2048 + k * 1024); } while (0)
#define PG8_MMA(ai, bj, At, Bt) do { __builtin_amdgcn_s_setprio(1); _Pragma("unroll") for (int m = 0; m < 4; ++m) _Pragma("unroll") for (int n = 0; n < 2; ++n) _Pragma("unroll") for (int k = 0; k < 2; ++k) \
        acc[ai][bj][m][n] = __builtin_amdgcn_mfma_f32_16x16x32_bf16(Bt[n][k], At[m][k], acc[ai][bj][m][n], 0, 0, 0); __builtin_amdgcn_s_setprio(0); } while (0)
#define PG8_WAIT_V(n) asm volatile("s_waitcnt vmcnt(" #n ")" ::: "memory")
#define PG8_WAIT_L(n) asm volatile("s_waitcnt lgkmcnt(" #n ")" ::: "memory")
#define PG8_BAR __builtin_amdgcn_s_barrier()
#define PG8_SCHED __builtin_amdgcn_sched_barrier(0)
    static_assert(SP2, "gemm_phase_g: SP2 form only");
    Unit cur, nxt; int ui = 0;
    if (!S.next(0, cur)) return;
    f32x4 acc[2][2][4][2];
#pragma unroll
    for (int a = 0; a < 2; ++a)
#pragma unroll
        for (int b = 0; b < 2; ++b)
#pragma unroll
            for (int m = 0; m < 4; ++m)
#pragma unroll
                for (int n = 0; n < 2; ++n) acc[a][b][m][n] = (f32x4){0.f, 0.f, 0.f, 0.f};
    bf16x8 At[4][2], B0[2][2], B1[2][2];
    const char* gA = (const char*)g.A; const char* cB = (const char*)g.Bt + (size_t)cur.pn * tstep;
#define PG8_ROWS(pm_, v0_, v1_) do { _Pragma("unroll") for (int _i = 0; _i < 2; ++_i) { v0_[_i] = (unsigned)(rowmap[(pm_) * BM + RA[_i]] * K + CA[_i]) * 2u; v1_[_i] = (unsigned)(rowmap[(pm_) * BM + HALF + RA[_i]] * K + CA[_i]) * 2u; } } while (0)
    PG8_ROWS(cur.pm, cv0, cv1);
    const unsigned voffA[2] = {0u, 0u}; const char* cA = gA; (void)voffA; (void)cA;
    S.a_ready(cur);
    if constexpr (SP2) {
        PG8_STAGE(PG8_SB(0, 0), cB, voffB); PG8_STAGE(PG8_SB(0, 1), cB + hstep, voffB); PG8_STAGE(PG8_SA(0, 0), gA, cv0); PG8_STAGE(PG8_SA(0, 1), gA, cv1);
        if (wr == 1) PG8_BAR;
        PG8_WAIT_V(2); PG8_BAR;
        PG8_STAGE(PG8_SB(1, 0), cB + kstep, voffB); PG8_STAGE(PG8_SA(1, 0), gA + kstep, cv0); PG8_STAGE(PG8_SB(1, 1), cB + hstep + kstep, voffB);
        PG8_WAIT_V(6); PG8_BAR;
    } else {
        PG8_STAGE(PG8_SB(0, 0), cB, voffB); PG8_STAGE(PG8_SA(0, 0), cA, voffA); PG8_STAGE(PG8_SB(0, 1), cB + hstep, voffB); PG8_STAGE(PG8_SA(0, 1), cA + hstep, voffA);
        if (wr == 1) PG8_BAR;
        PG8_WAIT_V(4); PG8_BAR;
        PG8_STAGE(PG8_SB(1, 0), cB + kstep, voffB); PG8_STAGE(PG8_SA(1, 0), cA + kstep, voffA); PG8_STAGE(PG8_SB(1, 1), cB + hstep + kstep, voffB);
        PG8_WAIT_V(6); PG8_BAR;
    }
    for (;;) {
        const bool has_next = S.next(ui + 1, nxt);
        const char* nB = has_next ? (const char*)g.Bt + (size_t)nxt.pn * tstep : cB;
        if (has_next) PG8_ROWS(nxt.pm, nv0, nv1); else { nv0[0] = cv0[0]; nv0[1] = cv0[1]; nv1[0] = cv1[0]; nv1[1] = cv1[1]; }
        for (int t = 0; t < nt; t += 2) {
            const bool last = (t == nt - 2);
            const char* a1 = gA + (size_t)(t + 1) * kstep;
            const char* a2 = last ? gA : gA + (size_t)(t + 2) * kstep; const char* b2 = last ? nB : cB + (size_t)(t + 2) * kstep;
            unsigned w0[2], w1[2]; w0[0] = last ? nv0[0] : cv0[0]; w0[1] = last ? nv0[1] : cv0[1]; w1[0] = last ? nv1[0] : cv1[0]; w1[1] = last ? nv1[1] : cv1[1];
            const char* a3 = a2 + kstep; const char* b3 = b2 + kstep;
            if (last && has_next) S.a_ready(nxt);
            if constexpr (SP2) {
            PG8_LDB(B0, 0, 0); PG8_LDB(B1, 0, 1); PG8_SCHED; PG8_LDA(At, 0, 0); PG8_STAGE(PG8_SA(1, 1), a1, cv1);
            PG8_WAIT_V(8); PG8_WAIT_L(0); PG8_BAR; PG8_MMA(0, 0, At, B0); PG8_MMA(0, 1, At, B1); PG8_BAR; PG8_SCHED;
            PG8_LDA(At, 0, 1); PG8_STAGE(PG8_SB(0, 0), b2, voffB); PG8_STAGE(PG8_SB(0, 1), b2 + hstep, voffB); PG8_STAGE(PG8_SA(0, 0), a2, w0);
            PG8_WAIT_V(8); PG8_WAIT_L(0); PG8_BAR; PG8_MMA(1, 0, At, B0); PG8_MMA(1, 1, At, B1); PG8_BAR; PG8_SCHED;
            PG8_LDB(B0, 1, 0); PG8_LDB(B1, 1, 1); PG8_SCHED; PG8_LDA(At, 1, 0); PG8_STAGE(PG8_SA(0, 1), a2, w1);
            PG8_WAIT_V(8); PG8_WAIT_L(0); PG8_BAR; PG8_MMA(0, 0, At, B0); PG8_MMA(0, 1, At, B1); PG8_BAR; PG8_SCHED;
            PG8_LDA(At, 1, 1); PG8_STAGE(PG8_SB(1, 0), b3, voffB); PG8_STAGE(PG8_SB(1, 1), b3 + hstep, voffB); PG8_STAGE(PG8_SA(1, 0), a3, w0);
            PG8_WAIT_V(8); PG8_WAIT_L(0); PG8_BAR; PG8_MMA(1, 0, At, B0); PG8_MMA(1, 1, At, B1); PG8_BAR; PG8_SCHED;
            } else {
            PG8_LDB(B0, 0, 0); PG8_SCHED; PG8_LDA(At, 0, 0); PG8_STAGE(PG8_SA(1, 1), a1, cv1);
            PG8_WAIT_L(8); PG8_BAR; PG8_WAIT_L(0); PG8_MMA(0, 0, At, B0); PG8_BAR; PG8_SCHED;
            PG8_LDB(B1, 0, 1); PG8_STAGE(PG8_SB(0, 0), b2, voffB);
            PG8_BAR; PG8_WAIT_L(0); PG8_MMA(0, 1, At, B1); PG8_BAR;
            PG8_LDA(At, 0, 1); PG8_STAGE(PG8_SA(0, 0), a2, voffA);
            PG8_BAR; PG8_WAIT_L(0); PG8_MMA(1, 0, At, B0); PG8_BAR; PG8_SCHED;
            PG8_STAGE(PG8_SB(0, 1), b2 + hstep, voffB);
            PG8_WAIT_V(6); PG8_BAR; PG8_MMA(1, 1, At, B1); PG8_BAR;
            PG8_LDB(B0, 1, 0); PG8_SCHED; PG8_LDA(At, 1, 0); PG8_STAGE(PG8_SA(0, 1), a2, w1);
            PG8_WAIT_L(8); PG8_BAR; PG8_WAIT_L(0); PG8_MMA(0, 0, At, B0); PG8_BAR; PG8_SCHED;
            PG8_LDB(B1, 1, 1); PG8_STAGE(PG8_SB(1, 0), b3, voffB);
            PG8_BAR; PG8_WAIT_L(0); PG8_MMA(0, 1, At, B1); PG8_BAR;
            PG8_LDA(At, 1, 1); PG8_STAGE(PG8_SA(1, 0), a3, voffA);
            PG8_BAR; PG8_WAIT_L(0); PG8_MMA(1, 0, At, B0); PG8_BAR; PG8_SCHED;
            PG8_STAGE(PG8_SB(1, 1), b3 + hstep, voffB);
            PG8_WAIT_V(6); PG8_BAR; PG8_MMA(1, 1, At, B1); PG8_BAR;
            }
        }
        if constexpr (ALIGN_EPI) { if (wr == 0) PG8_BAR; }
        if constexpr (!Epi::AFTER_DRAIN) { E(acc, cur, wr, wc, fr, fq); S.done(cur); }
        if (!has_next) break;
#pragma unroll
        for (int a = 0; a < 2; ++a)
#pragma unroll
            for (int b = 0; b < 2; ++b)
#pragma unroll
                for (int m = 0; m < 4; ++m)
#pragma unroll
                    for (int n = 0; n < 2; ++n) acc[a][b][m][n] = (f32x4){0.f, 0.f, 0.f, 0.f};
        cur = nxt; cB = nB; ++ui; cv0[0] = nv0[0]; cv0[1] = nv0[1]; cv1[0] = nv1[0]; cv1[1] = nv1[1];
        if constexpr (ALIGN_EPI) { if (wr == 1) PG8_BAR; }
    }
    PG8_WAIT_V(0);
    if constexpr (!ALIGN_EPI) { if (wr == 0) PG8_BAR; }
    PG8_BAR;
    if constexpr (Epi::AFTER_DRAIN) { E.fused(acc, cur, wr, wc, fr, fq, lds, wid, lane); S.done(cur); }
#undef PG8_ROWS
#undef PG8_SA
#undef PG8_SB
#undef PG8_STAGE
#undef PG8_LDA
#undef PG8_LDB
#undef PG8_MMA
#undef PG8_WAIT_V
#undef PG8_WAIT_L
#undef PG8_BAR
#undef PG8_SCHED
}
}

#ifndef REP_MASK
#define REP_MASK 0
#endif
#define NREP(k) (1 + ((REP_MASK >> (k)) & 1))

constexpr int NB = 16, SEQ = 2048, D = 1024, NMETA = 16;
constexpr int MX = NB * SEQ;
constexpr int INW = 3344, PW = 3584;
constexpr int GQ = 0, GK = 256, GV = 512, GG = 1024, GKL = 1536;
constexpr int RW0 = 1552;
constexpr int RR = RW0, RK = RW0 + 512, RV = RW0 + 1024, RWL = RW0 + 1536, RAL = RW0 + 1600, RGL = RW0 + 1664;
constexpr int NE = 32, TOPK = 4;
constexpr int NCH = 33;
constexpr float ALPHA = 1.189207115002721f;
constexpr int NWAVES = 8, NTHR = 512;

constexpr size_t MiB = 1u << 20;
constexpr size_t WS_CTL = 0, CTL_ZERO_BYTES = 1 * MiB;
constexpr size_t WS_STATS = 1 * MiB;
constexpr size_t WS_TOPI  = WS_STATS + 256 * 1024;
constexpr size_t WS_GATE  = WS_TOPI + 512 * 1024;
constexpr size_t WS_RANK  = WS_GATE + 512 * 1024;
constexpr size_t WS_TSLOT = WS_RANK + 512 * 1024;
constexpr size_t WS_BON   = WS_TSLOT + 512 * 1024;
constexpr size_t WS_PROJM = WS_BON + 1 * MiB;
constexpr size_t WS_OPSM  = WS_PROJM + 256 * 1024;
constexpr size_t WS_DL    = WS_OPSM + 256 * 1024;
constexpr size_t WS_W2T   = WS_DL + 1 * MiB;
constexpr size_t WS_A2T   = WS_W2T + 64 * 1024;
constexpr size_t WS_G2T   = WS_A2T + 64 * 1024;
constexpr size_t WS_TILEE = WS_G2T + 128 * 1024;
constexpr size_t WS_SLOTTOK = WS_TILEE + 4096;
constexpr size_t WS_WIN   = 8 * MiB;
constexpr size_t WS_WOUT  = 15 * MiB;
static_assert(WS_SLOTTOK + 139264 * 4 <= WS_WIN, "table region");
constexpr size_t WS_A0    = 20 * MiB;
constexpr size_t WS_YMIX  = WS_A0;
constexpr size_t WS_PROJ  = 84 * MiB;
constexpr size_t WS_R1    = 308 * MiB;
constexpr size_t WS_GAM   = 520 * MiB;
constexpr size_t WS_GUS   = 692 * MiB;
constexpr size_t WS_H1    = 20 * MiB;
constexpr size_t WS_XS    = 84 * MiB;
constexpr size_t WS_YS    = WS_XS;
constexpr size_t WS_ACT   = 356 * MiB;
constexpr size_t WS_S1    = 628 * MiB;
constexpr size_t WS_WUP   = 758 * MiB;
constexpr size_t WS_WDN   = 886 * MiB;
constexpr size_t WS_END   = 950 * MiB;
constexpr int CW_BAR = 4096;
constexpr int CW_CNT = 16384;
constexpr int CW_QH = 20480;

constexpr int RING_BYTES = 131072;
constexpr int LDS_BYTES = 147456;
constexpr int TAB_OFF = 132096;
constexpr int MISC_OFF = LDS_BYTES - 512;

#define LAS __attribute__((address_space(3)))
typedef unsigned short bf16;
typedef unsigned v4u __attribute__((ext_vector_type(4)));
typedef unsigned v2u __attribute__((ext_vector_type(2)));
typedef float f32x4 __attribute__((ext_vector_type(4)));
typedef short bf16x8 __attribute__((ext_vector_type(8)));
#define LDS_WAIT() asm volatile("s_waitcnt lgkmcnt(0)" ::: "memory")
__device__ __forceinline__ float bflo(unsigned w) { return __uint_as_float(w << 16); }
__device__ __forceinline__ float bfhi(unsigned w) { return __uint_as_float(w & 0xffff0000u); }
__device__ __forceinline__ unsigned f2bf(float f) { unsigned u = __float_as_uint(f); return (u + 0x7fffu + ((u >> 16) & 1u)) >> 16; }
__device__ __forceinline__ unsigned pk2(float lo, float hi) { return f2bf(lo) | (f2bf(hi) << 16); }
__device__ __forceinline__ float wave_sum(float v) {
#pragma unroll
    for (int o = 1; o < 64; o <<= 1) v += __shfl_xor(v, o);
    return v;
}
__device__ __forceinline__ float softplus_f(float x) { return fmaxf(x, 0.f) + log1pf(expf(-fabsf(x))); }
__device__ __forceinline__ float logsigmoid_f(float x) { return fminf(x, 0.f) - log1pf(expf(-fabsf(x))); }
__device__ __forceinline__ float sigmoid_f(float x) { return 1.f / (1.f + expf(-x)); }
__device__ __forceinline__ float fexp(float x) { return __builtin_amdgcn_exp2f(x * 1.4426950408889634f); }
__device__ __forceinline__ float flog(float x) { return __builtin_amdgcn_logf(x) * 0.6931471805599453f; }
__device__ __forceinline__ float fsigmoid(float x) { return __builtin_amdgcn_rcpf(1.f + fexp(-x)); }
__device__ __forceinline__ float ftanh(float x) { return 2.f * fsigmoid(2.f * x) - 1.f; }
__device__ __forceinline__ float fsoftplus(float x) { return fmaxf(x, 0.f) + flog(1.f + fexp(-fabsf(x))); }
__device__ __forceinline__ float flogsigmoid(float x) { return fminf(x, 0.f) - flog(1.f + fexp(-fabsf(x))); }
template <int CTRL> __device__ __forceinline__ float dppf(float x) { return __int_as_float(__builtin_amdgcn_update_dpp(0, __float_as_int(x), CTRL, 0xF, 0xF, true)); }
__device__ __forceinline__ float red8(float x) {
    x += dppf<0xB1>(x); x += dppf<0x4E>(x); x += dppf<0x141>(x); return x;
}
__device__ __forceinline__ f32x4 mfma16(bf16x8 a, bf16x8 b, f32x4 c) { return __builtin_amdgcn_mfma_f32_16x16x32_bf16(a, b, c, 0, 0, 0); }
__device__ __forceinline__ unsigned ld_agent(const unsigned* p) { return __hip_atomic_load(p, __ATOMIC_RELAXED, __HIP_MEMORY_SCOPE_AGENT); }

#define XB_TMO      128
#define XB_XCNT(j)  (256  + 64 * (j))
#define XB_XSUB(j)  (1280 + 64 * (j))
#define XB_XGEN(j)  (2304 + 64 * (j))
#define XB_TOP      3328
#define XB_TOPGEN   3392
#define XCD_BAR_WORDS 3456
#define XB_SPIN_CAP (1u << 18)
__device__ __forceinline__ unsigned xb_ld(unsigned* p)              { return __hip_atomic_load(p, __ATOMIC_RELAXED, __HIP_MEMORY_SCOPE_AGENT); }
__device__ __forceinline__ unsigned xb_add(unsigned* p, unsigned v) { return __hip_atomic_fetch_add(p, v, __ATOMIC_RELAXED, __HIP_MEMORY_SCOPE_AGENT); }
__device__ __forceinline__ unsigned xb_xcc_id() { return (unsigned)__builtin_amdgcn_s_getreg((3 << 11) | 20) & 0xFu; }
#define XB_SPIN(cond, bar) do { unsigned _sp = 0; while (cond) { __builtin_amdgcn_s_sleep(1); \
    if ((++_sp & 255u) == 0u) { if (xb_ld(&(bar)[XB_TMO])) break; if (_sp > XB_SPIN_CAP) { atomicAdd(&(bar)[XB_TMO], 1u); break; } } } } while (0)
struct XcdBarrier { unsigned* bar; unsigned x; volatile LAS unsigned* st; };
__device__ __forceinline__ XcdBarrier xcd_barrier_post(unsigned* bar, volatile LAS unsigned* st, bool leader) {
    XcdBarrier b; b.bar = bar; b.x = xb_xcc_id(); b.st = st;
    if (leader) (void)xb_add(&bar[XB_XCNT(b.x)], 1u);
    return b;
}
__device__ __forceinline__ void xcd_barrier_complete(unsigned* bar, unsigned x, unsigned& nloc, unsigned& nx) {
    const unsigned G = gridDim.x * gridDim.y * gridDim.z;
    unsigned sum, cnt, mine, sp = 0u;
    for (;;) {
        sum = 0u; cnt = 0u; mine = 0u;
#pragma unroll
        for (unsigned j = 0; j < 16; ++j) { const unsigned c = xb_ld(&bar[XB_XCNT(j)]); sum += c; cnt += (c > 0u) ? 1u : 0u; mine = (j == x) ? c : mine; }
        if (sum == G) break;
        __builtin_amdgcn_s_sleep(1);
        if ((++sp & 255u) == 0u) { if (xb_ld(&bar[XB_TMO])) break; if (sp > XB_SPIN_CAP) { atomicAdd(&bar[XB_TMO], 1u); break; } }
    }
    nloc = mine > 0u ? mine : 1u; nx = cnt > 0u ? cnt : 1u;
}
__device__ __forceinline__ void xcd_barrier(const XcdBarrier& b, bool leader) {
    asm volatile("s_waitcnt vmcnt(0)" ::: "memory");
    __syncthreads();
    if (leader) {
        unsigned* bar = b.bar;
        __builtin_amdgcn_s_waitcnt(0);
        unsigned nloc = b.st[0], nx = b.st[1];
        if (nloc == 0u) { xcd_barrier_complete(bar, b.x, nloc, nx); b.st[0] = nloc; b.st[1] = nx; }
        const unsigned old = xb_add(&bar[XB_XSUB(b.x)], 1u);
        const unsigned gen = old / nloc;
        if (old + 1u == (gen + 1u) * nloc) {
            __builtin_amdgcn_fence(__ATOMIC_RELEASE, "agent");
            asm volatile("s_waitcnt vmcnt(0)" ::: "memory");
            const unsigned og = xb_add(&bar[XB_TOP], 1u);
            const unsigned tg = og / nx;
            if (og + 1u == (tg + 1u) * nx) xb_add(&bar[XB_TOPGEN], 1u);
            else XB_SPIN(xb_ld(&bar[XB_TOPGEN]) == tg, bar);
            __builtin_amdgcn_fence(__ATOMIC_ACQUIRE, "agent");
            xb_add(&bar[XB_XGEN(b.x)], 1u);
            asm volatile("s_waitcnt vmcnt(0)" ::: "memory");
        } else {
            XB_SPIN(xb_ld(&bar[XB_XGEN(b.x)]) == gen, bar);
            __builtin_amdgcn_fence(__ATOMIC_ACQUIRE, "agent");
            asm volatile("s_waitcnt vmcnt(0)" ::: "memory");
        }
    }
    __syncthreads();
}

struct Args { const float* in[30]; float* out; unsigned char* ws; };
enum { I_X = 0, I_META, I_LNIN_G, I_LNIN_B, I_WIN, I_GKW2, I_GKB, I_GNORM, I_MU, I_W0, I_W2, I_A0, I_A2, I_G2, I_KK, I_KA, I_RK, I_RLNG, I_RLNB, I_WOUT,
       I_LN1G, I_LN1B, I_RTW, I_RTB, I_WUP, I_BUP, I_WDN, I_BDN, I_LN2G, I_LN2B };
struct Frame { LAS unsigned char* lds; int tid, lane, wave, blk, G; };
__device__ __forceinline__ int lane_id() { int l = (int)__builtin_amdgcn_mbcnt_hi(~0u, __builtin_amdgcn_mbcnt_lo(~0u, 0u)); asm volatile("" : "+v"(l)); return l; }
__device__ __forceinline__ Frame mkframe(LAS unsigned char* lds, int wave) { Frame F; F.lds = lds; F.wave = wave; F.lane = lane_id(); F.tid = wave * 64 + F.lane; F.blk = blockIdx.x; F.G = gridDim.x; return F; }

__device__ __forceinline__ void transpose_item(const float* W, int K, int N, int nblk, bf16* WT, LAS float* scr, int item, int lane) {
    const int kb = item / nblk, nb = item - kb * nblk, k0 = 64 * kb, n0 = 32 * nb;
    const int nn = n0 + (lane & 31); const bool ok = nn < N;
#pragma unroll 8
    for (int i = 0; i < 32; ++i) { const int kk = 2 * i + (lane >> 5); scr[kk * 33 + (lane & 31)] = ok ? W[(size_t)(k0 + kk) * N + nn] : 0.f; }
    LDS_WAIT();
    const int c = lane & 7;
#pragma unroll
    for (int j = 0; j < 4; ++j) { const int n = (lane >> 3) + 8 * j; const LAS float* s = scr + (8 * c) * 33 + n;
        v4u o; o.x = pk2(s[0 * 33], s[1 * 33]); o.y = pk2(s[2 * 33], s[3 * 33]); o.z = pk2(s[4 * 33], s[5 * 33]); o.w = pk2(s[6 * 33], s[7 * 33]);
        *(v4u*)(WT + (size_t)(n0 + n) * K + k0 + 8 * c) = o; }
    LDS_WAIT();
}

__device__ __forceinline__ void transpose_item64(const float* W, int K, int N, bf16* WT, LAS float* scr, int item, int lane) {
    const int nblk = N >> 6, kb = item / nblk, nb = item - kb * nblk, k0 = 64 * kb, n0 = 64 * nb;
    const int r4 = lane >> 4, c4 = lane & 15;
    f32x4 v[16];
#pragma unroll
    for (int i = 0; i < 16; ++i) v[i] = *(const f32x4*)(W + (size_t)(k0 + 4 * i + r4) * N + n0 + 4 * c4);
#pragma unroll
    for (int i = 0; i < 16; ++i) *(LAS f32x4*)(scr + (4 * i + r4) * 68 + 4 * c4) = v[i];
    LDS_WAIT();
    bf16* orow = WT + (size_t)(n0 + lane) * K + k0;
#pragma unroll
    for (int g = 0; g < 8; ++g) { const LAS float* s = scr + (8 * g) * 68 + lane;
        v4u o; o.x = pk2(s[0 * 68], s[1 * 68]); o.y = pk2(s[2 * 68], s[3 * 68]); o.z = pk2(s[4 * 68], s[5 * 68]); o.w = pk2(s[6 * 68], s[7 * 68]);
        *(v4u*)(orow + 8 * g) = o; }
    LDS_WAIT();
}
__device__ __forceinline__ void convert_expert_weights(const Args& a, const Frame& F) {
    unsigned char* ws = a.ws;
    LAS float* scr = (LAS float*)(F.lds + F.wave * 17408);
    unsigned* QH = (unsigned*)(ws + WS_CTL) + CW_QH;
    constexpr int I_UP = 16 * 32, I_DN = 16 * 16, NIT = NE * (I_UP + I_DN);
    for (;;) {
        unsigned base = 0;
        if (F.lane == 0) base = __hip_atomic_fetch_add(QH, 8u, __ATOMIC_RELAXED, __HIP_MEMORY_SCOPE_AGENT);
        base = (unsigned)__builtin_amdgcn_readfirstlane((int)base);
        if (base >= (unsigned)NIT) break;
        for (int it = (int)base; it < (int)base + 8; ++it) {
            if (it < NE * I_UP) { const int e = it / I_UP, r = it - e * I_UP;
                transpose_item64(a.in[I_WUP] + (size_t)e * D * 2048, D, 2048, (bf16*)(ws + WS_WUP) + (size_t)e * 2048 * D, scr, r, F.lane); }
            else { const int it2 = it - NE * I_UP, e = it2 / I_DN, r = it2 - e * I_DN;
                transpose_item64(a.in[I_WDN] + (size_t)e * D * D, D, D, (bf16*)(ws + WS_WDN) + (size_t)e * D * D, scr, r, F.lane); }
        }
    }
}

__device__ __forceinline__ void phase0(const Args& a, const Frame& F) {
    unsigned char* ws = a.ws;
    const int gw = F.blk * NWAVES + F.wave, NGW = F.G * NWAVES;
    for (int cgp = F.blk; cgp < 53; cgp += F.G) {
        LAS float* HM = (LAS float*)F.lds;
        LAS float* PART = (LAS float*)(F.lds + 65536);
        for (int rr = 0; rr < 2; ++rr) {
            const int row = 2 * F.wave + rr; const f32x4* xr = (const f32x4*)(a.in[I_META] + row * D) + F.lane;
            f32x4 v[4]; float s = 0.f;
#pragma unroll
            for (int j = 0; j < 4; ++j) { v[j] = xr[64 * j]; s += (v[j].x + v[j].y) + (v[j].z + v[j].w); }
            const float mean = wave_sum(s) * (1.f / D); float s2 = 0.f;
#pragma unroll
            for (int j = 0; j < 4; ++j) { v[j] = v[j] - mean; s2 += (v[j].x * v[j].x + v[j].y * v[j].y) + (v[j].z * v[j].z + v[j].w * v[j].w); }
            const float rstd = 1.f / sqrtf(wave_sum(s2) * (1.f / D) + 1e-5f);
#pragma unroll
            for (int j = 0; j < 4; ++j) { const int col = 4 * (F.lane + 64 * j);
                const f32x4 gv = *(const f32x4*)(a.in[I_LNIN_G] + col), bv = *(const f32x4*)(a.in[I_LNIN_B] + col);
                const f32x4 y = v[j] * rstd * gv + bv;
                HM[(col + 0) * 16 + row] = y.x; HM[(col + 1) * 16 + row] = y.y; HM[(col + 2) * 16 + row] = y.z; HM[(col + 3) * 16 + row] = y.w; }
        }
        __syncthreads();
        const int col = cgp * 64 + F.lane; const bool ok = col < INW;
        float acc[16];
#pragma unroll
        for (int r = 0; r < 16; ++r) acc[r] = 0.f;
        const float* wp = a.in[I_WIN];
        for (int k = F.wave * 128; k < F.wave * 128 + 128; ++k) {
            const float wv = ok ? wp[(size_t)k * INW + col] : 0.f;
            const LAS f32x4* h = (const LAS f32x4*)(HM + k * 16);
#pragma unroll
            for (int q = 0; q < 4; ++q) { const f32x4 hv = h[q]; acc[4 * q + 0] += hv.x * wv; acc[4 * q + 1] += hv.y * wv; acc[4 * q + 2] += hv.z * wv; acc[4 * q + 3] += hv.w * wv; }
        }
#pragma unroll
        for (int r = 0; r < 16; ++r) PART[(F.wave * 16 + r) * 64 + F.lane] = acc[r];
        __syncthreads();
        bf16* PROJM = (bf16*)(ws + WS_PROJM);
        for (int o = F.tid; o < 1024; o += NTHR) { const int r = o >> 6, l = o & 63; float s = 0.f;
#pragma unroll
            for (int w = 0; w < 8; ++w) s += PART[(w * 16 + r) * 64 + l];
            PROJM[r * PW + cgp * 64 + l] = (bf16)f2bf(s); }
        if (F.tid < 64) PROJM[NMETA * PW + cgp * 64 + F.tid] = 0;
        __syncthreads();
    }
    {
        LAS float* scr = (LAS float*)(F.lds + F.wave * 16384);
        constexpr int I_IN = 16 * (PW / 32), I_OUT = 16 * 32;
        for (int it = gw; it < I_IN + I_OUT; it += NGW) {
            if (it < I_IN) transpose_item(a.in[I_WIN], D, INW, PW / 32, (bf16*)(ws + WS_WIN), scr, it, F.lane);
            else transpose_item(a.in[I_WOUT], D, D, 32, (bf16*)(ws + WS_WOUT), scr, it - I_IN, F.lane);
        }
    }
    {
        bf16* W2T = (bf16*)(ws + WS_W2T); bf16* A2T = (bf16*)(ws + WS_A2T); bf16* G2T = (bf16*)(ws + WS_G2T);
        for (int i = F.blk * NTHR + F.tid; i < 131072; i += F.G * NTHR) {
            if (i < 32768) { const int n = i >> 6, k = i & 63; W2T[i] = (bf16)f2bf(a.in[I_W2][k * 512 + n]); }
            else if (i < 65536) { const int j = i - 32768, n = j >> 6, k = j & 63; A2T[j] = (bf16)f2bf(a.in[I_A2][k * 512 + n]); }
            else { const int j = i - 65536, n = j >> 7, k = j & 127; G2T[j] = (bf16)f2bf(a.in[I_G2][k * 512 + n]); }
        }
    }
    {
        bf16* A0 = (bf16*)(ws + WS_A0); float* ST = (float*)(ws + WS_STATS);
        for (int m = gw; m < MX; m += NGW) {
            const f32x4* xr = (const f32x4*)(a.in[I_X] + (size_t)m * D) + F.lane;
            f32x4 v[4]; float s = 0.f;
#pragma unroll
            for (int j = 0; j < 4; ++j) { v[j] = xr[64 * j]; s += (v[j].x + v[j].y) + (v[j].z + v[j].w); }
            const float mean = wave_sum(s) * (1.f / D); float s2 = 0.f;
#pragma unroll
            for (int j = 0; j < 4; ++j) { v[j] = v[j] - mean; s2 += (v[j].x * v[j].x + v[j].y * v[j].y) + (v[j].z * v[j].z + v[j].w * v[j].w); }
            const float rstd = 1.f / sqrtf(wave_sum(s2) * (1.f / D) + 1e-5f);
#pragma unroll
            for (int j = 0; j < 4; ++j) { const int col = 4 * (F.lane + 64 * j);
                const f32x4 gv = *(const f32x4*)(a.in[I_LNIN_G] + col), bv = *(const f32x4*)(a.in[I_LNIN_B] + col);
                const f32x4 y = v[j] * rstd * gv + bv;
                v2u o; o.x = pk2(y.x, y.y); o.y = pk2(y.z, y.w);
                *(v2u*)(A0 + (size_t)m * D + col) = o; }
            if (F.lane == 0) { ST[2 * m] = mean; ST[2 * m + 1] = rstd; }
        }
    }
}

__device__ __forceinline__ const bf16* prow(const bf16* PROJ, const bf16* PROJM, int b, int vp) {
    const bf16* px = PROJ + (size_t)(b * SEQ + (vp >= NMETA ? vp - NMETA : 0)) * PW;
    const bf16* pm = PROJM + (size_t)(vp < 0 ? NMETA : (vp < NMETA ? vp : 0)) * PW;
    return vp >= NMETA ? px : pm;
}
__device__ __forceinline__ f32x4 ldp4(const bf16* PROJ, const bf16* PROJM, int b, int vp, int col) {
    const v2u w = *(const v2u*)(prow(PROJ, PROJM, b, vp) + col);
    return (f32x4){bflo(w.x), bfhi(w.x), bflo(w.y), bfhi(w.y)};
}

constexpr int R1_STRIDE = 49152;
constexpr int TP = 80;
constexpr int L1_SLOT = 64 * TP * 2;
constexpr int L1_LC = 12 * L1_SLOT;
constexpr int L1_XCH = L1_LC + 64 * 65 * 4;
constexpr int L1_LR = 8 * L1_SLOT;
__device__ __forceinline__ v2u pack4(f32x4 v) { v2u o; o.x = pk2(v[0], v[1]); o.y = pk2(v[2], v[3]); return o; }
__device__ __forceinline__ f32x4 tile_mm(const LAS bf16* A, const LAS bf16* Bt, int rt, int ct, int fr, int fq, f32x4 acc) {
#pragma unroll
    for (int ks = 0; ks < 2; ++ks)
        acc = mfma16(*(const LAS bf16x8*)(Bt + (ct * 16 + fr) * TP + ks * 32 + 8 * fq), *(const LAS bf16x8*)(A + (rt * 16 + fr) * TP + ks * 32 + 8 * fq), acc);
    return acc;
}
__device__ __forceinline__ void tile_st(LAS bf16* O, int rt, int ct, int fr, int fq, f32x4 v) { *(LAS v2u*)(O + (rt * 16 + fr) * TP + ct * 16 + 4 * fq) = pack4(v); }
#define L1S(n) ((LAS bf16*)(F.lds + (n) * L1_SLOT))

__device__ __forceinline__ void rwkv_l1_unit(const Args& a, const Frame& F, int b, int h, int c) {
    unsigned char* ws = a.ws;
    const bf16* PROJ = (const bf16*)(ws + WS_PROJ); const bf16* PROJM = (const bf16*)(ws + WS_PROJM);
    const bf16* W2T = (const bf16*)(ws + WS_W2T); const bf16* A2T = (const bf16*)(ws + WS_A2T); const bf16* G2T = (const bf16*)(ws + WS_G2T);
    const int unit = (b * 8 + h) * NCH + c;
    unsigned char* r1 = ws + WS_R1 + (size_t)unit * R1_STRIDE;
    float* GAM = (float*)(ws + WS_GAM) + (size_t)unit * 64;
    const float* mu = a.in[I_MU];
    const int vp0 = (c == 0) ? -48 : NMETA + 64 * (c - 1);
    constexpr int LRP = 264;
    LAS bf16* LR = (LAS bf16*)(F.lds + L1_LR);
    LAS float* LC = (LAS float*)(F.lds + L1_LC);
    LAS float* XCH = (LAS float*)(F.lds + L1_XCH);
    {
        const int cg = F.tid & 31, tr = F.tid >> 5;
        const int col = RWL + 8 * cg;
        const f32x4 m0 = *(const f32x4*)(mu + 1536 + 8 * cg), m1 = *(const f32x4*)(mu + 1536 + 8 * cg + 4);
#pragma unroll
        for (int i = 0; i < 4; ++i) {
            const int row = 4 * tr + i, vp = vp0 + row;
            const f32x4 c0 = ldp4(PROJ, PROJM, b, vp, col), c1 = ldp4(PROJ, PROJM, b, vp, col + 4);
            const f32x4 p0 = ldp4(PROJ, PROJM, b, vp - 1, col), p1 = ldp4(PROJ, PROJM, b, vp - 1, col + 4);
            float v[8];
            v[0] = c0.x + (p0.x - c0.x) * m0.x; v[1] = c0.y + (p0.y - c0.y) * m0.y; v[2] = c0.z + (p0.z - c0.z) * m0.z; v[3] = c0.w + (p0.w - c0.w) * m0.w;
            v[4] = c1.x + (p1.x - c1.x) * m1.x; v[5] = c1.y + (p1.y - c1.y) * m1.y; v[6] = c1.z + (p1.z - c1.z) * m1.z; v[7] = c1.w + (p1.w - c1.w) * m1.w;
#pragma unroll
            for (int q = 0; q < 8; ++q) { if (cg < 8) v[q] = ftanh(v[q]); else if (cg >= 16) v[q] = fsigmoid(v[q]); }
            v4u o; o.x = pk2(v[0], v[1]); o.y = pk2(v[2], v[3]); o.z = pk2(v[4], v[5]); o.w = pk2(v[6], v[7]);
            *(LAS v4u*)(LR + row * LRP + 8 * cg) = o;
        }
    }
    __syncthreads();
    const int rt = F.wave & 3, cp = F.wave >> 2, fr = F.lane & 15, fq = F.lane >> 4;
    const int t = rt * 16 + fr, vp = vp0 + t;
    const bool valid = vp >= 0;
    float lwv[2][4], asg[2][4], kkr[2][4], kmd[2][4], rrv[2][4], vvv[2][4];
    float ssq = 0.f, bon = 0.f;
    {
        const LAS bf16* lrow = LR + t * LRP + 8 * fq;
#pragma unroll
        for (int cc = 0; cc < 2; ++cc) {
            const int ct = 2 * cp + cc, j = ct * 16 + 4 * fq, jc = h * 64 + j, n = h * 64 + ct * 16 + fr;
            f32x4 aw = {0.f, 0.f, 0.f, 0.f}, aa = aw, ag = aw;
#pragma unroll
            for (int ks = 0; ks < 2; ++ks) {
                aw = mfma16(*(const bf16x8*)(W2T + (size_t)n * 64 + ks * 32 + 8 * fq), *(const LAS bf16x8*)(lrow + ks * 32), aw);
                aa = mfma16(*(const bf16x8*)(A2T + (size_t)n * 64 + ks * 32 + 8 * fq), *(const LAS bf16x8*)(lrow + 64 + ks * 32), aa);
            }
#pragma unroll
            for (int ks = 0; ks < 4; ++ks)
                ag = mfma16(*(const bf16x8*)(G2T + (size_t)n * 128 + ks * 32 + 8 * fq), *(const LAS bf16x8*)(lrow + 128 + ks * 32), ag);
            const f32x4 rc = ldp4(PROJ, PROJM, b, vp, RR + jc), rp = ldp4(PROJ, PROJM, b, vp - 1, RR + jc), mr = *(const f32x4*)(mu + jc);
            const f32x4 kc = ldp4(PROJ, PROJM, b, vp, RK + jc), kp = ldp4(PROJ, PROJM, b, vp - 1, RK + jc), mk = *(const f32x4*)(mu + 512 + jc);
            const f32x4 vc = ldp4(PROJ, PROJM, b, vp, RV + jc), vpv = ldp4(PROJ, PROJM, b, vp - 1, RV + jc), mv = *(const f32x4*)(mu + 1024 + jc);
            const f32x4 rs = rc + (rp - rc) * mr, ks_ = kc + (kp - kc) * mk, vs = vc + (vpv - vc) * mv;
            const f32x4 w0v = *(const f32x4*)(a.in[I_W0] + jc), a0v = *(const f32x4*)(a.in[I_A0] + jc);
            const f32x4 kkw = *(const f32x4*)(a.in[I_KK] + jc), kaw = *(const f32x4*)(a.in[I_KA] + jc), rkw = *(const f32x4*)(a.in[I_RK] + jc);
#pragma unroll
            for (int i = 0; i < 4; ++i) {
                const float u = w0v[i] + aw[i];
                const float wl = -fsoftplus(-u) - 0.5f;
                lwv[cc][i] = valid ? -fexp(wl) : 0.f;
                const float as_ = fsigmoid(a0v[i] + aa[i]);
                asg[cc][i] = as_;
                const float kraw = ks_[i], kk = kraw * kkw[i];
                kkr[cc][i] = kk; ssq += kk * kk;
                const float km = kraw * (1.f + (as_ - 1.f) * kaw[i]);
                kmd[cc][i] = km; rrv[cc][i] = rs[i]; vvv[cc][i] = vs[i];
                bon += rs[i] * km * rkw[i];
                LC[t * 65 + j + i] = lwv[cc][i];
            }
            *(v2u*)(r1 + 4 * 8192 + (size_t)(t * 64 + j) * 2) = pack4(ag);
        }
        ssq += __shfl_xor(ssq, 16); ssq += __shfl_xor(ssq, 32);
        bon += __shfl_xor(bon, 16); bon += __shfl_xor(bon, 32);
        if (fq == 0) { XCH[(cp * 64 + t) * 2] = ssq; XCH[(cp * 64 + t) * 2 + 1] = bon; }
    }
    __syncthreads();
    const float ssq_t = XCH[t * 2] + XCH[(64 + t) * 2], bon_t = XCH[t * 2 + 1] + XCH[(64 + t) * 2 + 1];
    const float inv = 1.f / fmaxf(sqrtf(ssq_t), 1e-12f);
    {
        LAS float* SEG = XCH + 256;
        const int jj = F.tid & 63, sg = F.tid >> 6;
        float cv[8];
#pragma unroll
        for (int i = 0; i < 8; ++i) cv[i] = LC[(sg * 8 + i) * 65 + jj];
#pragma unroll
        for (int i = 1; i < 8; ++i) cv[i] += cv[i - 1];
        SEG[sg * 64 + jj] = cv[7];
        __syncthreads();
        float pre = 0.f;
#pragma unroll
        for (int s2 = 0; s2 < 7; ++s2) pre += (s2 < sg) ? SEG[s2 * 64 + jj] : 0.f;
#pragma unroll
        for (int i = 0; i < 8; ++i) LC[(sg * 8 + i) * 65 + jj] = cv[i] + pre;
    }
    __syncthreads();
    f32x4 rtil[2];
    {
#pragma unroll
        for (int cc = 0; cc < 2; ++cc) {
            const int j = (2 * cp + cc) * 16 + 4 * fq;
            f32x4 At, Bt, Kt, Bh, Kh, bvv;
#pragma unroll
            for (int i = 0; i < 4; ++i) {
                const float Lc = LC[t * 65 + j + i], LcC = LC[63 * 65 + j + i];
                const float kn = kkr[cc][i] * inv, av = -kn, bv = kn * asg[cc][i], km = kmd[cc][i];
                const float eA = fexp(Lc - lwv[cc][i]), eR = fexp(Lc), eB = fexp(-Lc), eH = fexp(LcC - Lc);
                At[i] = av * eA; rtil[cc][i] = rrv[cc][i] * eR; Bt[i] = bv * eB; Kt[i] = km * eB; Bh[i] = bv * eH; Kh[i] = km * eH;
                bvv[i] = bon_t * vvv[cc][i];
                if (t == 63) GAM[j + i] = fexp(LcC);
            }
            *(LAS v2u*)(L1S(0) + t * TP + j) = pack4(Bt); *(LAS v2u*)(L1S(1) + t * TP + j) = pack4(Kt);
            *(LAS v2u*)(L1S(2) + t * TP + j) = pack4(At); *(LAS v2u*)(L1S(3) + t * TP + j) = pack4(rtil[cc]);
#pragma unroll
            for (int i = 0; i < 4; ++i) {
                L1S(4)[(j + i) * TP + t] = (bf16)f2bf(At[i]); L1S(5)[(j + i) * TP + t] = (bf16)f2bf(Bh[i]);
                L1S(6)[(j + i) * TP + t] = (bf16)f2bf(Kh[i]); L1S(7)[(j + i) * TP + t] = (bf16)f2bf(vvv[cc][i]);
            }
            *(v2u*)(r1 + 5 * 8192 + (size_t)(t * 64 + j) * 2) = pack4(bvv);
        }
    }
    __syncthreads();
    f32x4 Pt[2];
    const int mrow = rt * 16 + fr;
#pragma unroll
    for (int cc = 0; cc < 2; ++cc) {
        const int ct = 2 * cp + cc, n0 = ct * 16 + 4 * fq;
        const f32x4 z = {0.f, 0.f, 0.f, 0.f};
        f32x4 Lv = tile_mm(L1S(2), L1S(0), rt, ct, fr, fq, z), Nv = tile_mm(L1S(0), L1S(2), rt, ct, fr, fq, z), Mv = tile_mm(L1S(1), L1S(2), rt, ct, fr, fq, z);
        f32x4 Bv = tile_mm(L1S(3), L1S(0), rt, ct, fr, fq, z), Kv = tile_mm(L1S(3), L1S(1), rt, ct, fr, fq, z);
#pragma unroll
        for (int i = 0; i < 4; ++i) { const int n = n0 + i;
            if (!(n < mrow)) Lv[i] = 0.f; if (!(mrow < n)) { Nv[i] = 0.f; Mv[i] = 0.f; } if (!(n <= mrow)) { Bv[i] = 0.f; Kv[i] = 0.f; }
            Pt[cc][i] = Lv[i] + ((n == mrow) ? 1.f : 0.f); }
        tile_st(L1S(8), rt, ct, fr, fq, Lv); tile_st(L1S(9), rt, ct, fr, fq, Nv); tile_st(L1S(10), rt, ct, fr, fq, Mv);
        tile_st(L1S(11), rt, ct, fr, fq, Bv); tile_st(L1S(12), rt, ct, fr, fq, Kv);
    }
    __syncthreads();
#pragma unroll
    for (int st = 1; st <= 5; ++st) {
        LAS bf16* Xl = (st & 1) ? L1S(8) : L1S(0); LAS bf16* Xn = (st & 1) ? L1S(9) : L1S(1);
        LAS bf16* Yl = (st & 1) ? L1S(0) : L1S(8); LAS bf16* Yn = (st & 1) ? L1S(1) : L1S(9);
        const f32x4 z = {0.f, 0.f, 0.f, 0.f};
#pragma unroll
        for (int cc = 0; cc < 2; ++cc) { const int ct = 2 * cp + cc;
            tile_st(Yl, rt, ct, fr, fq, tile_mm(Xl, Xn, rt, ct, fr, fq, z)); tile_st(Yn, rt, ct, fr, fq, tile_mm(Xn, Xl, rt, ct, fr, fq, z));
            tile_st(L1S(2), rt, ct, fr, fq, Pt[cc]); }
        __syncthreads();
#pragma unroll
        for (int cc = 0; cc < 2; ++cc) Pt[cc] = tile_mm(L1S(2), Yn, rt, 2 * cp + cc, fr, fq, Pt[cc]);
        __syncthreads();
    }
#pragma unroll
    for (int cc = 0; cc < 2; ++cc) tile_st(L1S(2), rt, 2 * cp + cc, fr, fq, Pt[cc]);
    __syncthreads();
    {
        const f32x4 z = {0.f, 0.f, 0.f, 0.f};
#pragma unroll
        for (int cc = 0; cc < 2; ++cc) { const int ct = 2 * cp + cc;
            tile_st(L1S(8), rt, ct, fr, fq, tile_mm(L1S(2), L1S(10), rt, ct, fr, fq, z)); tile_st(L1S(9), rt, ct, fr, fq, tile_mm(L1S(4), L1S(2), rt, ct, fr, fq, z)); }
    }
    __syncthreads();
    {
        const f32x4 z = {0.f, 0.f, 0.f, 0.f};
#pragma unroll
        for (int cc = 0; cc < 2; ++cc) { const int ct = 2 * cp + cc; tile_st(L1S(0), rt, ct, fr, fq, tile_mm(L1S(7), L1S(8), rt, ct, fr, fq, z)); }
    }
    __syncthreads();
    {
        const f32x4 z = {0.f, 0.f, 0.f, 0.f};
#pragma unroll
        for (int cc = 0; cc < 2; ++cc) { const int ct = 2 * cp + cc; const size_t eo = (size_t)(mrow * 64 + ct * 16 + 4 * fq) * 2;
            const f32x4 gp = tile_mm(L1S(5), L1S(9), rt, ct, fr, fq, z);
            const f32x4 hh = tile_mm(L1S(7), L1S(6), rt, ct, fr, fq, tile_mm(L1S(0), L1S(5), rt, ct, fr, fq, z));
            const f32x4 rh = tile_mm(L1S(11), L1S(9), rt, ct, fr, fq, rtil[cc]);
            const f32x4 yl = tile_mm(L1S(12), L1S(7), rt, ct, fr, fq, tile_mm(L1S(11), L1S(0), rt, ct, fr, fq, z));
            *(v2u*)(r1 + 0 * 8192 + eo) = pack4(gp); *(v2u*)(r1 + 1 * 8192 + eo) = pack4(hh);
            *(v2u*)(r1 + 2 * 8192 + eo) = pack4(rh); *(v2u*)(r1 + 3 * 8192 + eo) = pack4(yl); }
    }
    __syncthreads();
}

constexpr int BCP = 65;
__device__ __forceinline__ void gla_bc(const Args& a, const Frame& F, int b, int h, int vp0, int ntok) {
    const bf16* PROJ = (const bf16*)(a.ws + WS_PROJ); const bf16* PROJM = (const bf16*)(a.ws + WS_PROJM);
    LAS float* GKLs = (LAS float*)F.lds; LAS float* BC = (LAS float*)(F.lds + 4096);
    if (F.tid < 256) { const int t = F.tid >> 2, q = F.tid & 3;
        const f32x4 v = ldp4(PROJ, PROJM, b, (t < ntok) ? vp0 + t : -1, GKL + 4 * q);
        *(LAS f32x4*)(GKLs + t * 16 + 4 * q) = v; }
    __syncthreads();
    {
        const int d = F.tid & 63, tg = F.tid >> 6;
        float wc[16];
#pragma unroll
        for (int r = 0; r < 16; ++r) wc[r] = a.in[I_GKW2][r * 256 + h * 64 + d];
        const float gb = a.in[I_GKB][h * 64 + d];
#pragma unroll
        for (int i = 0; i < 8; ++i) { const int t = tg * 8 + i; float z = gb;
            const LAS f32x4* g4 = (const LAS f32x4*)(GKLs + t * 16);
#pragma unroll
            for (int q = 0; q < 4; ++q) { const f32x4 gv = g4[q]; z += gv.x * wc[4 * q] + gv.y * wc[4 * q + 1] + gv.z * wc[4 * q + 2] + gv.w * wc[4 * q + 3]; }
            BC[t * BCP + d] = (t < ntok) ? flogsigmoid(z) * (1.f / 16.f) : 0.f; }
    }
    __syncthreads();
    if (F.tid < 64) { float run = 0.f;
#pragma unroll 8
        for (int t = 0; t < 64; ++t) { run += BC[t * BCP + F.tid]; BC[t * BCP + F.tid] = run; } }
    __syncthreads();
}

__device__ __forceinline__ void gla_g1_unit(const Args& a, const Frame& F, int b, int h, int c) {
    const bf16* PROJ = (const bf16*)(a.ws + WS_PROJ); const bf16* PROJM = (const bf16*)(a.ws + WS_PROJM);
    float* GUS = (float*)(a.ws + WS_GUS); float* DL = (float*)(a.ws + WS_DL);
    const int ntok = (c == 0) ? NMETA : 64, vp0 = (c == 0) ? 0 : NMETA + 64 * (c - 1);
    gla_bc(a, F, b, h, vp0, ntok);
    LAS float* BC = (LAS float*)(F.lds + 4096);
    LAS bf16* KT = (LAS bf16*)(F.lds + 24576);
    LAS bf16* VT = (LAS bf16*)(F.lds + 24576 + 64 * TP * 2);
    {
        const int t = F.tid >> 3, q = F.tid & 7;
        const float* bl = nullptr; (void)bl;
#pragma unroll
        for (int half = 0; half < 2; ++half) {
            const int d0 = 8 * q + 4 * half;
            const f32x4 kv = ldp4(PROJ, PROJM, b, (t < ntok) ? vp0 + t : -1, GK + h * 64 + d0);
#pragma unroll
            for (int i = 0; i < 4; ++i) { const int d = d0 + i; const float e = (t < ntok) ? fexp(BC[(ntok - 1) * BCP + d] - BC[t * BCP + d]) : 0.f;
                KT[d * TP + t] = (bf16)f2bf(kv[i] * e); }
        }
#pragma unroll
        for (int qq = 0; qq < 4; ++qq) {
            const int e0 = 16 * q + 4 * qq;
            const f32x4 vv = ldp4(PROJ, PROJM, b, (t < ntok) ? vp0 + t : -1, GV + h * 128 + e0);
#pragma unroll
            for (int i = 0; i < 4; ++i) VT[(e0 + i) * TP + t] = (bf16)f2bf(vv[i]);
        }
    }
    __syncthreads();
    {
        const int rt = F.wave & 3, ch = F.wave >> 2, fr = F.lane & 15, fq = F.lane >> 4;
        float* up = GUS + ((size_t)((b * 4 + h) * NCH + c) * 64 + rt * 16 + fr) * 128;
#pragma unroll
        for (int cc = 0; cc < 4; ++cc) { const int ct = ch * 4 + cc;
            f32x4 acc = {0.f, 0.f, 0.f, 0.f};
#pragma unroll
            for (int ks = 0; ks < 2; ++ks)
                acc = mfma16(*(const LAS bf16x8*)(VT + (ct * 16 + fr) * TP + ks * 32 + 8 * fq), *(const LAS bf16x8*)(KT + (rt * 16 + fr) * TP + ks * 32 + 8 * fq), acc);
            *(f32x4*)(up + ct * 16 + 4 * fq) = acc; }
        if (F.tid < 64) DL[(size_t)((b * 4 + h) * NCH + c) * 64 + F.tid] = fexp(BC[(ntok - 1) * BCP + F.tid]);
    }
    __syncthreads();
}

__device__ __forceinline__ void phase2(const Args& a, const Frame& F) {
    for (int u = F.blk; u < NB * 8 * NCH; u += F.G) { const int c = u % NCH, bh = u / NCH; rwkv_l1_unit(a, F, bh >> 3, bh & 7, c); }
    for (int u = F.blk; u < NB * 4 * 32; u += F.G) { const int c = u & 31, bh = u >> 5; gla_g1_unit(a, F, bh >> 2, bh & 3, c); }
}

__device__ __forceinline__ void rwkv_l2_unit(const Args& a, const Frame& F, int bh) {
    unsigned char* ws = a.ws;
    const int b = bh >> 3, h = bh & 7;
    LAS bf16* Sb0 = (LAS bf16*)F.lds; LAS bf16* Sb1 = Sb0 + 64 * TP;
    const int fr = F.lane & 15, fq = F.lane >> 4;
    const int rt = F.wave & 3;
    const int row = rt * 16 + fr;
    const unsigned char* r1b = ws + WS_R1 + (size_t)bh * NCH * R1_STRIDE + (size_t)(row * 64 + 4 * fq) * 2;
    if (F.wave < 4) {
        bf16* yout = (bf16*)(ws + WS_YMIX) + ((size_t)b * SEQ + row) * D + 512 + h * 64 + 4 * fq;
        f32x4 lg[4], lb[4];
#pragma unroll
        for (int ct = 0; ct < 4; ++ct) { lg[ct] = *(const f32x4*)(a.in[I_RLNG] + h * 64 + ct * 16 + 4 * fq); lb[ct] = *(const f32x4*)(a.in[I_RLNB] + h * 64 + ct * 16 + 4 * fq); }
        bf16x8 fa0, fa1; v2u q0[4], q1[4], q2[4];
#define Y_FETCH(cn) do { const unsigned char* r1 = r1b + (size_t)(cn) * R1_STRIDE; \
            fa0 = *(const bf16x8*)(r1 + 2 * 8192 + 8 * fq); fa1 = *(const bf16x8*)(r1 + 2 * 8192 + 64 + 8 * fq); \
            _Pragma("unroll") for (int ct = 0; ct < 4; ++ct) { q0[ct] = *(const v2u*)(r1 + 3 * 8192 + ct * 32); q1[ct] = *(const v2u*)(r1 + 4 * 8192 + ct * 32); q2[ct] = *(const v2u*)(r1 + 5 * 8192 + ct * 32); } } while (0)
        Y_FETCH(1);
        __syncthreads();
        __syncthreads();
#pragma nounroll
        for (int c = 1; c < NCH; ++c) {
            const LAS bf16* Sc = (c & 1) ? Sb1 : Sb0;
            const bf16x8 af0 = fa0, af1 = fa1; v2u yl[4], gw[4], bw[4];
#pragma unroll
            for (int ct = 0; ct < 4; ++ct) { yl[ct] = q0[ct]; gw[ct] = q1[ct]; bw[ct] = q2[ct]; }
            if (c + 1 < NCH) Y_FETCH(c + 1);
            f32x4 y[4]; float s = 0.f;
#pragma unroll
            for (int ct = 0; ct < 4; ++ct) {
                f32x4 acc = {bflo(yl[ct].x), bfhi(yl[ct].x), bflo(yl[ct].y), bfhi(yl[ct].y)};
                acc = mfma16(*(const LAS bf16x8*)(Sc + (ct * 16 + fr) * TP + 8 * fq), af0, acc);
                acc = mfma16(*(const LAS bf16x8*)(Sc + (ct * 16 + fr) * TP + 32 + 8 * fq), af1, acc);
                y[ct] = acc; s += (acc[0] + acc[1]) + (acc[2] + acc[3]);
            }
            s += __shfl_xor(s, 16); s += __shfl_xor(s, 32);
            const float mean = s * (1.f / 64.f); float q = 0.f;
#pragma unroll
            for (int ct = 0; ct < 4; ++ct) { y[ct] = y[ct] - mean; q += (y[ct][0] * y[ct][0] + y[ct][1] * y[ct][1]) + (y[ct][2] * y[ct][2] + y[ct][3] * y[ct][3]); }
            q += __shfl_xor(q, 16); q += __shfl_xor(q, 32);
            const float rstd = 1.f / sqrtf(q * (1.f / 64.f) + 64e-5f);
#pragma unroll
            for (int ct = 0; ct < 4; ++ct) {
                const f32x4 g = {bflo(gw[ct].x), bfhi(gw[ct].x), bflo(gw[ct].y), bfhi(gw[ct].y)}, bv = {bflo(bw[ct].x), bfhi(bw[ct].x), bflo(bw[ct].y), bfhi(bw[ct].y)};
                const f32x4 o = (y[ct] * rstd * lg[ct] + lb[ct] + bv) * g;
                *(v2u*)(yout + ct * 16) = pack4(o); }
            yout += (size_t)64 * D;
            __syncthreads();
        }
#undef Y_FETCH
    } else {
        f32x4 Sm[4];
#pragma unroll
        for (int ct = 0; ct < 4; ++ct) { Sm[ct] = (f32x4){0.f, 0.f, 0.f, 0.f}; *(LAS v2u*)(Sb0 + row * TP + ct * 16 + 4 * fq) = (v2u){0u, 0u}; }
        const float* gamb = (const float*)(ws + WS_GAM) + (size_t)bh * NCH * 64 + 4 * fq;
        const unsigned char* gpb = ws + WS_R1 + (size_t)bh * NCH * R1_STRIDE + (size_t)(fr * 64 + 8 * fq) * 2;
        bf16x8 fg[8]; v2u hq[4]; f32x4 gm[4];
#define S_FETCH(cn) do { const unsigned char* r1 = r1b + (size_t)(cn) * R1_STRIDE; const unsigned char* gp = gpb + (size_t)(cn) * R1_STRIDE; \
            _Pragma("unroll") for (int ct = 0; ct < 4; ++ct) { fg[2 * ct] = *(const bf16x8*)(gp + ct * 2048); fg[2 * ct + 1] = *(const bf16x8*)(gp + ct * 2048 + 64); \
                hq[ct] = *(const v2u*)(r1 + 8192 + ct * 32); gm[ct] = *(const f32x4*)(gamb + (size_t)(cn) * 64 + ct * 16); } } while (0)
        S_FETCH(0);
        __syncthreads();
#pragma nounroll
        for (int c = 0; c < NCH - 1; ++c) {
            const LAS bf16* Sc = (c & 1) ? Sb1 : Sb0; LAS bf16* Sn = (c & 1) ? Sb0 : Sb1;
            bf16x8 g8[8]; v2u hw[4]; f32x4 gmc[4];
#pragma unroll
            for (int ct = 0; ct < 4; ++ct) { g8[2 * ct] = fg[2 * ct]; g8[2 * ct + 1] = fg[2 * ct + 1]; hw[ct] = hq[ct]; gmc[ct] = gm[ct]; }
            if (c + 2 < NCH) S_FETCH(c + 1);
            const bf16x8 af0 = *(const LAS bf16x8*)(Sc + row * TP + 8 * fq), af1 = *(const LAS bf16x8*)(Sc + row * TP + 32 + 8 * fq);
#pragma unroll
            for (int ct = 0; ct < 4; ++ct) {
                f32x4 acc = {bflo(hw[ct].x), bfhi(hw[ct].x), bflo(hw[ct].y), bfhi(hw[ct].y)};
                acc = mfma16(g8[2 * ct], af0, acc);
                acc = mfma16(g8[2 * ct + 1], af1, acc);
                Sm[ct] = Sm[ct] * gmc[ct] + acc;
                *(LAS v2u*)(Sn + row * TP + ct * 16 + 4 * fq) = pack4(Sm[ct]); }
            __syncthreads();
        }
        __syncthreads();
#undef S_FETCH
    }
}
__device__ __forceinline__ void gla_scan_unit(const Args& a, const Frame& F, int j) {
    float* GUS = (float*)(a.ws + WS_GUS); const float* DL = (const float*)(a.ws + WS_DL);
    const int bh = j >> 1, half = j & 1;
    const int d = 32 * half + (F.tid >> 4), e0 = (F.tid & 15) * 8;
    float* base = GUS + (size_t)bh * NCH * 8192 + d * 128 + e0;
    const float* dl = DL + (size_t)bh * NCH * 64 + d;
    f32x4 s0 = {0.f, 0.f, 0.f, 0.f}, s1 = s0;
    f32x4 u0 = *(const f32x4*)(base), u1 = *(const f32x4*)(base + 4); float dc = dl[0];
    for (int c = 0; c < NCH - 1; ++c) {
        f32x4 n0 = u0, n1 = u1; float dn = dc;
        if (c + 1 < NCH - 1) { n0 = *(const f32x4*)(base + (size_t)(c + 1) * 8192); n1 = *(const f32x4*)(base + (size_t)(c + 1) * 8192 + 4); dn = dl[(c + 1) * 64]; }
        *(f32x4*)(base + (size_t)c * 8192) = s0; *(f32x4*)(base + (size_t)c * 8192 + 4) = s1;
        s0 = s0 * dc + u0; s1 = s1 * dc + u1;
        u0 = n0; u1 = n1; dc = dn;
    }
    *(f32x4*)(base + (size_t)(NCH - 1) * 8192) = s0; *(f32x4*)(base + (size_t)(NCH - 1) * 8192 + 4) = s1;
}
__device__ __forceinline__ void phase3(const Args& a, const Frame& F) {
    for (int u = F.blk; u < 256; u += F.G) { if (u < 128) { for (int rep_ = 0; rep_ < NREP(3); ++rep_) rwkv_l2_unit(a, F, u); } else gla_scan_unit(a, F, u - 128); }
    __syncthreads();
    convert_expert_weights(a, F);
}

__device__ __forceinline__ void gla_g3_unit(const Args& a, const Frame& F, int b, int h, int c) {
    const bf16* PROJ = (const bf16*)(a.ws + WS_PROJ); const bf16* PROJM = (const bf16*)(a.ws + WS_PROJM);
    const float* GUS = (const float*)(a.ws + WS_GUS); bf16* YMIX = (bf16*)(a.ws + WS_YMIX);
    const int vp0 = NMETA + 64 * (c - 1);
    gla_bc(a, F, b, h, vp0, 64);
    LAS float* BC = (LAS float*)(F.lds + 4096);
    LAS bf16* QT = (LAS bf16*)(F.lds + 24576);
    LAS bf16* KL = QT + 64 * TP;
    LAS bf16* AT = KL + 64 * TP;
    LAS bf16* VT = AT + 64 * TP;
    LAS bf16* ST = VT + 128 * TP;
    LAS float* RS = (LAS float*)(ST + 128 * TP);
    {
        const int t = F.tid >> 3, q = F.tid & 7;
        const f32x4 q0 = ldp4(PROJ, PROJM, b, vp0 + t, GQ + h * 64 + 8 * q), q1 = ldp4(PROJ, PROJM, b, vp0 + t, GQ + h * 64 + 8 * q + 4);
        const f32x4 k0 = ldp4(PROJ, PROJM, b, vp0 + t, GK + h * 64 + 8 * q), k1 = ldp4(PROJ, PROJM, b, vp0 + t, GK + h * 64 + 8 * q + 4);
        float qv[8] = {q0.x, q0.y, q0.z, q0.w, q1.x, q1.y, q1.z, q1.w}, kv[8] = {k0.x, k0.y, k0.z, k0.w, k1.x, k1.y, k1.z, k1.w};
#pragma unroll
        for (int i = 0; i < 8; ++i) { const float bcv = BC[t * BCP + 8 * q + i]; qv[i] *= fexp(bcv) * 0.125f; kv[i] *= fexp(-bcv); }
        v4u o; o.x = pk2(qv[0], qv[1]); o.y = pk2(qv[2], qv[3]); o.z = pk2(qv[4], qv[5]); o.w = pk2(qv[6], qv[7]);
        *(LAS v4u*)(QT + t * TP + 8 * q) = o;
        o.x = pk2(kv[0], kv[1]); o.y = pk2(kv[2], kv[3]); o.z = pk2(kv[4], kv[5]); o.w = pk2(kv[6], kv[7]);
        *(LAS v4u*)(KL + t * TP + 8 * q) = o;
#pragma unroll
        for (int qq = 0; qq < 4; ++qq) {
            const int e0 = 16 * q + 4 * qq;
            const f32x4 vv = ldp4(PROJ, PROJM, b, vp0 + t, GV + h * 128 + e0);
#pragma unroll
            for (int i = 0; i < 4; ++i) VT[(e0 + i) * TP + t] = (bf16)f2bf(vv[i]);
            const f32x4 sv = *(const f32x4*)(GUS + ((size_t)((b * 4 + h) * NCH + c) * 64 + t) * 128 + e0);
#pragma unroll
            for (int i = 0; i < 4; ++i) ST[(e0 + i) * TP + t] = (bf16)f2bf(sv[i]);
        }
    }
    __syncthreads();
    const int rt = F.wave & 3, wh = F.wave >> 2, fr = F.lane & 15, fq = F.lane >> 4;
    const int trow = rt * 16 + fr;
    {
#pragma unroll
        for (int cc = 0; cc < 2; ++cc) { const int ct = 2 * wh + cc;
            f32x4 acc = {0.f, 0.f, 0.f, 0.f};
#pragma unroll
            for (int ks = 0; ks < 2; ++ks)
                acc = mfma16(*(const LAS bf16x8*)(KL + (ct * 16 + fr) * TP + ks * 32 + 8 * fq), *(const LAS bf16x8*)(QT + trow * TP + ks * 32 + 8 * fq), acc);
            const int s0 = ct * 16 + 4 * fq;
#pragma unroll
            for (int i = 0; i < 4; ++i) if (s0 + i > trow) acc[i] = 0.f;
            v2u o; o.x = pk2(acc[0], acc[1]); o.y = pk2(acc[2], acc[3]);
            *(LAS v2u*)(AT + trow * TP + s0) = o; }
    }
    __syncthreads();
    f32x4 oacc[4]; float ssq = 0.f;
#pragma unroll
    for (int cc = 0; cc < 4; ++cc) { const int ct = wh * 4 + cc;
        f32x4 acc = {0.f, 0.f, 0.f, 0.f};
#pragma unroll
        for (int ks = 0; ks < 2; ++ks) {
            acc = mfma16(*(const LAS bf16x8*)(VT + (ct * 16 + fr) * TP + ks * 32 + 8 * fq), *(const LAS bf16x8*)(AT + trow * TP + ks * 32 + 8 * fq), acc);
            acc = mfma16(*(const LAS bf16x8*)(ST + (ct * 16 + fr) * TP + ks * 32 + 8 * fq), *(const LAS bf16x8*)(QT + trow * TP + ks * 32 + 8 * fq), acc);
        }
        oacc[cc] = acc; ssq += (acc[0] * acc[0] + acc[1] * acc[1]) + (acc[2] * acc[2] + acc[3] * acc[3]); }
    ssq += __shfl_xor(ssq, 16); ssq += __shfl_xor(ssq, 32);
    if (fq == 0) RS[wh * 64 + trow] = ssq;
    __syncthreads();
    {
        const float tot = RS[trow] + RS[64 + trow];
        const float rstd = 1.f / sqrtf(tot * (1.f / 128.f) + 1e-6f);
        const size_t m = (size_t)b * SEQ + (vp0 - NMETA) + trow;
#pragma unroll
        for (int cc = 0; cc < 4; ++cc) { const int e0 = (wh * 4 + cc) * 16 + 4 * fq;
            const f32x4 gv = ldp4(PROJ, PROJM, b, vp0 + trow, GG + h * 128 + e0);
            const f32x4 ng = *(const f32x4*)(a.in[I_GNORM] + e0);
            float y[4];
#pragma unroll
            for (int i = 0; i < 4; ++i) { const float gi = gv[i]; y[i] = oacc[cc][i] * rstd * ng[i] * (gi * fsigmoid(gi)); }
            v2u o; o.x = pk2(y[0], y[1]); o.y = pk2(y[2], y[3]);
            *(v2u*)(YMIX + m * D + h * 128 + e0) = o; }
    }
    __syncthreads();
}
__device__ __forceinline__ void phase4(const Args& a, const Frame& F) {
    for (int u = F.blk; u < NB * 4 * 32; u += F.G) { const int c = 1 + (u & 31), bh = u >> 5; gla_g3_unit(a, F, bh >> 2, bh & 3, c); }
}

__device__ __forceinline__ int eidx_of(int L) { return 16 * (L & 1) + 8 * ((L >> 1) & 1) + 4 * ((L >> 2) & 1) + 2 * ((L >> 3) & 1) + ((L >> 4) & 1); }
__device__ __forceinline__ void phase6(const Args& a, const Frame& F) {
    unsigned char* ws = a.ws;
    const int gw = F.blk * NWAVES + F.wave, NGW = F.G * NWAVES;
    constexpr int RWP = 1028;
    LAS float* rwT = (LAS float*)F.lds;
    LAS int* hist = (LAS int*)(F.lds + 32 * RWP * 4);
    for (int i = F.tid; i < D * NE; i += NTHR) { const int c = i >> 5, e = i & 31; rwT[e * RWP + c] = a.in[I_RTW][i]; }
    const float* S1 = (const float*)(ws + WS_S1); bf16* H1 = (bf16*)(ws + WS_H1);
    int* TOPI = (int*)(ws + WS_TOPI); float* GATE = (float*)(ws + WS_GATE); int* RANK = (int*)(ws + WS_RANK);
    unsigned* CNT = (unsigned*)(ws + WS_CTL) + CW_CNT;
    for (int rb = F.blk; rb < MX / 128; rb += F.G) {
        if (F.tid < 64) hist[F.tid] = 0;
        __syncthreads();
        int my_e = 0;
        for (int i = 0; i < 16; ++i) {
            const int m = rb * 128 + F.wave * 16 + i;
            const f32x4* xr = (const f32x4*)(S1 + (size_t)m * D) + F.lane;
            f32x4 v[4]; float s = 0.f;
#pragma unroll
            for (int j = 0; j < 4; ++j) { v[j] = xr[64 * j]; s += (v[j].x + v[j].y) + (v[j].z + v[j].w); }
            const float mean = wave_sum(s) * (1.f / D); float s2 = 0.f;
#pragma unroll
            for (int j = 0; j < 4; ++j) { v[j] = v[j] - mean; s2 += (v[j].x * v[j].x + v[j].y * v[j].y) + (v[j].z * v[j].z + v[j].w * v[j].w); }
            const float rstd = 1.f / sqrtf(wave_sum(s2) * (1.f / D) + 1e-5f);
#pragma unroll
            for (int j = 0; j < 4; ++j) { const int col = 4 * (F.lane + 64 * j);
                const f32x4 gv = *(const f32x4*)(a.in[I_LN1G] + col), bv = *(const f32x4*)(a.in[I_LN1B] + col);
                v[j] = v[j] * rstd * gv + bv;
                v2u o; o.x = pk2(v[j].x, v[j].y); o.y = pk2(v[j].z, v[j].w);
                *(v2u*)(H1 + (size_t)m * D + col) = o; }
            float p[32];
#pragma unroll
            for (int e = 0; e < 32; ++e) { float acc = 0.f;
#pragma unroll
                for (int j = 0; j < 4; ++j) { const f32x4 w = *(const LAS f32x4*)(rwT + e * RWP + 4 * (F.lane + 64 * j)); acc += (v[j].x * w.x + v[j].y * w.y) + (v[j].z * w.z + v[j].w * w.w); }
                p[e] = acc; if ((e & 3) == 3) __builtin_amdgcn_sched_barrier(0); }
#define TR_STAGE(n, dmask) _Pragma("unroll") for (int i2 = 0; i2 < (n) / 2; ++i2) { const bool up = (F.lane & (dmask)) != 0; const float keep = up ? p[i2 + (n) / 2] : p[i2]; const float send = up ? p[i2] : p[i2 + (n) / 2]; p[i2] = keep + __shfl_xor(send, (dmask)); }
            TR_STAGE(32, 1) TR_STAGE(16, 2) TR_STAGE(8, 4) TR_STAGE(4, 8) TR_STAGE(2, 16)
#undef TR_STAGE
            const int eidx = eidx_of(F.lane);
            const float logit = p[0] + __shfl_xor(p[0], 32) + a.in[I_RTB][eidx];
            int rank = 0;
#pragma unroll
            for (int j = 0; j < 32; ++j) { const float lj = __int_as_float(__builtin_amdgcn_readlane(__float_as_int(logit), j)); const int ej = eidx_of(j);
                rank += (lj > logit || (lj == logit && ej < eidx)) ? 1 : 0; }
            int ek[4]; float lk[4];
#pragma unroll
            for (int k = 0; k < 4; ++k) { const unsigned long long mk = __ballot(rank == k) & 0xffffffffull; const int src = __builtin_amdgcn_readfirstlane((int)__builtin_ctzll(mk | (1ull << 63)));
                ek[k] = eidx_of(src); lk[k] = __int_as_float(__builtin_amdgcn_readlane(__float_as_int(logit), src)); }
            const float e0 = 1.f, e1 = expf(lk[1] - lk[0]), e2 = expf(lk[2] - lk[0]), e3 = expf(lk[3] - lk[0]);
            const float inv = 1.f / (e0 + e1 + e2 + e3);
            if (F.lane < 4) { const int k = F.lane; const int ee = k == 0 ? ek[0] : k == 1 ? ek[1] : k == 2 ? ek[2] : ek[3]; const float gg = (k == 0 ? e0 : k == 1 ? e1 : k == 2 ? e2 : e3) * inv;
                TOPI[(size_t)m * 4 + k] = ee; GATE[(size_t)m * 4 + k] = gg; }
            if ((F.lane >> 2) == i) { const int k = F.lane & 3; my_e = k == 0 ? ek[0] : k == 1 ? ek[1] : k == 2 ? ek[2] : ek[3]; }
        }
        const int lrank = __hip_atomic_fetch_add(&hist[my_e], 1, __ATOMIC_RELAXED, __HIP_MEMORY_SCOPE_WORKGROUP);
        __syncthreads();
        if (F.tid < 32) hist[32 + F.tid] = (int)__hip_atomic_fetch_add(CNT + 64 * F.tid, (unsigned)hist[F.tid], __ATOMIC_RELAXED, __HIP_MEMORY_SCOPE_AGENT);
        __syncthreads();
        RANK[((size_t)rb * 128 + F.wave * 16 + (F.lane >> 2)) * 4 + (F.lane & 3)] = hist[32 + my_e] + lrank;
        __syncthreads();
    }
}

__device__ __forceinline__ void phase7(const Args& a, const Frame& F) {
    unsigned char* ws = a.ws;
    LAS int* starts = (LAS int*)F.lds;
    unsigned* CNT = (unsigned*)(ws + WS_CTL) + CW_CNT;
    int* TILEE = (int*)(ws + WS_TILEE); int* SLOTTOK = (int*)(ws + WS_SLOTTOK);
    if (F.tid < 32) { const int cnt = (int)ld_agent(CNT + 64 * F.tid); starts[64 + F.tid] = cnt; starts[32 + F.tid] = (cnt + 255) & ~255; }
    __syncthreads();
    if (F.tid == 0) { int run = 0; for (int e = 0; e < 32; ++e) { starts[e] = run; run += starts[32 + e]; }
        if (F.blk == 0) { TILEE[1023] = run >> 8; for (int e = 0; e < 32; ++e) for (int tl = starts[e] >> 8; tl < (starts[e] + starts[32 + e]) >> 8; ++tl) TILEE[tl] = e; } }
    __syncthreads();
    if (F.blk == 0) { for (int e = 0; e < 32; ++e) for (int s = starts[e] + starts[64 + e] + F.tid; s < starts[e] + starts[32 + e]; s += NTHR) SLOTTOK[s] = 0; }
    const int* TOPI = (const int*)(ws + WS_TOPI); const int* RANK = (const int*)(ws + WS_RANK); int* TSLOT = (int*)(ws + WS_TSLOT);
    for (int q = F.blk * NTHR + F.tid; q < MX * 4; q += F.G * NTHR) {
        const int slot = starts[TOPI[q]] + RANK[q];
        TSLOT[q] = slot; SLOTTOK[slot] = q >> 2;
    }
}
__device__ __forceinline__ int moe_fill_table(const Args& a, const Frame& F, int nN, int RM) {
    LAS int* tab = (LAS int*)(F.lds + TAB_OFF);
    const unsigned* TILEE = (const unsigned*)(a.ws + WS_TILEE);
    if (F.tid == 0) {
        const int NT = (int)ld_agent(TILEE + 1023);
        const int x = F.blk & 7, j = F.blk >> 3; int n = 0;
        for (int i = 0; i < 64; ++i) { const int s = i * 8 + x, pm = s * RM + j / nN; if (pm >= NT) break;
            const int e = (int)ld_agent(TILEE + pm); tab[2 * n] = pm; tab[2 * n + 1] = e * nN + (j % nN); ++n; }
        tab[128] = n;
    }
    __syncthreads();
    return __builtin_amdgcn_readfirstlane(tab[128]);
}

__device__ __forceinline__ void phase10(const Args& a, const Frame& F) {
    unsigned char* ws = a.ws;
    const bf16* H1 = (const bf16*)(ws + WS_H1); const bf16* YS = (const bf16*)(ws + WS_YS);
    const int* TSLOT = (const int*)(ws + WS_TSLOT); const float* GATE = (const float*)(ws + WS_GATE);
    const int gw = F.blk * NWAVES + F.wave, NGW = F.G * NWAVES;
    for (int m = gw; m < MX; m += NGW) {
        float s[16];
#pragma unroll
        for (int j = 0; j < 2; ++j) { const v4u w = *(const v4u*)(H1 + (size_t)m * D + 8 * F.lane + 512 * j);
            s[8 * j + 0] = ALPHA * bflo(w.x); s[8 * j + 1] = ALPHA * bfhi(w.x); s[8 * j + 2] = ALPHA * bflo(w.y); s[8 * j + 3] = ALPHA * bfhi(w.y);
            s[8 * j + 4] = ALPHA * bflo(w.z); s[8 * j + 5] = ALPHA * bfhi(w.z); s[8 * j + 6] = ALPHA * bflo(w.w); s[8 * j + 7] = ALPHA * bfhi(w.w); }
#pragma unroll
        for (int k = 0; k < 4; ++k) { const int slot = TSLOT[(size_t)m * 4 + k]; const float g = GATE[(size_t)m * 4 + k];
#pragma unroll
            for (int j = 0; j < 2; ++j) { const v4u w = *(const v4u*)(YS + (size_t)slot * D + 8 * F.lane + 512 * j);
                s[8 * j + 0] += g * bflo(w.x); s[8 * j + 1] += g * bfhi(w.x); s[8 * j + 2] += g * bflo(w.y); s[8 * j + 3] += g * bfhi(w.y);
                s[8 * j + 4] += g * bflo(w.z); s[8 * j + 5] += g * bfhi(w.z); s[8 * j + 6] += g * bflo(w.w); s[8 * j + 7] += g * bfhi(w.w); } }
        float t = 0.f;
#pragma unroll
        for (int i = 0; i < 16; ++i) t += s[i];
        const float mean = wave_sum(t) * (1.f / D); float q = 0.f;
#pragma unroll
        for (int i = 0; i < 16; ++i) { s[i] -= mean; q += s[i] * s[i]; }
        const float rstd = 1.f / sqrtf(wave_sum(q) * (1.f / D) + 1e-5f);
#pragma unroll
        for (int j = 0; j < 2; ++j) { const int col = 8 * F.lane + 512 * j;
#pragma unroll
            for (int hh = 0; hh < 2; ++hh) { const f32x4 gv = *(const f32x4*)(a.in[I_LN2G] + col + 4 * hh), bv = *(const f32x4*)(a.in[I_LN2B] + col + 4 * hh);
                f32x4 o; o.x = s[8 * j + 4 * hh + 0] * rstd * gv.x + bv.x; o.y = s[8 * j + 4 * hh + 1] * rstd * gv.y + bv.y; o.z = s[8 * j + 4 * hh + 2] * rstd * gv.z + bv.z; o.w = s[8 * j + 4 * hh + 3] * rstd * gv.w + bv.w;
                *(f32x4*)(a.out + (size_t)m * D + col + 4 * hh) = o; } }
    }
}

template <int LO, int HI>
__global__ void __launch_bounds__(NTHR, 2) fwd(Args a) {
    extern __shared__ __attribute__((aligned(16))) unsigned char lds_raw[];
    LAS unsigned char* lds = (LAS unsigned char*)lds_raw;
    const int wave = __builtin_amdgcn_readfirstlane((int)(threadIdx.x >> 6));
    volatile LAS unsigned* MISC = (volatile LAS unsigned*)(lds + MISC_OFF);
    if (wave == 0) MISC[lane_id()] = 0u;
    __syncthreads();
    unsigned* ctl = (unsigned*)(a.ws + WS_CTL);
    XcdBarrier bar; bar.bar = ctl + CW_BAR; bar.x = 0; bar.st = nullptr;
    if constexpr (HI - LO > 1) bar = xcd_barrier_post(ctl + CW_BAR, MISC + 8, wave == 0 && lane_id() == 0);
#define PH(k) if constexpr (LO <= (k) && (k) < HI)
#define SEAM(k) if constexpr (LO <= (k) && (k) + 1 < HI) xcd_barrier(bar, wave == 0 && lane_id() == 0)
    PH(0) for (int rep_ = 0; rep_ < NREP(0); ++rep_) { const Frame F = mkframe(lds, wave); phase0(a, F); } SEAM(0);
    PH(1) for (int rep_ = 0; rep_ < NREP(1); ++rep_) { const Frame F = mkframe(lds, wave);
            pg8::Gemm g{(const pg8::bf16_t*)(a.ws + WS_A0), (const pg8::bf16_t*)(a.ws + WS_WIN), MX, PW, D}; pg8::StaticOrder S; S.init(MX, PW, F.G, F.blk);
            pg8::EpiBf16Plain E{(pg8::bf16_t*)(a.ws + WS_PROJ), PW};
            pg8::gemm_phase<pg8::EpiBf16Plain, pg8::StaticOrder, true, true>(F.lds, g, S, E, F.tid); } SEAM(1);
    PH(2) for (int rep_ = 0; rep_ < NREP(2); ++rep_) { const Frame F = mkframe(lds, wave); phase2(a, F); } SEAM(2);
    PH(3) { const Frame F = mkframe(lds, wave); phase3(a, F); } SEAM(3);
    PH(4) for (int rep_ = 0; rep_ < NREP(4); ++rep_) { const Frame F = mkframe(lds, wave); phase4(a, F); } SEAM(4);
    PH(5) for (int rep_ = 0; rep_ < NREP(5); ++rep_) { const Frame F = mkframe(lds, wave);
            pg8::Gemm g{(const pg8::bf16_t*)(a.ws + WS_YMIX), (const pg8::bf16_t*)(a.ws + WS_WOUT), MX, D, D}; pg8::StaticOrder S; S.init(MX, D, F.G, F.blk);
            pg8::EpiResid E{(float*)(a.ws + WS_S1), a.in[I_X], (const float*)(a.ws + WS_STATS), a.in[I_LNIN_G], a.in[I_LNIN_B], ALPHA};
            pg8::gemm_phase<pg8::EpiResid, pg8::StaticOrder, true, true>(F.lds, g, S, E, F.tid); } SEAM(5);
    PH(6) { const Frame F = mkframe(lds, wave); phase6(a, F); } SEAM(6);
    PH(7) for (int rep_ = 0; rep_ < NREP(7); ++rep_) { const Frame F = mkframe(lds, wave); phase7(a, F); } SEAM(7);
    PH(8) for (int rep_ = 0; rep_ < NREP(8); ++rep_) { const Frame F = mkframe(lds, wave); const int n = moe_fill_table(a, F, 8, 4);
            pg8::Gemm g{(const pg8::bf16_t*)(a.ws + WS_H1), (const pg8::bf16_t*)(a.ws + WS_WUP), 0, 0, D}; pg8::TableOrder S{(const LAS int*)(F.lds + TAB_OFF), n};
            pg8::EpiSwiglu E{(pg8::bf16_t*)(a.ws + WS_ACT), a.in[I_BUP]};
            pg8::gemm_phase_g<pg8::EpiSwiglu, pg8::TableOrder, true, true>(F.lds, g, S, E, F.tid, (const int*)(a.ws + WS_SLOTTOK)); } SEAM(8);
    PH(9) for (int rep_ = 0; rep_ < NREP(9); ++rep_) { const Frame F = mkframe(lds, wave); const int n = moe_fill_table(a, F, 4, 8);
            pg8::Gemm g{(const pg8::bf16_t*)(a.ws + WS_ACT), (const pg8::bf16_t*)(a.ws + WS_WDN), 0, 0, D}; pg8::TableOrder S{(const LAS int*)(F.lds + TAB_OFF), n};
            pg8::EpiDown E{(pg8::bf16_t*)(a.ws + WS_YS), a.in[I_BDN]};
            pg8::gemm_phase<pg8::EpiDown, pg8::TableOrder, true, true>(F.lds, g, S, E, F.tid); } SEAM(9);
    PH(10) for (int rep_ = 0; rep_ < NREP(10); ++rep_) { const Frame F = mkframe(lds, wave); phase10(a, F); }
#undef PH
#undef SEAM
}

#ifndef MK_SINGLE
#define MK_SINGLE 1
#endif
template <int LO, int HI> static void launch_range(const Args& a, int grid, hipStream_t stream) {
    static bool attr = false;
    if (!attr) { (void)hipFuncSetAttribute((const void*)fwd<LO, HI>, hipFuncAttributeMaxDynamicSharedMemorySize, LDS_BYTES); attr = true; }
    hipLaunchKernelGGL((fwd<LO, HI>), dim3(grid), dim3(NTHR), LDS_BYTES, stream, a);
}
extern "C" void kernel_launch(void* const* d_in, const int* in_sizes, int n_in, void* d_out, int out_size, void* d_ws, size_t ws_size, hipStream_t stream) {
    if (n_in != 30 || ws_size < WS_END) { fprintf(stderr, "kernel_launch: unexpected inputs (n_in %d, ws %zu)\n", n_in, ws_size); return; }
    const int grid = 256;
    (void)hipMemsetAsync((char*)d_ws + WS_CTL, 0, CTL_ZERO_BYTES, stream);
    Args a{};
    for (int i = 0; i < 30; ++i) a.in[i] = (const float*)d_in[i];
    a.out = (float*)d_out; a.ws = (unsigned char*)d_ws;
#if MK_SINGLE
    launch_range<0, 11>(a, grid, stream);
#else
    launch_range<0, 1>(a, grid, stream); launch_range<1, 2>(a, grid, stream); launch_range<2, 3>(a, grid, stream); launch_range<3, 4>(a, grid, stream);
    launch_range<4, 5>(a, grid, stream); launch_range<5, 6>(a, grid, stream); launch_range<6, 7>(a, grid, stream); launch_range<7, 8>(a, grid, stream);
    launch_range<8, 9>(a, grid, stream); launch_range<9, 10>(a, grid, stream); launch_range<10, 11>(a, grid, stream);
#endif
}
```

```cpp
#include <hip/hip_runtime.h>
#include <cstdio>
#include <cstdint>
#include <cmath>
namespace pg8 {
#define PG8_LAS __attribute__((address_space(3)))
typedef unsigned short bf16_t;
typedef short bf16x8 __attribute__((ext_vector_type(8)));
typedef float f32x4 __attribute__((ext_vector_type(4)));
typedef unsigned u32x4 __attribute__((ext_vector_type(4)));
constexpr int BM = 256, BK = 64, HALF = 128, HTB = HALF * BK * 2  , STAGE_BYTES = 8 * HTB, NXCD = 8, WGM = 8;

__host__ __device__ __forceinline__ int lds_byte(int r, int c) { const int st = (r >> 4) * 2 + (c >> 5), rr = r & 15, cc = c & 31, ob = rr * 64 + cc * 2; return st * 1024 + (ob ^ (((ob >> 9) & 1) << 5)); }
__host__ __device__ __forceinline__ void stage_rc(int b, int& R, int& C) { const int st = b / 1024, sb = b % 1024, swz = sb ^ (((sb >> 9) & 1) << 5); R = (st >> 1) * 16 + swz / 64; C = (st & 1) * 32 + (swz % 64) / 2; }
__host__ __device__ __forceinline__ int perm32(int rho) { const int n = rho >> 4, i = rho & 15; return 8 * (i >> 2) + 4 * n + (i & 3); }

struct Unit { int pm, pn; };
struct Gemm { const bf16_t* A; const bf16_t* Bt; int M, N, K; };

struct StaticOrder {
    int nM, nN, nwg, G, c;
    __host__ __device__ void init(int M, int N, int G_, int c_) { nM = M / BM; nN = N / BM; nwg = nM * nN; G = G_; c = c_; }
    __host__ __device__ bool next(int i, Unit& u) const {
        const long L = (long)i * G + c; if (L >= nwg) return false;
        int wgid = (int)L; { const int q = nwg / NXCD, r = nwg % NXCD, xcd = wgid % NXCD, off = wgid / NXCD; wgid = (xcd < r ? xcd * (q + 1) : r * (q + 1) + (xcd - r) * q) + off; }
        const int nig = WGM * nN, gid = wgid / nig, fm = gid * WGM, gsz = (nM - fm) < WGM ? (nM - fm) : WGM;
        u.pm = fm + ((wgid % nig) % gsz); u.pn = (wgid % nig) / gsz; return true;
    }
    __device__ __forceinline__ void a_ready(const Unit&) const {}
    __device__ __forceinline__ void done(const Unit&) const {}
};


__device__ __forceinline__ unsigned cvt_pk_bf16(float lo, float hi) { unsigned r; asm volatile("v_cvt_pk_bf16_f32 %0, %1, %2" : "=v"(r) : "v"(lo), "v"(hi)); return r; }
typedef unsigned u32x2 __attribute__((ext_vector_type(2)));
typedef int i32x8 __attribute__((ext_vector_type(8))); typedef int i32x4 __attribute__((ext_vector_type(4)));
__device__ __forceinline__ void mfma_f8(f32x4& acc, i32x8 a, i32x8 b, int sa, int sb) {
    asm volatile("s_nop 1\n\tv_mfma_scale_f32_16x16x128_f8f6f4 %0, %1, %2, %0, %3, %4 op_sel_hi:[0,0,0]" : "+v"(acc) : "v"(a), "v"(b), "v"(sa), "v"(sb));
}
__device__ __forceinline__ i32x8 cat8(bf16x8 lo, bf16x8 hi) { const i32x4 a = __builtin_bit_cast(i32x4, lo), b = __builtin_bit_cast(i32x4, hi); return __builtin_shufflevector(a, b, 0, 1, 2, 3, 4, 5, 6, 7); }

struct EpiBf16Plain {
    static constexpr bool PERM = true, AFTER_DRAIN = false;
    bf16_t* O; int ldc;
    __device__ __forceinline__ void operator()(const f32x4 (&acc)[2][2][4][2], const Unit& u, int wr, int wc, int fr, int fq) const {
        const int row0 = u.pm * BM + wr * 64 + fr, col0 = u.pn * BM + wc * 32 + 8 * fq;
#pragma unroll
        for (int ai = 0; ai < 2; ++ai)
#pragma unroll
            for (int m = 0; m < 4; ++m) { bf16_t* rowp = O + (size_t)(row0 + ai * HALF + m * 16) * ldc + col0;
#pragma unroll
                for (int bj = 0; bj < 2; ++bj) { const f32x4 v0 = acc[ai][bj][m][0], v1 = acc[ai][bj][m][1];
                    u32x4 w; w.x = cvt_pk_bf16(v0[0], v0[1]); w.y = cvt_pk_bf16(v0[2], v0[3]); w.z = cvt_pk_bf16(v1[0], v1[1]); w.w = cvt_pk_bf16(v1[2], v1[3]);
                    *(u32x4*)(rowp + bj * HALF) = w; } }
    }
};

struct EpiResid {
    static constexpr bool PERM = false, AFTER_DRAIN = false;
    float* S1; const float* x; const float* stats; const float* g; const float* bta; float alpha;
    __device__ __forceinline__ void operator()(const f32x4 (&acc)[2][2][4][2], const Unit& u, int wr, int wc, int fr, int fq) const {
        const int row0 = u.pm * BM + wr * 64 + fr, col0 = u.pn * BM + wc * 32 + 4 * fq;
#pragma unroll
        for (int bj = 0; bj < 2; ++bj)
#pragma unroll
            for (int n = 0; n < 2; ++n) { const int c = col0 + bj * HALF + n * 16;
                const f32x4 gv = *(const f32x4*)(g + c) * alpha, bv = *(const f32x4*)(bta + c) * alpha;
#pragma unroll
                for (int ai = 0; ai < 2; ++ai)
#pragma unroll
                    for (int m = 0; m < 4; ++m) { const int r = row0 + ai * HALF + m * 16;
                        const float mean = stats[2 * r], rstd = stats[2 * r + 1];
                        const f32x4 xv = *(const f32x4*)(x + (size_t)r * 1024 + c);
                        *(f32x4*)(S1 + (size_t)r * 1024 + c) = ((xv - mean) * rstd) * gv + bv + acc[ai][bj][m][n]; } }
    }
};

__device__ __forceinline__ float swiglu1(float glu, float lin) {
    const float xg = fminf(glu, 7.0f), xl = fminf(fmaxf(lin, -7.0f), 7.0f);
    const float sg = __builtin_amdgcn_rcpf(1.0f + __expf(-1.702f * xg));
    return xg * sg * (xl + 1.0f);
}
struct EpiSwiglu {
    static constexpr bool PERM = true, AFTER_DRAIN = false;
    bf16_t* ACT; const float* bup;
    __device__ __forceinline__ void operator()(const f32x4 (&acc)[2][2][4][2], const Unit& u, int wr, int wc, int fr, int fq) const {
        const int e = u.pn >> 3, pn = u.pn & 7;
        const int row0 = u.pm * BM + wr * 64 + fr, ucol0 = pn * BM + wc * 32 + 8 * fq, acol0 = ucol0 >> 1;
        f32x4 bv[2][2];
#pragma unroll
        for (int bj = 0; bj < 2; ++bj)
#pragma unroll
            for (int n = 0; n < 2; ++n) bv[bj][n] = *(const f32x4*)(bup + (size_t)e * 2048 + ucol0 + bj * HALF + 4 * n);
#pragma unroll
        for (int ai = 0; ai < 2; ++ai)
#pragma unroll
            for (int m = 0; m < 4; ++m) { bf16_t* rowp = ACT + (size_t)(row0 + ai * HALF + m * 16) * 1024 + acol0;
#pragma unroll
                for (int bj = 0; bj < 2; ++bj) { const f32x4 v0 = acc[ai][bj][m][0] + bv[bj][0], v1 = acc[ai][bj][m][1] + bv[bj][1];
                    u32x2 w; w.x = cvt_pk_bf16(swiglu1(v0[0], v0[1]), swiglu1(v0[2], v0[3])); w.y = cvt_pk_bf16(swiglu1(v1[0], v1[1]), swiglu1(v1[2], v1[3]));
                    *(u32x2*)(rowp + bj * (HALF / 2)) = w; } }
    }
};
struct EpiSwiglu8 {
    static constexpr bool PERM = true, AFTER_DRAIN = false;
    unsigned char* ACT; const float* bup;
    __device__ __forceinline__ void operator()(const f32x4 (&acc)[2][2][4][2], const Unit& u, int wr, int wc, int fr, int fq) const {
        const int e = u.pn >> 3, pn = u.pn & 7;
        const int row0 = u.pm * BM + wr * 64 + fr, ucol0 = pn * BM + wc * 32 + 8 * fq, acol0 = ucol0 >> 1;
        f32x4 bv[2][2];
#pragma unroll
        for (int bj = 0; bj < 2; ++bj)
#pragma unroll
            for (int n = 0; n < 2; ++n) bv[bj][n] = *(const f32x4*)(bup + (size_t)e * 2048 + ucol0 + bj * HALF + 4 * n);
#pragma unroll
        for (int ai = 0; ai < 2; ++ai)
#pragma unroll
            for (int m = 0; m < 4; ++m) { unsigned char* rowp = ACT + (size_t)(row0 + ai * HALF + m * 16) * 1024 + acol0;
#pragma unroll
                for (int bj = 0; bj < 2; ++bj) { const f32x4 v0 = acc[ai][bj][m][0] + bv[bj][0], v1 = acc[ai][bj][m][1] + bv[bj][1];
                    int w = __builtin_amdgcn_cvt_pk_fp8_f32(swiglu1(v0[0], v0[1]), swiglu1(v0[2], v0[3]), 0, false);
                    w = __builtin_amdgcn_cvt_pk_fp8_f32(swiglu1(v1[0], v1[1]), swiglu1(v1[2], v1[3]), w, true);
                    *(int*)(rowp + bj * (HALF / 2)) = w; } }
    }
};
struct EpiDown {
    static constexpr bool PERM = true, AFTER_DRAIN = false;
    bf16_t* YS; const float* bdn;
    __device__ __forceinline__ void operator()(const f32x4 (&acc)[2][2][4][2], const Unit& u, int wr, int wc, int fr, int fq) const {
        const int e = u.pn >> 2, pn = u.pn & 3;
        const int row0 = u.pm * BM + wr * 64 + fr, col0 = pn * BM + wc * 32 + 8 * fq;
        f32x4 bv[2][2];
#pragma unroll
        for (int bj = 0; bj < 2; ++bj)
#pragma unroll
            for (int n = 0; n < 2; ++n) bv[bj][n] = *(const f32x4*)(bdn + (size_t)e * 1024 + col0 + bj * HALF + 4 * n);
#pragma unroll
        for (int ai = 0; ai < 2; ++ai)
#pragma unroll
            for (int m = 0; m < 4; ++m) { bf16_t* rowp = YS + (size_t)(row0 + ai * HALF + m * 16) * 1024 + col0;
#pragma unroll
                for (int bj = 0; bj < 2; ++bj) { const f32x4 v0 = acc[ai][bj][m][0] + bv[bj][0], v1 = acc[ai][bj][m][1] + bv[bj][1];
                    u32x4 w; w.x = cvt_pk_bf16(v0[0], v0[1]); w.y = cvt_pk_bf16(v0[2], v0[3]); w.z = cvt_pk_bf16(v1[0], v1[1]); w.w = cvt_pk_bf16(v1[2], v1[3]);
                    *(u32x4*)(rowp + bj * HALF) = w; } }
    }
};
struct TableOrder {
    const PG8_LAS int* tab; int n;
    __device__ __forceinline__ bool next(int i, Unit& u) const {
        if (i >= n) return false;
        u.pm = __builtin_amdgcn_readfirstlane(tab[2 * i]); u.pn = __builtin_amdgcn_readfirstlane(tab[2 * i + 1]); return true;
    }
    __device__ __forceinline__ void a_ready(const Unit&) const {}
    __device__ __forceinline__ void done(const Unit&) const {}
};

template <class Epi, class Sched, bool ALIGN_EPI = false, bool SP2 = false, int SCW = 0>
__device__ __forceinline__ void gemm_phase(PG8_LAS unsigned char* lds, const Gemm g, const Sched& S, const Epi& E, const int tid) {
    const int wid = __builtin_amdgcn_readfirstlane(tid >> 6), lane = tid & 63, wr = wid >> 2, wc = wid & 3, fr = lane & 15, fq = lane >> 4;
    int K_ = g.K; asm volatile("" : "+s"(K_));
    const int K = K_, nt = K / BK;
    unsigned voffA[2], voffB[2];
#pragma unroll
    for (int i = 0; i < 2; ++i) { int R, C; stage_rc(tid * 16 + i * 8192, R, C); const int Rb = Epi::PERM ? ((R & ~31) + perm32(R & 31)) : R;
        voffA[i] = (unsigned)(R * K + C) * 2u; voffB[i] = (unsigned)(Rb * K + C) * 2u; }
    const size_t kstep = (size_t)(BK * 2);
    const size_t hstep = (size_t)HALF * K * 2;
    const size_t tstep = 2 * hstep;
    const unsigned ldsw = (unsigned)wid * 1024u;
    const int aoff = lds_byte(wr * 64 + fr, fq * 8), boff = lds_byte(wc * 32 + fr, fq * 8);
#define PG8_SA(b, h) (((b) * 2 + (h)) * HTB)
#define PG8_SB(b, h) ((4 + (b) * 2 + (h)) * HTB)
#define PG8_STAGE(bufoff, gbase, voff) do { _Pragma("unroll") for (int _i = 0; _i < 2; ++_i) \
        __builtin_amdgcn_global_load_lds((const unsigned*)((const char*)(gbase) + (voff)[_i]), (PG8_LAS unsigned*)(lds + (bufoff) + ldsw + _i * 8192), 16, 0, 0); } while (0)
#define PG8_LDA(dst, b, h) do { _Pragma("unroll") for (int m = 0; m < 4; ++m) _Pragma("unroll") for (int k = 0; k < 2; ++k) dst[m][k] = *(const PG8_LAS bf16x8*)(lds + PG8_SA(b, h) + aoff + m * 2048 + k * 1024); } while (0)
#define PG8_LDB(dst, b, h) do { _Pragma("unroll") for (int n = 0; n < 2; ++n) _Pragma("unroll") for (int k = 0; k < 2; ++k) dst[n][k] = *(const PG8_LAS bf16x8*)(lds + PG8_SB(b, h) + boff + n * 2048 + k * 1024); } while (0)
#define PG8_MMA(ai, bj, At, Bt) do { __builtin_amdgcn_s_setprio(1); _Pragma("unroll") for (int m = 0; m < 4; ++m) _Pragma("unroll") for (int n = 0; n < 2; ++n) { \
        if constexpr (SCW != 0) mfma_f8(acc[ai][bj][m][n], cat8(Bt[n][0], Bt[n][1]), cat8(At[m][0], At[m][1]), SCW * 0x01010101, 0x7f7f7f7f); \
        else { _Pragma("unroll") for (int k = 0; k < 2; ++k) acc[ai][bj][m][n] = __builtin_amdgcn_mfma_f32_16x16x32_bf16(Bt[n][k], At[m][k], acc[ai][bj][m][n], 0, 0, 0); } } __builtin_amdgcn_s_setprio(0); } while (0)
#define PG8_WAIT_V(n) asm volatile("s_waitcnt vmcnt(" #n ")" ::: "memory")
#define PG8_WAIT_L(n) asm volatile("s_waitcnt lgkmcnt(" #n ")" ::: "memory")
#define PG8_BAR __builtin_amdgcn_s_barrier()
#define PG8_SCHED __builtin_amdgcn_sched_barrier(0)
    Unit cur, nxt; int ui = 0;
    if (!S.next(0, cur)) return;
    f32x4 acc[2][2][4][2];
#pragma unroll
    for (int a = 0; a < 2; ++a)
#pragma unroll
        for (int b = 0; b < 2; ++b)
#pragma unroll
            for (int m = 0; m < 4; ++m)
#pragma unroll
                for (int n = 0; n < 2; ++n) acc[a][b][m][n] = (f32x4){0.f, 0.f, 0.f, 0.f};
    bf16x8 At[4][2], B0[2][2], B1[2][2];
    const char* cA = (const char*)g.A + (size_t)cur.pm * tstep; const char* cB = (const char*)g.Bt + (size_t)cur.pn * tstep;
    S.a_ready(cur);
    if constexpr (SP2) {
        PG8_STAGE(PG8_SB(0, 0), cB, voffB); PG8_STAGE(PG8_SB(0, 1), cB + hstep, voffB); PG8_STAGE(PG8_SA(0, 0), cA, voffA); PG8_STAGE(PG8_SA(0, 1), cA + hstep, voffA);
        if (wr == 1) PG8_BAR;
        PG8_WAIT_V(2); PG8_BAR;
        PG8_STAGE(PG8_SB(1, 0), cB + kstep, voffB); PG8_STAGE(PG8_SA(1, 0), cA + kstep, voffA); PG8_STAGE(PG8_SB(1, 1), cB + hstep + kstep, voffB);
        PG8_WAIT_V(6); PG8_BAR;
    } else {
        PG8_STAGE(PG8_SB(0, 0), cB, voffB); PG8_STAGE(PG8_SA(0, 0), cA, voffA); PG8_STAGE(PG8_SB(0, 1), cB + hstep, voffB); PG8_STAGE(PG8_SA(0, 1), cA + hstep, voffA);
        if (wr == 1) PG8_BAR;
        PG8_WAIT_V(4); PG8_BAR;
        PG8_STAGE(PG8_SB(1, 0), cB + kstep, voffB); PG8_STAGE(PG8_SA(1, 0), cA + kstep, voffA); PG8_STAGE(PG8_SB(1, 1), cB + hstep + kstep, voffB);
        PG8_WAIT_V(6); PG8_BAR;
    }
    for (;;) {
        const bool has_next = S.next(ui + 1, nxt);
        const char* nA = has_next ? (const char*)g.A + (size_t)nxt.pm * tstep : cA; const char* nB = has_next ? (const char*)g.Bt + (size_t)nxt.pn * tstep : cB;
        for (int t = 0; t < nt; t += 2) {
            const bool last = (t == nt - 2);
            const char* a1 = cA + (size_t)(t + 1) * kstep;
            const char* a2 = last ? nA : cA + (size_t)(t + 2) * kstep; const char* b2 = last ? nB : cB + (size_t)(t + 2) * kstep;
            const char* a3 = a2 + kstep; const char* b3 = b2 + kstep;
            if (last && has_next) S.a_ready(nxt);
            if constexpr (SP2) {
            PG8_LDB(B0, 0, 0); PG8_LDB(B1, 0, 1); PG8_SCHED; PG8_LDA(At, 0, 0); PG8_STAGE(PG8_SA(1, 1), a1 + hstep, voffA);
            PG8_WAIT_V(8); PG8_WAIT_L(0); PG8_BAR; PG8_MMA(0, 0, At, B0); PG8_MMA(0, 1, At, B1); PG8_BAR; PG8_SCHED;
            PG8_LDA(At, 0, 1); PG8_STAGE(PG8_SB(0, 0), b2, voffB); PG8_STAGE(PG8_SB(0, 1), b2 + hstep, voffB); PG8_STAGE(PG8_SA(0, 0), a2, voffA);
            PG8_WAIT_V(8); PG8_WAIT_L(0); PG8_BAR; PG8_MMA(1, 0, At, B0); PG8_MMA(1, 1, At, B1); PG8_BAR; PG8_SCHED;
            PG8_LDB(B0, 1, 0); PG8_LDB(B1, 1, 1); PG8_SCHED; PG8_LDA(At, 1, 0); PG8_STAGE(PG8_SA(0, 1), a2 + hstep, voffA);
            PG8_WAIT_V(8); PG8_WAIT_L(0); PG8_BAR; PG8_MMA(0, 0, At, B0); PG8_MMA(0, 1, At, B1); PG8_BAR; PG8_SCHED;
            PG8_LDA(At, 1, 1); PG8_STAGE(PG8_SB(1, 0), b3, voffB); PG8_STAGE(PG8_SB(1, 1), b3 + hstep, voffB); PG8_STAGE(PG8_SA(1, 0), a3, voffA);
            PG8_WAIT_V(8); PG8_WAIT_L(0); PG8_BAR; PG8_MMA(1, 0, At, B0); PG8_MMA(1, 1, At, B1); PG8_BAR; PG8_SCHED;
            } else {
            PG8_LDB(B0, 0, 0); PG8_SCHED; PG8_LDA(At, 0, 0); PG8_STAGE(PG8_SA(1, 1), a1 + hstep, voffA);
            PG8_WAIT_L(8); PG8_BAR; PG8_WAIT_L(0); PG8_MMA(0, 0, At, B0); PG8_BAR; PG8_SCHED;
            PG8_LDB(B1, 0, 1); PG8_STAGE(PG8_SB(0, 0), b2, voffB);
            PG8_BAR; PG8_WAIT_L(0); PG8_MMA(0, 1, At, B1); PG8_BAR;
            PG8_LDA(At, 0, 1); PG8_STAGE(PG8_SA(0, 0), a2, voffA);
            PG8_BAR; PG8_WAIT_L(0); PG8_MMA(1, 0, At, B0); PG8_BAR; PG8_SCHED;
            PG8_STAGE(PG8_SB(0, 1), b2 + hstep, voffB);
            PG8_WAIT_V(6); PG8_BAR; PG8_MMA(1, 1, At, B1); PG8_BAR;
            PG8_LDB(B0, 1, 0); PG8_SCHED; PG8_LDA(At, 1, 0); PG8_STAGE(PG8_SA(0, 1), a2 + hstep, voffA);
            PG8_WAIT_L(8); PG8_BAR; PG8_WAIT_L(0); PG8_MMA(0, 0, At, B0); PG8_BAR; PG8_SCHED;
            PG8_LDB(B1, 1, 1); PG8_STAGE(PG8_SB(1, 0), b3, voffB);
            PG8_BAR; PG8_WAIT_L(0); PG8_MMA(0, 1, At, B1); PG8_BAR;
            PG8_LDA(At, 1, 1); PG8_STAGE(PG8_SA(1, 0), a3, voffA);
            PG8_BAR; PG8_WAIT_L(0); PG8_MMA(1, 0, At, B0); PG8_BAR; PG8_SCHED;
            PG8_STAGE(PG8_SB(1, 1), b3 + hstep, voffB);
            PG8_WAIT_V(6); PG8_BAR; PG8_MMA(1, 1, At, B1); PG8_BAR;
            }
        }
        if constexpr (SCW != 0) asm volatile("s_nop 15\n\ts_nop 15" ::: "memory");
        if constexpr (ALIGN_EPI) { if (wr == 0) PG8_BAR; }
        if constexpr (!Epi::AFTER_DRAIN) { E(acc, cur, wr, wc, fr, fq); S.done(cur); }
        if (!has_next) break;
#pragma unroll
        for (int a = 0; a < 2; ++a)
#pragma unroll
            for (int b = 0; b < 2; ++b)
#pragma unroll
                for (int m = 0; m < 4; ++m)
#pragma unroll
                    for (int n = 0; n < 2; ++n) acc[a][b][m][n] = (f32x4){0.f, 0.f, 0.f, 0.f};
        cur = nxt; cA = nA; cB = nB; ++ui;
        if constexpr (ALIGN_EPI) { if (wr == 1) PG8_BAR; }
    }
    PG8_WAIT_V(0);
    if constexpr (!ALIGN_EPI) { if (wr == 0) PG8_BAR; }
    PG8_BAR;
    if constexpr (Epi::AFTER_DRAIN) { E.fused(acc, cur, wr, wc, fr, fq, lds, wid, lane); S.done(cur); }
#undef PG8_SA
#undef PG8_SB
#undef PG8_STAGE
#undef PG8_LDA
#undef PG8_LDB
#undef PG8_MMA
#undef PG8_WAIT_V
#undef PG8_WAIT_L
#undef PG8_BAR
#undef PG8_SCHED
}
template <class Epi, class Sched, bool ALIGN_EPI = false, bool SP2 = false, int SCW = 0>
__device__ __forceinline__ void gemm_phase_g(PG8_LAS unsigned char* lds, const Gemm g, const Sched& S, const Epi& E, const int tid, const int* rowmap) {
    const int wid = __builtin_amdgcn_readfirstlane(tid >> 6), lane = tid & 63, wr = wid >> 2, wc = wid & 3, fr = lane & 15, fq = lane >> 4;
    int K_ = g.K; asm volatile("" : "+s"(K_));
    const int K = K_, nt = K / BK;
    unsigned voffB[2], cv0[2], cv1[2], nv0[2], nv1[2]; int RA[2], CA[2];
#pragma unroll
    for (int i = 0; i < 2; ++i) { int R, C; stage_rc(tid * 16 + i * 8192, R, C); const int Rb = Epi::PERM ? ((R & ~31) + perm32(R & 31)) : R;
        RA[i] = R; CA[i] = C; voffB[i] = (unsigned)(Rb * K + C) * 2u; }
    const size_t kstep = (size_t)(BK * 2);
    const size_t hstep = (size_t)HALF * K * 2;
    const size_t tstep = 2 * hstep;
    const unsigned ldsw = (unsigned)wid * 1024u;
    const int aoff = lds_byte(wr * 64 + fr, fq * 8), boff = lds_byte(wc * 32 + fr, fq * 8);
#define PG8_SA(b, h) (((b) * 2 + (h)) * HTB)
#define PG8_SB(b, h) ((4 + (b) * 2 + (h)) * HTB)
#define PG8_STAGE(bufoff, gbase, voff) do { _Pragma("unroll") for (int _i = 0; _i < 2; ++_i) \
        __builtin_amdgcn_global_load_lds((const unsigned*)((const char*)(gbase) + (voff)[_i]), (PG8_LAS unsigned*)(lds + (bufoff) + ldsw + _i * 8192), 16, 0, 0); } while (0)
#define PG8_LDA(dst, b, h) do { _Pragma("unroll") for (int m = 0; m < 4; ++m) _Pragma("unroll") for (int k = 0; k < 2; ++k) dst[m][k] = *(const PG8_LAS bf16x8*)(lds + PG8_SA(b, h) + aoff + m * 2048 + k * 1024); } while (0)
#define PG8_LDB(dst, b, h) do { _Pragma("unroll") for (int n = 0; n < 2; ++n) _Pragma("unroll") for (int k = 0; k < 2; ++k) dst[n][k] = *(const PG8_LAS bf16x8*)(lds + PG8_SB(b, h) + boff + n * 2048 + k * 1024); } while (0)
#define PG8_MMA(ai, bj, At, Bt) do { __builtin_amdgcn_s_setprio(1); _Pragma("unroll") for (int m = 0; m < 4; ++m) _Pragma("unroll") for (int n = 0; n < 2; ++n) { \
        if constexpr (SCW != 0) mfma_f8(acc[ai][bj][m][n], cat8(Bt[n][0], Bt[n][1]), cat8(At[m][0], At[m][1]), SCW * 0x01010101, 0x7f7f7f7f); \
        else { _Pragma("unroll") for (int k = 0; k < 2; ++k) acc[ai][bj][m][n] = __builtin_amdgcn_mfma_f32_16x16x32_bf16(Bt[n][k], At[m][k], acc[ai][bj][m][n], 0, 0, 0); } } __builtin_amdgcn_s_setprio(0); } while (0)
#define PG8_WAIT_V(n) asm volatile("s_waitcnt vmcnt(" #n ")" ::: "memory")
#define PG8_WAIT_L(n) asm volatile("s_waitcnt lgkmcnt(" #n ")" ::: "memory")
#define PG8_BAR __builtin_amdgcn_s_barrier()
#define PG8_SCHED __builtin_amdgcn_sched_barrier(0)
    static_assert(SP2, "gemm_phase_g: SP2 form only");
    Unit cur, nxt; int ui = 0;
    if (!S.next(0, cur)) return;
    f32x4 acc[2][2][4][2];
#pragma unroll
    for (int a = 0; a < 2; ++a)
#pragma unroll
        for (int b = 0; b < 2; ++b)
#pragma unroll
            for (int m = 0; m < 4; ++m)
#pragma unroll
                for (int n = 0; n < 2; ++n) acc[a][b][m][n] = (f32x4){0.f, 0.f, 0.f, 0.f};
    bf16x8 At[4][2], B0[2][2], B1[2][2];
    const char* gA = (const char*)g.A; const char* cB = (const char*)g.Bt + (size_t)cur.pn * tstep;
#define PG8_ROWS(pm_, v0_, v1_) do { _Pragma("unroll") for (int _i = 0; _i < 2; ++_i) { v0_[_i] = (unsigned)(rowmap[(pm_) * BM + RA[_i]] * K + CA[_i]) * 2u; v1_[_i] = (unsigned)(rowmap[(pm_) * BM + HALF + RA[_i]] * K + CA[_i]) * 2u; } } while (0)
    PG8_ROWS(cur.pm, cv0, cv1);
    const unsigned voffA[2] = {0u, 0u}; const char* cA = gA; (void)voffA; (void)cA;
    S.a_ready(cur);
    if constexpr (SP2) {
        PG8_STAGE(PG8_SB(0, 0), cB, voffB); PG8_STAGE(PG8_SB(0, 1), cB + hstep, voffB); PG8_STAGE(PG8_SA(0, 0), gA, cv0); PG8_STAGE(PG8_SA(0, 1), gA, cv1);
        if (wr == 1) PG8_BAR;
        PG8_WAIT_V(2); PG8_BAR;
        PG8_STAGE(PG8_SB(1, 0), cB + kstep, voffB); PG8_STAGE(PG8_SA(1, 0), gA + kstep, cv0); PG8_STAGE(PG8_SB(1, 1), cB + hstep + kstep, voffB);
        PG8_WAIT_V(6); PG8_BAR;
    } else {
        PG8_STAGE(PG8_SB(0, 0), cB, voffB); PG8_STAGE(PG8_SA(0, 0), cA, voffA); PG8_STAGE(PG8_SB(0, 1), cB + hstep, voffB); PG8_STAGE(PG8_SA(0, 1), cA + hstep, voffA);
        if (wr == 1) PG8_BAR;
        PG8_WAIT_V(4); PG8_BAR;
        PG8_STAGE(PG8_SB(1, 0), cB + kstep, voffB); PG8_STAGE(PG8_SA(1, 0), cA + kstep, voffA); PG8_STAGE(PG8_SB(1, 1), cB + hstep + kstep, voffB);
        PG8_WAIT_V(6); PG8_BAR;
    }
    for (;;) {
        const bool has_next = S.next(ui + 1, nxt);
        const char* nB = has_next ? (const char*)g.Bt + (size_t)nxt.pn * tstep : cB;
        if (has_next) PG8_ROWS(nxt.pm, nv0, nv1); else { nv0[0] = cv0[0]; nv0[1] = cv0[1]; nv1[0] = cv1[0]; nv1[1] = cv1[1]; }
        for (int t = 0; t < nt; t += 2) {
            const bool last = (t == nt - 2);
            const char* a1 = gA + (size_t)(t + 1) * kstep;
            const char* a2 = last ? gA : gA + (size_t)(t + 2) * kstep; const char* b2 = last ? nB : cB + (size_t)(t + 2) * kstep;
            unsigned w0[2], w1[2]; w0[0] = last ? nv0[0] : cv0[0]; w0[1] = last ? nv0[1] : cv0[1]; w1[0] = last ? nv1[0] : cv1[0]; w1[1] = last ? nv1[1] : cv1[1];
            const char* a3 = a2 + kstep; const char* b3 = b2 + kstep;
            if (last && has_next) S.a_ready(nxt);
            if constexpr (SP2) {
            PG8_LDB(B0, 0, 0); PG8_LDB(B1, 0, 1); PG8_SCHED; PG8_LDA(At, 0, 0); PG8_STAGE(PG8_SA(1, 1), a1, cv1);
            PG8_WAIT_V(8); PG8_WAIT_L(0); PG8_BAR; PG8_MMA(0, 0, At, B0); PG8_MMA(0, 1, At, B1); PG8_BAR; PG8_SCHED;
            PG8_LDA(At, 0, 1); PG8_STAGE(PG8_SB(0, 0), b2, voffB); PG8_STAGE(PG8_SB(0, 1), b2 + hstep, voffB); PG8_STAGE(PG8_SA(0, 0), a2, w0);
            PG8_WAIT_V(8); PG8_WAIT_L(0); PG8_BAR; PG8_MMA(1, 0, At, B0); PG8_MMA(1, 1, At, B1); PG8_BAR; PG8_SCHED;
            PG8_LDB(B0, 1, 0); PG8_LDB(B1, 1, 1); PG8_SCHED; PG8_LDA(At, 1, 0); PG8_STAGE(PG8_SA(0, 1), a2, w1);
            PG8_WAIT_V(8); PG8_WAIT_L(0); PG8_BAR; PG8_MMA(0, 0, At, B0); PG8_MMA(0, 1, At, B1); PG8_BAR; PG8_SCHED;
            PG8_LDA(At, 1, 1); PG8_STAGE(PG8_SB(1, 0), b3, voffB); PG8_STAGE(PG8_SB(1, 1), b3 + hstep, voffB); PG8_STAGE(PG8_SA(1, 0), a3, w0);
            PG8_WAIT_V(8); PG8_WAIT_L(0); PG8_BAR; PG8_MMA(1, 0, At, B0); PG8_MMA(1, 1, At, B1); PG8_BAR; PG8_SCHED;
            } else {
            PG8_LDB(B0, 0, 0); PG8_SCHED; PG8_LDA(At, 0, 0); PG8_STAGE(PG8_SA(1, 1), a1, cv1);
            PG8_WAIT_L(8); PG8_BAR; PG8_WAIT_L(0); PG8_MMA(0, 0, At, B0); PG8_BAR; PG8_SCHED;
            PG8_LDB(B1, 0, 1); PG8_STAGE(PG8_SB(0, 0), b2, voffB);
            PG8_BAR; PG8_WAIT_L(0); PG8_MMA(0, 1, At, B1); PG8_BAR;
            PG8_LDA(At, 0, 1); PG8_STAGE(PG8_SA(0, 0), a2, voffA);
            PG8_BAR; PG8_WAIT_L(0); PG8_MMA(1, 0, At, B0); PG8_BAR; PG8_SCHED;
            PG8_STAGE(PG8_SB(0, 1), b2 + hstep, voffB);
            PG8_WAIT_V(6); PG8_BAR; PG8_MMA(1, 1, At, B1); PG8_BAR;
            PG8_LDB(B0, 1, 0); PG8_SCHED; PG8_LDA(At, 1, 0); PG8_STAGE(PG8_SA(0, 1), a2, w1);
            PG8_WAIT_L(8); PG8_BAR; PG8_WAIT_L(0); PG8_MMA(0, 0, At, B0); PG8_BAR; PG8_SCHED;
            PG8_LDB(B1, 1, 1); PG8_STAGE(PG8_SB(1, 0), b3, voffB);
            PG8_BAR; PG8_WAIT_L(0); PG8_MMA(0, 1, At, B1); PG8_BAR;
            PG8_LDA(At, 1, 1); PG8_STAGE(PG8_SA(1, 0), a3, voffA);
            PG8_BAR; PG8_WAIT_L(0); PG8_MMA(1, 0, At, B0); PG8_BAR; PG8_SCHED;
            PG8_STAGE(PG8_SB(1, 1), b3 + hstep, voffB);
            PG8_WAIT_V(6); PG8_BAR; PG8_MMA(1, 1, At, B1); PG8_BAR;
            }
        }
        if constexpr (SCW != 0) asm volatile("s_nop 15\n\ts_nop 15" ::: "memory");
        if constexpr (ALIGN_EPI) { if (wr == 0) PG8_BAR; }
        if constexpr (!Epi::AFTER_DRAIN) { E(acc, cur, wr, wc, fr, fq); S.done(cur); }
        if (!has_next) break;
#pragma unroll
        for (int a = 0; a < 2; ++a)
#pragma unroll
            for (int b = 0; b < 2; ++b)
#pragma unroll
                for (int m = 0; m < 4; ++m)
#pragma unroll
                    for (int n = 0; n < 2; ++n) acc[a][b][m][n] = (f32x4){0.f, 0.f, 0.f, 0.f};
        cur = nxt; cB = nB; ++ui; cv0[0] = nv0[0]; cv0[1] = nv0[1]; cv1[0] = nv1[0]; cv1[1] = nv1[1];
        if constexpr (ALIGN_EPI) { if (wr == 1) PG8_BAR; }
    }
    PG8_WAIT_V(0);
    if constexpr (!ALIGN_EPI) { if (wr == 0) PG8_BAR; }
    PG8_BAR;
    if constexpr (Epi::AFTER_DRAIN) { E.fused(acc, cur, wr, wc, fr, fq, lds, wid, lane); S.done(cur); }
#undef PG8_ROWS
#undef PG8_SA
#undef PG8_SB
#undef PG8_STAGE
#undef PG8_LDA
#undef PG8_LDB
#undef PG8_MMA
#undef PG8_WAIT_V
#undef PG8_WAIT_L
#undef PG8_BAR
#undef PG8_SCHED
}
}

#ifndef REP_MASK
#define REP_MASK 0
#endif
#define NREP(k) (1 + ((REP_MASK >> (k)) & 1))

constexpr int NB = 16, SEQ = 2048, D = 1024, NMETA = 16;
constexpr int MX = NB * SEQ;
constexpr int INW = 3344, PW = 3584;
constexpr int GQ = 0, GK = 256, GV = 512, GG = 1024, GKL = 1536;
constexpr int RW0 = 1552;
constexpr int RR = RW0, RK = RW0 + 512, RV = RW0 + 1024, RWL = RW0 + 1536, RAL = RW0 + 1600, RGL = RW0 + 1664;
constexpr int NE = 32, TOPK = 4;
constexpr int NCH = 33;
constexpr float ALPHA = 1.189207115002721f;
constexpr int NWAVES = 8, NTHR = 512;

constexpr size_t MiB = 1u << 20;
constexpr size_t WS_CTL = 0, CTL_ZERO_BYTES = 1 * MiB;
constexpr size_t WS_STATS = 1 * MiB;
constexpr size_t WS_TOPI  = WS_STATS + 256 * 1024;
constexpr size_t WS_GATE  = WS_TOPI + 512 * 1024;
constexpr size_t WS_RANK  = WS_GATE + 512 * 1024;
constexpr size_t WS_TSLOT = WS_RANK + 512 * 1024;
constexpr size_t WS_BON   = WS_TSLOT + 512 * 1024;
constexpr size_t WS_PROJM = WS_BON + 1 * MiB;
constexpr size_t WS_OPSM  = WS_PROJM + 256 * 1024;
constexpr size_t WS_DL    = WS_OPSM + 256 * 1024;
constexpr size_t WS_W2T   = WS_DL + 1 * MiB;
constexpr size_t WS_A2T   = WS_W2T + 64 * 1024;
constexpr size_t WS_G2T   = WS_A2T + 64 * 1024;
constexpr size_t WS_TILEE = WS_G2T + 128 * 1024;
constexpr size_t WS_SLOTTOK = WS_TILEE + 4096;
constexpr size_t WS_WIN   = 8 * MiB;
constexpr size_t WS_WOUT  = 15 * MiB;
static_assert(WS_SLOTTOK + 139264 * 4 <= WS_WIN, "table region");
constexpr size_t WS_A0    = 20 * MiB;
constexpr size_t WS_YMIX  = WS_A0;
constexpr size_t WS_PROJ  = 84 * MiB;
constexpr size_t WS_R1    = 308 * MiB;
constexpr size_t WS_GAM   = 520 * MiB;
constexpr size_t WS_GUS   = 692 * MiB;
constexpr size_t WS_H1    = 20 * MiB;
constexpr size_t WS_XS    = 84 * MiB;
constexpr size_t WS_YS    = WS_XS;
constexpr size_t WS_ACT   = 356 * MiB;
constexpr size_t WS_S1    = 628 * MiB;
constexpr size_t WS_WUP   = 758 * MiB;
constexpr size_t WS_WDN   = 822 * MiB;
constexpr size_t WS_H1Q   = 854 * MiB;
constexpr size_t WS_END   = 886 * MiB;
constexpr int CW_BAR = 4096;
constexpr int CW_CNT = 16384;
constexpr int CW_QH = 20480;

constexpr int RING_BYTES = 131072;
constexpr int LDS_BYTES = 147456;
constexpr int TAB_OFF = 132096;
constexpr int MISC_OFF = LDS_BYTES - 512;

#define LAS __attribute__((address_space(3)))
typedef unsigned short bf16;
typedef unsigned v4u __attribute__((ext_vector_type(4)));
typedef unsigned v2u __attribute__((ext_vector_type(2)));
typedef float f32x4 __attribute__((ext_vector_type(4)));
typedef short bf16x8 __attribute__((ext_vector_type(8)));
#define LDS_WAIT() asm volatile("s_waitcnt lgkmcnt(0)" ::: "memory")
__device__ __forceinline__ float bflo(unsigned w) { return __uint_as_float(w << 16); }
__device__ __forceinline__ float bfhi(unsigned w) { return __uint_as_float(w & 0xffff0000u); }
typedef float f32x2_t __attribute__((ext_vector_type(2))); typedef __bf16 bf16x2_t __attribute__((ext_vector_type(2)));
__device__ __forceinline__ unsigned pk2(float lo, float hi) { const f32x2_t v = {lo, hi}; const bf16x2_t b = __builtin_convertvector(v, bf16x2_t); return __builtin_bit_cast(unsigned, b); }
__device__ __forceinline__ unsigned f2bf(float f) { return pk2(f, 0.f) & 0xffffu; }
__device__ __forceinline__ void lds_barrier() { asm volatile("s_waitcnt lgkmcnt(0)" ::: "memory"); __builtin_amdgcn_s_barrier(); asm volatile("" ::: "memory"); }
__device__ __forceinline__ float shx(float v, int mask, int lane) { return __int_as_float(__builtin_amdgcn_ds_bpermute((lane ^ mask) << 2, __float_as_int(v))); }
template <int CTRL> __device__ __forceinline__ float dppf0(float x) { return __int_as_float(__builtin_amdgcn_update_dpp(0, __float_as_int(x), CTRL, 0xF, 0xF, true)); }
__device__ __forceinline__ float wave_sum(float v, int lane) {
    v += dppf0<0xB1>(v); v += dppf0<0x4E>(v); v += dppf0<0x141>(v); v += dppf0<0x140>(v);
    v += shx(v, 16, lane); v += shx(v, 32, lane);
    return v;
}
__device__ __forceinline__ float softplus_f(float x) { return fmaxf(x, 0.f) + log1pf(expf(-fabsf(x))); }
__device__ __forceinline__ float logsigmoid_f(float x) { return fminf(x, 0.f) - log1pf(expf(-fabsf(x))); }
__device__ __forceinline__ float sigmoid_f(float x) { return 1.f / (1.f + expf(-x)); }
__device__ __forceinline__ float fexp(float x) { return __builtin_amdgcn_exp2f(x * 1.4426950408889634f); }
__device__ __forceinline__ float flog(float x) { return __builtin_amdgcn_logf(x) * 0.6931471805599453f; }
__device__ __forceinline__ float fsigmoid(float x) { return __builtin_amdgcn_rcpf(1.f + fexp(-x)); }
__device__ __forceinline__ float ftanh(float x) { return 2.f * fsigmoid(2.f * x) - 1.f; }
__device__ __forceinline__ float fsoftplus(float x) { return fmaxf(x, 0.f) + flog(1.f + fexp(-fabsf(x))); }
__device__ __forceinline__ float flogsigmoid(float x) { return fminf(x, 0.f) - flog(1.f + fexp(-fabsf(x))); }
template <int CTRL> __device__ __forceinline__ float dppf(float x) { return __int_as_float(__builtin_amdgcn_update_dpp(0, __float_as_int(x), CTRL, 0xF, 0xF, true)); }
__device__ __forceinline__ float red8(float x) {
    x += dppf<0xB1>(x); x += dppf<0x4E>(x); x += dppf<0x141>(x); return x;
}
__device__ __forceinline__ f32x4 mfma16(bf16x8 a, bf16x8 b, f32x4 c) { return __builtin_amdgcn_mfma_f32_16x16x32_bf16(a, b, c, 0, 0, 0); }
__device__ __forceinline__ unsigned ld_agent(const unsigned* p) { return __hip_atomic_load(p, __ATOMIC_RELAXED, __HIP_MEMORY_SCOPE_AGENT); }

#define XB_TMO      128
#define XB_XCNT(j)  (256  + 64 * (j))
#define XB_XSUB(j)  (1280 + 64 * (j))
#define XB_XGEN(j)  (2304 + 64 * (j))
#define XB_TOP      3328
#define XB_TOPGEN   3392
#define XCD_BAR_WORDS 3456
#define XB_SPIN_CAP (1u << 18)
__device__ __forceinline__ unsigned xb_ld(unsigned* p)              { return __hip_atomic_load(p, __ATOMIC_RELAXED, __HIP_MEMORY_SCOPE_AGENT); }
__device__ __forceinline__ unsigned xb_add(unsigned* p, unsigned v) { return __hip_atomic_fetch_add(p, v, __ATOMIC_RELAXED, __HIP_MEMORY_SCOPE_AGENT); }
__device__ __forceinline__ unsigned xb_xcc_id() { return (unsigned)__builtin_amdgcn_s_getreg((3 << 11) | 20) & 0xFu; }
#define XB_SPIN(cond, bar) do { unsigned _sp = 0; while (cond) { __builtin_amdgcn_s_sleep(1); \
    if ((++_sp & 255u) == 0u) { if (xb_ld(&(bar)[XB_TMO])) break; if (_sp > XB_SPIN_CAP) { atomicAdd(&(bar)[XB_TMO], 1u); break; } } } } while (0)
struct XcdBarrier { unsigned* bar; unsigned x; volatile LAS unsigned* st; };
__device__ __forceinline__ XcdBarrier xcd_barrier_post(unsigned* bar, volatile LAS unsigned* st, bool leader) {
    XcdBarrier b; b.bar = bar; b.x = xb_xcc_id(); b.st = st;
    if (leader) (void)xb_add(&bar[XB_XCNT(b.x)], 1u);
    return b;
}
__device__ __forceinline__ void xcd_barrier_complete(unsigned* bar, unsigned x, unsigned& nloc, unsigned& nx) {
    const unsigned G = gridDim.x * gridDim.y * gridDim.z;
    unsigned sum, cnt, mine, sp = 0u;
    for (;;) {
        sum = 0u; cnt = 0u; mine = 0u;
#pragma unroll
        for (unsigned j = 0; j < 16; ++j) { const unsigned c = xb_ld(&bar[XB_XCNT(j)]); sum += c; cnt += (c > 0u) ? 1u : 0u; mine = (j == x) ? c : mine; }
        if (sum == G) break;
        __builtin_amdgcn_s_sleep(1);
        if ((++sp & 255u) == 0u) { if (xb_ld(&bar[XB_TMO])) break; if (sp > XB_SPIN_CAP) { atomicAdd(&bar[XB_TMO], 1u); break; } }
    }
    nloc = mine > 0u ? mine : 1u; nx = cnt > 0u ? cnt : 1u;
}
__device__ __forceinline__ void xcd_barrier(const XcdBarrier& b, bool leader) {
    asm volatile("s_waitcnt vmcnt(0)" ::: "memory");
    __syncthreads();
    if (leader) {
        unsigned* bar = b.bar;
        __builtin_amdgcn_s_waitcnt(0);
        unsigned nloc = b.st[0], nx = b.st[1];
        if (nloc == 0u) { xcd_barrier_complete(bar, b.x, nloc, nx); b.st[0] = nloc; b.st[1] = nx; }
        const unsigned old = xb_add(&bar[XB_XSUB(b.x)], 1u);
        const unsigned gen = old / nloc;
        if (old + 1u == (gen + 1u) * nloc) {
            __builtin_amdgcn_fence(__ATOMIC_RELEASE, "agent");
            asm volatile("s_waitcnt vmcnt(0)" ::: "memory");
            const unsigned og = xb_add(&bar[XB_TOP], 1u);
            const unsigned tg = og / nx;
            if (og + 1u == (tg + 1u) * nx) xb_add(&bar[XB_TOPGEN], 1u);
            else XB_SPIN(xb_ld(&bar[XB_TOPGEN]) == tg, bar);
            __builtin_amdgcn_fence(__ATOMIC_ACQUIRE, "agent");
            xb_add(&bar[XB_XGEN(b.x)], 1u);
            asm volatile("s_waitcnt vmcnt(0)" ::: "memory");
        } else {
            XB_SPIN(xb_ld(&bar[XB_XGEN(b.x)]) == gen, bar);
            __builtin_amdgcn_fence(__ATOMIC_ACQUIRE, "agent");
            asm volatile("s_waitcnt vmcnt(0)" ::: "memory");
        }
    }
    __syncthreads();
}

struct Args { const float* in[30]; float* out; unsigned char* ws; };
enum { I_X = 0, I_META, I_LNIN_G, I_LNIN_B, I_WIN, I_GKW2, I_GKB, I_GNORM, I_MU, I_W0, I_W2, I_A0, I_A2, I_G2, I_KK, I_KA, I_RK, I_RLNG, I_RLNB, I_WOUT,
       I_LN1G, I_LN1B, I_RTW, I_RTB, I_WUP, I_BUP, I_WDN, I_BDN, I_LN2G, I_LN2B };
struct Frame { LAS unsigned char* lds; int tid, lane, wave, blk, G; };
__device__ __forceinline__ int lane_id() { int l; asm volatile("v_mbcnt_lo_u32_b32 %0, -1, 0\n\tv_mbcnt_hi_u32_b32 %0, -1, %0" : "=v"(l)); return l; }
__device__ __forceinline__ Frame mkframe(LAS unsigned char* lds, int wave) { Frame F; F.lds = lds; F.wave = wave; F.lane = lane_id(); F.tid = wave * 64 + F.lane; F.blk = blockIdx.x; F.G = gridDim.x; return F; }

__device__ __forceinline__ void transpose_item(const float* W, int K, int N, int nblk, bf16* WT, LAS float* scr, int item, int lane) {
    const int kb = item / nblk, nb = item - kb * nblk, k0 = 64 * kb, n0 = 32 * nb;
    const int nn = n0 + (lane & 31); const bool ok = nn < N;
#pragma unroll 8
    for (int i = 0; i < 32; ++i) { const int kk = 2 * i + (lane >> 5); scr[kk * 33 + (lane & 31)] = ok ? W[(size_t)(k0 + kk) * N + nn] : 0.f; }
    LDS_WAIT();
    const int c = lane & 7;
#pragma unroll
    for (int j = 0; j < 4; ++j) { const int n = (lane >> 3) + 8 * j; const LAS float* s = scr + (8 * c) * 33 + n;
        v4u o; o.x = pk2(s[0 * 33], s[1 * 33]); o.y = pk2(s[2 * 33], s[3 * 33]); o.z = pk2(s[4 * 33], s[5 * 33]); o.w = pk2(s[6 * 33], s[7 * 33]);
        *(v4u*)(WT + (size_t)(n0 + n) * K + k0 + 8 * c) = o; }
    LDS_WAIT();
}

__device__ __forceinline__ void transpose_item64_f8(const float* W, int K, int N, unsigned char* WT, float scale, LAS float* scr, int item, int lane) {
    const int nblk = N >> 6, kb = item / nblk, nb = item - kb * nblk, k0 = 64 * kb, n0 = 64 * nb;
    const int r4 = lane >> 4, c4 = lane & 15;
    f32x4 v[16];
#pragma unroll
    for (int i = 0; i < 16; ++i) v[i] = *(const f32x4*)(W + (size_t)(k0 + 4 * i + r4) * N + n0 + 4 * c4);
#pragma unroll
    for (int i = 0; i < 16; ++i) *(LAS f32x4*)(scr + (4 * i + r4) * 68 + 4 * c4) = v[i];
    LDS_WAIT();
    unsigned char* orow = WT + (size_t)(n0 + lane) * K + k0;
#pragma unroll
    for (int g = 0; g < 4; ++g) { const LAS float* s = scr + (16 * g) * 68 + lane; v4u o;
#pragma unroll
        for (int q = 0; q < 4; ++q) { int w = __builtin_amdgcn_cvt_pk_fp8_f32(s[(4 * q + 0) * 68] * scale, s[(4 * q + 1) * 68] * scale, 0, false);
            w = __builtin_amdgcn_cvt_pk_fp8_f32(s[(4 * q + 2) * 68] * scale, s[(4 * q + 3) * 68] * scale, w, true); o[q] = (unsigned)w; }
        *(v4u*)(orow + 16 * g) = o; }
    LDS_WAIT();
}
__device__ __forceinline__ void convert_expert_weights(const Args& a, const Frame& F, int qsel) {
    unsigned char* ws = a.ws;
    LAS float* scr = (LAS float*)(F.lds + F.wave * 17408);
    unsigned* QH = (unsigned*)(ws + WS_CTL) + CW_QH + 64 * qsel;
    constexpr int I_UP = 16 * 32, I_DN = 16 * 16, NIT = NE * (I_UP + I_DN);
    for (;;) {
        unsigned base = 0;
        if (F.lane == 0) base = __hip_atomic_fetch_add(QH, 8u, __ATOMIC_RELAXED, __HIP_MEMORY_SCOPE_AGENT);
        base = (unsigned)__builtin_amdgcn_readfirstlane((int)base);
        if (base >= (unsigned)NIT) break;
        for (int it = (int)base; it < (int)base + 8; ++it) {
            if (it < NE * I_UP) { const int e = it / I_UP, r = it - e * I_UP;
                transpose_item64_f8(a.in[I_WUP] + (size_t)e * D * 2048, D, 2048, ws + WS_WUP + (size_t)e * 2048 * D, 64.f, scr, r, F.lane); }
            else { const int it2 = it - NE * I_UP, e = it2 / I_DN, r = it2 - e * I_DN;
                transpose_item64_f8(a.in[I_WDN] + (size_t)e * D * D, D, D, ws + WS_WDN + (size_t)e * D * D, 128.f, scr, r, F.lane); }
        }
    }
}

__device__ __forceinline__ void phase0(const Args& a, const Frame& F) {
    unsigned char* ws = a.ws;
    const int gw = F.blk * NWAVES + F.wave, NGW = F.G * NWAVES;
    for (int cgp = F.blk; cgp < 53; cgp += F.G) {
        LAS float* HM = (LAS float*)F.lds;
        LAS float* PART = (LAS float*)(F.lds + 65536);
        for (int rr = 0; rr < 2; ++rr) {
            const int row = 2 * F.wave + rr; const f32x4* xr = (const f32x4*)(a.in[I_META] + row * D) + F.lane;
            f32x4 v[4]; float s = 0.f;
#pragma unroll
            for (int j = 0; j < 4; ++j) { v[j] = xr[64 * j]; s += (v[j].x + v[j].y) + (v[j].z + v[j].w); }
            const float mean = wave_sum(s, F.lane) * (1.f / D); float s2 = 0.f;
#pragma unroll
            for (int j = 0; j < 4; ++j) { v[j] = v[j] - mean; s2 += (v[j].x * v[j].x + v[j].y * v[j].y) + (v[j].z * v[j].z + v[j].w * v[j].w); }
            const float rstd = 1.f / sqrtf(wave_sum(s2, F.lane) * (1.f / D) + 1e-5f);
#pragma unroll
            for (int j = 0; j < 4; ++j) { const int col = 4 * (F.lane + 64 * j);
                const f32x4 gv = *(const f32x4*)(a.in[I_LNIN_G] + col), bv = *(const f32x4*)(a.in[I_LNIN_B] + col);
                const f32x4 y = v[j] * rstd * gv + bv;
                HM[(col + 0) * 16 + row] = y.x; HM[(col + 1) * 16 + row] = y.y; HM[(col + 2) * 16 + row] = y.z; HM[(col + 3) * 16 + row] = y.w; }
        }
        __syncthreads();
        const int col = cgp * 64 + F.lane; const bool ok = col < INW;
        float acc[16];
#pragma unroll
        for (int r = 0; r < 16; ++r) acc[r] = 0.f;
        const float* wp = a.in[I_WIN];
        for (int k = F.wave * 128; k < F.wave * 128 + 128; ++k) {
            const float wv = ok ? wp[(size_t)k * INW + col] : 0.f;
            const LAS f32x4* h = (const LAS f32x4*)(HM + k * 16);
#pragma unroll
            for (int q = 0; q < 4; ++q) { const f32x4 hv = h[q]; acc[4 * q + 0] += hv.x * wv; acc[4 * q + 1] += hv.y * wv; acc[4 * q + 2] += hv.z * wv; acc[4 * q + 3] += hv.w * wv; }
        }
#pragma unroll
        for (int r = 0; r < 16; ++r) PART[(F.wave * 16 + r) * 64 + F.lane] = acc[r];
        __syncthreads();
        bf16* PROJM = (bf16*)(ws + WS_PROJM);
        for (int o = F.tid; o < 1024; o += NTHR) { const int r = o >> 6, l = o & 63; float s = 0.f;
#pragma unroll
            for (int w = 0; w < 8; ++w) s += PART[(w * 16 + r) * 64 + l];
            PROJM[r * PW + cgp * 64 + l] = (bf16)f2bf(s); }
        if (F.tid < 64) PROJM[NMETA * PW + cgp * 64 + F.tid] = 0;
        __syncthreads();
    }
    {
        LAS float* scr = (LAS float*)(F.lds + F.wave * 16384);
        constexpr int I_IN = 16 * (PW / 32), I_OUT = 16 * 32;
        for (int it = gw; it < I_IN + I_OUT; it += NGW) {
            if (it < I_IN) transpose_item(a.in[I_WIN], D, INW, PW / 32, (bf16*)(ws + WS_WIN), scr, it, F.lane);
            else transpose_item(a.in[I_WOUT], D, D, 32, (bf16*)(ws + WS_WOUT), scr, it - I_IN, F.lane);
        }
    }
    {
        bf16* W2T = (bf16*)(ws + WS_W2T); bf16* A2T = (bf16*)(ws + WS_A2T); bf16* G2T = (bf16*)(ws + WS_G2T);
        for (int i = F.blk * NTHR + F.tid; i < 131072; i += F.G * NTHR) {
            if (i < 32768) { const int n = i >> 6, k = i & 63; W2T[i] = (bf16)f2bf(a.in[I_W2][k * 512 + n]); }
            else if (i < 65536) { const int j = i - 32768, n = j >> 6, k = j & 63; A2T[j] = (bf16)f2bf(a.in[I_A2][k * 512 + n]); }
            else { const int j = i - 65536, n = j >> 7, k = j & 127; G2T[j] = (bf16)f2bf(a.in[I_G2][k * 512 + n]); }
        }
    }
    {
        bf16* A0 = (bf16*)(ws + WS_A0); float* ST = (float*)(ws + WS_STATS);
        for (int m = gw; m < MX; m += NGW) {
            const f32x4* xr = (const f32x4*)(a.in[I_X] + (size_t)m * D) + F.lane;
            f32x4 v[4]; float s = 0.f;
#pragma unroll
            for (int j = 0; j < 4; ++j) { v[j] = xr[64 * j]; s += (v[j].x + v[j].y) + (v[j].z + v[j].w); }
            const float mean = wave_sum(s, F.lane) * (1.f / D); float s2 = 0.f;
#pragma unroll
            for (int j = 0; j < 4; ++j) { v[j] = v[j] - mean; s2 += (v[j].x * v[j].x + v[j].y * v[j].y) + (v[j].z * v[j].z + v[j].w * v[j].w); }
            const float rstd = 1.f / sqrtf(wave_sum(s2, F.lane) * (1.f / D) + 1e-5f);
#pragma unroll
            for (int j = 0; j < 4; ++j) { const int col = 4 * (F.lane + 64 * j);
                const f32x4 gv = *(const f32x4*)(a.in[I_LNIN_G] + col), bv = *(const f32x4*)(a.in[I_LNIN_B] + col);
                const f32x4 y = v[j] * rstd * gv + bv;
                v2u o; o.x = pk2(y.x, y.y); o.y = pk2(y.z, y.w);
                *(v2u*)(A0 + (size_t)m * D + col) = o; }
            if (F.lane == 0) { ST[2 * m] = mean; ST[2 * m + 1] = rstd; }
        }
    }
}

__device__ __forceinline__ const bf16* prow(const bf16* PROJ, const bf16* PROJM, int b, int vp) {
    const bf16* px = PROJ + (size_t)(b * SEQ + (vp >= NMETA ? vp - NMETA : 0)) * PW;
    const bf16* pm = PROJM + (size_t)(vp < 0 ? NMETA : (vp < NMETA ? vp : 0)) * PW;
    return vp >= NMETA ? px : pm;
}
__device__ __forceinline__ f32x4 ldp4(const bf16* PROJ, const bf16* PROJM, int b, int vp, int col) {
    const v2u w = *(const v2u*)(prow(PROJ, PROJM, b, vp) + col);
    return (f32x4){bflo(w.x), bfhi(w.x), bflo(w.y), bfhi(w.y)};
}

constexpr int R1_STRIDE = 49152;
constexpr int TP = 80;
constexpr int L1_SLOT = 64 * TP * 2;
constexpr int L1_LC = 12 * L1_SLOT;
constexpr int L1_XCH = L1_LC + 64 * 65 * 4;
constexpr int L1_LR = 8 * L1_SLOT;
__device__ __forceinline__ v2u pack4(f32x4 v) { v2u o; o.x = pk2(v[0], v[1]); o.y = pk2(v[2], v[3]); return o; }
__device__ __forceinline__ f32x4 tile_mm(const LAS bf16* A, const LAS bf16* Bt, int rt, int ct, int fr, int fq, f32x4 acc) {
#pragma unroll
    for (int ks = 0; ks < 2; ++ks)
        acc = mfma16(*(const LAS bf16x8*)(Bt + (ct * 16 + fr) * TP + ks * 32 + 8 * fq), *(const LAS bf16x8*)(A + (rt * 16 + fr) * TP + ks * 32 + 8 * fq), acc);
    return acc;
}
__device__ __forceinline__ void tile_st(LAS bf16* O, int rt, int ct, int fr, int fq, f32x4 v) { *(LAS v2u*)(O + (rt * 16 + fr) * TP + ct * 16 + 4 * fq) = pack4(v); }
#define L1S(n) ((LAS bf16*)(F.lds + (n) * L1_SLOT))

struct L1Pf { v4u sa[5]; v2u r[2][2], k[2][2], v[2][2]; };
__device__ __forceinline__ void l1_fetch(const Args& a, const Frame& F, int b, int h, int c, L1Pf& pf) {
    const bf16* PROJ = (const bf16*)(a.ws + WS_PROJ); const bf16* PROJM = (const bf16*)(a.ws + WS_PROJM);
    const int vp0 = (c == 0) ? -48 : NMETA + 64 * (c - 1);
    { const int cg = F.tid & 31, tr = F.tid >> 5;
#pragma unroll
      for (int i = 0; i < 5; ++i) pf.sa[i] = *(const v4u*)(prow(PROJ, PROJM, b, vp0 + 4 * tr - 1 + i) + RWL + 8 * cg); }
    { const int rt = F.wave & 3, cp = F.wave >> 2, fr = F.lane & 15, fq = F.lane >> 4, vp = vp0 + rt * 16 + fr;
      const bf16* p0 = prow(PROJ, PROJM, b, vp - 1); const bf16* p1 = prow(PROJ, PROJM, b, vp);
#pragma unroll
      for (int cc = 0; cc < 2; ++cc) { const int jc = h * 64 + (2 * cp + cc) * 16 + 4 * fq;
          pf.r[cc][0] = *(const v2u*)(p0 + RR + jc); pf.r[cc][1] = *(const v2u*)(p1 + RR + jc);
          pf.k[cc][0] = *(const v2u*)(p0 + RK + jc); pf.k[cc][1] = *(const v2u*)(p1 + RK + jc);
          pf.v[cc][0] = *(const v2u*)(p0 + RV + jc); pf.v[cc][1] = *(const v2u*)(p1 + RV + jc); } }
}
__device__ __forceinline__ f32x4 unpk4(v2u w) { return (f32x4){bflo(w.x), bfhi(w.x), bflo(w.y), bfhi(w.y)}; }

__device__ __forceinline__ void rwkv_l1_front(const Args& a, const Frame& F, int b, int h, int c, const L1Pf& pf, f32x4 (&rtil)[2]) {
    unsigned char* ws = a.ws;
    const bf16* W2T = (const bf16*)(ws + WS_W2T); const bf16* A2T = (const bf16*)(ws + WS_A2T); const bf16* G2T = (const bf16*)(ws + WS_G2T);
    const int unit = (b * 8 + h) * NCH + c;
    unsigned char* r1 = ws + WS_R1 + (size_t)unit * R1_STRIDE;
    float* GAM = (float*)(ws + WS_GAM) + (size_t)unit * 64;
    const float* mu = a.in[I_MU];
    const int vp0 = (c == 0) ? -48 : NMETA + 64 * (c - 1);
    constexpr int LRP = 264;
    LAS bf16* LR = (LAS bf16*)(F.lds + L1_LR);
    LAS float* LC = (LAS float*)(F.lds + L1_LC);
    LAS float* XCH = (LAS float*)(F.lds + L1_XCH);
    const int rt = F.wave & 3, cp = F.wave >> 2, fr = F.lane & 15, fq = F.lane >> 4;
    {
        const int cg = F.tid & 31, tr = F.tid >> 5;
        const f32x4 m0 = *(const f32x4*)(mu + 1536 + 8 * cg), m1 = *(const f32x4*)(mu + 1536 + 8 * cg + 4);
#pragma unroll
        for (int i = 0; i < 4; ++i) {
            const int row = 4 * tr + i;
            const v4u cw = pf.sa[i + 1], pw = pf.sa[i];
            const f32x4 c0 = unpk4((v2u){cw.x, cw.y}), c1 = unpk4((v2u){cw.z, cw.w}), p0 = unpk4((v2u){pw.x, pw.y}), p1 = unpk4((v2u){pw.z, pw.w});
            float v[8];
            v[0] = c0.x + (p0.x - c0.x) * m0.x; v[1] = c0.y + (p0.y - c0.y) * m0.y; v[2] = c0.z + (p0.z - c0.z) * m0.z; v[3] = c0.w + (p0.w - c0.w) * m0.w;
            v[4] = c1.x + (p1.x - c1.x) * m1.x; v[5] = c1.y + (p1.y - c1.y) * m1.y; v[6] = c1.z + (p1.z - c1.z) * m1.z; v[7] = c1.w + (p1.w - c1.w) * m1.w;
#pragma unroll
            for (int q = 0; q < 8; ++q) { if (cg < 8) v[q] = ftanh(v[q]); else if (cg >= 16) v[q] = fsigmoid(v[q]); }
            v4u o; o.x = pk2(v[0], v[1]); o.y = pk2(v[2], v[3]); o.z = pk2(v[4], v[5]); o.w = pk2(v[6], v[7]);
            *(LAS v4u*)(LR + row * LRP + 8 * cg) = o;
        }
    }
    lds_barrier();
    const int t = rt * 16 + fr, vp = vp0 + t;
    const bool valid = vp >= 0;
    float lwv[2][4], asg[2][4], kkr[2][4], kmd[2][4], rrv[2][4], vvv[2][4];
    float ssq = 0.f, bon = 0.f;
    {
        const LAS bf16* lrow = LR + t * LRP + 8 * fq;
#pragma unroll
        for (int cc = 0; cc < 2; ++cc) {
            const int ct = 2 * cp + cc, j = ct * 16 + 4 * fq, jc = h * 64 + j;
            f32x4 mr[2], mk[2], mv[2], w0v[2], a0v[2], kkw[2], kaw[2], rkw[2];
            mr[cc] = *(const f32x4*)(mu + jc); mk[cc] = *(const f32x4*)(mu + 512 + jc); mv[cc] = *(const f32x4*)(mu + 1024 + jc);
            w0v[cc] = *(const f32x4*)(a.in[I_W0] + jc); a0v[cc] = *(const f32x4*)(a.in[I_A0] + jc);
            kkw[cc] = *(const f32x4*)(a.in[I_KK] + jc); kaw[cc] = *(const f32x4*)(a.in[I_KA] + jc); rkw[cc] = *(const f32x4*)(a.in[I_RK] + jc);
            f32x4 aw = {0.f, 0.f, 0.f, 0.f}, aa = aw, ag = aw;
#pragma unroll
            for (int ks = 0; ks < 2; ++ks) {
                aw = mfma16(*(const bf16x8*)(W2T + (size_t)(h * 64 + ct * 16 + fr) * 64 + ks * 32 + 8 * fq), *(const LAS bf16x8*)(lrow + ks * 32), aw);
                aa = mfma16(*(const bf16x8*)(A2T + (size_t)(h * 64 + ct * 16 + fr) * 64 + ks * 32 + 8 * fq), *(const LAS bf16x8*)(lrow + 64 + ks * 32), aa);
            }
#pragma unroll
            for (int ks = 0; ks < 4; ++ks) ag = mfma16(*(const bf16x8*)(G2T + (size_t)(h * 64 + ct * 16 + fr) * 128 + ks * 32 + 8 * fq), *(const LAS bf16x8*)(lrow + 128 + ks * 32), ag);
            const f32x4 rc = unpk4(pf.r[cc][1]), rp = unpk4(pf.r[cc][0]), kc = unpk4(pf.k[cc][1]), kp = unpk4(pf.k[cc][0]), vc = unpk4(pf.v[cc][1]), vpv = unpk4(pf.v[cc][0]);
            const f32x4 rs = rc + (rp - rc) * mr[cc], ks_ = kc + (kp - kc) * mk[cc], vs = vc + (vpv - vc) * mv[cc];
#pragma unroll
            for (int i = 0; i < 4; ++i) {
                const float u = w0v[cc][i] + aw[i];
                const float wl = -fsoftplus(-u) - 0.5f;
                lwv[cc][i] = valid ? -fexp(wl) : 0.f;
                const float as_ = fsigmoid(a0v[cc][i] + aa[i]);
                asg[cc][i] = as_;
                const float kraw = ks_[i], kk = kraw * kkw[cc][i];
                kkr[cc][i] = kk; ssq += kk * kk;
                const float km = kraw * (1.f + (as_ - 1.f) * kaw[cc][i]);
                kmd[cc][i] = km; rrv[cc][i] = rs[i]; vvv[cc][i] = vs[i];
                bon += rs[i] * km * rkw[cc][i];
            }
            *(v2u*)(r1 + 4 * 8192 + (size_t)(t * 64 + j) * 2) = pack4(ag);
            __builtin_amdgcn_sched_barrier(0);
        }
#pragma unroll
        for (int cc = 0; cc < 2; ++cc)
#pragma unroll
            for (int i = 0; i < 4; ++i) LC[t * 65 + (2 * cp + cc) * 16 + 4 * fq + i] = lwv[cc][i];
        ssq += shx(ssq, 16, F.lane); ssq += shx(ssq, 32, F.lane);
        bon += shx(bon, 16, F.lane); bon += shx(bon, 32, F.lane);
        if (fq == 0) { XCH[(cp * 64 + t) * 2] = ssq; XCH[(cp * 64 + t) * 2 + 1] = bon; }
    }
    lds_barrier();
    const float ssq_t = XCH[t * 2] + XCH[(64 + t) * 2], bon_t = XCH[t * 2 + 1] + XCH[(64 + t) * 2 + 1];
    const float inv = 1.f / fmaxf(sqrtf(ssq_t), 1e-12f);
    {
        LAS float* SEG = XCH + 256;
        const int jj = F.tid & 63, sg = F.tid >> 6;
        float cv[8];
#pragma unroll
        for (int i = 0; i < 8; ++i) cv[i] = LC[(sg * 8 + i) * 65 + jj];
#pragma unroll
        for (int i = 1; i < 8; ++i) cv[i] += cv[i - 1];
        SEG[sg * 64 + jj] = cv[7];
        lds_barrier();
        float pre = 0.f;
#pragma unroll
        for (int s2 = 0; s2 < 7; ++s2) pre += (s2 < sg) ? SEG[s2 * 64 + jj] : 0.f;
#pragma unroll
        for (int i = 0; i < 8; ++i) LC[(sg * 8 + i) * 65 + jj] = cv[i] + pre;
    }
    lds_barrier();
    {
#pragma unroll
        for (int cc = 0; cc < 2; ++cc) {
            const int j = (2 * cp + cc) * 16 + 4 * fq;
            f32x4 At, Bt, Kt, Bh, Kh, bvv;
#pragma unroll
            for (int i = 0; i < 4; ++i) {
                const float Lc = LC[t * 65 + j + i], LcC = LC[63 * 65 + j + i];
                const float kn = kkr[cc][i] * inv, av = -kn, bv = kn * asg[cc][i], km = kmd[cc][i];
                const float eA = fexp(Lc - lwv[cc][i]), eR = fexp(Lc), eB = fexp(-Lc), eH = fexp(LcC - Lc);
                At[i] = av * eA; rtil[cc][i] = rrv[cc][i] * eR; Bt[i] = bv * eB; Kt[i] = km * eB; Bh[i] = bv * eH; Kh[i] = km * eH;
                bvv[i] = bon_t * vvv[cc][i];
                if (t == 63) GAM[j + i] = fexp(LcC);
            }
            *(LAS v2u*)(L1S(0) + t * TP + j) = pack4(Bt); *(LAS v2u*)(L1S(1) + t * TP + j) = pack4(Kt);
            *(LAS v2u*)(L1S(2) + t * TP + j) = pack4(At); *(LAS v2u*)(L1S(3) + t * TP + j) = pack4(rtil[cc]);
#pragma unroll
            for (int i = 0; i < 4; ++i) {
                L1S(4)[(j + i) * TP + t] = (bf16)f2bf(At[i]); L1S(5)[(j + i) * TP + t] = (bf16)f2bf(Bh[i]);
                L1S(6)[(j + i) * TP + t] = (bf16)f2bf(Kh[i]); L1S(7)[(j + i) * TP + t] = (bf16)f2bf(vvv[cc][i]);
            }
            *(v2u*)(r1 + 5 * 8192 + (size_t)(t * 64 + j) * 2) = pack4(bvv);
        }
    }
    lds_barrier();
}
__device__ __forceinline__ void rwkv_l1_back(const Args& a, const Frame& F, int b, int h, int c, const f32x4 (&rtil)[2]) {
    unsigned char* r1 = a.ws + WS_R1 + (size_t)((b * 8 + h) * NCH + c) * R1_STRIDE;
    const int rt = F.wave & 3, cp = F.wave >> 2, fr = F.lane & 15, fq = F.lane >> 4;
    f32x4 Pt[2];
    const int mrow = rt * 16 + fr;
    const f32x4 z = {0.f, 0.f, 0.f, 0.f};
    {
        f32x4 Lv[2], Nv[2], Mv[2], Bv[2], Kv[2];
#pragma unroll
        for (int cc = 0; cc < 2; ++cc) { const int ct = 2 * cp + cc;
            Lv[cc] = tile_mm(L1S(2), L1S(0), rt, ct, fr, fq, z); Nv[cc] = tile_mm(L1S(0), L1S(2), rt, ct, fr, fq, z); Mv[cc] = tile_mm(L1S(1), L1S(2), rt, ct, fr, fq, z);
            Bv[cc] = tile_mm(L1S(3), L1S(0), rt, ct, fr, fq, z); Kv[cc] = tile_mm(L1S(3), L1S(1), rt, ct, fr, fq, z); }
#pragma unroll
        for (int cc = 0; cc < 2; ++cc) { const int ct = 2 * cp + cc, n0 = ct * 16 + 4 * fq;
#pragma unroll
            for (int i = 0; i < 4; ++i) { const int n = n0 + i;
                if (!(n < mrow)) Lv[cc][i] = 0.f; if (!(mrow < n)) { Nv[cc][i] = 0.f; Mv[cc][i] = 0.f; } if (!(n <= mrow)) { Bv[cc][i] = 0.f; Kv[cc][i] = 0.f; }
                Pt[cc][i] = Lv[cc][i] + ((n == mrow) ? 1.f : 0.f); }
            tile_st(L1S(8), rt, ct, fr, fq, Lv[cc]); tile_st(L1S(9), rt, ct, fr, fq, Nv[cc]); tile_st(L1S(10), rt, ct, fr, fq, Mv[cc]);
            tile_st(L1S(11), rt, ct, fr, fq, Bv[cc]); tile_st(L1S(12), rt, ct, fr, fq, Kv[cc]); }
    }
    lds_barrier();
#pragma unroll
    for (int st = 1; st <= 5; ++st) {
        LAS bf16* Xl = (st & 1) ? L1S(8) : L1S(0); LAS bf16* Xn = (st & 1) ? L1S(9) : L1S(1);
        LAS bf16* Yl = (st & 1) ? L1S(0) : L1S(8); LAS bf16* Yn = (st & 1) ? L1S(1) : L1S(9);
        f32x4 l2[2], n2[2];
#pragma unroll
        for (int cc = 0; cc < 2; ++cc) { const int ct = 2 * cp + cc; l2[cc] = tile_mm(Xl, Xn, rt, ct, fr, fq, z); n2[cc] = tile_mm(Xn, Xl, rt, ct, fr, fq, z); }
#pragma unroll
        for (int cc = 0; cc < 2; ++cc) { const int ct = 2 * cp + cc; tile_st(Yl, rt, ct, fr, fq, l2[cc]); tile_st(Yn, rt, ct, fr, fq, n2[cc]); tile_st(L1S(2), rt, ct, fr, fq, Pt[cc]); }
        lds_barrier();
#pragma unroll
        for (int cc = 0; cc < 2; ++cc) Pt[cc] = tile_mm(L1S(2), Yn, rt, 2 * cp + cc, fr, fq, Pt[cc]);
        lds_barrier();
    }
#pragma unroll
    for (int cc = 0; cc < 2; ++cc) tile_st(L1S(2), rt, 2 * cp + cc, fr, fq, Pt[cc]);
    lds_barrier();
    {
        f32x4 q[2], w[2];
#pragma unroll
        for (int cc = 0; cc < 2; ++cc) { const int ct = 2 * cp + cc; q[cc] = tile_mm(L1S(2), L1S(10), rt, ct, fr, fq, z); w[cc] = tile_mm(L1S(4), L1S(2), rt, ct, fr, fq, z); }
#pragma unroll
        for (int cc = 0; cc < 2; ++cc) { const int ct = 2 * cp + cc; tile_st(L1S(8), rt, ct, fr, fq, q[cc]); tile_st(L1S(9), rt, ct, fr, fq, w[cc]); }
    }
    lds_barrier();
    {
        f32x4 ul[2];
#pragma unroll
        for (int cc = 0; cc < 2; ++cc) ul[cc] = tile_mm(L1S(7), L1S(8), rt, 2 * cp + cc, fr, fq, z);
#pragma unroll
        for (int cc = 0; cc < 2; ++cc) tile_st(L1S(0), rt, 2 * cp + cc, fr, fq, ul[cc]);
    }
    lds_barrier();
    {
#pragma unroll
        for (int cc = 0; cc < 2; ++cc) { const int ct = 2 * cp + cc; const size_t eo = (size_t)(mrow * 64 + ct * 16 + 4 * fq) * 2;
            const f32x4 gp = tile_mm(L1S(5), L1S(9), rt, ct, fr, fq, z);
            const f32x4 hh = tile_mm(L1S(7), L1S(6), rt, ct, fr, fq, tile_mm(L1S(0), L1S(5), rt, ct, fr, fq, z));
            const f32x4 rh = tile_mm(L1S(11), L1S(9), rt, ct, fr, fq, rtil[cc]);
            const f32x4 yl = tile_mm(L1S(12), L1S(7), rt, ct, fr, fq, tile_mm(L1S(11), L1S(0), rt, ct, fr, fq, z));
            *(v2u*)(r1 + 0 * 8192 + eo) = pack4(gp); *(v2u*)(r1 + 1 * 8192 + eo) = pack4(hh);
            *(v2u*)(r1 + 2 * 8192 + eo) = pack4(rh); *(v2u*)(r1 + 3 * 8192 + eo) = pack4(yl); }
    }
    lds_barrier();
}

constexpr int BCP = 65;
__device__ __forceinline__ void gla_bc(const Args& a, const Frame& F, int b, int h, int vp0, int ntok) {
    const bf16* PROJ = (const bf16*)(a.ws + WS_PROJ); const bf16* PROJM = (const bf16*)(a.ws + WS_PROJM);
    LAS float* GKLs = (LAS float*)F.lds; LAS float* BC = (LAS float*)(F.lds + 4096);
    if (F.tid < 256) { const int t = F.tid >> 2, q = F.tid & 3;
        const f32x4 v = ldp4(PROJ, PROJM, b, (t < ntok) ? vp0 + t : -1, GKL + 4 * q);
        *(LAS f32x4*)(GKLs + t * 16 + 4 * q) = v; }
    lds_barrier();
    {
        const int d = F.tid & 63, tg = F.tid >> 6;
        float wc[16];
#pragma unroll
        for (int r = 0; r < 16; ++r) wc[r] = a.in[I_GKW2][r * 256 + h * 64 + d];
        const float gb = a.in[I_GKB][h * 64 + d];
#pragma unroll
        for (int i = 0; i < 8; ++i) { const int t = tg * 8 + i; float z = gb;
            const LAS f32x4* g4 = (const LAS f32x4*)(GKLs + t * 16);
#pragma unroll
            for (int q = 0; q < 4; ++q) { const f32x4 gv = g4[q]; z += gv.x * wc[4 * q] + gv.y * wc[4 * q + 1] + gv.z * wc[4 * q + 2] + gv.w * wc[4 * q + 3]; }
            BC[t * BCP + d] = (t < ntok) ? flogsigmoid(z) * (1.f / 16.f) : 0.f; }
    }
    lds_barrier();
    if (F.tid < 64) { float run = 0.f;
#pragma unroll 8
        for (int t = 0; t < 64; ++t) { run += BC[t * BCP + F.tid]; BC[t * BCP + F.tid] = run; } }
    lds_barrier();
}

__device__ __forceinline__ void gla_g1_unit(const Args& a, const Frame& F, int b, int h, int c) {
    const bf16* PROJ = (const bf16*)(a.ws + WS_PROJ); const bf16* PROJM = (const bf16*)(a.ws + WS_PROJM);
    float* GUS = (float*)(a.ws + WS_GUS); float* DL = (float*)(a.ws + WS_DL);
    const int ntok = (c == 0) ? NMETA : 64, vp0 = (c == 0) ? 0 : NMETA + 64 * (c - 1);
    gla_bc(a, F, b, h, vp0, ntok);
    LAS float* BC = (LAS float*)(F.lds + 4096);
    LAS bf16* KT = (LAS bf16*)(F.lds + 24576);
    LAS bf16* VT = (LAS bf16*)(F.lds + 24576 + 64 * TP * 2);
    {
        const int t = F.tid >> 3, q = F.tid & 7;
        const float* bl = nullptr; (void)bl;
#pragma unroll
        for (int half = 0; half < 2; ++half) {
            const int d0 = 8 * q + 4 * half;
            const f32x4 kv = ldp4(PROJ, PROJM, b, (t < ntok) ? vp0 + t : -1, GK + h * 64 + d0);
#pragma unroll
            for (int i = 0; i < 4; ++i) { const int d = d0 + i; const float e = (t < ntok) ? fexp(BC[(ntok - 1) * BCP + d] - BC[t * BCP + d]) : 0.f;
                KT[d * TP + t] = (bf16)f2bf(kv[i] * e); }
        }
#pragma unroll
        for (int qq = 0; qq < 4; ++qq) {
            const int e0 = 16 * q + 4 * qq;
            const f32x4 vv = ldp4(PROJ, PROJM, b, (t < ntok) ? vp0 + t : -1, GV + h * 128 + e0);
#pragma unroll
            for (int i = 0; i < 4; ++i) VT[(e0 + i) * TP + t] = (bf16)f2bf(vv[i]);
        }
    }
    lds_barrier();
    {
        const int rt = F.wave & 3, ch = F.wave >> 2, fr = F.lane & 15, fq = F.lane >> 4;
        float* up = GUS + ((size_t)((b * 4 + h) * NCH + c) * 64 + rt * 16 + fr) * 128;
#pragma unroll
        for (int cc = 0; cc < 4; ++cc) { const int ct = ch * 4 + cc;
            f32x4 acc = {0.f, 0.f, 0.f, 0.f};
#pragma unroll
            for (int ks = 0; ks < 2; ++ks)
                acc = mfma16(*(const LAS bf16x8*)(VT + (ct * 16 + fr) * TP + ks * 32 + 8 * fq), *(const LAS bf16x8*)(KT + (rt * 16 + fr) * TP + ks * 32 + 8 * fq), acc);
            *(f32x4*)(up + ct * 16 + 4 * fq) = acc; }
        if (F.tid < 64) DL[(size_t)((b * 4 + h) * NCH + c) * 64 + F.tid] = fexp(BC[(ntok - 1) * BCP + F.tid]);
    }
    lds_barrier();
}

__device__ __forceinline__ void phase2(const Args& a, const Frame& F) {
    {
        constexpr int NU = NB * 8 * NCH;
        const int u0 = (int)((long)F.blk * NU / F.G), u1 = (int)((long)(F.blk + 1) * NU / F.G);
        L1Pf pf;
        if (u0 < u1) l1_fetch(a, F, (u0 / NCH) >> 3, (u0 / NCH) & 7, u0 % NCH, pf);
        unsigned long long tf_ = 0, tb_ = 0;
        for (int u = u0; u < u1; ++u) {
            const int c = u % NCH, bh = u / NCH; f32x4 rtil[2];
            const unsigned long long t0_ = (REP_MASK >> 16) ? __builtin_amdgcn_s_memrealtime() : 0ull;
            { const Frame F1 = mkframe(F.lds, F.wave); rwkv_l1_front(a, F1, bh >> 3, bh & 7, c, pf, rtil); }
            const unsigned long long t1_ = (REP_MASK >> 16) ? __builtin_amdgcn_s_memrealtime() : 0ull;
            { const Frame F2 = mkframe(F.lds, F.wave);
              if (u + 1 < u1) l1_fetch(a, F2, ((u + 1) / NCH) >> 3, ((u + 1) / NCH) & 7, (u + 1) % NCH, pf);
              rwkv_l1_back(a, F2, bh >> 3, bh & 7, c, rtil); }
            const unsigned long long t2_ = (REP_MASK >> 16) ? __builtin_amdgcn_s_memrealtime() : 0ull;
            tf_ += t1_ - t0_; tb_ += t2_ - t1_;
        }
        if ((REP_MASK >> 16) != 0) {
            const unsigned long long dt_ = ((REP_MASK >> 16) == 1) ? tf_ : tb_, s0_ = __builtin_amdgcn_s_memrealtime();
            while (__builtin_amdgcn_s_memrealtime() - s0_ < dt_) __builtin_amdgcn_s_sleep(8);
        }
    }
    for (int rep_ = 0; rep_ < NREP(12); ++rep_)
    for (int u = F.blk; u < NB * 4 * 32; u += F.G) { const int c = u & 31, bh = u >> 5; gla_g1_unit(a, F, bh >> 2, bh & 3, c); }
}

__device__ __forceinline__ void rwkv_l2_unit(const Args& a, const Frame& F, int bh) {
    unsigned char* ws = a.ws;
    const int b = bh >> 3, h = bh & 7;
    LAS bf16* Sb0 = (LAS bf16*)F.lds; LAS bf16* Sb1 = Sb0 + 64 * TP;
    const int fr = F.lane & 15, fq = F.lane >> 4;
    const int rt = F.wave & 3;
    const int row = rt * 16 + fr;
    const unsigned char* r1b = ws + WS_R1 + (size_t)bh * NCH * R1_STRIDE + (size_t)(row * 64 + 4 * fq) * 2;
    if (F.wave < 4) {
        bf16* yout = (bf16*)(ws + WS_YMIX) + ((size_t)b * SEQ + row) * D + 512 + h * 64 + 4 * fq;
        f32x4 lg[4], lb[4];
#pragma unroll
        for (int ct = 0; ct < 4; ++ct) { lg[ct] = *(const f32x4*)(a.in[I_RLNG] + h * 64 + ct * 16 + 4 * fq); lb[ct] = *(const f32x4*)(a.in[I_RLNB] + h * 64 + ct * 16 + 4 * fq); }
        bf16x8 fa0, fa1; v2u q0[4], q1[4], q2[4];
#define Y_FETCH(cn) do { const unsigned char* r1 = r1b + (size_t)(cn) * R1_STRIDE; \
            fa0 = *(const bf16x8*)(r1 + 2 * 8192 + 8 * fq); fa1 = *(const bf16x8*)(r1 + 2 * 8192 + 64 + 8 * fq); \
            _Pragma("unroll") for (int ct = 0; ct < 4; ++ct) { q0[ct] = *(const v2u*)(r1 + 3 * 8192 + ct * 32); q1[ct] = *(const v2u*)(r1 + 4 * 8192 + ct * 32); q2[ct] = *(const v2u*)(r1 + 5 * 8192 + ct * 32); } } while (0)
        Y_FETCH(1);
        lds_barrier();
        lds_barrier();
#pragma nounroll
        for (int c = 1; c < NCH; ++c) {
            const LAS bf16* Sc = (c & 1) ? Sb1 : Sb0;
            const bf16x8 af0 = fa0, af1 = fa1; v2u yl[4], gw[4], bw[4];
#pragma unroll
            for (int ct = 0; ct < 4; ++ct) { yl[ct] = q0[ct]; gw[ct] = q1[ct]; bw[ct] = q2[ct]; }
            if (c + 1 < NCH) Y_FETCH(c + 1);
            f32x4 y[4]; float s = 0.f;
#pragma unroll
            for (int ct = 0; ct < 4; ++ct) {
                f32x4 acc = {bflo(yl[ct].x), bfhi(yl[ct].x), bflo(yl[ct].y), bfhi(yl[ct].y)};
                acc = mfma16(*(const LAS bf16x8*)(Sc + (ct * 16 + fr) * TP + 8 * fq), af0, acc);
                acc = mfma16(*(const LAS bf16x8*)(Sc + (ct * 16 + fr) * TP + 32 + 8 * fq), af1, acc);
                y[ct] = acc; s += (acc[0] + acc[1]) + (acc[2] + acc[3]);
            }
            s += shx(s, 16, F.lane); s += shx(s, 32, F.lane);
            const float mean = s * (1.f / 64.f); float q = 0.f;
#pragma unroll
            for (int ct = 0; ct < 4; ++ct) { y[ct] = y[ct] - mean; q += (y[ct][0] * y[ct][0] + y[ct][1] * y[ct][1]) + (y[ct][2] * y[ct][2] + y[ct][3] * y[ct][3]); }
            q += shx(q, 16, F.lane); q += shx(q, 32, F.lane);
            const float rstd = 1.f / sqrtf(q * (1.f / 64.f) + 64e-5f);
#pragma unroll
            for (int ct = 0; ct < 4; ++ct) {
                const f32x4 g = {bflo(gw[ct].x), bfhi(gw[ct].x), bflo(gw[ct].y), bfhi(gw[ct].y)}, bv = {bflo(bw[ct].x), bfhi(bw[ct].x), bflo(bw[ct].y), bfhi(bw[ct].y)};
                const f32x4 o = (y[ct] * rstd * lg[ct] + lb[ct] + bv) * g;
                *(v2u*)(yout + ct * 16) = pack4(o); }
            yout += (size_t)64 * D;
            lds_barrier();
        }
#undef Y_FETCH
    } else {
        f32x4 Sm[4];
#pragma unroll
        for (int ct = 0; ct < 4; ++ct) { Sm[ct] = (f32x4){0.f, 0.f, 0.f, 0.f}; *(LAS v2u*)(Sb0 + row * TP + ct * 16 + 4 * fq) = (v2u){0u, 0u}; }
        const float* gamb = (const float*)(ws + WS_GAM) + (size_t)bh * NCH * 64 + 4 * fq;
        const unsigned char* gpb = ws + WS_R1 + (size_t)bh * NCH * R1_STRIDE + (size_t)(fr * 64 + 8 * fq) * 2;
        bf16x8 fg[8]; v2u hq[4]; f32x4 gm[4];
#define S_FETCH(cn) do { const unsigned char* r1 = r1b + (size_t)(cn) * R1_STRIDE; const unsigned char* gp = gpb + (size_t)(cn) * R1_STRIDE; \
            _Pragma("unroll") for (int ct = 0; ct < 4; ++ct) { fg[2 * ct] = *(const bf16x8*)(gp + ct * 2048); fg[2 * ct + 1] = *(const bf16x8*)(gp + ct * 2048 + 64); \
                hq[ct] = *(const v2u*)(r1 + 8192 + ct * 32); gm[ct] = *(const f32x4*)(gamb + (size_t)(cn) * 64 + ct * 16); } } while (0)
        S_FETCH(0);
        lds_barrier();
#pragma nounroll
        for (int c = 0; c < NCH - 1; ++c) {
            const LAS bf16* Sc = (c & 1) ? Sb1 : Sb0; LAS bf16* Sn = (c & 1) ? Sb0 : Sb1;
            bf16x8 g8[8]; v2u hw[4]; f32x4 gmc[4];
#pragma unroll
            for (int ct = 0; ct < 4; ++ct) { g8[2 * ct] = fg[2 * ct]; g8[2 * ct + 1] = fg[2 * ct + 1]; hw[ct] = hq[ct]; gmc[ct] = gm[ct]; }
            if (c + 2 < NCH) S_FETCH(c + 1);
            const bf16x8 af0 = *(const LAS bf16x8*)(Sc + row * TP + 8 * fq), af1 = *(const LAS bf16x8*)(Sc + row * TP + 32 + 8 * fq);
#pragma unroll
            for (int ct = 0; ct < 4; ++ct) {
                f32x4 acc = {bflo(hw[ct].x), bfhi(hw[ct].x), bflo(hw[ct].y), bfhi(hw[ct].y)};
                acc = mfma16(g8[2 * ct], af0, acc);
                acc = mfma16(g8[2 * ct + 1], af1, acc);
                Sm[ct] = Sm[ct] * gmc[ct] + acc;
                *(LAS v2u*)(Sn + row * TP + ct * 16 + 4 * fq) = pack4(Sm[ct]); }
            lds_barrier();
        }
        lds_barrier();
#undef S_FETCH
    }
}
__device__ __forceinline__ void gla_scan_unit(const Args& a, const Frame& F, int j) {
    float* GUS = (float*)(a.ws + WS_GUS); const float* DL = (const float*)(a.ws + WS_DL);
    const int bh = j >> 1, half = j & 1;
    const int d = 32 * half + (F.tid >> 4), e0 = (F.tid & 15) * 8;
    float* base = GUS + (size_t)bh * NCH * 8192 + d * 128 + e0;
    const float* dl = DL + (size_t)bh * NCH * 64 + d;
    f32x4 s0 = {0.f, 0.f, 0.f, 0.f}, s1 = s0;
    f32x4 u0 = *(const f32x4*)(base), u1 = *(const f32x4*)(base + 4); float dc = dl[0];
    for (int c = 0; c < NCH - 1; ++c) {
        f32x4 n0 = u0, n1 = u1; float dn = dc;
        if (c + 1 < NCH - 1) { n0 = *(const f32x4*)(base + (size_t)(c + 1) * 8192); n1 = *(const f32x4*)(base + (size_t)(c + 1) * 8192 + 4); dn = dl[(c + 1) * 64]; }
        *(f32x4*)(base + (size_t)c * 8192) = s0; *(f32x4*)(base + (size_t)c * 8192 + 4) = s1;
        s0 = s0 * dc + u0; s1 = s1 * dc + u1;
        u0 = n0; u1 = n1; dc = dn;
    }
    *(f32x4*)(base + (size_t)(NCH - 1) * 8192) = s0; *(f32x4*)(base + (size_t)(NCH - 1) * 8192 + 4) = s1;
}
__device__ __forceinline__ void phase3(const Args& a, const Frame& F) {
    for (int u = F.blk; u < 256; u += F.G) { if (u < 128) { for (int rep_ = 0; rep_ < NREP(3); ++rep_) rwkv_l2_unit(a, F, u); } else gla_scan_unit(a, F, u - 128); }
    __syncthreads();
    for (int rep_ = 0; rep_ < NREP(14); ++rep_) convert_expert_weights(a, F, rep_);
}

__device__ __forceinline__ void gla_g3_unit(const Args& a, const Frame& F, int b, int h, int c) {
    const bf16* PROJ = (const bf16*)(a.ws + WS_PROJ); const bf16* PROJM = (const bf16*)(a.ws + WS_PROJM);
    const float* GUS = (const float*)(a.ws + WS_GUS); bf16* YMIX = (bf16*)(a.ws + WS_YMIX);
    const int vp0 = NMETA + 64 * (c - 1);
    gla_bc(a, F, b, h, vp0, 64);
    LAS float* BC = (LAS float*)(F.lds + 4096);
    LAS bf16* QT = (LAS bf16*)(F.lds + 24576);
    LAS bf16* KL = QT + 64 * TP;
    LAS bf16* AT = KL + 64 * TP;
    LAS bf16* VT = AT + 64 * TP;
    LAS bf16* ST = VT + 128 * TP;
    LAS float* RS = (LAS float*)(ST + 128 * TP);
    {
        const int t = F.tid >> 3, q = F.tid & 7;
        const f32x4 q0 = ldp4(PROJ, PROJM, b, vp0 + t, GQ + h * 64 + 8 * q), q1 = ldp4(PROJ, PROJM, b, vp0 + t, GQ + h * 64 + 8 * q + 4);
        const f32x4 k0 = ldp4(PROJ, PROJM, b, vp0 + t, GK + h * 64 + 8 * q), k1 = ldp4(PROJ, PROJM, b, vp0 + t, GK + h * 64 + 8 * q + 4);
        float qv[8] = {q0.x, q0.y, q0.z, q0.w, q1.x, q1.y, q1.z, q1.w}, kv[8] = {k0.x, k0.y, k0.z, k0.w, k1.x, k1.y, k1.z, k1.w};
#pragma unroll
        for (int i = 0; i < 8; ++i) { const float bcv = BC[t * BCP + 8 * q + i]; qv[i] *= fexp(bcv) * 0.125f; kv[i] *= fexp(-bcv); }
        v4u o; o.x = pk2(qv[0], qv[1]); o.y = pk2(qv[2], qv[3]); o.z = pk2(qv[4], qv[5]); o.w = pk2(qv[6], qv[7]);
        *(LAS v4u*)(QT + t * TP + 8 * q) = o;
        o.x = pk2(kv[0], kv[1]); o.y = pk2(kv[2], kv[3]); o.z = pk2(kv[4], kv[5]); o.w = pk2(kv[6], kv[7]);
        *(LAS v4u*)(KL + t * TP + 8 * q) = o;
#pragma unroll
        for (int qq = 0; qq < 4; ++qq) {
            const int e0 = 16 * q + 4 * qq;
            const f32x4 vv = ldp4(PROJ, PROJM, b, vp0 + t, GV + h * 128 + e0);
#pragma unroll
            for (int i = 0; i < 4; ++i) VT[(e0 + i) * TP + t] = (bf16)f2bf(vv[i]);
            const f32x4 sv = *(const f32x4*)(GUS + ((size_t)((b * 4 + h) * NCH + c) * 64 + t) * 128 + e0);
#pragma unroll
            for (int i = 0; i < 4; ++i) ST[(e0 + i) * TP + t] = (bf16)f2bf(sv[i]);
        }
    }
    lds_barrier();
    const int rt = F.wave & 3, wh = F.wave >> 2, fr = F.lane & 15, fq = F.lane >> 4;
    const int trow = rt * 16 + fr;
    {
#pragma unroll
        for (int cc = 0; cc < 2; ++cc) { const int ct = 2 * wh + cc;
            f32x4 acc = {0.f, 0.f, 0.f, 0.f};
#pragma unroll
            for (int ks = 0; ks < 2; ++ks)
                acc = mfma16(*(const LAS bf16x8*)(KL + (ct * 16 + fr) * TP + ks * 32 + 8 * fq), *(const LAS bf16x8*)(QT + trow * TP + ks * 32 + 8 * fq), acc);
            const int s0 = ct * 16 + 4 * fq;
#pragma unroll
            for (int i = 0; i < 4; ++i) if (s0 + i > trow) acc[i] = 0.f;
            v2u o; o.x = pk2(acc[0], acc[1]); o.y = pk2(acc[2], acc[3]);
            *(LAS v2u*)(AT + trow * TP + s0) = o; }
    }
    lds_barrier();
    f32x4 oacc[4]; float ssq = 0.f;
#pragma unroll
    for (int cc = 0; cc < 4; ++cc) { const int ct = wh * 4 + cc;
        f32x4 acc = {0.f, 0.f, 0.f, 0.f};
#pragma unroll
        for (int ks = 0; ks < 2; ++ks) {
            acc = mfma16(*(const LAS bf16x8*)(VT + (ct * 16 + fr) * TP + ks * 32 + 8 * fq), *(const LAS bf16x8*)(AT + trow * TP + ks * 32 + 8 * fq), acc);
            acc = mfma16(*(const LAS bf16x8*)(ST + (ct * 16 + fr) * TP + ks * 32 + 8 * fq), *(const LAS bf16x8*)(QT + trow * TP + ks * 32 + 8 * fq), acc);
        }
        oacc[cc] = acc; ssq += (acc[0] * acc[0] + acc[1] * acc[1]) + (acc[2] * acc[2] + acc[3] * acc[3]); }
    ssq += shx(ssq, 16, F.lane); ssq += shx(ssq, 32, F.lane);
    if (fq == 0) RS[wh * 64 + trow] = ssq;
    lds_barrier();
    {
        const float tot = RS[trow] + RS[64 + trow];
        const float rstd = 1.f / sqrtf(tot * (1.f / 128.f) + 1e-6f);
        const size_t m = (size_t)b * SEQ + (vp0 - NMETA) + trow;
#pragma unroll
        for (int cc = 0; cc < 4; ++cc) { const int e0 = (wh * 4 + cc) * 16 + 4 * fq;
            const f32x4 gv = ldp4(PROJ, PROJM, b, vp0 + trow, GG + h * 128 + e0);
            const f32x4 ng = *(const f32x4*)(a.in[I_GNORM] + e0);
            float y[4];
#pragma unroll
            for (int i = 0; i < 4; ++i) { const float gi = gv[i]; y[i] = oacc[cc][i] * rstd * ng[i] * (gi * fsigmoid(gi)); }
            v2u o; o.x = pk2(y[0], y[1]); o.y = pk2(y[2], y[3]);
            *(v2u*)(YMIX + m * D + h * 128 + e0) = o; }
    }
    lds_barrier();
}
__device__ __forceinline__ void phase4(const Args& a, const Frame& F) {
    for (int u = F.blk; u < NB * 4 * 32; u += F.G) { const int c = 1 + (u & 31), bh = u >> 5; gla_g3_unit(a, F, bh >> 2, bh & 3, c); }
}

__device__ __forceinline__ int eidx_of(int L) { return 16 * (L & 1) + 8 * ((L >> 1) & 1) + 4 * ((L >> 2) & 1) + 2 * ((L >> 3) & 1) + ((L >> 4) & 1); }
__device__ __forceinline__ void phase6(const Args& a, const Frame& F, int csel) {
    unsigned char* ws = a.ws;
    const int gw = F.blk * NWAVES + F.wave, NGW = F.G * NWAVES;
    constexpr int RWP = 1028;
    LAS float* rwT = (LAS float*)F.lds;
    LAS int* hist = (LAS int*)(F.lds + 32 * RWP * 4);
    for (int i = F.tid; i < D * NE; i += NTHR) { const int c = i >> 5, e = i & 31; rwT[e * RWP + c] = a.in[I_RTW][i]; }
    const float* S1 = (const float*)(ws + WS_S1); bf16* H1 = (bf16*)(ws + WS_H1);
    int* TOPI = (int*)(ws + WS_TOPI); float* GATE = (float*)(ws + WS_GATE); int* RANK = (int*)(ws + WS_RANK);
    unsigned* CNT = (unsigned*)(ws + WS_CTL) + CW_CNT + 2048 * csel;
    for (int rb = F.blk; rb < MX / 128; rb += F.G) {
        if (F.tid < 64) hist[F.tid] = 0;
        __syncthreads();
        int my_e = 0;
        for (int i = 0; i < 16; ++i) {
            const int m = rb * 128 + F.wave * 16 + i;
            const f32x4* xr = (const f32x4*)(S1 + (size_t)m * D) + F.lane;
            f32x4 v[4]; float s = 0.f;
#pragma unroll
            for (int j = 0; j < 4; ++j) { v[j] = xr[64 * j]; s += (v[j].x + v[j].y) + (v[j].z + v[j].w); }
            const float mean = wave_sum(s, F.lane) * (1.f / D); float s2 = 0.f;
#pragma unroll
            for (int j = 0; j < 4; ++j) { v[j] = v[j] - mean; s2 += (v[j].x * v[j].x + v[j].y * v[j].y) + (v[j].z * v[j].z + v[j].w * v[j].w); }
            const float rstd = 1.f / sqrtf(wave_sum(s2, F.lane) * (1.f / D) + 1e-5f);
#pragma unroll
            for (int j = 0; j < 4; ++j) { const int col = 4 * (F.lane + 64 * j);
                const f32x4 gv = *(const f32x4*)(a.in[I_LN1G] + col), bv = *(const f32x4*)(a.in[I_LN1B] + col);
                v[j] = v[j] * rstd * gv + bv;
                v2u o; o.x = pk2(v[j].x, v[j].y); o.y = pk2(v[j].z, v[j].w);
                *(v2u*)(H1 + (size_t)m * D + col) = o;
                int w8 = __builtin_amdgcn_cvt_pk_fp8_f32(v[j].x, v[j].y, 0, false); w8 = __builtin_amdgcn_cvt_pk_fp8_f32(v[j].z, v[j].w, w8, true);
                *(int*)(ws + WS_H1Q + (size_t)m * D + col) = w8; }
            float p[32];
#pragma unroll
            for (int e = 0; e < 32; ++e) { float acc = 0.f;
#pragma unroll
                for (int j = 0; j < 4; ++j) { const f32x4 w = *(const LAS f32x4*)(rwT + e * RWP + 4 * (F.lane + 64 * j)); acc += (v[j].x * w.x + v[j].y * w.y) + (v[j].z * w.z + v[j].w * w.w); }
                p[e] = acc; if ((e & 3) == 3) __builtin_amdgcn_sched_barrier(0); }
#define TR_STAGE(n, dmask) _Pragma("unroll") for (int i2 = 0; i2 < (n) / 2; ++i2) { const bool up = (F.lane & (dmask)) != 0; const float keep = up ? p[i2 + (n) / 2] : p[i2]; const float send = up ? p[i2] : p[i2 + (n) / 2]; p[i2] = keep + shx(send, (dmask), F.lane); }
            TR_STAGE(32, 1) TR_STAGE(16, 2) TR_STAGE(8, 4) TR_STAGE(4, 8) TR_STAGE(2, 16)
#undef TR_STAGE
            const int eidx = eidx_of(F.lane);
            const float logit = p[0] + shx(p[0], 32, F.lane) + a.in[I_RTB][eidx];
            int rank = 0;
#pragma unroll
            for (int j = 0; j < 32; ++j) { const float lj = __int_as_float(__builtin_amdgcn_readlane(__float_as_int(logit), j)); const int ej = eidx_of(j);
                rank += (lj > logit || (lj == logit && ej < eidx)) ? 1 : 0; }
            int ek[4]; float lk[4];
#pragma unroll
            for (int k = 0; k < 4; ++k) { const unsigned long long mk = __ballot(rank == k) & 0xffffffffull; const int src = __builtin_amdgcn_readfirstlane((int)__builtin_ctzll(mk | (1ull << 63)));
                ek[k] = eidx_of(src); lk[k] = __int_as_float(__builtin_amdgcn_readlane(__float_as_int(logit), src)); }
            const float e0 = 1.f, e1 = expf(lk[1] - lk[0]), e2 = expf(lk[2] - lk[0]), e3 = expf(lk[3] - lk[0]);
            const float inv = 1.f / (e0 + e1 + e2 + e3);
            if (F.lane < 4) { const int k = F.lane; const int ee = k == 0 ? ek[0] : k == 1 ? ek[1] : k == 2 ? ek[2] : ek[3]; const float gg = (k == 0 ? e0 : k == 1 ? e1 : k == 2 ? e2 : e3) * inv;
                TOPI[(size_t)m * 4 + k] = ee; GATE[(size_t)m * 4 + k] = gg; }
            if ((F.lane >> 2) == i) { const int k = F.lane & 3; my_e = k == 0 ? ek[0] : k == 1 ? ek[1] : k == 2 ? ek[2] : ek[3]; }
        }
        const int lrank = __hip_atomic_fetch_add(&hist[my_e], 1, __ATOMIC_RELAXED, __HIP_MEMORY_SCOPE_WORKGROUP);
        __syncthreads();
        if (F.tid < 32) hist[32 + F.tid] = (int)__hip_atomic_fetch_add(CNT + 64 * F.tid, (unsigned)hist[F.tid], __ATOMIC_RELAXED, __HIP_MEMORY_SCOPE_AGENT);
        __syncthreads();
        RANK[((size_t)rb * 128 + F.wave * 16 + (F.lane >> 2)) * 4 + (F.lane & 3)] = hist[32 + my_e] + lrank;
        __syncthreads();
    }
}

__device__ __forceinline__ void phase7(const Args& a, const Frame& F) {
    unsigned char* ws = a.ws;
    LAS int* starts = (LAS int*)F.lds;
    unsigned* CNT = (unsigned*)(ws + WS_CTL) + CW_CNT;
    int* TILEE = (int*)(ws + WS_TILEE); int* SLOTTOK = (int*)(ws + WS_SLOTTOK);
    if (F.tid < 32) { const int cnt = (int)ld_agent(CNT + 64 * F.tid); starts[64 + F.tid] = cnt; starts[32 + F.tid] = (cnt + 255) & ~255; }
    __syncthreads();
    if (F.tid == 0) { int run = 0; for (int e = 0; e < 32; ++e) { starts[e] = run; run += starts[32 + e]; }
        if (F.blk == 0) { TILEE[1023] = run >> 8; for (int e = 0; e < 32; ++e) for (int tl = starts[e] >> 8; tl < (starts[e] + starts[32 + e]) >> 8; ++tl) TILEE[tl] = e; } }
    __syncthreads();
    if (F.blk == 0) { for (int e = 0; e < 32; ++e) for (int s = starts[e] + starts[64 + e] + F.tid; s < starts[e] + starts[32 + e]; s += NTHR) SLOTTOK[s] = 0; }
    const int* TOPI = (const int*)(ws + WS_TOPI); const int* RANK = (const int*)(ws + WS_RANK); int* TSLOT = (int*)(ws + WS_TSLOT);
    for (int q = F.blk * NTHR + F.tid; q < MX * 4; q += F.G * NTHR) {
        const int slot = starts[TOPI[q]] + RANK[q];
        TSLOT[q] = slot; SLOTTOK[slot] = q >> 2;
    }
}
__device__ __forceinline__ int moe_fill_table(const Args& a, const Frame& F, int nN, int RM) {
    LAS int* tab = (LAS int*)(F.lds + TAB_OFF);
    const unsigned* TILEE = (const unsigned*)(a.ws + WS_TILEE);
    if (F.tid == 0) {
        const int NT = (int)ld_agent(TILEE + 1023);
        const int x = F.blk & 7, j = F.blk >> 3; int n = 0;
        for (int i = 0; i < 64; ++i) { const int s = i * 8 + x, pm = s * RM + j / nN; if (pm >= NT) break;
            const int e = (int)ld_agent(TILEE + pm); tab[2 * n] = pm; tab[2 * n + 1] = e * nN + (j % nN); ++n; }
        tab[128] = n;
    }
    __syncthreads();
    return __builtin_amdgcn_readfirstlane(tab[128]);
}

__device__ __forceinline__ void phase10(const Args& a, const Frame& F) {
    unsigned char* ws = a.ws;
    const bf16* H1 = (const bf16*)(ws + WS_H1); const bf16* YS = (const bf16*)(ws + WS_YS);
    const int* TSLOT = (const int*)(ws + WS_TSLOT); const float* GATE = (const float*)(ws + WS_GATE);
    const int gw = F.blk * NWAVES + F.wave, NGW = F.G * NWAVES;
    for (int m = gw; m < MX; m += NGW) {
        float s[16];
#pragma unroll
        for (int j = 0; j < 2; ++j) { const v4u w = *(const v4u*)(H1 + (size_t)m * D + 8 * F.lane + 512 * j);
            s[8 * j + 0] = ALPHA * bflo(w.x); s[8 * j + 1] = ALPHA * bfhi(w.x); s[8 * j + 2] = ALPHA * bflo(w.y); s[8 * j + 3] = ALPHA * bfhi(w.y);
            s[8 * j + 4] = ALPHA * bflo(w.z); s[8 * j + 5] = ALPHA * bfhi(w.z); s[8 * j + 6] = ALPHA * bflo(w.w); s[8 * j + 7] = ALPHA * bfhi(w.w); }
#pragma unroll
        for (int k = 0; k < 4; ++k) { const int slot = TSLOT[(size_t)m * 4 + k]; const float g = GATE[(size_t)m * 4 + k];
#pragma unroll
            for (int j = 0; j < 2; ++j) { const v4u w = *(const v4u*)(YS + (size_t)slot * D + 8 * F.lane + 512 * j);
                s[8 * j + 0] += g * bflo(w.x); s[8 * j + 1] += g * bfhi(w.x); s[8 * j + 2] += g * bflo(w.y); s[8 * j + 3] += g * bfhi(w.y);
                s[8 * j + 4] += g * bflo(w.z); s[8 * j + 5] += g * bfhi(w.z); s[8 * j + 6] += g * bflo(w.w); s[8 * j + 7] += g * bfhi(w.w); } }
        float t = 0.f;
#pragma unroll
        for (int i = 0; i < 16; ++i) t += s[i];
        const float mean = wave_sum(t, F.lane) * (1.f / D); float q = 0.f;
#pragma unroll
        for (int i = 0; i < 16; ++i) { s[i] -= mean; q += s[i] * s[i]; }
        const float rstd = 1.f / sqrtf(wave_sum(q, F.lane) * (1.f / D) + 1e-5f);
#pragma unroll
        for (int j = 0; j < 2; ++j) { const int col = 8 * F.lane + 512 * j;
#pragma unroll
            for (int hh = 0; hh < 2; ++hh) { const f32x4 gv = *(const f32x4*)(a.in[I_LN2G] + col + 4 * hh), bv = *(const f32x4*)(a.in[I_LN2B] + col + 4 * hh);
                f32x4 o; o.x = s[8 * j + 4 * hh + 0] * rstd * gv.x + bv.x; o.y = s[8 * j + 4 * hh + 1] * rstd * gv.y + bv.y; o.z = s[8 * j + 4 * hh + 2] * rstd * gv.z + bv.z; o.w = s[8 * j + 4 * hh + 3] * rstd * gv.w + bv.w;
                *(f32x4*)(a.out + (size_t)m * D + col + 4 * hh) = o; } }
    }
}

template <int LO, int HI>
__global__ void __launch_bounds__(NTHR, 2) fwd(Args a) {
    extern __shared__ __attribute__((aligned(16))) unsigned char lds_raw[];
    LAS unsigned char* lds = (LAS unsigned char*)lds_raw;
    const int wave = __builtin_amdgcn_readfirstlane((int)(threadIdx.x >> 6));
    volatile LAS unsigned* MISC = (volatile LAS unsigned*)(lds + MISC_OFF);
    if (wave == 0) MISC[lane_id()] = 0u;
    __syncthreads();
    unsigned* ctl = (unsigned*)(a.ws + WS_CTL);
    XcdBarrier bar; bar.bar = ctl + CW_BAR; bar.x = 0; bar.st = nullptr;
    if constexpr (HI - LO > 1) bar = xcd_barrier_post(ctl + CW_BAR, MISC + 8, wave == 0 && lane_id() == 0);
#define PH(k) if constexpr (LO <= (k) && (k) < HI)
#define SEAM(k) if constexpr (LO <= (k) && (k) + 1 < HI) xcd_barrier(bar, wave == 0 && lane_id() == 0)
    PH(0) for (int rep_ = 0; rep_ < NREP(0); ++rep_) { const Frame F = mkframe(lds, wave); phase0(a, F); } SEAM(0);
    PH(1) for (int rep_ = 0; rep_ < NREP(1); ++rep_) { const Frame F = mkframe(lds, wave);
            pg8::Gemm g{(const pg8::bf16_t*)(a.ws + WS_A0), (const pg8::bf16_t*)(a.ws + WS_WIN), MX, PW, D}; pg8::StaticOrder S; S.init(MX, PW, F.G, F.blk);
            pg8::EpiBf16Plain E{(pg8::bf16_t*)(a.ws + WS_PROJ), PW};
            pg8::gemm_phase<pg8::EpiBf16Plain, pg8::StaticOrder, true, true>(F.lds, g, S, E, F.tid); } SEAM(1);
    PH(2) for (int rep_ = 0; rep_ < NREP(2); ++rep_) { const Frame F = mkframe(lds, wave); phase2(a, F); } SEAM(2);
    PH(3) { const Frame F = mkframe(lds, wave); phase3(a, F); } SEAM(3);
    PH(4) for (int rep_ = 0; rep_ < NREP(4); ++rep_) { const Frame F = mkframe(lds, wave); phase4(a, F); } SEAM(4);
    PH(5) for (int rep_ = 0; rep_ < NREP(5); ++rep_) { const Frame F = mkframe(lds, wave);
            pg8::Gemm g{(const pg8::bf16_t*)(a.ws + WS_YMIX), (const pg8::bf16_t*)(a.ws + WS_WOUT), MX, D, D}; pg8::StaticOrder S; S.init(MX, D, F.G, F.blk);
            pg8::EpiResid E{(float*)(a.ws + WS_S1), a.in[I_X], (const float*)(a.ws + WS_STATS), a.in[I_LNIN_G], a.in[I_LNIN_B], ALPHA};
            pg8::gemm_phase<pg8::EpiResid, pg8::StaticOrder, true, true>(F.lds, g, S, E, F.tid); } SEAM(5);
    PH(6) for (int rep_ = 0; rep_ < NREP(6); ++rep_) { const Frame F = mkframe(lds, wave); phase6(a, F, rep_); } SEAM(6);
    PH(7) for (int rep_ = 0; rep_ < NREP(7); ++rep_) { const Frame F = mkframe(lds, wave); phase7(a, F); } SEAM(7);
    PH(8) for (int rep_ = 0; rep_ < NREP(8); ++rep_) { const Frame F = mkframe(lds, wave); const int n = moe_fill_table(a, F, 8, 4);
            pg8::Gemm g{(const pg8::bf16_t*)(a.ws + WS_H1Q), (const pg8::bf16_t*)(a.ws + WS_WUP), 0, 0, D / 2}; pg8::TableOrder S{(const LAS int*)(F.lds + TAB_OFF), n};
            pg8::EpiSwiglu8 E{a.ws + WS_ACT, a.in[I_BUP]};
            pg8::gemm_phase_g<pg8::EpiSwiglu8, pg8::TableOrder, true, true, 121>(F.lds, g, S, E, F.tid, (const int*)(a.ws + WS_SLOTTOK)); } SEAM(8);
    PH(9) for (int rep_ = 0; rep_ < NREP(9); ++rep_) { const Frame F = mkframe(lds, wave); const int n = moe_fill_table(a, F, 4, 8);
            pg8::Gemm g{(const pg8::bf16_t*)(a.ws + WS_ACT), (const pg8::bf16_t*)(a.ws + WS_WDN), 0, 0, D / 2}; pg8::TableOrder S{(const LAS int*)(F.lds + TAB_OFF), n};
            pg8::EpiDown E{(pg8::bf16_t*)(a.ws + WS_YS), a.in[I_BDN]};
            pg8::gemm_phase<pg8::EpiDown, pg8::TableOrder, true, true, 120>(F.lds, g, S, E, F.tid); } SEAM(9);
    PH(10) for (int rep_ = 0; rep_ < NREP(10); ++rep_) { const Frame F = mkframe(lds, wave); phase10(a, F); }
#undef PH
#undef SEAM
}

#ifndef MK_SINGLE
#define MK_SINGLE 1
#endif
template <int LO, int HI> static void launch_range(const Args& a, int grid, hipStream_t stream) {
    static bool attr = false;
    if (!attr) { (void)hipFuncSetAttribute((const void*)fwd<LO, HI>, hipFuncAttributeMaxDynamicSharedMemorySize, LDS_BYTES); attr = true; }
    hipLaunchKernelGGL((fwd<LO, HI>), dim3(grid), dim3(NTHR), LDS_BYTES, stream, a);
}
extern "C" void kernel_launch(void* const* d_in, const int* in_sizes, int n_in, void* d_out, int out_size, void* d_ws, size_t ws_size, hipStream_t stream) {
    if (n_in != 30 || ws_size < WS_END) { fprintf(stderr, "kernel_launch: unexpected inputs (n_in %d, ws %zu)\n", n_in, ws_size); return; }
    const int grid = 256;
    (void)hipMemsetAsync((char*)d_ws + WS_CTL, 0, CTL_ZERO_BYTES, stream);
    Args a{};
    for (int i = 0; i < 30; ++i) a.in[i] = (const float*)d_in[i];
    a.out = (float*)d_out; a.ws = (unsigned char*)d_ws;
#if MK_SINGLE
    launch_range<0, 11>(a, grid, stream);
#else
    launch_range<0, 1>(a, grid, stream); launch_range<1, 2>(a, grid, stream); launch_range<2, 3>(a, grid, stream); launch_range<3, 4>(a, grid, stream);
    launch_range<4, 5>(a, grid, stream); launch_range<5, 6>(a, grid, stream); launch_range<6, 7>(a, grid, stream); launch_range<7, 8>(a, grid, stream);
    launch_range<8, 9>(a, grid, stream); launch_range<9, 10>(a, grid, stream); launch_range<10, 11>(a, grid, stream);
#endif
}
```

```cpp
#include <hip/hip_runtime.h>
#include <cstdio>
#include <cstdint>
#include <cmath>
namespace pg8 {
#define PG8_LAS __attribute__((address_space(3)))
typedef unsigned short bf16_t;
typedef short bf16x8 __attribute__((ext_vector_type(8)));
typedef float f32x4 __attribute__((ext_vector_type(4)));
typedef unsigned u32x4 __attribute__((ext_vector_type(4)));
constexpr int BM = 256, BK = 64, HALF = 128, HTB = HALF * BK * 2  , STAGE_BYTES = 8 * HTB, NXCD = 8, WGM = 8;

__host__ __device__ __forceinline__ int lds_byte(int r, int c) { const int st = (r >> 4) * 2 + (c >> 5), rr = r & 15, cc = c & 31, ob = rr * 64 + cc * 2; return st * 1024 + (ob ^ (((ob >> 9) & 1) << 5)); }
__host__ __device__ __forceinline__ void stage_rc(int b, int& R, int& C) { const int st = b / 1024, sb = b % 1024, swz = sb ^ (((sb >> 9) & 1) << 5); R = (st >> 1) * 16 + swz / 64; C = (st & 1) * 32 + (swz % 64) / 2; }
__host__ __device__ __forceinline__ int perm32(int rho) { const int n = rho >> 4, i = rho & 15; return 8 * (i >> 2) + 4 * n + (i & 3); }

struct Unit { int pm, pn; };
struct Gemm { const bf16_t* A; const bf16_t* Bt; int M, N, K; };

struct StaticOrder {
    int nM, nN, nwg, G, c;
    __host__ __device__ void init(int M, int N, int G_, int c_) { nM = M / BM; nN = N / BM; nwg = nM * nN; G = G_; c = c_; }
    __host__ __device__ bool next(int i, Unit& u) const {
        const long L = (long)i * G + c; if (L >= nwg) return false;
        int wgid = (int)L; { const int q = nwg / NXCD, r = nwg % NXCD, xcd = wgid % NXCD, off = wgid / NXCD; wgid = (xcd < r ? xcd * (q + 1) : r * (q + 1) + (xcd - r) * q) + off; }
        const int nig = WGM * nN, gid = wgid / nig, fm = gid * WGM, gsz = (nM - fm) < WGM ? (nM - fm) : WGM;
        u.pm = fm + ((wgid % nig) % gsz); u.pn = (wgid % nig) / gsz; return true;
    }
    __device__ __forceinline__ void a_ready(const Unit&) const {}
    __device__ __forceinline__ void done(const Unit&) const {}
};


__device__ __forceinline__ unsigned cvt_pk_bf16(float lo, float hi) { unsigned r; asm volatile("v_cvt_pk_bf16_f32 %0, %1, %2" : "=v"(r) : "v"(lo), "v"(hi)); return r; }
typedef unsigned u32x2 __attribute__((ext_vector_type(2)));
typedef int i32x8 __attribute__((ext_vector_type(8))); typedef int i32x4 __attribute__((ext_vector_type(4)));
__device__ __forceinline__ void mfma_f8(f32x4& acc, i32x8 a, i32x8 b, int sa, int sb) {
    asm volatile("s_nop 1\n\tv_mfma_scale_f32_16x16x128_f8f6f4 %0, %1, %2, %0, %3, %4 op_sel_hi:[0,0,0]" : "+v"(acc) : "v"(a), "v"(b), "v"(sa), "v"(sb));
}
__device__ __forceinline__ i32x8 cat8(bf16x8 lo, bf16x8 hi) { const i32x4 a = __builtin_bit_cast(i32x4, lo), b = __builtin_bit_cast(i32x4, hi); return __builtin_shufflevector(a, b, 0, 1, 2, 3, 4, 5, 6, 7); }

struct EpiBf16Plain {
    static constexpr bool PERM = true, AFTER_DRAIN = false;
    bf16_t* O; int ldc;
    __device__ __forceinline__ void operator()(const f32x4 (&acc)[2][2][4][2], const Unit& u, int wr, int wc, int fr, int fq) const {
        const int row0 = u.pm * BM + wr * 64 + fr, col0 = u.pn * BM + wc * 32 + 8 * fq;
#pragma unroll
        for (int ai = 0; ai < 2; ++ai)
#pragma unroll
            for (int m = 0; m < 4; ++m) { bf16_t* rowp = O + (size_t)(row0 + ai * HALF + m * 16) * ldc + col0;
#pragma unroll
                for (int bj = 0; bj < 2; ++bj) { const f32x4 v0 = acc[ai][bj][m][0], v1 = acc[ai][bj][m][1];
                    u32x4 w; w.x = cvt_pk_bf16(v0[0], v0[1]); w.y = cvt_pk_bf16(v0[2], v0[3]); w.z = cvt_pk_bf16(v1[0], v1[1]); w.w = cvt_pk_bf16(v1[2], v1[3]);
                    *(u32x4*)(rowp + bj * HALF) = w; } }
    }
};

struct EpiResid {
    static constexpr bool PERM = false, AFTER_DRAIN = false;
    float* S1; const float* x; const float* stats; const float* g; const float* bta; float alpha;
    __device__ __forceinline__ void operator()(const f32x4 (&acc)[2][2][4][2], const Unit& u, int wr, int wc, int fr, int fq) const {
        const int row0 = u.pm * BM + wr * 64 + fr, col0 = u.pn * BM + wc * 32 + 4 * fq;
#pragma unroll
        for (int bj = 0; bj < 2; ++bj)
#pragma unroll
            for (int n = 0; n < 2; ++n) { const int c = col0 + bj * HALF + n * 16;
                const f32x4 gv = *(const f32x4*)(g + c) * alpha, bv = *(const f32x4*)(bta + c) * alpha;
#pragma unroll
                for (int ai = 0; ai < 2; ++ai)
#pragma unroll
                    for (int m = 0; m < 4; ++m) { const int r = row0 + ai * HALF + m * 16;
                        const float mean = stats[2 * r], rstd = stats[2 * r + 1];
                        const f32x4 xv = *(const f32x4*)(x + (size_t)r * 1024 + c);
                        *(f32x4*)(S1 + (size_t)r * 1024 + c) = ((xv - mean) * rstd) * gv + bv + acc[ai][bj][m][n]; } }
    }
};

__device__ __forceinline__ float swiglu1(float glu, float lin) {
    const float xg = fminf(glu, 7.0f), xl = fminf(fmaxf(lin, -7.0f), 7.0f);
    const float sg = __builtin_amdgcn_rcpf(1.0f + __expf(-1.702f * xg));
    return xg * sg * (xl + 1.0f);
}
struct EpiSwiglu {
    static constexpr bool PERM = true, AFTER_DRAIN = false;
    bf16_t* ACT; const float* bup;
    __device__ __forceinline__ void operator()(const f32x4 (&acc)[2][2][4][2], const Unit& u, int wr, int wc, int fr, int fq) const {
        const int e = u.pn >> 3, pn = u.pn & 7;
        const int row0 = u.pm * BM + wr * 64 + fr, ucol0 = pn * BM + wc * 32 + 8 * fq, acol0 = ucol0 >> 1;
        f32x4 bv[2][2];
#pragma unroll
        for (int bj = 0; bj < 2; ++bj)
#pragma unroll
            for (int n = 0; n < 2; ++n) bv[bj][n] = *(const f32x4*)(bup + (size_t)e * 2048 + ucol0 + bj * HALF + 4 * n);
#pragma unroll
        for (int ai = 0; ai < 2; ++ai)
#pragma unroll
            for (int m = 0; m < 4; ++m) { bf16_t* rowp = ACT + (size_t)(row0 + ai * HALF + m * 16) * 1024 + acol0;
#pragma unroll
                for (int bj = 0; bj < 2; ++bj) { const f32x4 v0 = acc[ai][bj][m][0] + bv[bj][0], v1 = acc[ai][bj][m][1] + bv[bj][1];
                    u32x2 w; w.x = cvt_pk_bf16(swiglu1(v0[0], v0[1]), swiglu1(v0[2], v0[3])); w.y = cvt_pk_bf16(swiglu1(v1[0], v1[1]), swiglu1(v1[2], v1[3]));
                    *(u32x2*)(rowp + bj * (HALF / 2)) = w; } }
    }
};
struct EpiSwiglu8 {
    static constexpr bool PERM = true, AFTER_DRAIN = false;
    unsigned char* ACT; const float* bup;
    __device__ __forceinline__ void operator()(const f32x4 (&acc)[2][2][4][2], const Unit& u, int wr, int wc, int fr, int fq) const {
        const int e = u.pn >> 3, pn = u.pn & 7;
        const int row0 = u.pm * BM + wr * 64 + fr, ucol0 = pn * BM + wc * 32 + 8 * fq, acol0 = ucol0 >> 1;
        f32x4 bv[2][2];
#pragma unroll
        for (int bj = 0; bj < 2; ++bj)
#pragma unroll
            for (int n = 0; n < 2; ++n) bv[bj][n] = *(const f32x4*)(bup + (size_t)e * 2048 + ucol0 + bj * HALF + 4 * n);
#pragma unroll
        for (int ai = 0; ai < 2; ++ai)
#pragma unroll
            for (int m = 0; m < 4; ++m) { unsigned char* rowp = ACT + (size_t)(row0 + ai * HALF + m * 16) * 1024 + acol0;
#pragma unroll
                for (int bj = 0; bj < 2; ++bj) { const f32x4 v0 = acc[ai][bj][m][0] + bv[bj][0], v1 = acc[ai][bj][m][1] + bv[bj][1];
                    int w = __builtin_amdgcn_cvt_pk_fp8_f32(swiglu1(v0[0], v0[1]), swiglu1(v0[2], v0[3]), 0, false);
                    w = __builtin_amdgcn_cvt_pk_fp8_f32(swiglu1(v1[0], v1[1]), swiglu1(v1[2], v1[3]), w, true);
                    *(int*)(rowp + bj * (HALF / 2)) = w; } }
    }
};
struct EpiDown {
    static constexpr bool PERM = true, AFTER_DRAIN = false;
    bf16_t* YS; const float* bdn;
    __device__ __forceinline__ void operator()(const f32x4 (&acc)[2][2][4][2], const Unit& u, int wr, int wc, int fr, int fq) const {
        const int e = u.pn >> 2, pn = u.pn & 3;
        const int row0 = u.pm * BM + wr * 64 + fr, col0 = pn * BM + wc * 32 + 8 * fq;
        f32x4 bv[2][2];
#pragma unroll
        for (int bj = 0; bj < 2; ++bj)
#pragma unroll
            for (int n = 0; n < 2; ++n) bv[bj][n] = *(const f32x4*)(bdn + (size_t)e * 1024 + col0 + bj * HALF + 4 * n);
#pragma unroll
        for (int ai = 0; ai < 2; ++ai)
#pragma unroll
            for (int m = 0; m < 4; ++m) { bf16_t* rowp = YS + (size_t)(row0 + ai * HALF + m * 16) * 1024 + col0;
#pragma unroll
                for (int bj = 0; bj < 2; ++bj) { const f32x4 v0 = acc[ai][bj][m][0] + bv[bj][0], v1 = acc[ai][bj][m][1] + bv[bj][1];
                    u32x4 w; w.x = cvt_pk_bf16(v0[0], v0[1]); w.y = cvt_pk_bf16(v0[2], v0[3]); w.z = cvt_pk_bf16(v1[0], v1[1]); w.w = cvt_pk_bf16(v1[2], v1[3]);
                    *(u32x4*)(rowp + bj * HALF) = w; } }
    }
};
struct TableOrder {
    const PG8_LAS int* tab; int n;
    __device__ __forceinline__ bool next(int i, Unit& u) const {
        if (i >= n) return false;
        u.pm = __builtin_amdgcn_readfirstlane(tab[2 * i]); u.pn = __builtin_amdgcn_readfirstlane(tab[2 * i + 1]); return true;
    }
    __device__ __forceinline__ void a_ready(const Unit&) const {}
    __device__ __forceinline__ void done(const Unit&) const {}
};

template <class Epi, class Sched, bool ALIGN_EPI = false, bool SP2 = false, int SCW = 0>
__device__ __forceinline__ void gemm_phase(PG8_LAS unsigned char* lds, const Gemm g, const Sched& S, const Epi& E, const int tid) {
    const int wid = __builtin_amdgcn_readfirstlane(tid >> 6), lane = tid & 63, wr = wid >> 2, wc = wid & 3, fr = lane & 15, fq = lane >> 4;
    int K_ = g.K; asm volatile("" : "+s"(K_));
    const int K = K_, nt = K / BK;
    unsigned voffA[2], voffB[2];
#pragma unroll
    for (int i = 0; i < 2; ++i) { int R, C; stage_rc(tid * 16 + i * 8192, R, C); const int Rb = Epi::PERM ? ((R & ~31) + perm32(R & 31)) : R;
        voffA[i] = (unsigned)(R * K + C) * 2u; voffB[i] = (unsigned)(Rb * K + C) * 2u; }
    const size_t kstep = (size_t)(BK * 2);
    const size_t hstep = (size_t)HALF * K * 2;
    const size_t tstep = 2 * hstep;
    const unsigned ldsw = (unsigned)wid * 1024u;
    const int aoff = lds_byte(wr * 64 + fr, fq * 8), boff = lds_byte(wc * 32 + fr, fq * 8);
#define PG8_SA(b, h) (((b) * 2 + (h)) * HTB)
#define PG8_SB(b, h) ((4 + (b) * 2 + (h)) * HTB)
#define PG8_STAGE(bufoff, gbase, voff) do { _Pragma("unroll") for (int _i = 0; _i < 2; ++_i) \
        __builtin_amdgcn_global_load_lds((const unsigned*)((const char*)(gbase) + (voff)[_i]), (PG8_LAS unsigned*)(lds + (bufoff) + ldsw + _i * 8192), 16, 0, 0); } while (0)
#define PG8_LDA(dst, b, h) do { _Pragma("unroll") for (int m = 0; m < 4; ++m) _Pragma("unroll") for (int k = 0; k < 2; ++k) dst[m][k] = *(const PG8_LAS bf16x8*)(lds + PG8_SA(b, h) + aoff + m * 2048 + k * 1024); } while (0)
#define PG8_LDB(dst, b, h) do { _Pragma("unroll") for (int n = 0; n < 2; ++n) _Pragma("unroll") for (int k = 0; k < 2; ++k) dst[n][k] = *(const PG8_LAS bf16x8*)(lds + PG8_SB(b, h) + boff + n * 2048 + k * 1024); } while (0)
#define PG8_MMA(ai, bj, At, Bt) do { __builtin_amdgcn_s_setprio(1); _Pragma("unroll") for (int m = 0; m < 4; ++m) _Pragma("unroll") for (int n = 0; n < 2; ++n) { \
        if constexpr (SCW != 0) mfma_f8(acc[ai][bj][m][n], cat8(Bt[n][0], Bt[n][1]), cat8(At[m][0], At[m][1]), SCW * 0x01010101, 0x7f7f7f7f); \
        else { _Pragma("unroll") for (int k = 0; k < 2; ++k) acc[ai][bj][m][n] = __builtin_amdgcn_mfma_f32_16x16x32_bf16(Bt[n][k], At[m][k], acc[ai][bj][m][n], 0, 0, 0); } } __builtin_amdgcn_s_setprio(0); } while (0)
#define PG8_WAIT_V(n) asm volatile("s_waitcnt vmcnt(" #n ")" ::: "memory")
#define PG8_WAIT_L(n) asm volatile("s_waitcnt lgkmcnt(" #n ")" ::: "memory")
#define PG8_BAR __builtin_amdgcn_s_barrier()
#define PG8_SCHED __builtin_amdgcn_sched_barrier(0)
    Unit cur, nxt; int ui = 0;
    if (!S.next(0, cur)) return;
    f32x4 acc[2][2][4][2];
#pragma unroll
    for (int a = 0; a < 2; ++a)
#pragma unroll
        for (int b = 0; b < 2; ++b)
#pragma unroll
            for (int m = 0; m < 4; ++m)
#pragma unroll
                for (int n = 0; n < 2; ++n) acc[a][b][m][n] = (f32x4){0.f, 0.f, 0.f, 0.f};
    bf16x8 At[4][2], B0[2][2], B1[2][2];
    const char* cA = (const char*)g.A + (size_t)cur.pm * tstep; const char* cB = (const char*)g.Bt + (size_t)cur.pn * tstep;
    S.a_ready(cur);
    if constexpr (SP2) {
        PG8_STAGE(PG8_SB(0, 0), cB, voffB); PG8_STAGE(PG8_SB(0, 1), cB + hstep, voffB); PG8_STAGE(PG8_SA(0, 0), cA, voffA); PG8_STAGE(PG8_SA(0, 1), cA + hstep, voffA);
        if (wr == 1) PG8_BAR;
        PG8_WAIT_V(2); PG8_BAR;
        PG8_STAGE(PG8_SB(1, 0), cB + kstep, voffB); PG8_STAGE(PG8_SA(1, 0), cA + kstep, voffA); PG8_STAGE(PG8_SB(1, 1), cB + hstep + kstep, voffB);
        PG8_WAIT_V(6); PG8_BAR;
    } else {
        PG8_STAGE(PG8_SB(0, 0), cB, voffB); PG8_STAGE(PG8_SA(0, 0), cA, voffA); PG8_STAGE(PG8_SB(0, 1), cB + hstep, voffB); PG8_STAGE(PG8_SA(0, 1), cA + hstep, voffA);
        if (wr == 1) PG8_BAR;
        PG8_WAIT_V(4); PG8_BAR;
        PG8_STAGE(PG8_SB(1, 0), cB + kstep, voffB); PG8_STAGE(PG8_SA(1, 0), cA + kstep, voffA); PG8_STAGE(PG8_SB(1, 1), cB + hstep + kstep, voffB);
        PG8_WAIT_V(6); PG8_BAR;
    }
    for (;;) {
        const bool has_next = S.next(ui + 1, nxt);
        const char* nA = has_next ? (const char*)g.A + (size_t)nxt.pm * tstep : cA; const char* nB = has_next ? (const char*)g.Bt + (size_t)nxt.pn * tstep : cB;
        for (int t = 0; t < nt; t += 2) {
            const bool last = (t == nt - 2);
            const char* a1 = cA + (size_t)(t + 1) * kstep;
            const char* a2 = last ? nA : cA + (size_t)(t + 2) * kstep; const char* b2 = last ? nB : cB + (size_t)(t + 2) * kstep;
            const char* a3 = a2 + kstep; const char* b3 = b2 + kstep;
            if (last && has_next) S.a_ready(nxt);
            if constexpr (SP2) {
            PG8_LDB(B0, 0, 0); PG8_LDB(B1, 0, 1); PG8_SCHED; PG8_LDA(At, 0, 0); PG8_STAGE(PG8_SA(1, 1), a1 + hstep, voffA);
            PG8_WAIT_V(8); PG8_WAIT_L(0); PG8_BAR; PG8_MMA(0, 0, At, B0); PG8_MMA(0, 1, At, B1); PG8_BAR; PG8_SCHED;
            PG8_LDA(At, 0, 1); PG8_STAGE(PG8_SB(0, 0), b2, voffB); PG8_STAGE(PG8_SB(0, 1), b2 + hstep, voffB); PG8_STAGE(PG8_SA(0, 0), a2, voffA);
            PG8_WAIT_V(8); PG8_WAIT_L(0); PG8_BAR; PG8_MMA(1, 0, At, B0); PG8_MMA(1, 1, At, B1); PG8_BAR; PG8_SCHED;
            PG8_LDB(B0, 1, 0); PG8_LDB(B1, 1, 1); PG8_SCHED; PG8_LDA(At, 1, 0); PG8_STAGE(PG8_SA(0, 1), a2 + hstep, voffA);
            PG8_WAIT_V(8); PG8_WAIT_L(0); PG8_BAR; PG8_MMA(0, 0, At, B0); PG8_MMA(0, 1, At, B1); PG8_BAR; PG8_SCHED;
            PG8_LDA(At, 1, 1); PG8_STAGE(PG8_SB(1, 0), b3, voffB); PG8_STAGE(PG8_SB(1, 1), b3 + hstep, voffB); PG8_STAGE(PG8_SA(1, 0), a3, voffA);
            PG8_WAIT_V(8); PG8_WAIT_L(0); PG8_BAR; PG8_MMA(1, 0, At, B0); PG8_MMA(1, 1, At, B1); PG8_BAR; PG8_SCHED;
            } else {
            PG8_LDB(B0, 0, 0); PG8_SCHED; PG8_LDA(At, 0, 0); PG8_STAGE(PG8_SA(1, 1), a1 + hstep, voffA);
            PG8_WAIT_L(8); PG8_BAR; PG8_WAIT_L(0); PG8_MMA(0, 0, At, B0); PG8_BAR; PG8_SCHED;
            PG8_LDB(B1, 0, 1); PG8_STAGE(PG8_SB(0, 0), b2, voffB);
            PG8_BAR; PG8_WAIT_L(0); PG8_MMA(0, 1, At, B1); PG8_BAR;
            PG8_LDA(At, 0, 1); PG8_STAGE(PG8_SA(0, 0), a2, voffA);
            PG8_BAR; PG8_WAIT_L(0); PG8_MMA(1, 0, At, B0); PG8_BAR; PG8_SCHED;
            PG8_STAGE(PG8_SB(0, 1), b2 + hstep, voffB);
            PG8_WAIT_V(6); PG8_BAR; PG8_MMA(1, 1, At, B1); PG8_BAR;
            PG8_LDB(B0, 1, 0); PG8_SCHED; PG8_LDA(At, 1, 0); PG8_STAGE(PG8_SA(0, 1), a2 + hstep, voffA);
            PG8_WAIT_L(8); PG8_BAR; PG8_WAIT_L(0); PG8_MMA(0, 0, At, B0); PG8_BAR; PG8_SCHED;
            PG8_LDB(B1, 1, 1); PG8_STAGE(PG8_SB(1, 0), b3, voffB);
            PG8_BAR; PG8_WAIT_L(0); PG8_MMA(0, 1, At, B1); PG8_BAR;
            PG8_LDA(At, 1, 1); PG8_STAGE(PG8_SA(1, 0), a3, voffA);
            PG8_BAR; PG8_WAIT_L(0); PG8_MMA(1, 0, At, B0); PG8_BAR; PG8_SCHED;
            PG8_STAGE(PG8_SB(1, 1), b3 + hstep, voffB);
            PG8_WAIT_V(6); PG8_BAR; PG8_MMA(1, 1, At, B1); PG8_BAR;
            }
        }
        if constexpr (SCW != 0) asm volatile("s_nop 15\n\ts_nop 15" ::: "memory");
        if constexpr (ALIGN_EPI) { if (wr == 0) PG8_BAR; }
        if constexpr (!Epi::AFTER_DRAIN) { E(acc, cur, wr, wc, fr, fq); S.done(cur); }
        if (!has_next) break;
#pragma unroll
        for (int a = 0; a < 2; ++a)
#pragma unroll
            for (int b = 0; b < 2; ++b)
#pragma unroll
                for (int m = 0; m < 4; ++m)
#pragma unroll
                    for (int n = 0; n < 2; ++n) acc[a][b][m][n] = (f32x4){0.f, 0.f, 0.f, 0.f};
        cur = nxt; cA = nA; cB = nB; ++ui;
        if constexpr (ALIGN_EPI) { if (wr == 1) PG8_BAR; }
    }
    PG8_WAIT_V(0);
    if constexpr (!ALIGN_EPI) { if (wr == 0) PG8_BAR; }
    PG8_BAR;
    if constexpr (Epi::AFTER_DRAIN) { E.fused(acc, cur, wr, wc, fr, fq, lds, wid, lane); S.done(cur); }
#undef PG8_SA
#undef PG8_SB
#undef PG8_STAGE
#undef PG8_LDA
#undef PG8_LDB
#undef PG8_MMA
#undef PG8_WAIT_V
#undef PG8_WAIT_L
#undef PG8_BAR
#undef PG8_SCHED
}
template <class Epi, class Sched, bool ALIGN_EPI = false, bool SP2 = false, int SCW = 0>
__device__ __forceinline__ void gemm_phase_g(PG8_LAS unsigned char* lds, const Gemm g, const Sched& S, const Epi& E, const int tid, const int* rowmap) {
    const int wid = __builtin_amdgcn_readfirstlane(tid >> 6), lane = tid & 63, wr = wid >> 2, wc = wid & 3, fr = lane & 15, fq = lane >> 4;
    int K_ = g.K; asm volatile("" : "+s"(K_));
    const int K = K_, nt = K / BK;
    unsigned voffB[2], cv0[2], cv1[2], nv0[2], nv1[2]; int RA[2], CA[2];
#pragma unroll
    for (int i = 0; i < 2; ++i) { int R, C; stage_rc(tid * 16 + i * 8192, R, C); const int Rb = Epi::PERM ? ((R & ~31) + perm32(R & 31)) : R;
        RA[i] = R; CA[i] = C; voffB[i] = (unsigned)(Rb * K + C) * 2u; }
    const size_t kstep = (size_t)(BK * 2);
    const size_t hstep = (size_t)HALF * K * 2;
    const size_t tstep = 2 * hstep;
    const unsigned ldsw = (unsigned)wid * 1024u;
    const int aoff = lds_byte(wr * 64 + fr, fq * 8), boff = lds_byte(wc * 32 + fr, fq * 8);
#define PG8_SA(b, h) (((b) * 2 + (h)) * HTB)
#define PG8_SB(b, h) ((4 + (b) * 2 + (h)) * HTB)
#define PG8_STAGE(bufoff, gbase, voff) do { _Pragma("unroll") for (int _i = 0; _i < 2; ++_i) \
        __builtin_amdgcn_global_load_lds((const unsigned*)((const char*)(gbase) + (voff)[_i]), (PG8_LAS unsigned*)(lds + (bufoff) + ldsw + _i * 8192), 16, 0, 0); } while (0)
#define PG8_LDA(dst, b, h) do { _Pragma("unroll") for (int m = 0; m < 4; ++m) _Pragma("unroll") for (int k = 0; k < 2; ++k) dst[m][k] = *(const PG8_LAS bf16x8*)(lds + PG8_SA(b, h) + aoff + m * 2048 + k * 1024); } while (0)
#define PG8_LDB(dst, b, h) do { _Pragma("unroll") for (int n = 0; n < 2; ++n) _Pragma("unroll") for (int k = 0; k < 2; ++k) dst[n][k] = *(const PG8_LAS bf16x8*)(lds + PG8_SB(b, h) + boff + n * 2048 + k * 1024); } while (0)
#define PG8_MMA(ai, bj, At, Bt) do { __builtin_amdgcn_s_setprio(1); _Pragma("unroll") for (int m = 0; m < 4; ++m) _Pragma("unroll") for (int n = 0; n < 2; ++n) { \
        if constexpr (SCW != 0) mfma_f8(acc[ai][bj][m][n], cat8(Bt[n][0], Bt[n][1]), cat8(At[m][0], At[m][1]), SCW * 0x01010101, 0x7f7f7f7f); \
        else { _Pragma("unroll") for (int k = 0; k < 2; ++k) acc[ai][bj][m][n] = __builtin_amdgcn_mfma_f32_16x16x32_bf16(Bt[n][k], At[m][k], acc[ai][bj][m][n], 0, 0, 0); } } __builtin_amdgcn_s_setprio(0); } while (0)
#define PG8_WAIT_V(n) asm volatile("s_waitcnt vmcnt(" #n ")" ::: "memory")
#define PG8_WAIT_L(n) asm volatile("s_waitcnt lgkmcnt(" #n ")" ::: "memory")
#define PG8_BAR __builtin_amdgcn_s_barrier()
#define PG8_SCHED __builtin_amdgcn_sched_barrier(0)
    static_assert(SP2, "gemm_phase_g: SP2 form only");
    Unit cur, nxt; int ui = 0;
    if (!S.next(0, cur)) return;
    f32x4 acc[2][2][4][2];
#pragma unroll
    for (int a = 0; a < 2; ++a)
#pragma unroll
        for (int b = 0; b < 2; ++b)
#pragma unroll
            for (int m = 0; m < 4; ++m)
#pragma unroll
                for (int n = 0; n < 2; ++n) acc[a][b][m][n] = (f32x4){0.f, 0.f, 0.f, 0.f};
    bf16x8 At[4][2], B0[2][2], B1[2][2];
    const char* gA = (const char*)g.A; const char* cB = (const char*)g.Bt + (size_t)cur.pn * tstep;
#define PG8_ROWS(pm_, v0_, v1_) do { _Pragma("unroll") for (int _i = 0; _i < 2; ++_i) { v0_[_i] = (unsigned)(rowmap[(pm_) * BM + RA[_i]] * K + CA[_i]) * 2u; v1_[_i] = (unsigned)(rowmap[(pm_) * BM + HALF + RA[_i]] * K + CA[_i]) * 2u; } } while (0)
    PG8_ROWS(cur.pm, cv0, cv1);
    const unsigned voffA[2] = {0u, 0u}; const char* cA = gA; (void)voffA; (void)cA;
    S.a_ready(cur);
    if constexpr (SP2) {
        PG8_STAGE(PG8_SB(0, 0), cB, voffB); PG8_STAGE(PG8_SB(0, 1), cB + hstep, voffB); PG8_STAGE(PG8_SA(0, 0), gA, cv0); PG8_STAGE(PG8_SA(0, 1), gA, cv1);
        if (wr == 1) PG8_BAR;
        PG8_WAIT_V(2); PG8_BAR;
        PG8_STAGE(PG8_SB(1, 0), cB + kstep, voffB); PG8_STAGE(PG8_SA(1, 0), gA + kstep, cv0); PG8_STAGE(PG8_SB(1, 1), cB + hstep + kstep, voffB);
        PG8_WAIT_V(6); PG8_BAR;
    } else {
        PG8_STAGE(PG8_SB(0, 0), cB, voffB); PG8_STAGE(PG8_SA(0, 0), cA, voffA); PG8_STAGE(PG8_SB(0, 1), cB + hstep, voffB); PG8_STAGE(PG8_SA(0, 1), cA + hstep, voffA);
        if (wr == 1) PG8_BAR;
        PG8_WAIT_V(4); PG8_BAR;
        PG8_STAGE(PG8_SB(1, 0), cB + kstep, voffB); PG8_STAGE(PG8_SA(1, 0), cA + kstep, voffA); PG8_STAGE(PG8_SB(1, 1), cB + hstep + kstep, voffB);
        PG8_WAIT_V(6); PG8_BAR;
    }
    for (;;) {
        const bool has_next = S.next(ui + 1, nxt);
        const char* nB = has_next ? (const char*)g.Bt + (size_t)nxt.pn * tstep : cB;
        if (has_next) PG8_ROWS(nxt.pm, nv0, nv1); else { nv0[0] = cv0[0]; nv0[1] = cv0[1]; nv1[0] = cv1[0]; nv1[1] = cv1[1]; }
        for (int t = 0; t < nt; t += 2) {
            const bool last = (t == nt - 2);
            const char* a1 = gA + (size_t)(t + 1) * kstep;
            const char* a2 = last ? gA : gA + (size_t)(t + 2) * kstep; const char* b2 = last ? nB : cB + (size_t)(t + 2) * kstep;
            unsigned w0[2], w1[2]; w0[0] = last ? nv0[0] : cv0[0]; w0[1] = last ? nv0[1] : cv0[1]; w1[0] = last ? nv1[0] : cv1[0]; w1[1] = last ? nv1[1] : cv1[1];
            const char* a3 = a2 + kstep; const char* b3 = b2 + kstep;
            if (last && has_next) S.a_ready(nxt);
            if constexpr (SP2) {
            PG8_LDB(B0, 0, 0); PG8_LDB(B1, 0, 1); PG8_SCHED; PG8_LDA(At, 0, 0); PG8_STAGE(PG8_SA(1, 1), a1, cv1);
            PG8_WAIT_V(8); PG8_WAIT_L(0); PG8_BAR; PG8_MMA(0, 0, At, B0); PG8_MMA(0, 1, At, B1); PG8_BAR; PG8_SCHED;
            PG8_LDA(At, 0, 1); PG8_STAGE(PG8_SB(0, 0), b2, voffB); PG8_STAGE(PG8_SB(0, 1), b2 + hstep, voffB); PG8_STAGE(PG8_SA(0, 0), a2, w0);
            PG8_WAIT_V(8); PG8_WAIT_L(0); PG8_BAR; PG8_MMA(1, 0, At, B0); PG8_MMA(1, 1, At, B1); PG8_BAR; PG8_SCHED;
            PG8_LDB(B0, 1, 0); PG8_LDB(B1, 1, 1); PG8_SCHED; PG8_LDA(At, 1, 0); PG8_STAGE(PG8_SA(0, 1), a2, w1);
            PG8_WAIT_V(8); PG8_WAIT_L(0); PG8_BAR; PG8_MMA(0, 0, At, B0); PG8_MMA(0, 1, At, B1); PG8_BAR; PG8_SCHED;
            PG8_LDA(At, 1, 1); PG8_STAGE(PG8_SB(1, 0), b3, voffB); PG8_STAGE(PG8_SB(1, 1), b3 + hstep, voffB); PG8_STAGE(PG8_SA(1, 0), a3, w0);
            PG8_WAIT_V(8); PG8_WAIT_L(0); PG8_BAR; PG8_MMA(1, 0, At, B0); PG8_MMA(1, 1, At, B1); PG8_BAR; PG8_SCHED;
            } else {
            PG8_LDB(B0, 0, 0); PG8_SCHED; PG8_LDA(At, 0, 0); PG8_STAGE(PG8_SA(1, 1), a1, cv1);
            PG8_WAIT_L(8); PG8_BAR; PG8_WAIT_L(0); PG8_MMA(0, 0, At, B0); PG8_BAR; PG8_SCHED;
            PG8_LDB(B1, 0, 1); PG8_STAGE(PG8_SB(0, 0), b2, voffB);
            PG8_BAR; PG8_WAIT_L(0); PG8_MMA(0, 1, At, B1); PG8_BAR;
            PG8_LDA(At, 0, 1); PG8_STAGE(PG8_SA(0, 0), a2, voffA);
            PG8_BAR; PG8_WAIT_L(0); PG8_MMA(1, 0, At, B0); PG8_BAR; PG8_SCHED;
            PG8_STAGE(PG8_SB(0, 1), b2 + hstep, voffB);
            PG8_WAIT_V(6); PG8_BAR; PG8_MMA(1, 1, At, B1); PG8_BAR;
            PG8_LDB(B0, 1, 0); PG8_SCHED; PG8_LDA(At, 1, 0); PG8_STAGE(PG8_SA(0, 1), a2, w1);
            PG8_WAIT_L(8); PG8_BAR; PG8_WAIT_L(0); PG8_MMA(0, 0, At, B0); PG8_BAR; PG8_SCHED;
            PG8_LDB(B1, 1, 1); PG8_STAGE(PG8_SB(1, 0), b3, voffB);
            PG8_BAR; PG8_WAIT_L(0); PG8_MMA(0, 1, At, B1); PG8_BAR;
            PG8_LDA(At, 1, 1); PG8_STAGE(PG8_SA(1, 0), a3, voffA);
            PG8_BAR; PG8_WAIT_L(0); PG8_MMA(1, 0, At, B0); PG8_BAR; PG8_SCHED;
            PG8_STAGE(PG8_SB(1, 1), b3 + hstep, voffB);
            PG8_WAIT_V(6); PG8_BAR; PG8_MMA(1, 1, At, B1); PG8_BAR;
            }
        }
        if constexpr (SCW != 0) asm volatile("s_nop 15\n\ts_nop 15" ::: "memory");
        if constexpr (ALIGN_EPI) { if (wr == 0) PG8_BAR; }
        if constexpr (!Epi::AFTER_DRAIN) { E(acc, cur, wr, wc, fr, fq); S.done(cur); }
        if (!has_next) break;
#pragma unroll
        for (int a = 0; a < 2; ++a)
#pragma unroll
            for (int b = 0; b < 2; ++b)
#pragma unroll
                for (int m = 0; m < 4; ++m)
#pragma unroll
                    for (int n = 0; n < 2; ++n) acc[a][b][m][n] = (f32x4){0.f, 0.f, 0.f, 0.f};
        cur = nxt; cB = nB; ++ui; cv0[0] = nv0[0]; cv0[1] = nv0[1]; cv1[0] = nv1[0]; cv1[1] = nv1[1];
        if constexpr (ALIGN_EPI) { if (wr == 1) PG8_BAR; }
    }
    PG8_WAIT_V(0);
    if constexpr (!ALIGN_EPI) { if (wr == 0) PG8_BAR; }
    PG8_BAR;
    if constexpr (Epi::AFTER_DRAIN) { E.fused(acc, cur, wr, wc, fr, fq, lds, wid, lane); S.done(cur); }
#undef PG8_ROWS
#undef PG8_SA
#undef PG8_SB
#undef PG8_STAGE
#undef PG8_LDA
#undef PG8_LDB
#undef PG8_MMA
#undef PG8_WAIT_V
#undef PG8_WAIT_L
#undef PG8_BAR
#undef PG8_SCHED
}
}

#ifndef REP_MASK
#define REP_MASK 0
#endif
#define NREP(k) (1 + ((REP_MASK >> (k)) & 1))

constexpr int NB = 16, SEQ = 2048, D = 1024, NMETA = 16;
constexpr int MX = NB * SEQ;
constexpr int INW = 3344, PW = 3584;
constexpr int GQ = 0, GK = 256, GV = 512, GG = 1024, GKL = 1536;
constexpr int RW0 = 1552;
constexpr int RR = RW0, RK = RW0 + 512, RV = RW0 + 1024, RWL = RW0 + 1536, RAL = RW0 + 1600, RGL = RW0 + 1664;
constexpr int NE = 32, TOPK = 4;
constexpr int NCH = 33;
constexpr float ALPHA = 1.189207115002721f;
constexpr int NWAVES = 8, NTHR = 512;

constexpr size_t MiB = 1u << 20;
constexpr size_t WS_CTL = 0, CTL_ZERO_BYTES = 1 * MiB;
constexpr size_t WS_STATS = 1 * MiB;
constexpr size_t WS_TOPI  = WS_STATS + 256 * 1024;
constexpr size_t WS_GATE  = WS_TOPI + 512 * 1024;
constexpr size_t WS_RANK  = WS_GATE + 512 * 1024;
constexpr size_t WS_TSLOT = WS_RANK + 512 * 1024;
constexpr size_t WS_BON   = WS_TSLOT + 512 * 1024;
constexpr size_t WS_PROJM = WS_BON + 1 * MiB;
constexpr size_t WS_OPSM  = WS_PROJM + 256 * 1024;
constexpr size_t WS_DL    = WS_OPSM + 256 * 1024;
constexpr size_t WS_W2T   = WS_DL + 1 * MiB;
constexpr size_t WS_A2T   = WS_W2T + 64 * 1024;
constexpr size_t WS_G2T   = WS_A2T + 64 * 1024;
constexpr size_t WS_TILEE = WS_G2T + 128 * 1024;
constexpr size_t WS_SLOTTOK = WS_TILEE + 4096;
constexpr size_t WS_WIN   = 8 * MiB;
constexpr size_t WS_WOUT  = 15 * MiB;
static_assert(WS_SLOTTOK + 139264 * 4 <= WS_WIN, "table region");
constexpr size_t WS_A0    = 20 * MiB;
constexpr size_t WS_YMIX  = WS_A0;
constexpr size_t WS_PROJ  = 84 * MiB;
constexpr size_t WS_R1    = 308 * MiB;
constexpr size_t WS_GAM   = 520 * MiB;
constexpr size_t WS_SST   = 524 * MiB;
constexpr size_t WS_GUS   = 692 * MiB;
constexpr size_t WS_H1    = 20 * MiB;
constexpr size_t WS_XS    = 84 * MiB;
constexpr size_t WS_YS    = WS_XS;
constexpr size_t WS_ACT   = 356 * MiB;
constexpr size_t WS_S1    = 628 * MiB;
constexpr size_t WS_WUP   = 758 * MiB;
constexpr size_t WS_WDN   = 822 * MiB;
constexpr size_t WS_H1Q   = 854 * MiB;
constexpr size_t WS_END   = 886 * MiB;
constexpr int CW_BAR = 4096;
constexpr int CW_CNT = 16384;
constexpr int CW_QH = 20480;

constexpr int RING_BYTES = 131072;
constexpr int LDS_BYTES = 147456;
constexpr int TAB_OFF = 132096;
constexpr int MISC_OFF = LDS_BYTES - 512;

#define LAS __attribute__((address_space(3)))
typedef unsigned short bf16;
typedef unsigned v4u __attribute__((ext_vector_type(4)));
typedef unsigned v2u __attribute__((ext_vector_type(2)));
typedef float f32x4 __attribute__((ext_vector_type(4)));
typedef short bf16x8 __attribute__((ext_vector_type(8)));
#define LDS_WAIT() asm volatile("s_waitcnt lgkmcnt(0)" ::: "memory")
__device__ __forceinline__ float bflo(unsigned w) { return __uint_as_float(w << 16); }
__device__ __forceinline__ float bfhi(unsigned w) { return __uint_as_float(w & 0xffff0000u); }
typedef float f32x2_t __attribute__((ext_vector_type(2))); typedef __bf16 bf16x2_t __attribute__((ext_vector_type(2)));
__device__ __forceinline__ unsigned pk2(float lo, float hi) { const f32x2_t v = {lo, hi}; const bf16x2_t b = __builtin_convertvector(v, bf16x2_t); return __builtin_bit_cast(unsigned, b); }
__device__ __forceinline__ unsigned f2bf(float f) { return pk2(f, 0.f) & 0xffffu; }
#define CYC() ((unsigned)__builtin_amdgcn_s_getreg((19 << 11) | 29))
__device__ __forceinline__ void lds_barrier() { asm volatile("s_waitcnt lgkmcnt(0)" ::: "memory"); __builtin_amdgcn_s_barrier(); asm volatile("" ::: "memory"); }
__device__ __forceinline__ float shx(float v, int mask, int lane) { return __int_as_float(__builtin_amdgcn_ds_bpermute((lane ^ mask) << 2, __float_as_int(v))); }
template <int CTRL> __device__ __forceinline__ float dppf0(float x) { return __int_as_float(__builtin_amdgcn_update_dpp(0, __float_as_int(x), CTRL, 0xF, 0xF, true)); }
__device__ __forceinline__ float wave_sum(float v, int lane) {
    v += dppf0<0xB1>(v); v += dppf0<0x4E>(v); v += dppf0<0x141>(v); v += dppf0<0x140>(v);
    v += shx(v, 16, lane); v += shx(v, 32, lane);
    return v;
}
__device__ __forceinline__ float softplus_f(float x) { return fmaxf(x, 0.f) + log1pf(expf(-fabsf(x))); }
__device__ __forceinline__ float logsigmoid_f(float x) { return fminf(x, 0.f) - log1pf(expf(-fabsf(x))); }
__device__ __forceinline__ float sigmoid_f(float x) { return 1.f / (1.f + expf(-x)); }
__device__ __forceinline__ float fexp(float x) { return __builtin_amdgcn_exp2f(x * 1.4426950408889634f); }
__device__ __forceinline__ float flog(float x) { return __builtin_amdgcn_logf(x) * 0.6931471805599453f; }
__device__ __forceinline__ float fsigmoid(float x) { return __builtin_amdgcn_rcpf(1.f + fexp(-x)); }
__device__ __forceinline__ float ftanh(float x) { return 2.f * fsigmoid(2.f * x) - 1.f; }
__device__ __forceinline__ float fsoftplus(float x) { return fmaxf(x, 0.f) + flog(1.f + fexp(-fabsf(x))); }
__device__ __forceinline__ float flogsigmoid(float x) { return fminf(x, 0.f) - flog(1.f + fexp(-fabsf(x))); }
template <int CTRL> __device__ __forceinline__ float dppf(float x) { return __int_as_float(__builtin_amdgcn_update_dpp(0, __float_as_int(x), CTRL, 0xF, 0xF, true)); }
__device__ __forceinline__ float red8(float x) {
    x += dppf<0xB1>(x); x += dppf<0x4E>(x); x += dppf<0x141>(x); return x;
}
__device__ __forceinline__ f32x4 mfma16(bf16x8 a, bf16x8 b, f32x4 c) { return __builtin_amdgcn_mfma_f32_16x16x32_bf16(a, b, c, 0, 0, 0); }
__device__ __forceinline__ unsigned ld_agent(const unsigned* p) { return __hip_atomic_load(p, __ATOMIC_RELAXED, __HIP_MEMORY_SCOPE_AGENT); }

#define XB_TMO      128
#define XB_XCNT(j)  (256  + 64 * (j))
#define XB_XSUB(j)  (1280 + 64 * (j))
#define XB_XGEN(j)  (2304 + 64 * (j))
#define XB_TOP      3328
#define XB_TOPGEN   3392
#define XCD_BAR_WORDS 3456
#define XB_SPIN_CAP (1u << 18)
__device__ __forceinline__ unsigned xb_ld(unsigned* p)              { return __hip_atomic_load(p, __ATOMIC_RELAXED, __HIP_MEMORY_SCOPE_AGENT); }
__device__ __forceinline__ unsigned xb_add(unsigned* p, unsigned v) { return __hip_atomic_fetch_add(p, v, __ATOMIC_RELAXED, __HIP_MEMORY_SCOPE_AGENT); }
__device__ __forceinline__ unsigned xb_xcc_id() { return (unsigned)__builtin_amdgcn_s_getreg((3 << 11) | 20) & 0xFu; }
#define XB_SPIN(cond, bar) do { unsigned _sp = 0; while (cond) { __builtin_amdgcn_s_sleep(1); \
    if ((++_sp & 255u) == 0u) { if (xb_ld(&(bar)[XB_TMO])) break; if (_sp > XB_SPIN_CAP) { atomicAdd(&(bar)[XB_TMO], 1u); break; } } } } while (0)
struct XcdBarrier { unsigned* bar; unsigned x; volatile LAS unsigned* st; };
__device__ __forceinline__ XcdBarrier xcd_barrier_post(unsigned* bar, volatile LAS unsigned* st, bool leader) {
    XcdBarrier b; b.bar = bar; b.x = xb_xcc_id(); b.st = st;
    if (leader) (void)xb_add(&bar[XB_XCNT(b.x)], 1u);
    return b;
}
__device__ __forceinline__ void xcd_barrier_complete(unsigned* bar, unsigned x, unsigned& nloc, unsigned& nx) {
    const unsigned G = gridDim.x * gridDim.y * gridDim.z;
    unsigned sum, cnt, mine, sp = 0u;
    for (;;) {
        sum = 0u; cnt = 0u; mine = 0u;
#pragma unroll
        for (unsigned j = 0; j < 16; ++j) { const unsigned c = xb_ld(&bar[XB_XCNT(j)]); sum += c; cnt += (c > 0u) ? 1u : 0u; mine = (j == x) ? c : mine; }
        if (sum == G) break;
        __builtin_amdgcn_s_sleep(1);
        if ((++sp & 255u) == 0u) { if (xb_ld(&bar[XB_TMO])) break; if (sp > XB_SPIN_CAP) { atomicAdd(&bar[XB_TMO], 1u); break; } }
    }
    nloc = mine > 0u ? mine : 1u; nx = cnt > 0u ? cnt : 1u;
}
__device__ __forceinline__ void xcd_barrier(const XcdBarrier& b, bool leader) {
    asm volatile("s_waitcnt vmcnt(0)" ::: "memory");
    __syncthreads();
    if (leader) {
        unsigned* bar = b.bar;
        __builtin_amdgcn_s_waitcnt(0);
        unsigned nloc = b.st[0], nx = b.st[1];
        if (nloc == 0u) { xcd_barrier_complete(bar, b.x, nloc, nx); b.st[0] = nloc; b.st[1] = nx; }
        const unsigned old = xb_add(&bar[XB_XSUB(b.x)], 1u);
        const unsigned gen = old / nloc;
        if (old + 1u == (gen + 1u) * nloc) {
            __builtin_amdgcn_fence(__ATOMIC_RELEASE, "agent");
            asm volatile("s_waitcnt vmcnt(0)" ::: "memory");
            const unsigned og = xb_add(&bar[XB_TOP], 1u);
            const unsigned tg = og / nx;
            if (og + 1u == (tg + 1u) * nx) xb_add(&bar[XB_TOPGEN], 1u);
            else XB_SPIN(xb_ld(&bar[XB_TOPGEN]) == tg, bar);
            __builtin_amdgcn_fence(__ATOMIC_ACQUIRE, "agent");
            xb_add(&bar[XB_XGEN(b.x)], 1u);
            asm volatile("s_waitcnt vmcnt(0)" ::: "memory");
        } else {
            XB_SPIN(xb_ld(&bar[XB_XGEN(b.x)]) == gen, bar);
            __builtin_amdgcn_fence(__ATOMIC_ACQUIRE, "agent");
            asm volatile("s_waitcnt vmcnt(0)" ::: "memory");
        }
    }
    __syncthreads();
}

struct Args { const float* in[30]; float* out; unsigned char* ws; };
enum { I_X = 0, I_META, I_LNIN_G, I_LNIN_B, I_WIN, I_GKW2, I_GKB, I_GNORM, I_MU, I_W0, I_W2, I_A0, I_A2, I_G2, I_KK, I_KA, I_RK, I_RLNG, I_RLNB, I_WOUT,
       I_LN1G, I_LN1B, I_RTW, I_RTB, I_WUP, I_BUP, I_WDN, I_BDN, I_LN2G, I_LN2B };
struct Frame { LAS unsigned char* lds; int tid, lane, wave, blk, G; };
__device__ __forceinline__ int lane_id() { int l; asm volatile("v_mbcnt_lo_u32_b32 %0, -1, 0\n\tv_mbcnt_hi_u32_b32 %0, -1, %0" : "=v"(l)); return l; }
__device__ __forceinline__ Frame mkframe(LAS unsigned char* lds, int wave) { Frame F; F.lds = lds; F.wave = wave; F.lane = lane_id(); F.tid = wave * 64 + F.lane; F.blk = blockIdx.x; F.G = gridDim.x; return F; }

__device__ __forceinline__ void transpose_item(const float* W, int K, int N, int nblk, bf16* WT, LAS float* scr, int item, int lane) {
    const int kb = item / nblk, nb = item - kb * nblk, k0 = 64 * kb, n0 = 32 * nb;
    const int nn = n0 + (lane & 31); const bool ok = nn < N;
#pragma unroll 8
    for (int i = 0; i < 32; ++i) { const int kk = 2 * i + (lane >> 5); scr[kk * 33 + (lane & 31)] = ok ? W[(size_t)(k0 + kk) * N + nn] : 0.f; }
    LDS_WAIT();
    const int c = lane & 7;
#pragma unroll
    for (int j = 0; j < 4; ++j) { const int n = (lane >> 3) + 8 * j; const LAS float* s = scr + (8 * c) * 33 + n;
        v4u o; o.x = pk2(s[0 * 33], s[1 * 33]); o.y = pk2(s[2 * 33], s[3 * 33]); o.z = pk2(s[4 * 33], s[5 * 33]); o.w = pk2(s[6 * 33], s[7 * 33]);
        *(v4u*)(WT + (size_t)(n0 + n) * K + k0 + 8 * c) = o; }
    LDS_WAIT();
}

__device__ __forceinline__ void transpose_item64_f8(const float* W, int K, int N, unsigned char* WT, float scale, LAS float* scr, int item, int lane) {
    const int nblk = N >> 6, kb = item / nblk, nb = item - kb * nblk, k0 = 64 * kb, n0 = 64 * nb;
    const int r4 = lane >> 4, c4 = lane & 15;
    f32x4 v[16];
#pragma unroll
    for (int i = 0; i < 16; ++i) v[i] = *(const f32x4*)(W + (size_t)(k0 + 4 * i + r4) * N + n0 + 4 * c4);
#pragma unroll
    for (int i = 0; i < 16; ++i) *(LAS f32x4*)(scr + (4 * i + r4) * 68 + 4 * c4) = v[i];
    LDS_WAIT();
    unsigned char* orow = WT + (size_t)(n0 + lane) * K + k0;
#pragma unroll
    for (int g = 0; g < 4; ++g) { const LAS float* s = scr + (16 * g) * 68 + lane; v4u o;
#pragma unroll
        for (int q = 0; q < 4; ++q) { int w = __builtin_amdgcn_cvt_pk_fp8_f32(s[(4 * q + 0) * 68] * scale, s[(4 * q + 1) * 68] * scale, 0, false);
            w = __builtin_amdgcn_cvt_pk_fp8_f32(s[(4 * q + 2) * 68] * scale, s[(4 * q + 3) * 68] * scale, w, true); o[q] = (unsigned)w; }
        *(v4u*)(orow + 16 * g) = o; }
    LDS_WAIT();
}
__device__ __forceinline__ void convert_expert_weights(const Args& a, const Frame& F, int qsel) {
    unsigned char* ws = a.ws;
    LAS float* scr = (LAS float*)(F.lds + F.wave * 17408);
    unsigned* QH = (unsigned*)(ws + WS_CTL) + CW_QH + 64 * qsel;
    constexpr int I_UP = 16 * 32, I_DN = 16 * 16, NIT = NE * (I_UP + I_DN);
    for (;;) {
        unsigned base = 0;
        if (F.lane == 0) base = __hip_atomic_fetch_add(QH, 8u, __ATOMIC_RELAXED, __HIP_MEMORY_SCOPE_AGENT);
        base = (unsigned)__builtin_amdgcn_readfirstlane((int)base);
        if (base >= (unsigned)NIT) break;
        for (int it = (int)base; it < (int)base + 8; ++it) {
            if (it < NE * I_UP) { const int e = it / I_UP, r = it - e * I_UP;
                transpose_item64_f8(a.in[I_WUP] + (size_t)e * D * 2048, D, 2048, ws + WS_WUP + (size_t)e * 2048 * D, 64.f, scr, r, F.lane); }
            else { const int it2 = it - NE * I_UP, e = it2 / I_DN, r = it2 - e * I_DN;
                transpose_item64_f8(a.in[I_WDN] + (size_t)e * D * D, D, D, ws + WS_WDN + (size_t)e * D * D, 128.f, scr, r, F.lane); }
        }
    }
}

__device__ __forceinline__ void phase0(const Args& a, const Frame& F) {
    unsigned char* ws = a.ws;
    const int gw = F.blk * NWAVES + F.wave, NGW = F.G * NWAVES;
    for (int cgp = F.blk; cgp < 53; cgp += F.G) {
        LAS float* HM = (LAS float*)F.lds;
        LAS float* PART = (LAS float*)(F.lds + 65536);
        for (int rr = 0; rr < 2; ++rr) {
            const int row = 2 * F.wave + rr; const f32x4* xr = (const f32x4*)(a.in[I_META] + row * D) + F.lane;
            f32x4 v[4]; float s = 0.f;
#pragma unroll
            for (int j = 0; j < 4; ++j) { v[j] = xr[64 * j]; s += (v[j].x + v[j].y) + (v[j].z + v[j].w); }
            const float mean = wave_sum(s, F.lane) * (1.f / D); float s2 = 0.f;
#pragma unroll
            for (int j = 0; j < 4; ++j) { v[j] = v[j] - mean; s2 += (v[j].x * v[j].x + v[j].y * v[j].y) + (v[j].z * v[j].z + v[j].w * v[j].w); }
            const float rstd = 1.f / sqrtf(wave_sum(s2, F.lane) * (1.f / D) + 1e-5f);
#pragma unroll
            for (int j = 0; j < 4; ++j) { const int col = 4 * (F.lane + 64 * j);
                const f32x4 gv = *(const f32x4*)(a.in[I_LNIN_G] + col), bv = *(const f32x4*)(a.in[I_LNIN_B] + col);
                const f32x4 y = v[j] * rstd * gv + bv;
                HM[(col + 0) * 16 + row] = y.x; HM[(col + 1) * 16 + row] = y.y; HM[(col + 2) * 16 + row] = y.z; HM[(col + 3) * 16 + row] = y.w; }
        }
        __syncthreads();
        const int col = cgp * 64 + F.lane; const bool ok = col < INW;
        float acc[16];
#pragma unroll
        for (int r = 0; r < 16; ++r) acc[r] = 0.f;
        const float* wp = a.in[I_WIN];
        for (int k = F.wave * 128; k < F.wave * 128 + 128; ++k) {
            const float wv = ok ? wp[(size_t)k * INW + col] : 0.f;
            const LAS f32x4* h = (const LAS f32x4*)(HM + k * 16);
#pragma unroll
            for (int q = 0; q < 4; ++q) { const f32x4 hv = h[q]; acc[4 * q + 0] += hv.x * wv; acc[4 * q + 1] += hv.y * wv; acc[4 * q + 2] += hv.z * wv; acc[4 * q + 3] += hv.w * wv; }
        }
#pragma unroll
        for (int r = 0; r < 16; ++r) PART[(F.wave * 16 + r) * 64 + F.lane] = acc[r];
        __syncthreads();
        bf16* PROJM = (bf16*)(ws + WS_PROJM);
        for (int o = F.tid; o < 1024; o += NTHR) { const int r = o >> 6, l = o & 63; float s = 0.f;
#pragma unroll
            for (int w = 0; w < 8; ++w) s += PART[(w * 16 + r) * 64 + l];
            PROJM[r * PW + cgp * 64 + l] = (bf16)f2bf(s); }
        if (F.tid < 64) PROJM[NMETA * PW + cgp * 64 + F.tid] = 0;
        __syncthreads();
    }
    {
        LAS float* scr = (LAS float*)(F.lds + F.wave * 16384);
        constexpr int I_IN = 16 * (PW / 32), I_OUT = 16 * 32;
        for (int it = gw; it < I_IN + I_OUT; it += NGW) {
            if (it < I_IN) transpose_item(a.in[I_WIN], D, INW, PW / 32, (bf16*)(ws + WS_WIN), scr, it, F.lane);
            else transpose_item(a.in[I_WOUT], D, D, 32, (bf16*)(ws + WS_WOUT), scr, it - I_IN, F.lane);
        }
    }
    {
        bf16* W2T = (bf16*)(ws + WS_W2T); bf16* A2T = (bf16*)(ws + WS_A2T); bf16* G2T = (bf16*)(ws + WS_G2T);
        for (int i = F.blk * NTHR + F.tid; i < 131072; i += F.G * NTHR) {
            if (i < 32768) { const int n = i >> 6, k = i & 63; W2T[i] = (bf16)f2bf(a.in[I_W2][k * 512 + n]); }
            else if (i < 65536) { const int j = i - 32768, n = j >> 6, k = j & 63; A2T[j] = (bf16)f2bf(a.in[I_A2][k * 512 + n]); }
            else { const int j = i - 65536, n = j >> 7, k = j & 127; G2T[j] = (bf16)f2bf(a.in[I_G2][k * 512 + n]); }
        }
    }
    {
        bf16* A0 = (bf16*)(ws + WS_A0); float* ST = (float*)(ws + WS_STATS);
        for (int m0 = gw; m0 < MX; m0 += 2 * NGW) {
            f32x4 v[2][4];
#pragma unroll
            for (int r = 0; r < 2; ++r) { const f32x4* xr = (const f32x4*)(a.in[I_X] + (size_t)(m0 + r * NGW) * D) + F.lane;
#pragma unroll
                for (int j = 0; j < 4; ++j) v[r][j] = xr[64 * j]; }
#pragma unroll
            for (int r = 0; r < 2; ++r) { const int m = m0 + r * NGW; float s = 0.f;
#pragma unroll
                for (int j = 0; j < 4; ++j) s += (v[r][j].x + v[r][j].y) + (v[r][j].z + v[r][j].w);
                const float mean = wave_sum(s, F.lane) * (1.f / D); float s2 = 0.f;
#pragma unroll
                for (int j = 0; j < 4; ++j) { v[r][j] = v[r][j] - mean; s2 += (v[r][j].x * v[r][j].x + v[r][j].y * v[r][j].y) + (v[r][j].z * v[r][j].z + v[r][j].w * v[r][j].w); }
                const float rstd = __builtin_amdgcn_rsqf(wave_sum(s2, F.lane) * (1.f / D) + 1e-5f);
#pragma unroll
                for (int j = 0; j < 4; ++j) { const int col = 4 * (F.lane + 64 * j);
                    const f32x4 gv = *(const f32x4*)(a.in[I_LNIN_G] + col), bv = *(const f32x4*)(a.in[I_LNIN_B] + col);
                    const f32x4 y = v[r][j] * rstd * gv + bv;
                    v2u o; o.x = pk2(y.x, y.y); o.y = pk2(y.z, y.w);
                    *(v2u*)(A0 + (size_t)m * D + col) = o; }
                if (F.lane == 0) { ST[2 * m] = mean; ST[2 * m + 1] = rstd; } }
        }
    }
    __syncthreads();
    for (int rep_ = 0; rep_ < NREP(14); ++rep_) convert_expert_weights(a, F, rep_);
}

__device__ __forceinline__ const bf16* prow(const bf16* PROJ, const bf16* PROJM, int b, int vp) {
    const bf16* px = PROJ + (size_t)(b * SEQ + (vp >= NMETA ? vp - NMETA : 0)) * PW;
    const bf16* pm = PROJM + (size_t)(vp < 0 ? NMETA : (vp < NMETA ? vp : 0)) * PW;
    return vp >= NMETA ? px : pm;
}
__device__ __forceinline__ f32x4 ldp4(const bf16* PROJ, const bf16* PROJM, int b, int vp, int col) {
    const v2u w = *(const v2u*)(prow(PROJ, PROJM, b, vp) + col);
    return (f32x4){bflo(w.x), bfhi(w.x), bflo(w.y), bfhi(w.y)};
}

constexpr int R1_STRIDE = 49152;
constexpr int TP = 80;
constexpr int L1_SLOT = 64 * TP * 2;
constexpr int L1_LC = 12 * L1_SLOT;
constexpr int L1_XCH = L1_LC + 64 * 65 * 4;
constexpr int L1_LR = 8 * L1_SLOT;
__device__ __forceinline__ v2u pack4(f32x4 v) { v2u o; o.x = pk2(v[0], v[1]); o.y = pk2(v[2], v[3]); return o; }
__device__ __forceinline__ f32x4 tile_mm(const LAS bf16* A, const LAS bf16* Bt, int rt, int ct, int fr, int fq, f32x4 acc) {
#pragma unroll
    for (int ks = 0; ks < 2; ++ks)
        acc = mfma16(*(const LAS bf16x8*)(Bt + (ct * 16 + fr) * TP + ks * 32 + 8 * fq), *(const LAS bf16x8*)(A + (rt * 16 + fr) * TP + ks * 32 + 8 * fq), acc);
    return acc;
}
__device__ __forceinline__ void tile_st(LAS bf16* O, int rt, int ct, int fr, int fq, f32x4 v) { *(LAS v2u*)(O + (rt * 16 + fr) * TP + ct * 16 + 4 * fq) = pack4(v); }
#define L1S(n) ((LAS bf16*)(F.lds + (n) * L1_SLOT))

struct L1Pf { v4u sa[5]; v2u r[2][2], k[2][2], v[2][2]; };
__device__ __forceinline__ void l1_fetch(const Args& a, const Frame& F, int b, int h, int c, L1Pf& pf) {
    const bf16* PROJ = (const bf16*)(a.ws + WS_PROJ); const bf16* PROJM = (const bf16*)(a.ws + WS_PROJM);
    const int vp0 = (c == 0) ? -48 : NMETA + 64 * (c - 1);
    { const int cg = F.tid & 31, tr = F.tid >> 5;
#pragma unroll
      for (int i = 0; i < 5; ++i) pf.sa[i] = *(const v4u*)(prow(PROJ, PROJM, b, vp0 + 4 * tr - 1 + i) + RWL + 8 * cg); }
    { const int rt = F.wave & 3, cp = F.wave >> 2, fr = F.lane & 15, fq = F.lane >> 4, vp = vp0 + rt * 16 + fr;
      const bf16* p0 = prow(PROJ, PROJM, b, vp - 1); const bf16* p1 = prow(PROJ, PROJM, b, vp);
#pragma unroll
      for (int cc = 0; cc < 2; ++cc) { const int jc = h * 64 + (2 * cp + cc) * 16 + 4 * fq;
          pf.r[cc][0] = *(const v2u*)(p0 + RR + jc); pf.r[cc][1] = *(const v2u*)(p1 + RR + jc);
          pf.k[cc][0] = *(const v2u*)(p0 + RK + jc); pf.k[cc][1] = *(const v2u*)(p1 + RK + jc);
          pf.v[cc][0] = *(const v2u*)(p0 + RV + jc); pf.v[cc][1] = *(const v2u*)(p1 + RV + jc); } }
}
__device__ __forceinline__ f32x4 unpk4(v2u w) { return (f32x4){bflo(w.x), bfhi(w.x), bflo(w.y), bfhi(w.y)}; }

__device__ __forceinline__ void rwkv_l1_front(const Args& a, const Frame& F, int b, int h, int c, const L1Pf& pf, f32x4 (&rtil)[2]) {
    unsigned char* ws = a.ws;
    const bf16* W2T = (const bf16*)(ws + WS_W2T); const bf16* A2T = (const bf16*)(ws + WS_A2T); const bf16* G2T = (const bf16*)(ws + WS_G2T);
    const int unit = (b * 8 + h) * NCH + c;
    unsigned char* r1 = ws + WS_R1 + (size_t)unit * R1_STRIDE;
    float* GAM = (float*)(ws + WS_GAM) + (size_t)unit * 64;
    const float* mu = a.in[I_MU];
    const int vp0 = (c == 0) ? -48 : NMETA + 64 * (c - 1);
    constexpr int LRP = 264;
    LAS bf16* LR = (LAS bf16*)(F.lds + L1_LR);
    LAS float* LC = (LAS float*)(F.lds + L1_LC);
    LAS float* XCH = (LAS float*)(F.lds + L1_XCH);
    const int rt = F.wave & 3, cp = F.wave >> 2, fr = F.lane & 15, fq = F.lane >> 4;
    {
        const int cg = F.tid & 31, tr = F.tid >> 5;
        const f32x4 m0 = *(const f32x4*)(mu + 1536 + 8 * cg), m1 = *(const f32x4*)(mu + 1536 + 8 * cg + 4);
#pragma unroll
        for (int i = 0; i < 4; ++i) {
            const int row = 4 * tr + i;
            const v4u cw = pf.sa[i + 1], pw = pf.sa[i];
            const f32x4 c0 = unpk4((v2u){cw.x, cw.y}), c1 = unpk4((v2u){cw.z, cw.w}), p0 = unpk4((v2u){pw.x, pw.y}), p1 = unpk4((v2u){pw.z, pw.w});
            float v[8];
            v[0] = c0.x + (p0.x - c0.x) * m0.x; v[1] = c0.y + (p0.y - c0.y) * m0.y; v[2] = c0.z + (p0.z - c0.z) * m0.z; v[3] = c0.w + (p0.w - c0.w) * m0.w;
            v[4] = c1.x + (p1.x - c1.x) * m1.x; v[5] = c1.y + (p1.y - c1.y) * m1.y; v[6] = c1.z + (p1.z - c1.z) * m1.z; v[7] = c1.w + (p1.w - c1.w) * m1.w;
#pragma unroll
            for (int q = 0; q < 8; ++q) { if (cg < 8) v[q] = ftanh(v[q]); else if (cg >= 16) v[q] = fsigmoid(v[q]); }
            v4u o; o.x = pk2(v[0], v[1]); o.y = pk2(v[2], v[3]); o.z = pk2(v[4], v[5]); o.w = pk2(v[6], v[7]);
            *(LAS v4u*)(LR + row * LRP + 8 * cg) = o;
        }
    }
    lds_barrier();
    const int t = rt * 16 + fr, vp = vp0 + t;
    const bool valid = vp >= 0;
    float lwv[2][4], asg[2][4], kkr[2][4], kmd[2][4], rrv[2][4], vvv[2][4];
    float ssq = 0.f, bon = 0.f;
    {
        const LAS bf16* lrow = LR + t * LRP + 8 * fq;
#pragma unroll
        for (int cc = 0; cc < 2; ++cc) {
            const int ct = 2 * cp + cc, j = ct * 16 + 4 * fq, jc = h * 64 + j;
            f32x4 mr[2], mk[2], mv[2], w0v[2], a0v[2], kkw[2], kaw[2], rkw[2];
            mr[cc] = *(const f32x4*)(mu + jc); mk[cc] = *(const f32x4*)(mu + 512 + jc); mv[cc] = *(const f32x4*)(mu + 1024 + jc);
            w0v[cc] = *(const f32x4*)(a.in[I_W0] + jc); a0v[cc] = *(const f32x4*)(a.in[I_A0] + jc);
            kkw[cc] = *(const f32x4*)(a.in[I_KK] + jc); kaw[cc] = *(const f32x4*)(a.in[I_KA] + jc); rkw[cc] = *(const f32x4*)(a.in[I_RK] + jc);
            f32x4 aw = {0.f, 0.f, 0.f, 0.f}, aa = aw, ag = aw;
#pragma unroll
            for (int ks = 0; ks < 2; ++ks) {
                aw = mfma16(*(const bf16x8*)(W2T + (size_t)(h * 64 + ct * 16 + fr) * 64 + ks * 32 + 8 * fq), *(const LAS bf16x8*)(lrow + ks * 32), aw);
                aa = mfma16(*(const bf16x8*)(A2T + (size_t)(h * 64 + ct * 16 + fr) * 64 + ks * 32 + 8 * fq), *(const LAS bf16x8*)(lrow + 64 + ks * 32), aa);
            }
#pragma unroll
            for (int ks = 0; ks < 4; ++ks) ag = mfma16(*(const bf16x8*)(G2T + (size_t)(h * 64 + ct * 16 + fr) * 128 + ks * 32 + 8 * fq), *(const LAS bf16x8*)(lrow + 128 + ks * 32), ag);
            const f32x4 rc = unpk4(pf.r[cc][1]), rp = unpk4(pf.r[cc][0]), kc = unpk4(pf.k[cc][1]), kp = unpk4(pf.k[cc][0]), vc = unpk4(pf.v[cc][1]), vpv = unpk4(pf.v[cc][0]);
            const f32x4 rs = rc + (rp - rc) * mr[cc], ks_ = kc + (kp - kc) * mk[cc], vs = vc + (vpv - vc) * mv[cc];
#pragma unroll
            for (int i = 0; i < 4; ++i) {
                const float u = w0v[cc][i] + aw[i];
                const float wl = -fsoftplus(-u) - 0.5f;
                lwv[cc][i] = valid ? -fexp(wl) : 0.f;
                const float as_ = fsigmoid(a0v[cc][i] + aa[i]);
                asg[cc][i] = as_;
                const float kraw = ks_[i], kk = kraw * kkw[cc][i];
                kkr[cc][i] = kk; ssq += kk * kk;
                const float km = kraw * (1.f + (as_ - 1.f) * kaw[cc][i]);
                kmd[cc][i] = km; rrv[cc][i] = rs[i]; vvv[cc][i] = vs[i];
                bon += rs[i] * km * rkw[cc][i];
            }
            *(v2u*)(r1 + 4 * 8192 + (size_t)(t * 64 + j) * 2) = pack4(ag);
            __builtin_amdgcn_sched_barrier(0);
        }
#pragma unroll
        for (int cc = 0; cc < 2; ++cc)
#pragma unroll
            for (int i = 0; i < 4; ++i) LC[t * 65 + (2 * cp + cc) * 16 + 4 * fq + i] = lwv[cc][i];
        ssq += shx(ssq, 16, F.lane); ssq += shx(ssq, 32, F.lane);
        bon += shx(bon, 16, F.lane); bon += shx(bon, 32, F.lane);
        if (fq == 0) { XCH[(cp * 64 + t) * 2] = ssq; XCH[(cp * 64 + t) * 2 + 1] = bon; }
    }
    lds_barrier();
    const float ssq_t = XCH[t * 2] + XCH[(64 + t) * 2], bon_t = XCH[t * 2 + 1] + XCH[(64 + t) * 2 + 1];
    const float inv = 1.f / fmaxf(sqrtf(ssq_t), 1e-12f);
    {
        LAS float* SEG = XCH + 256;
        const int jj = F.tid & 63, sg = F.tid >> 6;
        float cv[8];
#pragma unroll
        for (int i = 0; i < 8; ++i) cv[i] = LC[(sg * 8 + i) * 65 + jj];
#pragma unroll
        for (int i = 1; i < 8; ++i) cv[i] += cv[i - 1];
        SEG[sg * 64 + jj] = cv[7];
        lds_barrier();
        float pre = 0.f;
#pragma unroll
        for (int s2 = 0; s2 < 7; ++s2) pre += (s2 < sg) ? SEG[s2 * 64 + jj] : 0.f;
#pragma unroll
        for (int i = 0; i < 8; ++i) LC[(sg * 8 + i) * 65 + jj] = cv[i] + pre;
    }
    lds_barrier();
    {
#pragma unroll
        for (int cc = 0; cc < 2; ++cc) {
            const int j = (2 * cp + cc) * 16 + 4 * fq;
            f32x4 At, Bt, Kt, Bh, Kh, bvv;
#pragma unroll
            for (int i = 0; i < 4; ++i) {
                const float Lc = LC[t * 65 + j + i], LcC = LC[63 * 65 + j + i];
                const float kn = kkr[cc][i] * inv, av = -kn, bv = kn * asg[cc][i], km = kmd[cc][i];
                const float eA = fexp(Lc - lwv[cc][i]), eR = fexp(Lc), eB = fexp(-Lc), eH = fexp(LcC - Lc);
                At[i] = av * eA; rtil[cc][i] = rrv[cc][i] * eR; Bt[i] = bv * eB; Kt[i] = km * eB; Bh[i] = bv * eH; Kh[i] = km * eH;
                bvv[i] = bon_t * vvv[cc][i];
                if (t == 63) GAM[j + i] = fexp(LcC);
            }
            *(LAS v2u*)(L1S(0) + t * TP + j) = pack4(Bt); *(LAS v2u*)(L1S(1) + t * TP + j) = pack4(Kt);
            *(LAS v2u*)(L1S(2) + t * TP + j) = pack4(At); *(LAS v2u*)(L1S(3) + t * TP + j) = pack4(rtil[cc]);
#pragma unroll
            for (int i = 0; i < 4; ++i) {
                L1S(4)[(j + i) * TP + t] = (bf16)f2bf(At[i]); L1S(5)[(j + i) * TP + t] = (bf16)f2bf(Bh[i]);
                L1S(6)[(j + i) * TP + t] = (bf16)f2bf(Kh[i]); L1S(7)[(j + i) * TP + t] = (bf16)f2bf(vvv[cc][i]);
            }
            *(v2u*)(r1 + 5 * 8192 + (size_t)(t * 64 + j) * 2) = pack4(bvv);
        }
    }
    lds_barrier();
}
__device__ __forceinline__ void rwkv_l1_back(const Args& a, const Frame& F, int b, int h, int c, const f32x4 (&rtil)[2]) {
    unsigned char* r1 = a.ws + WS_R1 + (size_t)((b * 8 + h) * NCH + c) * R1_STRIDE;
    const int rt = F.wave & 3, cp = F.wave >> 2, fr = F.lane & 15, fq = F.lane >> 4;
    f32x4 Pt[2];
    const int mrow = rt * 16 + fr;
    const f32x4 z = {0.f, 0.f, 0.f, 0.f};
    {
        f32x4 Lv[2], Nv[2], Mv[2], Bv[2], Kv[2];
#pragma unroll
        for (int cc = 0; cc < 2; ++cc) { const int ct = 2 * cp + cc;
            Lv[cc] = tile_mm(L1S(2), L1S(0), rt, ct, fr, fq, z); Nv[cc] = tile_mm(L1S(0), L1S(2), rt, ct, fr, fq, z); Mv[cc] = tile_mm(L1S(2), L1S(1), rt, ct, fr, fq, z);
            Bv[cc] = tile_mm(L1S(3), L1S(0), rt, ct, fr, fq, z); Kv[cc] = tile_mm(L1S(3), L1S(1), rt, ct, fr, fq, z); }
#pragma unroll
        for (int cc = 0; cc < 2; ++cc) { const int ct = 2 * cp + cc, n0 = ct * 16 + 4 * fq;
#pragma unroll
            for (int i = 0; i < 4; ++i) { const int n = n0 + i;
                if (!(n < mrow)) { Lv[cc][i] = 0.f; Mv[cc][i] = 0.f; } if (!(mrow < n)) Nv[cc][i] = 0.f; if (!(n <= mrow)) { Bv[cc][i] = 0.f; Kv[cc][i] = 0.f; }
                Pt[cc][i] = Lv[cc][i] + ((n == mrow) ? 1.f : 0.f); }
            tile_st(L1S(8), rt, ct, fr, fq, Lv[cc]); tile_st(L1S(9), rt, ct, fr, fq, Nv[cc]); tile_st(L1S(10), rt, ct, fr, fq, Mv[cc]);
            tile_st(L1S(11), rt, ct, fr, fq, Bv[cc]); tile_st(L1S(12), rt, ct, fr, fq, Kv[cc]); }
    }
    lds_barrier();
    f32x4 Xv[2];
#pragma unroll
    for (int st = 1; st <= 6; ++st) {
        LAS bf16* Xl = (st & 1) ? L1S(8) : L1S(0); LAS bf16* Xn = (st & 1) ? L1S(9) : L1S(1);
        LAS bf16* Yl = (st & 1) ? L1S(0) : L1S(8); LAS bf16* Yn = (st & 1) ? L1S(1) : L1S(9);
        LAS bf16* Pr = (st & 1) ? L1S(2) : L1S(3); LAS bf16* Pw = (st & 1) ? L1S(3) : L1S(2);
        f32x4 l2[2], n2[2];
#pragma unroll
        for (int cc = 0; cc < 2; ++cc) { const int ct = 2 * cp + cc;
            if (st <= 5) { l2[cc] = tile_mm(Xl, Xn, rt, ct, fr, fq, z); n2[cc] = tile_mm(Xn, Xl, rt, ct, fr, fq, z); }
            if (st >= 2) Pt[cc] = tile_mm(Pr, Xn, rt, ct, fr, fq, Pt[cc]);
            if (st == 1) Xv[cc] = tile_mm(L1S(7), L1S(10), rt, ct, fr, fq, z); }
#pragma unroll
        for (int cc = 0; cc < 2; ++cc) { const int ct = 2 * cp + cc;
            if (st <= 5) { tile_st(Yl, rt, ct, fr, fq, l2[cc]); tile_st(Yn, rt, ct, fr, fq, n2[cc]); }
            tile_st(Pw, rt, ct, fr, fq, Pt[cc]); }
        if (st == 1) { lds_barrier();
#pragma unroll
            for (int cc = 0; cc < 2; ++cc) tile_st(L1S(10), rt, 2 * cp + cc, fr, fq, Xv[cc]); }
        lds_barrier();
    }
    {
        f32x4 u[2], w[2];
#pragma unroll
        for (int cc = 0; cc < 2; ++cc) { const int ct = 2 * cp + cc; u[cc] = tile_mm(L1S(10), L1S(2), rt, ct, fr, fq, z); w[cc] = tile_mm(L1S(4), L1S(2), rt, ct, fr, fq, z); }
#pragma unroll
        for (int cc = 0; cc < 2; ++cc) { const int ct = 2 * cp + cc; tile_st(L1S(8), rt, ct, fr, fq, u[cc]); tile_st(L1S(9), rt, ct, fr, fq, w[cc]); }
    }
    lds_barrier();
    {
#pragma unroll
        for (int cc = 0; cc < 2; ++cc) { const int ct = 2 * cp + cc; const size_t eo = (size_t)(mrow * 64 + ct * 16 + 4 * fq) * 2;
            const f32x4 gp = tile_mm(L1S(5), L1S(9), rt, ct, fr, fq, z);
            const f32x4 hh = tile_mm(L1S(7), L1S(6), rt, ct, fr, fq, tile_mm(L1S(8), L1S(5), rt, ct, fr, fq, z));
            const f32x4 rh = tile_mm(L1S(11), L1S(9), rt, ct, fr, fq, rtil[cc]);
            const f32x4 yl = tile_mm(L1S(12), L1S(7), rt, ct, fr, fq, tile_mm(L1S(11), L1S(8), rt, ct, fr, fq, z));
            *(v2u*)(r1 + 0 * 8192 + eo) = pack4(gp); *(v2u*)(r1 + 1 * 8192 + eo) = pack4(hh);
            *(v2u*)(r1 + 2 * 8192 + eo) = pack4(rh); *(v2u*)(r1 + 3 * 8192 + eo) = pack4(yl); }
    }
    lds_barrier();
}

constexpr int BCP = 65;
__device__ __forceinline__ void gla_bc(const Args& a, const Frame& F, int b, int h, int vp0, int ntok) {
    const bf16* PROJ = (const bf16*)(a.ws + WS_PROJ); const bf16* PROJM = (const bf16*)(a.ws + WS_PROJM);
    LAS float* GKLs = (LAS float*)F.lds; LAS float* BC = (LAS float*)(F.lds + 4096);
    if (F.tid < 256) { const int t = F.tid >> 2, q = F.tid & 3;
        const f32x4 v = ldp4(PROJ, PROJM, b, (t < ntok) ? vp0 + t : -1, GKL + 4 * q);
        *(LAS f32x4*)(GKLs + t * 16 + 4 * q) = v; }
    lds_barrier();
    {
        const int d = F.tid & 63, tg = F.tid >> 6;
        float wc[16];
#pragma unroll
        for (int r = 0; r < 16; ++r) wc[r] = a.in[I_GKW2][r * 256 + h * 64 + d];
        const float gb = a.in[I_GKB][h * 64 + d];
#pragma unroll
        for (int i = 0; i < 8; ++i) { const int t = tg * 8 + i; float z = gb;
            const LAS f32x4* g4 = (const LAS f32x4*)(GKLs + t * 16);
#pragma unroll
            for (int q = 0; q < 4; ++q) { const f32x4 gv = g4[q]; z += gv.x * wc[4 * q] + gv.y * wc[4 * q + 1] + gv.z * wc[4 * q + 2] + gv.w * wc[4 * q + 3]; }
            BC[t * BCP + d] = (t < ntok) ? flogsigmoid(z) * (1.f / 16.f) : 0.f; }
    }
    lds_barrier();
    if (F.tid < 64) { float run = 0.f;
#pragma unroll 8
        for (int t = 0; t < 64; ++t) { run += BC[t * BCP + F.tid]; BC[t * BCP + F.tid] = run; } }
    lds_barrier();
}

__device__ __forceinline__ void gla_g1_unit(const Args& a, const Frame& F, int b, int h, int c) {
    const bf16* PROJ = (const bf16*)(a.ws + WS_PROJ); const bf16* PROJM = (const bf16*)(a.ws + WS_PROJM);
    float* GUS = (float*)(a.ws + WS_GUS); float* DL = (float*)(a.ws + WS_DL);
    const int ntok = (c == 0) ? NMETA : 64, vp0 = (c == 0) ? 0 : NMETA + 64 * (c - 1);
    gla_bc(a, F, b, h, vp0, ntok);
    LAS float* BC = (LAS float*)(F.lds + 4096);
    LAS bf16* KT = (LAS bf16*)(F.lds + 24576);
    LAS bf16* VT = (LAS bf16*)(F.lds + 24576 + 64 * TP * 2);
    {
        const int t = F.tid >> 3, q = F.tid & 7;
        const float* bl = nullptr; (void)bl;
#pragma unroll
        for (int half = 0; half < 2; ++half) {
            const int d0 = 8 * q + 4 * half;
            const f32x4 kv = ldp4(PROJ, PROJM, b, (t < ntok) ? vp0 + t : -1, GK + h * 64 + d0);
#pragma unroll
            for (int i = 0; i < 4; ++i) { const int d = d0 + i; const float e = (t < ntok) ? fexp(BC[(ntok - 1) * BCP + d] - BC[t * BCP + d]) : 0.f;
                KT[d * TP + t] = (bf16)f2bf(kv[i] * e); }
        }
#pragma unroll
        for (int qq = 0; qq < 4; ++qq) {
            const int e0 = 16 * q + 4 * qq;
            const f32x4 vv = ldp4(PROJ, PROJM, b, (t < ntok) ? vp0 + t : -1, GV + h * 128 + e0);
#pragma unroll
            for (int i = 0; i < 4; ++i) VT[(e0 + i) * TP + t] = (bf16)f2bf(vv[i]);
        }
    }
    lds_barrier();
    {
        const int rt = F.wave & 3, ch = F.wave >> 2, fr = F.lane & 15, fq = F.lane >> 4;
        float* up = GUS + ((size_t)((b * 4 + h) * NCH + c) * 64 + rt * 16 + fr) * 128;
#pragma unroll
        for (int cc = 0; cc < 4; ++cc) { const int ct = ch * 4 + cc;
            f32x4 acc = {0.f, 0.f, 0.f, 0.f};
#pragma unroll
            for (int ks = 0; ks < 2; ++ks)
                acc = mfma16(*(const LAS bf16x8*)(VT + (ct * 16 + fr) * TP + ks * 32 + 8 * fq), *(const LAS bf16x8*)(KT + (rt * 16 + fr) * TP + ks * 32 + 8 * fq), acc);
            *(f32x4*)(up + ct * 16 + 4 * fq) = acc; }
        if (F.tid < 64) DL[(size_t)((b * 4 + h) * NCH + c) * 64 + F.tid] = fexp(BC[(ntok - 1) * BCP + F.tid]);
    }
    lds_barrier();
}

__device__ __forceinline__ void phase2(const Args& a, const Frame& F) {
    {
        constexpr int NU = NB * 8 * NCH;
        const int u0 = (int)((long)F.blk * NU / F.G), u1 = (int)((long)(F.blk + 1) * NU / F.G);
        L1Pf pf;
        if (u0 < u1) l1_fetch(a, F, (u0 / NCH) >> 3, (u0 / NCH) & 7, u0 % NCH, pf);
        unsigned long long tf_ = 0, tb_ = 0;
        for (int u = u0; u < u1; ++u) {
            const int c = u % NCH, bh = u / NCH; f32x4 rtil[2];
            const unsigned long long t0_ = (REP_MASK >> 16) ? __builtin_amdgcn_s_memrealtime() : 0ull;
            { const Frame F1 = mkframe(F.lds, F.wave); rwkv_l1_front(a, F1, bh >> 3, bh & 7, c, pf, rtil); }
            const unsigned long long t1_ = (REP_MASK >> 16) ? __builtin_amdgcn_s_memrealtime() : 0ull;
            { const Frame F2 = mkframe(F.lds, F.wave);
              if (u + 1 < u1) l1_fetch(a, F2, ((u + 1) / NCH) >> 3, ((u + 1) / NCH) & 7, (u + 1) % NCH, pf);
              rwkv_l1_back(a, F2, bh >> 3, bh & 7, c, rtil); }
            const unsigned long long t2_ = (REP_MASK >> 16) ? __builtin_amdgcn_s_memrealtime() : 0ull;
            tf_ += t1_ - t0_; tb_ += t2_ - t1_;
        }
        if ((REP_MASK >> 16) != 0) {
            const unsigned long long dt_ = ((REP_MASK >> 16) == 1) ? tf_ : tb_, s0_ = __builtin_amdgcn_s_memrealtime();
            while (__builtin_amdgcn_s_memrealtime() - s0_ < dt_) __builtin_amdgcn_s_sleep(8);
        }
    }
    for (int rep_ = 0; rep_ < NREP(12); ++rep_)
    for (int u = F.blk; u < NB * 4 * 32; u += F.G) { const int c = u & 31, bh = u >> 5; gla_g1_unit(a, F, bh >> 2, bh & 3, c); }
}

struct L2S { bf16x8 fg[4]; v2u hq[2]; f32x4 gm[2]; };
__device__ __forceinline__ void l2s_fetch(L2S& r, const unsigned char* hp, const unsigned char* gp, const float* gam) {
#pragma unroll
    for (int cc = 0; cc < 2; ++cc) { r.fg[2 * cc] = *(const bf16x8*)(gp + cc * 2048); r.fg[2 * cc + 1] = *(const bf16x8*)(gp + cc * 2048 + 64);
        r.hq[cc] = *(const v2u*)(hp + cc * 32); r.gm[cc] = *(const f32x4*)(gam + cc * 16); }
}
__device__ __forceinline__ void l2s_step(const L2S& r, const LAS bf16* Sc, LAS bf16* Sn, f32x4 (&Sm)[2], int row, int col0, int fq, bf16* gout, int tid) {
    {
        const int r_ = tid >> 3, c8 = tid & 7;
        *(v4u*)(gout + r_ * 64 + 8 * c8) = *(const LAS v4u*)(Sc + r_ * TP + 8 * c8);
    }
    const bf16x8 af0 = *(const LAS bf16x8*)(Sc + row * TP + 8 * fq), af1 = *(const LAS bf16x8*)(Sc + row * TP + 32 + 8 * fq);
#pragma unroll
    for (int cc = 0; cc < 2; ++cc) {
        f32x4 acc = {bflo(r.hq[cc].x), bfhi(r.hq[cc].x), bflo(r.hq[cc].y), bfhi(r.hq[cc].y)};
        acc = mfma16(r.fg[2 * cc], af0, acc);
        acc = mfma16(r.fg[2 * cc + 1], af1, acc);
        Sm[cc] = Sm[cc] * r.gm[cc] + acc; }
#pragma unroll
    for (int cc = 0; cc < 2; ++cc) *(LAS v2u*)(Sn + row * TP + col0 + cc * 16) = pack4(Sm[cc]);
}
__device__ __forceinline__ void rwkv_l2_unit(const Args& a, const Frame& F, int bh) {
    unsigned char* ws = a.ws;
    LAS bf16* Sb0 = (LAS bf16*)F.lds; LAS bf16* Sb1 = Sb0 + 64 * TP;
    const int fr = F.lane & 15, fq = F.lane >> 4, rt = F.wave & 3, cp = F.wave >> 2;
    const int row = rt * 16 + fr, col0 = cp * 32 + 4 * fq;
    const unsigned char* hpb = ws + WS_R1 + (size_t)bh * NCH * R1_STRIDE + 8192 + (size_t)(row * 64 + col0) * 2;
    const unsigned char* gpb = ws + WS_R1 + (size_t)bh * NCH * R1_STRIDE + (size_t)((cp * 32 + fr) * 64 + 8 * fq) * 2;
    const float* gamb = (const float*)(ws + WS_GAM) + (size_t)bh * NCH * 64 + col0;
    bf16* sst = (bf16*)(ws + WS_SST) + (size_t)bh * NCH * 4096;
    f32x4 Sm[2];
#pragma unroll
    for (int cc = 0; cc < 2; ++cc) { Sm[cc] = (f32x4){0.f, 0.f, 0.f, 0.f}; *(LAS v2u*)(Sb0 + row * TP + col0 + cc * 16) = (v2u){0u, 0u}; }
    L2S r0, r1, r2, r3;
#define L2F(rr, cn) l2s_fetch(rr, hpb + (size_t)(cn) * R1_STRIDE, gpb + (size_t)(cn) * R1_STRIDE, gamb + (size_t)(cn) * 64)
    L2F(r0, 0); L2F(r1, 1); L2F(r2, 2);
    lds_barrier();
#pragma nounroll
    for (int c = 0; c < NCH - 1; c += 4) {
        L2F(r3, c + 3);
        l2s_step(r0, Sb0, Sb1, Sm, row, col0, fq, sst + (size_t)c * 4096, F.tid); lds_barrier();
        if (c + 4 < NCH - 1) L2F(r0, c + 4);
        l2s_step(r1, Sb1, Sb0, Sm, row, col0, fq, sst + (size_t)(c + 1) * 4096, F.tid); lds_barrier();
        if (c + 5 < NCH - 1) L2F(r1, c + 5);
        l2s_step(r2, Sb0, Sb1, Sm, row, col0, fq, sst + (size_t)(c + 2) * 4096, F.tid); lds_barrier();
        if (c + 6 < NCH - 1) L2F(r2, c + 6);
        l2s_step(r3, Sb1, Sb0, Sm, row, col0, fq, sst + (size_t)(c + 3) * 4096, F.tid); lds_barrier();
    }
#undef L2F
    { const int r_ = F.tid >> 3, c8 = F.tid & 7;
      *(v4u*)(sst + (size_t)(NCH - 1) * 4096 + r_ * 64 + 8 * c8) = *(const LAS v4u*)(Sb0 + r_ * TP + 8 * c8); }
    lds_barrier();
}
__device__ __forceinline__ void rwkv_y_task(const Args& a, const Frame& F, int task) {
    unsigned char* ws = a.ws;
    const int rt = task & 3, c = 1 + ((task >> 2) & 31), bh = task >> 7, b = bh >> 3, h = bh & 7;
    const int fr = F.lane & 15, fq = F.lane >> 4, row = rt * 16 + fr;
    const unsigned char* r1 = ws + WS_R1 + (size_t)(bh * NCH + c) * R1_STRIDE + (size_t)(row * 64 + 4 * fq) * 2;
    const bf16* Sg = (const bf16*)(ws + WS_SST) + (size_t)(bh * NCH + c) * 4096 + fr * 64 + 8 * fq;
    const bf16x8 fa0 = *(const bf16x8*)(r1 + 2 * 8192 + 8 * fq), fa1 = *(const bf16x8*)(r1 + 2 * 8192 + 64 + 8 * fq);
    bf16x8 sf[8]; v2u q0[4], q1[4], q2[4];
#pragma unroll
    for (int ct = 0; ct < 4; ++ct) { sf[2 * ct] = *(const bf16x8*)(Sg + ct * 1024); sf[2 * ct + 1] = *(const bf16x8*)(Sg + ct * 1024 + 32);
        q0[ct] = *(const v2u*)(r1 + 3 * 8192 + ct * 32); q1[ct] = *(const v2u*)(r1 + 4 * 8192 + ct * 32); q2[ct] = *(const v2u*)(r1 + 5 * 8192 + ct * 32); }
    f32x4 y[4]; float s = 0.f;
#pragma unroll
    for (int ct = 0; ct < 4; ++ct) {
        f32x4 acc = {bflo(q0[ct].x), bfhi(q0[ct].x), bflo(q0[ct].y), bfhi(q0[ct].y)};
        acc = mfma16(sf[2 * ct], fa0, acc); acc = mfma16(sf[2 * ct + 1], fa1, acc);
        y[ct] = acc; s += (acc[0] + acc[1]) + (acc[2] + acc[3]); }
    s += shx(s, 16, F.lane); s += shx(s, 32, F.lane);
    const float mean = s * (1.f / 64.f); float q = 0.f;
#pragma unroll
    for (int ct = 0; ct < 4; ++ct) { y[ct] = y[ct] - mean; q += (y[ct][0] * y[ct][0] + y[ct][1] * y[ct][1]) + (y[ct][2] * y[ct][2] + y[ct][3] * y[ct][3]); }
    q += shx(q, 16, F.lane); q += shx(q, 32, F.lane);
    const float rstd = __builtin_amdgcn_rsqf(q * (1.f / 64.f) + 64e-5f);
    LAS bf16* ost = (LAS bf16*)(F.lds + 102400 + F.wave * 2304);
#pragma unroll
    for (int ct = 0; ct < 4; ++ct) { const int i0 = h * 64 + ct * 16 + 4 * fq;
        const f32x4 lg = *(const f32x4*)(a.in[I_RLNG] + i0), lb = *(const f32x4*)(a.in[I_RLNB] + i0);
        const f32x4 g = {bflo(q1[ct].x), bfhi(q1[ct].x), bflo(q1[ct].y), bfhi(q1[ct].y)}, bv = {bflo(q2[ct].x), bfhi(q2[ct].x), bflo(q2[ct].y), bfhi(q2[ct].y)};
        const f32x4 o = (y[ct] * rstd * lg + lb + bv) * g;
        *(LAS v2u*)(ost + fr * 72 + ct * 16 + 4 * fq) = pack4(o); }
    asm volatile("s_waitcnt lgkmcnt(0)" ::: "memory");
    bf16* yout = (bf16*)(ws + WS_YMIX) + ((size_t)b * SEQ + 64 * (c - 1) + rt * 16) * D + 512 + h * 64;
#pragma unroll
    for (int hh = 0; hh < 2; ++hh) { const int tr = (F.lane >> 3) + 8 * hh, c8 = F.lane & 7;
        *(v4u*)(yout + (size_t)tr * D + 8 * c8) = *(const LAS v4u*)(ost + tr * 72 + 8 * c8); }
    asm volatile("s_waitcnt lgkmcnt(0)" ::: "memory");
}
__device__ __forceinline__ void gla_scan_unit(const Args& a, const Frame& F, int j) {
    float* GUS = (float*)(a.ws + WS_GUS); const float* DL = (const float*)(a.ws + WS_DL);
    const int bh = j >> 1, half = j & 1;
    const int d = 32 * half + (F.tid >> 4), e0 = (F.tid & 15) * 8;
    float* base = GUS + (size_t)bh * NCH * 8192 + d * 128 + e0;
    const float* dl = DL + (size_t)bh * NCH * 64 + d;
    f32x4 s0 = {0.f, 0.f, 0.f, 0.f}, s1 = s0;
    f32x4 ua[4], ub[4]; float dq[4];
#pragma unroll
    for (int q = 0; q < 3; ++q) { ua[q] = *(const f32x4*)(base + (size_t)q * 8192); ub[q] = *(const f32x4*)(base + (size_t)q * 8192 + 4); dq[q] = dl[q * 64]; }
#pragma unroll 4
    for (int c = 0; c < NCH - 1; ++c) {
        const int cn = (c + 3 < NCH - 1) ? c + 3 : NCH - 2;
        ua[(c + 3) & 3] = *(const f32x4*)(base + (size_t)cn * 8192); ub[(c + 3) & 3] = *(const f32x4*)(base + (size_t)cn * 8192 + 4); dq[(c + 3) & 3] = dl[cn * 64];
        *(f32x4*)(base + (size_t)c * 8192) = s0; *(f32x4*)(base + (size_t)c * 8192 + 4) = s1;
        s0 = s0 * dq[c & 3] + ua[c & 3]; s1 = s1 * dq[c & 3] + ub[c & 3];
    }
    *(f32x4*)(base + (size_t)(NCH - 1) * 8192) = s0; *(f32x4*)(base + (size_t)(NCH - 1) * 8192 + 4) = s1;
}
__device__ __forceinline__ void phase3(const Args& a, const Frame& F) {
    constexpr int PSEL = (REP_MASK >> 20) & 7;
    const unsigned long long t0_ = PSEL ? __builtin_amdgcn_s_memrealtime() : 0ull;
    for (int u = F.blk; u < 256; u += F.G) {
        if (u < 128) { for (int rep_ = 0; rep_ < NREP(3); ++rep_) rwkv_l2_unit(a, F, u); }
        else gla_scan_unit(a, F, u - 128);
    }
    if (PSEL) { const unsigned long long t1_ = __builtin_amdgcn_s_memrealtime();
        unsigned long long dt_ = 0;
        if (PSEL == 1 && F.blk < 128) dt_ = t1_ - t0_;
        if (PSEL == 2 && F.blk >= 128) dt_ = t1_ - t0_;
        while (__builtin_amdgcn_s_memrealtime() - t1_ < dt_) __builtin_amdgcn_s_sleep(8); }
}

__device__ __forceinline__ void gla_g3_unit(const Args& a, const Frame& F, int b, int h, int c) {
    const bf16* PROJ = (const bf16*)(a.ws + WS_PROJ); const bf16* PROJM = (const bf16*)(a.ws + WS_PROJM);
    const float* GUS = (const float*)(a.ws + WS_GUS); bf16* YMIX = (bf16*)(a.ws + WS_YMIX);
    const int vp0 = NMETA + 64 * (c - 1);
    gla_bc(a, F, b, h, vp0, 64);
    LAS float* BC = (LAS float*)(F.lds + 4096);
    LAS bf16* QT = (LAS bf16*)(F.lds + 24576);
    LAS bf16* KL = QT + 64 * TP;
    LAS bf16* AT = KL + 64 * TP;
    LAS bf16* VT = AT + 64 * TP;
    LAS bf16* ST = VT + 128 * TP;
    LAS float* RS = (LAS float*)(ST + 128 * TP);
    {
        const int t = F.tid >> 3, q = F.tid & 7;
        const f32x4 q0 = ldp4(PROJ, PROJM, b, vp0 + t, GQ + h * 64 + 8 * q), q1 = ldp4(PROJ, PROJM, b, vp0 + t, GQ + h * 64 + 8 * q + 4);
        const f32x4 k0 = ldp4(PROJ, PROJM, b, vp0 + t, GK + h * 64 + 8 * q), k1 = ldp4(PROJ, PROJM, b, vp0 + t, GK + h * 64 + 8 * q + 4);
        float qv[8] = {q0.x, q0.y, q0.z, q0.w, q1.x, q1.y, q1.z, q1.w}, kv[8] = {k0.x, k0.y, k0.z, k0.w, k1.x, k1.y, k1.z, k1.w};
#pragma unroll
        for (int i = 0; i < 8; ++i) { const float bcv = BC[t * BCP + 8 * q + i]; qv[i] *= fexp(bcv) * 0.125f; kv[i] *= fexp(-bcv); }
        v4u o; o.x = pk2(qv[0], qv[1]); o.y = pk2(qv[2], qv[3]); o.z = pk2(qv[4], qv[5]); o.w = pk2(qv[6], qv[7]);
        *(LAS v4u*)(QT + t * TP + 8 * q) = o;
        o.x = pk2(kv[0], kv[1]); o.y = pk2(kv[2], kv[3]); o.z = pk2(kv[4], kv[5]); o.w = pk2(kv[6], kv[7]);
        *(LAS v4u*)(KL + t * TP + 8 * q) = o;
#pragma unroll
        for (int qq = 0; qq < 4; ++qq) {
            const int e0 = 16 * q + 4 * qq;
            const f32x4 vv = ldp4(PROJ, PROJM, b, vp0 + t, GV + h * 128 + e0);
#pragma unroll
            for (int i = 0; i < 4; ++i) VT[(e0 + i) * TP + t] = (bf16)f2bf(vv[i]);
            const f32x4 sv = *(const f32x4*)(GUS + ((size_t)((b * 4 + h) * NCH + c) * 64 + t) * 128 + e0);
#pragma unroll
            for (int i = 0; i < 4; ++i) ST[(e0 + i) * TP + t] = (bf16)f2bf(sv[i]);
        }
    }
    lds_barrier();
    const int rt = F.wave & 3, wh = F.wave >> 2, fr = F.lane & 15, fq = F.lane >> 4;
    const int trow = rt * 16 + fr;
    {
#pragma unroll
        for (int cc = 0; cc < 2; ++cc) { const int ct = 2 * wh + cc;
            f32x4 acc = {0.f, 0.f, 0.f, 0.f};
#pragma unroll
            for (int ks = 0; ks < 2; ++ks)
                acc = mfma16(*(const LAS bf16x8*)(KL + (ct * 16 + fr) * TP + ks * 32 + 8 * fq), *(const LAS bf16x8*)(QT + trow * TP + ks * 32 + 8 * fq), acc);
            const int s0 = ct * 16 + 4 * fq;
#pragma unroll
            for (int i = 0; i < 4; ++i) if (s0 + i > trow) acc[i] = 0.f;
            v2u o; o.x = pk2(acc[0], acc[1]); o.y = pk2(acc[2], acc[3]);
            *(LAS v2u*)(AT + trow * TP + s0) = o; }
    }
    lds_barrier();
    f32x4 oacc[4]; float ssq = 0.f;
#pragma unroll
    for (int cc = 0; cc < 4; ++cc) { const int ct = wh * 4 + cc;
        f32x4 acc = {0.f, 0.f, 0.f, 0.f};
#pragma unroll
        for (int ks = 0; ks < 2; ++ks) {
            acc = mfma16(*(const LAS bf16x8*)(VT + (ct * 16 + fr) * TP + ks * 32 + 8 * fq), *(const LAS bf16x8*)(AT + trow * TP + ks * 32 + 8 * fq), acc);
            acc = mfma16(*(const LAS bf16x8*)(ST + (ct * 16 + fr) * TP + ks * 32 + 8 * fq), *(const LAS bf16x8*)(QT + trow * TP + ks * 32 + 8 * fq), acc);
        }
        oacc[cc] = acc; ssq += (acc[0] * acc[0] + acc[1] * acc[1]) + (acc[2] * acc[2] + acc[3] * acc[3]); }
    ssq += shx(ssq, 16, F.lane); ssq += shx(ssq, 32, F.lane);
    if (fq == 0) RS[wh * 64 + trow] = ssq;
    lds_barrier();
    {
        const float tot = RS[trow] + RS[64 + trow];
        const float rstd = 1.f / sqrtf(tot * (1.f / 128.f) + 1e-6f);
        const size_t m = (size_t)b * SEQ + (vp0 - NMETA) + trow;
#pragma unroll
        for (int cc = 0; cc < 4; ++cc) { const int e0 = (wh * 4 + cc) * 16 + 4 * fq;
            const f32x4 gv = ldp4(PROJ, PROJM, b, vp0 + trow, GG + h * 128 + e0);
            const f32x4 ng = *(const f32x4*)(a.in[I_GNORM] + e0);
            float y[4];
#pragma unroll
            for (int i = 0; i < 4; ++i) { const float gi = gv[i]; y[i] = oacc[cc][i] * rstd * ng[i] * (gi * fsigmoid(gi)); }
            v2u o; o.x = pk2(y[0], y[1]); o.y = pk2(y[2], y[3]);
            *(v2u*)(YMIX + m * D + h * 128 + e0) = o; }
    }
    lds_barrier();
}
__device__ __forceinline__ void phase4(const Args& a, const Frame& F) {
    for (int t = F.blk * NWAVES + F.wave; t < 128 * 32 * 4; t += F.G * NWAVES) rwkv_y_task(a, F, t);
    __syncthreads();
    for (int u = F.blk; u < NB * 4 * 32; u += F.G) { const int c = 1 + (u & 31), bh = u >> 5; gla_g3_unit(a, F, bh >> 2, bh & 3, c); }
}

__device__ __forceinline__ int eidx_of(int L) { return 16 * (L & 1) + 8 * ((L >> 1) & 1) + 4 * ((L >> 2) & 1) + 2 * ((L >> 3) & 1) + ((L >> 4) & 1); }
__device__ __forceinline__ void p6_row(const Args& a, const Frame& F, int m, int i, f32x4 (&v)[4], const LAS float* rwT, int& my_e) {
    unsigned char* ws = a.ws; constexpr int RWP = 1028;
    bf16* H1 = (bf16*)(ws + WS_H1); int* TOPI = (int*)(ws + WS_TOPI); float* GATE = (float*)(ws + WS_GATE);
    float s = 0.f;
#pragma unroll
    for (int j = 0; j < 4; ++j) s += (v[j].x + v[j].y) + (v[j].z + v[j].w);
    const float mean = wave_sum(s, F.lane) * (1.f / D); float s2 = 0.f;
#pragma unroll
    for (int j = 0; j < 4; ++j) { v[j] = v[j] - mean; s2 += (v[j].x * v[j].x + v[j].y * v[j].y) + (v[j].z * v[j].z + v[j].w * v[j].w); }
    const float rstd = 1.f / sqrtf(wave_sum(s2, F.lane) * (1.f / D) + 1e-5f);
#pragma unroll
    for (int j = 0; j < 4; ++j) { const int col = 4 * (F.lane + 64 * j);
        const f32x4 gv = *(const f32x4*)(a.in[I_LN1G] + col), bv = *(const f32x4*)(a.in[I_LN1B] + col);
        v[j] = v[j] * rstd * gv + bv;
        v2u o; o.x = pk2(v[j].x, v[j].y); o.y = pk2(v[j].z, v[j].w);
        *(v2u*)(H1 + (size_t)m * D + col) = o;
        int w8 = __builtin_amdgcn_cvt_pk_fp8_f32(v[j].x, v[j].y, 0, false); w8 = __builtin_amdgcn_cvt_pk_fp8_f32(v[j].z, v[j].w, w8, true);
        *(int*)(ws + WS_H1Q + (size_t)m * D + col) = w8; }
    float p[32];
#pragma unroll
    for (int e = 0; e < 32; ++e) { float acc = 0.f;
#pragma unroll
        for (int j = 0; j < 4; ++j) { const f32x4 w = *(const LAS f32x4*)(rwT + e * RWP + 4 * (F.lane + 64 * j)); acc += (v[j].x * w.x + v[j].y * w.y) + (v[j].z * w.z + v[j].w * w.w); }
        p[e] = acc; if ((e & 3) == 3) __builtin_amdgcn_sched_barrier(0); }
#define TR_STAGE(n, dmask) _Pragma("unroll") for (int i2 = 0; i2 < (n) / 2; ++i2) { const bool up = (F.lane & (dmask)) != 0; const float keep = up ? p[i2 + (n) / 2] : p[i2]; const float send = up ? p[i2] : p[i2 + (n) / 2]; p[i2] = keep + shx(send, (dmask), F.lane); }
    TR_STAGE(32, 1) TR_STAGE(16, 2) TR_STAGE(8, 4) TR_STAGE(4, 8) TR_STAGE(2, 16)
#undef TR_STAGE
    const int eidx = eidx_of(F.lane);
    const float logit = p[0] + shx(p[0], 32, F.lane) + a.in[I_RTB][eidx];
    int rank = 0;
#pragma unroll
    for (int j = 0; j < 32; ++j) { const float lj = __int_as_float(__builtin_amdgcn_readlane(__float_as_int(logit), j)); const int ej = eidx_of(j);
        rank += (lj > logit || (lj == logit && ej < eidx)) ? 1 : 0; }
    int ek[4]; float lk[4];
#pragma unroll
    for (int k = 0; k < 4; ++k) { const unsigned long long mk = __ballot(rank == k) & 0xffffffffull; const int src = __builtin_amdgcn_readfirstlane((int)__builtin_ctzll(mk | (1ull << 63)));
        ek[k] = eidx_of(src); lk[k] = __int_as_float(__builtin_amdgcn_readlane(__float_as_int(logit), src)); }
    const float e0 = 1.f, e1 = expf(lk[1] - lk[0]), e2 = expf(lk[2] - lk[0]), e3 = expf(lk[3] - lk[0]);
    const float inv = 1.f / (e0 + e1 + e2 + e3);
    if (F.lane < 4) { const int k = F.lane; const int ee = k == 0 ? ek[0] : k == 1 ? ek[1] : k == 2 ? ek[2] : ek[3]; const float gg = (k == 0 ? e0 : k == 1 ? e1 : k == 2 ? e2 : e3) * inv;
        TOPI[(size_t)m * 4 + k] = ee; GATE[(size_t)m * 4 + k] = gg; }
    if ((F.lane >> 2) == i) { const int k = F.lane & 3; my_e = k == 0 ? ek[0] : k == 1 ? ek[1] : k == 2 ? ek[2] : ek[3]; }
}
__device__ __forceinline__ void phase6(const Args& a, const Frame& F, int csel) {
    unsigned char* ws = a.ws;
    const int gw = F.blk * NWAVES + F.wave, NGW = F.G * NWAVES;
    constexpr int RWP = 1028;
    LAS float* rwT = (LAS float*)F.lds;
    LAS int* hist = (LAS int*)(F.lds + 32 * RWP * 4);
    for (int i = F.tid; i < D * NE; i += NTHR) { const int c = i >> 5, e = i & 31; rwT[e * RWP + c] = a.in[I_RTW][i]; }
    const float* S1 = (const float*)(ws + WS_S1); bf16* H1 = (bf16*)(ws + WS_H1);
    int* TOPI = (int*)(ws + WS_TOPI); float* GATE = (float*)(ws + WS_GATE); int* RANK = (int*)(ws + WS_RANK);
    unsigned* CNT = (unsigned*)(ws + WS_CTL) + CW_CNT + 2048 * csel;
    for (int rb = F.blk; rb < MX / 128; rb += F.G) {
        if (F.tid < 64) hist[F.tid] = 0;
        __syncthreads();
        int my_e = 0;
        {
            const f32x4* xr0 = (const f32x4*)(S1 + (size_t)(rb * 128 + F.wave * 16) * D) + F.lane;
            f32x4 va[4], vb[4];
#pragma unroll
            for (int j = 0; j < 4; ++j) va[j] = xr0[64 * j];
#pragma nounroll
            for (int i = 0; i < 16; i += 2) {
#pragma unroll
                for (int j = 0; j < 4; ++j) vb[j] = xr0[(size_t)(i + 1) * (D / 4) + 64 * j];
                p6_row(a, F, rb * 128 + F.wave * 16 + i, i, va, rwT, my_e);
                if (i + 2 < 16) {
#pragma unroll
                    for (int j = 0; j < 4; ++j) va[j] = xr0[(size_t)(i + 2) * (D / 4) + 64 * j]; }
                p6_row(a, F, rb * 128 + F.wave * 16 + i + 1, i + 1, vb, rwT, my_e);
            }
        }
        const int lrank = __hip_atomic_fetch_add(&hist[my_e], 1, __ATOMIC_RELAXED, __HIP_MEMORY_SCOPE_WORKGROUP);
        __syncthreads();
        if (F.tid < 32) hist[32 + F.tid] = (int)__hip_atomic_fetch_add(CNT + 64 * F.tid, (unsigned)hist[F.tid], __ATOMIC_RELAXED, __HIP_MEMORY_SCOPE_AGENT);
        __syncthreads();
        RANK[((size_t)rb * 128 + F.wave * 16 + (F.lane >> 2)) * 4 + (F.lane & 3)] = hist[32 + my_e] + lrank;
        __syncthreads();
    }
}

__device__ __forceinline__ void phase7(const Args& a, const Frame& F) {
    unsigned char* ws = a.ws;
    LAS int* starts = (LAS int*)F.lds;
    unsigned* CNT = (unsigned*)(ws + WS_CTL) + CW_CNT;
    int* TILEE = (int*)(ws + WS_TILEE); int* SLOTTOK = (int*)(ws + WS_SLOTTOK);
    if (F.tid < 32) { const int cnt = (int)ld_agent(CNT + 64 * F.tid); starts[64 + F.tid] = cnt; starts[32 + F.tid] = (cnt + 255) & ~255; }
    __syncthreads();
    if (F.tid == 0) { int run = 0; for (int e = 0; e < 32; ++e) { starts[e] = run; run += starts[32 + e]; }
        if (F.blk == 0) { TILEE[1023] = run >> 8; for (int e = 0; e < 32; ++e) for (int tl = starts[e] >> 8; tl < (starts[e] + starts[32 + e]) >> 8; ++tl) TILEE[tl] = e; } }
    __syncthreads();
    if (F.blk == 0) { for (int e = 0; e < 32; ++e) for (int s = starts[e] + starts[64 + e] + F.tid; s < starts[e] + starts[32 + e]; s += NTHR) SLOTTOK[s] = 0; }
    const int* TOPI = (const int*)(ws + WS_TOPI); const int* RANK = (const int*)(ws + WS_RANK); int* TSLOT = (int*)(ws + WS_TSLOT);
    for (int q = F.blk * NTHR + F.tid; q < MX * 4; q += F.G * NTHR) {
        const int slot = starts[TOPI[q]] + RANK[q];
        TSLOT[q] = slot; SLOTTOK[slot] = q >> 2;
    }
}
__device__ __forceinline__ int moe_fill_table(const Args& a, const Frame& F, int nN, int RM) {
    LAS int* tab = (LAS int*)(F.lds + TAB_OFF);
    const unsigned* TILEE = (const unsigned*)(a.ws + WS_TILEE);
    if (F.tid == 0) {
        const int NT = (int)ld_agent(TILEE + 1023);
        const int x = F.blk & 7, j = F.blk >> 3; int n = 0;
        for (int i = 0; i < 64; ++i) { const int s = i * 8 + x, pm = s * RM + j / nN; if (pm >= NT) break;
            const int e = (int)ld_agent(TILEE + pm); tab[2 * n] = pm; tab[2 * n + 1] = e * nN + (j % nN); ++n; }
        tab[128] = n;
    }
    __syncthreads();
    return __builtin_amdgcn_readfirstlane(tab[128]);
}

__device__ __forceinline__ void p10_acc(float (&s)[16], int j, const v4u w, float g) {
    s[8 * j + 0] += g * bflo(w.x); s[8 * j + 1] += g * bfhi(w.x); s[8 * j + 2] += g * bflo(w.y); s[8 * j + 3] += g * bfhi(w.y);
    s[8 * j + 4] += g * bflo(w.z); s[8 * j + 5] += g * bfhi(w.z); s[8 * j + 6] += g * bflo(w.w); s[8 * j + 7] += g * bfhi(w.w);
}
__device__ __forceinline__ void phase10(const Args& a, const Frame& F) {
    unsigned char* ws = a.ws;
    const bf16* H1 = (const bf16*)(ws + WS_H1); const bf16* YS = (const bf16*)(ws + WS_YS);
    const int* TSLOT = (const int*)(ws + WS_TSLOT); const float* GATE = (const float*)(ws + WS_GATE);
    const int gw = F.blk * NWAVES + F.wave, NGW = F.G * NWAVES;
    f32x4 gv[4], bv[4];
#pragma unroll
    for (int q = 0; q < 4; ++q) { const int col = 8 * F.lane + 512 * (q >> 1) + 4 * (q & 1); gv[q] = *(const f32x4*)(a.in[I_LN2G] + col); bv[q] = *(const f32x4*)(a.in[I_LN2B] + col); }
    for (int m0 = gw; m0 < MX; m0 += 2 * NGW) {
        int mm[2]; mm[0] = m0; mm[1] = (m0 + NGW < MX) ? m0 + NGW : m0;
        int slot[2][4]; float gt[2][4]; v4u hw[2][2], yw[2][4][2];
#pragma unroll
        for (int r = 0; r < 2; ++r) {
#pragma unroll
            for (int k = 0; k < 4; ++k) { slot[r][k] = TSLOT[(size_t)mm[r] * 4 + k]; gt[r][k] = GATE[(size_t)mm[r] * 4 + k]; }
#pragma unroll
            for (int j = 0; j < 2; ++j) hw[r][j] = *(const v4u*)(H1 + (size_t)mm[r] * D + 8 * F.lane + 512 * j); }
#pragma unroll
        for (int r = 0; r < 2; ++r)
#pragma unroll
            for (int k = 0; k < 4; ++k)
#pragma unroll
                for (int j = 0; j < 2; ++j) yw[r][k][j] = *(const v4u*)(YS + (size_t)slot[r][k] * D + 8 * F.lane + 512 * j);
#pragma unroll
        for (int r = 0; r < 2; ++r) {
            float s[16];
#pragma unroll
            for (int i = 0; i < 16; ++i) s[i] = 0.f;
#pragma unroll
            for (int j = 0; j < 2; ++j) p10_acc(s, j, hw[r][j], ALPHA);
#pragma unroll
            for (int k = 0; k < 4; ++k)
#pragma unroll
                for (int j = 0; j < 2; ++j) p10_acc(s, j, yw[r][k][j], gt[r][k]);
            float t = 0.f;
#pragma unroll
            for (int i = 0; i < 16; ++i) t += s[i];
            const float mean = wave_sum(t, F.lane) * (1.f / D); float q = 0.f;
#pragma unroll
            for (int i = 0; i < 16; ++i) { s[i] -= mean; q += s[i] * s[i]; }
            const float rstd = __builtin_amdgcn_rsqf(wave_sum(q, F.lane) * (1.f / D) + 1e-5f);
            if (r == 0 || mm[1] != mm[0]) {
#pragma unroll
                for (int q4 = 0; q4 < 4; ++q4) { const int col = 8 * F.lane + 512 * (q4 >> 1) + 4 * (q4 & 1);
                    f32x4 o; o.x = s[4 * q4 + 0] * rstd * gv[q4].x + bv[q4].x; o.y = s[4 * q4 + 1] * rstd * gv[q4].y + bv[q4].y; o.z = s[4 * q4 + 2] * rstd * gv[q4].z + bv[q4].z; o.w = s[4 * q4 + 3] * rstd * gv[q4].w + bv[q4].w;
                    *(f32x4*)(a.out + (size_t)mm[r] * D + col) = o; } }
        }
    }
}

template <int LO, int HI>
__global__ void __launch_bounds__(NTHR, 2) fwd(Args a) {
    extern __shared__ __attribute__((aligned(16))) unsigned char lds_raw[];
    LAS unsigned char* lds = (LAS unsigned char*)lds_raw;
    const int wave = __builtin_amdgcn_readfirstlane((int)(threadIdx.x >> 6));
    volatile LAS unsigned* MISC = (volatile LAS unsigned*)(lds + MISC_OFF);
    if (wave == 0) MISC[lane_id()] = 0u;
    __syncthreads();
    unsigned* ctl = (unsigned*)(a.ws + WS_CTL);
    XcdBarrier bar; bar.bar = ctl + CW_BAR; bar.x = 0; bar.st = nullptr;
    if constexpr (HI - LO > 1) bar = xcd_barrier_post(ctl + CW_BAR, MISC + 8, wave == 0 && lane_id() == 0);
#define PH(k) if constexpr (LO <= (k) && (k) < HI)
#define SEAM(k) if constexpr (LO <= (k) && (k) + 1 < HI) xcd_barrier(bar, wave == 0 && lane_id() == 0)
    PH(0) for (int rep_ = 0; rep_ < NREP(0); ++rep_) { const Frame F = mkframe(lds, wave); phase0(a, F); } SEAM(0);
    PH(1) for (int rep_ = 0; rep_ < NREP(1); ++rep_) { const Frame F = mkframe(lds, wave);
            pg8::Gemm g{(const pg8::bf16_t*)(a.ws + WS_A0), (const pg8::bf16_t*)(a.ws + WS_WIN), MX, PW, D}; pg8::StaticOrder S; S.init(MX, PW, F.G, F.blk);
            pg8::EpiBf16Plain E{(pg8::bf16_t*)(a.ws + WS_PROJ), PW};
            pg8::gemm_phase<pg8::EpiBf16Plain, pg8::StaticOrder, true, true>(F.lds, g, S, E, F.tid); } SEAM(1);
    PH(2) for (int rep_ = 0; rep_ < NREP(2); ++rep_) { const Frame F = mkframe(lds, wave); phase2(a, F); } SEAM(2);
    PH(3) { const Frame F = mkframe(lds, wave); phase3(a, F); } SEAM(3);
    PH(4) for (int rep_ = 0; rep_ < NREP(4); ++rep_) { const Frame F = mkframe(lds, wave); phase4(a, F); } SEAM(4);
    PH(5) for (int rep_ = 0; rep_ < NREP(5); ++rep_) { const Frame F = mkframe(lds, wave);
            pg8::Gemm g{(const pg8::bf16_t*)(a.ws + WS_YMIX), (const pg8::bf16_t*)(a.ws + WS_WOUT), MX, D, D}; pg8::StaticOrder S; S.init(MX, D, F.G, F.blk);
            pg8::EpiResid E{(float*)(a.ws + WS_S1), a.in[I_X], (const float*)(a.ws + WS_STATS), a.in[I_LNIN_G], a.in[I_LNIN_B], ALPHA};
            pg8::gemm_phase<pg8::EpiResid, pg8::StaticOrder, true, true>(F.lds, g, S, E, F.tid); } SEAM(5);
    PH(6) for (int rep_ = 0; rep_ < NREP(6); ++rep_) { const Frame F = mkframe(lds, wave); phase6(a, F, rep_); } SEAM(6);
    PH(7) for (int rep_ = 0; rep_ < NREP(7); ++rep_) { const Frame F = mkframe(lds, wave); phase7(a, F); } SEAM(7);
    PH(8) for (int rep_ = 0; rep_ < NREP(8); ++rep_) { const Frame F = mkframe(lds, wave); const int n = moe_fill_table(a, F, 8, 4);
            pg8::Gemm g{(const pg8::bf16_t*)(a.ws + WS_H1Q), (const pg8::bf16_t*)(a.ws + WS_WUP), 0, 0, D / 2}; pg8::TableOrder S{(const LAS int*)(F.lds + TAB_OFF), n};
            pg8::EpiSwiglu8 E{a.ws + WS_ACT, a.in[I_BUP]};
            pg8::gemm_phase_g<pg8::EpiSwiglu8, pg8::TableOrder, true, true, 121>(F.lds, g, S, E, F.tid, (const int*)(a.ws + WS_SLOTTOK)); } SEAM(8);
    PH(9) for (int rep_ = 0; rep_ < NREP(9); ++rep_) { const Frame F = mkframe(lds, wave); const int n = moe_fill_table(a, F, 4, 8);
            pg8::Gemm g{(const pg8::bf16_t*)(a.ws + WS_ACT), (const pg8::bf16_t*)(a.ws + WS_WDN), 0, 0, D / 2}; pg8::TableOrder S{(const LAS int*)(F.lds + TAB_OFF), n};
            pg8::EpiDown E{(pg8::bf16_t*)(a.ws + WS_YS), a.in[I_BDN]};
            pg8::gemm_phase<pg8::EpiDown, pg8::TableOrder, true, true, 120>(F.lds, g, S, E, F.tid); } SEAM(9);
    PH(10) for (int rep_ = 0; rep_ < NREP(10); ++rep_) { const Frame F = mkframe(lds, wave); phase10(a, F); }
#undef PH
#undef SEAM
}

#ifndef MK_SINGLE
#define MK_SINGLE 1
#endif
template <int LO, int HI> static void launch_range(const Args& a, int grid, hipStream_t stream) {
    static bool attr = false;
    if (!attr) { (void)hipFuncSetAttribute((const void*)fwd<LO, HI>, hipFuncAttributeMaxDynamicSharedMemorySize, LDS_BYTES); attr = true; }
    hipLaunchKernelGGL((fwd<LO, HI>), dim3(grid), dim3(NTHR), LDS_BYTES, stream, a);
}
extern "C" void kernel_launch(void* const* d_in, const int* in_sizes, int n_in, void* d_out, int out_size, void* d_ws, size_t ws_size, hipStream_t stream) {
    if (n_in != 30 || ws_size < WS_END) { fprintf(stderr, "kernel_launch: unexpected inputs (n_in %d, ws %zu)\n", n_in, ws_size); return; }
    const int grid = 256;
    (void)hipMemsetAsync((char*)d_ws + WS_CTL, 0, CTL_ZERO_BYTES, stream);
    Args a{};
    for (int i = 0; i < 30; ++i) a.in[i] = (const float*)d_in[i];
    a.out = (float*)d_out; a.ws = (unsigned char*)d_ws;
#if MK_SINGLE
    launch_range<0, 11>(a, grid, stream);
#else
    launch_range<0, 1>(a, grid, stream); launch_range<1, 2>(a, grid, stream); launch_range<2, 3>(a, grid, stream); launch_range<3, 4>(a, grid, stream);
    launch_range<4, 5>(a, grid, stream); launch_range<5, 6>(a, grid, stream); launch_range<6, 7>(a, grid, stream); launch_range<7, 8>(a, grid, stream);
    launch_range<8, 9>(a, grid, stream); launch_range<9, 10>(a, grid, stream); launch_range<10, 11>(a, grid, stream);
#endif
}
```

```cpp
#include <hip/hip_runtime.h>
#include <cstdio>
#include <cstdint>
#include <cmath>
namespace pg8 {
#define PG8_LAS __attribute__((address_space(3)))
typedef unsigned short bf16_t;
typedef short bf16x8 __attribute__((ext_vector_type(8)));
typedef float f32x4 __attribute__((ext_vector_type(4)));
typedef unsigned u32x4 __attribute__((ext_vector_type(4)));
constexpr int BM = 256, BK = 64, HALF = 128, HTB = HALF * BK * 2  , STAGE_BYTES = 8 * HTB, NXCD = 8, WGM = 8;

__host__ __device__ __forceinline__ int lds_byte(int r, int c) { const int st = (r >> 4) * 2 + (c >> 5), rr = r & 15, cc = c & 31, ob = rr * 64 + cc * 2; return st * 1024 + (ob ^ (((ob >> 9) & 1) << 5)); }
__host__ __device__ __forceinline__ void stage_rc(int b, int& R, int& C) { const int st = b / 1024, sb = b % 1024, swz = sb ^ (((sb >> 9) & 1) << 5); R = (st >> 1) * 16 + swz / 64; C = (st & 1) * 32 + (swz % 64) / 2; }
__host__ __device__ __forceinline__ int perm32(int rho) { const int n = rho >> 4, i = rho & 15; return 8 * (i >> 2) + 4 * n + (i & 3); }

struct Unit { int pm, pn; };
struct Gemm { const bf16_t* A; const bf16_t* Bt; int M, N, K; };

struct StaticOrder {
    int nM, nN, nwg, G, c;
    __host__ __device__ void init(int M, int N, int G_, int c_) { nM = M / BM; nN = N / BM; nwg = nM * nN; G = G_; c = c_; }
    __host__ __device__ bool next(int i, Unit& u) const {
        const long L = (long)i * G + c; if (L >= nwg) return false;
        int wgid = (int)L; { const int q = nwg / NXCD, r = nwg % NXCD, xcd = wgid % NXCD, off = wgid / NXCD; wgid = (xcd < r ? xcd * (q + 1) : r * (q + 1) + (xcd - r) * q) + off; }
        const int nig = WGM * nN, gid = wgid / nig, fm = gid * WGM, gsz = (nM - fm) < WGM ? (nM - fm) : WGM;
        u.pm = fm + ((wgid % nig) % gsz); u.pn = (wgid % nig) / gsz; return true;
    }
    __device__ __forceinline__ void a_ready(const Unit&) const {}
    __device__ __forceinline__ void done(const Unit&) const {}
};


__device__ __forceinline__ unsigned cvt_pk_bf16(float lo, float hi) { unsigned r; asm volatile("v_cvt_pk_bf16_f32 %0, %1, %2" : "=v"(r) : "v"(lo), "v"(hi)); return r; }
typedef unsigned u32x2 __attribute__((ext_vector_type(2)));
typedef int i32x8 __attribute__((ext_vector_type(8))); typedef int i32x4 __attribute__((ext_vector_type(4)));
__device__ __forceinline__ void mfma_f8(f32x4& acc, i32x8 a, i32x8 b, int sa, int sb) {
    asm volatile("s_nop 1\n\tv_mfma_scale_f32_16x16x128_f8f6f4 %0, %1, %2, %0, %3, %4 op_sel_hi:[0,0,0]" : "+v"(acc) : "v"(a), "v"(b), "v"(sa), "v"(sb));
}
__device__ __forceinline__ i32x8 cat8(bf16x8 lo, bf16x8 hi) { const i32x4 a = __builtin_bit_cast(i32x4, lo), b = __builtin_bit_cast(i32x4, hi); return __builtin_shufflevector(a, b, 0, 1, 2, 3, 4, 5, 6, 7); }

struct EpiBf16Plain {
    static constexpr bool PERM = true, AFTER_DRAIN = false;
    bf16_t* O; int ldc;
    __device__ __forceinline__ void operator()(const f32x4 (&acc)[2][2][4][2], const Unit& u, int wr, int wc, int fr, int fq) const {
        const int row0 = u.pm * BM + wr * 64 + fr, col0 = u.pn * BM + wc * 32 + 8 * fq;
#pragma unroll
        for (int ai = 0; ai < 2; ++ai)
#pragma unroll
            for (int m = 0; m < 4; ++m) { bf16_t* rowp = O + (size_t)(row0 + ai * HALF + m * 16) * ldc + col0;
#pragma unroll
                for (int bj = 0; bj < 2; ++bj) { const f32x4 v0 = acc[ai][bj][m][0], v1 = acc[ai][bj][m][1];
                    u32x4 w; w.x = cvt_pk_bf16(v0[0], v0[1]); w.y = cvt_pk_bf16(v0[2], v0[3]); w.z = cvt_pk_bf16(v1[0], v1[1]); w.w = cvt_pk_bf16(v1[2], v1[3]);
                    *(u32x4*)(rowp + bj * HALF) = w; } }
    }
};

struct EpiResid {
    static constexpr bool PERM = false, AFTER_DRAIN = false;
    float* S1; const float* x; const float* stats; const float* g; const float* bta; float alpha;
    __device__ __forceinline__ void operator()(const f32x4 (&acc)[2][2][4][2], const Unit& u, int wr, int wc, int fr, int fq) const {
        const int row0 = u.pm * BM + wr * 64 + fr, col0 = u.pn * BM + wc * 32 + 4 * fq;
#pragma unroll
        for (int bj = 0; bj < 2; ++bj)
#pragma unroll
            for (int n = 0; n < 2; ++n) { const int c = col0 + bj * HALF + n * 16;
                const f32x4 gv = *(const f32x4*)(g + c) * alpha, bv = *(const f32x4*)(bta + c) * alpha;
#pragma unroll
                for (int ai = 0; ai < 2; ++ai)
#pragma unroll
                    for (int m = 0; m < 4; ++m) { const int r = row0 + ai * HALF + m * 16;
                        const float mean = stats[2 * r], rstd = stats[2 * r + 1];
                        const f32x4 xv = *(const f32x4*)(x + (size_t)r * 1024 + c);
                        *(f32x4*)(S1 + (size_t)r * 1024 + c) = ((xv - mean) * rstd) * gv + bv + acc[ai][bj][m][n]; } }
    }
};

__device__ __forceinline__ float swiglu1(float glu, float lin) {
    const float xg = fminf(glu, 7.0f), xl = fminf(fmaxf(lin, -7.0f), 7.0f);
    const float sg = __builtin_amdgcn_rcpf(1.0f + __expf(-1.702f * xg));
    return xg * sg * (xl + 1.0f);
}
struct EpiSwiglu {
    static constexpr bool PERM = true, AFTER_DRAIN = false;
    bf16_t* ACT; const float* bup;
    __device__ __forceinline__ void operator()(const f32x4 (&acc)[2][2][4][2], const Unit& u, int wr, int wc, int fr, int fq) const {
        const int e = u.pn >> 3, pn = u.pn & 7;
        const int row0 = u.pm * BM + wr * 64 + fr, ucol0 = pn * BM + wc * 32 + 8 * fq, acol0 = ucol0 >> 1;
        f32x4 bv[2][2];
#pragma unroll
        for (int bj = 0; bj < 2; ++bj)
#pragma unroll
            for (int n = 0; n < 2; ++n) bv[bj][n] = *(const f32x4*)(bup + (size_t)e * 2048 + ucol0 + bj * HALF + 4 * n);
#pragma unroll
        for (int ai = 0; ai < 2; ++ai)
#pragma unroll
            for (int m = 0; m < 4; ++m) { bf16_t* rowp = ACT + (size_t)(row0 + ai * HALF + m * 16) * 1024 + acol0;
#pragma unroll
                for (int bj = 0; bj < 2; ++bj) { const f32x4 v0 = acc[ai][bj][m][0] + bv[bj][0], v1 = acc[ai][bj][m][1] + bv[bj][1];
                    u32x2 w; w.x = cvt_pk_bf16(swiglu1(v0[0], v0[1]), swiglu1(v0[2], v0[3])); w.y = cvt_pk_bf16(swiglu1(v1[0], v1[1]), swiglu1(v1[2], v1[3]));
                    *(u32x2*)(rowp + bj * (HALF / 2)) = w; } }
    }
};
struct EpiSwiglu8 {
    static constexpr bool PERM = true, AFTER_DRAIN = false;
    unsigned char* ACT; const float* bup;
    __device__ __forceinline__ void operator()(const f32x4 (&acc)[2][2][4][2], const Unit& u, int wr, int wc, int fr, int fq) const {
        const int e = u.pn >> 3, pn = u.pn & 7;
        const int row0 = u.pm * BM + wr * 64 + fr, ucol0 = pn * BM + wc * 32 + 8 * fq, acol0 = ucol0 >> 1;
        f32x4 bv[2][2];
#pragma unroll
        for (int bj = 0; bj < 2; ++bj)
#pragma unroll
            for (int n = 0; n < 2; ++n) bv[bj][n] = *(const f32x4*)(bup + (size_t)e * 2048 + ucol0 + bj * HALF + 4 * n);
#pragma unroll
        for (int ai = 0; ai < 2; ++ai)
#pragma unroll
            for (int m = 0; m < 4; ++m) { unsigned char* rowp = ACT + (size_t)(row0 + ai * HALF + m * 16) * 1024 + acol0;
#pragma unroll
                for (int bj = 0; bj < 2; ++bj) { const f32x4 v0 = acc[ai][bj][m][0] + bv[bj][0], v1 = acc[ai][bj][m][1] + bv[bj][1];
                    int w = __builtin_amdgcn_cvt_pk_fp8_f32(swiglu1(v0[0], v0[1]), swiglu1(v0[2], v0[3]), 0, false);
                    w = __builtin_amdgcn_cvt_pk_fp8_f32(swiglu1(v1[0], v1[1]), swiglu1(v1[2], v1[3]), w, true);
                    *(int*)(rowp + bj * (HALF / 2)) = w; } }
    }
};
struct EpiDown {
    static constexpr bool PERM = true, AFTER_DRAIN = false;
    bf16_t* YS; const float* bdn;
    __device__ __forceinline__ void operator()(const f32x4 (&acc)[2][2][4][2], const Unit& u, int wr, int wc, int fr, int fq) const {
        const int e = u.pn >> 2, pn = u.pn & 3;
        const int row0 = u.pm * BM + wr * 64 + fr, col0 = pn * BM + wc * 32 + 8 * fq;
        f32x4 bv[2][2];
#pragma unroll
        for (int bj = 0; bj < 2; ++bj)
#pragma unroll
            for (int n = 0; n < 2; ++n) bv[bj][n] = *(const f32x4*)(bdn + (size_t)e * 1024 + col0 + bj * HALF + 4 * n);
#pragma unroll
        for (int ai = 0; ai < 2; ++ai)
#pragma unroll
            for (int m = 0; m < 4; ++m) { bf16_t* rowp = YS + (size_t)(row0 + ai * HALF + m * 16) * 1024 + col0;
#pragma unroll
                for (int bj = 0; bj < 2; ++bj) { const f32x4 v0 = acc[ai][bj][m][0] + bv[bj][0], v1 = acc[ai][bj][m][1] + bv[bj][1];
                    u32x4 w; w.x = cvt_pk_bf16(v0[0], v0[1]); w.y = cvt_pk_bf16(v0[2], v0[3]); w.z = cvt_pk_bf16(v1[0], v1[1]); w.w = cvt_pk_bf16(v1[2], v1[3]);
                    *(u32x4*)(rowp + bj * HALF) = w; } }
    }
};
struct TableOrder {
    const PG8_LAS int* tab; int n;
    __device__ __forceinline__ bool next(int i, Unit& u) const {
        if (i >= n) return false;
        u.pm = __builtin_amdgcn_readfirstlane(tab[2 * i]); u.pn = __builtin_amdgcn_readfirstlane(tab[2 * i + 1]); return true;
    }
    __device__ __forceinline__ void a_ready(const Unit&) const {}
    __device__ __forceinline__ void done(const Unit&) const {}
};

template <class Epi, class Sched, bool ALIGN_EPI = false, bool SP2 = false, int SCW = 0>
__device__ __forceinline__ void gemm_phase(PG8_LAS unsigned char* lds, const Gemm g, const Sched& S, const Epi& E, const int tid) {
    const int wid = __builtin_amdgcn_readfirstlane(tid >> 6), lane = tid & 63, wr = wid >> 2, wc = wid & 3, fr = lane & 15, fq = lane >> 4;
    int K_ = g.K; asm volatile("" : "+s"(K_));
    const int K = K_, nt = K / BK;
    unsigned voffA[2], voffB[2];
#pragma unroll
    for (int i = 0; i < 2; ++i) { int R, C; stage_rc(tid * 16 + i * 8192, R, C); const int Rb = Epi::PERM ? ((R & ~31) + perm32(R & 31)) : R;
        voffA[i] = (unsigned)(R * K + C) * 2u; voffB[i] = (unsigned)(Rb * K + C) * 2u; }
    const size_t kstep = (size_t)(BK * 2);
    const size_t hstep = (size_t)HALF * K * 2;
    const size_t tstep = 2 * hstep;
    const unsigned ldsw = (unsigned)wid * 1024u;
    const int aoff = lds_byte(wr * 64 + fr, fq * 8), boff = lds_byte(wc * 32 + fr, fq * 8);
#define PG8_SA(b, h) (((b) * 2 + (h)) * HTB)
#define PG8_SB(b, h) ((4 + (b) * 2 + (h)) * HTB)
#define PG8_STAGE(bufoff, gbase, voff) do { _Pragma("unroll") for (int _i = 0; _i < 2; ++_i) \
        __builtin_amdgcn_global_load_lds((const unsigned*)((const char*)(gbase) + (voff)[_i]), (PG8_LAS unsigned*)(lds + (bufoff) + ldsw + _i * 8192), 16, 0, 0); } while (0)
#define PG8_LDA(dst, b, h) do { _Pragma("unroll") for (int m = 0; m < 4; ++m) _Pragma("unroll") for (int k = 0; k < 2; ++k) dst[m][k] = *(const PG8_LAS bf16x8*)(lds + PG8_SA(b, h) + aoff + m * 2048 + k * 1024); } while (0)
#define PG8_LDB(dst, b, h) do { _Pragma("unroll") for (int n = 0; n < 2; ++n) _Pragma("unroll") for (int k = 0; k < 2; ++k) dst[n][k] = *(const PG8_LAS bf16x8*)(lds + PG8_SB(b, h) + boff + n * 2048 + k * 1024); } while (0)
#define PG8_MMA(ai, bj, At, Bt) do { __builtin_amdgcn_s_setprio(1); _Pragma("unroll") for (int m = 0; m < 4; ++m) _Pragma("unroll") for (int n = 0; n < 2; ++n) { \
        if constexpr (SCW != 0) mfma_f8(acc[ai][bj][m][n], cat8(Bt[n][0], Bt[n][1]), cat8(At[m][0], At[m][1]), SCW * 0x01010101, 0x7f7f7f7f); \
        else { _Pragma("unroll") for (int k = 0; k < 2; ++k) acc[ai][bj][m][n] = __builtin_amdgcn_mfma_f32_16x16x32_bf16(Bt[n][k], At[m][k], acc[ai][bj][m][n], 0, 0, 0); } } __builtin_amdgcn_s_setprio(0); } while (0)
#define PG8_WAIT_V(n) asm volatile("s_waitcnt vmcnt(" #n ")" ::: "memory")
#define PG8_WAIT_L(n) asm volatile("s_waitcnt lgkmcnt(" #n ")" ::: "memory")
#define PG8_BAR __builtin_amdgcn_s_barrier()
#define PG8_SCHED __builtin_amdgcn_sched_barrier(0)
    Unit cur, nxt; int ui = 0;
    if (!S.next(0, cur)) return;
    f32x4 acc[2][2][4][2];
#pragma unroll
    for (int a = 0; a < 2; ++a)
#pragma unroll
        for (int b = 0; b < 2; ++b)
#pragma unroll
            for (int m = 0; m < 4; ++m)
#pragma unroll
                for (int n = 0; n < 2; ++n) acc[a][b][m][n] = (f32x4){0.f, 0.f, 0.f, 0.f};
    bf16x8 At[4][2], B0[2][2], B1[2][2];
    const char* cA = (const char*)g.A + (size_t)cur.pm * tstep; const char* cB = (const char*)g.Bt + (size_t)cur.pn * tstep;
    S.a_ready(cur);
    if constexpr (SP2) {
        PG8_STAGE(PG8_SB(0, 0), cB, voffB); PG8_STAGE(PG8_SB(0, 1), cB + hstep, voffB); PG8_STAGE(PG8_SA(0, 0), cA, voffA); PG8_STAGE(PG8_SA(0, 1), cA + hstep, voffA);
        if (wr == 1) PG8_BAR;
        PG8_WAIT_V(2); PG8_BAR;
        PG8_STAGE(PG8_SB(1, 0), cB + kstep, voffB); PG8_STAGE(PG8_SA(1, 0), cA + kstep, voffA); PG8_STAGE(PG8_SB(1, 1), cB + hstep + kstep, voffB);
        PG8_WAIT_V(6); PG8_BAR;
    } else {
        PG8_STAGE(PG8_SB(0, 0), cB, voffB); PG8_STAGE(PG8_SA(0, 0), cA, voffA); PG8_STAGE(PG8_SB(0, 1), cB + hstep, voffB); PG8_STAGE(PG8_SA(0, 1), cA + hstep, voffA);
        if (wr == 1) PG8_BAR;
        PG8_WAIT_V(4); PG8_BAR;
        PG8_STAGE(PG8_SB(1, 0), cB + kstep, voffB); PG8_STAGE(PG8_SA(1, 0), cA + kstep, voffA); PG8_STAGE(PG8_SB(1, 1), cB + hstep + kstep, voffB);
        PG8_WAIT_V(6); PG8_BAR;
    }
    for (;;) {
        const bool has_next = S.next(ui + 1, nxt);
        const char* nA = has_next ? (const char*)g.A + (size_t)nxt.pm * tstep : cA; const char* nB = has_next ? (const char*)g.Bt + (size_t)nxt.pn * tstep : cB;
        for (int t = 0; t < nt; t += 2) {
            const bool last = (t == nt - 2);
            const char* a1 = cA + (size_t)(t + 1) * kstep;
            const char* a2 = last ? nA : cA + (size_t)(t + 2) * kstep; const char* b2 = last ? nB : cB + (size_t)(t + 2) * kstep;
            const char* a3 = a2 + kstep; const char* b3 = b2 + kstep;
            if (last && has_next) S.a_ready(nxt);
            if constexpr (SP2) {
            PG8_LDB(B0, 0, 0); PG8_LDB(B1, 0, 1); PG8_SCHED; PG8_LDA(At, 0, 0); PG8_STAGE(PG8_SA(1, 1), a1 + hstep, voffA);
            PG8_WAIT_V(8); PG8_WAIT_L(0); PG8_BAR; PG8_MMA(0, 0, At, B0); PG8_MMA(0, 1, At, B1); PG8_BAR; PG8_SCHED;
            PG8_LDA(At, 0, 1); PG8_STAGE(PG8_SB(0, 0), b2, voffB); PG8_STAGE(PG8_SB(0, 1), b2 + hstep, voffB); PG8_STAGE(PG8_SA(0, 0), a2, voffA);
            PG8_WAIT_V(8); PG8_WAIT_L(0); PG8_BAR; PG8_MMA(1, 0, At, B0); PG8_MMA(1, 1, At, B1); PG8_BAR; PG8_SCHED;
            PG8_LDB(B0, 1, 0); PG8_LDB(B1, 1, 1); PG8_SCHED; PG8_LDA(At, 1, 0); PG8_STAGE(PG8_SA(0, 1), a2 + hstep, voffA);
            PG8_WAIT_V(8); PG8_WAIT_L(0); PG8_BAR; PG8_MMA(0, 0, At, B0); PG8_MMA(0, 1, At, B1); PG8_BAR; PG8_SCHED;
            PG8_LDA(At, 1, 1); PG8_STAGE(PG8_SB(1, 0), b3, voffB); PG8_STAGE(PG8_SB(1, 1), b3 + hstep, voffB); PG8_STAGE(PG8_SA(1, 0), a3, voffA);
            PG8_WAIT_V(8); PG8_WAIT_L(0); PG8_BAR; PG8_MMA(1, 0, At, B0); PG8_MMA(1, 1, At, B1); PG8_BAR; PG8_SCHED;
            } else {
            PG8_LDB(B0, 0, 0); PG8_SCHED; PG8_LDA(At, 0, 0); PG8_STAGE(PG8_SA(1, 1), a1 + hstep, voffA);
            PG8_WAIT_L(8); PG8_BAR; PG8_WAIT_L(0); PG8_MMA(0, 0, At, B0); PG8_BAR; PG8_SCHED;
            PG8_LDB(B1, 0, 1); PG8_STAGE(PG8_SB(0, 0), b2, voffB);
            PG8_BAR; PG8_WAIT_L(0); PG8_MMA(0, 1, At, B1); PG8_BAR;
            PG8_LDA(At, 0, 1); PG8_STAGE(PG8_SA(0, 0), a2, voffA);
            PG8_BAR; PG8_WAIT_L(0); PG8_MMA(1, 0, At, B0); PG8_BAR; PG8_SCHED;
            PG8_STAGE(PG8_SB(0, 1), b2 + hstep, voffB);
            PG8_WAIT_V(6); PG8_BAR; PG8_MMA(1, 1, At, B1); PG8_BAR;
            PG8_LDB(B0, 1, 0); PG8_SCHED; PG8_LDA(At, 1, 0); PG8_STAGE(PG8_SA(0, 1), a2 + hstep, voffA);
            PG8_WAIT_L(8); PG8_BAR; PG8_WAIT_L(0); PG8_MMA(0, 0, At, B0); PG8_BAR; PG8_SCHED;
            PG8_LDB(B1, 1, 1); PG8_STAGE(PG8_SB(1, 0), b3, voffB);
            PG8_BAR; PG8_WAIT_L(0); PG8_MMA(0, 1, At, B1); PG8_BAR;
            PG8_LDA(At, 1, 1); PG8_STAGE(PG8_SA(1, 0), a3, voffA);
            PG8_BAR; PG8_WAIT_L(0); PG8_MMA(1, 0, At, B0); PG8_BAR; PG8_SCHED;
            PG8_STAGE(PG8_SB(1, 1), b3 + hstep, voffB);
            PG8_WAIT_V(6); PG8_BAR; PG8_MMA(1, 1, At, B1); PG8_BAR;
            }
        }
        if constexpr (SCW != 0) asm volatile("s_nop 15\n\ts_nop 15" ::: "memory");
        if constexpr (ALIGN_EPI) { if (wr == 0) PG8_BAR; }
        if constexpr (!Epi::AFTER_DRAIN) { E(acc, cur, wr, wc, fr, fq); S.done(cur); }
        if (!has_next) break;
#pragma unroll
        for (int a = 0; a < 2; ++a)
#pragma unroll
            for (int b = 0; b < 2; ++b)
#pragma unroll
                for (int m = 0; m < 4; ++m)
#pragma unroll
                    for (int n = 0; n < 2; ++n) acc[a][b][m][n] = (f32x4){0.f, 0.f, 0.f, 0.f};
        cur = nxt; cA = nA; cB = nB; ++ui;
        if constexpr (ALIGN_EPI) { if (wr == 1) PG8_BAR; }
    }
    PG8_WAIT_V(0);
    if constexpr (!ALIGN_EPI) { if (wr == 0) PG8_BAR; }
    PG8_BAR;
    if constexpr (Epi::AFTER_DRAIN) { E.fused(acc, cur, wr, wc, fr, fq, lds, wid, lane); S.done(cur); }
#undef PG8_SA
#undef PG8_SB
#undef PG8_STAGE
#undef PG8_LDA
#undef PG8_LDB
#undef PG8_MMA
#undef PG8_WAIT_V
#undef PG8_WAIT_L
#undef PG8_BAR
#undef PG8_SCHED
}
template <class Epi, class Sched, bool ALIGN_EPI = false, bool SP2 = false, int SCW = 0>
__device__ __forceinline__ void gemm_phase_g(PG8_LAS unsigned char* lds, const Gemm g, const Sched& S, const Epi& E, const int tid, const int* rowmap) {
    const int wid = __builtin_amdgcn_readfirstlane(tid >> 6), lane = tid & 63, wr = wid >> 2, wc = wid & 3, fr = lane & 15, fq = lane >> 4;
    int K_ = g.K; asm volatile("" : "+s"(K_));
    const int K = K_, nt = K / BK;
    unsigned voffB[2], cv0[2], cv1[2], nv0[2], nv1[2]; int RA[2], CA[2];
#pragma unroll
    for (int i = 0; i < 2; ++i) { int R, C; stage_rc(tid * 16 + i * 8192, R, C); const int Rb = Epi::PERM ? ((R & ~31) + perm32(R & 31)) : R;
        RA[i] = R; CA[i] = C; voffB[i] = (unsigned)(Rb * K + C) * 2u; }
    const size_t kstep = (size_t)(BK * 2);
    const size_t hstep = (size_t)HALF * K * 2;
    const size_t tstep = 2 * hstep;
    const unsigned ldsw = (unsigned)wid * 1024u;
    const int aoff = lds_byte(wr * 64 + fr, fq * 8), boff = lds_byte(wc * 32 + fr, fq * 8);
#define PG8_SA(b, h) (((b) * 2 + (h)) * HTB)
#define PG8_SB(b, h) ((4 + (b) * 2 + (h)) * HTB)
#define PG8_STAGE(bufoff, gbase, voff) do { _Pragma("unroll") for (int _i = 0; _i < 2; ++_i) \
        __builtin_amdgcn_global_load_lds((const unsigned*)((const char*)(gbase) + (voff)[_i]), (PG8_LAS unsigned*)(lds + (bufoff) + ldsw + _i * 8192), 16, 0, 0); } while (0)
#define PG8_LDA(dst, b, h) do { _Pragma("unroll") for (int m = 0; m < 4; ++m) _Pragma("unroll") for (int k = 0; k < 2; ++k) dst[m][k] = *(const PG8_LAS bf16x8*)(lds + PG8_SA(b, h) + aoff + m * 2048 + k * 1024); } while (0)
#define PG8_LDB(dst, b, h) do { _Pragma("unroll") for (int n = 0; n < 2; ++n) _Pragma("unroll") for (int k = 0; k < 2; ++k) dst[n][k] = *(const PG8_LAS bf16x8*)(lds + PG8_SB(b, h) + boff + n * 2048 + k * 1024); } while (0)
#define PG8_MMA(ai, bj, At, Bt) do { __builtin_amdgcn_s_setprio(1); _Pragma("unroll") for (int m = 0; m < 4; ++m) _Pragma("unroll") for (int n = 0; n < 2; ++n) { \
        if constexpr (SCW != 0) mfma_f8(acc[ai][bj][m][n], cat8(Bt[n][0], Bt[n][1]), cat8(At[m][0], At[m][1]), SCW * 0x01010101, 0x7f7f7f7f); \
        else { _Pragma("unroll") for (int k = 0; k < 2; ++k) acc[ai][bj][m][n] = __builtin_amdgcn_mfma_f32_16x16x32_bf16(Bt[n][k], At[m][k], acc[ai][bj][m][n], 0, 0, 0); } } __builtin_amdgcn_s_setprio(0); } while (0)
#define PG8_WAIT_V(n) asm volatile("s_waitcnt vmcnt(" #n ")" ::: "memory")
#define PG8_WAIT_L(n) asm volatile("s_waitcnt lgkmcnt(" #n ")" ::: "memory")
#define PG8_BAR __builtin_amdgcn_s_barrier()
#define PG8_SCHED __builtin_amdgcn_sched_barrier(0)
    static_assert(SP2, "gemm_phase_g: SP2 form only");
    Unit cur, nxt; int ui = 0;
    if (!S.next(0, cur)) return;
    f32x4 acc[2][2][4][2];
#pragma unroll
    for (int a = 0; a < 2; ++a)
#pragma unroll
        for (int b = 0; b < 2; ++b)
#pragma unroll
            for (int m = 0; m < 4; ++m)
#pragma unroll
                for (int n = 0; n < 2; ++n) acc[a][b][m][n] = (f32x4){0.f, 0.f, 0.f, 0.f};
    bf16x8 At[4][2], B0[2][2], B1[2][2];
    const char* gA = (const char*)g.A; const char* cB = (const char*)g.Bt + (size_t)cur.pn * tstep;
#define PG8_ROWS(pm_, v0_, v1_) do { _Pragma("unroll") for (int _i = 0; _i < 2; ++_i) { v0_[_i] = (unsigned)(rowmap[(pm_) * BM + RA[_i]] * K + CA[_i]) * 2u; v1_[_i] = (unsigned)(rowmap[(pm_) * BM + HALF + RA[_i]] * K + CA[_i]) * 2u; } } while (0)
    PG8_ROWS(cur.pm, cv0, cv1);
    const unsigned voffA[2] = {0u, 0u}; const char* cA = gA; (void)voffA; (void)cA;
    S.a_ready(cur);
    if constexpr (SP2) {
        PG8_STAGE(PG8_SB(0, 0), cB, voffB); PG8_STAGE(PG8_SB(0, 1), cB + hstep, voffB); PG8_STAGE(PG8_SA(0, 0), gA, cv0); PG8_STAGE(PG8_SA(0, 1), gA, cv1);
        if (wr == 1) PG8_BAR;
        PG8_WAIT_V(2); PG8_BAR;
        PG8_STAGE(PG8_SB(1, 0), cB + kstep, voffB); PG8_STAGE(PG8_SA(1, 0), gA + kstep, cv0); PG8_STAGE(PG8_SB(1, 1), cB + hstep + kstep, voffB);
        PG8_WAIT_V(6); PG8_BAR;
    } else {
        PG8_STAGE(PG8_SB(0, 0), cB, voffB); PG8_STAGE(PG8_SA(0, 0), cA, voffA); PG8_STAGE(PG8_SB(0, 1), cB + hstep, voffB); PG8_STAGE(PG8_SA(0, 1), cA + hstep, voffA);
        if (wr == 1) PG8_BAR;
        PG8_WAIT_V(4); PG8_BAR;
        PG8_STAGE(PG8_SB(1, 0), cB + kstep, voffB); PG8_STAGE(PG8_SA(1, 0), cA + kstep, voffA); PG8_STAGE(PG8_SB(1, 1), cB + hstep + kstep, voffB);
        PG8_WAIT_V(6); PG8_BAR;
    }
    for (;;) {
        const bool has_next = S.next(ui + 1, nxt);
        const char* nB = has_next ? (const char*)g.Bt + (size_t)nxt.pn * tstep : cB;
        if (has_next) PG8_ROWS(nxt.pm, nv0, nv1); else { nv0[0] = cv0[0]; nv0[1] = cv0[1]; nv1[0] = cv1[0]; nv1[1] = cv1[1]; }
        for (int t = 0; t < nt; t += 2) {
            const bool last = (t == nt - 2);
            const char* a1 = gA + (size_t)(t + 1) * kstep;
            const char* a2 = last ? gA : gA + (size_t)(t + 2) * kstep; const char* b2 = last ? nB : cB + (size_t)(t + 2) * kstep;
            unsigned w0[2], w1[2]; w0[0] = last ? nv0[0] : cv0[0]; w0[1] = last ? nv0[1] : cv0[1]; w1[0] = last ? nv1[0] : cv1[0]; w1[1] = last ? nv1[1] : cv1[1];
            const char* a3 = a2 + kstep; const char* b3 = b2 + kstep;
            if (last && has_next) S.a_ready(nxt);
            if constexpr (SP2) {
            PG8_LDB(B0, 0, 0); PG8_LDB(B1, 0, 1); PG8_SCHED; PG8_LDA(At, 0, 0); PG8_STAGE(PG8_SA(1, 1), a1, cv1);
            PG8_WAIT_V(8); PG8_WAIT_L(0); PG8_BAR; PG8_MMA(0, 0, At, B0); PG8_MMA(0, 1, At, B1); PG8_BAR; PG8_SCHED;
            PG8_LDA(At, 0, 1); PG8_STAGE(PG8_SB(0, 0), b2, voffB); PG8_STAGE(PG8_SB(0, 1), b2 + hstep, voffB); PG8_STAGE(PG8_SA(0, 0), a2, w0);
            PG8_WAIT_V(8); PG8_WAIT_L(0); PG8_BAR; PG8_MMA(1, 0, At, B0); PG8_MMA(1, 1, At, B1); PG8_BAR; PG8_SCHED;
            PG8_LDB(B0, 1, 0); PG8_LDB(B1, 1, 1); PG8_SCHED; PG8_LDA(At, 1, 0); PG8_STAGE(PG8_SA(0, 1), a2, w1);
            PG8_WAIT_V(8); PG8_WAIT_L(0); PG8_BAR; PG8_MMA(0, 0, At, B0); PG8_MMA(0, 1, At, B1); PG8_BAR; PG8_SCHED;
            PG8_LDA(At, 1, 1); PG8_STAGE(PG8_SB(1, 0), b3, voffB); PG8_STAGE(PG8_SB(1, 1), b3 + hstep, voffB); PG8_STAGE(PG8_SA(1, 0), a3, w0);
            PG8_WAIT_V(8); PG8_WAIT_L(0); PG8_BAR; PG8_MMA(1, 0, At, B0); PG8_MMA(1, 1, At, B1); PG8_BAR; PG8_SCHED;
            } else {
            PG8_LDB(B0, 0, 0); PG8_SCHED; PG8_LDA(At, 0, 0); PG8_STAGE(PG8_SA(1, 1), a1, cv1);
            PG8_WAIT_L(8); PG8_BAR; PG8_WAIT_L(0); PG8_MMA(0, 0, At, B0); PG8_BAR; PG8_SCHED;
            PG8_LDB(B1, 0, 1); PG8_STAGE(PG8_SB(0, 0), b2, voffB);
            PG8_BAR; PG8_WAIT_L(0); PG8_MMA(0, 1, At, B1); PG8_BAR;
            PG8_LDA(At, 0, 1); PG8_STAGE(PG8_SA(0, 0), a2, voffA);
            PG8_BAR; PG8_WAIT_L(0); PG8_MMA(1, 0, At, B0); PG8_BAR; PG8_SCHED;
            PG8_STAGE(PG8_SB(0, 1), b2 + hstep, voffB);
            PG8_WAIT_V(6); PG8_BAR; PG8_MMA(1, 1, At, B1); PG8_BAR;
            PG8_LDB(B0, 1, 0); PG8_SCHED; PG8_LDA(At, 1, 0); PG8_STAGE(PG8_SA(0, 1), a2, w1);
            PG8_WAIT_L(8); PG8_BAR; PG8_WAIT_L(0); PG8_MMA(0, 0, At, B0); PG8_BAR; PG8_SCHED;
            PG8_LDB(B1, 1, 1); PG8_STAGE(PG8_SB(1, 0), b3, voffB);
            PG8_BAR; PG8_WAIT_L(0); PG8_MMA(0, 1, At, B1); PG8_BAR;
            PG8_LDA(At, 1, 1); PG8_STAGE(PG8_SA(1, 0), a3, voffA);
            PG8_BAR; PG8_WAIT_L(0); PG8_MMA(1, 0, At, B0); PG8_BAR; PG8_SCHED;
            PG8_STAGE(PG8_SB(1, 1), b3 + hstep, voffB);
            PG8_WAIT_V(6); PG8_BAR; PG8_MMA(1, 1, At, B1); PG8_BAR;
            }
        }
        if constexpr (SCW != 0) asm volatile("s_nop 15\n\ts_nop 15" ::: "memory");
        if constexpr (ALIGN_EPI) { if (wr == 0) PG8_BAR; }
        if constexpr (!Epi::AFTER_DRAIN) { E(acc, cur, wr, wc, fr, fq); S.done(cur); }
        if (!has_next) break;
#pragma unroll
        for (int a = 0; a < 2; ++a)
#pragma unroll
            for (int b = 0; b < 2; ++b)
#pragma unroll
                for (int m = 0; m < 4; ++m)
#pragma unroll
                    for (int n = 0; n < 2; ++n) acc[a][b][m][n] = (f32x4){0.f, 0.f, 0.f, 0.f};
        cur = nxt; cB = nB; ++ui; cv0[0] = nv0[0]; cv0[1] = nv0[1]; cv1[0] = nv1[0]; cv1[1] = nv1[1];
        if constexpr (ALIGN_EPI) { if (wr == 1) PG8_BAR; }
    }
    PG8_WAIT_V(0);
    if constexpr (!ALIGN_EPI) { if (wr == 0) PG8_BAR; }
    PG8_BAR;
    if constexpr (Epi::AFTER_DRAIN) { E.fused(acc, cur, wr, wc, fr, fq, lds, wid, lane); S.done(cur); }
#undef PG8_ROWS
#undef PG8_SA
#undef PG8_SB
#undef PG8_STAGE
#undef PG8_LDA
#undef PG8_LDB
#undef PG8_MMA
#undef PG8_WAIT_V
#undef PG8_WAIT_L
#undef PG8_BAR
#undef PG8_SCHED
}
}

#ifndef REP_MASK
#define REP_MASK 0
#endif
#define NREP(k) (1 + ((REP_MASK >> (k)) & 1))

constexpr int NB = 16, SEQ = 2048, D = 1024, NMETA = 16;
constexpr int MX = NB * SEQ;
constexpr int INW = 3344, PW = 3584;
constexpr int GQ = 0, GK = 256, GV = 512, GG = 1024, GKL = 1536;
constexpr int RW0 = 1552;
constexpr int RR = RW0, RK = RW0 + 512, RV = RW0 + 1024, RWL = RW0 + 1536, RAL = RW0 + 1600, RGL = RW0 + 1664;
constexpr int NE = 32, TOPK = 4;
constexpr int NCH = 33;
constexpr float ALPHA = 1.189207115002721f;
constexpr int NWAVES = 8, NTHR = 512;

constexpr size_t MiB = 1u << 20;
constexpr size_t WS_CTL = 0, CTL_ZERO_BYTES = 1 * MiB;
constexpr size_t WS_STATS = 1 * MiB;
constexpr size_t WS_TOPI  = WS_STATS + 256 * 1024;
constexpr size_t WS_GATE  = WS_TOPI + 512 * 1024;
constexpr size_t WS_RANK  = WS_GATE + 512 * 1024;
constexpr size_t WS_TSLOT = WS_RANK + 512 * 1024;
constexpr size_t WS_BON   = WS_TSLOT + 512 * 1024;
constexpr size_t WS_PROJM = WS_BON + 1 * MiB;
constexpr size_t WS_OPSM  = WS_PROJM + 256 * 1024;
constexpr size_t WS_DL    = WS_OPSM + 256 * 1024;
constexpr size_t WS_W2T   = WS_DL + 1 * MiB;
constexpr size_t WS_A2T   = WS_W2T + 64 * 1024;
constexpr size_t WS_G2T   = WS_A2T + 64 * 1024;
constexpr size_t WS_TILEE = WS_G2T + 128 * 1024;
constexpr size_t WS_SLOTTOK = WS_TILEE + 4096;
constexpr size_t WS_WIN   = 8 * MiB;
constexpr size_t WS_WOUT  = 15 * MiB;
static_assert(WS_SLOTTOK + 139264 * 4 <= WS_WIN, "table region");
constexpr size_t WS_A0    = 20 * MiB;
constexpr size_t WS_YMIX  = WS_A0;
constexpr size_t WS_PROJ  = 84 * MiB;
constexpr size_t WS_R1    = 308 * MiB;
constexpr size_t WS_GAM   = 520 * MiB;
constexpr size_t WS_SST   = 524 * MiB;
constexpr size_t WS_GUS   = 692 * MiB;
constexpr size_t WS_H1    = 20 * MiB;
constexpr size_t WS_XS    = 84 * MiB;
constexpr size_t WS_YS    = WS_XS;
constexpr size_t WS_ACT   = 356 * MiB;
constexpr size_t WS_MIXB  = 628 * MiB;
constexpr size_t WS_WUP   = 758 * MiB;
constexpr size_t WS_WDN   = 822 * MiB;
constexpr size_t WS_H1Q   = 854 * MiB;
constexpr size_t WS_END   = 886 * MiB;
constexpr int CW_BAR = 4096;
constexpr int CW_CNT = 16384;
constexpr int CW_QH = 20480;

constexpr int RING_BYTES = 131072;
constexpr int LDS_BYTES = 147456;
constexpr int TAB_OFF = 132096;
constexpr int MISC_OFF = LDS_BYTES - 512;

#define LAS __attribute__((address_space(3)))
typedef unsigned short bf16;
typedef unsigned v4u __attribute__((ext_vector_type(4)));
typedef unsigned v2u __attribute__((ext_vector_type(2)));
typedef float f32x4 __attribute__((ext_vector_type(4)));
typedef short bf16x8 __attribute__((ext_vector_type(8)));
#define LDS_WAIT() asm volatile("s_waitcnt lgkmcnt(0)" ::: "memory")
__device__ __forceinline__ float bflo(unsigned w) { return __uint_as_float(w << 16); }
__device__ __forceinline__ float bfhi(unsigned w) { return __uint_as_float(w & 0xffff0000u); }
typedef float f32x2_t __attribute__((ext_vector_type(2))); typedef __bf16 bf16x2_t __attribute__((ext_vector_type(2)));
__device__ __forceinline__ unsigned pk2(float lo, float hi) { const f32x2_t v = {lo, hi}; const bf16x2_t b = __builtin_convertvector(v, bf16x2_t); return __builtin_bit_cast(unsigned, b); }
__device__ __forceinline__ unsigned f2bf(float f) { return pk2(f, 0.f) & 0xffffu; }
#define CYC() ((unsigned)__builtin_amdgcn_s_getreg((19 << 11) | 29))
__device__ __forceinline__ void lds_barrier() { asm volatile("s_waitcnt lgkmcnt(0)" ::: "memory"); __builtin_amdgcn_s_barrier(); asm volatile("" ::: "memory"); }
__device__ __forceinline__ float shx(float v, int mask, int lane) { return __int_as_float(__builtin_amdgcn_ds_bpermute((lane ^ mask) << 2, __float_as_int(v))); }
template <int CTRL> __device__ __forceinline__ float dppf0(float x) { return __int_as_float(__builtin_amdgcn_update_dpp(0, __float_as_int(x), CTRL, 0xF, 0xF, true)); }
__device__ __forceinline__ float wave_sum(float v, int lane) {
    v += dppf0<0xB1>(v); v += dppf0<0x4E>(v); v += dppf0<0x141>(v); v += dppf0<0x140>(v);
    v += shx(v, 16, lane); v += shx(v, 32, lane);
    return v;
}
__device__ __forceinline__ float softplus_f(float x) { return fmaxf(x, 0.f) + log1pf(expf(-fabsf(x))); }
__device__ __forceinline__ float logsigmoid_f(float x) { return fminf(x, 0.f) - log1pf(expf(-fabsf(x))); }
__device__ __forceinline__ float sigmoid_f(float x) { return 1.f / (1.f + expf(-x)); }
__device__ __forceinline__ float fexp(float x) { return __builtin_amdgcn_exp2f(x * 1.4426950408889634f); }
__device__ __forceinline__ float flog(float x) { return __builtin_amdgcn_logf(x) * 0.6931471805599453f; }
__device__ __forceinline__ float fsigmoid(float x) { return __builtin_amdgcn_rcpf(1.f + fexp(-x)); }
__device__ __forceinline__ float ftanh(float x) { return 2.f * fsigmoid(2.f * x) - 1.f; }
__device__ __forceinline__ float fsoftplus(float x) { return fmaxf(x, 0.f) + flog(1.f + fexp(-fabsf(x))); }
__device__ __forceinline__ float flogsigmoid(float x) { return fminf(x, 0.f) - flog(1.f + fexp(-fabsf(x))); }
template <int CTRL> __device__ __forceinline__ float dppf(float x) { return __int_as_float(__builtin_amdgcn_update_dpp(0, __float_as_int(x), CTRL, 0xF, 0xF, true)); }
__device__ __forceinline__ float red8(float x) {
    x += dppf<0xB1>(x); x += dppf<0x4E>(x); x += dppf<0x141>(x); return x;
}
__device__ __forceinline__ f32x4 mfma16(bf16x8 a, bf16x8 b, f32x4 c) { return __builtin_amdgcn_mfma_f32_16x16x32_bf16(a, b, c, 0, 0, 0); }
__device__ __forceinline__ unsigned ld_agent(const unsigned* p) { return __hip_atomic_load(p, __ATOMIC_RELAXED, __HIP_MEMORY_SCOPE_AGENT); }

#define XB_TMO      128
#define XB_XCNT(j)  (256  + 64 * (j))
#define XB_XSUB(j)  (1280 + 64 * (j))
#define XB_XGEN(j)  (2304 + 64 * (j))
#define XB_TOP      3328
#define XB_TOPGEN   3392
#define XCD_BAR_WORDS 3456
#define XB_SPIN_CAP (1u << 18)
__device__ __forceinline__ unsigned xb_ld(unsigned* p)              { return __hip_atomic_load(p, __ATOMIC_RELAXED, __HIP_MEMORY_SCOPE_AGENT); }
__device__ __forceinline__ unsigned xb_add(unsigned* p, unsigned v) { return __hip_atomic_fetch_add(p, v, __ATOMIC_RELAXED, __HIP_MEMORY_SCOPE_AGENT); }
__device__ __forceinline__ unsigned xb_xcc_id() { return (unsigned)__builtin_amdgcn_s_getreg((3 << 11) | 20) & 0xFu; }
#define XB_SPIN(cond, bar) do { unsigned _sp = 0; while (cond) { __builtin_amdgcn_s_sleep(1); \
    if ((++_sp & 255u) == 0u) { if (xb_ld(&(bar)[XB_TMO])) break; if (_sp > XB_SPIN_CAP) { atomicAdd(&(bar)[XB_TMO], 1u); break; } } } } while (0)
struct XcdBarrier { unsigned* bar; unsigned x; volatile LAS unsigned* st; };
__device__ __forceinline__ XcdBarrier xcd_barrier_post(unsigned* bar, volatile LAS unsigned* st, bool leader) {
    XcdBarrier b; b.bar = bar; b.x = xb_xcc_id(); b.st = st;
    if (leader) (void)xb_add(&bar[XB_XCNT(b.x)], 1u);
    return b;
}
__device__ __forceinline__ void xcd_barrier_complete(unsigned* bar, unsigned x, unsigned& nloc, unsigned& nx) {
    const unsigned G = gridDim.x * gridDim.y * gridDim.z;
    unsigned sum, cnt, mine, sp = 0u;
    for (;;) {
        sum = 0u; cnt = 0u; mine = 0u;
#pragma unroll
        for (unsigned j = 0; j < 16; ++j) { const unsigned c = xb_ld(&bar[XB_XCNT(j)]); sum += c; cnt += (c > 0u) ? 1u : 0u; mine = (j == x) ? c : mine; }
        if (sum == G) break;
        __builtin_amdgcn_s_sleep(1);
        if ((++sp & 255u) == 0u) { if (xb_ld(&bar[XB_TMO])) break; if (sp > XB_SPIN_CAP) { atomicAdd(&bar[XB_TMO], 1u); break; } }
    }
    nloc = mine > 0u ? mine : 1u; nx = cnt > 0u ? cnt : 1u;
}
__device__ __forceinline__ void xcd_barrier(const XcdBarrier& b, bool leader) {
    asm volatile("s_waitcnt vmcnt(0)" ::: "memory");
    __syncthreads();
    if (leader) {
        unsigned* bar = b.bar;
        __builtin_amdgcn_s_waitcnt(0);
        unsigned nloc = b.st[0], nx = b.st[1];
        if (nloc == 0u) { xcd_barrier_complete(bar, b.x, nloc, nx); b.st[0] = nloc; b.st[1] = nx; }
        const unsigned old = xb_add(&bar[XB_XSUB(b.x)], 1u);
        const unsigned gen = old / nloc;
        if (old + 1u == (gen + 1u) * nloc) {
            __builtin_amdgcn_fence(__ATOMIC_RELEASE, "agent");
            asm volatile("s_waitcnt vmcnt(0)" ::: "memory");
            const unsigned og = xb_add(&bar[XB_TOP], 1u);
            const unsigned tg = og / nx;
            if (og + 1u == (tg + 1u) * nx) xb_add(&bar[XB_TOPGEN], 1u);
            else XB_SPIN(xb_ld(&bar[XB_TOPGEN]) == tg, bar);
            __builtin_amdgcn_fence(__ATOMIC_ACQUIRE, "agent");
            xb_add(&bar[XB_XGEN(b.x)], 1u);
            asm volatile("s_waitcnt vmcnt(0)" ::: "memory");
        } else {
            XB_SPIN(xb_ld(&bar[XB_XGEN(b.x)]) == gen, bar);
            __builtin_amdgcn_fence(__ATOMIC_ACQUIRE, "agent");
            asm volatile("s_waitcnt vmcnt(0)" ::: "memory");
        }
    }
    __syncthreads();
}

struct Args { const float* in[30]; float* out; unsigned char* ws; };
enum { I_X = 0, I_META, I_LNIN_G, I_LNIN_B, I_WIN, I_GKW2, I_GKB, I_GNORM, I_MU, I_W0, I_W2, I_A0, I_A2, I_G2, I_KK, I_KA, I_RK, I_RLNG, I_RLNB, I_WOUT,
       I_LN1G, I_LN1B, I_RTW, I_RTB, I_WUP, I_BUP, I_WDN, I_BDN, I_LN2G, I_LN2B };
struct Frame { LAS unsigned char* lds; int tid, lane, wave, blk, G; };
__device__ __forceinline__ int lane_id() { int l; asm volatile("v_mbcnt_lo_u32_b32 %0, -1, 0\n\tv_mbcnt_hi_u32_b32 %0, -1, %0" : "=v"(l)); return l; }
__device__ __forceinline__ Frame mkframe(LAS unsigned char* lds, int wave) { Frame F; F.lds = lds; F.wave = wave; F.lane = lane_id(); F.tid = wave * 64 + F.lane; F.blk = blockIdx.x; F.G = gridDim.x; return F; }

__device__ __forceinline__ void transpose_item(const float* W, int K, int N, int nblk, bf16* WT, LAS float* scr, int item, int lane) {
    const int kb = item / nblk, nb = item - kb * nblk, k0 = 64 * kb, n0 = 32 * nb;
    const int nn = n0 + (lane & 31); const bool ok = nn < N;
#pragma unroll 8
    for (int i = 0; i < 32; ++i) { const int kk = 2 * i + (lane >> 5); scr[kk * 33 + (lane & 31)] = ok ? W[(size_t)(k0 + kk) * N + nn] : 0.f; }
    LDS_WAIT();
    const int c = lane & 7;
#pragma unroll
    for (int j = 0; j < 4; ++j) { const int n = (lane >> 3) + 8 * j; const LAS float* s = scr + (8 * c) * 33 + n;
        v4u o; o.x = pk2(s[0 * 33], s[1 * 33]); o.y = pk2(s[2 * 33], s[3 * 33]); o.z = pk2(s[4 * 33], s[5 * 33]); o.w = pk2(s[6 * 33], s[7 * 33]);
        *(v4u*)(WT + (size_t)(n0 + n) * K + k0 + 8 * c) = o; }
    LDS_WAIT();
}

__device__ __forceinline__ void transpose_item64_f8(const float* W, int K, int N, unsigned char* WT, float scale, LAS float* scr, int item, int lane) {
    const int nblk = N >> 6, kb = item / nblk, nb = item - kb * nblk, k0 = 64 * kb, n0 = 64 * nb;
    const int r4 = lane >> 4, c4 = lane & 15;
    f32x4 v[16];
#pragma unroll
    for (int i = 0; i < 16; ++i) v[i] = *(const f32x4*)(W + (size_t)(k0 + 4 * i + r4) * N + n0 + 4 * c4);
#pragma unroll
    for (int i = 0; i < 16; ++i) *(LAS f32x4*)(scr + (4 * i + r4) * 68 + 4 * c4) = v[i];
    LDS_WAIT();
    unsigned char* orow = WT + (size_t)(n0 + lane) * K + k0;
#pragma unroll
    for (int g = 0; g < 4; ++g) { const LAS float* s = scr + (16 * g) * 68 + lane; v4u o;
#pragma unroll
        for (int q = 0; q < 4; ++q) { int w = __builtin_amdgcn_cvt_pk_fp8_f32(s[(4 * q + 0) * 68] * scale, s[(4 * q + 1) * 68] * scale, 0, false);
            w = __builtin_amdgcn_cvt_pk_fp8_f32(s[(4 * q + 2) * 68] * scale, s[(4 * q + 3) * 68] * scale, w, true); o[q] = (unsigned)w; }
        *(v4u*)(orow + 16 * g) = o; }
    LDS_WAIT();
}
__device__ __forceinline__ void convert_expert_weights(const Args& a, const Frame& F, int qsel) {
    unsigned char* ws = a.ws;
    LAS float* scr = (LAS float*)(F.lds + F.wave * 17408);
    unsigned* QH = (unsigned*)(ws + WS_CTL) + CW_QH + 64 * qsel;
    constexpr int I_UP = 16 * 32, I_DN = 16 * 16, NIT = NE * (I_UP + I_DN);
    for (;;) {
        unsigned base = 0;
        if (F.lane == 0) base = __hip_atomic_fetch_add(QH, 8u, __ATOMIC_RELAXED, __HIP_MEMORY_SCOPE_AGENT);
        base = (unsigned)__builtin_amdgcn_readfirstlane((int)base);
        if (base >= (unsigned)NIT) break;
        for (int it = (int)base; it < (int)base + 8; ++it) {
            if (it < NE * I_UP) { const int e = it / I_UP, r = it - e * I_UP;
                transpose_item64_f8(a.in[I_WUP] + (size_t)e * D * 2048, D, 2048, ws + WS_WUP + (size_t)e * 2048 * D, 64.f, scr, r, F.lane); }
            else { const int it2 = it - NE * I_UP, e = it2 / I_DN, r = it2 - e * I_DN;
                transpose_item64_f8(a.in[I_WDN] + (size_t)e * D * D, D, D, ws + WS_WDN + (size_t)e * D * D, 128.f, scr, r, F.lane); }
        }
    }
}

__device__ __forceinline__ void phase0(const Args& a, const Frame& F) {
    unsigned char* ws = a.ws;
    const int gw = F.blk * NWAVES + F.wave, NGW = F.G * NWAVES;
    for (int cgp = F.blk; cgp < 53; cgp += F.G) {
        LAS float* HM = (LAS float*)F.lds;
        LAS float* PART = (LAS float*)(F.lds + 65536);
        for (int rr = 0; rr < 2; ++rr) {
            const int row = 2 * F.wave + rr; const f32x4* xr = (const f32x4*)(a.in[I_META] + row * D) + F.lane;
            f32x4 v[4]; float s = 0.f;
#pragma unroll
            for (int j = 0; j < 4; ++j) { v[j] = xr[64 * j]; s += (v[j].x + v[j].y) + (v[j].z + v[j].w); }
            const float mean = wave_sum(s, F.lane) * (1.f / D); float s2 = 0.f;
#pragma unroll
            for (int j = 0; j < 4; ++j) { v[j] = v[j] - mean; s2 += (v[j].x * v[j].x + v[j].y * v[j].y) + (v[j].z * v[j].z + v[j].w * v[j].w); }
            const float rstd = 1.f / sqrtf(wave_sum(s2, F.lane) * (1.f / D) + 1e-5f);
#pragma unroll
            for (int j = 0; j < 4; ++j) { const int col = 4 * (F.lane + 64 * j);
                const f32x4 gv = *(const f32x4*)(a.in[I_LNIN_G] + col), bv = *(const f32x4*)(a.in[I_LNIN_B] + col);
                const f32x4 y = v[j] * rstd * gv + bv;
                HM[(col + 0) * 16 + row] = y.x; HM[(col + 1) * 16 + row] = y.y; HM[(col + 2) * 16 + row] = y.z; HM[(col + 3) * 16 + row] = y.w; }
        }
        __syncthreads();
        const int col = cgp * 64 + F.lane; const bool ok = col < INW;
        float acc[16];
#pragma unroll
        for (int r = 0; r < 16; ++r) acc[r] = 0.f;
        const float* wp = a.in[I_WIN];
        for (int k = F.wave * 128; k < F.wave * 128 + 128; ++k) {
            const float wv = ok ? wp[(size_t)k * INW + col] : 0.f;
            const LAS f32x4* h = (const LAS f32x4*)(HM + k * 16);
#pragma unroll
            for (int q = 0; q < 4; ++q) { const f32x4 hv = h[q]; acc[4 * q + 0] += hv.x * wv; acc[4 * q + 1] += hv.y * wv; acc[4 * q + 2] += hv.z * wv; acc[4 * q + 3] += hv.w * wv; }
        }
#pragma unroll
        for (int r = 0; r < 16; ++r) PART[(F.wave * 16 + r) * 64 + F.lane] = acc[r];
        __syncthreads();
        bf16* PROJM = (bf16*)(ws + WS_PROJM);
        for (int o = F.tid; o < 1024; o += NTHR) { const int r = o >> 6, l = o & 63; float s = 0.f;
#pragma unroll
            for (int w = 0; w < 8; ++w) s += PART[(w * 16 + r) * 64 + l];
            PROJM[r * PW + cgp * 64 + l] = (bf16)f2bf(s); }
        if (F.tid < 64) PROJM[NMETA * PW + cgp * 64 + F.tid] = 0;
        __syncthreads();
    }
    {
        LAS float* scr = (LAS float*)(F.lds + F.wave * 16384);
        constexpr int I_IN = 16 * (PW / 32), I_OUT = 16 * 32;
        for (int it = gw; it < I_IN + I_OUT; it += NGW) {
            if (it < I_IN) transpose_item(a.in[I_WIN], D, INW, PW / 32, (bf16*)(ws + WS_WIN), scr, it, F.lane);
            else transpose_item(a.in[I_WOUT], D, D, 32, (bf16*)(ws + WS_WOUT), scr, it - I_IN, F.lane);
        }
    }
    {
        bf16* W2T = (bf16*)(ws + WS_W2T); bf16* A2T = (bf16*)(ws + WS_A2T); bf16* G2T = (bf16*)(ws + WS_G2T);
        for (int i = F.blk * NTHR + F.tid; i < 131072; i += F.G * NTHR) {
            if (i < 32768) { const int n = i >> 6, k = i & 63; W2T[i] = (bf16)f2bf(a.in[I_W2][k * 512 + n]); }
            else if (i < 65536) { const int j = i - 32768, n = j >> 6, k = j & 63; A2T[j] = (bf16)f2bf(a.in[I_A2][k * 512 + n]); }
            else { const int j = i - 65536, n = j >> 7, k = j & 127; G2T[j] = (bf16)f2bf(a.in[I_G2][k * 512 + n]); }
        }
    }
    {
        bf16* A0 = (bf16*)(ws + WS_A0); float* ST = (float*)(ws + WS_STATS);
        for (int m0 = gw; m0 < MX; m0 += 2 * NGW) {
            f32x4 v[2][4];
#pragma unroll
            for (int r = 0; r < 2; ++r) { const f32x4* xr = (const f32x4*)(a.in[I_X] + (size_t)(m0 + r * NGW) * D) + F.lane;
#pragma unroll
                for (int j = 0; j < 4; ++j) v[r][j] = xr[64 * j]; }
#pragma unroll
            for (int r = 0; r < 2; ++r) { const int m = m0 + r * NGW; float s = 0.f;
#pragma unroll
                for (int j = 0; j < 4; ++j) s += (v[r][j].x + v[r][j].y) + (v[r][j].z + v[r][j].w);
                const float mean = wave_sum(s, F.lane) * (1.f / D); float s2 = 0.f;
#pragma unroll
                for (int j = 0; j < 4; ++j) { v[r][j] = v[r][j] - mean; s2 += (v[r][j].x * v[r][j].x + v[r][j].y * v[r][j].y) + (v[r][j].z * v[r][j].z + v[r][j].w * v[r][j].w); }
                const float rstd = __builtin_amdgcn_rsqf(wave_sum(s2, F.lane) * (1.f / D) + 1e-5f);
#pragma unroll
                for (int j = 0; j < 4; ++j) { const int col = 4 * (F.lane + 64 * j);
                    const f32x4 gv = *(const f32x4*)(a.in[I_LNIN_G] + col), bv = *(const f32x4*)(a.in[I_LNIN_B] + col);
                    const f32x4 y = v[r][j] * rstd * gv + bv;
                    v2u o; o.x = pk2(y.x, y.y); o.y = pk2(y.z, y.w);
                    *(v2u*)(A0 + (size_t)m * D + col) = o; }
                if (F.lane == 0) { ST[2 * m] = mean; ST[2 * m + 1] = rstd; } }
        }
    }
    __syncthreads();
    for (int rep_ = 0; rep_ < NREP(14); ++rep_) convert_expert_weights(a, F, rep_);
}

__device__ __forceinline__ const bf16* prow(const bf16* PROJ, const bf16* PROJM, int b, int vp) {
    const bf16* px = PROJ + (size_t)(b * SEQ + (vp >= NMETA ? vp - NMETA : 0)) * PW;
    const bf16* pm = PROJM + (size_t)(vp < 0 ? NMETA : (vp < NMETA ? vp : 0)) * PW;
    return vp >= NMETA ? px : pm;
}
__device__ __forceinline__ f32x4 ldp4(const bf16* PROJ, const bf16* PROJM, int b, int vp, int col) {
    const v2u w = *(const v2u*)(prow(PROJ, PROJM, b, vp) + col);
    return (f32x4){bflo(w.x), bfhi(w.x), bflo(w.y), bfhi(w.y)};
}

constexpr int R1_STRIDE = 49152;
constexpr int TP = 80;
constexpr int L1_SLOT = 64 * TP * 2;
constexpr int L1_LC = 12 * L1_SLOT;
constexpr int L1_XCH = L1_LC + 64 * 65 * 4;
constexpr int L1_LR = 8 * L1_SLOT;
__device__ __forceinline__ v2u pack4(f32x4 v) { v2u o; o.x = pk2(v[0], v[1]); o.y = pk2(v[2], v[3]); return o; }
__device__ __forceinline__ f32x4 tile_mm(const LAS bf16* A, const LAS bf16* Bt, int rt, int ct, int fr, int fq, f32x4 acc) {
#pragma unroll
    for (int ks = 0; ks < 2; ++ks)
        acc = mfma16(*(const LAS bf16x8*)(Bt + (ct * 16 + fr) * TP + ks * 32 + 8 * fq), *(const LAS bf16x8*)(A + (rt * 16 + fr) * TP + ks * 32 + 8 * fq), acc);
    return acc;
}
__device__ __forceinline__ void tile_st(LAS bf16* O, int rt, int ct, int fr, int fq, f32x4 v) { *(LAS v2u*)(O + (rt * 16 + fr) * TP + ct * 16 + 4 * fq) = pack4(v); }
#define L1S(n) ((LAS bf16*)(F.lds + (n) * L1_SLOT))

struct L1Pf { v4u sa[5]; v2u r[2][2], k[2][2], v[2][2]; };
__device__ __forceinline__ void l1_fetch(const Args& a, const Frame& F, int b, int h, int c, L1Pf& pf) {
    const bf16* PROJ = (const bf16*)(a.ws + WS_PROJ); const bf16* PROJM = (const bf16*)(a.ws + WS_PROJM);
    const int vp0 = (c == 0) ? -48 : NMETA + 64 * (c - 1);
    { const int cg = F.tid & 31, tr = F.tid >> 5;
#pragma unroll
      for (int i = 0; i < 5; ++i) pf.sa[i] = *(const v4u*)(prow(PROJ, PROJM, b, vp0 + 4 * tr - 1 + i) + RWL + 8 * cg); }
    { const int rt = F.wave & 3, cp = F.wave >> 2, fr = F.lane & 15, fq = F.lane >> 4, vp = vp0 + rt * 16 + fr;
      const bf16* p0 = prow(PROJ, PROJM, b, vp - 1); const bf16* p1 = prow(PROJ, PROJM, b, vp);
#pragma unroll
      for (int cc = 0; cc < 2; ++cc) { const int jc = h * 64 + (2 * cp + cc) * 16 + 4 * fq;
          pf.r[cc][0] = *(const v2u*)(p0 + RR + jc); pf.r[cc][1] = *(const v2u*)(p1 + RR + jc);
          pf.k[cc][0] = *(const v2u*)(p0 + RK + jc); pf.k[cc][1] = *(const v2u*)(p1 + RK + jc);
          pf.v[cc][0] = *(const v2u*)(p0 + RV + jc); pf.v[cc][1] = *(const v2u*)(p1 + RV + jc); } }
}
__device__ __forceinline__ f32x4 unpk4(v2u w) { return (f32x4){bflo(w.x), bfhi(w.x), bflo(w.y), bfhi(w.y)}; }

__device__ __forceinline__ void rwkv_l1_front(const Args& a, const Frame& F, int b, int h, int c, const L1Pf& pf, f32x4 (&rtil)[2]) {
    unsigned char* ws = a.ws;
    const bf16* W2T = (const bf16*)(ws + WS_W2T); const bf16* A2T = (const bf16*)(ws + WS_A2T); const bf16* G2T = (const bf16*)(ws + WS_G2T);
    const int unit = (b * 8 + h) * NCH + c;
    unsigned char* r1 = ws + WS_R1 + (size_t)unit * R1_STRIDE;
    float* GAM = (float*)(ws + WS_GAM) + (size_t)unit * 64;
    const float* mu = a.in[I_MU];
    const int vp0 = (c == 0) ? -48 : NMETA + 64 * (c - 1);
    constexpr int LRP = 264;
    LAS bf16* LR = (LAS bf16*)(F.lds + L1_LR);
    LAS float* LC = (LAS float*)(F.lds + L1_LC);
    LAS float* XCH = (LAS float*)(F.lds + L1_XCH);
    const int rt = F.wave & 3, cp = F.wave >> 2, fr = F.lane & 15, fq = F.lane >> 4;
    {
        const int cg = F.tid & 31, tr = F.tid >> 5;
        const f32x4 m0 = *(const f32x4*)(mu + 1536 + 8 * cg), m1 = *(const f32x4*)(mu + 1536 + 8 * cg + 4);
#pragma unroll
        for (int i = 0; i < 4; ++i) {
            const int row = 4 * tr + i;
            const v4u cw = pf.sa[i + 1], pw = pf.sa[i];
            const f32x4 c0 = unpk4((v2u){cw.x, cw.y}), c1 = unpk4((v2u){cw.z, cw.w}), p0 = unpk4((v2u){pw.x, pw.y}), p1 = unpk4((v2u){pw.z, pw.w});
            float v[8];
            v[0] = c0.x + (p0.x - c0.x) * m0.x; v[1] = c0.y + (p0.y - c0.y) * m0.y; v[2] = c0.z + (p0.z - c0.z) * m0.z; v[3] = c0.w + (p0.w - c0.w) * m0.w;
            v[4] = c1.x + (p1.x - c1.x) * m1.x; v[5] = c1.y + (p1.y - c1.y) * m1.y; v[6] = c1.z + (p1.z - c1.z) * m1.z; v[7] = c1.w + (p1.w - c1.w) * m1.w;
#pragma unroll
            for (int q = 0; q < 8; ++q) { if (cg < 8) v[q] = ftanh(v[q]); else if (cg >= 16) v[q] = fsigmoid(v[q]); }
            v4u o; o.x = pk2(v[0], v[1]); o.y = pk2(v[2], v[3]); o.z = pk2(v[4], v[5]); o.w = pk2(v[6], v[7]);
            *(LAS v4u*)(LR + row * LRP + 8 * cg) = o;
        }
    }
    lds_barrier();
    const int t = rt * 16 + fr, vp = vp0 + t;
    const bool valid = vp >= 0;
    float lwv[2][4], asg[2][4], kkr[2][4], kmd[2][4], rrv[2][4], vvv[2][4];
    float ssq = 0.f, bon = 0.f;
    {
        const LAS bf16* lrow = LR + t * LRP + 8 * fq;
#pragma unroll
        for (int cc = 0; cc < 2; ++cc) {
            const int ct = 2 * cp + cc, j = ct * 16 + 4 * fq, jc = h * 64 + j;
            f32x4 mr[2], mk[2], mv[2], w0v[2], a0v[2], kkw[2], kaw[2], rkw[2];
            mr[cc] = *(const f32x4*)(mu + jc); mk[cc] = *(const f32x4*)(mu + 512 + jc); mv[cc] = *(const f32x4*)(mu + 1024 + jc);
            w0v[cc] = *(const f32x4*)(a.in[I_W0] + jc); a0v[cc] = *(const f32x4*)(a.in[I_A0] + jc);
            kkw[cc] = *(const f32x4*)(a.in[I_KK] + jc); kaw[cc] = *(const f32x4*)(a.in[I_KA] + jc); rkw[cc] = *(const f32x4*)(a.in[I_RK] + jc);
            f32x4 aw = {0.f, 0.f, 0.f, 0.f}, aa = aw, ag = aw;
#pragma unroll
            for (int ks = 0; ks < 2; ++ks) {
                aw = mfma16(*(const bf16x8*)(W2T + (size_t)(h * 64 + ct * 16 + fr) * 64 + ks * 32 + 8 * fq), *(const LAS bf16x8*)(lrow + ks * 32), aw);
                aa = mfma16(*(const bf16x8*)(A2T + (size_t)(h * 64 + ct * 16 + fr) * 64 + ks * 32 + 8 * fq), *(const LAS bf16x8*)(lrow + 64 + ks * 32), aa);
            }
#pragma unroll
            for (int ks = 0; ks < 4; ++ks) ag = mfma16(*(const bf16x8*)(G2T + (size_t)(h * 64 + ct * 16 + fr) * 128 + ks * 32 + 8 * fq), *(const LAS bf16x8*)(lrow + 128 + ks * 32), ag);
            const f32x4 rc = unpk4(pf.r[cc][1]), rp = unpk4(pf.r[cc][0]), kc = unpk4(pf.k[cc][1]), kp = unpk4(pf.k[cc][0]), vc = unpk4(pf.v[cc][1]), vpv = unpk4(pf.v[cc][0]);
            const f32x4 rs = rc + (rp - rc) * mr[cc], ks_ = kc + (kp - kc) * mk[cc], vs = vc + (vpv - vc) * mv[cc];
#pragma unroll
            for (int i = 0; i < 4; ++i) {
                const float u = w0v[cc][i] + aw[i];
                const float wl = -fsoftplus(-u) - 0.5f;
                lwv[cc][i] = valid ? -fexp(wl) : 0.f;
                const float as_ = fsigmoid(a0v[cc][i] + aa[i]);
                asg[cc][i] = as_;
                const float kraw = ks_[i], kk = kraw * kkw[cc][i];
                kkr[cc][i] = kk; ssq += kk * kk;
                const float km = kraw * (1.f + (as_ - 1.f) * kaw[cc][i]);
                kmd[cc][i] = km; rrv[cc][i] = rs[i]; vvv[cc][i] = vs[i];
                bon += rs[i] * km * rkw[cc][i];
            }
            *(v2u*)(r1 + 4 * 8192 + (size_t)(t * 64 + j) * 2) = pack4(ag);
            __builtin_amdgcn_sched_barrier(0);
        }
#pragma unroll
        for (int cc = 0; cc < 2; ++cc)
#pragma unroll
            for (int i = 0; i < 4; ++i) LC[t * 65 + (2 * cp + cc) * 16 + 4 * fq + i] = lwv[cc][i];
        ssq += shx(ssq, 16, F.lane); ssq += shx(ssq, 32, F.lane);
        bon += shx(bon, 16, F.lane); bon += shx(bon, 32, F.lane);
        if (fq == 0) { XCH[(cp * 64 + t) * 2] = ssq; XCH[(cp * 64 + t) * 2 + 1] = bon; }
    }
    lds_barrier();
    const float ssq_t = XCH[t * 2] + XCH[(64 + t) * 2], bon_t = XCH[t * 2 + 1] + XCH[(64 + t) * 2 + 1];
    const float inv = 1.f / fmaxf(sqrtf(ssq_t), 1e-12f);
    {
        LAS float* SEG = XCH + 256;
        const int jj = F.tid & 63, sg = F.tid >> 6;
        float cv[8];
#pragma unroll
        for (int i = 0; i < 8; ++i) cv[i] = LC[(sg * 8 + i) * 65 + jj];
#pragma unroll
        for (int i = 1; i < 8; ++i) cv[i] += cv[i - 1];
        SEG[sg * 64 + jj] = cv[7];
        lds_barrier();
        float pre = 0.f;
#pragma unroll
        for (int s2 = 0; s2 < 7; ++s2) pre += (s2 < sg) ? SEG[s2 * 64 + jj] : 0.f;
#pragma unroll
        for (int i = 0; i < 8; ++i) LC[(sg * 8 + i) * 65 + jj] = cv[i] + pre;
    }
    lds_barrier();
    {
#pragma unroll
        for (int cc = 0; cc < 2; ++cc) {
            const int j = (2 * cp + cc) * 16 + 4 * fq;
            f32x4 At, Bt, Kt, Bh, Kh, bvv;
#pragma unroll
            for (int i = 0; i < 4; ++i) {
                const float Lc = LC[t * 65 + j + i], LcC = LC[63 * 65 + j + i];
                const float kn = kkr[cc][i] * inv, av = -kn, bv = kn * asg[cc][i], km = kmd[cc][i];
                const float eA = fexp(Lc - lwv[cc][i]), eR = fexp(Lc), eB = fexp(-Lc), eH = fexp(LcC - Lc);
                At[i] = av * eA; rtil[cc][i] = rrv[cc][i] * eR; Bt[i] = bv * eB; Kt[i] = km * eB; Bh[i] = bv * eH; Kh[i] = km * eH;
                bvv[i] = bon_t * vvv[cc][i];
                if (t == 63) GAM[j + i] = fexp(LcC);
            }
            *(LAS v2u*)(L1S(0) + t * TP + j) = pack4(Bt); *(LAS v2u*)(L1S(1) + t * TP + j) = pack4(Kt);
            *(LAS v2u*)(L1S(2) + t * TP + j) = pack4(At); *(LAS v2u*)(L1S(3) + t * TP + j) = pack4(rtil[cc]);
#pragma unroll
            for (int i = 0; i < 4; ++i) {
                L1S(4)[(j + i) * TP + t] = (bf16)f2bf(At[i]); L1S(5)[(j + i) * TP + t] = (bf16)f2bf(Bh[i]);
                L1S(6)[(j + i) * TP + t] = (bf16)f2bf(Kh[i]); L1S(7)[(j + i) * TP + t] = (bf16)f2bf(vvv[cc][i]);
            }
            *(v2u*)(r1 + 5 * 8192 + (size_t)(t * 64 + j) * 2) = pack4(bvv);
        }
    }
    lds_barrier();
}
__device__ __forceinline__ void rwkv_l1_back(const Args& a, const Frame& F, int b, int h, int c, const f32x4 (&rtil)[2]) {
    unsigned char* r1 = a.ws + WS_R1 + (size_t)((b * 8 + h) * NCH + c) * R1_STRIDE;
    const int rt = F.wave & 3, cp = F.wave >> 2, fr = F.lane & 15, fq = F.lane >> 4;
    f32x4 Pt[2];
    const int mrow = rt * 16 + fr;
    const f32x4 z = {0.f, 0.f, 0.f, 0.f};
    {
        f32x4 Lv[2], Nv[2], Mv[2], Bv[2], Kv[2];
#pragma unroll
        for (int cc = 0; cc < 2; ++cc) { const int ct = 2 * cp + cc;
            Lv[cc] = tile_mm(L1S(2), L1S(0), rt, ct, fr, fq, z); Nv[cc] = tile_mm(L1S(0), L1S(2), rt, ct, fr, fq, z); Mv[cc] = tile_mm(L1S(2), L1S(1), rt, ct, fr, fq, z);
            Bv[cc] = tile_mm(L1S(3), L1S(0), rt, ct, fr, fq, z); Kv[cc] = tile_mm(L1S(3), L1S(1), rt, ct, fr, fq, z); }
#pragma unroll
        for (int cc = 0; cc < 2; ++cc) { const int ct = 2 * cp + cc, n0 = ct * 16 + 4 * fq;
#pragma unroll
            for (int i = 0; i < 4; ++i) { const int n = n0 + i;
                if (!(n < mrow)) { Lv[cc][i] = 0.f; Mv[cc][i] = 0.f; } if (!(mrow < n)) Nv[cc][i] = 0.f; if (!(n <= mrow)) { Bv[cc][i] = 0.f; Kv[cc][i] = 0.f; }
                Pt[cc][i] = Lv[cc][i] + ((n == mrow) ? 1.f : 0.f); }
            tile_st(L1S(8), rt, ct, fr, fq, Lv[cc]); tile_st(L1S(9), rt, ct, fr, fq, Nv[cc]); tile_st(L1S(10), rt, ct, fr, fq, Mv[cc]);
            tile_st(L1S(11), rt, ct, fr, fq, Bv[cc]); tile_st(L1S(12), rt, ct, fr, fq, Kv[cc]); }
    }
    lds_barrier();
    f32x4 Xv[2];
#pragma unroll
    for (int st = 1; st <= 6; ++st) {
        LAS bf16* Xl = (st & 1) ? L1S(8) : L1S(0); LAS bf16* Xn = (st & 1) ? L1S(9) : L1S(1);
        LAS bf16* Yl = (st & 1) ? L1S(0) : L1S(8); LAS bf16* Yn = (st & 1) ? L1S(1) : L1S(9);
        LAS bf16* Pr = (st & 1) ? L1S(2) : L1S(3); LAS bf16* Pw = (st & 1) ? L1S(3) : L1S(2);
        f32x4 l2[2], n2[2];
#pragma unroll
        for (int cc = 0; cc < 2; ++cc) { const int ct = 2 * cp + cc;
            if (st <= 5) { l2[cc] = tile_mm(Xl, Xn, rt, ct, fr, fq, z); n2[cc] = tile_mm(Xn, Xl, rt, ct, fr, fq, z); }
            if (st >= 2) Pt[cc] = tile_mm(Pr, Xn, rt, ct, fr, fq, Pt[cc]);
            if (st == 1) Xv[cc] = tile_mm(L1S(7), L1S(10), rt, ct, fr, fq, z); }
#pragma unroll
        for (int cc = 0; cc < 2; ++cc) { const int ct = 2 * cp + cc;
            if (st <= 5) { tile_st(Yl, rt, ct, fr, fq, l2[cc]); tile_st(Yn, rt, ct, fr, fq, n2[cc]); }
            tile_st(Pw, rt, ct, fr, fq, Pt[cc]); }
        if (st == 1) { lds_barrier();
#pragma unroll
            for (int cc = 0; cc < 2; ++cc) tile_st(L1S(10), rt, 2 * cp + cc, fr, fq, Xv[cc]); }
        lds_barrier();
    }
    {
        f32x4 u[2], w[2];
#pragma unroll
        for (int cc = 0; cc < 2; ++cc) { const int ct = 2 * cp + cc; u[cc] = tile_mm(L1S(10), L1S(2), rt, ct, fr, fq, z); w[cc] = tile_mm(L1S(4), L1S(2), rt, ct, fr, fq, z); }
#pragma unroll
        for (int cc = 0; cc < 2; ++cc) { const int ct = 2 * cp + cc; tile_st(L1S(8), rt, ct, fr, fq, u[cc]); tile_st(L1S(9), rt, ct, fr, fq, w[cc]); }
    }
    lds_barrier();
    {
#pragma unroll
        for (int cc = 0; cc < 2; ++cc) { const int ct = 2 * cp + cc; const size_t eo = (size_t)(mrow * 64 + ct * 16 + 4 * fq) * 2;
            const f32x4 gp = tile_mm(L1S(5), L1S(9), rt, ct, fr, fq, z);
            const f32x4 hh = tile_mm(L1S(7), L1S(6), rt, ct, fr, fq, tile_mm(L1S(8), L1S(5), rt, ct, fr, fq, z));
            const f32x4 rh = tile_mm(L1S(11), L1S(9), rt, ct, fr, fq, rtil[cc]);
            const f32x4 yl = tile_mm(L1S(12), L1S(7), rt, ct, fr, fq, tile_mm(L1S(11), L1S(8), rt, ct, fr, fq, z));
            *(v2u*)(r1 + 0 * 8192 + eo) = pack4(gp); *(v2u*)(r1 + 1 * 8192 + eo) = pack4(hh);
            *(v2u*)(r1 + 2 * 8192 + eo) = pack4(rh); *(v2u*)(r1 + 3 * 8192 + eo) = pack4(yl); }
    }
    lds_barrier();
}

constexpr int BCP = 65;
__device__ __forceinline__ void gla_bc(const Args& a, const Frame& F, int b, int h, int vp0, int ntok) {
    const bf16* PROJ = (const bf16*)(a.ws + WS_PROJ); const bf16* PROJM = (const bf16*)(a.ws + WS_PROJM);
    LAS float* GKLs = (LAS float*)F.lds; LAS float* BC = (LAS float*)(F.lds + 4096);
    if (F.tid < 256) { const int t = F.tid >> 2, q = F.tid & 3;
        const f32x4 v = ldp4(PROJ, PROJM, b, (t < ntok) ? vp0 + t : -1, GKL + 4 * q);
        *(LAS f32x4*)(GKLs + t * 16 + 4 * q) = v; }
    lds_barrier();
    {
        const int d = F.tid & 63, tg = F.tid >> 6;
        float wc[16];
#pragma unroll
        for (int r = 0; r < 16; ++r) wc[r] = a.in[I_GKW2][r * 256 + h * 64 + d];
        const float gb = a.in[I_GKB][h * 64 + d];
#pragma unroll
        for (int i = 0; i < 8; ++i) { const int t = tg * 8 + i; float z = gb;
            const LAS f32x4* g4 = (const LAS f32x4*)(GKLs + t * 16);
#pragma unroll
            for (int q = 0; q < 4; ++q) { const f32x4 gv = g4[q]; z += gv.x * wc[4 * q] + gv.y * wc[4 * q + 1] + gv.z * wc[4 * q + 2] + gv.w * wc[4 * q + 3]; }
            BC[t * BCP + d] = (t < ntok) ? flogsigmoid(z) * (1.f / 16.f) : 0.f; }
    }
    lds_barrier();
    if (F.tid < 64) { float run = 0.f;
#pragma unroll 8
        for (int t = 0; t < 64; ++t) { run += BC[t * BCP + F.tid]; BC[t * BCP + F.tid] = run; } }
    lds_barrier();
}

__device__ __forceinline__ void gla_g1_unit(const Args& a, const Frame& F, int b, int h, int c) {
    const bf16* PROJ = (const bf16*)(a.ws + WS_PROJ); const bf16* PROJM = (const bf16*)(a.ws + WS_PROJM);
    float* GUS = (float*)(a.ws + WS_GUS); float* DL = (float*)(a.ws + WS_DL);
    const int ntok = (c == 0) ? NMETA : 64, vp0 = (c == 0) ? 0 : NMETA + 64 * (c - 1);
    gla_bc(a, F, b, h, vp0, ntok);
    LAS float* BC = (LAS float*)(F.lds + 4096);
    LAS bf16* KT = (LAS bf16*)(F.lds + 24576);
    LAS bf16* VT = (LAS bf16*)(F.lds + 24576 + 64 * TP * 2);
    {
        const int t = F.tid >> 3, q = F.tid & 7;
        const float* bl = nullptr; (void)bl;
#pragma unroll
        for (int half = 0; half < 2; ++half) {
            const int d0 = 8 * q + 4 * half;
            const f32x4 kv = ldp4(PROJ, PROJM, b, (t < ntok) ? vp0 + t : -1, GK + h * 64 + d0);
#pragma unroll
            for (int i = 0; i < 4; ++i) { const int d = d0 + i; const float e = (t < ntok) ? fexp(BC[(ntok - 1) * BCP + d] - BC[t * BCP + d]) : 0.f;
                KT[d * TP + t] = (bf16)f2bf(kv[i] * e); }
        }
#pragma unroll
        for (int qq = 0; qq < 4; ++qq) {
            const int e0 = 16 * q + 4 * qq;
            const f32x4 vv = ldp4(PROJ, PROJM, b, (t < ntok) ? vp0 + t : -1, GV + h * 128 + e0);
#pragma unroll
            for (int i = 0; i < 4; ++i) VT[(e0 + i) * TP + t] = (bf16)f2bf(vv[i]);
        }
    }
    lds_barrier();
    {
        const int rt = F.wave & 3, ch = F.wave >> 2, fr = F.lane & 15, fq = F.lane >> 4;
        float* up = GUS + ((size_t)((b * 4 + h) * NCH + c) * 64 + rt * 16 + fr) * 128;
#pragma unroll
        for (int cc = 0; cc < 4; ++cc) { const int ct = ch * 4 + cc;
            f32x4 acc = {0.f, 0.f, 0.f, 0.f};
#pragma unroll
            for (int ks = 0; ks < 2; ++ks)
                acc = mfma16(*(const LAS bf16x8*)(VT + (ct * 16 + fr) * TP + ks * 32 + 8 * fq), *(const LAS bf16x8*)(KT + (rt * 16 + fr) * TP + ks * 32 + 8 * fq), acc);
            *(f32x4*)(up + ct * 16 + 4 * fq) = acc; }
        if (F.tid < 64) DL[(size_t)((b * 4 + h) * NCH + c) * 64 + F.tid] = fexp(BC[(ntok - 1) * BCP + F.tid]);
    }
    lds_barrier();
}

__device__ __forceinline__ void phase2(const Args& a, const Frame& F) {
    {
        constexpr int NU = NB * 8 * NCH;
        const int u0 = (int)((long)F.blk * NU / F.G), u1 = (int)((long)(F.blk + 1) * NU / F.G);
        L1Pf pf;
        if (u0 < u1) l1_fetch(a, F, (u0 / NCH) >> 3, (u0 / NCH) & 7, u0 % NCH, pf);
        unsigned long long tf_ = 0, tb_ = 0;
        for (int u = u0; u < u1; ++u) {
            const int c = u % NCH, bh = u / NCH; f32x4 rtil[2];
            const unsigned long long t0_ = (REP_MASK >> 16) ? __builtin_amdgcn_s_memrealtime() : 0ull;
            { const Frame F1 = mkframe(F.lds, F.wave); rwkv_l1_front(a, F1, bh >> 3, bh & 7, c, pf, rtil); }
            const unsigned long long t1_ = (REP_MASK >> 16) ? __builtin_amdgcn_s_memrealtime() : 0ull;
            { const Frame F2 = mkframe(F.lds, F.wave);
              if (u + 1 < u1) l1_fetch(a, F2, ((u + 1) / NCH) >> 3, ((u + 1) / NCH) & 7, (u + 1) % NCH, pf);
              rwkv_l1_back(a, F2, bh >> 3, bh & 7, c, rtil); }
            const unsigned long long t2_ = (REP_MASK >> 16) ? __builtin_amdgcn_s_memrealtime() : 0ull;
            tf_ += t1_ - t0_; tb_ += t2_ - t1_;
        }
        if ((REP_MASK >> 16) != 0) {
            const unsigned long long dt_ = ((REP_MASK >> 16) == 1) ? tf_ : tb_, s0_ = __builtin_amdgcn_s_memrealtime();
            while (__builtin_amdgcn_s_memrealtime() - s0_ < dt_) __builtin_amdgcn_s_sleep(8);
        }
    }
    for (int rep_ = 0; rep_ < NREP(12); ++rep_)
    for (int u = F.blk; u < NB * 4 * 32; u += F.G) { const int c = u & 31, bh = u >> 5; gla_g1_unit(a, F, bh >> 2, bh & 3, c); }
}

struct L2S { bf16x8 fg[4]; v2u hq[2]; f32x4 gm[2]; };
__device__ __forceinline__ void l2s_fetch(L2S& r, const unsigned char* hp, const unsigned char* gp, const float* gam) {
#pragma unroll
    for (int cc = 0; cc < 2; ++cc) { r.fg[2 * cc] = *(const bf16x8*)(gp + cc * 2048); r.fg[2 * cc + 1] = *(const bf16x8*)(gp + cc * 2048 + 64);
        r.hq[cc] = *(const v2u*)(hp + cc * 32); r.gm[cc] = *(const f32x4*)(gam + cc * 16); }
}
__device__ __forceinline__ void l2s_step(const L2S& r, const LAS bf16* Sc, LAS bf16* Sn, f32x4 (&Sm)[2], int row, int col0, int fq, bf16* gout, int tid) {
    {
        const int r_ = tid >> 3, c8 = tid & 7;
        *(v4u*)(gout + r_ * 64 + 8 * c8) = *(const LAS v4u*)(Sc + r_ * TP + 8 * c8);
    }
    const bf16x8 af0 = *(const LAS bf16x8*)(Sc + row * TP + 8 * fq), af1 = *(const LAS bf16x8*)(Sc + row * TP + 32 + 8 * fq);
#pragma unroll
    for (int cc = 0; cc < 2; ++cc) {
        f32x4 acc = {bflo(r.hq[cc].x), bfhi(r.hq[cc].x), bflo(r.hq[cc].y), bfhi(r.hq[cc].y)};
        acc = mfma16(r.fg[2 * cc], af0, acc);
        acc = mfma16(r.fg[2 * cc + 1], af1, acc);
        Sm[cc] = Sm[cc] * r.gm[cc] + acc; }
#pragma unroll
    for (int cc = 0; cc < 2; ++cc) *(LAS v2u*)(Sn + row * TP + col0 + cc * 16) = pack4(Sm[cc]);
}
__device__ __forceinline__ void rwkv_l2_unit(const Args& a, const Frame& F, int bh) {
    unsigned char* ws = a.ws;
    LAS bf16* Sb0 = (LAS bf16*)F.lds; LAS bf16* Sb1 = Sb0 + 64 * TP;
    const int fr = F.lane & 15, fq = F.lane >> 4, rt = F.wave & 3, cp = F.wave >> 2;
    const int row = rt * 16 + fr, col0 = cp * 32 + 4 * fq;
    const unsigned char* hpb = ws + WS_R1 + (size_t)bh * NCH * R1_STRIDE + 8192 + (size_t)(row * 64 + col0) * 2;
    const unsigned char* gpb = ws + WS_R1 + (size_t)bh * NCH * R1_STRIDE + (size_t)((cp * 32 + fr) * 64 + 8 * fq) * 2;
    const float* gamb = (const float*)(ws + WS_GAM) + (size_t)bh * NCH * 64 + col0;
    bf16* sst = (bf16*)(ws + WS_SST) + (size_t)bh * NCH * 4096;
    f32x4 Sm[2];
#pragma unroll
    for (int cc = 0; cc < 2; ++cc) { Sm[cc] = (f32x4){0.f, 0.f, 0.f, 0.f}; *(LAS v2u*)(Sb0 + row * TP + col0 + cc * 16) = (v2u){0u, 0u}; }
    L2S r0, r1, r2, r3;
#define L2F(rr, cn) l2s_fetch(rr, hpb + (size_t)(cn) * R1_STRIDE, gpb + (size_t)(cn) * R1_STRIDE, gamb + (size_t)(cn) * 64)
    L2F(r0, 0); L2F(r1, 1); L2F(r2, 2);
    lds_barrier();
#pragma nounroll
    for (int c = 0; c < NCH - 1; c += 4) {
        L2F(r3, c + 3);
        l2s_step(r0, Sb0, Sb1, Sm, row, col0, fq, sst + (size_t)c * 4096, F.tid); lds_barrier();
        if (c + 4 < NCH - 1) L2F(r0, c + 4);
        l2s_step(r1, Sb1, Sb0, Sm, row, col0, fq, sst + (size_t)(c + 1) * 4096, F.tid); lds_barrier();
        if (c + 5 < NCH - 1) L2F(r1, c + 5);
        l2s_step(r2, Sb0, Sb1, Sm, row, col0, fq, sst + (size_t)(c + 2) * 4096, F.tid); lds_barrier();
        if (c + 6 < NCH - 1) L2F(r2, c + 6);
        l2s_step(r3, Sb1, Sb0, Sm, row, col0, fq, sst + (size_t)(c + 3) * 4096, F.tid); lds_barrier();
    }
#undef L2F
    { const int r_ = F.tid >> 3, c8 = F.tid & 7;
      *(v4u*)(sst + (size_t)(NCH - 1) * 4096 + r_ * 64 + 8 * c8) = *(const LAS v4u*)(Sb0 + r_ * TP + 8 * c8); }
    lds_barrier();
}
__device__ __forceinline__ void rwkv_y_task(const Args& a, const Frame& F, int task) {
    unsigned char* ws = a.ws;
    const int rt = task & 3, c = 1 + ((task >> 2) & 31), bh = task >> 7, b = bh >> 3, h = bh & 7;
    const int fr = F.lane & 15, fq = F.lane >> 4, row = rt * 16 + fr;
    const unsigned char* r1 = ws + WS_R1 + (size_t)(bh * NCH + c) * R1_STRIDE + (size_t)(row * 64 + 4 * fq) * 2;
    const bf16* Sg = (const bf16*)(ws + WS_SST) + (size_t)(bh * NCH + c) * 4096 + fr * 64 + 8 * fq;
    const bf16x8 fa0 = *(const bf16x8*)(r1 + 2 * 8192 + 8 * fq), fa1 = *(const bf16x8*)(r1 + 2 * 8192 + 64 + 8 * fq);
    bf16x8 sf[8]; v2u q0[4], q1[4], q2[4];
#pragma unroll
    for (int ct = 0; ct < 4; ++ct) { sf[2 * ct] = *(const bf16x8*)(Sg + ct * 1024); sf[2 * ct + 1] = *(const bf16x8*)(Sg + ct * 1024 + 32);
        q0[ct] = *(const v2u*)(r1 + 3 * 8192 + ct * 32); q1[ct] = *(const v2u*)(r1 + 4 * 8192 + ct * 32); q2[ct] = *(const v2u*)(r1 + 5 * 8192 + ct * 32); }
    f32x4 y[4]; float s = 0.f;
#pragma unroll
    for (int ct = 0; ct < 4; ++ct) {
        f32x4 acc = {bflo(q0[ct].x), bfhi(q0[ct].x), bflo(q0[ct].y), bfhi(q0[ct].y)};
        acc = mfma16(sf[2 * ct], fa0, acc); acc = mfma16(sf[2 * ct + 1], fa1, acc);
        y[ct] = acc; s += (acc[0] + acc[1]) + (acc[2] + acc[3]); }
    s += shx(s, 16, F.lane); s += shx(s, 32, F.lane);
    const float mean = s * (1.f / 64.f); float q = 0.f;
#pragma unroll
    for (int ct = 0; ct < 4; ++ct) { y[ct] = y[ct] - mean; q += (y[ct][0] * y[ct][0] + y[ct][1] * y[ct][1]) + (y[ct][2] * y[ct][2] + y[ct][3] * y[ct][3]); }
    q += shx(q, 16, F.lane); q += shx(q, 32, F.lane);
    const float rstd = __builtin_amdgcn_rsqf(q * (1.f / 64.f) + 64e-5f);
    LAS bf16* ost = (LAS bf16*)(F.lds + 102400 + F.wave * 2304);
#pragma unroll
    for (int ct = 0; ct < 4; ++ct) { const int i0 = h * 64 + ct * 16 + 4 * fq;
        const f32x4 lg = *(const f32x4*)(a.in[I_RLNG] + i0), lb = *(const f32x4*)(a.in[I_RLNB] + i0);
        const f32x4 g = {bflo(q1[ct].x), bfhi(q1[ct].x), bflo(q1[ct].y), bfhi(q1[ct].y)}, bv = {bflo(q2[ct].x), bfhi(q2[ct].x), bflo(q2[ct].y), bfhi(q2[ct].y)};
        const f32x4 o = (y[ct] * rstd * lg + lb + bv) * g;
        *(LAS v2u*)(ost + fr * 72 + ct * 16 + 4 * fq) = pack4(o); }
    asm volatile("s_waitcnt lgkmcnt(0)" ::: "memory");
    bf16* yout = (bf16*)(ws + WS_YMIX) + ((size_t)b * SEQ + 64 * (c - 1) + rt * 16) * D + 512 + h * 64;
#pragma unroll
    for (int hh = 0; hh < 2; ++hh) { const int tr = (F.lane >> 3) + 8 * hh, c8 = F.lane & 7;
        *(v4u*)(yout + (size_t)tr * D + 8 * c8) = *(const LAS v4u*)(ost + tr * 72 + 8 * c8); }
    asm volatile("s_waitcnt lgkmcnt(0)" ::: "memory");
}
__device__ __forceinline__ void gla_scan_unit(const Args& a, const Frame& F, int j) {
    float* GUS = (float*)(a.ws + WS_GUS); const float* DL = (const float*)(a.ws + WS_DL);
    const int bh = j >> 1, half = j & 1;
    const int d = 32 * half + (F.tid >> 4), e0 = (F.tid & 15) * 8;
    float* base = GUS + (size_t)bh * NCH * 8192 + d * 128 + e0;
    const float* dl = DL + (size_t)bh * NCH * 64 + d;
    f32x4 s0 = {0.f, 0.f, 0.f, 0.f}, s1 = s0;
    f32x4 ua[4], ub[4]; float dq[4];
#pragma unroll
    for (int q = 0; q < 3; ++q) { ua[q] = *(const f32x4*)(base + (size_t)q * 8192); ub[q] = *(const f32x4*)(base + (size_t)q * 8192 + 4); dq[q] = dl[q * 64]; }
#pragma unroll 4
    for (int c = 0; c < NCH - 1; ++c) {
        const int cn = (c + 3 < NCH - 1) ? c + 3 : NCH - 2;
        ua[(c + 3) & 3] = *(const f32x4*)(base + (size_t)cn * 8192); ub[(c + 3) & 3] = *(const f32x4*)(base + (size_t)cn * 8192 + 4); dq[(c + 3) & 3] = dl[cn * 64];
        *(f32x4*)(base + (size_t)c * 8192) = s0; *(f32x4*)(base + (size_t)c * 8192 + 4) = s1;
        s0 = s0 * dq[c & 3] + ua[c & 3]; s1 = s1 * dq[c & 3] + ub[c & 3];
    }
    *(f32x4*)(base + (size_t)(NCH - 1) * 8192) = s0; *(f32x4*)(base + (size_t)(NCH - 1) * 8192 + 4) = s1;
}
__device__ __forceinline__ void phase3(const Args& a, const Frame& F) {
    constexpr int PSEL = (REP_MASK >> 20) & 7;
    const unsigned long long t0_ = PSEL ? __builtin_amdgcn_s_memrealtime() : 0ull;
    for (int u = F.blk; u < 256; u += F.G) {
        if (u < 128) { for (int rep_ = 0; rep_ < NREP(3); ++rep_) rwkv_l2_unit(a, F, u); }
        else gla_scan_unit(a, F, u - 128);
    }
    if (PSEL) { const unsigned long long t1_ = __builtin_amdgcn_s_memrealtime();
        unsigned long long dt_ = 0;
        if (PSEL == 1 && F.blk < 128) dt_ = t1_ - t0_;
        if (PSEL == 2 && F.blk >= 128) dt_ = t1_ - t0_;
        while (__builtin_amdgcn_s_memrealtime() - t1_ < dt_) __builtin_amdgcn_s_sleep(8); }
}

__device__ __forceinline__ void gla_g3_unit(const Args& a, const Frame& F, int b, int h, int c) {
    const bf16* PROJ = (const bf16*)(a.ws + WS_PROJ); const bf16* PROJM = (const bf16*)(a.ws + WS_PROJM);
    const float* GUS = (const float*)(a.ws + WS_GUS); bf16* YMIX = (bf16*)(a.ws + WS_YMIX);
    const int vp0 = NMETA + 64 * (c - 1);
    gla_bc(a, F, b, h, vp0, 64);
    LAS float* BC = (LAS float*)(F.lds + 4096);
    LAS bf16* QT = (LAS bf16*)(F.lds + 24576);
    LAS bf16* KL = QT + 64 * TP;
    LAS bf16* AT = KL + 64 * TP;
    LAS bf16* VT = AT + 64 * TP;
    LAS bf16* ST = VT + 128 * TP;
    LAS float* RS = (LAS float*)(ST + 128 * TP);
    {
        const int t = F.tid >> 3, q = F.tid & 7;
        const f32x4 q0 = ldp4(PROJ, PROJM, b, vp0 + t, GQ + h * 64 + 8 * q), q1 = ldp4(PROJ, PROJM, b, vp0 + t, GQ + h * 64 + 8 * q + 4);
        const f32x4 k0 = ldp4(PROJ, PROJM, b, vp0 + t, GK + h * 64 + 8 * q), k1 = ldp4(PROJ, PROJM, b, vp0 + t, GK + h * 64 + 8 * q + 4);
        float qv[8] = {q0.x, q0.y, q0.z, q0.w, q1.x, q1.y, q1.z, q1.w}, kv[8] = {k0.x, k0.y, k0.z, k0.w, k1.x, k1.y, k1.z, k1.w};
#pragma unroll
        for (int i = 0; i < 8; ++i) { const float bcv = BC[t * BCP + 8 * q + i]; qv[i] *= fexp(bcv) * 0.125f; kv[i] *= fexp(-bcv); }
        v4u o; o.x = pk2(qv[0], qv[1]); o.y = pk2(qv[2], qv[3]); o.z = pk2(qv[4], qv[5]); o.w = pk2(qv[6], qv[7]);
        *(LAS v4u*)(QT + t * TP + 8 * q) = o;
        o.x = pk2(kv[0], kv[1]); o.y = pk2(kv[2], kv[3]); o.z = pk2(kv[4], kv[5]); o.w = pk2(kv[6], kv[7]);
        *(LAS v4u*)(KL + t * TP + 8 * q) = o;
#pragma unroll
        for (int qq = 0; qq < 4; ++qq) {
            const int e0 = 16 * q + 4 * qq;
            const f32x4 vv = ldp4(PROJ, PROJM, b, vp0 + t, GV + h * 128 + e0);
#pragma unroll
            for (int i = 0; i < 4; ++i) VT[(e0 + i) * TP + t] = (bf16)f2bf(vv[i]);
            const f32x4 sv = *(const f32x4*)(GUS + ((size_t)((b * 4 + h) * NCH + c) * 64 + t) * 128 + e0);
#pragma unroll
            for (int i = 0; i < 4; ++i) ST[(e0 + i) * TP + t] = (bf16)f2bf(sv[i]);
        }
    }
    lds_barrier();
    const int rt = F.wave & 3, wh = F.wave >> 2, fr = F.lane & 15, fq = F.lane >> 4;
    const int trow = rt * 16 + fr;
    {
#pragma unroll
        for (int cc = 0; cc < 2; ++cc) { const int ct = 2 * wh + cc;
            f32x4 acc = {0.f, 0.f, 0.f, 0.f};
#pragma unroll
            for (int ks = 0; ks < 2; ++ks)
                acc = mfma16(*(const LAS bf16x8*)(KL + (ct * 16 + fr) * TP + ks * 32 + 8 * fq), *(const LAS bf16x8*)(QT + trow * TP + ks * 32 + 8 * fq), acc);
            const int s0 = ct * 16 + 4 * fq;
#pragma unroll
            for (int i = 0; i < 4; ++i) if (s0 + i > trow) acc[i] = 0.f;
            v2u o; o.x = pk2(acc[0], acc[1]); o.y = pk2(acc[2], acc[3]);
            *(LAS v2u*)(AT + trow * TP + s0) = o; }
    }
    lds_barrier();
    f32x4 oacc[4]; float ssq = 0.f;
#pragma unroll
    for (int cc = 0; cc < 4; ++cc) { const int ct = wh * 4 + cc;
        f32x4 acc = {0.f, 0.f, 0.f, 0.f};
#pragma unroll
        for (int ks = 0; ks < 2; ++ks) {
            acc = mfma16(*(const LAS bf16x8*)(VT + (ct * 16 + fr) * TP + ks * 32 + 8 * fq), *(const LAS bf16x8*)(AT + trow * TP + ks * 32 + 8 * fq), acc);
            acc = mfma16(*(const LAS bf16x8*)(ST + (ct * 16 + fr) * TP + ks * 32 + 8 * fq), *(const LAS bf16x8*)(QT + trow * TP + ks * 32 + 8 * fq), acc);
        }
        oacc[cc] = acc; ssq += (acc[0] * acc[0] + acc[1] * acc[1]) + (acc[2] * acc[2] + acc[3] * acc[3]); }
    ssq += shx(ssq, 16, F.lane); ssq += shx(ssq, 32, F.lane);
    if (fq == 0) RS[wh * 64 + trow] = ssq;
    lds_barrier();
    {
        const float tot = RS[trow] + RS[64 + trow];
        const float rstd = 1.f / sqrtf(tot * (1.f / 128.f) + 1e-6f);
        const size_t m = (size_t)b * SEQ + (vp0 - NMETA) + trow;
#pragma unroll
        for (int cc = 0; cc < 4; ++cc) { const int e0 = (wh * 4 + cc) * 16 + 4 * fq;
            const f32x4 gv = ldp4(PROJ, PROJM, b, vp0 + trow, GG + h * 128 + e0);
            const f32x4 ng = *(const f32x4*)(a.in[I_GNORM] + e0);
            float y[4];
#pragma unroll
            for (int i = 0; i < 4; ++i) { const float gi = gv[i]; y[i] = oacc[cc][i] * rstd * ng[i] * (gi * fsigmoid(gi)); }
            v2u o; o.x = pk2(y[0], y[1]); o.y = pk2(y[2], y[3]);
            *(v2u*)(YMIX + m * D + h * 128 + e0) = o; }
    }
    lds_barrier();
}
__device__ __forceinline__ void phase4(const Args& a, const Frame& F) {
    for (int t = F.blk * NWAVES + F.wave; t < 128 * 32 * 4; t += F.G * NWAVES) rwkv_y_task(a, F, t);
    __syncthreads();
    for (int u = F.blk; u < NB * 4 * 32; u += F.G) { const int c = 1 + (u & 31), bh = u >> 5; gla_g3_unit(a, F, bh >> 2, bh & 3, c); }
}

__device__ __forceinline__ int eidx_of(int L) { return 16 * (L & 1) + 8 * ((L >> 1) & 1) + 4 * ((L >> 2) & 1) + 2 * ((L >> 3) & 1) + ((L >> 4) & 1); }
__device__ __forceinline__ void p6_ln(const Args& a, const Frame& F, int m, f32x4 (&v)[4]) {
    unsigned char* ws = a.ws; bf16* H1 = (bf16*)(ws + WS_H1);
    float s = 0.f;
#pragma unroll
    for (int j = 0; j < 4; ++j) s += (v[j].x + v[j].y) + (v[j].z + v[j].w);
    const float mean = wave_sum(s, F.lane) * (1.f / D); float s2 = 0.f;
#pragma unroll
    for (int j = 0; j < 4; ++j) { v[j] = v[j] - mean; s2 += (v[j].x * v[j].x + v[j].y * v[j].y) + (v[j].z * v[j].z + v[j].w * v[j].w); }
    const float rstd = __builtin_amdgcn_rsqf(wave_sum(s2, F.lane) * (1.f / D) + 1e-5f);
#pragma unroll
    for (int j = 0; j < 4; ++j) { const int col = 4 * (F.lane + 64 * j);
        const f32x4 gv = *(const f32x4*)(a.in[I_LN1G] + col), bv = *(const f32x4*)(a.in[I_LN1B] + col);
        v[j] = v[j] * rstd * gv + bv;
        v2u o; o.x = pk2(v[j].x, v[j].y); o.y = pk2(v[j].z, v[j].w);
        *(v2u*)(H1 + (size_t)m * D + col) = o;
        int w8 = __builtin_amdgcn_cvt_pk_fp8_f32(v[j].x, v[j].y, 0, false); w8 = __builtin_amdgcn_cvt_pk_fp8_f32(v[j].z, v[j].w, w8, true);
        *(int*)(ws + WS_H1Q + (size_t)m * D + col) = w8; }
}
__device__ __forceinline__ void p6_top(const Args& a, const Frame& F, int m, int i, float (&p)[16], int& my_e) {
    int* TOPI = (int*)(a.ws + WS_TOPI); float* GATE = (float*)(a.ws + WS_GATE);
#define TR_STAGE(n, dmask) _Pragma("unroll") for (int i2 = 0; i2 < (n) / 2; ++i2) { const bool up = (F.lane & (dmask)) != 0; const float keep = up ? p[i2 + (n) / 2] : p[i2]; const float send = up ? p[i2] : p[i2 + (n) / 2]; p[i2] = keep + shx(send, (dmask), F.lane); }
    TR_STAGE(16, 2) TR_STAGE(8, 4) TR_STAGE(4, 8) TR_STAGE(2, 16)
#undef TR_STAGE
    const int eidx = eidx_of(F.lane);
    const float logit = p[0] + shx(p[0], 32, F.lane) + a.in[I_RTB][eidx];
    int rank = 0;
#pragma unroll
    for (int j = 0; j < 32; ++j) { const float lj = __int_as_float(__builtin_amdgcn_readlane(__float_as_int(logit), j)); const int ej = eidx_of(j);
        rank += (lj > logit || (lj == logit && ej < eidx)) ? 1 : 0; }
    int ek[4]; float lk[4];
#pragma unroll
    for (int k = 0; k < 4; ++k) { const unsigned long long mk = __ballot(rank == k) & 0xffffffffull; const int src = __builtin_amdgcn_readfirstlane((int)__builtin_ctzll(mk | (1ull << 63)));
        ek[k] = eidx_of(src); lk[k] = __int_as_float(__builtin_amdgcn_readlane(__float_as_int(logit), src)); }
    const float e0 = 1.f, e1 = expf(lk[1] - lk[0]), e2 = expf(lk[2] - lk[0]), e3 = expf(lk[3] - lk[0]);
    const float inv = 1.f / (e0 + e1 + e2 + e3);
    if (F.lane < 4) { const int k = F.lane; const int ee = k == 0 ? ek[0] : k == 1 ? ek[1] : k == 2 ? ek[2] : ek[3]; const float gg = (k == 0 ? e0 : k == 1 ? e1 : k == 2 ? e2 : e3) * inv;
        TOPI[(size_t)m * 4 + k] = ee; GATE[(size_t)m * 4 + k] = gg; }
    if ((F.lane >> 2) == i) { const int k = F.lane & 3; my_e = k == 0 ? ek[0] : k == 1 ? ek[1] : k == 2 ? ek[2] : ek[3]; }
}
__device__ __forceinline__ void p6_pair(const Args& a, const Frame& F, int m, int i, f32x4 (&v0)[4], f32x4 (&v1)[4], const LAS float* rwT, int& my_e) {
    constexpr int RWP = 1028;
    p6_ln(a, F, m, v0); p6_ln(a, F, m + 1, v1);
    float p0[16], p1[16]; const bool up = (F.lane & 1) != 0;
#pragma unroll
    for (int e = 0; e < 16; ++e) { float a0 = 0.f, a1 = 0.f, b0 = 0.f, b1 = 0.f;
#pragma unroll
        for (int j = 0; j < 4; ++j) { const f32x4 w = *(const LAS f32x4*)(rwT + e * RWP + 4 * (F.lane + 64 * j)), x = *(const LAS f32x4*)(rwT + (e + 16) * RWP + 4 * (F.lane + 64 * j));
            a0 += (v0[j].x * w.x + v0[j].y * w.y) + (v0[j].z * w.z + v0[j].w * w.w); a1 += (v1[j].x * w.x + v1[j].y * w.y) + (v1[j].z * w.z + v1[j].w * w.w);
            b0 += (v0[j].x * x.x + v0[j].y * x.y) + (v0[j].z * x.z + v0[j].w * x.w); b1 += (v1[j].x * x.x + v1[j].y * x.y) + (v1[j].z * x.z + v1[j].w * x.w); }
        p0[e] = (up ? b0 : a0) + shx(up ? a0 : b0, 1, F.lane); p1[e] = (up ? b1 : a1) + shx(up ? a1 : b1, 1, F.lane);
        if ((e & 1) == 1) __builtin_amdgcn_sched_barrier(0); }
    p6_top(a, F, m, i, p0, my_e); p6_top(a, F, m + 1, i + 1, p1, my_e);
}
__device__ __forceinline__ void phase6(const Args& a, const Frame& F, int csel) {
    unsigned char* ws = a.ws;
    const int gw = F.blk * NWAVES + F.wave, NGW = F.G * NWAVES;
    constexpr int RWP = 1028;
    LAS float* rwT = (LAS float*)F.lds;
    LAS int* hist = (LAS int*)(F.lds + 32 * RWP * 4);
    for (int i = F.tid; i < D * NE; i += NTHR) { const int c = i >> 5, e = i & 31; rwT[e * RWP + c] = a.in[I_RTW][i]; }
    bf16* H1 = (bf16*)(ws + WS_H1);
    int* TOPI = (int*)(ws + WS_TOPI); float* GATE = (float*)(ws + WS_GATE); int* RANK = (int*)(ws + WS_RANK);
    unsigned* CNT = (unsigned*)(ws + WS_CTL) + CW_CNT + 2048 * csel;
    for (int rb = F.blk; rb < MX / 128; rb += F.G) {
        if (F.tid < 64) hist[F.tid] = 0;
        __syncthreads();
        int my_e = 0;
        {
            const int mb = rb * 128 + F.wave * 16; const Frame& Fo = F;
            const f32x4* xr0 = (const f32x4*)(a.in[I_X] + (size_t)mb * D) + F.lane;
            const v2u* mr0 = (const v2u*)((const bf16*)(ws + WS_MIXB) + (size_t)mb * D) + F.lane;
            const float* st0 = (const float*)(ws + WS_STATS) + 2 * (size_t)mb;
            f32x4 va[4], vb[4], vc[4], vd[4]; v2u ma[4], mbv[4], mc[4], md[4]; float sa0, sa1, sb0, sb1, sc0, sc1, sd0, sd1;
#define P6_LOAD(vv, mmv, s0v, s1v, ii) do { _Pragma("unroll") for (int j = 0; j < 4; ++j) { vv[j] = xr0[(size_t)(ii) * (D / 4) + 64 * j]; mmv[j] = mr0[(size_t)(ii) * (D / 4) + 64 * j]; } s0v = st0[2 * (ii)]; s1v = st0[2 * (ii) + 1]; } while (0)
#define P6_FORM(vv, mmv, s0v, s1v) do { _Pragma("unroll") for (int j = 0; j < 4; ++j) { const int col = 4 * (F.lane + 64 * j); \
            const f32x4 gi = *(const f32x4*)(a.in[I_LNIN_G] + col) * ALPHA, bi = *(const f32x4*)(a.in[I_LNIN_B] + col) * ALPHA; \
            vv[j] = ((vv[j] - s0v) * s1v) * gi + bi + unpk4(mmv[j]); } } while (0)
            P6_LOAD(va, ma, sa0, sa1, 0); P6_LOAD(vb, mbv, sb0, sb1, 1);
#pragma nounroll
            for (int i = 0; i < 16; i += 4) {
                P6_LOAD(vc, mc, sc0, sc1, i + 2); P6_LOAD(vd, md, sd0, sd1, i + 3);
                { const Frame F = mkframe(Fo.lds, Fo.wave);
                  P6_FORM(va, ma, sa0, sa1); P6_FORM(vb, mbv, sb0, sb1);
                  p6_pair(a, F, mb + i, i, va, vb, rwT, my_e); }
                if (i + 4 < 16) { P6_LOAD(va, ma, sa0, sa1, i + 4); P6_LOAD(vb, mbv, sb0, sb1, i + 5); }
                { const Frame F = mkframe(Fo.lds, Fo.wave);
                  P6_FORM(vc, mc, sc0, sc1); P6_FORM(vd, md, sd0, sd1);
                  p6_pair(a, F, mb + i + 2, i + 2, vc, vd, rwT, my_e); }
            }
#undef P6_LOAD
#undef P6_FORM
        }
        const int lrank = __hip_atomic_fetch_add(&hist[my_e], 1, __ATOMIC_RELAXED, __HIP_MEMORY_SCOPE_WORKGROUP);
        __syncthreads();
        if (F.tid < 32) hist[32 + F.tid] = (int)__hip_atomic_fetch_add(CNT + 64 * F.tid, (unsigned)hist[F.tid], __ATOMIC_RELAXED, __HIP_MEMORY_SCOPE_AGENT);
        __syncthreads();
        RANK[((size_t)rb * 128 + F.wave * 16 + (F.lane >> 2)) * 4 + (F.lane & 3)] = hist[32 + my_e] + lrank;
        __syncthreads();
    }
}

__device__ __forceinline__ void phase7(const Args& a, const Frame& F) {
    unsigned char* ws = a.ws;
    LAS int* starts = (LAS int*)F.lds;
    unsigned* CNT = (unsigned*)(ws + WS_CTL) + CW_CNT;
    int* TILEE = (int*)(ws + WS_TILEE); int* SLOTTOK = (int*)(ws + WS_SLOTTOK);
    if (F.tid < 32) { const int cnt = (int)ld_agent(CNT + 64 * F.tid); starts[64 + F.tid] = cnt; starts[32 + F.tid] = (cnt + 255) & ~255; }
    __syncthreads();
    if (F.tid == 0) { int run = 0; for (int e = 0; e < 32; ++e) { starts[e] = run; run += starts[32 + e]; }
        if (F.blk == 0) { TILEE[1023] = run >> 8; for (int e = 0; e < 32; ++e) for (int tl = starts[e] >> 8; tl < (starts[e] + starts[32 + e]) >> 8; ++tl) TILEE[tl] = e; } }
    __syncthreads();
    if (F.blk == 0) { for (int e = 0; e < 32; ++e) for (int s = starts[e] + starts[64 + e] + F.tid; s < starts[e] + starts[32 + e]; s += NTHR) SLOTTOK[s] = 0; }
    const int* TOPI = (const int*)(ws + WS_TOPI); const int* RANK = (const int*)(ws + WS_RANK); int* TSLOT = (int*)(ws + WS_TSLOT);
    for (int q = F.blk * NTHR + F.tid; q < MX * 4; q += F.G * NTHR) {
        const int slot = starts[TOPI[q]] + RANK[q];
        TSLOT[q] = slot; SLOTTOK[slot] = q >> 2;
    }
}
__device__ __forceinline__ int moe_fill_table(const Args& a, const Frame& F, int nN, int RM) {
    LAS int* tab = (LAS int*)(F.lds + TAB_OFF);
    const unsigned* TILEE = (const unsigned*)(a.ws + WS_TILEE);
    if (F.tid == 0) {
        const int NT = (int)ld_agent(TILEE + 1023);
        const int x = F.blk & 7, j = F.blk >> 3; int n = 0;
        for (int i = 0; i < 64; ++i) { const int s = i * 8 + x, pm = s * RM + j / nN; if (pm >= NT) break;
            const int e = (int)ld_agent(TILEE + pm); tab[2 * n] = pm; tab[2 * n + 1] = e * nN + (j % nN); ++n; }
        tab[128] = n;
    }
    __syncthreads();
    return __builtin_amdgcn_readfirstlane(tab[128]);
}

__device__ __forceinline__ void p10_acc(float (&s)[16], int j, const v4u w, float g) {
    s[8 * j + 0] += g * bflo(w.x); s[8 * j + 1] += g * bfhi(w.x); s[8 * j + 2] += g * bflo(w.y); s[8 * j + 3] += g * bfhi(w.y);
    s[8 * j + 4] += g * bflo(w.z); s[8 * j + 5] += g * bfhi(w.z); s[8 * j + 6] += g * bflo(w.w); s[8 * j + 7] += g * bfhi(w.w);
}
__device__ __forceinline__ void phase10(const Args& a, const Frame& F) {
    unsigned char* ws = a.ws;
    const bf16* H1 = (const bf16*)(ws + WS_H1); const bf16* YS = (const bf16*)(ws + WS_YS);
    const int* TSLOT = (const int*)(ws + WS_TSLOT); const float* GATE = (const float*)(ws + WS_GATE);
    const int gw = F.blk * NWAVES + F.wave, NGW = F.G * NWAVES;
    f32x4 gv[4], bv[4];
#pragma unroll
    for (int q = 0; q < 4; ++q) { const int col = 8 * F.lane + 512 * (q >> 1) + 4 * (q & 1); gv[q] = *(const f32x4*)(a.in[I_LN2G] + col); bv[q] = *(const f32x4*)(a.in[I_LN2B] + col); }
    for (int m0 = gw; m0 < MX; m0 += 2 * NGW) {
        int mm[2]; mm[0] = m0; mm[1] = (m0 + NGW < MX) ? m0 + NGW : m0;
        int slot[2][4]; float gt[2][4]; v4u hw[2][2], yw[2][4][2];
#pragma unroll
        for (int r = 0; r < 2; ++r) {
#pragma unroll
            for (int k = 0; k < 4; ++k) { slot[r][k] = TSLOT[(size_t)mm[r] * 4 + k]; gt[r][k] = GATE[(size_t)mm[r] * 4 + k]; }
#pragma unroll
            for (int j = 0; j < 2; ++j) hw[r][j] = *(const v4u*)(H1 + (size_t)mm[r] * D + 8 * F.lane + 512 * j); }
#pragma unroll
        for (int r = 0; r < 2; ++r)
#pragma unroll
            for (int k = 0; k < 4; ++k)
#pragma unroll
                for (int j = 0; j < 2; ++j) yw[r][k][j] = *(const v4u*)(YS + (size_t)slot[r][k] * D + 8 * F.lane + 512 * j);
#pragma unroll
        for (int r = 0; r < 2; ++r) {
            float s[16];
#pragma unroll
            for (int i = 0; i < 16; ++i) s[i] = 0.f;
#pragma unroll
            for (int j = 0; j < 2; ++j) p10_acc(s, j, hw[r][j], ALPHA);
#pragma unroll
            for (int k = 0; k < 4; ++k)
#pragma unroll
                for (int j = 0; j < 2; ++j) p10_acc(s, j, yw[r][k][j], gt[r][k]);
            float t = 0.f;
#pragma unroll
            for (int i = 0; i < 16; ++i) t += s[i];
            const float mean = wave_sum(t, F.lane) * (1.f / D); float q = 0.f;
#pragma unroll
            for (int i = 0; i < 16; ++i) { s[i] -= mean; q += s[i] * s[i]; }
            const float rstd = __builtin_amdgcn_rsqf(wave_sum(q, F.lane) * (1.f / D) + 1e-5f);
            if (r == 0 || mm[1] != mm[0]) {
#pragma unroll
                for (int q4 = 0; q4 < 4; ++q4) { const int col = 8 * F.lane + 512 * (q4 >> 1) + 4 * (q4 & 1);
                    f32x4 o; o.x = s[4 * q4 + 0] * rstd * gv[q4].x + bv[q4].x; o.y = s[4 * q4 + 1] * rstd * gv[q4].y + bv[q4].y; o.z = s[4 * q4 + 2] * rstd * gv[q4].z + bv[q4].z; o.w = s[4 * q4 + 3] * rstd * gv[q4].w + bv[q4].w;
                    *(f32x4*)(a.out + (size_t)mm[r] * D + col) = o; } }
        }
    }
}

template <int LO, int HI>
__global__ void __launch_bounds__(NTHR, 2) fwd(Args a) {
    extern __shared__ __attribute__((aligned(16))) unsigned char lds_raw[];
    LAS unsigned char* lds = (LAS unsigned char*)lds_raw;
    const int wave = __builtin_amdgcn_readfirstlane((int)(threadIdx.x >> 6));
    volatile LAS unsigned* MISC = (volatile LAS unsigned*)(lds + MISC_OFF);
    if (wave == 0) MISC[lane_id()] = 0u;
    __syncthreads();
    unsigned* ctl = (unsigned*)(a.ws + WS_CTL);
    XcdBarrier bar; bar.bar = ctl + CW_BAR; bar.x = 0; bar.st = nullptr;
    if constexpr (HI - LO > 1) bar = xcd_barrier_post(ctl + CW_BAR, MISC + 8, wave == 0 && lane_id() == 0);
#define PH(k) if constexpr (LO <= (k) && (k) < HI)
#define SEAM(k) if constexpr (LO <= (k) && (k) + 1 < HI) xcd_barrier(bar, wave == 0 && lane_id() == 0)
    PH(0) for (int rep_ = 0; rep_ < NREP(0); ++rep_) { const Frame F = mkframe(lds, wave); phase0(a, F); } SEAM(0);
    PH(1) for (int rep_ = 0; rep_ < NREP(1); ++rep_) { const Frame F = mkframe(lds, wave);
            pg8::Gemm g{(const pg8::bf16_t*)(a.ws + WS_A0), (const pg8::bf16_t*)(a.ws + WS_WIN), MX, PW, D}; pg8::StaticOrder S; S.init(MX, PW, F.G, F.blk);
            pg8::EpiBf16Plain E{(pg8::bf16_t*)(a.ws + WS_PROJ), PW};
            pg8::gemm_phase<pg8::EpiBf16Plain, pg8::StaticOrder, true, true>(F.lds, g, S, E, F.tid); } SEAM(1);
    PH(2) for (int rep_ = 0; rep_ < NREP(2); ++rep_) { const Frame F = mkframe(lds, wave); phase2(a, F); } SEAM(2);
    PH(3) { const Frame F = mkframe(lds, wave); phase3(a, F); } SEAM(3);
    PH(4) for (int rep_ = 0; rep_ < NREP(4); ++rep_) { const Frame F = mkframe(lds, wave); phase4(a, F); } SEAM(4);
    PH(5) for (int rep_ = 0; rep_ < NREP(5); ++rep_) { const Frame F = mkframe(lds, wave);
            pg8::Gemm g{(const pg8::bf16_t*)(a.ws + WS_YMIX), (const pg8::bf16_t*)(a.ws + WS_WOUT), MX, D, D}; pg8::StaticOrder S; S.init(MX, D, F.G, F.blk);
            pg8::EpiBf16Plain E{(pg8::bf16_t*)(a.ws + WS_MIXB), D};
            pg8::gemm_phase<pg8::EpiBf16Plain, pg8::StaticOrder, true, true>(F.lds, g, S, E, F.tid); } SEAM(5);
    PH(6) for (int rep_ = 0; rep_ < NREP(6); ++rep_) { const Frame F = mkframe(lds, wave); phase6(a, F, rep_); } SEAM(6);
    PH(7) for (int rep_ = 0; rep_ < NREP(7); ++rep_) { const Frame F = mkframe(lds, wave); phase7(a, F); } SEAM(7);
    PH(8) for (int rep_ = 0; rep_ < NREP(8); ++rep_) { const Frame F = mkframe(lds, wave); const int n = moe_fill_table(a, F, 8, 4);
            pg8::Gemm g{(const pg8::bf16_t*)(a.ws + WS_H1Q), (const pg8::bf16_t*)(a.ws + WS_WUP), 0, 0, D / 2}; pg8::TableOrder S{(const LAS int*)(F.lds + TAB_OFF), n};
            pg8::EpiSwiglu8 E{a.ws + WS_ACT, a.in[I_BUP]};
            pg8::gemm_phase_g<pg8::EpiSwiglu8, pg8::TableOrder, true, true, 121>(F.lds, g, S, E, F.tid, (const int*)(a.ws + WS_SLOTTOK)); } SEAM(8);
    PH(9) for (int rep_ = 0; rep_ < NREP(9); ++rep_) { const Frame F = mkframe(lds, wave); const int n = moe_fill_table(a, F, 4, 8);
            pg8::Gemm g{(const pg8::bf16_t*)(a.ws + WS_ACT), (const pg8::bf16_t*)(a.ws + WS_WDN), 0, 0, D / 2}; pg8::TableOrder S{(const LAS int*)(F.lds + TAB_OFF), n};
            pg8::EpiDown E{(pg8::bf16_t*)(a.ws + WS_YS), a.in[I_BDN]};
            pg8::gemm_phase<pg8::EpiDown, pg8::TableOrder, true, true, 120>(F.lds, g, S, E, F.tid); } SEAM(9);
    PH(10) for (int rep_ = 0; rep_ < NREP(10); ++rep_) { const Frame F = mkframe(lds, wave); phase10(a, F); }
#undef PH
#undef SEAM
}

#ifndef MK_SINGLE
#define MK_SINGLE 1
#endif
template <int LO, int HI> static void launch_range(const Args& a, int grid, hipStream_t stream) {
    static bool attr = false;
    if (!attr) { (void)hipFuncSetAttribute((const void*)fwd<LO, HI>, hipFuncAttributeMaxDynamicSharedMemorySize, LDS_BYTES); attr = true; }
    hipLaunchKernelGGL((fwd<LO, HI>), dim3(grid), dim3(NTHR), LDS_BYTES, stream, a);
}
extern "C" void kernel_launch(void* const* d_in, const int* in_sizes, int n_in, void* d_out, int out_size, void* d_ws, size_t ws_size, hipStream_t stream) {
    if (n_in != 30 || ws_size < WS_END) { fprintf(stderr, "kernel_launch: unexpected inputs (n_in %d, ws %zu)\n", n_in, ws_size); return; }
    const int grid = 256;
    (void)hipMemsetAsync((char*)d_ws + WS_CTL, 0, CTL_ZERO_BYTES, stream);
    Args a{};
    for (int i = 0; i < 30; ++i) a.in[i] = (const float*)d_in[i];
    a.out = (float*)d_out; a.ws = (unsigned char*)d_ws;
#if MK_SINGLE
    launch_range<0, 11>(a, grid, stream);
#else
    launch_range<0, 1>(a, grid, stream); launch_range<1, 2>(a, grid, stream); launch_range<2, 3>(a, grid, stream); launch_range<3, 4>(a, grid, stream);
    launch_range<4, 5>(a, grid, stream); launch_range<5, 6>(a, grid, stream); launch_range<6, 7>(a, grid, stream); launch_range<7, 8>(a, grid, stream);
    launch_range<8, 9>(a, grid, stream); launch_range<9, 10>(a, grid, stream); launch_range<10, 11>(a, grid, stream);
#endif
}
```

```cpp
#include <hip/hip_runtime.h>
#include <cstdio>
#include <cstdint>
#include <cmath>
namespace pg8 {
#define PG8_LAS __attribute__((address_space(3)))
typedef unsigned short bf16_t;
typedef short bf16x8 __attribute__((ext_vector_type(8)));
typedef float f32x4 __attribute__((ext_vector_type(4)));
typedef unsigned u32x4 __attribute__((ext_vector_type(4)));
constexpr int BM = 256, BK = 64, HALF = 128, HTB = HALF * BK * 2  , STAGE_BYTES = 8 * HTB, NXCD = 8, WGM = 8;

__host__ __device__ __forceinline__ int lds_byte(int r, int c) { const int st = (r >> 4) * 2 + (c >> 5), rr = r & 15, cc = c & 31, ob = rr * 64 + cc * 2; return st * 1024 + (ob ^ (((ob >> 9) & 1) << 5)); }
__host__ __device__ __forceinline__ void stage_rc(int b, int& R, int& C) { const int st = b / 1024, sb = b % 1024, swz = sb ^ (((sb >> 9) & 1) << 5); R = (st >> 1) * 16 + swz / 64; C = (st & 1) * 32 + (swz % 64) / 2; }
__host__ __device__ __forceinline__ int perm32(int rho) { const int n = rho >> 4, i = rho & 15; return 8 * (i >> 2) + 4 * n + (i & 3); }

struct Unit { int pm, pn; };
struct Gemm { const bf16_t* A; const bf16_t* Bt; int M, N, K; };

struct StaticOrder {
    int nM, nN, nwg, G, c;
    __host__ __device__ void init(int M, int N, int G_, int c_) { nM = M / BM; nN = N / BM; nwg = nM * nN; G = G_; c = c_; }
    __host__ __device__ bool next(int i, Unit& u) const {
        const long L = (long)i * G + c; if (L >= nwg) return false;
        int wgid = (int)L; { const int q = nwg / NXCD, r = nwg % NXCD, xcd = wgid % NXCD, off = wgid / NXCD; wgid = (xcd < r ? xcd * (q + 1) : r * (q + 1) + (xcd - r) * q) + off; }
        const int nig = WGM * nN, gid = wgid / nig, fm = gid * WGM, gsz = (nM - fm) < WGM ? (nM - fm) : WGM;
        u.pm = fm + ((wgid % nig) % gsz); u.pn = (wgid % nig) / gsz; return true;
    }
    __device__ __forceinline__ void a_ready(const Unit&) const {}
    __device__ __forceinline__ void done(const Unit&) const {}
};


__device__ __forceinline__ unsigned cvt_pk_bf16(float lo, float hi) { unsigned r; asm volatile("v_cvt_pk_bf16_f32 %0, %1, %2" : "=v"(r) : "v"(lo), "v"(hi)); return r; }
typedef unsigned u32x2 __attribute__((ext_vector_type(2)));
typedef int i32x8 __attribute__((ext_vector_type(8))); typedef int i32x4 __attribute__((ext_vector_type(4)));
__device__ __forceinline__ void mfma_f8(f32x4& acc, i32x8 a, i32x8 b, int sa, int sb) {
    asm volatile("s_nop 1\n\tv_mfma_scale_f32_16x16x128_f8f6f4 %0, %1, %2, %0, %3, %4 op_sel_hi:[0,0,0]" : "+v"(acc) : "v"(a), "v"(b), "v"(sa), "v"(sb));
}
__device__ __forceinline__ i32x8 cat8(bf16x8 lo, bf16x8 hi) { const i32x4 a = __builtin_bit_cast(i32x4, lo), b = __builtin_bit_cast(i32x4, hi); return __builtin_shufflevector(a, b, 0, 1, 2, 3, 4, 5, 6, 7); }

struct EpiBf16Plain {
    static constexpr bool PERM = true, AFTER_DRAIN = false;
    bf16_t* O; int ldc;
    __device__ __forceinline__ void operator()(const f32x4 (&acc)[2][2][4][2], const Unit& u, int wr, int wc, int fr, int fq) const {
        const int row0 = u.pm * BM + wr * 64 + fr, col0 = u.pn * BM + wc * 32 + 8 * fq;
#pragma unroll
        for (int ai = 0; ai < 2; ++ai)
#pragma unroll
            for (int m = 0; m < 4; ++m) { bf16_t* rowp = O + (size_t)(row0 + ai * HALF + m * 16) * ldc + col0;
#pragma unroll
                for (int bj = 0; bj < 2; ++bj) { const f32x4 v0 = acc[ai][bj][m][0], v1 = acc[ai][bj][m][1];
                    u32x4 w; w.x = cvt_pk_bf16(v0[0], v0[1]); w.y = cvt_pk_bf16(v0[2], v0[3]); w.z = cvt_pk_bf16(v1[0], v1[1]); w.w = cvt_pk_bf16(v1[2], v1[3]);
                    *(u32x4*)(rowp + bj * HALF) = w; } }
    }
};

struct EpiResid {
    static constexpr bool PERM = false, AFTER_DRAIN = false;
    float* S1; const float* x; const float* stats; const float* g; const float* bta; float alpha;
    __device__ __forceinline__ void operator()(const f32x4 (&acc)[2][2][4][2], const Unit& u, int wr, int wc, int fr, int fq) const {
        const int row0 = u.pm * BM + wr * 64 + fr, col0 = u.pn * BM + wc * 32 + 4 * fq;
#pragma unroll
        for (int bj = 0; bj < 2; ++bj)
#pragma unroll
            for (int n = 0; n < 2; ++n) { const int c = col0 + bj * HALF + n * 16;
                const f32x4 gv = *(const f32x4*)(g + c) * alpha, bv = *(const f32x4*)(bta + c) * alpha;
#pragma unroll
                for (int ai = 0; ai < 2; ++ai)
#pragma unroll
                    for (int m = 0; m < 4; ++m) { const int r = row0 + ai * HALF + m * 16;
                        const float mean = stats[2 * r], rstd = stats[2 * r + 1];
                        const f32x4 xv = *(const f32x4*)(x + (size_t)r * 1024 + c);
                        *(f32x4*)(S1 + (size_t)r * 1024 + c) = ((xv - mean) * rstd) * gv + bv + acc[ai][bj][m][n]; } }
    }
};

__device__ __forceinline__ float swiglu1(float glu, float lin) {
    const float xg = fminf(glu, 7.0f), xl = fminf(fmaxf(lin, -7.0f), 7.0f);
    const float sg = __builtin_amdgcn_rcpf(1.0f + __expf(-1.702f * xg));
    return xg * sg * (xl + 1.0f);
}
struct EpiSwiglu {
    static constexpr bool PERM = true, AFTER_DRAIN = false;
    bf16_t* ACT; const float* bup;
    __device__ __forceinline__ void operator()(const f32x4 (&acc)[2][2][4][2], const Unit& u, int wr, int wc, int fr, int fq) const {
        const int e = u.pn >> 3, pn = u.pn & 7;
        const int row0 = u.pm * BM + wr * 64 + fr, ucol0 = pn * BM + wc * 32 + 8 * fq, acol0 = ucol0 >> 1;
        f32x4 bv[2][2];
#pragma unroll
        for (int bj = 0; bj < 2; ++bj)
#pragma unroll
            for (int n = 0; n < 2; ++n) bv[bj][n] = *(const f32x4*)(bup + (size_t)e * 2048 + ucol0 + bj * HALF + 4 * n);
#pragma unroll
        for (int ai = 0; ai < 2; ++ai)
#pragma unroll
            for (int m = 0; m < 4; ++m) { bf16_t* rowp = ACT + (size_t)(row0 + ai * HALF + m * 16) * 1024 + acol0;
#pragma unroll
                for (int bj = 0; bj < 2; ++bj) { const f32x4 v0 = acc[ai][bj][m][0] + bv[bj][0], v1 = acc[ai][bj][m][1] + bv[bj][1];
                    u32x2 w; w.x = cvt_pk_bf16(swiglu1(v0[0], v0[1]), swiglu1(v0[2], v0[3])); w.y = cvt_pk_bf16(swiglu1(v1[0], v1[1]), swiglu1(v1[2], v1[3]));
                    *(u32x2*)(rowp + bj * (HALF / 2)) = w; } }
    }
};
struct EpiSwiglu8 {
    static constexpr bool PERM = true, AFTER_DRAIN = false;
    unsigned char* ACT; const float* bup;
    __device__ __forceinline__ void operator()(const f32x4 (&acc)[2][2][4][2], const Unit& u, int wr, int wc, int fr, int fq) const {
        const int e = u.pn >> 3, pn = u.pn & 7;
        const int row0 = u.pm * BM + wr * 64 + fr, ucol0 = pn * BM + wc * 32 + 8 * fq, acol0 = ucol0 >> 1;
        f32x4 bv[2][2];
#pragma unroll
        for (int bj = 0; bj < 2; ++bj)
#pragma unroll
            for (int n = 0; n < 2; ++n) bv[bj][n] = *(const f32x4*)(bup + (size_t)e * 2048 + ucol0 + bj * HALF + 4 * n);
#pragma unroll
        for (int ai = 0; ai < 2; ++ai)
#pragma unroll
            for (int m = 0; m < 4; ++m) { unsigned char* rowp = ACT + (size_t)(row0 + ai * HALF + m * 16) * 1024 + acol0;
#pragma unroll
                for (int bj = 0; bj < 2; ++bj) { const f32x4 v0 = acc[ai][bj][m][0] + bv[bj][0], v1 = acc[ai][bj][m][1] + bv[bj][1];
                    int w = __builtin_amdgcn_cvt_pk_fp8_f32(swiglu1(v0[0], v0[1]), swiglu1(v0[2], v0[3]), 0, false);
                    w = __builtin_amdgcn_cvt_pk_fp8_f32(swiglu1(v1[0], v1[1]), swiglu1(v1[2], v1[3]), w, true);
                    *(int*)(rowp + bj * (HALF / 2)) = w; } }
    }
};
struct EpiDown {
    static constexpr bool PERM = true, AFTER_DRAIN = false;
    bf16_t* YS; const float* bdn;
    __device__ __forceinline__ void operator()(const f32x4 (&acc)[2][2][4][2], const Unit& u, int wr, int wc, int fr, int fq) const {
        const int e = u.pn >> 2, pn = u.pn & 3;
        const int row0 = u.pm * BM + wr * 64 + fr, col0 = pn * BM + wc * 32 + 8 * fq;
        f32x4 bv[2][2];
#pragma unroll
        for (int bj = 0; bj < 2; ++bj)
#pragma unroll
            for (int n = 0; n < 2; ++n) bv[bj][n] = *(const f32x4*)(bdn + (size_t)e * 1024 + col0 + bj * HALF + 4 * n);
#pragma unroll
        for (int ai = 0; ai < 2; ++ai)
#pragma unroll
            for (int m = 0; m < 4; ++m) { bf16_t* rowp = YS + (size_t)(row0 + ai * HALF + m * 16) * 1024 + col0;
#pragma unroll
                for (int bj = 0; bj < 2; ++bj) { const f32x4 v0 = acc[ai][bj][m][0] + bv[bj][0], v1 = acc[ai][bj][m][1] + bv[bj][1];
                    u32x4 w; w.x = cvt_pk_bf16(v0[0], v0[1]); w.y = cvt_pk_bf16(v0[2], v0[3]); w.z = cvt_pk_bf16(v1[0], v1[1]); w.w = cvt_pk_bf16(v1[2], v1[3]);
                    *(u32x4*)(rowp + bj * HALF) = w; } }
    }
};
struct TableOrder {
    const PG8_LAS int* tab; int n;
    __device__ __forceinline__ bool next(int i, Unit& u) const {
        if (i >= n) return false;
        u.pm = __builtin_amdgcn_readfirstlane(tab[2 * i]); u.pn = __builtin_amdgcn_readfirstlane(tab[2 * i + 1]); return true;
    }
    __device__ __forceinline__ void a_ready(const Unit&) const {}
    __device__ __forceinline__ void done(const Unit&) const {}
};

template <class Epi, class Sched, bool ALIGN_EPI = false, bool SP2 = false, int SCW = 0>
__device__ __forceinline__ void gemm_phase(PG8_LAS unsigned char* lds, const Gemm g, const Sched& S, const Epi& E, const int tid) {
    const int wid = __builtin_amdgcn_readfirstlane(tid >> 6), lane = tid & 63, wr = wid >> 2, wc = wid & 3, fr = lane & 15, fq = lane >> 4;
    int K_ = g.K; asm volatile("" : "+s"(K_));
    const int K = K_, nt = K / BK;
    unsigned voffA[2], voffB[2];
#pragma unroll
    for (int i = 0; i < 2; ++i) { int R, C; stage_rc(tid * 16 + i * 8192, R, C); const int Rb = Epi::PERM ? ((R & ~31) + perm32(R & 31)) : R;
        voffA[i] = (unsigned)(R * K + C) * 2u; voffB[i] = (unsigned)(Rb * K + C) * 2u; }
    const size_t kstep = (size_t)(BK * 2);
    const size_t hstep = (size_t)HALF * K * 2;
    const size_t tstep = 2 * hstep;
    const unsigned ldsw = (unsigned)wid * 1024u;
    const int aoff = lds_byte(wr * 64 + fr, fq * 8), boff = lds_byte(wc * 32 + fr, fq * 8);
#define PG8_SA(b, h) (((b) * 2 + (h)) * HTB)
#define PG8_SB(b, h) ((4 + (b) * 2 + (h)) * HTB)
#define PG8_STAGE(bufoff, gbase, voff) do { _Pragma("unroll") for (int _i = 0; _i < 2; ++_i) \
        __builtin_amdgcn_global_load_lds((const unsigned*)((const char*)(gbase) + (voff)[_i]), (PG8_LAS unsigned*)(lds + (bufoff) + ldsw + _i * 8192), 16, 0, 0); } while (0)
#define PG8_LDA(dst, b, h) do { _Pragma("unroll") for (int m = 0; m < 4; ++m) _Pragma("unroll") for (int k = 0; k < 2; ++k) dst[m][k] = *(const PG8_LAS bf16x8*)(lds + PG8_SA(b, h) + aoff + m * 2048 + k * 1024); } while (0)
#define PG8_LDB(dst, b, h) do { _Pragma("unroll") for (int n = 0; n < 2; ++n) _Pragma("unroll") for (int k = 0; k < 2; ++k) dst[n][k] = *(const PG8_LAS bf16x8*)(lds + PG8_SB(b, h) + boff + n * 2048 + k * 1024); } while (0)
#define PG8_MMA(ai, bj, At, Bt) do { __builtin_amdgcn_s_setprio(1); _Pragma("unroll") for (int m = 0; m < 4; ++m) _Pragma("unroll") for (int n = 0; n < 2; ++n) { \
        if constexpr (SCW != 0) mfma_f8(acc[ai][bj][m][n], cat8(Bt[n][0], Bt[n][1]), cat8(At[m][0], At[m][1]), SCW * 0x01010101, 0x7f7f7f7f); \
        else { _Pragma("unroll") for (int k = 0; k < 2; ++k) acc[ai][bj][m][n] = __builtin_amdgcn_mfma_f32_16x16x32_bf16(Bt[n][k], At[m][k], acc[ai][bj][m][n], 0, 0, 0); } } __builtin_amdgcn_s_setprio(0); } while (0)
#define PG8_WAIT_V(n) asm volatile("s_waitcnt vmcnt(" #n ")" ::: "memory")
#define PG8_WAIT_L(n) asm volatile("s_waitcnt lgkmcnt(" #n ")" ::: "memory")
#define PG8_BAR __builtin_amdgcn_s_barrier()
#define PG8_SCHED __builtin_amdgcn_sched_barrier(0)
    Unit cur, nxt; int ui = 0;
    if (!S.next(0, cur)) return;
    f32x4 acc[2][2][4][2];
#pragma unroll
    for (int a = 0; a < 2; ++a)
#pragma unroll
        for (int b = 0; b < 2; ++b)
#pragma unroll
            for (int m = 0; m < 4; ++m)
#pragma unroll
                for (int n = 0; n < 2; ++n) acc[a][b][m][n] = (f32x4){0.f, 0.f, 0.f, 0.f};
    bf16x8 At[4][2], B0[2][2], B1[2][2];
    const char* cA = (const char*)g.A + (size_t)cur.pm * tstep; const char* cB = (const char*)g.Bt + (size_t)cur.pn * tstep;
    S.a_ready(cur);
    if constexpr (SP2) {
        PG8_STAGE(PG8_SB(0, 0), cB, voffB); PG8_STAGE(PG8_SB(0, 1), cB + hstep, voffB); PG8_STAGE(PG8_SA(0, 0), cA, voffA); PG8_STAGE(PG8_SA(0, 1), cA + hstep, voffA);
        if (wr == 1) PG8_BAR;
        PG8_WAIT_V(2); PG8_BAR;
        PG8_STAGE(PG8_SB(1, 0), cB + kstep, voffB); PG8_STAGE(PG8_SA(1, 0), cA + kstep, voffA); PG8_STAGE(PG8_SB(1, 1), cB + hstep + kstep, voffB);
        PG8_WAIT_V(6); PG8_BAR;
    } else {
        PG8_STAGE(PG8_SB(0, 0), cB, voffB); PG8_STAGE(PG8_SA(0, 0), cA, voffA); PG8_STAGE(PG8_SB(0, 1), cB + hstep, voffB); PG8_STAGE(PG8_SA(0, 1), cA + hstep, voffA);
        if (wr == 1) PG8_BAR;
        PG8_WAIT_V(4); PG8_BAR;
        PG8_STAGE(PG8_SB(1, 0), cB + kstep, voffB); PG8_STAGE(PG8_SA(1, 0), cA + kstep, voffA); PG8_STAGE(PG8_SB(1, 1), cB + hstep + kstep, voffB);
        PG8_WAIT_V(6); PG8_BAR;
    }
    for (;;) {
        const bool has_next = S.next(ui + 1, nxt);
        const char* nA = has_next ? (const char*)g.A + (size_t)nxt.pm * tstep : cA; const char* nB = has_next ? (const char*)g.Bt + (size_t)nxt.pn * tstep : cB;
        for (int t = 0; t < nt; t += 2) {
            const bool last = (t == nt - 2);
            const char* a1 = cA + (size_t)(t + 1) * kstep;
            const char* a2 = last ? nA : cA + (size_t)(t + 2) * kstep; const char* b2 = last ? nB : cB + (size_t)(t + 2) * kstep;
            const char* a3 = a2 + kstep; const char* b3 = b2 + kstep;
            if (last && has_next) S.a_ready(nxt);
            if constexpr (SP2) {
            PG8_LDB(B0, 0, 0); PG8_LDB(B1, 0, 1); PG8_SCHED; PG8_LDA(At, 0, 0); PG8_STAGE(PG8_SA(1, 1), a1 + hstep, voffA);
            PG8_WAIT_V(8); PG8_WAIT_L(0); PG8_BAR; PG8_MMA(0, 0, At, B0); PG8_MMA(0, 1, At, B1); PG8_BAR; PG8_SCHED;
            PG8_LDA(At, 0, 1); PG8_STAGE(PG8_SB(0, 0), b2, voffB); PG8_STAGE(PG8_SB(0, 1), b2 + hstep, voffB); PG8_STAGE(PG8_SA(0, 0), a2, voffA);
            PG8_WAIT_V(8); PG8_WAIT_L(0); PG8_BAR; PG8_MMA(1, 0, At, B0); PG8_MMA(1, 1, At, B1); PG8_BAR; PG8_SCHED;
            PG8_LDB(B0, 1, 0); PG8_LDB(B1, 1, 1); PG8_SCHED; PG8_LDA(At, 1, 0); PG8_STAGE(PG8_SA(0, 1), a2 + hstep, voffA);
            PG8_WAIT_V(8); PG8_WAIT_L(0); PG8_BAR; PG8_MMA(0, 0, At, B0); PG8_MMA(0, 1, At, B1); PG8_BAR; PG8_SCHED;
            PG8_LDA(At, 1, 1); PG8_STAGE(PG8_SB(1, 0), b3, voffB); PG8_STAGE(PG8_SB(1, 1), b3 + hstep, voffB); PG8_STAGE(PG8_SA(1, 0), a3, voffA);
            PG8_WAIT_V(8); PG8_WAIT_L(0); PG8_BAR; PG8_MMA(1, 0, At, B0); PG8_MMA(1, 1, At, B1); PG8_BAR; PG8_SCHED;
            } else {
            PG8_LDB(B0, 0, 0); PG8_SCHED; PG8_LDA(At, 0, 0); PG8_STAGE(PG8_SA(1, 1), a1 + hstep, voffA);
            PG8_WAIT_L(8); PG8_BAR; PG8_WAIT_L(0); PG8_MMA(0, 0, At, B0); PG8_BAR; PG8_SCHED;
            PG8_LDB(B1, 0, 1); PG8_STAGE(PG8_SB(0, 0), b2, voffB);
            PG8_BAR; PG8_WAIT_L(0); PG8_MMA(0, 1, At, B1); PG8_BAR;
            PG8_LDA(At, 0, 1); PG8_STAGE(PG8_SA(0, 0), a2, voffA);
            PG8_BAR; PG8_WAIT_L(0); PG8_MMA(1, 0, At, B0); PG8_BAR; PG8_SCHED;
            PG8_STAGE(PG8_SB(0, 1), b2 + hstep, voffB);
            PG8_WAIT_V(6); PG8_BAR; PG8_MMA(1, 1, At, B1); PG8_BAR;
            PG8_LDB(B0, 1, 0); PG8_SCHED; PG8_LDA(At, 1, 0); PG8_STAGE(PG8_SA(0, 1), a2 + hstep, voffA);
            PG8_WAIT_L(8); PG8_BAR; PG8_WAIT_L(0); PG8_MMA(0, 0, At, B0); PG8_BAR; PG8_SCHED;
            PG8_LDB(B1, 1, 1); PG8_STAGE(PG8_SB(1, 0), b3, voffB);
            PG8_BAR; PG8_WAIT_L(0); PG8_MMA(0, 1, At, B1); PG8_BAR;
            PG8_LDA(At, 1, 1); PG8_STAGE(PG8_SA(1, 0), a3, voffA);
            PG8_BAR; PG8_WAIT_L(0); PG8_MMA(1, 0, At, B0); PG8_BAR; PG8_SCHED;
            PG8_STAGE(PG8_SB(1, 1), b3 + hstep, voffB);
            PG8_WAIT_V(6); PG8_BAR; PG8_MMA(1, 1, At, B1); PG8_BAR;
            }
        }
        if constexpr (SCW != 0) asm volatile("s_nop 15\n\ts_nop 15" ::: "memory");
        if constexpr (ALIGN_EPI) { if (wr == 0) PG8_BAR; }
        if constexpr (!Epi::AFTER_DRAIN) { E(acc, cur, wr, wc, fr, fq); S.done(cur); }
        if (!has_next) break;
#pragma unroll
        for (int a = 0; a < 2; ++a)
#pragma unroll
            for (int b = 0; b < 2; ++b)
#pragma unroll
                for (int m = 0; m < 4; ++m)
#pragma unroll
                    for (int n = 0; n < 2; ++n) acc[a][b][m][n] = (f32x4){0.f, 0.f, 0.f, 0.f};
        cur = nxt; cA = nA; cB = nB; ++ui;
        if constexpr (ALIGN_EPI) { if (wr == 1) PG8_BAR; }
    }
    PG8_WAIT_V(0);
    if constexpr (!ALIGN_EPI) { if (wr == 0) PG8_BAR; }
    PG8_BAR;
    if constexpr (Epi::AFTER_DRAIN) { E.fused(acc, cur, wr, wc, fr, fq, lds, wid, lane); S.done(cur); }
#undef PG8_SA
#undef PG8_SB
#undef PG8_STAGE
#undef PG8_LDA
#undef PG8_LDB
#undef PG8_MMA
#undef PG8_WAIT_V
#undef PG8_WAIT_L
#undef PG8_BAR
#undef PG8_SCHED
}
template <class Epi, class Sched, bool ALIGN_EPI = false, bool SP2 = false, int SCW = 0>
__device__ __forceinline__ void gemm_phase_g(PG8_LAS unsigned char* lds, const Gemm g, const Sched& S, const Epi& E, const int tid, const int* rowmap) {
    const int wid = __builtin_amdgcn_readfirstlane(tid >> 6), lane = tid & 63, wr = wid >> 2, wc = wid & 3, fr = lane & 15, fq = lane >> 4;
    int K_ = g.K; asm volatile("" : "+s"(K_));
    const int K = K_, nt = K / BK;
    unsigned voffB[2], cv0[2], cv1[2], nv0[2], nv1[2]; int RA[2], CA[2];
#pragma unroll
    for (int i = 0; i < 2; ++i) { int R, C; stage_rc(tid * 16 + i * 8192, R, C); const int Rb = Epi::PERM ? ((R & ~31) + perm32(R & 31)) : R;
        RA[i] = R; CA[i] = C; voffB[i] = (unsigned)(Rb * K + C) * 2u; }
    const size_t kstep = (size_t)(BK * 2);
    const size_t hstep = (size_t)HALF * K * 2;
    const size_t tstep = 2 * hstep;
    const unsigned ldsw = (unsigned)wid * 1024u;
    const int aoff = lds_byte(wr * 64 + fr, fq * 8), boff = lds_byte(wc * 32 + fr, fq * 8);
#define PG8_SA(b, h) (((b) * 2 + (h)) * HTB)
#define PG8_SB(b, h) ((4 + (b) * 2 + (h)) * HTB)
#define PG8_STAGE(bufoff, gbase, voff) do { _Pragma("unroll") for (int _i = 0; _i < 2; ++_i) \
        __builtin_amdgcn_global_load_lds((const unsigned*)((const char*)(gbase) + (voff)[_i]), (PG8_LAS unsigned*)(lds + (bufoff) + ldsw + _i * 8192), 16, 0, 0); } while (0)
#define PG8_LDA(dst, b, h) do { _Pragma("unroll") for (int m = 0; m < 4; ++m) _Pragma("unroll") for (int k = 0; k < 2; ++k) dst[m][k] = *(const PG8_LAS bf16x8*)(lds + PG8_SA(b, h) + aoff + m * 2048 + k * 1024); } while (0)
#define PG8_LDB(dst, b, h) do { _Pragma("unroll") for (int n = 0; n < 2; ++n) _Pragma("unroll") for (int k = 0; k < 2; ++k) dst[n][k] = *(const PG8_LAS bf16x8*)(lds + PG8_SB(b, h) + boff + n * 2048 + k * 1024); } while (0)
#define PG8_MMA(ai, bj, At, Bt) do { __builtin_amdgcn_s_setprio(1); _Pragma("unroll") for (int m = 0; m < 4; ++m) _Pragma("unroll") for (int n = 0; n < 2; ++n) { \
        if constexpr (SCW != 0) mfma_f8(acc[ai][bj][m][n], cat8(Bt[n][0], Bt[n][1]), cat8(At[m][0], At[m][1]), SCW * 0x01010101, 0x7f7f7f7f); \
        else { _Pragma("unroll") for (int k = 0; k < 2; ++k) acc[ai][bj][m][n] = __builtin_amdgcn_mfma_f32_16x16x32_bf16(Bt[n][k], At[m][k], acc[ai][bj][m][n], 0, 0, 0); } } __builtin_amdgcn_s_setprio(0); } while (0)
#define PG8_WAIT_V(n) asm volatile("s_waitcnt vmcnt(" #n ")" ::: "memory")
#define PG8_WAIT_L(n) asm volatile("s_waitcnt lgkmcnt(" #n ")" ::: "memory")
#define PG8_BAR __builtin_amdgcn_s_barrier()
#define PG8_SCHED __builtin_amdgcn_sched_barrier(0)
    static_assert(SP2, "gemm_phase_g: SP2 form only");
    Unit cur, nxt; int ui = 0;
    if (!S.next(0, cur)) return;
    f32x4 acc[2][2][4][2];
#pragma unroll
    for (int a = 0; a < 2; ++a)
#pragma unroll
        for (int b = 0; b < 2; ++b)
#pragma unroll
            for (int m = 0; m < 4; ++m)
#pragma unroll
                for (int n = 0; n < 2; ++n) acc[a][b][m][n] = (f32x4){0.f, 0.f, 0.f, 0.f};
    bf16x8 At[4][2], B0[2][2], B1[2][2];
    const char* gA = (const char*)g.A; const char* cB = (const char*)g.Bt + (size_t)cur.pn * tstep;
#define PG8_ROWS(pm_, v0_, v1_) do { _Pragma("unroll") for (int _i = 0; _i < 2; ++_i) { v0_[_i] = (unsigned)(rowmap[(pm_) * BM + RA[_i]] * K + CA[_i]) * 2u; v1_[_i] = (unsigned)(rowmap[(pm_) * BM + HALF + RA[_i]] * K + CA[_i]) * 2u; } } while (0)
    PG8_ROWS(cur.pm, cv0, cv1);
    const unsigned voffA[2] = {0u, 0u}; const char* cA = gA; (void)voffA; (void)cA;
    S.a_ready(cur);
    if constexpr (SP2) {
        PG8_STAGE(PG8_SB(0, 0), cB, voffB); PG8_STAGE(PG8_SB(0, 1), cB + hstep, voffB); PG8_STAGE(PG8_SA(0, 0), gA, cv0); PG8_STAGE(PG8_SA(0, 1), gA, cv1);
        if (wr == 1) PG8_BAR;
        PG8_WAIT_V(2); PG8_BAR;
        PG8_STAGE(PG8_SB(1, 0), cB + kstep, voffB); PG8_STAGE(PG8_SA(1, 0), gA + kstep, cv0); PG8_STAGE(PG8_SB(1, 1), cB + hstep + kstep, voffB);
        PG8_WAIT_V(6); PG8_BAR;
    } else {
        PG8_STAGE(PG8_SB(0, 0), cB, voffB); PG8_STAGE(PG8_SA(0, 0), cA, voffA); PG8_STAGE(PG8_SB(0, 1), cB + hstep, voffB); PG8_STAGE(PG8_SA(0, 1), cA + hstep, voffA);
        if (wr == 1) PG8_BAR;
        PG8_WAIT_V(4); PG8_BAR;
        PG8_STAGE(PG8_SB(1, 0), cB + kstep, voffB); PG8_STAGE(PG8_SA(1, 0), cA + kstep, voffA); PG8_STAGE(PG8_SB(1, 1), cB + hstep + kstep, voffB);
        PG8_WAIT_V(6); PG8_BAR;
    }
    for (;;) {
        const bool has_next = S.next(ui + 1, nxt);
        const char* nB = has_next ? (const char*)g.Bt + (size_t)nxt.pn * tstep : cB;
        if (has_next) PG8_ROWS(nxt.pm, nv0, nv1); else { nv0[0] = cv0[0]; nv0[1] = cv0[1]; nv1[0] = cv1[0]; nv1[1] = cv1[1]; }
        for (int t = 0; t < nt; t += 2) {
            const bool last = (t == nt - 2);
            const char* a1 = gA + (size_t)(t + 1) * kstep;
            const char* a2 = last ? gA : gA + (size_t)(t + 2) * kstep; const char* b2 = last ? nB : cB + (size_t)(t + 2) * kstep;
            unsigned w0[2], w1[2]; w0[0] = last ? nv0[0] : cv0[0]; w0[1] = last ? nv0[1] : cv0[1]; w1[0] = last ? nv1[0] : cv1[0]; w1[1] = last ? nv1[1] : cv1[1];
            const char* a3 = a2 + kstep; const char* b3 = b2 + kstep;
            if (last && has_next) S.a_ready(nxt);
            if constexpr (SP2) {
            PG8_LDB(B0, 0, 0); PG8_LDB(B1, 0, 1); PG8_SCHED; PG8_LDA(At, 0, 0); PG8_STAGE(PG8_SA(1, 1), a1, cv1);
            PG8_WAIT_V(8); PG8_WAIT_L(0); PG8_BAR; PG8_MMA(0, 0, At, B0); PG8_MMA(0, 1, At, B1); PG8_BAR; PG8_SCHED;
            PG8_LDA(At, 0, 1); PG8_STAGE(PG8_SB(0, 0), b2, voffB); PG8_STAGE(PG8_SB(0, 1), b2 + hstep, voffB); PG8_STAGE(PG8_SA(0, 0), a2, w0);
            PG8_WAIT_V(8); PG8_WAIT_L(0); PG8_BAR; PG8_MMA(1, 0, At, B0); PG8_MMA(1, 1, At, B1); PG8_BAR; PG8_SCHED;
            PG8_LDB(B0, 1, 0); PG8_LDB(B1, 1, 1); PG8_SCHED; PG8_LDA(At, 1, 0); PG8_STAGE(PG8_SA(0, 1), a2, w1);
            PG8_WAIT_V(8); PG8_WAIT_L(0); PG8_BAR; PG8_MMA(0, 0, At, B0); PG8_MMA(0, 1, At, B1); PG8_BAR; PG8_SCHED;
            PG8_LDA(At, 1, 1); PG8_STAGE(PG8_SB(1, 0), b3, voffB); PG8_STAGE(PG8_SB(1, 1), b3 + hstep, voffB); PG8_STAGE(PG8_SA(1, 0), a3, w0);
            PG8_WAIT_V(8); PG8_WAIT_L(0); PG8_BAR; PG8_MMA(1, 0, At, B0); PG8_MMA(1, 1, At, B1); PG8_BAR; PG8_SCHED;
            } else {
            PG8_LDB(B0, 0, 0); PG8_SCHED; PG8_LDA(At, 0, 0); PG8_STAGE(PG8_SA(1, 1), a1, cv1);
            PG8_WAIT_L(8); PG8_BAR; PG8_WAIT_L(0); PG8_MMA(0, 0, At, B0); PG8_BAR; PG8_SCHED;
            PG8_LDB(B1, 0, 1); PG8_STAGE(PG8_SB(0, 0), b2, voffB);
            PG8_BAR; PG8_WAIT_L(0); PG8_MMA(0, 1, At, B1); PG8_BAR;
            PG8_LDA(At, 0, 1); PG8_STAGE(PG8_SA(0, 0), a2, voffA);
            PG8_BAR; PG8_WAIT_L(0); PG8_MMA(1, 0, At, B0); PG8_BAR; PG8_SCHED;
            PG8_STAGE(PG8_SB(0, 1), b2 + hstep, voffB);
            PG8_WAIT_V(6); PG8_BAR; PG8_MMA(1, 1, At, B1); PG8_BAR;
            PG8_LDB(B0, 1, 0); PG8_SCHED; PG8_LDA(At, 1, 0); PG8_STAGE(PG8_SA(0, 1), a2, w1);
            PG8_WAIT_L(8); PG8_BAR; PG8_WAIT_L(0); PG8_MMA(0, 0, At, B0); PG8_BAR; PG8_SCHED;
            PG8_LDB(B1, 1, 1); PG8_STAGE(PG8_SB(1, 0), b3, voffB);
            PG8_BAR; PG8_WAIT_L(0); PG8_MMA(0, 1, At, B1); PG8_BAR;
            PG8_LDA(At, 1, 1); PG8_STAGE(PG8_SA(1, 0), a3, voffA);
            PG8_BAR; PG8_WAIT_L(0); PG8_MMA(1, 0, At, B0); PG8_BAR; PG8_SCHED;
            PG8_STAGE(PG8_SB(1, 1), b3 + hstep, voffB);
            PG8_WAIT_V(6); PG8_BAR; PG8_MMA(1, 1, At, B1); PG8_BAR;
            }
        }
        if constexpr (SCW != 0) asm volatile("s_nop 15\n\ts_nop 15" ::: "memory");
        if constexpr (ALIGN_EPI) { if (wr == 0) PG8_BAR; }
        if constexpr (!Epi::AFTER_DRAIN) { E(acc, cur, wr, wc, fr, fq); S.done(cur); }
        if (!has_next) break;
#pragma unroll
        for (int a = 0; a < 2; ++a)
#pragma unroll
            for (int b = 0; b < 2; ++b)
#pragma unroll
                for (int m = 0; m < 4; ++m)
#pragma unroll
                    for (int n = 0; n < 2; ++n) acc[a][b][m][n] = (f32x4){0.f, 0.f, 0.f, 0.f};
        cur = nxt; cB = nB; ++ui; cv0[0] = nv0[0]; cv0[1] = nv0[1]; cv1[0] = nv1[0]; cv1[1] = nv1[1];
        if constexpr (ALIGN_EPI) { if (wr == 1) PG8_BAR; }
    }
    PG8_WAIT_V(0);
    if constexpr (!ALIGN_EPI) { if (wr == 0) PG8_BAR; }
    PG8_BAR;
    if constexpr (Epi::AFTER_DRAIN) { E.fused(acc, cur, wr, wc, fr, fq, lds, wid, lane); S.done(cur); }
#undef PG8_ROWS
#undef PG8_SA
#undef PG8_SB
#undef PG8_STAGE
#undef PG8_LDA
#undef PG8_LDB
#undef PG8_MMA
#undef PG8_WAIT_V
#undef PG8_WAIT_L
#undef PG8_BAR
#undef PG8_SCHED
}
}

#ifndef REP_MASK
#define REP_MASK 0
#endif
#define NREP(k) (1 + ((REP_MASK >> (k)) & 1))

constexpr int NB = 16, SEQ = 2048, D = 1024, NMETA = 16;
constexpr int MX = NB * SEQ;
constexpr int INW = 3344, PW = 3584;
constexpr int GQ = 0, GK = 256, GV = 512, GG = 1024, GKL = 1536;
constexpr int RW0 = 1552;
constexpr int RR = RW0, RK = RW0 + 512, RV = RW0 + 1024, RWL = RW0 + 1536, RAL = RW0 + 1600, RGL = RW0 + 1664;
constexpr int NE = 32, TOPK = 4;
constexpr int NCH = 33;
constexpr float ALPHA = 1.189207115002721f;
constexpr int NWAVES = 8, NTHR = 512;

constexpr size_t MiB = 1u << 20;
constexpr size_t WS_CTL = 0, CTL_ZERO_BYTES = 1 * MiB;
constexpr size_t WS_STATS = 1 * MiB;
constexpr size_t WS_TOPI  = WS_STATS + 256 * 1024;
constexpr size_t WS_GATE  = WS_TOPI + 512 * 1024;
constexpr size_t WS_RANK  = WS_GATE + 512 * 1024;
constexpr size_t WS_TSLOT = WS_RANK + 512 * 1024;
constexpr size_t WS_BON   = WS_TSLOT + 512 * 1024;
constexpr size_t WS_PROJM = WS_BON + 1 * MiB;
constexpr size_t WS_OPSM  = WS_PROJM + 256 * 1024;
constexpr size_t WS_DL    = WS_OPSM + 256 * 1024;
constexpr size_t WS_W2T   = WS_DL + 1 * MiB;
constexpr size_t WS_A2T   = WS_W2T + 64 * 1024;
constexpr size_t WS_G2T   = WS_A2T + 64 * 1024;
constexpr size_t WS_TILEE = WS_G2T + 128 * 1024;
constexpr size_t WS_SLOTTOK = WS_TILEE + 4096;
constexpr size_t WS_WIN   = 8 * MiB;
constexpr size_t WS_WOUT  = 15 * MiB;
static_assert(WS_SLOTTOK + 139264 * 4 <= WS_WIN, "table region");
constexpr size_t WS_A0    = 20 * MiB;
constexpr size_t WS_YMIX  = WS_A0;
constexpr size_t WS_PROJ  = 84 * MiB;
constexpr size_t WS_R1    = 308 * MiB;
constexpr size_t WS_GAM   = 520 * MiB;
constexpr size_t WS_SST   = 524 * MiB;
constexpr size_t WS_GUS   = 692 * MiB;
constexpr size_t WS_H1    = 20 * MiB;
constexpr size_t WS_XS    = 84 * MiB;
constexpr size_t WS_YS    = WS_XS;
constexpr size_t WS_ACT   = 356 * MiB;
constexpr size_t WS_MIXB  = 628 * MiB;
constexpr size_t WS_WUP   = 758 * MiB;
constexpr size_t WS_WDN   = 822 * MiB;
constexpr size_t WS_H1Q   = 854 * MiB;
constexpr size_t WS_END   = 886 * MiB;
constexpr int CW_BAR = 4096;
constexpr int CW_CNT = 16384;
constexpr int CW_QH = 20480;

constexpr int RING_BYTES = 131072;
constexpr int LDS_BYTES = 147456;
constexpr int TAB_OFF = 132096;
constexpr int MISC_OFF = LDS_BYTES - 512;

#define LAS __attribute__((address_space(3)))
typedef unsigned short bf16;
typedef unsigned v4u __attribute__((ext_vector_type(4)));
typedef unsigned v2u __attribute__((ext_vector_type(2)));
typedef float f32x4 __attribute__((ext_vector_type(4)));
typedef short bf16x8 __attribute__((ext_vector_type(8)));
#define LDS_WAIT() asm volatile("s_waitcnt lgkmcnt(0)" ::: "memory")
__device__ __forceinline__ float bflo(unsigned w) { return __uint_as_float(w << 16); }
__device__ __forceinline__ float bfhi(unsigned w) { return __uint_as_float(w & 0xffff0000u); }
typedef float f32x2_t __attribute__((ext_vector_type(2))); typedef __bf16 bf16x2_t __attribute__((ext_vector_type(2)));
__device__ __forceinline__ unsigned pk2(float lo, float hi) { const f32x2_t v = {lo, hi}; const bf16x2_t b = __builtin_convertvector(v, bf16x2_t); return __builtin_bit_cast(unsigned, b); }
__device__ __forceinline__ unsigned f2bf(float f) { return pk2(f, 0.f) & 0xffffu; }
#define CYC() ((unsigned)__builtin_amdgcn_s_getreg((19 << 11) | 29))
__device__ __forceinline__ void lds_barrier() { asm volatile("s_waitcnt lgkmcnt(0)" ::: "memory"); __builtin_amdgcn_s_barrier(); asm volatile("" ::: "memory"); }
__device__ __forceinline__ float shx(float v, int mask, int lane) { return __int_as_float(__builtin_amdgcn_ds_bpermute((lane ^ mask) << 2, __float_as_int(v))); }
template <int CTRL> __device__ __forceinline__ float dppf0(float x) { return __int_as_float(__builtin_amdgcn_update_dpp(0, __float_as_int(x), CTRL, 0xF, 0xF, true)); }
__device__ __forceinline__ float wave_sum(float v, int lane) {
    v += dppf0<0xB1>(v); v += dppf0<0x4E>(v); v += dppf0<0x141>(v); v += dppf0<0x140>(v);
    v += shx(v, 16, lane); v += shx(v, 32, lane);
    return v;
}
__device__ __forceinline__ float softplus_f(float x) { return fmaxf(x, 0.f) + log1pf(expf(-fabsf(x))); }
__device__ __forceinline__ float logsigmoid_f(float x) { return fminf(x, 0.f) - log1pf(expf(-fabsf(x))); }
__device__ __forceinline__ float sigmoid_f(float x) { return 1.f / (1.f + expf(-x)); }
__device__ __forceinline__ float fexp(float x) { return __builtin_amdgcn_exp2f(x * 1.4426950408889634f); }
__device__ __forceinline__ float flog(float x) { return __builtin_amdgcn_logf(x) * 0.6931471805599453f; }
__device__ __forceinline__ float fsigmoid(float x) { return __builtin_amdgcn_rcpf(1.f + fexp(-x)); }
__device__ __forceinline__ float ftanh(float x) { return 2.f * fsigmoid(2.f * x) - 1.f; }
__device__ __forceinline__ float fsoftplus(float x) { return fmaxf(x, 0.f) + flog(1.f + fexp(-fabsf(x))); }
__device__ __forceinline__ float flogsigmoid(float x) { return fminf(x, 0.f) - flog(1.f + fexp(-fabsf(x))); }
template <int CTRL> __device__ __forceinline__ float dppf(float x) { return __int_as_float(__builtin_amdgcn_update_dpp(0, __float_as_int(x), CTRL, 0xF, 0xF, true)); }
__device__ __forceinline__ float red8(float x) {
    x += dppf<0xB1>(x); x += dppf<0x4E>(x); x += dppf<0x141>(x); return x;
}
__device__ __forceinline__ f32x4 mfma16(bf16x8 a, bf16x8 b, f32x4 c) { return __builtin_amdgcn_mfma_f32_16x16x32_bf16(a, b, c, 0, 0, 0); }
__device__ __forceinline__ unsigned ld_agent(const unsigned* p) { return __hip_atomic_load(p, __ATOMIC_RELAXED, __HIP_MEMORY_SCOPE_AGENT); }

#define XB_TMO      128
#define XB_XCNT(j)  (256  + 64 * (j))
#define XB_XSUB(j)  (1280 + 64 * (j))
#define XB_XGEN(j)  (2304 + 64 * (j))
#define XB_TOP      3328
#define XB_TOPGEN   3392
#define XCD_BAR_WORDS 3456
#define XB_SPIN_CAP (1u << 18)
__device__ __forceinline__ unsigned xb_ld(unsigned* p)              { return __hip_atomic_load(p, __ATOMIC_RELAXED, __HIP_MEMORY_SCOPE_AGENT); }
__device__ __forceinline__ unsigned xb_add(unsigned* p, unsigned v) { return __hip_atomic_fetch_add(p, v, __ATOMIC_RELAXED, __HIP_MEMORY_SCOPE_AGENT); }
__device__ __forceinline__ unsigned xb_xcc_id() { return (unsigned)__builtin_amdgcn_s_getreg((3 << 11) | 20) & 0xFu; }
#define XB_SPIN(cond, bar) do { unsigned _sp = 0; while (cond) { __builtin_amdgcn_s_sleep(1); \
    if ((++_sp & 255u) == 0u) { if (xb_ld(&(bar)[XB_TMO])) break; if (_sp > XB_SPIN_CAP) { atomicAdd(&(bar)[XB_TMO], 1u); break; } } } } while (0)
struct XcdBarrier { unsigned* bar; unsigned x; volatile LAS unsigned* st; };
__device__ __forceinline__ XcdBarrier xcd_barrier_post(unsigned* bar, volatile LAS unsigned* st, bool leader) {
    XcdBarrier b; b.bar = bar; b.x = xb_xcc_id(); b.st = st;
    if (leader) (void)xb_add(&bar[XB_XCNT(b.x)], 1u);
    return b;
}
__device__ __forceinline__ void xcd_barrier_complete(unsigned* bar, unsigned x, unsigned& nloc, unsigned& nx) {
    const unsigned G = gridDim.x * gridDim.y * gridDim.z;
    unsigned sum, cnt, mine, sp = 0u;
    for (;;) {
        sum = 0u; cnt = 0u; mine = 0u;
#pragma unroll
        for (unsigned j = 0; j < 16; ++j) { const unsigned c = xb_ld(&bar[XB_XCNT(j)]); sum += c; cnt += (c > 0u) ? 1u : 0u; mine = (j == x) ? c : mine; }
        if (sum == G) break;
        __builtin_amdgcn_s_sleep(1);
        if ((++sp & 255u) == 0u) { if (xb_ld(&bar[XB_TMO])) break; if (sp > XB_SPIN_CAP) { atomicAdd(&bar[XB_TMO], 1u); break; } }
    }
    nloc = mine > 0u ? mine : 1u; nx = cnt > 0u ? cnt : 1u;
}
__device__ __forceinline__ void xcd_barrier(const XcdBarrier& b, bool leader) {
    asm volatile("s_waitcnt vmcnt(0)" ::: "memory");
    __syncthreads();
    if (leader) {
        unsigned* bar = b.bar;
        __builtin_amdgcn_s_waitcnt(0);
        unsigned nloc = b.st[0], nx = b.st[1];
        if (nloc == 0u) { xcd_barrier_complete(bar, b.x, nloc, nx); b.st[0] = nloc; b.st[1] = nx; }
        const unsigned old = xb_add(&bar[XB_XSUB(b.x)], 1u);
        const unsigned gen = old / nloc;
        if (old + 1u == (gen + 1u) * nloc) {
            __builtin_amdgcn_fence(__ATOMIC_RELEASE, "agent");
            asm volatile("s_waitcnt vmcnt(0)" ::: "memory");
            const unsigned og = xb_add(&bar[XB_TOP], 1u);
            const unsigned tg = og / nx;
            if (og + 1u == (tg + 1u) * nx) xb_add(&bar[XB_TOPGEN], 1u);
            else XB_SPIN(xb_ld(&bar[XB_TOPGEN]) == tg, bar);
            __builtin_amdgcn_fence(__ATOMIC_ACQUIRE, "agent");
            xb_add(&bar[XB_XGEN(b.x)], 1u);
            asm volatile("s_waitcnt vmcnt(0)" ::: "memory");
        } else {
            XB_SPIN(xb_ld(&bar[XB_XGEN(b.x)]) == gen, bar);
            __builtin_amdgcn_fence(__ATOMIC_ACQUIRE, "agent");
            asm volatile("s_waitcnt vmcnt(0)" ::: "memory");
        }
    }
    __syncthreads();
}

struct Args { const float* in[30]; float* out; unsigned char* ws; };
enum { I_X = 0, I_META, I_LNIN_G, I_LNIN_B, I_WIN, I_GKW2, I_GKB, I_GNORM, I_MU, I_W0, I_W2, I_A0, I_A2, I_G2, I_KK, I_KA, I_RK, I_RLNG, I_RLNB, I_WOUT,
       I_LN1G, I_LN1B, I_RTW, I_RTB, I_WUP, I_BUP, I_WDN, I_BDN, I_LN2G, I_LN2B };
struct Frame { LAS unsigned char* lds; int tid, lane, wave, blk, G; };
__device__ __forceinline__ int lane_id() { int l; asm volatile("v_mbcnt_lo_u32_b32 %0, -1, 0\n\tv_mbcnt_hi_u32_b32 %0, -1, %0" : "=v"(l)); return l; }
__device__ __forceinline__ Frame mkframe(LAS unsigned char* lds, int wave) { Frame F; F.lds = lds; F.wave = wave; F.lane = lane_id(); F.tid = wave * 64 + F.lane; F.blk = blockIdx.x; F.G = gridDim.x; return F; }

__device__ __forceinline__ void transpose_item(const float* W, int K, int N, int nblk, bf16* WT, LAS float* scr, int item, int lane) {
    const int kb = item / nblk, nb = item - kb * nblk, k0 = 64 * kb, n0 = 32 * nb;
    const int nn = n0 + (lane & 31); const bool ok = nn < N;
#pragma unroll 8
    for (int i = 0; i < 32; ++i) { const int kk = 2 * i + (lane >> 5); scr[kk * 33 + (lane & 31)] = ok ? W[(size_t)(k0 + kk) * N + nn] : 0.f; }
    LDS_WAIT();
    const int c = lane & 7;
#pragma unroll
    for (int j = 0; j < 4; ++j) { const int n = (lane >> 3) + 8 * j; const LAS float* s = scr + (8 * c) * 33 + n;
        v4u o; o.x = pk2(s[0 * 33], s[1 * 33]); o.y = pk2(s[2 * 33], s[3 * 33]); o.z = pk2(s[4 * 33], s[5 * 33]); o.w = pk2(s[6 * 33], s[7 * 33]);
        *(v4u*)(WT + (size_t)(n0 + n) * K + k0 + 8 * c) = o; }
    LDS_WAIT();
}

__device__ __forceinline__ void transpose_item64_f8(const float* W, int K, int N, unsigned char* WT, float scale, LAS float* scr, int item, int lane) {
    const int nblk = N >> 6, kb = item / nblk, nb = item - kb * nblk, k0 = 64 * kb, n0 = 64 * nb;
    const int r4 = lane >> 4, c4 = lane & 15;
    f32x4 v[16];
#pragma unroll
    for (int i = 0; i < 16; ++i) v[i] = *(const f32x4*)(W + (size_t)(k0 + 4 * i + r4) * N + n0 + 4 * c4);
#pragma unroll
    for (int i = 0; i < 16; ++i) *(LAS f32x4*)(scr + (4 * i + r4) * 68 + 4 * c4) = v[i];
    LDS_WAIT();
    unsigned char* orow = WT + (size_t)(n0 + lane) * K + k0;
#pragma unroll
    for (int g = 0; g < 4; ++g) { const LAS float* s = scr + (16 * g) * 68 + lane; v4u o;
#pragma unroll
        for (int q = 0; q < 4; ++q) { int w = __builtin_amdgcn_cvt_pk_fp8_f32(s[(4 * q + 0) * 68] * scale, s[(4 * q + 1) * 68] * scale, 0, false);
            w = __builtin_amdgcn_cvt_pk_fp8_f32(s[(4 * q + 2) * 68] * scale, s[(4 * q + 3) * 68] * scale, w, true); o[q] = (unsigned)w; }
        *(v4u*)(orow + 16 * g) = o; }
    LDS_WAIT();
}
__device__ __forceinline__ void convert_expert_weights(const Args& a, const Frame& F, int qsel) {
    unsigned char* ws = a.ws;
    LAS float* scr = (LAS float*)(F.lds + F.wave * 17408);
    unsigned* QH = (unsigned*)(ws + WS_CTL) + CW_QH + 64 * qsel;
    constexpr int I_UP = 16 * 32, I_DN = 16 * 16, NIT = NE * (I_UP + I_DN);
    for (;;) {
        unsigned base = 0;
        if (F.lane == 0) base = __hip_atomic_fetch_add(QH, 8u, __ATOMIC_RELAXED, __HIP_MEMORY_SCOPE_AGENT);
        base = (unsigned)__builtin_amdgcn_readfirstlane((int)base);
        if (base >= (unsigned)NIT) break;
        for (int it = (int)base; it < (int)base + 8; ++it) {
            if (it < NE * I_UP) { const int e = it / I_UP, r = it - e * I_UP;
                transpose_item64_f8(a.in[I_WUP] + (size_t)e * D * 2048, D, 2048, ws + WS_WUP + (size_t)e * 2048 * D, 64.f, scr, r, F.lane); }
            else { const int it2 = it - NE * I_UP, e = it2 / I_DN, r = it2 - e * I_DN;
                transpose_item64_f8(a.in[I_WDN] + (size_t)e * D * D, D, D, ws + WS_WDN + (size_t)e * D * D, 128.f, scr, r, F.lane); }
        }
    }
}

__device__ __forceinline__ void phase0(const Args& a, const Frame& F) {
    unsigned char* ws = a.ws;
    const int gw = F.blk * NWAVES + F.wave, NGW = F.G * NWAVES;
    for (int cgp = F.blk; cgp < 53; cgp += F.G) {
        LAS float* HM = (LAS float*)F.lds;
        LAS float* PART = (LAS float*)(F.lds + 65536);
        for (int rr = 0; rr < 2; ++rr) {
            const int row = 2 * F.wave + rr; const f32x4* xr = (const f32x4*)(a.in[I_META] + row * D) + F.lane;
            f32x4 v[4]; float s = 0.f;
#pragma unroll
            for (int j = 0; j < 4; ++j) { v[j] = xr[64 * j]; s += (v[j].x + v[j].y) + (v[j].z + v[j].w); }
            const float mean = wave_sum(s, F.lane) * (1.f / D); float s2 = 0.f;
#pragma unroll
            for (int j = 0; j < 4; ++j) { v[j] = v[j] - mean; s2 += (v[j].x * v[j].x + v[j].y * v[j].y) + (v[j].z * v[j].z + v[j].w * v[j].w); }
            const float rstd = 1.f / sqrtf(wave_sum(s2, F.lane) * (1.f / D) + 1e-5f);
#pragma unroll
            for (int j = 0; j < 4; ++j) { const int col = 4 * (F.lane + 64 * j);
                const f32x4 gv = *(const f32x4*)(a.in[I_LNIN_G] + col), bv = *(const f32x4*)(a.in[I_LNIN_B] + col);
                const f32x4 y = v[j] * rstd * gv + bv;
                HM[(col + 0) * 16 + row] = y.x; HM[(col + 1) * 16 + row] = y.y; HM[(col + 2) * 16 + row] = y.z; HM[(col + 3) * 16 + row] = y.w; }
        }
        __syncthreads();
        const int col = cgp * 64 + F.lane; const bool ok = col < INW;
        float acc[16];
#pragma unroll
        for (int r = 0; r < 16; ++r) acc[r] = 0.f;
        const float* wp = a.in[I_WIN];
        for (int k = F.wave * 128; k < F.wave * 128 + 128; ++k) {
            const float wv = ok ? wp[(size_t)k * INW + col] : 0.f;
            const LAS f32x4* h = (const LAS f32x4*)(HM + k * 16);
#pragma unroll
            for (int q = 0; q < 4; ++q) { const f32x4 hv = h[q]; acc[4 * q + 0] += hv.x * wv; acc[4 * q + 1] += hv.y * wv; acc[4 * q + 2] += hv.z * wv; acc[4 * q + 3] += hv.w * wv; }
        }
#pragma unroll
        for (int r = 0; r < 16; ++r) PART[(F.wave * 16 + r) * 64 + F.lane] = acc[r];
        __syncthreads();
        bf16* PROJM = (bf16*)(ws + WS_PROJM);
        for (int o = F.tid; o < 1024; o += NTHR) { const int r = o >> 6, l = o & 63; float s = 0.f;
#pragma unroll
            for (int w = 0; w < 8; ++w) s += PART[(w * 16 + r) * 64 + l];
            PROJM[r * PW + cgp * 64 + l] = (bf16)f2bf(s); }
        if (F.tid < 64) PROJM[NMETA * PW + cgp * 64 + F.tid] = 0;
        __syncthreads();
    }
    {
        LAS float* scr = (LAS float*)(F.lds + F.wave * 16384);
        constexpr int I_IN = 16 * (PW / 32), I_OUT = 16 * 32;
        for (int it = gw; it < I_IN + I_OUT; it += NGW) {
            if (it < I_IN) transpose_item(a.in[I_WIN], D, INW, PW / 32, (bf16*)(ws + WS_WIN), scr, it, F.lane);
            else transpose_item(a.in[I_WOUT], D, D, 32, (bf16*)(ws + WS_WOUT), scr, it - I_IN, F.lane);
        }
    }
    {
        bf16* W2T = (bf16*)(ws + WS_W2T); bf16* A2T = (bf16*)(ws + WS_A2T); bf16* G2T = (bf16*)(ws + WS_G2T);
        for (int i = F.blk * NTHR + F.tid; i < 131072; i += F.G * NTHR) {
            if (i < 32768) { const int n = i >> 6, k = i & 63; W2T[i] = (bf16)f2bf(a.in[I_W2][k * 512 + n]); }
            else if (i < 65536) { const int j = i - 32768, n = j >> 6, k = j & 63; A2T[j] = (bf16)f2bf(a.in[I_A2][k * 512 + n]); }
            else { const int j = i - 65536, n = j >> 7, k = j & 127; G2T[j] = (bf16)f2bf(a.in[I_G2][k * 512 + n]); }
        }
    }
    {
        bf16* A0 = (bf16*)(ws + WS_A0); float* ST = (float*)(ws + WS_STATS);
        for (int m0 = gw; m0 < MX; m0 += 2 * NGW) {
            f32x4 v[2][4];
#pragma unroll
            for (int r = 0; r < 2; ++r) { const f32x4* xr = (const f32x4*)(a.in[I_X] + (size_t)(m0 + r * NGW) * D) + F.lane;
#pragma unroll
                for (int j = 0; j < 4; ++j) v[r][j] = xr[64 * j]; }
#pragma unroll
            for (int r = 0; r < 2; ++r) { const int m = m0 + r * NGW; float s = 0.f;
#pragma unroll
                for (int j = 0; j < 4; ++j) s += (v[r][j].x + v[r][j].y) + (v[r][j].z + v[r][j].w);
                const float mean = wave_sum(s, F.lane) * (1.f / D); float s2 = 0.f;
#pragma unroll
                for (int j = 0; j < 4; ++j) { v[r][j] = v[r][j] - mean; s2 += (v[r][j].x * v[r][j].x + v[r][j].y * v[r][j].y) + (v[r][j].z * v[r][j].z + v[r][j].w * v[r][j].w); }
                const float rstd = __builtin_amdgcn_rsqf(wave_sum(s2, F.lane) * (1.f / D) + 1e-5f);
#pragma unroll
                for (int j = 0; j < 4; ++j) { const int col = 4 * (F.lane + 64 * j);
                    const f32x4 gv = *(const f32x4*)(a.in[I_LNIN_G] + col), bv = *(const f32x4*)(a.in[I_LNIN_B] + col);
                    const f32x4 y = v[r][j] * rstd * gv + bv;
                    v2u o; o.x = pk2(y.x, y.y); o.y = pk2(y.z, y.w);
                    *(v2u*)(A0 + (size_t)m * D + col) = o; }
                if (F.lane == 0) { ST[2 * m] = mean; ST[2 * m + 1] = rstd; } }
        }
    }
    __syncthreads();
    for (int rep_ = 0; rep_ < NREP(14); ++rep_) convert_expert_weights(a, F, rep_);
}

__device__ __forceinline__ const bf16* prow(const bf16* PROJ, const bf16* PROJM, int b, int vp) {
    const bf16* px = PROJ + (size_t)(b * SEQ + (vp >= NMETA ? vp - NMETA : 0)) * PW;
    const bf16* pm = PROJM + (size_t)(vp < 0 ? NMETA : (vp < NMETA ? vp : 0)) * PW;
    return vp >= NMETA ? px : pm;
}
__device__ __forceinline__ f32x4 ldp4(const bf16* PROJ, const bf16* PROJM, int b, int vp, int col) {
    const v2u w = *(const v2u*)(prow(PROJ, PROJM, b, vp) + col);
    return (f32x4){bflo(w.x), bfhi(w.x), bflo(w.y), bfhi(w.y)};
}

constexpr int R1_STRIDE = 49152;
constexpr int TP = 80;
constexpr int L1_SLOT = 64 * TP * 2;
constexpr int L1_LC = 12 * L1_SLOT;
constexpr int L1_XCH = L1_LC + 64 * 65 * 4;
constexpr int L1_LR = 8 * L1_SLOT;
__device__ __forceinline__ v2u pack4(f32x4 v) { v2u o; o.x = pk2(v[0], v[1]); o.y = pk2(v[2], v[3]); return o; }
__device__ __forceinline__ f32x4 tile_mm(const LAS bf16* A, const LAS bf16* Bt, int rt, int ct, int fr, int fq, f32x4 acc) {
#pragma unroll
    for (int ks = 0; ks < 2; ++ks)
        acc = mfma16(*(const LAS bf16x8*)(Bt + (ct * 16 + fr) * TP + ks * 32 + 8 * fq), *(const LAS bf16x8*)(A + (rt * 16 + fr) * TP + ks * 32 + 8 * fq), acc);
    return acc;
}
__device__ __forceinline__ void tile_st(LAS bf16* O, int rt, int ct, int fr, int fq, f32x4 v) { *(LAS v2u*)(O + (rt * 16 + fr) * TP + ct * 16 + 4 * fq) = pack4(v); }
#define L1S(n) ((LAS bf16*)(F.lds + (n) * L1_SLOT))

struct L1Pf { v4u sa[5]; v2u r[2][2], k[2][2], v[2][2]; };
__device__ __forceinline__ void l1_fetch(const Args& a, const Frame& F, int b, int h, int c, L1Pf& pf, bool need_sa) {
    const bf16* PROJ = (const bf16*)(a.ws + WS_PROJ); const bf16* PROJM = (const bf16*)(a.ws + WS_PROJM);
    const int vp0 = (c == 0) ? -48 : NMETA + 64 * (c - 1);
    if (need_sa) { const int cg = F.tid & 31, tr = F.tid >> 5;
#pragma unroll
      for (int i = 0; i < 5; ++i) pf.sa[i] = *(const v4u*)(prow(PROJ, PROJM, b, vp0 + 4 * tr - 1 + i) + RWL + 8 * cg); }
    { const int rt = F.wave & 3, cp = F.wave >> 2, fr = F.lane & 15, fq = F.lane >> 4, vp = vp0 + rt * 16 + fr;
      const bf16* p0 = prow(PROJ, PROJM, b, vp - 1); const bf16* p1 = prow(PROJ, PROJM, b, vp);
#pragma unroll
      for (int cc = 0; cc < 2; ++cc) { const int jc = h * 64 + (2 * cp + cc) * 16 + 4 * fq;
          pf.r[cc][0] = *(const v2u*)(p0 + RR + jc); pf.r[cc][1] = *(const v2u*)(p1 + RR + jc);
          pf.k[cc][0] = *(const v2u*)(p0 + RK + jc); pf.k[cc][1] = *(const v2u*)(p1 + RK + jc);
          pf.v[cc][0] = *(const v2u*)(p0 + RV + jc); pf.v[cc][1] = *(const v2u*)(p1 + RV + jc); } }
}
__device__ __forceinline__ f32x4 unpk4(v2u w) { return (f32x4){bflo(w.x), bfhi(w.x), bflo(w.y), bfhi(w.y)}; }

__device__ __forceinline__ void rwkv_l1_front(const Args& a, const Frame& F, int b, int h, int c, const L1Pf& pf, f32x4 (&rtil)[2], bool newgrp, bf16x8 (&lrf)[8]) {
    unsigned char* ws = a.ws;
    const bf16* W2T = (const bf16*)(ws + WS_W2T); const bf16* A2T = (const bf16*)(ws + WS_A2T); const bf16* G2T = (const bf16*)(ws + WS_G2T);
    const int unit = (b * 8 + h) * NCH + c;
    unsigned char* r1 = ws + WS_R1 + (size_t)unit * R1_STRIDE;
    float* GAM = (float*)(ws + WS_GAM) + (size_t)unit * 64;
    const float* mu = a.in[I_MU];
    const int vp0 = (c == 0) ? -48 : NMETA + 64 * (c - 1);
    constexpr int LRP = 264;
    LAS bf16* LR = (LAS bf16*)(F.lds + L1_LR);
    LAS float* LC = (LAS float*)(F.lds + L1_LC);
    LAS float* XCH = (LAS float*)(F.lds + L1_XCH);
    const int rt = F.wave & 3, cp = F.wave >> 2, fr = F.lane & 15, fq = F.lane >> 4;
    if (newgrp) {
        const int cg = F.tid & 31, tr = F.tid >> 5;
        const f32x4 m0 = *(const f32x4*)(mu + 1536 + 8 * cg), m1 = *(const f32x4*)(mu + 1536 + 8 * cg + 4);
#pragma unroll
        for (int i = 0; i < 4; ++i) {
            const int row = 4 * tr + i;
            const v4u cw = pf.sa[i + 1], pw = pf.sa[i];
            const f32x4 c0 = unpk4((v2u){cw.x, cw.y}), c1 = unpk4((v2u){cw.z, cw.w}), p0 = unpk4((v2u){pw.x, pw.y}), p1 = unpk4((v2u){pw.z, pw.w});
            float v[8];
            v[0] = c0.x + (p0.x - c0.x) * m0.x; v[1] = c0.y + (p0.y - c0.y) * m0.y; v[2] = c0.z + (p0.z - c0.z) * m0.z; v[3] = c0.w + (p0.w - c0.w) * m0.w;
            v[4] = c1.x + (p1.x - c1.x) * m1.x; v[5] = c1.y + (p1.y - c1.y) * m1.y; v[6] = c1.z + (p1.z - c1.z) * m1.z; v[7] = c1.w + (p1.w - c1.w) * m1.w;
#pragma unroll
            for (int q = 0; q < 8; ++q) { if (cg < 8) v[q] = ftanh(v[q]); else if (cg >= 16) v[q] = fsigmoid(v[q]); }
            v4u o; o.x = pk2(v[0], v[1]); o.y = pk2(v[2], v[3]); o.z = pk2(v[4], v[5]); o.w = pk2(v[6], v[7]);
            *(LAS v4u*)(LR + row * LRP + 8 * cg) = o;
        }
    }
    const int t = rt * 16 + fr, vp = vp0 + t;
    const bool valid = vp >= 0;
    if (newgrp) { lds_barrier();
        const LAS bf16* lrow = LR + t * LRP + 8 * fq;
#pragma unroll
        for (int q = 0; q < 8; ++q) lrf[q] = *(const LAS bf16x8*)(lrow + q * 32); }
    float lwv[2][4], asg[2][4], kkr[2][4], kmd[2][4], rrv[2][4], vvv[2][4];
    float ssq = 0.f, bon = 0.f;
    {
#pragma unroll
        for (int cc = 0; cc < 2; ++cc) {
            const int ct = 2 * cp + cc, j = ct * 16 + 4 * fq, jc = h * 64 + j;
            f32x4 mr[2], mk[2], mv[2], w0v[2], a0v[2], kkw[2], kaw[2], rkw[2];
            mr[cc] = *(const f32x4*)(mu + jc); mk[cc] = *(const f32x4*)(mu + 512 + jc); mv[cc] = *(const f32x4*)(mu + 1024 + jc);
            w0v[cc] = *(const f32x4*)(a.in[I_W0] + jc); a0v[cc] = *(const f32x4*)(a.in[I_A0] + jc);
            kkw[cc] = *(const f32x4*)(a.in[I_KK] + jc); kaw[cc] = *(const f32x4*)(a.in[I_KA] + jc); rkw[cc] = *(const f32x4*)(a.in[I_RK] + jc);
            f32x4 aw = {0.f, 0.f, 0.f, 0.f}, aa = aw, ag = aw;
#pragma unroll
            for (int ks = 0; ks < 2; ++ks) {
                aw = mfma16(*(const bf16x8*)(W2T + (size_t)(h * 64 + ct * 16 + fr) * 64 + ks * 32 + 8 * fq), lrf[ks], aw);
                aa = mfma16(*(const bf16x8*)(A2T + (size_t)(h * 64 + ct * 16 + fr) * 64 + ks * 32 + 8 * fq), lrf[2 + ks], aa);
            }
#pragma unroll
            for (int ks = 0; ks < 4; ++ks) ag = mfma16(*(const bf16x8*)(G2T + (size_t)(h * 64 + ct * 16 + fr) * 128 + ks * 32 + 8 * fq), lrf[4 + ks], ag);
            const f32x4 rc = unpk4(pf.r[cc][1]), rp = unpk4(pf.r[cc][0]), kc = unpk4(pf.k[cc][1]), kp = unpk4(pf.k[cc][0]), vc = unpk4(pf.v[cc][1]), vpv = unpk4(pf.v[cc][0]);
            const f32x4 rs = rc + (rp - rc) * mr[cc], ks_ = kc + (kp - kc) * mk[cc], vs = vc + (vpv - vc) * mv[cc];
#pragma unroll
            for (int i = 0; i < 4; ++i) {
                const float u = w0v[cc][i] + aw[i];
                const float wl = -fsoftplus(-u) - 0.5f;
                lwv[cc][i] = valid ? -fexp(wl) : 0.f;
                const float as_ = fsigmoid(a0v[cc][i] + aa[i]);
                asg[cc][i] = as_;
                const float kraw = ks_[i], kk = kraw * kkw[cc][i];
                kkr[cc][i] = kk; ssq += kk * kk;
                const float km = kraw * (1.f + (as_ - 1.f) * kaw[cc][i]);
                kmd[cc][i] = km; rrv[cc][i] = rs[i]; vvv[cc][i] = vs[i];
                bon += rs[i] * km * rkw[cc][i];
            }
            *(v2u*)(r1 + 4 * 8192 + (size_t)(t * 64 + j) * 2) = pack4(ag);
            __builtin_amdgcn_sched_barrier(0);
        }
#pragma unroll
        for (int cc = 0; cc < 2; ++cc)
#pragma unroll
            for (int i = 0; i < 4; ++i) LC[t * 65 + (2 * cp + cc) * 16 + 4 * fq + i] = lwv[cc][i];
        ssq += shx(ssq, 16, F.lane); ssq += shx(ssq, 32, F.lane);
        bon += shx(bon, 16, F.lane); bon += shx(bon, 32, F.lane);
        if (fq == 0) { XCH[(cp * 64 + t) * 2] = ssq; XCH[(cp * 64 + t) * 2 + 1] = bon; }
    }
    lds_barrier();
    const float ssq_t = XCH[t * 2] + XCH[(64 + t) * 2], bon_t = XCH[t * 2 + 1] + XCH[(64 + t) * 2 + 1];
    const float inv = 1.f / fmaxf(sqrtf(ssq_t), 1e-12f);
    {
        LAS float* SEG = XCH + 256;
        const int jj = F.tid & 63, sg = F.tid >> 6;
        float cv[8];
#pragma unroll
        for (int i = 0; i < 8; ++i) cv[i] = LC[(sg * 8 + i) * 65 + jj];
#pragma unroll
        for (int i = 1; i < 8; ++i) cv[i] += cv[i - 1];
        SEG[sg * 64 + jj] = cv[7];
        lds_barrier();
        float pre = 0.f;
#pragma unroll
        for (int s2 = 0; s2 < 7; ++s2) pre += (s2 < sg) ? SEG[s2 * 64 + jj] : 0.f;
#pragma unroll
        for (int i = 0; i < 8; ++i) LC[(sg * 8 + i) * 65 + jj] = cv[i] + pre;
    }
    lds_barrier();
    {
#pragma unroll
        for (int cc = 0; cc < 2; ++cc) {
            const int j = (2 * cp + cc) * 16 + 4 * fq;
            f32x4 At, Bt, Kt, Bh, Kh, bvv;
#pragma unroll
            for (int i = 0; i < 4; ++i) {
                const float Lc = LC[t * 65 + j + i], LcC = LC[63 * 65 + j + i];
                const float kn = kkr[cc][i] * inv, av = -kn, bv = kn * asg[cc][i], km = kmd[cc][i];
                const float eA = fexp(Lc - lwv[cc][i]), eR = fexp(Lc), eB = fexp(-Lc), eH = fexp(LcC - Lc);
                At[i] = av * eA; rtil[cc][i] = rrv[cc][i] * eR; Bt[i] = bv * eB; Kt[i] = km * eB; Bh[i] = bv * eH; Kh[i] = km * eH;
                bvv[i] = bon_t * vvv[cc][i];
                if (t == 63) GAM[j + i] = fexp(LcC);
            }
            *(LAS v2u*)(L1S(0) + t * TP + j) = pack4(Bt); *(LAS v2u*)(L1S(1) + t * TP + j) = pack4(Kt);
            *(LAS v2u*)(L1S(2) + t * TP + j) = pack4(At); *(LAS v2u*)(L1S(3) + t * TP + j) = pack4(rtil[cc]);
#pragma unroll
            for (int i = 0; i < 4; ++i) {
                L1S(4)[(j + i) * TP + t] = (bf16)f2bf(At[i]); L1S(5)[(j + i) * TP + t] = (bf16)f2bf(Bh[i]);
                L1S(6)[(j + i) * TP + t] = (bf16)f2bf(Kh[i]); L1S(7)[(j + i) * TP + t] = (bf16)f2bf(vvv[cc][i]);
            }
            *(v2u*)(r1 + 5 * 8192 + (size_t)(t * 64 + j) * 2) = pack4(bvv);
        }
    }
    lds_barrier();
}
__device__ __forceinline__ void rwkv_l1_back(const Args& a, const Frame& F, int b, int h, int c, const f32x4 (&rtil)[2]) {
    unsigned char* r1 = a.ws + WS_R1 + (size_t)((b * 8 + h) * NCH + c) * R1_STRIDE;
    const int rt = F.wave & 3, cp = F.wave >> 2, fr = F.lane & 15, fq = F.lane >> 4;
    f32x4 Pt[2];
    const int mrow = rt * 16 + fr;
    const f32x4 z = {0.f, 0.f, 0.f, 0.f};
    {
        f32x4 Lv[2], Nv[2], Mv[2], Bv[2], Kv[2];
#pragma unroll
        for (int cc = 0; cc < 2; ++cc) { const int ct = 2 * cp + cc;
            Lv[cc] = tile_mm(L1S(2), L1S(0), rt, ct, fr, fq, z); Nv[cc] = tile_mm(L1S(0), L1S(2), rt, ct, fr, fq, z); Mv[cc] = tile_mm(L1S(2), L1S(1), rt, ct, fr, fq, z);
            Bv[cc] = tile_mm(L1S(3), L1S(0), rt, ct, fr, fq, z); Kv[cc] = tile_mm(L1S(3), L1S(1), rt, ct, fr, fq, z); }
#pragma unroll
        for (int cc = 0; cc < 2; ++cc) { const int ct = 2 * cp + cc, n0 = ct * 16 + 4 * fq;
#pragma unroll
            for (int i = 0; i < 4; ++i) { const int n = n0 + i;
                if (!(n < mrow)) { Lv[cc][i] = 0.f; Mv[cc][i] = 0.f; } if (!(mrow < n)) Nv[cc][i] = 0.f; if (!(n <= mrow)) { Bv[cc][i] = 0.f; Kv[cc][i] = 0.f; }
                Pt[cc][i] = Lv[cc][i] + ((n == mrow) ? 1.f : 0.f); }
            tile_st(L1S(8), rt, ct, fr, fq, Lv[cc]); tile_st(L1S(9), rt, ct, fr, fq, Nv[cc]); tile_st(L1S(10), rt, ct, fr, fq, Mv[cc]);
            tile_st(L1S(11), rt, ct, fr, fq, Bv[cc]); tile_st(L1S(12), rt, ct, fr, fq, Kv[cc]); }
    }
    lds_barrier();
    f32x4 Xv[2];
#pragma unroll
    for (int st = 1; st <= 6; ++st) {
        LAS bf16* Xl = (st & 1) ? L1S(8) : L1S(0); LAS bf16* Xn = (st & 1) ? L1S(9) : L1S(1);
        LAS bf16* Yl = (st & 1) ? L1S(0) : L1S(8); LAS bf16* Yn = (st & 1) ? L1S(1) : L1S(9);
        LAS bf16* Pr = (st & 1) ? L1S(2) : L1S(3); LAS bf16* Pw = (st & 1) ? L1S(3) : L1S(2);
        f32x4 l2[2], n2[2];
#pragma unroll
        for (int cc = 0; cc < 2; ++cc) { const int ct = 2 * cp + cc;
            if (st <= 5) { l2[cc] = tile_mm(Xl, Xn, rt, ct, fr, fq, z); n2[cc] = tile_mm(Xn, Xl, rt, ct, fr, fq, z); }
            if (st >= 2) Pt[cc] = tile_mm(Pr, Xn, rt, ct, fr, fq, Pt[cc]);
            if (st == 1) Xv[cc] = tile_mm(L1S(7), L1S(10), rt, ct, fr, fq, z); }
#pragma unroll
        for (int cc = 0; cc < 2; ++cc) { const int ct = 2 * cp + cc;
            if (st <= 5) { tile_st(Yl, rt, ct, fr, fq, l2[cc]); tile_st(Yn, rt, ct, fr, fq, n2[cc]); }
            tile_st(Pw, rt, ct, fr, fq, Pt[cc]); }
        if (st == 1) { lds_barrier();
#pragma unroll
            for (int cc = 0; cc < 2; ++cc) tile_st(L1S(10), rt, 2 * cp + cc, fr, fq, Xv[cc]); }
        lds_barrier();
    }
    {
        f32x4 u[2], w[2];
#pragma unroll
        for (int cc = 0; cc < 2; ++cc) { const int ct = 2 * cp + cc; u[cc] = tile_mm(L1S(10), L1S(2), rt, ct, fr, fq, z); w[cc] = tile_mm(L1S(4), L1S(2), rt, ct, fr, fq, z); }
#pragma unroll
        for (int cc = 0; cc < 2; ++cc) { const int ct = 2 * cp + cc; tile_st(L1S(8), rt, ct, fr, fq, u[cc]); tile_st(L1S(9), rt, ct, fr, fq, w[cc]); }
    }
    lds_barrier();
    {
#pragma unroll
        for (int cc = 0; cc < 2; ++cc) { const int ct = 2 * cp + cc; const size_t eo = (size_t)(mrow * 64 + ct * 16 + 4 * fq) * 2;
            const f32x4 gp = tile_mm(L1S(5), L1S(9), rt, ct, fr, fq, z);
            const f32x4 hh = tile_mm(L1S(7), L1S(6), rt, ct, fr, fq, tile_mm(L1S(8), L1S(5), rt, ct, fr, fq, z));
            const f32x4 rh = tile_mm(L1S(11), L1S(9), rt, ct, fr, fq, rtil[cc]);
            const f32x4 yl = tile_mm(L1S(12), L1S(7), rt, ct, fr, fq, tile_mm(L1S(11), L1S(8), rt, ct, fr, fq, z));
            *(v2u*)(r1 + 0 * 8192 + eo) = pack4(gp); *(v2u*)(r1 + 1 * 8192 + eo) = pack4(hh);
            *(v2u*)(r1 + 2 * 8192 + eo) = pack4(rh); *(v2u*)(r1 + 3 * 8192 + eo) = pack4(yl); }
    }
    lds_barrier();
}

constexpr int BCP = 65;
__device__ __forceinline__ void gla_bc(const Args& a, const Frame& F, int b, int h, int vp0, int ntok) {
    const bf16* PROJ = (const bf16*)(a.ws + WS_PROJ); const bf16* PROJM = (const bf16*)(a.ws + WS_PROJM);
    LAS float* GKLs = (LAS float*)F.lds; LAS float* BC = (LAS float*)(F.lds + 4096);
    if (F.tid < 256) { const int t = F.tid >> 2, q = F.tid & 3;
        const f32x4 v = ldp4(PROJ, PROJM, b, (t < ntok) ? vp0 + t : -1, GKL + 4 * q);
        *(LAS f32x4*)(GKLs + t * 16 + 4 * q) = v; }
    lds_barrier();
    {
        const int d = F.tid & 63, tg = F.tid >> 6;
        float wc[16];
#pragma unroll
        for (int r = 0; r < 16; ++r) wc[r] = a.in[I_GKW2][r * 256 + h * 64 + d];
        const float gb = a.in[I_GKB][h * 64 + d];
        float lgv[8];
#pragma unroll
        for (int i = 0; i < 8; ++i) { const int t = tg * 8 + i; float z = gb;
            const LAS f32x4* g4 = (const LAS f32x4*)(GKLs + t * 16);
#pragma unroll
            for (int q = 0; q < 4; ++q) { const f32x4 gv = g4[q]; z += gv.x * wc[4 * q] + gv.y * wc[4 * q + 1] + gv.z * wc[4 * q + 2] + gv.w * wc[4 * q + 3]; }
            lgv[i] = (t < ntok) ? flogsigmoid(z) * (1.f / 16.f) : 0.f; }
        LAS float* SEG = (LAS float*)(F.lds + 20736);
#pragma unroll
        for (int i = 1; i < 8; ++i) lgv[i] += lgv[i - 1];
        SEG[tg * 64 + d] = lgv[7];
        lds_barrier();
        float pre = 0.f;
#pragma unroll
        for (int s2 = 0; s2 < 7; ++s2) pre += (s2 < tg) ? SEG[s2 * 64 + d] : 0.f;
#pragma unroll
        for (int i = 0; i < 8; ++i) BC[(tg * 8 + i) * BCP + d] = lgv[i] + pre;
    }
    lds_barrier();
}

__device__ __forceinline__ void gla_g1_unit(const Args& a, const Frame& F, int b, int h, int c) {
    const bf16* PROJ = (const bf16*)(a.ws + WS_PROJ); const bf16* PROJM = (const bf16*)(a.ws + WS_PROJM);
    float* GUS = (float*)(a.ws + WS_GUS); float* DL = (float*)(a.ws + WS_DL);
    const int ntok = (c == 0) ? NMETA : 64, vp0 = (c == 0) ? 0 : NMETA + 64 * (c - 1);
    gla_bc(a, F, b, h, vp0, ntok);
    LAS float* BC = (LAS float*)(F.lds + 4096);
    LAS bf16* KT = (LAS bf16*)(F.lds + 24576);
    LAS bf16* VT = (LAS bf16*)(F.lds + 24576 + 64 * TP * 2);
    {
        const int t = F.tid >> 3, q = F.tid & 7;
        const float* bl = nullptr; (void)bl;
#pragma unroll
        for (int half = 0; half < 2; ++half) {
            const int d0 = 8 * q + 4 * half;
            const f32x4 kv = ldp4(PROJ, PROJM, b, (t < ntok) ? vp0 + t : -1, GK + h * 64 + d0);
#pragma unroll
            for (int i = 0; i < 4; ++i) { const int d = d0 + i; const float e = (t < ntok) ? fexp(BC[(ntok - 1) * BCP + d] - BC[t * BCP + d]) : 0.f;
                KT[d * TP + t] = (bf16)f2bf(kv[i] * e); }
        }
#pragma unroll
        for (int qq = 0; qq < 4; ++qq) {
            const int e0 = 16 * q + 4 * qq;
            const f32x4 vv = ldp4(PROJ, PROJM, b, (t < ntok) ? vp0 + t : -1, GV + h * 128 + e0);
#pragma unroll
            for (int i = 0; i < 4; ++i) VT[(e0 + i) * TP + t] = (bf16)f2bf(vv[i]);
        }
    }
    lds_barrier();
    {
        const int rt = F.wave & 3, ch = F.wave >> 2, fr = F.lane & 15, fq = F.lane >> 4;
        float* up = GUS + ((size_t)((b * 4 + h) * NCH + c) * 64 + rt * 16 + fr) * 128;
#pragma unroll
        for (int cc = 0; cc < 4; ++cc) { const int ct = ch * 4 + cc;
            f32x4 acc = {0.f, 0.f, 0.f, 0.f};
#pragma unroll
            for (int ks = 0; ks < 2; ++ks)
                acc = mfma16(*(const LAS bf16x8*)(VT + (ct * 16 + fr) * TP + ks * 32 + 8 * fq), *(const LAS bf16x8*)(KT + (rt * 16 + fr) * TP + ks * 32 + 8 * fq), acc);
            *(f32x4*)(up + ct * 16 + 4 * fq) = acc; }
        if (F.tid < 64) DL[(size_t)((b * 4 + h) * NCH + c) * 64 + F.tid] = fexp(BC[(ntok - 1) * BCP + F.tid]);
    }
    lds_barrier();
}

__device__ __forceinline__ void phase2(const Args& a, const Frame& F) {
    {
        constexpr int NU = NB * 8 * NCH;
        const int u0 = (int)((long)F.blk * NU / F.G), u1 = (int)((long)(F.blk + 1) * NU / F.G);
        L1Pf pf;
        bf16x8 lrf[8];
        if (u0 < u1) l1_fetch(a, F, (u0 >> 3) / NCH, u0 & 7, (u0 >> 3) % NCH, pf, true);
        unsigned long long tf_ = 0, tb_ = 0;
        for (int u = u0; u < u1; ++u) {
            const int h = u & 7, c = (u >> 3) % NCH, b = (u >> 3) / NCH; f32x4 rtil[2];
            const bool newgrp = (u == u0) || (h == 0);
            { const Frame F1 = mkframe(F.lds, F.wave); rwkv_l1_front(a, F1, b, h, c, pf, rtil, newgrp, lrf); }
            { const Frame F2 = mkframe(F.lds, F.wave);
              if (u + 1 < u1) l1_fetch(a, F2, ((u + 1) >> 3) / NCH, (u + 1) & 7, ((u + 1) >> 3) % NCH, pf, ((u + 1) & 7) == 0);
              rwkv_l1_back(a, F2, b, h, c, rtil); }
        }
        if ((REP_MASK >> 16) != 0) {
            const unsigned long long dt_ = ((REP_MASK >> 16) == 1) ? tf_ : tb_, s0_ = __builtin_amdgcn_s_memrealtime();
            while (__builtin_amdgcn_s_memrealtime() - s0_ < dt_) __builtin_amdgcn_s_sleep(8);
        }
    }
    for (int rep_ = 0; rep_ < NREP(12); ++rep_)
    for (int u = F.blk; u < NB * 4 * 32; u += F.G) { const int c = u & 31, bh = u >> 5; const Frame F1 = mkframe(F.lds, F.wave); gla_g1_unit(a, F1, bh >> 2, bh & 3, c); }
}

struct L2S { bf16x8 fg[4]; v2u hq[2]; f32x4 gm[2]; };
__device__ __forceinline__ void l2s_fetch(L2S& r, const unsigned char* hp, const unsigned char* gp, const float* gam) {
#pragma unroll
    for (int cc = 0; cc < 2; ++cc) { r.fg[2 * cc] = *(const bf16x8*)(gp + cc * 2048); r.fg[2 * cc + 1] = *(const bf16x8*)(gp + cc * 2048 + 64);
        r.hq[cc] = *(const v2u*)(hp + cc * 32); r.gm[cc] = *(const f32x4*)(gam + cc * 16); }
}
__device__ __forceinline__ void l2s_step(const L2S& r, const LAS bf16* Sc, LAS bf16* Sn, f32x4 (&Sm)[2], int row, int col0, int fq, bf16* gout, int tid) {
    {
        const int r_ = tid >> 3, c8 = tid & 7;
        *(v4u*)(gout + r_ * 64 + 8 * c8) = *(const LAS v4u*)(Sc + r_ * TP + 8 * c8);
    }
    const bf16x8 af0 = *(const LAS bf16x8*)(Sc + row * TP + 8 * fq), af1 = *(const LAS bf16x8*)(Sc + row * TP + 32 + 8 * fq);
#pragma unroll
    for (int cc = 0; cc < 2; ++cc) {
        f32x4 acc = {bflo(r.hq[cc].x), bfhi(r.hq[cc].x), bflo(r.hq[cc].y), bfhi(r.hq[cc].y)};
        acc = mfma16(r.fg[2 * cc], af0, acc);
        acc = mfma16(r.fg[2 * cc + 1], af1, acc);
        Sm[cc] = Sm[cc] * r.gm[cc] + acc; }
#pragma unroll
    for (int cc = 0; cc < 2; ++cc) *(LAS v2u*)(Sn + row * TP + col0 + cc * 16) = pack4(Sm[cc]);
}
__device__ __forceinline__ void rwkv_l2_unit(const Args& a, const Frame& F, int bh) {
    unsigned char* ws = a.ws;
    LAS bf16* Sb0 = (LAS bf16*)F.lds; LAS bf16* Sb1 = Sb0 + 64 * TP;
    const int fr = F.lane & 15, fq = F.lane >> 4, rt = F.wave & 3, cp = F.wave >> 2;
    const int row = rt * 16 + fr, col0 = cp * 32 + 4 * fq;
    const unsigned char* hpb = ws + WS_R1 + (size_t)bh * NCH * R1_STRIDE + 8192 + (size_t)(row * 64 + col0) * 2;
    const unsigned char* gpb = ws + WS_R1 + (size_t)bh * NCH * R1_STRIDE + (size_t)((cp * 32 + fr) * 64 + 8 * fq) * 2;
    const float* gamb = (const float*)(ws + WS_GAM) + (size_t)bh * NCH * 64 + col0;
    bf16* sst = (bf16*)(ws + WS_SST) + (size_t)bh * NCH * 4096;
    f32x4 Sm[2];
#pragma unroll
    for (int cc = 0; cc < 2; ++cc) { Sm[cc] = (f32x4){0.f, 0.f, 0.f, 0.f}; *(LAS v2u*)(Sb0 + row * TP + col0 + cc * 16) = (v2u){0u, 0u}; }
    L2S r0, r1, r2, r3;
#define L2F(rr, cn) l2s_fetch(rr, hpb + (size_t)(cn) * R1_STRIDE, gpb + (size_t)(cn) * R1_STRIDE, gamb + (size_t)(cn) * 64)
    L2F(r0, 0); L2F(r1, 1); L2F(r2, 2);
    lds_barrier();
#pragma nounroll
    for (int c = 0; c < NCH - 1; c += 4) {
        L2F(r3, c + 3);
        l2s_step(r0, Sb0, Sb1, Sm, row, col0, fq, sst + (size_t)c * 4096, F.tid); lds_barrier();
        if (c + 4 < NCH - 1) L2F(r0, c + 4);
        l2s_step(r1, Sb1, Sb0, Sm, row, col0, fq, sst + (size_t)(c + 1) * 4096, F.tid); lds_barrier();
        if (c + 5 < NCH - 1) L2F(r1, c + 5);
        l2s_step(r2, Sb0, Sb1, Sm, row, col0, fq, sst + (size_t)(c + 2) * 4096, F.tid); lds_barrier();
        if (c + 6 < NCH - 1) L2F(r2, c + 6);
        l2s_step(r3, Sb1, Sb0, Sm, row, col0, fq, sst + (size_t)(c + 3) * 4096, F.tid); lds_barrier();
    }
#undef L2F
    { const int r_ = F.tid >> 3, c8 = F.tid & 7;
      *(v4u*)(sst + (size_t)(NCH - 1) * 4096 + r_ * 64 + 8 * c8) = *(const LAS v4u*)(Sb0 + r_ * TP + 8 * c8); }
    lds_barrier();
}
__device__ __forceinline__ void rwkv_y_task(const Args& a, const Frame& F, int task) {
    unsigned char* ws = a.ws;
    const int rt = task & 3, c = 1 + ((task >> 2) & 31), bh = task >> 7, b = bh >> 3, h = bh & 7;
    const int fr = F.lane & 15, fq = F.lane >> 4, row = rt * 16 + fr;
    const unsigned char* r1 = ws + WS_R1 + (size_t)(bh * NCH + c) * R1_STRIDE + (size_t)(row * 64 + 4 * fq) * 2;
    const bf16* Sg = (const bf16*)(ws + WS_SST) + (size_t)(bh * NCH + c) * 4096 + fr * 64 + 8 * fq;
    const bf16x8 fa0 = *(const bf16x8*)(r1 + 2 * 8192 + 8 * fq), fa1 = *(const bf16x8*)(r1 + 2 * 8192 + 64 + 8 * fq);
    bf16x8 sf[8]; v2u q0[4], q1[4], q2[4];
#pragma unroll
    for (int ct = 0; ct < 4; ++ct) { sf[2 * ct] = *(const bf16x8*)(Sg + ct * 1024); sf[2 * ct + 1] = *(const bf16x8*)(Sg + ct * 1024 + 32);
        q0[ct] = *(const v2u*)(r1 + 3 * 8192 + ct * 32); q1[ct] = *(const v2u*)(r1 + 4 * 8192 + ct * 32); q2[ct] = *(const v2u*)(r1 + 5 * 8192 + ct * 32); }
    f32x4 y[4]; float s = 0.f;
#pragma unroll
    for (int ct = 0; ct < 4; ++ct) {
        f32x4 acc = {bflo(q0[ct].x), bfhi(q0[ct].x), bflo(q0[ct].y), bfhi(q0[ct].y)};
        acc = mfma16(sf[2 * ct], fa0, acc); acc = mfma16(sf[2 * ct + 1], fa1, acc);
        y[ct] = acc; s += (acc[0] + acc[1]) + (acc[2] + acc[3]); }
    s += shx(s, 16, F.lane); s += shx(s, 32, F.lane);
    const float mean = s * (1.f / 64.f); float q = 0.f;
#pragma unroll
    for (int ct = 0; ct < 4; ++ct) { y[ct] = y[ct] - mean; q += (y[ct][0] * y[ct][0] + y[ct][1] * y[ct][1]) + (y[ct][2] * y[ct][2] + y[ct][3] * y[ct][3]); }
    q += shx(q, 16, F.lane); q += shx(q, 32, F.lane);
    const float rstd = __builtin_amdgcn_rsqf(q * (1.f / 64.f) + 64e-5f);
    LAS bf16* ost = (LAS bf16*)(F.lds + 102400 + F.wave * 2304);
#pragma unroll
    for (int ct = 0; ct < 4; ++ct) { const int i0 = h * 64 + ct * 16 + 4 * fq;
        const f32x4 lg = *(const f32x4*)(a.in[I_RLNG] + i0), lb = *(const f32x4*)(a.in[I_RLNB] + i0);
        const f32x4 g = {bflo(q1[ct].x), bfhi(q1[ct].x), bflo(q1[ct].y), bfhi(q1[ct].y)}, bv = {bflo(q2[ct].x), bfhi(q2[ct].x), bflo(q2[ct].y), bfhi(q2[ct].y)};
        const f32x4 o = (y[ct] * rstd * lg + lb + bv) * g;
        *(LAS v2u*)(ost + fr * 72 + ct * 16 + 4 * fq) = pack4(o); }
    asm volatile("s_waitcnt lgkmcnt(0)" ::: "memory");
    bf16* yout = (bf16*)(ws + WS_YMIX) + ((size_t)b * SEQ + 64 * (c - 1) + rt * 16) * D + 512 + h * 64;
#pragma unroll
    for (int hh = 0; hh < 2; ++hh) { const int tr = (F.lane >> 3) + 8 * hh, c8 = F.lane & 7;
        *(v4u*)(yout + (size_t)tr * D + 8 * c8) = *(const LAS v4u*)(ost + tr * 72 + 8 * c8); }
    asm volatile("s_waitcnt lgkmcnt(0)" ::: "memory");
}
__device__ __forceinline__ void gla_scan_unit(const Args& a, const Frame& F, int j) {
    float* GUS = (float*)(a.ws + WS_GUS); const float* DL = (const float*)(a.ws + WS_DL);
    const int bh = j >> 1, half = j & 1;
    const int d = 32 * half + (F.tid >> 4), e0 = (F.tid & 15) * 8;
    float* base = GUS + (size_t)bh * NCH * 8192 + d * 128 + e0;
    const float* dl = DL + (size_t)bh * NCH * 64 + d;
    f32x4 s0 = {0.f, 0.f, 0.f, 0.f}, s1 = s0;
    f32x4 ua[4], ub[4]; float dq[4];
#pragma unroll
    for (int q = 0; q < 3; ++q) { ua[q] = *(const f32x4*)(base + (size_t)q * 8192); ub[q] = *(const f32x4*)(base + (size_t)q * 8192 + 4); dq[q] = dl[q * 64]; }
#pragma unroll 4
    for (int c = 0; c < NCH - 1; ++c) {
        const int cn = (c + 3 < NCH - 1) ? c + 3 : NCH - 2;
        ua[(c + 3) & 3] = *(const f32x4*)(base + (size_t)cn * 8192); ub[(c + 3) & 3] = *(const f32x4*)(base + (size_t)cn * 8192 + 4); dq[(c + 3) & 3] = dl[cn * 64];
        *(f32x4*)(base + (size_t)c * 8192) = s0; *(f32x4*)(base + (size_t)c * 8192 + 4) = s1;
        s0 = s0 * dq[c & 3] + ua[c & 3]; s1 = s1 * dq[c & 3] + ub[c & 3];
    }
    *(f32x4*)(base + (size_t)(NCH - 1) * 8192) = s0; *(f32x4*)(base + (size_t)(NCH - 1) * 8192 + 4) = s1;
}
__device__ __forceinline__ void phase3(const Args& a, const Frame& F) {
    constexpr int PSEL = (REP_MASK >> 20) & 7;
    const unsigned long long t0_ = PSEL ? __builtin_amdgcn_s_memrealtime() : 0ull;
    for (int u = F.blk; u < 256; u += F.G) {
        if (u < 128) { for (int rep_ = 0; rep_ < NREP(3); ++rep_) rwkv_l2_unit(a, F, u); }
        else gla_scan_unit(a, F, u - 128);
    }
    if (PSEL) { const unsigned long long t1_ = __builtin_amdgcn_s_memrealtime();
        unsigned long long dt_ = 0;
        if (PSEL == 1 && F.blk < 128) dt_ = t1_ - t0_;
        if (PSEL == 2 && F.blk >= 128) dt_ = t1_ - t0_;
        while (__builtin_amdgcn_s_memrealtime() - t1_ < dt_) __builtin_amdgcn_s_sleep(8); }
}

__device__ __forceinline__ void gla_g3_unit(const Args& a, const Frame& F, int b, int h, int c) {
    const bf16* PROJ = (const bf16*)(a.ws + WS_PROJ); const bf16* PROJM = (const bf16*)(a.ws + WS_PROJM);
    const float* GUS = (const float*)(a.ws + WS_GUS); bf16* YMIX = (bf16*)(a.ws + WS_YMIX);
    const int vp0 = NMETA + 64 * (c - 1);
    gla_bc(a, F, b, h, vp0, 64);
    LAS float* BC = (LAS float*)(F.lds + 4096);
    LAS bf16* QT = (LAS bf16*)(F.lds + 24576);
    LAS bf16* KL = QT + 64 * TP;
    LAS bf16* AT = KL + 64 * TP;
    LAS bf16* VT = AT + 64 * TP;
    LAS bf16* ST = VT + 128 * TP;
    LAS float* RS = (LAS float*)(ST + 128 * TP);
    {
        const int t = F.tid >> 3, q = F.tid & 7;
        const f32x4 q0 = ldp4(PROJ, PROJM, b, vp0 + t, GQ + h * 64 + 8 * q), q1 = ldp4(PROJ, PROJM, b, vp0 + t, GQ + h * 64 + 8 * q + 4);
        const f32x4 k0 = ldp4(PROJ, PROJM, b, vp0 + t, GK + h * 64 + 8 * q), k1 = ldp4(PROJ, PROJM, b, vp0 + t, GK + h * 64 + 8 * q + 4);
        float qv[8] = {q0.x, q0.y, q0.z, q0.w, q1.x, q1.y, q1.z, q1.w}, kv[8] = {k0.x, k0.y, k0.z, k0.w, k1.x, k1.y, k1.z, k1.w};
#pragma unroll
        for (int i = 0; i < 8; ++i) { const float bcv = BC[t * BCP + 8 * q + i]; qv[i] *= fexp(bcv) * 0.125f; kv[i] *= fexp(-bcv); }
        v4u o; o.x = pk2(qv[0], qv[1]); o.y = pk2(qv[2], qv[3]); o.z = pk2(qv[4], qv[5]); o.w = pk2(qv[6], qv[7]);
        *(LAS v4u*)(QT + t * TP + 8 * q) = o;
        o.x = pk2(kv[0], kv[1]); o.y = pk2(kv[2], kv[3]); o.z = pk2(kv[4], kv[5]); o.w = pk2(kv[6], kv[7]);
        *(LAS v4u*)(KL + t * TP + 8 * q) = o;
#pragma unroll
        for (int qq = 0; qq < 4; ++qq) {
            const int e0 = 16 * q + 4 * qq;
            const f32x4 vv = ldp4(PROJ, PROJM, b, vp0 + t, GV + h * 128 + e0);
#pragma unroll
            for (int i = 0; i < 4; ++i) VT[(e0 + i) * TP + t] = (bf16)f2bf(vv[i]);
            const f32x4 sv = *(const f32x4*)(GUS + ((size_t)((b * 4 + h) * NCH + c) * 64 + t) * 128 + e0);
#pragma unroll
            for (int i = 0; i < 4; ++i) ST[(e0 + i) * TP + t] = (bf16)f2bf(sv[i]);
        }
    }
    lds_barrier();
    const int rt = F.wave & 3, wh = F.wave >> 2, fr = F.lane & 15, fq = F.lane >> 4;
    const int trow = rt * 16 + fr;
    {
        f32x4 av[2];
#pragma unroll
        for (int cc = 0; cc < 2; ++cc) { const int ct = 2 * wh + cc;
            f32x4 acc = {0.f, 0.f, 0.f, 0.f};
#pragma unroll
            for (int ks = 0; ks < 2; ++ks)
                acc = mfma16(*(const LAS bf16x8*)(KL + (ct * 16 + fr) * TP + ks * 32 + 8 * fq), *(const LAS bf16x8*)(QT + trow * TP + ks * 32 + 8 * fq), acc);
            const int s0 = ct * 16 + 4 * fq;
#pragma unroll
            for (int i = 0; i < 4; ++i) if (s0 + i > trow) acc[i] = 0.f;
            av[cc] = acc; }
#pragma unroll
        for (int cc = 0; cc < 2; ++cc) *(LAS v2u*)(AT + trow * TP + (2 * wh + cc) * 16 + 4 * fq) = pack4(av[cc]);
    }
    lds_barrier();
    f32x4 oacc[4]; float ssq = 0.f;
#pragma unroll
    for (int cc = 0; cc < 4; ++cc) { const int ct = wh * 4 + cc;
        f32x4 acc = {0.f, 0.f, 0.f, 0.f};
#pragma unroll
        for (int ks = 0; ks < 2; ++ks) {
            acc = mfma16(*(const LAS bf16x8*)(VT + (ct * 16 + fr) * TP + ks * 32 + 8 * fq), *(const LAS bf16x8*)(AT + trow * TP + ks * 32 + 8 * fq), acc);
            acc = mfma16(*(const LAS bf16x8*)(ST + (ct * 16 + fr) * TP + ks * 32 + 8 * fq), *(const LAS bf16x8*)(QT + trow * TP + ks * 32 + 8 * fq), acc);
        }
        oacc[cc] = acc; ssq += (acc[0] * acc[0] + acc[1] * acc[1]) + (acc[2] * acc[2] + acc[3] * acc[3]); }
    ssq += shx(ssq, 16, F.lane); ssq += shx(ssq, 32, F.lane);
    if (fq == 0) RS[wh * 64 + trow] = ssq;
    lds_barrier();
    {
        const float tot = RS[trow] + RS[64 + trow];
        const float rstd = 1.f / sqrtf(tot * (1.f / 128.f) + 1e-6f);
        const size_t m = (size_t)b * SEQ + (vp0 - NMETA) + trow;
#pragma unroll
        for (int cc = 0; cc < 4; ++cc) { const int e0 = (wh * 4 + cc) * 16 + 4 * fq;
            const f32x4 gv = ldp4(PROJ, PROJM, b, vp0 + trow, GG + h * 128 + e0);
            const f32x4 ng = *(const f32x4*)(a.in[I_GNORM] + e0);
            float y[4];
#pragma unroll
            for (int i = 0; i < 4; ++i) { const float gi = gv[i]; y[i] = oacc[cc][i] * rstd * ng[i] * (gi * fsigmoid(gi)); }
            v2u o; o.x = pk2(y[0], y[1]); o.y = pk2(y[2], y[3]);
            *(v2u*)(YMIX + m * D + h * 128 + e0) = o; }
    }
    lds_barrier();
}
__device__ __forceinline__ void phase4(const Args& a, const Frame& F) {
    for (int t = F.blk * NWAVES + F.wave; t < 128 * 32 * 4; t += F.G * NWAVES) { const Frame F1 = mkframe(F.lds, F.wave); rwkv_y_task(a, F1, t); }
    __syncthreads();
    for (int u = F.blk; u < NB * 4 * 32; u += F.G) { const int c = 1 + (u & 31), bh = u >> 5; const Frame F1 = mkframe(F.lds, F.wave); gla_g3_unit(a, F1, bh >> 2, bh & 3, c); }
}

__device__ __forceinline__ int eidx_of(int L) { return 16 * (L & 1) + 8 * ((L >> 1) & 1) + 4 * ((L >> 2) & 1) + 2 * ((L >> 3) & 1) + ((L >> 4) & 1); }
__device__ __forceinline__ void p6_ln(const Args& a, const Frame& F, int m, f32x4 (&v)[4]) {
    unsigned char* ws = a.ws; bf16* H1 = (bf16*)(ws + WS_H1);
    float s = 0.f;
#pragma unroll
    for (int j = 0; j < 4; ++j) s += (v[j].x + v[j].y) + (v[j].z + v[j].w);
    const float mean = wave_sum(s, F.lane) * (1.f / D); float s2 = 0.f;
#pragma unroll
    for (int j = 0; j < 4; ++j) { v[j] = v[j] - mean; s2 += (v[j].x * v[j].x + v[j].y * v[j].y) + (v[j].z * v[j].z + v[j].w * v[j].w); }
    const float rstd = __builtin_amdgcn_rsqf(wave_sum(s2, F.lane) * (1.f / D) + 1e-5f);
#pragma unroll
    for (int j = 0; j < 4; ++j) { const int col = 4 * (F.lane + 64 * j);
        const f32x4 gv = *(const f32x4*)(a.in[I_LN1G] + col), bv = *(const f32x4*)(a.in[I_LN1B] + col);
        v[j] = v[j] * rstd * gv + bv;
        v2u o; o.x = pk2(v[j].x, v[j].y); o.y = pk2(v[j].z, v[j].w);
        *(v2u*)(H1 + (size_t)m * D + col) = o;
        int w8 = __builtin_amdgcn_cvt_pk_fp8_f32(v[j].x, v[j].y, 0, false); w8 = __builtin_amdgcn_cvt_pk_fp8_f32(v[j].z, v[j].w, w8, true);
        *(int*)(ws + WS_H1Q + (size_t)m * D + col) = w8; }
}
__device__ __forceinline__ void p6_top(const Args& a, const Frame& F, int m, int i, float (&p)[16], int& my_e) {
    int* TOPI = (int*)(a.ws + WS_TOPI); float* GATE = (float*)(a.ws + WS_GATE);
#define TR_STAGE(n, dmask) _Pragma("unroll") for (int i2 = 0; i2 < (n) / 2; ++i2) { const bool up = (F.lane & (dmask)) != 0; const float keep = up ? p[i2 + (n) / 2] : p[i2]; const float send = up ? p[i2] : p[i2 + (n) / 2]; p[i2] = keep + shx(send, (dmask), F.lane); }
    TR_STAGE(16, 2) TR_STAGE(8, 4) TR_STAGE(4, 8) TR_STAGE(2, 16)
#undef TR_STAGE
    const int eidx = eidx_of(F.lane);
    const float logit = p[0] + shx(p[0], 32, F.lane) + a.in[I_RTB][eidx];
    int rank = 0;
#pragma unroll
    for (int j = 0; j < 32; ++j) { const float lj = __int_as_float(__builtin_amdgcn_readlane(__float_as_int(logit), j)); const int ej = eidx_of(j);
        rank += (lj > logit || (lj == logit && ej < eidx)) ? 1 : 0; }
    int ek[4]; float lk[4];
#pragma unroll
    for (int k = 0; k < 4; ++k) { const unsigned long long mk = __ballot(rank == k) & 0xffffffffull; const int src = __builtin_amdgcn_readfirstlane((int)__builtin_ctzll(mk | (1ull << 63)));
        ek[k] = eidx_of(src); lk[k] = __int_as_float(__builtin_amdgcn_readlane(__float_as_int(logit), src)); }
    const float e0 = 1.f, e1 = expf(lk[1] - lk[0]), e2 = expf(lk[2] - lk[0]), e3 = expf(lk[3] - lk[0]);
    const float inv = 1.f / (e0 + e1 + e2 + e3);
    if (F.lane < 4) { const int k = F.lane; const int ee = k == 0 ? ek[0] : k == 1 ? ek[1] : k == 2 ? ek[2] : ek[3]; const float gg = (k == 0 ? e0 : k == 1 ? e1 : k == 2 ? e2 : e3) * inv;
        TOPI[(size_t)m * 4 + k] = ee; GATE[(size_t)m * 4 + k] = gg; }
    if ((F.lane >> 2) == i) { const int k = F.lane & 3; my_e = k == 0 ? ek[0] : k == 1 ? ek[1] : k == 2 ? ek[2] : ek[3]; }
}
__device__ __forceinline__ void p6_pair(const Args& a, const Frame& F, int m, int i, f32x4 (&v0)[4], f32x4 (&v1)[4], const LAS float* rwT, int& my_e) {
    constexpr int RWP = 1028;
    p6_ln(a, F, m, v0); p6_ln(a, F, m + 1, v1);
    float p0[16], p1[16]; const bool up = (F.lane & 1) != 0;
#pragma unroll
    for (int e = 0; e < 16; ++e) { float a0 = 0.f, a1 = 0.f, b0 = 0.f, b1 = 0.f;
#pragma unroll
        for (int j = 0; j < 4; ++j) { const f32x4 w = *(const LAS f32x4*)(rwT + e * RWP + 4 * (F.lane + 64 * j)), x = *(const LAS f32x4*)(rwT + (e + 16) * RWP + 4 * (F.lane + 64 * j));
            a0 += (v0[j].x * w.x + v0[j].y * w.y) + (v0[j].z * w.z + v0[j].w * w.w); a1 += (v1[j].x * w.x + v1[j].y * w.y) + (v1[j].z * w.z + v1[j].w * w.w);
            b0 += (v0[j].x * x.x + v0[j].y * x.y) + (v0[j].z * x.z + v0[j].w * x.w); b1 += (v1[j].x * x.x + v1[j].y * x.y) + (v1[j].z * x.z + v1[j].w * x.w); }
        p0[e] = (up ? b0 : a0) + shx(up ? a0 : b0, 1, F.lane); p1[e] = (up ? b1 : a1) + shx(up ? a1 : b1, 1, F.lane);
        if ((e & 1) == 1) __builtin_amdgcn_sched_barrier(0); }
    p6_top(a, F, m, i, p0, my_e); p6_top(a, F, m + 1, i + 1, p1, my_e);
}
__device__ __forceinline__ void phase6(const Args& a, const Frame& F, int csel) {
    unsigned char* ws = a.ws;
    const int gw = F.blk * NWAVES + F.wave, NGW = F.G * NWAVES;
    constexpr int RWP = 1028;
    LAS float* rwT = (LAS float*)F.lds;
    LAS int* hist = (LAS int*)(F.lds + 32 * RWP * 4);
    for (int i = F.tid; i < D * NE; i += NTHR) { const int c = i >> 5, e = i & 31; rwT[e * RWP + c] = a.in[I_RTW][i]; }
    bf16* H1 = (bf16*)(ws + WS_H1);
    int* TOPI = (int*)(ws + WS_TOPI); float* GATE = (float*)(ws + WS_GATE); int* RANK = (int*)(ws + WS_RANK);
    unsigned* CNT = (unsigned*)(ws + WS_CTL) + CW_CNT + 2048 * csel;
    for (int rb = F.blk; rb < MX / 128; rb += F.G) {
        if (F.tid < 64) hist[F.tid] = 0;
        __syncthreads();
        int my_e = 0;
        {
            const int mb = rb * 128 + F.wave * 16; const Frame& Fo = F;
            const f32x4* xr0 = (const f32x4*)(a.in[I_X] + (size_t)mb * D) + F.lane;
            const v2u* mr0 = (const v2u*)((const bf16*)(ws + WS_MIXB) + (size_t)mb * D) + F.lane;
            const float* st0 = (const float*)(ws + WS_STATS) + 2 * (size_t)mb;
            f32x4 va[4], vb[4], vc[4], vd[4]; v2u ma[4], mbv[4], mc[4], md[4]; float sa0, sa1, sb0, sb1, sc0, sc1, sd0, sd1;
#define P6_LOAD(vv, mmv, s0v, s1v, ii) do { _Pragma("unroll") for (int j = 0; j < 4; ++j) { vv[j] = xr0[(size_t)(ii) * (D / 4) + 64 * j]; mmv[j] = mr0[(size_t)(ii) * (D / 4) + 64 * j]; } s0v = st0[2 * (ii)]; s1v = st0[2 * (ii) + 1]; } while (0)
#define P6_FORM(vv, mmv, s0v, s1v) do { _Pragma("unroll") for (int j = 0; j < 4; ++j) { const int col = 4 * (F.lane + 64 * j); \
            const f32x4 gi = *(const f32x4*)(a.in[I_LNIN_G] + col) * ALPHA, bi = *(const f32x4*)(a.in[I_LNIN_B] + col) * ALPHA; \
            vv[j] = ((vv[j] - s0v) * s1v) * gi + bi + unpk4(mmv[j]); } } while (0)
            P6_LOAD(va, ma, sa0, sa1, 0); P6_LOAD(vb, mbv, sb0, sb1, 1);
#pragma nounroll
            for (int i = 0; i < 16; i += 4) {
                P6_LOAD(vc, mc, sc0, sc1, i + 2); P6_LOAD(vd, md, sd0, sd1, i + 3);
                { const Frame F = mkframe(Fo.lds, Fo.wave);
                  P6_FORM(va, ma, sa0, sa1); P6_FORM(vb, mbv, sb0, sb1);
                  p6_pair(a, F, mb + i, i, va, vb, rwT, my_e); }
                if (i + 4 < 16) { P6_LOAD(va, ma, sa0, sa1, i + 4); P6_LOAD(vb, mbv, sb0, sb1, i + 5); }
                { const Frame F = mkframe(Fo.lds, Fo.wave);
                  P6_FORM(vc, mc, sc0, sc1); P6_FORM(vd, md, sd0, sd1);
                  p6_pair(a, F, mb + i + 2, i + 2, vc, vd, rwT, my_e); }
            }
#undef P6_LOAD
#undef P6_FORM
        }
        const int lrank = __hip_atomic_fetch_add(&hist[my_e], 1, __ATOMIC_RELAXED, __HIP_MEMORY_SCOPE_WORKGROUP);
        __syncthreads();
        if (F.tid < 32) hist[32 + F.tid] = (int)__hip_atomic_fetch_add(CNT + 64 * F.tid, (unsigned)hist[F.tid], __ATOMIC_RELAXED, __HIP_MEMORY_SCOPE_AGENT);
        __syncthreads();
        RANK[((size_t)rb * 128 + F.wave * 16 + (F.lane >> 2)) * 4 + (F.lane & 3)] = hist[32 + my_e] + lrank;
        __syncthreads();
    }
}

__device__ __forceinline__ void phase7(const Args& a, const Frame& F) {
    unsigned char* ws = a.ws;
    LAS int* starts = (LAS int*)F.lds;
    unsigned* CNT = (unsigned*)(ws + WS_CTL) + CW_CNT;
    int* TILEE = (int*)(ws + WS_TILEE); int* SLOTTOK = (int*)(ws + WS_SLOTTOK);
    if (F.tid < 32) { const int cnt = (int)ld_agent(CNT + 64 * F.tid); starts[64 + F.tid] = cnt; starts[32 + F.tid] = (cnt + 255) & ~255; }
    __syncthreads();
    if (F.tid == 0) { int run = 0; for (int e = 0; e < 32; ++e) { starts[e] = run; run += starts[32 + e]; }
        if (F.blk == 0) { TILEE[1023] = run >> 8; for (int e = 0; e < 32; ++e) for (int tl = starts[e] >> 8; tl < (starts[e] + starts[32 + e]) >> 8; ++tl) TILEE[tl] = e; } }
    __syncthreads();
    if (F.blk == 0) { for (int e = 0; e < 32; ++e) for (int s = starts[e] + starts[64 + e] + F.tid; s < starts[e] + starts[32 + e]; s += NTHR) SLOTTOK[s] = 0; }
    const int* TOPI = (const int*)(ws + WS_TOPI); const int* RANK = (const int*)(ws + WS_RANK); int* TSLOT = (int*)(ws + WS_TSLOT);
    for (int q = F.blk * NTHR + F.tid; q < MX * 4; q += F.G * NTHR) {
        const int slot = starts[TOPI[q]] + RANK[q];
        TSLOT[q] = slot; SLOTTOK[slot] = q >> 2;
    }
}
__device__ __forceinline__ int moe_fill_table(const Args& a, const Frame& F, int nN, int RM) {
    LAS int* tab = (LAS int*)(F.lds + TAB_OFF);
    const unsigned* TILEE = (const unsigned*)(a.ws + WS_TILEE);
    if (F.tid == 0) {
        const int NT = (int)ld_agent(TILEE + 1023);
        const int x = F.blk & 7, j = F.blk >> 3; int n = 0;
        for (int i = 0; i < 64; ++i) { const int s = i * 8 + x, pm = s * RM + j / nN; if (pm >= NT) break;
            const int e = (int)ld_agent(TILEE + pm); tab[2 * n] = pm; tab[2 * n + 1] = e * nN + (j % nN); ++n; }
        tab[128] = n;
    }
    __syncthreads();
    return __builtin_amdgcn_readfirstlane(tab[128]);
}

__device__ __forceinline__ void p10_acc(float (&s)[16], int j, const v4u w, float g) {
    s[8 * j + 0] += g * bflo(w.x); s[8 * j + 1] += g * bfhi(w.x); s[8 * j + 2] += g * bflo(w.y); s[8 * j + 3] += g * bfhi(w.y);
    s[8 * j + 4] += g * bflo(w.z); s[8 * j + 5] += g * bfhi(w.z); s[8 * j + 6] += g * bflo(w.w); s[8 * j + 7] += g * bfhi(w.w);
}
__device__ __forceinline__ void phase10(const Args& a, const Frame& F) {
    unsigned char* ws = a.ws;
    const bf16* H1 = (const bf16*)(ws + WS_H1); const bf16* YS = (const bf16*)(ws + WS_YS);
    const int* TSLOT = (const int*)(ws + WS_TSLOT); const float* GATE = (const float*)(ws + WS_GATE);
    const int gw = F.blk * NWAVES + F.wave, NGW = F.G * NWAVES;
    f32x4 gv[4], bv[4];
#pragma unroll
    for (int q = 0; q < 4; ++q) { const int col = 8 * F.lane + 512 * (q >> 1) + 4 * (q & 1); gv[q] = *(const f32x4*)(a.in[I_LN2G] + col); bv[q] = *(const f32x4*)(a.in[I_LN2B] + col); }
    for (int m0 = gw; m0 < MX; m0 += 2 * NGW) {
        int mm[2]; mm[0] = m0; mm[1] = (m0 + NGW < MX) ? m0 + NGW : m0;
        int slot[2][4]; float gt[2][4]; v4u hw[2][2], yw[2][4][2];
#pragma unroll
        for (int r = 0; r < 2; ++r) {
#pragma unroll
            for (int k = 0; k < 4; ++k) { slot[r][k] = TSLOT[(size_t)mm[r] * 4 + k]; gt[r][k] = GATE[(size_t)mm[r] * 4 + k]; }
#pragma unroll
            for (int j = 0; j < 2; ++j) hw[r][j] = *(const v4u*)(H1 + (size_t)mm[r] * D + 8 * F.lane + 512 * j); }
#pragma unroll
        for (int r = 0; r < 2; ++r)
#pragma unroll
            for (int k = 0; k < 4; ++k)
#pragma unroll
                for (int j = 0; j < 2; ++j) yw[r][k][j] = *(const v4u*)(YS + (size_t)slot[r][k] * D + 8 * F.lane + 512 * j);
#pragma unroll
        for (int r = 0; r < 2; ++r) {
            float s[16];
#pragma unroll
            for (int i = 0; i < 16; ++i) s[i] = 0.f;
#pragma unroll
            for (int j = 0; j < 2; ++j) p10_acc(s, j, hw[r][j], ALPHA);
#pragma unroll
            for (int k = 0; k < 4; ++k)
#pragma unroll
                for (int j = 0; j < 2; ++j) p10_acc(s, j, yw[r][k][j], gt[r][k]);
            float t = 0.f;
#pragma unroll
            for (int i = 0; i < 16; ++i) t += s[i];
            const float mean = wave_sum(t, F.lane) * (1.f / D); float q = 0.f;
#pragma unroll
            for (int i = 0; i < 16; ++i) { s[i] -= mean; q += s[i] * s[i]; }
            const float rstd = __builtin_amdgcn_rsqf(wave_sum(q, F.lane) * (1.f / D) + 1e-5f);
            if (r == 0 || mm[1] != mm[0]) {
#pragma unroll
                for (int q4 = 0; q4 < 4; ++q4) { const int col = 8 * F.lane + 512 * (q4 >> 1) + 4 * (q4 & 1);
                    f32x4 o; o.x = s[4 * q4 + 0] * rstd * gv[q4].x + bv[q4].x; o.y = s[4 * q4 + 1] * rstd * gv[q4].y + bv[q4].y; o.z = s[4 * q4 + 2] * rstd * gv[q4].z + bv[q4].z; o.w = s[4 * q4 + 3] * rstd * gv[q4].w + bv[q4].w;
                    *(f32x4*)(a.out + (size_t)mm[r] * D + col) = o; } }
        }
    }
}

template <int LO, int HI>
__global__ void __launch_bounds__(NTHR, 2) fwd(Args a) {
    extern __shared__ __attribute__((aligned(16))) unsigned char lds_raw[];
    LAS unsigned char* lds = (LAS unsigned char*)lds_raw;
    const int wave = __builtin_amdgcn_readfirstlane((int)(threadIdx.x >> 6));
    volatile LAS unsigned* MISC = (volatile LAS unsigned*)(lds + MISC_OFF);
    if (wave == 0) MISC[lane_id()] = 0u;
    __syncthreads();
    unsigned* ctl = (unsigned*)(a.ws + WS_CTL);
    XcdBarrier bar; bar.bar = ctl + CW_BAR; bar.x = 0; bar.st = nullptr;
    if constexpr (HI - LO > 1) bar = xcd_barrier_post(ctl + CW_BAR, MISC + 8, wave == 0 && lane_id() == 0);
#define PH(k) if constexpr (LO <= (k) && (k) < HI)
#define SEAM(k) if constexpr (LO <= (k) && (k) + 1 < HI) xcd_barrier(bar, wave == 0 && lane_id() == 0)
    PH(0) for (int rep_ = 0; rep_ < NREP(0); ++rep_) { const Frame F = mkframe(lds, wave); phase0(a, F); } SEAM(0);
    PH(1) for (int rep_ = 0; rep_ < NREP(1); ++rep_) { const Frame F = mkframe(lds, wave);
            pg8::Gemm g{(const pg8::bf16_t*)(a.ws + WS_A0), (const pg8::bf16_t*)(a.ws + WS_WIN), MX, PW, D}; pg8::StaticOrder S; S.init(MX, PW, F.G, F.blk);
            pg8::EpiBf16Plain E{(pg8::bf16_t*)(a.ws + WS_PROJ), PW};
            pg8::gemm_phase<pg8::EpiBf16Plain, pg8::StaticOrder, true, true>(F.lds, g, S, E, F.tid); } SEAM(1);
    PH(2) for (int rep_ = 0; rep_ < NREP(2); ++rep_) { const Frame F = mkframe(lds, wave); phase2(a, F); } SEAM(2);
    PH(3) { const Frame F = mkframe(lds, wave); phase3(a, F); } SEAM(3);
    PH(4) for (int rep_ = 0; rep_ < NREP(4); ++rep_) { const Frame F = mkframe(lds, wave); phase4(a, F); } SEAM(4);
    PH(5) for (int rep_ = 0; rep_ < NREP(5); ++rep_) { const Frame F = mkframe(lds, wave);
            pg8::Gemm g{(const pg8::bf16_t*)(a.ws + WS_YMIX), (const pg8::bf16_t*)(a.ws + WS_WOUT), MX, D, D}; pg8::StaticOrder S; S.init(MX, D, F.G, F.blk);
            pg8::EpiBf16Plain E{(pg8::bf16_t*)(a.ws + WS_MIXB), D};
            pg8::gemm_phase<pg8::EpiBf16Plain, pg8::StaticOrder, true, true>(F.lds, g, S, E, F.tid); } SEAM(5);
    PH(6) for (int rep_ = 0; rep_ < NREP(6); ++rep_) { const Frame F = mkframe(lds, wave); phase6(a, F, rep_); } SEAM(6);
    PH(7) for (int rep_ = 0; rep_ < NREP(7); ++rep_) { const Frame F = mkframe(lds, wave); phase7(a, F); } SEAM(7);
    PH(8) for (int rep_ = 0; rep_ < NREP(8); ++rep_) { const Frame F = mkframe(lds, wave); const int n = moe_fill_table(a, F, 8, 4);
            pg8::Gemm g{(const pg8::bf16_t*)(a.ws + WS_H1Q), (const pg8::bf16_t*)(a.ws + WS_WUP), 0, 0, D / 2}; pg8::TableOrder S{(const LAS int*)(F.lds + TAB_OFF), n};
            pg8::EpiSwiglu8 E{a.ws + WS_ACT, a.in[I_BUP]};
            pg8::gemm_phase_g<pg8::EpiSwiglu8, pg8::TableOrder, true, true, 121>(F.lds, g, S, E, F.tid, (const int*)(a.ws + WS_SLOTTOK)); } SEAM(8);
    PH(9) for (int rep_ = 0; rep_ < NREP(9); ++rep_) { const Frame F = mkframe(lds, wave); const int n = moe_fill_table(a, F, 4, 8);
            pg8::Gemm g{(const pg8::bf16_t*)(a.ws + WS_ACT), (const pg8::bf16_t*)(a.ws + WS_WDN), 0, 0, D / 2}; pg8::TableOrder S{(const LAS int*)(F.lds + TAB_OFF), n};
            pg8::EpiDown E{(pg8::bf16_t*)(a.ws + WS_YS), a.in[I_BDN]};
            pg8::gemm_phase<pg8::EpiDown, pg8::TableOrder, true, true, 120>(F.lds, g, S, E, F.tid); } SEAM(9);
    PH(10) for (int rep_ = 0; rep_ < NREP(10); ++rep_) { const Frame F = mkframe(lds, wave); phase10(a, F); }
#undef PH
#undef SEAM
}

#ifndef MK_SINGLE
#define MK_SINGLE 1
#endif
template <int LO, int HI> static void launch_range(const Args& a, int grid, hipStream_t stream) {
    static bool attr = false;
    if (!attr) { (void)hipFuncSetAttribute((const void*)fwd<LO, HI>, hipFuncAttributeMaxDynamicSharedMemorySize, LDS_BYTES); attr = true; }
    hipLaunchKernelGGL((fwd<LO, HI>), dim3(grid), dim3(NTHR), LDS_BYTES, stream, a);
}
extern "C" void kernel_launch(void* const* d_in, const int* in_sizes, int n_in, void* d_out, int out_size, void* d_ws, size_t ws_size, hipStream_t stream) {
    if (n_in != 30 || ws_size < WS_END) { fprintf(stderr, "kernel_launch: unexpected inputs (n_in %d, ws %zu)\n", n_in, ws_size); return; }
    const int grid = 256;
    (void)hipMemsetAsync((char*)d_ws + WS_CTL, 0, CTL_ZERO_BYTES, stream);
    Args a{};
    for (int i = 0; i < 30; ++i) a.in[i] = (const float*)d_in[i];
    a.out = (float*)d_out; a.ws = (unsigned char*)d_ws;
#if MK_SINGLE
    launch_range<0, 11>(a, grid, stream);
#else
    launch_range<0, 1>(a, grid, stream); launch_range<1, 2>(a, grid, stream); launch_range<2, 3>(a, grid, stream); launch_range<3, 4>(a, grid, stream);
    launch_range<4, 5>(a, grid, stream); launch_range<5, 6>(a, grid, stream); launch_range<6, 7>(a, grid, stream); launch_range<7, 8>(a, grid, stream);
    launch_range<8, 9>(a, grid, stream); launch_range<9, 10>(a, grid, stream); launch_range<10, 11>(a, grid, stream);
#endif
}
```

```cpp
#include <hip/hip_runtime.h>
#include <cstdio>
#include <cstdint>
#include <cmath>
namespace pg8 {
#define PG8_LAS __attribute__((address_space(3)))
typedef unsigned short bf16_t;
typedef short bf16x8 __attribute__((ext_vector_type(8)));
typedef float f32x4 __attribute__((ext_vector_type(4)));
typedef unsigned u32x4 __attribute__((ext_vector_type(4)));
constexpr int BM = 256, BK = 64, HALF = 128, HTB = HALF * BK * 2  , STAGE_BYTES = 8 * HTB, NXCD = 8, WGM = 8;

__host__ __device__ __forceinline__ int lds_byte(int r, int c) { const int st = (r >> 4) * 2 + (c >> 5), rr = r & 15, cc = c & 31, ob = rr * 64 + cc * 2; return st * 1024 + (ob ^ (((ob >> 9) & 1) << 5)); }
__host__ __device__ __forceinline__ void stage_rc(int b, int& R, int& C) { const int st = b / 1024, sb = b % 1024, swz = sb ^ (((sb >> 9) & 1) << 5); R = (st >> 1) * 16 + swz / 64; C = (st & 1) * 32 + (swz % 64) / 2; }
__host__ __device__ __forceinline__ int perm32(int rho) { const int n = rho >> 4, i = rho & 15; return 8 * (i >> 2) + 4 * n + (i & 3); }

struct Unit { int pm, pn; };
struct Gemm { const bf16_t* A; const bf16_t* Bt; int M, N, K; };

struct StaticOrder {
    int nM, nN, nwg, G, c;
    __host__ __device__ void init(int M, int N, int G_, int c_) { nM = M / BM; nN = N / BM; nwg = nM * nN; G = G_; c = c_; }
    __host__ __device__ bool next(int i, Unit& u) const {
        const long L = (long)i * G + c; if (L >= nwg) return false;
        int wgid = (int)L; { const int q = nwg / NXCD, r = nwg % NXCD, xcd = wgid % NXCD, off = wgid / NXCD; wgid = (xcd < r ? xcd * (q + 1) : r * (q + 1) + (xcd - r) * q) + off; }
        const int nig = WGM * nN, gid = wgid / nig, fm = gid * WGM, gsz = (nM - fm) < WGM ? (nM - fm) : WGM;
        u.pm = fm + ((wgid % nig) % gsz); u.pn = (wgid % nig) / gsz; return true;
    }
    __device__ __forceinline__ void a_ready(const Unit&) const {}
    __device__ __forceinline__ void done(const Unit&) const {}
};


__device__ __forceinline__ unsigned cvt_pk_bf16(float lo, float hi) { unsigned r; asm volatile("v_cvt_pk_bf16_f32 %0, %1, %2" : "=v"(r) : "v"(lo), "v"(hi)); return r; }
typedef unsigned u32x2 __attribute__((ext_vector_type(2)));
typedef int i32x8 __attribute__((ext_vector_type(8))); typedef int i32x4 __attribute__((ext_vector_type(4)));
__device__ __forceinline__ void mfma_f8(f32x4& acc, i32x8 a, i32x8 b, int sa, int sb) {
    asm volatile("s_nop 1\n\tv_mfma_scale_f32_16x16x128_f8f6f4 %0, %1, %2, %0, %3, %4 op_sel_hi:[0,0,0]" : "+v"(acc) : "v"(a), "v"(b), "v"(sa), "v"(sb));
}
__device__ __forceinline__ i32x8 cat8(bf16x8 lo, bf16x8 hi) { const i32x4 a = __builtin_bit_cast(i32x4, lo), b = __builtin_bit_cast(i32x4, hi); return __builtin_shufflevector(a, b, 0, 1, 2, 3, 4, 5, 6, 7); }

struct EpiBf16Plain {
    static constexpr bool PERM = true, AFTER_DRAIN = false;
    bf16_t* O; int ldc;
    __device__ __forceinline__ void operator()(const f32x4 (&acc)[2][2][4][2], const Unit& u, int wr, int wc, int fr, int fq) const {
        const int row0 = u.pm * BM + wr * 64 + fr, col0 = u.pn * BM + wc * 32 + 8 * fq;
#pragma unroll
        for (int ai = 0; ai < 2; ++ai)
#pragma unroll
            for (int m = 0; m < 4; ++m) { bf16_t* rowp = O + (size_t)(row0 + ai * HALF + m * 16) * ldc + col0;
#pragma unroll
                for (int bj = 0; bj < 2; ++bj) { const f32x4 v0 = acc[ai][bj][m][0], v1 = acc[ai][bj][m][1];
                    u32x4 w; w.x = cvt_pk_bf16(v0[0], v0[1]); w.y = cvt_pk_bf16(v0[2], v0[3]); w.z = cvt_pk_bf16(v1[0], v1[1]); w.w = cvt_pk_bf16(v1[2], v1[3]);
                    *(u32x4*)(rowp + bj * HALF) = w; } }
    }
};

struct EpiResid {
    static constexpr bool PERM = false, AFTER_DRAIN = false;
    float* S1; const float* x; const float* stats; const float* g; const float* bta; float alpha;
    __device__ __forceinline__ void operator()(const f32x4 (&acc)[2][2][4][2], const Unit& u, int wr, int wc, int fr, int fq) const {
        const int row0 = u.pm * BM + wr * 64 + fr, col0 = u.pn * BM + wc * 32 + 4 * fq;
#pragma unroll
        for (int bj = 0; bj < 2; ++bj)
#pragma unroll
            for (int n = 0; n < 2; ++n) { const int c = col0 + bj * HALF + n * 16;
                const f32x4 gv = *(const f32x4*)(g + c) * alpha, bv = *(const f32x4*)(bta + c) * alpha;
#pragma unroll
                for (int ai = 0; ai < 2; ++ai)
#pragma unroll
                    for (int m = 0; m < 4; ++m) { const int r = row0 + ai * HALF + m * 16;
                        const float mean = stats[2 * r], rstd = stats[2 * r + 1];
                        const f32x4 xv = *(const f32x4*)(x + (size_t)r * 1024 + c);
                        *(f32x4*)(S1 + (size_t)r * 1024 + c) = ((xv - mean) * rstd) * gv + bv + acc[ai][bj][m][n]; } }
    }
};

__device__ __forceinline__ float swiglu1(float glu, float lin) {
    const float xg = fminf(glu, 7.0f), xl = fminf(fmaxf(lin, -7.0f), 7.0f);
    const float sg = __builtin_amdgcn_rcpf(1.0f + __expf(-1.702f * xg));
    return xg * sg * (xl + 1.0f);
}
struct EpiSwiglu {
    static constexpr bool PERM = true, AFTER_DRAIN = false;
    bf16_t* ACT; const float* bup;
    __device__ __forceinline__ void operator()(const f32x4 (&acc)[2][2][4][2], const Unit& u, int wr, int wc, int fr, int fq) const {
        const int e = u.pn >> 3, pn = u.pn & 7;
        const int row0 = u.pm * BM + wr * 64 + fr, ucol0 = pn * BM + wc * 32 + 8 * fq, acol0 = ucol0 >> 1;
        f32x4 bv[2][2];
#pragma unroll
        for (int bj = 0; bj < 2; ++bj)
#pragma unroll
            for (int n = 0; n < 2; ++n) bv[bj][n] = *(const f32x4*)(bup + (size_t)e * 2048 + ucol0 + bj * HALF + 4 * n);
#pragma unroll
        for (int ai = 0; ai < 2; ++ai)
#pragma unroll
            for (int m = 0; m < 4; ++m) { bf16_t* rowp = ACT + (size_t)(row0 + ai * HALF + m * 16) * 1024 + acol0;
#pragma unroll
                for (int bj = 0; bj < 2; ++bj) { const f32x4 v0 = acc[ai][bj][m][0] + bv[bj][0], v1 = acc[ai][bj][m][1] + bv[bj][1];
                    u32x2 w; w.x = cvt_pk_bf16(swiglu1(v0[0], v0[1]), swiglu1(v0[2], v0[3])); w.y = cvt_pk_bf16(swiglu1(v1[0], v1[1]), swiglu1(v1[2], v1[3]));
                    *(u32x2*)(rowp + bj * (HALF / 2)) = w; } }
    }
};
struct EpiSwiglu8 {
    static constexpr bool PERM = true, AFTER_DRAIN = false;
    unsigned char* ACT; const float* bup;
    __device__ __forceinline__ void operator()(const f32x4 (&acc)[2][2][4][2], const Unit& u, int wr, int wc, int fr, int fq) const {
        const int e = u.pn >> 3, pn = u.pn & 7;
        const int row0 = u.pm * BM + wr * 64 + fr, ucol0 = pn * BM + wc * 32 + 8 * fq, acol0 = ucol0 >> 1;
        f32x4 bv[2][2];
#pragma unroll
        for (int bj = 0; bj < 2; ++bj)
#pragma unroll
            for (int n = 0; n < 2; ++n) bv[bj][n] = *(const f32x4*)(bup + (size_t)e * 2048 + ucol0 + bj * HALF + 4 * n);
#pragma unroll
        for (int ai = 0; ai < 2; ++ai)
#pragma unroll
            for (int m = 0; m < 4; ++m) { unsigned char* rowp = ACT + (size_t)(row0 + ai * HALF + m * 16) * 1024 + acol0;
#pragma unroll
                for (int bj = 0; bj < 2; ++bj) { const f32x4 v0 = acc[ai][bj][m][0] + bv[bj][0], v1 = acc[ai][bj][m][1] + bv[bj][1];
                    int w = __builtin_amdgcn_cvt_pk_fp8_f32(swiglu1(v0[0], v0[1]), swiglu1(v0[2], v0[3]), 0, false);
                    w = __builtin_amdgcn_cvt_pk_fp8_f32(swiglu1(v1[0], v1[1]), swiglu1(v1[2], v1[3]), w, true);
                    *(int*)(rowp + bj * (HALF / 2)) = w; } }
    }
};
struct EpiDown {
    static constexpr bool PERM = true, AFTER_DRAIN = false;
    bf16_t* YS; const float* bdn;
    __device__ __forceinline__ void operator()(const f32x4 (&acc)[2][2][4][2], const Unit& u, int wr, int wc, int fr, int fq) const {
        const int e = u.pn >> 2, pn = u.pn & 3;
        const int row0 = u.pm * BM + wr * 64 + fr, col0 = pn * BM + wc * 32 + 8 * fq;
        f32x4 bv[2][2];
#pragma unroll
        for (int bj = 0; bj < 2; ++bj)
#pragma unroll
            for (int n = 0; n < 2; ++n) bv[bj][n] = *(const f32x4*)(bdn + (size_t)e * 1024 + col0 + bj * HALF + 4 * n);
#pragma unroll
        for (int ai = 0; ai < 2; ++ai)
#pragma unroll
            for (int m = 0; m < 4; ++m) { bf16_t* rowp = YS + (size_t)(row0 + ai * HALF + m * 16) * 1024 + col0;
#pragma unroll
                for (int bj = 0; bj < 2; ++bj) { const f32x4 v0 = acc[ai][bj][m][0] + bv[bj][0], v1 = acc[ai][bj][m][1] + bv[bj][1];
                    u32x4 w; w.x = cvt_pk_bf16(v0[0], v0[1]); w.y = cvt_pk_bf16(v0[2], v0[3]); w.z = cvt_pk_bf16(v1[0], v1[1]); w.w = cvt_pk_bf16(v1[2], v1[3]);
                    *(u32x4*)(rowp + bj * HALF) = w; } }
    }
};
struct TableOrder {
    const PG8_LAS int* tab; int n;
    __device__ __forceinline__ bool next(int i, Unit& u) const {
        if (i >= n) return false;
        u.pm = __builtin_amdgcn_readfirstlane(tab[2 * i]); u.pn = __builtin_amdgcn_readfirstlane(tab[2 * i + 1]); return true;
    }
    __device__ __forceinline__ void a_ready(const Unit&) const {}
    __device__ __forceinline__ void done(const Unit&) const {}
};

template <class Epi, class Sched, bool ALIGN_EPI = false, bool SP2 = false, int SCW = 0>
__device__ __forceinline__ void gemm_phase(PG8_LAS unsigned char* lds, const Gemm g, const Sched& S, const Epi& E, const int tid) {
    const int wid = __builtin_amdgcn_readfirstlane(tid >> 6), lane = tid & 63, wr = wid >> 2, wc = wid & 3, fr = lane & 15, fq = lane >> 4;
    int K_ = g.K; asm volatile("" : "+s"(K_));
    const int K = K_, nt = K / BK;
    unsigned voffA[2], voffB[2];
#pragma unroll
    for (int i = 0; i < 2; ++i) { int R, C; stage_rc(tid * 16 + i * 8192, R, C); const int Rb = Epi::PERM ? ((R & ~31) + perm32(R & 31)) : R;
        voffA[i] = (unsigned)(R * K + C) * 2u; voffB[i] = (unsigned)(Rb * K + C) * 2u; }
    const size_t kstep = (size_t)(BK * 2);
    const size_t hstep = (size_t)HALF * K * 2;
    const size_t tstep = 2 * hstep;
    const unsigned ldsw = (unsigned)wid * 1024u;
    const int aoff = lds_byte(wr * 64 + fr, fq * 8), boff = lds_byte(wc * 32 + fr, fq * 8);
#define PG8_SA(b, h) (((b) * 2 + (h)) * HTB)
#define PG8_SB(b, h) ((4 + (b) * 2 + (h)) * HTB)
#define PG8_STAGE(bufoff, gbase, voff) do { _Pragma("unroll") for (int _i = 0; _i < 2; ++_i) \
        __builtin_amdgcn_global_load_lds((const unsigned*)((const char*)(gbase) + (voff)[_i]), (PG8_LAS unsigned*)(lds + (bufoff) + ldsw + _i * 8192), 16, 0, 0); } while (0)
#define PG8_LDA(dst, b, h) do { _Pragma("unroll") for (int m = 0; m < 4; ++m) _Pragma("unroll") for (int k = 0; k < 2; ++k) dst[m][k] = *(const PG8_LAS bf16x8*)(lds + PG8_SA(b, h) + aoff + m * 2048 + k * 1024); } while (0)
#define PG8_LDB(dst, b, h) do { _Pragma("unroll") for (int n = 0; n < 2; ++n) _Pragma("unroll") for (int k = 0; k < 2; ++k) dst[n][k] = *(const PG8_LAS bf16x8*)(lds + PG8_SB(b, h) + boff + n * 2048 + k * 1024); } while (0)
#define PG8_MMA(ai, bj, At, Bt) do { __builtin_amdgcn_s_setprio(1); _Pragma("unroll") for (int m = 0; m < 4; ++m) _Pragma("unroll") for (int n = 0; n < 2; ++n) { \
        if constexpr (SCW != 0) mfma_f8(acc[ai][bj][m][n], cat8(Bt[n][0], Bt[n][1]), cat8(At[m][0], At[m][1]), SCW * 0x01010101, 0x7f7f7f7f); \
        else { _Pragma("unroll") for (int k = 0; k < 2; ++k) acc[ai][bj][m][n] = __builtin_amdgcn_mfma_f32_16x16x32_bf16(Bt[n][k], At[m][k], acc[ai][bj][m][n], 0, 0, 0); } } __builtin_amdgcn_s_setprio(0); } while (0)
#define PG8_WAIT_V(n) asm volatile("s_waitcnt vmcnt(" #n ")" ::: "memory")
#define PG8_WAIT_L(n) asm volatile("s_waitcnt lgkmcnt(" #n ")" ::: "memory")
#define PG8_BAR __builtin_amdgcn_s_barrier()
#define PG8_SCHED __builtin_amdgcn_sched_barrier(0)
    Unit cur, nxt; int ui = 0;
    if (!S.next(0, cur)) return;
    f32x4 acc[2][2][4][2];
#pragma unroll
    for (int a = 0; a < 2; ++a)
#pragma unroll
        for (int b = 0; b < 2; ++b)
#pragma unroll
            for (int m = 0; m < 4; ++m)
#pragma unroll
                for (int n = 0; n < 2; ++n) acc[a][b][m][n] = (f32x4){0.f, 0.f, 0.f, 0.f};
    bf16x8 At[4][2], B0[2][2], B1[2][2];
    const char* cA = (const char*)g.A + (size_t)cur.pm * tstep; const char* cB = (const char*)g.Bt + (size_t)cur.pn * tstep;
    S.a_ready(cur);
    if constexpr (SP2) {
        PG8_STAGE(PG8_SB(0, 0), cB, voffB); PG8_STAGE(PG8_SB(0, 1), cB + hstep, voffB); PG8_STAGE(PG8_SA(0, 0), cA, voffA); PG8_STAGE(PG8_SA(0, 1), cA + hstep, voffA);
        if (wr == 1) PG8_BAR;
        PG8_WAIT_V(2); PG8_BAR;
        PG8_STAGE(PG8_SB(1, 0), cB + kstep, voffB); PG8_STAGE(PG8_SA(1, 0), cA + kstep, voffA); PG8_STAGE(PG8_SB(1, 1), cB + hstep + kstep, voffB);
        PG8_WAIT_V(6); PG8_BAR;
    } else {
        PG8_STAGE(PG8_SB(0, 0), cB, voffB); PG8_STAGE(PG8_SA(0, 0), cA, voffA); PG8_STAGE(PG8_SB(0, 1), cB + hstep, voffB); PG8_STAGE(PG8_SA(0, 1), cA + hstep, voffA);
        if (wr == 1) PG8_BAR;
        PG8_WAIT_V(4); PG8_BAR;
        PG8_STAGE(PG8_SB(1, 0), cB + kstep, voffB); PG8_STAGE(PG8_SA(1, 0), cA + kstep, voffA); PG8_STAGE(PG8_SB(1, 1), cB + hstep + kstep, voffB);
        PG8_WAIT_V(6); PG8_BAR;
    }
    for (;;) {
        const bool has_next = S.next(ui + 1, nxt);
        const char* nA = has_next ? (const char*)g.A + (size_t)nxt.pm * tstep : cA; const char* nB = has_next ? (const char*)g.Bt + (size_t)nxt.pn * tstep : cB;
        for (int t = 0; t < nt; t += 2) {
            const bool last = (t == nt - 2);
            const char* a1 = cA + (size_t)(t + 1) * kstep;
            const char* a2 = last ? nA : cA + (size_t)(t + 2) * kstep; const char* b2 = last ? nB : cB + (size_t)(t + 2) * kstep;
            const char* a3 = a2 + kstep; const char* b3 = b2 + kstep;
            if (last && has_next) S.a_ready(nxt);
            if constexpr (SP2) {
            PG8_LDB(B0, 0, 0); PG8_LDB(B1, 0, 1); PG8_SCHED; PG8_LDA(At, 0, 0); PG8_STAGE(PG8_SA(1, 1), a1 + hstep, voffA);
            PG8_WAIT_V(8); PG8_WAIT_L(0); PG8_BAR; PG8_MMA(0, 0, At, B0); PG8_MMA(0, 1, At, B1); PG8_BAR; PG8_SCHED;
            PG8_LDA(At, 0, 1); PG8_STAGE(PG8_SB(0, 0), b2, voffB); PG8_STAGE(PG8_SB(0, 1), b2 + hstep, voffB); PG8_STAGE(PG8_SA(0, 0), a2, voffA);
            PG8_WAIT_V(8); PG8_WAIT_L(0); PG8_BAR; PG8_MMA(1, 0, At, B0); PG8_MMA(1, 1, At, B1); PG8_BAR; PG8_SCHED;
            PG8_LDB(B0, 1, 0); PG8_LDB(B1, 1, 1); PG8_SCHED; PG8_LDA(At, 1, 0); PG8_STAGE(PG8_SA(0, 1), a2 + hstep, voffA);
            PG8_WAIT_V(8); PG8_WAIT_L(0); PG8_BAR; PG8_MMA(0, 0, At, B0); PG8_MMA(0, 1, At, B1); PG8_BAR; PG8_SCHED;
            PG8_LDA(At, 1, 1); PG8_STAGE(PG8_SB(1, 0), b3, voffB); PG8_STAGE(PG8_SB(1, 1), b3 + hstep, voffB); PG8_STAGE(PG8_SA(1, 0), a3, voffA);
            PG8_WAIT_V(8); PG8_WAIT_L(0); PG8_BAR; PG8_MMA(1, 0, At, B0); PG8_MMA(1, 1, At, B1); PG8_BAR; PG8_SCHED;
            } else {
            PG8_LDB(B0, 0, 0); PG8_SCHED; PG8_LDA(At, 0, 0); PG8_STAGE(PG8_SA(1, 1), a1 + hstep, voffA);
            PG8_WAIT_L(8); PG8_BAR; PG8_WAIT_L(0); PG8_MMA(0, 0, At, B0); PG8_BAR; PG8_SCHED;
            PG8_LDB(B1, 0, 1); PG8_STAGE(PG8_SB(0, 0), b2, voffB);
            PG8_BAR; PG8_WAIT_L(0); PG8_MMA(0, 1, At, B1); PG8_BAR;
            PG8_LDA(At, 0, 1); PG8_STAGE(PG8_SA(0, 0), a2, voffA);
            PG8_BAR; PG8_WAIT_L(0); PG8_MMA(1, 0, At, B0); PG8_BAR; PG8_SCHED;
            PG8_STAGE(PG8_SB(0, 1), b2 + hstep, voffB);
            PG8_WAIT_V(6); PG8_BAR; PG8_MMA(1, 1, At, B1); PG8_BAR;
            PG8_LDB(B0, 1, 0); PG8_SCHED; PG8_LDA(At, 1, 0); PG8_STAGE(PG8_SA(0, 1), a2 + hstep, voffA);
            PG8_WAIT_L(8); PG8_BAR; PG8_WAIT_L(0); PG8_MMA(0, 0, At, B0); PG8_BAR; PG8_SCHED;
            PG8_LDB(B1, 1, 1); PG8_STAGE(PG8_SB(1, 0), b3, voffB);
            PG8_BAR; PG8_WAIT_L(0); PG8_MMA(0, 1, At, B1); PG8_BAR;
            PG8_LDA(At, 1, 1); PG8_STAGE(PG8_SA(1, 0), a3, voffA);
            PG8_BAR; PG8_WAIT_L(0); PG8_MMA(1, 0, At, B0); PG8_BAR; PG8_SCHED;
            PG8_STAGE(PG8_SB(1, 1), b3 + hstep, voffB);
            PG8_WAIT_V(6); PG8_BAR; PG8_MMA(1, 1, At, B1); PG8_BAR;
            }
        }
        if constexpr (SCW != 0) asm volatile("s_nop 15\n\ts_nop 15" ::: "memory");
        if constexpr (ALIGN_EPI) { if (wr == 0) PG8_BAR; }
        if constexpr (!Epi::AFTER_DRAIN) { E(acc, cur, wr, wc, fr, fq); S.done(cur); }
        if (!has_next) break;
#pragma unroll
        for (int a = 0; a < 2; ++a)
#pragma unroll
            for (int b = 0; b < 2; ++b)
#pragma unroll
                for (int m = 0; m < 4; ++m)
#pragma unroll
                    for (int n = 0; n < 2; ++n) acc[a][b][m][n] = (f32x4){0.f, 0.f, 0.f, 0.f};
        cur = nxt; cA = nA; cB = nB; ++ui;
        if constexpr (ALIGN_EPI) { if (wr == 1) PG8_BAR; }
    }
    PG8_WAIT_V(0);
    if constexpr (!ALIGN_EPI) { if (wr == 0) PG8_BAR; }
    PG8_BAR;
    if constexpr (Epi::AFTER_DRAIN) { E.fused(acc, cur, wr, wc, fr, fq, lds, wid, lane); S.done(cur); }
#undef PG8_SA
#undef PG8_SB
#undef PG8_STAGE
#undef PG8_LDA
#undef PG8_LDB
#undef PG8_MMA
#undef PG8_WAIT_V
#undef PG8_WAIT_L
#undef PG8_BAR
#undef PG8_SCHED
}
template <class Epi, class Sched, bool ALIGN_EPI = false, bool SP2 = false, int SCW = 0>
__device__ __forceinline__ void gemm_phase_g(PG8_LAS unsigned char* lds, const Gemm g, const Sched& S, const Epi& E, const int tid, const int* rowmap) {
    const int wid = __builtin_amdgcn_readfirstlane(tid >> 6), lane = tid & 63, wr = wid >> 2, wc = wid & 3, fr = lane & 15, fq = lane >> 4;
    int K_ = g.K; asm volatile("" : "+s"(K_));
    const int K = K_, nt = K / BK;
    unsigned voffB[2], cv0[2], cv1[2], nv0[2], nv1[2]; int RA[2], CA[2];
#pragma unroll
    for (int i = 0; i < 2; ++i) { int R, C; stage_rc(tid * 16 + i * 8192, R, C); const int Rb = Epi::PERM ? ((R & ~31) + perm32(R & 31)) : R;
        RA[i] = R; CA[i] = C; voffB[i] = (unsigned)(Rb * K + C) * 2u; }
    const size_t kstep = (size_t)(BK * 2);
    const size_t hstep = (size_t)HALF * K * 2;
    const size_t tstep = 2 * hstep;
    const unsigned ldsw = (unsigned)wid * 1024u;
    const int aoff = lds_byte(wr * 64 + fr, fq * 8), boff = lds_byte(wc * 32 + fr, fq * 8);
#define PG8_SA(b, h) (((b) * 2 + (h)) * HTB)
#define PG8_SB(b, h) ((4 + (b) * 2 + (h)) * HTB)
#define PG8_STAGE(bufoff, gbase, voff) do { _Pragma("unroll") for (int _i = 0; _i < 2; ++_i) \
        __builtin_amdgcn_global_load_lds((const unsigned*)((const char*)(gbase) + (voff)[_i]), (PG8_LAS unsigned*)(lds + (bufoff) + ldsw + _i * 8192), 16, 0, 0); } while (0)
#define PG8_LDA(dst, b, h) do { _Pragma("unroll") for (int m = 0; m < 4; ++m) _Pragma("unroll") for (int k = 0; k < 2; ++k) dst[m][k] = *(const PG8_LAS bf16x8*)(lds + PG8_SA(b, h) + aoff + m * 2048 + k * 1024); } while (0)
#define PG8_LDB(dst, b, h) do { _Pragma("unroll") for (int n = 0; n < 2; ++n) _Pragma("unroll") for (int k = 0; k < 2; ++k) dst[n][k] = *(const PG8_LAS bf16x8*)(lds + PG8_SB(b, h) + boff + n * 2048 + k * 1024); } while (0)
#define PG8_MMA(ai, bj, At, Bt) do { __builtin_amdgcn_s_setprio(1); _Pragma("unroll") for (int m = 0; m < 4; ++m) _Pragma("unroll") for (int n = 0; n < 2; ++n) { \
        if constexpr (SCW != 0) mfma_f8(acc[ai][bj][m][n], cat8(Bt[n][0], Bt[n][1]), cat8(At[m][0], At[m][1]), SCW * 0x01010101, 0x7f7f7f7f); \
        else { _Pragma("unroll") for (int k = 0; k < 2; ++k) acc[ai][bj][m][n] = __builtin_amdgcn_mfma_f32_16x16x32_bf16(Bt[n][k], At[m][k], acc[ai][bj][m][n], 0, 0, 0); } } __builtin_amdgcn_s_setprio(0); } while (0)
#define PG8_WAIT_V(n) asm volatile("s_waitcnt vmcnt(" #n ")" ::: "memory")
#define PG8_WAIT_L(n) asm volatile("s_waitcnt lgkmcnt(" #n ")" ::: "memory")
#define PG8_BAR __builtin_amdgcn_s_barrier()
#define PG8_SCHED __builtin_amdgcn_sched_barrier(0)
    static_assert(SP2, "gemm_phase_g: SP2 form only");
    Unit cur, nxt; int ui = 0;
    if (!S.next(0, cur)) return;
    f32x4 acc[2][2][4][2];
#pragma unroll
    for (int a = 0; a < 2; ++a)
#pragma unroll
        for (int b = 0; b < 2; ++b)
#pragma unroll
            for (int m = 0; m < 4; ++m)
#pragma unroll
                for (int n = 0; n < 2; ++n) acc[a][b][m][n] = (f32x4){0.f, 0.f, 0.f, 0.f};
    bf16x8 At[4][2], B0[2][2], B1[2][2];
    const char* gA = (const char*)g.A; const char* cB = (const char*)g.Bt + (size_t)cur.pn * tstep;
#define PG8_ROWS(pm_, v0_, v1_) do { _Pragma("unroll") for (int _i = 0; _i < 2; ++_i) { v0_[_i] = (unsigned)(rowmap[(pm_) * BM + RA[_i]] * K + CA[_i]) * 2u; v1_[_i] = (unsigned)(rowmap[(pm_) * BM + HALF + RA[_i]] * K + CA[_i]) * 2u; } } while (0)
    PG8_ROWS(cur.pm, cv0, cv1);
    const unsigned voffA[2] = {0u, 0u}; const char* cA = gA; (void)voffA; (void)cA;
    S.a_ready(cur);
    if constexpr (SP2) {
        PG8_STAGE(PG8_SB(0, 0), cB, voffB); PG8_STAGE(PG8_SB(0, 1), cB + hstep, voffB); PG8_STAGE(PG8_SA(0, 0), gA, cv0); PG8_STAGE(PG8_SA(0, 1), gA, cv1);
        if (wr == 1) PG8_BAR;
        PG8_WAIT_V(2); PG8_BAR;
        PG8_STAGE(PG8_SB(1, 0), cB + kstep, voffB); PG8_STAGE(PG8_SA(1, 0), gA + kstep, cv0); PG8_STAGE(PG8_SB(1, 1), cB + hstep + kstep, voffB);
        PG8_WAIT_V(6); PG8_BAR;
    } else {
        PG8_STAGE(PG8_SB(0, 0), cB, voffB); PG8_STAGE(PG8_SA(0, 0), cA, voffA); PG8_STAGE(PG8_SB(0, 1), cB + hstep, voffB); PG8_STAGE(PG8_SA(0, 1), cA + hstep, voffA);
        if (wr == 1) PG8_BAR;
        PG8_WAIT_V(4); PG8_BAR;
        PG8_STAGE(PG8_SB(1, 0), cB + kstep, voffB); PG8_STAGE(PG8_SA(1, 0), cA + kstep, voffA); PG8_STAGE(PG8_SB(1, 1), cB + hstep + kstep, voffB);
        PG8_WAIT_V(6); PG8_BAR;
    }
    for (;;) {
        const bool has_next = S.next(ui + 1, nxt);
        const char* nB = has_next ? (const char*)g.Bt + (size_t)nxt.pn * tstep : cB;
        if (has_next) PG8_ROWS(nxt.pm, nv0, nv1); else { nv0[0] = cv0[0]; nv0[1] = cv0[1]; nv1[0] = cv1[0]; nv1[1] = cv1[1]; }
        for (int t = 0; t < nt; t += 2) {
            const bool last = (t == nt - 2);
            const char* a1 = gA + (size_t)(t + 1) * kstep;
            const char* a2 = last ? gA : gA + (size_t)(t + 2) * kstep; const char* b2 = last ? nB : cB + (size_t)(t + 2) * kstep;
            unsigned w0[2], w1[2]; w0[0] = last ? nv0[0] : cv0[0]; w0[1] = last ? nv0[1] : cv0[1]; w1[0] = last ? nv1[0] : cv1[0]; w1[1] = last ? nv1[1] : cv1[1];
            const char* a3 = a2 + kstep; const char* b3 = b2 + kstep;
            if (last && has_next) S.a_ready(nxt);
            if constexpr (SP2) {
            PG8_LDB(B0, 0, 0); PG8_LDB(B1, 0, 1); PG8_SCHED; PG8_LDA(At, 0, 0); PG8_STAGE(PG8_SA(1, 1), a1, cv1);
            PG8_WAIT_V(8); PG8_WAIT_L(0); PG8_BAR; PG8_MMA(0, 0, At, B0); PG8_MMA(0, 1, At, B1); PG8_BAR; PG8_SCHED;
            PG8_LDA(At, 0, 1); PG8_STAGE(PG8_SB(0, 0), b2, voffB); PG8_STAGE(PG8_SB(0, 1), b2 + hstep, voffB); PG8_STAGE(PG8_SA(0, 0), a2, w0);
            PG8_WAIT_V(8); PG8_WAIT_L(0); PG8_BAR; PG8_MMA(1, 0, At, B0); PG8_MMA(1, 1, At, B1); PG8_BAR; PG8_SCHED;
            PG8_LDB(B0, 1, 0); PG8_LDB(B1, 1, 1); PG8_SCHED; PG8_LDA(At, 1, 0); PG8_STAGE(PG8_SA(0, 1), a2, w1);
            PG8_WAIT_V(8); PG8_WAIT_L(0); PG8_BAR; PG8_MMA(0, 0, At, B0); PG8_MMA(0, 1, At, B1); PG8_BAR; PG8_SCHED;
            PG8_LDA(At, 1, 1); PG8_STAGE(PG8_SB(1, 0), b3, voffB); PG8_STAGE(PG8_SB(1, 1), b3 + hstep, voffB); PG8_STAGE(PG8_SA(1, 0), a3, w0);
            PG8_WAIT_V(8); PG8_WAIT_L(0); PG8_BAR; PG8_MMA(1, 0, At, B0); PG8_MMA(1, 1, At, B1); PG8_BAR; PG8_SCHED;
            } else {
            PG8_LDB(B0, 0, 0); PG8_SCHED; PG8_LDA(At, 0, 0); PG8_STAGE(PG8_SA(1, 1), a1, cv1);
            PG8_WAIT_L(8); PG8_BAR; PG8_WAIT_L(0); PG8_MMA(0, 0, At, B0); PG8_BAR; PG8_SCHED;
            PG8_LDB(B1, 0, 1); PG8_STAGE(PG8_SB(0, 0), b2, voffB);
            PG8_BAR; PG8_WAIT_L(0); PG8_MMA(0, 1, At, B1); PG8_BAR;
            PG8_LDA(At, 0, 1); PG8_STAGE(PG8_SA(0, 0), a2, voffA);
            PG8_BAR; PG8_WAIT_L(0); PG8_MMA(1, 0, At, B0); PG8_BAR; PG8_SCHED;
            PG8_STAGE(PG8_SB(0, 1), b2 + hstep, voffB);
            PG8_WAIT_V(6); PG8_BAR; PG8_MMA(1, 1, At, B1); PG8_BAR;
            PG8_LDB(B0, 1, 0); PG8_SCHED; PG8_LDA(At, 1, 0); PG8_STAGE(PG8_SA(0, 1), a2, w1);
            PG8_WAIT_L(8); PG8_BAR; PG8_WAIT_L(0); PG8_MMA(0, 0, At, B0); PG8_BAR; PG8_SCHED;
            PG8_LDB(B1, 1, 1); PG8_STAGE(PG8_SB(1, 0), b3, voffB);
            PG8_BAR; PG8_WAIT_L(0); PG8_MMA(0, 1, At, B1); PG8_BAR;
            PG8_LDA(At, 1, 1); PG8_STAGE(PG8_SA(1, 0), a3, voffA);
            PG8_BAR; PG8_WAIT_L(0); PG8_MMA(1, 0, At, B0); PG8_BAR; PG8_SCHED;
            PG8_STAGE(PG8_SB(1, 1), b3 + hstep, voffB);
            PG8_WAIT_V(6); PG8_BAR; PG8_MMA(1, 1, At, B1); PG8_BAR;
            }
        }
        if constexpr (SCW != 0) asm volatile("s_nop 15\n\ts_nop 15" ::: "memory");
        if constexpr (ALIGN_EPI) { if (wr == 0) PG8_BAR; }
        if constexpr (!Epi::AFTER_DRAIN) { E(acc, cur, wr, wc, fr, fq); S.done(cur); }
        if (!has_next) break;
#pragma unroll
        for (int a = 0; a < 2; ++a)
#pragma unroll
            for (int b = 0; b < 2; ++b)
#pragma unroll
                for (int m = 0; m < 4; ++m)
#pragma unroll
                    for (int n = 0; n < 2; ++n) acc[a][b][m][n] = (f32x4){0.f, 0.f, 0.f, 0.f};
        cur = nxt; cB = nB; ++ui; cv0[0] = nv0[0]; cv0[1] = nv0[1]; cv1[0] = nv1[0]; cv1[1] = nv1[1];
        if constexpr (ALIGN_EPI) { if (wr == 1) PG8_BAR; }
    }
    PG8_WAIT_V(0);
    if constexpr (!ALIGN_EPI) { if (wr == 0) PG8_BAR; }
    PG8_BAR;
    if constexpr (Epi::AFTER_DRAIN) { E.fused(acc, cur, wr, wc, fr, fq, lds, wid, lane); S.done(cur); }
#undef PG8_ROWS
#undef PG8_SA
#undef PG8_SB
#undef PG8_STAGE
#undef PG8_LDA
#undef PG8_LDB
#undef PG8_MMA
#undef PG8_WAIT_V
#undef PG8_WAIT_L
#undef PG8_BAR
#undef PG8_SCHED
}
}

#ifndef REP_MASK
#define REP_MASK 0
#endif
#define NREP(k) (1 + ((REP_MASK >> (k)) & 1))

constexpr int NB = 16, SEQ = 2048, D = 1024, NMETA = 16;
constexpr int MX = NB * SEQ;
constexpr int INW = 3344, PW = 3584;
constexpr int GQ = 0, GK = 256, GV = 512, GG = 1024, GKL = 1536;
constexpr int RW0 = 1552;
constexpr int RR = RW0, RK = RW0 + 512, RV = RW0 + 1024, RWL = RW0 + 1536, RAL = RW0 + 1600, RGL = RW0 + 1664;
constexpr int NE = 32, TOPK = 4;
constexpr int NCH = 33;
constexpr float ALPHA = 1.189207115002721f;
constexpr int NWAVES = 8, NTHR = 512;

constexpr size_t MiB = 1u << 20;
constexpr size_t WS_CTL = 0, CTL_ZERO_BYTES = 1 * MiB;
constexpr size_t WS_STATS = 1 * MiB;
constexpr size_t WS_TOPI  = WS_STATS + 256 * 1024;
constexpr size_t WS_GATE  = WS_TOPI + 512 * 1024;
constexpr size_t WS_RANK  = WS_GATE + 512 * 1024;
constexpr size_t WS_TSLOT = WS_RANK + 512 * 1024;
constexpr size_t WS_BON   = WS_TSLOT + 512 * 1024;
constexpr size_t WS_PROJM = WS_BON + 1 * MiB;
constexpr size_t WS_OPSM  = WS_PROJM + 256 * 1024;
constexpr size_t WS_DL    = WS_OPSM + 256 * 1024;
constexpr size_t WS_W2T   = WS_DL + 1 * MiB;
constexpr size_t WS_A2T   = WS_W2T + 64 * 1024;
constexpr size_t WS_G2T   = WS_A2T + 64 * 1024;
constexpr size_t WS_RWH   = WS_G2T + 128 * 1024;
constexpr size_t WS_RWL   = WS_RWH + 64 * 1024;
constexpr size_t WS_TILEE = WS_RWL + 64 * 1024;
constexpr size_t WS_SLOTTOK = WS_TILEE + 4096;
constexpr size_t WS_WIN   = 8 * MiB;
constexpr size_t WS_WOUT  = 15 * MiB;
static_assert(WS_SLOTTOK + 139264 * 4 <= WS_WIN, "table region");
constexpr size_t WS_A0    = 20 * MiB;
constexpr size_t WS_YMIX  = WS_A0;
constexpr size_t WS_PROJ  = 84 * MiB;
constexpr size_t WS_R1    = 308 * MiB;
constexpr size_t WS_GAM   = 520 * MiB;
constexpr size_t WS_SST   = 524 * MiB;
constexpr size_t WS_GUS   = 692 * MiB;
constexpr size_t WS_H1    = 20 * MiB;
constexpr size_t WS_XS    = 84 * MiB;
constexpr size_t WS_YS    = WS_XS;
constexpr size_t WS_ACT   = 356 * MiB;
constexpr size_t WS_MIXB  = 628 * MiB;
constexpr size_t WS_WUP   = 758 * MiB;
constexpr size_t WS_WDN   = 822 * MiB;
constexpr size_t WS_H1Q   = 854 * MiB;
constexpr size_t WS_END   = 886 * MiB;
constexpr int CW_BAR = 4096;
constexpr int CW_CNT = 16384;
constexpr int CW_QH = 20480;

constexpr int RING_BYTES = 131072;
constexpr int LDS_BYTES = 147456;
constexpr int TAB_OFF = 132096;
constexpr int MISC_OFF = LDS_BYTES - 512;

#define LAS __attribute__((address_space(3)))
typedef unsigned short bf16;
typedef unsigned v4u __attribute__((ext_vector_type(4)));
typedef unsigned v2u __attribute__((ext_vector_type(2)));
typedef float f32x4 __attribute__((ext_vector_type(4)));
typedef short bf16x8 __attribute__((ext_vector_type(8)));
typedef int i32x4g __attribute__((ext_vector_type(4)));
#define LDS_WAIT() asm volatile("s_waitcnt lgkmcnt(0)" ::: "memory")
__device__ __forceinline__ float bflo(unsigned w) { return __uint_as_float(w << 16); }
__device__ __forceinline__ float bfhi(unsigned w) { return __uint_as_float(w & 0xffff0000u); }
typedef float f32x2_t __attribute__((ext_vector_type(2))); typedef __bf16 bf16x2_t __attribute__((ext_vector_type(2)));
__device__ __forceinline__ unsigned pk2(float lo, float hi) { const f32x2_t v = {lo, hi}; const bf16x2_t b = __builtin_convertvector(v, bf16x2_t); return __builtin_bit_cast(unsigned, b); }
__device__ __forceinline__ unsigned f2bf(float f) { return pk2(f, 0.f) & 0xffffu; }
#define CYC() ((unsigned)__builtin_amdgcn_s_getreg((19 << 11) | 29))
__device__ __forceinline__ void lds_barrier() { asm volatile("s_waitcnt lgkmcnt(0)" ::: "memory"); __builtin_amdgcn_s_barrier(); asm volatile("" ::: "memory"); }
__device__ __forceinline__ float shx(float v, int mask, int lane) { return __int_as_float(__builtin_amdgcn_ds_bpermute((lane ^ mask) << 2, __float_as_int(v))); }
template <int CTRL> __device__ __forceinline__ float dppf0(float x) { return __int_as_float(__builtin_amdgcn_update_dpp(0, __float_as_int(x), CTRL, 0xF, 0xF, true)); }
__device__ __forceinline__ float wave_sum(float v, int lane) {
    v += dppf0<0xB1>(v); v += dppf0<0x4E>(v); v += dppf0<0x141>(v); v += dppf0<0x140>(v);
    v += shx(v, 16, lane); v += shx(v, 32, lane);
    return v;
}
__device__ __forceinline__ float softplus_f(float x) { return fmaxf(x, 0.f) + log1pf(expf(-fabsf(x))); }
__device__ __forceinline__ float logsigmoid_f(float x) { return fminf(x, 0.f) - log1pf(expf(-fabsf(x))); }
__device__ __forceinline__ float sigmoid_f(float x) { return 1.f / (1.f + expf(-x)); }
__device__ __forceinline__ float fexp(float x) { return __builtin_amdgcn_exp2f(x * 1.4426950408889634f); }
__device__ __forceinline__ float flog(float x) { return __builtin_amdgcn_logf(x) * 0.6931471805599453f; }
__device__ __forceinline__ float fsigmoid(float x) { return __builtin_amdgcn_rcpf(1.f + fexp(-x)); }
__device__ __forceinline__ float ftanh(float x) { return 2.f * fsigmoid(2.f * x) - 1.f; }
__device__ __forceinline__ float fsoftplus(float x) { return fmaxf(x, 0.f) + flog(1.f + fexp(-fabsf(x))); }
__device__ __forceinline__ float flogsigmoid(float x) { return fminf(x, 0.f) - flog(1.f + fexp(-fabsf(x))); }
template <int CTRL> __device__ __forceinline__ float dppf(float x) { return __int_as_float(__builtin_amdgcn_update_dpp(0, __float_as_int(x), CTRL, 0xF, 0xF, true)); }
__device__ __forceinline__ float red8(float x) {
    x += dppf<0xB1>(x); x += dppf<0x4E>(x); x += dppf<0x141>(x); return x;
}
__device__ __forceinline__ f32x4 mfma16(bf16x8 a, bf16x8 b, f32x4 c) { return __builtin_amdgcn_mfma_f32_16x16x32_bf16(a, b, c, 0, 0, 0); }
__device__ __forceinline__ unsigned ld_agent(const unsigned* p) { return __hip_atomic_load(p, __ATOMIC_RELAXED, __HIP_MEMORY_SCOPE_AGENT); }

#define XB_TMO      128
#define XB_XCNT(j)  (256  + 64 * (j))
#define XB_XSUB(j)  (1280 + 64 * (j))
#define XB_XGEN(j)  (2304 + 64 * (j))
#define XB_TOP      3328
#define XB_TOPGEN   3392
#define XCD_BAR_WORDS 3456
#define XB_SPIN_CAP (1u << 18)
__device__ __forceinline__ unsigned xb_ld(unsigned* p)              { return __hip_atomic_load(p, __ATOMIC_RELAXED, __HIP_MEMORY_SCOPE_AGENT); }
__device__ __forceinline__ unsigned xb_add(unsigned* p, unsigned v) { return __hip_atomic_fetch_add(p, v, __ATOMIC_RELAXED, __HIP_MEMORY_SCOPE_AGENT); }
__device__ __forceinline__ unsigned xb_xcc_id() { return (unsigned)__builtin_amdgcn_s_getreg((3 << 11) | 20) & 0xFu; }
#define XB_SPIN(cond, bar) do { unsigned _sp = 0; while (cond) { __builtin_amdgcn_s_sleep(1); \
    if ((++_sp & 255u) == 0u) { if (xb_ld(&(bar)[XB_TMO])) break; if (_sp > XB_SPIN_CAP) { atomicAdd(&(bar)[XB_TMO], 1u); break; } } } } while (0)
struct XcdBarrier { unsigned* bar; unsigned x; volatile LAS unsigned* st; };
__device__ __forceinline__ XcdBarrier xcd_barrier_post(unsigned* bar, volatile LAS unsigned* st, bool leader) {
    XcdBarrier b; b.bar = bar; b.x = xb_xcc_id(); b.st = st;
    if (leader) (void)xb_add(&bar[XB_XCNT(b.x)], 1u);
    return b;
}
__device__ __forceinline__ void xcd_barrier_complete(unsigned* bar, unsigned x, unsigned& nloc, unsigned& nx) {
    const unsigned G = gridDim.x * gridDim.y * gridDim.z;
    unsigned sum, cnt, mine, sp = 0u;
    for (;;) {
        sum = 0u; cnt = 0u; mine = 0u;
#pragma unroll
        for (unsigned j = 0; j < 16; ++j) { const unsigned c = xb_ld(&bar[XB_XCNT(j)]); sum += c; cnt += (c > 0u) ? 1u : 0u; mine = (j == x) ? c : mine; }
        if (sum == G) break;
        __builtin_amdgcn_s_sleep(1);
        if ((++sp & 255u) == 0u) { if (xb_ld(&bar[XB_TMO])) break; if (sp > XB_SPIN_CAP) { atomicAdd(&bar[XB_TMO], 1u); break; } }
    }
    nloc = mine > 0u ? mine : 1u; nx = cnt > 0u ? cnt : 1u;
}
__device__ __forceinline__ void xcd_barrier(const XcdBarrier& b, bool leader) {
    asm volatile("s_waitcnt vmcnt(0)" ::: "memory");
    __syncthreads();
    if (leader) {
        unsigned* bar = b.bar;
        __builtin_amdgcn_s_waitcnt(0);
        unsigned nloc = b.st[0], nx = b.st[1];
        if (nloc == 0u) { xcd_barrier_complete(bar, b.x, nloc, nx); b.st[0] = nloc; b.st[1] = nx; }
        const unsigned old = xb_add(&bar[XB_XSUB(b.x)], 1u);
        const unsigned gen = old / nloc;
        if (old + 1u == (gen + 1u) * nloc) {
            __builtin_amdgcn_fence(__ATOMIC_RELEASE, "agent");
            asm volatile("s_waitcnt vmcnt(0)" ::: "memory");
            const unsigned og = xb_add(&bar[XB_TOP], 1u);
            const unsigned tg = og / nx;
            if (og + 1u == (tg + 1u) * nx) xb_add(&bar[XB_TOPGEN], 1u);
            else XB_SPIN(xb_ld(&bar[XB_TOPGEN]) == tg, bar);
            __builtin_amdgcn_fence(__ATOMIC_ACQUIRE, "agent");
            xb_add(&bar[XB_XGEN(b.x)], 1u);
            asm volatile("s_waitcnt vmcnt(0)" ::: "memory");
        } else {
            XB_SPIN(xb_ld(&bar[XB_XGEN(b.x)]) == gen, bar);
            __builtin_amdgcn_fence(__ATOMIC_ACQUIRE, "agent");
            asm volatile("s_waitcnt vmcnt(0)" ::: "memory");
        }
    }
    __syncthreads();
}

struct Args { const float* in[30]; float* out; unsigned char* ws; };
enum { I_X = 0, I_META, I_LNIN_G, I_LNIN_B, I_WIN, I_GKW2, I_GKB, I_GNORM, I_MU, I_W0, I_W2, I_A0, I_A2, I_G2, I_KK, I_KA, I_RK, I_RLNG, I_RLNB, I_WOUT,
       I_LN1G, I_LN1B, I_RTW, I_RTB, I_WUP, I_BUP, I_WDN, I_BDN, I_LN2G, I_LN2B };
struct Frame { LAS unsigned char* lds; int tid, lane, wave, blk, G; };
__device__ __forceinline__ int lane_id() { int l; asm volatile("v_mbcnt_lo_u32_b32 %0, -1, 0\n\tv_mbcnt_hi_u32_b32 %0, -1, %0" : "=v"(l)); return l; }
__device__ __forceinline__ Frame mkframe(LAS unsigned char* lds, int wave) { Frame F; F.lds = lds; F.wave = wave; F.lane = lane_id(); F.tid = wave * 64 + F.lane; F.blk = blockIdx.x; F.G = gridDim.x; return F; }

__device__ __forceinline__ void transpose_item(const float* W, int K, int N, int nblk, bf16* WT, LAS float* scr, int item, int lane) {
    const int kb = item / nblk, nb = item - kb * nblk, k0 = 64 * kb, n0 = 32 * nb;
    const int nn = n0 + (lane & 31); const bool ok = nn < N;
#pragma unroll 8
    for (int i = 0; i < 32; ++i) { const int kk = 2 * i + (lane >> 5); scr[kk * 33 + (lane & 31)] = ok ? W[(size_t)(k0 + kk) * N + nn] : 0.f; }
    LDS_WAIT();
    const int c = lane & 7;
#pragma unroll
    for (int j = 0; j < 4; ++j) { const int n = (lane >> 3) + 8 * j; const LAS float* s = scr + (8 * c) * 33 + n;
        v4u o; o.x = pk2(s[0 * 33], s[1 * 33]); o.y = pk2(s[2 * 33], s[3 * 33]); o.z = pk2(s[4 * 33], s[5 * 33]); o.w = pk2(s[6 * 33], s[7 * 33]);
        *(v4u*)(WT + (size_t)(n0 + n) * K + k0 + 8 * c) = o; }
    LDS_WAIT();
}

__device__ __forceinline__ void transpose_item64_f8(const float* W, int K, int N, unsigned char* WT, float scale, LAS float* scr, int item, int lane) {
    const int nblk = N >> 6, kb = item / nblk, nb = item - kb * nblk, k0 = 64 * kb, n0 = 64 * nb;
    const int r4 = lane >> 4, c4 = lane & 15;
    f32x4 v[16];
#pragma unroll
    for (int i = 0; i < 16; ++i) v[i] = *(const f32x4*)(W + (size_t)(k0 + 4 * i + r4) * N + n0 + 4 * c4);
#pragma unroll
    for (int i = 0; i < 16; ++i) *(LAS f32x4*)(scr + (4 * i + r4) * 68 + 4 * c4) = v[i];
    LDS_WAIT();
    unsigned char* orow = WT + (size_t)(n0 + lane) * K + k0;
#pragma unroll
    for (int g = 0; g < 4; ++g) { const LAS float* s = scr + (16 * g) * 68 + lane; v4u o;
#pragma unroll
        for (int q = 0; q < 4; ++q) { int w = __builtin_amdgcn_cvt_pk_fp8_f32(s[(4 * q + 0) * 68] * scale, s[(4 * q + 1) * 68] * scale, 0, false);
            w = __builtin_amdgcn_cvt_pk_fp8_f32(s[(4 * q + 2) * 68] * scale, s[(4 * q + 3) * 68] * scale, w, true); o[q] = (unsigned)w; }
        *(v4u*)(orow + 16 * g) = o; }
    LDS_WAIT();
}
__device__ __forceinline__ void convert_expert_weights(const Args& a, const Frame& F, int qsel) {
    unsigned char* ws = a.ws;
    LAS float* scr = (LAS float*)(F.lds + F.wave * 17408);
    unsigned* QH = (unsigned*)(ws + WS_CTL) + CW_QH + 64 * qsel;
    constexpr int I_UP = 16 * 32, I_DN = 16 * 16, NIT = NE * (I_UP + I_DN);
    for (;;) {
        unsigned base = 0;
        if (F.lane == 0) base = __hip_atomic_fetch_add(QH, 8u, __ATOMIC_RELAXED, __HIP_MEMORY_SCOPE_AGENT);
        base = (unsigned)__builtin_amdgcn_readfirstlane((int)base);
        if (base >= (unsigned)NIT) break;
        for (int it = (int)base; it < (int)base + 8; ++it) {
            if (it < NE * I_UP) { const int e = it / I_UP, r = it - e * I_UP;
                transpose_item64_f8(a.in[I_WUP] + (size_t)e * D * 2048, D, 2048, ws + WS_WUP + (size_t)e * 2048 * D, 64.f, scr, r, F.lane); }
            else { const int it2 = it - NE * I_UP, e = it2 / I_DN, r = it2 - e * I_DN;
                transpose_item64_f8(a.in[I_WDN] + (size_t)e * D * D, D, D, ws + WS_WDN + (size_t)e * D * D, 128.f, scr, r, F.lane); }
        }
    }
}

__device__ __forceinline__ void phase0(const Args& a, const Frame& F) {
    unsigned char* ws = a.ws;
    const int gw = F.blk * NWAVES + F.wave, NGW = F.G * NWAVES;
    for (int cgp = F.blk; cgp < 53; cgp += F.G) {
        LAS float* HM = (LAS float*)F.lds;
        LAS float* PART = (LAS float*)(F.lds + 65536);
        for (int rr = 0; rr < 2; ++rr) {
            const int row = 2 * F.wave + rr; const f32x4* xr = (const f32x4*)(a.in[I_META] + row * D) + F.lane;
            f32x4 v[4]; float s = 0.f;
#pragma unroll
            for (int j = 0; j < 4; ++j) { v[j] = xr[64 * j]; s += (v[j].x + v[j].y) + (v[j].z + v[j].w); }
            const float mean = wave_sum(s, F.lane) * (1.f / D); float s2 = 0.f;
#pragma unroll
            for (int j = 0; j < 4; ++j) { v[j] = v[j] - mean; s2 += (v[j].x * v[j].x + v[j].y * v[j].y) + (v[j].z * v[j].z + v[j].w * v[j].w); }
            const float rstd = 1.f / sqrtf(wave_sum(s2, F.lane) * (1.f / D) + 1e-5f);
#pragma unroll
            for (int j = 0; j < 4; ++j) { const int col = 4 * (F.lane + 64 * j);
                const f32x4 gv = *(const f32x4*)(a.in[I_LNIN_G] + col), bv = *(const f32x4*)(a.in[I_LNIN_B] + col);
                const f32x4 y = v[j] * rstd * gv + bv;
                HM[(col + 0) * 16 + row] = y.x; HM[(col + 1) * 16 + row] = y.y; HM[(col + 2) * 16 + row] = y.z; HM[(col + 3) * 16 + row] = y.w; }
        }
        __syncthreads();
        const int col = cgp * 64 + F.lane; const bool ok = col < INW;
        float acc[16];
#pragma unroll
        for (int r = 0; r < 16; ++r) acc[r] = 0.f;
        const float* wp = a.in[I_WIN];
        for (int k = F.wave * 128; k < F.wave * 128 + 128; ++k) {
            const float wv = ok ? wp[(size_t)k * INW + col] : 0.f;
            const LAS f32x4* h = (const LAS f32x4*)(HM + k * 16);
#pragma unroll
            for (int q = 0; q < 4; ++q) { const f32x4 hv = h[q]; acc[4 * q + 0] += hv.x * wv; acc[4 * q + 1] += hv.y * wv; acc[4 * q + 2] += hv.z * wv; acc[4 * q + 3] += hv.w * wv; }
        }
#pragma unroll
        for (int r = 0; r < 16; ++r) PART[(F.wave * 16 + r) * 64 + F.lane] = acc[r];
        __syncthreads();
        bf16* PROJM = (bf16*)(ws + WS_PROJM);
        for (int o = F.tid; o < 1024; o += NTHR) { const int r = o >> 6, l = o & 63; float s = 0.f;
#pragma unroll
            for (int w = 0; w < 8; ++w) s += PART[(w * 16 + r) * 64 + l];
            PROJM[r * PW + cgp * 64 + l] = (bf16)f2bf(s); }
        if (F.tid < 64) PROJM[NMETA * PW + cgp * 64 + F.tid] = 0;
        __syncthreads();
    }
    {
        LAS float* scr = (LAS float*)(F.lds + F.wave * 16384);
        constexpr int I_IN = 16 * (PW / 32), I_OUT = 16 * 32;
        for (int it = gw; it < I_IN + I_OUT; it += NGW) {
            if (it < I_IN) transpose_item(a.in[I_WIN], D, INW, PW / 32, (bf16*)(ws + WS_WIN), scr, it, F.lane);
            else transpose_item(a.in[I_WOUT], D, D, 32, (bf16*)(ws + WS_WOUT), scr, it - I_IN, F.lane);
        }
    }
    {
        bf16* W2T = (bf16*)(ws + WS_W2T); bf16* A2T = (bf16*)(ws + WS_A2T); bf16* G2T = (bf16*)(ws + WS_G2T);
        for (int i = F.blk * NTHR + F.tid; i < 131072; i += F.G * NTHR) {
            if (i < 32768) { const int n = i >> 6, k = i & 63; W2T[i] = (bf16)f2bf(a.in[I_W2][k * 512 + n]); }
            else if (i < 65536) { const int j = i - 32768, n = j >> 6, k = j & 63; A2T[j] = (bf16)f2bf(a.in[I_A2][k * 512 + n]); }
            else { const int j = i - 65536, n = j >> 7, k = j & 127; G2T[j] = (bf16)f2bf(a.in[I_G2][k * 512 + n]); }
        }
    }
    {
        bf16* RWH = (bf16*)(ws + WS_RWH); bf16* RWL = (bf16*)(ws + WS_RWL);
        for (int i = F.blk * NTHR + F.tid; i < D * NE; i += F.G * NTHR) { const int c = i >> 5, e = i & 31; const float w = a.in[I_RTW][i];
            const unsigned hi = f2bf(w); const float lo = w - __uint_as_float(hi << 16);
            RWH[e * D + c] = (bf16)hi; RWL[e * D + c] = (bf16)f2bf(lo); }
    }
    {
        bf16* A0 = (bf16*)(ws + WS_A0); float* ST = (float*)(ws + WS_STATS);
        for (int m0 = gw; m0 < MX; m0 += 2 * NGW) {
            f32x4 v[2][4];
#pragma unroll
            for (int r = 0; r < 2; ++r) { const f32x4* xr = (const f32x4*)(a.in[I_X] + (size_t)(m0 + r * NGW) * D) + F.lane;
#pragma unroll
                for (int j = 0; j < 4; ++j) v[r][j] = xr[64 * j]; }
#pragma unroll
            for (int r = 0; r < 2; ++r) { const int m = m0 + r * NGW; float s = 0.f;
#pragma unroll
                for (int j = 0; j < 4; ++j) s += (v[r][j].x + v[r][j].y) + (v[r][j].z + v[r][j].w);
                const float mean = wave_sum(s, F.lane) * (1.f / D); float s2 = 0.f;
#pragma unroll
                for (int j = 0; j < 4; ++j) { v[r][j] = v[r][j] - mean; s2 += (v[r][j].x * v[r][j].x + v[r][j].y * v[r][j].y) + (v[r][j].z * v[r][j].z + v[r][j].w * v[r][j].w); }
                const float rstd = __builtin_amdgcn_rsqf(wave_sum(s2, F.lane) * (1.f / D) + 1e-5f);
#pragma unroll
                for (int j = 0; j < 4; ++j) { const int col = 4 * (F.lane + 64 * j);
                    const f32x4 gv = *(const f32x4*)(a.in[I_LNIN_G] + col), bv = *(const f32x4*)(a.in[I_LNIN_B] + col);
                    const f32x4 y = v[r][j] * rstd * gv + bv;
                    v2u o; o.x = pk2(y.x, y.y); o.y = pk2(y.z, y.w);
                    *(v2u*)(A0 + (size_t)m * D + col) = o; }
                if (F.lane == 0) { ST[2 * m] = mean; ST[2 * m + 1] = rstd; } }
        }
    }
    __syncthreads();
    for (int rep_ = 0; rep_ < NREP(14); ++rep_) convert_expert_weights(a, F, rep_);
}

__device__ __forceinline__ const bf16* prow(const bf16* PROJ, const bf16* PROJM, int b, int vp) {
    const bf16* px = PROJ + (size_t)(b * SEQ + (vp >= NMETA ? vp - NMETA : 0)) * PW;
    const bf16* pm = PROJM + (size_t)(vp < 0 ? NMETA : (vp < NMETA ? vp : 0)) * PW;
    return vp >= NMETA ? px : pm;
}
__device__ __forceinline__ f32x4 ldp4(const bf16* PROJ, const bf16* PROJM, int b, int vp, int col) {
    const v2u w = *(const v2u*)(prow(PROJ, PROJM, b, vp) + col);
    return (f32x4){bflo(w.x), bfhi(w.x), bflo(w.y), bfhi(w.y)};
}

constexpr int R1_STRIDE = 49152;
constexpr int TP = 80;
constexpr int L1_SLOT = 64 * TP * 2;
constexpr int L1_LC = 12 * L1_SLOT;
constexpr int L1_XCH = L1_LC + 64 * 65 * 4;
constexpr int L1_LR = 8 * L1_SLOT;
__device__ __forceinline__ v2u pack4(f32x4 v) { v2u o; o.x = pk2(v[0], v[1]); o.y = pk2(v[2], v[3]); return o; }
__device__ __forceinline__ f32x4 tile_mm(const LAS bf16* A, const LAS bf16* Bt, int rt, int ct, int fr, int fq, f32x4 acc) {
#pragma unroll
    for (int ks = 0; ks < 2; ++ks)
        acc = mfma16(*(const LAS bf16x8*)(Bt + (ct * 16 + fr) * TP + ks * 32 + 8 * fq), *(const LAS bf16x8*)(A + (rt * 16 + fr) * TP + ks * 32 + 8 * fq), acc);
    return acc;
}
__device__ __forceinline__ void tile_st(LAS bf16* O, int rt, int ct, int fr, int fq, f32x4 v) { *(LAS v2u*)(O + (rt * 16 + fr) * TP + ct * 16 + 4 * fq) = pack4(v); }
#define L1S(n) ((LAS bf16*)(F.lds + (n) * L1_SLOT))

struct L1Pf { v4u sa[5]; v2u r[2][2], k[2][2], v[2][2]; };
__device__ __forceinline__ void l1_fetch(const Args& a, const Frame& F, int b, int h, int c, L1Pf& pf, bool need_sa) {
    const bf16* PROJ = (const bf16*)(a.ws + WS_PROJ); const bf16* PROJM = (const bf16*)(a.ws + WS_PROJM);
    const int vp0 = (c == 0) ? -48 : NMETA + 64 * (c - 1);
    if (need_sa) { const int cg = F.tid & 31, tr = F.tid >> 5;
#pragma unroll
      for (int i = 0; i < 5; ++i) pf.sa[i] = *(const v4u*)(prow(PROJ, PROJM, b, vp0 + 4 * tr - 1 + i) + RWL + 8 * cg); }
    { const int rt = F.wave & 3, cp = F.wave >> 2, fr = F.lane & 15, fq = F.lane >> 4, vp = vp0 + rt * 16 + fr;
      const bf16* p0 = prow(PROJ, PROJM, b, vp - 1); const bf16* p1 = prow(PROJ, PROJM, b, vp);
#pragma unroll
      for (int cc = 0; cc < 2; ++cc) { const int jc = h * 64 + (2 * cp + cc) * 16 + 4 * fq;
          pf.r[cc][0] = *(const v2u*)(p0 + RR + jc); pf.r[cc][1] = *(const v2u*)(p1 + RR + jc);
          pf.k[cc][0] = *(const v2u*)(p0 + RK + jc); pf.k[cc][1] = *(const v2u*)(p1 + RK + jc);
          pf.v[cc][0] = *(const v2u*)(p0 + RV + jc); pf.v[cc][1] = *(const v2u*)(p1 + RV + jc); } }
}
__device__ __forceinline__ f32x4 unpk4(v2u w) { return (f32x4){bflo(w.x), bfhi(w.x), bflo(w.y), bfhi(w.y)}; }

__device__ __forceinline__ void rwkv_l1_front(const Args& a, const Frame& F, int b, int h, int c, const L1Pf& pf, f32x4 (&rtil)[2], bool newgrp, bf16x8 (&lrf)[8]) {
    unsigned char* ws = a.ws;
    const bf16* W2T = (const bf16*)(ws + WS_W2T); const bf16* A2T = (const bf16*)(ws + WS_A2T); const bf16* G2T = (const bf16*)(ws + WS_G2T);
    const int unit = (b * 8 + h) * NCH + c;
    unsigned char* r1 = ws + WS_R1 + (size_t)unit * R1_STRIDE;
    float* GAM = (float*)(ws + WS_GAM) + (size_t)unit * 64;
    const float* mu = a.in[I_MU];
    const int vp0 = (c == 0) ? -48 : NMETA + 64 * (c - 1);
    constexpr int LRP = 264;
    LAS bf16* LR = (LAS bf16*)(F.lds + L1_LR);
    LAS float* LC = (LAS float*)(F.lds + L1_LC);
    LAS float* XCH = (LAS float*)(F.lds + L1_XCH);
    const int rt = F.wave & 3, cp = F.wave >> 2, fr = F.lane & 15, fq = F.lane >> 4;
    if (newgrp) {
        const int cg = F.tid & 31, tr = F.tid >> 5;
        const f32x4 m0 = *(const f32x4*)(mu + 1536 + 8 * cg), m1 = *(const f32x4*)(mu + 1536 + 8 * cg + 4);
#pragma unroll
        for (int i = 0; i < 4; ++i) {
            const int row = 4 * tr + i;
            const v4u cw = pf.sa[i + 1], pw = pf.sa[i];
            const f32x4 c0 = unpk4((v2u){cw.x, cw.y}), c1 = unpk4((v2u){cw.z, cw.w}), p0 = unpk4((v2u){pw.x, pw.y}), p1 = unpk4((v2u){pw.z, pw.w});
            float v[8];
            v[0] = c0.x + (p0.x - c0.x) * m0.x; v[1] = c0.y + (p0.y - c0.y) * m0.y; v[2] = c0.z + (p0.z - c0.z) * m0.z; v[3] = c0.w + (p0.w - c0.w) * m0.w;
            v[4] = c1.x + (p1.x - c1.x) * m1.x; v[5] = c1.y + (p1.y - c1.y) * m1.y; v[6] = c1.z + (p1.z - c1.z) * m1.z; v[7] = c1.w + (p1.w - c1.w) * m1.w;
#pragma unroll
            for (int q = 0; q < 8; ++q) { if (cg < 8) v[q] = ftanh(v[q]); else if (cg >= 16) v[q] = fsigmoid(v[q]); }
            v4u o; o.x = pk2(v[0], v[1]); o.y = pk2(v[2], v[3]); o.z = pk2(v[4], v[5]); o.w = pk2(v[6], v[7]);
            *(LAS v4u*)(LR + row * LRP + 8 * cg) = o;
        }
    }
    const int t = rt * 16 + fr, vp = vp0 + t;
    const bool valid = vp >= 0;
    if (newgrp) { lds_barrier();
        const LAS bf16* lrow = LR + t * LRP + 8 * fq;
#pragma unroll
        for (int q = 0; q < 8; ++q) lrf[q] = *(const LAS bf16x8*)(lrow + q * 32); }
    float lwv[2][4], asg[2][4], kkr[2][4], kmd[2][4], rrv[2][4], vvv[2][4];
    float ssq = 0.f, bon = 0.f;
    {
#pragma unroll
        for (int cc = 0; cc < 2; ++cc) {
            const int ct = 2 * cp + cc, j = ct * 16 + 4 * fq, jc = h * 64 + j;
            f32x4 mr[2], mk[2], mv[2], w0v[2], a0v[2], kkw[2], kaw[2], rkw[2];
            mr[cc] = *(const f32x4*)(mu + jc); mk[cc] = *(const f32x4*)(mu + 512 + jc); mv[cc] = *(const f32x4*)(mu + 1024 + jc);
            w0v[cc] = *(const f32x4*)(a.in[I_W0] + jc); a0v[cc] = *(const f32x4*)(a.in[I_A0] + jc);
            kkw[cc] = *(const f32x4*)(a.in[I_KK] + jc); kaw[cc] = *(const f32x4*)(a.in[I_KA] + jc); rkw[cc] = *(const f32x4*)(a.in[I_RK] + jc);
            f32x4 aw = {0.f, 0.f, 0.f, 0.f}, aa = aw, ag = aw;
#pragma unroll
            for (int ks = 0; ks < 2; ++ks) {
                aw = mfma16(*(const bf16x8*)(W2T + (size_t)(h * 64 + ct * 16 + fr) * 64 + ks * 32 + 8 * fq), lrf[ks], aw);
                aa = mfma16(*(const bf16x8*)(A2T + (size_t)(h * 64 + ct * 16 + fr) * 64 + ks * 32 + 8 * fq), lrf[2 + ks], aa);
            }
#pragma unroll
            for (int ks = 0; ks < 4; ++ks) ag = mfma16(*(const bf16x8*)(G2T + (size_t)(h * 64 + ct * 16 + fr) * 128 + ks * 32 + 8 * fq), lrf[4 + ks], ag);
            const f32x4 rc = unpk4(pf.r[cc][1]), rp = unpk4(pf.r[cc][0]), kc = unpk4(pf.k[cc][1]), kp = unpk4(pf.k[cc][0]), vc = unpk4(pf.v[cc][1]), vpv = unpk4(pf.v[cc][0]);
            const f32x4 rs = rc + (rp - rc) * mr[cc], ks_ = kc + (kp - kc) * mk[cc], vs = vc + (vpv - vc) * mv[cc];
#pragma unroll
            for (int i = 0; i < 4; ++i) {
                const float u = w0v[cc][i] + aw[i];
                const float wl = -fsoftplus(-u) - 0.5f;
                lwv[cc][i] = valid ? -fexp(wl) : 0.f;
                const float as_ = fsigmoid(a0v[cc][i] + aa[i]);
                asg[cc][i] = as_;
                const float kraw = ks_[i], kk = kraw * kkw[cc][i];
                kkr[cc][i] = kk; ssq += kk * kk;
                const float km = kraw * (1.f + (as_ - 1.f) * kaw[cc][i]);
                kmd[cc][i] = km; rrv[cc][i] = rs[i]; vvv[cc][i] = vs[i];
                bon += rs[i] * km * rkw[cc][i];
            }
            *(v2u*)(r1 + 4 * 8192 + (size_t)(t * 64 + j) * 2) = pack4(ag);
            __builtin_amdgcn_sched_barrier(0);
        }
#pragma unroll
        for (int cc = 0; cc < 2; ++cc)
#pragma unroll
            for (int i = 0; i < 4; ++i) LC[t * 65 + (2 * cp + cc) * 16 + 4 * fq + i] = lwv[cc][i];
        ssq += shx(ssq, 16, F.lane); ssq += shx(ssq, 32, F.lane);
        bon += shx(bon, 16, F.lane); bon += shx(bon, 32, F.lane);
        if (fq == 0) { XCH[(cp * 64 + t) * 2] = ssq; XCH[(cp * 64 + t) * 2 + 1] = bon; }
    }
    lds_barrier();
    const float ssq_t = XCH[t * 2] + XCH[(64 + t) * 2], bon_t = XCH[t * 2 + 1] + XCH[(64 + t) * 2 + 1];
    const float inv = 1.f / fmaxf(sqrtf(ssq_t), 1e-12f);
    {
        LAS float* SEG = XCH + 256;
        const int jj = F.tid & 63, sg = F.tid >> 6;
        float cv[8];
#pragma unroll
        for (int i = 0; i < 8; ++i) cv[i] = LC[(sg * 8 + i) * 65 + jj];
#pragma unroll
        for (int i = 1; i < 8; ++i) cv[i] += cv[i - 1];
        SEG[sg * 64 + jj] = cv[7];
        lds_barrier();
        float pre = 0.f;
#pragma unroll
        for (int s2 = 0; s2 < 7; ++s2) pre += (s2 < sg) ? SEG[s2 * 64 + jj] : 0.f;
#pragma unroll
        for (int i = 0; i < 8; ++i) LC[(sg * 8 + i) * 65 + jj] = cv[i] + pre;
    }
    lds_barrier();
    {
#pragma unroll
        for (int cc = 0; cc < 2; ++cc) {
            const int j = (2 * cp + cc) * 16 + 4 * fq;
            f32x4 At, Bt, Kt, Bh, Kh, bvv;
#pragma unroll
            for (int i = 0; i < 4; ++i) {
                const float Lc = LC[t * 65 + j + i], LcC = LC[63 * 65 + j + i];
                const float kn = kkr[cc][i] * inv, av = -kn, bv = kn * asg[cc][i], km = kmd[cc][i];
                const float eA = fexp(Lc - lwv[cc][i]), eR = fexp(Lc), eB = fexp(-Lc), eH = fexp(LcC - Lc);
                At[i] = av * eA; rtil[cc][i] = rrv[cc][i] * eR; Bt[i] = bv * eB; Kt[i] = km * eB; Bh[i] = bv * eH; Kh[i] = km * eH;
                bvv[i] = bon_t * vvv[cc][i];
                if (t == 63) GAM[j + i] = fexp(LcC);
            }
            *(LAS v2u*)(L1S(0) + t * TP + j) = pack4(Bt); *(LAS v2u*)(L1S(1) + t * TP + j) = pack4(Kt);
            *(LAS v2u*)(L1S(2) + t * TP + j) = pack4(At); *(LAS v2u*)(L1S(3) + t * TP + j) = pack4(rtil[cc]);
#pragma unroll
            for (int i = 0; i < 4; ++i) {
                L1S(4)[(j + i) * TP + t] = (bf16)f2bf(At[i]); L1S(5)[(j + i) * TP + t] = (bf16)f2bf(Bh[i]);
                L1S(6)[(j + i) * TP + t] = (bf16)f2bf(Kh[i]); L1S(7)[(j + i) * TP + t] = (bf16)f2bf(vvv[cc][i]);
            }
            *(v2u*)(r1 + 5 * 8192 + (size_t)(t * 64 + j) * 2) = pack4(bvv);
        }
    }
    lds_barrier();
}
__device__ __forceinline__ void rwkv_l1_back(const Args& a, const Frame& F, int b, int h, int c, const f32x4 (&rtil)[2]) {
    unsigned char* r1 = a.ws + WS_R1 + (size_t)((b * 8 + h) * NCH + c) * R1_STRIDE;
    const int rt = F.wave & 3, cp = F.wave >> 2, fr = F.lane & 15, fq = F.lane >> 4;
    f32x4 Pt[2];
    const int mrow = rt * 16 + fr;
    const f32x4 z = {0.f, 0.f, 0.f, 0.f};
    {
        f32x4 Lv[2], Nv[2], Mv[2], Bv[2], Kv[2];
#pragma unroll
        for (int cc = 0; cc < 2; ++cc) { const int ct = 2 * cp + cc;
            Lv[cc] = tile_mm(L1S(2), L1S(0), rt, ct, fr, fq, z); Nv[cc] = tile_mm(L1S(0), L1S(2), rt, ct, fr, fq, z); Mv[cc] = tile_mm(L1S(2), L1S(1), rt, ct, fr, fq, z);
            Bv[cc] = tile_mm(L1S(3), L1S(0), rt, ct, fr, fq, z); Kv[cc] = tile_mm(L1S(3), L1S(1), rt, ct, fr, fq, z); }
#pragma unroll
        for (int cc = 0; cc < 2; ++cc) { const int ct = 2 * cp + cc, n0 = ct * 16 + 4 * fq;
#pragma unroll
            for (int i = 0; i < 4; ++i) { const int n = n0 + i;
                if (!(n < mrow)) { Lv[cc][i] = 0.f; Mv[cc][i] = 0.f; } if (!(mrow < n)) Nv[cc][i] = 0.f; if (!(n <= mrow)) { Bv[cc][i] = 0.f; Kv[cc][i] = 0.f; }
                Pt[cc][i] = Lv[cc][i] + ((n == mrow) ? 1.f : 0.f); }
            tile_st(L1S(8), rt, ct, fr, fq, Lv[cc]); tile_st(L1S(9), rt, ct, fr, fq, Nv[cc]); tile_st(L1S(10), rt, ct, fr, fq, Mv[cc]);
            tile_st(L1S(11), rt, ct, fr, fq, Bv[cc]); tile_st(L1S(12), rt, ct, fr, fq, Kv[cc]); }
    }
    lds_barrier();
    f32x4 Xv[2];
#pragma unroll
    for (int st = 1; st <= 6; ++st) {
        LAS bf16* Xl = (st & 1) ? L1S(8) : L1S(0); LAS bf16* Xn = (st & 1) ? L1S(9) : L1S(1);
        LAS bf16* Yl = (st & 1) ? L1S(0) : L1S(8); LAS bf16* Yn = (st & 1) ? L1S(1) : L1S(9);
        LAS bf16* Pr = (st & 1) ? L1S(2) : L1S(3); LAS bf16* Pw = (st & 1) ? L1S(3) : L1S(2);
        f32x4 l2[2], n2[2];
#pragma unroll
        for (int cc = 0; cc < 2; ++cc) { const int ct = 2 * cp + cc;
            if (st <= 5) { l2[cc] = tile_mm(Xl, Xn, rt, ct, fr, fq, z); n2[cc] = tile_mm(Xn, Xl, rt, ct, fr, fq, z); }
            if (st >= 2) Pt[cc] = tile_mm(Pr, Xn, rt, ct, fr, fq, Pt[cc]);
            if (st == 1) Xv[cc] = tile_mm(L1S(7), L1S(10), rt, ct, fr, fq, z); }
#pragma unroll
        for (int cc = 0; cc < 2; ++cc) { const int ct = 2 * cp + cc;
            if (st <= 5) { tile_st(Yl, rt, ct, fr, fq, l2[cc]); tile_st(Yn, rt, ct, fr, fq, n2[cc]); }
            tile_st(Pw, rt, ct, fr, fq, Pt[cc]); }
        if (st == 1) { lds_barrier();
#pragma unroll
            for (int cc = 0; cc < 2; ++cc) tile_st(L1S(10), rt, 2 * cp + cc, fr, fq, Xv[cc]); }
        lds_barrier();
    }
    {
        f32x4 u[2], w[2];
#pragma unroll
        for (int cc = 0; cc < 2; ++cc) { const int ct = 2 * cp + cc; u[cc] = tile_mm(L1S(10), L1S(2), rt, ct, fr, fq, z); w[cc] = tile_mm(L1S(4), L1S(2), rt, ct, fr, fq, z); }
#pragma unroll
        for (int cc = 0; cc < 2; ++cc) { const int ct = 2 * cp + cc; tile_st(L1S(8), rt, ct, fr, fq, u[cc]); tile_st(L1S(9), rt, ct, fr, fq, w[cc]); }
    }
    lds_barrier();
    {
#pragma unroll
        for (int cc = 0; cc < 2; ++cc) { const int ct = 2 * cp + cc; const size_t eo = (size_t)(mrow * 64 + ct * 16 + 4 * fq) * 2;
            const f32x4 gp = tile_mm(L1S(5), L1S(9), rt, ct, fr, fq, z);
            const f32x4 hh = tile_mm(L1S(7), L1S(6), rt, ct, fr, fq, tile_mm(L1S(8), L1S(5), rt, ct, fr, fq, z));
            const f32x4 rh = tile_mm(L1S(11), L1S(9), rt, ct, fr, fq, rtil[cc]);
            const f32x4 yl = tile_mm(L1S(12), L1S(7), rt, ct, fr, fq, tile_mm(L1S(11), L1S(8), rt, ct, fr, fq, z));
            *(v2u*)(r1 + 0 * 8192 + eo) = pack4(gp); *(v2u*)(r1 + 1 * 8192 + eo) = pack4(hh);
            *(v2u*)(r1 + 2 * 8192 + eo) = pack4(rh); *(v2u*)(r1 + 3 * 8192 + eo) = pack4(yl); }
    }
    lds_barrier();
}

constexpr int BCP = 65;
__device__ __forceinline__ void gla_bc(const Args& a, const Frame& F, int b, int h, int vp0, int ntok) {
    const bf16* PROJ = (const bf16*)(a.ws + WS_PROJ); const bf16* PROJM = (const bf16*)(a.ws + WS_PROJM);
    LAS float* GKLs = (LAS float*)F.lds; LAS float* BC = (LAS float*)(F.lds + 4096);
    if (F.tid < 256) { const int t = F.tid >> 2, q = F.tid & 3;
        const f32x4 v = ldp4(PROJ, PROJM, b, (t < ntok) ? vp0 + t : -1, GKL + 4 * q);
        *(LAS f32x4*)(GKLs + t * 16 + 4 * q) = v; }
    lds_barrier();
    {
        const int d = F.tid & 63, tg = F.tid >> 6;
        float wc[16];
#pragma unroll
        for (int r = 0; r < 16; ++r) wc[r] = a.in[I_GKW2][r * 256 + h * 64 + d];
        const float gb = a.in[I_GKB][h * 64 + d];
        float lgv[8];
#pragma unroll
        for (int i = 0; i < 8; ++i) { const int t = tg * 8 + i; float z = gb;
            const LAS f32x4* g4 = (const LAS f32x4*)(GKLs + t * 16);
#pragma unroll
            for (int q = 0; q < 4; ++q) { const f32x4 gv = g4[q]; z += gv.x * wc[4 * q] + gv.y * wc[4 * q + 1] + gv.z * wc[4 * q + 2] + gv.w * wc[4 * q + 3]; }
            lgv[i] = (t < ntok) ? flogsigmoid(z) * (1.f / 16.f) : 0.f; }
        LAS float* SEG = (LAS float*)(F.lds + 20736);
#pragma unroll
        for (int i = 1; i < 8; ++i) lgv[i] += lgv[i - 1];
        SEG[tg * 64 + d] = lgv[7];
        lds_barrier();
        float pre = 0.f;
#pragma unroll
        for (int s2 = 0; s2 < 7; ++s2) pre += (s2 < tg) ? SEG[s2 * 64 + d] : 0.f;
#pragma unroll
        for (int i = 0; i < 8; ++i) BC[(tg * 8 + i) * BCP + d] = lgv[i] + pre;
    }
    lds_barrier();
}

__device__ __forceinline__ void gla_g1_unit(const Args& a, const Frame& F, int b, int h, int c) {
    const bf16* PROJ = (const bf16*)(a.ws + WS_PROJ); const bf16* PROJM = (const bf16*)(a.ws + WS_PROJM);
    float* GUS = (float*)(a.ws + WS_GUS); float* DL = (float*)(a.ws + WS_DL);
    const int ntok = (c == 0) ? NMETA : 64, vp0 = (c == 0) ? 0 : NMETA + 64 * (c - 1);
    gla_bc(a, F, b, h, vp0, ntok);
    LAS float* BC = (LAS float*)(F.lds + 4096);
    LAS bf16* KT = (LAS bf16*)(F.lds + 24576);
    LAS bf16* VT = (LAS bf16*)(F.lds + 24576 + 64 * TP * 2);
    {
        const int t = F.tid >> 3, q = F.tid & 7;
        const float* bl = nullptr; (void)bl;
#pragma unroll
        for (int half = 0; half < 2; ++half) {
            const int d0 = 8 * q + 4 * half;
            const f32x4 kv = ldp4(PROJ, PROJM, b, (t < ntok) ? vp0 + t : -1, GK + h * 64 + d0);
#pragma unroll
            for (int i = 0; i < 4; ++i) { const int d = d0 + i; const float e = (t < ntok) ? fexp(BC[(ntok - 1) * BCP + d] - BC[t * BCP + d]) : 0.f;
                KT[d * TP + t] = (bf16)f2bf(kv[i] * e); }
        }
#pragma unroll
        for (int qq = 0; qq < 4; ++qq) {
            const int e0 = 16 * q + 4 * qq;
            const f32x4 vv = ldp4(PROJ, PROJM, b, (t < ntok) ? vp0 + t : -1, GV + h * 128 + e0);
#pragma unroll
            for (int i = 0; i < 4; ++i) VT[(e0 + i) * TP + t] = (bf16)f2bf(vv[i]);
        }
    }
    lds_barrier();
    {
        const int rt = F.wave & 3, ch = F.wave >> 2, fr = F.lane & 15, fq = F.lane >> 4;
        float* up = GUS + ((size_t)((b * 4 + h) * NCH + c) * 64 + rt * 16 + fr) * 128;
#pragma unroll
        for (int cc = 0; cc < 4; ++cc) { const int ct = ch * 4 + cc;
            f32x4 acc = {0.f, 0.f, 0.f, 0.f};
#pragma unroll
            for (int ks = 0; ks < 2; ++ks)
                acc = mfma16(*(const LAS bf16x8*)(VT + (ct * 16 + fr) * TP + ks * 32 + 8 * fq), *(const LAS bf16x8*)(KT + (rt * 16 + fr) * TP + ks * 32 + 8 * fq), acc);
            *(f32x4*)(up + ct * 16 + 4 * fq) = acc; }
        if (F.tid < 64) DL[(size_t)((b * 4 + h) * NCH + c) * 64 + F.tid] = fexp(BC[(ntok - 1) * BCP + F.tid]);
    }
    lds_barrier();
}

__device__ __forceinline__ void phase2(const Args& a, const Frame& F) {
    {
        constexpr int NU = NB * 8 * NCH;
        const int u0 = (int)((long)F.blk * NU / F.G), u1 = (int)((long)(F.blk + 1) * NU / F.G);
        L1Pf pf;
        bf16x8 lrf[8];
        if (u0 < u1) l1_fetch(a, F, (u0 >> 3) / NCH, u0 & 7, (u0 >> 3) % NCH, pf, true);
        unsigned long long tf_ = 0, tb_ = 0;
        for (int u = u0; u < u1; ++u) {
            const int h = u & 7, c = (u >> 3) % NCH, b = (u >> 3) / NCH; f32x4 rtil[2];
            const bool newgrp = (u == u0) || (h == 0);
            { const Frame F1 = mkframe(F.lds, F.wave); rwkv_l1_front(a, F1, b, h, c, pf, rtil, newgrp, lrf); }
            { const Frame F2 = mkframe(F.lds, F.wave);
              if (u + 1 < u1) l1_fetch(a, F2, ((u + 1) >> 3) / NCH, (u + 1) & 7, ((u + 1) >> 3) % NCH, pf, ((u + 1) & 7) == 0);
              rwkv_l1_back(a, F2, b, h, c, rtil); }
        }
        if ((REP_MASK >> 16) != 0) {
            const unsigned long long dt_ = ((REP_MASK >> 16) == 1) ? tf_ : tb_, s0_ = __builtin_amdgcn_s_memrealtime();
            while (__builtin_amdgcn_s_memrealtime() - s0_ < dt_) __builtin_amdgcn_s_sleep(8);
        }
    }
    for (int rep_ = 0; rep_ < NREP(12); ++rep_)
    for (int u = F.blk; u < NB * 4 * 32; u += F.G) { const int c = u & 31, bh = u >> 5; const Frame F1 = mkframe(F.lds, F.wave); gla_g1_unit(a, F1, bh >> 2, bh & 3, c); }
}

struct L2S { bf16x8 fg[4]; v2u hq[2]; f32x4 gm[2]; };
__device__ __forceinline__ void l2s_fetch(L2S& r, const unsigned char* hp, const unsigned char* gp, const float* gam) {
#pragma unroll
    for (int cc = 0; cc < 2; ++cc) { r.fg[2 * cc] = *(const bf16x8*)(gp + cc * 2048); r.fg[2 * cc + 1] = *(const bf16x8*)(gp + cc * 2048 + 64);
        r.hq[cc] = *(const v2u*)(hp + cc * 32); r.gm[cc] = *(const f32x4*)(gam + cc * 16); }
}
__device__ __forceinline__ void l2s_step(const L2S& r, const LAS bf16* Sc, LAS bf16* Sn, f32x4 (&Sm)[2], int row, int col0, int fq, bf16* gout, int tid) {
    {
        const int r_ = tid >> 3, c8 = tid & 7;
        *(v4u*)(gout + r_ * 64 + 8 * c8) = *(const LAS v4u*)(Sc + r_ * TP + 8 * c8);
    }
    const bf16x8 af0 = *(const LAS bf16x8*)(Sc + row * TP + 8 * fq), af1 = *(const LAS bf16x8*)(Sc + row * TP + 32 + 8 * fq);
#pragma unroll
    for (int cc = 0; cc < 2; ++cc) {
        f32x4 acc = {bflo(r.hq[cc].x), bfhi(r.hq[cc].x), bflo(r.hq[cc].y), bfhi(r.hq[cc].y)};
        acc = mfma16(r.fg[2 * cc], af0, acc);
        acc = mfma16(r.fg[2 * cc + 1], af1, acc);
        Sm[cc] = Sm[cc] * r.gm[cc] + acc; }
#pragma unroll
    for (int cc = 0; cc < 2; ++cc) *(LAS v2u*)(Sn + row * TP + col0 + cc * 16) = pack4(Sm[cc]);
}
__device__ __forceinline__ void rwkv_l2_unit(const Args& a, const Frame& F, int bh) {
    unsigned char* ws = a.ws;
    LAS bf16* Sb0 = (LAS bf16*)F.lds; LAS bf16* Sb1 = Sb0 + 64 * TP;
    const int fr = F.lane & 15, fq = F.lane >> 4, rt = F.wave & 3, cp = F.wave >> 2;
    const int row = rt * 16 + fr, col0 = cp * 32 + 4 * fq;
    const unsigned char* hpb = ws + WS_R1 + (size_t)bh * NCH * R1_STRIDE + 8192 + (size_t)(row * 64 + col0) * 2;
    const unsigned char* gpb = ws + WS_R1 + (size_t)bh * NCH * R1_STRIDE + (size_t)((cp * 32 + fr) * 64 + 8 * fq) * 2;
    const float* gamb = (const float*)(ws + WS_GAM) + (size_t)bh * NCH * 64 + col0;
    bf16* sst = (bf16*)(ws + WS_SST) + (size_t)bh * NCH * 4096;
    f32x4 Sm[2];
#pragma unroll
    for (int cc = 0; cc < 2; ++cc) { Sm[cc] = (f32x4){0.f, 0.f, 0.f, 0.f}; *(LAS v2u*)(Sb0 + row * TP + col0 + cc * 16) = (v2u){0u, 0u}; }
    L2S r0, r1, r2, r3;
#define L2F(rr, cn) l2s_fetch(rr, hpb + (size_t)(cn) * R1_STRIDE, gpb + (size_t)(cn) * R1_STRIDE, gamb + (size_t)(cn) * 64)
    L2F(r0, 0); L2F(r1, 1); L2F(r2, 2);
    lds_barrier();
#pragma nounroll
    for (int c = 0; c < NCH - 1; c += 4) {
        L2F(r3, c + 3);
        l2s_step(r0, Sb0, Sb1, Sm, row, col0, fq, sst + (size_t)c * 4096, F.tid); lds_barrier();
        if (c + 4 < NCH - 1) L2F(r0, c + 4);
        l2s_step(r1, Sb1, Sb0, Sm, row, col0, fq, sst + (size_t)(c + 1) * 4096, F.tid); lds_barrier();
        if (c + 5 < NCH - 1) L2F(r1, c + 5);
        l2s_step(r2, Sb0, Sb1, Sm, row, col0, fq, sst + (size_t)(c + 2) * 4096, F.tid); lds_barrier();
        if (c + 6 < NCH - 1) L2F(r2, c + 6);
        l2s_step(r3, Sb1, Sb0, Sm, row, col0, fq, sst + (size_t)(c + 3) * 4096, F.tid); lds_barrier();
    }
#undef L2F
    { const int r_ = F.tid >> 3, c8 = F.tid & 7;
      *(v4u*)(sst + (size_t)(NCH - 1) * 4096 + r_ * 64 + 8 * c8) = *(const LAS v4u*)(Sb0 + r_ * TP + 8 * c8); }
    lds_barrier();
}
__device__ __forceinline__ void rwkv_y_task(const Args& a, const Frame& F, int task) {
    unsigned char* ws = a.ws;
    const int rt = task & 3, c = 1 + ((task >> 2) & 31), bh = task >> 7, b = bh >> 3, h = bh & 7;
    const int fr = F.lane & 15, fq = F.lane >> 4, row = rt * 16 + fr;
    const unsigned char* r1 = ws + WS_R1 + (size_t)(bh * NCH + c) * R1_STRIDE + (size_t)(row * 64 + 4 * fq) * 2;
    const bf16* Sg = (const bf16*)(ws + WS_SST) + (size_t)(bh * NCH + c) * 4096 + fr * 64 + 8 * fq;
    const bf16x8 fa0 = *(const bf16x8*)(r1 + 2 * 8192 + 8 * fq), fa1 = *(const bf16x8*)(r1 + 2 * 8192 + 64 + 8 * fq);
    bf16x8 sf[8]; v2u q0[4], q1[4], q2[4];
#pragma unroll
    for (int ct = 0; ct < 4; ++ct) { sf[2 * ct] = *(const bf16x8*)(Sg + ct * 1024); sf[2 * ct + 1] = *(const bf16x8*)(Sg + ct * 1024 + 32);
        q0[ct] = *(const v2u*)(r1 + 3 * 8192 + ct * 32); q1[ct] = *(const v2u*)(r1 + 4 * 8192 + ct * 32); q2[ct] = *(const v2u*)(r1 + 5 * 8192 + ct * 32); }
    f32x4 y[4]; float s = 0.f;
#pragma unroll
    for (int ct = 0; ct < 4; ++ct) {
        f32x4 acc = {bflo(q0[ct].x), bfhi(q0[ct].x), bflo(q0[ct].y), bfhi(q0[ct].y)};
        acc = mfma16(sf[2 * ct], fa0, acc); acc = mfma16(sf[2 * ct + 1], fa1, acc);
        y[ct] = acc; s += (acc[0] + acc[1]) + (acc[2] + acc[3]); }
    s += shx(s, 16, F.lane); s += shx(s, 32, F.lane);
    const float mean = s * (1.f / 64.f); float q = 0.f;
#pragma unroll
    for (int ct = 0; ct < 4; ++ct) { y[ct] = y[ct] - mean; q += (y[ct][0] * y[ct][0] + y[ct][1] * y[ct][1]) + (y[ct][2] * y[ct][2] + y[ct][3] * y[ct][3]); }
    q += shx(q, 16, F.lane); q += shx(q, 32, F.lane);
    const float rstd = __builtin_amdgcn_rsqf(q * (1.f / 64.f) + 64e-5f);
    LAS bf16* ost = (LAS bf16*)(F.lds + 102400 + F.wave * 2304);
#pragma unroll
    for (int ct = 0; ct < 4; ++ct) { const int i0 = h * 64 + ct * 16 + 4 * fq;
        const f32x4 lg = *(const f32x4*)(a.in[I_RLNG] + i0), lb = *(const f32x4*)(a.in[I_RLNB] + i0);
        const f32x4 g = {bflo(q1[ct].x), bfhi(q1[ct].x), bflo(q1[ct].y), bfhi(q1[ct].y)}, bv = {bflo(q2[ct].x), bfhi(q2[ct].x), bflo(q2[ct].y), bfhi(q2[ct].y)};
        const f32x4 o = (y[ct] * rstd * lg + lb + bv) * g;
        *(LAS v2u*)(ost + fr * 72 + ct * 16 + 4 * fq) = pack4(o); }
    asm volatile("s_waitcnt lgkmcnt(0)" ::: "memory");
    bf16* yout = (bf16*)(ws + WS_YMIX) + ((size_t)b * SEQ + 64 * (c - 1) + rt * 16) * D + 512 + h * 64;
#pragma unroll
    for (int hh = 0; hh < 2; ++hh) { const int tr = (F.lane >> 3) + 8 * hh, c8 = F.lane & 7;
        *(v4u*)(yout + (size_t)tr * D + 8 * c8) = *(const LAS v4u*)(ost + tr * 72 + 8 * c8); }
    asm volatile("s_waitcnt lgkmcnt(0)" ::: "memory");
}
__device__ __forceinline__ void gla_scan_unit(const Args& a, const Frame& F, int j) {
    float* GUS = (float*)(a.ws + WS_GUS); const float* DL = (const float*)(a.ws + WS_DL);
    const int bh = j >> 1, half = j & 1;
    const int d = 32 * half + (F.tid >> 4), e0 = (F.tid & 15) * 8;
    float* base = GUS + (size_t)bh * NCH * 8192 + d * 128 + e0;
    const float* dl = DL + (size_t)bh * NCH * 64 + d;
    f32x4 s0 = {0.f, 0.f, 0.f, 0.f}, s1 = s0;
    f32x4 ua[4], ub[4]; float dq[4];
#pragma unroll
    for (int q = 0; q < 3; ++q) { ua[q] = *(const f32x4*)(base + (size_t)q * 8192); ub[q] = *(const f32x4*)(base + (size_t)q * 8192 + 4); dq[q] = dl[q * 64]; }
#pragma unroll 4
    for (int c = 0; c < NCH - 1; ++c) {
        const int cn = (c + 3 < NCH - 1) ? c + 3 : NCH - 2;
        ua[(c + 3) & 3] = *(const f32x4*)(base + (size_t)cn * 8192); ub[(c + 3) & 3] = *(const f32x4*)(base + (size_t)cn * 8192 + 4); dq[(c + 3) & 3] = dl[cn * 64];
        *(f32x4*)(base + (size_t)c * 8192) = s0; *(f32x4*)(base + (size_t)c * 8192 + 4) = s1;
        s0 = s0 * dq[c & 3] + ua[c & 3]; s1 = s1 * dq[c & 3] + ub[c & 3];
    }
    *(f32x4*)(base + (size_t)(NCH - 1) * 8192) = s0; *(f32x4*)(base + (size_t)(NCH - 1) * 8192 + 4) = s1;
}
__device__ __forceinline__ void phase3(const Args& a, const Frame& F) {
    constexpr int PSEL = (REP_MASK >> 20) & 7;
    const unsigned long long t0_ = PSEL ? __builtin_amdgcn_s_memrealtime() : 0ull;
    for (int u = F.blk; u < 256; u += F.G) {
        if (u < 128) { for (int rep_ = 0; rep_ < NREP(3); ++rep_) rwkv_l2_unit(a, F, u); }
        else gla_scan_unit(a, F, u - 128);
    }
    if (PSEL) { const unsigned long long t1_ = __builtin_amdgcn_s_memrealtime();
        unsigned long long dt_ = 0;
        if (PSEL == 1 && F.blk < 128) dt_ = t1_ - t0_;
        if (PSEL == 2 && F.blk >= 128) dt_ = t1_ - t0_;
        while (__builtin_amdgcn_s_memrealtime() - t1_ < dt_) __builtin_amdgcn_s_sleep(8); }
}

__device__ __forceinline__ void gla_g3_unit(const Args& a, const Frame& F, int b, int h, int c) {
    const bf16* PROJ = (const bf16*)(a.ws + WS_PROJ); const bf16* PROJM = (const bf16*)(a.ws + WS_PROJM);
    const float* GUS = (const float*)(a.ws + WS_GUS); bf16* YMIX = (bf16*)(a.ws + WS_YMIX);
    const int vp0 = NMETA + 64 * (c - 1);
    gla_bc(a, F, b, h, vp0, 64);
    LAS float* BC = (LAS float*)(F.lds + 4096);
    LAS bf16* QT = (LAS bf16*)(F.lds + 24576);
    LAS bf16* KL = QT + 64 * TP;
    LAS bf16* AT = KL + 64 * TP;
    LAS bf16* VT = AT + 64 * TP;
    LAS bf16* ST = VT + 128 * TP;
    LAS float* RS = (LAS float*)(ST + 128 * TP);
    {
        const int t = F.tid >> 3, q = F.tid & 7;
        const f32x4 q0 = ldp4(PROJ, PROJM, b, vp0 + t, GQ + h * 64 + 8 * q), q1 = ldp4(PROJ, PROJM, b, vp0 + t, GQ + h * 64 + 8 * q + 4);
        const f32x4 k0 = ldp4(PROJ, PROJM, b, vp0 + t, GK + h * 64 + 8 * q), k1 = ldp4(PROJ, PROJM, b, vp0 + t, GK + h * 64 + 8 * q + 4);
        float qv[8] = {q0.x, q0.y, q0.z, q0.w, q1.x, q1.y, q1.z, q1.w}, kv[8] = {k0.x, k0.y, k0.z, k0.w, k1.x, k1.y, k1.z, k1.w};
#pragma unroll
        for (int i = 0; i < 8; ++i) { const float bcv = BC[t * BCP + 8 * q + i]; qv[i] *= fexp(bcv) * 0.125f; kv[i] *= fexp(-bcv); }
        v4u o; o.x = pk2(qv[0], qv[1]); o.y = pk2(qv[2], qv[3]); o.z = pk2(qv[4], qv[5]); o.w = pk2(qv[6], qv[7]);
        *(LAS v4u*)(QT + t * TP + 8 * q) = o;
        o.x = pk2(kv[0], kv[1]); o.y = pk2(kv[2], kv[3]); o.z = pk2(kv[4], kv[5]); o.w = pk2(kv[6], kv[7]);
        *(LAS v4u*)(KL + t * TP + 8 * q) = o;
#pragma unroll
        for (int qq = 0; qq < 4; ++qq) {
            const int e0 = 16 * q + 4 * qq;
            const f32x4 vv = ldp4(PROJ, PROJM, b, vp0 + t, GV + h * 128 + e0);
#pragma unroll
            for (int i = 0; i < 4; ++i) VT[(e0 + i) * TP + t] = (bf16)f2bf(vv[i]);
            const f32x4 sv = *(const f32x4*)(GUS + ((size_t)((b * 4 + h) * NCH + c) * 64 + t) * 128 + e0);
#pragma unroll
            for (int i = 0; i < 4; ++i) ST[(e0 + i) * TP + t] = (bf16)f2bf(sv[i]);
        }
    }
    lds_barrier();
    const int rt = F.wave & 3, wh = F.wave >> 2, fr = F.lane & 15, fq = F.lane >> 4;
    const int trow = rt * 16 + fr;
    {
        f32x4 av[2];
#pragma unroll
        for (int cc = 0; cc < 2; ++cc) { const int ct = 2 * wh + cc;
            f32x4 acc = {0.f, 0.f, 0.f, 0.f};
#pragma unroll
            for (int ks = 0; ks < 2; ++ks)
                acc = mfma16(*(const LAS bf16x8*)(KL + (ct * 16 + fr) * TP + ks * 32 + 8 * fq), *(const LAS bf16x8*)(QT + trow * TP + ks * 32 + 8 * fq), acc);
            const int s0 = ct * 16 + 4 * fq;
#pragma unroll
            for (int i = 0; i < 4; ++i) if (s0 + i > trow) acc[i] = 0.f;
            av[cc] = acc; }
#pragma unroll
        for (int cc = 0; cc < 2; ++cc) *(LAS v2u*)(AT + trow * TP + (2 * wh + cc) * 16 + 4 * fq) = pack4(av[cc]);
    }
    lds_barrier();
    f32x4 oacc[4]; float ssq = 0.f;
#pragma unroll
    for (int cc = 0; cc < 4; ++cc) { const int ct = wh * 4 + cc;
        f32x4 acc = {0.f, 0.f, 0.f, 0.f};
#pragma unroll
        for (int ks = 0; ks < 2; ++ks) {
            acc = mfma16(*(const LAS bf16x8*)(VT + (ct * 16 + fr) * TP + ks * 32 + 8 * fq), *(const LAS bf16x8*)(AT + trow * TP + ks * 32 + 8 * fq), acc);
            acc = mfma16(*(const LAS bf16x8*)(ST + (ct * 16 + fr) * TP + ks * 32 + 8 * fq), *(const LAS bf16x8*)(QT + trow * TP + ks * 32 + 8 * fq), acc);
        }
        oacc[cc] = acc; ssq += (acc[0] * acc[0] + acc[1] * acc[1]) + (acc[2] * acc[2] + acc[3] * acc[3]); }
    ssq += shx(ssq, 16, F.lane); ssq += shx(ssq, 32, F.lane);
    if (fq == 0) RS[wh * 64 + trow] = ssq;
    lds_barrier();
    {
        const float tot = RS[trow] + RS[64 + trow];
        const float rstd = 1.f / sqrtf(tot * (1.f / 128.f) + 1e-6f);
        const size_t m = (size_t)b * SEQ + (vp0 - NMETA) + trow;
#pragma unroll
        for (int cc = 0; cc < 4; ++cc) { const int e0 = (wh * 4 + cc) * 16 + 4 * fq;
            const f32x4 gv = ldp4(PROJ, PROJM, b, vp0 + trow, GG + h * 128 + e0);
            const f32x4 ng = *(const f32x4*)(a.in[I_GNORM] + e0);
            float y[4];
#pragma unroll
            for (int i = 0; i < 4; ++i) { const float gi = gv[i]; y[i] = oacc[cc][i] * rstd * ng[i] * (gi * fsigmoid(gi)); }
            v2u o; o.x = pk2(y[0], y[1]); o.y = pk2(y[2], y[3]);
            *(v2u*)(YMIX + m * D + h * 128 + e0) = o; }
    }
    lds_barrier();
}
__device__ __forceinline__ void phase4(const Args& a, const Frame& F) {
    for (int t = F.blk * NWAVES + F.wave; t < 128 * 32 * 4; t += F.G * NWAVES) { const Frame F1 = mkframe(F.lds, F.wave); rwkv_y_task(a, F1, t); }
    __syncthreads();
    for (int u = F.blk; u < NB * 4 * 32; u += F.G) { const int c = 1 + (u & 31), bh = u >> 5; const Frame F1 = mkframe(F.lds, F.wave); gla_g3_unit(a, F1, bh >> 2, bh & 3, c); }
}

__device__ __forceinline__ int eidx_of(int L) { return 16 * (L & 1) + 8 * ((L >> 1) & 1) + 4 * ((L >> 2) & 1) + 2 * ((L >> 3) & 1) + ((L >> 4) & 1); }
__device__ __forceinline__ void p6_ln(const Args& a, const Frame& F, int m, f32x4 (&v)[4]) {
    unsigned char* ws = a.ws; bf16* H1 = (bf16*)(ws + WS_H1);
    float s = 0.f;
#pragma unroll
    for (int j = 0; j < 4; ++j) s += (v[j].x + v[j].y) + (v[j].z + v[j].w);
    const float mean = wave_sum(s, F.lane) * (1.f / D); float s2 = 0.f;
#pragma unroll
    for (int j = 0; j < 4; ++j) { v[j] = v[j] - mean; s2 += (v[j].x * v[j].x + v[j].y * v[j].y) + (v[j].z * v[j].z + v[j].w * v[j].w); }
    const float rstd = __builtin_amdgcn_rsqf(wave_sum(s2, F.lane) * (1.f / D) + 1e-5f);
#pragma unroll
    for (int j = 0; j < 4; ++j) { const int col = 4 * (F.lane + 64 * j);
        const f32x4 gv = *(const f32x4*)(a.in[I_LN1G] + col), bv = *(const f32x4*)(a.in[I_LN1B] + col);
        v[j] = v[j] * rstd * gv + bv;
        v2u o; o.x = pk2(v[j].x, v[j].y); o.y = pk2(v[j].z, v[j].w);
        *(v2u*)(H1 + (size_t)m * D + col) = o;
        int w8 = __builtin_amdgcn_cvt_pk_fp8_f32(v[j].x, v[j].y, 0, false); w8 = __builtin_amdgcn_cvt_pk_fp8_f32(v[j].z, v[j].w, w8, true);
        *(int*)(ws + WS_H1Q + (size_t)m * D + col) = w8; }
}
__device__ __forceinline__ void phase6(const Args& a, const Frame& F, int csel) {
    unsigned char* ws = a.ws;
    LAS float* LG = (LAS float*)(F.lds + F.wave * 2560);
    LAS int* hist = (LAS int*)(F.lds + 8 * 2560);
    bf16* H1 = (bf16*)(ws + WS_H1);
    const bf16* RWH = (const bf16*)(ws + WS_RWH); const bf16* RWL = (const bf16*)(ws + WS_RWL);
    int* TOPI = (int*)(ws + WS_TOPI); float* GATE = (float*)(ws + WS_GATE); int* RANK = (int*)(ws + WS_RANK);
    unsigned* CNT = (unsigned*)(ws + WS_CTL) + CW_CNT + 2048 * csel;
    for (int rb = F.blk; rb < MX / 128; rb += F.G) {
        if (F.tid < 64) hist[F.tid] = 0;
        __syncthreads();
        const int mb = rb * 128 + F.wave * 16; const Frame& Fo = F;
        {
            const f32x4* xr0 = (const f32x4*)(a.in[I_X] + (size_t)mb * D) + F.lane;
            const v2u* mr0 = (const v2u*)((const bf16*)(ws + WS_MIXB) + (size_t)mb * D) + F.lane;
            const float* st0 = (const float*)(ws + WS_STATS) + 2 * (size_t)mb;
            f32x4 va[4], vb[4], vc[4], vd[4]; v2u ma[4], mbv[4], mc[4], md[4]; float sa0, sa1, sb0, sb1, sc0, sc1, sd0, sd1;
#define P6_LOAD(vv, mmv, s0v, s1v, ii) do { _Pragma("unroll") for (int j = 0; j < 4; ++j) { vv[j] = xr0[(size_t)(ii) * (D / 4) + 64 * j]; mmv[j] = mr0[(size_t)(ii) * (D / 4) + 64 * j]; } s0v = st0[2 * (ii)]; s1v = st0[2 * (ii) + 1]; } while (0)
#define P6_FORM(vv, mmv, s0v, s1v) do { _Pragma("unroll") for (int j = 0; j < 4; ++j) { const int col = 4 * (F.lane + 64 * j); \
            const f32x4 gi = *(const f32x4*)(a.in[I_LNIN_G] + col) * ALPHA, bi = *(const f32x4*)(a.in[I_LNIN_B] + col) * ALPHA; \
            vv[j] = ((vv[j] - s0v) * s1v) * gi + bi + unpk4(mmv[j]); } } while (0)
            P6_LOAD(va, ma, sa0, sa1, 0); P6_LOAD(vb, mbv, sb0, sb1, 1);
#pragma nounroll
            for (int i = 0; i < 16; i += 4) {
                P6_LOAD(vc, mc, sc0, sc1, i + 2); P6_LOAD(vd, md, sd0, sd1, i + 3);
                { const Frame F = mkframe(Fo.lds, Fo.wave);
                  P6_FORM(va, ma, sa0, sa1); P6_FORM(vb, mbv, sb0, sb1); p6_ln(a, F, mb + i, va); p6_ln(a, F, mb + i + 1, vb); }
                if (i + 4 < 16) { P6_LOAD(va, ma, sa0, sa1, i + 4); P6_LOAD(vb, mbv, sb0, sb1, i + 5); }
                { const Frame F = mkframe(Fo.lds, Fo.wave);
                  P6_FORM(vc, mc, sc0, sc1); P6_FORM(vd, md, sd0, sd1); p6_ln(a, F, mb + i + 2, vc); p6_ln(a, F, mb + i + 3, vd); }
            }
#undef P6_LOAD
#undef P6_FORM
        }
        asm volatile("s_waitcnt vmcnt(0)" ::: "memory");
        {
            const int fr = F.lane & 15, fq = F.lane >> 4;
            const bf16* ap = H1 + (size_t)(mb + fr) * D + 8 * fq;
            const bf16* bh = RWH + (size_t)fr * D + 8 * fq; const bf16* bl = RWL + (size_t)fr * D + 8 * fq;
            f32x4 acc0 = {0.f, 0.f, 0.f, 0.f}, acc1 = acc0;
#pragma unroll 8
            for (int ks = 0; ks < 32; ++ks) { const bf16x8 af = *(const bf16x8*)(ap + ks * 32);
                acc0 = mfma16(*(const bf16x8*)(bh + ks * 32), af, acc0); acc0 = mfma16(*(const bf16x8*)(bl + ks * 32), af, acc0);
                acc1 = mfma16(*(const bf16x8*)(bh + 16 * D + ks * 32), af, acc1); acc1 = mfma16(*(const bf16x8*)(bl + 16 * D + ks * 32), af, acc1); }
            const f32x4 rb0 = *(const f32x4*)(a.in[I_RTB] + 4 * fq), rb1 = *(const f32x4*)(a.in[I_RTB] + 16 + 4 * fq);
#pragma unroll
            for (int q = 0; q < 4; ++q) { LG[fr * 33 + 4 * fq + q] = acc0[q] + rb0[q]; LG[fr * 33 + 16 + 4 * fq + q] = acc1[q] + rb1[q]; }
        }
        asm volatile("s_waitcnt lgkmcnt(0)" ::: "memory");
        LAS int* EK = (LAS int*)(LG + 528);
        if (F.lane < 16) {
            float lv[32];
#pragma unroll
            for (int e = 0; e < 32; ++e) lv[e] = LG[F.lane * 33 + e];
            int ek[4]; float lk[4];
#pragma unroll
            for (int k = 0; k < 4; ++k) { float best = -3.0e38f; int bi = 0;
#pragma unroll
                for (int e = 0; e < 32; ++e) { const bool tk = lv[e] > best; best = tk ? lv[e] : best; bi = tk ? e : bi; }
                ek[k] = bi; lk[k] = best;
#pragma unroll
                for (int e = 0; e < 32; ++e) lv[e] = (e == bi) ? -3.0e38f : lv[e]; }
            const float e1 = expf(lk[1] - lk[0]), e2 = expf(lk[2] - lk[0]), e3 = expf(lk[3] - lk[0]);
            const float inv = 1.f / (1.f + e1 + e2 + e3);
            const size_t m = (size_t)(mb + F.lane);
            *(i32x4g*)(TOPI + m * 4) = (i32x4g){ek[0], ek[1], ek[2], ek[3]};
            *(f32x4*)(GATE + m * 4) = (f32x4){inv, e1 * inv, e2 * inv, e3 * inv};
#pragma unroll
            for (int k = 0; k < 4; ++k) EK[F.lane * 4 + k] = ek[k];
        }
        asm volatile("s_waitcnt lgkmcnt(0)" ::: "memory");
        const int my_e = EK[F.lane];
        const int lrank = __hip_atomic_fetch_add(&hist[my_e], 1, __ATOMIC_RELAXED, __HIP_MEMORY_SCOPE_WORKGROUP);
        __syncthreads();
        if (F.tid < 32) hist[32 + F.tid] = (int)__hip_atomic_fetch_add(CNT + 64 * F.tid, (unsigned)hist[F.tid], __ATOMIC_RELAXED, __HIP_MEMORY_SCOPE_AGENT);
        __syncthreads();
        RANK[((size_t)rb * 128 + F.wave * 16 + (F.lane >> 2)) * 4 + (F.lane & 3)] = hist[32 + my_e] + lrank;
        __syncthreads();
    }
}

__device__ __forceinline__ void phase7(const Args& a, const Frame& F) {
    unsigned char* ws = a.ws;
    LAS int* starts = (LAS int*)F.lds;
    unsigned* CNT = (unsigned*)(ws + WS_CTL) + CW_CNT;
    int* TILEE = (int*)(ws + WS_TILEE); int* SLOTTOK = (int*)(ws + WS_SLOTTOK);
    if (F.tid < 32) { const int cnt = (int)ld_agent(CNT + 64 * F.tid); starts[64 + F.tid] = cnt; starts[32 + F.tid] = (cnt + 255) & ~255; }
    __syncthreads();
    if (F.tid == 0) { int run = 0; for (int e = 0; e < 32; ++e) { starts[e] = run; run += starts[32 + e]; }
        if (F.blk == 0) { TILEE[1023] = run >> 8; for (int e = 0; e < 32; ++e) for (int tl = starts[e] >> 8; tl < (starts[e] + starts[32 + e]) >> 8; ++tl) TILEE[tl] = e; } }
    __syncthreads();
    if (F.blk == 0) { for (int e = 0; e < 32; ++e) for (int s = starts[e] + starts[64 + e] + F.tid; s < starts[e] + starts[32 + e]; s += NTHR) SLOTTOK[s] = 0; }
    const int* TOPI = (const int*)(ws + WS_TOPI); const int* RANK = (const int*)(ws + WS_RANK); int* TSLOT = (int*)(ws + WS_TSLOT);
    for (int q = F.blk * NTHR + F.tid; q < MX * 4; q += F.G * NTHR) {
        const int slot = starts[TOPI[q]] + RANK[q];
        TSLOT[q] = slot; SLOTTOK[slot] = q >> 2;
    }
}
__device__ __forceinline__ int moe_fill_table(const Args& a, const Frame& F, int nN, int RM) {
    LAS int* tab = (LAS int*)(F.lds + TAB_OFF);
    const unsigned* TILEE = (const unsigned*)(a.ws + WS_TILEE);
    if (F.tid == 0) {
        const int NT = (int)ld_agent(TILEE + 1023);
        const int x = F.blk & 7, j = F.blk >> 3; int n = 0;
        for (int i = 0; i < 64; ++i) { const int s = i * 8 + x, pm = s * RM + j / nN; if (pm >= NT) break;
            const int e = (int)ld_agent(TILEE + pm); tab[2 * n] = pm; tab[2 * n + 1] = e * nN + (j % nN); ++n; }
        tab[128] = n;
    }
    __syncthreads();
    return __builtin_amdgcn_readfirstlane(tab[128]);
}

__device__ __forceinline__ void p10_acc(float (&s)[16], int j, const v4u w, float g) {
    s[8 * j + 0] += g * bflo(w.x); s[8 * j + 1] += g * bfhi(w.x); s[8 * j + 2] += g * bflo(w.y); s[8 * j + 3] += g * bfhi(w.y);
    s[8 * j + 4] += g * bflo(w.z); s[8 * j + 5] += g * bfhi(w.z); s[8 * j + 6] += g * bflo(w.w); s[8 * j + 7] += g * bfhi(w.w);
}
__device__ __forceinline__ void phase10(const Args& a, const Frame& F) {
    unsigned char* ws = a.ws;
    const bf16* H1 = (const bf16*)(ws + WS_H1); const bf16* YS = (const bf16*)(ws + WS_YS);
    const int* TSLOT = (const int*)(ws + WS_TSLOT); const float* GATE = (const float*)(ws + WS_GATE);
    const int gw = F.blk * NWAVES + F.wave, NGW = F.G * NWAVES;
    f32x4 gv[4], bv[4];
#pragma unroll
    for (int q = 0; q < 4; ++q) { const int col = 8 * F.lane + 512 * (q >> 1) + 4 * (q & 1); gv[q] = *(const f32x4*)(a.in[I_LN2G] + col); bv[q] = *(const f32x4*)(a.in[I_LN2B] + col); }
    for (int m0 = gw; m0 < MX; m0 += 2 * NGW) {
        int mm[2]; mm[0] = m0; mm[1] = (m0 + NGW < MX) ? m0 + NGW : m0;
        int slot[2][4]; float gt[2][4]; v4u hw[2][2], yw[2][4][2];
#pragma unroll
        for (int r = 0; r < 2; ++r) {
#pragma unroll
            for (int k = 0; k < 4; ++k) { slot[r][k] = TSLOT[(size_t)mm[r] * 4 + k]; gt[r][k] = GATE[(size_t)mm[r] * 4 + k]; }
#pragma unroll
            for (int j = 0; j < 2; ++j) hw[r][j] = *(const v4u*)(H1 + (size_t)mm[r] * D + 8 * F.lane + 512 * j); }
#pragma unroll
        for (int r = 0; r < 2; ++r)
#pragma unroll
            for (int k = 0; k < 4; ++k)
#pragma unroll
                for (int j = 0; j < 2; ++j) yw[r][k][j] = *(const v4u*)(YS + (size_t)slot[r][k] * D + 8 * F.lane + 512 * j);
#pragma unroll
        for (int r = 0; r < 2; ++r) {
            float s[16];
#pragma unroll
            for (int i = 0; i < 16; ++i) s[i] = 0.f;
#pragma unroll
            for (int j = 0; j < 2; ++j) p10_acc(s, j, hw[r][j], ALPHA);
#pragma unroll
            for (int k = 0; k < 4; ++k)
#pragma unroll
                for (int j = 0; j < 2; ++j) p10_acc(s, j, yw[r][k][j], gt[r][k]);
            float t = 0.f;
#pragma unroll
            for (int i = 0; i < 16; ++i) t += s[i];
            const float mean = wave_sum(t, F.lane) * (1.f / D); float q = 0.f;
#pragma unroll
            for (int i = 0; i < 16; ++i) { s[i] -= mean; q += s[i] * s[i]; }
            const float rstd = __builtin_amdgcn_rsqf(wave_sum(q, F.lane) * (1.f / D) + 1e-5f);
            if (r == 0 || mm[1] != mm[0]) {
#pragma unroll
                for (int q4 = 0; q4 < 4; ++q4) { const int col = 8 * F.lane + 512 * (q4 >> 1) + 4 * (q4 & 1);
                    f32x4 o; o.x = s[4 * q4 + 0] * rstd * gv[q4].x + bv[q4].x; o.y = s[4 * q4 + 1] * rstd * gv[q4].y + bv[q4].y; o.z = s[4 * q4 + 2] * rstd * gv[q4].z + bv[q4].z; o.w = s[4 * q4 + 3] * rstd * gv[q4].w + bv[q4].w;
                    *(f32x4*)(a.out + (size_t)mm[r] * D + col) = o; } }
        }
    }
}

template <int LO, int HI>
__global__ void __launch_bounds__(NTHR, 2) fwd(Args a) {
    extern __shared__ __attribute__((aligned(16))) unsigned char lds_raw[];
    LAS unsigned char* lds = (LAS unsigned char*)lds_raw;
    const int wave = __builtin_amdgcn_readfirstlane((int)(threadIdx.x >> 6));
    volatile LAS unsigned* MISC = (volatile LAS unsigned*)(lds + MISC_OFF);
    if (wave == 0) MISC[lane_id()] = 0u;
    __syncthreads();
    unsigned* ctl = (unsigned*)(a.ws + WS_CTL);
    XcdBarrier bar; bar.bar = ctl + CW_BAR; bar.x = 0; bar.st = nullptr;
    if constexpr (HI - LO > 1) bar = xcd_barrier_post(ctl + CW_BAR, MISC + 8, wave == 0 && lane_id() == 0);
#define PH(k) if constexpr (LO <= (k) && (k) < HI)
#define SEAM(k) if constexpr (LO <= (k) && (k) + 1 < HI) xcd_barrier(bar, wave == 0 && lane_id() == 0)
    PH(0) for (int rep_ = 0; rep_ < NREP(0); ++rep_) { const Frame F = mkframe(lds, wave); phase0(a, F); } SEAM(0);
    PH(1) for (int rep_ = 0; rep_ < NREP(1); ++rep_) { const Frame F = mkframe(lds, wave);
            pg8::Gemm g{(const pg8::bf16_t*)(a.ws + WS_A0), (const pg8::bf16_t*)(a.ws + WS_WIN), MX, PW, D}; pg8::StaticOrder S; S.init(MX, PW, F.G, F.blk);
            pg8::EpiBf16Plain E{(pg8::bf16_t*)(a.ws + WS_PROJ), PW};
            pg8::gemm_phase<pg8::EpiBf16Plain, pg8::StaticOrder, true, true>(F.lds, g, S, E, F.tid); } SEAM(1);
    PH(2) for (int rep_ = 0; rep_ < NREP(2); ++rep_) { const Frame F = mkframe(lds, wave); phase2(a, F); } SEAM(2);
    PH(3) { const Frame F = mkframe(lds, wave); phase3(a, F); } SEAM(3);
    PH(4) for (int rep_ = 0; rep_ < NREP(4); ++rep_) { const Frame F = mkframe(lds, wave); phase4(a, F); } SEAM(4);
    PH(5) for (int rep_ = 0; rep_ < NREP(5); ++rep_) { const Frame F = mkframe(lds, wave);
            pg8::Gemm g{(const pg8::bf16_t*)(a.ws + WS_YMIX), (const pg8::bf16_t*)(a.ws + WS_WOUT), MX, D, D}; pg8::StaticOrder S; S.init(MX, D, F.G, F.blk);
            pg8::EpiBf16Plain E{(pg8::bf16_t*)(a.ws + WS_MIXB), D};
            pg8::gemm_phase<pg8::EpiBf16Plain, pg8::StaticOrder, true, true>(F.lds, g, S, E, F.tid); } SEAM(5);
    PH(6) for (int rep_ = 0; rep_ < NREP(6); ++rep_) { const Frame F = mkframe(lds, wave); phase6(a, F, rep_); } SEAM(6);
    PH(7) for (int rep_ = 0; rep_ < NREP(7); ++rep_) { const Frame F = mkframe(lds, wave); phase7(a, F); } SEAM(7);
    PH(8) for (int rep_ = 0; rep_ < NREP(8); ++rep_) { const Frame F = mkframe(lds, wave); const int n = moe_fill_table(a, F, 8, 4);
            pg8::Gemm g{(const pg8::bf16_t*)(a.ws + WS_H1Q), (const pg8::bf16_t*)(a.ws + WS_WUP), 0, 0, D / 2}; pg8::TableOrder S{(const LAS int*)(F.lds + TAB_OFF), n};
            pg8::EpiSwiglu8 E{a.ws + WS_ACT, a.in[I_BUP]};
            pg8::gemm_phase_g<pg8::EpiSwiglu8, pg8::TableOrder, true, true, 121>(F.lds, g, S, E, F.tid, (const int*)(a.ws + WS_SLOTTOK)); } SEAM(8);
    PH(9) for (int rep_ = 0; rep_ < NREP(9); ++rep_) { const Frame F = mkframe(lds, wave); const int n = moe_fill_table(a, F, 4, 8);
            pg8::Gemm g{(const pg8::bf16_t*)(a.ws + WS_ACT), (const pg8::bf16_t*)(a.ws + WS_WDN), 0, 0, D / 2}; pg8::TableOrder S{(const LAS int*)(F.lds + TAB_OFF), n};
            pg8::EpiDown E{(pg8::bf16_t*)(a.ws + WS_YS), a.in[I_BDN]};
            pg8::gemm_phase<pg8::EpiDown, pg8::TableOrder, true, true, 120>(F.lds, g, S, E, F.tid); } SEAM(9);
    PH(10) for (int rep_ = 0; rep_ < NREP(10); ++rep_) { const Frame F = mkframe(lds, wave); phase10(a, F); }
#undef PH
#undef SEAM
}

#ifndef MK_SINGLE
#define MK_SINGLE 1
#endif
template <int LO, int HI> static void launch_range(const Args& a, int grid, hipStream_t stream) {
    static bool attr = false;
    if (!attr) { (void)hipFuncSetAttribute((const void*)fwd<LO, HI>, hipFuncAttributeMaxDynamicSharedMemorySize, LDS_BYTES); attr = true; }
    hipLaunchKernelGGL((fwd<LO, HI>), dim3(grid), dim3(NTHR), LDS_BYTES, stream, a);
}
extern "C" void kernel_launch(void* const* d_in, const int* in_sizes, int n_in, void* d_out, int out_size, void* d_ws, size_t ws_size, hipStream_t stream) {
    if (n_in != 30 || ws_size < WS_END) { fprintf(stderr, "kernel_launch: unexpected inputs (n_in %d, ws %zu)\n", n_in, ws_size); return; }
    const int grid = 256;
    (void)hipMemsetAsync((char*)d_ws + WS_CTL, 0, CTL_ZERO_BYTES, stream);
    Args a{};
    for (int i = 0; i < 30; ++i) a.in[i] = (const float*)d_in[i];
    a.out = (float*)d_out; a.ws = (unsigned char*)d_ws;
#if MK_SINGLE
    launch_range<0, 11>(a, grid, stream);
#else
    launch_range<0, 1>(a, grid, stream); launch_range<1, 2>(a, grid, stream); launch_range<2, 3>(a, grid, stream); launch_range<3, 4>(a, grid, stream);
    launch_range<4, 5>(a, grid, stream); launch_range<5, 6>(a, grid, stream); launch_range<6, 7>(a, grid, stream); launch_range<7, 8>(a, grid, stream);
    launch_range<8, 9>(a, grid, stream); launch_range<9, 10>(a, grid, stream); launch_range<10, 11>(a, grid, stream);
#endif
}
```

```cpp
#include <hip/hip_runtime.h>
#include <cstdio>
#include <cstdint>
#include <cmath>
namespace pg8 {
#define PG8_LAS __attribute__((address_space(3)))
typedef unsigned short bf16_t;
typedef short bf16x8 __attribute__((ext_vector_type(8)));
typedef float f32x4 __attribute__((ext_vector_type(4)));
typedef unsigned u32x4 __attribute__((ext_vector_type(4)));
constexpr int BM = 256, BK = 64, HALF = 128, HTB = HALF * BK * 2  , STAGE_BYTES = 8 * HTB, NXCD = 8, WGM = 8;

__host__ __device__ __forceinline__ int lds_byte(int r, int c) { const int st = (r >> 4) * 2 + (c >> 5), rr = r & 15, cc = c & 31, ob = rr * 64 + cc * 2; return st * 1024 + (ob ^ (((ob >> 9) & 1) << 5)); }
__host__ __device__ __forceinline__ void stage_rc(int b, int& R, int& C) { const int st = b / 1024, sb = b % 1024, swz = sb ^ (((sb >> 9) & 1) << 5); R = (st >> 1) * 16 + swz / 64; C = (st & 1) * 32 + (swz % 64) / 2; }
__host__ __device__ __forceinline__ int perm32(int rho) { const int n = rho >> 4, i = rho & 15; return 8 * (i >> 2) + 4 * n + (i & 3); }

struct Unit { int pm, pn; };
struct Gemm { const bf16_t* A; const bf16_t* Bt; int M, N, K; };

struct StaticOrder {
    int nM, nN, nwg, G, c;
    __host__ __device__ void init(int M, int N, int G_, int c_) { nM = M / BM; nN = N / BM; nwg = nM * nN; G = G_; c = c_; }
    __host__ __device__ bool next(int i, Unit& u) const {
        const long L = (long)i * G + c; if (L >= nwg) return false;
        int wgid = (int)L; { const int q = nwg / NXCD, r = nwg % NXCD, xcd = wgid % NXCD, off = wgid / NXCD; wgid = (xcd < r ? xcd * (q + 1) : r * (q + 1) + (xcd - r) * q) + off; }
        const int nig = WGM * nN, gid = wgid / nig, fm = gid * WGM, gsz = (nM - fm) < WGM ? (nM - fm) : WGM;
        u.pm = fm + ((wgid % nig) % gsz); u.pn = (wgid % nig) / gsz; return true;
    }
    __device__ __forceinline__ void a_ready(const Unit&) const {}
    __device__ __forceinline__ void done(const Unit&) const {}
};


__device__ __forceinline__ unsigned cvt_pk_bf16(float lo, float hi) { unsigned r; asm volatile("v_cvt_pk_bf16_f32 %0, %1, %2" : "=v"(r) : "v"(lo), "v"(hi)); return r; }
typedef unsigned u32x2 __attribute__((ext_vector_type(2)));
typedef int i32x8 __attribute__((ext_vector_type(8))); typedef int i32x4 __attribute__((ext_vector_type(4)));
__device__ __forceinline__ void mfma_f8(f32x4& acc, i32x8 a, i32x8 b, int sa, int sb) {
    asm volatile("s_nop 1\n\tv_mfma_scale_f32_16x16x128_f8f6f4 %0, %1, %2, %0, %3, %4 op_sel_hi:[0,0,0]" : "+v"(acc) : "v"(a), "v"(b), "v"(sa), "v"(sb));
}
__device__ __forceinline__ i32x8 cat8(bf16x8 lo, bf16x8 hi) { const i32x4 a = __builtin_bit_cast(i32x4, lo), b = __builtin_bit_cast(i32x4, hi); return __builtin_shufflevector(a, b, 0, 1, 2, 3, 4, 5, 6, 7); }

struct EpiBf16Plain {
    static constexpr bool PERM = true, AFTER_DRAIN = false;
    bf16_t* O; int ldc;
    __device__ __forceinline__ void operator()(const f32x4 (&acc)[2][2][4][2], const Unit& u, int wr, int wc, int fr, int fq) const {
        const int row0 = u.pm * BM + wr * 64 + fr, col0 = u.pn * BM + wc * 32 + 8 * fq;
#pragma unroll
        for (int ai = 0; ai < 2; ++ai)
#pragma unroll
            for (int m = 0; m < 4; ++m) { bf16_t* rowp = O + (size_t)(row0 + ai * HALF + m * 16) * ldc + col0;
#pragma unroll
                for (int bj = 0; bj < 2; ++bj) { const f32x4 v0 = acc[ai][bj][m][0], v1 = acc[ai][bj][m][1];
                    u32x4 w; w.x = cvt_pk_bf16(v0[0], v0[1]); w.y = cvt_pk_bf16(v0[2], v0[3]); w.z = cvt_pk_bf16(v1[0], v1[1]); w.w = cvt_pk_bf16(v1[2], v1[3]);
                    *(u32x4*)(rowp + bj * HALF) = w; } }
    }
};

struct EpiResid {
    static constexpr bool PERM = false, AFTER_DRAIN = false;
    float* S1; const float* x; const float* stats; const float* g; const float* bta; float alpha;
    __device__ __forceinline__ void operator()(const f32x4 (&acc)[2][2][4][2], const Unit& u, int wr, int wc, int fr, int fq) const {
        const int row0 = u.pm * BM + wr * 64 + fr, col0 = u.pn * BM + wc * 32 + 4 * fq;
#pragma unroll
        for (int bj = 0; bj < 2; ++bj)
#pragma unroll
            for (int n = 0; n < 2; ++n) { const int c = col0 + bj * HALF + n * 16;
                const f32x4 gv = *(const f32x4*)(g + c) * alpha, bv = *(const f32x4*)(bta + c) * alpha;
#pragma unroll
                for (int ai = 0; ai < 2; ++ai)
#pragma unroll
                    for (int m = 0; m < 4; ++m) { const int r = row0 + ai * HALF + m * 16;
                        const float mean = stats[2 * r], rstd = stats[2 * r + 1];
                        const f32x4 xv = *(const f32x4*)(x + (size_t)r * 1024 + c);
                        *(f32x4*)(S1 + (size_t)r * 1024 + c) = ((xv - mean) * rstd) * gv + bv + acc[ai][bj][m][n]; } }
    }
};

__device__ __forceinline__ float swiglu1(float glu, float lin) {
    const float xg = fminf(glu, 7.0f), xl = fminf(fmaxf(lin, -7.0f), 7.0f);
    const float sg = __builtin_amdgcn_rcpf(1.0f + __expf(-1.702f * xg));
    return xg * sg * (xl + 1.0f);
}
struct EpiSwiglu {
    static constexpr bool PERM = true, AFTER_DRAIN = false;
    bf16_t* ACT; const float* bup;
    __device__ __forceinline__ void operator()(const f32x4 (&acc)[2][2][4][2], const Unit& u, int wr, int wc, int fr, int fq) const {
        const int e = u.pn >> 3, pn = u.pn & 7;
        const int row0 = u.pm * BM + wr * 64 + fr, ucol0 = pn * BM + wc * 32 + 8 * fq, acol0 = ucol0 >> 1;
        f32x4 bv[2][2];
#pragma unroll
        for (int bj = 0; bj < 2; ++bj)
#pragma unroll
            for (int n = 0; n < 2; ++n) bv[bj][n] = *(const f32x4*)(bup + (size_t)e * 2048 + ucol0 + bj * HALF + 4 * n);
#pragma unroll
        for (int ai = 0; ai < 2; ++ai)
#pragma unroll
            for (int m = 0; m < 4; ++m) { bf16_t* rowp = ACT + (size_t)(row0 + ai * HALF + m * 16) * 1024 + acol0;
#pragma unroll
                for (int bj = 0; bj < 2; ++bj) { const f32x4 v0 = acc[ai][bj][m][0] + bv[bj][0], v1 = acc[ai][bj][m][1] + bv[bj][1];
                    u32x2 w; w.x = cvt_pk_bf16(swiglu1(v0[0], v0[1]), swiglu1(v0[2], v0[3])); w.y = cvt_pk_bf16(swiglu1(v1[0], v1[1]), swiglu1(v1[2], v1[3]));
                    *(u32x2*)(rowp + bj * (HALF / 2)) = w; } }
    }
};
struct EpiSwiglu8 {
    static constexpr bool PERM = true, AFTER_DRAIN = false;
    unsigned char* ACT; const float* bup;
    __device__ __forceinline__ void operator()(const f32x4 (&acc)[2][2][4][2], const Unit& u, int wr, int wc, int fr, int fq) const {
        const int e = u.pn >> 3, pn = u.pn & 7;
        const int row0 = u.pm * BM + wr * 64 + fr, ucol0 = pn * BM + wc * 32 + 8 * fq, acol0 = ucol0 >> 1;
        f32x4 bv[2][2];
#pragma unroll
        for (int bj = 0; bj < 2; ++bj)
#pragma unroll
            for (int n = 0; n < 2; ++n) bv[bj][n] = *(const f32x4*)(bup + (size_t)e * 2048 + ucol0 + bj * HALF + 4 * n);
#pragma unroll
        for (int ai = 0; ai < 2; ++ai)
#pragma unroll
            for (int m = 0; m < 4; ++m) { unsigned char* rowp = ACT + (size_t)(row0 + ai * HALF + m * 16) * 1024 + acol0;
#pragma unroll
                for (int bj = 0; bj < 2; ++bj) { const f32x4 v0 = acc[ai][bj][m][0] + bv[bj][0], v1 = acc[ai][bj][m][1] + bv[bj][1];
                    int w = __builtin_amdgcn_cvt_pk_fp8_f32(swiglu1(v0[0], v0[1]), swiglu1(v0[2], v0[3]), 0, false);
                    w = __builtin_amdgcn_cvt_pk_fp8_f32(swiglu1(v1[0], v1[1]), swiglu1(v1[2], v1[3]), w, true);
                    *(int*)(rowp + bj * (HALF / 2)) = w; } }
    }
};
struct EpiDown {
    static constexpr bool PERM = true, AFTER_DRAIN = false;
    bf16_t* YS; const float* bdn;
    __device__ __forceinline__ void operator()(const f32x4 (&acc)[2][2][4][2], const Unit& u, int wr, int wc, int fr, int fq) const {
        const int e = u.pn >> 2, pn = u.pn & 3;
        const int row0 = u.pm * BM + wr * 64 + fr, col0 = pn * BM + wc * 32 + 8 * fq;
        f32x4 bv[2][2];
#pragma unroll
        for (int bj = 0; bj < 2; ++bj)
#pragma unroll
            for (int n = 0; n < 2; ++n) bv[bj][n] = *(const f32x4*)(bdn + (size_t)e * 1024 + col0 + bj * HALF + 4 * n);
#pragma unroll
        for (int ai = 0; ai < 2; ++ai)
#pragma unroll
            for (int m = 0; m < 4; ++m) { bf16_t* rowp = YS + (size_t)(row0 + ai * HALF + m * 16) * 1024 + col0;
#pragma unroll
                for (int bj = 0; bj < 2; ++bj) { const f32x4 v0 = acc[ai][bj][m][0] + bv[bj][0], v1 = acc[ai][bj][m][1] + bv[bj][1];
                    u32x4 w; w.x = cvt_pk_bf16(v0[0], v0[1]); w.y = cvt_pk_bf16(v0[2], v0[3]); w.z = cvt_pk_bf16(v1[0], v1[1]); w.w = cvt_pk_bf16(v1[2], v1[3]);
                    *(u32x4*)(rowp + bj * HALF) = w; } }
    }
};
struct TableOrder {
    const PG8_LAS int* tab; int n;
    __device__ __forceinline__ bool next(int i, Unit& u) const {
        if (i >= n) return false;
        u.pm = __builtin_amdgcn_readfirstlane(tab[2 * i]); u.pn = __builtin_amdgcn_readfirstlane(tab[2 * i + 1]); return true;
    }
    __device__ __forceinline__ void a_ready(const Unit&) const {}
    __device__ __forceinline__ void done(const Unit&) const {}
};

template <class Epi, class Sched, bool ALIGN_EPI = false, bool SP2 = false, int SCW = 0>
__device__ __forceinline__ void gemm_phase(PG8_LAS unsigned char* lds, const Gemm g, const Sched& S, const Epi& E, const int tid) {
    const int wid = __builtin_amdgcn_readfirstlane(tid >> 6), lane = tid & 63, wr = wid >> 2, wc = wid & 3, fr = lane & 15, fq = lane >> 4;
    int K_ = g.K; asm volatile("" : "+s"(K_));
    const int K = K_, nt = K / BK;
    unsigned voffA[2], voffB[2];
#pragma unroll
    for (int i = 0; i < 2; ++i) { int R, C; stage_rc(tid * 16 + i * 8192, R, C); const int Rb = Epi::PERM ? ((R & ~31) + perm32(R & 31)) : R;
        voffA[i] = (unsigned)(R * K + C) * 2u; voffB[i] = (unsigned)(Rb * K + C) * 2u; }
    const size_t kstep = (size_t)(BK * 2);
    const size_t hstep = (size_t)HALF * K * 2;
    const size_t tstep = 2 * hstep;
    const unsigned ldsw = (unsigned)wid * 1024u;
    const int aoff = lds_byte(wr * 64 + fr, fq * 8), boff = lds_byte(wc * 32 + fr, fq * 8);
#define PG8_SA(b, h) (((b) * 2 + (h)) * HTB)
#define PG8_SB(b, h) ((4 + (b) * 2 + (h)) * HTB)
#define PG8_STAGE(bufoff, gbase, voff) do { _Pragma("unroll") for (int _i = 0; _i < 2; ++_i) \
        __builtin_amdgcn_global_load_lds((const unsigned*)((const char*)(gbase) + (voff)[_i]), (PG8_LAS unsigned*)(lds + (bufoff) + ldsw + _i * 8192), 16, 0, 0); } while (0)
#define PG8_LDA(dst, b, h) do { _Pragma("unroll") for (int m = 0; m < 4; ++m) _Pragma("unroll") for (int k = 0; k < 2; ++k) dst[m][k] = *(const PG8_LAS bf16x8*)(lds + PG8_SA(b, h) + aoff + m * 2048 + k * 1024); } while (0)
#define PG8_LDB(dst, b, h) do { _Pragma("unroll") for (int n = 0; n < 2; ++n) _Pragma("unroll") for (int k = 0; k < 2; ++k) dst[n][k] = *(const PG8_LAS bf16x8*)(lds + PG8_SB(b, h) + boff + n * 2048 + k * 1024); } while (0)
#define PG8_MMA(ai, bj, At, Bt) do { __builtin_amdgcn_s_setprio(1); _Pragma("unroll") for (int m = 0; m < 4; ++m) _Pragma("unroll") for (int n = 0; n < 2; ++n) { \
        if constexpr (SCW != 0) mfma_f8(acc[ai][bj][m][n], cat8(Bt[n][0], Bt[n][1]), cat8(At[m][0], At[m][1]), SCW * 0x01010101, 0x7f7f7f7f); \
        else { _Pragma("unroll") for (int k = 0; k < 2; ++k) acc[ai][bj][m][n] = __builtin_amdgcn_mfma_f32_16x16x32_bf16(Bt[n][k], At[m][k], acc[ai][bj][m][n], 0, 0, 0); } } __builtin_amdgcn_s_setprio(0); } while (0)
#define PG8_WAIT_V(n) asm volatile("s_waitcnt vmcnt(" #n ")" ::: "memory")
#define PG8_WAIT_L(n) asm volatile("s_waitcnt lgkmcnt(" #n ")" ::: "memory")
#define PG8_BAR __builtin_amdgcn_s_barrier()
#define PG8_SCHED __builtin_amdgcn_sched_barrier(0)
    Unit cur, nxt; int ui = 0;
    if (!S.next(0, cur)) return;
    f32x4 acc[2][2][4][2];
#pragma unroll
    for (int a = 0; a < 2; ++a)
#pragma unroll
        for (int b = 0; b < 2; ++b)
#pragma unroll
            for (int m = 0; m < 4; ++m)
#pragma unroll
                for (int n = 0; n < 2; ++n) acc[a][b][m][n] = (f32x4){0.f, 0.f, 0.f, 0.f};
    bf16x8 At[4][2], B0[2][2], B1[2][2];
    const char* cA = (const char*)g.A + (size_t)cur.pm * tstep; const char* cB = (const char*)g.Bt + (size_t)cur.pn * tstep;
    S.a_ready(cur);
    if constexpr (SP2) {
        PG8_STAGE(PG8_SB(0, 0), cB, voffB); PG8_STAGE(PG8_SB(0, 1), cB + hstep, voffB); PG8_STAGE(PG8_SA(0, 0), cA, voffA); PG8_STAGE(PG8_SA(0, 1), cA + hstep, voffA);
        if (wr == 1) PG8_BAR;
        PG8_WAIT_V(2); PG8_BAR;
        PG8_STAGE(PG8_SB(1, 0), cB + kstep, voffB); PG8_STAGE(PG8_SA(1, 0), cA + kstep, voffA); PG8_STAGE(PG8_SB(1, 1), cB + hstep + kstep, voffB);
        PG8_WAIT_V(6); PG8_BAR;
    } else {
        PG8_STAGE(PG8_SB(0, 0), cB, voffB); PG8_STAGE(PG8_SA(0, 0), cA, voffA); PG8_STAGE(PG8_SB(0, 1), cB + hstep, voffB); PG8_STAGE(PG8_SA(0, 1), cA + hstep, voffA);
        if (wr == 1) PG8_BAR;
        PG8_WAIT_V(4); PG8_BAR;
        PG8_STAGE(PG8_SB(1, 0), cB + kstep, voffB); PG8_STAGE(PG8_SA(1, 0), cA + kstep, voffA); PG8_STAGE(PG8_SB(1, 1), cB + hstep + kstep, voffB);
        PG8_WAIT_V(6); PG8_BAR;
    }
    for (;;) {
        const bool has_next = S.next(ui + 1, nxt);
        const char* nA = has_next ? (const char*)g.A + (size_t)nxt.pm * tstep : cA; const char* nB = has_next ? (const char*)g.Bt + (size_t)nxt.pn * tstep : cB;
        for (int t = 0; t < nt; t += 2) {
            const bool last = (t == nt - 2);
            const char* a1 = cA + (size_t)(t + 1) * kstep;
            const char* a2 = last ? nA : cA + (size_t)(t + 2) * kstep; const char* b2 = last ? nB : cB + (size_t)(t + 2) * kstep;
            const char* a3 = a2 + kstep; const char* b3 = b2 + kstep;
            if (last && has_next) S.a_ready(nxt);
            if constexpr (SP2) {
            PG8_LDB(B0, 0, 0); PG8_LDB(B1, 0, 1); PG8_SCHED; PG8_LDA(At, 0, 0); PG8_STAGE(PG8_SA(1, 1), a1 + hstep, voffA);
            PG8_WAIT_V(8); PG8_WAIT_L(0); PG8_BAR; PG8_MMA(0, 0, At, B0); PG8_MMA(0, 1, At, B1); PG8_BAR; PG8_SCHED;
            PG8_LDA(At, 0, 1); PG8_STAGE(PG8_SB(0, 0), b2, voffB); PG8_STAGE(PG8_SB(0, 1), b2 + hstep, voffB); PG8_STAGE(PG8_SA(0, 0), a2, voffA);
            PG8_WAIT_V(8); PG8_WAIT_L(0); PG8_BAR; PG8_MMA(1, 0, At, B0); PG8_MMA(1, 1, At, B1); PG8_BAR; PG8_SCHED;
            PG8_LDB(B0, 1, 0); PG8_LDB(B1, 1, 1); PG8_SCHED; PG8_LDA(At, 1, 0); PG8_STAGE(PG8_SA(0, 1), a2 + hstep, voffA);
            PG8_WAIT_V(8); PG8_WAIT_L(0); PG8_BAR; PG8_MMA(0, 0, At, B0); PG8_MMA(0, 1, At, B1); PG8_BAR; PG8_SCHED;
            PG8_LDA(At, 1, 1); PG8_STAGE(PG8_SB(1, 0), b3, voffB); PG8_STAGE(PG8_SB(1, 1), b3 + hstep, voffB); PG8_STAGE(PG8_SA(1, 0), a3, voffA);
            PG8_WAIT_V(8); PG8_WAIT_L(0); PG8_BAR; PG8_MMA(1, 0, At, B0); PG8_MMA(1, 1, At, B1); PG8_BAR; PG8_SCHED;
            } else {
            PG8_LDB(B0, 0, 0); PG8_SCHED; PG8_LDA(At, 0, 0); PG8_STAGE(PG8_SA(1, 1), a1 + hstep, voffA);
            PG8_WAIT_L(8); PG8_BAR; PG8_WAIT_L(0); PG8_MMA(0, 0, At, B0); PG8_BAR; PG8_SCHED;
            PG8_LDB(B1, 0, 1); PG8_STAGE(PG8_SB(0, 0), b2, voffB);
            PG8_BAR; PG8_WAIT_L(0); PG8_MMA(0, 1, At, B1); PG8_BAR;
            PG8_LDA(At, 0, 1); PG8_STAGE(PG8_SA(0, 0), a2, voffA);
            PG8_BAR; PG8_WAIT_L(0); PG8_MMA(1, 0, At, B0); PG8_BAR; PG8_SCHED;
            PG8_STAGE(PG8_SB(0, 1), b2 + hstep, voffB);
            PG8_WAIT_V(6); PG8_BAR; PG8_MMA(1, 1, At, B1); PG8_BAR;
            PG8_LDB(B0, 1, 0); PG8_SCHED; PG8_LDA(At, 1, 0); PG8_STAGE(PG8_SA(0, 1), a2 + hstep, voffA);
            PG8_WAIT_L(8); PG8_BAR; PG8_WAIT_L(0); PG8_MMA(0, 0, At, B0); PG8_BAR; PG8_SCHED;
            PG8_LDB(B1, 1, 1); PG8_STAGE(PG8_SB(1, 0), b3, voffB);
            PG8_BAR; PG8_WAIT_L(0); PG8_MMA(0, 1, At, B1); PG8_BAR;
            PG8_LDA(At, 1, 1); PG8_STAGE(PG8_SA(1, 0), a3, voffA);
            PG8_BAR; PG8_WAIT_L(0); PG8_MMA(1, 0, At, B0); PG8_BAR; PG8_SCHED;
            PG8_STAGE(PG8_SB(1, 1), b3 + hstep, voffB);
            PG8_WAIT_V(6); PG8_BAR; PG8_MMA(1, 1, At, B1); PG8_BAR;
            }
        }
        if constexpr (SCW != 0) asm volatile("s_nop 15\n\ts_nop 15" ::: "memory");
        if constexpr (ALIGN_EPI) { if (wr == 0) PG8_BAR; }
        if constexpr (!Epi::AFTER_DRAIN) { E(acc, cur, wr, wc, fr, fq); S.done(cur); }
        if (!has_next) break;
#pragma unroll
        for (int a = 0; a < 2; ++a)
#pragma unroll
            for (int b = 0; b < 2; ++b)
#pragma unroll
                for (int m = 0; m < 4; ++m)
#pragma unroll
                    for (int n = 0; n < 2; ++n) acc[a][b][m][n] = (f32x4){0.f, 0.f, 0.f, 0.f};
        cur = nxt; cA = nA; cB = nB; ++ui;
        if constexpr (ALIGN_EPI) { if (wr == 1) PG8_BAR; }
    }
    PG8_WAIT_V(0);
    if constexpr (!ALIGN_EPI) { if (wr == 0) PG8_BAR; }
    PG8_BAR;
    if constexpr (Epi::AFTER_DRAIN) { E.fused(acc, cur, wr, wc, fr, fq, lds, wid, lane); S.done(cur); }
#undef PG8_SA
#undef PG8_SB
#undef PG8_STAGE
#undef PG8_LDA
#undef PG8_LDB
#undef PG8_MMA
#undef PG8_WAIT_V
#undef PG8_WAIT_L
#undef PG8_BAR
#undef PG8_SCHED
}
template <class Epi, class Sched, bool ALIGN_EPI = false, bool SP2 = false, int SCW = 0>
__device__ __forceinline__ void gemm_phase_g(PG8_LAS unsigned char* lds, const Gemm g, const Sched& S, const Epi& E, const int tid, const int* rowmap) {
    const int wid = __builtin_amdgcn_readfirstlane(tid >> 6), lane = tid & 63, wr = wid >> 2, wc = wid & 3, fr = lane & 15, fq = lane >> 4;
    int K_ = g.K; asm volatile("" : "+s"(K_));
    const int K = K_, nt = K / BK;
    unsigned voffB[2], cv0[2], cv1[2], nv0[2], nv1[2]; int RA[2], CA[2];
#pragma unroll
    for (int i = 0; i < 2; ++i) { int R, C; stage_rc(tid * 16 + i * 8192, R, C); const int Rb = Epi::PERM ? ((R & ~31) + perm32(R & 31)) : R;
        RA[i] = R; CA[i] = C; voffB[i] = (unsigned)(Rb * K + C) * 2u; }
    const size_t kstep = (size_t)(BK * 2);
    const size_t hstep = (size_t)HALF * K * 2;
    const size_t tstep = 2 * hstep;
    const unsigned ldsw = (unsigned)wid * 1024u;
    const int aoff = lds_byte(wr * 64 + fr, fq * 8), boff = lds_byte(wc * 32 + fr, fq * 8);
#define PG8_SA(b, h) (((b) * 2 + (h)) * HTB)
#define PG8_SB(b, h) ((4 + (b) * 2 + (h)) * HTB)
#define PG8_STAGE(bufoff, gbase, voff) do { _Pragma("unroll") for (int _i = 0; _i < 2; ++_i) \
        __builtin_amdgcn_global_load_lds((const unsigned*)((const char*)(gbase) + (voff)[_i]), (PG8_LAS unsigned*)(lds + (bufoff) + ldsw + _i * 8192), 16, 0, 0); } while (0)
#define PG8_LDA(dst, b, h) do { _Pragma("unroll") for (int m = 0; m < 4; ++m) _Pragma("unroll") for (int k = 0; k < 2; ++k) dst[m][k] = *(const PG8_LAS bf16x8*)(lds + PG8_SA(b, h) + aoff + m * 2048 + k * 1024); } while (0)
#define PG8_LDB(dst, b, h) do { _Pragma("unroll") for (int n = 0; n < 2; ++n) _Pragma("unroll") for (int k = 0; k < 2; ++k) dst[n][k] = *(const PG8_LAS bf16x8*)(lds + PG8_SB(b, h) + boff + n * 2048 + k * 1024); } while (0)
#define PG8_MMA(ai, bj, At, Bt) do { __builtin_amdgcn_s_setprio(1); _Pragma("unroll") for (int m = 0; m < 4; ++m) _Pragma("unroll") for (int n = 0; n < 2; ++n) { \
        if constexpr (SCW != 0) mfma_f8(acc[ai][bj][m][n], cat8(Bt[n][0], Bt[n][1]), cat8(At[m][0], At[m][1]), SCW * 0x01010101, 0x7f7f7f7f); \
        else { _Pragma("unroll") for (int k = 0; k < 2; ++k) acc[ai][bj][m][n] = __builtin_amdgcn_mfma_f32_16x16x32_bf16(Bt[n][k], At[m][k], acc[ai][bj][m][n], 0, 0, 0); } } __builtin_amdgcn_s_setprio(0); } while (0)
#define PG8_WAIT_V(n) asm volatile("s_waitcnt vmcnt(" #n ")" ::: "memory")
#define PG8_WAIT_L(n) asm volatile("s_waitcnt lgkmcnt(" #n ")" ::: "memory")
#define PG8_BAR __builtin_amdgcn_s_barrier()
#define PG8_SCHED __builtin_amdgcn_sched_barrier(0)
    static_assert(SP2, "gemm_phase_g: SP2 form only");
    Unit cur, nxt; int ui = 0;
    if (!S.next(0, cur)) return;
    f32x4 acc[2][2][4][2];
#pragma unroll
    for (int a = 0; a < 2; ++a)
#pragma unroll
        for (int b = 0; b < 2; ++b)
#pragma unroll
            for (int m = 0; m < 4; ++m)
#pragma unroll
                for (int n = 0; n < 2; ++n) acc[a][b][m][n] = (f32x4){0.f, 0.f, 0.f, 0.f};
    bf16x8 At[4][2], B0[2][2], B1[2][2];
    const char* gA = (const char*)g.A; const char* cB = (const char*)g.Bt + (size_t)cur.pn * tstep;
#define PG8_ROWS(pm_, v0_, v1_) do { _Pragma("unroll") for (int _i = 0; _i < 2; ++_i) { v0_[_i] = (unsigned)(rowmap[(pm_) * BM + RA[_i]] * K + CA[_i]) * 2u; v1_[_i] = (unsigned)(rowmap[(pm_) * BM + HALF + RA[_i]] * K + CA[_i]) * 2u; } } while (0)
    PG8_ROWS(cur.pm, cv0, cv1);
    const unsigned voffA[2] = {0u, 0u}; const char* cA = gA; (void)voffA; (void)cA;
    S.a_ready(cur);
    if constexpr (SP2) {
        PG8_STAGE(PG8_SB(0, 0), cB, voffB); PG8_STAGE(PG8_SB(0, 1), cB + hstep, voffB); PG8_STAGE(PG8_SA(0, 0), gA, cv0); PG8_STAGE(PG8_SA(0, 1), gA, cv1);
        if (wr == 1) PG8_BAR;
        PG8_WAIT_V(2); PG8_BAR;
        PG8_STAGE(PG8_SB(1, 0), cB + kstep, voffB); PG8_STAGE(PG8_SA(1, 0), gA + kstep, cv0); PG8_STAGE(PG8_SB(1, 1), cB + hstep + kstep, voffB);
        PG8_WAIT_V(6); PG8_BAR;
    } else {
        PG8_STAGE(PG8_SB(0, 0), cB, voffB); PG8_STAGE(PG8_SA(0, 0), cA, voffA); PG8_STAGE(PG8_SB(0, 1), cB + hstep, voffB); PG8_STAGE(PG8_SA(0, 1), cA + hstep, voffA);
        if (wr == 1) PG8_BAR;
        PG8_WAIT_V(4); PG8_BAR;
        PG8_STAGE(PG8_SB(1, 0), cB + kstep, voffB); PG8_STAGE(PG8_SA(1, 0), cA + kstep, voffA); PG8_STAGE(PG8_SB(1, 1), cB + hstep + kstep, voffB);
        PG8_WAIT_V(6); PG8_BAR;
    }
    for (;;) {
        const bool has_next = S.next(ui + 1, nxt);
        const char* nB = has_next ? (const char*)g.Bt + (size_t)nxt.pn * tstep : cB;
        if (has_next) PG8_ROWS(nxt.pm, nv0, nv1); else { nv0[0] = cv0[0]; nv0[1] = cv0[1]; nv1[0] = cv1[0]; nv1[1] = cv1[1]; }
        for (int t = 0; t < nt; t += 2) {
            const bool last = (t == nt - 2);
            const char* a1 = gA + (size_t)(t + 1) * kstep;
            const char* a2 = last ? gA : gA + (size_t)(t + 2) * kstep; const char* b2 = last ? nB : cB + (size_t)(t + 2) * kstep;
            unsigned w0[2], w1[2]; w0[0] = last ? nv0[0] : cv0[0]; w0[1] = last ? nv0[1] : cv0[1]; w1[0] = last ? nv1[0] : cv1[0]; w1[1] = last ? nv1[1] : cv1[1];
            const char* a3 = a2 + kstep; const char* b3 = b2 + kstep;
            if (last && has_next) S.a_ready(nxt);
            if constexpr (SP2) {
            PG8_LDB(B0, 0, 0); PG8_LDB(B1, 0, 1); PG8_SCHED; PG8_LDA(At, 0, 0); PG8_STAGE(PG8_SA(1, 1), a1, cv1);
            PG8_WAIT_V(8); PG8_WAIT_L(0); PG8_BAR; PG8_MMA(0, 0, At, B0); PG8_MMA(0, 1, At, B1); PG8_BAR; PG8_SCHED;
            PG8_LDA(At, 0, 1); PG8_STAGE(PG8_SB(0, 0), b2, voffB); PG8_STAGE(PG8_SB(0, 1), b2 + hstep, voffB); PG8_STAGE(PG8_SA(0, 0), a2, w0);
            PG8_WAIT_V(8); PG8_WAIT_L(0); PG8_BAR; PG8_MMA(1, 0, At, B0); PG8_MMA(1, 1, At, B1); PG8_BAR; PG8_SCHED;
            PG8_LDB(B0, 1, 0); PG8_LDB(B1, 1, 1); PG8_SCHED; PG8_LDA(At, 1, 0); PG8_STAGE(PG8_SA(0, 1), a2, w1);
            PG8_WAIT_V(8); PG8_WAIT_L(0); PG8_BAR; PG8_MMA(0, 0, At, B0); PG8_MMA(0, 1, At, B1); PG8_BAR; PG8_SCHED;
            PG8_LDA(At, 1, 1); PG8_STAGE(PG8_SB(1, 0), b3, voffB); PG8_STAGE(PG8_SB(1, 1), b3 + hstep, voffB); PG8_STAGE(PG8_SA(1, 0), a3, w0);
            PG8_WAIT_V(8); PG8_WAIT_L(0); PG8_BAR; PG8_MMA(1, 0, At, B0); PG8_MMA(1, 1, At, B1); PG8_BAR; PG8_SCHED;
            } else {
            PG8_LDB(B0, 0, 0); PG8_SCHED; PG8_LDA(At, 0, 0); PG8_STAGE(PG8_SA(1, 1), a1, cv1);
            PG8_WAIT_L(8); PG8_BAR; PG8_WAIT_L(0); PG8_MMA(0, 0, At, B0); PG8_BAR; PG8_SCHED;
            PG8_LDB(B1, 0, 1); PG8_STAGE(PG8_SB(0, 0), b2, voffB);
            PG8_BAR; PG8_WAIT_L(0); PG8_MMA(0, 1, At, B1); PG8_BAR;
            PG8_LDA(At, 0, 1); PG8_STAGE(PG8_SA(0, 0), a2, voffA);
            PG8_BAR; PG8_WAIT_L(0); PG8_MMA(1, 0, At, B0); PG8_BAR; PG8_SCHED;
            PG8_STAGE(PG8_SB(0, 1), b2 + hstep, voffB);
            PG8_WAIT_V(6); PG8_BAR; PG8_MMA(1, 1, At, B1); PG8_BAR;
            PG8_LDB(B0, 1, 0); PG8_SCHED; PG8_LDA(At, 1, 0); PG8_STAGE(PG8_SA(0, 1), a2, w1);
            PG8_WAIT_L(8); PG8_BAR; PG8_WAIT_L(0); PG8_MMA(0, 0, At, B0); PG8_BAR; PG8_SCHED;
            PG8_LDB(B1, 1, 1); PG8_STAGE(PG8_SB(1, 0), b3, voffB);
            PG8_BAR; PG8_WAIT_L(0); PG8_MMA(0, 1, At, B1); PG8_BAR;
            PG8_LDA(At, 1, 1); PG8_STAGE(PG8_SA(1, 0), a3, voffA);
            PG8_BAR; PG8_WAIT_L(0); PG8_MMA(1, 0, At, B0); PG8_BAR; PG8_SCHED;
            PG8_STAGE(PG8_SB(1, 1), b3 + hstep, voffB);
            PG8_WAIT_V(6); PG8_BAR; PG8_MMA(1, 1, At, B1); PG8_BAR;
            }
        }
        if constexpr (SCW != 0) asm volatile("s_nop 15\n\ts_nop 15" ::: "memory");
        if constexpr (ALIGN_EPI) { if (wr == 0) PG8_BAR; }
        if constexpr (!Epi::AFTER_DRAIN) { E(acc, cur, wr, wc, fr, fq); S.done(cur); }
        if (!has_next) break;
#pragma unroll
        for (int a = 0; a < 2; ++a)
#pragma unroll
            for (int b = 0; b < 2; ++b)
#pragma unroll
                for (int m = 0; m < 4; ++m)
#pragma unroll
                    for (int n = 0; n < 2; ++n) acc[a][b][m][n] = (f32x4){0.f, 0.f, 0.f, 0.f};
        cur = nxt; cB = nB; ++ui; cv0[0] = nv0[0]; cv0[1] = nv0[1]; cv1[0] = nv1[0]; cv1[1] = nv1[1];
        if constexpr (ALIGN_EPI) { if (wr == 1) PG8_BAR; }
    }
    PG8_WAIT_V(0);
    if constexpr (!ALIGN_EPI) { if (wr == 0) PG8_BAR; }
    PG8_BAR;
    if constexpr (Epi::AFTER_DRAIN) { E.fused(acc, cur, wr, wc, fr, fq, lds, wid, lane); S.done(cur); }
#undef PG8_ROWS
#undef PG8_SA
#undef PG8_SB
#undef PG8_STAGE
#undef PG8_LDA
#undef PG8_LDB
#undef PG8_MMA
#undef PG8_WAIT_V
#undef PG8_WAIT_L
#undef PG8_BAR
#undef PG8_SCHED
}
}

#ifndef REP_MASK
#define REP_MASK 0
#endif
#define NREP(k) (1 + ((REP_MASK >> (k)) & 1))

constexpr int NB = 16, SEQ = 2048, D = 1024, NMETA = 16;
constexpr int MX = NB * SEQ;
constexpr int INW = 3344, PW = 3584;
constexpr int GQ = 0, GK = 256, GV = 512, GG = 1024, GKL = 1536;
constexpr int RW0 = 1552;
constexpr int RR = RW0, RK = RW0 + 512, RV = RW0 + 1024, RWL = RW0 + 1536, RAL = RW0 + 1600, RGL = RW0 + 1664;
constexpr int NE = 32, TOPK = 4;
constexpr int NCH = 33;
constexpr float ALPHA = 1.189207115002721f;
constexpr int NWAVES = 8, NTHR = 512;

constexpr size_t MiB = 1u << 20;
constexpr size_t WS_CTL = 0, CTL_ZERO_BYTES = 1 * MiB;
constexpr size_t WS_STATS = 1 * MiB;
constexpr size_t WS_TOPI  = WS_STATS + 256 * 1024;
constexpr size_t WS_GATE  = WS_TOPI + 512 * 1024;
constexpr size_t WS_RANK  = WS_GATE + 512 * 1024;
constexpr size_t WS_TSLOT = WS_RANK + 512 * 1024;
constexpr size_t WS_BON   = WS_TSLOT + 512 * 1024;
constexpr size_t WS_PROJM = WS_BON + 1 * MiB;
constexpr size_t WS_OPSM  = WS_PROJM + 256 * 1024;
constexpr size_t WS_DL    = WS_OPSM + 256 * 1024;
constexpr size_t WS_W2T   = WS_DL + 1 * MiB;
constexpr size_t WS_A2T   = WS_W2T + 64 * 1024;
constexpr size_t WS_G2T   = WS_A2T + 64 * 1024;
constexpr size_t WS_RWH   = WS_G2T + 128 * 1024;
constexpr size_t WS_RWL   = WS_RWH + 64 * 1024;
constexpr size_t WS_TILEE = WS_RWL + 64 * 1024;
constexpr size_t WS_SLOTTOK = WS_TILEE + 4096;
constexpr size_t WS_WIN   = 8 * MiB;
constexpr size_t WS_WOUT  = 15 * MiB;
static_assert(WS_SLOTTOK + 139264 * 4 <= WS_WIN, "table region");
constexpr size_t WS_A0    = 20 * MiB;
constexpr size_t WS_YMIX  = WS_A0;
constexpr size_t WS_PROJ  = 84 * MiB;
constexpr size_t WS_R1    = 308 * MiB;
constexpr size_t WS_GAM   = 520 * MiB;
constexpr size_t WS_SST   = 524 * MiB;
constexpr size_t WS_GUS   = 692 * MiB;
constexpr size_t WS_H1    = 20 * MiB;
constexpr size_t WS_XS    = 84 * MiB;
constexpr size_t WS_YS    = WS_XS;
constexpr size_t WS_ACT   = 356 * MiB;
constexpr size_t WS_MIXB  = 628 * MiB;
constexpr size_t WS_WUP   = 758 * MiB;
constexpr size_t WS_WDN   = 822 * MiB;
constexpr size_t WS_H1Q   = 854 * MiB;
constexpr size_t WS_END   = 886 * MiB;
constexpr int CW_BAR = 4096;
constexpr int CW_CNT = 16384;
constexpr int CW_QH = 20480;

constexpr int RING_BYTES = 131072;
constexpr int LDS_BYTES = 147456;
constexpr int TAB_OFF = 132096;
constexpr int MISC_OFF = LDS_BYTES - 512;

#define LAS __attribute__((address_space(3)))
typedef unsigned short bf16;
typedef unsigned v4u __attribute__((ext_vector_type(4)));
typedef unsigned v2u __attribute__((ext_vector_type(2)));
typedef float f32x4 __attribute__((ext_vector_type(4)));
typedef short bf16x8 __attribute__((ext_vector_type(8)));
typedef int i32x4g __attribute__((ext_vector_type(4)));
#define LDS_WAIT() asm volatile("s_waitcnt lgkmcnt(0)" ::: "memory")
__device__ __forceinline__ float bflo(unsigned w) { return __uint_as_float(w << 16); }
__device__ __forceinline__ float bfhi(unsigned w) { return __uint_as_float(w & 0xffff0000u); }
typedef float f32x2_t __attribute__((ext_vector_type(2))); typedef __bf16 bf16x2_t __attribute__((ext_vector_type(2)));
__device__ __forceinline__ unsigned pk2(float lo, float hi) { const f32x2_t v = {lo, hi}; const bf16x2_t b = __builtin_convertvector(v, bf16x2_t); return __builtin_bit_cast(unsigned, b); }
__device__ __forceinline__ unsigned f2bf(float f) { return pk2(f, 0.f) & 0xffffu; }
#define CYC() ((unsigned)__builtin_amdgcn_s_getreg((19 << 11) | 29))
__device__ __forceinline__ void lds_barrier() { asm volatile("s_waitcnt lgkmcnt(0)" ::: "memory"); __builtin_amdgcn_s_barrier(); asm volatile("" ::: "memory"); }
__device__ __forceinline__ float shx(float v, int mask, int lane) { return __int_as_float(__builtin_amdgcn_ds_bpermute((lane ^ mask) << 2, __float_as_int(v))); }
template <int CTRL> __device__ __forceinline__ float dppf0(float x) { return __int_as_float(__builtin_amdgcn_update_dpp(0, __float_as_int(x), CTRL, 0xF, 0xF, true)); }
__device__ __forceinline__ float wave_sum(float v, int lane) {
    v += dppf0<0xB1>(v); v += dppf0<0x4E>(v); v += dppf0<0x141>(v); v += dppf0<0x140>(v);
    v += shx(v, 16, lane); v += shx(v, 32, lane);
    return v;
}
__device__ __forceinline__ float softplus_f(float x) { return fmaxf(x, 0.f) + log1pf(expf(-fabsf(x))); }
__device__ __forceinline__ float logsigmoid_f(float x) { return fminf(x, 0.f) - log1pf(expf(-fabsf(x))); }
__device__ __forceinline__ float sigmoid_f(float x) { return 1.f / (1.f + expf(-x)); }
__device__ __forceinline__ float fexp(float x) { return __builtin_amdgcn_exp2f(x * 1.4426950408889634f); }
__device__ __forceinline__ float flog(float x) { return __builtin_amdgcn_logf(x) * 0.6931471805599453f; }
__device__ __forceinline__ float fsigmoid(float x) { return __builtin_amdgcn_rcpf(1.f + fexp(-x)); }
__device__ __forceinline__ float ftanh(float x) { return 2.f * fsigmoid(2.f * x) - 1.f; }
__device__ __forceinline__ float fsoftplus(float x) { return fmaxf(x, 0.f) + flog(1.f + fexp(-fabsf(x))); }
__device__ __forceinline__ float flogsigmoid(float x) { return fminf(x, 0.f) - flog(1.f + fexp(-fabsf(x))); }
template <int CTRL> __device__ __forceinline__ float dppf(float x) { return __int_as_float(__builtin_amdgcn_update_dpp(0, __float_as_int(x), CTRL, 0xF, 0xF, true)); }
__device__ __forceinline__ float red8(float x) {
    x += dppf<0xB1>(x); x += dppf<0x4E>(x); x += dppf<0x141>(x); return x;
}
__device__ __forceinline__ f32x4 mfma16(bf16x8 a, bf16x8 b, f32x4 c) { return __builtin_amdgcn_mfma_f32_16x16x32_bf16(a, b, c, 0, 0, 0); }
__device__ __forceinline__ unsigned ld_agent(const unsigned* p) { return __hip_atomic_load(p, __ATOMIC_RELAXED, __HIP_MEMORY_SCOPE_AGENT); }

#define XB_TMO      128
#define XB_XCNT(j)  (256  + 64 * (j))
#define XB_XSUB(j)  (1280 + 64 * (j))
#define XB_XGEN(j)  (2304 + 64 * (j))
#define XB_TOP      3328
#define XB_TOPGEN   3392
#define XCD_BAR_WORDS 3456
#define XB_SPIN_CAP (1u << 18)
__device__ __forceinline__ unsigned xb_ld(unsigned* p)              { return __hip_atomic_load(p, __ATOMIC_RELAXED, __HIP_MEMORY_SCOPE_AGENT); }
__device__ __forceinline__ unsigned xb_add(unsigned* p, unsigned v) { return __hip_atomic_fetch_add(p, v, __ATOMIC_RELAXED, __HIP_MEMORY_SCOPE_AGENT); }
__device__ __forceinline__ unsigned xb_xcc_id() { return (unsigned)__builtin_amdgcn_s_getreg((3 << 11) | 20) & 0xFu; }
#define XB_SPIN(cond, bar) do { unsigned _sp = 0; while (cond) { __builtin_amdgcn_s_sleep(1); \
    if ((++_sp & 255u) == 0u) { if (xb_ld(&(bar)[XB_TMO])) break; if (_sp > XB_SPIN_CAP) { atomicAdd(&(bar)[XB_TMO], 1u); break; } } } } while (0)
struct XcdBarrier { unsigned* bar; unsigned x; volatile LAS unsigned* st; };
__device__ __forceinline__ XcdBarrier xcd_barrier_post(unsigned* bar, volatile LAS unsigned* st, bool leader) {
    XcdBarrier b; b.bar = bar; b.x = xb_xcc_id(); b.st = st;
    if (leader) (void)xb_add(&bar[XB_XCNT(b.x)], 1u);
    return b;
}
__device__ __forceinline__ void xcd_barrier_complete(unsigned* bar, unsigned x, unsigned& nloc, unsigned& nx) {
    const unsigned G = gridDim.x * gridDim.y * gridDim.z;
    unsigned sum, cnt, mine, sp = 0u;
    for (;;) {
        sum = 0u; cnt = 0u; mine = 0u;
#pragma unroll
        for (unsigned j = 0; j < 16; ++j) { const unsigned c = xb_ld(&bar[XB_XCNT(j)]); sum += c; cnt += (c > 0u) ? 1u : 0u; mine = (j == x) ? c : mine; }
        if (sum == G) break;
        __builtin_amdgcn_s_sleep(1);
        if ((++sp & 255u) == 0u) { if (xb_ld(&bar[XB_TMO])) break; if (sp > XB_SPIN_CAP) { atomicAdd(&bar[XB_TMO], 1u); break; } }
    }
    nloc = mine > 0u ? mine : 1u; nx = cnt > 0u ? cnt : 1u;
}
__device__ __forceinline__ void xcd_barrier(const XcdBarrier& b, bool leader) {
    asm volatile("s_waitcnt vmcnt(0)" ::: "memory");
    __syncthreads();
    if (leader) {
        unsigned* bar = b.bar;
        __builtin_amdgcn_s_waitcnt(0);
        unsigned nloc = b.st[0], nx = b.st[1];
        if (nloc == 0u) { xcd_barrier_complete(bar, b.x, nloc, nx); b.st[0] = nloc; b.st[1] = nx; }
        const unsigned old = xb_add(&bar[XB_XSUB(b.x)], 1u);
        const unsigned gen = old / nloc;
        if (old + 1u == (gen + 1u) * nloc) {
            __builtin_amdgcn_fence(__ATOMIC_RELEASE, "agent");
            asm volatile("s_waitcnt vmcnt(0)" ::: "memory");
            const unsigned og = xb_add(&bar[XB_TOP], 1u);
            const unsigned tg = og / nx;
            if (og + 1u == (tg + 1u) * nx) xb_add(&bar[XB_TOPGEN], 1u);
            else XB_SPIN(xb_ld(&bar[XB_TOPGEN]) == tg, bar);
            __builtin_amdgcn_fence(__ATOMIC_ACQUIRE, "agent");
            xb_add(&bar[XB_XGEN(b.x)], 1u);
            asm volatile("s_waitcnt vmcnt(0)" ::: "memory");
        } else {
            XB_SPIN(xb_ld(&bar[XB_XGEN(b.x)]) == gen, bar);
            __builtin_amdgcn_fence(__ATOMIC_ACQUIRE, "agent");
            asm volatile("s_waitcnt vmcnt(0)" ::: "memory");
        }
    }
    __syncthreads();
}

struct Args { const float* in[30]; float* out; unsigned char* ws; };
enum { I_X = 0, I_META, I_LNIN_G, I_LNIN_B, I_WIN, I_GKW2, I_GKB, I_GNORM, I_MU, I_W0, I_W2, I_A0, I_A2, I_G2, I_KK, I_KA, I_RK, I_RLNG, I_RLNB, I_WOUT,
       I_LN1G, I_LN1B, I_RTW, I_RTB, I_WUP, I_BUP, I_WDN, I_BDN, I_LN2G, I_LN2B };
struct Frame { LAS unsigned char* lds; int tid, lane, wave, blk, G; };
__device__ __forceinline__ int lane_id() { int l; asm volatile("v_mbcnt_lo_u32_b32 %0, -1, 0\n\tv_mbcnt_hi_u32_b32 %0, -1, %0" : "=v"(l)); return l; }
__device__ __forceinline__ Frame mkframe(LAS unsigned char* lds, int wave) { Frame F; F.lds = lds; F.wave = wave; F.lane = lane_id(); F.tid = wave * 64 + F.lane; F.blk = blockIdx.x; F.G = gridDim.x; return F; }

__device__ __forceinline__ void transpose_item(const float* W, int K, int N, int nblk, bf16* WT, LAS float* scr, int item, int lane) {
    const int kb = item / nblk, nb = item - kb * nblk, k0 = 64 * kb, n0 = 32 * nb;
    const int nn = n0 + (lane & 31); const bool ok = nn < N;
#pragma unroll 8
    for (int i = 0; i < 32; ++i) { const int kk = 2 * i + (lane >> 5); scr[kk * 33 + (lane & 31)] = ok ? W[(size_t)(k0 + kk) * N + nn] : 0.f; }
    LDS_WAIT();
    const int c = lane & 7;
#pragma unroll
    for (int j = 0; j < 4; ++j) { const int n = (lane >> 3) + 8 * j; const LAS float* s = scr + (8 * c) * 33 + n;
        v4u o; o.x = pk2(s[0 * 33], s[1 * 33]); o.y = pk2(s[2 * 33], s[3 * 33]); o.z = pk2(s[4 * 33], s[5 * 33]); o.w = pk2(s[6 * 33], s[7 * 33]);
        *(v4u*)(WT + (size_t)(n0 + n) * K + k0 + 8 * c) = o; }
    LDS_WAIT();
}

__device__ __forceinline__ void transpose_item64_f8(const float* W, int K, int N, unsigned char* WT, float scale, LAS float* scr, int item, int lane) {
    const int nblk = N >> 6, kb = item / nblk, nb = item - kb * nblk, k0 = 64 * kb, n0 = 64 * nb;
    const int r4 = lane >> 4, c4 = lane & 15;
    f32x4 v[16];
#pragma unroll
    for (int i = 0; i < 16; ++i) v[i] = *(const f32x4*)(W + (size_t)(k0 + 4 * i + r4) * N + n0 + 4 * c4);
#pragma unroll
    for (int i = 0; i < 16; ++i) *(LAS f32x4*)(scr + (4 * i + r4) * 68 + 4 * c4) = v[i];
    LDS_WAIT();
    unsigned char* orow = WT + (size_t)(n0 + lane) * K + k0;
#pragma unroll
    for (int g = 0; g < 4; ++g) { const LAS float* s = scr + (16 * g) * 68 + lane; v4u o;
#pragma unroll
        for (int q = 0; q < 4; ++q) { int w = __builtin_amdgcn_cvt_pk_fp8_f32(s[(4 * q + 0) * 68] * scale, s[(4 * q + 1) * 68] * scale, 0, false);
            w = __builtin_amdgcn_cvt_pk_fp8_f32(s[(4 * q + 2) * 68] * scale, s[(4 * q + 3) * 68] * scale, w, true); o[q] = (unsigned)w; }
        *(v4u*)(orow + 16 * g) = o; }
    LDS_WAIT();
}
__device__ __forceinline__ void convert_expert_weights(const Args& a, const Frame& F, int qsel) {
    unsigned char* ws = a.ws;
    LAS float* scr = (LAS float*)(F.lds + F.wave * 17408);
    unsigned* QH = (unsigned*)(ws + WS_CTL) + CW_QH + 64 * qsel;
    constexpr int I_UP = 16 * 32, I_DN = 16 * 16, NIT = NE * (I_UP + I_DN);
    for (;;) {
        unsigned base = 0;
        if (F.lane == 0) base = __hip_atomic_fetch_add(QH, 8u, __ATOMIC_RELAXED, __HIP_MEMORY_SCOPE_AGENT);
        base = (unsigned)__builtin_amdgcn_readfirstlane((int)base);
        if (base >= (unsigned)NIT) break;
        for (int it = (int)base; it < (int)base + 8; ++it) {
            if (it < NE * I_UP) { const int e = it / I_UP, r = it - e * I_UP;
                transpose_item64_f8(a.in[I_WUP] + (size_t)e * D * 2048, D, 2048, ws + WS_WUP + (size_t)e * 2048 * D, 64.f, scr, r, F.lane); }
            else { const int it2 = it - NE * I_UP, e = it2 / I_DN, r = it2 - e * I_DN;
                transpose_item64_f8(a.in[I_WDN] + (size_t)e * D * D, D, D, ws + WS_WDN + (size_t)e * D * D, 128.f, scr, r, F.lane); }
        }
    }
}

__device__ __forceinline__ void phase0(const Args& a, const Frame& F) {
    unsigned char* ws = a.ws;
    const int gw = F.blk * NWAVES + F.wave, NGW = F.G * NWAVES;
    for (int cgp = F.blk; cgp < 53; cgp += F.G) {
        LAS float* HM = (LAS float*)F.lds;
        LAS float* PART = (LAS float*)(F.lds + 65536);
        for (int rr = 0; rr < 2; ++rr) {
            const int row = 2 * F.wave + rr; const f32x4* xr = (const f32x4*)(a.in[I_META] + row * D) + F.lane;
            f32x4 v[4]; float s = 0.f;
#pragma unroll
            for (int j = 0; j < 4; ++j) { v[j] = xr[64 * j]; s += (v[j].x + v[j].y) + (v[j].z + v[j].w); }
            const float mean = wave_sum(s, F.lane) * (1.f / D); float s2 = 0.f;
#pragma unroll
            for (int j = 0; j < 4; ++j) { v[j] = v[j] - mean; s2 += (v[j].x * v[j].x + v[j].y * v[j].y) + (v[j].z * v[j].z + v[j].w * v[j].w); }
            const float rstd = 1.f / sqrtf(wave_sum(s2, F.lane) * (1.f / D) + 1e-5f);
#pragma unroll
            for (int j = 0; j < 4; ++j) { const int col = 4 * (F.lane + 64 * j);
                const f32x4 gv = *(const f32x4*)(a.in[I_LNIN_G] + col), bv = *(const f32x4*)(a.in[I_LNIN_B] + col);
                const f32x4 y = v[j] * rstd * gv + bv;
                HM[(col + 0) * 16 + row] = y.x; HM[(col + 1) * 16 + row] = y.y; HM[(col + 2) * 16 + row] = y.z; HM[(col + 3) * 16 + row] = y.w; }
        }
        __syncthreads();
        const int col = cgp * 64 + F.lane; const bool ok = col < INW;
        float acc[16];
#pragma unroll
        for (int r = 0; r < 16; ++r) acc[r] = 0.f;
        const float* wp = a.in[I_WIN];
        for (int k = F.wave * 128; k < F.wave * 128 + 128; ++k) {
            const float wv = ok ? wp[(size_t)k * INW + col] : 0.f;
            const LAS f32x4* h = (const LAS f32x4*)(HM + k * 16);
#pragma unroll
            for (int q = 0; q < 4; ++q) { const f32x4 hv = h[q]; acc[4 * q + 0] += hv.x * wv; acc[4 * q + 1] += hv.y * wv; acc[4 * q + 2] += hv.z * wv; acc[4 * q + 3] += hv.w * wv; }
        }
#pragma unroll
        for (int r = 0; r < 16; ++r) PART[(F.wave * 16 + r) * 64 + F.lane] = acc[r];
        __syncthreads();
        bf16* PROJM = (bf16*)(ws + WS_PROJM);
        for (int o = F.tid; o < 1024; o += NTHR) { const int r = o >> 6, l = o & 63; float s = 0.f;
#pragma unroll
            for (int w = 0; w < 8; ++w) s += PART[(w * 16 + r) * 64 + l];
            PROJM[r * PW + cgp * 64 + l] = (bf16)f2bf(s); }
        if (F.tid < 64) PROJM[NMETA * PW + cgp * 64 + F.tid] = 0;
        __syncthreads();
    }
    {
        LAS float* scr = (LAS float*)(F.lds + F.wave * 16384);
        constexpr int I_IN = 16 * (PW / 32), I_OUT = 16 * 32;
        for (int it = gw; it < I_IN + I_OUT; it += NGW) {
            if (it < I_IN) transpose_item(a.in[I_WIN], D, INW, PW / 32, (bf16*)(ws + WS_WIN), scr, it, F.lane);
            else transpose_item(a.in[I_WOUT], D, D, 32, (bf16*)(ws + WS_WOUT), scr, it - I_IN, F.lane);
        }
    }
    {
        bf16* W2T = (bf16*)(ws + WS_W2T); bf16* A2T = (bf16*)(ws + WS_A2T); bf16* G2T = (bf16*)(ws + WS_G2T);
        for (int i = F.blk * NTHR + F.tid; i < 131072; i += F.G * NTHR) {
            if (i < 32768) { const int n = i >> 6, k = i & 63; W2T[i] = (bf16)f2bf(a.in[I_W2][k * 512 + n]); }
            else if (i < 65536) { const int j = i - 32768, n = j >> 6, k = j & 63; A2T[j] = (bf16)f2bf(a.in[I_A2][k * 512 + n]); }
            else { const int j = i - 65536, n = j >> 7, k = j & 127; G2T[j] = (bf16)f2bf(a.in[I_G2][k * 512 + n]); }
        }
    }
    {
        bf16* RWH = (bf16*)(ws + WS_RWH); bf16* RWL = (bf16*)(ws + WS_RWL);
        for (int i = F.blk * NTHR + F.tid; i < D * NE; i += F.G * NTHR) { const int c = i >> 5, e = i & 31; const float w = a.in[I_RTW][i];
            const unsigned hi = f2bf(w); const float lo = w - __uint_as_float(hi << 16);
            RWH[e * D + c] = (bf16)hi; RWL[e * D + c] = (bf16)f2bf(lo); }
    }
    {
        bf16* A0 = (bf16*)(ws + WS_A0); float* ST = (float*)(ws + WS_STATS);
        for (int m0 = gw; m0 < MX; m0 += 2 * NGW) {
            f32x4 v[2][4];
#pragma unroll
            for (int r = 0; r < 2; ++r) { const f32x4* xr = (const f32x4*)(a.in[I_X] + (size_t)(m0 + r * NGW) * D) + F.lane;
#pragma unroll
                for (int j = 0; j < 4; ++j) v[r][j] = xr[64 * j]; }
#pragma unroll
            for (int r = 0; r < 2; ++r) { const int m = m0 + r * NGW; float s = 0.f;
#pragma unroll
                for (int j = 0; j < 4; ++j) s += (v[r][j].x + v[r][j].y) + (v[r][j].z + v[r][j].w);
                const float mean = wave_sum(s, F.lane) * (1.f / D); float s2 = 0.f;
#pragma unroll
                for (int j = 0; j < 4; ++j) { v[r][j] = v[r][j] - mean; s2 += (v[r][j].x * v[r][j].x + v[r][j].y * v[r][j].y) + (v[r][j].z * v[r][j].z + v[r][j].w * v[r][j].w); }
                const float rstd = __builtin_amdgcn_rsqf(wave_sum(s2, F.lane) * (1.f / D) + 1e-5f);
#pragma unroll
                for (int j = 0; j < 4; ++j) { const int col = 4 * (F.lane + 64 * j);
                    const f32x4 gv = *(const f32x4*)(a.in[I_LNIN_G] + col), bv = *(const f32x4*)(a.in[I_LNIN_B] + col);
                    const f32x4 y = v[r][j] * rstd * gv + bv;
                    v2u o; o.x = pk2(y.x, y.y); o.y = pk2(y.z, y.w);
                    *(v2u*)(A0 + (size_t)m * D + col) = o; }
                if (F.lane == 0) { ST[2 * m] = mean; ST[2 * m + 1] = rstd; } }
        }
    }
    __syncthreads();
    for (int rep_ = 0; rep_ < NREP(14); ++rep_) convert_expert_weights(a, F, rep_);
}

__device__ __forceinline__ const bf16* prow(const bf16* PROJ, const bf16* PROJM, int b, int vp) {
    const bf16* px = PROJ + (size_t)(b * SEQ + (vp >= NMETA ? vp - NMETA : 0)) * PW;
    const bf16* pm = PROJM + (size_t)(vp < 0 ? NMETA : (vp < NMETA ? vp : 0)) * PW;
    return vp >= NMETA ? px : pm;
}
__device__ __forceinline__ f32x4 ldp4(const bf16* PROJ, const bf16* PROJM, int b, int vp, int col) {
    const v2u w = *(const v2u*)(prow(PROJ, PROJM, b, vp) + col);
    return (f32x4){bflo(w.x), bfhi(w.x), bflo(w.y), bfhi(w.y)};
}

constexpr int R1_STRIDE = 49152;
constexpr int TP = 80;
constexpr int L1_SLOT = 64 * TP * 2;
constexpr int L1_LC = 12 * L1_SLOT;
constexpr int L1_XCH = L1_LC + 64 * 65 * 4;
constexpr int L1_LR = 8 * L1_SLOT;
__device__ __forceinline__ v2u pack4(f32x4 v) { v2u o; o.x = pk2(v[0], v[1]); o.y = pk2(v[2], v[3]); return o; }
__device__ __forceinline__ f32x4 tile_mm(const LAS bf16* A, const LAS bf16* Bt, int rt, int ct, int fr, int fq, f32x4 acc) {
#pragma unroll
    for (int ks = 0; ks < 2; ++ks)
        acc = mfma16(*(const LAS bf16x8*)(Bt + (ct * 16 + fr) * TP + ks * 32 + 8 * fq), *(const LAS bf16x8*)(A + (rt * 16 + fr) * TP + ks * 32 + 8 * fq), acc);
    return acc;
}
__device__ __forceinline__ void tile_st(LAS bf16* O, int rt, int ct, int fr, int fq, f32x4 v) { *(LAS v2u*)(O + (rt * 16 + fr) * TP + ct * 16 + 4 * fq) = pack4(v); }
#define L1S(n) ((LAS bf16*)(F.lds + (n) * L1_SLOT))

struct L1Pf { v4u sa[5]; v2u r[2][2], k[2][2], v[2][2]; };
__device__ __forceinline__ void l1_fetch(const Args& a, const Frame& F, int b, int h, int c, L1Pf& pf, bool need_sa) {
    const bf16* PROJ = (const bf16*)(a.ws + WS_PROJ); const bf16* PROJM = (const bf16*)(a.ws + WS_PROJM);
    const int vp0 = (c == 0) ? -48 : NMETA + 64 * (c - 1);
    if (need_sa) { const int cg = F.tid & 31, tr = F.tid >> 5;
#pragma unroll
      for (int i = 0; i < 5; ++i) pf.sa[i] = *(const v4u*)(prow(PROJ, PROJM, b, vp0 + 4 * tr - 1 + i) + RWL + 8 * cg); }
    { const int rt = F.wave & 3, cp = F.wave >> 2, fr = F.lane & 15, fq = F.lane >> 4, vp = vp0 + rt * 16 + fr;
      const bf16* p0 = prow(PROJ, PROJM, b, vp - 1); const bf16* p1 = prow(PROJ, PROJM, b, vp);
#pragma unroll
      for (int cc = 0; cc < 2; ++cc) { const int jc = h * 64 + (2 * cp + cc) * 16 + 4 * fq;
          pf.r[cc][0] = *(const v2u*)(p0 + RR + jc); pf.r[cc][1] = *(const v2u*)(p1 + RR + jc);
          pf.k[cc][0] = *(const v2u*)(p0 + RK + jc); pf.k[cc][1] = *(const v2u*)(p1 + RK + jc);
          pf.v[cc][0] = *(const v2u*)(p0 + RV + jc); pf.v[cc][1] = *(const v2u*)(p1 + RV + jc); } }
}
__device__ __forceinline__ f32x4 unpk4(v2u w) { return (f32x4){bflo(w.x), bfhi(w.x), bflo(w.y), bfhi(w.y)}; }

__device__ __forceinline__ void rwkv_l1_front(const Args& a, const Frame& F, int b, int h, int c, const L1Pf& pf, f32x4 (&rtil)[2], bool newgrp, bf16x8 (&lrf)[8]) {
    unsigned char* ws = a.ws;
    const bf16* W2T = (const bf16*)(ws + WS_W2T); const bf16* A2T = (const bf16*)(ws + WS_A2T); const bf16* G2T = (const bf16*)(ws + WS_G2T);
    const int unit = (b * 8 + h) * NCH + c;
    unsigned char* r1 = ws + WS_R1 + (size_t)unit * R1_STRIDE;
    float* GAM = (float*)(ws + WS_GAM) + (size_t)unit * 64;
    const float* mu = a.in[I_MU];
    const int vp0 = (c == 0) ? -48 : NMETA + 64 * (c - 1);
    constexpr int LRP = 264;
    LAS bf16* LR = (LAS bf16*)(F.lds + L1_LR);
    LAS float* LC = (LAS float*)(F.lds + L1_LC);
    LAS float* XCH = (LAS float*)(F.lds + L1_XCH);
    const int rt = F.wave & 3, cp = F.wave >> 2, fr = F.lane & 15, fq = F.lane >> 4;
    if (newgrp) {
        const int cg = F.tid & 31, tr = F.tid >> 5;
        const f32x4 m0 = *(const f32x4*)(mu + 1536 + 8 * cg), m1 = *(const f32x4*)(mu + 1536 + 8 * cg + 4);
#pragma unroll
        for (int i = 0; i < 4; ++i) {
            const int row = 4 * tr + i;
            const v4u cw = pf.sa[i + 1], pw = pf.sa[i];
            const f32x4 c0 = unpk4((v2u){cw.x, cw.y}), c1 = unpk4((v2u){cw.z, cw.w}), p0 = unpk4((v2u){pw.x, pw.y}), p1 = unpk4((v2u){pw.z, pw.w});
            float v[8];
            v[0] = c0.x + (p0.x - c0.x) * m0.x; v[1] = c0.y + (p0.y - c0.y) * m0.y; v[2] = c0.z + (p0.z - c0.z) * m0.z; v[3] = c0.w + (p0.w - c0.w) * m0.w;
            v[4] = c1.x + (p1.x - c1.x) * m1.x; v[5] = c1.y + (p1.y - c1.y) * m1.y; v[6] = c1.z + (p1.z - c1.z) * m1.z; v[7] = c1.w + (p1.w - c1.w) * m1.w;
#pragma unroll
            for (int q = 0; q < 8; ++q) { if (cg < 8) v[q] = ftanh(v[q]); else if (cg >= 16) v[q] = fsigmoid(v[q]); }
            v4u o; o.x = pk2(v[0], v[1]); o.y = pk2(v[2], v[3]); o.z = pk2(v[4], v[5]); o.w = pk2(v[6], v[7]);
            *(LAS v4u*)(LR + row * LRP + 8 * cg) = o;
        }
    }
    const int t = rt * 16 + fr, vp = vp0 + t;
    const bool valid = vp >= 0;
    if (newgrp) { lds_barrier();
        const LAS bf16* lrow = LR + t * LRP + 8 * fq;
#pragma unroll
        for (int q = 0; q < 8; ++q) lrf[q] = *(const LAS bf16x8*)(lrow + q * 32); }
    float lwv[2][4], asg[2][4], kkr[2][4], kmd[2][4], rrv[2][4], vvv[2][4];
    float ssq = 0.f, bon = 0.f;
    {
#pragma unroll
        for (int cc = 0; cc < 2; ++cc) {
            const int ct = 2 * cp + cc, j = ct * 16 + 4 * fq, jc = h * 64 + j;
            f32x4 mr[2], mk[2], mv[2], w0v[2], a0v[2], kkw[2], kaw[2], rkw[2];
            mr[cc] = *(const f32x4*)(mu + jc); mk[cc] = *(const f32x4*)(mu + 512 + jc); mv[cc] = *(const f32x4*)(mu + 1024 + jc);
            w0v[cc] = *(const f32x4*)(a.in[I_W0] + jc); a0v[cc] = *(const f32x4*)(a.in[I_A0] + jc);
            kkw[cc] = *(const f32x4*)(a.in[I_KK] + jc); kaw[cc] = *(const f32x4*)(a.in[I_KA] + jc); rkw[cc] = *(const f32x4*)(a.in[I_RK] + jc);
            f32x4 aw = {0.f, 0.f, 0.f, 0.f}, aa = aw, ag = aw;
#pragma unroll
            for (int ks = 0; ks < 2; ++ks) {
                aw = mfma16(*(const bf16x8*)(W2T + (size_t)(h * 64 + ct * 16 + fr) * 64 + ks * 32 + 8 * fq), lrf[ks], aw);
                aa = mfma16(*(const bf16x8*)(A2T + (size_t)(h * 64 + ct * 16 + fr) * 64 + ks * 32 + 8 * fq), lrf[2 + ks], aa);
            }
#pragma unroll
            for (int ks = 0; ks < 4; ++ks) ag = mfma16(*(const bf16x8*)(G2T + (size_t)(h * 64 + ct * 16 + fr) * 128 + ks * 32 + 8 * fq), lrf[4 + ks], ag);
            const f32x4 rc = unpk4(pf.r[cc][1]), rp = unpk4(pf.r[cc][0]), kc = unpk4(pf.k[cc][1]), kp = unpk4(pf.k[cc][0]), vc = unpk4(pf.v[cc][1]), vpv = unpk4(pf.v[cc][0]);
            const f32x4 rs = rc + (rp - rc) * mr[cc], ks_ = kc + (kp - kc) * mk[cc], vs = vc + (vpv - vc) * mv[cc];
#pragma unroll
            for (int i = 0; i < 4; ++i) {
                const float u = w0v[cc][i] + aw[i];
                const float wl = -fsoftplus(-u) - 0.5f;
                lwv[cc][i] = valid ? -fexp(wl) : 0.f;
                const float as_ = fsigmoid(a0v[cc][i] + aa[i]);
                asg[cc][i] = as_;
                const float kraw = ks_[i], kk = kraw * kkw[cc][i];
                kkr[cc][i] = kk; ssq += kk * kk;
                const float km = kraw * (1.f + (as_ - 1.f) * kaw[cc][i]);
                kmd[cc][i] = km; rrv[cc][i] = rs[i]; vvv[cc][i] = vs[i];
                bon += rs[i] * km * rkw[cc][i];
            }
            *(v2u*)(r1 + 4 * 8192 + (size_t)(t * 64 + j) * 2) = pack4(ag);
            __builtin_amdgcn_sched_barrier(0);
        }
#pragma unroll
        for (int cc = 0; cc < 2; ++cc)
#pragma unroll
            for (int i = 0; i < 4; ++i) LC[t * 65 + (2 * cp + cc) * 16 + 4 * fq + i] = lwv[cc][i];
        ssq += shx(ssq, 16, F.lane); ssq += shx(ssq, 32, F.lane);
        bon += shx(bon, 16, F.lane); bon += shx(bon, 32, F.lane);
        if (fq == 0) { XCH[(cp * 64 + t) * 2] = ssq; XCH[(cp * 64 + t) * 2 + 1] = bon; }
    }
    lds_barrier();
    const float ssq_t = XCH[t * 2] + XCH[(64 + t) * 2], bon_t = XCH[t * 2 + 1] + XCH[(64 + t) * 2 + 1];
    const float inv = 1.f / fmaxf(sqrtf(ssq_t), 1e-12f);
    {
        LAS float* SEG = XCH + 256;
        const int jj = F.tid & 63, sg = F.tid >> 6;
        float cv[8];
#pragma unroll
        for (int i = 0; i < 8; ++i) cv[i] = LC[(sg * 8 + i) * 65 + jj];
#pragma unroll
        for (int i = 1; i < 8; ++i) cv[i] += cv[i - 1];
        SEG[sg * 64 + jj] = cv[7];
        lds_barrier();
        float pre = 0.f;
#pragma unroll
        for (int s2 = 0; s2 < 7; ++s2) pre += (s2 < sg) ? SEG[s2 * 64 + jj] : 0.f;
#pragma unroll
        for (int i = 0; i < 8; ++i) LC[(sg * 8 + i) * 65 + jj] = cv[i] + pre;
    }
    lds_barrier();
    {
#pragma unroll
        for (int cc = 0; cc < 2; ++cc) {
            const int j = (2 * cp + cc) * 16 + 4 * fq;
            f32x4 At, Bt, Kt, Bh, Kh, bvv;
#pragma unroll
            for (int i = 0; i < 4; ++i) {
                const float Lc = LC[t * 65 + j + i], LcC = LC[63 * 65 + j + i];
                const float kn = kkr[cc][i] * inv, av = -kn, bv = kn * asg[cc][i], km = kmd[cc][i];
                const float eA = fexp(Lc - lwv[cc][i]), eR = fexp(Lc), eB = fexp(-Lc), eH = fexp(LcC - Lc);
                At[i] = av * eA; rtil[cc][i] = rrv[cc][i] * eR; Bt[i] = bv * eB; Kt[i] = km * eB; Bh[i] = bv * eH; Kh[i] = km * eH;
                bvv[i] = bon_t * vvv[cc][i];
                if (t == 63) GAM[j + i] = fexp(LcC);
            }
            *(LAS v2u*)(L1S(0) + t * TP + j) = pack4(Bt); *(LAS v2u*)(L1S(1) + t * TP + j) = pack4(Kt);
            *(LAS v2u*)(L1S(2) + t * TP + j) = pack4(At); *(LAS v2u*)(L1S(3) + t * TP + j) = pack4(rtil[cc]);
#pragma unroll
            for (int i = 0; i < 4; ++i) {
                L1S(4)[(j + i) * TP + t] = (bf16)f2bf(At[i]); L1S(5)[(j + i) * TP + t] = (bf16)f2bf(Bh[i]);
                L1S(6)[(j + i) * TP + t] = (bf16)f2bf(Kh[i]); L1S(7)[(j + i) * TP + t] = (bf16)f2bf(vvv[cc][i]);
            }
            *(v2u*)(r1 + 5 * 8192 + (size_t)(t * 64 + j) * 2) = pack4(bvv);
        }
    }
    lds_barrier();
}
__device__ __forceinline__ void rwkv_l1_back(const Args& a, const Frame& F, int b, int h, int c, const f32x4 (&rtil)[2]) {
    unsigned char* r1 = a.ws + WS_R1 + (size_t)((b * 8 + h) * NCH + c) * R1_STRIDE;
    const int rt = F.wave & 3, cp = F.wave >> 2, fr = F.lane & 15, fq = F.lane >> 4;
    f32x4 Pt[2];
    const int mrow = rt * 16 + fr;
    const f32x4 z = {0.f, 0.f, 0.f, 0.f};
    {
        f32x4 Lv[2], Nv[2], Mv[2], Bv[2], Kv[2];
#pragma unroll
        for (int cc = 0; cc < 2; ++cc) { const int ct = 2 * cp + cc;
            Lv[cc] = tile_mm(L1S(2), L1S(0), rt, ct, fr, fq, z); Nv[cc] = tile_mm(L1S(0), L1S(2), rt, ct, fr, fq, z); Mv[cc] = tile_mm(L1S(2), L1S(1), rt, ct, fr, fq, z);
            Bv[cc] = tile_mm(L1S(3), L1S(0), rt, ct, fr, fq, z); Kv[cc] = tile_mm(L1S(3), L1S(1), rt, ct, fr, fq, z); }
#pragma unroll
        for (int cc = 0; cc < 2; ++cc) { const int ct = 2 * cp + cc, n0 = ct * 16 + 4 * fq;
#pragma unroll
            for (int i = 0; i < 4; ++i) { const int n = n0 + i;
                if (!(n < mrow)) { Lv[cc][i] = 0.f; Mv[cc][i] = 0.f; } if (!(mrow < n)) Nv[cc][i] = 0.f; if (!(n <= mrow)) { Bv[cc][i] = 0.f; Kv[cc][i] = 0.f; }
                Pt[cc][i] = Lv[cc][i] + ((n == mrow) ? 1.f : 0.f); }
            tile_st(L1S(8), rt, ct, fr, fq, Lv[cc]); tile_st(L1S(9), rt, ct, fr, fq, Nv[cc]); tile_st(L1S(10), rt, ct, fr, fq, Mv[cc]);
            tile_st(L1S(11), rt, ct, fr, fq, Bv[cc]); tile_st(L1S(12), rt, ct, fr, fq, Kv[cc]); }
    }
    lds_barrier();
    f32x4 Xv[2];
#pragma unroll
    for (int st = 1; st <= 6; ++st) {
        LAS bf16* Xl = (st & 1) ? L1S(8) : L1S(0); LAS bf16* Xn = (st & 1) ? L1S(9) : L1S(1);
        LAS bf16* Yl = (st & 1) ? L1S(0) : L1S(8); LAS bf16* Yn = (st & 1) ? L1S(1) : L1S(9);
        LAS bf16* Pr = (st & 1) ? L1S(2) : L1S(3); LAS bf16* Pw = (st & 1) ? L1S(3) : L1S(2);
        f32x4 l2[2], n2[2];
#pragma unroll
        for (int cc = 0; cc < 2; ++cc) { const int ct = 2 * cp + cc;
            if (st <= 5) { l2[cc] = tile_mm(Xl, Xn, rt, ct, fr, fq, z); n2[cc] = tile_mm(Xn, Xl, rt, ct, fr, fq, z); }
            if (st >= 2) Pt[cc] = tile_mm(Pr, Xn, rt, ct, fr, fq, Pt[cc]);
            if (st == 1) Xv[cc] = tile_mm(L1S(7), L1S(10), rt, ct, fr, fq, z); }
#pragma unroll
        for (int cc = 0; cc < 2; ++cc) { const int ct = 2 * cp + cc;
            if (st <= 5) { tile_st(Yl, rt, ct, fr, fq, l2[cc]); tile_st(Yn, rt, ct, fr, fq, n2[cc]); }
            tile_st(Pw, rt, ct, fr, fq, Pt[cc]); }
        if (st == 1) { lds_barrier();
#pragma unroll
            for (int cc = 0; cc < 2; ++cc) tile_st(L1S(10), rt, 2 * cp + cc, fr, fq, Xv[cc]); }
        lds_barrier();
    }
    {
        f32x4 u[2], w[2];
#pragma unroll
        for (int cc = 0; cc < 2; ++cc) { const int ct = 2 * cp + cc; u[cc] = tile_mm(L1S(10), L1S(2), rt, ct, fr, fq, z); w[cc] = tile_mm(L1S(4), L1S(2), rt, ct, fr, fq, z); }
#pragma unroll
        for (int cc = 0; cc < 2; ++cc) { const int ct = 2 * cp + cc; tile_st(L1S(8), rt, ct, fr, fq, u[cc]); tile_st(L1S(9), rt, ct, fr, fq, w[cc]); }
    }
    lds_barrier();
    {
#pragma unroll
        for (int cc = 0; cc < 2; ++cc) { const int ct = 2 * cp + cc; const size_t eo = (size_t)(mrow * 64 + ct * 16 + 4 * fq) * 2;
            const f32x4 gp = tile_mm(L1S(5), L1S(9), rt, ct, fr, fq, z);
            const f32x4 hh = tile_mm(L1S(7), L1S(6), rt, ct, fr, fq, tile_mm(L1S(8), L1S(5), rt, ct, fr, fq, z));
            const f32x4 rh = tile_mm(L1S(11), L1S(9), rt, ct, fr, fq, rtil[cc]);
            const f32x4 yl = tile_mm(L1S(12), L1S(7), rt, ct, fr, fq, tile_mm(L1S(11), L1S(8), rt, ct, fr, fq, z));
            *(v2u*)(r1 + 0 * 8192 + eo) = pack4(gp); *(v2u*)(r1 + 1 * 8192 + eo) = pack4(hh);
            *(v2u*)(r1 + 2 * 8192 + eo) = pack4(rh); *(v2u*)(r1 + 3 * 8192 + eo) = pack4(yl); }
    }
    lds_barrier();
}

constexpr int BCP = 65;
__device__ __forceinline__ void gla_bc(const Args& a, const Frame& F, int b, int h, int vp0, int ntok) {
    const bf16* PROJ = (const bf16*)(a.ws + WS_PROJ); const bf16* PROJM = (const bf16*)(a.ws + WS_PROJM);
    LAS float* GKLs = (LAS float*)F.lds; LAS float* BC = (LAS float*)(F.lds + 4096);
    if (F.tid < 256) { const int t = F.tid >> 2, q = F.tid & 3;
        const f32x4 v = ldp4(PROJ, PROJM, b, (t < ntok) ? vp0 + t : -1, GKL + 4 * q);
        *(LAS f32x4*)(GKLs + t * 16 + 4 * q) = v; }
    lds_barrier();
    {
        const int d = F.tid & 63, tg = F.tid >> 6;
        float wc[16];
#pragma unroll
        for (int r = 0; r < 16; ++r) wc[r] = a.in[I_GKW2][r * 256 + h * 64 + d];
        const float gb = a.in[I_GKB][h * 64 + d];
        float lgv[8];
#pragma unroll
        for (int i = 0; i < 8; ++i) { const int t = tg * 8 + i; float z = gb;
            const LAS f32x4* g4 = (const LAS f32x4*)(GKLs + t * 16);
#pragma unroll
            for (int q = 0; q < 4; ++q) { const f32x4 gv = g4[q]; z += gv.x * wc[4 * q] + gv.y * wc[4 * q + 1] + gv.z * wc[4 * q + 2] + gv.w * wc[4 * q + 3]; }
            lgv[i] = (t < ntok) ? flogsigmoid(z) * (1.f / 16.f) : 0.f; }
        LAS float* SEG = (LAS float*)(F.lds + 20736);
#pragma unroll
        for (int i = 1; i < 8; ++i) lgv[i] += lgv[i - 1];
        SEG[tg * 64 + d] = lgv[7];
        lds_barrier();
        float pre = 0.f;
#pragma unroll
        for (int s2 = 0; s2 < 7; ++s2) pre += (s2 < tg) ? SEG[s2 * 64 + d] : 0.f;
#pragma unroll
        for (int i = 0; i < 8; ++i) BC[(tg * 8 + i) * BCP + d] = lgv[i] + pre;
    }
    lds_barrier();
}

__device__ __forceinline__ void gla_g1_unit(const Args& a, const Frame& F, int b, int h, int c) {
    const bf16* PROJ = (const bf16*)(a.ws + WS_PROJ); const bf16* PROJM = (const bf16*)(a.ws + WS_PROJM);
    float* GUS = (float*)(a.ws + WS_GUS); float* DL = (float*)(a.ws + WS_DL);
    const int ntok = (c == 0) ? NMETA : 64, vp0 = (c == 0) ? 0 : NMETA + 64 * (c - 1);
    gla_bc(a, F, b, h, vp0, ntok);
    LAS float* BC = (LAS float*)(F.lds + 4096);
    LAS bf16* KT = (LAS bf16*)(F.lds + 24576);
    LAS bf16* VT = (LAS bf16*)(F.lds + 24576 + 64 * TP * 2);
    {
        const int t = F.tid >> 3, q = F.tid & 7;
        const float* bl = nullptr; (void)bl;
#pragma unroll
        for (int half = 0; half < 2; ++half) {
            const int d0 = 8 * q + 4 * half;
            const f32x4 kv = ldp4(PROJ, PROJM, b, (t < ntok) ? vp0 + t : -1, GK + h * 64 + d0);
#pragma unroll
            for (int i = 0; i < 4; ++i) { const int d = d0 + i; const float e = (t < ntok) ? fexp(BC[(ntok - 1) * BCP + d] - BC[t * BCP + d]) : 0.f;
                KT[d * TP + t] = (bf16)f2bf(kv[i] * e); }
        }
#pragma unroll
        for (int qq = 0; qq < 4; ++qq) {
            const int e0 = 16 * q + 4 * qq;
            const f32x4 vv = ldp4(PROJ, PROJM, b, (t < ntok) ? vp0 + t : -1, GV + h * 128 + e0);
#pragma unroll
            for (int i = 0; i < 4; ++i) VT[(e0 + i) * TP + t] = (bf16)f2bf(vv[i]);
        }
    }
    lds_barrier();
    {
        const int rt = F.wave & 3, ch = F.wave >> 2, fr = F.lane & 15, fq = F.lane >> 4;
        float* up = GUS + ((size_t)((b * 4 + h) * NCH + c) * 64 + rt * 16 + fr) * 128;
#pragma unroll
        for (int cc = 0; cc < 4; ++cc) { const int ct = ch * 4 + cc;
            f32x4 acc = {0.f, 0.f, 0.f, 0.f};
#pragma unroll
            for (int ks = 0; ks < 2; ++ks)
                acc = mfma16(*(const LAS bf16x8*)(VT + (ct * 16 + fr) * TP + ks * 32 + 8 * fq), *(const LAS bf16x8*)(KT + (rt * 16 + fr) * TP + ks * 32 + 8 * fq), acc);
            *(f32x4*)(up + ct * 16 + 4 * fq) = acc; }
        if (F.tid < 64) DL[(size_t)((b * 4 + h) * NCH + c) * 64 + F.tid] = fexp(BC[(ntok - 1) * BCP + F.tid]);
    }
    lds_barrier();
}

__device__ __forceinline__ void phase2(const Args& a, const Frame& F) {
    {
        constexpr int NU = NB * 8 * NCH;
        const int u0 = (int)((long)F.blk * NU / F.G), u1 = (int)((long)(F.blk + 1) * NU / F.G);
        L1Pf pf;
        bf16x8 lrf[8];
        if (u0 < u1) l1_fetch(a, F, (u0 >> 3) / NCH, u0 & 7, (u0 >> 3) % NCH, pf, true);
        unsigned long long tf_ = 0, tb_ = 0;
        for (int u = u0; u < u1; ++u) {
            const int h = u & 7, c = (u >> 3) % NCH, b = (u >> 3) / NCH; f32x4 rtil[2];
            const bool newgrp = (u == u0) || (h == 0);
            { const Frame F1 = mkframe(F.lds, F.wave); rwkv_l1_front(a, F1, b, h, c, pf, rtil, newgrp, lrf); }
            { const Frame F2 = mkframe(F.lds, F.wave);
              if (u + 1 < u1) l1_fetch(a, F2, ((u + 1) >> 3) / NCH, (u + 1) & 7, ((u + 1) >> 3) % NCH, pf, ((u + 1) & 7) == 0);
              rwkv_l1_back(a, F2, b, h, c, rtil); }
        }
        if ((REP_MASK >> 16) != 0) {
            const unsigned long long dt_ = ((REP_MASK >> 16) == 1) ? tf_ : tb_, s0_ = __builtin_amdgcn_s_memrealtime();
            while (__builtin_amdgcn_s_memrealtime() - s0_ < dt_) __builtin_amdgcn_s_sleep(8);
        }
    }
    for (int rep_ = 0; rep_ < NREP(12); ++rep_)
    for (int u = F.blk; u < NB * 4 * 32; u += F.G) { const int c = u & 31, bh = u >> 5; const Frame F1 = mkframe(F.lds, F.wave); gla_g1_unit(a, F1, bh >> 2, bh & 3, c); }
}

struct L2S { bf16x8 fg[4]; v2u hq[2]; f32x4 gm[2]; };
__device__ __forceinline__ void l2s_fetch(L2S& r, const unsigned char* hp, const unsigned char* gp, const float* gam) {
#pragma unroll
    for (int cc = 0; cc < 2; ++cc) { r.fg[2 * cc] = *(const bf16x8*)(gp + cc * 2048); r.fg[2 * cc + 1] = *(const bf16x8*)(gp + cc * 2048 + 64);
        r.hq[cc] = *(const v2u*)(hp + cc * 32); r.gm[cc] = *(const f32x4*)(gam + cc * 16); }
}
__device__ __forceinline__ void l2s_step(const L2S& r, const LAS bf16* Sc, LAS bf16* Sn, f32x4 (&Sm)[2], int row, int col0, int fq, bf16* gout, int tid) {
    {
        const int r_ = tid >> 3, c8 = tid & 7;
        *(v4u*)(gout + r_ * 64 + 8 * c8) = *(const LAS v4u*)(Sc + r_ * TP + 8 * c8);
    }
    const bf16x8 af0 = *(const LAS bf16x8*)(Sc + row * TP + 8 * fq), af1 = *(const LAS bf16x8*)(Sc + row * TP + 32 + 8 * fq);
#pragma unroll
    for (int cc = 0; cc < 2; ++cc) {
        f32x4 acc = {bflo(r.hq[cc].x), bfhi(r.hq[cc].x), bflo(r.hq[cc].y), bfhi(r.hq[cc].y)};
        acc = mfma16(r.fg[2 * cc], af0, acc);
        acc = mfma16(r.fg[2 * cc + 1], af1, acc);
        Sm[cc] = Sm[cc] * r.gm[cc] + acc; }
#pragma unroll
    for (int cc = 0; cc < 2; ++cc) *(LAS v2u*)(Sn + row * TP + col0 + cc * 16) = pack4(Sm[cc]);
}
__device__ __forceinline__ void rwkv_l2_unit(const Args& a, const Frame& F, int bh) {
    unsigned char* ws = a.ws;
    LAS bf16* Sb0 = (LAS bf16*)F.lds; LAS bf16* Sb1 = Sb0 + 64 * TP;
    const int fr = F.lane & 15, fq = F.lane >> 4, rt = F.wave & 3, cp = F.wave >> 2;
    const int row = rt * 16 + fr, col0 = cp * 32 + 4 * fq;
    const unsigned char* hpb = ws + WS_R1 + (size_t)bh * NCH * R1_STRIDE + 8192 + (size_t)(row * 64 + col0) * 2;
    const unsigned char* gpb = ws + WS_R1 + (size_t)bh * NCH * R1_STRIDE + (size_t)((cp * 32 + fr) * 64 + 8 * fq) * 2;
    const float* gamb = (const float*)(ws + WS_GAM) + (size_t)bh * NCH * 64 + col0;
    bf16* sst = (bf16*)(ws + WS_SST) + (size_t)bh * NCH * 4096;
    f32x4 Sm[2];
#pragma unroll
    for (int cc = 0; cc < 2; ++cc) { Sm[cc] = (f32x4){0.f, 0.f, 0.f, 0.f}; *(LAS v2u*)(Sb0 + row * TP + col0 + cc * 16) = (v2u){0u, 0u}; }
    L2S r0, r1, r2, r3;
#define L2F(rr, cn) l2s_fetch(rr, hpb + (size_t)(cn) * R1_STRIDE, gpb + (size_t)(cn) * R1_STRIDE, gamb + (size_t)(cn) * 64)
    L2F(r0, 0); L2F(r1, 1); L2F(r2, 2);
    lds_barrier();
#pragma nounroll
    for (int c = 0; c < NCH - 1; c += 4) {
        L2F(r3, c + 3);
        l2s_step(r0, Sb0, Sb1, Sm, row, col0, fq, sst + (size_t)c * 4096, F.tid); lds_barrier();
        if (c + 4 < NCH - 1) L2F(r0, c + 4);
        l2s_step(r1, Sb1, Sb0, Sm, row, col0, fq, sst + (size_t)(c + 1) * 4096, F.tid); lds_barrier();
        if (c + 5 < NCH - 1) L2F(r1, c + 5);
        l2s_step(r2, Sb0, Sb1, Sm, row, col0, fq, sst + (size_t)(c + 2) * 4096, F.tid); lds_barrier();
        if (c + 6 < NCH - 1) L2F(r2, c + 6);
        l2s_step(r3, Sb1, Sb0, Sm, row, col0, fq, sst + (size_t)(c + 3) * 4096, F.tid); lds_barrier();
    }
#undef L2F
    { const int r_ = F.tid >> 3, c8 = F.tid & 7;
      *(v4u*)(sst + (size_t)(NCH - 1) * 4096 + r_ * 64 + 8 * c8) = *(const LAS v4u*)(Sb0 + r_ * TP + 8 * c8); }
    lds_barrier();
}
__device__ __forceinline__ void rwkv_y_task(const Args& a, const Frame& F, int task) {
    unsigned char* ws = a.ws;
    const int c = 1 + (task & 31), bh = task >> 5, b = bh >> 3, h = bh & 7;
    const int fr = F.lane & 15, fq = F.lane >> 4;
    const bf16* Sg = (const bf16*)(ws + WS_SST) + (size_t)(bh * NCH + c) * 4096 + fr * 64 + 8 * fq;
    bf16x8 sf[8];
#pragma unroll
    for (int ct = 0; ct < 4; ++ct) { sf[2 * ct] = *(const bf16x8*)(Sg + ct * 1024); sf[2 * ct + 1] = *(const bf16x8*)(Sg + ct * 1024 + 32); }
    f32x4 lg[4], lb[4];
#pragma unroll
    for (int ct = 0; ct < 4; ++ct) { const int i0 = h * 64 + ct * 16 + 4 * fq; lg[ct] = *(const f32x4*)(a.in[I_RLNG] + i0); lb[ct] = *(const f32x4*)(a.in[I_RLNB] + i0); }
    LAS bf16* ost = (LAS bf16*)(F.lds + 102400 + F.wave * 2304);
    const unsigned char* r1u = ws + WS_R1 + (size_t)(bh * NCH + c) * R1_STRIDE + (size_t)(fr * 64 + 4 * fq) * 2;
    bf16x8 fa0[4], fa1[4]; v2u q0[4][4];
#pragma unroll
    for (int rt = 0; rt < 4; ++rt) { const unsigned char* r1 = r1u + rt * 2048;
        fa0[rt] = *(const bf16x8*)(r1 + 2 * 8192 + 8 * fq); fa1[rt] = *(const bf16x8*)(r1 + 2 * 8192 + 64 + 8 * fq);
#pragma unroll
        for (int ct = 0; ct < 4; ++ct) q0[rt][ct] = *(const v2u*)(r1 + 3 * 8192 + ct * 32); }
#pragma unroll
    for (int rt = 0; rt < 4; ++rt) {
        const unsigned char* r1 = r1u + rt * 2048;
        v2u q1[4], q2[4];
#pragma unroll
        for (int ct = 0; ct < 4; ++ct) { q1[ct] = *(const v2u*)(r1 + 4 * 8192 + ct * 32); q2[ct] = *(const v2u*)(r1 + 5 * 8192 + ct * 32); }
        f32x4 y[4]; float s = 0.f;
#pragma unroll
        for (int ct = 0; ct < 4; ++ct) {
            f32x4 acc = {bflo(q0[rt][ct].x), bfhi(q0[rt][ct].x), bflo(q0[rt][ct].y), bfhi(q0[rt][ct].y)};
            acc = mfma16(sf[2 * ct], fa0[rt], acc); acc = mfma16(sf[2 * ct + 1], fa1[rt], acc);
            y[ct] = acc; s += (acc[0] + acc[1]) + (acc[2] + acc[3]); }
        s += shx(s, 16, F.lane); s += shx(s, 32, F.lane);
        const float mean = s * (1.f / 64.f); float q = 0.f;
#pragma unroll
        for (int ct = 0; ct < 4; ++ct) { y[ct] = y[ct] - mean; q += (y[ct][0] * y[ct][0] + y[ct][1] * y[ct][1]) + (y[ct][2] * y[ct][2] + y[ct][3] * y[ct][3]); }
        q += shx(q, 16, F.lane); q += shx(q, 32, F.lane);
        const float rstd = __builtin_amdgcn_rsqf(q * (1.f / 64.f) + 64e-5f);
#pragma unroll
        for (int ct = 0; ct < 4; ++ct) {
            const f32x4 g = {bflo(q1[ct].x), bfhi(q1[ct].x), bflo(q1[ct].y), bfhi(q1[ct].y)}, bv = {bflo(q2[ct].x), bfhi(q2[ct].x), bflo(q2[ct].y), bfhi(q2[ct].y)};
            const f32x4 o = (y[ct] * rstd * lg[ct] + lb[ct] + bv) * g;
            *(LAS v2u*)(ost + fr * 72 + ct * 16 + 4 * fq) = pack4(o); }
        asm volatile("s_waitcnt lgkmcnt(0)" ::: "memory");
        bf16* yout = (bf16*)(ws + WS_YMIX) + ((size_t)b * SEQ + 64 * (c - 1) + rt * 16) * D + 512 + h * 64;
#pragma unroll
        for (int hh = 0; hh < 2; ++hh) { const int tr = (F.lane >> 3) + 8 * hh, c8 = F.lane & 7;
            *(v4u*)(yout + (size_t)tr * D + 8 * c8) = *(const LAS v4u*)(ost + tr * 72 + 8 * c8); }
        asm volatile("s_waitcnt lgkmcnt(0)" ::: "memory");
    }
}
__device__ __forceinline__ void gla_scan_unit(const Args& a, const Frame& F, int j) {
    float* GUS = (float*)(a.ws + WS_GUS); const float* DL = (const float*)(a.ws + WS_DL);
    const int bh = j >> 1, half = j & 1;
    const int d = 32 * half + (F.tid >> 4), e0 = (F.tid & 15) * 8;
    float* base = GUS + (size_t)bh * NCH * 8192 + d * 128 + e0;
    const float* dl = DL + (size_t)bh * NCH * 64 + d;
    f32x4 s0 = {0.f, 0.f, 0.f, 0.f}, s1 = s0;
    f32x4 ua[4], ub[4]; float dq[4];
#pragma unroll
    for (int q = 0; q < 3; ++q) { ua[q] = *(const f32x4*)(base + (size_t)q * 8192); ub[q] = *(const f32x4*)(base + (size_t)q * 8192 + 4); dq[q] = dl[q * 64]; }
#pragma unroll 4
    for (int c = 0; c < NCH - 1; ++c) {
        const int cn = (c + 3 < NCH - 1) ? c + 3 : NCH - 2;
        ua[(c + 3) & 3] = *(const f32x4*)(base + (size_t)cn * 8192); ub[(c + 3) & 3] = *(const f32x4*)(base + (size_t)cn * 8192 + 4); dq[(c + 3) & 3] = dl[cn * 64];
        *(f32x4*)(base + (size_t)c * 8192) = s0; *(f32x4*)(base + (size_t)c * 8192 + 4) = s1;
        s0 = s0 * dq[c & 3] + ua[c & 3]; s1 = s1 * dq[c & 3] + ub[c & 3];
    }
    *(f32x4*)(base + (size_t)(NCH - 1) * 8192) = s0; *(f32x4*)(base + (size_t)(NCH - 1) * 8192 + 4) = s1;
}
__device__ __forceinline__ void phase3(const Args& a, const Frame& F) {
    constexpr int PSEL = (REP_MASK >> 20) & 7;
    const unsigned long long t0_ = PSEL ? __builtin_amdgcn_s_memrealtime() : 0ull;
    for (int u = F.blk; u < 256; u += F.G) {
        if (u < 128) { for (int rep_ = 0; rep_ < NREP(3); ++rep_) rwkv_l2_unit(a, F, u); }
        else gla_scan_unit(a, F, u - 128);
    }
    if (PSEL) { const unsigned long long t1_ = __builtin_amdgcn_s_memrealtime();
        unsigned long long dt_ = 0;
        if (PSEL == 1 && F.blk < 128) dt_ = t1_ - t0_;
        if (PSEL == 2 && F.blk >= 128) dt_ = t1_ - t0_;
        while (__builtin_amdgcn_s_memrealtime() - t1_ < dt_) __builtin_amdgcn_s_sleep(8); }
}

__device__ __forceinline__ void gla_g3_unit(const Args& a, const Frame& F, int b, int h, int c) {
    const bf16* PROJ = (const bf16*)(a.ws + WS_PROJ); const bf16* PROJM = (const bf16*)(a.ws + WS_PROJM);
    const float* GUS = (const float*)(a.ws + WS_GUS); bf16* YMIX = (bf16*)(a.ws + WS_YMIX);
    const int vp0 = NMETA + 64 * (c - 1);
    gla_bc(a, F, b, h, vp0, 64);
    LAS float* BC = (LAS float*)(F.lds + 4096);
    LAS bf16* QT = (LAS bf16*)(F.lds + 24576);
    LAS bf16* KL = QT + 64 * TP;
    LAS bf16* AT = KL + 64 * TP;
    LAS bf16* VT = AT + 64 * TP;
    LAS bf16* ST = VT + 128 * TP;
    LAS float* RS = (LAS float*)(ST + 128 * TP);
    {
        const int t = F.tid >> 3, q = F.tid & 7;
        const f32x4 q0 = ldp4(PROJ, PROJM, b, vp0 + t, GQ + h * 64 + 8 * q), q1 = ldp4(PROJ, PROJM, b, vp0 + t, GQ + h * 64 + 8 * q + 4);
        const f32x4 k0 = ldp4(PROJ, PROJM, b, vp0 + t, GK + h * 64 + 8 * q), k1 = ldp4(PROJ, PROJM, b, vp0 + t, GK + h * 64 + 8 * q + 4);
        float qv[8] = {q0.x, q0.y, q0.z, q0.w, q1.x, q1.y, q1.z, q1.w}, kv[8] = {k0.x, k0.y, k0.z, k0.w, k1.x, k1.y, k1.z, k1.w};
#pragma unroll
        for (int i = 0; i < 8; ++i) { const float bcv = BC[t * BCP + 8 * q + i]; qv[i] *= fexp(bcv) * 0.125f; kv[i] *= fexp(-bcv); }
        v4u o; o.x = pk2(qv[0], qv[1]); o.y = pk2(qv[2], qv[3]); o.z = pk2(qv[4], qv[5]); o.w = pk2(qv[6], qv[7]);
        *(LAS v4u*)(QT + t * TP + 8 * q) = o;
        o.x = pk2(kv[0], kv[1]); o.y = pk2(kv[2], kv[3]); o.z = pk2(kv[4], kv[5]); o.w = pk2(kv[6], kv[7]);
        *(LAS v4u*)(KL + t * TP + 8 * q) = o;
#pragma unroll
        for (int qq = 0; qq < 4; ++qq) {
            const int e0 = 16 * q + 4 * qq;
            const f32x4 vv = ldp4(PROJ, PROJM, b, vp0 + t, GV + h * 128 + e0);
#pragma unroll
            for (int i = 0; i < 4; ++i) VT[(e0 + i) * TP + t] = (bf16)f2bf(vv[i]);
            const f32x4 sv = *(const f32x4*)(GUS + ((size_t)((b * 4 + h) * NCH + c) * 64 + t) * 128 + e0);
#pragma unroll
            for (int i = 0; i < 4; ++i) ST[(e0 + i) * TP + t] = (bf16)f2bf(sv[i]);
        }
    }
    lds_barrier();
    const int rt = F.wave & 3, wh = F.wave >> 2, fr = F.lane & 15, fq = F.lane >> 4;
    const int trow = rt * 16 + fr;
    {
        f32x4 av[2];
#pragma unroll
        for (int cc = 0; cc < 2; ++cc) { const int ct = 2 * wh + cc;
            f32x4 acc = {0.f, 0.f, 0.f, 0.f};
#pragma unroll
            for (int ks = 0; ks < 2; ++ks)
                acc = mfma16(*(const LAS bf16x8*)(KL + (ct * 16 + fr) * TP + ks * 32 + 8 * fq), *(const LAS bf16x8*)(QT + trow * TP + ks * 32 + 8 * fq), acc);
            const int s0 = ct * 16 + 4 * fq;
#pragma unroll
            for (int i = 0; i < 4; ++i) if (s0 + i > trow) acc[i] = 0.f;
            av[cc] = acc; }
#pragma unroll
        for (int cc = 0; cc < 2; ++cc) *(LAS v2u*)(AT + trow * TP + (2 * wh + cc) * 16 + 4 * fq) = pack4(av[cc]);
    }
    lds_barrier();
    f32x4 oacc[4]; float ssq = 0.f;
#pragma unroll
    for (int cc = 0; cc < 4; ++cc) { const int ct = wh * 4 + cc;
        f32x4 acc = {0.f, 0.f, 0.f, 0.f};
#pragma unroll
        for (int ks = 0; ks < 2; ++ks) {
            acc = mfma16(*(const LAS bf16x8*)(VT + (ct * 16 + fr) * TP + ks * 32 + 8 * fq), *(const LAS bf16x8*)(AT + trow * TP + ks * 32 + 8 * fq), acc);
            acc = mfma16(*(const LAS bf16x8*)(ST + (ct * 16 + fr) * TP + ks * 32 + 8 * fq), *(const LAS bf16x8*)(QT + trow * TP + ks * 32 + 8 * fq), acc);
        }
        oacc[cc] = acc; ssq += (acc[0] * acc[0] + acc[1] * acc[1]) + (acc[2] * acc[2] + acc[3] * acc[3]); }
    ssq += shx(ssq, 16, F.lane); ssq += shx(ssq, 32, F.lane);
    if (fq == 0) RS[wh * 64 + trow] = ssq;
    lds_barrier();
    {
        const float tot = RS[trow] + RS[64 + trow];
        const float rstd = 1.f / sqrtf(tot * (1.f / 128.f) + 1e-6f);
        const size_t m = (size_t)b * SEQ + (vp0 - NMETA) + trow;
#pragma unroll
        for (int cc = 0; cc < 4; ++cc) { const int e0 = (wh * 4 + cc) * 16 + 4 * fq;
            const f32x4 gv = ldp4(PROJ, PROJM, b, vp0 + trow, GG + h * 128 + e0);
            const f32x4 ng = *(const f32x4*)(a.in[I_GNORM] + e0);
            float y[4];
#pragma unroll
            for (int i = 0; i < 4; ++i) { const float gi = gv[i]; y[i] = oacc[cc][i] * rstd * ng[i] * (gi * fsigmoid(gi)); }
            v2u o; o.x = pk2(y[0], y[1]); o.y = pk2(y[2], y[3]);
            *(v2u*)(YMIX + m * D + h * 128 + e0) = o; }
    }
    lds_barrier();
}
__device__ __forceinline__ void phase4(const Args& a, const Frame& F) {
    for (int t = F.blk * NWAVES + F.wave; t < 128 * 32; t += F.G * NWAVES) { const Frame F1 = mkframe(F.lds, F.wave); rwkv_y_task(a, F1, t); }
    __syncthreads();
    for (int u = F.blk; u < NB * 4 * 32; u += F.G) { const int c = 1 + (u & 31), bh = u >> 5; const Frame F1 = mkframe(F.lds, F.wave); gla_g3_unit(a, F1, bh >> 2, bh & 3, c); }
}

__device__ __forceinline__ int eidx_of(int L) { return 16 * (L & 1) + 8 * ((L >> 1) & 1) + 4 * ((L >> 2) & 1) + 2 * ((L >> 3) & 1) + ((L >> 4) & 1); }
__device__ __forceinline__ void p6_ln(const Args& a, const Frame& F, int m, f32x4 (&v)[4], const f32x4 (&g1)[4], const f32x4 (&b1)[4]) {
    unsigned char* ws = a.ws; bf16* H1 = (bf16*)(ws + WS_H1);
    float s = 0.f;
#pragma unroll
    for (int j = 0; j < 4; ++j) s += (v[j].x + v[j].y) + (v[j].z + v[j].w);
    const float mean = wave_sum(s, F.lane) * (1.f / D); float s2 = 0.f;
#pragma unroll
    for (int j = 0; j < 4; ++j) { v[j] = v[j] - mean; s2 += (v[j].x * v[j].x + v[j].y * v[j].y) + (v[j].z * v[j].z + v[j].w * v[j].w); }
    const float rstd = __builtin_amdgcn_rsqf(wave_sum(s2, F.lane) * (1.f / D) + 1e-5f);
#pragma unroll
    for (int j = 0; j < 4; ++j) { const int col = 4 * (F.lane + 64 * j);
        v[j] = v[j] * rstd * g1[j] + b1[j];
        v2u o; o.x = pk2(v[j].x, v[j].y); o.y = pk2(v[j].z, v[j].w);
        *(v2u*)(H1 + (size_t)m * D + col) = o;
        int w8 = __builtin_amdgcn_cvt_pk_fp8_f32(v[j].x, v[j].y, 0, false); w8 = __builtin_amdgcn_cvt_pk_fp8_f32(v[j].z, v[j].w, w8, true);
        *(int*)(ws + WS_H1Q + (size_t)m * D + col) = w8; }
}
__device__ __forceinline__ void phase6(const Args& a, const Frame& F, int csel) {
    unsigned char* ws = a.ws;
    LAS float* LG = (LAS float*)(F.lds + F.wave * 2560);
    LAS int* hist = (LAS int*)(F.lds + 8 * 2560);
    bf16* H1 = (bf16*)(ws + WS_H1);
    const bf16* RWH = (const bf16*)(ws + WS_RWH); const bf16* RWL = (const bf16*)(ws + WS_RWL);
    int* TOPI = (int*)(ws + WS_TOPI); float* GATE = (float*)(ws + WS_GATE); int* RANK = (int*)(ws + WS_RANK);
    unsigned* CNT = (unsigned*)(ws + WS_CTL) + CW_CNT + 2048 * csel;
    for (int rb = F.blk; rb < MX / 128; rb += F.G) {
        if (F.tid < 64) hist[F.tid] = 0;
        __syncthreads();
        const int mb = rb * 128 + F.wave * 16; const Frame& Fo = F;
        {
            const f32x4* xr0 = (const f32x4*)(a.in[I_X] + (size_t)mb * D) + F.lane;
            const v2u* mr0 = (const v2u*)((const bf16*)(ws + WS_MIXB) + (size_t)mb * D) + F.lane;
            const float* st0 = (const float*)(ws + WS_STATS) + 2 * (size_t)mb;
            f32x4 va[4], vb[4], vc[4], vd[4]; v2u ma[4], mbv[4], mc[4], md[4]; float sa0, sa1, sb0, sb1, sc0, sc1, sd0, sd1;
#define P6_LOAD(vv, mmv, s0v, s1v, ii) do { _Pragma("unroll") for (int j = 0; j < 4; ++j) { vv[j] = xr0[(size_t)(ii) * (D / 4) + 64 * j]; mmv[j] = mr0[(size_t)(ii) * (D / 4) + 64 * j]; } s0v = st0[2 * (ii)]; s1v = st0[2 * (ii) + 1]; } while (0)
#define P6_FORM(vv, mmv, s0v, s1v) do { _Pragma("unroll") for (int j = 0; j < 4; ++j) vv[j] = ((vv[j] - s0v) * s1v) * gi[j] + bi[j] + unpk4(mmv[j]); } while (0)
            f32x4 gi[4], bi[4], g1[4], b1[4];
#pragma unroll
            for (int j = 0; j < 4; ++j) { const int col = 4 * (F.lane + 64 * j);
                gi[j] = *(const f32x4*)(a.in[I_LNIN_G] + col) * ALPHA; bi[j] = *(const f32x4*)(a.in[I_LNIN_B] + col) * ALPHA;
                g1[j] = *(const f32x4*)(a.in[I_LN1G] + col); b1[j] = *(const f32x4*)(a.in[I_LN1B] + col); }
            P6_LOAD(va, ma, sa0, sa1, 0); P6_LOAD(vb, mbv, sb0, sb1, 1);
#pragma nounroll
            for (int i = 0; i < 16; i += 4) {
                P6_LOAD(vc, mc, sc0, sc1, i + 2); P6_LOAD(vd, md, sd0, sd1, i + 3);
                P6_FORM(va, ma, sa0, sa1); P6_FORM(vb, mbv, sb0, sb1); p6_ln(a, F, mb + i, va, g1, b1); p6_ln(a, F, mb + i + 1, vb, g1, b1);
                if (i + 4 < 16) { P6_LOAD(va, ma, sa0, sa1, i + 4); P6_LOAD(vb, mbv, sb0, sb1, i + 5); }
                P6_FORM(vc, mc, sc0, sc1); P6_FORM(vd, md, sd0, sd1); p6_ln(a, F, mb + i + 2, vc, g1, b1); p6_ln(a, F, mb + i + 3, vd, g1, b1);
            }
#undef P6_LOAD
#undef P6_FORM
        }
        asm volatile("s_waitcnt vmcnt(0)" ::: "memory");
        {
            const int fr = F.lane & 15, fq = F.lane >> 4;
            const bf16* ap = H1 + (size_t)(mb + fr) * D + 8 * fq;
            const bf16* bh = RWH + (size_t)fr * D + 8 * fq; const bf16* bl = RWL + (size_t)fr * D + 8 * fq;
            f32x4 acc0 = {0.f, 0.f, 0.f, 0.f}, acc1 = acc0;
#pragma unroll 8
            for (int ks = 0; ks < 32; ++ks) { const bf16x8 af = *(const bf16x8*)(ap + ks * 32);
                acc0 = mfma16(*(const bf16x8*)(bh + ks * 32), af, acc0); acc0 = mfma16(*(const bf16x8*)(bl + ks * 32), af, acc0);
                acc1 = mfma16(*(const bf16x8*)(bh + 16 * D + ks * 32), af, acc1); acc1 = mfma16(*(const bf16x8*)(bl + 16 * D + ks * 32), af, acc1); }
            const f32x4 rb0 = *(const f32x4*)(a.in[I_RTB] + 4 * fq), rb1 = *(const f32x4*)(a.in[I_RTB] + 16 + 4 * fq);
#pragma unroll
            for (int q = 0; q < 4; ++q) { LG[fr * 33 + 4 * fq + q] = acc0[q] + rb0[q]; LG[fr * 33 + 16 + 4 * fq + q] = acc1[q] + rb1[q]; }
        }
        asm volatile("s_waitcnt lgkmcnt(0)" ::: "memory");
        LAS int* EK = (LAS int*)(LG + 528);
        if (F.lane < 16) {
            float lv[32];
#pragma unroll
            for (int e = 0; e < 32; ++e) lv[e] = LG[F.lane * 33 + e];
            int ek[4]; float lk[4];
#pragma unroll
            for (int k = 0; k < 4; ++k) { float best = -3.0e38f; int bi = 0;
#pragma unroll
                for (int e = 0; e < 32; ++e) { const bool tk = lv[e] > best; best = tk ? lv[e] : best; bi = tk ? e : bi; }
                ek[k] = bi; lk[k] = best;
#pragma unroll
                for (int e = 0; e < 32; ++e) lv[e] = (e == bi) ? -3.0e38f : lv[e]; }
            const float e1 = expf(lk[1] - lk[0]), e2 = expf(lk[2] - lk[0]), e3 = expf(lk[3] - lk[0]);
            const float inv = 1.f / (1.f + e1 + e2 + e3);
            const size_t m = (size_t)(mb + F.lane);
            *(i32x4g*)(TOPI + m * 4) = (i32x4g){ek[0], ek[1], ek[2], ek[3]};
            *(f32x4*)(GATE + m * 4) = (f32x4){inv, e1 * inv, e2 * inv, e3 * inv};
#pragma unroll
            for (int k = 0; k < 4; ++k) EK[F.lane * 4 + k] = ek[k];
        }
        asm volatile("s_waitcnt lgkmcnt(0)" ::: "memory");
        const int my_e = EK[F.lane];
        const int lrank = __hip_atomic_fetch_add(&hist[my_e], 1, __ATOMIC_RELAXED, __HIP_MEMORY_SCOPE_WORKGROUP);
        __syncthreads();
        if (F.tid < 32) hist[32 + F.tid] = (int)__hip_atomic_fetch_add(CNT + 64 * F.tid, (unsigned)hist[F.tid], __ATOMIC_RELAXED, __HIP_MEMORY_SCOPE_AGENT);
        __syncthreads();
        RANK[((size_t)rb * 128 + F.wave * 16 + (F.lane >> 2)) * 4 + (F.lane & 3)] = hist[32 + my_e] + lrank;
        __syncthreads();
    }
}

__device__ __forceinline__ void phase7(const Args& a, const Frame& F) {
    unsigned char* ws = a.ws;
    LAS int* starts = (LAS int*)F.lds;
    unsigned* CNT = (unsigned*)(ws + WS_CTL) + CW_CNT;
    int* TILEE = (int*)(ws + WS_TILEE); int* SLOTTOK = (int*)(ws + WS_SLOTTOK);
    if (F.tid < 32) { const int cnt = (int)ld_agent(CNT + 64 * F.tid); starts[64 + F.tid] = cnt; starts[32 + F.tid] = (cnt + 255) & ~255; }
    __syncthreads();
    if (F.tid == 0) { int run = 0; for (int e = 0; e < 32; ++e) { starts[e] = run; run += starts[32 + e]; }
        if (F.blk == 0) { TILEE[1023] = run >> 8; for (int e = 0; e < 32; ++e) for (int tl = starts[e] >> 8; tl < (starts[e] + starts[32 + e]) >> 8; ++tl) TILEE[tl] = e; } }
    __syncthreads();
    if (F.blk == 0) { for (int e = 0; e < 32; ++e) for (int s = starts[e] + starts[64 + e] + F.tid; s < starts[e] + starts[32 + e]; s += NTHR) SLOTTOK[s] = 0; }
    const int* TOPI = (const int*)(ws + WS_TOPI); const int* RANK = (const int*)(ws + WS_RANK); int* TSLOT = (int*)(ws + WS_TSLOT);
    for (int q = F.blk * NTHR + F.tid; q < MX * 4; q += F.G * NTHR) {
        const int slot = starts[TOPI[q]] + RANK[q];
        TSLOT[q] = slot; SLOTTOK[slot] = q >> 2;
    }
}
__device__ __forceinline__ int moe_fill_table(const Args& a, const Frame& F, int nN, int RM) {
    LAS int* tab = (LAS int*)(F.lds + TAB_OFF);
    const unsigned* TILEE = (const unsigned*)(a.ws + WS_TILEE);
    if (F.tid == 0) {
        const int NT = (int)ld_agent(TILEE + 1023);
        const int x = F.blk & 7, j = F.blk >> 3; int n = 0;
        for (int i = 0; i < 64; ++i) { const int s = i * 8 + x, pm = s * RM + j / nN; if (pm >= NT) break;
            const int e = (int)ld_agent(TILEE + pm); tab[2 * n] = pm; tab[2 * n + 1] = e * nN + (j % nN); ++n; }
        tab[128] = n;
    }
    __syncthreads();
    return __builtin_amdgcn_readfirstlane(tab[128]);
}

__device__ __forceinline__ void p10_acc(float (&s)[16], int j, const v4u w, float g) {
    s[8 * j + 0] += g * bflo(w.x); s[8 * j + 1] += g * bfhi(w.x); s[8 * j + 2] += g * bflo(w.y); s[8 * j + 3] += g * bfhi(w.y);
    s[8 * j + 4] += g * bflo(w.z); s[8 * j + 5] += g * bfhi(w.z); s[8 * j + 6] += g * bflo(w.w); s[8 * j + 7] += g * bfhi(w.w);
}
__device__ __forceinline__ void phase10(const Args& a, const Frame& F) {
    unsigned char* ws = a.ws;
    const bf16* H1 = (const bf16*)(ws + WS_H1); const bf16* YS = (const bf16*)(ws + WS_YS);
    const int* TSLOT = (const int*)(ws + WS_TSLOT); const float* GATE = (const float*)(ws + WS_GATE);
    const int gw = F.blk * NWAVES + F.wave, NGW = F.G * NWAVES;
    f32x4 gv[4], bv[4];
#pragma unroll
    for (int q = 0; q < 4; ++q) { const int col = 8 * F.lane + 512 * (q >> 1) + 4 * (q & 1); gv[q] = *(const f32x4*)(a.in[I_LN2G] + col); bv[q] = *(const f32x4*)(a.in[I_LN2B] + col); }
    for (int m0 = gw; m0 < MX; m0 += 2 * NGW) {
        int mm[2]; mm[0] = m0; mm[1] = (m0 + NGW < MX) ? m0 + NGW : m0;
        int slot[2][4]; float gt[2][4]; v4u hw[2][2], yw[2][4][2];
#pragma unroll
        for (int r = 0; r < 2; ++r) {
#pragma unroll
            for (int k = 0; k < 4; ++k) { slot[r][k] = TSLOT[(size_t)mm[r] * 4 + k]; gt[r][k] = GATE[(size_t)mm[r] * 4 + k]; }
#pragma unroll
            for (int j = 0; j < 2; ++j) hw[r][j] = *(const v4u*)(H1 + (size_t)mm[r] * D + 8 * F.lane + 512 * j); }
#pragma unroll
        for (int r = 0; r < 2; ++r)
#pragma unroll
            for (int k = 0; k < 4; ++k)
#pragma unroll
                for (int j = 0; j < 2; ++j) yw[r][k][j] = *(const v4u*)(YS + (size_t)slot[r][k] * D + 8 * F.lane + 512 * j);
#pragma unroll
        for (int r = 0; r < 2; ++r) {
            float s[16];
#pragma unroll
            for (int i = 0; i < 16; ++i) s[i] = 0.f;
#pragma unroll
            for (int j = 0; j < 2; ++j) p10_acc(s, j, hw[r][j], ALPHA);
#pragma unroll
            for (int k = 0; k < 4; ++k)
#pragma unroll
                for (int j = 0; j < 2; ++j) p10_acc(s, j, yw[r][k][j], gt[r][k]);
            float t = 0.f;
#pragma unroll
            for (int i = 0; i < 16; ++i) t += s[i];
            const float mean = wave_sum(t, F.lane) * (1.f / D); float q = 0.f;
#pragma unroll
            for (int i = 0; i < 16; ++i) { s[i] -= mean; q += s[i] * s[i]; }
            const float rstd = __builtin_amdgcn_rsqf(wave_sum(q, F.lane) * (1.f / D) + 1e-5f);
            if (r == 0 || mm[1] != mm[0]) {
#pragma unroll
                for (int q4 = 0; q4 < 4; ++q4) { const int col = 8 * F.lane + 512 * (q4 >> 1) + 4 * (q4 & 1);
                    f32x4 o; o.x = s[4 * q4 + 0] * rstd * gv[q4].x + bv[q4].x; o.y = s[4 * q4 + 1] * rstd * gv[q4].y + bv[q4].y; o.z = s[4 * q4 + 2] * rstd * gv[q4].z + bv[q4].z; o.w = s[4 * q4 + 3] * rstd * gv[q4].w + bv[q4].w;
                    *(f32x4*)(a.out + (size_t)mm[r] * D + col) = o; } }
        }
    }
}

template <int LO, int HI>
__global__ void __launch_bounds__(NTHR, 2) fwd(Args a) {
    extern __shared__ __attribute__((aligned(16))) unsigned char lds_raw[];
    LAS unsigned char* lds = (LAS unsigned char*)lds_raw;
    const int wave = __builtin_amdgcn_readfirstlane((int)(threadIdx.x >> 6));
    volatile LAS unsigned* MISC = (volatile LAS unsigned*)(lds + MISC_OFF);
    if (wave == 0) MISC[lane_id()] = 0u;
    __syncthreads();
    unsigned* ctl = (unsigned*)(a.ws + WS_CTL);
    XcdBarrier bar; bar.bar = ctl + CW_BAR; bar.x = 0; bar.st = nullptr;
    if constexpr (HI - LO > 1) bar = xcd_barrier_post(ctl + CW_BAR, MISC + 8, wave == 0 && lane_id() == 0);
#define PH(k) if constexpr (LO <= (k) && (k) < HI)
#define SEAM(k) if constexpr (LO <= (k) && (k) + 1 < HI) xcd_barrier(bar, wave == 0 && lane_id() == 0)
    PH(0) for (int rep_ = 0; rep_ < NREP(0); ++rep_) { const Frame F = mkframe(lds, wave); phase0(a, F); } SEAM(0);
    PH(1) for (int rep_ = 0; rep_ < NREP(1); ++rep_) { const Frame F = mkframe(lds, wave);
            pg8::Gemm g{(const pg8::bf16_t*)(a.ws + WS_A0), (const pg8::bf16_t*)(a.ws + WS_WIN), MX, PW, D}; pg8::StaticOrder S; S.init(MX, PW, F.G, F.blk);
            pg8::EpiBf16Plain E{(pg8::bf16_t*)(a.ws + WS_PROJ), PW};
            pg8::gemm_phase<pg8::EpiBf16Plain, pg8::StaticOrder, true, true>(F.lds, g, S, E, F.tid); } SEAM(1);
    PH(2) for (int rep_ = 0; rep_ < NREP(2); ++rep_) { const Frame F = mkframe(lds, wave); phase2(a, F); } SEAM(2);
    PH(3) { const Frame F = mkframe(lds, wave); phase3(a, F); } SEAM(3);
    PH(4) for (int rep_ = 0; rep_ < NREP(4); ++rep_) { const Frame F = mkframe(lds, wave); phase4(a, F); } SEAM(4);
    PH(5) for (int rep_ = 0; rep_ < NREP(5); ++rep_) { const Frame F = mkframe(lds, wave);
            pg8::Gemm g{(const pg8::bf16_t*)(a.ws + WS_YMIX), (const pg8::bf16_t*)(a.ws + WS_WOUT), MX, D, D}; pg8::StaticOrder S; S.init(MX, D, F.G, F.blk);
            pg8::EpiBf16Plain E{(pg8::bf16_t*)(a.ws + WS_MIXB), D};
            pg8::gemm_phase<pg8::EpiBf16Plain, pg8::StaticOrder, true, true>(F.lds, g, S, E, F.tid); } SEAM(5);
    PH(6) for (int rep_ = 0; rep_ < NREP(6); ++rep_) { const Frame F = mkframe(lds, wave); phase6(a, F, rep_); } SEAM(6);
    PH(7) for (int rep_ = 0; rep_ < NREP(7); ++rep_) { const Frame F = mkframe(lds, wave); phase7(a, F); } SEAM(7);
    PH(8) for (int rep_ = 0; rep_ < NREP(8); ++rep_) { const Frame F = mkframe(lds, wave); const int n = moe_fill_table(a, F, 8, 4);
            pg8::Gemm g{(const pg8::bf16_t*)(a.ws + WS_H1Q), (const pg8::bf16_t*)(a.ws + WS_WUP), 0, 0, D / 2}; pg8::TableOrder S{(const LAS int*)(F.lds + TAB_OFF), n};
            pg8::EpiSwiglu8 E{a.ws + WS_ACT, a.in[I_BUP]};
            pg8::gemm_phase_g<pg8::EpiSwiglu8, pg8::TableOrder, true, true, 121>(F.lds, g, S, E, F.tid, (const int*)(a.ws + WS_SLOTTOK)); } SEAM(8);
    PH(9) for (int rep_ = 0; rep_ < NREP(9); ++rep_) { const Frame F = mkframe(lds, wave); const int n = moe_fill_table(a, F, 4, 8);
            pg8::Gemm g{(const pg8::bf16_t*)(a.ws + WS_ACT), (const pg8::bf16_t*)(a.ws + WS_WDN), 0, 0, D / 2}; pg8::TableOrder S{(const LAS int*)(F.lds + TAB_OFF), n};
            pg8::EpiDown E{(pg8::bf16_t*)(a.ws + WS_YS), a.in[I_BDN]};
            pg8::gemm_phase<pg8::EpiDown, pg8::TableOrder, true, true, 120>(F.lds, g, S, E, F.tid); } SEAM(9);
    PH(10) for (int rep_ = 0; rep_ < NREP(10); ++rep_) { const Frame F = mkframe(lds, wave); phase10(a, F); }
#undef PH
#undef SEAM
}

#ifndef MK_SINGLE
#define MK_SINGLE 1
#endif
template <int LO, int HI> static void launch_range(const Args& a, int grid, hipStream_t stream) {
    static bool attr = false;
    if (!attr) { (void)hipFuncSetAttribute((const void*)fwd<LO, HI>, hipFuncAttributeMaxDynamicSharedMemorySize, LDS_BYTES); attr = true; }
    hipLaunchKernelGGL((fwd<LO, HI>), dim3(grid), dim3(NTHR), LDS_BYTES, stream, a);
}
extern "C" void kernel_launch(void* const* d_in, const int* in_sizes, int n_in, void* d_out, int out_size, void* d_ws, size_t ws_size, hipStream_t stream) {
    if (n_in != 30 || ws_size < WS_END) { fprintf(stderr, "kernel_launch: unexpected inputs (n_in %d, ws %zu)\n", n_in, ws_size); return; }
    const int grid = 256;
    (void)hipMemsetAsync((char*)d_ws + WS_CTL, 0, CTL_ZERO_BYTES, stream);
    Args a{};
    for (int i = 0; i < 30; ++i) a.in[i] = (const float*)d_in[i];
    a.out = (float*)d_out; a.ws = (unsigned char*)d_ws;
#if MK_SINGLE
    launch_range<0, 11>(a, grid, stream);
#else
    launch_range<0, 1>(a, grid, stream); launch_range<1, 2>(a, grid, stream); launch_range<2, 3>(a, grid, stream); launch_range<3, 4>(a, grid, stream);
    launch_range<4, 5>(a, grid, stream); launch_range<5, 6>(a, grid, stream); launch_range<6, 7>(a, grid, stream); launch_range<7, 8>(a, grid, stream);
    launch_range<8, 9>(a, grid, stream); launch_range<9, 10>(a, grid, stream); launch_range<10, 11>(a, grid, stream);
#endif
}
```

```cpp
#include <hip/hip_runtime.h>
#include <cstdio>
#include <cstdint>
#include <cmath>
namespace pg8 {
#define PG8_LAS __attribute__((address_space(3)))
typedef unsigned short bf16_t;
typedef short bf16x8 __attribute__((ext_vector_type(8)));
typedef float f32x4 __attribute__((ext_vector_type(4)));
typedef unsigned u32x4 __attribute__((ext_vector_type(4)));
constexpr int BM = 256, BK = 64, HALF = 128, HTB = HALF * BK * 2  , STAGE_BYTES = 8 * HTB, NXCD = 8, WGM = 8;

__host__ __device__ __forceinline__ int lds_byte(int r, int c) { const int st = (r >> 4) * 2 + (c >> 5), rr = r & 15, cc = c & 31, ob = rr * 64 + cc * 2; return st * 1024 + (ob ^ (((ob >> 9) & 1) << 5)); }
__host__ __device__ __forceinline__ void stage_rc(int b, int& R, int& C) { const int st = b / 1024, sb = b % 1024, swz = sb ^ (((sb >> 9) & 1) << 5); R = (st >> 1) * 16 + swz / 64; C = (st & 1) * 32 + (swz % 64) / 2; }
__host__ __device__ __forceinline__ int perm32(int rho) { const int n = rho >> 4, i = rho & 15; return 8 * (i >> 2) + 4 * n + (i & 3); }

struct Unit { int pm, pn; };
struct Gemm { const bf16_t* A; const bf16_t* Bt; int M, N, K; };

struct StaticOrder {
    int nM, nN, nwg, G, c;
    __host__ __device__ void init(int M, int N, int G_, int c_) { nM = M / BM; nN = N / BM; nwg = nM * nN; G = G_; c = c_; }
    __host__ __device__ bool next(int i, Unit& u) const {
        const long L = (long)i * G + c; if (L >= nwg) return false;
        int wgid = (int)L; { const int q = nwg / NXCD, r = nwg % NXCD, xcd = wgid % NXCD, off = wgid / NXCD; wgid = (xcd < r ? xcd * (q + 1) : r * (q + 1) + (xcd - r) * q) + off; }
        const int nig = WGM * nN, gid = wgid / nig, fm = gid * WGM, gsz = (nM - fm) < WGM ? (nM - fm) : WGM;
        u.pm = fm + ((wgid % nig) % gsz); u.pn = (wgid % nig) / gsz; return true;
    }
    __device__ __forceinline__ void a_ready(const Unit&) const {}
    __device__ __forceinline__ void done(const Unit&) const {}
};


__device__ __forceinline__ unsigned cvt_pk_bf16(float lo, float hi) { unsigned r; asm volatile("v_cvt_pk_bf16_f32 %0, %1, %2" : "=v"(r) : "v"(lo), "v"(hi)); return r; }
typedef unsigned u32x2 __attribute__((ext_vector_type(2)));
typedef int i32x8 __attribute__((ext_vector_type(8))); typedef int i32x4 __attribute__((ext_vector_type(4)));
__device__ __forceinline__ void mfma_f8(f32x4& acc, i32x8 a, i32x8 b, int sa, int sb) {
    asm volatile("s_nop 1\n\tv_mfma_scale_f32_16x16x128_f8f6f4 %0, %1, %2, %0, %3, %4 op_sel_hi:[0,0,0]" : "+v"(acc) : "v"(a), "v"(b), "v"(sa), "v"(sb));
}
__device__ __forceinline__ i32x8 cat8(bf16x8 lo, bf16x8 hi) { const i32x4 a = __builtin_bit_cast(i32x4, lo), b = __builtin_bit_cast(i32x4, hi); return __builtin_shufflevector(a, b, 0, 1, 2, 3, 4, 5, 6, 7); }

struct EpiBf16Plain {
    static constexpr bool PERM = true, AFTER_DRAIN = false;
    bf16_t* O; int ldc;
    __device__ __forceinline__ void operator()(const f32x4 (&acc)[2][2][4][2], const Unit& u, int wr, int wc, int fr, int fq) const {
        const int row0 = u.pm * BM + wr * 64 + fr, col0 = u.pn * BM + wc * 32 + 8 * fq;
#pragma unroll
        for (int ai = 0; ai < 2; ++ai)
#pragma unroll
            for (int m = 0; m < 4; ++m) { bf16_t* rowp = O + (size_t)(row0 + ai * HALF + m * 16) * ldc + col0;
#pragma unroll
                for (int bj = 0; bj < 2; ++bj) { const f32x4 v0 = acc[ai][bj][m][0], v1 = acc[ai][bj][m][1];
                    u32x4 w; w.x = cvt_pk_bf16(v0[0], v0[1]); w.y = cvt_pk_bf16(v0[2], v0[3]); w.z = cvt_pk_bf16(v1[0], v1[1]); w.w = cvt_pk_bf16(v1[2], v1[3]);
                    *(u32x4*)(rowp + bj * HALF) = w; } }
    }
};

struct EpiResid {
    static constexpr bool PERM = false, AFTER_DRAIN = false;
    float* S1; const float* x; const float* stats; const float* g; const float* bta; float alpha;
    __device__ __forceinline__ void operator()(const f32x4 (&acc)[2][2][4][2], const Unit& u, int wr, int wc, int fr, int fq) const {
        const int row0 = u.pm * BM + wr * 64 + fr, col0 = u.pn * BM + wc * 32 + 4 * fq;
#pragma unroll
        for (int bj = 0; bj < 2; ++bj)
#pragma unroll
            for (int n = 0; n < 2; ++n) { const int c = col0 + bj * HALF + n * 16;
                const f32x4 gv = *(const f32x4*)(g + c) * alpha, bv = *(const f32x4*)(bta + c) * alpha;
#pragma unroll
                for (int ai = 0; ai < 2; ++ai)
#pragma unroll
                    for (int m = 0; m < 4; ++m) { const int r = row0 + ai * HALF + m * 16;
                        const float mean = stats[2 * r], rstd = stats[2 * r + 1];
                        const f32x4 xv = *(const f32x4*)(x + (size_t)r * 1024 + c);
                        *(f32x4*)(S1 + (size_t)r * 1024 + c) = ((xv - mean) * rstd) * gv + bv + acc[ai][bj][m][n]; } }
    }
};

__device__ __forceinline__ float swiglu1(float glu, float lin) {
    const float xg = fminf(glu, 7.0f), xl = fminf(fmaxf(lin, -7.0f), 7.0f);
    const float sg = __builtin_amdgcn_rcpf(1.0f + __expf(-1.702f * xg));
    return xg * sg * (xl + 1.0f);
}
struct EpiSwiglu {
    static constexpr bool PERM = true, AFTER_DRAIN = false;
    bf16_t* ACT; const float* bup;
    __device__ __forceinline__ void operator()(const f32x4 (&acc)[2][2][4][2], const Unit& u, int wr, int wc, int fr, int fq) const {
        const int e = u.pn >> 3, pn = u.pn & 7;
        const int row0 = u.pm * BM + wr * 64 + fr, ucol0 = pn * BM + wc * 32 + 8 * fq, acol0 = ucol0 >> 1;
        f32x4 bv[2][2];
#pragma unroll
        for (int bj = 0; bj < 2; ++bj)
#pragma unroll
            for (int n = 0; n < 2; ++n) bv[bj][n] = *(const f32x4*)(bup + (size_t)e * 2048 + ucol0 + bj * HALF + 4 * n);
#pragma unroll
        for (int ai = 0; ai < 2; ++ai)
#pragma unroll
            for (int m = 0; m < 4; ++m) { bf16_t* rowp = ACT + (size_t)(row0 + ai * HALF + m * 16) * 1024 + acol0;
#pragma unroll
                for (int bj = 0; bj < 2; ++bj) { const f32x4 v0 = acc[ai][bj][m][0] + bv[bj][0], v1 = acc[ai][bj][m][1] + bv[bj][1];
                    u32x2 w; w.x = cvt_pk_bf16(swiglu1(v0[0], v0[1]), swiglu1(v0[2], v0[3])); w.y = cvt_pk_bf16(swiglu1(v1[0], v1[1]), swiglu1(v1[2], v1[3]));
                    *(u32x2*)(rowp + bj * (HALF / 2)) = w; } }
    }
};
struct EpiSwiglu8 {
    static constexpr bool PERM = true, AFTER_DRAIN = false;
    unsigned char* ACT; const float* bup;
    __device__ __forceinline__ void operator()(const f32x4 (&acc)[2][2][4][2], const Unit& u, int wr, int wc, int fr, int fq) const {
        const int e = u.pn >> 3, pn = u.pn & 7;
        const int row0 = u.pm * BM + wr * 64 + fr, ucol0 = pn * BM + wc * 32 + 8 * fq, acol0 = ucol0 >> 1;
        f32x4 bv[2][2];
#pragma unroll
        for (int bj = 0; bj < 2; ++bj)
#pragma unroll
            for (int n = 0; n < 2; ++n) bv[bj][n] = *(const f32x4*)(bup + (size_t)e * 2048 + ucol0 + bj * HALF + 4 * n);
#pragma unroll
        for (int ai = 0; ai < 2; ++ai)
#pragma unroll
            for (int m = 0; m < 4; ++m) { unsigned char* rowp = ACT + (size_t)(row0 + ai * HALF + m * 16) * 1024 + acol0;
#pragma unroll
                for (int bj = 0; bj < 2; ++bj) { const f32x4 v0 = acc[ai][bj][m][0] + bv[bj][0], v1 = acc[ai][bj][m][1] + bv[bj][1];
                    int w = __builtin_amdgcn_cvt_pk_fp8_f32(swiglu1(v0[0], v0[1]), swiglu1(v0[2], v0[3]), 0, false);
                    w = __builtin_amdgcn_cvt_pk_fp8_f32(swiglu1(v1[0], v1[1]), swiglu1(v1[2], v1[3]), w, true);
                    *(int*)(rowp + bj * (HALF / 2)) = w; } }
    }
};
struct EpiDown {
    static constexpr bool PERM = true, AFTER_DRAIN = false;
    bf16_t* YS; const float* bdn;
    __device__ __forceinline__ void operator()(const f32x4 (&acc)[2][2][4][2], const Unit& u, int wr, int wc, int fr, int fq) const {
        const int e = u.pn >> 2, pn = u.pn & 3;
        const int row0 = u.pm * BM + wr * 64 + fr, col0 = pn * BM + wc * 32 + 8 * fq;
        f32x4 bv[2][2];
#pragma unroll
        for (int bj = 0; bj < 2; ++bj)
#pragma unroll
            for (int n = 0; n < 2; ++n) bv[bj][n] = *(const f32x4*)(bdn + (size_t)e * 1024 + col0 + bj * HALF + 4 * n);
#pragma unroll
        for (int ai = 0; ai < 2; ++ai)
#pragma unroll
            for (int m = 0; m < 4; ++m) { bf16_t* rowp = YS + (size_t)(row0 + ai * HALF + m * 16) * 1024 + col0;
#pragma unroll
                for (int bj = 0; bj < 2; ++bj) { const f32x4 v0 = acc[ai][bj][m][0] + bv[bj][0], v1 = acc[ai][bj][m][1] + bv[bj][1];
                    u32x4 w; w.x = cvt_pk_bf16(v0[0], v0[1]); w.y = cvt_pk_bf16(v0[2], v0[3]); w.z = cvt_pk_bf16(v1[0], v1[1]); w.w = cvt_pk_bf16(v1[2], v1[3]);
                    *(u32x4*)(rowp + bj * HALF) = w; } }
    }
};
struct EpiDown8 {
    static constexpr bool PERM = true, AFTER_DRAIN = false;
    unsigned char* YS; const float* bdn;
    __device__ __forceinline__ void operator()(const f32x4 (&acc)[2][2][4][2], const Unit& u, int wr, int wc, int fr, int fq) const {
        const int e = u.pn >> 2, pn = u.pn & 3;
        const int row0 = u.pm * BM + wr * 64 + fr, col0 = pn * BM + wc * 32 + 8 * fq;
        f32x4 bv[2][2];
#pragma unroll
        for (int bj = 0; bj < 2; ++bj)
#pragma unroll
            for (int n = 0; n < 2; ++n) bv[bj][n] = *(const f32x4*)(bdn + (size_t)e * 1024 + col0 + bj * HALF + 4 * n);
#pragma unroll
        for (int ai = 0; ai < 2; ++ai)
#pragma unroll
            for (int m = 0; m < 4; ++m) { unsigned char* rowp = YS + (size_t)(row0 + ai * HALF + m * 16) * 1024 + col0;
#pragma unroll
                for (int bj = 0; bj < 2; ++bj) { const f32x4 v0 = acc[ai][bj][m][0] + bv[bj][0], v1 = acc[ai][bj][m][1] + bv[bj][1];
                    int w0 = __builtin_amdgcn_cvt_pk_fp8_f32(v0[0], v0[1], 0, false); w0 = __builtin_amdgcn_cvt_pk_fp8_f32(v0[2], v0[3], w0, true);
                    int w1 = __builtin_amdgcn_cvt_pk_fp8_f32(v1[0], v1[1], 0, false); w1 = __builtin_amdgcn_cvt_pk_fp8_f32(v1[2], v1[3], w1, true);
                    u32x2 w; w.x = (unsigned)w0; w.y = (unsigned)w1;
                    *(u32x2*)(rowp + bj * HALF) = w; } }
    }
};
struct TableOrder {
    const PG8_LAS int* tab; int n;
    __device__ __forceinline__ bool next(int i, Unit& u) const {
        if (i >= n) return false;
        u.pm = __builtin_amdgcn_readfirstlane(tab[2 * i]); u.pn = __builtin_amdgcn_readfirstlane(tab[2 * i + 1]); return true;
    }
    __device__ __forceinline__ void a_ready(const Unit&) const {}
    __device__ __forceinline__ void done(const Unit&) const {}
};

template <class Epi, class Sched, bool ALIGN_EPI = false, bool SP2 = false, int SCW = 0>
__device__ __forceinline__ void gemm_phase(PG8_LAS unsigned char* lds, const Gemm g, const Sched& S, const Epi& E, const int tid) {
    const int wid = __builtin_amdgcn_readfirstlane(tid >> 6), lane = tid & 63, wr = wid >> 2, wc = wid & 3, fr = lane & 15, fq = lane >> 4;
    int K_ = g.K; asm volatile("" : "+s"(K_));
    const int K = K_, nt = K / BK;
    unsigned voffA[2], voffB[2];
#pragma unroll
    for (int i = 0; i < 2; ++i) { int R, C; stage_rc(tid * 16 + i * 8192, R, C); const int Rb = Epi::PERM ? ((R & ~31) + perm32(R & 31)) : R;
        voffA[i] = (unsigned)(R * K + C) * 2u; voffB[i] = (unsigned)(Rb * K + C) * 2u; }
    const size_t kstep = (size_t)(BK * 2);
    const size_t hstep = (size_t)HALF * K * 2;
    const size_t tstep = 2 * hstep;
    const unsigned ldsw = (unsigned)wid * 1024u;
    const int aoff = lds_byte(wr * 64 + fr, fq * 8), boff = lds_byte(wc * 32 + fr, fq * 8);
#define PG8_SA(b, h) (((b) * 2 + (h)) * HTB)
#define PG8_SB(b, h) ((4 + (b) * 2 + (h)) * HTB)
#define PG8_STAGE(bufoff, gbase, voff) do { _Pragma("unroll") for (int _i = 0; _i < 2; ++_i) \
        __builtin_amdgcn_global_load_lds((const unsigned*)((const char*)(gbase) + (voff)[_i]), (PG8_LAS unsigned*)(lds + (bufoff) + ldsw + _i * 8192), 16, 0, 0); } while (0)
#define PG8_LDA(dst, b, h) do { _Pragma("unroll") for (int m = 0; m < 4; ++m) _Pragma("unroll") for (int k = 0; k < 2; ++k) dst[m][k] = *(const PG8_LAS bf16x8*)(lds + PG8_SA(b, h) + aoff + m * 2048 + k * 1024); } while (0)
#define PG8_LDB(dst, b, h) do { _Pragma("unroll") for (int n = 0; n < 2; ++n) _Pragma("unroll") for (int k = 0; k < 2; ++k) dst[n][k] = *(const PG8_LAS bf16x8*)(lds + PG8_SB(b, h) + boff + n * 2048 + k * 1024); } while (0)
#define PG8_MMA(ai, bj, At, Bt) do { __builtin_amdgcn_s_setprio(1); _Pragma("unroll") for (int m = 0; m < 4; ++m) _Pragma("unroll") for (int n = 0; n < 2; ++n) { \
        if constexpr (SCW != 0) mfma_f8(acc[ai][bj][m][n], cat8(Bt[n][0], Bt[n][1]), cat8(At[m][0], At[m][1]), SCW * 0x01010101, 0x7f7f7f7f); \
        else { _Pragma("unroll") for (int k = 0; k < 2; ++k) acc[ai][bj][m][n] = __builtin_amdgcn_mfma_f32_16x16x32_bf16(Bt[n][k], At[m][k], acc[ai][bj][m][n], 0, 0, 0); } } __builtin_amdgcn_s_setprio(0); } while (0)
#define PG8_WAIT_V(n) asm volatile("s_waitcnt vmcnt(" #n ")" ::: "memory")
#define PG8_WAIT_L(n) asm volatile("s_waitcnt lgkmcnt(" #n ")" ::: "memory")
#define PG8_BAR __builtin_amdgcn_s_barrier()
#define PG8_SCHED __builtin_amdgcn_sched_barrier(0)
    Unit cur, nxt; int ui = 0;
    if (!S.next(0, cur)) return;
    f32x4 acc[2][2][4][2];
#pragma unroll
    for (int a = 0; a < 2; ++a)
#pragma unroll
        for (int b = 0; b < 2; ++b)
#pragma unroll
            for (int m = 0; m < 4; ++m)
#pragma unroll
                for (int n = 0; n < 2; ++n) acc[a][b][m][n] = (f32x4){0.f, 0.f, 0.f, 0.f};
    bf16x8 At[4][2], B0[2][2], B1[2][2];
    const char* cA = (const char*)g.A + (size_t)cur.pm * tstep; const char* cB = (const char*)g.Bt + (size_t)cur.pn * tstep;
    S.a_ready(cur);
    if constexpr (SP2) {
        PG8_STAGE(PG8_SB(0, 0), cB, voffB); PG8_STAGE(PG8_SB(0, 1), cB + hstep, voffB); PG8_STAGE(PG8_SA(0, 0), cA, voffA); PG8_STAGE(PG8_SA(0, 1), cA + hstep, voffA);
        if (wr == 1) PG8_BAR;
        PG8_WAIT_V(2); PG8_BAR;
        PG8_STAGE(PG8_SB(1, 0), cB + kstep, voffB); PG8_STAGE(PG8_SA(1, 0), cA + kstep, voffA); PG8_STAGE(PG8_SB(1, 1), cB + hstep + kstep, voffB);
        PG8_WAIT_V(6); PG8_BAR;
    } else {
        PG8_STAGE(PG8_SB(0, 0), cB, voffB); PG8_STAGE(PG8_SA(0, 0), cA, voffA); PG8_STAGE(PG8_SB(0, 1), cB + hstep, voffB); PG8_STAGE(PG8_SA(0, 1), cA + hstep, voffA);
        if (wr == 1) PG8_BAR;
        PG8_WAIT_V(4); PG8_BAR;
        PG8_STAGE(PG8_SB(1, 0), cB + kstep, voffB); PG8_STAGE(PG8_SA(1, 0), cA + kstep, voffA); PG8_STAGE(PG8_SB(1, 1), cB + hstep + kstep, voffB);
        PG8_WAIT_V(6); PG8_BAR;
    }
    for (;;) {
        const bool has_next = S.next(ui + 1, nxt);
        const char* nA = has_next ? (const char*)g.A + (size_t)nxt.pm * tstep : cA; const char* nB = has_next ? (const char*)g.Bt + (size_t)nxt.pn * tstep : cB;
        for (int t = 0; t < nt; t += 2) {
            const bool last = (t == nt - 2);
            const char* a1 = cA + (size_t)(t + 1) * kstep;
            const char* a2 = last ? nA : cA + (size_t)(t + 2) * kstep; const char* b2 = last ? nB : cB + (size_t)(t + 2) * kstep;
            const char* a3 = a2 + kstep; const char* b3 = b2 + kstep;
            if (last && has_next) S.a_ready(nxt);
            if constexpr (SP2) {
            PG8_LDB(B0, 0, 0); PG8_LDB(B1, 0, 1); PG8_SCHED; PG8_LDA(At, 0, 0); PG8_STAGE(PG8_SA(1, 1), a1 + hstep, voffA);
            PG8_WAIT_V(8); PG8_WAIT_L(0); PG8_BAR; PG8_MMA(0, 0, At, B0); PG8_MMA(0, 1, At, B1); PG8_BAR; PG8_SCHED;
            PG8_LDA(At, 0, 1); PG8_STAGE(PG8_SB(0, 0), b2, voffB); PG8_STAGE(PG8_SB(0, 1), b2 + hstep, voffB); PG8_STAGE(PG8_SA(0, 0), a2, voffA);
            PG8_WAIT_V(8); PG8_WAIT_L(0); PG8_BAR; PG8_MMA(1, 0, At, B0); PG8_MMA(1, 1, At, B1); PG8_BAR; PG8_SCHED;
            PG8_LDB(B0, 1, 0); PG8_LDB(B1, 1, 1); PG8_SCHED; PG8_LDA(At, 1, 0); PG8_STAGE(PG8_SA(0, 1), a2 + hstep, voffA);
            PG8_WAIT_V(8); PG8_WAIT_L(0); PG8_BAR; PG8_MMA(0, 0, At, B0); PG8_MMA(0, 1, At, B1); PG8_BAR; PG8_SCHED;
            PG8_LDA(At, 1, 1); PG8_STAGE(PG8_SB(1, 0), b3, voffB); PG8_STAGE(PG8_SB(1, 1), b3 + hstep, voffB); PG8_STAGE(PG8_SA(1, 0), a3, voffA);
            PG8_WAIT_V(8); PG8_WAIT_L(0); PG8_BAR; PG8_MMA(1, 0, At, B0); PG8_MMA(1, 1, At, B1); PG8_BAR; PG8_SCHED;
            } else {
            PG8_LDB(B0, 0, 0); PG8_SCHED; PG8_LDA(At, 0, 0); PG8_STAGE(PG8_SA(1, 1), a1 + hstep, voffA);
            PG8_WAIT_L(8); PG8_BAR; PG8_WAIT_L(0); PG8_MMA(0, 0, At, B0); PG8_BAR; PG8_SCHED;
            PG8_LDB(B1, 0, 1); PG8_STAGE(PG8_SB(0, 0), b2, voffB);
            PG8_BAR; PG8_WAIT_L(0); PG8_MMA(0, 1, At, B1); PG8_BAR;
            PG8_LDA(At, 0, 1); PG8_STAGE(PG8_SA(0, 0), a2, voffA);
            PG8_BAR; PG8_WAIT_L(0); PG8_MMA(1, 0, At, B0); PG8_BAR; PG8_SCHED;
            PG8_STAGE(PG8_SB(0, 1), b2 + hstep, voffB);
            PG8_WAIT_V(6); PG8_BAR; PG8_MMA(1, 1, At, B1); PG8_BAR;
            PG8_LDB(B0, 1, 0); PG8_SCHED; PG8_LDA(At, 1, 0); PG8_STAGE(PG8_SA(0, 1), a2 + hstep, voffA);
            PG8_WAIT_L(8); PG8_BAR; PG8_WAIT_L(0); PG8_MMA(0, 0, At, B0); PG8_BAR; PG8_SCHED;
            PG8_LDB(B1, 1, 1); PG8_STAGE(PG8_SB(1, 0), b3, voffB);
            PG8_BAR; PG8_WAIT_L(0); PG8_MMA(0, 1, At, B1); PG8_BAR;
            PG8_LDA(At, 1, 1); PG8_STAGE(PG8_SA(1, 0), a3, voffA);
            PG8_BAR; PG8_WAIT_L(0); PG8_MMA(1, 0, At, B0); PG8_BAR; PG8_SCHED;
            PG8_STAGE(PG8_SB(1, 1), b3 + hstep, voffB);
            PG8_WAIT_V(6); PG8_BAR; PG8_MMA(1, 1, At, B1); PG8_BAR;
            }
        }
        if constexpr (SCW != 0) asm volatile("s_nop 15\n\ts_nop 15" ::: "memory");
        if constexpr (ALIGN_EPI) { if (wr == 0) PG8_BAR; }
        if constexpr (!Epi::AFTER_DRAIN) { E(acc, cur, wr, wc, fr, fq); S.done(cur); }
        if (!has_next) break;
#pragma unroll
        for (int a = 0; a < 2; ++a)
#pragma unroll
            for (int b = 0; b < 2; ++b)
#pragma unroll
                for (int m = 0; m < 4; ++m)
#pragma unroll
                    for (int n = 0; n < 2; ++n) acc[a][b][m][n] = (f32x4){0.f, 0.f, 0.f, 0.f};
        cur = nxt; cA = nA; cB = nB; ++ui;
        if constexpr (ALIGN_EPI) { if (wr == 1) PG8_BAR; }
    }
    PG8_WAIT_V(0);
    if constexpr (!ALIGN_EPI) { if (wr == 0) PG8_BAR; }
    PG8_BAR;
    if constexpr (Epi::AFTER_DRAIN) { E.fused(acc, cur, wr, wc, fr, fq, lds, wid, lane); S.done(cur); }
#undef PG8_SA
#undef PG8_SB
#undef PG8_STAGE
#undef PG8_LDA
#undef PG8_LDB
#undef PG8_MMA
#undef PG8_WAIT_V
#undef PG8_WAIT_L
#undef PG8_BAR
#undef PG8_SCHED
}
template <class Epi, class Sched, bool ALIGN_EPI = false, bool SP2 = false, int SCW = 0>
__device__ __forceinline__ void gemm_phase_g(PG8_LAS unsigned char* lds, const Gemm g, const Sched& S, const Epi& E, const int tid, const int* rowmap) {
    const int wid = __builtin_amdgcn_readfirstlane(tid >> 6), lane = tid & 63, wr = wid >> 2, wc = wid & 3, fr = lane & 15, fq = lane >> 4;
    int K_ = g.K; asm volatile("" : "+s"(K_));
    const int K = K_, nt = K / BK;
    unsigned voffB[2], cv0[2], cv1[2], nv0[2], nv1[2]; int RA[2], CA[2];
#pragma unroll
    for (int i = 0; i < 2; ++i) { int R, C; stage_rc(tid * 16 + i * 8192, R, C); const int Rb = Epi::PERM ? ((R & ~31) + perm32(R & 31)) : R;
        RA[i] = R; CA[i] = C; voffB[i] = (unsigned)(Rb * K + C) * 2u; }
    const size_t kstep = (size_t)(BK * 2);
    const size_t hstep = (size_t)HALF * K * 2;
    const size_t tstep = 2 * hstep;
    const unsigned ldsw = (unsigned)wid * 1024u;
    const int aoff = lds_byte(wr * 64 + fr, fq * 8), boff = lds_byte(wc * 32 + fr, fq * 8);
#define PG8_SA(b, h) (((b) * 2 + (h)) * HTB)
#define PG8_SB(b, h) ((4 + (b) * 2 + (h)) * HTB)
#define PG8_STAGE(bufoff, gbase, voff) do { _Pragma("unroll") for (int _i = 0; _i < 2; ++_i) \
        __builtin_amdgcn_global_load_lds((const unsigned*)((const char*)(gbase) + (voff)[_i]), (PG8_LAS unsigned*)(lds + (bufoff) + ldsw + _i * 8192), 16, 0, 0); } while (0)
#define PG8_LDA(dst, b, h) do { _Pragma("unroll") for (int m = 0; m < 4; ++m) _Pragma("unroll") for (int k = 0; k < 2; ++k) dst[m][k] = *(const PG8_LAS bf16x8*)(lds + PG8_SA(b, h) + aoff + m * 2048 + k * 1024); } while (0)
#define PG8_LDB(dst, b, h) do { _Pragma("unroll") for (int n = 0; n < 2; ++n) _Pragma("unroll") for (int k = 0; k < 2; ++k) dst[n][k] = *(const PG8_LAS bf16x8*)(lds + PG8_SB(b, h) + boff + n * 2048 + k * 1024); } while (0)
#define PG8_MMA(ai, bj, At, Bt) do { __builtin_amdgcn_s_setprio(1); _Pragma("unroll") for (int m = 0; m < 4; ++m) _Pragma("unroll") for (int n = 0; n < 2; ++n) { \
        if constexpr (SCW != 0) mfma_f8(acc[ai][bj][m][n], cat8(Bt[n][0], Bt[n][1]), cat8(At[m][0], At[m][1]), SCW * 0x01010101, 0x7f7f7f7f); \
        else { _Pragma("unroll") for (int k = 0; k < 2; ++k) acc[ai][bj][m][n] = __builtin_amdgcn_mfma_f32_16x16x32_bf16(Bt[n][k], At[m][k], acc[ai][bj][m][n], 0, 0, 0); } } __builtin_amdgcn_s_setprio(0); } while (0)
#define PG8_WAIT_V(n) asm volatile("s_waitcnt vmcnt(" #n ")" ::: "memory")
#define PG8_WAIT_L(n) asm volatile("s_waitcnt lgkmcnt(" #n ")" ::: "memory")
#define PG8_BAR __builtin_amdgcn_s_barrier()
#define PG8_SCHED __builtin_amdgcn_sched_barrier(0)
    static_assert(SP2, "gemm_phase_g: SP2 form only");
    Unit cur, nxt; int ui = 0;
    if (!S.next(0, cur)) return;
    f32x4 acc[2][2][4][2];
#pragma unroll
    for (int a = 0; a < 2; ++a)
#pragma unroll
        for (int b = 0; b < 2; ++b)
#pragma unroll
            for (int m = 0; m < 4; ++m)
#pragma unroll
                for (int n = 0; n < 2; ++n) acc[a][b][m][n] = (f32x4){0.f, 0.f, 0.f, 0.f};
    bf16x8 At[4][2], B0[2][2], B1[2][2];
    const char* gA = (const char*)g.A; const char* cB = (const char*)g.Bt + (size_t)cur.pn * tstep;
#define PG8_ROWS(pm_, v0_, v1_) do { _Pragma("unroll") for (int _i = 0; _i < 2; ++_i) { v0_[_i] = (unsigned)(rowmap[(pm_) * BM + RA[_i]] * K + CA[_i]) * 2u; v1_[_i] = (unsigned)(rowmap[(pm_) * BM + HALF + RA[_i]] * K + CA[_i]) * 2u; } } while (0)
    PG8_ROWS(cur.pm, cv0, cv1);
    const unsigned voffA[2] = {0u, 0u}; const char* cA = gA; (void)voffA; (void)cA;
    S.a_ready(cur);
    if constexpr (SP2) {
        PG8_STAGE(PG8_SB(0, 0), cB, voffB); PG8_STAGE(PG8_SB(0, 1), cB + hstep, voffB); PG8_STAGE(PG8_SA(0, 0), gA, cv0); PG8_STAGE(PG8_SA(0, 1), gA, cv1);
        if (wr == 1) PG8_BAR;
        PG8_WAIT_V(2); PG8_BAR;
        PG8_STAGE(PG8_SB(1, 0), cB + kstep, voffB); PG8_STAGE(PG8_SA(1, 0), gA + kstep, cv0); PG8_STAGE(PG8_SB(1, 1), cB + hstep + kstep, voffB);
        PG8_WAIT_V(6); PG8_BAR;
    } else {
        PG8_STAGE(PG8_SB(0, 0), cB, voffB); PG8_STAGE(PG8_SA(0, 0), cA, voffA); PG8_STAGE(PG8_SB(0, 1), cB + hstep, voffB); PG8_STAGE(PG8_SA(0, 1), cA + hstep, voffA);
        if (wr == 1) PG8_BAR;
        PG8_WAIT_V(4); PG8_BAR;
        PG8_STAGE(PG8_SB(1, 0), cB + kstep, voffB); PG8_STAGE(PG8_SA(1, 0), cA + kstep, voffA); PG8_STAGE(PG8_SB(1, 1), cB + hstep + kstep, voffB);
        PG8_WAIT_V(6); PG8_BAR;
    }
    for (;;) {
        const bool has_next = S.next(ui + 1, nxt);
        const char* nB = has_next ? (const char*)g.Bt + (size_t)nxt.pn * tstep : cB;
        if (has_next) PG8_ROWS(nxt.pm, nv0, nv1); else { nv0[0] = cv0[0]; nv0[1] = cv0[1]; nv1[0] = cv1[0]; nv1[1] = cv1[1]; }
        for (int t = 0; t < nt; t += 2) {
            const bool last = (t == nt - 2);
            const char* a1 = gA + (size_t)(t + 1) * kstep;
            const char* a2 = last ? gA : gA + (size_t)(t + 2) * kstep; const char* b2 = last ? nB : cB + (size_t)(t + 2) * kstep;
            unsigned w0[2], w1[2]; w0[0] = last ? nv0[0] : cv0[0]; w0[1] = last ? nv0[1] : cv0[1]; w1[0] = last ? nv1[0] : cv1[0]; w1[1] = last ? nv1[1] : cv1[1];
            const char* a3 = a2 + kstep; const char* b3 = b2 + kstep;
            if (last && has_next) S.a_ready(nxt);
            if constexpr (SP2) {
            PG8_LDB(B0, 0, 0); PG8_LDB(B1, 0, 1); PG8_SCHED; PG8_LDA(At, 0, 0); PG8_STAGE(PG8_SA(1, 1), a1, cv1);
            PG8_WAIT_V(8); PG8_WAIT_L(0); PG8_BAR; PG8_MMA(0, 0, At, B0); PG8_MMA(0, 1, At, B1); PG8_BAR; PG8_SCHED;
            PG8_LDA(At, 0, 1); PG8_STAGE(PG8_SB(0, 0), b2, voffB); PG8_STAGE(PG8_SB(0, 1), b2 + hstep, voffB); PG8_STAGE(PG8_SA(0, 0), a2, w0);
            PG8_WAIT_V(8); PG8_WAIT_L(0); PG8_BAR; PG8_MMA(1, 0, At, B0); PG8_MMA(1, 1, At, B1); PG8_BAR; PG8_SCHED;
            PG8_LDB(B0, 1, 0); PG8_LDB(B1, 1, 1); PG8_SCHED; PG8_LDA(At, 1, 0); PG8_STAGE(PG8_SA(0, 1), a2, w1);
            PG8_WAIT_V(8); PG8_WAIT_L(0); PG8_BAR; PG8_MMA(0, 0, At, B0); PG8_MMA(0, 1, At, B1); PG8_BAR; PG8_SCHED;
            PG8_LDA(At, 1, 1); PG8_STAGE(PG8_SB(1, 0), b3, voffB); PG8_STAGE(PG8_SB(1, 1), b3 + hstep, voffB); PG8_STAGE(PG8_SA(1, 0), a3, w0);
            PG8_WAIT_V(8); PG8_WAIT_L(0); PG8_BAR; PG8_MMA(1, 0, At, B0); PG8_MMA(1, 1, At, B1); PG8_BAR; PG8_SCHED;
            } else {
            PG8_LDB(B0, 0, 0); PG8_SCHED; PG8_LDA(At, 0, 0); PG8_STAGE(PG8_SA(1, 1), a1, cv1);
            PG8_WAIT_L(8); PG8_BAR; PG8_WAIT_L(0); PG8_MMA(0, 0, At, B0); PG8_BAR; PG8_SCHED;
            PG8_LDB(B1, 0, 1); PG8_STAGE(PG8_SB(0, 0), b2, voffB);
            PG8_BAR; PG8_WAIT_L(0); PG8_MMA(0, 1, At, B1); PG8_BAR;
            PG8_LDA(At, 0, 1); PG8_STAGE(PG8_SA(0, 0), a2, voffA);
            PG8_BAR; PG8_WAIT_L(0); PG8_MMA(1, 0, At, B0); PG8_BAR; PG8_SCHED;
            PG8_STAGE(PG8_SB(0, 1), b2 + hstep, voffB);
            PG8_WAIT_V(6); PG8_BAR; PG8_MMA(1, 1, At, B1); PG8_BAR;
            PG8_LDB(B0, 1, 0); PG8_SCHED; PG8_LDA(At, 1, 0); PG8_STAGE(PG8_SA(0, 1), a2, w1);
            PG8_WAIT_L(8); PG8_BAR; PG8_WAIT_L(0); PG8_MMA(0, 0, At, B0); PG8_BAR; PG8_SCHED;
            PG8_LDB(B1, 1, 1); PG8_STAGE(PG8_SB(1, 0), b3, voffB);
            PG8_BAR; PG8_WAIT_L(0); PG8_MMA(0, 1, At, B1); PG8_BAR;
            PG8_LDA(At, 1, 1); PG8_STAGE(PG8_SA(1, 0), a3, voffA);
            PG8_BAR; PG8_WAIT_L(0); PG8_MMA(1, 0, At, B0); PG8_BAR; PG8_SCHED;
            PG8_STAGE(PG8_SB(1, 1), b3 + hstep, voffB);
            PG8_WAIT_V(6); PG8_BAR; PG8_MMA(1, 1, At, B1); PG8_BAR;
            }
        }
        if constexpr (SCW != 0) asm volatile("s_nop 15\n\ts_nop 15" ::: "memory");
        if constexpr (ALIGN_EPI) { if (wr == 0) PG8_BAR; }
        if constexpr (!Epi::AFTER_DRAIN) { E(acc, cur, wr, wc, fr, fq); S.done(cur); }
        if (!has_next) break;
#pragma unroll
        for (int a = 0; a < 2; ++a)
#pragma unroll
            for (int b = 0; b < 2; ++b)
#pragma unroll
                for (int m = 0; m < 4; ++m)
#pragma unroll
                    for (int n = 0; n < 2; ++n) acc[a][b][m][n] = (f32x4){0.f, 0.f, 0.f, 0.f};
        cur = nxt; cB = nB; ++ui; cv0[0] = nv0[0]; cv0[1] = nv0[1]; cv1[0] = nv1[0]; cv1[1] = nv1[1];
        if constexpr (ALIGN_EPI) { if (wr == 1) PG8_BAR; }
    }
    PG8_WAIT_V(0);
    if constexpr (!ALIGN_EPI) { if (wr == 0) PG8_BAR; }
    PG8_BAR;
    if constexpr (Epi::AFTER_DRAIN) { E.fused(acc, cur, wr, wc, fr, fq, lds, wid, lane); S.done(cur); }
#undef PG8_ROWS
#undef PG8_SA
#undef PG8_SB
#undef PG8_STAGE
#undef PG8_LDA
#undef PG8_LDB
#undef PG8_MMA
#undef PG8_WAIT_V
#undef PG8_WAIT_L
#undef PG8_BAR
#undef PG8_SCHED
}
}

#ifndef REP_MASK
#define REP_MASK 0
#endif
#define NREP(k) (1 + ((REP_MASK >> (k)) & 1))

constexpr int NB = 16, SEQ = 2048, D = 1024, NMETA = 16;
constexpr int MX = NB * SEQ;
constexpr int INW = 3344, PW = 3584;
constexpr int GQ = 0, GK = 256, GV = 512, GG = 1024, GKL = 1536;
constexpr int RW0 = 1552;
constexpr int RR = RW0, RK = RW0 + 512, RV = RW0 + 1024, RWL = RW0 + 1536, RAL = RW0 + 1600, RGL = RW0 + 1664;
constexpr int NE = 32, TOPK = 4;
constexpr int NCH = 33;
constexpr float ALPHA = 1.189207115002721f;
constexpr int NWAVES = 8, NTHR = 512;

constexpr size_t MiB = 1u << 20;
constexpr size_t WS_CTL = 0, CTL_ZERO_BYTES = 1 * MiB;
constexpr size_t WS_STATS = 1 * MiB;
constexpr size_t WS_TOPI  = WS_STATS + 256 * 1024;
constexpr size_t WS_GATE  = WS_TOPI + 512 * 1024;
constexpr size_t WS_RANK  = WS_GATE + 512 * 1024;
constexpr size_t WS_TSLOT = WS_RANK + 512 * 1024;
constexpr size_t WS_BON   = WS_TSLOT + 512 * 1024;
constexpr size_t WS_PROJM = WS_BON + 1 * MiB;
constexpr size_t WS_OPSM  = WS_PROJM + 256 * 1024;
constexpr size_t WS_DL    = WS_OPSM + 256 * 1024;
constexpr size_t WS_W2T   = WS_DL + 1 * MiB;
constexpr size_t WS_A2T   = WS_W2T + 64 * 1024;
constexpr size_t WS_G2T   = WS_A2T + 64 * 1024;
constexpr size_t WS_RWH   = WS_G2T + 128 * 1024;
constexpr size_t WS_RWL   = WS_RWH + 64 * 1024;
constexpr size_t WS_TILEE = WS_RWL + 64 * 1024;
constexpr size_t WS_SLOTTOK = WS_TILEE + 4096;
constexpr size_t WS_WIN   = 8 * MiB;
constexpr size_t WS_WOUT  = 15 * MiB;
static_assert(WS_SLOTTOK + 139264 * 4 <= WS_WIN, "table region");
constexpr size_t WS_A0    = 20 * MiB;
constexpr size_t WS_YMIX  = WS_A0;
constexpr size_t WS_PROJ  = 84 * MiB;
constexpr size_t WS_R1    = 308 * MiB;
constexpr size_t WS_GAM   = 520 * MiB;
constexpr size_t WS_SST   = 524 * MiB;
constexpr size_t WS_GUS   = 692 * MiB;
constexpr size_t WS_H1    = 20 * MiB;
constexpr size_t WS_XS    = 84 * MiB;
constexpr size_t WS_YS    = WS_XS;
constexpr size_t WS_ACT   = 356 * MiB;
constexpr size_t WS_MIXB  = 628 * MiB;
constexpr size_t WS_WUP   = 758 * MiB;
constexpr size_t WS_WDN   = 822 * MiB;
constexpr size_t WS_H1Q   = 854 * MiB;
constexpr size_t WS_END   = 886 * MiB;
constexpr int CW_BAR = 4096;
constexpr int CW_CNT = 16384;
constexpr int CW_QH = 20480;

constexpr int RING_BYTES = 131072;
constexpr int LDS_BYTES = 147456;
constexpr int TAB_OFF = 132096;
constexpr int MISC_OFF = LDS_BYTES - 512;

#define LAS __attribute__((address_space(3)))
typedef unsigned short bf16;
typedef unsigned v4u __attribute__((ext_vector_type(4)));
typedef unsigned v2u __attribute__((ext_vector_type(2)));
typedef float f32x4 __attribute__((ext_vector_type(4)));
typedef short bf16x8 __attribute__((ext_vector_type(8)));
typedef int i32x4g __attribute__((ext_vector_type(4)));
#define LDS_WAIT() asm volatile("s_waitcnt lgkmcnt(0)" ::: "memory")
__device__ __forceinline__ float bflo(unsigned w) { return __uint_as_float(w << 16); }
__device__ __forceinline__ float bfhi(unsigned w) { return __uint_as_float(w & 0xffff0000u); }
typedef float f32x2_t __attribute__((ext_vector_type(2))); typedef __bf16 bf16x2_t __attribute__((ext_vector_type(2)));
__device__ __forceinline__ unsigned pk2(float lo, float hi) { const f32x2_t v = {lo, hi}; const bf16x2_t b = __builtin_convertvector(v, bf16x2_t); return __builtin_bit_cast(unsigned, b); }
__device__ __forceinline__ unsigned f2bf(float f) { return pk2(f, 0.f) & 0xffffu; }
#define CYC() ((unsigned)__builtin_amdgcn_s_getreg((19 << 11) | 29))
__device__ __forceinline__ void lds_barrier() { asm volatile("s_waitcnt lgkmcnt(0)" ::: "memory"); __builtin_amdgcn_s_barrier(); asm volatile("" ::: "memory"); }
__device__ __forceinline__ float shx(float v, int mask, int lane) { return __int_as_float(__builtin_amdgcn_ds_bpermute((lane ^ mask) << 2, __float_as_int(v))); }
template <int CTRL> __device__ __forceinline__ float dppf0(float x) { return __int_as_float(__builtin_amdgcn_update_dpp(0, __float_as_int(x), CTRL, 0xF, 0xF, true)); }
__device__ __forceinline__ float wave_sum(float v, int lane) {
    v += dppf0<0xB1>(v); v += dppf0<0x4E>(v); v += dppf0<0x141>(v); v += dppf0<0x140>(v);
    v += shx(v, 16, lane); v += shx(v, 32, lane);
    return v;
}
__device__ __forceinline__ float softplus_f(float x) { return fmaxf(x, 0.f) + log1pf(expf(-fabsf(x))); }
__device__ __forceinline__ float logsigmoid_f(float x) { return fminf(x, 0.f) - log1pf(expf(-fabsf(x))); }
__device__ __forceinline__ float sigmoid_f(float x) { return 1.f / (1.f + expf(-x)); }
__device__ __forceinline__ float fexp(float x) { return __builtin_amdgcn_exp2f(x * 1.4426950408889634f); }
__device__ __forceinline__ float flog(float x) { return __builtin_amdgcn_logf(x) * 0.6931471805599453f; }
__device__ __forceinline__ float fsigmoid(float x) { return __builtin_amdgcn_rcpf(1.f + fexp(-x)); }
__device__ __forceinline__ float ftanh(float x) { return 2.f * fsigmoid(2.f * x) - 1.f; }
__device__ __forceinline__ float fsoftplus(float x) { return fmaxf(x, 0.f) + flog(1.f + fexp(-fabsf(x))); }
__device__ __forceinline__ float flogsigmoid(float x) { return fminf(x, 0.f) - flog(1.f + fexp(-fabsf(x))); }
template <int CTRL> __device__ __forceinline__ float dppf(float x) { return __int_as_float(__builtin_amdgcn_update_dpp(0, __float_as_int(x), CTRL, 0xF, 0xF, true)); }
__device__ __forceinline__ float red8(float x) {
    x += dppf<0xB1>(x); x += dppf<0x4E>(x); x += dppf<0x141>(x); return x;
}
__device__ __forceinline__ f32x4 mfma16(bf16x8 a, bf16x8 b, f32x4 c) { return __builtin_amdgcn_mfma_f32_16x16x32_bf16(a, b, c, 0, 0, 0); }
__device__ __forceinline__ unsigned ld_agent(const unsigned* p) { return __hip_atomic_load(p, __ATOMIC_RELAXED, __HIP_MEMORY_SCOPE_AGENT); }

#define XB_TMO      128
#define XB_XCNT(j)  (256  + 64 * (j))
#define XB_XSUB(j)  (1280 + 64 * (j))
#define XB_XGEN(j)  (2304 + 64 * (j))
#define XB_TOP      3328
#define XB_TOPGEN   3392
#define XCD_BAR_WORDS 3456
#define XB_SPIN_CAP (1u << 18)
__device__ __forceinline__ unsigned xb_ld(unsigned* p)              { return __hip_atomic_load(p, __ATOMIC_RELAXED, __HIP_MEMORY_SCOPE_AGENT); }
__device__ __forceinline__ unsigned xb_add(unsigned* p, unsigned v) { return __hip_atomic_fetch_add(p, v, __ATOMIC_RELAXED, __HIP_MEMORY_SCOPE_AGENT); }
__device__ __forceinline__ unsigned xb_xcc_id() { return (unsigned)__builtin_amdgcn_s_getreg((3 << 11) | 20) & 0xFu; }
#define XB_SPIN(cond, bar) do { unsigned _sp = 0; while (cond) { __builtin_amdgcn_s_sleep(1); \
    if ((++_sp & 255u) == 0u) { if (xb_ld(&(bar)[XB_TMO])) break; if (_sp > XB_SPIN_CAP) { atomicAdd(&(bar)[XB_TMO], 1u); break; } } } } while (0)
struct XcdBarrier { unsigned* bar; unsigned x; volatile LAS unsigned* st; };
__device__ __forceinline__ XcdBarrier xcd_barrier_post(unsigned* bar, volatile LAS unsigned* st, bool leader) {
    XcdBarrier b; b.bar = bar; b.x = xb_xcc_id(); b.st = st;
    if (leader) (void)xb_add(&bar[XB_XCNT(b.x)], 1u);
    return b;
}
__device__ __forceinline__ void xcd_barrier_complete(unsigned* bar, unsigned x, unsigned& nloc, unsigned& nx) {
    const unsigned G = gridDim.x * gridDim.y * gridDim.z;
    unsigned sum, cnt, mine, sp = 0u;
    for (;;) {
        sum = 0u; cnt = 0u; mine = 0u;
#pragma unroll
        for (unsigned j = 0; j < 16; ++j) { const unsigned c = xb_ld(&bar[XB_XCNT(j)]); sum += c; cnt += (c > 0u) ? 1u : 0u; mine = (j == x) ? c : mine; }
        if (sum == G) break;
        __builtin_amdgcn_s_sleep(1);
        if ((++sp & 255u) == 0u) { if (xb_ld(&bar[XB_TMO])) break; if (sp > XB_SPIN_CAP) { atomicAdd(&bar[XB_TMO], 1u); break; } }
    }
    nloc = mine > 0u ? mine : 1u; nx = cnt > 0u ? cnt : 1u;
}
__device__ __forceinline__ void xcd_barrier(const XcdBarrier& b, bool leader) {
    asm volatile("s_waitcnt vmcnt(0)" ::: "memory");
    __syncthreads();
    if (leader) {
        unsigned* bar = b.bar;
        __builtin_amdgcn_s_waitcnt(0);
        unsigned nloc = b.st[0], nx = b.st[1];
        if (nloc == 0u) { xcd_barrier_complete(bar, b.x, nloc, nx); b.st[0] = nloc; b.st[1] = nx; }
        const unsigned old = xb_add(&bar[XB_XSUB(b.x)], 1u);
        const unsigned gen = old / nloc;
        if (old + 1u == (gen + 1u) * nloc) {
            __builtin_amdgcn_fence(__ATOMIC_RELEASE, "agent");
            asm volatile("s_waitcnt vmcnt(0)" ::: "memory");
            const unsigned og = xb_add(&bar[XB_TOP], 1u);
            const unsigned tg = og / nx;
            if (og + 1u == (tg + 1u) * nx) xb_add(&bar[XB_TOPGEN], 1u);
            else XB_SPIN(xb_ld(&bar[XB_TOPGEN]) == tg, bar);
            __builtin_amdgcn_fence(__ATOMIC_ACQUIRE, "agent");
            xb_add(&bar[XB_XGEN(b.x)], 1u);
            asm volatile("s_waitcnt vmcnt(0)" ::: "memory");
        } else {
            XB_SPIN(xb_ld(&bar[XB_XGEN(b.x)]) == gen, bar);
            __builtin_amdgcn_fence(__ATOMIC_ACQUIRE, "agent");
            asm volatile("s_waitcnt vmcnt(0)" ::: "memory");
        }
    }
    __syncthreads();
}

struct Args { const float* in[30]; float* out; unsigned char* ws; };
enum { I_X = 0, I_META, I_LNIN_G, I_LNIN_B, I_WIN, I_GKW2, I_GKB, I_GNORM, I_MU, I_W0, I_W2, I_A0, I_A2, I_G2, I_KK, I_KA, I_RK, I_RLNG, I_RLNB, I_WOUT,
       I_LN1G, I_LN1B, I_RTW, I_RTB, I_WUP, I_BUP, I_WDN, I_BDN, I_LN2G, I_LN2B };
struct Frame { LAS unsigned char* lds; int tid, lane, wave, blk, G; };
__device__ __forceinline__ int lane_id() { int l; asm volatile("v_mbcnt_lo_u32_b32 %0, -1, 0\n\tv_mbcnt_hi_u32_b32 %0, -1, %0" : "=v"(l)); return l; }
__device__ __forceinline__ Frame mkframe(LAS unsigned char* lds, int wave) { Frame F; F.lds = lds; F.wave = wave; F.lane = lane_id(); F.tid = wave * 64 + F.lane; F.blk = blockIdx.x; F.G = gridDim.x; return F; }

__device__ __forceinline__ void transpose_item(const float* W, int K, int N, int nblk, bf16* WT, LAS float* scr, int item, int lane) {
    const int kb = item / nblk, nb = item - kb * nblk, k0 = 64 * kb, n0 = 32 * nb;
    const int nn = n0 + (lane & 31); const bool ok = nn < N;
#pragma unroll 8
    for (int i = 0; i < 32; ++i) { const int kk = 2 * i + (lane >> 5); scr[kk * 33 + (lane & 31)] = ok ? W[(size_t)(k0 + kk) * N + nn] : 0.f; }
    LDS_WAIT();
    const int c = lane & 7;
#pragma unroll
    for (int j = 0; j < 4; ++j) { const int n = (lane >> 3) + 8 * j; const LAS float* s = scr + (8 * c) * 33 + n;
        v4u o; o.x = pk2(s[0 * 33], s[1 * 33]); o.y = pk2(s[2 * 33], s[3 * 33]); o.z = pk2(s[4 * 33], s[5 * 33]); o.w = pk2(s[6 * 33], s[7 * 33]);
        *(v4u*)(WT + (size_t)(n0 + n) * K + k0 + 8 * c) = o; }
    LDS_WAIT();
}

__device__ __forceinline__ void transpose_item64_f8(const float* W, int K, int N, unsigned char* WT, float scale, LAS float* scr, int item, int lane) {
    const int nblk = N >> 6, kb = item / nblk, nb = item - kb * nblk, k0 = 64 * kb, n0 = 64 * nb;
    const int r4 = lane >> 4, c4 = lane & 15;
    f32x4 v[16];
#pragma unroll
    for (int i = 0; i < 16; ++i) v[i] = *(const f32x4*)(W + (size_t)(k0 + 4 * i + r4) * N + n0 + 4 * c4);
#pragma unroll
    for (int i = 0; i < 16; ++i) *(LAS f32x4*)(scr + (4 * i + r4) * 68 + 4 * c4) = v[i];
    LDS_WAIT();
    unsigned char* orow = WT + (size_t)(n0 + lane) * K + k0;
#pragma unroll
    for (int g = 0; g < 4; ++g) { const LAS float* s = scr + (16 * g) * 68 + lane; v4u o;
#pragma unroll
        for (int q = 0; q < 4; ++q) { int w = __builtin_amdgcn_cvt_pk_fp8_f32(s[(4 * q + 0) * 68] * scale, s[(4 * q + 1) * 68] * scale, 0, false);
            w = __builtin_amdgcn_cvt_pk_fp8_f32(s[(4 * q + 2) * 68] * scale, s[(4 * q + 3) * 68] * scale, w, true); o[q] = (unsigned)w; }
        *(v4u*)(orow + 16 * g) = o; }
    LDS_WAIT();
}
__device__ __forceinline__ void convert_expert_weights(const Args& a, const Frame& F, int qsel) {
    unsigned char* ws = a.ws;
    LAS float* scr = (LAS float*)(F.lds + F.wave * 17408);
    unsigned* QH = (unsigned*)(ws + WS_CTL) + CW_QH + 64 * qsel;
    constexpr int I_UP = 16 * 32, I_DN = 16 * 16, NIT = NE * (I_UP + I_DN);
    for (;;) {
        unsigned base = 0;
        if (F.lane == 0) base = __hip_atomic_fetch_add(QH, 8u, __ATOMIC_RELAXED, __HIP_MEMORY_SCOPE_AGENT);
        base = (unsigned)__builtin_amdgcn_readfirstlane((int)base);
        if (base >= (unsigned)NIT) break;
        for (int it = (int)base; it < (int)base + 8; ++it) {
            if (it < NE * I_UP) { const int e = it / I_UP, r = it - e * I_UP;
                transpose_item64_f8(a.in[I_WUP] + (size_t)e * D * 2048, D, 2048, ws + WS_WUP + (size_t)e * 2048 * D, 64.f, scr, r, F.lane); }
            else { const int it2 = it - NE * I_UP, e = it2 / I_DN, r = it2 - e * I_DN;
                transpose_item64_f8(a.in[I_WDN] + (size_t)e * D * D, D, D, ws + WS_WDN + (size_t)e * D * D, 128.f, scr, r, F.lane); }
        }
    }
}

__device__ __forceinline__ void phase0(const Args& a, const Frame& F) {
    unsigned char* ws = a.ws;
    const int gw = F.blk * NWAVES + F.wave, NGW = F.G * NWAVES;
    for (int cgp = F.blk; cgp < 53; cgp += F.G) {
        LAS float* HM = (LAS float*)F.lds;
        LAS float* PART = (LAS float*)(F.lds + 65536);
        for (int rr = 0; rr < 2; ++rr) {
            const int row = 2 * F.wave + rr; const f32x4* xr = (const f32x4*)(a.in[I_META] + row * D) + F.lane;
            f32x4 v[4]; float s = 0.f;
#pragma unroll
            for (int j = 0; j < 4; ++j) { v[j] = xr[64 * j]; s += (v[j].x + v[j].y) + (v[j].z + v[j].w); }
            const float mean = wave_sum(s, F.lane) * (1.f / D); float s2 = 0.f;
#pragma unroll
            for (int j = 0; j < 4; ++j) { v[j] = v[j] - mean; s2 += (v[j].x * v[j].x + v[j].y * v[j].y) + (v[j].z * v[j].z + v[j].w * v[j].w); }
            const float rstd = 1.f / sqrtf(wave_sum(s2, F.lane) * (1.f / D) + 1e-5f);
#pragma unroll
            for (int j = 0; j < 4; ++j) { const int col = 4 * (F.lane + 64 * j);
                const f32x4 gv = *(const f32x4*)(a.in[I_LNIN_G] + col), bv = *(const f32x4*)(a.in[I_LNIN_B] + col);
                const f32x4 y = v[j] * rstd * gv + bv;
                HM[(col + 0) * 16 + row] = y.x; HM[(col + 1) * 16 + row] = y.y; HM[(col + 2) * 16 + row] = y.z; HM[(col + 3) * 16 + row] = y.w; }
        }
        __syncthreads();
        const int col = cgp * 64 + F.lane; const bool ok = col < INW;
        float acc[16];
#pragma unroll
        for (int r = 0; r < 16; ++r) acc[r] = 0.f;
        const float* wp = a.in[I_WIN];
        for (int k = F.wave * 128; k < F.wave * 128 + 128; ++k) {
            const float wv = ok ? wp[(size_t)k * INW + col] : 0.f;
            const LAS f32x4* h = (const LAS f32x4*)(HM + k * 16);
#pragma unroll
            for (int q = 0; q < 4; ++q) { const f32x4 hv = h[q]; acc[4 * q + 0] += hv.x * wv; acc[4 * q + 1] += hv.y * wv; acc[4 * q + 2] += hv.z * wv; acc[4 * q + 3] += hv.w * wv; }
        }
#pragma unroll
        for (int r = 0; r < 16; ++r) PART[(F.wave * 16 + r) * 64 + F.lane] = acc[r];
        __syncthreads();
        bf16* PROJM = (bf16*)(ws + WS_PROJM);
        for (int o = F.tid; o < 1024; o += NTHR) { const int r = o >> 6, l = o & 63; float s = 0.f;
#pragma unroll
            for (int w = 0; w < 8; ++w) s += PART[(w * 16 + r) * 64 + l];
            PROJM[r * PW + cgp * 64 + l] = (bf16)f2bf(s); }
        if (F.tid < 64) PROJM[NMETA * PW + cgp * 64 + F.tid] = 0;
        __syncthreads();
    }
    {
        LAS float* scr = (LAS float*)(F.lds + F.wave * 16384);
        constexpr int I_IN = 16 * (PW / 32), I_OUT = 16 * 32;
        for (int it = gw; it < I_IN + I_OUT; it += NGW) {
            if (it < I_IN) transpose_item(a.in[I_WIN], D, INW, PW / 32, (bf16*)(ws + WS_WIN), scr, it, F.lane);
            else transpose_item(a.in[I_WOUT], D, D, 32, (bf16*)(ws + WS_WOUT), scr, it - I_IN, F.lane);
        }
    }
    {
        bf16* W2T = (bf16*)(ws + WS_W2T); bf16* A2T = (bf16*)(ws + WS_A2T); bf16* G2T = (bf16*)(ws + WS_G2T);
        for (int i = F.blk * NTHR + F.tid; i < 131072; i += F.G * NTHR) {
            if (i < 32768) { const int n = i >> 6, k = i & 63; W2T[i] = (bf16)f2bf(a.in[I_W2][k * 512 + n]); }
            else if (i < 65536) { const int j = i - 32768, n = j >> 6, k = j & 63; A2T[j] = (bf16)f2bf(a.in[I_A2][k * 512 + n]); }
            else { const int j = i - 65536, n = j >> 7, k = j & 127; G2T[j] = (bf16)f2bf(a.in[I_G2][k * 512 + n]); }
        }
    }
    {
        bf16* RWH = (bf16*)(ws + WS_RWH); bf16* RWL = (bf16*)(ws + WS_RWL);
        for (int i = F.blk * NTHR + F.tid; i < D * NE; i += F.G * NTHR) { const int c = i >> 5, e = i & 31; const float w = a.in[I_RTW][i];
            const unsigned hi = f2bf(w); const float lo = w - __uint_as_float(hi << 16);
            RWH[e * D + c] = (bf16)hi; RWL[e * D + c] = (bf16)f2bf(lo); }
    }
    {
        bf16* A0 = (bf16*)(ws + WS_A0); float* ST = (float*)(ws + WS_STATS);
        for (int m0 = gw; m0 < MX; m0 += 2 * NGW) {
            f32x4 v[2][4];
#pragma unroll
            for (int r = 0; r < 2; ++r) { const f32x4* xr = (const f32x4*)(a.in[I_X] + (size_t)(m0 + r * NGW) * D) + F.lane;
#pragma unroll
                for (int j = 0; j < 4; ++j) v[r][j] = xr[64 * j]; }
#pragma unroll
            for (int r = 0; r < 2; ++r) { const int m = m0 + r * NGW; float s = 0.f;
#pragma unroll
                for (int j = 0; j < 4; ++j) s += (v[r][j].x + v[r][j].y) + (v[r][j].z + v[r][j].w);
                const float mean = wave_sum(s, F.lane) * (1.f / D); float s2 = 0.f;
#pragma unroll
                for (int j = 0; j < 4; ++j) { v[r][j] = v[r][j] - mean; s2 += (v[r][j].x * v[r][j].x + v[r][j].y * v[r][j].y) + (v[r][j].z * v[r][j].z + v[r][j].w * v[r][j].w); }
                const float rstd = __builtin_amdgcn_rsqf(wave_sum(s2, F.lane) * (1.f / D) + 1e-5f);
#pragma unroll
                for (int j = 0; j < 4; ++j) { const int col = 4 * (F.lane + 64 * j);
                    const f32x4 gv = *(const f32x4*)(a.in[I_LNIN_G] + col), bv = *(const f32x4*)(a.in[I_LNIN_B] + col);
                    const f32x4 y = v[r][j] * rstd * gv + bv;
                    v2u o; o.x = pk2(y.x, y.y); o.y = pk2(y.z, y.w);
                    *(v2u*)(A0 + (size_t)m * D + col) = o; }
                if (F.lane == 0) { ST[2 * m] = mean; ST[2 * m + 1] = rstd; } }
        }
    }
    __syncthreads();
    for (int rep_ = 0; rep_ < NREP(14); ++rep_) convert_expert_weights(a, F, rep_);
}

__device__ __forceinline__ const bf16* prow(const bf16* PROJ, const bf16* PROJM, int b, int vp) {
    const bf16* px = PROJ + (size_t)(b * SEQ + (vp >= NMETA ? vp - NMETA : 0)) * PW;
    const bf16* pm = PROJM + (size_t)(vp < 0 ? NMETA : (vp < NMETA ? vp : 0)) * PW;
    return vp >= NMETA ? px : pm;
}
__device__ __forceinline__ f32x4 ldp4(const bf16* PROJ, const bf16* PROJM, int b, int vp, int col) {
    const v2u w = *(const v2u*)(prow(PROJ, PROJM, b, vp) + col);
    return (f32x4){bflo(w.x), bfhi(w.x), bflo(w.y), bfhi(w.y)};
}

constexpr int R1_STRIDE = 49152;
constexpr int TP = 80;
constexpr int L1_SLOT = 64 * TP * 2;
constexpr int L1_LC = 12 * L1_SLOT;
constexpr int L1_XCH = L1_LC + 64 * 65 * 4;
constexpr int L1_LR = 8 * L1_SLOT;
__device__ __forceinline__ v2u pack4(f32x4 v) { v2u o; o.x = pk2(v[0], v[1]); o.y = pk2(v[2], v[3]); return o; }
__device__ __forceinline__ f32x4 tile_mm(const LAS bf16* A, const LAS bf16* Bt, int rt, int ct, int fr, int fq, f32x4 acc) {
#pragma unroll
    for (int ks = 0; ks < 2; ++ks)
        acc = mfma16(*(const LAS bf16x8*)(Bt + (ct * 16 + fr) * TP + ks * 32 + 8 * fq), *(const LAS bf16x8*)(A + (rt * 16 + fr) * TP + ks * 32 + 8 * fq), acc);
    return acc;
}
__device__ __forceinline__ void tile_st(LAS bf16* O, int rt, int ct, int fr, int fq, f32x4 v) { *(LAS v2u*)(O + (rt * 16 + fr) * TP + ct * 16 + 4 * fq) = pack4(v); }
#define L1S(n) ((LAS bf16*)(F.lds + (n) * L1_SLOT))

struct L1Pf { v4u sa[5]; v2u r[2][2], k[2][2], v[2][2]; };
__device__ __forceinline__ void l1_fetch(const Args& a, const Frame& F, int b, int h, int c, L1Pf& pf, bool need_sa) {
    const bf16* PROJ = (const bf16*)(a.ws + WS_PROJ); const bf16* PROJM = (const bf16*)(a.ws + WS_PROJM);
    const int vp0 = (c == 0) ? -48 : NMETA + 64 * (c - 1);
    if (need_sa) { const int cg = F.tid & 31, tr = F.tid >> 5;
#pragma unroll
      for (int i = 0; i < 5; ++i) pf.sa[i] = *(const v4u*)(prow(PROJ, PROJM, b, vp0 + 4 * tr - 1 + i) + RWL + 8 * cg); }
    { const int rt = F.wave & 3, cp = F.wave >> 2, fr = F.lane & 15, fq = F.lane >> 4, vp = vp0 + rt * 16 + fr;
      const bf16* p0 = prow(PROJ, PROJM, b, vp - 1); const bf16* p1 = prow(PROJ, PROJM, b, vp);
#pragma unroll
      for (int cc = 0; cc < 2; ++cc) { const int jc = h * 64 + (2 * cp + cc) * 16 + 4 * fq;
          pf.r[cc][0] = *(const v2u*)(p0 + RR + jc); pf.r[cc][1] = *(const v2u*)(p1 + RR + jc);
          pf.k[cc][0] = *(const v2u*)(p0 + RK + jc); pf.k[cc][1] = *(const v2u*)(p1 + RK + jc);
          pf.v[cc][0] = *(const v2u*)(p0 + RV + jc); pf.v[cc][1] = *(const v2u*)(p1 + RV + jc); } }
}
__device__ __forceinline__ f32x4 unpk4(v2u w) { return (f32x4){bflo(w.x), bfhi(w.x), bflo(w.y), bfhi(w.y)}; }

__device__ __forceinline__ void rwkv_l1_front(const Args& a, const Frame& F, int b, int h, int c, const L1Pf& pf, f32x4 (&rtil)[2], bool newgrp, bf16x8 (&lrf)[8]) {
    unsigned char* ws = a.ws;
    const bf16* W2T = (const bf16*)(ws + WS_W2T); const bf16* A2T = (const bf16*)(ws + WS_A2T); const bf16* G2T = (const bf16*)(ws + WS_G2T);
    const int unit = (b * 8 + h) * NCH + c;
    unsigned char* r1 = ws + WS_R1 + (size_t)unit * R1_STRIDE;
    float* GAM = (float*)(ws + WS_GAM) + (size_t)unit * 64;
    const float* mu = a.in[I_MU];
    const int vp0 = (c == 0) ? -48 : NMETA + 64 * (c - 1);
    constexpr int LRP = 264;
    LAS bf16* LR = (LAS bf16*)(F.lds + L1_LR);
    LAS float* LC = (LAS float*)(F.lds + L1_LC);
    LAS float* XCH = (LAS float*)(F.lds + L1_XCH);
    const int rt = F.wave & 3, cp = F.wave >> 2, fr = F.lane & 15, fq = F.lane >> 4;
    if (newgrp) {
        const int cg = F.tid & 31, tr = F.tid >> 5;
        const f32x4 m0 = *(const f32x4*)(mu + 1536 + 8 * cg), m1 = *(const f32x4*)(mu + 1536 + 8 * cg + 4);
#pragma unroll
        for (int i = 0; i < 4; ++i) {
            const int row = 4 * tr + i;
            const v4u cw = pf.sa[i + 1], pw = pf.sa[i];
            const f32x4 c0 = unpk4((v2u){cw.x, cw.y}), c1 = unpk4((v2u){cw.z, cw.w}), p0 = unpk4((v2u){pw.x, pw.y}), p1 = unpk4((v2u){pw.z, pw.w});
            float v[8];
            v[0] = c0.x + (p0.x - c0.x) * m0.x; v[1] = c0.y + (p0.y - c0.y) * m0.y; v[2] = c0.z + (p0.z - c0.z) * m0.z; v[3] = c0.w + (p0.w - c0.w) * m0.w;
            v[4] = c1.x + (p1.x - c1.x) * m1.x; v[5] = c1.y + (p1.y - c1.y) * m1.y; v[6] = c1.z + (p1.z - c1.z) * m1.z; v[7] = c1.w + (p1.w - c1.w) * m1.w;
#pragma unroll
            for (int q = 0; q < 8; ++q) { if (cg < 8) v[q] = ftanh(v[q]); else if (cg >= 16) v[q] = fsigmoid(v[q]); }
            v4u o; o.x = pk2(v[0], v[1]); o.y = pk2(v[2], v[3]); o.z = pk2(v[4], v[5]); o.w = pk2(v[6], v[7]);
            *(LAS v4u*)(LR + row * LRP + 8 * cg) = o;
        }
    }
    const int t = rt * 16 + fr, vp = vp0 + t;
    const bool valid = vp >= 0;
    if (newgrp) { lds_barrier();
        const LAS bf16* lrow = LR + t * LRP + 8 * fq;
#pragma unroll
        for (int q = 0; q < 8; ++q) lrf[q] = *(const LAS bf16x8*)(lrow + q * 32); }
    float lwv[2][4], asg[2][4], kkr[2][4], kmd[2][4], rrv[2][4], vvv[2][4];
    float ssq = 0.f, bon = 0.f;
    {
#pragma unroll
        for (int cc = 0; cc < 2; ++cc) {
            const int ct = 2 * cp + cc, j = ct * 16 + 4 * fq, jc = h * 64 + j;
            f32x4 mr[2], mk[2], mv[2], w0v[2], a0v[2], kkw[2], kaw[2], rkw[2];
            mr[cc] = *(const f32x4*)(mu + jc); mk[cc] = *(const f32x4*)(mu + 512 + jc); mv[cc] = *(const f32x4*)(mu + 1024 + jc);
            w0v[cc] = *(const f32x4*)(a.in[I_W0] + jc); a0v[cc] = *(const f32x4*)(a.in[I_A0] + jc);
            kkw[cc] = *(const f32x4*)(a.in[I_KK] + jc); kaw[cc] = *(const f32x4*)(a.in[I_KA] + jc); rkw[cc] = *(const f32x4*)(a.in[I_RK] + jc);
            f32x4 aw = {0.f, 0.f, 0.f, 0.f}, aa = aw, ag = aw;
#pragma unroll
            for (int ks = 0; ks < 2; ++ks) {
                aw = mfma16(*(const bf16x8*)(W2T + (size_t)(h * 64 + ct * 16 + fr) * 64 + ks * 32 + 8 * fq), lrf[ks], aw);
                aa = mfma16(*(const bf16x8*)(A2T + (size_t)(h * 64 + ct * 16 + fr) * 64 + ks * 32 + 8 * fq), lrf[2 + ks], aa);
            }
#pragma unroll
            for (int ks = 0; ks < 4; ++ks) ag = mfma16(*(const bf16x8*)(G2T + (size_t)(h * 64 + ct * 16 + fr) * 128 + ks * 32 + 8 * fq), lrf[4 + ks], ag);
            const f32x4 rc = unpk4(pf.r[cc][1]), rp = unpk4(pf.r[cc][0]), kc = unpk4(pf.k[cc][1]), kp = unpk4(pf.k[cc][0]), vc = unpk4(pf.v[cc][1]), vpv = unpk4(pf.v[cc][0]);
            const f32x4 rs = rc + (rp - rc) * mr[cc], ks_ = kc + (kp - kc) * mk[cc], vs = vc + (vpv - vc) * mv[cc];
#pragma unroll
            for (int i = 0; i < 4; ++i) {
                const float u = w0v[cc][i] + aw[i];
                const float wl = -fsoftplus(-u) - 0.5f;
                lwv[cc][i] = valid ? -fexp(wl) : 0.f;
                const float as_ = fsigmoid(a0v[cc][i] + aa[i]);
                asg[cc][i] = as_;
                const float kraw = ks_[i], kk = kraw * kkw[cc][i];
                kkr[cc][i] = kk; ssq += kk * kk;
                const float km = kraw * (1.f + (as_ - 1.f) * kaw[cc][i]);
                kmd[cc][i] = km; rrv[cc][i] = rs[i]; vvv[cc][i] = vs[i];
                bon += rs[i] * km * rkw[cc][i];
            }
            *(v2u*)(r1 + 4 * 8192 + (size_t)(t * 64 + j) * 2) = pack4(ag);
            __builtin_amdgcn_sched_barrier(0);
        }
#pragma unroll
        for (int cc = 0; cc < 2; ++cc)
#pragma unroll
            for (int i = 0; i < 4; ++i) LC[t * 65 + (2 * cp + cc) * 16 + 4 * fq + i] = lwv[cc][i];
        ssq += shx(ssq, 16, F.lane); ssq += shx(ssq, 32, F.lane);
        bon += shx(bon, 16, F.lane); bon += shx(bon, 32, F.lane);
        if (fq == 0) { XCH[(cp * 64 + t) * 2] = ssq; XCH[(cp * 64 + t) * 2 + 1] = bon; }
    }
    lds_barrier();
    const float ssq_t = XCH[t * 2] + XCH[(64 + t) * 2], bon_t = XCH[t * 2 + 1] + XCH[(64 + t) * 2 + 1];
    const float inv = 1.f / fmaxf(sqrtf(ssq_t), 1e-12f);
    {
        LAS float* SEG = XCH + 256;
        const int jj = F.tid & 63, sg = F.tid >> 6;
        float cv[8];
#pragma unroll
        for (int i = 0; i < 8; ++i) cv[i] = LC[(sg * 8 + i) * 65 + jj];
#pragma unroll
        for (int i = 1; i < 8; ++i) cv[i] += cv[i - 1];
        SEG[sg * 64 + jj] = cv[7];
        lds_barrier();
        float pre = 0.f;
#pragma unroll
        for (int s2 = 0; s2 < 7; ++s2) pre += (s2 < sg) ? SEG[s2 * 64 + jj] : 0.f;
#pragma unroll
        for (int i = 0; i < 8; ++i) LC[(sg * 8 + i) * 65 + jj] = cv[i] + pre;
    }
    lds_barrier();
    {
#pragma unroll
        for (int cc = 0; cc < 2; ++cc) {
            const int j = (2 * cp + cc) * 16 + 4 * fq;
            f32x4 At, Bt, Kt, Bh, Kh, bvv;
#pragma unroll
            for (int i = 0; i < 4; ++i) {
                const float Lc = LC[t * 65 + j + i], LcC = LC[63 * 65 + j + i];
                const float kn = kkr[cc][i] * inv, av = -kn, bv = kn * asg[cc][i], km = kmd[cc][i];
                const float eA = fexp(Lc - lwv[cc][i]), eR = fexp(Lc), eB = fexp(-Lc), eH = fexp(LcC - Lc);
                At[i] = av * eA; rtil[cc][i] = rrv[cc][i] * eR; Bt[i] = bv * eB; Kt[i] = km * eB; Bh[i] = bv * eH; Kh[i] = km * eH;
                bvv[i] = bon_t * vvv[cc][i];
                if (t == 63) GAM[j + i] = fexp(LcC);
            }
            *(LAS v2u*)(L1S(0) + t * TP + j) = pack4(Bt); *(LAS v2u*)(L1S(1) + t * TP + j) = pack4(Kt);
            *(LAS v2u*)(L1S(2) + t * TP + j) = pack4(At); *(LAS v2u*)(L1S(3) + t * TP + j) = pack4(rtil[cc]);
#pragma unroll
            for (int i = 0; i < 4; ++i) {
                L1S(4)[(j + i) * TP + t] = (bf16)f2bf(At[i]); L1S(5)[(j + i) * TP + t] = (bf16)f2bf(Bh[i]);
                L1S(6)[(j + i) * TP + t] = (bf16)f2bf(Kh[i]); L1S(7)[(j + i) * TP + t] = (bf16)f2bf(vvv[cc][i]);
            }
            *(v2u*)(r1 + 5 * 8192 + (size_t)(t * 64 + j) * 2) = pack4(bvv);
        }
    }
    lds_barrier();
}
__device__ __forceinline__ void rwkv_l1_back(const Args& a, const Frame& F, int b, int h, int c, const f32x4 (&rtil)[2]) {
    unsigned char* r1 = a.ws + WS_R1 + (size_t)((b * 8 + h) * NCH + c) * R1_STRIDE;
    const int rt = F.wave & 3, cp = F.wave >> 2, fr = F.lane & 15, fq = F.lane >> 4;
    f32x4 Pt[2];
    const int mrow = rt * 16 + fr;
    const f32x4 z = {0.f, 0.f, 0.f, 0.f};
    {
        f32x4 Lv[2], Nv[2], Mv[2], Bv[2], Kv[2];
#pragma unroll
        for (int cc = 0; cc < 2; ++cc) { const int ct = 2 * cp + cc;
            Lv[cc] = tile_mm(L1S(2), L1S(0), rt, ct, fr, fq, z); Nv[cc] = tile_mm(L1S(0), L1S(2), rt, ct, fr, fq, z); Mv[cc] = tile_mm(L1S(2), L1S(1), rt, ct, fr, fq, z);
            Bv[cc] = tile_mm(L1S(3), L1S(0), rt, ct, fr, fq, z); Kv[cc] = tile_mm(L1S(3), L1S(1), rt, ct, fr, fq, z); }
#pragma unroll
        for (int cc = 0; cc < 2; ++cc) { const int ct = 2 * cp + cc, n0 = ct * 16 + 4 * fq;
#pragma unroll
            for (int i = 0; i < 4; ++i) { const int n = n0 + i;
                if (!(n < mrow)) { Lv[cc][i] = 0.f; Mv[cc][i] = 0.f; } if (!(mrow < n)) Nv[cc][i] = 0.f; if (!(n <= mrow)) { Bv[cc][i] = 0.f; Kv[cc][i] = 0.f; }
                Pt[cc][i] = Lv[cc][i] + ((n == mrow) ? 1.f : 0.f); }
            tile_st(L1S(8), rt, ct, fr, fq, Lv[cc]); tile_st(L1S(9), rt, ct, fr, fq, Nv[cc]); tile_st(L1S(10), rt, ct, fr, fq, Mv[cc]);
            tile_st(L1S(11), rt, ct, fr, fq, Bv[cc]); tile_st(L1S(12), rt, ct, fr, fq, Kv[cc]); }
    }
    lds_barrier();
    f32x4 Xv[2];
#pragma unroll
    for (int st = 1; st <= 6; ++st) {
        LAS bf16* Xl = (st & 1) ? L1S(8) : L1S(0); LAS bf16* Xn = (st & 1) ? L1S(9) : L1S(1);
        LAS bf16* Yl = (st & 1) ? L1S(0) : L1S(8); LAS bf16* Yn = (st & 1) ? L1S(1) : L1S(9);
        LAS bf16* Pr = (st & 1) ? L1S(2) : L1S(3); LAS bf16* Pw = (st & 1) ? L1S(3) : L1S(2);
        f32x4 l2[2], n2[2];
#pragma unroll
        for (int cc = 0; cc < 2; ++cc) { const int ct = 2 * cp + cc;
            if (st <= 5) { l2[cc] = tile_mm(Xl, Xn, rt, ct, fr, fq, z); n2[cc] = tile_mm(Xn, Xl, rt, ct, fr, fq, z); }
            if (st >= 2) Pt[cc] = tile_mm(Pr, Xn, rt, ct, fr, fq, Pt[cc]);
            if (st == 1) Xv[cc] = tile_mm(L1S(7), L1S(10), rt, ct, fr, fq, z); }
#pragma unroll
        for (int cc = 0; cc < 2; ++cc) { const int ct = 2 * cp + cc;
            if (st <= 5) { tile_st(Yl, rt, ct, fr, fq, l2[cc]); tile_st(Yn, rt, ct, fr, fq, n2[cc]); }
            tile_st(Pw, rt, ct, fr, fq, Pt[cc]); }
        if (st == 1) { lds_barrier();
#pragma unroll
            for (int cc = 0; cc < 2; ++cc) tile_st(L1S(10), rt, 2 * cp + cc, fr, fq, Xv[cc]); }
        lds_barrier();
    }
    {
        f32x4 u[2], w[2];
#pragma unroll
        for (int cc = 0; cc < 2; ++cc) { const int ct = 2 * cp + cc; u[cc] = tile_mm(L1S(10), L1S(2), rt, ct, fr, fq, z); w[cc] = tile_mm(L1S(4), L1S(2), rt, ct, fr, fq, z); }
#pragma unroll
        for (int cc = 0; cc < 2; ++cc) { const int ct = 2 * cp + cc; tile_st(L1S(8), rt, ct, fr, fq, u[cc]); tile_st(L1S(9), rt, ct, fr, fq, w[cc]); }
    }
    lds_barrier();
    {
#pragma unroll
        for (int cc = 0; cc < 2; ++cc) { const int ct = 2 * cp + cc; const size_t eo = (size_t)(mrow * 64 + ct * 16 + 4 * fq) * 2;
            const f32x4 gp = tile_mm(L1S(5), L1S(9), rt, ct, fr, fq, z);
            const f32x4 hh = tile_mm(L1S(7), L1S(6), rt, ct, fr, fq, tile_mm(L1S(8), L1S(5), rt, ct, fr, fq, z));
            const f32x4 rh = tile_mm(L1S(11), L1S(9), rt, ct, fr, fq, rtil[cc]);
            const f32x4 yl = tile_mm(L1S(12), L1S(7), rt, ct, fr, fq, tile_mm(L1S(11), L1S(8), rt, ct, fr, fq, z));
            *(v2u*)(r1 + 0 * 8192 + eo) = pack4(gp); *(v2u*)(r1 + 1 * 8192 + eo) = pack4(hh);
            *(v2u*)(r1 + 2 * 8192 + eo) = pack4(rh); *(v2u*)(r1 + 3 * 8192 + eo) = pack4(yl); }
    }
    lds_barrier();
}

constexpr int BCP = 65;
__device__ __forceinline__ void gla_bc(const Args& a, const Frame& F, int b, int h, int vp0, int ntok) {
    const bf16* PROJ = (const bf16*)(a.ws + WS_PROJ); const bf16* PROJM = (const bf16*)(a.ws + WS_PROJM);
    LAS float* GKLs = (LAS float*)F.lds; LAS float* BC = (LAS float*)(F.lds + 4096);
    if (F.tid < 256) { const int t = F.tid >> 2, q = F.tid & 3;
        const f32x4 v = ldp4(PROJ, PROJM, b, (t < ntok) ? vp0 + t : -1, GKL + 4 * q);
        *(LAS f32x4*)(GKLs + t * 16 + 4 * q) = v; }
    lds_barrier();
    {
        const int d = F.tid & 63, tg = F.tid >> 6;
        float wc[16];
#pragma unroll
        for (int r = 0; r < 16; ++r) wc[r] = a.in[I_GKW2][r * 256 + h * 64 + d];
        const float gb = a.in[I_GKB][h * 64 + d];
        float lgv[8];
#pragma unroll
        for (int i = 0; i < 8; ++i) { const int t = tg * 8 + i; float z = gb;
            const LAS f32x4* g4 = (const LAS f32x4*)(GKLs + t * 16);
#pragma unroll
            for (int q = 0; q < 4; ++q) { const f32x4 gv = g4[q]; z += gv.x * wc[4 * q] + gv.y * wc[4 * q + 1] + gv.z * wc[4 * q + 2] + gv.w * wc[4 * q + 3]; }
            lgv[i] = (t < ntok) ? flogsigmoid(z) * (1.f / 16.f) : 0.f; }
        LAS float* SEG = (LAS float*)(F.lds + 20736);
#pragma unroll
        for (int i = 1; i < 8; ++i) lgv[i] += lgv[i - 1];
        SEG[tg * 64 + d] = lgv[7];
        lds_barrier();
        float pre = 0.f;
#pragma unroll
        for (int s2 = 0; s2 < 7; ++s2) pre += (s2 < tg) ? SEG[s2 * 64 + d] : 0.f;
#pragma unroll
        for (int i = 0; i < 8; ++i) BC[(tg * 8 + i) * BCP + d] = lgv[i] + pre;
    }
    lds_barrier();
}

__device__ __forceinline__ void gla_g1_unit(const Args& a, const Frame& F, int b, int h, int c) {
    const bf16* PROJ = (const bf16*)(a.ws + WS_PROJ); const bf16* PROJM = (const bf16*)(a.ws + WS_PROJM);
    float* GUS = (float*)(a.ws + WS_GUS); float* DL = (float*)(a.ws + WS_DL);
    const int ntok = (c == 0) ? NMETA : 64, vp0 = (c == 0) ? 0 : NMETA + 64 * (c - 1);
    gla_bc(a, F, b, h, vp0, ntok);
    LAS float* BC = (LAS float*)(F.lds + 4096);
    LAS bf16* KT = (LAS bf16*)(F.lds + 24576);
    LAS bf16* VT = (LAS bf16*)(F.lds + 24576 + 64 * TP * 2);
    {
        const int t = F.tid >> 3, q = F.tid & 7;
        const float* bl = nullptr; (void)bl;
#pragma unroll
        for (int half = 0; half < 2; ++half) {
            const int d0 = 8 * q + 4 * half;
            const f32x4 kv = ldp4(PROJ, PROJM, b, (t < ntok) ? vp0 + t : -1, GK + h * 64 + d0);
#pragma unroll
            for (int i = 0; i < 4; ++i) { const int d = d0 + i; const float e = (t < ntok) ? fexp(BC[(ntok - 1) * BCP + d] - BC[t * BCP + d]) : 0.f;
                KT[d * TP + t] = (bf16)f2bf(kv[i] * e); }
        }
#pragma unroll
        for (int qq = 0; qq < 4; ++qq) {
            const int e0 = 16 * q + 4 * qq;
            const f32x4 vv = ldp4(PROJ, PROJM, b, (t < ntok) ? vp0 + t : -1, GV + h * 128 + e0);
#pragma unroll
            for (int i = 0; i < 4; ++i) VT[(e0 + i) * TP + t] = (bf16)f2bf(vv[i]);
        }
    }
    lds_barrier();
    {
        const int rt = F.wave & 3, ch = F.wave >> 2, fr = F.lane & 15, fq = F.lane >> 4;
        float* up = GUS + ((size_t)((b * 4 + h) * NCH + c) * 64 + rt * 16 + fr) * 128;
#pragma unroll
        for (int cc = 0; cc < 4; ++cc) { const int ct = ch * 4 + cc;
            f32x4 acc = {0.f, 0.f, 0.f, 0.f};
#pragma unroll
            for (int ks = 0; ks < 2; ++ks)
                acc = mfma16(*(const LAS bf16x8*)(VT + (ct * 16 + fr) * TP + ks * 32 + 8 * fq), *(const LAS bf16x8*)(KT + (rt * 16 + fr) * TP + ks * 32 + 8 * fq), acc);
            *(f32x4*)(up + ct * 16 + 4 * fq) = acc; }
        if (F.tid < 64) DL[(size_t)((b * 4 + h) * NCH + c) * 64 + F.tid] = fexp(BC[(ntok - 1) * BCP + F.tid]);
    }
    lds_barrier();
}

__device__ __forceinline__ void phase2(const Args& a, const Frame& F) {
    {
        constexpr int NU = NB * 8 * NCH;
        const int u0 = (int)((long)F.blk * NU / F.G), u1 = (int)((long)(F.blk + 1) * NU / F.G);
        L1Pf pf;
        bf16x8 lrf[8];
        if (u0 < u1) l1_fetch(a, F, (u0 >> 3) / NCH, u0 & 7, (u0 >> 3) % NCH, pf, true);
        unsigned long long tf_ = 0, tb_ = 0;
        for (int u = u0; u < u1; ++u) {
            const int h = u & 7, c = (u >> 3) % NCH, b = (u >> 3) / NCH; f32x4 rtil[2];
            const bool newgrp = (u == u0) || (h == 0);
            { const Frame F1 = mkframe(F.lds, F.wave); rwkv_l1_front(a, F1, b, h, c, pf, rtil, newgrp, lrf); }
            { const Frame F2 = mkframe(F.lds, F.wave);
              if (u + 1 < u1) l1_fetch(a, F2, ((u + 1) >> 3) / NCH, (u + 1) & 7, ((u + 1) >> 3) % NCH, pf, ((u + 1) & 7) == 0);
              rwkv_l1_back(a, F2, b, h, c, rtil); }
        }
        if ((REP_MASK >> 16) != 0) {
            const unsigned long long dt_ = ((REP_MASK >> 16) == 1) ? tf_ : tb_, s0_ = __builtin_amdgcn_s_memrealtime();
            while (__builtin_amdgcn_s_memrealtime() - s0_ < dt_) __builtin_amdgcn_s_sleep(8);
        }
    }
    for (int rep_ = 0; rep_ < NREP(12); ++rep_)
    for (int u = F.blk; u < NB * 4 * 32; u += F.G) { const int c = u & 31, bh = u >> 5; const Frame F1 = mkframe(F.lds, F.wave); gla_g1_unit(a, F1, bh >> 2, bh & 3, c); }
}

struct L2S { bf16x8 fg[4]; v2u hq[2]; f32x4 gm[2]; };
__device__ __forceinline__ void l2s_fetch(L2S& r, const unsigned char* hp, const unsigned char* gp, const float* gam) {
#pragma unroll
    for (int cc = 0; cc < 2; ++cc) { r.fg[2 * cc] = *(const bf16x8*)(gp + cc * 2048); r.fg[2 * cc + 1] = *(const bf16x8*)(gp + cc * 2048 + 64);
        r.hq[cc] = *(const v2u*)(hp + cc * 32); r.gm[cc] = *(const f32x4*)(gam + cc * 16); }
}
__device__ __forceinline__ void l2s_step(const L2S& r, const LAS bf16* Sc, LAS bf16* Sn, f32x4 (&Sm)[2], int row, int col0, int fq, bf16* gout, int tid) {
    {
        const int r_ = tid >> 3, c8 = tid & 7;
        *(v4u*)(gout + r_ * 64 + 8 * c8) = *(const LAS v4u*)(Sc + r_ * TP + 8 * c8);
    }
    const bf16x8 af0 = *(const LAS bf16x8*)(Sc + row * TP + 8 * fq), af1 = *(const LAS bf16x8*)(Sc + row * TP + 32 + 8 * fq);
#pragma unroll
    for (int cc = 0; cc < 2; ++cc) {
        f32x4 acc = {bflo(r.hq[cc].x), bfhi(r.hq[cc].x), bflo(r.hq[cc].y), bfhi(r.hq[cc].y)};
        acc = mfma16(r.fg[2 * cc], af0, acc);
        acc = mfma16(r.fg[2 * cc + 1], af1, acc);
        Sm[cc] = Sm[cc] * r.gm[cc] + acc; }
#pragma unroll
    for (int cc = 0; cc < 2; ++cc) *(LAS v2u*)(Sn + row * TP + col0 + cc * 16) = pack4(Sm[cc]);
}
__device__ __forceinline__ void rwkv_l2_unit(const Args& a, const Frame& F, int bh) {
    unsigned char* ws = a.ws;
    LAS bf16* Sb0 = (LAS bf16*)F.lds; LAS bf16* Sb1 = Sb0 + 64 * TP;
    const int fr = F.lane & 15, fq = F.lane >> 4, rt = F.wave & 3, cp = F.wave >> 2;
    const int row = rt * 16 + fr, col0 = cp * 32 + 4 * fq;
    const unsigned char* hpb = ws + WS_R1 + (size_t)bh * NCH * R1_STRIDE + 8192 + (size_t)(row * 64 + col0) * 2;
    const unsigned char* gpb = ws + WS_R1 + (size_t)bh * NCH * R1_STRIDE + (size_t)((cp * 32 + fr) * 64 + 8 * fq) * 2;
    const float* gamb = (const float*)(ws + WS_GAM) + (size_t)bh * NCH * 64 + col0;
    bf16* sst = (bf16*)(ws + WS_SST) + (size_t)bh * NCH * 4096;
    f32x4 Sm[2];
#pragma unroll
    for (int cc = 0; cc < 2; ++cc) { Sm[cc] = (f32x4){0.f, 0.f, 0.f, 0.f}; *(LAS v2u*)(Sb0 + row * TP + col0 + cc * 16) = (v2u){0u, 0u}; }
    L2S r0, r1, r2, r3;
#define L2F(rr, cn) l2s_fetch(rr, hpb + (size_t)(cn) * R1_STRIDE, gpb + (size_t)(cn) * R1_STRIDE, gamb + (size_t)(cn) * 64)
    L2F(r0, 0); L2F(r1, 1); L2F(r2, 2);
    lds_barrier();
#pragma nounroll
    for (int c = 0; c < NCH - 1; c += 4) {
        L2F(r3, c + 3);
        l2s_step(r0, Sb0, Sb1, Sm, row, col0, fq, sst + (size_t)c * 4096, F.tid); lds_barrier();
        if (c + 4 < NCH - 1) L2F(r0, c + 4);
        l2s_step(r1, Sb1, Sb0, Sm, row, col0, fq, sst + (size_t)(c + 1) * 4096, F.tid); lds_barrier();
        if (c + 5 < NCH - 1) L2F(r1, c + 5);
        l2s_step(r2, Sb0, Sb1, Sm, row, col0, fq, sst + (size_t)(c + 2) * 4096, F.tid); lds_barrier();
        if (c + 6 < NCH - 1) L2F(r2, c + 6);
        l2s_step(r3, Sb1, Sb0, Sm, row, col0, fq, sst + (size_t)(c + 3) * 4096, F.tid); lds_barrier();
    }
#undef L2F
    { const int r_ = F.tid >> 3, c8 = F.tid & 7;
      *(v4u*)(sst + (size_t)(NCH - 1) * 4096 + r_ * 64 + 8 * c8) = *(const LAS v4u*)(Sb0 + r_ * TP + 8 * c8); }
    lds_barrier();
}
__device__ __forceinline__ void rwkv_y_task(const Args& a, const Frame& F, int task) {
    unsigned char* ws = a.ws;
    const int c = 1 + (task & 31), bh = task >> 5, b = bh >> 3, h = bh & 7;
    const int fr = F.lane & 15, fq = F.lane >> 4;
    const bf16* Sg = (const bf16*)(ws + WS_SST) + (size_t)(bh * NCH + c) * 4096 + fr * 64 + 8 * fq;
    bf16x8 sf[8];
#pragma unroll
    for (int ct = 0; ct < 4; ++ct) { sf[2 * ct] = *(const bf16x8*)(Sg + ct * 1024); sf[2 * ct + 1] = *(const bf16x8*)(Sg + ct * 1024 + 32); }
    f32x4 lg[4], lb[4];
#pragma unroll
    for (int ct = 0; ct < 4; ++ct) { const int i0 = h * 64 + ct * 16 + 4 * fq; lg[ct] = *(const f32x4*)(a.in[I_RLNG] + i0); lb[ct] = *(const f32x4*)(a.in[I_RLNB] + i0); }
    LAS bf16* ost = (LAS bf16*)(F.lds + 102400 + F.wave * 2304);
    const unsigned char* r1u = ws + WS_R1 + (size_t)(bh * NCH + c) * R1_STRIDE + (size_t)(fr * 64 + 4 * fq) * 2;
    bf16x8 fa0[4], fa1[4]; v2u q0[4][4];
#pragma unroll
    for (int rt = 0; rt < 4; ++rt) { const unsigned char* r1 = r1u + rt * 2048;
        fa0[rt] = *(const bf16x8*)(r1 + 2 * 8192 + 8 * fq); fa1[rt] = *(const bf16x8*)(r1 + 2 * 8192 + 64 + 8 * fq);
#pragma unroll
        for (int ct = 0; ct < 4; ++ct) q0[rt][ct] = *(const v2u*)(r1 + 3 * 8192 + ct * 32); }
#pragma unroll
    for (int rt = 0; rt < 4; ++rt) {
        const unsigned char* r1 = r1u + rt * 2048;
        v2u q1[4], q2[4];
#pragma unroll
        for (int ct = 0; ct < 4; ++ct) { q1[ct] = *(const v2u*)(r1 + 4 * 8192 + ct * 32); q2[ct] = *(const v2u*)(r1 + 5 * 8192 + ct * 32); }
        f32x4 y[4]; float s = 0.f;
#pragma unroll
        for (int ct = 0; ct < 4; ++ct) {
            f32x4 acc = {bflo(q0[rt][ct].x), bfhi(q0[rt][ct].x), bflo(q0[rt][ct].y), bfhi(q0[rt][ct].y)};
            acc = mfma16(sf[2 * ct], fa0[rt], acc); acc = mfma16(sf[2 * ct + 1], fa1[rt], acc);
            y[ct] = acc; s += (acc[0] + acc[1]) + (acc[2] + acc[3]); }
        s += shx(s, 16, F.lane); s += shx(s, 32, F.lane);
        const float mean = s * (1.f / 64.f); float q = 0.f;
#pragma unroll
        for (int ct = 0; ct < 4; ++ct) { y[ct] = y[ct] - mean; q += (y[ct][0] * y[ct][0] + y[ct][1] * y[ct][1]) + (y[ct][2] * y[ct][2] + y[ct][3] * y[ct][3]); }
        q += shx(q, 16, F.lane); q += shx(q, 32, F.lane);
        const float rstd = __builtin_amdgcn_rsqf(q * (1.f / 64.f) + 64e-5f);
#pragma unroll
        for (int ct = 0; ct < 4; ++ct) {
            const f32x4 g = {bflo(q1[ct].x), bfhi(q1[ct].x), bflo(q1[ct].y), bfhi(q1[ct].y)}, bv = {bflo(q2[ct].x), bfhi(q2[ct].x), bflo(q2[ct].y), bfhi(q2[ct].y)};
            const f32x4 o = (y[ct] * rstd * lg[ct] + lb[ct] + bv) * g;
            *(LAS v2u*)(ost + fr * 72 + ct * 16 + 4 * fq) = pack4(o); }
        asm volatile("s_waitcnt lgkmcnt(0)" ::: "memory");
        bf16* yout = (bf16*)(ws + WS_YMIX) + ((size_t)b * SEQ + 64 * (c - 1) + rt * 16) * D + 512 + h * 64;
#pragma unroll
        for (int hh = 0; hh < 2; ++hh) { const int tr = (F.lane >> 3) + 8 * hh, c8 = F.lane & 7;
            *(v4u*)(yout + (size_t)tr * D + 8 * c8) = *(const LAS v4u*)(ost + tr * 72 + 8 * c8); }
        asm volatile("s_waitcnt lgkmcnt(0)" ::: "memory");
    }
}
__device__ __forceinline__ void gla_scan_unit(const Args& a, const Frame& F, int j) {
    float* GUS = (float*)(a.ws + WS_GUS); const float* DL = (const float*)(a.ws + WS_DL);
    const int bh = j >> 1, half = j & 1;
    const int d = 32 * half + (F.tid >> 4), e0 = (F.tid & 15) * 8;
    float* base = GUS + (size_t)bh * NCH * 8192 + d * 128 + e0;
    const float* dl = DL + (size_t)bh * NCH * 64 + d;
    f32x4 s0 = {0.f, 0.f, 0.f, 0.f}, s1 = s0;
    f32x4 ua[4], ub[4]; float dq[4];
#pragma unroll
    for (int q = 0; q < 3; ++q) { ua[q] = *(const f32x4*)(base + (size_t)q * 8192); ub[q] = *(const f32x4*)(base + (size_t)q * 8192 + 4); dq[q] = dl[q * 64]; }
#pragma unroll 4
    for (int c = 0; c < NCH - 1; ++c) {
        const int cn = (c + 3 < NCH - 1) ? c + 3 : NCH - 2;
        ua[(c + 3) & 3] = *(const f32x4*)(base + (size_t)cn * 8192); ub[(c + 3) & 3] = *(const f32x4*)(base + (size_t)cn * 8192 + 4); dq[(c + 3) & 3] = dl[cn * 64];
        *(f32x4*)(base + (size_t)c * 8192) = s0; *(f32x4*)(base + (size_t)c * 8192 + 4) = s1;
        s0 = s0 * dq[c & 3] + ua[c & 3]; s1 = s1 * dq[c & 3] + ub[c & 3];
    }
    *(f32x4*)(base + (size_t)(NCH - 1) * 8192) = s0; *(f32x4*)(base + (size_t)(NCH - 1) * 8192 + 4) = s1;
}
__device__ __forceinline__ void phase3(const Args& a, const Frame& F) {
    constexpr int PSEL = (REP_MASK >> 20) & 7;
    const unsigned long long t0_ = PSEL ? __builtin_amdgcn_s_memrealtime() : 0ull;
    for (int u = F.blk; u < 256; u += F.G) {
        if (u < 128) { for (int rep_ = 0; rep_ < NREP(3); ++rep_) rwkv_l2_unit(a, F, u); }
        else gla_scan_unit(a, F, u - 128);
    }
    if (PSEL) { const unsigned long long t1_ = __builtin_amdgcn_s_memrealtime();
        unsigned long long dt_ = 0;
        if (PSEL == 1 && F.blk < 128) dt_ = t1_ - t0_;
        if (PSEL == 2 && F.blk >= 128) dt_ = t1_ - t0_;
        while (__builtin_amdgcn_s_memrealtime() - t1_ < dt_) __builtin_amdgcn_s_sleep(8); }
}

__device__ __forceinline__ void gla_g3_unit(const Args& a, const Frame& F, int b, int h, int c) {
    const bf16* PROJ = (const bf16*)(a.ws + WS_PROJ); const bf16* PROJM = (const bf16*)(a.ws + WS_PROJM);
    const float* GUS = (const float*)(a.ws + WS_GUS); bf16* YMIX = (bf16*)(a.ws + WS_YMIX);
    const int vp0 = NMETA + 64 * (c - 1);
    gla_bc(a, F, b, h, vp0, 64);
    LAS float* BC = (LAS float*)(F.lds + 4096);
    LAS bf16* QT = (LAS bf16*)(F.lds + 24576);
    LAS bf16* KL = QT + 64 * TP;
    LAS bf16* AT = KL + 64 * TP;
    LAS bf16* VT = AT + 64 * TP;
    LAS bf16* ST = VT + 128 * TP;
    LAS float* RS = (LAS float*)(ST + 128 * TP);
    {
        const int t = F.tid >> 3, q = F.tid & 7;
        const f32x4 q0 = ldp4(PROJ, PROJM, b, vp0 + t, GQ + h * 64 + 8 * q), q1 = ldp4(PROJ, PROJM, b, vp0 + t, GQ + h * 64 + 8 * q + 4);
        const f32x4 k0 = ldp4(PROJ, PROJM, b, vp0 + t, GK + h * 64 + 8 * q), k1 = ldp4(PROJ, PROJM, b, vp0 + t, GK + h * 64 + 8 * q + 4);
        float qv[8] = {q0.x, q0.y, q0.z, q0.w, q1.x, q1.y, q1.z, q1.w}, kv[8] = {k0.x, k0.y, k0.z, k0.w, k1.x, k1.y, k1.z, k1.w};
#pragma unroll
        for (int i = 0; i < 8; ++i) { const float bcv = BC[t * BCP + 8 * q + i]; qv[i] *= fexp(bcv) * 0.125f; kv[i] *= fexp(-bcv); }
        v4u o; o.x = pk2(qv[0], qv[1]); o.y = pk2(qv[2], qv[3]); o.z = pk2(qv[4], qv[5]); o.w = pk2(qv[6], qv[7]);
        *(LAS v4u*)(QT + t * TP + 8 * q) = o;
        o.x = pk2(kv[0], kv[1]); o.y = pk2(kv[2], kv[3]); o.z = pk2(kv[4], kv[5]); o.w = pk2(kv[6], kv[7]);
        *(LAS v4u*)(KL + t * TP + 8 * q) = o;
#pragma unroll
        for (int qq = 0; qq < 4; ++qq) {
            const int e0 = 16 * q + 4 * qq;
            const f32x4 vv = ldp4(PROJ, PROJM, b, vp0 + t, GV + h * 128 + e0);
#pragma unroll
            for (int i = 0; i < 4; ++i) VT[(e0 + i) * TP + t] = (bf16)f2bf(vv[i]);
            const f32x4 sv = *(const f32x4*)(GUS + ((size_t)((b * 4 + h) * NCH + c) * 64 + t) * 128 + e0);
#pragma unroll
            for (int i = 0; i < 4; ++i) ST[(e0 + i) * TP + t] = (bf16)f2bf(sv[i]);
        }
    }
    lds_barrier();
    const int rt = F.wave & 3, wh = F.wave >> 2, fr = F.lane & 15, fq = F.lane >> 4;
    const int trow = rt * 16 + fr;
    {
        f32x4 av[2];
#pragma unroll
        for (int cc = 0; cc < 2; ++cc) { const int ct = 2 * wh + cc;
            f32x4 acc = {0.f, 0.f, 0.f, 0.f};
#pragma unroll
            for (int ks = 0; ks < 2; ++ks)
                acc = mfma16(*(const LAS bf16x8*)(KL + (ct * 16 + fr) * TP + ks * 32 + 8 * fq), *(const LAS bf16x8*)(QT + trow * TP + ks * 32 + 8 * fq), acc);
            const int s0 = ct * 16 + 4 * fq;
#pragma unroll
            for (int i = 0; i < 4; ++i) if (s0 + i > trow) acc[i] = 0.f;
            av[cc] = acc; }
#pragma unroll
        for (int cc = 0; cc < 2; ++cc) *(LAS v2u*)(AT + trow * TP + (2 * wh + cc) * 16 + 4 * fq) = pack4(av[cc]);
    }
    lds_barrier();
    f32x4 oacc[4]; float ssq = 0.f;
#pragma unroll
    for (int cc = 0; cc < 4; ++cc) { const int ct = wh * 4 + cc;
        f32x4 acc = {0.f, 0.f, 0.f, 0.f};
#pragma unroll
        for (int ks = 0; ks < 2; ++ks) {
            acc = mfma16(*(const LAS bf16x8*)(VT + (ct * 16 + fr) * TP + ks * 32 + 8 * fq), *(const LAS bf16x8*)(AT + trow * TP + ks * 32 + 8 * fq), acc);
            acc = mfma16(*(const LAS bf16x8*)(ST + (ct * 16 + fr) * TP + ks * 32 + 8 * fq), *(const LAS bf16x8*)(QT + trow * TP + ks * 32 + 8 * fq), acc);
        }
        oacc[cc] = acc; ssq += (acc[0] * acc[0] + acc[1] * acc[1]) + (acc[2] * acc[2] + acc[3] * acc[3]); }
    ssq += shx(ssq, 16, F.lane); ssq += shx(ssq, 32, F.lane);
    if (fq == 0) RS[wh * 64 + trow] = ssq;
    lds_barrier();
    {
        const float tot = RS[trow] + RS[64 + trow];
        const float rstd = 1.f / sqrtf(tot * (1.f / 128.f) + 1e-6f);
        const size_t m = (size_t)b * SEQ + (vp0 - NMETA) + trow;
#pragma unroll
        for (int cc = 0; cc < 4; ++cc) { const int e0 = (wh * 4 + cc) * 16 + 4 * fq;
            const f32x4 gv = ldp4(PROJ, PROJM, b, vp0 + trow, GG + h * 128 + e0);
            const f32x4 ng = *(const f32x4*)(a.in[I_GNORM] + e0);
            float y[4];
#pragma unroll
            for (int i = 0; i < 4; ++i) { const float gi = gv[i]; y[i] = oacc[cc][i] * rstd * ng[i] * (gi * fsigmoid(gi)); }
            v2u o; o.x = pk2(y[0], y[1]); o.y = pk2(y[2], y[3]);
            *(v2u*)(YMIX + m * D + h * 128 + e0) = o; }
    }
    lds_barrier();
}
__device__ __forceinline__ void phase4(const Args& a, const Frame& F) {
    for (int t = F.blk * NWAVES + F.wave; t < 128 * 32; t += F.G * NWAVES) { const Frame F1 = mkframe(F.lds, F.wave); rwkv_y_task(a, F1, t); }
    __syncthreads();
    for (int u = F.blk; u < NB * 4 * 32; u += F.G) { const int c = 1 + (u & 31), bh = u >> 5; const Frame F1 = mkframe(F.lds, F.wave); gla_g3_unit(a, F1, bh >> 2, bh & 3, c); }
}

__device__ __forceinline__ int eidx_of(int L) { return 16 * (L & 1) + 8 * ((L >> 1) & 1) + 4 * ((L >> 2) & 1) + 2 * ((L >> 3) & 1) + ((L >> 4) & 1); }
__device__ __forceinline__ void p6_ln(const Args& a, const Frame& F, int m, f32x4 (&v)[4], const f32x4 (&g1)[4], const f32x4 (&b1)[4]) {
    unsigned char* ws = a.ws; bf16* H1 = (bf16*)(ws + WS_H1);
    float s = 0.f;
#pragma unroll
    for (int j = 0; j < 4; ++j) s += (v[j].x + v[j].y) + (v[j].z + v[j].w);
    const float mean = wave_sum(s, F.lane) * (1.f / D); float s2 = 0.f;
#pragma unroll
    for (int j = 0; j < 4; ++j) { v[j] = v[j] - mean; s2 += (v[j].x * v[j].x + v[j].y * v[j].y) + (v[j].z * v[j].z + v[j].w * v[j].w); }
    const float rstd = __builtin_amdgcn_rsqf(wave_sum(s2, F.lane) * (1.f / D) + 1e-5f);
#pragma unroll
    for (int j = 0; j < 4; ++j) { const int col = 4 * (F.lane + 64 * j);
        v[j] = v[j] * rstd * g1[j] + b1[j];
        v2u o; o.x = pk2(v[j].x, v[j].y); o.y = pk2(v[j].z, v[j].w);
        *(v2u*)(H1 + (size_t)m * D + col) = o;
        int w8 = __builtin_amdgcn_cvt_pk_fp8_f32(v[j].x, v[j].y, 0, false); w8 = __builtin_amdgcn_cvt_pk_fp8_f32(v[j].z, v[j].w, w8, true);
        *(int*)(ws + WS_H1Q + (size_t)m * D + col) = w8; }
}
__device__ __forceinline__ void phase6(const Args& a, const Frame& F, int csel) {
    unsigned char* ws = a.ws;
    LAS float* LG = (LAS float*)(F.lds + F.wave * 2560);
    LAS int* hist = (LAS int*)(F.lds + 8 * 2560);
    bf16* H1 = (bf16*)(ws + WS_H1);
    const bf16* RWH = (const bf16*)(ws + WS_RWH); const bf16* RWL = (const bf16*)(ws + WS_RWL);
    int* TOPI = (int*)(ws + WS_TOPI); float* GATE = (float*)(ws + WS_GATE); int* RANK = (int*)(ws + WS_RANK);
    unsigned* CNT = (unsigned*)(ws + WS_CTL) + CW_CNT + 2048 * csel;
    for (int rb = F.blk; rb < MX / 128; rb += F.G) {
        if (F.tid < 64) hist[F.tid] = 0;
        __syncthreads();
        const int mb = rb * 128 + F.wave * 16; const Frame& Fo = F;
        {
            const f32x4* xr0 = (const f32x4*)(a.in[I_X] + (size_t)mb * D) + F.lane;
            const v2u* mr0 = (const v2u*)((const bf16*)(ws + WS_MIXB) + (size_t)mb * D) + F.lane;
            const float* st0 = (const float*)(ws + WS_STATS) + 2 * (size_t)mb;
            f32x4 va[4], vb[4], vc[4], vd[4]; v2u ma[4], mbv[4], mc[4], md[4]; float sa0, sa1, sb0, sb1, sc0, sc1, sd0, sd1;
#define P6_LOAD(vv, mmv, s0v, s1v, ii) do { _Pragma("unroll") for (int j = 0; j < 4; ++j) { vv[j] = xr0[(size_t)(ii) * (D / 4) + 64 * j]; mmv[j] = mr0[(size_t)(ii) * (D / 4) + 64 * j]; } s0v = st0[2 * (ii)]; s1v = st0[2 * (ii) + 1]; } while (0)
#define P6_FORM(vv, mmv, s0v, s1v) do { _Pragma("unroll") for (int j = 0; j < 4; ++j) vv[j] = ((vv[j] - s0v) * s1v) * gi[j] + bi[j] + unpk4(mmv[j]); } while (0)
            f32x4 gi[4], bi[4], g1[4], b1[4];
#pragma unroll
            for (int j = 0; j < 4; ++j) { const int col = 4 * (F.lane + 64 * j);
                gi[j] = *(const f32x4*)(a.in[I_LNIN_G] + col) * ALPHA; bi[j] = *(const f32x4*)(a.in[I_LNIN_B] + col) * ALPHA;
                g1[j] = *(const f32x4*)(a.in[I_LN1G] + col); b1[j] = *(const f32x4*)(a.in[I_LN1B] + col); }
            P6_LOAD(va, ma, sa0, sa1, 0); P6_LOAD(vb, mbv, sb0, sb1, 1);
#pragma nounroll
            for (int i = 0; i < 16; i += 4) {
                P6_LOAD(vc, mc, sc0, sc1, i + 2); P6_LOAD(vd, md, sd0, sd1, i + 3);
                P6_FORM(va, ma, sa0, sa1); P6_FORM(vb, mbv, sb0, sb1); p6_ln(a, F, mb + i, va, g1, b1); p6_ln(a, F, mb + i + 1, vb, g1, b1);
                if (i + 4 < 16) { P6_LOAD(va, ma, sa0, sa1, i + 4); P6_LOAD(vb, mbv, sb0, sb1, i + 5); }
                P6_FORM(vc, mc, sc0, sc1); P6_FORM(vd, md, sd0, sd1); p6_ln(a, F, mb + i + 2, vc, g1, b1); p6_ln(a, F, mb + i + 3, vd, g1, b1);
            }
#undef P6_LOAD
#undef P6_FORM
        }
        asm volatile("s_waitcnt vmcnt(0)" ::: "memory");
        {
            const int fr = F.lane & 15, fq = F.lane >> 4;
            const bf16* ap = H1 + (size_t)(mb + fr) * D + 8 * fq;
            const bf16* bh = RWH + (size_t)fr * D + 8 * fq; const bf16* bl = RWL + (size_t)fr * D + 8 * fq;
            f32x4 acc0 = {0.f, 0.f, 0.f, 0.f}, acc1 = acc0;
#pragma unroll 8
            for (int ks = 0; ks < 32; ++ks) { const bf16x8 af = *(const bf16x8*)(ap + ks * 32);
                acc0 = mfma16(*(const bf16x8*)(bh + ks * 32), af, acc0); acc0 = mfma16(*(const bf16x8*)(bl + ks * 32), af, acc0);
                acc1 = mfma16(*(const bf16x8*)(bh + 16 * D + ks * 32), af, acc1); acc1 = mfma16(*(const bf16x8*)(bl + 16 * D + ks * 32), af, acc1); }
            const f32x4 rb0 = *(const f32x4*)(a.in[I_RTB] + 4 * fq), rb1 = *(const f32x4*)(a.in[I_RTB] + 16 + 4 * fq);
#pragma unroll
            for (int q = 0; q < 4; ++q) { LG[fr * 33 + 4 * fq + q] = acc0[q] + rb0[q]; LG[fr * 33 + 16 + 4 * fq + q] = acc1[q] + rb1[q]; }
        }
        asm volatile("s_waitcnt lgkmcnt(0)" ::: "memory");
        LAS int* EK = (LAS int*)(LG + 528);
        if (F.lane < 16) {
            float lv[32];
#pragma unroll
            for (int e = 0; e < 32; ++e) lv[e] = LG[F.lane * 33 + e];
            int ek[4]; float lk[4];
#pragma unroll
            for (int k = 0; k < 4; ++k) { float best = -3.0e38f; int bi = 0;
#pragma unroll
                for (int e = 0; e < 32; ++e) { const bool tk = lv[e] > best; best = tk ? lv[e] : best; bi = tk ? e : bi; }
                ek[k] = bi; lk[k] = best;
#pragma unroll
                for (int e = 0; e < 32; ++e) lv[e] = (e == bi) ? -3.0e38f : lv[e]; }
            const float e1 = expf(lk[1] - lk[0]), e2 = expf(lk[2] - lk[0]), e3 = expf(lk[3] - lk[0]);
            const float inv = 1.f / (1.f + e1 + e2 + e3);
            const size_t m = (size_t)(mb + F.lane);
            *(i32x4g*)(TOPI + m * 4) = (i32x4g){ek[0], ek[1], ek[2], ek[3]};
            *(f32x4*)(GATE + m * 4) = (f32x4){inv, e1 * inv, e2 * inv, e3 * inv};
#pragma unroll
            for (int k = 0; k < 4; ++k) EK[F.lane * 4 + k] = ek[k];
        }
        asm volatile("s_waitcnt lgkmcnt(0)" ::: "memory");
        const int my_e = EK[F.lane];
        const int lrank = __hip_atomic_fetch_add(&hist[my_e], 1, __ATOMIC_RELAXED, __HIP_MEMORY_SCOPE_WORKGROUP);
        __syncthreads();
        if (F.tid < 32) hist[32 + F.tid] = (int)__hip_atomic_fetch_add(CNT + 64 * F.tid, (unsigned)hist[F.tid], __ATOMIC_RELAXED, __HIP_MEMORY_SCOPE_AGENT);
        __syncthreads();
        RANK[((size_t)rb * 128 + F.wave * 16 + (F.lane >> 2)) * 4 + (F.lane & 3)] = hist[32 + my_e] + lrank;
        __syncthreads();
    }
}

__device__ __forceinline__ void phase7(const Args& a, const Frame& F) {
    unsigned char* ws = a.ws;
    LAS int* starts = (LAS int*)F.lds;
    unsigned* CNT = (unsigned*)(ws + WS_CTL) + CW_CNT;
    int* TILEE = (int*)(ws + WS_TILEE); int* SLOTTOK = (int*)(ws + WS_SLOTTOK);
    if (F.tid < 32) { const int cnt = (int)ld_agent(CNT + 64 * F.tid); starts[64 + F.tid] = cnt; starts[32 + F.tid] = (cnt + 255) & ~255; }
    __syncthreads();
    if (F.tid == 0) { int run = 0; for (int e = 0; e < 32; ++e) { starts[e] = run; run += starts[32 + e]; }
        if (F.blk == 0) { TILEE[1023] = run >> 8; for (int e = 0; e < 32; ++e) for (int tl = starts[e] >> 8; tl < (starts[e] + starts[32 + e]) >> 8; ++tl) TILEE[tl] = e; } }
    __syncthreads();
    if (F.blk == 0) { for (int e = 0; e < 32; ++e) for (int s = starts[e] + starts[64 + e] + F.tid; s < starts[e] + starts[32 + e]; s += NTHR) SLOTTOK[s] = 0; }
    const int* TOPI = (const int*)(ws + WS_TOPI); const int* RANK = (const int*)(ws + WS_RANK); int* TSLOT = (int*)(ws + WS_TSLOT);
    for (int q = F.blk * NTHR + F.tid; q < MX * 4; q += F.G * NTHR) {
        const int slot = starts[TOPI[q]] + RANK[q];
        TSLOT[q] = slot; SLOTTOK[slot] = q >> 2;
    }
}
__device__ __forceinline__ int moe_fill_table(const Args& a, const Frame& F, int nN, int RM) {
    LAS int* tab = (LAS int*)(F.lds + TAB_OFF);
    const unsigned* TILEE = (const unsigned*)(a.ws + WS_TILEE);
    if (F.tid == 0) {
        const int NT = (int)ld_agent(TILEE + 1023);
        const int x = F.blk & 7, j = F.blk >> 3; int n = 0;
        for (int i = 0; i < 64; ++i) { const int s = i * 8 + x, pm = s * RM + j / nN; if (pm >= NT) break;
            const int e = (int)ld_agent(TILEE + pm); tab[2 * n] = pm; tab[2 * n + 1] = e * nN + (j % nN); ++n; }
        tab[128] = n;
    }
    __syncthreads();
    return __builtin_amdgcn_readfirstlane(tab[128]);
}

__device__ __forceinline__ void p10_acc(float (&s)[16], int j, const v4u w, float g) {
    s[8 * j + 0] += g * bflo(w.x); s[8 * j + 1] += g * bfhi(w.x); s[8 * j + 2] += g * bflo(w.y); s[8 * j + 3] += g * bfhi(w.y);
    s[8 * j + 4] += g * bflo(w.z); s[8 * j + 5] += g * bfhi(w.z); s[8 * j + 6] += g * bflo(w.w); s[8 * j + 7] += g * bfhi(w.w);
}
typedef float f32x2 __attribute__((ext_vector_type(2)));
__device__ __forceinline__ void p10_acc8(float (&s)[16], int j, const v2u w, float g) {
    const f32x2 a0 = __builtin_amdgcn_cvt_pk_f32_fp8((int)w.x, false), a1 = __builtin_amdgcn_cvt_pk_f32_fp8((int)w.x, true);
    const f32x2 a2 = __builtin_amdgcn_cvt_pk_f32_fp8((int)w.y, false), a3 = __builtin_amdgcn_cvt_pk_f32_fp8((int)w.y, true);
    s[8 * j + 0] += g * a0.x; s[8 * j + 1] += g * a0.y; s[8 * j + 2] += g * a1.x; s[8 * j + 3] += g * a1.y;
    s[8 * j + 4] += g * a2.x; s[8 * j + 5] += g * a2.y; s[8 * j + 6] += g * a3.x; s[8 * j + 7] += g * a3.y;
}
__device__ __forceinline__ void phase10(const Args& a, const Frame& F) {
    unsigned char* ws = a.ws;
    const bf16* H1 = (const bf16*)(ws + WS_H1); const unsigned char* YS = ws + WS_YS;
    const int* TSLOT = (const int*)(ws + WS_TSLOT); const float* GATE = (const float*)(ws + WS_GATE);
    const int gw = F.blk * NWAVES + F.wave, NGW = F.G * NWAVES;
    f32x4 gv[4], bv[4];
#pragma unroll
    for (int q = 0; q < 4; ++q) { const int col = 8 * F.lane + 512 * (q >> 1) + 4 * (q & 1); gv[q] = *(const f32x4*)(a.in[I_LN2G] + col); bv[q] = *(const f32x4*)(a.in[I_LN2B] + col); }
    for (int m0 = gw; m0 < MX; m0 += 2 * NGW) {
        int mm[2]; mm[0] = m0; mm[1] = (m0 + NGW < MX) ? m0 + NGW : m0;
        int slot[2][4]; float gt[2][4]; v4u hw[2][2]; v2u yw[2][4][2];
#pragma unroll
        for (int r = 0; r < 2; ++r) {
#pragma unroll
            for (int k = 0; k < 4; ++k) { slot[r][k] = TSLOT[(size_t)mm[r] * 4 + k]; gt[r][k] = GATE[(size_t)mm[r] * 4 + k]; }
#pragma unroll
            for (int j = 0; j < 2; ++j) hw[r][j] = *(const v4u*)(H1 + (size_t)mm[r] * D + 8 * F.lane + 512 * j); }
#pragma unroll
        for (int r = 0; r < 2; ++r)
#pragma unroll
            for (int k = 0; k < 4; ++k)
#pragma unroll
                for (int j = 0; j < 2; ++j) yw[r][k][j] = *(const v2u*)(YS + (size_t)slot[r][k] * D + 8 * F.lane + 512 * j);
#pragma unroll
        for (int r = 0; r < 2; ++r) {
            float s[16];
#pragma unroll
            for (int i = 0; i < 16; ++i) s[i] = 0.f;
#pragma unroll
            for (int j = 0; j < 2; ++j) p10_acc(s, j, hw[r][j], ALPHA);
#pragma unroll
            for (int k = 0; k < 4; ++k)
#pragma unroll
                for (int j = 0; j < 2; ++j) p10_acc8(s, j, yw[r][k][j], gt[r][k]);
            float t = 0.f;
#pragma unroll
            for (int i = 0; i < 16; ++i) t += s[i];
            const float mean = wave_sum(t, F.lane) * (1.f / D); float q = 0.f;
#pragma unroll
            for (int i = 0; i < 16; ++i) { s[i] -= mean; q += s[i] * s[i]; }
            const float rstd = __builtin_amdgcn_rsqf(wave_sum(q, F.lane) * (1.f / D) + 1e-5f);
            if (r == 0 || mm[1] != mm[0]) {
#pragma unroll
                for (int q4 = 0; q4 < 4; ++q4) { const int col = 8 * F.lane + 512 * (q4 >> 1) + 4 * (q4 & 1);
                    f32x4 o; o.x = s[4 * q4 + 0] * rstd * gv[q4].x + bv[q4].x; o.y = s[4 * q4 + 1] * rstd * gv[q4].y + bv[q4].y; o.z = s[4 * q4 + 2] * rstd * gv[q4].z + bv[q4].z; o.w = s[4 * q4 + 3] * rstd * gv[q4].w + bv[q4].w;
                    *(f32x4*)(a.out + (size_t)mm[r] * D + col) = o; } }
        }
    }
}

template <int LO, int HI>
__global__ void __launch_bounds__(NTHR, 2) fwd(Args a) {
    extern __shared__ __attribute__((aligned(16))) unsigned char lds_raw[];
    LAS unsigned char* lds = (LAS unsigned char*)lds_raw;
    const int wave = __builtin_amdgcn_readfirstlane((int)(threadIdx.x >> 6));
    volatile LAS unsigned* MISC = (volatile LAS unsigned*)(lds + MISC_OFF);
    if (wave == 0) MISC[lane_id()] = 0u;
    __syncthreads();
    unsigned* ctl = (unsigned*)(a.ws + WS_CTL);
    XcdBarrier bar; bar.bar = ctl + CW_BAR; bar.x = 0; bar.st = nullptr;
    if constexpr (HI - LO > 1) bar = xcd_barrier_post(ctl + CW_BAR, MISC + 8, wave == 0 && lane_id() == 0);
#define PH(k) if constexpr (LO <= (k) && (k) < HI)
#define SEAM(k) if constexpr (LO <= (k) && (k) + 1 < HI) xcd_barrier(bar, wave == 0 && lane_id() == 0)
    PH(0) for (int rep_ = 0; rep_ < NREP(0); ++rep_) { const Frame F = mkframe(lds, wave); phase0(a, F); } SEAM(0);
    PH(1) for (int rep_ = 0; rep_ < NREP(1); ++rep_) { const Frame F = mkframe(lds, wave);
            pg8::Gemm g{(const pg8::bf16_t*)(a.ws + WS_A0), (const pg8::bf16_t*)(a.ws + WS_WIN), MX, PW, D}; pg8::StaticOrder S; S.init(MX, PW, F.G, F.blk);
            pg8::EpiBf16Plain E{(pg8::bf16_t*)(a.ws + WS_PROJ), PW};
            pg8::gemm_phase<pg8::EpiBf16Plain, pg8::StaticOrder, true, true>(F.lds, g, S, E, F.tid); } SEAM(1);
    PH(2) for (int rep_ = 0; rep_ < NREP(2); ++rep_) { const Frame F = mkframe(lds, wave); phase2(a, F); } SEAM(2);
    PH(3) { const Frame F = mkframe(lds, wave); phase3(a, F); } SEAM(3);
    PH(4) for (int rep_ = 0; rep_ < NREP(4); ++rep_) { const Frame F = mkframe(lds, wave); phase4(a, F); } SEAM(4);
    PH(5) for (int rep_ = 0; rep_ < NREP(5); ++rep_) { const Frame F = mkframe(lds, wave);
            pg8::Gemm g{(const pg8::bf16_t*)(a.ws + WS_YMIX), (const pg8::bf16_t*)(a.ws + WS_WOUT), MX, D, D}; pg8::StaticOrder S; S.init(MX, D, F.G, F.blk);
            pg8::EpiBf16Plain E{(pg8::bf16_t*)(a.ws + WS_MIXB), D};
            pg8::gemm_phase<pg8::EpiBf16Plain, pg8::StaticOrder, true, true>(F.lds, g, S, E, F.tid); } SEAM(5);
    PH(6) for (int rep_ = 0; rep_ < NREP(6); ++rep_) { const Frame F = mkframe(lds, wave); phase6(a, F, rep_); } SEAM(6);
    PH(7) for (int rep_ = 0; rep_ < NREP(7); ++rep_) { const Frame F = mkframe(lds, wave); phase7(a, F); } SEAM(7);
    PH(8) for (int rep_ = 0; rep_ < NREP(8); ++rep_) { const Frame F = mkframe(lds, wave); const int n = moe_fill_table(a, F, 8, 4);
            pg8::Gemm g{(const pg8::bf16_t*)(a.ws + WS_H1Q), (const pg8::bf16_t*)(a.ws + WS_WUP), 0, 0, D / 2}; pg8::TableOrder S{(const LAS int*)(F.lds + TAB_OFF), n};
            pg8::EpiSwiglu8 E{a.ws + WS_ACT, a.in[I_BUP]};
            pg8::gemm_phase_g<pg8::EpiSwiglu8, pg8::TableOrder, true, true, 121>(F.lds, g, S, E, F.tid, (const int*)(a.ws + WS_SLOTTOK)); } SEAM(8);
    PH(9) for (int rep_ = 0; rep_ < NREP(9); ++rep_) { const Frame F = mkframe(lds, wave); const int n = moe_fill_table(a, F, 4, 8);
            pg8::Gemm g{(const pg8::bf16_t*)(a.ws + WS_ACT), (const pg8::bf16_t*)(a.ws + WS_WDN), 0, 0, D / 2}; pg8::TableOrder S{(const LAS int*)(F.lds + TAB_OFF), n};
            pg8::EpiDown8 E{a.ws + WS_YS, a.in[I_BDN]};
            pg8::gemm_phase<pg8::EpiDown8, pg8::TableOrder, true, true, 120>(F.lds, g, S, E, F.tid); } SEAM(9);
    PH(10) for (int rep_ = 0; rep_ < NREP(10); ++rep_) { const Frame F = mkframe(lds, wave); phase10(a, F); }
#undef PH
#undef SEAM
}

#ifndef MK_SINGLE
#define MK_SINGLE 1
#endif
template <int LO, int HI> static void launch_range(const Args& a, int grid, hipStream_t stream) {
    static bool attr = false;
    if (!attr) { (void)hipFuncSetAttribute((const void*)fwd<LO, HI>, hipFuncAttributeMaxDynamicSharedMemorySize, LDS_BYTES); attr = true; }
    hipLaunchKernelGGL((fwd<LO, HI>), dim3(grid), dim3(NTHR), LDS_BYTES, stream, a);
}
extern "C" void kernel_launch(void* const* d_in, const int* in_sizes, int n_in, void* d_out, int out_size, void* d_ws, size_t ws_size, hipStream_t stream) {
    if (n_in != 30 || ws_size < WS_END) { fprintf(stderr, "kernel_launch: unexpected inputs (n_in %d, ws %zu)\n", n_in, ws_size); return; }
    const int grid = 256;
    (void)hipMemsetAsync((char*)d_ws + WS_CTL, 0, CTL_ZERO_BYTES, stream);
    Args a{};
    for (int i = 0; i < 30; ++i) a.in[i] = (const float*)d_in[i];
    a.out = (float*)d_out; a.ws = (unsigned char*)d_ws;
#if MK_SINGLE
    launch_range<0, 11>(a, grid, stream);
#else
    launch_range<0, 1>(a, grid, stream); launch_range<1, 2>(a, grid, stream); launch_range<2, 3>(a, grid, stream); launch_range<3, 4>(a, grid, stream);
    launch_range<4, 5>(a, grid, stream); launch_range<5, 6>(a, grid, stream); launch_range<6, 7>(a, grid, stream); launch_range<7, 8>(a, grid, stream);
    launch_range<8, 9>(a, grid, stream); launch_range<9, 10>(a, grid, stream); launch_range<10, 11>(a, grid, stream);
#endif
}
```

```cpp
#include <hip/hip_runtime.h>
#include <cstdio>
#include <cstdint>
#include <cmath>
namespace pg8 {
#define PG8_LAS __attribute__((address_space(3)))
typedef unsigned short bf16_t;
typedef short bf16x8 __attribute__((ext_vector_type(8)));
typedef float f32x4 __attribute__((ext_vector_type(4)));
typedef unsigned u32x4 __attribute__((ext_vector_type(4)));
constexpr int BM = 256, BK = 64, HALF = 128, HTB = HALF * BK * 2  , STAGE_BYTES = 8 * HTB, NXCD = 8, WGM = 8;

__host__ __device__ __forceinline__ int lds_byte(int r, int c) { const int st = (r >> 4) * 2 + (c >> 5), rr = r & 15, cc = c & 31, ob = rr * 64 + cc * 2; return st * 1024 + (ob ^ (((ob >> 9) & 1) << 5)); }
__host__ __device__ __forceinline__ void stage_rc(int b, int& R, int& C) { const int st = b / 1024, sb = b % 1024, swz = sb ^ (((sb >> 9) & 1) << 5); R = (st >> 1) * 16 + swz / 64; C = (st & 1) * 32 + (swz % 64) / 2; }
__host__ __device__ __forceinline__ int perm32(int rho) { const int n = rho >> 4, i = rho & 15; return 8 * (i >> 2) + 4 * n + (i & 3); }

struct Unit { int pm, pn; };
struct Gemm { const bf16_t* A; const bf16_t* Bt; int M, N, K; };

struct StaticOrder {
    int nM, nN, nwg, G, c;
    __host__ __device__ void init(int M, int N, int G_, int c_) { nM = M / BM; nN = N / BM; nwg = nM * nN; G = G_; c = c_; }
    __host__ __device__ bool next(int i, Unit& u) const {
        const long L = (long)i * G + c; if (L >= nwg) return false;
        int wgid = (int)L; { const int q = nwg / NXCD, r = nwg % NXCD, xcd = wgid % NXCD, off = wgid / NXCD; wgid = (xcd < r ? xcd * (q + 1) : r * (q + 1) + (xcd - r) * q) + off; }
        const int nig = WGM * nN, gid = wgid / nig, fm = gid * WGM, gsz = (nM - fm) < WGM ? (nM - fm) : WGM;
        u.pm = fm + ((wgid % nig) % gsz); u.pn = (wgid % nig) / gsz; return true;
    }
    __device__ __forceinline__ void a_ready(const Unit&) const {}
    __device__ __forceinline__ void done(const Unit&) const {}
};


__device__ __forceinline__ unsigned cvt_pk_bf16(float lo, float hi) { unsigned r; asm volatile("v_cvt_pk_bf16_f32 %0, %1, %2" : "=v"(r) : "v"(lo), "v"(hi)); return r; }
typedef unsigned u32x2 __attribute__((ext_vector_type(2)));
typedef int i32x8 __attribute__((ext_vector_type(8))); typedef int i32x4 __attribute__((ext_vector_type(4)));
__device__ __forceinline__ void mfma_f8(f32x4& acc, i32x8 a, i32x8 b, int sa, int sb) {
    asm volatile("s_nop 1\n\tv_mfma_scale_f32_16x16x128_f8f6f4 %0, %1, %2, %0, %3, %4 op_sel_hi:[0,0,0]" : "+v"(acc) : "v"(a), "v"(b), "v"(sa), "v"(sb));
}
__device__ __forceinline__ i32x8 cat8(bf16x8 lo, bf16x8 hi) { const i32x4 a = __builtin_bit_cast(i32x4, lo), b = __builtin_bit_cast(i32x4, hi); return __builtin_shufflevector(a, b, 0, 1, 2, 3, 4, 5, 6, 7); }

struct EpiBf16Plain {
    static constexpr bool PERM = true, AFTER_DRAIN = false, HAS_BIAS = false;
    bf16_t* O; int ldc;
    __device__ __forceinline__ const float* bias_ptr(const Unit&) const { return nullptr; }
    __device__ __forceinline__ void operator()(const f32x4 (&acc)[2][2][4][2], const Unit& u, int wr, int wc, int fr, int fq, const PG8_LAS float*) const {
        const int row0 = u.pm * BM + wr * 64 + fr, col0 = u.pn * BM + wc * 32 + 8 * fq;
#pragma unroll
        for (int ai = 0; ai < 2; ++ai)
#pragma unroll
            for (int m = 0; m < 4; ++m) { bf16_t* rowp = O + (size_t)(row0 + ai * HALF + m * 16) * ldc + col0;
#pragma unroll
                for (int bj = 0; bj < 2; ++bj) { const f32x4 v0 = acc[ai][bj][m][0], v1 = acc[ai][bj][m][1];
                    u32x4 w; w.x = cvt_pk_bf16(v0[0], v0[1]); w.y = cvt_pk_bf16(v0[2], v0[3]); w.z = cvt_pk_bf16(v1[0], v1[1]); w.w = cvt_pk_bf16(v1[2], v1[3]);
                    *(u32x4*)(rowp + bj * HALF) = w; } }
    }
};

__device__ __forceinline__ float swiglu1(float glu, float lin) {
    const float xg = fminf(glu, 7.0f), xl = fminf(fmaxf(lin, -7.0f), 7.0f);
    const float sg = __builtin_amdgcn_rcpf(1.0f + __expf(-1.702f * xg));
    return xg * sg * (xl + 1.0f);
}
struct EpiSwiglu8 {
    static constexpr bool PERM = true, AFTER_DRAIN = false, HAS_BIAS = true;
    unsigned char* ACT; const float* bup;
    __device__ __forceinline__ const float* bias_ptr(const Unit& u) const { return bup + (size_t)(u.pn >> 3) * 2048 + (u.pn & 7) * BM; }
    __device__ __forceinline__ void operator()(const f32x4 (&acc)[2][2][4][2], const Unit& u, int wr, int wc, int fr, int fq, const PG8_LAS float* bl) const {
        const int pn = u.pn & 7;
        const int row0 = u.pm * BM + wr * 64 + fr, ucol0 = pn * BM + wc * 32 + 8 * fq, acol0 = ucol0 >> 1;
        f32x4 bv[2][2];
#pragma unroll
        for (int bj = 0; bj < 2; ++bj)
#pragma unroll
            for (int n = 0; n < 2; ++n) bv[bj][n] = *(const PG8_LAS f32x4*)(bl + wc * 32 + 8 * fq + bj * HALF + 4 * n);
#pragma unroll
        for (int ai = 0; ai < 2; ++ai)
#pragma unroll
            for (int m = 0; m < 4; ++m) { unsigned char* rowp = ACT + (size_t)(row0 + ai * HALF + m * 16) * 1024 + acol0;
#pragma unroll
                for (int bj = 0; bj < 2; ++bj) { const f32x4 v0 = acc[ai][bj][m][0] + bv[bj][0], v1 = acc[ai][bj][m][1] + bv[bj][1];
                    int w = __builtin_amdgcn_cvt_pk_fp8_f32(swiglu1(v0[0], v0[1]), swiglu1(v0[2], v0[3]), 0, false);
                    w = __builtin_amdgcn_cvt_pk_fp8_f32(swiglu1(v1[0], v1[1]), swiglu1(v1[2], v1[3]), w, true);
                    *(int*)(rowp + bj * (HALF / 2)) = w; } }
    }
};
struct EpiDown8 {
    static constexpr bool PERM = true, AFTER_DRAIN = false, HAS_BIAS = true;
    unsigned char* YS; const float* bdn;
    __device__ __forceinline__ const float* bias_ptr(const Unit& u) const { return bdn + (size_t)(u.pn >> 2) * 1024 + (u.pn & 3) * BM; }
    __device__ __forceinline__ void operator()(const f32x4 (&acc)[2][2][4][2], const Unit& u, int wr, int wc, int fr, int fq, const PG8_LAS float* bl) const {
        const int pn = u.pn & 3;
        const int row0 = u.pm * BM + wr * 64 + fr, col0 = pn * BM + wc * 32 + 8 * fq;
        f32x4 bv[2][2];
#pragma unroll
        for (int bj = 0; bj < 2; ++bj)
#pragma unroll
            for (int n = 0; n < 2; ++n) bv[bj][n] = *(const PG8_LAS f32x4*)(bl + wc * 32 + 8 * fq + bj * HALF + 4 * n);
#pragma unroll
        for (int ai = 0; ai < 2; ++ai)
#pragma unroll
            for (int m = 0; m < 4; ++m) { unsigned char* rowp = YS + (size_t)(row0 + ai * HALF + m * 16) * 1024 + col0;
#pragma unroll
                for (int bj = 0; bj < 2; ++bj) { const f32x4 v0 = acc[ai][bj][m][0] + bv[bj][0], v1 = acc[ai][bj][m][1] + bv[bj][1];
                    int w0 = __builtin_amdgcn_cvt_pk_fp8_f32(v0[0], v0[1], 0, false); w0 = __builtin_amdgcn_cvt_pk_fp8_f32(v0[2], v0[3], w0, true);
                    int w1 = __builtin_amdgcn_cvt_pk_fp8_f32(v1[0], v1[1], 0, false); w1 = __builtin_amdgcn_cvt_pk_fp8_f32(v1[2], v1[3], w1, true);
                    u32x2 w; w.x = (unsigned)w0; w.y = (unsigned)w1;
                    *(u32x2*)(rowp + bj * HALF) = w; } }
    }
};
struct TableOrder {
    const PG8_LAS int* tab; int n;
    __device__ __forceinline__ bool next(int i, Unit& u) const {
        if (i >= n) return false;
        u.pm = __builtin_amdgcn_readfirstlane(tab[2 * i]); u.pn = __builtin_amdgcn_readfirstlane(tab[2 * i + 1]); return true;
    }
    __device__ __forceinline__ void a_ready(const Unit&) const {}
    __device__ __forceinline__ void done(const Unit&) const {}
};

constexpr int ROWS_LDS = 131072;
constexpr int BIAS_LDS = 133120;
template <class Epi, class Sched, bool ALIGN_EPI = false, bool SP2 = false, int SCW = 0>
__device__ __forceinline__ void gemm_phase(PG8_LAS unsigned char* lds, const Gemm g, const Sched& S, const Epi& E, const int tid) {
    static_assert(SP2, "two-super-phase form only");
    const int wid = __builtin_amdgcn_readfirstlane(tid >> 6), lane = tid & 63, wr = wid >> 2, wc = wid & 3, fr = lane & 15, fq = lane >> 4;
    int K_ = g.K; asm volatile("" : "+s"(K_));
    const int K = K_, nt = K / BK;
    constexpr int EXTRA = 16 + (Epi::HAS_BIAS ? 1 : 0);
    unsigned voffA[2], voffB[2];
#pragma unroll
    for (int i = 0; i < 2; ++i) { int R, C; stage_rc(tid * 16 + i * 8192, R, C); const int Rb = Epi::PERM ? ((R & ~31) + perm32(R & 31)) : R;
        voffA[i] = (unsigned)(R * K + C) * 2u; voffB[i] = (unsigned)(Rb * K + C) * 2u; }
    const size_t kstep = (size_t)(BK * 2);
    const size_t hstep = (size_t)HALF * K * 2;
    const size_t tstep = 2 * hstep;
    const unsigned ldsw = (unsigned)wid * 1024u;
    const int aoff = lds_byte(wr * 64 + fr, fq * 8), boff = lds_byte(wc * 32 + fr, fq * 8);
#define PG8_SA(b, h) (((b) * 2 + (h)) * HTB)
#define PG8_SB(b, h) ((4 + (b) * 2 + (h)) * HTB)
#define PG8_STAGE(bufoff, gbase, voff) do { _Pragma("unroll") for (int _i = 0; _i < 2; ++_i) \
        __builtin_amdgcn_global_load_lds((const unsigned*)((const char*)(gbase) + (voff)[_i]), (PG8_LAS unsigned*)(lds + (bufoff) + ldsw + _i * 8192), 16, 0, 0); } while (0)
#define PG8_LDA(dst, b, h) do { _Pragma("unroll") for (int m = 0; m < 4; ++m) _Pragma("unroll") for (int k = 0; k < 2; ++k) dst[m][k] = *(const PG8_LAS bf16x8*)(lds + PG8_SA(b, h) + aoff + m * 2048 + k * 1024); } while (0)
#define PG8_LDB(dst, b, h) do { _Pragma("unroll") for (int n = 0; n < 2; ++n) _Pragma("unroll") for (int k = 0; k < 2; ++k) dst[n][k] = *(const PG8_LAS bf16x8*)(lds + PG8_SB(b, h) + boff + n * 2048 + k * 1024); } while (0)
#define PG8_MMA(ai, bj, At, Bt) do { __builtin_amdgcn_s_setprio(1); _Pragma("unroll") for (int m = 0; m < 4; ++m) _Pragma("unroll") for (int n = 0; n < 2; ++n) { \
        if constexpr (SCW != 0) mfma_f8(acc[ai][bj][m][n], cat8(Bt[n][0], Bt[n][1]), cat8(At[m][0], At[m][1]), SCW * 0x01010101, 0x7f7f7f7f); \
        else { _Pragma("unroll") for (int k = 0; k < 2; ++k) acc[ai][bj][m][n] = __builtin_amdgcn_mfma_f32_16x16x32_bf16(Bt[n][k], At[m][k], acc[ai][bj][m][n], 0, 0, 0); } } __builtin_amdgcn_s_setprio(0); } while (0)
#define PG8_WAIT_V(n) asm volatile("s_waitcnt vmcnt(" #n ")" ::: "memory")
#define PG8_WAIT_VX(aft_) do { if (aft_) asm volatile("s_waitcnt vmcnt(%0)" :: "i"(8 + EXTRA) : "memory"); else asm volatile("s_waitcnt vmcnt(8)" ::: "memory"); } while (0)
#define PG8_WAIT_L(n) asm volatile("s_waitcnt lgkmcnt(" #n ")" ::: "memory")
#define PG8_BAR __builtin_amdgcn_s_barrier()
#define PG8_SCHED __builtin_amdgcn_sched_barrier(0)
#define PG8_BIAS(u_) do { if constexpr (Epi::HAS_BIAS) __builtin_amdgcn_global_load_lds((const unsigned*)(E.bias_ptr(u_) + 4 * lane), (PG8_LAS unsigned*)(lds + BIAS_LDS + wid * 1024), 16, 0, 0); } while (0)
    Unit cur, nxt; int ui = 0;
    if (!S.next(0, cur)) return;
    f32x4 acc[2][2][4][2];
#pragma unroll
    for (int a = 0; a < 2; ++a)
#pragma unroll
        for (int b = 0; b < 2; ++b)
#pragma unroll
            for (int m = 0; m < 4; ++m)
#pragma unroll
                for (int n = 0; n < 2; ++n) acc[a][b][m][n] = (f32x4){0.f, 0.f, 0.f, 0.f};
    bf16x8 At[4][2], B0[2][2], B1[2][2];
    const PG8_LAS float* biasl = (const PG8_LAS float*)(lds + BIAS_LDS + wid * 1024);
    PG8_BIAS(cur);
    const char* cA = (const char*)g.A + (size_t)cur.pm * tstep; const char* cB = (const char*)g.Bt + (size_t)cur.pn * tstep;
    S.a_ready(cur);
    PG8_STAGE(PG8_SB(0, 0), cB, voffB); PG8_STAGE(PG8_SB(0, 1), cB + hstep, voffB); PG8_STAGE(PG8_SA(0, 0), cA, voffA); PG8_STAGE(PG8_SA(0, 1), cA + hstep, voffA);
    if (wr == 1) PG8_BAR;
    PG8_WAIT_V(2); PG8_BAR;
    PG8_STAGE(PG8_SB(1, 0), cB + kstep, voffB); PG8_STAGE(PG8_SA(1, 0), cA + kstep, voffA); PG8_STAGE(PG8_SB(1, 1), cB + hstep + kstep, voffB); PG8_STAGE(PG8_SA(1, 1), cA + hstep + kstep, voffA);
    PG8_WAIT_V(8); PG8_BAR;
    for (;;) {
        const bool has_next = S.next(ui + 1, nxt);
        const char* nA = has_next ? (const char*)g.A + (size_t)nxt.pm * tstep : cA; const char* nB = has_next ? (const char*)g.Bt + (size_t)nxt.pn * tstep : cB;
        for (int t = 0; t < nt; t += 2) {
            const bool last = (t == nt - 2);
            const bool aft = (t == 0) && (ui > 0);
            const char* a1 = cA + (size_t)(t + 1) * kstep;
            const char* a2 = last ? nA : cA + (size_t)(t + 2) * kstep; const char* b2 = last ? nB : cB + (size_t)(t + 2) * kstep;
            const char* a3 = a2 + kstep; const char* b3 = b2 + kstep;
            if (last && has_next) S.a_ready(nxt);
            PG8_LDB(B0, 0, 0); PG8_LDB(B1, 0, 1); PG8_SCHED; PG8_LDA(At, 0, 0); if (t > 0) PG8_STAGE(PG8_SA(1, 1), a1 + hstep, voffA);
            PG8_WAIT_VX(aft); PG8_WAIT_L(0); PG8_BAR; PG8_MMA(0, 0, At, B0); PG8_MMA(0, 1, At, B1); PG8_BAR; PG8_SCHED;
            PG8_LDA(At, 0, 1); PG8_STAGE(PG8_SB(0, 0), b2, voffB); PG8_STAGE(PG8_SB(0, 1), b2 + hstep, voffB); PG8_STAGE(PG8_SA(0, 0), a2, voffA);
            PG8_WAIT_VX(aft); PG8_WAIT_L(0); PG8_BAR; PG8_MMA(1, 0, At, B0); PG8_MMA(1, 1, At, B1); PG8_BAR; PG8_SCHED;
            PG8_LDB(B0, 1, 0); PG8_LDB(B1, 1, 1); PG8_SCHED; PG8_LDA(At, 1, 0); PG8_STAGE(PG8_SA(0, 1), a2 + hstep, voffA);
            PG8_WAIT_VX(aft); PG8_WAIT_L(0); PG8_BAR; PG8_MMA(0, 0, At, B0); PG8_MMA(0, 1, At, B1); PG8_BAR; PG8_SCHED;
            PG8_LDA(At, 1, 1); PG8_STAGE(PG8_SB(1, 0), b3, voffB); PG8_STAGE(PG8_SB(1, 1), b3 + hstep, voffB); PG8_STAGE(PG8_SA(1, 0), a3, voffA);
            PG8_WAIT_V(8); PG8_WAIT_L(0); PG8_BAR; PG8_MMA(1, 0, At, B0); PG8_MMA(1, 1, At, B1); PG8_BAR; PG8_SCHED;
        }
        if (has_next) { PG8_STAGE(PG8_SA(1, 1), nA + hstep + kstep, voffA); }
        asm volatile("" ::: "memory"); PG8_SCHED;
        if constexpr (SCW != 0) asm volatile("s_nop 15\n\ts_nop 15" ::: "memory");
        if constexpr (ALIGN_EPI) { if (wr == 0) PG8_BAR; }
        E(acc, cur, wr, wc, fr, fq, biasl); S.done(cur);
        if (!has_next) break;
#pragma unroll
            for (int a = 0; a < 2; ++a)
#pragma unroll
            for (int b = 0; b < 2; ++b)
#pragma unroll
                for (int m = 0; m < 4; ++m)
#pragma unroll
                    for (int n = 0; n < 2; ++n) acc[a][b][m][n] = (f32x4){0.f, 0.f, 0.f, 0.f};
        cur = nxt; cA = nA; cB = nB; ++ui;
        asm volatile("s_waitcnt lgkmcnt(0)" ::: "memory");
        PG8_BIAS(cur);
        if constexpr (ALIGN_EPI) { if (wr == 1) PG8_BAR; }
    }
    PG8_WAIT_V(0);
    if constexpr (!ALIGN_EPI) { if (wr == 0) PG8_BAR; }
    PG8_BAR;
#undef PG8_SA
#undef PG8_SB
#undef PG8_STAGE
#undef PG8_LDA
#undef PG8_LDB
#undef PG8_MMA
#undef PG8_WAIT_V
#undef PG8_WAIT_VX
#undef PG8_WAIT_L
#undef PG8_BAR
#undef PG8_SCHED
#undef PG8_BIAS
}
template <class Epi, class Sched, bool ALIGN_EPI = false, bool SP2 = false, int SCW = 0>
__device__ __forceinline__ void gemm_phase_g(PG8_LAS unsigned char* lds, const Gemm g, const Sched& S, const Epi& E, const int tid, const int* rowmap) {
    static_assert(SP2, "two-super-phase form only");
    const int wid = __builtin_amdgcn_readfirstlane(tid >> 6), lane = tid & 63, wr = wid >> 2, wc = wid & 3, fr = lane & 15, fq = lane >> 4;
    int K_ = g.K; asm volatile("" : "+s"(K_));
    const int K = K_, nt = K / BK;
    constexpr int EXTRA = 16 + (Epi::HAS_BIAS ? 1 : 0) + 1;
    unsigned voffB[2], cv0[2], cv1[2]; int RA[2], CA[2];
#pragma unroll
    for (int i = 0; i < 2; ++i) { int R, C; stage_rc(tid * 16 + i * 8192, R, C); const int Rb = Epi::PERM ? ((R & ~31) + perm32(R & 31)) : R;
        RA[i] = R; CA[i] = C; voffB[i] = (unsigned)(Rb * K + C) * 2u; }
    const size_t kstep = (size_t)(BK * 2);
    const size_t hstep = (size_t)HALF * K * 2;
    const size_t tstep = 2 * hstep;
    const unsigned ldsw = (unsigned)wid * 1024u;
    const int aoff = lds_byte(wr * 64 + fr, fq * 8), boff = lds_byte(wc * 32 + fr, fq * 8);
#define PG8_SA(b, h) (((b) * 2 + (h)) * HTB)
#define PG8_SB(b, h) ((4 + (b) * 2 + (h)) * HTB)
#define PG8_STAGE(bufoff, gbase, voff) do { _Pragma("unroll") for (int _i = 0; _i < 2; ++_i) \
        __builtin_amdgcn_global_load_lds((const unsigned*)((const char*)(gbase) + (voff)[_i]), (PG8_LAS unsigned*)(lds + (bufoff) + ldsw + _i * 8192), 16, 0, 0); } while (0)
#define PG8_LDA(dst, b, h) do { _Pragma("unroll") for (int m = 0; m < 4; ++m) _Pragma("unroll") for (int k = 0; k < 2; ++k) dst[m][k] = *(const PG8_LAS bf16x8*)(lds + PG8_SA(b, h) + aoff + m * 2048 + k * 1024); } while (0)
#define PG8_LDB(dst, b, h) do { _Pragma("unroll") for (int n = 0; n < 2; ++n) _Pragma("unroll") for (int k = 0; k < 2; ++k) dst[n][k] = *(const PG8_LAS bf16x8*)(lds + PG8_SB(b, h) + boff + n * 2048 + k * 1024); } while (0)
#define PG8_MMA(ai, bj, At, Bt) do { __builtin_amdgcn_s_setprio(1); _Pragma("unroll") for (int m = 0; m < 4; ++m) _Pragma("unroll") for (int n = 0; n < 2; ++n) { \
        if constexpr (SCW != 0) mfma_f8(acc[ai][bj][m][n], cat8(Bt[n][0], Bt[n][1]), cat8(At[m][0], At[m][1]), SCW * 0x01010101, 0x7f7f7f7f); \
        else { _Pragma("unroll") for (int k = 0; k < 2; ++k) acc[ai][bj][m][n] = __builtin_amdgcn_mfma_f32_16x16x32_bf16(Bt[n][k], At[m][k], acc[ai][bj][m][n], 0, 0, 0); } } __builtin_amdgcn_s_setprio(0); } while (0)
#define PG8_WAIT_V(n) asm volatile("s_waitcnt vmcnt(" #n ")" ::: "memory")
#define PG8_WAIT_VX(aft_) do { if (aft_) asm volatile("s_waitcnt vmcnt(%0)" :: "i"(8 + EXTRA) : "memory"); else asm volatile("s_waitcnt vmcnt(8)" ::: "memory"); } while (0)
#define PG8_WAIT_L(n) asm volatile("s_waitcnt lgkmcnt(" #n ")" ::: "memory")
#define PG8_BAR __builtin_amdgcn_s_barrier()
#define PG8_SCHED __builtin_amdgcn_sched_barrier(0)
#define PG8_BIAS(u_) do { if constexpr (Epi::HAS_BIAS) __builtin_amdgcn_global_load_lds((const unsigned*)(E.bias_ptr(u_) + 4 * lane), (PG8_LAS unsigned*)(lds + BIAS_LDS + wid * 1024), 16, 0, 0); } while (0)
    Unit cur, nxt; int ui = 0;
    if (!S.next(0, cur)) return;
    f32x4 acc[2][2][4][2];
#pragma unroll
    for (int a = 0; a < 2; ++a)
#pragma unroll
        for (int b = 0; b < 2; ++b)
#pragma unroll
            for (int m = 0; m < 4; ++m)
#pragma unroll
                for (int n = 0; n < 2; ++n) acc[a][b][m][n] = (f32x4){0.f, 0.f, 0.f, 0.f};
    bf16x8 At[4][2], B0[2][2], B1[2][2];
    const PG8_LAS float* biasl = (const PG8_LAS float*)(lds + BIAS_LDS + wid * 1024);
    PG8_BIAS(cur);
    const char* gA = (const char*)g.A; const char* cB = (const char*)g.Bt + (size_t)cur.pn * tstep;
    const PG8_LAS int* rowsl = (const PG8_LAS int*)(lds + ROWS_LDS);
#define PG8_ROWDMA(pm_) __builtin_amdgcn_global_load_lds((const unsigned*)(rowmap + (pm_) * BM + 4 * lane), (PG8_LAS unsigned*)(lds + ROWS_LDS), 16, 0, 0)
#define PG8_ROWS(v0_, v1_) do { _Pragma("unroll") for (int _i = 0; _i < 2; ++_i) { v0_[_i] = (unsigned)(rowsl[RA[_i]] * K + CA[_i]) * 2u; v1_[_i] = (unsigned)(rowsl[HALF + RA[_i]] * K + CA[_i]) * 2u; } } while (0)
    PG8_ROWDMA(cur.pm); PG8_WAIT_V(0);
    PG8_ROWS(cv0, cv1); PG8_WAIT_L(0);
    S.a_ready(cur);
    PG8_STAGE(PG8_SB(0, 0), cB, voffB); PG8_STAGE(PG8_SB(0, 1), cB + hstep, voffB); PG8_STAGE(PG8_SA(0, 0), gA, cv0); PG8_STAGE(PG8_SA(0, 1), gA, cv1);
    if (wr == 1) PG8_BAR;
    PG8_WAIT_V(2); PG8_BAR;
    PG8_STAGE(PG8_SB(1, 0), cB + kstep, voffB); PG8_STAGE(PG8_SA(1, 0), gA + kstep, cv0); PG8_STAGE(PG8_SB(1, 1), cB + hstep + kstep, voffB); PG8_STAGE(PG8_SA(1, 1), gA + kstep, cv1);
    PG8_WAIT_V(8); PG8_BAR;
    for (;;) {
        const bool has_next = S.next(ui + 1, nxt);
        const char* nB = has_next ? (const char*)g.Bt + (size_t)nxt.pn * tstep : cB;
        PG8_ROWDMA(has_next ? nxt.pm : cur.pm);
        unsigned w0[2] = {cv0[0], cv0[1]}, w1[2] = {cv1[0], cv1[1]};
        for (int t = 0; t < nt; t += 2) {
            const bool last = (t == nt - 2);
            const bool aft = (t == 0) && (ui > 0);
            const char* a1 = gA + (size_t)(t + 1) * kstep;
            const char* a2 = last ? gA : gA + (size_t)(t + 2) * kstep; const char* b2 = last ? nB : cB + (size_t)(t + 2) * kstep;
            const char* a3 = a2 + kstep; const char* b3 = b2 + kstep;
            if (last && has_next) S.a_ready(nxt);
            PG8_LDB(B0, 0, 0); PG8_LDB(B1, 0, 1); PG8_SCHED; PG8_LDA(At, 0, 0); if (t > 0) PG8_STAGE(PG8_SA(1, 1), a1, cv1);
            PG8_WAIT_VX(aft); PG8_WAIT_L(0); PG8_BAR; PG8_MMA(0, 0, At, B0); PG8_MMA(0, 1, At, B1); PG8_BAR; PG8_SCHED;
            PG8_LDA(At, 0, 1); PG8_STAGE(PG8_SB(0, 0), b2, voffB); PG8_STAGE(PG8_SB(0, 1), b2 + hstep, voffB); PG8_STAGE(PG8_SA(0, 0), a2, w0);
            PG8_WAIT_VX(aft); PG8_WAIT_L(0); PG8_BAR; PG8_MMA(1, 0, At, B0); PG8_MMA(1, 1, At, B1); PG8_BAR; PG8_SCHED;
            PG8_LDB(B0, 1, 0); PG8_LDB(B1, 1, 1); PG8_SCHED; PG8_LDA(At, 1, 0); PG8_STAGE(PG8_SA(0, 1), a2, w1);
            PG8_WAIT_VX(aft); PG8_WAIT_L(0); PG8_BAR; PG8_MMA(0, 0, At, B0); PG8_MMA(0, 1, At, B1); PG8_BAR; PG8_SCHED;
            PG8_LDA(At, 1, 1); PG8_STAGE(PG8_SB(1, 0), b3, voffB); PG8_STAGE(PG8_SB(1, 1), b3 + hstep, voffB); PG8_STAGE(PG8_SA(1, 0), a3, w0);
            PG8_WAIT_V(8); PG8_WAIT_L(0); PG8_BAR; PG8_MMA(1, 0, At, B0); PG8_MMA(1, 1, At, B1); PG8_BAR; PG8_SCHED;
            if (t + 4 == nt) { PG8_ROWS(w0, w1); }
        }
        if (has_next) { PG8_STAGE(PG8_SA(1, 1), gA + kstep, w1); }
        asm volatile("" ::: "memory"); PG8_SCHED;
        if constexpr (SCW != 0) asm volatile("s_nop 15\n\ts_nop 15" ::: "memory");
        if constexpr (ALIGN_EPI) { if (wr == 0) PG8_BAR; }
        E(acc, cur, wr, wc, fr, fq, biasl); S.done(cur);
        if (!has_next) break;
#pragma unroll
            for (int a = 0; a < 2; ++a)
#pragma unroll
            for (int b = 0; b < 2; ++b)
#pragma unroll
                for (int m = 0; m < 4; ++m)
#pragma unroll
                    for (int n = 0; n < 2; ++n) acc[a][b][m][n] = (f32x4){0.f, 0.f, 0.f, 0.f};
        cur = nxt; cB = nB; ++ui; cv0[0] = w0[0]; cv0[1] = w0[1]; cv1[0] = w1[0]; cv1[1] = w1[1];
        asm volatile("s_waitcnt lgkmcnt(0)" ::: "memory");
        PG8_BIAS(cur);
        if constexpr (ALIGN_EPI) { if (wr == 1) PG8_BAR; }
    }
    PG8_WAIT_V(0);
    if constexpr (!ALIGN_EPI) { if (wr == 0) PG8_BAR; }
    PG8_BAR;
#undef PG8_ROWS
#undef PG8_ROWDMA
#undef PG8_SA
#undef PG8_SB
#undef PG8_STAGE
#undef PG8_LDA
#undef PG8_LDB
#undef PG8_MMA
#undef PG8_WAIT_V
#undef PG8_WAIT_VX
#undef PG8_WAIT_L
#undef PG8_BAR
#undef PG8_SCHED
#undef PG8_BIAS
}
}

#ifndef REP_MASK
#define REP_MASK 0
#endif
#define NREP(k) (1 + ((REP_MASK >> (k)) & 1))

constexpr int NB = 16, SEQ = 2048, D = 1024, NMETA = 16;
constexpr int MX = NB * SEQ;
constexpr int INW = 3344, PW = 3584;
constexpr int GQ = 0, GK = 256, GV = 512, GG = 1024, GKL = 1536;
constexpr int RW0 = 1552;
constexpr int RR = RW0, RK = RW0 + 512, RV = RW0 + 1024, RWL = RW0 + 1536, RAL = RW0 + 1600, RGL = RW0 + 1664;
constexpr int NE = 32, TOPK = 4;
constexpr int NCH = 33;
constexpr float ALPHA = 1.189207115002721f;
constexpr int NWAVES = 8, NTHR = 512;

constexpr size_t MiB = 1u << 20;
constexpr size_t WS_CTL = 0, CTL_ZERO_BYTES = 1 * MiB;
constexpr size_t WS_STATS = 1 * MiB;
constexpr size_t WS_TOPI  = WS_STATS + 256 * 1024;
constexpr size_t WS_GATE  = WS_TOPI + 512 * 1024;
constexpr size_t WS_RANK  = WS_GATE + 512 * 1024;
constexpr size_t WS_TSLOT = WS_RANK + 512 * 1024;
constexpr size_t WS_BON   = WS_TSLOT + 512 * 1024;
constexpr size_t WS_PROJM = WS_BON + 1 * MiB;
constexpr size_t WS_OPSM  = WS_PROJM + 256 * 1024;
constexpr size_t WS_DL    = WS_OPSM + 256 * 1024;
constexpr size_t WS_W2T   = WS_DL + 1 * MiB;
constexpr size_t WS_A2T   = WS_W2T + 64 * 1024;
constexpr size_t WS_G2T   = WS_A2T + 64 * 1024;
constexpr size_t WS_RWH   = WS_G2T + 128 * 1024;
constexpr size_t WS_RWL   = WS_RWH + 64 * 1024;
constexpr size_t WS_TILEE = WS_RWL + 64 * 1024;
constexpr size_t WS_SLOTTOK = WS_TILEE + 4096;
constexpr size_t WS_WIN   = 8 * MiB;
constexpr size_t WS_WOUT  = 15 * MiB;
static_assert(WS_SLOTTOK + 139264 * 4 <= WS_WIN, "table region");
constexpr size_t WS_A0    = 20 * MiB;
constexpr size_t WS_YMIX  = WS_A0;
constexpr size_t WS_PROJ  = 84 * MiB;
constexpr size_t WS_R1    = 308 * MiB;
constexpr size_t WS_GAM   = 520 * MiB;
constexpr size_t WS_SST   = 524 * MiB;
constexpr size_t WS_GUS   = 692 * MiB;
constexpr size_t WS_H1    = 20 * MiB;
constexpr size_t WS_XS    = 84 * MiB;
constexpr size_t WS_YS    = WS_XS;
constexpr size_t WS_ACT   = 356 * MiB;
constexpr size_t WS_MIXB  = 628 * MiB;
constexpr size_t WS_WUP   = 758 * MiB;
constexpr size_t WS_WDN   = 822 * MiB;
constexpr size_t WS_H1Q   = 854 * MiB;
constexpr size_t WS_END   = 886 * MiB;
constexpr int CW_BAR = 4096;
constexpr int CW_CNT = 16384;
constexpr int CW_QH = 20480;

constexpr int RING_BYTES = 131072;
constexpr int LDS_BYTES = 147456;
constexpr int TAB_OFF = 132096;
constexpr int MISC_OFF = LDS_BYTES - 512;

#define LAS __attribute__((address_space(3)))
typedef unsigned short bf16;
typedef unsigned v4u __attribute__((ext_vector_type(4)));
typedef unsigned v2u __attribute__((ext_vector_type(2)));
typedef float f32x4 __attribute__((ext_vector_type(4)));
typedef short bf16x8 __attribute__((ext_vector_type(8)));
typedef int i32x4g __attribute__((ext_vector_type(4)));
#define LDS_WAIT() asm volatile("s_waitcnt lgkmcnt(0)" ::: "memory")
__device__ __forceinline__ float bflo(unsigned w) { return __uint_as_float(w << 16); }
__device__ __forceinline__ float bfhi(unsigned w) { return __uint_as_float(w & 0xffff0000u); }
typedef float f32x2_t __attribute__((ext_vector_type(2))); typedef __bf16 bf16x2_t __attribute__((ext_vector_type(2)));
__device__ __forceinline__ unsigned pk2(float lo, float hi) { const f32x2_t v = {lo, hi}; const bf16x2_t b = __builtin_convertvector(v, bf16x2_t); return __builtin_bit_cast(unsigned, b); }
__device__ __forceinline__ unsigned f2bf(float f) { return pk2(f, 0.f) & 0xffffu; }
#define CYC() ((unsigned)__builtin_amdgcn_s_getreg((19 << 11) | 29))
__device__ __forceinline__ void lds_barrier() { asm volatile("s_waitcnt lgkmcnt(0)" ::: "memory"); __builtin_amdgcn_s_barrier(); asm volatile("" ::: "memory"); }
__device__ __forceinline__ float shx(float v, int mask, int lane) { return __int_as_float(__builtin_amdgcn_ds_bpermute((lane ^ mask) << 2, __float_as_int(v))); }
template <int CTRL> __device__ __forceinline__ float dppf0(float x) { return __int_as_float(__builtin_amdgcn_update_dpp(0, __float_as_int(x), CTRL, 0xF, 0xF, true)); }
__device__ __forceinline__ float wave_sum(float v, int lane) {
    v += dppf0<0xB1>(v); v += dppf0<0x4E>(v); v += dppf0<0x141>(v); v += dppf0<0x140>(v);
    v += shx(v, 16, lane); v += shx(v, 32, lane);
    return v;
}
__device__ __forceinline__ float softplus_f(float x) { return fmaxf(x, 0.f) + log1pf(expf(-fabsf(x))); }
__device__ __forceinline__ float logsigmoid_f(float x) { return fminf(x, 0.f) - log1pf(expf(-fabsf(x))); }
__device__ __forceinline__ float sigmoid_f(float x) { return 1.f / (1.f + expf(-x)); }
__device__ __forceinline__ float fexp(float x) { return __builtin_amdgcn_exp2f(x * 1.4426950408889634f); }
__device__ __forceinline__ float flog(float x) { return __builtin_amdgcn_logf(x) * 0.6931471805599453f; }
__device__ __forceinline__ float fsigmoid(float x) { return __builtin_amdgcn_rcpf(1.f + fexp(-x)); }
__device__ __forceinline__ float ftanh(float x) { return 2.f * fsigmoid(2.f * x) - 1.f; }
__device__ __forceinline__ float fsoftplus(float x) { return fmaxf(x, 0.f) + flog(1.f + fexp(-fabsf(x))); }
__device__ __forceinline__ float flogsigmoid(float x) { return fminf(x, 0.f) - flog(1.f + fexp(-fabsf(x))); }
template <int CTRL> __device__ __forceinline__ float dppf(float x) { return __int_as_float(__builtin_amdgcn_update_dpp(0, __float_as_int(x), CTRL, 0xF, 0xF, true)); }
__device__ __forceinline__ float red8(float x) {
    x += dppf<0xB1>(x); x += dppf<0x4E>(x); x += dppf<0x141>(x); return x;
}
__device__ __forceinline__ f32x4 mfma16(bf16x8 a, bf16x8 b, f32x4 c) { return __builtin_amdgcn_mfma_f32_16x16x32_bf16(a, b, c, 0, 0, 0); }
__device__ __forceinline__ unsigned ld_agent(const unsigned* p) { return __hip_atomic_load(p, __ATOMIC_RELAXED, __HIP_MEMORY_SCOPE_AGENT); }

#define XB_TMO      128
#define XB_XCNT(j)  (256  + 64 * (j))
#define XB_XSUB(j)  (1280 + 64 * (j))
#define XB_XGEN(j)  (2304 + 64 * (j))
#define XB_TOP      3328
#define XB_TOPGEN   3392
#define XCD_BAR_WORDS 3456
#define XB_SPIN_CAP (1u << 18)
__device__ __forceinline__ unsigned xb_ld(unsigned* p)              { return __hip_atomic_load(p, __ATOMIC_RELAXED, __HIP_MEMORY_SCOPE_AGENT); }
__device__ __forceinline__ unsigned xb_add(unsigned* p, unsigned v) { return __hip_atomic_fetch_add(p, v, __ATOMIC_RELAXED, __HIP_MEMORY_SCOPE_AGENT); }
__device__ __forceinline__ unsigned xb_xcc_id() { return (unsigned)__builtin_amdgcn_s_getreg((3 << 11) | 20) & 0xFu; }
#define XB_SPIN(cond, bar) do { unsigned _sp = 0; while (cond) { __builtin_amdgcn_s_sleep(1); \
    if ((++_sp & 255u) == 0u) { if (xb_ld(&(bar)[XB_TMO])) break; if (_sp > XB_SPIN_CAP) { atomicAdd(&(bar)[XB_TMO], 1u); break; } } } } while (0)
struct XcdBarrier { unsigned* bar; unsigned x; volatile LAS unsigned* st; };
__device__ __forceinline__ XcdBarrier xcd_barrier_post(unsigned* bar, volatile LAS unsigned* st, bool leader) {
    XcdBarrier b; b.bar = bar; b.x = xb_xcc_id(); b.st = st;
    if (leader) (void)xb_add(&bar[XB_XCNT(b.x)], 1u);
    return b;
}
__device__ __forceinline__ void xcd_barrier_complete(unsigned* bar, unsigned x, unsigned& nloc, unsigned& nx) {
    const unsigned G = gridDim.x * gridDim.y * gridDim.z;
    unsigned sum, cnt, mine, sp = 0u;
    for (;;) {
        sum = 0u; cnt = 0u; mine = 0u;
#pragma unroll
        for (unsigned j = 0; j < 16; ++j) { const unsigned c = xb_ld(&bar[XB_XCNT(j)]); sum += c; cnt += (c > 0u) ? 1u : 0u; mine = (j == x) ? c : mine; }
        if (sum == G) break;
        __builtin_amdgcn_s_sleep(1);
        if ((++sp & 255u) == 0u) { if (xb_ld(&bar[XB_TMO])) break; if (sp > XB_SPIN_CAP) { atomicAdd(&bar[XB_TMO], 1u); break; } }
    }
    nloc = mine > 0u ? mine : 1u; nx = cnt > 0u ? cnt : 1u;
}
__device__ __forceinline__ void xcd_barrier(const XcdBarrier& b, bool leader) {
    asm volatile("s_waitcnt vmcnt(0)" ::: "memory");
    __syncthreads();
    if (leader) {
        unsigned* bar = b.bar;
        __builtin_amdgcn_s_waitcnt(0);
        unsigned nloc = b.st[0], nx = b.st[1];
        if (nloc == 0u) { xcd_barrier_complete(bar, b.x, nloc, nx); b.st[0] = nloc; b.st[1] = nx; }
        const unsigned old = xb_add(&bar[XB_XSUB(b.x)], 1u);
        const unsigned gen = old / nloc;
        if (old + 1u == (gen + 1u) * nloc) {
            __builtin_amdgcn_fence(__ATOMIC_RELEASE, "agent");
            asm volatile("s_waitcnt vmcnt(0)" ::: "memory");
            const unsigned og = xb_add(&bar[XB_TOP], 1u);
            const unsigned tg = og / nx;
            if (og + 1u == (tg + 1u) * nx) xb_add(&bar[XB_TOPGEN], 1u);
            else XB_SPIN(xb_ld(&bar[XB_TOPGEN]) == tg, bar);
            __builtin_amdgcn_fence(__ATOMIC_ACQUIRE, "agent");
            xb_add(&bar[XB_XGEN(b.x)], 1u);
            asm volatile("s_waitcnt vmcnt(0)" ::: "memory");
        } else {
            XB_SPIN(xb_ld(&bar[XB_XGEN(b.x)]) == gen, bar);
            __builtin_amdgcn_fence(__ATOMIC_ACQUIRE, "agent");
            asm volatile("s_waitcnt vmcnt(0)" ::: "memory");
        }
    }
    __syncthreads();
}

struct Args { const float* in[30]; float* out; unsigned char* ws; };
enum { I_X = 0, I_META, I_LNIN_G, I_LNIN_B, I_WIN, I_GKW2, I_GKB, I_GNORM, I_MU, I_W0, I_W2, I_A0, I_A2, I_G2, I_KK, I_KA, I_RK, I_RLNG, I_RLNB, I_WOUT,
       I_LN1G, I_LN1B, I_RTW, I_RTB, I_WUP, I_BUP, I_WDN, I_BDN, I_LN2G, I_LN2B };
struct Frame { LAS unsigned char* lds; int tid, lane, wave, blk, G; };
__device__ __forceinline__ int lane_id() { int l; asm volatile("v_mbcnt_lo_u32_b32 %0, -1, 0\n\tv_mbcnt_hi_u32_b32 %0, -1, %0" : "=v"(l)); return l; }
__device__ __forceinline__ Frame mkframe(LAS unsigned char* lds, int wave) { Frame F; F.lds = lds; F.wave = wave; F.lane = lane_id(); F.tid = wave * 64 + F.lane; F.blk = blockIdx.x; F.G = gridDim.x; return F; }

__device__ __forceinline__ void transpose_item(const float* W, int K, int N, int nblk, bf16* WT, LAS float* scr, int item, int lane) {
    const int kb = item / nblk, nb = item - kb * nblk, k0 = 64 * kb, n0 = 32 * nb;
    const int nn = n0 + (lane & 31); const bool ok = nn < N;
#pragma unroll 8
    for (int i = 0; i < 32; ++i) { const int kk = 2 * i + (lane >> 5); scr[kk * 33 + (lane & 31)] = ok ? W[(size_t)(k0 + kk) * N + nn] : 0.f; }
    LDS_WAIT();
    const int c = lane & 7;
#pragma unroll
    for (int j = 0; j < 4; ++j) { const int n = (lane >> 3) + 8 * j; const LAS float* s = scr + (8 * c) * 33 + n;
        v4u o; o.x = pk2(s[0 * 33], s[1 * 33]); o.y = pk2(s[2 * 33], s[3 * 33]); o.z = pk2(s[4 * 33], s[5 * 33]); o.w = pk2(s[6 * 33], s[7 * 33]);
        *(v4u*)(WT + (size_t)(n0 + n) * K + k0 + 8 * c) = o; }
    LDS_WAIT();
}

__device__ __forceinline__ void transpose_item64_f8(const float* W, int K, int N, unsigned char* WT, float scale, LAS float* scr, int item, int lane) {
    const int nblk = N >> 6, kb = item / nblk, nb = item - kb * nblk, k0 = 64 * kb, n0 = 64 * nb;
    const int r4 = lane >> 4, c4 = lane & 15;
    f32x4 v[16];
#pragma unroll
    for (int i = 0; i < 16; ++i) v[i] = *(const f32x4*)(W + (size_t)(k0 + 4 * i + r4) * N + n0 + 4 * c4);
#pragma unroll
    for (int i = 0; i < 16; ++i) *(LAS f32x4*)(scr + (4 * i + r4) * 68 + 4 * c4) = v[i];
    LDS_WAIT();
    unsigned char* orow = WT + (size_t)(n0 + lane) * K + k0;
#pragma unroll
    for (int g = 0; g < 4; ++g) { const LAS float* s = scr + (16 * g) * 68 + lane; v4u o;
#pragma unroll
        for (int q = 0; q < 4; ++q) { int w = __builtin_amdgcn_cvt_pk_fp8_f32(s[(4 * q + 0) * 68] * scale, s[(4 * q + 1) * 68] * scale, 0, false);
            w = __builtin_amdgcn_cvt_pk_fp8_f32(s[(4 * q + 2) * 68] * scale, s[(4 * q + 3) * 68] * scale, w, true); o[q] = (unsigned)w; }
        *(v4u*)(orow + 16 * g) = o; }
    LDS_WAIT();
}
__device__ __forceinline__ void convert_expert_weights(const Args& a, const Frame& F, int qsel) {
    unsigned char* ws = a.ws;
    LAS float* scr = (LAS float*)(F.lds + F.wave * 17408);
    unsigned* QH = (unsigned*)(ws + WS_CTL) + CW_QH + 64 * qsel;
    constexpr int I_UP = 16 * 32, I_DN = 16 * 16, NIT = NE * (I_UP + I_DN);
    for (;;) {
        unsigned base = 0;
        if (F.lane == 0) base = __hip_atomic_fetch_add(QH, 8u, __ATOMIC_RELAXED, __HIP_MEMORY_SCOPE_AGENT);
        base = (unsigned)__builtin_amdgcn_readfirstlane((int)base);
        if (base >= (unsigned)NIT) break;
        for (int it = (int)base; it < (int)base + 8; ++it) {
            if (it < NE * I_UP) { const int e = it / I_UP, r = it - e * I_UP;
                transpose_item64_f8(a.in[I_WUP] + (size_t)e * D * 2048, D, 2048, ws + WS_WUP + (size_t)e * 2048 * D, 64.f, scr, r, F.lane); }
            else { const int it2 = it - NE * I_UP, e = it2 / I_DN, r = it2 - e * I_DN;
                transpose_item64_f8(a.in[I_WDN] + (size_t)e * D * D, D, D, ws + WS_WDN + (size_t)e * D * D, 128.f, scr, r, F.lane); }
        }
    }
}

__device__ __forceinline__ void phase0(const Args& a, const Frame& F) {
    unsigned char* ws = a.ws;
    const int gw = F.blk * NWAVES + F.wave, NGW = F.G * NWAVES;
    for (int cgp = F.blk; cgp < 53; cgp += F.G) {
        LAS float* HM = (LAS float*)F.lds;
        LAS float* PART = (LAS float*)(F.lds + 65536);
        for (int rr = 0; rr < 2; ++rr) {
            const int row = 2 * F.wave + rr; const f32x4* xr = (const f32x4*)(a.in[I_META] + row * D) + F.lane;
            f32x4 v[4]; float s = 0.f;
#pragma unroll
            for (int j = 0; j < 4; ++j) { v[j] = xr[64 * j]; s += (v[j].x + v[j].y) + (v[j].z + v[j].w); }
            const float mean = wave_sum(s, F.lane) * (1.f / D); float s2 = 0.f;
#pragma unroll
            for (int j = 0; j < 4; ++j) { v[j] = v[j] - mean; s2 += (v[j].x * v[j].x + v[j].y * v[j].y) + (v[j].z * v[j].z + v[j].w * v[j].w); }
            const float rstd = 1.f / sqrtf(wave_sum(s2, F.lane) * (1.f / D) + 1e-5f);
#pragma unroll
            for (int j = 0; j < 4; ++j) { const int col = 4 * (F.lane + 64 * j);
                const f32x4 gv = *(const f32x4*)(a.in[I_LNIN_G] + col), bv = *(const f32x4*)(a.in[I_LNIN_B] + col);
                const f32x4 y = v[j] * rstd * gv + bv;
                HM[(col + 0) * 16 + row] = y.x; HM[(col + 1) * 16 + row] = y.y; HM[(col + 2) * 16 + row] = y.z; HM[(col + 3) * 16 + row] = y.w; }
        }
        __syncthreads();
        const int col = cgp * 64 + F.lane; const bool ok = col < INW;
        float acc[16];
#pragma unroll
        for (int r = 0; r < 16; ++r) acc[r] = 0.f;
        const float* wp = a.in[I_WIN];
        for (int k = F.wave * 128; k < F.wave * 128 + 128; ++k) {
            const float wv = ok ? wp[(size_t)k * INW + col] : 0.f;
            const LAS f32x4* h = (const LAS f32x4*)(HM + k * 16);
#pragma unroll
            for (int q = 0; q < 4; ++q) { const f32x4 hv = h[q]; acc[4 * q + 0] += hv.x * wv; acc[4 * q + 1] += hv.y * wv; acc[4 * q + 2] += hv.z * wv; acc[4 * q + 3] += hv.w * wv; }
        }
#pragma unroll
        for (int r = 0; r < 16; ++r) PART[(F.wave * 16 + r) * 64 + F.lane] = acc[r];
        __syncthreads();
        bf16* PROJM = (bf16*)(ws + WS_PROJM);
        for (int o = F.tid; o < 1024; o += NTHR) { const int r = o >> 6, l = o & 63; float s = 0.f;
#pragma unroll
            for (int w = 0; w < 8; ++w) s += PART[(w * 16 + r) * 64 + l];
            PROJM[r * PW + cgp * 64 + l] = (bf16)f2bf(s); }
        if (F.tid < 64) PROJM[NMETA * PW + cgp * 64 + F.tid] = 0;
        __syncthreads();
    }
    {
        LAS float* scr = (LAS float*)(F.lds + F.wave * 16384);
        constexpr int I_IN = 16 * (PW / 32), I_OUT = 16 * 32;
        for (int it = gw; it < I_IN + I_OUT; it += NGW) {
            if (it < I_IN) transpose_item(a.in[I_WIN], D, INW, PW / 32, (bf16*)(ws + WS_WIN), scr, it, F.lane);
            else transpose_item(a.in[I_WOUT], D, D, 32, (bf16*)(ws + WS_WOUT), scr, it - I_IN, F.lane);
        }
    }
    {
        bf16* W2T = (bf16*)(ws + WS_W2T); bf16* A2T = (bf16*)(ws + WS_A2T); bf16* G2T = (bf16*)(ws + WS_G2T);
        for (int i = F.blk * NTHR + F.tid; i < 131072; i += F.G * NTHR) {
            if (i < 32768) { const int n = i >> 6, k = i & 63; W2T[i] = (bf16)f2bf(a.in[I_W2][k * 512 + n]); }
            else if (i < 65536) { const int j = i - 32768, n = j >> 6, k = j & 63; A2T[j] = (bf16)f2bf(a.in[I_A2][k * 512 + n]); }
            else { const int j = i - 65536, n = j >> 7, k = j & 127; G2T[j] = (bf16)f2bf(a.in[I_G2][k * 512 + n]); }
        }
    }
    {
        bf16* RWH = (bf16*)(ws + WS_RWH); bf16* RWL = (bf16*)(ws + WS_RWL);
        for (int i = F.blk * NTHR + F.tid; i < D * NE; i += F.G * NTHR) { const int c = i >> 5, e = i & 31; const float w = a.in[I_RTW][i];
            const unsigned hi = f2bf(w); const float lo = w - __uint_as_float(hi << 16);
            RWH[e * D + c] = (bf16)hi; RWL[e * D + c] = (bf16)f2bf(lo); }
    }
    {
        bf16* A0 = (bf16*)(ws + WS_A0); float* ST = (float*)(ws + WS_STATS);
        for (int m0 = gw; m0 < MX; m0 += 2 * NGW) {
            f32x4 v[2][4];
#pragma unroll
            for (int r = 0; r < 2; ++r) { const f32x4* xr = (const f32x4*)(a.in[I_X] + (size_t)(m0 + r * NGW) * D) + F.lane;
#pragma unroll
                for (int j = 0; j < 4; ++j) v[r][j] = xr[64 * j]; }
#pragma unroll
            for (int r = 0; r < 2; ++r) { const int m = m0 + r * NGW; float s = 0.f;
#pragma unroll
                for (int j = 0; j < 4; ++j) s += (v[r][j].x + v[r][j].y) + (v[r][j].z + v[r][j].w);
                const float mean = wave_sum(s, F.lane) * (1.f / D); float s2 = 0.f;
#pragma unroll
                for (int j = 0; j < 4; ++j) { v[r][j] = v[r][j] - mean; s2 += (v[r][j].x * v[r][j].x + v[r][j].y * v[r][j].y) + (v[r][j].z * v[r][j].z + v[r][j].w * v[r][j].w); }
                const float rstd = __builtin_amdgcn_rsqf(wave_sum(s2, F.lane) * (1.f / D) + 1e-5f);
#pragma unroll
                for (int j = 0; j < 4; ++j) { const int col = 4 * (F.lane + 64 * j);
                    const f32x4 gv = *(const f32x4*)(a.in[I_LNIN_G] + col), bv = *(const f32x4*)(a.in[I_LNIN_B] + col);
                    const f32x4 y = v[r][j] * rstd * gv + bv;
                    v2u o; o.x = pk2(y.x, y.y); o.y = pk2(y.z, y.w);
                    *(v2u*)(A0 + (size_t)m * D + col) = o; }
                if (F.lane == 0) { ST[2 * m] = mean; ST[2 * m + 1] = rstd; } }
        }
    }
    __syncthreads();
    for (int rep_ = 0; rep_ < NREP(14); ++rep_) convert_expert_weights(a, F, rep_);
}

__device__ __forceinline__ const bf16* prow(const bf16* PROJ, const bf16* PROJM, int b, int vp) {
    const bf16* px = PROJ + (size_t)(b * SEQ + (vp >= NMETA ? vp - NMETA : 0)) * PW;
    const bf16* pm = PROJM + (size_t)(vp < 0 ? NMETA : (vp < NMETA ? vp : 0)) * PW;
    return vp >= NMETA ? px : pm;
}
__device__ __forceinline__ f32x4 ldp4(const bf16* PROJ, const bf16* PROJM, int b, int vp, int col) {
    const v2u w = *(const v2u*)(prow(PROJ, PROJM, b, vp) + col);
    return (f32x4){bflo(w.x), bfhi(w.x), bflo(w.y), bfhi(w.y)};
}

constexpr int R1_STRIDE = 49152;
constexpr int TP = 80;
constexpr int L1_SLOT = 64 * TP * 2;
constexpr int L1_LC = 12 * L1_SLOT;
constexpr int L1_XCH = L1_LC + 64 * 65 * 4;
constexpr int L1_LR = 8 * L1_SLOT;
__device__ __forceinline__ v2u pack4(f32x4 v) { v2u o; o.x = pk2(v[0], v[1]); o.y = pk2(v[2], v[3]); return o; }
__device__ __forceinline__ f32x4 tile_mm(const LAS bf16* A, const LAS bf16* Bt, int rt, int ct, int fr, int fq, f32x4 acc) {
#pragma unroll
    for (int ks = 0; ks < 2; ++ks)
        acc = mfma16(*(const LAS bf16x8*)(Bt + (ct * 16 + fr) * TP + ks * 32 + 8 * fq), *(const LAS bf16x8*)(A + (rt * 16 + fr) * TP + ks * 32 + 8 * fq), acc);
    return acc;
}
__device__ __forceinline__ void tile_st(LAS bf16* O, int rt, int ct, int fr, int fq, f32x4 v) { *(LAS v2u*)(O + (rt * 16 + fr) * TP + ct * 16 + 4 * fq) = pack4(v); }
#define L1S(n) ((LAS bf16*)(F.lds + (n) * L1_SLOT))

struct L1Pf { v4u sa[5]; v2u r[2][2], k[2][2], v[2][2]; };
__device__ __forceinline__ void l1_fetch(const Args& a, const Frame& F, int b, int h, int c, L1Pf& pf, bool need_sa) {
    const bf16* PROJ = (const bf16*)(a.ws + WS_PROJ); const bf16* PROJM = (const bf16*)(a.ws + WS_PROJM);
    const int vp0 = (c == 0) ? -48 : NMETA + 64 * (c - 1);
    if (need_sa) { const int cg = F.tid & 31, tr = F.tid >> 5;
#pragma unroll
      for (int i = 0; i < 5; ++i) pf.sa[i] = *(const v4u*)(prow(PROJ, PROJM, b, vp0 + 4 * tr - 1 + i) + RWL + 8 * cg); }
    { const int rt = F.wave & 3, cp = F.wave >> 2, fr = F.lane & 15, fq = F.lane >> 4, vp = vp0 + rt * 16 + fr;
      const bf16* p0 = prow(PROJ, PROJM, b, vp - 1); const bf16* p1 = prow(PROJ, PROJM, b, vp);
#pragma unroll
      for (int cc = 0; cc < 2; ++cc) { const int jc = h * 64 + (2 * cp + cc) * 16 + 4 * fq;
          pf.r[cc][0] = *(const v2u*)(p0 + RR + jc); pf.r[cc][1] = *(const v2u*)(p1 + RR + jc);
          pf.k[cc][0] = *(const v2u*)(p0 + RK + jc); pf.k[cc][1] = *(const v2u*)(p1 + RK + jc);
          pf.v[cc][0] = *(const v2u*)(p0 + RV + jc); pf.v[cc][1] = *(const v2u*)(p1 + RV + jc); } }
}
__device__ __forceinline__ f32x4 unpk4(v2u w) { return (f32x4){bflo(w.x), bfhi(w.x), bflo(w.y), bfhi(w.y)}; }

__device__ __forceinline__ void rwkv_l1_front(const Args& a, const Frame& F, int b, int h, int c, const L1Pf& pf, f32x4 (&rtil)[2], bool newgrp, bf16x8 (&lrf)[8]) {
    unsigned char* ws = a.ws;
    const bf16* W2T = (const bf16*)(ws + WS_W2T); const bf16* A2T = (const bf16*)(ws + WS_A2T); const bf16* G2T = (const bf16*)(ws + WS_G2T);
    const int unit = (b * 8 + h) * NCH + c;
    unsigned char* r1 = ws + WS_R1 + (size_t)unit * R1_STRIDE;
    float* GAM = (float*)(ws + WS_GAM) + (size_t)unit * 64;
    const float* mu = a.in[I_MU];
    const int vp0 = (c == 0) ? -48 : NMETA + 64 * (c - 1);
    constexpr int LRP = 264;
    LAS bf16* LR = (LAS bf16*)(F.lds + L1_LR);
    LAS float* LC = (LAS float*)(F.lds + L1_LC);
    LAS float* XCH = (LAS float*)(F.lds + L1_XCH);
    const int rt = F.wave & 3, cp = F.wave >> 2, fr = F.lane & 15, fq = F.lane >> 4;
    if (newgrp) {
        const int cg = F.tid & 31, tr = F.tid >> 5;
        const f32x4 m0 = *(const f32x4*)(mu + 1536 + 8 * cg), m1 = *(const f32x4*)(mu + 1536 + 8 * cg + 4);
#pragma unroll
        for (int i = 0; i < 4; ++i) {
            const int row = 4 * tr + i;
            const v4u cw = pf.sa[i + 1], pw = pf.sa[i];
            const f32x4 c0 = unpk4((v2u){cw.x, cw.y}), c1 = unpk4((v2u){cw.z, cw.w}), p0 = unpk4((v2u){pw.x, pw.y}), p1 = unpk4((v2u){pw.z, pw.w});
            float v[8];
            v[0] = c0.x + (p0.x - c0.x) * m0.x; v[1] = c0.y + (p0.y - c0.y) * m0.y; v[2] = c0.z + (p0.z - c0.z) * m0.z; v[3] = c0.w + (p0.w - c0.w) * m0.w;
            v[4] = c1.x + (p1.x - c1.x) * m1.x; v[5] = c1.y + (p1.y - c1.y) * m1.y; v[6] = c1.z + (p1.z - c1.z) * m1.z; v[7] = c1.w + (p1.w - c1.w) * m1.w;
#pragma unroll
            for (int q = 0; q < 8; ++q) { if (cg < 8) v[q] = ftanh(v[q]); else if (cg >= 16) v[q] = fsigmoid(v[q]); }
            v4u o; o.x = pk2(v[0], v[1]); o.y = pk2(v[2], v[3]); o.z = pk2(v[4], v[5]); o.w = pk2(v[6], v[7]);
            *(LAS v4u*)(LR + row * LRP + 8 * cg) = o;
        }
    }
    const int t = rt * 16 + fr, vp = vp0 + t;
    const bool valid = vp >= 0;
    if (newgrp) { lds_barrier();
        const LAS bf16* lrow = LR + t * LRP + 8 * fq;
#pragma unroll
        for (int q = 0; q < 8; ++q) lrf[q] = *(const LAS bf16x8*)(lrow + q * 32); }
    float lwv[2][4], asg[2][4], kkr[2][4], kmd[2][4], rrv[2][4], vvv[2][4];
    float ssq = 0.f, bon = 0.f;
    {
#pragma unroll
        for (int cc = 0; cc < 2; ++cc) {
            const int ct = 2 * cp + cc, j = ct * 16 + 4 * fq, jc = h * 64 + j;
            f32x4 mr[2], mk[2], mv[2], w0v[2], a0v[2], kkw[2], kaw[2], rkw[2];
            mr[cc] = *(const f32x4*)(mu + jc); mk[cc] = *(const f32x4*)(mu + 512 + jc); mv[cc] = *(const f32x4*)(mu + 1024 + jc);
            w0v[cc] = *(const f32x4*)(a.in[I_W0] + jc); a0v[cc] = *(const f32x4*)(a.in[I_A0] + jc);
            kkw[cc] = *(const f32x4*)(a.in[I_KK] + jc); kaw[cc] = *(const f32x4*)(a.in[I_KA] + jc); rkw[cc] = *(const f32x4*)(a.in[I_RK] + jc);
            f32x4 aw = {0.f, 0.f, 0.f, 0.f}, aa = aw, ag = aw;
#pragma unroll
            for (int ks = 0; ks < 2; ++ks) {
                aw = mfma16(*(const bf16x8*)(W2T + (size_t)(h * 64 + ct * 16 + fr) * 64 + ks * 32 + 8 * fq), lrf[ks], aw);
                aa = mfma16(*(const bf16x8*)(A2T + (size_t)(h * 64 + ct * 16 + fr) * 64 + ks * 32 + 8 * fq), lrf[2 + ks], aa);
            }
#pragma unroll
            for (int ks = 0; ks < 4; ++ks) ag = mfma16(*(const bf16x8*)(G2T + (size_t)(h * 64 + ct * 16 + fr) * 128 + ks * 32 + 8 * fq), lrf[4 + ks], ag);
            const f32x4 rc = unpk4(pf.r[cc][1]), rp = unpk4(pf.r[cc][0]), kc = unpk4(pf.k[cc][1]), kp = unpk4(pf.k[cc][0]), vc = unpk4(pf.v[cc][1]), vpv = unpk4(pf.v[cc][0]);
            const f32x4 rs = rc + (rp - rc) * mr[cc], ks_ = kc + (kp - kc) * mk[cc], vs = vc + (vpv - vc) * mv[cc];
#pragma unroll
            for (int i = 0; i < 4; ++i) {
                const float u = w0v[cc][i] + aw[i];
                const float wl = -fsoftplus(-u) - 0.5f;
                lwv[cc][i] = valid ? -fexp(wl) : 0.f;
                const float as_ = fsigmoid(a0v[cc][i] + aa[i]);
                asg[cc][i] = as_;
                const float kraw = ks_[i], kk = kraw * kkw[cc][i];
                kkr[cc][i] = kk; ssq += kk * kk;
                const float km = kraw * (1.f + (as_ - 1.f) * kaw[cc][i]);
                kmd[cc][i] = km; rrv[cc][i] = rs[i]; vvv[cc][i] = vs[i];
                bon += rs[i] * km * rkw[cc][i];
            }
            *(v2u*)(r1 + 4 * 8192 + (size_t)(t * 64 + j) * 2) = pack4(ag);
            __builtin_amdgcn_sched_barrier(0);
        }
#pragma unroll
        for (int cc = 0; cc < 2; ++cc)
#pragma unroll
            for (int i = 0; i < 4; ++i) LC[t * 65 + (2 * cp + cc) * 16 + 4 * fq + i] = lwv[cc][i];
        ssq += shx(ssq, 16, F.lane); ssq += shx(ssq, 32, F.lane);
        bon += shx(bon, 16, F.lane); bon += shx(bon, 32, F.lane);
        if (fq == 0) { XCH[(cp * 64 + t) * 2] = ssq; XCH[(cp * 64 + t) * 2 + 1] = bon; }
    }
    lds_barrier();
    const float ssq_t = XCH[t * 2] + XCH[(64 + t) * 2], bon_t = XCH[t * 2 + 1] + XCH[(64 + t) * 2 + 1];
    const float inv = 1.f / fmaxf(sqrtf(ssq_t), 1e-12f);
    {
        LAS float* SEG = XCH + 256;
        const int jj = F.tid & 63, sg = F.tid >> 6;
        float cv[8];
#pragma unroll
        for (int i = 0; i < 8; ++i) cv[i] = LC[(sg * 8 + i) * 65 + jj];
#pragma unroll
        for (int i = 1; i < 8; ++i) cv[i] += cv[i - 1];
        SEG[sg * 64 + jj] = cv[7];
        lds_barrier();
        float pre = 0.f;
#pragma unroll
        for (int s2 = 0; s2 < 7; ++s2) pre += (s2 < sg) ? SEG[s2 * 64 + jj] : 0.f;
#pragma unroll
        for (int i = 0; i < 8; ++i) LC[(sg * 8 + i) * 65 + jj] = cv[i] + pre;
    }
    lds_barrier();
    {
#pragma unroll
        for (int cc = 0; cc < 2; ++cc) {
            const int j = (2 * cp + cc) * 16 + 4 * fq;
            f32x4 At, Bt, Kt, Bh, Kh, bvv;
#pragma unroll
            for (int i = 0; i < 4; ++i) {
                const float Lc = LC[t * 65 + j + i], LcC = LC[63 * 65 + j + i];
                const float kn = kkr[cc][i] * inv, av = -kn, bv = kn * asg[cc][i], km = kmd[cc][i];
                const float eA = fexp(Lc - lwv[cc][i]), eR = fexp(Lc), eB = fexp(-Lc), eH = fexp(LcC - Lc);
                At[i] = av * eA; rtil[cc][i] = rrv[cc][i] * eR; Bt[i] = bv * eB; Kt[i] = km * eB; Bh[i] = bv * eH; Kh[i] = km * eH;
                bvv[i] = bon_t * vvv[cc][i];
                if (t == 63) GAM[j + i] = fexp(LcC);
            }
            *(LAS v2u*)(L1S(0) + t * TP + j) = pack4(Bt); *(LAS v2u*)(L1S(1) + t * TP + j) = pack4(Kt);
            *(LAS v2u*)(L1S(2) + t * TP + j) = pack4(At); *(LAS v2u*)(L1S(3) + t * TP + j) = pack4(rtil[cc]);
#pragma unroll
            for (int i = 0; i < 4; ++i) {
                L1S(4)[(j + i) * TP + t] = (bf16)f2bf(At[i]); L1S(5)[(j + i) * TP + t] = (bf16)f2bf(Bh[i]);
                L1S(6)[(j + i) * TP + t] = (bf16)f2bf(Kh[i]); L1S(7)[(j + i) * TP + t] = (bf16)f2bf(vvv[cc][i]);
            }
            *(v2u*)(r1 + 5 * 8192 + (size_t)(t * 64 + j) * 2) = pack4(bvv);
        }
    }
    lds_barrier();
}
__device__ __forceinline__ void rwkv_l1_back(const Args& a, const Frame& F, int b, int h, int c, const f32x4 (&rtil)[2]) {
    unsigned char* r1 = a.ws + WS_R1 + (size_t)((b * 8 + h) * NCH + c) * R1_STRIDE;
    const int rt = F.wave & 3, cp = F.wave >> 2, fr = F.lane & 15, fq = F.lane >> 4;
    f32x4 Pt[2];
    const int mrow = rt * 16 + fr;
    const f32x4 z = {0.f, 0.f, 0.f, 0.f};
    {
        f32x4 Lv[2], Nv[2], Mv[2], Bv[2], Kv[2];
#pragma unroll
        for (int cc = 0; cc < 2; ++cc) { const int ct = 2 * cp + cc;
            Lv[cc] = tile_mm(L1S(2), L1S(0), rt, ct, fr, fq, z); Nv[cc] = tile_mm(L1S(0), L1S(2), rt, ct, fr, fq, z); Mv[cc] = tile_mm(L1S(2), L1S(1), rt, ct, fr, fq, z);
            Bv[cc] = tile_mm(L1S(3), L1S(0), rt, ct, fr, fq, z); Kv[cc] = tile_mm(L1S(3), L1S(1), rt, ct, fr, fq, z); }
#pragma unroll
        for (int cc = 0; cc < 2; ++cc) { const int ct = 2 * cp + cc, n0 = ct * 16 + 4 * fq;
#pragma unroll
            for (int i = 0; i < 4; ++i) { const int n = n0 + i;
                if (!(n < mrow)) { Lv[cc][i] = 0.f; Mv[cc][i] = 0.f; } if (!(mrow < n)) Nv[cc][i] = 0.f; if (!(n <= mrow)) { Bv[cc][i] = 0.f; Kv[cc][i] = 0.f; }
                Pt[cc][i] = Lv[cc][i] + ((n == mrow) ? 1.f : 0.f); }
            tile_st(L1S(8), rt, ct, fr, fq, Lv[cc]); tile_st(L1S(9), rt, ct, fr, fq, Nv[cc]); tile_st(L1S(10), rt, ct, fr, fq, Mv[cc]);
            tile_st(L1S(11), rt, ct, fr, fq, Bv[cc]); tile_st(L1S(12), rt, ct, fr, fq, Kv[cc]); }
    }
    lds_barrier();
    f32x4 Xv[2];
#pragma unroll
    for (int st = 1; st <= 6; ++st) {
        LAS bf16* Xl = (st & 1) ? L1S(8) : L1S(0); LAS bf16* Xn = (st & 1) ? L1S(9) : L1S(1);
        LAS bf16* Yl = (st & 1) ? L1S(0) : L1S(8); LAS bf16* Yn = (st & 1) ? L1S(1) : L1S(9);
        LAS bf16* Pr = (st & 1) ? L1S(2) : L1S(3); LAS bf16* Pw = (st & 1) ? L1S(3) : L1S(2);
        f32x4 l2[2], n2[2];
#pragma unroll
        for (int cc = 0; cc < 2; ++cc) { const int ct = 2 * cp + cc;
            if (st <= 5) { l2[cc] = tile_mm(Xl, Xn, rt, ct, fr, fq, z); n2[cc] = tile_mm(Xn, Xl, rt, ct, fr, fq, z); }
            if (st >= 2) Pt[cc] = tile_mm(Pr, Xn, rt, ct, fr, fq, Pt[cc]);
            if (st == 1) Xv[cc] = tile_mm(L1S(7), L1S(10), rt, ct, fr, fq, z); }
#pragma unroll
        for (int cc = 0; cc < 2; ++cc) { const int ct = 2 * cp + cc;
            if (st <= 5) { tile_st(Yl, rt, ct, fr, fq, l2[cc]); tile_st(Yn, rt, ct, fr, fq, n2[cc]); }
            tile_st(Pw, rt, ct, fr, fq, Pt[cc]); }
        if (st == 1) { lds_barrier();
#pragma unroll
            for (int cc = 0; cc < 2; ++cc) tile_st(L1S(10), rt, 2 * cp + cc, fr, fq, Xv[cc]); }
        lds_barrier();
    }
    {
        f32x4 u[2], w[2];
#pragma unroll
        for (int cc = 0; cc < 2; ++cc) { const int ct = 2 * cp + cc; u[cc] = tile_mm(L1S(10), L1S(2), rt, ct, fr, fq, z); w[cc] = tile_mm(L1S(4), L1S(2), rt, ct, fr, fq, z); }
#pragma unroll
        for (int cc = 0; cc < 2; ++cc) { const int ct = 2 * cp + cc; tile_st(L1S(8), rt, ct, fr, fq, u[cc]); tile_st(L1S(9), rt, ct, fr, fq, w[cc]); }
    }
    lds_barrier();
    {
#pragma unroll
        for (int cc = 0; cc < 2; ++cc) { const int ct = 2 * cp + cc; const size_t eo = (size_t)(mrow * 64 + ct * 16 + 4 * fq) * 2;
            const f32x4 gp = tile_mm(L1S(5), L1S(9), rt, ct, fr, fq, z);
            const f32x4 hh = tile_mm(L1S(7), L1S(6), rt, ct, fr, fq, tile_mm(L1S(8), L1S(5), rt, ct, fr, fq, z));
            const f32x4 rh = tile_mm(L1S(11), L1S(9), rt, ct, fr, fq, rtil[cc]);
            const f32x4 yl = tile_mm(L1S(12), L1S(7), rt, ct, fr, fq, tile_mm(L1S(11), L1S(8), rt, ct, fr, fq, z));
            *(v2u*)(r1 + 0 * 8192 + eo) = pack4(gp); *(v2u*)(r1 + 1 * 8192 + eo) = pack4(hh);
            *(v2u*)(r1 + 2 * 8192 + eo) = pack4(rh); *(v2u*)(r1 + 3 * 8192 + eo) = pack4(yl); }
    }
    lds_barrier();
}

constexpr int BCP = 65;
__device__ __forceinline__ void gla_bc(const Args& a, const Frame& F, int b, int h, int vp0, int ntok) {
    const bf16* PROJ = (const bf16*)(a.ws + WS_PROJ); const bf16* PROJM = (const bf16*)(a.ws + WS_PROJM);
    LAS float* GKLs = (LAS float*)F.lds; LAS float* BC = (LAS float*)(F.lds + 4096);
    if (F.tid < 256) { const int t = F.tid >> 2, q = F.tid & 3;
        const f32x4 v = ldp4(PROJ, PROJM, b, (t < ntok) ? vp0 + t : -1, GKL + 4 * q);
        *(LAS f32x4*)(GKLs + t * 16 + 4 * q) = v; }
    lds_barrier();
    {
        const int d = F.tid & 63, tg = F.tid >> 6;
        float wc[16];
#pragma unroll
        for (int r = 0; r < 16; ++r) wc[r] = a.in[I_GKW2][r * 256 + h * 64 + d];
        const float gb = a.in[I_GKB][h * 64 + d];
        float lgv[8];
#pragma unroll
        for (int i = 0; i < 8; ++i) { const int t = tg * 8 + i; float z = gb;
            const LAS f32x4* g4 = (const LAS f32x4*)(GKLs + t * 16);
#pragma unroll
            for (int q = 0; q < 4; ++q) { const f32x4 gv = g4[q]; z += gv.x * wc[4 * q] + gv.y * wc[4 * q + 1] + gv.z * wc[4 * q + 2] + gv.w * wc[4 * q + 3]; }
            lgv[i] = (t < ntok) ? flogsigmoid(z) * (1.f / 16.f) : 0.f; }
        LAS float* SEG = (LAS float*)(F.lds + 20736);
#pragma unroll
        for (int i = 1; i < 8; ++i) lgv[i] += lgv[i - 1];
        SEG[tg * 64 + d] = lgv[7];
        lds_barrier();
        float pre = 0.f;
#pragma unroll
        for (int s2 = 0; s2 < 7; ++s2) pre += (s2 < tg) ? SEG[s2 * 64 + d] : 0.f;
#pragma unroll
        for (int i = 0; i < 8; ++i) BC[(tg * 8 + i) * BCP + d] = lgv[i] + pre;
    }
    lds_barrier();
}

__device__ __forceinline__ void gla_g1_unit(const Args& a, const Frame& F, int b, int h, int c) {
    const bf16* PROJ = (const bf16*)(a.ws + WS_PROJ); const bf16* PROJM = (const bf16*)(a.ws + WS_PROJM);
    float* GUS = (float*)(a.ws + WS_GUS); float* DL = (float*)(a.ws + WS_DL);
    const int ntok = (c == 0) ? NMETA : 64, vp0 = (c == 0) ? 0 : NMETA + 64 * (c - 1);
    gla_bc(a, F, b, h, vp0, ntok);
    LAS float* BC = (LAS float*)(F.lds + 4096);
    LAS bf16* KT = (LAS bf16*)(F.lds + 24576);
    LAS bf16* VT = (LAS bf16*)(F.lds + 24576 + 64 * TP * 2);
    {
        const int t = F.tid >> 3, q = F.tid & 7;
        const float* bl = nullptr; (void)bl;
#pragma unroll
        for (int half = 0; half < 2; ++half) {
            const int d0 = 8 * q + 4 * half;
            const f32x4 kv = ldp4(PROJ, PROJM, b, (t < ntok) ? vp0 + t : -1, GK + h * 64 + d0);
#pragma unroll
            for (int i = 0; i < 4; ++i) { const int d = d0 + i; const float e = (t < ntok) ? fexp(BC[(ntok - 1) * BCP + d] - BC[t * BCP + d]) : 0.f;
                KT[d * TP + t] = (bf16)f2bf(kv[i] * e); }
        }
#pragma unroll
        for (int qq = 0; qq < 4; ++qq) {
            const int e0 = 16 * q + 4 * qq;
            const f32x4 vv = ldp4(PROJ, PROJM, b, (t < ntok) ? vp0 + t : -1, GV + h * 128 + e0);
#pragma unroll
            for (int i = 0; i < 4; ++i) VT[(e0 + i) * TP + t] = (bf16)f2bf(vv[i]);
        }
    }
    lds_barrier();
    {
        const int rt = F.wave & 3, ch = F.wave >> 2, fr = F.lane & 15, fq = F.lane >> 4;
        float* up = GUS + ((size_t)((b * 4 + h) * NCH + c) * 64 + rt * 16 + fr) * 128;
#pragma unroll
        for (int cc = 0; cc < 4; ++cc) { const int ct = ch * 4 + cc;
            f32x4 acc = {0.f, 0.f, 0.f, 0.f};
#pragma unroll
            for (int ks = 0; ks < 2; ++ks)
                acc = mfma16(*(const LAS bf16x8*)(VT + (ct * 16 + fr) * TP + ks * 32 + 8 * fq), *(const LAS bf16x8*)(KT + (rt * 16 + fr) * TP + ks * 32 + 8 * fq), acc);
            *(f32x4*)(up + ct * 16 + 4 * fq) = acc; }
        if (F.tid < 64) DL[(size_t)((b * 4 + h) * NCH + c) * 64 + F.tid] = fexp(BC[(ntok - 1) * BCP + F.tid]);
    }
    lds_barrier();
}

__device__ __forceinline__ void phase2(const Args& a, const Frame& F) {
    {
        constexpr int NU = NB * 8 * NCH;
        const int u0 = (int)((long)F.blk * NU / F.G), u1 = (int)((long)(F.blk + 1) * NU / F.G);
        L1Pf pf;
        bf16x8 lrf[8];
        if (u0 < u1) l1_fetch(a, F, (u0 >> 3) / NCH, u0 & 7, (u0 >> 3) % NCH, pf, true);
        unsigned long long tf_ = 0, tb_ = 0;
        for (int u = u0; u < u1; ++u) {
            const int h = u & 7, c = (u >> 3) % NCH, b = (u >> 3) / NCH; f32x4 rtil[2];
            const bool newgrp = (u == u0) || (h == 0);
            { const Frame F1 = mkframe(F.lds, F.wave); rwkv_l1_front(a, F1, b, h, c, pf, rtil, newgrp, lrf); }
            { const Frame F2 = mkframe(F.lds, F.wave);
              if (u + 1 < u1) l1_fetch(a, F2, ((u + 1) >> 3) / NCH, (u + 1) & 7, ((u + 1) >> 3) % NCH, pf, ((u + 1) & 7) == 0);
              rwkv_l1_back(a, F2, b, h, c, rtil); }
        }
        if ((REP_MASK >> 16) != 0) {
            const unsigned long long dt_ = ((REP_MASK >> 16) == 1) ? tf_ : tb_, s0_ = __builtin_amdgcn_s_memrealtime();
            while (__builtin_amdgcn_s_memrealtime() - s0_ < dt_) __builtin_amdgcn_s_sleep(8);
        }
    }
    for (int rep_ = 0; rep_ < NREP(12); ++rep_)
    for (int u = F.blk; u < NB * 4 * 32; u += F.G) { const int c = u & 31, bh = u >> 5; const Frame F1 = mkframe(F.lds, F.wave); gla_g1_unit(a, F1, bh >> 2, bh & 3, c); }
}

struct L2S { bf16x8 fg[4]; v2u hq[2]; f32x4 gm[2]; };
__device__ __forceinline__ void l2s_fetch(L2S& r, const unsigned char* hp, const unsigned char* gp, const float* gam) {
#pragma unroll
    for (int cc = 0; cc < 2; ++cc) { r.fg[2 * cc] = *(const bf16x8*)(gp + cc * 2048); r.fg[2 * cc + 1] = *(const bf16x8*)(gp + cc * 2048 + 64);
        r.hq[cc] = *(const v2u*)(hp + cc * 32); r.gm[cc] = *(const f32x4*)(gam + cc * 16); }
}
__device__ __forceinline__ void l2s_step(const L2S& r, const LAS bf16* Sc, LAS bf16* Sn, f32x4 (&Sm)[2], int row, int col0, int fq, bf16* gout, int tid) {
    {
        const int r_ = tid >> 3, c8 = tid & 7;
        *(v4u*)(gout + r_ * 64 + 8 * c8) = *(const LAS v4u*)(Sc + r_ * TP + 8 * c8);
    }
    const bf16x8 af0 = *(const LAS bf16x8*)(Sc + row * TP + 8 * fq), af1 = *(const LAS bf16x8*)(Sc + row * TP + 32 + 8 * fq);
#pragma unroll
    for (int cc = 0; cc < 2; ++cc) {
        f32x4 acc = {bflo(r.hq[cc].x), bfhi(r.hq[cc].x), bflo(r.hq[cc].y), bfhi(r.hq[cc].y)};
        acc = mfma16(r.fg[2 * cc], af0, acc);
        acc = mfma16(r.fg[2 * cc + 1], af1, acc);
        Sm[cc] = Sm[cc] * r.gm[cc] + acc; }
#pragma unroll
    for (int cc = 0; cc < 2; ++cc) *(LAS v2u*)(Sn + row * TP + col0 + cc * 16) = pack4(Sm[cc]);
}
__device__ __forceinline__ void rwkv_l2_unit(const Args& a, const Frame& F, int bh) {
    unsigned char* ws = a.ws;
    LAS bf16* Sb0 = (LAS bf16*)F.lds; LAS bf16* Sb1 = Sb0 + 64 * TP;
    const int fr = F.lane & 15, fq = F.lane >> 4, rt = F.wave & 3, cp = F.wave >> 2;
    const int row = rt * 16 + fr, col0 = cp * 32 + 4 * fq;
    const unsigned char* hpb = ws + WS_R1 + (size_t)bh * NCH * R1_STRIDE + 8192 + (size_t)(row * 64 + col0) * 2;
    const unsigned char* gpb = ws + WS_R1 + (size_t)bh * NCH * R1_STRIDE + (size_t)((cp * 32 + fr) * 64 + 8 * fq) * 2;
    const float* gamb = (const float*)(ws + WS_GAM) + (size_t)bh * NCH * 64 + col0;
    bf16* sst = (bf16*)(ws + WS_SST) + (size_t)bh * NCH * 4096;
    f32x4 Sm[2];
#pragma unroll
    for (int cc = 0; cc < 2; ++cc) { Sm[cc] = (f32x4){0.f, 0.f, 0.f, 0.f}; *(LAS v2u*)(Sb0 + row * TP + col0 + cc * 16) = (v2u){0u, 0u}; }
    L2S r0, r1, r2, r3;
#define L2F(rr, cn) l2s_fetch(rr, hpb + (size_t)(cn) * R1_STRIDE, gpb + (size_t)(cn) * R1_STRIDE, gamb + (size_t)(cn) * 64)
    L2F(r0, 0); L2F(r1, 1); L2F(r2, 2);
    lds_barrier();
#pragma nounroll
    for (int c = 0; c < NCH - 1; c += 4) {
        L2F(r3, c + 3);
        l2s_step(r0, Sb0, Sb1, Sm, row, col0, fq, sst + (size_t)c * 4096, F.tid); lds_barrier();
        if (c + 4 < NCH - 1) L2F(r0, c + 4);
        l2s_step(r1, Sb1, Sb0, Sm, row, col0, fq, sst + (size_t)(c + 1) * 4096, F.tid); lds_barrier();
        if (c + 5 < NCH - 1) L2F(r1, c + 5);
        l2s_step(r2, Sb0, Sb1, Sm, row, col0, fq, sst + (size_t)(c + 2) * 4096, F.tid); lds_barrier();
        if (c + 6 < NCH - 1) L2F(r2, c + 6);
        l2s_step(r3, Sb1, Sb0, Sm, row, col0, fq, sst + (size_t)(c + 3) * 4096, F.tid); lds_barrier();
    }
#undef L2F
    { const int r_ = F.tid >> 3, c8 = F.tid & 7;
      *(v4u*)(sst + (size_t)(NCH - 1) * 4096 + r_ * 64 + 8 * c8) = *(const LAS v4u*)(Sb0 + r_ * TP + 8 * c8); }
    lds_barrier();
}
__device__ __forceinline__ void rwkv_y_task(const Args& a, const Frame& F, int task) {
    unsigned char* ws = a.ws;
    const int c = 1 + (task & 31), bh = task >> 5, b = bh >> 3, h = bh & 7;
    const int fr = F.lane & 15, fq = F.lane >> 4;
    const bf16* Sg = (const bf16*)(ws + WS_SST) + (size_t)(bh * NCH + c) * 4096 + fr * 64 + 8 * fq;
    bf16x8 sf[8];
#pragma unroll
    for (int ct = 0; ct < 4; ++ct) { sf[2 * ct] = *(const bf16x8*)(Sg + ct * 1024); sf[2 * ct + 1] = *(const bf16x8*)(Sg + ct * 1024 + 32); }
    f32x4 lg[4], lb[4];
#pragma unroll
    for (int ct = 0; ct < 4; ++ct) { const int i0 = h * 64 + ct * 16 + 4 * fq; lg[ct] = *(const f32x4*)(a.in[I_RLNG] + i0); lb[ct] = *(const f32x4*)(a.in[I_RLNB] + i0); }
    LAS bf16* ost = (LAS bf16*)(F.lds + 102400 + F.wave * 2304);
    const unsigned char* r1u = ws + WS_R1 + (size_t)(bh * NCH + c) * R1_STRIDE + (size_t)(fr * 64 + 4 * fq) * 2;
    bf16x8 fa0[4], fa1[4]; v2u q0[4][4];
#pragma unroll
    for (int rt = 0; rt < 4; ++rt) { const unsigned char* r1 = r1u + rt * 2048;
        fa0[rt] = *(const bf16x8*)(r1 + 2 * 8192 + 8 * fq); fa1[rt] = *(const bf16x8*)(r1 + 2 * 8192 + 64 + 8 * fq);
#pragma unroll
        for (int ct = 0; ct < 4; ++ct) q0[rt][ct] = *(const v2u*)(r1 + 3 * 8192 + ct * 32); }
#pragma unroll
    for (int rt = 0; rt < 4; ++rt) {
        const unsigned char* r1 = r1u + rt * 2048;
        v2u q1[4], q2[4];
#pragma unroll
        for (int ct = 0; ct < 4; ++ct) { q1[ct] = *(const v2u*)(r1 + 4 * 8192 + ct * 32); q2[ct] = *(const v2u*)(r1 + 5 * 8192 + ct * 32); }
        f32x4 y[4]; float s = 0.f;
#pragma unroll
        for (int ct = 0; ct < 4; ++ct) {
            f32x4 acc = {bflo(q0[rt][ct].x), bfhi(q0[rt][ct].x), bflo(q0[rt][ct].y), bfhi(q0[rt][ct].y)};
            acc = mfma16(sf[2 * ct], fa0[rt], acc); acc = mfma16(sf[2 * ct + 1], fa1[rt], acc);
            y[ct] = acc; s += (acc[0] + acc[1]) + (acc[2] + acc[3]); }
        s += shx(s, 16, F.lane); s += shx(s, 32, F.lane);
        const float mean = s * (1.f / 64.f); float q = 0.f;
#pragma unroll
        for (int ct = 0; ct < 4; ++ct) { y[ct] = y[ct] - mean; q += (y[ct][0] * y[ct][0] + y[ct][1] * y[ct][1]) + (y[ct][2] * y[ct][2] + y[ct][3] * y[ct][3]); }
        q += shx(q, 16, F.lane); q += shx(q, 32, F.lane);
        const float rstd = __builtin_amdgcn_rsqf(q * (1.f / 64.f) + 64e-5f);
#pragma unroll
        for (int ct = 0; ct < 4; ++ct) {
            const f32x4 g = {bflo(q1[ct].x), bfhi(q1[ct].x), bflo(q1[ct].y), bfhi(q1[ct].y)}, bv = {bflo(q2[ct].x), bfhi(q2[ct].x), bflo(q2[ct].y), bfhi(q2[ct].y)};
            const f32x4 o = (y[ct] * rstd * lg[ct] + lb[ct] + bv) * g;
            *(LAS v2u*)(ost + fr * 72 + ct * 16 + 4 * fq) = pack4(o); }
        asm volatile("s_waitcnt lgkmcnt(0)" ::: "memory");
        bf16* yout = (bf16*)(ws + WS_YMIX) + ((size_t)b * SEQ + 64 * (c - 1) + rt * 16) * D + 512 + h * 64;
#pragma unroll
        for (int hh = 0; hh < 2; ++hh) { const int tr = (F.lane >> 3) + 8 * hh, c8 = F.lane & 7;
            *(v4u*)(yout + (size_t)tr * D + 8 * c8) = *(const LAS v4u*)(ost + tr * 72 + 8 * c8); }
        asm volatile("s_waitcnt lgkmcnt(0)" ::: "memory");
    }
}
__device__ __forceinline__ void gla_scan_unit(const Args& a, const Frame& F, int j) {
    float* GUS = (float*)(a.ws + WS_GUS); const float* DL = (const float*)(a.ws + WS_DL);
    const int bh = j >> 1, half = j & 1;
    const int d = 32 * half + (F.tid >> 4), e0 = (F.tid & 15) * 8;
    float* base = GUS + (size_t)bh * NCH * 8192 + d * 128 + e0;
    const float* dl = DL + (size_t)bh * NCH * 64 + d;
    f32x4 s0 = {0.f, 0.f, 0.f, 0.f}, s1 = s0;
    f32x4 ua[4], ub[4]; float dq[4];
#pragma unroll
    for (int q = 0; q < 3; ++q) { ua[q] = *(const f32x4*)(base + (size_t)q * 8192); ub[q] = *(const f32x4*)(base + (size_t)q * 8192 + 4); dq[q] = dl[q * 64]; }
#pragma unroll 4
    for (int c = 0; c < NCH - 1; ++c) {
        const int cn = (c + 3 < NCH - 1) ? c + 3 : NCH - 2;
        ua[(c + 3) & 3] = *(const f32x4*)(base + (size_t)cn * 8192); ub[(c + 3) & 3] = *(const f32x4*)(base + (size_t)cn * 8192 + 4); dq[(c + 3) & 3] = dl[cn * 64];
        *(f32x4*)(base + (size_t)c * 8192) = s0; *(f32x4*)(base + (size_t)c * 8192 + 4) = s1;
        s0 = s0 * dq[c & 3] + ua[c & 3]; s1 = s1 * dq[c & 3] + ub[c & 3];
    }
    *(f32x4*)(base + (size_t)(NCH - 1) * 8192) = s0; *(f32x4*)(base + (size_t)(NCH - 1) * 8192 + 4) = s1;
}
__device__ __forceinline__ void phase3(const Args& a, const Frame& F) {
    constexpr int PSEL = (REP_MASK >> 20) & 7;
    const unsigned long long t0_ = PSEL ? __builtin_amdgcn_s_memrealtime() : 0ull;
    for (int u = F.blk; u < 256; u += F.G) {
        if (u < 128) { for (int rep_ = 0; rep_ < NREP(3); ++rep_) rwkv_l2_unit(a, F, u); }
        else gla_scan_unit(a, F, u - 128);
    }
    if (PSEL) { const unsigned long long t1_ = __builtin_amdgcn_s_memrealtime();
        unsigned long long dt_ = 0;
        if (PSEL == 1 && F.blk < 128) dt_ = t1_ - t0_;
        if (PSEL == 2 && F.blk >= 128) dt_ = t1_ - t0_;
        while (__builtin_amdgcn_s_memrealtime() - t1_ < dt_) __builtin_amdgcn_s_sleep(8); }
}

__device__ __forceinline__ void gla_g3_unit(const Args& a, const Frame& F, int b, int h, int c) {
    const bf16* PROJ = (const bf16*)(a.ws + WS_PROJ); const bf16* PROJM = (const bf16*)(a.ws + WS_PROJM);
    const float* GUS = (const float*)(a.ws + WS_GUS); bf16* YMIX = (bf16*)(a.ws + WS_YMIX);
    const int vp0 = NMETA + 64 * (c - 1);
    gla_bc(a, F, b, h, vp0, 64);
    LAS float* BC = (LAS float*)(F.lds + 4096);
    LAS bf16* QT = (LAS bf16*)(F.lds + 24576);
    LAS bf16* KL = QT + 64 * TP;
    LAS bf16* AT = KL + 64 * TP;
    LAS bf16* VT = AT + 64 * TP;
    LAS bf16* ST = VT + 128 * TP;
    LAS float* RS = (LAS float*)(ST + 128 * TP);
    {
        const int t = F.tid >> 3, q = F.tid & 7;
        const f32x4 q0 = ldp4(PROJ, PROJM, b, vp0 + t, GQ + h * 64 + 8 * q), q1 = ldp4(PROJ, PROJM, b, vp0 + t, GQ + h * 64 + 8 * q + 4);
        const f32x4 k0 = ldp4(PROJ, PROJM, b, vp0 + t, GK + h * 64 + 8 * q), k1 = ldp4(PROJ, PROJM, b, vp0 + t, GK + h * 64 + 8 * q + 4);
        float qv[8] = {q0.x, q0.y, q0.z, q0.w, q1.x, q1.y, q1.z, q1.w}, kv[8] = {k0.x, k0.y, k0.z, k0.w, k1.x, k1.y, k1.z, k1.w};
#pragma unroll
        for (int i = 0; i < 8; ++i) { const float bcv = BC[t * BCP + 8 * q + i]; qv[i] *= fexp(bcv) * 0.125f; kv[i] *= fexp(-bcv); }
        v4u o; o.x = pk2(qv[0], qv[1]); o.y = pk2(qv[2], qv[3]); o.z = pk2(qv[4], qv[5]); o.w = pk2(qv[6], qv[7]);
        *(LAS v4u*)(QT + t * TP + 8 * q) = o;
        o.x = pk2(kv[0], kv[1]); o.y = pk2(kv[2], kv[3]); o.z = pk2(kv[4], kv[5]); o.w = pk2(kv[6], kv[7]);
        *(LAS v4u*)(KL + t * TP + 8 * q) = o;
#pragma unroll
        for (int qq = 0; qq < 4; ++qq) {
            const int e0 = 16 * q + 4 * qq;
            const f32x4 vv = ldp4(PROJ, PROJM, b, vp0 + t, GV + h * 128 + e0);
#pragma unroll
            for (int i = 0; i < 4; ++i) VT[(e0 + i) * TP + t] = (bf16)f2bf(vv[i]);
            const f32x4 sv = *(const f32x4*)(GUS + ((size_t)((b * 4 + h) * NCH + c) * 64 + t) * 128 + e0);
#pragma unroll
            for (int i = 0; i < 4; ++i) ST[(e0 + i) * TP + t] = (bf16)f2bf(sv[i]);
        }
    }
    lds_barrier();
    const int rt = F.wave & 3, wh = F.wave >> 2, fr = F.lane & 15, fq = F.lane >> 4;
    const int trow = rt * 16 + fr;
    {
        f32x4 av[2];
#pragma unroll
        for (int cc = 0; cc < 2; ++cc) { const int ct = 2 * wh + cc;
            f32x4 acc = {0.f, 0.f, 0.f, 0.f};
#pragma unroll
            for (int ks = 0; ks < 2; ++ks)
                acc = mfma16(*(const LAS bf16x8*)(KL + (ct * 16 + fr) * TP + ks * 32 + 8 * fq), *(const LAS bf16x8*)(QT + trow * TP + ks * 32 + 8 * fq), acc);
            const int s0 = ct * 16 + 4 * fq;
#pragma unroll
            for (int i = 0; i < 4; ++i) if (s0 + i > trow) acc[i] = 0.f;
            av[cc] = acc; }
#pragma unroll
        for (int cc = 0; cc < 2; ++cc) *(LAS v2u*)(AT + trow * TP + (2 * wh + cc) * 16 + 4 * fq) = pack4(av[cc]);
    }
    lds_barrier();
    f32x4 oacc[4]; float ssq = 0.f;
#pragma unroll
    for (int cc = 0; cc < 4; ++cc) { const int ct = wh * 4 + cc;
        f32x4 acc = {0.f, 0.f, 0.f, 0.f};
#pragma unroll
        for (int ks = 0; ks < 2; ++ks) {
            acc = mfma16(*(const LAS bf16x8*)(VT + (ct * 16 + fr) * TP + ks * 32 + 8 * fq), *(const LAS bf16x8*)(AT + trow * TP + ks * 32 + 8 * fq), acc);
            acc = mfma16(*(const LAS bf16x8*)(ST + (ct * 16 + fr) * TP + ks * 32 + 8 * fq), *(const LAS bf16x8*)(QT + trow * TP + ks * 32 + 8 * fq), acc);
        }
        oacc[cc] = acc; ssq += (acc[0] * acc[0] + acc[1] * acc[1]) + (acc[2] * acc[2] + acc[3] * acc[3]); }
    ssq += shx(ssq, 16, F.lane); ssq += shx(ssq, 32, F.lane);
    if (fq == 0) RS[wh * 64 + trow] = ssq;
    lds_barrier();
    {
        const float tot = RS[trow] + RS[64 + trow];
        const float rstd = 1.f / sqrtf(tot * (1.f / 128.f) + 1e-6f);
        const size_t m = (size_t)b * SEQ + (vp0 - NMETA) + trow;
#pragma unroll
        for (int cc = 0; cc < 4; ++cc) { const int e0 = (wh * 4 + cc) * 16 + 4 * fq;
            const f32x4 gv = ldp4(PROJ, PROJM, b, vp0 + trow, GG + h * 128 + e0);
            const f32x4 ng = *(const f32x4*)(a.in[I_GNORM] + e0);
            float y[4];
#pragma unroll
            for (int i = 0; i < 4; ++i) { const float gi = gv[i]; y[i] = oacc[cc][i] * rstd * ng[i] * (gi * fsigmoid(gi)); }
            v2u o; o.x = pk2(y[0], y[1]); o.y = pk2(y[2], y[3]);
            *(v2u*)(YMIX + m * D + h * 128 + e0) = o; }
    }
    lds_barrier();
}
__device__ __forceinline__ void phase4(const Args& a, const Frame& F) {
    for (int t = F.blk * NWAVES + F.wave; t < 128 * 32; t += F.G * NWAVES) { const Frame F1 = mkframe(F.lds, F.wave); rwkv_y_task(a, F1, t); }
    __syncthreads();
    for (int u = F.blk; u < NB * 4 * 32; u += F.G) { const int c = 1 + (u & 31), bh = u >> 5; const Frame F1 = mkframe(F.lds, F.wave); gla_g3_unit(a, F1, bh >> 2, bh & 3, c); }
}

__device__ __forceinline__ int eidx_of(int L) { return 16 * (L & 1) + 8 * ((L >> 1) & 1) + 4 * ((L >> 2) & 1) + 2 * ((L >> 3) & 1) + ((L >> 4) & 1); }
__device__ __forceinline__ void p6_ln(const Args& a, const Frame& F, int m, f32x4 (&v)[4], const f32x4 (&g1)[4], const f32x4 (&b1)[4]) {
    unsigned char* ws = a.ws; bf16* H1 = (bf16*)(ws + WS_H1);
    float s = 0.f;
#pragma unroll
    for (int j = 0; j < 4; ++j) s += (v[j].x + v[j].y) + (v[j].z + v[j].w);
    const float mean = wave_sum(s, F.lane) * (1.f / D); float s2 = 0.f;
#pragma unroll
    for (int j = 0; j < 4; ++j) { v[j] = v[j] - mean; s2 += (v[j].x * v[j].x + v[j].y * v[j].y) + (v[j].z * v[j].z + v[j].w * v[j].w); }
    const float rstd = __builtin_amdgcn_rsqf(wave_sum(s2, F.lane) * (1.f / D) + 1e-5f);
#pragma unroll
    for (int j = 0; j < 4; ++j) { const int col = 4 * (F.lane + 64 * j);
        v[j] = v[j] * rstd * g1[j] + b1[j];
        v2u o; o.x = pk2(v[j].x, v[j].y); o.y = pk2(v[j].z, v[j].w);
        *(v2u*)(H1 + (size_t)m * D + col) = o;
        int w8 = __builtin_amdgcn_cvt_pk_fp8_f32(v[j].x, v[j].y, 0, false); w8 = __builtin_amdgcn_cvt_pk_fp8_f32(v[j].z, v[j].w, w8, true);
        *(int*)(ws + WS_H1Q + (size_t)m * D + col) = w8; }
}
__device__ __forceinline__ void phase6(const Args& a, const Frame& F, int csel) {
    unsigned char* ws = a.ws;
    LAS float* LG = (LAS float*)(F.lds + F.wave * 2560);
    LAS int* hist = (LAS int*)(F.lds + 8 * 2560);
    bf16* H1 = (bf16*)(ws + WS_H1);
    const bf16* RWH = (const bf16*)(ws + WS_RWH); const bf16* RWL = (const bf16*)(ws + WS_RWL);
    int* TOPI = (int*)(ws + WS_TOPI); float* GATE = (float*)(ws + WS_GATE); int* RANK = (int*)(ws + WS_RANK);
    unsigned* CNT = (unsigned*)(ws + WS_CTL) + CW_CNT + 2048 * csel;
    for (int rb = F.blk; rb < MX / 128; rb += F.G) {
        if (F.tid < 64) hist[F.tid] = 0;
        __syncthreads();
        const int mb = rb * 128 + F.wave * 16; const Frame& Fo = F;
        {
            const f32x4* xr0 = (const f32x4*)(a.in[I_X] + (size_t)mb * D) + F.lane;
            const v2u* mr0 = (const v2u*)((const bf16*)(ws + WS_MIXB) + (size_t)mb * D) + F.lane;
            const float* st0 = (const float*)(ws + WS_STATS) + 2 * (size_t)mb;
            f32x4 va[4], vb[4], vc[4], vd[4]; v2u ma[4], mbv[4], mc[4], md[4]; float sa0, sa1, sb0, sb1, sc0, sc1, sd0, sd1;
#define P6_LOAD(vv, mmv, s0v, s1v, ii) do { _Pragma("unroll") for (int j = 0; j < 4; ++j) { vv[j] = xr0[(size_t)(ii) * (D / 4) + 64 * j]; mmv[j] = mr0[(size_t)(ii) * (D / 4) + 64 * j]; } s0v = st0[2 * (ii)]; s1v = st0[2 * (ii) + 1]; } while (0)
#define P6_FORM(vv, mmv, s0v, s1v) do { _Pragma("unroll") for (int j = 0; j < 4; ++j) vv[j] = ((vv[j] - s0v) * s1v) * gi[j] + bi[j] + unpk4(mmv[j]); } while (0)
            f32x4 gi[4], bi[4], g1[4], b1[4];
#pragma unroll
            for (int j = 0; j < 4; ++j) { const int col = 4 * (F.lane + 64 * j);
                gi[j] = *(const f32x4*)(a.in[I_LNIN_G] + col) * ALPHA; bi[j] = *(const f32x4*)(a.in[I_LNIN_B] + col) * ALPHA;
                g1[j] = *(const f32x4*)(a.in[I_LN1G] + col); b1[j] = *(const f32x4*)(a.in[I_LN1B] + col); }
            P6_LOAD(va, ma, sa0, sa1, 0); P6_LOAD(vb, mbv, sb0, sb1, 1);
#pragma nounroll
            for (int i = 0; i < 16; i += 4) {
                P6_LOAD(vc, mc, sc0, sc1, i + 2); P6_LOAD(vd, md, sd0, sd1, i + 3);
                P6_FORM(va, ma, sa0, sa1); P6_FORM(vb, mbv, sb0, sb1); p6_ln(a, F, mb + i, va, g1, b1); p6_ln(a, F, mb + i + 1, vb, g1, b1);
                if (i + 4 < 16) { P6_LOAD(va, ma, sa0, sa1, i + 4); P6_LOAD(vb, mbv, sb0, sb1, i + 5); }
                P6_FORM(vc, mc, sc0, sc1); P6_FORM(vd, md, sd0, sd1); p6_ln(a, F, mb + i + 2, vc, g1, b1); p6_ln(a, F, mb + i + 3, vd, g1, b1);
            }
#undef P6_LOAD
#undef P6_FORM
        }
        asm volatile("s_waitcnt vmcnt(0)" ::: "memory");
        {
            const int fr = F.lane & 15, fq = F.lane >> 4;
            const bf16* ap = H1 + (size_t)(mb + fr) * D + 8 * fq;
            const bf16* bh = RWH + (size_t)fr * D + 8 * fq; const bf16* bl = RWL + (size_t)fr * D + 8 * fq;
            f32x4 acc0 = {0.f, 0.f, 0.f, 0.f}, acc1 = acc0;
#pragma unroll 8
            for (int ks = 0; ks < 32; ++ks) { const bf16x8 af = *(const bf16x8*)(ap + ks * 32);
                acc0 = mfma16(*(const bf16x8*)(bh + ks * 32), af, acc0); acc0 = mfma16(*(const bf16x8*)(bl + ks * 32), af, acc0);
                acc1 = mfma16(*(const bf16x8*)(bh + 16 * D + ks * 32), af, acc1); acc1 = mfma16(*(const bf16x8*)(bl + 16 * D + ks * 32), af, acc1); }
            const f32x4 rb0 = *(const f32x4*)(a.in[I_RTB] + 4 * fq), rb1 = *(const f32x4*)(a.in[I_RTB] + 16 + 4 * fq);
#pragma unroll
            for (int q = 0; q < 4; ++q) { LG[fr * 33 + 4 * fq + q] = acc0[q] + rb0[q]; LG[fr * 33 + 16 + 4 * fq + q] = acc1[q] + rb1[q]; }
        }
        asm volatile("s_waitcnt lgkmcnt(0)" ::: "memory");
        LAS int* EK = (LAS int*)(LG + 528);
        if (F.lane < 16) {
            float lv[32];
#pragma unroll
            for (int e = 0; e < 32; ++e) lv[e] = LG[F.lane * 33 + e];
            int ek[4]; float lk[4];
#pragma unroll
            for (int k = 0; k < 4; ++k) { float best = -3.0e38f; int bi = 0;
#pragma unroll
                for (int e = 0; e < 32; ++e) { const bool tk = lv[e] > best; best = tk ? lv[e] : best; bi = tk ? e : bi; }
                ek[k] = bi; lk[k] = best;
#pragma unroll
                for (int e = 0; e < 32; ++e) lv[e] = (e == bi) ? -3.0e38f : lv[e]; }
            const float e1 = expf(lk[1] - lk[0]), e2 = expf(lk[2] - lk[0]), e3 = expf(lk[3] - lk[0]);
            const float inv = 1.f / (1.f + e1 + e2 + e3);
            const size_t m = (size_t)(mb + F.lane);
            *(i32x4g*)(TOPI + m * 4) = (i32x4g){ek[0], ek[1], ek[2], ek[3]};
            *(f32x4*)(GATE + m * 4) = (f32x4){inv, e1 * inv, e2 * inv, e3 * inv};
#pragma unroll
            for (int k = 0; k < 4; ++k) EK[F.lane * 4 + k] = ek[k];
        }
        asm volatile("s_waitcnt lgkmcnt(0)" ::: "memory");
        const int my_e = EK[F.lane];
        const int lrank = __hip_atomic_fetch_add(&hist[my_e], 1, __ATOMIC_RELAXED, __HIP_MEMORY_SCOPE_WORKGROUP);
        __syncthreads();
        if (F.tid < 32) hist[32 + F.tid] = (int)__hip_atomic_fetch_add(CNT + 64 * F.tid, (unsigned)hist[F.tid], __ATOMIC_RELAXED, __HIP_MEMORY_SCOPE_AGENT);
        __syncthreads();
        RANK[((size_t)rb * 128 + F.wave * 16 + (F.lane >> 2)) * 4 + (F.lane & 3)] = hist[32 + my_e] + lrank;
        __syncthreads();
    }
}

__device__ __forceinline__ void phase7(const Args& a, const Frame& F) {
    unsigned char* ws = a.ws;
    LAS int* starts = (LAS int*)F.lds;
    unsigned* CNT = (unsigned*)(ws + WS_CTL) + CW_CNT;
    int* TILEE = (int*)(ws + WS_TILEE); int* SLOTTOK = (int*)(ws + WS_SLOTTOK);
    if (F.tid < 32) { const int cnt = (int)ld_agent(CNT + 64 * F.tid); starts[64 + F.tid] = cnt; starts[32 + F.tid] = (cnt + 255) & ~255; }
    __syncthreads();
    if (F.tid == 0) { int run = 0; for (int e = 0; e < 32; ++e) { starts[e] = run; run += starts[32 + e]; }
        if (F.blk == 0) { TILEE[1023] = run >> 8; for (int e = 0; e < 32; ++e) for (int tl = starts[e] >> 8; tl < (starts[e] + starts[32 + e]) >> 8; ++tl) TILEE[tl] = e; } }
    __syncthreads();
    if (F.blk == 0) { for (int e = 0; e < 32; ++e) for (int s = starts[e] + starts[64 + e] + F.tid; s < starts[e] + starts[32 + e]; s += NTHR) SLOTTOK[s] = 0; }
    const int* TOPI = (const int*)(ws + WS_TOPI); const int* RANK = (const int*)(ws + WS_RANK); int* TSLOT = (int*)(ws + WS_TSLOT);
    for (int q = F.blk * NTHR + F.tid; q < MX * 4; q += F.G * NTHR) {
        const int slot = starts[TOPI[q]] + RANK[q];
        TSLOT[q] = slot; SLOTTOK[slot] = q >> 2;
    }
}
__device__ __forceinline__ int moe_fill_table(const Args& a, const Frame& F, int nN, int RM) {
    LAS int* tab = (LAS int*)(F.lds + TAB_OFF);
    const unsigned* TILEE = (const unsigned*)(a.ws + WS_TILEE);
    if (F.tid == 0) {
        const int NT = (int)ld_agent(TILEE + 1023);
        const int x = F.blk & 7, j = F.blk >> 3; int n = 0;
        for (int i = 0; i < 64; ++i) { const int s = i * 8 + x, pm = s * RM + j / nN; if (pm >= NT) break;
            const int e = (int)ld_agent(TILEE + pm); tab[2 * n] = pm; tab[2 * n + 1] = e * nN + (j % nN); ++n; }
        tab[128] = n;
    }
    __syncthreads();
    return __builtin_amdgcn_readfirstlane(tab[128]);
}

__device__ __forceinline__ void p10_acc(float (&s)[16], int j, const v4u w, float g) {
    s[8 * j + 0] += g * bflo(w.x); s[8 * j + 1] += g * bfhi(w.x); s[8 * j + 2] += g * bflo(w.y); s[8 * j + 3] += g * bfhi(w.y);
    s[8 * j + 4] += g * bflo(w.z); s[8 * j + 5] += g * bfhi(w.z); s[8 * j + 6] += g * bflo(w.w); s[8 * j + 7] += g * bfhi(w.w);
}
typedef float f32x2 __attribute__((ext_vector_type(2)));
__device__ __forceinline__ void p10_acc8(float (&s)[16], int j, const v2u w, float g) {
    const f32x2 a0 = __builtin_amdgcn_cvt_pk_f32_fp8((int)w.x, false), a1 = __builtin_amdgcn_cvt_pk_f32_fp8((int)w.x, true);
    const f32x2 a2 = __builtin_amdgcn_cvt_pk_f32_fp8((int)w.y, false), a3 = __builtin_amdgcn_cvt_pk_f32_fp8((int)w.y, true);
    s[8 * j + 0] += g * a0.x; s[8 * j + 1] += g * a0.y; s[8 * j + 2] += g * a1.x; s[8 * j + 3] += g * a1.y;
    s[8 * j + 4] += g * a2.x; s[8 * j + 5] += g * a2.y; s[8 * j + 6] += g * a3.x; s[8 * j + 7] += g * a3.y;
}
__device__ __forceinline__ void phase10(const Args& a, const Frame& F) {
    unsigned char* ws = a.ws;
    const bf16* H1 = (const bf16*)(ws + WS_H1); const unsigned char* YS = ws + WS_YS;
    const int* TSLOT = (const int*)(ws + WS_TSLOT); const float* GATE = (const float*)(ws + WS_GATE);
    const int gw = F.blk * NWAVES + F.wave, NGW = F.G * NWAVES;
    f32x4 gv[4], bv[4];
#pragma unroll
    for (int q = 0; q < 4; ++q) { const int col = 8 * F.lane + 512 * (q >> 1) + 4 * (q & 1); gv[q] = *(const f32x4*)(a.in[I_LN2G] + col); bv[q] = *(const f32x4*)(a.in[I_LN2B] + col); }
    for (int m0 = gw; m0 < MX; m0 += 2 * NGW) {
        int mm[2]; mm[0] = m0; mm[1] = (m0 + NGW < MX) ? m0 + NGW : m0;
        int slot[2][4]; float gt[2][4]; v4u hw[2][2]; v2u yw[2][4][2];
#pragma unroll
        for (int r = 0; r < 2; ++r) {
#pragma unroll
            for (int k = 0; k < 4; ++k) { slot[r][k] = TSLOT[(size_t)mm[r] * 4 + k]; gt[r][k] = GATE[(size_t)mm[r] * 4 + k]; }
#pragma unroll
            for (int j = 0; j < 2; ++j) hw[r][j] = *(const v4u*)(H1 + (size_t)mm[r] * D + 8 * F.lane + 512 * j); }
#pragma unroll
        for (int r = 0; r < 2; ++r)
#pragma unroll
            for (int k = 0; k < 4; ++k)
#pragma unroll
                for (int j = 0; j < 2; ++j) yw[r][k][j] = *(const v2u*)(YS + (size_t)slot[r][k] * D + 8 * F.lane + 512 * j);
#pragma unroll
        for (int r = 0; r < 2; ++r) {
            float s[16];
#pragma unroll
            for (int i = 0; i < 16; ++i) s[i] = 0.f;
#pragma unroll
            for (int j = 0; j < 2; ++j) p10_acc(s, j, hw[r][j], ALPHA);
#pragma unroll
            for (int k = 0; k < 4; ++k)
#pragma unroll
                for (int j = 0; j < 2; ++j) p10_acc8(s, j, yw[r][k][j], gt[r][k]);
            float t = 0.f;
#pragma unroll
            for (int i = 0; i < 16; ++i) t += s[i];
            const float mean = wave_sum(t, F.lane) * (1.f / D); float q = 0.f;
#pragma unroll
            for (int i = 0; i < 16; ++i) { s[i] -= mean; q += s[i] * s[i]; }
            const float rstd = __builtin_amdgcn_rsqf(wave_sum(q, F.lane) * (1.f / D) + 1e-5f);
            if (r == 0 || mm[1] != mm[0]) {
#pragma unroll
                for (int q4 = 0; q4 < 4; ++q4) { const int col = 8 * F.lane + 512 * (q4 >> 1) + 4 * (q4 & 1);
                    f32x4 o; o.x = s[4 * q4 + 0] * rstd * gv[q4].x + bv[q4].x; o.y = s[4 * q4 + 1] * rstd * gv[q4].y + bv[q4].y; o.z = s[4 * q4 + 2] * rstd * gv[q4].z + bv[q4].z; o.w = s[4 * q4 + 3] * rstd * gv[q4].w + bv[q4].w;
                    *(f32x4*)(a.out + (size_t)mm[r] * D + col) = o; } }
        }
    }
}

template <int LO, int HI>
__global__ void __launch_bounds__(NTHR, 2) fwd(Args a) {
    extern __shared__ __attribute__((aligned(16))) unsigned char lds_raw[];
    LAS unsigned char* lds = (LAS unsigned char*)lds_raw;
    const int wave = __builtin_amdgcn_readfirstlane((int)(threadIdx.x >> 6));
    volatile LAS unsigned* MISC = (volatile LAS unsigned*)(lds + MISC_OFF);
    if (wave == 0) MISC[lane_id()] = 0u;
    __syncthreads();
    unsigned* ctl = (unsigned*)(a.ws + WS_CTL);
    XcdBarrier bar; bar.bar = ctl + CW_BAR; bar.x = 0; bar.st = nullptr;
    if constexpr (HI - LO > 1) bar = xcd_barrier_post(ctl + CW_BAR, MISC + 8, wave == 0 && lane_id() == 0);
#define PH(k) if constexpr (LO <= (k) && (k) < HI)
#define SEAM(k) if constexpr (LO <= (k) && (k) + 1 < HI) xcd_barrier(bar, wave == 0 && lane_id() == 0)
    PH(0) for (int rep_ = 0; rep_ < NREP(0); ++rep_) { const Frame F = mkframe(lds, wave); phase0(a, F); } SEAM(0);
    PH(1) for (int rep_ = 0; rep_ < NREP(1); ++rep_) { const Frame F = mkframe(lds, wave);
            pg8::Gemm g{(const pg8::bf16_t*)(a.ws + WS_A0), (const pg8::bf16_t*)(a.ws + WS_WIN), MX, PW, D}; pg8::StaticOrder S; S.init(MX, PW, F.G, F.blk);
            pg8::EpiBf16Plain E{(pg8::bf16_t*)(a.ws + WS_PROJ), PW};
            pg8::gemm_phase<pg8::EpiBf16Plain, pg8::StaticOrder, true, true>(F.lds, g, S, E, F.tid); } SEAM(1);
    PH(2) for (int rep_ = 0; rep_ < NREP(2); ++rep_) { const Frame F = mkframe(lds, wave); phase2(a, F); } SEAM(2);
    PH(3) { const Frame F = mkframe(lds, wave); phase3(a, F); } SEAM(3);
    PH(4) for (int rep_ = 0; rep_ < NREP(4); ++rep_) { const Frame F = mkframe(lds, wave); phase4(a, F); } SEAM(4);
    PH(5) for (int rep_ = 0; rep_ < NREP(5); ++rep_) { const Frame F = mkframe(lds, wave);
            pg8::Gemm g{(const pg8::bf16_t*)(a.ws + WS_YMIX), (const pg8::bf16_t*)(a.ws + WS_WOUT), MX, D, D}; pg8::StaticOrder S; S.init(MX, D, F.G, F.blk);
            pg8::EpiBf16Plain E{(pg8::bf16_t*)(a.ws + WS_MIXB), D};
            pg8::gemm_phase<pg8::EpiBf16Plain, pg8::StaticOrder, true, true>(F.lds, g, S, E, F.tid); } SEAM(5);
    PH(6) for (int rep_ = 0; rep_ < NREP(6); ++rep_) { const Frame F = mkframe(lds, wave); phase6(a, F, rep_); } SEAM(6);
    PH(7) for (int rep_ = 0; rep_ < NREP(7); ++rep_) { const Frame F = mkframe(lds, wave); phase7(a, F); } SEAM(7);
    PH(8) for (int rep_ = 0; rep_ < NREP(8); ++rep_) { const Frame F = mkframe(lds, wave); const int n = moe_fill_table(a, F, 8, 4);
            pg8::Gemm g{(const pg8::bf16_t*)(a.ws + WS_H1Q), (const pg8::bf16_t*)(a.ws + WS_WUP), 0, 0, D / 2}; pg8::TableOrder S{(const LAS int*)(F.lds + TAB_OFF), n};
            pg8::EpiSwiglu8 E{a.ws + WS_ACT, a.in[I_BUP]};
            pg8::gemm_phase_g<pg8::EpiSwiglu8, pg8::TableOrder, true, true, 121>(F.lds, g, S, E, F.tid, (const int*)(a.ws + WS_SLOTTOK)); } SEAM(8);
    PH(9) for (int rep_ = 0; rep_ < NREP(9); ++rep_) { const Frame F = mkframe(lds, wave); const int n = moe_fill_table(a, F, 4, 8);
            pg8::Gemm g{(const pg8::bf16_t*)(a.ws + WS_ACT), (const pg8::bf16_t*)(a.ws + WS_WDN), 0, 0, D / 2}; pg8::TableOrder S{(const LAS int*)(F.lds + TAB_OFF), n};
            pg8::EpiDown8 E{a.ws + WS_YS, a.in[I_BDN]};
            pg8::gemm_phase<pg8::EpiDown8, pg8::TableOrder, true, true, 120>(F.lds, g, S, E, F.tid); } SEAM(9);
    PH(10) for (int rep_ = 0; rep_ < NREP(10); ++rep_) { const Frame F = mkframe(lds, wave); phase10(a, F); }
#undef PH
#undef SEAM
}

#ifndef MK_SINGLE
#define MK_SINGLE 1
#endif
template <int LO, int HI> static void launch_range(const Args& a, int grid, hipStream_t stream) {
    static bool attr = false;
    if (!attr) { (void)hipFuncSetAttribute((const void*)fwd<LO, HI>, hipFuncAttributeMaxDynamicSharedMemorySize, LDS_BYTES); attr = true; }
    hipLaunchKernelGGL((fwd<LO, HI>), dim3(grid), dim3(NTHR), LDS_BYTES, stream, a);
}
extern "C" void kernel_launch(void* const* d_in, const int* in_sizes, int n_in, void* d_out, int out_size, void* d_ws, size_t ws_size, hipStream_t stream) {
    if (n_in != 30 || ws_size < WS_END) { fprintf(stderr, "kernel_launch: unexpected inputs (n_in %d, ws %zu)\n", n_in, ws_size); return; }
    const int grid = 256;
    (void)hipMemsetAsync((char*)d_ws + WS_CTL, 0, CTL_ZERO_BYTES, stream);
    Args a{};
    for (int i = 0; i < 30; ++i) a.in[i] = (const float*)d_in[i];
    a.out = (float*)d_out; a.ws = (unsigned char*)d_ws;
#if MK_SINGLE
    launch_range<0, 11>(a, grid, stream);
#else
    launch_range<0, 1>(a, grid, stream); launch_range<1, 2>(a, grid, stream); launch_range<2, 3>(a, grid, stream); launch_range<3, 4>(a, grid, stream);
    launch_range<4, 5>(a, grid, stream); launch_range<5, 6>(a, grid, stream); launch_range<6, 7>(a, grid, stream); launch_range<7, 8>(a, grid, stream);
    launch_range<8, 9>(a, grid, stream); launch_range<9, 10>(a, grid, stream); launch_range<10, 11>(a, grid, stream);
#endif
}
```

```cpp
#include <hip/hip_runtime.h>
#include <cstdio>
#include <cstdint>
#include <cmath>
namespace pg8 {
#define PG8_LAS __attribute__((address_space(3)))
typedef unsigned short bf16_t;
typedef short bf16x8 __attribute__((ext_vector_type(8)));
typedef float f32x4 __attribute__((ext_vector_type(4)));
typedef unsigned u32x4 __attribute__((ext_vector_type(4)));
constexpr int BM = 256, BK = 64, HALF = 128, HTB = HALF * BK * 2  , STAGE_BYTES = 8 * HTB, NXCD = 8, WGM = 8;

__host__ __device__ __forceinline__ int lds_byte(int r, int c) { const int st = (r >> 4) * 2 + (c >> 5), rr = r & 15, cc = c & 31, ob = rr * 64 + cc * 2; return st * 1024 + (ob ^ (((ob >> 9) & 1) << 5)); }
__host__ __device__ __forceinline__ void stage_rc(int b, int& R, int& C) { const int st = b / 1024, sb = b % 1024, swz = sb ^ (((sb >> 9) & 1) << 5); R = (st >> 1) * 16 + swz / 64; C = (st & 1) * 32 + (swz % 64) / 2; }
__host__ __device__ __forceinline__ int perm32(int rho) { const int n = rho >> 4, i = rho & 15; return 8 * (i >> 2) + 4 * n + (i & 3); }

struct Unit { int pm, pn; };
struct Gemm { const bf16_t* A; const bf16_t* Bt; int M, N, K; };

struct StaticOrder {
    int nM, nN, nwg, G, c;
    __host__ __device__ void init(int M, int N, int G_, int c_) { nM = M / BM; nN = N / BM; nwg = nM * nN; G = G_; c = c_; }
    __host__ __device__ bool next(int i, Unit& u) const {
        const long L = (long)i * G + c; if (L >= nwg) return false;
        int wgid = (int)L; { const int q = nwg / NXCD, r = nwg % NXCD, xcd = wgid % NXCD, off = wgid / NXCD; wgid = (xcd < r ? xcd * (q + 1) : r * (q + 1) + (xcd - r) * q) + off; }
        const int nig = WGM * nN, gid = wgid / nig, fm = gid * WGM, gsz = (nM - fm) < WGM ? (nM - fm) : WGM;
        u.pm = fm + ((wgid % nig) % gsz); u.pn = (wgid % nig) / gsz; return true;
    }
    __device__ __forceinline__ void a_ready(const Unit&) const {}
    __device__ __forceinline__ void done(const Unit&) const {}
};


__device__ __forceinline__ unsigned cvt_pk_bf16(float lo, float hi) { unsigned r; asm volatile("v_cvt_pk_bf16_f32 %0, %1, %2" : "=v"(r) : "v"(lo), "v"(hi)); return r; }
typedef unsigned u32x2 __attribute__((ext_vector_type(2)));
typedef int i32x8 __attribute__((ext_vector_type(8))); typedef int i32x4 __attribute__((ext_vector_type(4)));
__device__ __forceinline__ void mfma_f8(f32x4& acc, i32x8 a, i32x8 b, int sa, int sb) {
    asm volatile("s_nop 1\n\tv_mfma_scale_f32_16x16x128_f8f6f4 %0, %1, %2, %0, %3, %4 op_sel_hi:[0,0,0]" : "+v"(acc) : "v"(a), "v"(b), "v"(sa), "v"(sb));
}
__device__ __forceinline__ i32x8 cat8(bf16x8 lo, bf16x8 hi) { const i32x4 a = __builtin_bit_cast(i32x4, lo), b = __builtin_bit_cast(i32x4, hi); return __builtin_shufflevector(a, b, 0, 1, 2, 3, 4, 5, 6, 7); }

struct EpiBf16Plain {
    static constexpr bool PERM = true, AFTER_DRAIN = false, HAS_BIAS = false;
    bf16_t* O; int ldc;
    __device__ __forceinline__ const float* bias_ptr(const Unit&) const { return nullptr; }
    __device__ __forceinline__ void operator()(const f32x4 (&acc)[2][2][4][2], const Unit& u, int wr, int wc, int fr, int fq, const PG8_LAS float*) const {
        const int row0 = u.pm * BM + wr * 64 + fr, col0 = u.pn * BM + wc * 32 + 8 * fq;
#pragma unroll
        for (int ai = 0; ai < 2; ++ai)
#pragma unroll
            for (int m = 0; m < 4; ++m) { bf16_t* rowp = O + (size_t)(row0 + ai * HALF + m * 16) * ldc + col0;
#pragma unroll
                for (int bj = 0; bj < 2; ++bj) { const f32x4 v0 = acc[ai][bj][m][0], v1 = acc[ai][bj][m][1];
                    u32x4 w; w.x = cvt_pk_bf16(v0[0], v0[1]); w.y = cvt_pk_bf16(v0[2], v0[3]); w.z = cvt_pk_bf16(v1[0], v1[1]); w.w = cvt_pk_bf16(v1[2], v1[3]);
                    *(u32x4*)(rowp + bj * HALF) = w; } }
    }
};

__device__ __forceinline__ float swiglu1(float glu, float lin) {
    const float xg = fminf(glu, 7.0f), xl = fminf(fmaxf(lin, -7.0f), 7.0f);
    const float sg = __builtin_amdgcn_rcpf(1.0f + __expf(-1.702f * xg));
    return xg * sg * (xl + 1.0f);
}
struct EpiSwiglu8 {
    static constexpr bool PERM = true, AFTER_DRAIN = false, HAS_BIAS = true;
    unsigned char* ACT; const float* bup;
    __device__ __forceinline__ const float* bias_ptr(const Unit& u) const { return bup + (size_t)(u.pn >> 3) * 2048 + (u.pn & 7) * BM; }
    __device__ __forceinline__ void operator()(const f32x4 (&acc)[2][2][4][2], const Unit& u, int wr, int wc, int fr, int fq, const PG8_LAS float* bl) const {
        const int pn = u.pn & 7;
        const int row0 = u.pm * BM + wr * 64 + fr, ucol0 = pn * BM + wc * 32 + 8 * fq, acol0 = ucol0 >> 1;
        f32x4 bv[2][2];
#pragma unroll
        for (int bj = 0; bj < 2; ++bj)
#pragma unroll
            for (int n = 0; n < 2; ++n) bv[bj][n] = *(const PG8_LAS f32x4*)(bl + wc * 32 + 8 * fq + bj * HALF + 4 * n);
#pragma unroll
        for (int ai = 0; ai < 2; ++ai)
#pragma unroll
            for (int m = 0; m < 4; ++m) { unsigned char* rowp = ACT + (size_t)(row0 + ai * HALF + m * 16) * 1024 + acol0;
#pragma unroll
                for (int bj = 0; bj < 2; ++bj) { const f32x4 v0 = acc[ai][bj][m][0] + bv[bj][0], v1 = acc[ai][bj][m][1] + bv[bj][1];
                    int w = __builtin_amdgcn_cvt_pk_fp8_f32(swiglu1(v0[0], v0[1]), swiglu1(v0[2], v0[3]), 0, false);
                    w = __builtin_amdgcn_cvt_pk_fp8_f32(swiglu1(v1[0], v1[1]), swiglu1(v1[2], v1[3]), w, true);
                    *(int*)(rowp + bj * (HALF / 2)) = w; } }
    }
};
struct EpiDown8 {
    static constexpr bool PERM = true, AFTER_DRAIN = false, HAS_BIAS = true;
    unsigned char* YS; const float* bdn;
    __device__ __forceinline__ const float* bias_ptr(const Unit& u) const { return bdn + (size_t)(u.pn >> 2) * 1024 + (u.pn & 3) * BM; }
    __device__ __forceinline__ void operator()(const f32x4 (&acc)[2][2][4][2], const Unit& u, int wr, int wc, int fr, int fq, const PG8_LAS float* bl) const {
        const int pn = u.pn & 3;
        const int row0 = u.pm * BM + wr * 64 + fr, col0 = pn * BM + wc * 32 + 8 * fq;
        f32x4 bv[2][2];
#pragma unroll
        for (int bj = 0; bj < 2; ++bj)
#pragma unroll
            for (int n = 0; n < 2; ++n) bv[bj][n] = *(const PG8_LAS f32x4*)(bl + wc * 32 + 8 * fq + bj * HALF + 4 * n);
#pragma unroll
        for (int ai = 0; ai < 2; ++ai)
#pragma unroll
            for (int m = 0; m < 4; ++m) { unsigned char* rowp = YS + (size_t)(row0 + ai * HALF + m * 16) * 1024 + col0;
#pragma unroll
                for (int bj = 0; bj < 2; ++bj) { const f32x4 v0 = acc[ai][bj][m][0] + bv[bj][0], v1 = acc[ai][bj][m][1] + bv[bj][1];
                    int w0 = __builtin_amdgcn_cvt_pk_fp8_f32(v0[0], v0[1], 0, false); w0 = __builtin_amdgcn_cvt_pk_fp8_f32(v0[2], v0[3], w0, true);
                    int w1 = __builtin_amdgcn_cvt_pk_fp8_f32(v1[0], v1[1], 0, false); w1 = __builtin_amdgcn_cvt_pk_fp8_f32(v1[2], v1[3], w1, true);
                    u32x2 w; w.x = (unsigned)w0; w.y = (unsigned)w1;
                    *(u32x2*)(rowp + bj * HALF) = w; } }
    }
};
struct TableOrder {
    const PG8_LAS int* tab; int n;
    __device__ __forceinline__ bool next(int i, Unit& u) const {
        if (i >= n) return false;
        u.pm = __builtin_amdgcn_readfirstlane(tab[2 * i]); u.pn = __builtin_amdgcn_readfirstlane(tab[2 * i + 1]); return true;
    }
    __device__ __forceinline__ void a_ready(const Unit&) const {}
    __device__ __forceinline__ void done(const Unit&) const {}
};

constexpr int ROWS_LDS = 131072;
constexpr int BIAS_LDS = 133120;
template <class Epi, class Sched, bool ALIGN_EPI = false, bool SP2 = false, int SCW = 0>
__device__ __forceinline__ void gemm_phase(PG8_LAS unsigned char* lds, const Gemm g, const Sched& S, const Epi& E, const int tid) {
    static_assert(SP2, "two-super-phase form only");
    const int wid = __builtin_amdgcn_readfirstlane(tid >> 6), lane = tid & 63, wr = wid >> 2, wc = wid & 3, fr = lane & 15, fq = lane >> 4;
    int K_ = g.K; asm volatile("" : "+s"(K_));
    const int K = K_, nt = K / BK;
    constexpr int EXTRA = 16 + (Epi::HAS_BIAS ? 1 : 0);
    unsigned voffA[2], voffB[2];
#pragma unroll
    for (int i = 0; i < 2; ++i) { int R, C; stage_rc(tid * 16 + i * 8192, R, C); const int Rb = Epi::PERM ? ((R & ~31) + perm32(R & 31)) : R;
        voffA[i] = (unsigned)(R * K + C) * 2u; voffB[i] = (unsigned)(Rb * K + C) * 2u; }
    const size_t kstep = (size_t)(BK * 2);
    const size_t hstep = (size_t)HALF * K * 2;
    const size_t tstep = 2 * hstep;
    const unsigned ldsw = (unsigned)wid * 1024u;
    const int aoff = lds_byte(wr * 64 + fr, fq * 8), boff = lds_byte(wc * 32 + fr, fq * 8);
#define PG8_SA(b, h) (((b) * 2 + (h)) * HTB)
#define PG8_SB(b, h) ((4 + (b) * 2 + (h)) * HTB)
#define PG8_STAGE(bufoff, gbase, voff) do { _Pragma("unroll") for (int _i = 0; _i < 2; ++_i) \
        __builtin_amdgcn_global_load_lds((const unsigned*)((const char*)(gbase) + (voff)[_i]), (PG8_LAS unsigned*)(lds + (bufoff) + ldsw + _i * 8192), 16, 0, 0); } while (0)
#define PG8_LDA(dst, b, h) do { _Pragma("unroll") for (int m = 0; m < 4; ++m) _Pragma("unroll") for (int k = 0; k < 2; ++k) dst[m][k] = *(const PG8_LAS bf16x8*)(lds + PG8_SA(b, h) + aoff + m * 2048 + k * 1024); } while (0)
#define PG8_LDB(dst, b, h) do { _Pragma("unroll") for (int n = 0; n < 2; ++n) _Pragma("unroll") for (int k = 0; k < 2; ++k) dst[n][k] = *(const PG8_LAS bf16x8*)(lds + PG8_SB(b, h) + boff + n * 2048 + k * 1024); } while (0)
#define PG8_MMA(ai, bj, At, Bt) do { __builtin_amdgcn_s_setprio(1); _Pragma("unroll") for (int m = 0; m < 4; ++m) _Pragma("unroll") for (int n = 0; n < 2; ++n) { \
        if constexpr (SCW != 0) mfma_f8(acc[ai][bj][m][n], cat8(Bt[n][0], Bt[n][1]), cat8(At[m][0], At[m][1]), SCW * 0x01010101, 0x7f7f7f7f); \
        else { _Pragma("unroll") for (int k = 0; k < 2; ++k) acc[ai][bj][m][n] = __builtin_amdgcn_mfma_f32_16x16x32_bf16(Bt[n][k], At[m][k], acc[ai][bj][m][n], 0, 0, 0); } } __builtin_amdgcn_s_setprio(0); } while (0)
#define PG8_WAIT_V(n) asm volatile("s_waitcnt vmcnt(" #n ")" ::: "memory")
#define PG8_WAIT_VX(aft_) do { if (aft_) asm volatile("s_waitcnt vmcnt(%0)" :: "i"(8 + EXTRA) : "memory"); else asm volatile("s_waitcnt vmcnt(8)" ::: "memory"); } while (0)
#define PG8_WAIT_L(n) asm volatile("s_waitcnt lgkmcnt(" #n ")" ::: "memory")
#define PG8_BAR __builtin_amdgcn_s_barrier()
#define PG8_SCHED __builtin_amdgcn_sched_barrier(0)
#define PG8_BIAS(u_) do { if constexpr (Epi::HAS_BIAS) __builtin_amdgcn_global_load_lds((const unsigned*)(E.bias_ptr(u_) + 4 * lane), (PG8_LAS unsigned*)(lds + BIAS_LDS + wid * 1024), 16, 0, 0); } while (0)
    Unit cur, nxt; int ui = 0;
    if (!S.next(0, cur)) return;
    f32x4 acc[2][2][4][2];
#pragma unroll
    for (int a = 0; a < 2; ++a)
#pragma unroll
        for (int b = 0; b < 2; ++b)
#pragma unroll
            for (int m = 0; m < 4; ++m)
#pragma unroll
                for (int n = 0; n < 2; ++n) acc[a][b][m][n] = (f32x4){0.f, 0.f, 0.f, 0.f};
    bf16x8 At[4][2], B0[2][2], B1[2][2];
    const PG8_LAS float* biasl = (const PG8_LAS float*)(lds + BIAS_LDS + wid * 1024);
    PG8_BIAS(cur);
    const char* cA = (const char*)g.A + (size_t)cur.pm * tstep; const char* cB = (const char*)g.Bt + (size_t)cur.pn * tstep;
    S.a_ready(cur);
    PG8_STAGE(PG8_SB(0, 0), cB, voffB); PG8_STAGE(PG8_SB(0, 1), cB + hstep, voffB); PG8_STAGE(PG8_SA(0, 0), cA, voffA); PG8_STAGE(PG8_SA(0, 1), cA + hstep, voffA);
    if (wr == 1) PG8_BAR;
    PG8_WAIT_V(2); PG8_BAR;
    PG8_STAGE(PG8_SB(1, 0), cB + kstep, voffB); PG8_STAGE(PG8_SA(1, 0), cA + kstep, voffA); PG8_STAGE(PG8_SB(1, 1), cB + hstep + kstep, voffB); PG8_STAGE(PG8_SA(1, 1), cA + hstep + kstep, voffA);
    PG8_WAIT_V(8); PG8_BAR;
    for (;;) {
        const bool has_next = S.next(ui + 1, nxt);
        const char* nA = has_next ? (const char*)g.A + (size_t)nxt.pm * tstep : cA; const char* nB = has_next ? (const char*)g.Bt + (size_t)nxt.pn * tstep : cB;
        for (int t = 0; t < nt; t += 2) {
            const bool last = (t == nt - 2);
            const bool aft = (t == 0) && (ui > 0);
            const char* a1 = cA + (size_t)(t + 1) * kstep;
            const char* a2 = last ? nA : cA + (size_t)(t + 2) * kstep; const char* b2 = last ? nB : cB + (size_t)(t + 2) * kstep;
            const char* a3 = a2 + kstep; const char* b3 = b2 + kstep;
            if (last && has_next) S.a_ready(nxt);
            PG8_LDB(B0, 0, 0); PG8_LDB(B1, 0, 1); PG8_SCHED; PG8_LDA(At, 0, 0); if (t > 0) PG8_STAGE(PG8_SA(1, 1), a1 + hstep, voffA);
            PG8_WAIT_VX(aft); PG8_WAIT_L(0); PG8_BAR; PG8_MMA(0, 0, At, B0); PG8_MMA(0, 1, At, B1); PG8_BAR; PG8_SCHED;
            PG8_LDA(At, 0, 1); PG8_STAGE(PG8_SB(0, 0), b2, voffB); PG8_STAGE(PG8_SB(0, 1), b2 + hstep, voffB); PG8_STAGE(PG8_SA(0, 0), a2, voffA);
            PG8_WAIT_VX(aft); PG8_WAIT_L(0); PG8_BAR; PG8_MMA(1, 0, At, B0); PG8_MMA(1, 1, At, B1); PG8_BAR; PG8_SCHED;
            PG8_LDB(B0, 1, 0); PG8_LDB(B1, 1, 1); PG8_SCHED; PG8_LDA(At, 1, 0); PG8_STAGE(PG8_SA(0, 1), a2 + hstep, voffA);
            PG8_WAIT_VX(aft); PG8_WAIT_L(0); PG8_BAR; PG8_MMA(0, 0, At, B0); PG8_MMA(0, 1, At, B1); PG8_BAR; PG8_SCHED;
            PG8_LDA(At, 1, 1); PG8_STAGE(PG8_SB(1, 0), b3, voffB); PG8_STAGE(PG8_SB(1, 1), b3 + hstep, voffB); PG8_STAGE(PG8_SA(1, 0), a3, voffA);
            PG8_WAIT_V(8); PG8_WAIT_L(0); PG8_BAR; PG8_MMA(1, 0, At, B0); PG8_MMA(1, 1, At, B1); PG8_BAR; PG8_SCHED;
        }
        if (has_next) { PG8_STAGE(PG8_SA(1, 1), nA + hstep + kstep, voffA); }
        asm volatile("" ::: "memory"); PG8_SCHED;
        if constexpr (SCW != 0) asm volatile("s_nop 15\n\ts_nop 15" ::: "memory");
        if constexpr (ALIGN_EPI) { if (wr == 0) PG8_BAR; }
        E(acc, cur, wr, wc, fr, fq, biasl); S.done(cur);
        if (!has_next) break;
#pragma unroll
            for (int a = 0; a < 2; ++a)
#pragma unroll
            for (int b = 0; b < 2; ++b)
#pragma unroll
                for (int m = 0; m < 4; ++m)
#pragma unroll
                    for (int n = 0; n < 2; ++n) acc[a][b][m][n] = (f32x4){0.f, 0.f, 0.f, 0.f};
        cur = nxt; cA = nA; cB = nB; ++ui;
        asm volatile("s_waitcnt lgkmcnt(0)" ::: "memory");
        PG8_BIAS(cur);
        if constexpr (ALIGN_EPI) { if (wr == 1) PG8_BAR; }
    }
    PG8_WAIT_V(0);
    if constexpr (!ALIGN_EPI) { if (wr == 0) PG8_BAR; }
    PG8_BAR;
#undef PG8_SA
#undef PG8_SB
#undef PG8_STAGE
#undef PG8_LDA
#undef PG8_LDB
#undef PG8_MMA
#undef PG8_WAIT_V
#undef PG8_WAIT_VX
#undef PG8_WAIT_L
#undef PG8_BAR
#undef PG8_SCHED
#undef PG8_BIAS
}
template <class Epi, class Sched, bool ALIGN_EPI = false, bool SP2 = false, int SCW = 0>
__device__ __forceinline__ void gemm_phase_g(PG8_LAS unsigned char* lds, const Gemm g, const Sched& S, const Epi& E, const int tid, const int* rowmap) {
    static_assert(SP2, "two-super-phase form only");
    const int wid = __builtin_amdgcn_readfirstlane(tid >> 6), lane = tid & 63, wr = wid >> 2, wc = wid & 3, fr = lane & 15, fq = lane >> 4;
    int K_ = g.K; asm volatile("" : "+s"(K_));
    const int K = K_, nt = K / BK;
    constexpr int EXTRA = 16 + (Epi::HAS_BIAS ? 1 : 0) + 1;
    unsigned voffB[2], cv0[2], cv1[2]; int RA[2], CA[2];
#pragma unroll
    for (int i = 0; i < 2; ++i) { int R, C; stage_rc(tid * 16 + i * 8192, R, C); const int Rb = Epi::PERM ? ((R & ~31) + perm32(R & 31)) : R;
        RA[i] = R; CA[i] = C; voffB[i] = (unsigned)(Rb * K + C) * 2u; }
    const size_t kstep = (size_t)(BK * 2);
    const size_t hstep = (size_t)HALF * K * 2;
    const size_t tstep = 2 * hstep;
    const unsigned ldsw = (unsigned)wid * 1024u;
    const int aoff = lds_byte(wr * 64 + fr, fq * 8), boff = lds_byte(wc * 32 + fr, fq * 8);
#define PG8_SA(b, h) (((b) * 2 + (h)) * HTB)
#define PG8_SB(b, h) ((4 + (b) * 2 + (h)) * HTB)
#define PG8_STAGE(bufoff, gbase, voff) do { _Pragma("unroll") for (int _i = 0; _i < 2; ++_i) \
        __builtin_amdgcn_global_load_lds((const unsigned*)((const char*)(gbase) + (voff)[_i]), (PG8_LAS unsigned*)(lds + (bufoff) + ldsw + _i * 8192), 16, 0, 0); } while (0)
#define PG8_LDA(dst, b, h) do { _Pragma("unroll") for (int m = 0; m < 4; ++m) _Pragma("unroll") for (int k = 0; k < 2; ++k) dst[m][k] = *(const PG8_LAS bf16x8*)(lds + PG8_SA(b, h) + aoff + m * 2048 + k * 1024); } while (0)
#define PG8_LDB(dst, b, h) do { _Pragma("unroll") for (int n = 0; n < 2; ++n) _Pragma("unroll") for (int k = 0; k < 2; ++k) dst[n][k] = *(const PG8_LAS bf16x8*)(lds + PG8_SB(b, h) + boff + n * 2048 + k * 1024); } while (0)
#define PG8_MMA(ai, bj, At, Bt) do { __builtin_amdgcn_s_setprio(1); _Pragma("unroll") for (int m = 0; m < 4; ++m) _Pragma("unroll") for (int n = 0; n < 2; ++n) { \
        if constexpr (SCW != 0) mfma_f8(acc[ai][bj][m][n], cat8(Bt[n][0], Bt[n][1]), cat8(At[m][0], At[m][1]), SCW * 0x01010101, 0x7f7f7f7f); \
        else { _Pragma("unroll") for (int k = 0; k < 2; ++k) acc[ai][bj][m][n] = __builtin_amdgcn_mfma_f32_16x16x32_bf16(Bt[n][k], At[m][k], acc[ai][bj][m][n], 0, 0, 0); } } __builtin_amdgcn_s_setprio(0); } while (0)
#define PG8_WAIT_V(n) asm volatile("s_waitcnt vmcnt(" #n ")" ::: "memory")
#define PG8_WAIT_VX(aft_) do { if (aft_) asm volatile("s_waitcnt vmcnt(%0)" :: "i"(8 + EXTRA) : "memory"); else asm volatile("s_waitcnt vmcnt(8)" ::: "memory"); } while (0)
#define PG8_WAIT_L(n) asm volatile("s_waitcnt lgkmcnt(" #n ")" ::: "memory")
#define PG8_BAR __builtin_amdgcn_s_barrier()
#define PG8_SCHED __builtin_amdgcn_sched_barrier(0)
#define PG8_BIAS(u_) do { if constexpr (Epi::HAS_BIAS) __builtin_amdgcn_global_load_lds((const unsigned*)(E.bias_ptr(u_) + 4 * lane), (PG8_LAS unsigned*)(lds + BIAS_LDS + wid * 1024), 16, 0, 0); } while (0)
    Unit cur, nxt; int ui = 0;
    if (!S.next(0, cur)) return;
    f32x4 acc[2][2][4][2];
#pragma unroll
    for (int a = 0; a < 2; ++a)
#pragma unroll
        for (int b = 0; b < 2; ++b)
#pragma unroll
            for (int m = 0; m < 4; ++m)
#pragma unroll
                for (int n = 0; n < 2; ++n) acc[a][b][m][n] = (f32x4){0.f, 0.f, 0.f, 0.f};
    bf16x8 At[4][2], B0[2][2], B1[2][2];
    const PG8_LAS float* biasl = (const PG8_LAS float*)(lds + BIAS_LDS + wid * 1024);
    PG8_BIAS(cur);
    const char* gA = (const char*)g.A; const char* cB = (const char*)g.Bt + (size_t)cur.pn * tstep;
    const PG8_LAS int* rowsl = (const PG8_LAS int*)(lds + ROWS_LDS);
#define PG8_ROWDMA(pm_) __builtin_amdgcn_global_load_lds((const unsigned*)(rowmap + (pm_) * BM + 4 * lane), (PG8_LAS unsigned*)(lds + ROWS_LDS), 16, 0, 0)
#define PG8_ROWS(v0_, v1_) do { _Pragma("unroll") for (int _i = 0; _i < 2; ++_i) { v0_[_i] = (unsigned)(rowsl[RA[_i]] * K + CA[_i]) * 2u; v1_[_i] = (unsigned)(rowsl[HALF + RA[_i]] * K + CA[_i]) * 2u; } } while (0)
    PG8_ROWDMA(cur.pm); PG8_WAIT_V(0);
    PG8_ROWS(cv0, cv1); PG8_WAIT_L(0);
    S.a_ready(cur);
    PG8_STAGE(PG8_SB(0, 0), cB, voffB); PG8_STAGE(PG8_SB(0, 1), cB + hstep, voffB); PG8_STAGE(PG8_SA(0, 0), gA, cv0); PG8_STAGE(PG8_SA(0, 1), gA, cv1);
    if (wr == 1) PG8_BAR;
    PG8_WAIT_V(2); PG8_BAR;
    PG8_STAGE(PG8_SB(1, 0), cB + kstep, voffB); PG8_STAGE(PG8_SA(1, 0), gA + kstep, cv0); PG8_STAGE(PG8_SB(1, 1), cB + hstep + kstep, voffB); PG8_STAGE(PG8_SA(1, 1), gA + kstep, cv1);
    PG8_WAIT_V(8); PG8_BAR;
    for (;;) {
        const bool has_next = S.next(ui + 1, nxt);
        const char* nB = has_next ? (const char*)g.Bt + (size_t)nxt.pn * tstep : cB;
        PG8_ROWDMA(has_next ? nxt.pm : cur.pm);
        unsigned w0[2] = {cv0[0], cv0[1]}, w1[2] = {cv1[0], cv1[1]};
        for (int t = 0; t < nt; t += 2) {
            const bool last = (t == nt - 2);
            const bool aft = (t == 0) && (ui > 0);
            const char* a1 = gA + (size_t)(t + 1) * kstep;
            const char* a2 = last ? gA : gA + (size_t)(t + 2) * kstep; const char* b2 = last ? nB : cB + (size_t)(t + 2) * kstep;
            const char* a3 = a2 + kstep; const char* b3 = b2 + kstep;
            if (last && has_next) S.a_ready(nxt);
            PG8_LDB(B0, 0, 0); PG8_LDB(B1, 0, 1); PG8_SCHED; PG8_LDA(At, 0, 0); if (t > 0) PG8_STAGE(PG8_SA(1, 1), a1, cv1);
            PG8_WAIT_VX(aft); PG8_WAIT_L(0); PG8_BAR; PG8_MMA(0, 0, At, B0); PG8_MMA(0, 1, At, B1); PG8_BAR; PG8_SCHED;
            PG8_LDA(At, 0, 1); PG8_STAGE(PG8_SB(0, 0), b2, voffB); PG8_STAGE(PG8_SB(0, 1), b2 + hstep, voffB); PG8_STAGE(PG8_SA(0, 0), a2, w0);
            PG8_WAIT_VX(aft); PG8_WAIT_L(0); PG8_BAR; PG8_MMA(1, 0, At, B0); PG8_MMA(1, 1, At, B1); PG8_BAR; PG8_SCHED;
            PG8_LDB(B0, 1, 0); PG8_LDB(B1, 1, 1); PG8_SCHED; PG8_LDA(At, 1, 0); PG8_STAGE(PG8_SA(0, 1), a2, w1);
            PG8_WAIT_VX(aft); PG8_WAIT_L(0); PG8_BAR; PG8_MMA(0, 0, At, B0); PG8_MMA(0, 1, At, B1); PG8_BAR; PG8_SCHED;
            PG8_LDA(At, 1, 1); PG8_STAGE(PG8_SB(1, 0), b3, voffB); PG8_STAGE(PG8_SB(1, 1), b3 + hstep, voffB); PG8_STAGE(PG8_SA(1, 0), a3, w0);
            PG8_WAIT_V(8); PG8_WAIT_L(0); PG8_BAR; PG8_MMA(1, 0, At, B0); PG8_MMA(1, 1, At, B1); PG8_BAR; PG8_SCHED;
            if (t + 4 == nt) { PG8_ROWS(w0, w1); }
        }
        if (has_next) { PG8_STAGE(PG8_SA(1, 1), gA + kstep, w1); }
        asm volatile("" ::: "memory"); PG8_SCHED;
        if constexpr (SCW != 0) asm volatile("s_nop 15\n\ts_nop 15" ::: "memory");
        if constexpr (ALIGN_EPI) { if (wr == 0) PG8_BAR; }
        E(acc, cur, wr, wc, fr, fq, biasl); S.done(cur);
        if (!has_next) break;
#pragma unroll
            for (int a = 0; a < 2; ++a)
#pragma unroll
            for (int b = 0; b < 2; ++b)
#pragma unroll
                for (int m = 0; m < 4; ++m)
#pragma unroll
                    for (int n = 0; n < 2; ++n) acc[a][b][m][n] = (f32x4){0.f, 0.f, 0.f, 0.f};
        cur = nxt; cB = nB; ++ui; cv0[0] = w0[0]; cv0[1] = w0[1]; cv1[0] = w1[0]; cv1[1] = w1[1];
        asm volatile("s_waitcnt lgkmcnt(0)" ::: "memory");
        PG8_BIAS(cur);
        if constexpr (ALIGN_EPI) { if (wr == 1) PG8_BAR; }
    }
    PG8_WAIT_V(0);
    if constexpr (!ALIGN_EPI) { if (wr == 0) PG8_BAR; }
    PG8_BAR;
#undef PG8_ROWS
#undef PG8_ROWDMA
#undef PG8_SA
#undef PG8_SB
#undef PG8_STAGE
#undef PG8_LDA
#undef PG8_LDB
#undef PG8_MMA
#undef PG8_WAIT_V
#undef PG8_WAIT_VX
#undef PG8_WAIT_L
#undef PG8_BAR
#undef PG8_SCHED
#undef PG8_BIAS
}
}

#ifndef REP_MASK
#define REP_MASK 0
#endif
#define NREP(k) (1 + ((REP_MASK >> (k)) & 1))

constexpr int NB = 16, SEQ = 2048, D = 1024, NMETA = 16;
constexpr int MX = NB * SEQ;
constexpr int INW = 3344, PW = 3584;
constexpr int GQ = 0, GK = 256, GV = 512, GG = 1024, GKL = 1536;
constexpr int RW0 = 1552;
constexpr int RR = RW0, RK = RW0 + 512, RV = RW0 + 1024, RWL = RW0 + 1536, RAL = RW0 + 1600, RGL = RW0 + 1664;
constexpr int NE = 32, TOPK = 4;
constexpr int NCH = 33;
constexpr float ALPHA = 1.189207115002721f;
constexpr int NWAVES = 8, NTHR = 512;

constexpr size_t MiB = 1u << 20;
constexpr size_t WS_CTL = 0, CTL_ZERO_BYTES = 1 * MiB;
constexpr size_t WS_STATS = 1 * MiB;
constexpr size_t WS_TOPI  = WS_STATS + 256 * 1024;
constexpr size_t WS_GATE  = WS_TOPI + 512 * 1024;
constexpr size_t WS_RANK  = WS_GATE + 512 * 1024;
constexpr size_t WS_TSLOT = WS_RANK + 512 * 1024;
constexpr size_t WS_BON   = WS_TSLOT + 512 * 1024;
constexpr size_t WS_PROJM = WS_BON + 1 * MiB;
constexpr size_t WS_OPSM  = WS_PROJM + 256 * 1024;
constexpr size_t WS_DL    = WS_OPSM + 256 * 1024;
constexpr size_t WS_W2T   = WS_DL + 1 * MiB;
constexpr size_t WS_A2T   = WS_W2T + 64 * 1024;
constexpr size_t WS_G2T   = WS_A2T + 64 * 1024;
constexpr size_t WS_RWH   = WS_G2T + 128 * 1024;
constexpr size_t WS_RWL   = WS_RWH + 64 * 1024;
constexpr size_t WS_TILEE = WS_RWL + 64 * 1024;
constexpr size_t WS_SLOTTOK = WS_TILEE + 4096;
constexpr size_t WS_WIN   = 8 * MiB;
constexpr size_t WS_WOUT  = 15 * MiB;
static_assert(WS_SLOTTOK + 139264 * 4 <= WS_WIN, "table region");
constexpr size_t WS_A0    = 20 * MiB;
constexpr size_t WS_YMIX  = WS_A0;
constexpr size_t WS_PROJ  = 84 * MiB;
constexpr size_t WS_R1    = 308 * MiB;
constexpr size_t WS_GAM   = 520 * MiB;
constexpr size_t WS_SST   = 524 * MiB;
constexpr size_t WS_GUS   = 692 * MiB;
constexpr size_t WS_H1    = 20 * MiB;
constexpr size_t WS_XS    = 84 * MiB;
constexpr size_t WS_YS    = WS_XS;
constexpr size_t WS_ACT   = 356 * MiB;
constexpr size_t WS_MIXB  = 628 * MiB;
constexpr size_t WS_WUP   = 758 * MiB;
constexpr size_t WS_WDN   = 822 * MiB;
constexpr size_t WS_H1Q   = 854 * MiB;
constexpr size_t WS_END   = 886 * MiB;
constexpr int CW_BAR = 4096;
constexpr int CW_CNT = 16384;
constexpr int CW_QH = 20480;

constexpr int RING_BYTES = 131072;
constexpr int LDS_BYTES = 147456;
constexpr int TAB_OFF = 132096;
constexpr int MISC_OFF = LDS_BYTES - 512;

#define LAS __attribute__((address_space(3)))
typedef unsigned short bf16;
typedef unsigned v4u __attribute__((ext_vector_type(4)));
typedef unsigned v2u __attribute__((ext_vector_type(2)));
typedef float f32x4 __attribute__((ext_vector_type(4)));
typedef short bf16x8 __attribute__((ext_vector_type(8)));
typedef int i32x4g __attribute__((ext_vector_type(4)));
#define LDS_WAIT() asm volatile("s_waitcnt lgkmcnt(0)" ::: "memory")
__device__ __forceinline__ float bflo(unsigned w) { return __uint_as_float(w << 16); }
__device__ __forceinline__ float bfhi(unsigned w) { return __uint_as_float(w & 0xffff0000u); }
typedef float f32x2_t __attribute__((ext_vector_type(2))); typedef __bf16 bf16x2_t __attribute__((ext_vector_type(2)));
__device__ __forceinline__ unsigned pk2(float lo, float hi) { const f32x2_t v = {lo, hi}; const bf16x2_t b = __builtin_convertvector(v, bf16x2_t); return __builtin_bit_cast(unsigned, b); }
__device__ __forceinline__ unsigned f2bf(float f) { return pk2(f, 0.f) & 0xffffu; }
#define CYC() ((unsigned)__builtin_amdgcn_s_getreg((19 << 11) | 29))
__device__ __forceinline__ void lds_barrier() { asm volatile("s_waitcnt lgkmcnt(0)" ::: "memory"); __builtin_amdgcn_s_barrier(); asm volatile("" ::: "memory"); }
__device__ __forceinline__ float shx(float v, int mask, int lane) { return __int_as_float(__builtin_amdgcn_ds_bpermute((lane ^ mask) << 2, __float_as_int(v))); }
template <int CTRL> __device__ __forceinline__ float dppf0(float x) { return __int_as_float(__builtin_amdgcn_update_dpp(0, __float_as_int(x), CTRL, 0xF, 0xF, true)); }
__device__ __forceinline__ float wave_sum(float v, int lane) {
    v += dppf0<0xB1>(v); v += dppf0<0x4E>(v); v += dppf0<0x141>(v); v += dppf0<0x140>(v);
    v += shx(v, 16, lane); v += shx(v, 32, lane);
    return v;
}
__device__ __forceinline__ float softplus_f(float x) { return fmaxf(x, 0.f) + log1pf(expf(-fabsf(x))); }
__device__ __forceinline__ float logsigmoid_f(float x) { return fminf(x, 0.f) - log1pf(expf(-fabsf(x))); }
__device__ __forceinline__ float sigmoid_f(float x) { return 1.f / (1.f + expf(-x)); }
__device__ __forceinline__ float fexp(float x) { return __builtin_amdgcn_exp2f(x * 1.4426950408889634f); }
__device__ __forceinline__ float flog(float x) { return __builtin_amdgcn_logf(x) * 0.6931471805599453f; }
__device__ __forceinline__ float fsigmoid(float x) { return __builtin_amdgcn_rcpf(1.f + fexp(-x)); }
__device__ __forceinline__ float ftanh(float x) { return 2.f * fsigmoid(2.f * x) - 1.f; }
__device__ __forceinline__ float fsoftplus(float x) { return fmaxf(x, 0.f) + flog(1.f + fexp(-fabsf(x))); }
__device__ __forceinline__ float flogsigmoid(float x) { return fminf(x, 0.f) - flog(1.f + fexp(-fabsf(x))); }
template <int CTRL> __device__ __forceinline__ float dppf(float x) { return __int_as_float(__builtin_amdgcn_update_dpp(0, __float_as_int(x), CTRL, 0xF, 0xF, true)); }
__device__ __forceinline__ float red8(float x) {
    x += dppf<0xB1>(x); x += dppf<0x4E>(x); x += dppf<0x141>(x); return x;
}
__device__ __forceinline__ f32x4 mfma16(bf16x8 a, bf16x8 b, f32x4 c) { return __builtin_amdgcn_mfma_f32_16x16x32_bf16(a, b, c, 0, 0, 0); }
__device__ __forceinline__ unsigned ld_agent(const unsigned* p) { return __hip_atomic_load(p, __ATOMIC_RELAXED, __HIP_MEMORY_SCOPE_AGENT); }

#define XB_TMO      128
#define XB_XCNT(j)  (256  + 64 * (j))
#define XB_XSUB(j)  (1280 + 64 * (j))
#define XB_XGEN(j)  (2304 + 64 * (j))
#define XB_TOP      3328
#define XB_TOPGEN   3392
#define XCD_BAR_WORDS 3456
#define XB_SPIN_CAP (1u << 18)
__device__ __forceinline__ unsigned xb_ld(unsigned* p)              { return __hip_atomic_load(p, __ATOMIC_RELAXED, __HIP_MEMORY_SCOPE_AGENT); }
__device__ __forceinline__ unsigned xb_add(unsigned* p, unsigned v) { return __hip_atomic_fetch_add(p, v, __ATOMIC_RELAXED, __HIP_MEMORY_SCOPE_AGENT); }
__device__ __forceinline__ unsigned xb_xcc_id() { return (unsigned)__builtin_amdgcn_s_getreg((3 << 11) | 20) & 0xFu; }
#define XB_SPIN(cond, bar) do { unsigned _sp = 0; while (cond) { __builtin_amdgcn_s_sleep(1); \
    if ((++_sp & 255u) == 0u) { if (xb_ld(&(bar)[XB_TMO])) break; if (_sp > XB_SPIN_CAP) { atomicAdd(&(bar)[XB_TMO], 1u); break; } } } } while (0)
struct XcdBarrier { unsigned* bar; unsigned x; volatile LAS unsigned* st; };
__device__ __forceinline__ XcdBarrier xcd_barrier_post(unsigned* bar, volatile LAS unsigned* st, bool leader) {
    XcdBarrier b; b.bar = bar; b.x = xb_xcc_id(); b.st = st;
    if (leader) (void)xb_add(&bar[XB_XCNT(b.x)], 1u);
    return b;
}
__device__ __forceinline__ void xcd_barrier_complete(unsigned* bar, unsigned x, unsigned& nloc, unsigned& nx) {
    const unsigned G = gridDim.x * gridDim.y * gridDim.z;
    unsigned sum, cnt, mine, sp = 0u;
    for (;;) {
        sum = 0u; cnt = 0u; mine = 0u;
#pragma unroll
        for (unsigned j = 0; j < 16; ++j) { const unsigned c = xb_ld(&bar[XB_XCNT(j)]); sum += c; cnt += (c > 0u) ? 1u : 0u; mine = (j == x) ? c : mine; }
        if (sum == G) break;
        __builtin_amdgcn_s_sleep(1);
        if ((++sp & 255u) == 0u) { if (xb_ld(&bar[XB_TMO])) break; if (sp > XB_SPIN_CAP) { atomicAdd(&bar[XB_TMO], 1u); break; } }
    }
    nloc = mine > 0u ? mine : 1u; nx = cnt > 0u ? cnt : 1u;
}
__device__ __forceinline__ void xcd_barrier(const XcdBarrier& b, bool leader) {
    asm volatile("s_waitcnt vmcnt(0)" ::: "memory");
    __syncthreads();
    if (leader) {
        unsigned* bar = b.bar;
        __builtin_amdgcn_s_waitcnt(0);
        unsigned nloc = b.st[0], nx = b.st[1];
        if (nloc == 0u) { xcd_barrier_complete(bar, b.x, nloc, nx); b.st[0] = nloc; b.st[1] = nx; }
        const unsigned old = xb_add(&bar[XB_XSUB(b.x)], 1u);
        const unsigned gen = old / nloc;
        if (old + 1u == (gen + 1u) * nloc) {
            __builtin_amdgcn_fence(__ATOMIC_RELEASE, "agent");
            asm volatile("s_waitcnt vmcnt(0)" ::: "memory");
            const unsigned og = xb_add(&bar[XB_TOP], 1u);
            const unsigned tg = og / nx;
            if (og + 1u == (tg + 1u) * nx) xb_add(&bar[XB_TOPGEN], 1u);
            else XB_SPIN(xb_ld(&bar[XB_TOPGEN]) == tg, bar);
            __builtin_amdgcn_fence(__ATOMIC_ACQUIRE, "agent");
            xb_add(&bar[XB_XGEN(b.x)], 1u);
            asm volatile("s_waitcnt vmcnt(0)" ::: "memory");
        } else {
            XB_SPIN(xb_ld(&bar[XB_XGEN(b.x)]) == gen, bar);
            __builtin_amdgcn_fence(__ATOMIC_ACQUIRE, "agent");
            asm volatile("s_waitcnt vmcnt(0)" ::: "memory");
        }
    }
    __syncthreads();
}

struct Args { const float* in[30]; float* out; unsigned char* ws; };
enum { I_X = 0, I_META, I_LNIN_G, I_LNIN_B, I_WIN, I_GKW2, I_GKB, I_GNORM, I_MU, I_W0, I_W2, I_A0, I_A2, I_G2, I_KK, I_KA, I_RK, I_RLNG, I_RLNB, I_WOUT,
       I_LN1G, I_LN1B, I_RTW, I_RTB, I_WUP, I_BUP, I_WDN, I_BDN, I_LN2G, I_LN2B };
struct Frame { LAS unsigned char* lds; int tid, lane, wave, blk, G; };
__device__ __forceinline__ int lane_id() { int l; asm volatile("v_mbcnt_lo_u32_b32 %0, -1, 0\n\tv_mbcnt_hi_u32_b32 %0, -1, %0" : "=v"(l)); return l; }
__device__ __forceinline__ Frame mkframe(LAS unsigned char* lds, int wave) { Frame F; F.lds = lds; F.wave = wave; F.lane = lane_id(); F.tid = wave * 64 + F.lane; F.blk = blockIdx.x; F.G = gridDim.x; return F; }

__device__ __forceinline__ void transpose_item(const float* W, int K, int N, int nblk, bf16* WT, LAS float* scr, int item, int lane) {
    const int kb = item / nblk, nb = item - kb * nblk, k0 = 64 * kb, n0 = 32 * nb;
    const int nn = n0 + (lane & 31); const bool ok = nn < N;
#pragma unroll 8
    for (int i = 0; i < 32; ++i) { const int kk = 2 * i + (lane >> 5); scr[kk * 33 + (lane & 31)] = ok ? W[(size_t)(k0 + kk) * N + nn] : 0.f; }
    LDS_WAIT();
    const int c = lane & 7;
#pragma unroll
    for (int j = 0; j < 4; ++j) { const int n = (lane >> 3) + 8 * j; const LAS float* s = scr + (8 * c) * 33 + n;
        v4u o; o.x = pk2(s[0 * 33], s[1 * 33]); o.y = pk2(s[2 * 33], s[3 * 33]); o.z = pk2(s[4 * 33], s[5 * 33]); o.w = pk2(s[6 * 33], s[7 * 33]);
        *(v4u*)(WT + (size_t)(n0 + n) * K + k0 + 8 * c) = o; }
    LDS_WAIT();
}

constexpr int CV_UP = 16 * 32, CV_DN = 16 * 16, CV_NIT = NE * (CV_UP + CV_DN);
__device__ __forceinline__ void cv_load(const Args& a, int it, int lane, f32x4 (&v)[16]) {
    const bool up = it < NE * CV_UP; const int it2 = up ? it : it - NE * CV_UP, per = up ? CV_UP : CV_DN, e = it2 / per, r = it2 - e * per;
    const int N = up ? 2048 : D, nblk = N >> 6, kb = r / nblk, nb = r - kb * nblk;
    const float* W = (up ? a.in[I_WUP] : a.in[I_WDN]) + (size_t)e * D * N + (size_t)(64 * kb + (lane >> 4)) * N + 64 * nb + 4 * (lane & 15);
#pragma unroll
    for (int i = 0; i < 16; ++i) v[i] = *(const f32x4*)(W + (size_t)(4 * i) * N);
}
__device__ __forceinline__ void cv_store(const Args& a, int it, int lane, const f32x4 (&v)[16], LAS float* scr) {
    const bool up = it < NE * CV_UP; const int it2 = up ? it : it - NE * CV_UP, per = up ? CV_UP : CV_DN, e = it2 / per, r = it2 - e * per;
    const int N = up ? 2048 : D, nblk = N >> 6, kb = r / nblk, nb = r - kb * nblk;
    const float scale = up ? 64.f : 128.f;
    const int r4 = lane >> 4, c4 = lane & 15;
#pragma unroll
    for (int i = 0; i < 16; ++i) *(LAS f32x4*)(scr + (4 * i + r4) * 68 + 4 * c4) = v[i];
    LDS_WAIT();
    unsigned char* orow = a.ws + (up ? WS_WUP : WS_WDN) + (size_t)e * N * D + (size_t)(64 * nb + lane) * D + 64 * kb;
#pragma unroll
    for (int g = 0; g < 4; ++g) { const LAS float* s = scr + (16 * g) * 68 + lane; v4u o;
#pragma unroll
        for (int q = 0; q < 4; ++q) { int w = __builtin_amdgcn_cvt_pk_fp8_f32(s[(4 * q + 0) * 68] * scale, s[(4 * q + 1) * 68] * scale, 0, false);
            w = __builtin_amdgcn_cvt_pk_fp8_f32(s[(4 * q + 2) * 68] * scale, s[(4 * q + 3) * 68] * scale, w, true); o[q] = (unsigned)w; }
        *(v4u*)(orow + 16 * g) = o; }
    LDS_WAIT();
}
__device__ __forceinline__ void convert_expert_weights(const Args& a, const Frame& F, int qsel) {
    LAS float* scr = (LAS float*)(F.lds + F.wave * 17408);
    unsigned* QH = (unsigned*)(a.ws + WS_CTL) + CW_QH + 64 * qsel;
    unsigned base = 0;
    if (F.lane == 0) base = __hip_atomic_fetch_add(QH, 4u, __ATOMIC_RELAXED, __HIP_MEMORY_SCOPE_AGENT);
    base = (unsigned)__builtin_amdgcn_readfirstlane((int)base);
    if (base >= (unsigned)CV_NIT) return;
    f32x4 va[16], vb[16];
    cv_load(a, (int)base, F.lane, va);
    for (;;) {
        unsigned nbase = 0;
        if (F.lane == 0) nbase = __hip_atomic_fetch_add(QH, 4u, __ATOMIC_RELAXED, __HIP_MEMORY_SCOPE_AGENT);
        nbase = (unsigned)__builtin_amdgcn_readfirstlane((int)nbase);
        const bool more = nbase < (unsigned)CV_NIT;
        cv_load(a, (int)base + 1, F.lane, vb); cv_store(a, (int)base, F.lane, va, scr);
        cv_load(a, (int)base + 2, F.lane, va); cv_store(a, (int)base + 1, F.lane, vb, scr);
        cv_load(a, (int)base + 3, F.lane, vb); cv_store(a, (int)base + 2, F.lane, va, scr);
        if (more) cv_load(a, (int)nbase, F.lane, va);
        cv_store(a, (int)base + 3, F.lane, vb, scr);
        if (!more) break;
        base = nbase;
    }
}

__device__ __forceinline__ void phase0(const Args& a, const Frame& F) {
    unsigned char* ws = a.ws;
    const int gw = F.blk * NWAVES + F.wave, NGW = F.G * NWAVES;
    for (int cgp = F.blk; cgp < 53; cgp += F.G) {
        LAS float* HM = (LAS float*)F.lds;
        LAS float* PART = (LAS float*)(F.lds + 65536);
        for (int rr = 0; rr < 2; ++rr) {
            const int row = 2 * F.wave + rr; const f32x4* xr = (const f32x4*)(a.in[I_META] + row * D) + F.lane;
            f32x4 v[4]; float s = 0.f;
#pragma unroll
            for (int j = 0; j < 4; ++j) { v[j] = xr[64 * j]; s += (v[j].x + v[j].y) + (v[j].z + v[j].w); }
            const float mean = wave_sum(s, F.lane) * (1.f / D); float s2 = 0.f;
#pragma unroll
            for (int j = 0; j < 4; ++j) { v[j] = v[j] - mean; s2 += (v[j].x * v[j].x + v[j].y * v[j].y) + (v[j].z * v[j].z + v[j].w * v[j].w); }
            const float rstd = 1.f / sqrtf(wave_sum(s2, F.lane) * (1.f / D) + 1e-5f);
#pragma unroll
            for (int j = 0; j < 4; ++j) { const int col = 4 * (F.lane + 64 * j);
                const f32x4 gv = *(const f32x4*)(a.in[I_LNIN_G] + col), bv = *(const f32x4*)(a.in[I_LNIN_B] + col);
                const f32x4 y = v[j] * rstd * gv + bv;
                HM[(col + 0) * 16 + row] = y.x; HM[(col + 1) * 16 + row] = y.y; HM[(col + 2) * 16 + row] = y.z; HM[(col + 3) * 16 + row] = y.w; }
        }
        __syncthreads();
        const int col = cgp * 64 + F.lane; const bool ok = col < INW;
        float acc[16];
#pragma unroll
        for (int r = 0; r < 16; ++r) acc[r] = 0.f;
        const float* wp = a.in[I_WIN];
        for (int k = F.wave * 128; k < F.wave * 128 + 128; ++k) {
            const float wv = ok ? wp[(size_t)k * INW + col] : 0.f;
            const LAS f32x4* h = (const LAS f32x4*)(HM + k * 16);
#pragma unroll
            for (int q = 0; q < 4; ++q) { const f32x4 hv = h[q]; acc[4 * q + 0] += hv.x * wv; acc[4 * q + 1] += hv.y * wv; acc[4 * q + 2] += hv.z * wv; acc[4 * q + 3] += hv.w * wv; }
        }
#pragma unroll
        for (int r = 0; r < 16; ++r) PART[(F.wave * 16 + r) * 64 + F.lane] = acc[r];
        __syncthreads();
        bf16* PROJM = (bf16*)(ws + WS_PROJM);
        for (int o = F.tid; o < 1024; o += NTHR) { const int r = o >> 6, l = o & 63; float s = 0.f;
#pragma unroll
            for (int w = 0; w < 8; ++w) s += PART[(w * 16 + r) * 64 + l];
            PROJM[r * PW + cgp * 64 + l] = (bf16)f2bf(s); }
        if (F.tid < 64) PROJM[NMETA * PW + cgp * 64 + F.tid] = 0;
        __syncthreads();
    }
    {
        LAS float* scr = (LAS float*)(F.lds + F.wave * 16384);
        constexpr int I_IN = 16 * (PW / 32), I_OUT = 16 * 32;
        for (int it = gw; it < I_IN + I_OUT; it += NGW) {
            if (it < I_IN) transpose_item(a.in[I_WIN], D, INW, PW / 32, (bf16*)(ws + WS_WIN), scr, it, F.lane);
            else transpose_item(a.in[I_WOUT], D, D, 32, (bf16*)(ws + WS_WOUT), scr, it - I_IN, F.lane);
        }
    }
    {
        bf16* W2T = (bf16*)(ws + WS_W2T); bf16* A2T = (bf16*)(ws + WS_A2T); bf16* G2T = (bf16*)(ws + WS_G2T);
        for (int i = F.blk * NTHR + F.tid; i < 131072; i += F.G * NTHR) {
            if (i < 32768) { const int n = i >> 6, k = i & 63; W2T[i] = (bf16)f2bf(a.in[I_W2][k * 512 + n]); }
            else if (i < 65536) { const int j = i - 32768, n = j >> 6, k = j & 63; A2T[j] = (bf16)f2bf(a.in[I_A2][k * 512 + n]); }
            else { const int j = i - 65536, n = j >> 7, k = j & 127; G2T[j] = (bf16)f2bf(a.in[I_G2][k * 512 + n]); }
        }
    }
    {
        bf16* RWH = (bf16*)(ws + WS_RWH); bf16* RWL = (bf16*)(ws + WS_RWL);
        for (int i = F.blk * NTHR + F.tid; i < D * NE; i += F.G * NTHR) { const int c = i >> 5, e = i & 31; const float w = a.in[I_RTW][i];
            const unsigned hi = f2bf(w); const float lo = w - __uint_as_float(hi << 16);
            RWH[e * D + c] = (bf16)hi; RWL[e * D + c] = (bf16)f2bf(lo); }
    }
    {
        bf16* A0 = (bf16*)(ws + WS_A0); float* ST = (float*)(ws + WS_STATS);
        for (int m0 = gw; m0 < MX; m0 += 2 * NGW) {
            f32x4 v[2][4];
#pragma unroll
            for (int r = 0; r < 2; ++r) { const f32x4* xr = (const f32x4*)(a.in[I_X] + (size_t)(m0 + r * NGW) * D) + F.lane;
#pragma unroll
                for (int j = 0; j < 4; ++j) v[r][j] = xr[64 * j]; }
#pragma unroll
            for (int r = 0; r < 2; ++r) { const int m = m0 + r * NGW; float s = 0.f;
#pragma unroll
                for (int j = 0; j < 4; ++j) s += (v[r][j].x + v[r][j].y) + (v[r][j].z + v[r][j].w);
                const float mean = wave_sum(s, F.lane) * (1.f / D); float s2 = 0.f;
#pragma unroll
                for (int j = 0; j < 4; ++j) { v[r][j] = v[r][j] - mean; s2 += (v[r][j].x * v[r][j].x + v[r][j].y * v[r][j].y) + (v[r][j].z * v[r][j].z + v[r][j].w * v[r][j].w); }
                const float rstd = __builtin_amdgcn_rsqf(wave_sum(s2, F.lane) * (1.f / D) + 1e-5f);
#pragma unroll
                for (int j = 0; j < 4; ++j) { const int col = 4 * (F.lane + 64 * j);
                    const f32x4 gv = *(const f32x4*)(a.in[I_LNIN_G] + col), bv = *(const f32x4*)(a.in[I_LNIN_B] + col);
                    const f32x4 y = v[r][j] * rstd * gv + bv;
                    v2u o; o.x = pk2(y.x, y.y); o.y = pk2(y.z, y.w);
                    *(v2u*)(A0 + (size_t)m * D + col) = o; }
                if (F.lane == 0) { ST[2 * m] = mean; ST[2 * m + 1] = rstd; } }
        }
    }
    __syncthreads();
    for (int rep_ = 0; rep_ < NREP(14); ++rep_) convert_expert_weights(a, F, rep_);
}

__device__ __forceinline__ const bf16* prow(const bf16* PROJ, const bf16* PROJM, int b, int vp) {
    const bf16* px = PROJ + (size_t)(b * SEQ + (vp >= NMETA ? vp - NMETA : 0)) * PW;
    const bf16* pm = PROJM + (size_t)(vp < 0 ? NMETA : (vp < NMETA ? vp : 0)) * PW;
    return vp >= NMETA ? px : pm;
}
__device__ __forceinline__ f32x4 ldp4(const bf16* PROJ, const bf16* PROJM, int b, int vp, int col) {
    const v2u w = *(const v2u*)(prow(PROJ, PROJM, b, vp) + col);
    return (f32x4){bflo(w.x), bfhi(w.x), bflo(w.y), bfhi(w.y)};
}

constexpr int R1_STRIDE = 49152;
constexpr int TP = 80;
constexpr int L1_SLOT = 64 * TP * 2;
constexpr int L1_LC = 12 * L1_SLOT;
constexpr int L1_XCH = L1_LC + 64 * 65 * 4;
constexpr int L1_LR = 8 * L1_SLOT;
__device__ __forceinline__ v2u pack4(f32x4 v) { v2u o; o.x = pk2(v[0], v[1]); o.y = pk2(v[2], v[3]); return o; }
__device__ __forceinline__ f32x4 tile_mm(const LAS bf16* A, const LAS bf16* Bt, int rt, int ct, int fr, int fq, f32x4 acc) {
#pragma unroll
    for (int ks = 0; ks < 2; ++ks)
        acc = mfma16(*(const LAS bf16x8*)(Bt + (ct * 16 + fr) * TP + ks * 32 + 8 * fq), *(const LAS bf16x8*)(A + (rt * 16 + fr) * TP + ks * 32 + 8 * fq), acc);
    return acc;
}
__device__ __forceinline__ void tile_st(LAS bf16* O, int rt, int ct, int fr, int fq, f32x4 v) { *(LAS v2u*)(O + (rt * 16 + fr) * TP + ct * 16 + 4 * fq) = pack4(v); }
#define L1S(n) ((LAS bf16*)(F.lds + (n) * L1_SLOT))

struct L1Pf { v4u sa[5]; v2u r[2][2], k[2][2], v[2][2]; };
__device__ __forceinline__ void l1_fetch(const Args& a, const Frame& F, int b, int h, int c, L1Pf& pf, bool need_sa) {
    const bf16* PROJ = (const bf16*)(a.ws + WS_PROJ); const bf16* PROJM = (const bf16*)(a.ws + WS_PROJM);
    const int vp0 = (c == 0) ? -48 : NMETA + 64 * (c - 1);
    if (need_sa) { const int cg = F.tid & 31, tr = F.tid >> 5;
#pragma unroll
      for (int i = 0; i < 5; ++i) pf.sa[i] = *(const v4u*)(prow(PROJ, PROJM, b, vp0 + 4 * tr - 1 + i) + RWL + 8 * cg); }
    { const int rt = F.wave & 3, cp = F.wave >> 2, fr = F.lane & 15, fq = F.lane >> 4, vp = vp0 + rt * 16 + fr;
      const bf16* p0 = prow(PROJ, PROJM, b, vp - 1); const bf16* p1 = prow(PROJ, PROJM, b, vp);
#pragma unroll
      for (int cc = 0; cc < 2; ++cc) { const int jc = h * 64 + (2 * cp + cc) * 16 + 4 * fq;
          pf.r[cc][0] = *(const v2u*)(p0 + RR + jc); pf.r[cc][1] = *(const v2u*)(p1 + RR + jc);
          pf.k[cc][0] = *(const v2u*)(p0 + RK + jc); pf.k[cc][1] = *(const v2u*)(p1 + RK + jc);
          pf.v[cc][0] = *(const v2u*)(p0 + RV + jc); pf.v[cc][1] = *(const v2u*)(p1 + RV + jc); } }
}
__device__ __forceinline__ f32x4 unpk4(v2u w) { return (f32x4){bflo(w.x), bfhi(w.x), bflo(w.y), bfhi(w.y)}; }

__device__ __forceinline__ void rwkv_l1_front(const Args& a, const Frame& F, int b, int h, int c, const L1Pf& pf, f32x4 (&rtil)[2], bool newgrp, bf16x8 (&lrf)[8]) {
    unsigned char* ws = a.ws;
    const bf16* W2T = (const bf16*)(ws + WS_W2T); const bf16* A2T = (const bf16*)(ws + WS_A2T); const bf16* G2T = (const bf16*)(ws + WS_G2T);
    const int unit = (b * 8 + h) * NCH + c;
    unsigned char* r1 = ws + WS_R1 + (size_t)unit * R1_STRIDE;
    float* GAM = (float*)(ws + WS_GAM) + (size_t)unit * 64;
    const float* mu = a.in[I_MU];
    const int vp0 = (c == 0) ? -48 : NMETA + 64 * (c - 1);
    constexpr int LRP = 264;
    LAS bf16* LR = (LAS bf16*)(F.lds + L1_LR);
    LAS float* LC = (LAS float*)(F.lds + L1_LC);
    LAS float* XCH = (LAS float*)(F.lds + L1_XCH);
    const int rt = F.wave & 3, cp = F.wave >> 2, fr = F.lane & 15, fq = F.lane >> 4;
    if (newgrp) {
        const int cg = F.tid & 31, tr = F.tid >> 5;
        const f32x4 m0 = *(const f32x4*)(mu + 1536 + 8 * cg), m1 = *(const f32x4*)(mu + 1536 + 8 * cg + 4);
#pragma unroll
        for (int i = 0; i < 4; ++i) {
            const int row = 4 * tr + i;
            const v4u cw = pf.sa[i + 1], pw = pf.sa[i];
            const f32x4 c0 = unpk4((v2u){cw.x, cw.y}), c1 = unpk4((v2u){cw.z, cw.w}), p0 = unpk4((v2u){pw.x, pw.y}), p1 = unpk4((v2u){pw.z, pw.w});
            float v[8];
            v[0] = c0.x + (p0.x - c0.x) * m0.x; v[1] = c0.y + (p0.y - c0.y) * m0.y; v[2] = c0.z + (p0.z - c0.z) * m0.z; v[3] = c0.w + (p0.w - c0.w) * m0.w;
            v[4] = c1.x + (p1.x - c1.x) * m1.x; v[5] = c1.y + (p1.y - c1.y) * m1.y; v[6] = c1.z + (p1.z - c1.z) * m1.z; v[7] = c1.w + (p1.w - c1.w) * m1.w;
#pragma unroll
            for (int q = 0; q < 8; ++q) { if (cg < 8) v[q] = ftanh(v[q]); else if (cg >= 16) v[q] = fsigmoid(v[q]); }
            v4u o; o.x = pk2(v[0], v[1]); o.y = pk2(v[2], v[3]); o.z = pk2(v[4], v[5]); o.w = pk2(v[6], v[7]);
            *(LAS v4u*)(LR + row * LRP + 8 * cg) = o;
        }
    }
    const int t = rt * 16 + fr, vp = vp0 + t;
    const bool valid = vp >= 0;
    if (newgrp) { lds_barrier();
        const LAS bf16* lrow = LR + t * LRP + 8 * fq;
#pragma unroll
        for (int q = 0; q < 8; ++q) lrf[q] = *(const LAS bf16x8*)(lrow + q * 32); }
    float lwv[2][4], asg[2][4], kkr[2][4], kmd[2][4], rrv[2][4], vvv[2][4];
    float ssq = 0.f, bon = 0.f;
    {
#pragma unroll
        for (int cc = 0; cc < 2; ++cc) {
            const int ct = 2 * cp + cc, j = ct * 16 + 4 * fq, jc = h * 64 + j;
            f32x4 mr[2], mk[2], mv[2], w0v[2], a0v[2], kkw[2], kaw[2], rkw[2];
            mr[cc] = *(const f32x4*)(mu + jc); mk[cc] = *(const f32x4*)(mu + 512 + jc); mv[cc] = *(const f32x4*)(mu + 1024 + jc);
            w0v[cc] = *(const f32x4*)(a.in[I_W0] + jc); a0v[cc] = *(const f32x4*)(a.in[I_A0] + jc);
            kkw[cc] = *(const f32x4*)(a.in[I_KK] + jc); kaw[cc] = *(const f32x4*)(a.in[I_KA] + jc); rkw[cc] = *(const f32x4*)(a.in[I_RK] + jc);
            f32x4 aw = {0.f, 0.f, 0.f, 0.f}, aa = aw, ag = aw;
#pragma unroll
            for (int ks = 0; ks < 2; ++ks) {
                aw = mfma16(*(const bf16x8*)(W2T + (size_t)(h * 64 + ct * 16 + fr) * 64 + ks * 32 + 8 * fq), lrf[ks], aw);
                aa = mfma16(*(const bf16x8*)(A2T + (size_t)(h * 64 + ct * 16 + fr) * 64 + ks * 32 + 8 * fq), lrf[2 + ks], aa);
            }
#pragma unroll
            for (int ks = 0; ks < 4; ++ks) ag = mfma16(*(const bf16x8*)(G2T + (size_t)(h * 64 + ct * 16 + fr) * 128 + ks * 32 + 8 * fq), lrf[4 + ks], ag);
            const f32x4 rc = unpk4(pf.r[cc][1]), rp = unpk4(pf.r[cc][0]), kc = unpk4(pf.k[cc][1]), kp = unpk4(pf.k[cc][0]), vc = unpk4(pf.v[cc][1]), vpv = unpk4(pf.v[cc][0]);
            const f32x4 rs = rc + (rp - rc) * mr[cc], ks_ = kc + (kp - kc) * mk[cc], vs = vc + (vpv - vc) * mv[cc];
#pragma unroll
            for (int i = 0; i < 4; ++i) {
                const float u = w0v[cc][i] + aw[i];
                const float wl = -fsoftplus(-u) - 0.5f;
                lwv[cc][i] = valid ? -fexp(wl) : 0.f;
                const float as_ = fsigmoid(a0v[cc][i] + aa[i]);
                asg[cc][i] = as_;
                const float kraw = ks_[i], kk = kraw * kkw[cc][i];
                kkr[cc][i] = kk; ssq += kk * kk;
                const float km = kraw * (1.f + (as_ - 1.f) * kaw[cc][i]);
                kmd[cc][i] = km; rrv[cc][i] = rs[i]; vvv[cc][i] = vs[i];
                bon += rs[i] * km * rkw[cc][i];
            }
            *(v2u*)(r1 + 4 * 8192 + (size_t)(t * 64 + j) * 2) = pack4(ag);
            __builtin_amdgcn_sched_barrier(0);
        }
#pragma unroll
        for (int cc = 0; cc < 2; ++cc)
#pragma unroll
            for (int i = 0; i < 4; ++i) LC[t * 65 + (2 * cp + cc) * 16 + 4 * fq + i] = lwv[cc][i];
        ssq += shx(ssq, 16, F.lane); ssq += shx(ssq, 32, F.lane);
        bon += shx(bon, 16, F.lane); bon += shx(bon, 32, F.lane);
        if (fq == 0) { XCH[(cp * 64 + t) * 2] = ssq; XCH[(cp * 64 + t) * 2 + 1] = bon; }
    }
    lds_barrier();
    const float ssq_t = XCH[t * 2] + XCH[(64 + t) * 2], bon_t = XCH[t * 2 + 1] + XCH[(64 + t) * 2 + 1];
    const float inv = 1.f / fmaxf(sqrtf(ssq_t), 1e-12f);
    {
        LAS float* SEG = XCH + 256;
        const int jj = F.tid & 63, sg = F.tid >> 6;
        float cv[8];
#pragma unroll
        for (int i = 0; i < 8; ++i) cv[i] = LC[(sg * 8 + i) * 65 + jj];
#pragma unroll
        for (int i = 1; i < 8; ++i) cv[i] += cv[i - 1];
        SEG[sg * 64 + jj] = cv[7];
        lds_barrier();
        float pre = 0.f;
#pragma unroll
        for (int s2 = 0; s2 < 7; ++s2) pre += (s2 < sg) ? SEG[s2 * 64 + jj] : 0.f;
#pragma unroll
        for (int i = 0; i < 8; ++i) LC[(sg * 8 + i) * 65 + jj] = cv[i] + pre;
    }
    lds_barrier();
    {
#pragma unroll
        for (int cc = 0; cc < 2; ++cc) {
            const int j = (2 * cp + cc) * 16 + 4 * fq;
            f32x4 At, Bt, Kt, Bh, Kh, bvv;
#pragma unroll
            for (int i = 0; i < 4; ++i) {
                const float Lc = LC[t * 65 + j + i], LcC = LC[63 * 65 + j + i];
                const float kn = kkr[cc][i] * inv, av = -kn, bv = kn * asg[cc][i], km = kmd[cc][i];
                const float eA = fexp(Lc - lwv[cc][i]), eR = fexp(Lc), eB = fexp(-Lc), eH = fexp(LcC - Lc);
                At[i] = av * eA; rtil[cc][i] = rrv[cc][i] * eR; Bt[i] = bv * eB; Kt[i] = km * eB; Bh[i] = bv * eH; Kh[i] = km * eH;
                bvv[i] = bon_t * vvv[cc][i];
                if (t == 63) GAM[j + i] = fexp(LcC);
            }
            *(LAS v2u*)(L1S(0) + t * TP + j) = pack4(Bt); *(LAS v2u*)(L1S(1) + t * TP + j) = pack4(Kt);
            *(LAS v2u*)(L1S(2) + t * TP + j) = pack4(At); *(LAS v2u*)(L1S(3) + t * TP + j) = pack4(rtil[cc]);
#pragma unroll
            for (int i = 0; i < 4; ++i) {
                L1S(4)[(j + i) * TP + t] = (bf16)f2bf(At[i]); L1S(5)[(j + i) * TP + t] = (bf16)f2bf(Bh[i]);
                L1S(6)[(j + i) * TP + t] = (bf16)f2bf(Kh[i]); L1S(7)[(j + i) * TP + t] = (bf16)f2bf(vvv[cc][i]);
            }
            *(v2u*)(r1 + 5 * 8192 + (size_t)(t * 64 + j) * 2) = pack4(bvv);
        }
    }
    lds_barrier();
}
__device__ __forceinline__ void rwkv_l1_back(const Args& a, const Frame& F, int b, int h, int c, const f32x4 (&rtil)[2]) {
    unsigned char* r1 = a.ws + WS_R1 + (size_t)((b * 8 + h) * NCH + c) * R1_STRIDE;
    const int rt = F.wave & 3, cp = F.wave >> 2, fr = F.lane & 15, fq = F.lane >> 4;
    f32x4 Pt[2];
    const int mrow = rt * 16 + fr;
    const f32x4 z = {0.f, 0.f, 0.f, 0.f};
    {
        f32x4 Lv[2], Nv[2], Mv[2], Bv[2], Kv[2];
#pragma unroll
        for (int cc = 0; cc < 2; ++cc) { const int ct = 2 * cp + cc;
            Lv[cc] = tile_mm(L1S(2), L1S(0), rt, ct, fr, fq, z); Nv[cc] = tile_mm(L1S(0), L1S(2), rt, ct, fr, fq, z); Mv[cc] = tile_mm(L1S(2), L1S(1), rt, ct, fr, fq, z);
            Bv[cc] = tile_mm(L1S(3), L1S(0), rt, ct, fr, fq, z); Kv[cc] = tile_mm(L1S(3), L1S(1), rt, ct, fr, fq, z); }
#pragma unroll
        for (int cc = 0; cc < 2; ++cc) { const int ct = 2 * cp + cc, n0 = ct * 16 + 4 * fq;
#pragma unroll
            for (int i = 0; i < 4; ++i) { const int n = n0 + i;
                if (!(n < mrow)) { Lv[cc][i] = 0.f; Mv[cc][i] = 0.f; } if (!(mrow < n)) Nv[cc][i] = 0.f; if (!(n <= mrow)) { Bv[cc][i] = 0.f; Kv[cc][i] = 0.f; }
                Pt[cc][i] = Lv[cc][i] + ((n == mrow) ? 1.f : 0.f); }
            tile_st(L1S(8), rt, ct, fr, fq, Lv[cc]); tile_st(L1S(9), rt, ct, fr, fq, Nv[cc]); tile_st(L1S(10), rt, ct, fr, fq, Mv[cc]);
            tile_st(L1S(11), rt, ct, fr, fq, Bv[cc]); tile_st(L1S(12), rt, ct, fr, fq, Kv[cc]); }
    }
    lds_barrier();
    f32x4 Xv[2];
#pragma unroll
    for (int st = 1; st <= 6; ++st) {
        LAS bf16* Xl = (st & 1) ? L1S(8) : L1S(0); LAS bf16* Xn = (st & 1) ? L1S(9) : L1S(1);
        LAS bf16* Yl = (st & 1) ? L1S(0) : L1S(8); LAS bf16* Yn = (st & 1) ? L1S(1) : L1S(9);
        LAS bf16* Pr = (st & 1) ? L1S(2) : L1S(3); LAS bf16* Pw = (st & 1) ? L1S(3) : L1S(2);
        f32x4 l2[2], n2[2];
#pragma unroll
        for (int cc = 0; cc < 2; ++cc) { const int ct = 2 * cp + cc;
            if (st <= 5) { l2[cc] = tile_mm(Xl, Xn, rt, ct, fr, fq, z); n2[cc] = tile_mm(Xn, Xl, rt, ct, fr, fq, z); }
            if (st >= 2) Pt[cc] = tile_mm(Pr, Xn, rt, ct, fr, fq, Pt[cc]);
            if (st == 1) Xv[cc] = tile_mm(L1S(7), L1S(10), rt, ct, fr, fq, z); }
#pragma unroll
        for (int cc = 0; cc < 2; ++cc) { const int ct = 2 * cp + cc;
            if (st <= 5) { tile_st(Yl, rt, ct, fr, fq, l2[cc]); tile_st(Yn, rt, ct, fr, fq, n2[cc]); }
            tile_st(Pw, rt, ct, fr, fq, Pt[cc]); }
        if (st == 1) { lds_barrier();
#pragma unroll
            for (int cc = 0; cc < 2; ++cc) tile_st(L1S(10), rt, 2 * cp + cc, fr, fq, Xv[cc]); }
        lds_barrier();
    }
    {
        f32x4 u[2], w[2];
#pragma unroll
        for (int cc = 0; cc < 2; ++cc) { const int ct = 2 * cp + cc; u[cc] = tile_mm(L1S(10), L1S(2), rt, ct, fr, fq, z); w[cc] = tile_mm(L1S(4), L1S(2), rt, ct, fr, fq, z); }
#pragma unroll
        for (int cc = 0; cc < 2; ++cc) { const int ct = 2 * cp + cc; tile_st(L1S(8), rt, ct, fr, fq, u[cc]); tile_st(L1S(9), rt, ct, fr, fq, w[cc]); }
    }
    lds_barrier();
    {
#pragma unroll
        for (int cc = 0; cc < 2; ++cc) { const int ct = 2 * cp + cc; const size_t eo = (size_t)(mrow * 64 + ct * 16 + 4 * fq) * 2;
            const f32x4 gp = tile_mm(L1S(5), L1S(9), rt, ct, fr, fq, z);
            const f32x4 hh = tile_mm(L1S(7), L1S(6), rt, ct, fr, fq, tile_mm(L1S(8), L1S(5), rt, ct, fr, fq, z));
            const f32x4 rh = tile_mm(L1S(11), L1S(9), rt, ct, fr, fq, rtil[cc]);
            const f32x4 yl = tile_mm(L1S(12), L1S(7), rt, ct, fr, fq, tile_mm(L1S(11), L1S(8), rt, ct, fr, fq, z));
            *(v2u*)(r1 + 0 * 8192 + eo) = pack4(gp); *(v2u*)(r1 + 1 * 8192 + eo) = pack4(hh);
            *(v2u*)(r1 + 2 * 8192 + eo) = pack4(rh); *(v2u*)(r1 + 3 * 8192 + eo) = pack4(yl); }
    }
    lds_barrier();
}

constexpr int BCP = 65;
__device__ __forceinline__ void gla_bc(const Args& a, const Frame& F, int b, int h, int vp0, int ntok) {
    const bf16* PROJ = (const bf16*)(a.ws + WS_PROJ); const bf16* PROJM = (const bf16*)(a.ws + WS_PROJM);
    LAS float* GKLs = (LAS float*)F.lds; LAS float* BC = (LAS float*)(F.lds + 4096);
    if (F.tid < 256) { const int t = F.tid >> 2, q = F.tid & 3;
        const f32x4 v = ldp4(PROJ, PROJM, b, (t < ntok) ? vp0 + t : -1, GKL + 4 * q);
        *(LAS f32x4*)(GKLs + t * 16 + 4 * q) = v; }
    lds_barrier();
    {
        const int d = F.tid & 63, tg = F.tid >> 6;
        float wc[16];
#pragma unroll
        for (int r = 0; r < 16; ++r) wc[r] = a.in[I_GKW2][r * 256 + h * 64 + d];
        const float gb = a.in[I_GKB][h * 64 + d];
        float lgv[8];
#pragma unroll
        for (int i = 0; i < 8; ++i) { const int t = tg * 8 + i; float z = gb;
            const LAS f32x4* g4 = (const LAS f32x4*)(GKLs + t * 16);
#pragma unroll
            for (int q = 0; q < 4; ++q) { const f32x4 gv = g4[q]; z += gv.x * wc[4 * q] + gv.y * wc[4 * q + 1] + gv.z * wc[4 * q + 2] + gv.w * wc[4 * q + 3]; }
            lgv[i] = (t < ntok) ? flogsigmoid(z) * (1.f / 16.f) : 0.f; }
        LAS float* SEG = (LAS float*)(F.lds + 20736);
#pragma unroll
        for (int i = 1; i < 8; ++i) lgv[i] += lgv[i - 1];
        SEG[tg * 64 + d] = lgv[7];
        lds_barrier();
        float pre = 0.f;
#pragma unroll
        for (int s2 = 0; s2 < 7; ++s2) pre += (s2 < tg) ? SEG[s2 * 64 + d] : 0.f;
#pragma unroll
        for (int i = 0; i < 8; ++i) BC[(tg * 8 + i) * BCP + d] = lgv[i] + pre;
    }
    lds_barrier();
}

__device__ __forceinline__ void gla_g1_unit(const Args& a, const Frame& F, int b, int h, int c) {
    const bf16* PROJ = (const bf16*)(a.ws + WS_PROJ); const bf16* PROJM = (const bf16*)(a.ws + WS_PROJM);
    float* GUS = (float*)(a.ws + WS_GUS); float* DL = (float*)(a.ws + WS_DL);
    const int ntok = (c == 0) ? NMETA : 64, vp0 = (c == 0) ? 0 : NMETA + 64 * (c - 1);
    gla_bc(a, F, b, h, vp0, ntok);
    LAS float* BC = (LAS float*)(F.lds + 4096);
    LAS bf16* KT = (LAS bf16*)(F.lds + 24576);
    LAS bf16* VT = (LAS bf16*)(F.lds + 24576 + 64 * TP * 2);
    {
        const int t = F.tid >> 3, q = F.tid & 7;
        const float* bl = nullptr; (void)bl;
#pragma unroll
        for (int half = 0; half < 2; ++half) {
            const int d0 = 8 * q + 4 * half;
            const f32x4 kv = ldp4(PROJ, PROJM, b, (t < ntok) ? vp0 + t : -1, GK + h * 64 + d0);
#pragma unroll
            for (int i = 0; i < 4; ++i) { const int d = d0 + i; const float e = (t < ntok) ? fexp(BC[(ntok - 1) * BCP + d] - BC[t * BCP + d]) : 0.f;
                KT[d * TP + t] = (bf16)f2bf(kv[i] * e); }
        }
#pragma unroll
        for (int qq = 0; qq < 4; ++qq) {
            const int e0 = 16 * q + 4 * qq;
            const f32x4 vv = ldp4(PROJ, PROJM, b, (t < ntok) ? vp0 + t : -1, GV + h * 128 + e0);
#pragma unroll
            for (int i = 0; i < 4; ++i) VT[(e0 + i) * TP + t] = (bf16)f2bf(vv[i]);
        }
    }
    lds_barrier();
    {
        const int rt = F.wave & 3, ch = F.wave >> 2, fr = F.lane & 15, fq = F.lane >> 4;
        float* up = GUS + ((size_t)((b * 4 + h) * NCH + c) * 64 + rt * 16 + fr) * 128;
#pragma unroll
        for (int cc = 0; cc < 4; ++cc) { const int ct = ch * 4 + cc;
            f32x4 acc = {0.f, 0.f, 0.f, 0.f};
#pragma unroll
            for (int ks = 0; ks < 2; ++ks)
                acc = mfma16(*(const LAS bf16x8*)(VT + (ct * 16 + fr) * TP + ks * 32 + 8 * fq), *(const LAS bf16x8*)(KT + (rt * 16 + fr) * TP + ks * 32 + 8 * fq), acc);
            *(f32x4*)(up + ct * 16 + 4 * fq) = acc; }
        if (F.tid < 64) DL[(size_t)((b * 4 + h) * NCH + c) * 64 + F.tid] = fexp(BC[(ntok - 1) * BCP + F.tid]);
    }
    lds_barrier();
}

template <bool BACK>
__device__ __forceinline__ void rwkv_l1_loop(const Args& a, const Frame& F) {
    constexpr int NU = NB * 8 * NCH;
    const int u0 = (int)((long)F.blk * NU / F.G), u1 = (int)((long)(F.blk + 1) * NU / F.G);
    L1Pf pf;
    bf16x8 lrf[8];
    if (u0 < u1) l1_fetch(a, F, (u0 >> 3) / NCH, u0 & 7, (u0 >> 3) % NCH, pf, true);
    for (int u = u0; u < u1; ++u) {
        const int h = u & 7, c = (u >> 3) % NCH, b = (u >> 3) / NCH; f32x4 rtil[2];
        const bool newgrp = (u == u0) || (h == 0);
        { const Frame F1 = mkframe(F.lds, F.wave); rwkv_l1_front(a, F1, b, h, c, pf, rtil, newgrp, lrf); }
        { const Frame F2 = mkframe(F.lds, F.wave);
          if (u + 1 < u1) l1_fetch(a, F2, ((u + 1) >> 3) / NCH, (u + 1) & 7, ((u + 1) >> 3) % NCH, pf, ((u + 1) & 7) == 0);
          if constexpr (BACK) rwkv_l1_back(a, F2, b, h, c, rtil); }
    }
}
__device__ __forceinline__ void phase2(const Args& a, const Frame& F) {
    if constexpr (((REP_MASK >> 19) & 1) != 0) { const Frame F0 = mkframe(F.lds, F.wave); rwkv_l1_loop<false>(a, F0); }
    { const Frame F0 = mkframe(F.lds, F.wave); rwkv_l1_loop<true>(a, F0); }
    for (int rep_ = 0; rep_ < NREP(12); ++rep_)
    for (int u = F.blk; u < NB * 4 * 32; u += F.G) { const int c = u & 31, bh = u >> 5; const Frame F1 = mkframe(F.lds, F.wave); gla_g1_unit(a, F1, bh >> 2, bh & 3, c); }
}

struct L2S { v4u g, h; f32x4 gm; };
__device__ __forceinline__ void l2s_fetch(L2S& r, const unsigned char* src, const float* gam) {
    r.g = *(const v4u*)src; r.h = *(const v4u*)(src + 8192); r.gm = *(const f32x4*)gam;
}
__device__ __forceinline__ void l2s_stage(const L2S& r, LAS bf16* Gt, LAS bf16* Ht, LAS float* Gm, int tid) {
    const int r_ = tid >> 3, c8 = tid & 7;
    *(LAS v4u*)(Gt + r_ * TP + 8 * c8) = r.g; *(LAS v4u*)(Ht + r_ * TP + 8 * c8) = r.h;
    if (tid < 16) *(LAS f32x4*)(Gm + 4 * tid) = r.gm;
}
__device__ __forceinline__ void l2s_step(const LAS bf16* Gt, const LAS bf16* Ht, const LAS float* Gm, const LAS bf16* Sc, LAS bf16* Sn, f32x4 (&Sm)[2], int row, int cp, int fr, int fq, bf16* gout, int tid) {
    {
        const int r_ = tid >> 3, c8 = tid & 7;
        *(v4u*)(gout + r_ * 64 + 8 * c8) = *(const LAS v4u*)(Sc + r_ * TP + 8 * c8);
    }
    const int col0 = cp * 32 + 4 * fq;
    const bf16x8 af0 = *(const LAS bf16x8*)(Sc + row * TP + 8 * fq), af1 = *(const LAS bf16x8*)(Sc + row * TP + 32 + 8 * fq);
    bf16x8 fg[4]; v2u hq[2]; f32x4 gm[2];
#pragma unroll
    for (int cc = 0; cc < 2; ++cc) { const LAS bf16* gr = Gt + (cp * 32 + cc * 16 + fr) * TP + 8 * fq;
        fg[2 * cc] = *(const LAS bf16x8*)gr; fg[2 * cc + 1] = *(const LAS bf16x8*)(gr + 32);
        hq[cc] = *(const LAS v2u*)(Ht + row * TP + col0 + cc * 16); gm[cc] = *(const LAS f32x4*)(Gm + col0 + cc * 16); }
#pragma unroll
    for (int cc = 0; cc < 2; ++cc) {
        f32x4 acc = {bflo(hq[cc].x), bfhi(hq[cc].x), bflo(hq[cc].y), bfhi(hq[cc].y)};
        acc = mfma16(fg[2 * cc], af0, acc);
        acc = mfma16(fg[2 * cc + 1], af1, acc);
        Sm[cc] = Sm[cc] * gm[cc] + acc; }
#pragma unroll
    for (int cc = 0; cc < 2; ++cc) *(LAS v2u*)(Sn + row * TP + col0 + cc * 16) = pack4(Sm[cc]);
}
template <bool FAKE>
__device__ __forceinline__ void rwkv_l2_unit(const Args& a, const Frame& F, int bh) {
    unsigned char* ws = a.ws;
    LAS bf16* Sb0 = (LAS bf16*)F.lds; LAS bf16* Sb1 = Sb0 + 64 * TP;
    LAS bf16* G0 = Sb0 + 2 * 64 * TP; LAS bf16* G1 = Sb0 + 3 * 64 * TP; LAS bf16* H0 = Sb0 + 4 * 64 * TP; LAS bf16* H1 = Sb0 + 5 * 64 * TP;
    LAS float* M0 = (LAS float*)(Sb0 + 6 * 64 * TP); LAS float* M1 = M0 + 64;
    const int fr = F.lane & 15, fq = F.lane >> 4, rt = F.wave & 3, cp = F.wave >> 2;
    const int row = rt * 16 + fr, col0 = cp * 32 + 4 * fq;
    const unsigned char* srcb = ws + WS_R1 + (size_t)bh * NCH * R1_STRIDE + (size_t)((F.tid >> 3) * 64 + 8 * (F.tid & 7)) * 2;
    const float* gamb = (const float*)(ws + WS_GAM) + (size_t)bh * NCH * 64 + 4 * (F.lane & 15);
    bf16* sst = (bf16*)(ws + WS_SST) + (size_t)bh * NCH * 4096;
    f32x4 Sm[2];
#pragma unroll
    for (int cc = 0; cc < 2; ++cc) { Sm[cc] = (f32x4){0.f, 0.f, 0.f, 0.f}; *(LAS v2u*)(Sb0 + row * TP + col0 + cc * 16) = (v2u){0u, 0u}; }
    L2S r0, r1, r2, r3;
#define L2F(rr, cn) do { const int cn_ = FAKE ? 0 : (((cn) < NCH - 1) ? (cn) : NCH - 2); l2s_fetch(rr, srcb + (size_t)cn_ * R1_STRIDE, gamb + (size_t)cn_ * 64); } while (0)
    L2F(r0, 0); L2F(r1, 1); L2F(r2, 2); L2F(r3, 3);
    l2s_stage(r0, G0, H0, M0, F.tid);
    lds_barrier(); __builtin_amdgcn_sched_barrier(0);
#pragma nounroll
    for (int c = 0; c < NCH - 1; c += 4) {
        l2s_stage(r1, G1, H1, M1, F.tid); L2F(r0, c + 4);
        l2s_step(G0, H0, M0, Sb0, Sb1, Sm, row, cp, fr, fq, sst + (size_t)c * 4096, F.tid); lds_barrier(); __builtin_amdgcn_sched_barrier(0);
        l2s_stage(r2, G0, H0, M0, F.tid); L2F(r1, c + 5);
        l2s_step(G1, H1, M1, Sb1, Sb0, Sm, row, cp, fr, fq, sst + (size_t)(c + 1) * 4096, F.tid); lds_barrier(); __builtin_amdgcn_sched_barrier(0);
        l2s_stage(r3, G1, H1, M1, F.tid); L2F(r2, c + 6);
        l2s_step(G0, H0, M0, Sb0, Sb1, Sm, row, cp, fr, fq, sst + (size_t)(c + 2) * 4096, F.tid); lds_barrier(); __builtin_amdgcn_sched_barrier(0);
        l2s_stage(r0, G0, H0, M0, F.tid); L2F(r3, c + 7);
        l2s_step(G1, H1, M1, Sb1, Sb0, Sm, row, cp, fr, fq, sst + (size_t)(c + 3) * 4096, F.tid); lds_barrier(); __builtin_amdgcn_sched_barrier(0);
    }
#undef L2F
    { const int r_ = F.tid >> 3, c8 = F.tid & 7;
      *(v4u*)(sst + (size_t)(NCH - 1) * 4096 + r_ * 64 + 8 * c8) = *(const LAS v4u*)(Sb0 + r_ * TP + 8 * c8); }
    lds_barrier();
}
__device__ __forceinline__ void rwkv_y_task(const Args& a, const Frame& F, int task) {
    unsigned char* ws = a.ws;
    const int c = 1 + (task & 31), bh = task >> 5, b = bh >> 3, h = bh & 7;
    const int fr = F.lane & 15, fq = F.lane >> 4;
    const bf16* Sg = (const bf16*)(ws + WS_SST) + (size_t)(bh * NCH + c) * 4096 + fr * 64 + 8 * fq;
    bf16x8 sf[8];
#pragma unroll
    for (int ct = 0; ct < 4; ++ct) { sf[2 * ct] = *(const bf16x8*)(Sg + ct * 1024); sf[2 * ct + 1] = *(const bf16x8*)(Sg + ct * 1024 + 32); }
    f32x4 lg[4], lb[4];
#pragma unroll
    for (int ct = 0; ct < 4; ++ct) { const int i0 = h * 64 + ct * 16 + 4 * fq; lg[ct] = *(const f32x4*)(a.in[I_RLNG] + i0); lb[ct] = *(const f32x4*)(a.in[I_RLNB] + i0); }
    LAS bf16* ost = (LAS bf16*)(F.lds + 102400 + F.wave * 2304);
    const unsigned char* r1u = ws + WS_R1 + (size_t)(bh * NCH + c) * R1_STRIDE + (size_t)(fr * 64 + 4 * fq) * 2;
    bf16x8 fa0[4], fa1[4]; v2u q0[4][4];
#pragma unroll
    for (int rt = 0; rt < 4; ++rt) { const unsigned char* r1 = r1u + rt * 2048;
        fa0[rt] = *(const bf16x8*)(r1 + 2 * 8192 + 8 * fq); fa1[rt] = *(const bf16x8*)(r1 + 2 * 8192 + 64 + 8 * fq);
#pragma unroll
        for (int ct = 0; ct < 4; ++ct) q0[rt][ct] = *(const v2u*)(r1 + 3 * 8192 + ct * 32); }
#pragma unroll
    for (int rt = 0; rt < 4; ++rt) {
        const unsigned char* r1 = r1u + rt * 2048;
        v2u q1[4], q2[4];
#pragma unroll
        for (int ct = 0; ct < 4; ++ct) { q1[ct] = *(const v2u*)(r1 + 4 * 8192 + ct * 32); q2[ct] = *(const v2u*)(r1 + 5 * 8192 + ct * 32); }
        f32x4 y[4]; float s = 0.f;
#pragma unroll
        for (int ct = 0; ct < 4; ++ct) {
            f32x4 acc = {bflo(q0[rt][ct].x), bfhi(q0[rt][ct].x), bflo(q0[rt][ct].y), bfhi(q0[rt][ct].y)};
            acc = mfma16(sf[2 * ct], fa0[rt], acc); acc = mfma16(sf[2 * ct + 1], fa1[rt], acc);
            y[ct] = acc; s += (acc[0] + acc[1]) + (acc[2] + acc[3]); }
        s += shx(s, 16, F.lane); s += shx(s, 32, F.lane);
        const float mean = s * (1.f / 64.f); float q = 0.f;
#pragma unroll
        for (int ct = 0; ct < 4; ++ct) { y[ct] = y[ct] - mean; q += (y[ct][0] * y[ct][0] + y[ct][1] * y[ct][1]) + (y[ct][2] * y[ct][2] + y[ct][3] * y[ct][3]); }
        q += shx(q, 16, F.lane); q += shx(q, 32, F.lane);
        const float rstd = __builtin_amdgcn_rsqf(q * (1.f / 64.f) + 64e-5f);
#pragma unroll
        for (int ct = 0; ct < 4; ++ct) {
            const f32x4 g = {bflo(q1[ct].x), bfhi(q1[ct].x), bflo(q1[ct].y), bfhi(q1[ct].y)}, bv = {bflo(q2[ct].x), bfhi(q2[ct].x), bflo(q2[ct].y), bfhi(q2[ct].y)};
            const f32x4 o = (y[ct] * rstd * lg[ct] + lb[ct] + bv) * g;
            *(LAS v2u*)(ost + fr * 72 + ct * 16 + 4 * fq) = pack4(o); }
        asm volatile("s_waitcnt lgkmcnt(0)" ::: "memory");
        bf16* yout = (bf16*)(ws + WS_YMIX) + ((size_t)b * SEQ + 64 * (c - 1) + rt * 16) * D + 512 + h * 64;
#pragma unroll
        for (int hh = 0; hh < 2; ++hh) { const int tr = (F.lane >> 3) + 8 * hh, c8 = F.lane & 7;
            *(v4u*)(yout + (size_t)tr * D + 8 * c8) = *(const LAS v4u*)(ost + tr * 72 + 8 * c8); }
        asm volatile("s_waitcnt lgkmcnt(0)" ::: "memory");
    }
}
__device__ __forceinline__ void gla_scan_unit(const Args& a, const Frame& F, int j) {
    float* GUS = (float*)(a.ws + WS_GUS); const float* DL = (const float*)(a.ws + WS_DL);
    const int bh = j >> 1, half = j & 1;
    const int d = 32 * half + (F.tid >> 4), e0 = (F.tid & 15) * 8;
    float* base = GUS + (size_t)bh * NCH * 8192 + d * 128 + e0;
    const float* dl = DL + (size_t)bh * NCH * 64 + d;
    f32x4 s0 = {0.f, 0.f, 0.f, 0.f}, s1 = s0;
    f32x4 ua[4], ub[4]; float dq[4];
#pragma unroll
    for (int q = 0; q < 3; ++q) { ua[q] = *(const f32x4*)(base + (size_t)q * 8192); ub[q] = *(const f32x4*)(base + (size_t)q * 8192 + 4); dq[q] = dl[q * 64]; }
#pragma unroll 4
    for (int c = 0; c < NCH - 1; ++c) {
        const int cn = (c + 3 < NCH - 1) ? c + 3 : NCH - 2;
        ua[(c + 3) & 3] = *(const f32x4*)(base + (size_t)cn * 8192); ub[(c + 3) & 3] = *(const f32x4*)(base + (size_t)cn * 8192 + 4); dq[(c + 3) & 3] = dl[cn * 64];
        *(f32x4*)(base + (size_t)c * 8192) = s0; *(f32x4*)(base + (size_t)c * 8192 + 4) = s1;
        s0 = s0 * dq[c & 3] + ua[c & 3]; s1 = s1 * dq[c & 3] + ub[c & 3];
    }
    *(f32x4*)(base + (size_t)(NCH - 1) * 8192) = s0; *(f32x4*)(base + (size_t)(NCH - 1) * 8192 + 4) = s1;
}
__device__ __forceinline__ void phase3(const Args& a, const Frame& F) {
    for (int u = F.blk; u < 256; u += F.G) {
        if (u < 128) { if constexpr (((REP_MASK >> 20) & 1) != 0) rwkv_l2_unit<true>(a, F, u); for (int rep_ = 0; rep_ < NREP(3); ++rep_) rwkv_l2_unit<false>(a, F, u); }
        else gla_scan_unit(a, F, u - 128);
    }
}

__device__ __forceinline__ void gla_g3_unit(const Args& a, const Frame& F, int b, int h, int c) {
    const bf16* PROJ = (const bf16*)(a.ws + WS_PROJ); const bf16* PROJM = (const bf16*)(a.ws + WS_PROJM);
    const float* GUS = (const float*)(a.ws + WS_GUS); bf16* YMIX = (bf16*)(a.ws + WS_YMIX);
    const int vp0 = NMETA + 64 * (c - 1);
    gla_bc(a, F, b, h, vp0, 64);
    LAS float* BC = (LAS float*)(F.lds + 4096);
    LAS bf16* QT = (LAS bf16*)(F.lds + 24576);
    LAS bf16* KL = QT + 64 * TP;
    LAS bf16* AT = KL + 64 * TP;
    LAS bf16* VT = AT + 64 * TP;
    LAS bf16* ST = VT + 128 * TP;
    LAS float* RS = (LAS float*)(ST + 128 * TP);
    {
        const int t = F.tid >> 3, q = F.tid & 7;
        const f32x4 q0 = ldp4(PROJ, PROJM, b, vp0 + t, GQ + h * 64 + 8 * q), q1 = ldp4(PROJ, PROJM, b, vp0 + t, GQ + h * 64 + 8 * q + 4);
        const f32x4 k0 = ldp4(PROJ, PROJM, b, vp0 + t, GK + h * 64 + 8 * q), k1 = ldp4(PROJ, PROJM, b, vp0 + t, GK + h * 64 + 8 * q + 4);
        float qv[8] = {q0.x, q0.y, q0.z, q0.w, q1.x, q1.y, q1.z, q1.w}, kv[8] = {k0.x, k0.y, k0.z, k0.w, k1.x, k1.y, k1.z, k1.w};
#pragma unroll
        for (int i = 0; i < 8; ++i) { const float bcv = BC[t * BCP + 8 * q + i]; qv[i] *= fexp(bcv) * 0.125f; kv[i] *= fexp(-bcv); }
        v4u o; o.x = pk2(qv[0], qv[1]); o.y = pk2(qv[2], qv[3]); o.z = pk2(qv[4], qv[5]); o.w = pk2(qv[6], qv[7]);
        *(LAS v4u*)(QT + t * TP + 8 * q) = o;
        o.x = pk2(kv[0], kv[1]); o.y = pk2(kv[2], kv[3]); o.z = pk2(kv[4], kv[5]); o.w = pk2(kv[6], kv[7]);
        *(LAS v4u*)(KL + t * TP + 8 * q) = o;
#pragma unroll
        for (int qq = 0; qq < 4; ++qq) {
            const int e0 = 16 * q + 4 * qq;
            const f32x4 vv = ldp4(PROJ, PROJM, b, vp0 + t, GV + h * 128 + e0);
#pragma unroll
            for (int i = 0; i < 4; ++i) VT[(e0 + i) * TP + t] = (bf16)f2bf(vv[i]);
            const f32x4 sv = *(const f32x4*)(GUS + ((size_t)((b * 4 + h) * NCH + c) * 64 + t) * 128 + e0);
#pragma unroll
            for (int i = 0; i < 4; ++i) ST[(e0 + i) * TP + t] = (bf16)f2bf(sv[i]);
        }
    }
    lds_barrier();
    const int rt = F.wave & 3, wh = F.wave >> 2, fr = F.lane & 15, fq = F.lane >> 4;
    const int trow = rt * 16 + fr;
    {
        f32x4 av[2];
#pragma unroll
        for (int cc = 0; cc < 2; ++cc) { const int ct = 2 * wh + cc;
            f32x4 acc = {0.f, 0.f, 0.f, 0.f};
#pragma unroll
            for (int ks = 0; ks < 2; ++ks)
                acc = mfma16(*(const LAS bf16x8*)(KL + (ct * 16 + fr) * TP + ks * 32 + 8 * fq), *(const LAS bf16x8*)(QT + trow * TP + ks * 32 + 8 * fq), acc);
            const int s0 = ct * 16 + 4 * fq;
#pragma unroll
            for (int i = 0; i < 4; ++i) if (s0 + i > trow) acc[i] = 0.f;
            av[cc] = acc; }
#pragma unroll
        for (int cc = 0; cc < 2; ++cc) *(LAS v2u*)(AT + trow * TP + (2 * wh + cc) * 16 + 4 * fq) = pack4(av[cc]);
    }
    lds_barrier();
    f32x4 oacc[4]; float ssq = 0.f;
#pragma unroll
    for (int cc = 0; cc < 4; ++cc) { const int ct = wh * 4 + cc;
        f32x4 acc = {0.f, 0.f, 0.f, 0.f};
#pragma unroll
        for (int ks = 0; ks < 2; ++ks) {
            acc = mfma16(*(const LAS bf16x8*)(VT + (ct * 16 + fr) * TP + ks * 32 + 8 * fq), *(const LAS bf16x8*)(AT + trow * TP + ks * 32 + 8 * fq), acc);
            acc = mfma16(*(const LAS bf16x8*)(ST + (ct * 16 + fr) * TP + ks * 32 + 8 * fq), *(const LAS bf16x8*)(QT + trow * TP + ks * 32 + 8 * fq), acc);
        }
        oacc[cc] = acc; ssq += (acc[0] * acc[0] + acc[1] * acc[1]) + (acc[2] * acc[2] + acc[3] * acc[3]); }
    ssq += shx(ssq, 16, F.lane); ssq += shx(ssq, 32, F.lane);
    if (fq == 0) RS[wh * 64 + trow] = ssq;
    lds_barrier();
    {
        const float tot = RS[trow] + RS[64 + trow];
        const float rstd = 1.f / sqrtf(tot * (1.f / 128.f) + 1e-6f);
        const size_t m = (size_t)b * SEQ + (vp0 - NMETA) + trow;
#pragma unroll
        for (int cc = 0; cc < 4; ++cc) { const int e0 = (wh * 4 + cc) * 16 + 4 * fq;
            const f32x4 gv = ldp4(PROJ, PROJM, b, vp0 + trow, GG + h * 128 + e0);
            const f32x4 ng = *(const f32x4*)(a.in[I_GNORM] + e0);
            float y[4];
#pragma unroll
            for (int i = 0; i < 4; ++i) { const float gi = gv[i]; y[i] = oacc[cc][i] * rstd * ng[i] * (gi * fsigmoid(gi)); }
            v2u o; o.x = pk2(y[0], y[1]); o.y = pk2(y[2], y[3]);
            *(v2u*)(YMIX + m * D + h * 128 + e0) = o; }
    }
    lds_barrier();
}
__device__ __forceinline__ void phase4(const Args& a, const Frame& F) {
    for (int t = F.blk * NWAVES + F.wave; t < 128 * 32; t += F.G * NWAVES) { const Frame F1 = mkframe(F.lds, F.wave); rwkv_y_task(a, F1, t); }
    __syncthreads();
    for (int u = F.blk; u < NB * 4 * 32; u += F.G) { const int c = 1 + (u & 31), bh = u >> 5; const Frame F1 = mkframe(F.lds, F.wave); gla_g3_unit(a, F1, bh >> 2, bh & 3, c); }
}

__device__ __forceinline__ int eidx_of(int L) { return 16 * (L & 1) + 8 * ((L >> 1) & 1) + 4 * ((L >> 2) & 1) + 2 * ((L >> 3) & 1) + ((L >> 4) & 1); }
__device__ __forceinline__ void p6_ln(const Args& a, const Frame& F, int m, f32x4 (&v)[4], const f32x4 (&g1)[4], const f32x4 (&b1)[4]) {
    unsigned char* ws = a.ws; bf16* H1 = (bf16*)(ws + WS_H1);
    float s = 0.f;
#pragma unroll
    for (int j = 0; j < 4; ++j) s += (v[j].x + v[j].y) + (v[j].z + v[j].w);
    const float mean = wave_sum(s, F.lane) * (1.f / D); float s2 = 0.f;
#pragma unroll
    for (int j = 0; j < 4; ++j) { v[j] = v[j] - mean; s2 += (v[j].x * v[j].x + v[j].y * v[j].y) + (v[j].z * v[j].z + v[j].w * v[j].w); }
    const float rstd = __builtin_amdgcn_rsqf(wave_sum(s2, F.lane) * (1.f / D) + 1e-5f);
#pragma unroll
    for (int j = 0; j < 4; ++j) { const int col = 4 * (F.lane + 64 * j);
        v[j] = v[j] * rstd * g1[j] + b1[j];
        v2u o; o.x = pk2(v[j].x, v[j].y); o.y = pk2(v[j].z, v[j].w);
        *(v2u*)(H1 + (size_t)m * D + col) = o;
        int w8 = __builtin_amdgcn_cvt_pk_fp8_f32(v[j].x, v[j].y, 0, false); w8 = __builtin_amdgcn_cvt_pk_fp8_f32(v[j].z, v[j].w, w8, true);
        *(int*)(ws + WS_H1Q + (size_t)m * D + col) = w8; }
}
__device__ __forceinline__ void phase6(const Args& a, const Frame& F, int csel) {
    unsigned char* ws = a.ws;
    LAS float* LG = (LAS float*)(F.lds + F.wave * 2560);
    LAS int* hist = (LAS int*)(F.lds + 8 * 2560);
    bf16* H1 = (bf16*)(ws + WS_H1);
    const bf16* RWH = (const bf16*)(ws + WS_RWH); const bf16* RWL = (const bf16*)(ws + WS_RWL);
    int* TOPI = (int*)(ws + WS_TOPI); float* GATE = (float*)(ws + WS_GATE); int* RANK = (int*)(ws + WS_RANK);
    unsigned* CNT = (unsigned*)(ws + WS_CTL) + CW_CNT + 2048 * csel;
    for (int rb = F.blk; rb < MX / 128; rb += F.G) {
        if (F.tid < 64) hist[F.tid] = 0;
        __syncthreads();
        const int mb = rb * 128 + F.wave * 16; const Frame& Fo = F;
        {
            const f32x4* xr0 = (const f32x4*)(a.in[I_X] + (size_t)mb * D) + F.lane;
            const v2u* mr0 = (const v2u*)((const bf16*)(ws + WS_MIXB) + (size_t)mb * D) + F.lane;
            const float* st0 = (const float*)(ws + WS_STATS) + 2 * (size_t)mb;
            f32x4 va[4], vb[4], vc[4], vd[4]; v2u ma[4], mbv[4], mc[4], md[4]; float sa0, sa1, sb0, sb1, sc0, sc1, sd0, sd1;
#define P6_LOAD(vv, mmv, s0v, s1v, ii) do { _Pragma("unroll") for (int j = 0; j < 4; ++j) { vv[j] = xr0[(size_t)(ii) * (D / 4) + 64 * j]; mmv[j] = mr0[(size_t)(ii) * (D / 4) + 64 * j]; } s0v = st0[2 * (ii)]; s1v = st0[2 * (ii) + 1]; } while (0)
#define P6_FORM(vv, mmv, s0v, s1v) do { _Pragma("unroll") for (int j = 0; j < 4; ++j) vv[j] = ((vv[j] - s0v) * s1v) * gi[j] + bi[j] + unpk4(mmv[j]); } while (0)
            f32x4 gi[4], bi[4], g1[4], b1[4];
#pragma unroll
            for (int j = 0; j < 4; ++j) { const int col = 4 * (F.lane + 64 * j);
                gi[j] = *(const f32x4*)(a.in[I_LNIN_G] + col) * ALPHA; bi[j] = *(const f32x4*)(a.in[I_LNIN_B] + col) * ALPHA;
                g1[j] = *(const f32x4*)(a.in[I_LN1G] + col); b1[j] = *(const f32x4*)(a.in[I_LN1B] + col); }
            P6_LOAD(va, ma, sa0, sa1, 0); P6_LOAD(vb, mbv, sb0, sb1, 1);
#pragma nounroll
            for (int i = 0; i < 16; i += 4) {
                P6_LOAD(vc, mc, sc0, sc1, i + 2); P6_LOAD(vd, md, sd0, sd1, i + 3);
                P6_FORM(va, ma, sa0, sa1); P6_FORM(vb, mbv, sb0, sb1); p6_ln(a, F, mb + i, va, g1, b1); p6_ln(a, F, mb + i + 1, vb, g1, b1);
                if (i + 4 < 16) { P6_LOAD(va, ma, sa0, sa1, i + 4); P6_LOAD(vb, mbv, sb0, sb1, i + 5); }
                P6_FORM(vc, mc, sc0, sc1); P6_FORM(vd, md, sd0, sd1); p6_ln(a, F, mb + i + 2, vc, g1, b1); p6_ln(a, F, mb + i + 3, vd, g1, b1);
            }
#undef P6_LOAD
#undef P6_FORM
        }
        asm volatile("s_waitcnt vmcnt(0)" ::: "memory");
        {
            const int fr = F.lane & 15, fq = F.lane >> 4;
            const bf16* ap = H1 + (size_t)(mb + fr) * D + 8 * fq;
            const bf16* bh = RWH + (size_t)fr * D + 8 * fq; const bf16* bl = RWL + (size_t)fr * D + 8 * fq;
            f32x4 acc0 = {0.f, 0.f, 0.f, 0.f}, acc1 = acc0;
#pragma unroll 8
            for (int ks = 0; ks < 32; ++ks) { const bf16x8 af = *(const bf16x8*)(ap + ks * 32);
                acc0 = mfma16(*(const bf16x8*)(bh + ks * 32), af, acc0); acc0 = mfma16(*(const bf16x8*)(bl + ks * 32), af, acc0);
                acc1 = mfma16(*(const bf16x8*)(bh + 16 * D + ks * 32), af, acc1); acc1 = mfma16(*(const bf16x8*)(bl + 16 * D + ks * 32), af, acc1); }
            const f32x4 rb0 = *(const f32x4*)(a.in[I_RTB] + 4 * fq), rb1 = *(const f32x4*)(a.in[I_RTB] + 16 + 4 * fq);
#pragma unroll
            for (int q = 0; q < 4; ++q) { LG[fr * 33 + 4 * fq + q] = acc0[q] + rb0[q]; LG[fr * 33 + 16 + 4 * fq + q] = acc1[q] + rb1[q]; }
        }
        asm volatile("s_waitcnt lgkmcnt(0)" ::: "memory");
        LAS int* EK = (LAS int*)(LG + 528);
        if (F.lane < 16) {
            float lv[32];
#pragma unroll
            for (int e = 0; e < 32; ++e) lv[e] = LG[F.lane * 33 + e];
            int ek[4]; float lk[4];
#pragma unroll
            for (int k = 0; k < 4; ++k) { float best = -3.0e38f; int bi = 0;
#pragma unroll
                for (int e = 0; e < 32; ++e) { const bool tk = lv[e] > best; best = tk ? lv[e] : best; bi = tk ? e : bi; }
                ek[k] = bi; lk[k] = best;
#pragma unroll
                for (int e = 0; e < 32; ++e) lv[e] = (e == bi) ? -3.0e38f : lv[e]; }
            const float e1 = expf(lk[1] - lk[0]), e2 = expf(lk[2] - lk[0]), e3 = expf(lk[3] - lk[0]);
            const float inv = 1.f / (1.f + e1 + e2 + e3);
            const size_t m = (size_t)(mb + F.lane);
            *(i32x4g*)(TOPI + m * 4) = (i32x4g){ek[0], ek[1], ek[2], ek[3]};
            *(f32x4*)(GATE + m * 4) = (f32x4){inv, e1 * inv, e2 * inv, e3 * inv};
#pragma unroll
            for (int k = 0; k < 4; ++k) EK[F.lane * 4 + k] = ek[k];
        }
        asm volatile("s_waitcnt lgkmcnt(0)" ::: "memory");
        const int my_e = EK[F.lane];
        const int lrank = __hip_atomic_fetch_add(&hist[my_e], 1, __ATOMIC_RELAXED, __HIP_MEMORY_SCOPE_WORKGROUP);
        __syncthreads();
        if (F.tid < 32) hist[32 + F.tid] = (int)__hip_atomic_fetch_add(CNT + 64 * F.tid, (unsigned)hist[F.tid], __ATOMIC_RELAXED, __HIP_MEMORY_SCOPE_AGENT);
        __syncthreads();
        RANK[((size_t)rb * 128 + F.wave * 16 + (F.lane >> 2)) * 4 + (F.lane & 3)] = hist[32 + my_e] + lrank;
        __syncthreads();
    }
}

__device__ __forceinline__ void phase7(const Args& a, const Frame& F) {
    unsigned char* ws = a.ws;
    LAS int* starts = (LAS int*)F.lds;
    unsigned* CNT = (unsigned*)(ws + WS_CTL) + CW_CNT;
    int* TILEE = (int*)(ws + WS_TILEE); int* SLOTTOK = (int*)(ws + WS_SLOTTOK);
    if (F.tid < 32) { const int cnt = (int)ld_agent(CNT + 64 * F.tid); starts[64 + F.tid] = cnt; starts[32 + F.tid] = (cnt + 255) & ~255; }
    __syncthreads();
    if (F.tid == 0) { int run = 0; for (int e = 0; e < 32; ++e) { starts[e] = run; run += starts[32 + e]; }
        if (F.blk == 0) { TILEE[1023] = run >> 8; for (int e = 0; e < 32; ++e) for (int tl = starts[e] >> 8; tl < (starts[e] + starts[32 + e]) >> 8; ++tl) TILEE[tl] = e; } }
    __syncthreads();
    if (F.blk == 0) { for (int e = 0; e < 32; ++e) for (int s = starts[e] + starts[64 + e] + F.tid; s < starts[e] + starts[32 + e]; s += NTHR) SLOTTOK[s] = 0; }
    const int* TOPI = (const int*)(ws + WS_TOPI); const int* RANK = (const int*)(ws + WS_RANK); int* TSLOT = (int*)(ws + WS_TSLOT);
    for (int q = F.blk * NTHR + F.tid; q < MX * 4; q += F.G * NTHR) {
        const int slot = starts[TOPI[q]] + RANK[q];
        TSLOT[q] = slot; SLOTTOK[slot] = q >> 2;
    }
}
__device__ __forceinline__ int moe_fill_table(const Args& a, const Frame& F, int nN, int RM) {
    LAS int* tab = (LAS int*)(F.lds + TAB_OFF);
    const unsigned* TILEE = (const unsigned*)(a.ws + WS_TILEE);
    if (F.tid == 0) {
        const int NT = (int)ld_agent(TILEE + 1023);
        const int x = F.blk & 7, j = F.blk >> 3; int n = 0;
        for (int i = 0; i < 64; ++i) { const int s = i * 8 + x, pm = s * RM + j / nN; if (pm >= NT) break;
            const int e = (int)ld_agent(TILEE + pm); tab[2 * n] = pm; tab[2 * n + 1] = e * nN + (j % nN); ++n; }
        tab[128] = n;
    }
    __syncthreads();
    return __builtin_amdgcn_readfirstlane(tab[128]);
}

__device__ __forceinline__ void p10_acc(float (&s)[16], int j, const v4u w, float g) {
    s[8 * j + 0] += g * bflo(w.x); s[8 * j + 1] += g * bfhi(w.x); s[8 * j + 2] += g * bflo(w.y); s[8 * j + 3] += g * bfhi(w.y);
    s[8 * j + 4] += g * bflo(w.z); s[8 * j + 5] += g * bfhi(w.z); s[8 * j + 6] += g * bflo(w.w); s[8 * j + 7] += g * bfhi(w.w);
}
typedef float f32x2 __attribute__((ext_vector_type(2)));
__device__ __forceinline__ void p10_acc8(float (&s)[16], int j, const v2u w, float g) {
    const f32x2 a0 = __builtin_amdgcn_cvt_pk_f32_fp8((int)w.x, false), a1 = __builtin_amdgcn_cvt_pk_f32_fp8((int)w.x, true);
    const f32x2 a2 = __builtin_amdgcn_cvt_pk_f32_fp8((int)w.y, false), a3 = __builtin_amdgcn_cvt_pk_f32_fp8((int)w.y, true);
    s[8 * j + 0] += g * a0.x; s[8 * j + 1] += g * a0.y; s[8 * j + 2] += g * a1.x; s[8 * j + 3] += g * a1.y;
    s[8 * j + 4] += g * a2.x; s[8 * j + 5] += g * a2.y; s[8 * j + 6] += g * a3.x; s[8 * j + 7] += g * a3.y;
}
__device__ __forceinline__ void phase10(const Args& a, const Frame& F) {
    unsigned char* ws = a.ws;
    const bf16* H1 = (const bf16*)(ws + WS_H1); const unsigned char* YS = ws + WS_YS;
    const int* TSLOT = (const int*)(ws + WS_TSLOT); const float* GATE = (const float*)(ws + WS_GATE);
    const int gw = F.blk * NWAVES + F.wave, NGW = F.G * NWAVES;
    f32x4 gv[4], bv[4];
#pragma unroll
    for (int q = 0; q < 4; ++q) { const int col = 8 * F.lane + 512 * (q >> 1) + 4 * (q & 1); gv[q] = *(const f32x4*)(a.in[I_LN2G] + col); bv[q] = *(const f32x4*)(a.in[I_LN2B] + col); }
    for (int m0 = gw; m0 < MX; m0 += 2 * NGW) {
        int mm[2]; mm[0] = m0; mm[1] = (m0 + NGW < MX) ? m0 + NGW : m0;
        int slot[2][4]; float gt[2][4]; v4u hw[2][2]; v2u yw[2][4][2];
#pragma unroll
        for (int r = 0; r < 2; ++r) {
#pragma unroll
            for (int k = 0; k < 4; ++k) { slot[r][k] = TSLOT[(size_t)mm[r] * 4 + k]; gt[r][k] = GATE[(size_t)mm[r] * 4 + k]; }
#pragma unroll
            for (int j = 0; j < 2; ++j) hw[r][j] = *(const v4u*)(H1 + (size_t)mm[r] * D + 8 * F.lane + 512 * j); }
#pragma unroll
        for (int r = 0; r < 2; ++r)
#pragma unroll
            for (int k = 0; k < 4; ++k)
#pragma unroll
                for (int j = 0; j < 2; ++j) yw[r][k][j] = *(const v2u*)(YS + (size_t)slot[r][k] * D + 8 * F.lane + 512 * j);
#pragma unroll
        for (int r = 0; r < 2; ++r) {
            float s[16];
#pragma unroll
            for (int i = 0; i < 16; ++i) s[i] = 0.f;
#pragma unroll
            for (int j = 0; j < 2; ++j) p10_acc(s, j, hw[r][j], ALPHA);
#pragma unroll
            for (int k = 0; k < 4; ++k)
#pragma unroll
                for (int j = 0; j < 2; ++j) p10_acc8(s, j, yw[r][k][j], gt[r][k]);
            float t = 0.f;
#pragma unroll
            for (int i = 0; i < 16; ++i) t += s[i];
            const float mean = wave_sum(t, F.lane) * (1.f / D); float q = 0.f;
#pragma unroll
            for (int i = 0; i < 16; ++i) { s[i] -= mean; q += s[i] * s[i]; }
            const float rstd = __builtin_amdgcn_rsqf(wave_sum(q, F.lane) * (1.f / D) + 1e-5f);
            if (r == 0 || mm[1] != mm[0]) {
#pragma unroll
                for (int q4 = 0; q4 < 4; ++q4) { const int col = 8 * F.lane + 512 * (q4 >> 1) + 4 * (q4 & 1);
                    f32x4 o; o.x = s[4 * q4 + 0] * rstd * gv[q4].x + bv[q4].x; o.y = s[4 * q4 + 1] * rstd * gv[q4].y + bv[q4].y; o.z = s[4 * q4 + 2] * rstd * gv[q4].z + bv[q4].z; o.w = s[4 * q4 + 3] * rstd * gv[q4].w + bv[q4].w;
                    *(f32x4*)(a.out + (size_t)mm[r] * D + col) = o; } }
        }
    }
}

template <int LO, int HI>
__global__ void __launch_bounds__(NTHR, 2) fwd(Args a) {
    extern __shared__ __attribute__((aligned(16))) unsigned char lds_raw[];
    LAS unsigned char* lds = (LAS unsigned char*)lds_raw;
    const int wave = __builtin_amdgcn_readfirstlane((int)(threadIdx.x >> 6));
    volatile LAS unsigned* MISC = (volatile LAS unsigned*)(lds + MISC_OFF);
    if (wave == 0) MISC[lane_id()] = 0u;
    __syncthreads();
    unsigned* ctl = (unsigned*)(a.ws + WS_CTL);
    XcdBarrier bar; bar.bar = ctl + CW_BAR; bar.x = 0; bar.st = nullptr;
    if constexpr (HI - LO > 1) bar = xcd_barrier_post(ctl + CW_BAR, MISC + 8, wave == 0 && lane_id() == 0);
#define PH(k) if constexpr (LO <= (k) && (k) < HI)
#define SEAM(k) if constexpr (LO <= (k) && (k) + 1 < HI) xcd_barrier(bar, wave == 0 && lane_id() == 0)
    PH(0) for (int rep_ = 0; rep_ < NREP(0); ++rep_) { const Frame F = mkframe(lds, wave); phase0(a, F); } SEAM(0);
    PH(1) for (int rep_ = 0; rep_ < NREP(1); ++rep_) { const Frame F = mkframe(lds, wave);
            pg8::Gemm g{(const pg8::bf16_t*)(a.ws + WS_A0), (const pg8::bf16_t*)(a.ws + WS_WIN), MX, PW, D}; pg8::StaticOrder S; S.init(MX, PW, F.G, F.blk);
            pg8::EpiBf16Plain E{(pg8::bf16_t*)(a.ws + WS_PROJ), PW};
            pg8::gemm_phase<pg8::EpiBf16Plain, pg8::StaticOrder, true, true>(F.lds, g, S, E, F.tid); } SEAM(1);
    PH(2) for (int rep_ = 0; rep_ < NREP(2); ++rep_) { const Frame F = mkframe(lds, wave); phase2(a, F); } SEAM(2);
    PH(3) { const Frame F = mkframe(lds, wave); phase3(a, F); } SEAM(3);
    PH(4) for (int rep_ = 0; rep_ < NREP(4); ++rep_) { const Frame F = mkframe(lds, wave); phase4(a, F); } SEAM(4);
    PH(5) for (int rep_ = 0; rep_ < NREP(5); ++rep_) { const Frame F = mkframe(lds, wave);
            pg8::Gemm g{(const pg8::bf16_t*)(a.ws + WS_YMIX), (const pg8::bf16_t*)(a.ws + WS_WOUT), MX, D, D}; pg8::StaticOrder S; S.init(MX, D, F.G, F.blk);
            pg8::EpiBf16Plain E{(pg8::bf16_t*)(a.ws + WS_MIXB), D};
            pg8::gemm_phase<pg8::EpiBf16Plain, pg8::StaticOrder, true, true>(F.lds, g, S, E, F.tid); } SEAM(5);
    PH(6) for (int rep_ = 0; rep_ < NREP(6); ++rep_) { const Frame F = mkframe(lds, wave); phase6(a, F, rep_); } SEAM(6);
    PH(7) for (int rep_ = 0; rep_ < NREP(7); ++rep_) { const Frame F = mkframe(lds, wave); phase7(a, F); } SEAM(7);
    PH(8) for (int rep_ = 0; rep_ < NREP(8); ++rep_) { const Frame F = mkframe(lds, wave); const int n = moe_fill_table(a, F, 8, 4);
            pg8::Gemm g{(const pg8::bf16_t*)(a.ws + WS_H1Q), (const pg8::bf16_t*)(a.ws + WS_WUP), 0, 0, D / 2}; pg8::TableOrder S{(const LAS int*)(F.lds + TAB_OFF), n};
            pg8::EpiSwiglu8 E{a.ws + WS_ACT, a.in[I_BUP]};
            pg8::gemm_phase_g<pg8::EpiSwiglu8, pg8::TableOrder, true, true, 121>(F.lds, g, S, E, F.tid, (const int*)(a.ws + WS_SLOTTOK)); } SEAM(8);
    PH(9) for (int rep_ = 0; rep_ < NREP(9); ++rep_) { const Frame F = mkframe(lds, wave); const int n = moe_fill_table(a, F, 4, 8);
            pg8::Gemm g{(const pg8::bf16_t*)(a.ws + WS_ACT), (const pg8::bf16_t*)(a.ws + WS_WDN), 0, 0, D / 2}; pg8::TableOrder S{(const LAS int*)(F.lds + TAB_OFF), n};
            pg8::EpiDown8 E{a.ws + WS_YS, a.in[I_BDN]};
            pg8::gemm_phase<pg8::EpiDown8, pg8::TableOrder, true, true, 120>(F.lds, g, S, E, F.tid); } SEAM(9);
    PH(10) for (int rep_ = 0; rep_ < NREP(10); ++rep_) { const Frame F = mkframe(lds, wave); phase10(a, F); }
#undef PH
#undef SEAM
}

#ifndef MK_SINGLE
#define MK_SINGLE 1
#endif
template <int LO, int HI> static void launch_range(const Args& a, int grid, hipStream_t stream) {
    static bool attr = false;
    if (!attr) { (void)hipFuncSetAttribute((const void*)fwd<LO, HI>, hipFuncAttributeMaxDynamicSharedMemorySize, LDS_BYTES); attr = true; }
    hipLaunchKernelGGL((fwd<LO, HI>), dim3(grid), dim3(NTHR), LDS_BYTES, stream, a);
}
extern "C" void kernel_launch(void* const* d_in, const int* in_sizes, int n_in, void* d_out, int out_size, void* d_ws, size_t ws_size, hipStream_t stream) {
    if (n_in != 30 || ws_size < WS_END) { fprintf(stderr, "kernel_launch: unexpected inputs (n_in %d, ws %zu)\n", n_in, ws_size); return; }
    const int grid = 256;
    (void)hipMemsetAsync((char*)d_ws + WS_CTL, 0, CTL_ZERO_BYTES, stream);
    Args a{};
    for (int i = 0; i < 30; ++i) a.in[i] = (const float*)d_in[i];
    a.out = (float*)d_out; a.ws = (unsigned char*)d_ws;
#if MK_SINGLE
    launch_range<0, 11>(a, grid, stream);
#else
    launch_range<0, 1>(a, grid, stream); launch_range<1, 2>(a, grid, stream); launch_range<2, 3>(a, grid, stream); launch_range<3, 4>(a, grid, stream);
    launch_range<4, 5>(a, grid, stream); launch_range<5, 6>(a, grid, stream); launch_range<6, 7>(a, grid, stream); launch_range<7, 8>(a, grid, stream);
    launch_range<8, 9>(a, grid, stream); launch_range<9, 10>(a, grid, stream); launch_range<10, 11>(a, grid, stream);
#endif
}
```

```cpp
#include <hip/hip_runtime.h>
#include <cstdio>
#include <cstdint>
#include <cmath>
namespace pg8 {
#define PG8_LAS __attribute__((address_space(3)))
typedef unsigned short bf16_t;
typedef short bf16x8 __attribute__((ext_vector_type(8)));
typedef float f32x4 __attribute__((ext_vector_type(4)));
typedef unsigned u32x4 __attribute__((ext_vector_type(4)));
constexpr int BM = 256, BK = 64, HALF = 128, HTB = HALF * BK * 2  , STAGE_BYTES = 8 * HTB, NXCD = 8, WGM = 8;

__host__ __device__ __forceinline__ int lds_byte(int r, int c) { const int st = (r >> 4) * 2 + (c >> 5), rr = r & 15, cc = c & 31, ob = rr * 64 + cc * 2; return st * 1024 + (ob ^ (((ob >> 9) & 1) << 5)); }
__host__ __device__ __forceinline__ void stage_rc(int b, int& R, int& C) { const int st = b / 1024, sb = b % 1024, swz = sb ^ (((sb >> 9) & 1) << 5); R = (st >> 1) * 16 + swz / 64; C = (st & 1) * 32 + (swz % 64) / 2; }
__host__ __device__ __forceinline__ int perm32(int rho) { const int n = rho >> 4, i = rho & 15; return 8 * (i >> 2) + 4 * n + (i & 3); }

struct Unit { int pm, pn; };
struct Gemm { const bf16_t* A; const bf16_t* Bt; int M, N, K; };

struct StaticOrder {
    int nM, nN, nwg, G, c;
    __host__ __device__ void init(int M, int N, int G_, int c_) { nM = M / BM; nN = N / BM; nwg = nM * nN; G = G_; c = c_; }
    __host__ __device__ bool next(int i, Unit& u) const {
        const long L = (long)i * G + c; if (L >= nwg) return false;
        int wgid = (int)L; { const int q = nwg / NXCD, r = nwg % NXCD, xcd = wgid % NXCD, off = wgid / NXCD; wgid = (xcd < r ? xcd * (q + 1) : r * (q + 1) + (xcd - r) * q) + off; }
        const int nig = WGM * nN, gid = wgid / nig, fm = gid * WGM, gsz = (nM - fm) < WGM ? (nM - fm) : WGM;
        u.pm = fm + ((wgid % nig) % gsz); u.pn = (wgid % nig) / gsz; return true;
    }
    __device__ __forceinline__ void a_ready(const Unit&) const {}
    __device__ __forceinline__ void done(const Unit&) const {}
};


__device__ __forceinline__ unsigned cvt_pk_bf16(float lo, float hi) { unsigned r; asm volatile("v_cvt_pk_bf16_f32 %0, %1, %2" : "=v"(r) : "v"(lo), "v"(hi)); return r; }
typedef unsigned u32x2 __attribute__((ext_vector_type(2)));
typedef int i32x8 __attribute__((ext_vector_type(8))); typedef int i32x4 __attribute__((ext_vector_type(4)));
__device__ __forceinline__ void mfma_f8(f32x4& acc, i32x8 a, i32x8 b, int sa, int sb) {
    asm volatile("s_nop 1\n\tv_mfma_scale_f32_16x16x128_f8f6f4 %0, %1, %2, %0, %3, %4 op_sel_hi:[0,0,0]" : "+v"(acc) : "v"(a), "v"(b), "v"(sa), "v"(sb));
}
__device__ __forceinline__ i32x8 cat8(bf16x8 lo, bf16x8 hi) { const i32x4 a = __builtin_bit_cast(i32x4, lo), b = __builtin_bit_cast(i32x4, hi); return __builtin_shufflevector(a, b, 0, 1, 2, 3, 4, 5, 6, 7); }

struct EpiBf16Plain {
    static constexpr bool PERM = true, AFTER_DRAIN = false, HAS_BIAS = false;
    bf16_t* O; int ldc;
    __device__ __forceinline__ const float* bias_ptr(const Unit&) const { return nullptr; }
    __device__ __forceinline__ void operator()(const f32x4 (&acc)[2][2][4][2], const Unit& u, int wr, int wc, int fr, int fq, const PG8_LAS float*) const {
        const int row0 = u.pm * BM + wr * 64 + fr, col0 = u.pn * BM + wc * 32 + 8 * fq;
#pragma unroll
        for (int ai = 0; ai < 2; ++ai)
#pragma unroll
            for (int m = 0; m < 4; ++m) { bf16_t* rowp = O + (size_t)(row0 + ai * HALF + m * 16) * ldc + col0;
#pragma unroll
                for (int bj = 0; bj < 2; ++bj) { const f32x4 v0 = acc[ai][bj][m][0], v1 = acc[ai][bj][m][1];
                    u32x4 w; w.x = cvt_pk_bf16(v0[0], v0[1]); w.y = cvt_pk_bf16(v0[2], v0[3]); w.z = cvt_pk_bf16(v1[0], v1[1]); w.w = cvt_pk_bf16(v1[2], v1[3]);
                    *(u32x4*)(rowp + bj * HALF) = w; } }
    }
};

__device__ __forceinline__ float swiglu1(float glu, float lin) {
    const float xg = fminf(glu, 7.0f), xl = fminf(fmaxf(lin, -7.0f), 7.0f);
    const float sg = __builtin_amdgcn_rcpf(1.0f + __expf(-1.702f * xg));
    return xg * sg * (xl + 1.0f);
}
struct EpiSwiglu8 {
    static constexpr bool PERM = true, AFTER_DRAIN = false, HAS_BIAS = true;
    unsigned char* ACT; const float* bup;
    __device__ __forceinline__ const float* bias_ptr(const Unit& u) const { return bup + (size_t)(u.pn >> 3) * 2048 + (u.pn & 7) * BM; }
    __device__ __forceinline__ void operator()(const f32x4 (&acc)[2][2][4][2], const Unit& u, int wr, int wc, int fr, int fq, const PG8_LAS float* bl) const {
        const int pn = u.pn & 7;
        const int row0 = u.pm * BM + wr * 64 + fr, ucol0 = pn * BM + wc * 32 + 8 * fq, acol0 = ucol0 >> 1;
        f32x4 bv[2][2];
#pragma unroll
        for (int bj = 0; bj < 2; ++bj)
#pragma unroll
            for (int n = 0; n < 2; ++n) bv[bj][n] = *(const PG8_LAS f32x4*)(bl + wc * 32 + 8 * fq + bj * HALF + 4 * n);
#pragma unroll
        for (int ai = 0; ai < 2; ++ai)
#pragma unroll
            for (int m = 0; m < 4; ++m) { unsigned char* rowp = ACT + (size_t)(row0 + ai * HALF + m * 16) * 1024 + acol0;
#pragma unroll
                for (int bj = 0; bj < 2; ++bj) { const f32x4 v0 = acc[ai][bj][m][0] + bv[bj][0], v1 = acc[ai][bj][m][1] + bv[bj][1];
                    int w = __builtin_amdgcn_cvt_pk_fp8_f32(swiglu1(v0[0], v0[1]), swiglu1(v0[2], v0[3]), 0, false);
                    w = __builtin_amdgcn_cvt_pk_fp8_f32(swiglu1(v1[0], v1[1]), swiglu1(v1[2], v1[3]), w, true);
                    *(int*)(rowp + bj * (HALF / 2)) = w; } }
    }
};
struct EpiDown8 {
    static constexpr bool PERM = true, AFTER_DRAIN = false, HAS_BIAS = true;
    unsigned char* YS; const float* bdn;
    __device__ __forceinline__ const float* bias_ptr(const Unit& u) const { return bdn + (size_t)(u.pn >> 2) * 1024 + (u.pn & 3) * BM; }
    __device__ __forceinline__ void operator()(const f32x4 (&acc)[2][2][4][2], const Unit& u, int wr, int wc, int fr, int fq, const PG8_LAS float* bl) const {
        const int pn = u.pn & 3;
        const int row0 = u.pm * BM + wr * 64 + fr, col0 = pn * BM + wc * 32 + 8 * fq;
        f32x4 bv[2][2];
#pragma unroll
        for (int bj = 0; bj < 2; ++bj)
#pragma unroll
            for (int n = 0; n < 2; ++n) bv[bj][n] = *(const PG8_LAS f32x4*)(bl + wc * 32 + 8 * fq + bj * HALF + 4 * n);
#pragma unroll
        for (int ai = 0; ai < 2; ++ai)
#pragma unroll
            for (int m = 0; m < 4; ++m) { unsigned char* rowp = YS + (size_t)(row0 + ai * HALF + m * 16) * 1024 + col0;
#pragma unroll
                for (int bj = 0; bj < 2; ++bj) { const f32x4 v0 = acc[ai][bj][m][0] + bv[bj][0], v1 = acc[ai][bj][m][1] + bv[bj][1];
                    int w0 = __builtin_amdgcn_cvt_pk_fp8_f32(v0[0], v0[1], 0, false); w0 = __builtin_amdgcn_cvt_pk_fp8_f32(v0[2], v0[3], w0, true);
                    int w1 = __builtin_amdgcn_cvt_pk_fp8_f32(v1[0], v1[1], 0, false); w1 = __builtin_amdgcn_cvt_pk_fp8_f32(v1[2], v1[3], w1, true);
                    u32x2 w; w.x = (unsigned)w0; w.y = (unsigned)w1;
                    *(u32x2*)(rowp + bj * HALF) = w; } }
    }
};
struct TableOrder {
    const PG8_LAS int* tab; int n;
    __device__ __forceinline__ bool next(int i, Unit& u) const {
        if (i >= n) return false;
        u.pm = __builtin_amdgcn_readfirstlane(tab[2 * i]); u.pn = __builtin_amdgcn_readfirstlane(tab[2 * i + 1]); return true;
    }
    __device__ __forceinline__ void a_ready(const Unit&) const {}
    __device__ __forceinline__ void done(const Unit&) const {}
};

constexpr int ROWS_LDS = 131072;
constexpr int BIAS_LDS = 133120;
template <class Epi, class Sched, bool ALIGN_EPI = false, bool SP2 = false, int SCW = 0>
__device__ __forceinline__ void gemm_phase(PG8_LAS unsigned char* lds, const Gemm g, const Sched& S, const Epi& E, const int tid) {
    static_assert(SP2, "two-super-phase form only");
    const int wid = __builtin_amdgcn_readfirstlane(tid >> 6), lane = tid & 63, wr = wid >> 2, wc = wid & 3, fr = lane & 15, fq = lane >> 4;
    int K_ = g.K; asm volatile("" : "+s"(K_));
    const int K = K_, nt = K / BK;
    constexpr int EXTRA = 16 + (Epi::HAS_BIAS ? 1 : 0);
    unsigned voffA[2], voffB[2];
#pragma unroll
    for (int i = 0; i < 2; ++i) { int R, C; stage_rc(tid * 16 + i * 8192, R, C); const int Rb = Epi::PERM ? ((R & ~31) + perm32(R & 31)) : R;
        voffA[i] = (unsigned)(R * K + C) * 2u; voffB[i] = (unsigned)(Rb * K + C) * 2u; }
    const size_t kstep = (size_t)(BK * 2);
    const size_t hstep = (size_t)HALF * K * 2;
    const size_t tstep = 2 * hstep;
    const unsigned ldsw = (unsigned)wid * 1024u;
    const int aoff = lds_byte(wr * 64 + fr, fq * 8), boff = lds_byte(wc * 32 + fr, fq * 8);
#define PG8_SA(b, h) (((b) * 2 + (h)) * HTB)
#define PG8_SB(b, h) ((4 + (b) * 2 + (h)) * HTB)
#define PG8_STAGE(bufoff, gbase, voff) do { _Pragma("unroll") for (int _i = 0; _i < 2; ++_i) \
        __builtin_amdgcn_global_load_lds((const unsigned*)((const char*)(gbase) + (voff)[_i]), (PG8_LAS unsigned*)(lds + (bufoff) + ldsw + _i * 8192), 16, 0, 0); } while (0)
#define PG8_LDA(dst, b, h) do { _Pragma("unroll") for (int m = 0; m < 4; ++m) _Pragma("unroll") for (int k = 0; k < 2; ++k) dst[m][k] = *(const PG8_LAS bf16x8*)(lds + PG8_SA(b, h) + aoff + m * 2048 + k * 1024); } while (0)
#define PG8_LDB(dst, b, h) do { _Pragma("unroll") for (int n = 0; n < 2; ++n) _Pragma("unroll") for (int k = 0; k < 2; ++k) dst[n][k] = *(const PG8_LAS bf16x8*)(lds + PG8_SB(b, h) + boff + n * 2048 + k * 1024); } while (0)
#define PG8_MMA(ai, bj, At, Bt) do { __builtin_amdgcn_s_setprio(1); _Pragma("unroll") for (int m = 0; m < 4; ++m) _Pragma("unroll") for (int n = 0; n < 2; ++n) { \
        if constexpr (SCW != 0) mfma_f8(acc[ai][bj][m][n], cat8(Bt[n][0], Bt[n][1]), cat8(At[m][0], At[m][1]), SCW * 0x01010101, 0x7f7f7f7f); \
        else { _Pragma("unroll") for (int k = 0; k < 2; ++k) acc[ai][bj][m][n] = __builtin_amdgcn_mfma_f32_16x16x32_bf16(Bt[n][k], At[m][k], acc[ai][bj][m][n], 0, 0, 0); } } __builtin_amdgcn_s_setprio(0); } while (0)
#define PG8_WAIT_V(n) asm volatile("s_waitcnt vmcnt(" #n ")" ::: "memory")
#define PG8_WAIT_VX(aft_) do { if (aft_) asm volatile("s_waitcnt vmcnt(%0)" :: "i"(8 + EXTRA) : "memory"); else asm volatile("s_waitcnt vmcnt(8)" ::: "memory"); } while (0)
#define PG8_WAIT_L(n) asm volatile("s_waitcnt lgkmcnt(" #n ")" ::: "memory")
#define PG8_BAR __builtin_amdgcn_s_barrier()
#define PG8_SCHED __builtin_amdgcn_sched_barrier(0)
#define PG8_BIAS(u_) do { if constexpr (Epi::HAS_BIAS) __builtin_amdgcn_global_load_lds((const unsigned*)(E.bias_ptr(u_) + 4 * lane), (PG8_LAS unsigned*)(lds + BIAS_LDS + wid * 1024), 16, 0, 0); } while (0)
    Unit cur, nxt; int ui = 0;
    if (!S.next(0, cur)) return;
    f32x4 acc[2][2][4][2];
#pragma unroll
    for (int a = 0; a < 2; ++a)
#pragma unroll
        for (int b = 0; b < 2; ++b)
#pragma unroll
            for (int m = 0; m < 4; ++m)
#pragma unroll
                for (int n = 0; n < 2; ++n) acc[a][b][m][n] = (f32x4){0.f, 0.f, 0.f, 0.f};
    bf16x8 At[4][2], B0[2][2], B1[2][2];
    const PG8_LAS float* biasl = (const PG8_LAS float*)(lds + BIAS_LDS + wid * 1024);
    PG8_BIAS(cur);
    const char* cA = (const char*)g.A + (size_t)cur.pm * tstep; const char* cB = (const char*)g.Bt + (size_t)cur.pn * tstep;
    S.a_ready(cur);
    PG8_STAGE(PG8_SB(0, 0), cB, voffB); PG8_STAGE(PG8_SB(0, 1), cB + hstep, voffB); PG8_STAGE(PG8_SA(0, 0), cA, voffA); PG8_STAGE(PG8_SA(0, 1), cA + hstep, voffA);
    if (wr == 1) PG8_BAR;
    PG8_WAIT_V(2); PG8_BAR;
    PG8_STAGE(PG8_SB(1, 0), cB + kstep, voffB); PG8_STAGE(PG8_SA(1, 0), cA + kstep, voffA); PG8_STAGE(PG8_SB(1, 1), cB + hstep + kstep, voffB); PG8_STAGE(PG8_SA(1, 1), cA + hstep + kstep, voffA);
    PG8_WAIT_V(8); PG8_BAR;
    for (;;) {
        const bool has_next = S.next(ui + 1, nxt);
        const char* nA = has_next ? (const char*)g.A + (size_t)nxt.pm * tstep : cA; const char* nB = has_next ? (const char*)g.Bt + (size_t)nxt.pn * tstep : cB;
        for (int t = 0; t < nt; t += 2) {
            const bool last = (t == nt - 2);
            const bool aft = (t == 0) && (ui > 0);
            const char* a1 = cA + (size_t)(t + 1) * kstep;
            const char* a2 = last ? nA : cA + (size_t)(t + 2) * kstep; const char* b2 = last ? nB : cB + (size_t)(t + 2) * kstep;
            const char* a3 = a2 + kstep; const char* b3 = b2 + kstep;
            if (last && has_next) S.a_ready(nxt);
            PG8_LDB(B0, 0, 0); PG8_LDB(B1, 0, 1); PG8_SCHED; PG8_LDA(At, 0, 0); if (t > 0) PG8_STAGE(PG8_SA(1, 1), a1 + hstep, voffA);
            PG8_WAIT_VX(aft); PG8_WAIT_L(0); PG8_BAR; PG8_MMA(0, 0, At, B0); PG8_MMA(0, 1, At, B1); PG8_BAR; PG8_SCHED;
            PG8_LDA(At, 0, 1); PG8_STAGE(PG8_SB(0, 0), b2, voffB); PG8_STAGE(PG8_SB(0, 1), b2 + hstep, voffB); PG8_STAGE(PG8_SA(0, 0), a2, voffA);
            PG8_WAIT_VX(aft); PG8_WAIT_L(0); PG8_BAR; PG8_MMA(1, 0, At, B0); PG8_MMA(1, 1, At, B1); PG8_BAR; PG8_SCHED;
            PG8_LDB(B0, 1, 0); PG8_LDB(B1, 1, 1); PG8_SCHED; PG8_LDA(At, 1, 0); PG8_STAGE(PG8_SA(0, 1), a2 + hstep, voffA);
            PG8_WAIT_VX(aft); PG8_WAIT_L(0); PG8_BAR; PG8_MMA(0, 0, At, B0); PG8_MMA(0, 1, At, B1); PG8_BAR; PG8_SCHED;
            PG8_LDA(At, 1, 1); PG8_STAGE(PG8_SB(1, 0), b3, voffB); PG8_STAGE(PG8_SB(1, 1), b3 + hstep, voffB); PG8_STAGE(PG8_SA(1, 0), a3, voffA);
            PG8_WAIT_V(8); PG8_WAIT_L(0); PG8_BAR; PG8_MMA(1, 0, At, B0); PG8_MMA(1, 1, At, B1); PG8_BAR; PG8_SCHED;
        }
        if (has_next) { PG8_STAGE(PG8_SA(1, 1), nA + hstep + kstep, voffA); }
        asm volatile("" ::: "memory"); PG8_SCHED;
        if constexpr (SCW != 0) asm volatile("s_nop 15\n\ts_nop 15" ::: "memory");
        if constexpr (ALIGN_EPI) { if (wr == 0) PG8_BAR; }
        E(acc, cur, wr, wc, fr, fq, biasl); S.done(cur);
        if (!has_next) break;
#pragma unroll
            for (int a = 0; a < 2; ++a)
#pragma unroll
            for (int b = 0; b < 2; ++b)
#pragma unroll
                for (int m = 0; m < 4; ++m)
#pragma unroll
                    for (int n = 0; n < 2; ++n) acc[a][b][m][n] = (f32x4){0.f, 0.f, 0.f, 0.f};
        cur = nxt; cA = nA; cB = nB; ++ui;
        asm volatile("s_waitcnt lgkmcnt(0)" ::: "memory");
        PG8_BIAS(cur);
        if constexpr (ALIGN_EPI) { if (wr == 1) PG8_BAR; }
    }
    PG8_WAIT_V(0);
    if constexpr (!ALIGN_EPI) { if (wr == 0) PG8_BAR; }
    PG8_BAR;
#undef PG8_SA
#undef PG8_SB
#undef PG8_STAGE
#undef PG8_LDA
#undef PG8_LDB
#undef PG8_MMA
#undef PG8_WAIT_V
#undef PG8_WAIT_VX
#undef PG8_WAIT_L
#undef PG8_BAR
#undef PG8_SCHED
#undef PG8_BIAS
}
template <class Epi, class Sched, bool ALIGN_EPI = false, bool SP2 = false, int SCW = 0>
__device__ __forceinline__ void gemm_phase_g(PG8_LAS unsigned char* lds, const Gemm g, const Sched& S, const Epi& E, const int tid, const int* rowmap) {
    static_assert(SP2, "two-super-phase form only");
    const int wid = __builtin_amdgcn_readfirstlane(tid >> 6), lane = tid & 63, wr = wid >> 2, wc = wid & 3, fr = lane & 15, fq = lane >> 4;
    int K_ = g.K; asm volatile("" : "+s"(K_));
    const int K = K_, nt = K / BK;
    constexpr int EXTRA = 16 + (Epi::HAS_BIAS ? 1 : 0) + 1;
    unsigned voffB[2], cv0[2], cv1[2]; int RA[2], CA[2];
#pragma unroll
    for (int i = 0; i < 2; ++i) { int R, C; stage_rc(tid * 16 + i * 8192, R, C); const int Rb = Epi::PERM ? ((R & ~31) + perm32(R & 31)) : R;
        RA[i] = R; CA[i] = C; voffB[i] = (unsigned)(Rb * K + C) * 2u; }
    const size_t kstep = (size_t)(BK * 2);
    const size_t hstep = (size_t)HALF * K * 2;
    const size_t tstep = 2 * hstep;
    const unsigned ldsw = (unsigned)wid * 1024u;
    const int aoff = lds_byte(wr * 64 + fr, fq * 8), boff = lds_byte(wc * 32 + fr, fq * 8);
#define PG8_SA(b, h) (((b) * 2 + (h)) * HTB)
#define PG8_SB(b, h) ((4 + (b) * 2 + (h)) * HTB)
#define PG8_STAGE(bufoff, gbase, voff) do { _Pragma("unroll") for (int _i = 0; _i < 2; ++_i) \
        __builtin_amdgcn_global_load_lds((const unsigned*)((const char*)(gbase) + (voff)[_i]), (PG8_LAS unsigned*)(lds + (bufoff) + ldsw + _i * 8192), 16, 0, 0); } while (0)
#define PG8_LDA(dst, b, h) do { _Pragma("unroll") for (int m = 0; m < 4; ++m) _Pragma("unroll") for (int k = 0; k < 2; ++k) dst[m][k] = *(const PG8_LAS bf16x8*)(lds + PG8_SA(b, h) + aoff + m * 2048 + k * 1024); } while (0)
#define PG8_LDB(dst, b, h) do { _Pragma("unroll") for (int n = 0; n < 2; ++n) _Pragma("unroll") for (int k = 0; k < 2; ++k) dst[n][k] = *(const PG8_LAS bf16x8*)(lds + PG8_SB(b, h) + boff + n * 2048 + k * 1024); } while (0)
#define PG8_MMA(ai, bj, At, Bt) do { __builtin_amdgcn_s_setprio(1); _Pragma("unroll") for (int m = 0; m < 4; ++m) _Pragma("unroll") for (int n = 0; n < 2; ++n) { \
        if constexpr (SCW != 0) mfma_f8(acc[ai][bj][m][n], cat8(Bt[n][0], Bt[n][1]), cat8(At[m][0], At[m][1]), SCW * 0x01010101, 0x7f7f7f7f); \
        else { _Pragma("unroll") for (int k = 0; k < 2; ++k) acc[ai][bj][m][n] = __builtin_amdgcn_mfma_f32_16x16x32_bf16(Bt[n][k], At[m][k], acc[ai][bj][m][n], 0, 0, 0); } } __builtin_amdgcn_s_setprio(0); } while (0)
#define PG8_WAIT_V(n) asm volatile("s_waitcnt vmcnt(" #n ")" ::: "memory")
#define PG8_WAIT_VX(aft_) do { if (aft_) asm volatile("s_waitcnt vmcnt(%0)" :: "i"(8 + EXTRA) : "memory"); else asm volatile("s_waitcnt vmcnt(8)" ::: "memory"); } while (0)
#define PG8_WAIT_L(n) asm volatile("s_waitcnt lgkmcnt(" #n ")" ::: "memory")
#define PG8_BAR __builtin_amdgcn_s_barrier()
#define PG8_SCHED __builtin_amdgcn_sched_barrier(0)
#define PG8_BIAS(u_) do { if constexpr (Epi::HAS_BIAS) __builtin_amdgcn_global_load_lds((const unsigned*)(E.bias_ptr(u_) + 4 * lane), (PG8_LAS unsigned*)(lds + BIAS_LDS + wid * 1024), 16, 0, 0); } while (0)
    Unit cur, nxt; int ui = 0;
    if (!S.next(0, cur)) return;
    f32x4 acc[2][2][4][2];
#pragma unroll
    for (int a = 0; a < 2; ++a)
#pragma unroll
        for (int b = 0; b < 2; ++b)
#pragma unroll
            for (int m = 0; m < 4; ++m)
#pragma unroll
                for (int n = 0; n < 2; ++n) acc[a][b][m][n] = (f32x4){0.f, 0.f, 0.f, 0.f};
    bf16x8 At[4][2], B0[2][2], B1[2][2];
    const PG8_LAS float* biasl = (const PG8_LAS float*)(lds + BIAS_LDS + wid * 1024);
    PG8_BIAS(cur);
    const char* gA = (const char*)g.A; const char* cB = (const char*)g.Bt + (size_t)cur.pn * tstep;
    const PG8_LAS int* rowsl = (const PG8_LAS int*)(lds + ROWS_LDS);
#define PG8_ROWDMA(pm_) __builtin_amdgcn_global_load_lds((const unsigned*)(rowmap + (pm_) * BM + 4 * lane), (PG8_LAS unsigned*)(lds + ROWS_LDS), 16, 0, 0)
#define PG8_ROWS(v0_, v1_) do { _Pragma("unroll") for (int _i = 0; _i < 2; ++_i) { v0_[_i] = (unsigned)(rowsl[RA[_i]] * K + CA[_i]) * 2u; v1_[_i] = (unsigned)(rowsl[HALF + RA[_i]] * K + CA[_i]) * 2u; } } while (0)
    PG8_ROWDMA(cur.pm); PG8_WAIT_V(0);
    PG8_ROWS(cv0, cv1); PG8_WAIT_L(0);
    S.a_ready(cur);
    PG8_STAGE(PG8_SB(0, 0), cB, voffB); PG8_STAGE(PG8_SB(0, 1), cB + hstep, voffB); PG8_STAGE(PG8_SA(0, 0), gA, cv0); PG8_STAGE(PG8_SA(0, 1), gA, cv1);
    if (wr == 1) PG8_BAR;
    PG8_WAIT_V(2); PG8_BAR;
    PG8_STAGE(PG8_SB(1, 0), cB + kstep, voffB); PG8_STAGE(PG8_SA(1, 0), gA + kstep, cv0); PG8_STAGE(PG8_SB(1, 1), cB + hstep + kstep, voffB); PG8_STAGE(PG8_SA(1, 1), gA + kstep, cv1);
    PG8_WAIT_V(8); PG8_BAR;
    for (;;) {
        const bool has_next = S.next(ui + 1, nxt);
        const char* nB = has_next ? (const char*)g.Bt + (size_t)nxt.pn * tstep : cB;
        PG8_ROWDMA(has_next ? nxt.pm : cur.pm);
        unsigned w0[2] = {cv0[0], cv0[1]}, w1[2] = {cv1[0], cv1[1]};
        for (int t = 0; t < nt; t += 2) {
            const bool last = (t == nt - 2);
            const bool aft = (t == 0) && (ui > 0);
            const char* a1 = gA + (size_t)(t + 1) * kstep;
            const char* a2 = last ? gA : gA + (size_t)(t + 2) * kstep; const char* b2 = last ? nB : cB + (size_t)(t + 2) * kstep;
            const char* a3 = a2 + kstep; const char* b3 = b2 + kstep;
            if (last && has_next) S.a_ready(nxt);
            PG8_LDB(B0, 0, 0); PG8_LDB(B1, 0, 1); PG8_SCHED; PG8_LDA(At, 0, 0); if (t > 0) PG8_STAGE(PG8_SA(1, 1), a1, cv1);
            PG8_WAIT_VX(aft); PG8_WAIT_L(0); PG8_BAR; PG8_MMA(0, 0, At, B0); PG8_MMA(0, 1, At, B1); PG8_BAR; PG8_SCHED;
            PG8_LDA(At, 0, 1); PG8_STAGE(PG8_SB(0, 0), b2, voffB); PG8_STAGE(PG8_SB(0, 1), b2 + hstep, voffB); PG8_STAGE(PG8_SA(0, 0), a2, w0);
            PG8_WAIT_VX(aft); PG8_WAIT_L(0); PG8_BAR; PG8_MMA(1, 0, At, B0); PG8_MMA(1, 1, At, B1); PG8_BAR; PG8_SCHED;
            PG8_LDB(B0, 1, 0); PG8_LDB(B1, 1, 1); PG8_SCHED; PG8_LDA(At, 1, 0); PG8_STAGE(PG8_SA(0, 1), a2, w1);
            PG8_WAIT_VX(aft); PG8_WAIT_L(0); PG8_BAR; PG8_MMA(0, 0, At, B0); PG8_MMA(0, 1, At, B1); PG8_BAR; PG8_SCHED;
            PG8_LDA(At, 1, 1); PG8_STAGE(PG8_SB(1, 0), b3, voffB); PG8_STAGE(PG8_SB(1, 1), b3 + hstep, voffB); PG8_STAGE(PG8_SA(1, 0), a3, w0);
            PG8_WAIT_V(8); PG8_WAIT_L(0); PG8_BAR; PG8_MMA(1, 0, At, B0); PG8_MMA(1, 1, At, B1); PG8_BAR; PG8_SCHED;
            if (t + 4 == nt) { PG8_ROWS(w0, w1); }
        }
        if (has_next) { PG8_STAGE(PG8_SA(1, 1), gA + kstep, w1); }
        asm volatile("" ::: "memory"); PG8_SCHED;
        if constexpr (SCW != 0) asm volatile("s_nop 15\n\ts_nop 15" ::: "memory");
        if constexpr (ALIGN_EPI) { if (wr == 0) PG8_BAR; }
        E(acc, cur, wr, wc, fr, fq, biasl); S.done(cur);
        if (!has_next) break;
#pragma unroll
            for (int a = 0; a < 2; ++a)
#pragma unroll
            for (int b = 0; b < 2; ++b)
#pragma unroll
                for (int m = 0; m < 4; ++m)
#pragma unroll
                    for (int n = 0; n < 2; ++n) acc[a][b][m][n] = (f32x4){0.f, 0.f, 0.f, 0.f};
        cur = nxt; cB = nB; ++ui; cv0[0] = w0[0]; cv0[1] = w0[1]; cv1[0] = w1[0]; cv1[1] = w1[1];
        asm volatile("s_waitcnt lgkmcnt(0)" ::: "memory");
        PG8_BIAS(cur);
        if constexpr (ALIGN_EPI) { if (wr == 1) PG8_BAR; }
    }
    PG8_WAIT_V(0);
    if constexpr (!ALIGN_EPI) { if (wr == 0) PG8_BAR; }
    PG8_BAR;
#undef PG8_ROWS
#undef PG8_ROWDMA
#undef PG8_SA
#undef PG8_SB
#undef PG8_STAGE
#undef PG8_LDA
#undef PG8_LDB
#undef PG8_MMA
#undef PG8_WAIT_V
#undef PG8_WAIT_VX
#undef PG8_WAIT_L
#undef PG8_BAR
#undef PG8_SCHED
#undef PG8_BIAS
}
}

#ifndef REP_MASK
#define REP_MASK 0
#endif
#define NREP(k) (1 + ((REP_MASK >> (k)) & 1))

constexpr int NB = 16, SEQ = 2048, D = 1024, NMETA = 16;
constexpr int MX = NB * SEQ;
constexpr int INW = 3344, PW = 3584;
constexpr int GQ = 0, GK = 256, GV = 512, GG = 1024, GKL = 1536;
constexpr int RW0 = 1552;
constexpr int RR = RW0, RK = RW0 + 512, RV = RW0 + 1024, RWL = RW0 + 1536, RAL = RW0 + 1600, RGL = RW0 + 1664;
constexpr int NE = 32, TOPK = 4;
constexpr int NCH = 33;
constexpr float ALPHA = 1.189207115002721f;
constexpr int NWAVES = 8, NTHR = 512;

constexpr size_t MiB = 1u << 20;
constexpr size_t WS_CTL = 0, CTL_ZERO_BYTES = 1 * MiB;
constexpr size_t WS_STATS = 1 * MiB;
constexpr size_t WS_TOPI  = WS_STATS + 256 * 1024;
constexpr size_t WS_GATE  = WS_TOPI + 512 * 1024;
constexpr size_t WS_RANK  = WS_GATE + 512 * 1024;
constexpr size_t WS_TSLOT = WS_RANK + 512 * 1024;
constexpr size_t WS_BON   = WS_TSLOT + 512 * 1024;
constexpr size_t WS_BCNT  = WS_BON;
constexpr size_t WS_PROJM = WS_BON + 1 * MiB;
constexpr size_t WS_OPSM  = WS_PROJM + 256 * 1024;
constexpr size_t WS_DL    = WS_OPSM + 256 * 1024;
constexpr size_t WS_W2T   = WS_DL + 1 * MiB;
constexpr size_t WS_A2T   = WS_W2T + 64 * 1024;
constexpr size_t WS_G2T   = WS_A2T + 64 * 1024;
constexpr size_t WS_RWH   = WS_G2T + 128 * 1024;
constexpr size_t WS_RWL   = WS_RWH + 64 * 1024;
constexpr size_t WS_TILEE = WS_RWL + 64 * 1024;
constexpr size_t WS_SLOTTOK = WS_TILEE + 4096;
constexpr size_t WS_WIN   = 8 * MiB;
constexpr size_t WS_WOUT  = 15 * MiB;
static_assert(WS_SLOTTOK + 139264 * 4 <= WS_WIN, "table region");
constexpr size_t WS_A0    = 20 * MiB;
constexpr size_t WS_YMIX  = 560 * MiB;
constexpr size_t WS_PROJ  = 84 * MiB;
constexpr size_t WS_R1    = 308 * MiB;
constexpr size_t WS_GAM   = 520 * MiB;
constexpr size_t WS_SST   = 524 * MiB;
constexpr size_t WS_GUS   = 692 * MiB;
constexpr size_t WS_H1    = WS_A0;
constexpr size_t WS_XS    = 84 * MiB;
constexpr size_t WS_YS    = WS_XS;
constexpr size_t WS_ACT   = 356 * MiB;
constexpr size_t WS_MIXB  = 628 * MiB;
constexpr size_t WS_WUP   = 758 * MiB;
constexpr size_t WS_WDN   = 822 * MiB;
constexpr size_t WS_H1Q   = 854 * MiB;
constexpr size_t WS_END   = 886 * MiB;
constexpr int CW_BAR = 4096;
constexpr int CW_CNT = 16384;
constexpr int CW_QH = 20480;

constexpr int RING_BYTES = 131072;
constexpr int LDS_BYTES = 147456;
constexpr int TAB_OFF = 132096;
constexpr int MISC_OFF = LDS_BYTES - 512;

#define LAS __attribute__((address_space(3)))
typedef unsigned short bf16;
typedef unsigned v4u __attribute__((ext_vector_type(4)));
typedef unsigned v2u __attribute__((ext_vector_type(2)));
typedef float f32x4 __attribute__((ext_vector_type(4)));
typedef short bf16x8 __attribute__((ext_vector_type(8)));
typedef int i32x4g __attribute__((ext_vector_type(4)));
#define LDS_WAIT() asm volatile("s_waitcnt lgkmcnt(0)" ::: "memory")
__device__ __forceinline__ float bflo(unsigned w) { return __uint_as_float(w << 16); }
__device__ __forceinline__ float bfhi(unsigned w) { return __uint_as_float(w & 0xffff0000u); }
typedef float f32x2_t __attribute__((ext_vector_type(2))); typedef __bf16 bf16x2_t __attribute__((ext_vector_type(2)));
__device__ __forceinline__ unsigned pk2(float lo, float hi) { const f32x2_t v = {lo, hi}; const bf16x2_t b = __builtin_convertvector(v, bf16x2_t); return __builtin_bit_cast(unsigned, b); }
__device__ __forceinline__ unsigned f2bf(float f) { return pk2(f, 0.f) & 0xffffu; }
#define CYC() ((unsigned)__builtin_amdgcn_s_getreg((19 << 11) | 29))
__device__ __forceinline__ void lds_barrier() { asm volatile("s_waitcnt lgkmcnt(0)" ::: "memory"); __builtin_amdgcn_s_barrier(); asm volatile("" ::: "memory"); }
__device__ __forceinline__ float shx(float v, int mask, int lane) { return __int_as_float(__builtin_amdgcn_ds_bpermute((lane ^ mask) << 2, __float_as_int(v))); }
template <int CTRL> __device__ __forceinline__ float dppf0(float x) { return __int_as_float(__builtin_amdgcn_update_dpp(0, __float_as_int(x), CTRL, 0xF, 0xF, true)); }
__device__ __forceinline__ float wave_sum(float v, int lane) {
    v += dppf0<0xB1>(v); v += dppf0<0x4E>(v); v += dppf0<0x141>(v); v += dppf0<0x140>(v);
    v += shx(v, 16, lane); v += shx(v, 32, lane);
    return v;
}
__device__ __forceinline__ float softplus_f(float x) { return fmaxf(x, 0.f) + log1pf(expf(-fabsf(x))); }
__device__ __forceinline__ float logsigmoid_f(float x) { return fminf(x, 0.f) - log1pf(expf(-fabsf(x))); }
__device__ __forceinline__ float sigmoid_f(float x) { return 1.f / (1.f + expf(-x)); }
__device__ __forceinline__ float fexp(float x) { return __builtin_amdgcn_exp2f(x * 1.4426950408889634f); }
__device__ __forceinline__ float flog(float x) { return __builtin_amdgcn_logf(x) * 0.6931471805599453f; }
__device__ __forceinline__ float fsigmoid(float x) { return __builtin_amdgcn_rcpf(1.f + fexp(-x)); }
__device__ __forceinline__ float ftanh(float x) { return 2.f * fsigmoid(2.f * x) - 1.f; }
__device__ __forceinline__ float fsoftplus(float x) { return fmaxf(x, 0.f) + flog(1.f + fexp(-fabsf(x))); }
__device__ __forceinline__ float flogsigmoid(float x) { return fminf(x, 0.f) - flog(1.f + fexp(-fabsf(x))); }
template <int CTRL> __device__ __forceinline__ float dppf(float x) { return __int_as_float(__builtin_amdgcn_update_dpp(0, __float_as_int(x), CTRL, 0xF, 0xF, true)); }
__device__ __forceinline__ float red8(float x) {
    x += dppf<0xB1>(x); x += dppf<0x4E>(x); x += dppf<0x141>(x); return x;
}
__device__ __forceinline__ f32x4 mfma16(bf16x8 a, bf16x8 b, f32x4 c) { return __builtin_amdgcn_mfma_f32_16x16x32_bf16(a, b, c, 0, 0, 0); }
__device__ __forceinline__ unsigned ld_agent(const unsigned* p) { return __hip_atomic_load(p, __ATOMIC_RELAXED, __HIP_MEMORY_SCOPE_AGENT); }

#define XB_TMO      128
#define XB_XCNT(j)  (256  + 64 * (j))
#define XB_XSUB(j)  (1280 + 64 * (j))
#define XB_XGEN(j)  (2304 + 64 * (j))
#define XB_TOP      3328
#define XB_TOPGEN   3392
#define XCD_BAR_WORDS 3456
#define XB_SPIN_CAP (1u << 18)
__device__ __forceinline__ unsigned xb_ld(unsigned* p)              { return __hip_atomic_load(p, __ATOMIC_RELAXED, __HIP_MEMORY_SCOPE_AGENT); }
__device__ __forceinline__ unsigned xb_add(unsigned* p, unsigned v) { return __hip_atomic_fetch_add(p, v, __ATOMIC_RELAXED, __HIP_MEMORY_SCOPE_AGENT); }
__device__ __forceinline__ unsigned xb_xcc_id() { return (unsigned)__builtin_amdgcn_s_getreg((3 << 11) | 20) & 0xFu; }
#define XB_SPIN(cond, bar) do { unsigned _sp = 0; while (cond) { __builtin_amdgcn_s_sleep(1); \
    if ((++_sp & 255u) == 0u) { if (xb_ld(&(bar)[XB_TMO])) break; if (_sp > XB_SPIN_CAP) { atomicAdd(&(bar)[XB_TMO], 1u); break; } } } } while (0)
struct XcdBarrier { unsigned* bar; unsigned x; volatile LAS unsigned* st; };
__device__ __forceinline__ XcdBarrier xcd_barrier_post(unsigned* bar, volatile LAS unsigned* st, bool leader) {
    XcdBarrier b; b.bar = bar; b.x = xb_xcc_id(); b.st = st;
    if (leader) (void)xb_add(&bar[XB_XCNT(b.x)], 1u);
    return b;
}
__device__ __forceinline__ void xcd_barrier_complete(unsigned* bar, unsigned x, unsigned& nloc, unsigned& nx) {
    const unsigned G = gridDim.x * gridDim.y * gridDim.z;
    unsigned sum, cnt, mine, sp = 0u;
    for (;;) {
        sum = 0u; cnt = 0u; mine = 0u;
#pragma unroll
        for (unsigned j = 0; j < 16; ++j) { const unsigned c = xb_ld(&bar[XB_XCNT(j)]); sum += c; cnt += (c > 0u) ? 1u : 0u; mine = (j == x) ? c : mine; }
        if (sum == G) break;
        __builtin_amdgcn_s_sleep(1);
        if ((++sp & 255u) == 0u) { if (xb_ld(&bar[XB_TMO])) break; if (sp > XB_SPIN_CAP) { atomicAdd(&bar[XB_TMO], 1u); break; } }
    }
    nloc = mine > 0u ? mine : 1u; nx = cnt > 0u ? cnt : 1u;
}
__device__ __forceinline__ void xcd_barrier(const XcdBarrier& b, bool leader) {
    asm volatile("s_waitcnt vmcnt(0)" ::: "memory");
    __syncthreads();
    if (leader) {
        unsigned* bar = b.bar;
        __builtin_amdgcn_s_waitcnt(0);
        unsigned nloc = b.st[0], nx = b.st[1];
        if (nloc == 0u) { xcd_barrier_complete(bar, b.x, nloc, nx); b.st[0] = nloc; b.st[1] = nx; }
        const unsigned old = xb_add(&bar[XB_XSUB(b.x)], 1u);
        const unsigned gen = old / nloc;
        if (old + 1u == (gen + 1u) * nloc) {
            __builtin_amdgcn_fence(__ATOMIC_RELEASE, "agent");
            asm volatile("s_waitcnt vmcnt(0)" ::: "memory");
            const unsigned og = xb_add(&bar[XB_TOP], 1u);
            const unsigned tg = og / nx;
            if (og + 1u == (tg + 1u) * nx) xb_add(&bar[XB_TOPGEN], 1u);
            else XB_SPIN(xb_ld(&bar[XB_TOPGEN]) == tg, bar);
            __builtin_amdgcn_fence(__ATOMIC_ACQUIRE, "agent");
            xb_add(&bar[XB_XGEN(b.x)], 1u);
            asm volatile("s_waitcnt vmcnt(0)" ::: "memory");
        } else {
            XB_SPIN(xb_ld(&bar[XB_XGEN(b.x)]) == gen, bar);
            __builtin_amdgcn_fence(__ATOMIC_ACQUIRE, "agent");
            asm volatile("s_waitcnt vmcnt(0)" ::: "memory");
        }
    }
    __syncthreads();
}

struct Args { const float* in[30]; float* out; unsigned char* ws; };
enum { I_X = 0, I_META, I_LNIN_G, I_LNIN_B, I_WIN, I_GKW2, I_GKB, I_GNORM, I_MU, I_W0, I_W2, I_A0, I_A2, I_G2, I_KK, I_KA, I_RK, I_RLNG, I_RLNB, I_WOUT,
       I_LN1G, I_LN1B, I_RTW, I_RTB, I_WUP, I_BUP, I_WDN, I_BDN, I_LN2G, I_LN2B };
struct Frame { LAS unsigned char* lds; int tid, lane, wave, blk, G; };
__device__ __forceinline__ int lane_id() { int l; asm volatile("v_mbcnt_lo_u32_b32 %0, -1, 0\n\tv_mbcnt_hi_u32_b32 %0, -1, %0" : "=v"(l)); return l; }
__device__ __forceinline__ Frame mkframe(LAS unsigned char* lds, int wave) { Frame F; F.lds = lds; F.wave = wave; F.lane = lane_id(); F.tid = wave * 64 + F.lane; F.blk = blockIdx.x; F.G = gridDim.x; return F; }

__device__ __forceinline__ void transpose_item(const float* W, int K, int N, int nblk, bf16* WT, LAS float* scr, int item, int lane) {
    const int kb = item / nblk, nb = item - kb * nblk, k0 = 64 * kb, n0 = 32 * nb;
    const int nn = n0 + (lane & 31); const bool ok = nn < N;
#pragma unroll 8
    for (int i = 0; i < 32; ++i) { const int kk = 2 * i + (lane >> 5); scr[kk * 33 + (lane & 31)] = ok ? W[(size_t)(k0 + kk) * N + nn] : 0.f; }
    LDS_WAIT();
    const int c = lane & 7;
#pragma unroll
    for (int j = 0; j < 4; ++j) { const int n = (lane >> 3) + 8 * j; const LAS float* s = scr + (8 * c) * 33 + n;
        v4u o; o.x = pk2(s[0 * 33], s[1 * 33]); o.y = pk2(s[2 * 33], s[3 * 33]); o.z = pk2(s[4 * 33], s[5 * 33]); o.w = pk2(s[6 * 33], s[7 * 33]);
        *(v4u*)(WT + (size_t)(n0 + n) * K + k0 + 8 * c) = o; }
    LDS_WAIT();
}

constexpr int CV_UP = 16 * 32, CV_DN = 16 * 16, CV_NIT = NE * (CV_UP + CV_DN);
__device__ __forceinline__ void cv_load(const Args& a, int it, int lane, f32x4 (&v)[16]) {
    const bool up = it < NE * CV_UP; const int it2 = up ? it : it - NE * CV_UP, per = up ? CV_UP : CV_DN, e = it2 / per, r = it2 - e * per;
    const int N = up ? 2048 : D, nblk = N >> 6, kb = r / nblk, nb = r - kb * nblk;
    const float* W = (up ? a.in[I_WUP] : a.in[I_WDN]) + (size_t)e * D * N + (size_t)(64 * kb + (lane >> 4)) * N + 64 * nb + 4 * (lane & 15);
#pragma unroll
    for (int i = 0; i < 16; ++i) v[i] = *(const f32x4*)(W + (size_t)(4 * i) * N);
}
__device__ __forceinline__ void cv_store(const Args& a, int it, int lane, const f32x4 (&v)[16], LAS float* scr) {
    const bool up = it < NE * CV_UP; const int it2 = up ? it : it - NE * CV_UP, per = up ? CV_UP : CV_DN, e = it2 / per, r = it2 - e * per;
    const int N = up ? 2048 : D, nblk = N >> 6, kb = r / nblk, nb = r - kb * nblk;
    const float scale = up ? 64.f : 128.f;
    const int r4 = lane >> 4, c4 = lane & 15;
#pragma unroll
    for (int i = 0; i < 16; ++i) *(LAS f32x4*)(scr + (4 * i + r4) * 68 + 4 * c4) = v[i];
    LDS_WAIT();
    unsigned char* orow = a.ws + (up ? WS_WUP : WS_WDN) + (size_t)e * N * D + (size_t)(64 * nb + lane) * D + 64 * kb;
#pragma unroll
    for (int g = 0; g < 4; ++g) { const LAS float* s = scr + (16 * g) * 68 + lane; v4u o;
#pragma unroll
        for (int q = 0; q < 4; ++q) { int w = __builtin_amdgcn_cvt_pk_fp8_f32(s[(4 * q + 0) * 68] * scale, s[(4 * q + 1) * 68] * scale, 0, false);
            w = __builtin_amdgcn_cvt_pk_fp8_f32(s[(4 * q + 2) * 68] * scale, s[(4 * q + 3) * 68] * scale, w, true); o[q] = (unsigned)w; }
        *(v4u*)(orow + 16 * g) = o; }
    LDS_WAIT();
}
__device__ __forceinline__ void convert_expert_weights(const Args& a, const Frame& F, int qsel) {
    LAS float* scr = (LAS float*)(F.lds + F.wave * 17408);
    unsigned* QH = (unsigned*)(a.ws + WS_CTL) + CW_QH + 64 * qsel;
    unsigned base = 0;
    if (F.lane == 0) base = __hip_atomic_fetch_add(QH, 4u, __ATOMIC_RELAXED, __HIP_MEMORY_SCOPE_AGENT);
    base = (unsigned)__builtin_amdgcn_readfirstlane((int)base);
    if (base >= (unsigned)CV_NIT) return;
    f32x4 va[16], vb[16];
    cv_load(a, (int)base, F.lane, va);
    for (;;) {
        unsigned nbase = 0;
        if (F.lane == 0) nbase = __hip_atomic_fetch_add(QH, 4u, __ATOMIC_RELAXED, __HIP_MEMORY_SCOPE_AGENT);
        nbase = (unsigned)__builtin_amdgcn_readfirstlane((int)nbase);
        const bool more = nbase < (unsigned)CV_NIT;
        cv_load(a, (int)base + 1, F.lane, vb); cv_store(a, (int)base, F.lane, va, scr);
        cv_load(a, (int)base + 2, F.lane, va); cv_store(a, (int)base + 1, F.lane, vb, scr);
        cv_load(a, (int)base + 3, F.lane, vb); cv_store(a, (int)base + 2, F.lane, va, scr);
        if (more) cv_load(a, (int)nbase, F.lane, va);
        cv_store(a, (int)base + 3, F.lane, vb, scr);
        if (!more) break;
        base = nbase;
    }
}

__device__ __forceinline__ void phase0(const Args& a, const Frame& F) {
    unsigned char* ws = a.ws;
    const int gw = F.blk * NWAVES + F.wave, NGW = F.G * NWAVES;
    for (int cgp = F.blk; cgp < 53; cgp += F.G) {
        LAS float* HM = (LAS float*)F.lds;
        LAS float* PART = (LAS float*)(F.lds + 65536);
        for (int rr = 0; rr < 2; ++rr) {
            const int row = 2 * F.wave + rr; const f32x4* xr = (const f32x4*)(a.in[I_META] + row * D) + F.lane;
            f32x4 v[4]; float s = 0.f;
#pragma unroll
            for (int j = 0; j < 4; ++j) { v[j] = xr[64 * j]; s += (v[j].x + v[j].y) + (v[j].z + v[j].w); }
            const float mean = wave_sum(s, F.lane) * (1.f / D); float s2 = 0.f;
#pragma unroll
            for (int j = 0; j < 4; ++j) { v[j] = v[j] - mean; s2 += (v[j].x * v[j].x + v[j].y * v[j].y) + (v[j].z * v[j].z + v[j].w * v[j].w); }
            const float rstd = 1.f / sqrtf(wave_sum(s2, F.lane) * (1.f / D) + 1e-5f);
#pragma unroll
            for (int j = 0; j < 4; ++j) { const int col = 4 * (F.lane + 64 * j);
                const f32x4 gv = *(const f32x4*)(a.in[I_LNIN_G] + col), bv = *(const f32x4*)(a.in[I_LNIN_B] + col);
                const f32x4 y = v[j] * rstd * gv + bv;
                HM[(col + 0) * 16 + row] = y.x; HM[(col + 1) * 16 + row] = y.y; HM[(col + 2) * 16 + row] = y.z; HM[(col + 3) * 16 + row] = y.w; }
        }
        __syncthreads();
        const int col = cgp * 64 + F.lane; const bool ok = col < INW;
        float acc[16];
#pragma unroll
        for (int r = 0; r < 16; ++r) acc[r] = 0.f;
        const float* wp = a.in[I_WIN];
        for (int k = F.wave * 128; k < F.wave * 128 + 128; ++k) {
            const float wv = ok ? wp[(size_t)k * INW + col] : 0.f;
            const LAS f32x4* h = (const LAS f32x4*)(HM + k * 16);
#pragma unroll
            for (int q = 0; q < 4; ++q) { const f32x4 hv = h[q]; acc[4 * q + 0] += hv.x * wv; acc[4 * q + 1] += hv.y * wv; acc[4 * q + 2] += hv.z * wv; acc[4 * q + 3] += hv.w * wv; }
        }
#pragma unroll
        for (int r = 0; r < 16; ++r) PART[(F.wave * 16 + r) * 64 + F.lane] = acc[r];
        __syncthreads();
        bf16* PROJM = (bf16*)(ws + WS_PROJM);
        for (int o = F.tid; o < 1024; o += NTHR) { const int r = o >> 6, l = o & 63; float s = 0.f;
#pragma unroll
            for (int w = 0; w < 8; ++w) s += PART[(w * 16 + r) * 64 + l];
            PROJM[r * PW + cgp * 64 + l] = (bf16)f2bf(s); }
        if (F.tid < 64) PROJM[NMETA * PW + cgp * 64 + F.tid] = 0;
        __syncthreads();
    }
    {
        LAS float* scr = (LAS float*)(F.lds + F.wave * 16384);
        constexpr int I_IN = 16 * (PW / 32), I_OUT = 16 * 32;
        for (int it = gw; it < I_IN + I_OUT; it += NGW) {
            if (it < I_IN) transpose_item(a.in[I_WIN], D, INW, PW / 32, (bf16*)(ws + WS_WIN), scr, it, F.lane);
            else transpose_item(a.in[I_WOUT], D, D, 32, (bf16*)(ws + WS_WOUT), scr, it - I_IN, F.lane);
        }
    }
    {
        bf16* W2T = (bf16*)(ws + WS_W2T); bf16* A2T = (bf16*)(ws + WS_A2T); bf16* G2T = (bf16*)(ws + WS_G2T);
        for (int i = F.blk * NTHR + F.tid; i < 131072; i += F.G * NTHR) {
            if (i < 32768) { const int n = i >> 6, k = i & 63; W2T[i] = (bf16)f2bf(a.in[I_W2][k * 512 + n]); }
            else if (i < 65536) { const int j = i - 32768, n = j >> 6, k = j & 63; A2T[j] = (bf16)f2bf(a.in[I_A2][k * 512 + n]); }
            else { const int j = i - 65536, n = j >> 7, k = j & 127; G2T[j] = (bf16)f2bf(a.in[I_G2][k * 512 + n]); }
        }
    }
    {
        bf16* RWH = (bf16*)(ws + WS_RWH); bf16* RWL = (bf16*)(ws + WS_RWL);
        for (int i = F.blk * NTHR + F.tid; i < D * NE; i += F.G * NTHR) { const int c = i >> 5, e = i & 31; const float w = a.in[I_RTW][i];
            const unsigned hi = f2bf(w); const float lo = w - __uint_as_float(hi << 16);
            RWH[e * D + c] = (bf16)hi; RWL[e * D + c] = (bf16)f2bf(lo); }
    }
    {
        bf16* A0 = (bf16*)(ws + WS_A0);
        for (int m0 = gw; m0 < MX; m0 += 2 * NGW) {
            f32x4 v[2][4];
#pragma unroll
            for (int r = 0; r < 2; ++r) { const f32x4* xr = (const f32x4*)(a.in[I_X] + (size_t)(m0 + r * NGW) * D) + F.lane;
#pragma unroll
                for (int j = 0; j < 4; ++j) v[r][j] = xr[64 * j]; }
#pragma unroll
            for (int r = 0; r < 2; ++r) { const int m = m0 + r * NGW; float s = 0.f;
#pragma unroll
                for (int j = 0; j < 4; ++j) s += (v[r][j].x + v[r][j].y) + (v[r][j].z + v[r][j].w);
                const float mean = wave_sum(s, F.lane) * (1.f / D); float s2 = 0.f;
#pragma unroll
                for (int j = 0; j < 4; ++j) { v[r][j] = v[r][j] - mean; s2 += (v[r][j].x * v[r][j].x + v[r][j].y * v[r][j].y) + (v[r][j].z * v[r][j].z + v[r][j].w * v[r][j].w); }
                const float rstd = __builtin_amdgcn_rsqf(wave_sum(s2, F.lane) * (1.f / D) + 1e-5f);
#pragma unroll
                for (int j = 0; j < 4; ++j) { const int col = 4 * (F.lane + 64 * j);
                    const f32x4 gv = *(const f32x4*)(a.in[I_LNIN_G] + col), bv = *(const f32x4*)(a.in[I_LNIN_B] + col);
                    const f32x4 y = v[r][j] * rstd * gv + bv;
                    v2u o; o.x = pk2(y.x, y.y); o.y = pk2(y.z, y.w);
                    *(v2u*)(A0 + (size_t)m * D + col) = o; }
                }
        }
    }
    __syncthreads();
    for (int rep_ = 0; rep_ < NREP(14); ++rep_) convert_expert_weights(a, F, rep_);
}

__device__ __forceinline__ const bf16* prow(const bf16* PROJ, const bf16* PROJM, int b, int vp) {
    const bf16* px = PROJ + (size_t)(b * SEQ + (vp >= NMETA ? vp - NMETA : 0)) * PW;
    const bf16* pm = PROJM + (size_t)(vp < 0 ? NMETA : (vp < NMETA ? vp : 0)) * PW;
    return vp >= NMETA ? px : pm;
}
__device__ __forceinline__ f32x4 ldp4(const bf16* PROJ, const bf16* PROJM, int b, int vp, int col) {
    const v2u w = *(const v2u*)(prow(PROJ, PROJM, b, vp) + col);
    return (f32x4){bflo(w.x), bfhi(w.x), bflo(w.y), bfhi(w.y)};
}

constexpr int R1_STRIDE = 49152;
constexpr int TP = 80;
constexpr int L1_SLOT = 64 * TP * 2;
constexpr int L1_LC = 12 * L1_SLOT;
constexpr int L1_XCH = L1_LC + 64 * 65 * 4;
constexpr int L1_LR = 8 * L1_SLOT;
__device__ __forceinline__ v2u pack4(f32x4 v) { v2u o; o.x = pk2(v[0], v[1]); o.y = pk2(v[2], v[3]); return o; }
__device__ __forceinline__ f32x4 tile_mm(const LAS bf16* A, const LAS bf16* Bt, int rt, int ct, int fr, int fq, f32x4 acc) {
#pragma unroll
    for (int ks = 0; ks < 2; ++ks)
        acc = mfma16(*(const LAS bf16x8*)(Bt + (ct * 16 + fr) * TP + ks * 32 + 8 * fq), *(const LAS bf16x8*)(A + (rt * 16 + fr) * TP + ks * 32 + 8 * fq), acc);
    return acc;
}
__device__ __forceinline__ void tile_st(LAS bf16* O, int rt, int ct, int fr, int fq, f32x4 v) { *(LAS v2u*)(O + (rt * 16 + fr) * TP + ct * 16 + 4 * fq) = pack4(v); }
#define L1S(n) ((LAS bf16*)(F.lds + (n) * L1_SLOT))

struct L1Pf { v4u sa[5]; v2u r[2][2], k[2][2], v[2][2]; };
__device__ __forceinline__ void l1_fetch(const Args& a, const Frame& F, int b, int h, int c, L1Pf& pf, bool need_sa) {
    const bf16* PROJ = (const bf16*)(a.ws + WS_PROJ); const bf16* PROJM = (const bf16*)(a.ws + WS_PROJM);
    const int vp0 = (c == 0) ? -48 : NMETA + 64 * (c - 1);
    if (need_sa) { const int cg = F.tid & 31, tr = F.tid >> 5;
#pragma unroll
      for (int i = 0; i < 5; ++i) pf.sa[i] = *(const v4u*)(prow(PROJ, PROJM, b, vp0 + 4 * tr - 1 + i) + RWL + 8 * cg); }
    { const int rt = F.wave & 3, cp = F.wave >> 2, fr = F.lane & 15, fq = F.lane >> 4, vp = vp0 + rt * 16 + fr;
      const bf16* p0 = prow(PROJ, PROJM, b, vp - 1); const bf16* p1 = prow(PROJ, PROJM, b, vp);
#pragma unroll
      for (int cc = 0; cc < 2; ++cc) { const int jc = h * 64 + (2 * cp + cc) * 16 + 4 * fq;
          pf.r[cc][0] = *(const v2u*)(p0 + RR + jc); pf.r[cc][1] = *(const v2u*)(p1 + RR + jc);
          pf.k[cc][0] = *(const v2u*)(p0 + RK + jc); pf.k[cc][1] = *(const v2u*)(p1 + RK + jc);
          pf.v[cc][0] = *(const v2u*)(p0 + RV + jc); pf.v[cc][1] = *(const v2u*)(p1 + RV + jc); } }
}
__device__ __forceinline__ f32x4 unpk4(v2u w) { return (f32x4){bflo(w.x), bfhi(w.x), bflo(w.y), bfhi(w.y)}; }

__device__ __forceinline__ void rwkv_l1_front(const Args& a, const Frame& F, int b, int h, int c, const L1Pf& pf, f32x4 (&rtil)[2], bool newgrp, bf16x8 (&lrf)[8]) {
    unsigned char* ws = a.ws;
    const bf16* W2T = (const bf16*)(ws + WS_W2T); const bf16* A2T = (const bf16*)(ws + WS_A2T); const bf16* G2T = (const bf16*)(ws + WS_G2T);
    const int unit = (b * 8 + h) * NCH + c;
    unsigned char* r1 = ws + WS_R1 + (size_t)unit * R1_STRIDE;
    float* GAM = (float*)(ws + WS_GAM) + (size_t)unit * 64;
    const float* mu = a.in[I_MU];
    const int vp0 = (c == 0) ? -48 : NMETA + 64 * (c - 1);
    constexpr int LRP = 264;
    LAS bf16* LR = (LAS bf16*)(F.lds + L1_LR);
    LAS float* LC = (LAS float*)(F.lds + L1_LC);
    LAS float* XCH = (LAS float*)(F.lds + L1_XCH);
    const int rt = F.wave & 3, cp = F.wave >> 2, fr = F.lane & 15, fq = F.lane >> 4;
    if (newgrp) {
        const int cg = F.tid & 31, tr = F.tid >> 5;
        const f32x4 m0 = *(const f32x4*)(mu + 1536 + 8 * cg), m1 = *(const f32x4*)(mu + 1536 + 8 * cg + 4);
#pragma unroll
        for (int i = 0; i < 4; ++i) {
            const int row = 4 * tr + i;
            const v4u cw = pf.sa[i + 1], pw = pf.sa[i];
            const f32x4 c0 = unpk4((v2u){cw.x, cw.y}), c1 = unpk4((v2u){cw.z, cw.w}), p0 = unpk4((v2u){pw.x, pw.y}), p1 = unpk4((v2u){pw.z, pw.w});
            float v[8];
            v[0] = c0.x + (p0.x - c0.x) * m0.x; v[1] = c0.y + (p0.y - c0.y) * m0.y; v[2] = c0.z + (p0.z - c0.z) * m0.z; v[3] = c0.w + (p0.w - c0.w) * m0.w;
            v[4] = c1.x + (p1.x - c1.x) * m1.x; v[5] = c1.y + (p1.y - c1.y) * m1.y; v[6] = c1.z + (p1.z - c1.z) * m1.z; v[7] = c1.w + (p1.w - c1.w) * m1.w;
#pragma unroll
            for (int q = 0; q < 8; ++q) { if (cg < 8) v[q] = ftanh(v[q]); else if (cg >= 16) v[q] = fsigmoid(v[q]); }
            v4u o; o.x = pk2(v[0], v[1]); o.y = pk2(v[2], v[3]); o.z = pk2(v[4], v[5]); o.w = pk2(v[6], v[7]);
            *(LAS v4u*)(LR + row * LRP + 8 * cg) = o;
        }
    }
    const int t = rt * 16 + fr, vp = vp0 + t;
    const bool valid = vp >= 0;
    if (newgrp) { lds_barrier();
        const LAS bf16* lrow = LR + t * LRP + 8 * fq;
#pragma unroll
        for (int q = 0; q < 8; ++q) lrf[q] = *(const LAS bf16x8*)(lrow + q * 32); }
    float lwv[2][4], asg[2][4], kkr[2][4], kmd[2][4], rrv[2][4], vvv[2][4];
    float ssq = 0.f, bon = 0.f;
    {
#pragma unroll
        for (int cc = 0; cc < 2; ++cc) {
            const int ct = 2 * cp + cc, j = ct * 16 + 4 * fq, jc = h * 64 + j;
            f32x4 mr[2], mk[2], mv[2], w0v[2], a0v[2], kkw[2], kaw[2], rkw[2];
            mr[cc] = *(const f32x4*)(mu + jc); mk[cc] = *(const f32x4*)(mu + 512 + jc); mv[cc] = *(const f32x4*)(mu + 1024 + jc);
            w0v[cc] = *(const f32x4*)(a.in[I_W0] + jc); a0v[cc] = *(const f32x4*)(a.in[I_A0] + jc);
            kkw[cc] = *(const f32x4*)(a.in[I_KK] + jc); kaw[cc] = *(const f32x4*)(a.in[I_KA] + jc); rkw[cc] = *(const f32x4*)(a.in[I_RK] + jc);
            f32x4 aw = {0.f, 0.f, 0.f, 0.f}, aa = aw, ag = aw;
#pragma unroll
            for (int ks = 0; ks < 2; ++ks) {
                aw = mfma16(*(const bf16x8*)(W2T + (size_t)(h * 64 + ct * 16 + fr) * 64 + ks * 32 + 8 * fq), lrf[ks], aw);
                aa = mfma16(*(const bf16x8*)(A2T + (size_t)(h * 64 + ct * 16 + fr) * 64 + ks * 32 + 8 * fq), lrf[2 + ks], aa);
            }
#pragma unroll
            for (int ks = 0; ks < 4; ++ks) ag = mfma16(*(const bf16x8*)(G2T + (size_t)(h * 64 + ct * 16 + fr) * 128 + ks * 32 + 8 * fq), lrf[4 + ks], ag);
            const f32x4 rc = unpk4(pf.r[cc][1]), rp = unpk4(pf.r[cc][0]), kc = unpk4(pf.k[cc][1]), kp = unpk4(pf.k[cc][0]), vc = unpk4(pf.v[cc][1]), vpv = unpk4(pf.v[cc][0]);
            const f32x4 rs = rc + (rp - rc) * mr[cc], ks_ = kc + (kp - kc) * mk[cc], vs = vc + (vpv - vc) * mv[cc];
#pragma unroll
            for (int i = 0; i < 4; ++i) {
                const float u = w0v[cc][i] + aw[i];
                const float wl = -fsoftplus(-u) - 0.5f;
                lwv[cc][i] = valid ? -fexp(wl) : 0.f;
                const float as_ = fsigmoid(a0v[cc][i] + aa[i]);
                asg[cc][i] = as_;
                const float kraw = ks_[i], kk = kraw * kkw[cc][i];
                kkr[cc][i] = kk; ssq += kk * kk;
                const float km = kraw * (1.f + (as_ - 1.f) * kaw[cc][i]);
                kmd[cc][i] = km; rrv[cc][i] = rs[i]; vvv[cc][i] = vs[i];
                bon += rs[i] * km * rkw[cc][i];
            }
            *(v2u*)(r1 + 4 * 8192 + (size_t)(t * 64 + j) * 2) = pack4(ag);
            __builtin_amdgcn_sched_barrier(0);
        }
#pragma unroll
        for (int cc = 0; cc < 2; ++cc)
#pragma unroll
            for (int i = 0; i < 4; ++i) LC[t * 65 + (2 * cp + cc) * 16 + 4 * fq + i] = lwv[cc][i];
        ssq += shx(ssq, 16, F.lane); ssq += shx(ssq, 32, F.lane);
        bon += shx(bon, 16, F.lane); bon += shx(bon, 32, F.lane);
        if (fq == 0) { XCH[(cp * 64 + t) * 2] = ssq; XCH[(cp * 64 + t) * 2 + 1] = bon; }
    }
    lds_barrier();
    const float ssq_t = XCH[t * 2] + XCH[(64 + t) * 2], bon_t = XCH[t * 2 + 1] + XCH[(64 + t) * 2 + 1];
    const float inv = 1.f / fmaxf(sqrtf(ssq_t), 1e-12f);
    {
        LAS float* SEG = XCH + 256;
        const int jj = F.tid & 63, sg = F.tid >> 6;
        float cv[8];
#pragma unroll
        for (int i = 0; i < 8; ++i) cv[i] = LC[(sg * 8 + i) * 65 + jj];
#pragma unroll
        for (int i = 1; i < 8; ++i) cv[i] += cv[i - 1];
        SEG[sg * 64 + jj] = cv[7];
        lds_barrier();
        float pre = 0.f;
#pragma unroll
        for (int s2 = 0; s2 < 7; ++s2) pre += (s2 < sg) ? SEG[s2 * 64 + jj] : 0.f;
#pragma unroll
        for (int i = 0; i < 8; ++i) LC[(sg * 8 + i) * 65 + jj] = cv[i] + pre;
    }
    lds_barrier();
    {
#pragma unroll
        for (int cc = 0; cc < 2; ++cc) {
            const int j = (2 * cp + cc) * 16 + 4 * fq;
            f32x4 At, Bt, Kt, Bh, Kh, bvv;
#pragma unroll
            for (int i = 0; i < 4; ++i) {
                const float Lc = LC[t * 65 + j + i], LcC = LC[63 * 65 + j + i];
                const float kn = kkr[cc][i] * inv, av = -kn, bv = kn * asg[cc][i], km = kmd[cc][i];
                const float eA = fexp(Lc - lwv[cc][i]), eR = fexp(Lc), eB = fexp(-Lc), eH = fexp(LcC - Lc);
                At[i] = av * eA; rtil[cc][i] = rrv[cc][i] * eR; Bt[i] = bv * eB; Kt[i] = km * eB; Bh[i] = bv * eH; Kh[i] = km * eH;
                bvv[i] = bon_t * vvv[cc][i];
                if (t == 63) GAM[j + i] = fexp(LcC);
            }
            *(LAS v2u*)(L1S(0) + t * TP + j) = pack4(Bt); *(LAS v2u*)(L1S(1) + t * TP + j) = pack4(Kt);
            *(LAS v2u*)(L1S(2) + t * TP + j) = pack4(At); *(LAS v2u*)(L1S(3) + t * TP + j) = pack4(rtil[cc]);
#pragma unroll
            for (int i = 0; i < 4; ++i) {
                L1S(4)[(j + i) * TP + t] = (bf16)f2bf(At[i]); L1S(5)[(j + i) * TP + t] = (bf16)f2bf(Bh[i]);
                L1S(6)[(j + i) * TP + t] = (bf16)f2bf(Kh[i]); L1S(7)[(j + i) * TP + t] = (bf16)f2bf(vvv[cc][i]);
            }
            *(v2u*)(r1 + 5 * 8192 + (size_t)(t * 64 + j) * 2) = pack4(bvv);
        }
    }
    lds_barrier();
}
__device__ __forceinline__ void rwkv_l1_back(const Args& a, const Frame& F, int b, int h, int c, const f32x4 (&rtil)[2]) {
    unsigned char* r1 = a.ws + WS_R1 + (size_t)((b * 8 + h) * NCH + c) * R1_STRIDE;
    const int rt = F.wave & 3, cp = F.wave >> 2, fr = F.lane & 15, fq = F.lane >> 4;
    f32x4 Pt[2];
    const int mrow = rt * 16 + fr;
    const f32x4 z = {0.f, 0.f, 0.f, 0.f};
    {
        f32x4 Lv[2], Nv[2], Mv[2], Bv[2], Kv[2];
#pragma unroll
        for (int cc = 0; cc < 2; ++cc) { const int ct = 2 * cp + cc;
            Lv[cc] = tile_mm(L1S(2), L1S(0), rt, ct, fr, fq, z); Nv[cc] = tile_mm(L1S(0), L1S(2), rt, ct, fr, fq, z); Mv[cc] = tile_mm(L1S(2), L1S(1), rt, ct, fr, fq, z);
            Bv[cc] = tile_mm(L1S(3), L1S(0), rt, ct, fr, fq, z); Kv[cc] = tile_mm(L1S(3), L1S(1), rt, ct, fr, fq, z); }
#pragma unroll
        for (int cc = 0; cc < 2; ++cc) { const int ct = 2 * cp + cc, n0 = ct * 16 + 4 * fq;
#pragma unroll
            for (int i = 0; i < 4; ++i) { const int n = n0 + i;
                if (!(n < mrow)) { Lv[cc][i] = 0.f; Mv[cc][i] = 0.f; } if (!(mrow < n)) Nv[cc][i] = 0.f; if (!(n <= mrow)) { Bv[cc][i] = 0.f; Kv[cc][i] = 0.f; }
                Pt[cc][i] = Lv[cc][i] + ((n == mrow) ? 1.f : 0.f); }
            tile_st(L1S(8), rt, ct, fr, fq, Lv[cc]); tile_st(L1S(9), rt, ct, fr, fq, Nv[cc]); tile_st(L1S(10), rt, ct, fr, fq, Mv[cc]);
            tile_st(L1S(11), rt, ct, fr, fq, Bv[cc]); tile_st(L1S(12), rt, ct, fr, fq, Kv[cc]); }
    }
    lds_barrier();
    f32x4 Xv[2];
#pragma unroll
    for (int st = 1; st <= 6; ++st) {
        LAS bf16* Xl = (st & 1) ? L1S(8) : L1S(0); LAS bf16* Xn = (st & 1) ? L1S(9) : L1S(1);
        LAS bf16* Yl = (st & 1) ? L1S(0) : L1S(8); LAS bf16* Yn = (st & 1) ? L1S(1) : L1S(9);
        LAS bf16* Pr = (st & 1) ? L1S(2) : L1S(3); LAS bf16* Pw = (st & 1) ? L1S(3) : L1S(2);
        f32x4 l2[2], n2[2];
#pragma unroll
        for (int cc = 0; cc < 2; ++cc) { const int ct = 2 * cp + cc;
            if (st <= 5) { l2[cc] = tile_mm(Xl, Xn, rt, ct, fr, fq, z); n2[cc] = tile_mm(Xn, Xl, rt, ct, fr, fq, z); }
            if (st >= 2) Pt[cc] = tile_mm(Pr, Xn, rt, ct, fr, fq, Pt[cc]);
            if (st == 1) Xv[cc] = tile_mm(L1S(7), L1S(10), rt, ct, fr, fq, z); }
#pragma unroll
        for (int cc = 0; cc < 2; ++cc) { const int ct = 2 * cp + cc;
            if (st <= 5) { tile_st(Yl, rt, ct, fr, fq, l2[cc]); tile_st(Yn, rt, ct, fr, fq, n2[cc]); }
            tile_st(Pw, rt, ct, fr, fq, Pt[cc]); }
        if (st == 1) { lds_barrier();
#pragma unroll
            for (int cc = 0; cc < 2; ++cc) tile_st(L1S(10), rt, 2 * cp + cc, fr, fq, Xv[cc]); }
        lds_barrier();
    }
    {
        f32x4 u[2], w[2];
#pragma unroll
        for (int cc = 0; cc < 2; ++cc) { const int ct = 2 * cp + cc; u[cc] = tile_mm(L1S(10), L1S(2), rt, ct, fr, fq, z); w[cc] = tile_mm(L1S(4), L1S(2), rt, ct, fr, fq, z); }
#pragma unroll
        for (int cc = 0; cc < 2; ++cc) { const int ct = 2 * cp + cc; tile_st(L1S(8), rt, ct, fr, fq, u[cc]); tile_st(L1S(9), rt, ct, fr, fq, w[cc]); }
    }
    lds_barrier();
    {
#pragma unroll
        for (int cc = 0; cc < 2; ++cc) { const int ct = 2 * cp + cc; const size_t eo = (size_t)(mrow * 64 + ct * 16 + 4 * fq) * 2;
            const f32x4 gp = tile_mm(L1S(5), L1S(9), rt, ct, fr, fq, z);
            const f32x4 hh = tile_mm(L1S(7), L1S(6), rt, ct, fr, fq, tile_mm(L1S(8), L1S(5), rt, ct, fr, fq, z));
            const f32x4 rh = tile_mm(L1S(11), L1S(9), rt, ct, fr, fq, rtil[cc]);
            const f32x4 yl = tile_mm(L1S(12), L1S(7), rt, ct, fr, fq, tile_mm(L1S(11), L1S(8), rt, ct, fr, fq, z));
            *(v2u*)(r1 + 0 * 8192 + eo) = pack4(gp); *(v2u*)(r1 + 1 * 8192 + eo) = pack4(hh);
            *(v2u*)(r1 + 2 * 8192 + eo) = pack4(rh); *(v2u*)(r1 + 3 * 8192 + eo) = pack4(yl); }
    }
    lds_barrier();
}

constexpr int BCP = 65;
__device__ __forceinline__ void gla_bc(const Args& a, const Frame& F, int b, int h, int vp0, int ntok) {
    const bf16* PROJ = (const bf16*)(a.ws + WS_PROJ); const bf16* PROJM = (const bf16*)(a.ws + WS_PROJM);
    LAS float* GKLs = (LAS float*)F.lds; LAS float* BC = (LAS float*)(F.lds + 4096);
    if (F.tid < 256) { const int t = F.tid >> 2, q = F.tid & 3;
        const f32x4 v = ldp4(PROJ, PROJM, b, (t < ntok) ? vp0 + t : -1, GKL + 4 * q);
        *(LAS f32x4*)(GKLs + t * 16 + 4 * q) = v; }
    lds_barrier();
    {
        const int d = F.tid & 63, tg = F.tid >> 6;
        float wc[16];
#pragma unroll
        for (int r = 0; r < 16; ++r) wc[r] = a.in[I_GKW2][r * 256 + h * 64 + d];
        const float gb = a.in[I_GKB][h * 64 + d];
        float lgv[8];
#pragma unroll
        for (int i = 0; i < 8; ++i) { const int t = tg * 8 + i; float z = gb;
            const LAS f32x4* g4 = (const LAS f32x4*)(GKLs + t * 16);
#pragma unroll
            for (int q = 0; q < 4; ++q) { const f32x4 gv = g4[q]; z += gv.x * wc[4 * q] + gv.y * wc[4 * q + 1] + gv.z * wc[4 * q + 2] + gv.w * wc[4 * q + 3]; }
            lgv[i] = (t < ntok) ? flogsigmoid(z) * (1.f / 16.f) : 0.f; }
        LAS float* SEG = (LAS float*)(F.lds + 20736);
#pragma unroll
        for (int i = 1; i < 8; ++i) lgv[i] += lgv[i - 1];
        SEG[tg * 64 + d] = lgv[7];
        lds_barrier();
        float pre = 0.f;
#pragma unroll
        for (int s2 = 0; s2 < 7; ++s2) pre += (s2 < tg) ? SEG[s2 * 64 + d] : 0.f;
#pragma unroll
        for (int i = 0; i < 8; ++i) BC[(tg * 8 + i) * BCP + d] = lgv[i] + pre;
    }
    lds_barrier();
}

__device__ __forceinline__ void gla_g1_unit(const Args& a, const Frame& F, int b, int h, int c) {
    const bf16* PROJ = (const bf16*)(a.ws + WS_PROJ); const bf16* PROJM = (const bf16*)(a.ws + WS_PROJM);
    float* GUS = (float*)(a.ws + WS_GUS); float* DL = (float*)(a.ws + WS_DL);
    const int ntok = (c == 0) ? NMETA : 64, vp0 = (c == 0) ? 0 : NMETA + 64 * (c - 1);
    gla_bc(a, F, b, h, vp0, ntok);
    LAS float* BC = (LAS float*)(F.lds + 4096);
    LAS bf16* KT = (LAS bf16*)(F.lds + 24576);
    LAS bf16* VT = (LAS bf16*)(F.lds + 24576 + 64 * TP * 2);
    {
        const int t = F.tid >> 3, q = F.tid & 7;
        const float* bl = nullptr; (void)bl;
#pragma unroll
        for (int half = 0; half < 2; ++half) {
            const int d0 = 8 * q + 4 * half;
            const f32x4 kv = ldp4(PROJ, PROJM, b, (t < ntok) ? vp0 + t : -1, GK + h * 64 + d0);
#pragma unroll
            for (int i = 0; i < 4; ++i) { const int d = d0 + i; const float e = (t < ntok) ? fexp(BC[(ntok - 1) * BCP + d] - BC[t * BCP + d]) : 0.f;
                KT[d * TP + t] = (bf16)f2bf(kv[i] * e); }
        }
#pragma unroll
        for (int qq = 0; qq < 4; ++qq) {
            const int e0 = 16 * q + 4 * qq;
            const f32x4 vv = ldp4(PROJ, PROJM, b, (t < ntok) ? vp0 + t : -1, GV + h * 128 + e0);
#pragma unroll
            for (int i = 0; i < 4; ++i) VT[(e0 + i) * TP + t] = (bf16)f2bf(vv[i]);
        }
    }
    lds_barrier();
    {
        const int rt = F.wave & 3, ch = F.wave >> 2, fr = F.lane & 15, fq = F.lane >> 4;
        float* up = GUS + ((size_t)((b * 4 + h) * NCH + c) * 64 + rt * 16 + fr) * 128;
#pragma unroll
        for (int cc = 0; cc < 4; ++cc) { const int ct = ch * 4 + cc;
            f32x4 acc = {0.f, 0.f, 0.f, 0.f};
#pragma unroll
            for (int ks = 0; ks < 2; ++ks)
                acc = mfma16(*(const LAS bf16x8*)(VT + (ct * 16 + fr) * TP + ks * 32 + 8 * fq), *(const LAS bf16x8*)(KT + (rt * 16 + fr) * TP + ks * 32 + 8 * fq), acc);
            *(f32x4*)(up + ct * 16 + 4 * fq) = acc; }
        if (F.tid < 64) DL[(size_t)((b * 4 + h) * NCH + c) * 64 + F.tid] = fexp(BC[(ntok - 1) * BCP + F.tid]);
    }
    lds_barrier();
}

template <bool BACK>
__device__ __forceinline__ void rwkv_l1_loop(const Args& a, const Frame& F) {
    constexpr int NU = NB * 8 * NCH;
    const int u0 = (int)((long)F.blk * NU / F.G), u1 = (int)((long)(F.blk + 1) * NU / F.G);
    L1Pf pf;
    bf16x8 lrf[8];
    if (u0 < u1) l1_fetch(a, F, (u0 >> 3) / NCH, u0 & 7, (u0 >> 3) % NCH, pf, true);
    for (int u = u0; u < u1; ++u) {
        const int h = u & 7, c = (u >> 3) % NCH, b = (u >> 3) / NCH; f32x4 rtil[2];
        const bool newgrp = (u == u0) || (h == 0);
        { const Frame F1 = mkframe(F.lds, F.wave); rwkv_l1_front(a, F1, b, h, c, pf, rtil, newgrp, lrf); }
        { const Frame F2 = mkframe(F.lds, F.wave);
          if (u + 1 < u1) l1_fetch(a, F2, ((u + 1) >> 3) / NCH, (u + 1) & 7, ((u + 1) >> 3) % NCH, pf, ((u + 1) & 7) == 0);
          if constexpr (BACK) rwkv_l1_back(a, F2, b, h, c, rtil); }
    }
}
__device__ __forceinline__ void phase2(const Args& a, const Frame& F) {
    if constexpr (((REP_MASK >> 19) & 1) != 0) { const Frame F0 = mkframe(F.lds, F.wave); rwkv_l1_loop<false>(a, F0); }
    { const Frame F0 = mkframe(F.lds, F.wave); rwkv_l1_loop<true>(a, F0); }
    for (int rep_ = 0; rep_ < NREP(12); ++rep_)
    for (int u = F.blk; u < NB * 4 * 32; u += F.G) { const int c = u & 31, bh = u >> 5; const Frame F1 = mkframe(F.lds, F.wave); gla_g1_unit(a, F1, bh >> 2, bh & 3, c); }
}

struct L2S { v4u g, h; f32x4 gm; };
__device__ __forceinline__ void l2s_fetch(L2S& r, const unsigned char* src, const float* gam) {
    r.g = *(const v4u*)src; r.h = *(const v4u*)(src + 8192); r.gm = *(const f32x4*)gam;
}
__device__ __forceinline__ void l2s_stage(const L2S& r, LAS bf16* Gt, LAS bf16* Ht, LAS float* Gm, int tid) {
    const int r_ = tid >> 3, c8 = tid & 7;
    *(LAS v4u*)(Gt + r_ * TP + 8 * c8) = r.g; *(LAS v4u*)(Ht + r_ * TP + 8 * c8) = r.h;
    if (tid < 16) *(LAS f32x4*)(Gm + 4 * tid) = r.gm;
}
__device__ __forceinline__ void l2s_step(const LAS bf16* Gt, const LAS bf16* Ht, const LAS float* Gm, const LAS bf16* Sc, LAS bf16* Sn, f32x4 (&Sm)[2], int row, int cp, int fr, int fq, bf16* gout, int tid) {
    {
        const int r_ = tid >> 3, c8 = tid & 7;
        *(v4u*)(gout + r_ * 64 + 8 * c8) = *(const LAS v4u*)(Sc + r_ * TP + 8 * c8);
    }
    const int col0 = cp * 32 + 4 * fq;
    const bf16x8 af0 = *(const LAS bf16x8*)(Sc + row * TP + 8 * fq), af1 = *(const LAS bf16x8*)(Sc + row * TP + 32 + 8 * fq);
    bf16x8 fg[4]; v2u hq[2]; f32x4 gm[2];
#pragma unroll
    for (int cc = 0; cc < 2; ++cc) { const LAS bf16* gr = Gt + (cp * 32 + cc * 16 + fr) * TP + 8 * fq;
        fg[2 * cc] = *(const LAS bf16x8*)gr; fg[2 * cc + 1] = *(const LAS bf16x8*)(gr + 32);
        hq[cc] = *(const LAS v2u*)(Ht + row * TP + col0 + cc * 16); gm[cc] = *(const LAS f32x4*)(Gm + col0 + cc * 16); }
#pragma unroll
    for (int cc = 0; cc < 2; ++cc) {
        f32x4 acc = {bflo(hq[cc].x), bfhi(hq[cc].x), bflo(hq[cc].y), bfhi(hq[cc].y)};
        acc = mfma16(fg[2 * cc], af0, acc);
        acc = mfma16(fg[2 * cc + 1], af1, acc);
        Sm[cc] = Sm[cc] * gm[cc] + acc; }
#pragma unroll
    for (int cc = 0; cc < 2; ++cc) *(LAS v2u*)(Sn + row * TP + col0 + cc * 16) = pack4(Sm[cc]);
}
template <bool FAKE>
__device__ __forceinline__ void rwkv_l2_unit(const Args& a, const Frame& F, int bh) {
    unsigned char* ws = a.ws;
    LAS bf16* Sb0 = (LAS bf16*)F.lds; LAS bf16* Sb1 = Sb0 + 64 * TP;
    LAS bf16* G0 = Sb0 + 2 * 64 * TP; LAS bf16* G1 = Sb0 + 3 * 64 * TP; LAS bf16* H0 = Sb0 + 4 * 64 * TP; LAS bf16* H1 = Sb0 + 5 * 64 * TP;
    LAS float* M0 = (LAS float*)(Sb0 + 6 * 64 * TP); LAS float* M1 = M0 + 64;
    const int fr = F.lane & 15, fq = F.lane >> 4, rt = F.wave & 3, cp = F.wave >> 2;
    const int row = rt * 16 + fr, col0 = cp * 32 + 4 * fq;
    const unsigned char* srcb = ws + WS_R1 + (size_t)bh * NCH * R1_STRIDE + (size_t)((F.tid >> 3) * 64 + 8 * (F.tid & 7)) * 2;
    const float* gamb = (const float*)(ws + WS_GAM) + (size_t)bh * NCH * 64 + 4 * (F.lane & 15);
    bf16* sst = (bf16*)(ws + WS_SST) + (size_t)bh * NCH * 4096;
    f32x4 Sm[2];
#pragma unroll
    for (int cc = 0; cc < 2; ++cc) { Sm[cc] = (f32x4){0.f, 0.f, 0.f, 0.f}; *(LAS v2u*)(Sb0 + row * TP + col0 + cc * 16) = (v2u){0u, 0u}; }
    L2S r0, r1, r2, r3;
#define L2F(rr, cn) do { const int cn_ = FAKE ? 0 : (((cn) < NCH - 1) ? (cn) : NCH - 2); l2s_fetch(rr, srcb + (size_t)cn_ * R1_STRIDE, gamb + (size_t)cn_ * 64); } while (0)
    L2F(r0, 0); L2F(r1, 1); L2F(r2, 2); L2F(r3, 3);
    l2s_stage(r0, G0, H0, M0, F.tid);
    lds_barrier(); __builtin_amdgcn_sched_barrier(0);
#pragma nounroll
    for (int c = 0; c < NCH - 1; c += 4) {
        l2s_stage(r1, G1, H1, M1, F.tid); L2F(r0, c + 4);
        l2s_step(G0, H0, M0, Sb0, Sb1, Sm, row, cp, fr, fq, sst + (size_t)c * 4096, F.tid); lds_barrier(); __builtin_amdgcn_sched_barrier(0);
        l2s_stage(r2, G0, H0, M0, F.tid); L2F(r1, c + 5);
        l2s_step(G1, H1, M1, Sb1, Sb0, Sm, row, cp, fr, fq, sst + (size_t)(c + 1) * 4096, F.tid); lds_barrier(); __builtin_amdgcn_sched_barrier(0);
        l2s_stage(r3, G1, H1, M1, F.tid); L2F(r2, c + 6);
        l2s_step(G0, H0, M0, Sb0, Sb1, Sm, row, cp, fr, fq, sst + (size_t)(c + 2) * 4096, F.tid); lds_barrier(); __builtin_amdgcn_sched_barrier(0);
        l2s_stage(r0, G0, H0, M0, F.tid); L2F(r3, c + 7);
        l2s_step(G1, H1, M1, Sb1, Sb0, Sm, row, cp, fr, fq, sst + (size_t)(c + 3) * 4096, F.tid); lds_barrier(); __builtin_amdgcn_sched_barrier(0);
    }
#undef L2F
    { const int r_ = F.tid >> 3, c8 = F.tid & 7;
      *(v4u*)(sst + (size_t)(NCH - 1) * 4096 + r_ * 64 + 8 * c8) = *(const LAS v4u*)(Sb0 + r_ * TP + 8 * c8); }
    lds_barrier();
}
__device__ __forceinline__ void rwkv_y_task(const Args& a, const Frame& F, int task) {
    unsigned char* ws = a.ws;
    const int c = 1 + (task & 31), bh = task >> 5, b = bh >> 3, h = bh & 7;
    const int fr = F.lane & 15, fq = F.lane >> 4;
    const bf16* Sg = (const bf16*)(ws + WS_SST) + (size_t)(bh * NCH + c) * 4096 + fr * 64 + 8 * fq;
    bf16x8 sf[8];
#pragma unroll
    for (int ct = 0; ct < 4; ++ct) { sf[2 * ct] = *(const bf16x8*)(Sg + ct * 1024); sf[2 * ct + 1] = *(const bf16x8*)(Sg + ct * 1024 + 32); }
    f32x4 lg[4], lb[4];
#pragma unroll
    for (int ct = 0; ct < 4; ++ct) { const int i0 = h * 64 + ct * 16 + 4 * fq; lg[ct] = *(const f32x4*)(a.in[I_RLNG] + i0); lb[ct] = *(const f32x4*)(a.in[I_RLNB] + i0); }
    LAS bf16* ost = (LAS bf16*)(F.lds + 102400 + F.wave * 2304);
    const unsigned char* r1u = ws + WS_R1 + (size_t)(bh * NCH + c) * R1_STRIDE + (size_t)(fr * 64 + 4 * fq) * 2;
    bf16x8 fa0[4], fa1[4]; v2u q0[4][4];
#pragma unroll
    for (int rt = 0; rt < 4; ++rt) { const unsigned char* r1 = r1u + rt * 2048;
        fa0[rt] = *(const bf16x8*)(r1 + 2 * 8192 + 8 * fq); fa1[rt] = *(const bf16x8*)(r1 + 2 * 8192 + 64 + 8 * fq);
#pragma unroll
        for (int ct = 0; ct < 4; ++ct) q0[rt][ct] = *(const v2u*)(r1 + 3 * 8192 + ct * 32); }
#pragma unroll
    for (int rt = 0; rt < 4; ++rt) {
        const unsigned char* r1 = r1u + rt * 2048;
        v2u q1[4], q2[4];
#pragma unroll
        for (int ct = 0; ct < 4; ++ct) { q1[ct] = *(const v2u*)(r1 + 4 * 8192 + ct * 32); q2[ct] = *(const v2u*)(r1 + 5 * 8192 + ct * 32); }
        f32x4 y[4]; float s = 0.f;
#pragma unroll
        for (int ct = 0; ct < 4; ++ct) {
            f32x4 acc = {bflo(q0[rt][ct].x), bfhi(q0[rt][ct].x), bflo(q0[rt][ct].y), bfhi(q0[rt][ct].y)};
            acc = mfma16(sf[2 * ct], fa0[rt], acc); acc = mfma16(sf[2 * ct + 1], fa1[rt], acc);
            y[ct] = acc; s += (acc[0] + acc[1]) + (acc[2] + acc[3]); }
        s += shx(s, 16, F.lane); s += shx(s, 32, F.lane);
        const float mean = s * (1.f / 64.f); float q = 0.f;
#pragma unroll
        for (int ct = 0; ct < 4; ++ct) { y[ct] = y[ct] - mean; q += (y[ct][0] * y[ct][0] + y[ct][1] * y[ct][1]) + (y[ct][2] * y[ct][2] + y[ct][3] * y[ct][3]); }
        q += shx(q, 16, F.lane); q += shx(q, 32, F.lane);
        const float rstd = __builtin_amdgcn_rsqf(q * (1.f / 64.f) + 64e-5f);
#pragma unroll
        for (int ct = 0; ct < 4; ++ct) {
            const f32x4 g = {bflo(q1[ct].x), bfhi(q1[ct].x), bflo(q1[ct].y), bfhi(q1[ct].y)}, bv = {bflo(q2[ct].x), bfhi(q2[ct].x), bflo(q2[ct].y), bfhi(q2[ct].y)};
            const f32x4 o = (y[ct] * rstd * lg[ct] + lb[ct] + bv) * g;
            *(LAS v2u*)(ost + fr * 72 + ct * 16 + 4 * fq) = pack4(o); }
        asm volatile("s_waitcnt lgkmcnt(0)" ::: "memory");
        bf16* yout = (bf16*)(ws + WS_YMIX) + ((size_t)b * SEQ + 64 * (c - 1) + rt * 16) * D + 512 + h * 64;
#pragma unroll
        for (int hh = 0; hh < 2; ++hh) { const int tr = (F.lane >> 3) + 8 * hh, c8 = F.lane & 7;
            *(v4u*)(yout + (size_t)tr * D + 8 * c8) = *(const LAS v4u*)(ost + tr * 72 + 8 * c8); }
        asm volatile("s_waitcnt lgkmcnt(0)" ::: "memory");
    }
}
__device__ __forceinline__ void gla_scan_unit(const Args& a, const Frame& F, int j) {
    float* GUS = (float*)(a.ws + WS_GUS); const float* DL = (const float*)(a.ws + WS_DL);
    const int bh = j >> 1, half = j & 1;
    const int d = 32 * half + (F.tid >> 4), e0 = (F.tid & 15) * 4;
    float* base = GUS + (size_t)bh * NCH * 8192 + d * 128 + e0;
    const float* dl = DL + (size_t)bh * NCH * 64 + d;
    f32x4 s0 = {0.f, 0.f, 0.f, 0.f}, s1 = s0;
    f32x4 ua[8], ub[8]; float dq[8];
#pragma unroll
    for (int q = 0; q < 7; ++q) { ua[q] = *(const f32x4*)(base + (size_t)q * 8192); ub[q] = *(const f32x4*)(base + (size_t)q * 8192 + 64); dq[q] = dl[q * 64]; }
#pragma unroll 8
    for (int c = 0; c < NCH - 1; ++c) {
        const int cn = (c + 7 < NCH - 1) ? c + 7 : NCH - 2;
        ua[(c + 7) & 7] = *(const f32x4*)(base + (size_t)cn * 8192); ub[(c + 7) & 7] = *(const f32x4*)(base + (size_t)cn * 8192 + 64); dq[(c + 7) & 7] = dl[cn * 64];
        *(f32x4*)(base + (size_t)c * 8192) = s0; *(f32x4*)(base + (size_t)c * 8192 + 64) = s1;
        s0 = s0 * dq[c & 7] + ua[c & 7]; s1 = s1 * dq[c & 7] + ub[c & 7];
    }
    *(f32x4*)(base + (size_t)(NCH - 1) * 8192) = s0; *(f32x4*)(base + (size_t)(NCH - 1) * 8192 + 64) = s1;
}
__device__ __forceinline__ void phase3(const Args& a, const Frame& F) {
    for (int u = F.blk; u < 256; u += F.G) {
        if (u < 128) { if constexpr (((REP_MASK >> 20) & 1) != 0) rwkv_l2_unit<true>(a, F, u); for (int rep_ = 0; rep_ < NREP(3); ++rep_) rwkv_l2_unit<false>(a, F, u); }
        else gla_scan_unit(a, F, u - 128);
    }
}

struct G3Pf { v2u gkl, q[2], k[2], v[4], gg[4]; f32x4 s[4]; };
struct G3Const { float wc[16], gb; f32x4 ng[4]; };
__device__ __forceinline__ void g3_fetch(const Args& a, const Frame& F, int b, int h, int c, G3Pf& pf) {
    const bf16* PROJ = (const bf16*)(a.ws + WS_PROJ); const bf16* PROJM = (const bf16*)(a.ws + WS_PROJM);
    const float* GUS = (const float*)(a.ws + WS_GUS);
    const int vp0 = NMETA + 64 * (c - 1);
    { const int t = (F.tid >> 2) & 63, q = F.tid & 3; pf.gkl = *(const v2u*)(prow(PROJ, PROJM, b, vp0 + t) + GKL + 4 * q); }
    const int t = F.tid >> 3, q = F.tid & 7; const bf16* pr = prow(PROJ, PROJM, b, vp0 + t);
#pragma unroll
    for (int i = 0; i < 2; ++i) { pf.q[i] = *(const v2u*)(pr + GQ + h * 64 + 8 * q + 4 * i); pf.k[i] = *(const v2u*)(pr + GK + h * 64 + 8 * q + 4 * i); }
#pragma unroll
    for (int qq = 0; qq < 4; ++qq) { pf.v[qq] = *(const v2u*)(pr + GV + h * 128 + 16 * q + 4 * qq);
        pf.s[qq] = *(const f32x4*)(GUS + ((size_t)((b * 4 + h) * NCH + c) * 64 + t) * 128 + 16 * q + 4 * qq); }
    const int rt = F.wave & 3, wh = F.wave >> 2, fr = F.lane & 15, fq = F.lane >> 4;
    const bf16* pg = prow(PROJ, PROJM, b, vp0 + rt * 16 + fr);
#pragma unroll
    for (int cc = 0; cc < 4; ++cc) pf.gg[cc] = *(const v2u*)(pg + GG + h * 128 + (wh * 4 + cc) * 16 + 4 * fq);
}
__device__ __forceinline__ void gla_g3_unit(const Args& a, const Frame& F, int b, int h, int c, const G3Pf& pf, const G3Const& K) {
    bf16* YMIX = (bf16*)(a.ws + WS_YMIX);
    const int vp0 = NMETA + 64 * (c - 1);
    LAS float* GKLs = (LAS float*)F.lds; LAS float* BC = (LAS float*)(F.lds + 4096);
    LAS bf16* QT = (LAS bf16*)(F.lds + 24576);
    LAS bf16* KL = QT + 64 * TP;
    LAS bf16* AT = KL + 64 * TP;
    LAS bf16* VT = AT + 64 * TP;
    LAS bf16* ST = VT + 128 * TP;
    LAS float* RS = (LAS float*)(ST + 128 * TP);
    if (F.tid < 256) { const int t = F.tid >> 2, q = F.tid & 3; *(LAS f32x4*)(GKLs + t * 16 + 4 * q) = unpk4(pf.gkl); }
    lds_barrier();
    {
        const int d = F.tid & 63, tg = F.tid >> 6;
        float lgv[8];
#pragma unroll
        for (int i = 0; i < 8; ++i) { const int t = tg * 8 + i; float z = K.gb;
            const LAS f32x4* g4 = (const LAS f32x4*)(GKLs + t * 16);
#pragma unroll
            for (int q = 0; q < 4; ++q) { const f32x4 gv = g4[q]; z += gv.x * K.wc[4 * q] + gv.y * K.wc[4 * q + 1] + gv.z * K.wc[4 * q + 2] + gv.w * K.wc[4 * q + 3]; }
            lgv[i] = flogsigmoid(z) * (1.f / 16.f); }
        LAS float* SEG = (LAS float*)(F.lds + 20736);
#pragma unroll
        for (int i = 1; i < 8; ++i) lgv[i] += lgv[i - 1];
        SEG[tg * 64 + d] = lgv[7];
        lds_barrier();
        float pre = 0.f;
#pragma unroll
        for (int s2 = 0; s2 < 7; ++s2) pre += (s2 < tg) ? SEG[s2 * 64 + d] : 0.f;
#pragma unroll
        for (int i = 0; i < 8; ++i) BC[(tg * 8 + i) * BCP + d] = lgv[i] + pre;
    }
    lds_barrier();
    const int rt = F.wave & 3, wh = F.wave >> 2, fr = F.lane & 15, fq = F.lane >> 4;
    const int trow = rt * 16 + fr;
    f32x4 sg[4];
#pragma unroll
    for (int cc = 0; cc < 4; ++cc) { const f32x4 gv = unpk4(pf.gg[cc]);
#pragma unroll
        for (int i = 0; i < 4; ++i) sg[cc][i] = K.ng[cc][i] * (gv[i] * fsigmoid(gv[i])); }
    {
        const int t = F.tid >> 3, q = F.tid & 7;
        const f32x4 q0 = unpk4(pf.q[0]), q1 = unpk4(pf.q[1]), k0 = unpk4(pf.k[0]), k1 = unpk4(pf.k[1]);
        float qv[8] = {q0.x, q0.y, q0.z, q0.w, q1.x, q1.y, q1.z, q1.w}, kv[8] = {k0.x, k0.y, k0.z, k0.w, k1.x, k1.y, k1.z, k1.w};
#pragma unroll
        for (int i = 0; i < 8; ++i) { const float bcv = BC[t * BCP + 8 * q + i]; qv[i] *= fexp(bcv) * 0.125f; kv[i] *= fexp(-bcv); }
        v4u o; o.x = pk2(qv[0], qv[1]); o.y = pk2(qv[2], qv[3]); o.z = pk2(qv[4], qv[5]); o.w = pk2(qv[6], qv[7]);
        *(LAS v4u*)(QT + t * TP + 8 * q) = o;
        o.x = pk2(kv[0], kv[1]); o.y = pk2(kv[2], kv[3]); o.z = pk2(kv[4], kv[5]); o.w = pk2(kv[6], kv[7]);
        *(LAS v4u*)(KL + t * TP + 8 * q) = o;
#pragma unroll
        for (int qq = 0; qq < 4; ++qq) {
            const int e0 = 16 * q + 4 * qq;
            const unsigned vx = pf.v[qq].x, vy = pf.v[qq].y;
            VT[(e0 + 0) * TP + t] = (bf16)(vx & 0xffffu); VT[(e0 + 1) * TP + t] = (bf16)(vx >> 16); VT[(e0 + 2) * TP + t] = (bf16)(vy & 0xffffu); VT[(e0 + 3) * TP + t] = (bf16)(vy >> 16);
#pragma unroll
            for (int i = 0; i < 4; ++i) ST[(e0 + i) * TP + t] = (bf16)f2bf(pf.s[qq][i]);
        }
    }
    lds_barrier();
    {
        f32x4 av[2];
#pragma unroll
        for (int cc = 0; cc < 2; ++cc) { const int ct = 2 * wh + cc;
            f32x4 acc = {0.f, 0.f, 0.f, 0.f};
#pragma unroll
            for (int ks = 0; ks < 2; ++ks)
                acc = mfma16(*(const LAS bf16x8*)(KL + (ct * 16 + fr) * TP + ks * 32 + 8 * fq), *(const LAS bf16x8*)(QT + trow * TP + ks * 32 + 8 * fq), acc);
            const int s0 = ct * 16 + 4 * fq;
#pragma unroll
            for (int i = 0; i < 4; ++i) if (s0 + i > trow) acc[i] = 0.f;
            av[cc] = acc; }
#pragma unroll
        for (int cc = 0; cc < 2; ++cc) *(LAS v2u*)(AT + trow * TP + (2 * wh + cc) * 16 + 4 * fq) = pack4(av[cc]);
    }
    lds_barrier();
    f32x4 oacc[4]; float ssq = 0.f;
#pragma unroll
    for (int cc = 0; cc < 4; ++cc) { const int ct = wh * 4 + cc;
        f32x4 acc = {0.f, 0.f, 0.f, 0.f};
#pragma unroll
        for (int ks = 0; ks < 2; ++ks) {
            acc = mfma16(*(const LAS bf16x8*)(VT + (ct * 16 + fr) * TP + ks * 32 + 8 * fq), *(const LAS bf16x8*)(AT + trow * TP + ks * 32 + 8 * fq), acc);
            acc = mfma16(*(const LAS bf16x8*)(ST + (ct * 16 + fr) * TP + ks * 32 + 8 * fq), *(const LAS bf16x8*)(QT + trow * TP + ks * 32 + 8 * fq), acc);
        }
        oacc[cc] = acc; ssq += (acc[0] * acc[0] + acc[1] * acc[1]) + (acc[2] * acc[2] + acc[3] * acc[3]); }
    ssq += shx(ssq, 16, F.lane); ssq += shx(ssq, 32, F.lane);
    if (fq == 0) RS[wh * 64 + trow] = ssq;
    lds_barrier();
    {
        const float tot = RS[trow] + RS[64 + trow];
        const float rstd = 1.f / sqrtf(tot * (1.f / 128.f) + 1e-6f);
        const size_t m = (size_t)b * SEQ + (vp0 - NMETA) + trow;
#pragma unroll
        for (int cc = 0; cc < 4; ++cc) { const int e0 = (wh * 4 + cc) * 16 + 4 * fq;
            const f32x4 y = oacc[cc] * rstd * sg[cc];
            *(v2u*)(YMIX + m * D + h * 128 + e0) = pack4(y); }
    }
    lds_barrier();
}
__device__ __forceinline__ void phase4(const Args& a, const Frame& F) {
    for (int rep_ = 0; rep_ < NREP(21); ++rep_)
    for (int t = F.blk * NWAVES + F.wave; t < 128 * 32; t += F.G * NWAVES) { const Frame F1 = mkframe(F.lds, F.wave); rwkv_y_task(a, F1, t); }
    __syncthreads();
    for (int rep_ = 0; rep_ < NREP(22); ++rep_) {
        constexpr int NU = NB * 4 * 32;
        const int h = (F.blk >> 5) & 3;
        G3Const K;
        { const int d = F.tid & 63, wh = F.wave >> 2, fq = F.lane >> 4;
#pragma unroll
          for (int r = 0; r < 16; ++r) K.wc[r] = a.in[I_GKW2][r * 256 + h * 64 + d];
          K.gb = a.in[I_GKB][h * 64 + d];
#pragma unroll
          for (int cc = 0; cc < 4; ++cc) K.ng[cc] = *(const f32x4*)(a.in[I_GNORM] + (wh * 4 + cc) * 16 + 4 * fq); }
        G3Pf pa, pb;
        if (F.blk < NU) g3_fetch(a, F, F.blk >> 7, h, 1 + (F.blk & 31), pa);
        for (int u = F.blk; u < NU; u += 2 * F.G) {
            const int u1 = u + F.G, u2 = u + 2 * F.G;
            { const Frame F1 = mkframe(F.lds, F.wave);
              { const int uf = (u1 < NU) ? u1 : u; g3_fetch(a, F1, uf >> 7, h, 1 + (uf & 31), pb); }
              gla_g3_unit(a, F1, u >> 7, h, 1 + (u & 31), pa, K); }
            if (u1 < NU) { const Frame F1 = mkframe(F.lds, F.wave);
              { const int uf = (u2 < NU) ? u2 : u1; g3_fetch(a, F1, uf >> 7, h, 1 + (uf & 31), pa); }
              gla_g3_unit(a, F1, u1 >> 7, h, 1 + (u1 & 31), pb, K); }
        }
    }
}

__device__ __forceinline__ int eidx_of(int L) { return 16 * (L & 1) + 8 * ((L >> 1) & 1) + 4 * ((L >> 2) & 1) + 2 * ((L >> 3) & 1) + ((L >> 4) & 1); }
__device__ __forceinline__ void p6_row(const Args& a, const Frame& F, int m, const v4u (&a0)[2], const v4u (&mx)[2], const f32x4 (&g1)[4], const f32x4 (&b1)[4]) {
    unsigned char* ws = a.ws; bf16* H1 = (bf16*)(ws + WS_H1);
    float v[16];
#pragma unroll
    for (int j = 0; j < 2; ++j)
#pragma unroll
        for (int k = 0; k < 4; ++k) { v[8 * j + 2 * k] = ALPHA * bflo(a0[j][k]) + bflo(mx[j][k]); v[8 * j + 2 * k + 1] = ALPHA * bfhi(a0[j][k]) + bfhi(mx[j][k]); }
    float s = 0.f;
#pragma unroll
    for (int k = 0; k < 16; ++k) s += v[k];
    const float mean = wave_sum(s, F.lane) * (1.f / D); float s2 = 0.f;
#pragma unroll
    for (int k = 0; k < 16; ++k) { v[k] -= mean; s2 += v[k] * v[k]; }
    const float rstd = __builtin_amdgcn_rsqf(wave_sum(s2, F.lane) * (1.f / D) + 1e-5f);
#pragma unroll
    for (int j = 0; j < 2; ++j) {
#pragma unroll
        for (int k = 0; k < 8; ++k) v[8 * j + k] = v[8 * j + k] * rstd * g1[2 * j + (k >> 2)][k & 3] + b1[2 * j + (k >> 2)][k & 3];
        v4u o; o.x = pk2(v[8 * j], v[8 * j + 1]); o.y = pk2(v[8 * j + 2], v[8 * j + 3]); o.z = pk2(v[8 * j + 4], v[8 * j + 5]); o.w = pk2(v[8 * j + 6], v[8 * j + 7]);
        *(v4u*)(H1 + (size_t)m * D + 8 * F.lane + 512 * j) = o;
        int w0 = __builtin_amdgcn_cvt_pk_fp8_f32(v[8 * j], v[8 * j + 1], 0, false); w0 = __builtin_amdgcn_cvt_pk_fp8_f32(v[8 * j + 2], v[8 * j + 3], w0, true);
        int w1 = __builtin_amdgcn_cvt_pk_fp8_f32(v[8 * j + 4], v[8 * j + 5], 0, false); w1 = __builtin_amdgcn_cvt_pk_fp8_f32(v[8 * j + 6], v[8 * j + 7], w1, true);
        *(v2u*)(ws + WS_H1Q + (size_t)m * D + 8 * F.lane + 512 * j) = (v2u){(unsigned)w0, (unsigned)w1}; }
}
__device__ __forceinline__ void phase6(const Args& a, const Frame& F, int csel) {
    unsigned char* ws = a.ws;
    LAS float* LG = (LAS float*)(F.lds + F.wave * 2560);
    LAS int* hist = (LAS int*)(F.lds + 8 * 2560);
    bf16* H1 = (bf16*)(ws + WS_H1);
    const bf16* RWH = (const bf16*)(ws + WS_RWH); const bf16* RWL = (const bf16*)(ws + WS_RWL);
    int* TOPI = (int*)(ws + WS_TOPI); float* GATE = (float*)(ws + WS_GATE); int* RANK = (int*)(ws + WS_RANK);
    int* BCNT = (int*)(ws + WS_BCNT); (void)csel;
    for (int rb = F.blk; rb < MX / 128; rb += F.G) {
        if (F.tid < 64) hist[F.tid] = 0;
        __syncthreads();
        const int mb = rb * 128 + F.wave * 16; const Frame& Fo = F;
        {
            const bf16* ar0 = (const bf16*)(ws + WS_A0) + (size_t)mb * D + 8 * F.lane;
            const bf16* mr0 = (const bf16*)(ws + WS_MIXB) + (size_t)mb * D + 8 * F.lane;
            constexpr int NS = 6;
            v4u av[NS][2], mv[NS][2];
            f32x4 g1[4], b1[4];
#pragma unroll
            for (int q = 0; q < 4; ++q) { const int col = 8 * F.lane + 512 * (q >> 1) + 4 * (q & 1); g1[q] = *(const f32x4*)(a.in[I_LN1G] + col); b1[q] = *(const f32x4*)(a.in[I_LN1B] + col); }
#define P6_LOAD(ss, ii) do { _Pragma("unroll") for (int j = 0; j < 2; ++j) { av[ss][j] = *(const v4u*)(ar0 + (size_t)(ii) * D + 512 * j); mv[ss][j] = *(const v4u*)(mr0 + (size_t)(ii) * D + 512 * j); } } while (0)
#pragma unroll
            for (int i = 0; i < NS - 1; ++i) P6_LOAD(i, i);
            __builtin_amdgcn_sched_barrier(0);
#pragma unroll
            for (int i = 0; i < 16; ++i) {
                if (i + NS - 1 < 16) P6_LOAD((i + NS - 1) % NS, i + NS - 1);
                __builtin_amdgcn_sched_barrier(0);
                p6_row(a, F, mb + i, av[i % NS], mv[i % NS], g1, b1);
            }
#undef P6_LOAD
        }
        asm volatile("s_waitcnt vmcnt(0)" ::: "memory");
        for (int rep2_ = 0; rep2_ < NREP(24); ++rep2_)
        {
            const int fr = F.lane & 15, fq = F.lane >> 4;
            const bf16* ap = H1 + (size_t)(mb + fr) * D + 8 * fq;
            const bf16* bh = RWH + (size_t)fr * D + 8 * fq; const bf16* bl = RWL + (size_t)fr * D + 8 * fq;
            f32x4 acc0 = {0.f, 0.f, 0.f, 0.f}, acc1 = acc0;
#pragma unroll 8
            for (int ks = 0; ks < 32; ++ks) { const bf16x8 af = *(const bf16x8*)(ap + ks * 32);
                acc0 = mfma16(*(const bf16x8*)(bh + ks * 32), af, acc0); acc0 = mfma16(*(const bf16x8*)(bl + ks * 32), af, acc0);
                acc1 = mfma16(*(const bf16x8*)(bh + 16 * D + ks * 32), af, acc1); acc1 = mfma16(*(const bf16x8*)(bl + 16 * D + ks * 32), af, acc1); }
            const f32x4 rb0 = *(const f32x4*)(a.in[I_RTB] + 4 * fq), rb1 = *(const f32x4*)(a.in[I_RTB] + 16 + 4 * fq);
#pragma unroll
            for (int q = 0; q < 4; ++q) { LG[fr * 33 + 4 * fq + q] = acc0[q] + rb0[q]; LG[fr * 33 + 16 + 4 * fq + q] = acc1[q] + rb1[q]; }
        }
        asm volatile("s_waitcnt lgkmcnt(0)" ::: "memory");
        LAS int* EK = (LAS int*)(LG + 528);
        if (F.lane < 16) {
            float lv[32];
#pragma unroll
            for (int e = 0; e < 32; ++e) lv[e] = LG[F.lane * 33 + e];
            int ek[4]; float lk[4];
#pragma unroll
            for (int k = 0; k < 4; ++k) { float best = -3.0e38f; int bi = 0;
#pragma unroll
                for (int e = 0; e < 32; ++e) { const bool tk = lv[e] > best; best = tk ? lv[e] : best; bi = tk ? e : bi; }
                ek[k] = bi; lk[k] = best;
#pragma unroll
                for (int e = 0; e < 32; ++e) lv[e] = (e == bi) ? -3.0e38f : lv[e]; }
            const float e1 = expf(lk[1] - lk[0]), e2 = expf(lk[2] - lk[0]), e3 = expf(lk[3] - lk[0]);
            const float inv = 1.f / (1.f + e1 + e2 + e3);
            const size_t m = (size_t)(mb + F.lane);
            *(i32x4g*)(TOPI + m * 4) = (i32x4g){ek[0], ek[1], ek[2], ek[3]};
            *(f32x4*)(GATE + m * 4) = (f32x4){inv, e1 * inv, e2 * inv, e3 * inv};
#pragma unroll
            for (int k = 0; k < 4; ++k) EK[F.lane * 4 + k] = ek[k];
        }
        asm volatile("s_waitcnt lgkmcnt(0)" ::: "memory");
        const int my_e = EK[F.lane];
        const int lrank = __hip_atomic_fetch_add(&hist[my_e], 1, __ATOMIC_RELAXED, __HIP_MEMORY_SCOPE_WORKGROUP);
        __syncthreads();
        if (F.tid < 32) BCNT[rb * 32 + F.tid] = hist[F.tid];
        RANK[((size_t)rb * 128 + F.wave * 16 + (F.lane >> 2)) * 4 + (F.lane & 3)] = lrank;
        __syncthreads();
    }
}

__device__ __forceinline__ void phase7(const Args& a, const Frame& F) {
    unsigned char* ws = a.ws;
    LAS int* starts = (LAS int*)F.lds;
    LAS int* part = (LAS int*)(F.lds + 1024);
    const int* BCNT = (const int*)(ws + WS_BCNT);
    int* TILEE = (int*)(ws + WS_TILEE); int* SLOTTOK = (int*)(ws + WS_SLOTTOK);
    { const int e = F.tid & 31, pt = F.tid >> 5; int tot = 0, below = 0;
#pragma unroll
      for (int i = 0; i < 16; ++i) { const int bb = 16 * pt + i; const int v = BCNT[bb * 32 + e]; tot += v; below += (bb < F.blk) ? v : 0; }
      part[pt * 64 + e] = tot; part[pt * 64 + 32 + e] = below; }
    __syncthreads();
    if (F.tid < 32) { int cnt = 0, bb = 0;
#pragma unroll
        for (int pt = 0; pt < 16; ++pt) { cnt += part[pt * 64 + F.tid]; bb += part[pt * 64 + 32 + F.tid]; }
        starts[64 + F.tid] = cnt; starts[32 + F.tid] = (cnt + 255) & ~255; starts[96 + F.tid] = bb; }
    __syncthreads();
    if (F.tid == 0) { int run = 0; for (int e = 0; e < 32; ++e) { starts[e] = run; run += starts[32 + e]; }
        if (F.blk == 0) { TILEE[1023] = run >> 8; for (int e = 0; e < 32; ++e) for (int tl = starts[e] >> 8; tl < (starts[e] + starts[32 + e]) >> 8; ++tl) TILEE[tl] = e; } }
    __syncthreads();
    if (F.blk == 0) { for (int e = 0; e < 32; ++e) for (int s = starts[e] + starts[64 + e] + F.tid; s < starts[e] + starts[32 + e]; s += NTHR) SLOTTOK[s] = 0; }
    const int* TOPI = (const int*)(ws + WS_TOPI); const int* RANK = (const int*)(ws + WS_RANK); int* TSLOT = (int*)(ws + WS_TSLOT);
    static_assert(MX * 4 == 256 * NTHR, "one (token, k) pair per thread; the tokens of workgroup b are row block b of P6");
    { const int q = F.blk * NTHR + F.tid; const int e = TOPI[q];
      const int slot = starts[e] + starts[96 + e] + RANK[q];
      TSLOT[q] = slot; SLOTTOK[slot] = q >> 2; }
}
__device__ __forceinline__ int moe_fill_table(const Args& a, const Frame& F, int nN, int RM) {
    LAS int* tab = (LAS int*)(F.lds + TAB_OFF);
    const unsigned* TILEE = (const unsigned*)(a.ws + WS_TILEE);
    if (F.tid == 0) {
        const int NT = (int)ld_agent(TILEE + 1023);
        const int x = F.blk & 7, j = F.blk >> 3; int n = 0;
        for (int i = 0; i < 64; ++i) { const int s = i * 8 + x, pm = s * RM + j / nN; if (pm >= NT) break;
            const int e = (int)ld_agent(TILEE + pm); tab[2 * n] = pm; tab[2 * n + 1] = e * nN + (j % nN); ++n; }
        tab[128] = n;
    }
    __syncthreads();
    return __builtin_amdgcn_readfirstlane(tab[128]);
}

__device__ __forceinline__ void p10_acc(float (&s)[16], int j, const v4u w, float g) {
    s[8 * j + 0] += g * bflo(w.x); s[8 * j + 1] += g * bfhi(w.x); s[8 * j + 2] += g * bflo(w.y); s[8 * j + 3] += g * bfhi(w.y);
    s[8 * j + 4] += g * bflo(w.z); s[8 * j + 5] += g * bfhi(w.z); s[8 * j + 6] += g * bflo(w.w); s[8 * j + 7] += g * bfhi(w.w);
}
typedef float f32x2 __attribute__((ext_vector_type(2)));
__device__ __forceinline__ void p10_acc8(float (&s)[16], int j, const v2u w, float g) {
    const f32x2 a0 = __builtin_amdgcn_cvt_pk_f32_fp8((int)w.x, false), a1 = __builtin_amdgcn_cvt_pk_f32_fp8((int)w.x, true);
    const f32x2 a2 = __builtin_amdgcn_cvt_pk_f32_fp8((int)w.y, false), a3 = __builtin_amdgcn_cvt_pk_f32_fp8((int)w.y, true);
    s[8 * j + 0] += g * a0.x; s[8 * j + 1] += g * a0.y; s[8 * j + 2] += g * a1.x; s[8 * j + 3] += g * a1.y;
    s[8 * j + 4] += g * a2.x; s[8 * j + 5] += g * a2.y; s[8 * j + 6] += g * a3.x; s[8 * j + 7] += g * a3.y;
}
__device__ __forceinline__ void phase10(const Args& a, const Frame& F) {
    unsigned char* ws = a.ws;
    const bf16* H1 = (const bf16*)(ws + WS_H1); const unsigned char* YS = ws + WS_YS;
    const int* TSLOT = (const int*)(ws + WS_TSLOT); const float* GATE = (const float*)(ws + WS_GATE);
    const int gw = F.blk * NWAVES + F.wave, NGW = F.G * NWAVES;
    f32x4 gv[4], bv[4];
#pragma unroll
    for (int q = 0; q < 4; ++q) { const int col = 8 * F.lane + 512 * (q >> 1) + 4 * (q & 1); gv[q] = *(const f32x4*)(a.in[I_LN2G] + col); bv[q] = *(const f32x4*)(a.in[I_LN2B] + col); }
    for (int m0 = gw; m0 < MX; m0 += 2 * NGW) {
        int mm[2]; mm[0] = m0; mm[1] = (m0 + NGW < MX) ? m0 + NGW : m0;
        int slot[2][4]; float gt[2][4]; v4u hw[2][2]; v2u yw[2][4][2];
#pragma unroll
        for (int r = 0; r < 2; ++r) {
#pragma unroll
            for (int k = 0; k < 4; ++k) { slot[r][k] = TSLOT[(size_t)mm[r] * 4 + k]; gt[r][k] = GATE[(size_t)mm[r] * 4 + k]; }
#pragma unroll
            for (int j = 0; j < 2; ++j) hw[r][j] = *(const v4u*)(H1 + (size_t)mm[r] * D + 8 * F.lane + 512 * j); }
#pragma unroll
        for (int r = 0; r < 2; ++r)
#pragma unroll
            for (int k = 0; k < 4; ++k)
#pragma unroll
                for (int j = 0; j < 2; ++j) yw[r][k][j] = *(const v2u*)(YS + (size_t)slot[r][k] * D + 8 * F.lane + 512 * j);
#pragma unroll
        for (int r = 0; r < 2; ++r) {
            float s[16];
#pragma unroll
            for (int i = 0; i < 16; ++i) s[i] = 0.f;
#pragma unroll
            for (int j = 0; j < 2; ++j) p10_acc(s, j, hw[r][j], ALPHA);
#pragma unroll
            for (int k = 0; k < 4; ++k)
#pragma unroll
                for (int j = 0; j < 2; ++j) p10_acc8(s, j, yw[r][k][j], gt[r][k]);
            float t = 0.f;
#pragma unroll
            for (int i = 0; i < 16; ++i) t += s[i];
            const float mean = wave_sum(t, F.lane) * (1.f / D); float q = 0.f;
#pragma unroll
            for (int i = 0; i < 16; ++i) { s[i] -= mean; q += s[i] * s[i]; }
            const float rstd = __builtin_amdgcn_rsqf(wave_sum(q, F.lane) * (1.f / D) + 1e-5f);
            if (r == 0 || mm[1] != mm[0]) {
#pragma unroll
                for (int q4 = 0; q4 < 4; ++q4) { const int col = 8 * F.lane + 512 * (q4 >> 1) + 4 * (q4 & 1);
                    f32x4 o; o.x = s[4 * q4 + 0] * rstd * gv[q4].x + bv[q4].x; o.y = s[4 * q4 + 1] * rstd * gv[q4].y + bv[q4].y; o.z = s[4 * q4 + 2] * rstd * gv[q4].z + bv[q4].z; o.w = s[4 * q4 + 3] * rstd * gv[q4].w + bv[q4].w;
                    *(f32x4*)(a.out + (size_t)mm[r] * D + col) = o; } }
        }
    }
}

template <int LO, int HI>
__global__ void __launch_bounds__(NTHR, 2) fwd(Args a) {
    extern __shared__ __attribute__((aligned(16))) unsigned char lds_raw[];
    LAS unsigned char* lds = (LAS unsigned char*)lds_raw;
    const int wave = __builtin_amdgcn_readfirstlane((int)(threadIdx.x >> 6));
    volatile LAS unsigned* MISC = (volatile LAS unsigned*)(lds + MISC_OFF);
    if (wave == 0) MISC[lane_id()] = 0u;
    __syncthreads();
    unsigned* ctl = (unsigned*)(a.ws + WS_CTL);
    XcdBarrier bar; bar.bar = ctl + CW_BAR; bar.x = 0; bar.st = nullptr;
    if constexpr (HI - LO > 1) bar = xcd_barrier_post(ctl + CW_BAR, MISC + 8, wave == 0 && lane_id() == 0);
#define PH(k) if constexpr (LO <= (k) && (k) < HI)
#define SEAM(k) if constexpr (LO <= (k) && (k) + 1 < HI) xcd_barrier(bar, wave == 0 && lane_id() == 0)
    PH(0) for (int rep_ = 0; rep_ < NREP(0); ++rep_) { const Frame F = mkframe(lds, wave); phase0(a, F); } SEAM(0);
    PH(1) for (int rep_ = 0; rep_ < NREP(1); ++rep_) { const Frame F = mkframe(lds, wave);
            pg8::Gemm g{(const pg8::bf16_t*)(a.ws + WS_A0), (const pg8::bf16_t*)(a.ws + WS_WIN), MX, PW, D}; pg8::StaticOrder S; S.init(MX, PW, F.G, F.blk);
            pg8::EpiBf16Plain E{(pg8::bf16_t*)(a.ws + WS_PROJ), PW};
            pg8::gemm_phase<pg8::EpiBf16Plain, pg8::StaticOrder, true, true>(F.lds, g, S, E, F.tid); } SEAM(1);
    PH(2) for (int rep_ = 0; rep_ < NREP(2); ++rep_) { const Frame F = mkframe(lds, wave); phase2(a, F); } SEAM(2);
    PH(3) { const Frame F = mkframe(lds, wave); phase3(a, F); } SEAM(3);
    PH(4) for (int rep_ = 0; rep_ < NREP(4); ++rep_) { const Frame F = mkframe(lds, wave); phase4(a, F); } SEAM(4);
    PH(5) for (int rep_ = 0; rep_ < NREP(5); ++rep_) { const Frame F = mkframe(lds, wave);
            pg8::Gemm g{(const pg8::bf16_t*)(a.ws + WS_YMIX), (const pg8::bf16_t*)(a.ws + WS_WOUT), MX, D, D}; pg8::StaticOrder S; S.init(MX, D, F.G, F.blk);
            pg8::EpiBf16Plain E{(pg8::bf16_t*)(a.ws + WS_MIXB), D};
            pg8::gemm_phase<pg8::EpiBf16Plain, pg8::StaticOrder, true, true>(F.lds, g, S, E, F.tid); } SEAM(5);
    PH(6) for (int rep_ = 0; rep_ < NREP(6); ++rep_) { const Frame F = mkframe(lds, wave); phase6(a, F, rep_); } SEAM(6);
    PH(7) for (int rep_ = 0; rep_ < NREP(7); ++rep_) { const Frame F = mkframe(lds, wave); phase7(a, F); } SEAM(7);
    PH(8) for (int rep_ = 0; rep_ < NREP(8); ++rep_) { const Frame F = mkframe(lds, wave); const int n = moe_fill_table(a, F, 8, 4);
            pg8::Gemm g{(const pg8::bf16_t*)(a.ws + WS_H1Q), (const pg8::bf16_t*)(a.ws + WS_WUP), 0, 0, D / 2}; pg8::TableOrder S{(const LAS int*)(F.lds + TAB_OFF), n};
            pg8::EpiSwiglu8 E{a.ws + WS_ACT, a.in[I_BUP]};
            pg8::gemm_phase_g<pg8::EpiSwiglu8, pg8::TableOrder, true, true, 121>(F.lds, g, S, E, F.tid, (const int*)(a.ws + WS_SLOTTOK)); } SEAM(8);
    PH(9) for (int rep_ = 0; rep_ < NREP(9); ++rep_) { const Frame F = mkframe(lds, wave); const int n = moe_fill_table(a, F, 4, 8);
            pg8::Gemm g{(const pg8::bf16_t*)(a.ws + WS_ACT), (const pg8::bf16_t*)(a.ws + WS_WDN), 0, 0, D / 2}; pg8::TableOrder S{(const LAS int*)(F.lds + TAB_OFF), n};
            pg8::EpiDown8 E{a.ws + WS_YS, a.in[I_BDN]};
            pg8::gemm_phase<pg8::EpiDown8, pg8::TableOrder, true, true, 120>(F.lds, g, S, E, F.tid); } SEAM(9);
    PH(10) for (int rep_ = 0; rep_ < NREP(10); ++rep_) { const Frame F = mkframe(lds, wave); phase10(a, F); }
#undef PH
#undef SEAM
}

#ifndef MK_SINGLE
#define MK_SINGLE 1
#endif
template <int LO, int HI> static void launch_range(const Args& a, int grid, hipStream_t stream) {
    static bool attr = false;
    if (!attr) { (void)hipFuncSetAttribute((const void*)fwd<LO, HI>, hipFuncAttributeMaxDynamicSharedMemorySize, LDS_BYTES); attr = true; }
    hipLaunchKernelGGL((fwd<LO, HI>), dim3(grid), dim3(NTHR), LDS_BYTES, stream, a);
}
extern "C" void kernel_launch(void* const* d_in, const int* in_sizes, int n_in, void* d_out, int out_size, void* d_ws, size_t ws_size, hipStream_t stream) {
    if (n_in != 30 || ws_size < WS_END) { fprintf(stderr, "kernel_launch: unexpected inputs (n_in %d, ws %zu)\n", n_in, ws_size); return; }
    const int grid = 256;
    (void)hipMemsetAsync((char*)d_ws + WS_CTL, 0, CTL_ZERO_BYTES, stream);
    Args a{};
    for (int i = 0; i < 30; ++i) a.in[i] = (const float*)d_in[i];
    a.out = (float*)d_out; a.ws = (unsigned char*)d_ws;
#if MK_SINGLE
    launch_range<0, 11>(a, grid, stream);
#else
    launch_range<0, 1>(a, grid, stream); launch_range<1, 2>(a, grid, stream); launch_range<2, 3>(a, grid, stream); launch_range<3, 4>(a, grid, stream);
    launch_range<4, 5>(a, grid, stream); launch_range<5, 6>(a, grid, stream); launch_range<6, 7>(a, grid, stream); launch_range<7, 8>(a, grid, stream);
    launch_range<8, 9>(a, grid, stream); launch_range<9, 10>(a, grid, stream); launch_range<10, 11>(a, grid, stream);
#endif
}
```

```cpp
#include <hip/hip_runtime.h>
#include <cstdio>
#include <cstdint>
#include <cmath>
namespace pg8 {
#define PG8_LAS __attribute__((address_space(3)))
typedef unsigned short bf16_t;
typedef short bf16x8 __attribute__((ext_vector_type(8)));
typedef float f32x4 __attribute__((ext_vector_type(4)));
typedef unsigned u32x4 __attribute__((ext_vector_type(4)));
constexpr int BM = 256, BK = 64, HALF = 128, HTB = HALF * BK * 2  , STAGE_BYTES = 8 * HTB, NXCD = 8, WGM = 8;

__host__ __device__ __forceinline__ int lds_byte(int r, int c) { const int ob = c * 2, rr = r & 7; return (r >> 3) * 1024 + rr * 128 + ((((ob >> 4) ^ rr) & 7) << 4) + (ob & 15); }
__host__ __device__ __forceinline__ void stage_rc(int b, int& R, int& C) { const int P = b / 1024, sb = b % 1024, rr = sb >> 7, ch = (sb >> 4) & 7; R = P * 8 + rr; C = (((ch ^ rr) << 4) + (sb & 15)) >> 1; }
__host__ __device__ __forceinline__ int perm32(int rho) { const int n = rho >> 4, i = rho & 15; return 8 * (i >> 2) + 4 * n + (i & 3); }

struct Unit { int pm, pn; };
struct Gemm { const bf16_t* A; const bf16_t* Bt; int M, N, K; };

struct StaticOrder {
    int nM, nN, nwg, G, c;
    __host__ __device__ void init(int M, int N, int G_, int c_) { nM = M / BM; nN = N / BM; nwg = nM * nN; G = G_; c = c_; }
    __host__ __device__ bool next(int i, Unit& u) const {
        const long L = (long)i * G + c; if (L >= nwg) return false;
        int wgid = (int)L; { const int q = nwg / NXCD, r = nwg % NXCD, xcd = wgid % NXCD, off = wgid / NXCD; wgid = (xcd < r ? xcd * (q + 1) : r * (q + 1) + (xcd - r) * q) + off; }
        const int nig = WGM * nN, gid = wgid / nig, fm = gid * WGM, gsz = (nM - fm) < WGM ? (nM - fm) : WGM;
        u.pm = fm + ((wgid % nig) % gsz); u.pn = (wgid % nig) / gsz; return true;
    }
    __device__ __forceinline__ void a_ready(const Unit&) const {}
    __device__ __forceinline__ void done(const Unit&) const {}
};


__device__ __forceinline__ unsigned cvt_pk_bf16(float lo, float hi) { unsigned r; asm volatile("v_cvt_pk_bf16_f32 %0, %1, %2" : "=v"(r) : "v"(lo), "v"(hi)); return r; }
typedef unsigned u32x2 __attribute__((ext_vector_type(2)));
typedef int i32x8 __attribute__((ext_vector_type(8))); typedef int i32x4 __attribute__((ext_vector_type(4)));
__device__ __forceinline__ void mfma_f8(f32x4& acc, i32x8 a, i32x8 b, int sa, int sb) {
    asm volatile("s_nop 1\n\tv_mfma_scale_f32_16x16x128_f8f6f4 %0, %1, %2, %0, %3, %4 op_sel_hi:[0,0,0]" : "+v"(acc) : "v"(a), "v"(b), "v"(sa), "v"(sb));
}
__device__ __forceinline__ i32x8 cat8(bf16x8 lo, bf16x8 hi) { const i32x4 a = __builtin_bit_cast(i32x4, lo), b = __builtin_bit_cast(i32x4, hi); return __builtin_shufflevector(a, b, 0, 1, 2, 3, 4, 5, 6, 7); }

struct EpiBf16Plain {
    static constexpr bool PERM = true, AFTER_DRAIN = false, HAS_BIAS = false;
    bf16_t* O; int ldc;
    __device__ __forceinline__ const float* bias_ptr(const Unit&) const { return nullptr; }
    __device__ __forceinline__ void operator()(const f32x4 (&acc)[2][2][4][2], const Unit& u, int wr, int wc, int fr, int fq, const PG8_LAS float*) const {
        const int row0 = u.pm * BM + wr * 64 + fr, col0 = u.pn * BM + wc * 32 + 8 * fq;
#pragma unroll
        for (int ai = 0; ai < 2; ++ai)
#pragma unroll
            for (int m = 0; m < 4; ++m) { bf16_t* rowp = O + (size_t)(row0 + ai * HALF + m * 16) * ldc + col0;
#pragma unroll
                for (int bj = 0; bj < 2; ++bj) { const f32x4 v0 = acc[ai][bj][m][0], v1 = acc[ai][bj][m][1];
                    u32x4 w; w.x = cvt_pk_bf16(v0[0], v0[1]); w.y = cvt_pk_bf16(v0[2], v0[3]); w.z = cvt_pk_bf16(v1[0], v1[1]); w.w = cvt_pk_bf16(v1[2], v1[3]);
                    *(u32x4*)(rowp + bj * HALF) = w; } }
    }
};

__device__ __forceinline__ float swiglu1(float glu, float lin) {
    const float xg = fminf(glu, 7.0f), xl = fminf(fmaxf(lin, -7.0f), 7.0f);
    const float sg = __builtin_amdgcn_rcpf(1.0f + __expf(-1.702f * xg));
    return xg * sg * (xl + 1.0f);
}
struct EpiSwiglu8 {
    static constexpr bool PERM = true, AFTER_DRAIN = false, HAS_BIAS = true;
    unsigned char* ACT; const float* bup;
    __device__ __forceinline__ const float* bias_ptr(const Unit& u) const { return bup + (size_t)(u.pn >> 3) * 2048 + (u.pn & 7) * BM; }
    __device__ __forceinline__ void operator()(const f32x4 (&acc)[2][2][4][2], const Unit& u, int wr, int wc, int fr, int fq, const PG8_LAS float* bl) const {
        const int pn = u.pn & 7;
        const int row0 = u.pm * BM + wr * 64 + fr, ucol0 = pn * BM + wc * 32 + 8 * fq, acol0 = ucol0 >> 1;
        f32x4 bv[2][2];
#pragma unroll
        for (int bj = 0; bj < 2; ++bj)
#pragma unroll
            for (int n = 0; n < 2; ++n) bv[bj][n] = *(const PG8_LAS f32x4*)(bl + wc * 32 + 8 * fq + bj * HALF + 4 * n);
#pragma unroll
        for (int ai = 0; ai < 2; ++ai)
#pragma unroll
            for (int m = 0; m < 4; ++m) { unsigned char* rowp = ACT + (size_t)(row0 + ai * HALF + m * 16) * 1024 + acol0;
#pragma unroll
                for (int bj = 0; bj < 2; ++bj) { const f32x4 v0 = acc[ai][bj][m][0] + bv[bj][0], v1 = acc[ai][bj][m][1] + bv[bj][1];
                    int w = __builtin_amdgcn_cvt_pk_fp8_f32(swiglu1(v0[0], v0[1]), swiglu1(v0[2], v0[3]), 0, false);
                    w = __builtin_amdgcn_cvt_pk_fp8_f32(swiglu1(v1[0], v1[1]), swiglu1(v1[2], v1[3]), w, true);
                    *(int*)(rowp + bj * (HALF / 2)) = w; } }
    }
};
struct EpiDown8 {
    static constexpr bool PERM = true, AFTER_DRAIN = false, HAS_BIAS = true;
    unsigned char* YS; const float* bdn;
    __device__ __forceinline__ const float* bias_ptr(const Unit& u) const { return bdn + (size_t)(u.pn >> 2) * 1024 + (u.pn & 3) * BM; }
    __device__ __forceinline__ void operator()(const f32x4 (&acc)[2][2][4][2], const Unit& u, int wr, int wc, int fr, int fq, const PG8_LAS float* bl) const {
        const int pn = u.pn & 3;
        const int row0 = u.pm * BM + wr * 64 + fr, col0 = pn * BM + wc * 32 + 8 * fq;
        f32x4 bv[2][2];
#pragma unroll
        for (int bj = 0; bj < 2; ++bj)
#pragma unroll
            for (int n = 0; n < 2; ++n) bv[bj][n] = *(const PG8_LAS f32x4*)(bl + wc * 32 + 8 * fq + bj * HALF + 4 * n);
#pragma unroll
        for (int ai = 0; ai < 2; ++ai)
#pragma unroll
            for (int m = 0; m < 4; ++m) { unsigned char* rowp = YS + (size_t)(row0 + ai * HALF + m * 16) * 1024 + col0;
#pragma unroll
                for (int bj = 0; bj < 2; ++bj) { const f32x4 v0 = acc[ai][bj][m][0] + bv[bj][0], v1 = acc[ai][bj][m][1] + bv[bj][1];
                    int w0 = __builtin_amdgcn_cvt_pk_fp8_f32(v0[0], v0[1], 0, false); w0 = __builtin_amdgcn_cvt_pk_fp8_f32(v0[2], v0[3], w0, true);
                    int w1 = __builtin_amdgcn_cvt_pk_fp8_f32(v1[0], v1[1], 0, false); w1 = __builtin_amdgcn_cvt_pk_fp8_f32(v1[2], v1[3], w1, true);
                    u32x2 w; w.x = (unsigned)w0; w.y = (unsigned)w1;
                    *(u32x2*)(rowp + bj * HALF) = w; } }
    }
};
struct TableOrder {
    const PG8_LAS int* tab; int n;
    __device__ __forceinline__ bool next(int i, Unit& u) const {
        if (i >= n) return false;
        u.pm = __builtin_amdgcn_readfirstlane(tab[2 * i]); u.pn = __builtin_amdgcn_readfirstlane(tab[2 * i + 1]); return true;
    }
    __device__ __forceinline__ void a_ready(const Unit&) const {}
    __device__ __forceinline__ void done(const Unit&) const {}
};

constexpr int ROWS_LDS = 131072;
constexpr int BIAS_LDS = 133120;
template <class Epi, class Sched, bool ALIGN_EPI = false, bool SP2 = false, int SCW = 0>
__device__ __forceinline__ void gemm_phase(PG8_LAS unsigned char* lds, const Gemm g, const Sched& S, const Epi& E, const int tid) {
    static_assert(SP2, "two-super-phase form only");
    const int wid = __builtin_amdgcn_readfirstlane(tid >> 6), lane = tid & 63, wr = wid >> 2, wc = wid & 3, fr = lane & 15, fq = lane >> 4;
    int K_ = g.K; asm volatile("" : "+s"(K_));
    const int K = K_, nt = K / BK;
    constexpr int EXTRA = 16 + (Epi::HAS_BIAS ? 1 : 0);
    unsigned voffA, voffB;
    { int R, C; stage_rc(tid * 16, R, C); const int Rb = Epi::PERM ? ((R & ~31) + perm32(R & 31)) : R;
      voffA = (unsigned)(R * K + C) * 2u; voffB = (unsigned)(Rb * K + C) * 2u; }
    const size_t qstep = (size_t)64 * K * 2;
    const size_t kstep = (size_t)(BK * 2);
    const size_t hstep = (size_t)HALF * K * 2;
    const size_t tstep = 2 * hstep;
    const unsigned ldsw = (unsigned)wid * 1024u;
    const int aoff = lds_byte(wr * 64 + fr, fq * 8), boff = lds_byte(wc * 32 + fr, fq * 8);
#define PG8_SA(b, h) (((b) * 2 + (h)) * HTB)
#define PG8_SB(b, h) ((4 + (b) * 2 + (h)) * HTB)
#define PG8_STAGE(bufoff, gbase, voff) do { _Pragma("unroll") for (int _i = 0; _i < 2; ++_i) { const char* _g = (const char*)(gbase) + (size_t)_i * qstep; asm volatile("" : "+s"(_g)); \
        __builtin_amdgcn_global_load_lds((const unsigned*)(_g + (voff)), (PG8_LAS unsigned*)(lds + (bufoff) + ldsw + _i * 8192), 16, 0, 0); } } while (0)
#define PG8_STAGE2(bufoff, gbase, voff) do { const char* _g = (const char*)(gbase); asm volatile("" : "+s"(_g)); _Pragma("unroll") for (int _i = 0; _i < 2; ++_i) \
        __builtin_amdgcn_global_load_lds((const unsigned*)(_g + (voff)[_i]), (PG8_LAS unsigned*)(lds + (bufoff) + ldsw + _i * 8192), 16, 0, 0); } while (0)
#define PG8_LDA(dst, b, h) do { int _x; asm volatile("v_xor_b32 %0, 64, %1" : "=v"(_x) : "v"(aoff)); _Pragma("unroll") for (int m = 0; m < 4; ++m) _Pragma("unroll") for (int k = 0; k < 2; ++k) dst[m][k] = *(const PG8_LAS bf16x8*)(lds + PG8_SA(b, h) + (k ? _x : aoff) + m * 2048); } while (0)
#define PG8_LDB(dst, b, h) do { int _x; asm volatile("v_xor_b32 %0, 64, %1" : "=v"(_x) : "v"(boff)); _Pragma("unroll") for (int n = 0; n < 2; ++n) _Pragma("unroll") for (int k = 0; k < 2; ++k) dst[n][k] = *(const PG8_LAS bf16x8*)(lds + PG8_SB(b, h) + (k ? _x : boff) + n * 2048); } while (0)
#define PG8_MMA(ai, bj, At, Bt) do { __builtin_amdgcn_s_setprio(1); _Pragma("unroll") for (int m = 0; m < 4; ++m) _Pragma("unroll") for (int n = 0; n < 2; ++n) { \
        if constexpr (SCW != 0) mfma_f8(acc[ai][bj][m][n], cat8(Bt[n][0], Bt[n][1]), cat8(At[m][0], At[m][1]), SCW * 0x01010101, 0x7f7f7f7f); \
        else { _Pragma("unroll") for (int k = 0; k < 2; ++k) acc[ai][bj][m][n] = __builtin_amdgcn_mfma_f32_16x16x32_bf16(Bt[n][k], At[m][k], acc[ai][bj][m][n], 0, 0, 0); } } __builtin_amdgcn_s_setprio(0); } while (0)
#define PG8_WAIT_V(n) asm volatile("s_waitcnt vmcnt(" #n ")" ::: "memory")
#define PG8_WAIT_VX(aft_) do { if (aft_) asm volatile("s_waitcnt vmcnt(%0)" :: "i"(8 + EXTRA) : "memory"); else asm volatile("s_waitcnt vmcnt(8)" ::: "memory"); } while (0)
#define PG8_WAIT_L(n) asm volatile("s_waitcnt lgkmcnt(" #n ")" ::: "memory")
#define PG8_BAR __builtin_amdgcn_s_barrier()
#define PG8_SCHED __builtin_amdgcn_sched_barrier(0)
#define PG8_BIAS(u_) do { if constexpr (Epi::HAS_BIAS) __builtin_amdgcn_global_load_lds((const unsigned*)(E.bias_ptr(u_) + 4 * lane), (PG8_LAS unsigned*)(lds + BIAS_LDS + wid * 1024), 16, 0, 0); } while (0)
    Unit cur, nxt; int ui = 0;
    if (!S.next(0, cur)) return;
    f32x4 acc[2][2][4][2];
#pragma unroll
    for (int a = 0; a < 2; ++a)
#pragma unroll
        for (int b = 0; b < 2; ++b)
#pragma unroll
            for (int m = 0; m < 4; ++m)
#pragma unroll
                for (int n = 0; n < 2; ++n) acc[a][b][m][n] = (f32x4){0.f, 0.f, 0.f, 0.f};
    bf16x8 At[4][2], B0[2][2], B1[2][2];
    const PG8_LAS float* biasl = (const PG8_LAS float*)(lds + BIAS_LDS + wid * 1024);
    PG8_BIAS(cur);
    const char* cA = (const char*)g.A + (size_t)cur.pm * tstep; const char* cB = (const char*)g.Bt + (size_t)cur.pn * tstep;
    S.a_ready(cur);
    PG8_STAGE(PG8_SB(0, 0), cB, voffB); PG8_STAGE(PG8_SB(0, 1), cB + hstep, voffB); PG8_STAGE(PG8_SA(0, 0), cA, voffA); PG8_STAGE(PG8_SA(0, 1), cA + hstep, voffA);
    if (wr == 1) PG8_BAR;
    PG8_WAIT_V(2); PG8_BAR;
    PG8_STAGE(PG8_SB(1, 0), cB + kstep, voffB); PG8_STAGE(PG8_SA(1, 0), cA + kstep, voffA); PG8_STAGE(PG8_SB(1, 1), cB + hstep + kstep, voffB); PG8_STAGE(PG8_SA(1, 1), cA + hstep + kstep, voffA);
    PG8_WAIT_V(8); PG8_BAR;
    for (;;) {
        const bool has_next = S.next(ui + 1, nxt);
        const char* nA = has_next ? (const char*)g.A + (size_t)nxt.pm * tstep : cA; const char* nB = has_next ? (const char*)g.Bt + (size_t)nxt.pn * tstep : cB;
        for (int t = 0; t < nt; t += 2) {
            const bool last = (t == nt - 2);
            const bool aft = (t == 0) && (ui > 0);
            const char* a1 = cA + (size_t)(t + 1) * kstep;
            const char* a2 = last ? nA : cA + (size_t)(t + 2) * kstep; const char* b2 = last ? nB : cB + (size_t)(t + 2) * kstep;
            const char* a3 = a2 + kstep; const char* b3 = b2 + kstep;
            if (last && has_next) S.a_ready(nxt);
            PG8_LDB(B0, 0, 0); PG8_LDB(B1, 0, 1); PG8_SCHED; PG8_LDA(At, 0, 0); if (t > 0) PG8_STAGE(PG8_SA(1, 1), a1 + hstep, voffA);
            PG8_WAIT_VX(aft); PG8_WAIT_L(0); PG8_BAR; PG8_MMA(0, 0, At, B0); PG8_MMA(0, 1, At, B1); PG8_BAR; PG8_SCHED;
            PG8_LDA(At, 0, 1); PG8_STAGE(PG8_SB(0, 0), b2, voffB); PG8_STAGE(PG8_SB(0, 1), b2 + hstep, voffB); PG8_STAGE(PG8_SA(0, 0), a2, voffA);
            PG8_WAIT_VX(aft); PG8_WAIT_L(0); PG8_BAR; PG8_MMA(1, 0, At, B0); PG8_MMA(1, 1, At, B1); PG8_BAR; PG8_SCHED;
            PG8_LDB(B0, 1, 0); PG8_LDB(B1, 1, 1); PG8_SCHED; PG8_LDA(At, 1, 0); PG8_STAGE(PG8_SA(0, 1), a2 + hstep, voffA);
            PG8_WAIT_VX(aft); PG8_WAIT_L(0); PG8_BAR; PG8_MMA(0, 0, At, B0); PG8_MMA(0, 1, At, B1); PG8_BAR; PG8_SCHED;
            PG8_LDA(At, 1, 1); PG8_STAGE(PG8_SB(1, 0), b3, voffB); PG8_STAGE(PG8_SB(1, 1), b3 + hstep, voffB); PG8_STAGE(PG8_SA(1, 0), a3, voffA);
            PG8_WAIT_V(8); PG8_WAIT_L(0); PG8_BAR; PG8_MMA(1, 0, At, B0); PG8_MMA(1, 1, At, B1); PG8_BAR; PG8_SCHED;
        }
        if (has_next) { PG8_STAGE(PG8_SA(1, 1), nA + hstep + kstep, voffA); }
        asm volatile("" ::: "memory"); PG8_SCHED;
        if constexpr (SCW != 0) asm volatile("s_nop 15\n\ts_nop 15" ::: "memory");
        if constexpr (ALIGN_EPI) { if (wr == 0) PG8_BAR; }
        E(acc, cur, wr, wc, fr, fq, biasl); S.done(cur);
        if (!has_next) break;
#pragma unroll
            for (int a = 0; a < 2; ++a)
#pragma unroll
            for (int b = 0; b < 2; ++b)
#pragma unroll
                for (int m = 0; m < 4; ++m)
#pragma unroll
                    for (int n = 0; n < 2; ++n) acc[a][b][m][n] = (f32x4){0.f, 0.f, 0.f, 0.f};
        cur = nxt; cA = nA; cB = nB; ++ui;
        asm volatile("s_waitcnt lgkmcnt(0)" ::: "memory");
        PG8_BIAS(cur);
        if constexpr (ALIGN_EPI) { if (wr == 1) PG8_BAR; }
    }
    PG8_WAIT_V(0);
    if constexpr (!ALIGN_EPI) { if (wr == 0) PG8_BAR; }
    PG8_BAR;
#undef PG8_SA
#undef PG8_SB
#undef PG8_STAGE
#undef PG8_STAGE2
#undef PG8_LDA
#undef PG8_LDB
#undef PG8_MMA
#undef PG8_WAIT_V
#undef PG8_WAIT_VX
#undef PG8_WAIT_L
#undef PG8_BAR
#undef PG8_SCHED
#undef PG8_BIAS
}
template <class Epi, class Sched, bool ALIGN_EPI = false, bool SP2 = false, int SCW = 0>
__device__ __forceinline__ void gemm_phase_g(PG8_LAS unsigned char* lds, const Gemm g, const Sched& S, const Epi& E, const int tid, const int* rowmap) {
    static_assert(SP2, "two-super-phase form only");
    const int wid = __builtin_amdgcn_readfirstlane(tid >> 6), lane = tid & 63, wr = wid >> 2, wc = wid & 3, fr = lane & 15, fq = lane >> 4;
    int K_ = g.K; asm volatile("" : "+s"(K_));
    const int K = K_, nt = K / BK;
    constexpr int EXTRA = 16 + (Epi::HAS_BIAS ? 1 : 0) + 1;
    unsigned voffB, cv0[2], cv1[2]; int RA0, CA0;
    { int R, C; stage_rc(tid * 16, R, C); const int Rb = Epi::PERM ? ((R & ~31) + perm32(R & 31)) : R;
      RA0 = R; CA0 = C; voffB = (unsigned)(Rb * K + C) * 2u; }
    const size_t qstep = (size_t)64 * K * 2;
    const size_t kstep = (size_t)(BK * 2);
    const size_t hstep = (size_t)HALF * K * 2;
    const size_t tstep = 2 * hstep;
    const unsigned ldsw = (unsigned)wid * 1024u;
    const int aoff = lds_byte(wr * 64 + fr, fq * 8), boff = lds_byte(wc * 32 + fr, fq * 8);
#define PG8_SA(b, h) (((b) * 2 + (h)) * HTB)
#define PG8_SB(b, h) ((4 + (b) * 2 + (h)) * HTB)
#define PG8_STAGE(bufoff, gbase, voff) do { _Pragma("unroll") for (int _i = 0; _i < 2; ++_i) { const char* _g = (const char*)(gbase) + (size_t)_i * qstep; asm volatile("" : "+s"(_g)); \
        __builtin_amdgcn_global_load_lds((const unsigned*)(_g + (voff)), (PG8_LAS unsigned*)(lds + (bufoff) + ldsw + _i * 8192), 16, 0, 0); } } while (0)
#define PG8_STAGE2(bufoff, gbase, voff) do { const char* _g = (const char*)(gbase); asm volatile("" : "+s"(_g)); _Pragma("unroll") for (int _i = 0; _i < 2; ++_i) \
        __builtin_amdgcn_global_load_lds((const unsigned*)(_g + (voff)[_i]), (PG8_LAS unsigned*)(lds + (bufoff) + ldsw + _i * 8192), 16, 0, 0); } while (0)
#define PG8_LDA(dst, b, h) do { int _x; asm volatile("v_xor_b32 %0, 64, %1" : "=v"(_x) : "v"(aoff)); _Pragma("unroll") for (int m = 0; m < 4; ++m) _Pragma("unroll") for (int k = 0; k < 2; ++k) dst[m][k] = *(const PG8_LAS bf16x8*)(lds + PG8_SA(b, h) + (k ? _x : aoff) + m * 2048); } while (0)
#define PG8_LDB(dst, b, h) do { int _x; asm volatile("v_xor_b32 %0, 64, %1" : "=v"(_x) : "v"(boff)); _Pragma("unroll") for (int n = 0; n < 2; ++n) _Pragma("unroll") for (int k = 0; k < 2; ++k) dst[n][k] = *(const PG8_LAS bf16x8*)(lds + PG8_SB(b, h) + (k ? _x : boff) + n * 2048); } while (0)
#define PG8_MMA(ai, bj, At, Bt) do { __builtin_amdgcn_s_setprio(1); _Pragma("unroll") for (int m = 0; m < 4; ++m) _Pragma("unroll") for (int n = 0; n < 2; ++n) { \
        if constexpr (SCW != 0) mfma_f8(acc[ai][bj][m][n], cat8(Bt[n][0], Bt[n][1]), cat8(At[m][0], At[m][1]), SCW * 0x01010101, 0x7f7f7f7f); \
        else { _Pragma("unroll") for (int k = 0; k < 2; ++k) acc[ai][bj][m][n] = __builtin_amdgcn_mfma_f32_16x16x32_bf16(Bt[n][k], At[m][k], acc[ai][bj][m][n], 0, 0, 0); } } __builtin_amdgcn_s_setprio(0); } while (0)
#define PG8_WAIT_V(n) asm volatile("s_waitcnt vmcnt(" #n ")" ::: "memory")
#define PG8_WAIT_VX(aft_) do { if (aft_) asm volatile("s_waitcnt vmcnt(%0)" :: "i"(8 + EXTRA) : "memory"); else asm volatile("s_waitcnt vmcnt(8)" ::: "memory"); } while (0)
#define PG8_WAIT_L(n) asm volatile("s_waitcnt lgkmcnt(" #n ")" ::: "memory")
#define PG8_BAR __builtin_amdgcn_s_barrier()
#define PG8_SCHED __builtin_amdgcn_sched_barrier(0)
#define PG8_BIAS(u_) do { if constexpr (Epi::HAS_BIAS) __builtin_amdgcn_global_load_lds((const unsigned*)(E.bias_ptr(u_) + 4 * lane), (PG8_LAS unsigned*)(lds + BIAS_LDS + wid * 1024), 16, 0, 0); } while (0)
    Unit cur, nxt; int ui = 0;
    if (!S.next(0, cur)) return;
    f32x4 acc[2][2][4][2];
#pragma unroll
    for (int a = 0; a < 2; ++a)
#pragma unroll
        for (int b = 0; b < 2; ++b)
#pragma unroll
            for (int m = 0; m < 4; ++m)
#pragma unroll
                for (int n = 0; n < 2; ++n) acc[a][b][m][n] = (f32x4){0.f, 0.f, 0.f, 0.f};
    bf16x8 At[4][2], B0[2][2], B1[2][2];
    const PG8_LAS float* biasl = (const PG8_LAS float*)(lds + BIAS_LDS + wid * 1024);
    PG8_BIAS(cur);
    const char* gA = (const char*)g.A; const char* cB = (const char*)g.Bt + (size_t)cur.pn * tstep;
    const PG8_LAS int* rowsl = (const PG8_LAS int*)(lds + ROWS_LDS);
#define PG8_ROWDMA(pm_) __builtin_amdgcn_global_load_lds((const unsigned*)(rowmap + (pm_) * BM + 4 * lane), (PG8_LAS unsigned*)(lds + ROWS_LDS), 16, 0, 0)
#define PG8_ROWS(v0_, v1_) do { _Pragma("unroll") for (int _i = 0; _i < 2; ++_i) { v0_[_i] = (unsigned)(rowsl[RA0 + 64 * _i] * K + CA0) * 2u; v1_[_i] = (unsigned)(rowsl[HALF + RA0 + 64 * _i] * K + CA0) * 2u; } } while (0)
    PG8_ROWDMA(cur.pm); PG8_WAIT_V(0);
    PG8_ROWS(cv0, cv1); PG8_WAIT_L(0);
    S.a_ready(cur);
    PG8_STAGE(PG8_SB(0, 0), cB, voffB); PG8_STAGE(PG8_SB(0, 1), cB + hstep, voffB); PG8_STAGE2(PG8_SA(0, 0), gA, cv0); PG8_STAGE2(PG8_SA(0, 1), gA, cv1);
    if (wr == 1) PG8_BAR;
    PG8_WAIT_V(2); PG8_BAR;
    PG8_STAGE(PG8_SB(1, 0), cB + kstep, voffB); PG8_STAGE2(PG8_SA(1, 0), gA + kstep, cv0); PG8_STAGE(PG8_SB(1, 1), cB + hstep + kstep, voffB); PG8_STAGE2(PG8_SA(1, 1), gA + kstep, cv1);
    PG8_WAIT_V(8); PG8_BAR;
    for (;;) {
        const bool has_next = S.next(ui + 1, nxt);
        const char* nB = has_next ? (const char*)g.Bt + (size_t)nxt.pn * tstep : cB;
        PG8_ROWDMA(has_next ? nxt.pm : cur.pm);
        unsigned w0[2] = {cv0[0], cv0[1]}, w1[2] = {cv1[0], cv1[1]};
        for (int t = 0; t < nt; t += 2) {
            const bool last = (t == nt - 2);
            const bool aft = (t == 0) && (ui > 0);
            const char* a1 = gA + (size_t)(t + 1) * kstep;
            const char* a2 = last ? gA : gA + (size_t)(t + 2) * kstep; const char* b2 = last ? nB : cB + (size_t)(t + 2) * kstep;
            const char* a3 = a2 + kstep; const char* b3 = b2 + kstep;
            if (last && has_next) S.a_ready(nxt);
            PG8_LDB(B0, 0, 0); PG8_LDB(B1, 0, 1); PG8_SCHED; PG8_LDA(At, 0, 0); if (t > 0) PG8_STAGE2(PG8_SA(1, 1), a1, cv1);
            PG8_WAIT_VX(aft); PG8_WAIT_L(0); PG8_BAR; PG8_MMA(0, 0, At, B0); PG8_MMA(0, 1, At, B1); PG8_BAR; PG8_SCHED;
            PG8_LDA(At, 0, 1); PG8_STAGE(PG8_SB(0, 0), b2, voffB); PG8_STAGE(PG8_SB(0, 1), b2 + hstep, voffB); PG8_STAGE2(PG8_SA(0, 0), a2, w0);
            PG8_WAIT_VX(aft); PG8_WAIT_L(0); PG8_BAR; PG8_MMA(1, 0, At, B0); PG8_MMA(1, 1, At, B1); PG8_BAR; PG8_SCHED;
            PG8_LDB(B0, 1, 0); PG8_LDB(B1, 1, 1); PG8_SCHED; PG8_LDA(At, 1, 0); PG8_STAGE2(PG8_SA(0, 1), a2, w1);
            PG8_WAIT_VX(aft); PG8_WAIT_L(0); PG8_BAR; PG8_MMA(0, 0, At, B0); PG8_MMA(0, 1, At, B1); PG8_BAR; PG8_SCHED;
            PG8_LDA(At, 1, 1); PG8_STAGE(PG8_SB(1, 0), b3, voffB); PG8_STAGE(PG8_SB(1, 1), b3 + hstep, voffB); PG8_STAGE2(PG8_SA(1, 0), a3, w0);
            PG8_WAIT_V(8); PG8_WAIT_L(0); PG8_BAR; PG8_MMA(1, 0, At, B0); PG8_MMA(1, 1, At, B1); PG8_BAR; PG8_SCHED;
            if (t + 4 == nt) { PG8_ROWS(w0, w1); }
        }
        if (has_next) { PG8_STAGE2(PG8_SA(1, 1), gA + kstep, w1); }
        asm volatile("" ::: "memory"); PG8_SCHED;
        if constexpr (SCW != 0) asm volatile("s_nop 15\n\ts_nop 15" ::: "memory");
        if constexpr (ALIGN_EPI) { if (wr == 0) PG8_BAR; }
        E(acc, cur, wr, wc, fr, fq, biasl); S.done(cur);
        if (!has_next) break;
#pragma unroll
            for (int a = 0; a < 2; ++a)
#pragma unroll
            for (int b = 0; b < 2; ++b)
#pragma unroll
                for (int m = 0; m < 4; ++m)
#pragma unroll
                    for (int n = 0; n < 2; ++n) acc[a][b][m][n] = (f32x4){0.f, 0.f, 0.f, 0.f};
        cur = nxt; cB = nB; ++ui; cv0[0] = w0[0]; cv0[1] = w0[1]; cv1[0] = w1[0]; cv1[1] = w1[1];
        asm volatile("s_waitcnt lgkmcnt(0)" ::: "memory");
        PG8_BIAS(cur);
        if constexpr (ALIGN_EPI) { if (wr == 1) PG8_BAR; }
    }
    PG8_WAIT_V(0);
    if constexpr (!ALIGN_EPI) { if (wr == 0) PG8_BAR; }
    PG8_BAR;
#undef PG8_ROWS
#undef PG8_ROWDMA
#undef PG8_SA
#undef PG8_SB
#undef PG8_STAGE
#undef PG8_STAGE2
#undef PG8_LDA
#undef PG8_LDB
#undef PG8_MMA
#undef PG8_WAIT_V
#undef PG8_WAIT_VX
#undef PG8_WAIT_L
#undef PG8_BAR
#undef PG8_SCHED
#undef PG8_BIAS
}
}

#ifndef REP_MASK
#define REP_MASK 0
#endif
#define NREP(k) (1 + ((REP_MASK >> (k)) & 1))

constexpr int NB = 16, SEQ = 2048, D = 1024, NMETA = 16;
constexpr int MX = NB * SEQ;
constexpr int INW = 3344, PW = 3584;
constexpr int GQ = 0, GK = 256, GV = 512, GG = 1024, GKL = 1536;
constexpr int RW0 = 1552;
constexpr int RR = RW0, RK = RW0 + 512, RV = RW0 + 1024, RWL = RW0 + 1536, RAL = RW0 + 1600, RGL = RW0 + 1664;
constexpr int NE = 32, TOPK = 4;
constexpr int NCH = 33;
constexpr float ALPHA = 1.189207115002721f;
constexpr int NWAVES = 8, NTHR = 512;

constexpr size_t MiB = 1u << 20;
constexpr size_t WS_CTL = 0, CTL_ZERO_BYTES = 1 * MiB;
constexpr size_t WS_STATS = 1 * MiB;
constexpr size_t WS_TOPI  = WS_STATS + 256 * 1024;
constexpr size_t WS_GATE  = WS_TOPI + 512 * 1024;
constexpr size_t WS_RANK  = WS_GATE + 512 * 1024;
constexpr size_t WS_TSLOT = WS_RANK + 512 * 1024;
constexpr size_t WS_BON   = WS_TSLOT + 512 * 1024;
constexpr size_t WS_BCNT  = WS_BON;
constexpr size_t WS_PROJM = WS_BON + 1 * MiB;
constexpr size_t WS_OPSM  = WS_PROJM + 256 * 1024;
constexpr size_t WS_DL    = WS_OPSM + 256 * 1024;
constexpr size_t WS_W2T   = WS_DL + 1 * MiB;
constexpr size_t WS_A2T   = WS_W2T + 64 * 1024;
constexpr size_t WS_G2T   = WS_A2T + 64 * 1024;
constexpr size_t WS_RWH   = WS_G2T + 128 * 1024;
constexpr size_t WS_RWL   = WS_RWH + 64 * 1024;
constexpr size_t WS_TILEE = WS_RWL + 64 * 1024;
constexpr size_t WS_SLOTTOK = WS_TILEE + 4096;
constexpr size_t WS_WIN   = 8 * MiB;
constexpr size_t WS_WOUT  = 15 * MiB;
static_assert(WS_SLOTTOK + 139264 * 4 <= WS_WIN, "table region");
constexpr size_t WS_A0    = 20 * MiB;
constexpr size_t WS_YMIX  = 560 * MiB;
constexpr size_t WS_PROJ  = 84 * MiB;
constexpr size_t WS_R1    = 308 * MiB;
constexpr size_t WS_GAM   = 520 * MiB;
constexpr size_t WS_SST   = 524 * MiB;
constexpr size_t WS_GUS   = 692 * MiB;
constexpr size_t WS_H1    = WS_A0;
constexpr size_t WS_XS    = 84 * MiB;
constexpr size_t WS_YS    = WS_XS;
constexpr size_t WS_ACT   = 356 * MiB;
constexpr size_t WS_MIXB  = 628 * MiB;
constexpr size_t WS_WUP   = 758 * MiB;
constexpr size_t WS_WDN   = 822 * MiB;
constexpr size_t WS_H1Q   = 854 * MiB;
constexpr size_t WS_END   = 886 * MiB;
constexpr int CW_BAR = 4096;
constexpr int CW_CNT = 16384;
constexpr int CW_QH = 20480;

constexpr int RING_BYTES = 131072;
constexpr int LDS_BYTES = 147456;
constexpr int TAB_OFF = 132096;
constexpr int MISC_OFF = LDS_BYTES - 512;

#define LAS __attribute__((address_space(3)))
typedef unsigned short bf16;
typedef unsigned v4u __attribute__((ext_vector_type(4)));
typedef unsigned v2u __attribute__((ext_vector_type(2)));
typedef float f32x4 __attribute__((ext_vector_type(4)));
typedef short bf16x8 __attribute__((ext_vector_type(8)));
typedef int i32x4g __attribute__((ext_vector_type(4)));
#define LDS_WAIT() asm volatile("s_waitcnt lgkmcnt(0)" ::: "memory")
__device__ __forceinline__ float bflo(unsigned w) { return __uint_as_float(w << 16); }
__device__ __forceinline__ float bfhi(unsigned w) { return __uint_as_float(w & 0xffff0000u); }
typedef float f32x2_t __attribute__((ext_vector_type(2))); typedef __bf16 bf16x2_t __attribute__((ext_vector_type(2)));
__device__ __forceinline__ unsigned pk2(float lo, float hi) { const f32x2_t v = {lo, hi}; const bf16x2_t b = __builtin_convertvector(v, bf16x2_t); return __builtin_bit_cast(unsigned, b); }
__device__ __forceinline__ unsigned f2bf(float f) { return pk2(f, 0.f) & 0xffffu; }
#define CYC() ((unsigned)__builtin_amdgcn_s_getreg((19 << 11) | 29))
__device__ __forceinline__ void lds_barrier() { asm volatile("s_waitcnt lgkmcnt(0)" ::: "memory"); __builtin_amdgcn_s_barrier(); asm volatile("" ::: "memory"); }
__device__ __forceinline__ float shx(float v, int mask, int lane) { return __int_as_float(__builtin_amdgcn_ds_bpermute((lane ^ mask) << 2, __float_as_int(v))); }
template <int CTRL> __device__ __forceinline__ float dppf0(float x) { return __int_as_float(__builtin_amdgcn_update_dpp(0, __float_as_int(x), CTRL, 0xF, 0xF, true)); }
__device__ __forceinline__ float wave_sum(float v, int lane) {
    v += dppf0<0xB1>(v); v += dppf0<0x4E>(v); v += dppf0<0x141>(v); v += dppf0<0x140>(v);
    v += shx(v, 16, lane); v += shx(v, 32, lane);
    return v;
}
__device__ __forceinline__ float softplus_f(float x) { return fmaxf(x, 0.f) + log1pf(expf(-fabsf(x))); }
__device__ __forceinline__ float logsigmoid_f(float x) { return fminf(x, 0.f) - log1pf(expf(-fabsf(x))); }
__device__ __forceinline__ float sigmoid_f(float x) { return 1.f / (1.f + expf(-x)); }
__device__ __forceinline__ float fexp(float x) { return __builtin_amdgcn_exp2f(x * 1.4426950408889634f); }
__device__ __forceinline__ float flog(float x) { return __builtin_amdgcn_logf(x) * 0.6931471805599453f; }
__device__ __forceinline__ float fsigmoid(float x) { return __builtin_amdgcn_rcpf(1.f + fexp(-x)); }
__device__ __forceinline__ float ftanh(float x) { return 2.f * fsigmoid(2.f * x) - 1.f; }
__device__ __forceinline__ float fsoftplus(float x) { return fmaxf(x, 0.f) + flog(1.f + fexp(-fabsf(x))); }
__device__ __forceinline__ float flogsigmoid(float x) { return fminf(x, 0.f) - flog(1.f + fexp(-fabsf(x))); }
template <int CTRL> __device__ __forceinline__ float dppf(float x) { return __int_as_float(__builtin_amdgcn_update_dpp(0, __float_as_int(x), CTRL, 0xF, 0xF, true)); }
__device__ __forceinline__ float red8(float x) {
    x += dppf<0xB1>(x); x += dppf<0x4E>(x); x += dppf<0x141>(x); return x;
}
__device__ __forceinline__ f32x4 mfma16(bf16x8 a, bf16x8 b, f32x4 c) { return __builtin_amdgcn_mfma_f32_16x16x32_bf16(a, b, c, 0, 0, 0); }
__device__ __forceinline__ unsigned ld_agent(const unsigned* p) { return __hip_atomic_load(p, __ATOMIC_RELAXED, __HIP_MEMORY_SCOPE_AGENT); }

#define XB_TMO      128
#define XB_XCNT(j)  (256  + 64 * (j))
#define XB_XSUB(j)  (1280 + 64 * (j))
#define XB_XGEN(j)  (2304 + 64 * (j))
#define XB_TOP      3328
#define XB_TOPGEN   3392
#define XCD_BAR_WORDS 3456
#define XB_SPIN_CAP (1u << 18)
__device__ __forceinline__ unsigned xb_ld(unsigned* p)              { return __hip_atomic_load(p, __ATOMIC_RELAXED, __HIP_MEMORY_SCOPE_AGENT); }
__device__ __forceinline__ unsigned xb_add(unsigned* p, unsigned v) { return __hip_atomic_fetch_add(p, v, __ATOMIC_RELAXED, __HIP_MEMORY_SCOPE_AGENT); }
__device__ __forceinline__ unsigned xb_xcc_id() { return (unsigned)__builtin_amdgcn_s_getreg((3 << 11) | 20) & 0xFu; }
#define XB_SPIN(cond, bar) do { unsigned _sp = 0; while (cond) { __builtin_amdgcn_s_sleep(1); \
    if ((++_sp & 255u) == 0u) { if (xb_ld(&(bar)[XB_TMO])) break; if (_sp > XB_SPIN_CAP) { atomicAdd(&(bar)[XB_TMO], 1u); break; } } } } while (0)
struct XcdBarrier { unsigned* bar; unsigned x; volatile LAS unsigned* st; };
__device__ __forceinline__ XcdBarrier xcd_barrier_post(unsigned* bar, volatile LAS unsigned* st, bool leader) {
    XcdBarrier b; b.bar = bar; b.x = xb_xcc_id(); b.st = st;
    if (leader) (void)xb_add(&bar[XB_XCNT(b.x)], 1u);
    return b;
}
__device__ __forceinline__ void xcd_barrier_complete(unsigned* bar, unsigned x, unsigned& nloc, unsigned& nx) {
    const unsigned G = gridDim.x * gridDim.y * gridDim.z;
    unsigned sum, cnt, mine, sp = 0u;
    for (;;) {
        sum = 0u; cnt = 0u; mine = 0u;
#pragma unroll
        for (unsigned j = 0; j < 16; ++j) { const unsigned c = xb_ld(&bar[XB_XCNT(j)]); sum += c; cnt += (c > 0u) ? 1u : 0u; mine = (j == x) ? c : mine; }
        if (sum == G) break;
        __builtin_amdgcn_s_sleep(1);
        if ((++sp & 255u) == 0u) { if (xb_ld(&bar[XB_TMO])) break; if (sp > XB_SPIN_CAP) { atomicAdd(&bar[XB_TMO], 1u); break; } }
    }
    nloc = mine > 0u ? mine : 1u; nx = cnt > 0u ? cnt : 1u;
}
__device__ __forceinline__ void xcd_barrier(const XcdBarrier& b, bool leader) {
    asm volatile("s_waitcnt vmcnt(0)" ::: "memory");
    __syncthreads();
    if (leader) {
        unsigned* bar = b.bar;
        __builtin_amdgcn_s_waitcnt(0);
        unsigned nloc = b.st[0], nx = b.st[1];
        if (nloc == 0u) { xcd_barrier_complete(bar, b.x, nloc, nx); b.st[0] = nloc; b.st[1] = nx; }
        const unsigned old = xb_add(&bar[XB_XSUB(b.x)], 1u);
        const unsigned gen = old / nloc;
        if (old + 1u == (gen + 1u) * nloc) {
            __builtin_amdgcn_fence(__ATOMIC_RELEASE, "agent");
            asm volatile("s_waitcnt vmcnt(0)" ::: "memory");
            const unsigned og = xb_add(&bar[XB_TOP], 1u);
            const unsigned tg = og / nx;
            if (og + 1u == (tg + 1u) * nx) xb_add(&bar[XB_TOPGEN], 1u);
            else XB_SPIN(xb_ld(&bar[XB_TOPGEN]) == tg, bar);
            __builtin_amdgcn_fence(__ATOMIC_ACQUIRE, "agent");
            xb_add(&bar[XB_XGEN(b.x)], 1u);
            asm volatile("s_waitcnt vmcnt(0)" ::: "memory");
        } else {
            XB_SPIN(xb_ld(&bar[XB_XGEN(b.x)]) == gen, bar);
            __builtin_amdgcn_fence(__ATOMIC_ACQUIRE, "agent");
            asm volatile("s_waitcnt vmcnt(0)" ::: "memory");
        }
    }
    __syncthreads();
}

struct Args { const float* in[30]; float* out; unsigned char* ws; };
enum { I_X = 0, I_META, I_LNIN_G, I_LNIN_B, I_WIN, I_GKW2, I_GKB, I_GNORM, I_MU, I_W0, I_W2, I_A0, I_A2, I_G2, I_KK, I_KA, I_RK, I_RLNG, I_RLNB, I_WOUT,
       I_LN1G, I_LN1B, I_RTW, I_RTB, I_WUP, I_BUP, I_WDN, I_BDN, I_LN2G, I_LN2B };
struct Frame { LAS unsigned char* lds; int tid, lane, wave, blk, G; };
__device__ __forceinline__ int lane_id() { int l; asm volatile("v_mbcnt_lo_u32_b32 %0, -1, 0\n\tv_mbcnt_hi_u32_b32 %0, -1, %0" : "=v"(l)); return l; }
__device__ __forceinline__ Frame mkframe(LAS unsigned char* lds, int wave) { Frame F; F.lds = lds; F.wave = wave; F.lane = lane_id(); F.tid = wave * 64 + F.lane; F.blk = blockIdx.x; F.G = gridDim.x; return F; }

__device__ __forceinline__ void transpose_item(const float* W, int K, int N, int nblk, bf16* WT, LAS float* scr, int item, int lane) {
    const int kb = item / nblk, nb = item - kb * nblk, k0 = 64 * kb, n0 = 32 * nb;
    const int nn = n0 + (lane & 31); const bool ok = nn < N;
#pragma unroll 8
    for (int i = 0; i < 32; ++i) { const int kk = 2 * i + (lane >> 5); scr[kk * 33 + (lane & 31)] = ok ? W[(size_t)(k0 + kk) * N + nn] : 0.f; }
    LDS_WAIT();
    const int c = lane & 7;
#pragma unroll
    for (int j = 0; j < 4; ++j) { const int n = (lane >> 3) + 8 * j; const LAS float* s = scr + (8 * c) * 33 + n;
        v4u o; o.x = pk2(s[0 * 33], s[1 * 33]); o.y = pk2(s[2 * 33], s[3 * 33]); o.z = pk2(s[4 * 33], s[5 * 33]); o.w = pk2(s[6 * 33], s[7 * 33]);
        *(v4u*)(WT + (size_t)(n0 + n) * K + k0 + 8 * c) = o; }
    LDS_WAIT();
}

constexpr int CV_UP = 16 * 32, CV_DN = 16 * 16, CV_NIT = NE * (CV_UP + CV_DN);
__device__ __forceinline__ void cv_load(const Args& a, int it, int lane, f32x4 (&v)[16]) {
    const bool up = it < NE * CV_UP; const int it2 = up ? it : it - NE * CV_UP, per = up ? CV_UP : CV_DN, e = it2 / per, r = it2 - e * per;
    const int N = up ? 2048 : D, nblk = N >> 6, kb = r / nblk, nb = r - kb * nblk;
    const float* W = (up ? a.in[I_WUP] : a.in[I_WDN]) + (size_t)e * D * N + (size_t)(64 * kb + (lane >> 4)) * N + 64 * nb + 4 * (lane & 15);
#pragma unroll
    for (int i = 0; i < 16; ++i) v[i] = *(const f32x4*)(W + (size_t)(4 * i) * N);
}
__device__ __forceinline__ void cv_store(const Args& a, int it, int lane, const f32x4 (&v)[16], LAS float* scr) {
    const bool up = it < NE * CV_UP; const int it2 = up ? it : it - NE * CV_UP, per = up ? CV_UP : CV_DN, e = it2 / per, r = it2 - e * per;
    const int N = up ? 2048 : D, nblk = N >> 6, kb = r / nblk, nb = r - kb * nblk;
    const float scale = up ? 64.f : 128.f;
    const int r4 = lane >> 4, c4 = lane & 15;
#pragma unroll
    for (int i = 0; i < 16; ++i) *(LAS f32x4*)(scr + (4 * i + r4) * 68 + 4 * c4) = v[i];
    LDS_WAIT();
    unsigned char* orow = a.ws + (up ? WS_WUP : WS_WDN) + (size_t)e * N * D + (size_t)(64 * nb + lane) * D + 64 * kb;
#pragma unroll
    for (int g = 0; g < 4; ++g) { const LAS float* s = scr + (16 * g) * 68 + lane; v4u o;
#pragma unroll
        for (int q = 0; q < 4; ++q) { int w = __builtin_amdgcn_cvt_pk_fp8_f32(s[(4 * q + 0) * 68] * scale, s[(4 * q + 1) * 68] * scale, 0, false);
            w = __builtin_amdgcn_cvt_pk_fp8_f32(s[(4 * q + 2) * 68] * scale, s[(4 * q + 3) * 68] * scale, w, true); o[q] = (unsigned)w; }
        *(v4u*)(orow + 16 * g) = o; }
    LDS_WAIT();
}
__device__ __forceinline__ void convert_expert_weights(const Args& a, const Frame& F, int qsel) {
    LAS float* scr = (LAS float*)(F.lds + F.wave * 17408);
    unsigned* QH = (unsigned*)(a.ws + WS_CTL) + CW_QH + 64 * qsel;
    unsigned base = 0;
    if (F.lane == 0) base = __hip_atomic_fetch_add(QH, 4u, __ATOMIC_RELAXED, __HIP_MEMORY_SCOPE_AGENT);
    base = (unsigned)__builtin_amdgcn_readfirstlane((int)base);
    if (base >= (unsigned)CV_NIT) return;
    f32x4 va[16], vb[16];
    cv_load(a, (int)base, F.lane, va);
    for (;;) {
        unsigned nbase = 0;
        if (F.lane == 0) nbase = __hip_atomic_fetch_add(QH, 4u, __ATOMIC_RELAXED, __HIP_MEMORY_SCOPE_AGENT);
        nbase = (unsigned)__builtin_amdgcn_readfirstlane((int)nbase);
        const bool more = nbase < (unsigned)CV_NIT;
        cv_load(a, (int)base + 1, F.lane, vb); cv_store(a, (int)base, F.lane, va, scr);
        cv_load(a, (int)base + 2, F.lane, va); cv_store(a, (int)base + 1, F.lane, vb, scr);
        cv_load(a, (int)base + 3, F.lane, vb); cv_store(a, (int)base + 2, F.lane, va, scr);
        if (more) cv_load(a, (int)nbase, F.lane, va);
        cv_store(a, (int)base + 3, F.lane, vb, scr);
        if (!more) break;
        base = nbase;
    }
}

__device__ __forceinline__ void phase0(const Args& a, const Frame& F) {
    unsigned char* ws = a.ws;
    const int gw = F.blk * NWAVES + F.wave, NGW = F.G * NWAVES;
    for (int cgp = F.blk; cgp < 53; cgp += F.G) {
        LAS float* HM = (LAS float*)F.lds;
        LAS float* PART = (LAS float*)(F.lds + 65536);
        for (int rr = 0; rr < 2; ++rr) {
            const int row = 2 * F.wave + rr; const f32x4* xr = (const f32x4*)(a.in[I_META] + row * D) + F.lane;
            f32x4 v[4]; float s = 0.f;
#pragma unroll
            for (int j = 0; j < 4; ++j) { v[j] = xr[64 * j]; s += (v[j].x + v[j].y) + (v[j].z + v[j].w); }
            const float mean = wave_sum(s, F.lane) * (1.f / D); float s2 = 0.f;
#pragma unroll
            for (int j = 0; j < 4; ++j) { v[j] = v[j] - mean; s2 += (v[j].x * v[j].x + v[j].y * v[j].y) + (v[j].z * v[j].z + v[j].w * v[j].w); }
            const float rstd = 1.f / sqrtf(wave_sum(s2, F.lane) * (1.f / D) + 1e-5f);
#pragma unroll
            for (int j = 0; j < 4; ++j) { const int col = 4 * (F.lane + 64 * j);
                const f32x4 gv = *(const f32x4*)(a.in[I_LNIN_G] + col), bv = *(const f32x4*)(a.in[I_LNIN_B] + col);
                const f32x4 y = v[j] * rstd * gv + bv;
                HM[(col + 0) * 16 + row] = y.x; HM[(col + 1) * 16 + row] = y.y; HM[(col + 2) * 16 + row] = y.z; HM[(col + 3) * 16 + row] = y.w; }
        }
        __syncthreads();
        const int col = cgp * 64 + F.lane; const bool ok = col < INW;
        float acc[16];
#pragma unroll
        for (int r = 0; r < 16; ++r) acc[r] = 0.f;
        const float* wp = a.in[I_WIN];
        for (int k = F.wave * 128; k < F.wave * 128 + 128; ++k) {
            const float wv = ok ? wp[(size_t)k * INW + col] : 0.f;
            const LAS f32x4* h = (const LAS f32x4*)(HM + k * 16);
#pragma unroll
            for (int q = 0; q < 4; ++q) { const f32x4 hv = h[q]; acc[4 * q + 0] += hv.x * wv; acc[4 * q + 1] += hv.y * wv; acc[4 * q + 2] += hv.z * wv; acc[4 * q + 3] += hv.w * wv; }
        }
#pragma unroll
        for (int r = 0; r < 16; ++r) PART[(F.wave * 16 + r) * 64 + F.lane] = acc[r];
        __syncthreads();
        bf16* PROJM = (bf16*)(ws + WS_PROJM);
        for (int o = F.tid; o < 1024; o += NTHR) { const int r = o >> 6, l = o & 63; float s = 0.f;
#pragma unroll
            for (int w = 0; w < 8; ++w) s += PART[(w * 16 + r) * 64 + l];
            PROJM[r * PW + cgp * 64 + l] = (bf16)f2bf(s); }
        if (F.tid < 64) PROJM[NMETA * PW + cgp * 64 + F.tid] = 0;
        __syncthreads();
    }
    {
        LAS float* scr = (LAS float*)(F.lds + F.wave * 16384);
        constexpr int I_IN = 16 * (PW / 32), I_OUT = 16 * 32;
        for (int it = gw; it < I_IN + I_OUT; it += NGW) {
            if (it < I_IN) transpose_item(a.in[I_WIN], D, INW, PW / 32, (bf16*)(ws + WS_WIN), scr, it, F.lane);
            else transpose_item(a.in[I_WOUT], D, D, 32, (bf16*)(ws + WS_WOUT), scr, it - I_IN, F.lane);
        }
    }
    {
        bf16* W2T = (bf16*)(ws + WS_W2T); bf16* A2T = (bf16*)(ws + WS_A2T); bf16* G2T = (bf16*)(ws + WS_G2T);
        for (int i = F.blk * NTHR + F.tid; i < 131072; i += F.G * NTHR) {
            if (i < 32768) { const int n = i >> 6, k = i & 63; W2T[i] = (bf16)f2bf(a.in[I_W2][k * 512 + n]); }
            else if (i < 65536) { const int j = i - 32768, n = j >> 6, k = j & 63; A2T[j] = (bf16)f2bf(a.in[I_A2][k * 512 + n]); }
            else { const int j = i - 65536, n = j >> 7, k = j & 127; G2T[j] = (bf16)f2bf(a.in[I_G2][k * 512 + n]); }
        }
    }
    {
        bf16* RWH = (bf16*)(ws + WS_RWH); bf16* RWL = (bf16*)(ws + WS_RWL);
        for (int i = F.blk * NTHR + F.tid; i < D * NE; i += F.G * NTHR) { const int c = i >> 5, e = i & 31; const float w = a.in[I_RTW][i];
            const unsigned hi = f2bf(w); const float lo = w - __uint_as_float(hi << 16);
            RWH[e * D + c] = (bf16)hi; RWL[e * D + c] = (bf16)f2bf(lo); }
    }
    {
        bf16* A0 = (bf16*)(ws + WS_A0);
        for (int m0 = gw; m0 < MX; m0 += 2 * NGW) {
            f32x4 v[2][4];
#pragma unroll
            for (int r = 0; r < 2; ++r) { const f32x4* xr = (const f32x4*)(a.in[I_X] + (size_t)(m0 + r * NGW) * D) + F.lane;
#pragma unroll
                for (int j = 0; j < 4; ++j) v[r][j] = xr[64 * j]; }
#pragma unroll
            for (int r = 0; r < 2; ++r) { const int m = m0 + r * NGW; float s = 0.f;
#pragma unroll
                for (int j = 0; j < 4; ++j) s += (v[r][j].x + v[r][j].y) + (v[r][j].z + v[r][j].w);
                const float mean = wave_sum(s, F.lane) * (1.f / D); float s2 = 0.f;
#pragma unroll
                for (int j = 0; j < 4; ++j) { v[r][j] = v[r][j] - mean; s2 += (v[r][j].x * v[r][j].x + v[r][j].y * v[r][j].y) + (v[r][j].z * v[r][j].z + v[r][j].w * v[r][j].w); }
                const float rstd = __builtin_amdgcn_rsqf(wave_sum(s2, F.lane) * (1.f / D) + 1e-5f);
#pragma unroll
                for (int j = 0; j < 4; ++j) { const int col = 4 * (F.lane + 64 * j);
                    const f32x4 gv = *(const f32x4*)(a.in[I_LNIN_G] + col), bv = *(const f32x4*)(a.in[I_LNIN_B] + col);
                    const f32x4 y = v[r][j] * rstd * gv + bv;
                    v2u o; o.x = pk2(y.x, y.y); o.y = pk2(y.z, y.w);
                    *(v2u*)(A0 + (size_t)m * D + col) = o; }
                }
        }
    }
    __syncthreads();
    for (int rep_ = 0; rep_ < NREP(14); ++rep_) convert_expert_weights(a, F, rep_);
}

__device__ __forceinline__ const bf16* prow(const bf16* PROJ, const bf16* PROJM, int b, int vp) {
    const bf16* px = PROJ + (size_t)(b * SEQ + (vp >= NMETA ? vp - NMETA : 0)) * PW;
    const bf16* pm = PROJM + (size_t)(vp < 0 ? NMETA : (vp < NMETA ? vp : 0)) * PW;
    return vp >= NMETA ? px : pm;
}
__device__ __forceinline__ f32x4 ldp4(const bf16* PROJ, const bf16* PROJM, int b, int vp, int col) {
    const v2u w = *(const v2u*)(prow(PROJ, PROJM, b, vp) + col);
    return (f32x4){bflo(w.x), bfhi(w.x), bflo(w.y), bfhi(w.y)};
}

constexpr int R1_STRIDE = 49152;
constexpr int TP = 80;
constexpr int L1_SLOT = 64 * TP * 2;
constexpr int L1_LC = 12 * L1_SLOT;
constexpr int L1_XCH = L1_LC + 64 * 65 * 4;
constexpr int L1_LR = 8 * L1_SLOT;
__device__ __forceinline__ v2u pack4(f32x4 v) { v2u o; o.x = pk2(v[0], v[1]); o.y = pk2(v[2], v[3]); return o; }
__device__ __forceinline__ f32x4 tile_mm(const LAS bf16* A, const LAS bf16* Bt, int rt, int ct, int fr, int fq, f32x4 acc) {
#pragma unroll
    for (int ks = 0; ks < 2; ++ks)
        acc = mfma16(*(const LAS bf16x8*)(Bt + (ct * 16 + fr) * TP + ks * 32 + 8 * fq), *(const LAS bf16x8*)(A + (rt * 16 + fr) * TP + ks * 32 + 8 * fq), acc);
    return acc;
}
__device__ __forceinline__ void tile_st(LAS bf16* O, int rt, int ct, int fr, int fq, f32x4 v) { *(LAS v2u*)(O + (rt * 16 + fr) * TP + ct * 16 + 4 * fq) = pack4(v); }
#define L1S(n) ((LAS bf16*)(F.lds + (n) * L1_SLOT))

struct L1Pf { v4u sa[5]; v2u r[2][2], k[2][2], v[2][2]; v4u w[4]; };
__device__ __forceinline__ void l1_fetch(const Args& a, const Frame& F, int b, int h, int c, L1Pf& pf, bool need_sa) {
    const bf16* PROJ = (const bf16*)(a.ws + WS_PROJ); const bf16* PROJM = (const bf16*)(a.ws + WS_PROJM);
    const int vp0 = (c == 0) ? -48 : NMETA + 64 * (c - 1);
    if (need_sa) { const int cg = F.tid & 31, tr = F.tid >> 5;
#pragma unroll
      for (int i = 0; i < 5; ++i) pf.sa[i] = *(const v4u*)(prow(PROJ, PROJM, b, vp0 + 4 * tr - 1 + i) + RWL + 8 * cg); }
    { const int rt = F.wave & 3, cp = F.wave >> 2, fr = F.lane & 15, fq = F.lane >> 4, vp = vp0 + rt * 16 + fr;
      const bf16* p0 = prow(PROJ, PROJM, b, vp - 1); const bf16* p1 = prow(PROJ, PROJM, b, vp);
#pragma unroll
      for (int cc = 0; cc < 2; ++cc) { const int jc = h * 64 + (2 * cp + cc) * 16 + 4 * fq;
          pf.r[cc][0] = *(const v2u*)(p0 + RR + jc); pf.r[cc][1] = *(const v2u*)(p1 + RR + jc);
          pf.k[cc][0] = *(const v2u*)(p0 + RK + jc); pf.k[cc][1] = *(const v2u*)(p1 + RK + jc);
          pf.v[cc][0] = *(const v2u*)(p0 + RV + jc); pf.v[cc][1] = *(const v2u*)(p1 + RV + jc); } }
    {
        const bf16* W2T = (const bf16*)(a.ws + WS_W2T); const bf16* A2T = (const bf16*)(a.ws + WS_A2T); const bf16* G2T = (const bf16*)(a.ws + WS_G2T);
        const int r = F.tid >> 3, ch = F.tid & 7;
        pf.w[0] = *(const v4u*)(W2T + (size_t)(h * 64 + r) * 64 + 8 * ch); pf.w[1] = *(const v4u*)(A2T + (size_t)(h * 64 + r) * 64 + 8 * ch);
#pragma unroll
        for (int i = 0; i < 2; ++i) { const int q = F.tid + 512 * i, r2 = q >> 4, c2 = q & 15; pf.w[2 + i] = *(const v4u*)(G2T + (size_t)(h * 64 + r2) * 128 + 8 * c2); }
    }
}
__device__ __forceinline__ f32x4 unpk4(v2u w) { return (f32x4){bflo(w.x), bfhi(w.x), bflo(w.y), bfhi(w.y)}; }

__device__ __forceinline__ void rwkv_l1_front(const Args& a, const Frame& F, int b, int h, int c, const L1Pf& pf, f32x4 (&rtil)[2], bool newgrp, bf16x8 (&lrf)[8]) {
    unsigned char* ws = a.ws;
    const int unit = (b * 8 + h) * NCH + c;
    unsigned char* r1 = ws + WS_R1 + (size_t)unit * R1_STRIDE;
    float* GAM = (float*)(ws + WS_GAM) + (size_t)unit * 64;
    const float* mu = a.in[I_MU];
    const int vp0 = (c == 0) ? -48 : NMETA + 64 * (c - 1);
    constexpr int LRP = 264;
    LAS bf16* LR = (LAS bf16*)(F.lds + L1_LR);
    LAS float* LC = (LAS float*)(F.lds + L1_LC);
    LAS float* XCH = (LAS float*)(F.lds + L1_XCH);
    const int rt = F.wave & 3, cp = F.wave >> 2, fr = F.lane & 15, fq = F.lane >> 4;
    {
        const int r = F.tid >> 3, ch = F.tid & 7;
        *(LAS v4u*)(L1S(0) + r * TP + 8 * ch) = pf.w[0]; *(LAS v4u*)(L1S(1) + r * TP + 8 * ch) = pf.w[1];
#pragma unroll
        for (int i = 0; i < 2; ++i) { const int q = F.tid + 512 * i, r2 = q >> 4, c2 = q & 15; *(LAS v4u*)(L1S(2 + (c2 >> 3)) + r2 * TP + 8 * (c2 & 7)) = pf.w[2 + i]; }
    }
    if (newgrp) {
        const int cg = F.tid & 31, tr = F.tid >> 5;
        const f32x4 m0 = *(const f32x4*)(mu + 1536 + 8 * cg), m1 = *(const f32x4*)(mu + 1536 + 8 * cg + 4);
#pragma unroll
        for (int i = 0; i < 4; ++i) {
            const int row = 4 * tr + i;
            const v4u cw = pf.sa[i + 1], pw = pf.sa[i];
            const f32x4 c0 = unpk4((v2u){cw.x, cw.y}), c1 = unpk4((v2u){cw.z, cw.w}), p0 = unpk4((v2u){pw.x, pw.y}), p1 = unpk4((v2u){pw.z, pw.w});
            float v[8];
            v[0] = c0.x + (p0.x - c0.x) * m0.x; v[1] = c0.y + (p0.y - c0.y) * m0.y; v[2] = c0.z + (p0.z - c0.z) * m0.z; v[3] = c0.w + (p0.w - c0.w) * m0.w;
            v[4] = c1.x + (p1.x - c1.x) * m1.x; v[5] = c1.y + (p1.y - c1.y) * m1.y; v[6] = c1.z + (p1.z - c1.z) * m1.z; v[7] = c1.w + (p1.w - c1.w) * m1.w;
#pragma unroll
            for (int q = 0; q < 8; ++q) { if (cg < 8) v[q] = ftanh(v[q]); else if (cg >= 16) v[q] = fsigmoid(v[q]); }
            v4u o; o.x = pk2(v[0], v[1]); o.y = pk2(v[2], v[3]); o.z = pk2(v[4], v[5]); o.w = pk2(v[6], v[7]);
            *(LAS v4u*)(LR + row * LRP + 8 * cg) = o;
        }
    }
    const int t = rt * 16 + fr, vp = vp0 + t;
    const bool valid = vp >= 0;
    lds_barrier();
    if (newgrp) {
        const LAS bf16* lrow = LR + t * LRP + 8 * fq;
#pragma unroll
        for (int q = 0; q < 8; ++q) lrf[q] = *(const LAS bf16x8*)(lrow + q * 32); }
    float lwv[2][4], asg[2][4], kkr[2][4], kmd[2][4], rrv[2][4], vvv[2][4];
    float ssq = 0.f, bon = 0.f;
    {
#pragma unroll
        for (int cc = 0; cc < 2; ++cc) {
            const int ct = 2 * cp + cc, j = ct * 16 + 4 * fq, jc = h * 64 + j;
            f32x4 mr[2], mk[2], mv[2], w0v[2], a0v[2], kkw[2], kaw[2], rkw[2];
            mr[cc] = *(const f32x4*)(mu + jc); mk[cc] = *(const f32x4*)(mu + 512 + jc); mv[cc] = *(const f32x4*)(mu + 1024 + jc);
            w0v[cc] = *(const f32x4*)(a.in[I_W0] + jc); a0v[cc] = *(const f32x4*)(a.in[I_A0] + jc);
            kkw[cc] = *(const f32x4*)(a.in[I_KK] + jc); kaw[cc] = *(const f32x4*)(a.in[I_KA] + jc); rkw[cc] = *(const f32x4*)(a.in[I_RK] + jc);
            f32x4 aw = {0.f, 0.f, 0.f, 0.f}, aa = aw, ag = aw;
#pragma unroll
            for (int ks = 0; ks < 2; ++ks) {
                aw = mfma16(*(const LAS bf16x8*)(L1S(0) + (ct * 16 + fr) * TP + ks * 32 + 8 * fq), lrf[ks], aw);
                aa = mfma16(*(const LAS bf16x8*)(L1S(1) + (ct * 16 + fr) * TP + ks * 32 + 8 * fq), lrf[2 + ks], aa);
            }
#pragma unroll
            for (int ks = 0; ks < 4; ++ks) ag = mfma16(*(const LAS bf16x8*)(L1S(2 + (ks >> 1)) + (ct * 16 + fr) * TP + (ks & 1) * 32 + 8 * fq), lrf[4 + ks], ag);
            const f32x4 rc = unpk4(pf.r[cc][1]), rp = unpk4(pf.r[cc][0]), kc = unpk4(pf.k[cc][1]), kp = unpk4(pf.k[cc][0]), vc = unpk4(pf.v[cc][1]), vpv = unpk4(pf.v[cc][0]);
            const f32x4 rs = rc + (rp - rc) * mr[cc], ks_ = kc + (kp - kc) * mk[cc], vs = vc + (vpv - vc) * mv[cc];
#pragma unroll
            for (int i = 0; i < 4; ++i) {
                const float u = w0v[cc][i] + aw[i];
                const float wl = -fsoftplus(-u) - 0.5f;
                lwv[cc][i] = valid ? -fexp(wl) : 0.f;
                const float as_ = fsigmoid(a0v[cc][i] + aa[i]);
                asg[cc][i] = as_;
                const float kraw = ks_[i], kk = kraw * kkw[cc][i];
                kkr[cc][i] = kk; ssq += kk * kk;
                const float km = kraw * (1.f + (as_ - 1.f) * kaw[cc][i]);
                kmd[cc][i] = km; rrv[cc][i] = rs[i]; vvv[cc][i] = vs[i];
                bon += rs[i] * km * rkw[cc][i];
            }
            *(v2u*)(r1 + 4 * 8192 + (size_t)(t * 64 + j) * 2) = pack4(ag);
            __builtin_amdgcn_sched_barrier(0);
        }
#pragma unroll
        for (int cc = 0; cc < 2; ++cc)
#pragma unroll
            for (int i = 0; i < 4; ++i) LC[t * 65 + (2 * cp + cc) * 16 + 4 * fq + i] = lwv[cc][i];
        ssq += shx(ssq, 16, F.lane); ssq += shx(ssq, 32, F.lane);
        bon += shx(bon, 16, F.lane); bon += shx(bon, 32, F.lane);
        if (fq == 0) { XCH[(cp * 64 + t) * 2] = ssq; XCH[(cp * 64 + t) * 2 + 1] = bon; }
    }
    lds_barrier();
    const float ssq_t = XCH[t * 2] + XCH[(64 + t) * 2], bon_t = XCH[t * 2 + 1] + XCH[(64 + t) * 2 + 1];
    const float inv = 1.f / fmaxf(sqrtf(ssq_t), 1e-12f);
    {
        LAS float* SEG = XCH + 256;
        const int jj = F.tid & 63, sg = F.tid >> 6;
        float cv[8];
#pragma unroll
        for (int i = 0; i < 8; ++i) cv[i] = LC[(sg * 8 + i) * 65 + jj];
#pragma unroll
        for (int i = 1; i < 8; ++i) cv[i] += cv[i - 1];
        SEG[sg * 64 + jj] = cv[7];
        lds_barrier();
        float pre = 0.f;
#pragma unroll
        for (int s2 = 0; s2 < 7; ++s2) pre += (s2 < sg) ? SEG[s2 * 64 + jj] : 0.f;
#pragma unroll
        for (int i = 0; i < 8; ++i) LC[(sg * 8 + i) * 65 + jj] = cv[i] + pre;
    }
    lds_barrier();
    {
#pragma unroll
        for (int cc = 0; cc < 2; ++cc) {
            const int j = (2 * cp + cc) * 16 + 4 * fq;
            f32x4 At, Bt, Kt, Bh, Kh, bvv;
#pragma unroll
            for (int i = 0; i < 4; ++i) {
                const float Lc = LC[t * 65 + j + i], LcC = LC[63 * 65 + j + i];
                const float kn = kkr[cc][i] * inv, av = -kn, bv = kn * asg[cc][i], km = kmd[cc][i];
                const float eA = fexp(Lc - lwv[cc][i]), eR = fexp(Lc), eB = fexp(-Lc), eH = fexp(LcC - Lc);
                At[i] = av * eA; rtil[cc][i] = rrv[cc][i] * eR; Bt[i] = bv * eB; Kt[i] = km * eB; Bh[i] = bv * eH; Kh[i] = km * eH;
                bvv[i] = bon_t * vvv[cc][i];
                if (t == 63) GAM[j + i] = fexp(LcC);
            }
            *(LAS v2u*)(L1S(0) + t * TP + j) = pack4(Bt); *(LAS v2u*)(L1S(1) + t * TP + j) = pack4(Kt);
            *(LAS v2u*)(L1S(2) + t * TP + j) = pack4(At); *(LAS v2u*)(L1S(3) + t * TP + j) = pack4(rtil[cc]);
#pragma unroll
            for (int i = 0; i < 4; ++i) {
                L1S(4)[(j + i) * TP + t] = (bf16)f2bf(At[i]); L1S(5)[(j + i) * TP + t] = (bf16)f2bf(Bh[i]);
                L1S(6)[(j + i) * TP + t] = (bf16)f2bf(Kh[i]); L1S(7)[(j + i) * TP + t] = (bf16)f2bf(vvv[cc][i]);
            }
            *(v2u*)(r1 + 5 * 8192 + (size_t)(t * 64 + j) * 2) = pack4(bvv);
        }
    }
    lds_barrier();
}
__device__ __forceinline__ void rwkv_l1_back(const Args& a, const Frame& F, int b, int h, int c, const f32x4 (&rtil)[2]) {
    unsigned char* r1 = a.ws + WS_R1 + (size_t)((b * 8 + h) * NCH + c) * R1_STRIDE;
    const int rt = F.wave & 3, cp = F.wave >> 2, fr = F.lane & 15, fq = F.lane >> 4;
    f32x4 Pt[2];
    const int mrow = rt * 16 + fr;
    const f32x4 z = {0.f, 0.f, 0.f, 0.f};
    {
        f32x4 Lv[2], Nv[2], Mv[2], Bv[2], Kv[2];
#pragma unroll
        for (int cc = 0; cc < 2; ++cc) { const int ct = 2 * cp + cc;
            Lv[cc] = tile_mm(L1S(2), L1S(0), rt, ct, fr, fq, z); Nv[cc] = tile_mm(L1S(0), L1S(2), rt, ct, fr, fq, z); Mv[cc] = tile_mm(L1S(2), L1S(1), rt, ct, fr, fq, z);
            Bv[cc] = tile_mm(L1S(3), L1S(0), rt, ct, fr, fq, z); Kv[cc] = tile_mm(L1S(3), L1S(1), rt, ct, fr, fq, z); }
#pragma unroll
        for (int cc = 0; cc < 2; ++cc) { const int ct = 2 * cp + cc, n0 = ct * 16 + 4 * fq;
#pragma unroll
            for (int i = 0; i < 4; ++i) { const int n = n0 + i;
                if (!(n < mrow)) { Lv[cc][i] = 0.f; Mv[cc][i] = 0.f; } if (!(mrow < n)) Nv[cc][i] = 0.f; if (!(n <= mrow)) { Bv[cc][i] = 0.f; Kv[cc][i] = 0.f; }
                Pt[cc][i] = Lv[cc][i] + ((n == mrow) ? 1.f : 0.f); }
            tile_st(L1S(8), rt, ct, fr, fq, Lv[cc]); tile_st(L1S(9), rt, ct, fr, fq, Nv[cc]); tile_st(L1S(10), rt, ct, fr, fq, Mv[cc]);
            tile_st(L1S(11), rt, ct, fr, fq, Bv[cc]); tile_st(L1S(12), rt, ct, fr, fq, Kv[cc]); }
    }
    lds_barrier();
    f32x4 Xv[2];
#pragma unroll
    for (int st = 1; st <= 6; ++st) {
        LAS bf16* Xl = (st & 1) ? L1S(8) : L1S(0); LAS bf16* Xn = (st & 1) ? L1S(9) : L1S(1);
        LAS bf16* Yl = (st & 1) ? L1S(0) : L1S(8); LAS bf16* Yn = (st & 1) ? L1S(1) : L1S(9);
        LAS bf16* Pr = (st & 1) ? L1S(2) : L1S(3); LAS bf16* Pw = (st & 1) ? L1S(3) : L1S(2);
        f32x4 l2[2], n2[2];
#pragma unroll
        for (int cc = 0; cc < 2; ++cc) { const int ct = 2 * cp + cc;
            if (st <= 5) { l2[cc] = tile_mm(Xl, Xn, rt, ct, fr, fq, z); n2[cc] = tile_mm(Xn, Xl, rt, ct, fr, fq, z); }
            if (st >= 2) Pt[cc] = tile_mm(Pr, Xn, rt, ct, fr, fq, Pt[cc]);
            if (st == 1) Xv[cc] = tile_mm(L1S(7), L1S(10), rt, ct, fr, fq, z); }
#pragma unroll
        for (int cc = 0; cc < 2; ++cc) { const int ct = 2 * cp + cc;
            if (st <= 5) { tile_st(Yl, rt, ct, fr, fq, l2[cc]); tile_st(Yn, rt, ct, fr, fq, n2[cc]); }
            tile_st(Pw, rt, ct, fr, fq, Pt[cc]); }
        if (st == 1) { lds_barrier();
#pragma unroll
            for (int cc = 0; cc < 2; ++cc) tile_st(L1S(10), rt, 2 * cp + cc, fr, fq, Xv[cc]); }
        lds_barrier();
    }
    {
        f32x4 u[2], w[2];
#pragma unroll
        for (int cc = 0; cc < 2; ++cc) { const int ct = 2 * cp + cc; u[cc] = tile_mm(L1S(10), L1S(2), rt, ct, fr, fq, z); w[cc] = tile_mm(L1S(4), L1S(2), rt, ct, fr, fq, z); }
#pragma unroll
        for (int cc = 0; cc < 2; ++cc) { const int ct = 2 * cp + cc; tile_st(L1S(8), rt, ct, fr, fq, u[cc]); tile_st(L1S(9), rt, ct, fr, fq, w[cc]); }
    }
    lds_barrier();
    {
#pragma unroll
        for (int cc = 0; cc < 2; ++cc) { const int ct = 2 * cp + cc; const size_t eo = (size_t)(mrow * 64 + ct * 16 + 4 * fq) * 2;
            const f32x4 gp = tile_mm(L1S(5), L1S(9), rt, ct, fr, fq, z);
            const f32x4 hh = tile_mm(L1S(7), L1S(6), rt, ct, fr, fq, tile_mm(L1S(8), L1S(5), rt, ct, fr, fq, z));
            const f32x4 rh = tile_mm(L1S(11), L1S(9), rt, ct, fr, fq, rtil[cc]);
            const f32x4 yl = tile_mm(L1S(12), L1S(7), rt, ct, fr, fq, tile_mm(L1S(11), L1S(8), rt, ct, fr, fq, z));
            *(v2u*)(r1 + 0 * 8192 + eo) = pack4(gp); *(v2u*)(r1 + 1 * 8192 + eo) = pack4(hh);
            *(v2u*)(r1 + 2 * 8192 + eo) = pack4(rh); *(v2u*)(r1 + 3 * 8192 + eo) = pack4(yl); }
    }
    lds_barrier();
}

constexpr int BCP = 65;
__device__ __forceinline__ void gla_bc(const Args& a, const Frame& F, int b, int h, int vp0, int ntok) {
    const bf16* PROJ = (const bf16*)(a.ws + WS_PROJ); const bf16* PROJM = (const bf16*)(a.ws + WS_PROJM);
    LAS float* GKLs = (LAS float*)F.lds; LAS float* BC = (LAS float*)(F.lds + 4096);
    if (F.tid < 256) { const int t = F.tid >> 2, q = F.tid & 3;
        const f32x4 v = ldp4(PROJ, PROJM, b, (t < ntok) ? vp0 + t : -1, GKL + 4 * q);
        *(LAS f32x4*)(GKLs + t * 16 + 4 * q) = v; }
    lds_barrier();
    {
        const int d = F.tid & 63, tg = F.tid >> 6;
        float wc[16];
#pragma unroll
        for (int r = 0; r < 16; ++r) wc[r] = a.in[I_GKW2][r * 256 + h * 64 + d];
        const float gb = a.in[I_GKB][h * 64 + d];
        float lgv[8];
#pragma unroll
        for (int i = 0; i < 8; ++i) { const int t = tg * 8 + i; float z = gb;
            const LAS f32x4* g4 = (const LAS f32x4*)(GKLs + t * 16);
#pragma unroll
            for (int q = 0; q < 4; ++q) { const f32x4 gv = g4[q]; z += gv.x * wc[4 * q] + gv.y * wc[4 * q + 1] + gv.z * wc[4 * q + 2] + gv.w * wc[4 * q + 3]; }
            lgv[i] = (t < ntok) ? flogsigmoid(z) * (1.f / 16.f) : 0.f; }
        LAS float* SEG = (LAS float*)(F.lds + 20736);
#pragma unroll
        for (int i = 1; i < 8; ++i) lgv[i] += lgv[i - 1];
        SEG[tg * 64 + d] = lgv[7];
        lds_barrier();
        float pre = 0.f;
#pragma unroll
        for (int s2 = 0; s2 < 7; ++s2) pre += (s2 < tg) ? SEG[s2 * 64 + d] : 0.f;
#pragma unroll
        for (int i = 0; i < 8; ++i) BC[(tg * 8 + i) * BCP + d] = lgv[i] + pre;
    }
    lds_barrier();
}

__device__ __forceinline__ void gla_g1_unit(const Args& a, const Frame& F, int b, int h, int c) {
    const bf16* PROJ = (const bf16*)(a.ws + WS_PROJ); const bf16* PROJM = (const bf16*)(a.ws + WS_PROJM);
    float* GUS = (float*)(a.ws + WS_GUS); float* DL = (float*)(a.ws + WS_DL);
    const int ntok = (c == 0) ? NMETA : 64, vp0 = (c == 0) ? 0 : NMETA + 64 * (c - 1);
    gla_bc(a, F, b, h, vp0, ntok);
    LAS float* BC = (LAS float*)(F.lds + 4096);
    LAS bf16* KT = (LAS bf16*)(F.lds + 24576);
    LAS bf16* VT = (LAS bf16*)(F.lds + 24576 + 64 * TP * 2);
    {
        const int t = F.tid >> 3, q = F.tid & 7;
        const float* bl = nullptr; (void)bl;
#pragma unroll
        for (int half = 0; half < 2; ++half) {
            const int d0 = 8 * q + 4 * half;
            const f32x4 kv = ldp4(PROJ, PROJM, b, (t < ntok) ? vp0 + t : -1, GK + h * 64 + d0);
#pragma unroll
            for (int i = 0; i < 4; ++i) { const int d = d0 + i; const float e = (t < ntok) ? fexp(BC[(ntok - 1) * BCP + d] - BC[t * BCP + d]) : 0.f;
                KT[d * TP + t] = (bf16)f2bf(kv[i] * e); }
        }
#pragma unroll
        for (int qq = 0; qq < 4; ++qq) {
            const int e0 = 16 * q + 4 * qq;
            const f32x4 vv = ldp4(PROJ, PROJM, b, (t < ntok) ? vp0 + t : -1, GV + h * 128 + e0);
#pragma unroll
            for (int i = 0; i < 4; ++i) VT[(e0 + i) * TP + t] = (bf16)f2bf(vv[i]);
        }
    }
    lds_barrier();
    {
        const int rt = F.wave & 3, ch = F.wave >> 2, fr = F.lane & 15, fq = F.lane >> 4;
        float* up = GUS + ((size_t)((b * 4 + h) * NCH + c) * 64 + rt * 16 + fr) * 128;
#pragma unroll
        for (int cc = 0; cc < 4; ++cc) { const int ct = ch * 4 + cc;
            f32x4 acc = {0.f, 0.f, 0.f, 0.f};
#pragma unroll
            for (int ks = 0; ks < 2; ++ks)
                acc = mfma16(*(const LAS bf16x8*)(VT + (ct * 16 + fr) * TP + ks * 32 + 8 * fq), *(const LAS bf16x8*)(KT + (rt * 16 + fr) * TP + ks * 32 + 8 * fq), acc);
            *(f32x4*)(up + ct * 16 + 4 * fq) = acc; }
        if (F.tid < 64) DL[(size_t)((b * 4 + h) * NCH + c) * 64 + F.tid] = fexp(BC[(ntok - 1) * BCP + F.tid]);
    }
    lds_barrier();
}

template <bool BACK>
__device__ __forceinline__ void rwkv_l1_loop(const Args& a, const Frame& F) {
    constexpr int NU = NB * 8 * NCH;
    const int u0 = (int)((long)F.blk * NU / F.G), u1 = (int)((long)(F.blk + 1) * NU / F.G);
    L1Pf pf;
    bf16x8 lrf[8];
    if (u0 < u1) l1_fetch(a, F, (u0 >> 3) / NCH, u0 & 7, (u0 >> 3) % NCH, pf, true);
    for (int u = u0; u < u1; ++u) {
        const int h = u & 7, c = (u >> 3) % NCH, b = (u >> 3) / NCH; f32x4 rtil[2];
        const bool newgrp = (u == u0) || (h == 0);
        { const Frame F1 = mkframe(F.lds, F.wave); rwkv_l1_front(a, F1, b, h, c, pf, rtil, newgrp, lrf); }
        { const Frame F2 = mkframe(F.lds, F.wave);
          if (u + 1 < u1) l1_fetch(a, F2, ((u + 1) >> 3) / NCH, (u + 1) & 7, ((u + 1) >> 3) % NCH, pf, ((u + 1) & 7) == 0);
          if constexpr (BACK) rwkv_l1_back(a, F2, b, h, c, rtil); }
    }
}
__device__ __forceinline__ void phase2(const Args& a, const Frame& F) {
    if constexpr (((REP_MASK >> 19) & 1) != 0) { const Frame F0 = mkframe(F.lds, F.wave); rwkv_l1_loop<false>(a, F0); }
    { const Frame F0 = mkframe(F.lds, F.wave); rwkv_l1_loop<true>(a, F0); }
    for (int rep_ = 0; rep_ < NREP(12); ++rep_)
    for (int u = F.blk; u < NB * 4 * 32; u += F.G) { const int c = u & 31, bh = u >> 5; const Frame F1 = mkframe(F.lds, F.wave); gla_g1_unit(a, F1, bh >> 2, bh & 3, c); }
}

struct L2S { v4u g, h; f32x4 gm; };
__device__ __forceinline__ void l2s_fetch(L2S& r, const unsigned char* src, const float* gam) {
    r.g = *(const v4u*)src; r.h = *(const v4u*)(src + 8192); r.gm = *(const f32x4*)gam;
}
__device__ __forceinline__ void l2s_stage(const L2S& r, LAS bf16* Gt, LAS bf16* Ht, LAS float* Gm, int tid) {
    const int r_ = tid >> 3, c8 = tid & 7;
    *(LAS v4u*)(Gt + r_ * TP + 8 * c8) = r.g; *(LAS v4u*)(Ht + r_ * TP + 8 * c8) = r.h;
    if (tid < 16) *(LAS f32x4*)(Gm + 4 * tid) = r.gm;
}
__device__ __forceinline__ void l2s_step(const LAS bf16* Gt, const LAS bf16* Ht, const LAS float* Gm, const LAS bf16* Sc, LAS bf16* Sn, f32x4 (&Sm)[2], int row, int cp, int fr, int fq, bf16* gout, int tid) {
    {
        const int r_ = tid >> 3, c8 = tid & 7;
        *(v4u*)(gout + r_ * 64 + 8 * c8) = *(const LAS v4u*)(Sc + r_ * TP + 8 * c8);
    }
    const int col0 = cp * 32 + 4 * fq;
    const bf16x8 af0 = *(const LAS bf16x8*)(Sc + row * TP + 8 * fq), af1 = *(const LAS bf16x8*)(Sc + row * TP + 32 + 8 * fq);
    bf16x8 fg[4]; v2u hq[2]; f32x4 gm[2];
#pragma unroll
    for (int cc = 0; cc < 2; ++cc) { const LAS bf16* gr = Gt + (cp * 32 + cc * 16 + fr) * TP + 8 * fq;
        fg[2 * cc] = *(const LAS bf16x8*)gr; fg[2 * cc + 1] = *(const LAS bf16x8*)(gr + 32);
        hq[cc] = *(const LAS v2u*)(Ht + row * TP + col0 + cc * 16); gm[cc] = *(const LAS f32x4*)(Gm + col0 + cc * 16); }
#pragma unroll
    for (int cc = 0; cc < 2; ++cc) {
        f32x4 acc = {bflo(hq[cc].x), bfhi(hq[cc].x), bflo(hq[cc].y), bfhi(hq[cc].y)};
        acc = mfma16(fg[2 * cc], af0, acc);
        acc = mfma16(fg[2 * cc + 1], af1, acc);
        Sm[cc] = Sm[cc] * gm[cc] + acc; }
#pragma unroll
    for (int cc = 0; cc < 2; ++cc) *(LAS v2u*)(Sn + row * TP + col0 + cc * 16) = pack4(Sm[cc]);
}
template <bool FAKE>
__device__ __forceinline__ void rwkv_l2_unit(const Args& a, const Frame& F, int bh) {
    unsigned char* ws = a.ws;
    LAS bf16* Sb0 = (LAS bf16*)F.lds; LAS bf16* Sb1 = Sb0 + 64 * TP;
    LAS bf16* G0 = Sb0 + 2 * 64 * TP; LAS bf16* G1 = Sb0 + 3 * 64 * TP; LAS bf16* H0 = Sb0 + 4 * 64 * TP; LAS bf16* H1 = Sb0 + 5 * 64 * TP;
    LAS float* M0 = (LAS float*)(Sb0 + 6 * 64 * TP); LAS float* M1 = M0 + 64;
    const int fr = F.lane & 15, fq = F.lane >> 4, rt = F.wave & 3, cp = F.wave >> 2;
    const int row = rt * 16 + fr, col0 = cp * 32 + 4 * fq;
    const unsigned char* srcb = ws + WS_R1 + (size_t)bh * NCH * R1_STRIDE + (size_t)((F.tid >> 3) * 64 + 8 * (F.tid & 7)) * 2;
    const float* gamb = (const float*)(ws + WS_GAM) + (size_t)bh * NCH * 64 + 4 * (F.lane & 15);
    bf16* sst = (bf16*)(ws + WS_SST) + (size_t)bh * NCH * 4096;
    f32x4 Sm[2];
#pragma unroll
    for (int cc = 0; cc < 2; ++cc) { Sm[cc] = (f32x4){0.f, 0.f, 0.f, 0.f}; *(LAS v2u*)(Sb0 + row * TP + col0 + cc * 16) = (v2u){0u, 0u}; }
    L2S r0, r1, r2, r3;
#define L2F(rr, cn) do { const int cn_ = FAKE ? 0 : (((cn) < NCH - 1) ? (cn) : NCH - 2); l2s_fetch(rr, srcb + (size_t)cn_ * R1_STRIDE, gamb + (size_t)cn_ * 64); } while (0)
    L2F(r0, 0); L2F(r1, 1); L2F(r2, 2); L2F(r3, 3);
    l2s_stage(r0, G0, H0, M0, F.tid);
    lds_barrier(); __builtin_amdgcn_sched_barrier(0);
#pragma nounroll
    for (int c = 0; c < NCH - 1; c += 4) {
        l2s_stage(r1, G1, H1, M1, F.tid); L2F(r0, c + 4);
        l2s_step(G0, H0, M0, Sb0, Sb1, Sm, row, cp, fr, fq, sst + (size_t)c * 4096, F.tid); lds_barrier(); __builtin_amdgcn_sched_barrier(0);
        l2s_stage(r2, G0, H0, M0, F.tid); L2F(r1, c + 5);
        l2s_step(G1, H1, M1, Sb1, Sb0, Sm, row, cp, fr, fq, sst + (size_t)(c + 1) * 4096, F.tid); lds_barrier(); __builtin_amdgcn_sched_barrier(0);
        l2s_stage(r3, G1, H1, M1, F.tid); L2F(r2, c + 6);
        l2s_step(G0, H0, M0, Sb0, Sb1, Sm, row, cp, fr, fq, sst + (size_t)(c + 2) * 4096, F.tid); lds_barrier(); __builtin_amdgcn_sched_barrier(0);
        l2s_stage(r0, G0, H0, M0, F.tid); L2F(r3, c + 7);
        l2s_step(G1, H1, M1, Sb1, Sb0, Sm, row, cp, fr, fq, sst + (size_t)(c + 3) * 4096, F.tid); lds_barrier(); __builtin_amdgcn_sched_barrier(0);
    }
#undef L2F
    { const int r_ = F.tid >> 3, c8 = F.tid & 7;
      *(v4u*)(sst + (size_t)(NCH - 1) * 4096 + r_ * 64 + 8 * c8) = *(const LAS v4u*)(Sb0 + r_ * TP + 8 * c8); }
    lds_barrier();
}
__device__ __forceinline__ void rwkv_y_task(const Args& a, const Frame& F, int task) {
    unsigned char* ws = a.ws;
    const int c = 1 + (task & 31), bh = task >> 5, b = bh >> 3, h = bh & 7;
    const int fr = F.lane & 15, fq = F.lane >> 4;
    const bf16* Sg = (const bf16*)(ws + WS_SST) + (size_t)(bh * NCH + c) * 4096 + fr * 64 + 8 * fq;
    bf16x8 sf[8];
#pragma unroll
    for (int ct = 0; ct < 4; ++ct) { sf[2 * ct] = *(const bf16x8*)(Sg + ct * 1024); sf[2 * ct + 1] = *(const bf16x8*)(Sg + ct * 1024 + 32); }
    f32x4 lg[4], lb[4];
#pragma unroll
    for (int ct = 0; ct < 4; ++ct) { const int i0 = h * 64 + ct * 16 + 4 * fq; lg[ct] = *(const f32x4*)(a.in[I_RLNG] + i0); lb[ct] = *(const f32x4*)(a.in[I_RLNB] + i0); }
    LAS bf16* ost = (LAS bf16*)(F.lds + 102400 + F.wave * 2304);
    const unsigned char* r1u = ws + WS_R1 + (size_t)(bh * NCH + c) * R1_STRIDE + (size_t)(fr * 64 + 4 * fq) * 2;
    bf16x8 fa0[4], fa1[4]; v2u q0[4][4];
#pragma unroll
    for (int rt = 0; rt < 4; ++rt) { const unsigned char* r1 = r1u + rt * 2048;
        fa0[rt] = *(const bf16x8*)(r1 + 2 * 8192 + 8 * fq); fa1[rt] = *(const bf16x8*)(r1 + 2 * 8192 + 64 + 8 * fq);
#pragma unroll
        for (int ct = 0; ct < 4; ++ct) q0[rt][ct] = *(const v2u*)(r1 + 3 * 8192 + ct * 32); }
#pragma unroll
    for (int rt = 0; rt < 4; ++rt) {
        const unsigned char* r1 = r1u + rt * 2048;
        v2u q1[4], q2[4];
#pragma unroll
        for (int ct = 0; ct < 4; ++ct) { q1[ct] = *(const v2u*)(r1 + 4 * 8192 + ct * 32); q2[ct] = *(const v2u*)(r1 + 5 * 8192 + ct * 32); }
        f32x4 y[4]; float s = 0.f;
#pragma unroll
        for (int ct = 0; ct < 4; ++ct) {
            f32x4 acc = {bflo(q0[rt][ct].x), bfhi(q0[rt][ct].x), bflo(q0[rt][ct].y), bfhi(q0[rt][ct].y)};
            acc = mfma16(sf[2 * ct], fa0[rt], acc); acc = mfma16(sf[2 * ct + 1], fa1[rt], acc);
            y[ct] = acc; s += (acc[0] + acc[1]) + (acc[2] + acc[3]); }
        s += shx(s, 16, F.lane); s += shx(s, 32, F.lane);
        const float mean = s * (1.f / 64.f); float q = 0.f;
#pragma unroll
        for (int ct = 0; ct < 4; ++ct) { y[ct] = y[ct] - mean; q += (y[ct][0] * y[ct][0] + y[ct][1] * y[ct][1]) + (y[ct][2] * y[ct][2] + y[ct][3] * y[ct][3]); }
        q += shx(q, 16, F.lane); q += shx(q, 32, F.lane);
        const float rstd = __builtin_amdgcn_rsqf(q * (1.f / 64.f) + 64e-5f);
#pragma unroll
        for (int ct = 0; ct < 4; ++ct) {
            const f32x4 g = {bflo(q1[ct].x), bfhi(q1[ct].x), bflo(q1[ct].y), bfhi(q1[ct].y)}, bv = {bflo(q2[ct].x), bfhi(q2[ct].x), bflo(q2[ct].y), bfhi(q2[ct].y)};
            const f32x4 o = (y[ct] * rstd * lg[ct] + lb[ct] + bv) * g;
            *(LAS v2u*)(ost + fr * 72 + ct * 16 + 4 * fq) = pack4(o); }
        asm volatile("s_waitcnt lgkmcnt(0)" ::: "memory");
        bf16* yout = (bf16*)(ws + WS_YMIX) + ((size_t)b * SEQ + 64 * (c - 1) + rt * 16) * D + 512 + h * 64;
#pragma unroll
        for (int hh = 0; hh < 2; ++hh) { const int tr = (F.lane >> 3) + 8 * hh, c8 = F.lane & 7;
            *(v4u*)(yout + (size_t)tr * D + 8 * c8) = *(const LAS v4u*)(ost + tr * 72 + 8 * c8); }
        asm volatile("s_waitcnt lgkmcnt(0)" ::: "memory");
    }
}
__device__ __forceinline__ void gla_scan_unit(const Args& a, const Frame& F, int j) {
    float* GUS = (float*)(a.ws + WS_GUS); const float* DL = (const float*)(a.ws + WS_DL);
    const int bh = j >> 1, half = j & 1;
    const int d = 32 * half + (F.tid >> 4), e0 = (F.tid & 15) * 4;
    float* base = GUS + (size_t)bh * NCH * 8192 + d * 128 + e0;
    const float* dl = DL + (size_t)bh * NCH * 64 + d;
    f32x4 s0 = {0.f, 0.f, 0.f, 0.f}, s1 = s0;
    f32x4 ua[8], ub[8]; float dq[8];
#pragma unroll
    for (int q = 0; q < 7; ++q) { ua[q] = *(const f32x4*)(base + (size_t)q * 8192); ub[q] = *(const f32x4*)(base + (size_t)q * 8192 + 64); dq[q] = dl[q * 64]; }
#pragma unroll 8
    for (int c = 0; c < NCH - 1; ++c) {
        const int cn = (c + 7 < NCH - 1) ? c + 7 : NCH - 2;
        ua[(c + 7) & 7] = *(const f32x4*)(base + (size_t)cn * 8192); ub[(c + 7) & 7] = *(const f32x4*)(base + (size_t)cn * 8192 + 64); dq[(c + 7) & 7] = dl[cn * 64];
        *(f32x4*)(base + (size_t)c * 8192) = s0; *(f32x4*)(base + (size_t)c * 8192 + 64) = s1;
        s0 = s0 * dq[c & 7] + ua[c & 7]; s1 = s1 * dq[c & 7] + ub[c & 7];
    }
    *(f32x4*)(base + (size_t)(NCH - 1) * 8192) = s0; *(f32x4*)(base + (size_t)(NCH - 1) * 8192 + 64) = s1;
}
__device__ __forceinline__ void phase3(const Args& a, const Frame& F) {
    for (int u = F.blk; u < 256; u += F.G) {
        if (u < 128) { if constexpr (((REP_MASK >> 20) & 1) != 0) rwkv_l2_unit<true>(a, F, u); for (int rep_ = 0; rep_ < NREP(3); ++rep_) rwkv_l2_unit<false>(a, F, u); }
        else gla_scan_unit(a, F, u - 128);
    }
}

struct G3Pf { v2u gkl, q[2], k[2], v[4], gg[4]; f32x4 s[4]; };
struct G3Const { float wc[16], gb; f32x4 ng[4]; };
__device__ __forceinline__ void g3_fetch(const Args& a, const Frame& F, int b, int h, int c, G3Pf& pf) {
    const bf16* PROJ = (const bf16*)(a.ws + WS_PROJ); const bf16* PROJM = (const bf16*)(a.ws + WS_PROJM);
    const float* GUS = (const float*)(a.ws + WS_GUS);
    const int vp0 = NMETA + 64 * (c - 1);
    { const int t = (F.tid >> 2) & 63, q = F.tid & 3; pf.gkl = *(const v2u*)(prow(PROJ, PROJM, b, vp0 + t) + GKL + 4 * q); }
    const int t = F.tid >> 3, q = F.tid & 7; const bf16* pr = prow(PROJ, PROJM, b, vp0 + t);
#pragma unroll
    for (int i = 0; i < 2; ++i) { pf.q[i] = *(const v2u*)(pr + GQ + h * 64 + 8 * q + 4 * i); pf.k[i] = *(const v2u*)(pr + GK + h * 64 + 8 * q + 4 * i); }
#pragma unroll
    for (int qq = 0; qq < 4; ++qq) { pf.v[qq] = *(const v2u*)(pr + GV + h * 128 + 16 * q + 4 * qq);
        pf.s[qq] = *(const f32x4*)(GUS + ((size_t)((b * 4 + h) * NCH + c) * 64 + t) * 128 + 16 * q + 4 * qq); }
    const int rt = F.wave & 3, wh = F.wave >> 2, fr = F.lane & 15, fq = F.lane >> 4;
    const bf16* pg = prow(PROJ, PROJM, b, vp0 + rt * 16 + fr);
#pragma unroll
    for (int cc = 0; cc < 4; ++cc) pf.gg[cc] = *(const v2u*)(pg + GG + h * 128 + (wh * 4 + cc) * 16 + 4 * fq);
}
__device__ __forceinline__ void gla_g3_unit(const Args& a, const Frame& F, int b, int h, int c, const G3Pf& pf, const G3Const& K) {
    bf16* YMIX = (bf16*)(a.ws + WS_YMIX);
    const int vp0 = NMETA + 64 * (c - 1);
    LAS float* GKLs = (LAS float*)F.lds; LAS float* BC = (LAS float*)(F.lds + 4096);
    LAS bf16* QT = (LAS bf16*)(F.lds + 24576);
    LAS bf16* KL = QT + 64 * TP;
    LAS bf16* AT = KL + 64 * TP;
    LAS bf16* VT = AT + 64 * TP;
    LAS bf16* ST = VT + 128 * TP;
    LAS float* RS = (LAS float*)(ST + 128 * TP);
    if (F.tid < 256) { const int t = F.tid >> 2, q = F.tid & 3; *(LAS f32x4*)(GKLs + t * 16 + 4 * q) = unpk4(pf.gkl); }
    lds_barrier();
    {
        const int d = F.tid & 63, tg = F.tid >> 6;
        float lgv[8];
#pragma unroll
        for (int i = 0; i < 8; ++i) { const int t = tg * 8 + i; float z = K.gb;
            const LAS f32x4* g4 = (const LAS f32x4*)(GKLs + t * 16);
#pragma unroll
            for (int q = 0; q < 4; ++q) { const f32x4 gv = g4[q]; z += gv.x * K.wc[4 * q] + gv.y * K.wc[4 * q + 1] + gv.z * K.wc[4 * q + 2] + gv.w * K.wc[4 * q + 3]; }
            lgv[i] = flogsigmoid(z) * (1.f / 16.f); }
        LAS float* SEG = (LAS float*)(F.lds + 20736);
#pragma unroll
        for (int i = 1; i < 8; ++i) lgv[i] += lgv[i - 1];
        SEG[tg * 64 + d] = lgv[7];
        lds_barrier();
        float pre = 0.f;
#pragma unroll
        for (int s2 = 0; s2 < 7; ++s2) pre += (s2 < tg) ? SEG[s2 * 64 + d] : 0.f;
#pragma unroll
        for (int i = 0; i < 8; ++i) BC[(tg * 8 + i) * BCP + d] = lgv[i] + pre;
    }
    lds_barrier();
    const int rt = F.wave & 3, wh = F.wave >> 2, fr = F.lane & 15, fq = F.lane >> 4;
    const int trow = rt * 16 + fr;
    f32x4 sg[4];
#pragma unroll
    for (int cc = 0; cc < 4; ++cc) { const f32x4 gv = unpk4(pf.gg[cc]);
#pragma unroll
        for (int i = 0; i < 4; ++i) sg[cc][i] = K.ng[cc][i] * (gv[i] * fsigmoid(gv[i])); }
    {
        const int t = F.tid >> 3, q = F.tid & 7;
        const f32x4 q0 = unpk4(pf.q[0]), q1 = unpk4(pf.q[1]), k0 = unpk4(pf.k[0]), k1 = unpk4(pf.k[1]);
        float qv[8] = {q0.x, q0.y, q0.z, q0.w, q1.x, q1.y, q1.z, q1.w}, kv[8] = {k0.x, k0.y, k0.z, k0.w, k1.x, k1.y, k1.z, k1.w};
#pragma unroll
        for (int i = 0; i < 8; ++i) { const float bcv = BC[t * BCP + 8 * q + i]; qv[i] *= fexp(bcv) * 0.125f; kv[i] *= fexp(-bcv); }
        v4u o; o.x = pk2(qv[0], qv[1]); o.y = pk2(qv[2], qv[3]); o.z = pk2(qv[4], qv[5]); o.w = pk2(qv[6], qv[7]);
        *(LAS v4u*)(QT + t * TP + 8 * q) = o;
        o.x = pk2(kv[0], kv[1]); o.y = pk2(kv[2], kv[3]); o.z = pk2(kv[4], kv[5]); o.w = pk2(kv[6], kv[7]);
        *(LAS v4u*)(KL + t * TP + 8 * q) = o;
#pragma unroll
        for (int qq = 0; qq < 4; ++qq) {
            const int e0 = 16 * q + 4 * qq;
            const unsigned vx = pf.v[qq].x, vy = pf.v[qq].y;
            VT[(e0 + 0) * TP + t] = (bf16)(vx & 0xffffu); VT[(e0 + 1) * TP + t] = (bf16)(vx >> 16); VT[(e0 + 2) * TP + t] = (bf16)(vy & 0xffffu); VT[(e0 + 3) * TP + t] = (bf16)(vy >> 16);
#pragma unroll
            for (int i = 0; i < 4; ++i) ST[(e0 + i) * TP + t] = (bf16)f2bf(pf.s[qq][i]);
        }
    }
    lds_barrier();
    {
        f32x4 av[2];
#pragma unroll
        for (int cc = 0; cc < 2; ++cc) { const int ct = 2 * wh + cc;
            f32x4 acc = {0.f, 0.f, 0.f, 0.f};
#pragma unroll
            for (int ks = 0; ks < 2; ++ks)
                acc = mfma16(*(const LAS bf16x8*)(KL + (ct * 16 + fr) * TP + ks * 32 + 8 * fq), *(const LAS bf16x8*)(QT + trow * TP + ks * 32 + 8 * fq), acc);
            const int s0 = ct * 16 + 4 * fq;
#pragma unroll
            for (int i = 0; i < 4; ++i) if (s0 + i > trow) acc[i] = 0.f;
            av[cc] = acc; }
#pragma unroll
        for (int cc = 0; cc < 2; ++cc) *(LAS v2u*)(AT + trow * TP + (2 * wh + cc) * 16 + 4 * fq) = pack4(av[cc]);
    }
    lds_barrier();
    f32x4 oacc[4]; float ssq = 0.f;
#pragma unroll
    for (int cc = 0; cc < 4; ++cc) { const int ct = wh * 4 + cc;
        f32x4 acc = {0.f, 0.f, 0.f, 0.f};
#pragma unroll
        for (int ks = 0; ks < 2; ++ks) {
            acc = mfma16(*(const LAS bf16x8*)(VT + (ct * 16 + fr) * TP + ks * 32 + 8 * fq), *(const LAS bf16x8*)(AT + trow * TP + ks * 32 + 8 * fq), acc);
            acc = mfma16(*(const LAS bf16x8*)(ST + (ct * 16 + fr) * TP + ks * 32 + 8 * fq), *(const LAS bf16x8*)(QT + trow * TP + ks * 32 + 8 * fq), acc);
        }
        oacc[cc] = acc; ssq += (acc[0] * acc[0] + acc[1] * acc[1]) + (acc[2] * acc[2] + acc[3] * acc[3]); }
    ssq += shx(ssq, 16, F.lane); ssq += shx(ssq, 32, F.lane);
    if (fq == 0) RS[wh * 64 + trow] = ssq;
    lds_barrier();
    {
        const float tot = RS[trow] + RS[64 + trow];
        const float rstd = 1.f / sqrtf(tot * (1.f / 128.f) + 1e-6f);
        const size_t m = (size_t)b * SEQ + (vp0 - NMETA) + trow;
#pragma unroll
        for (int cc = 0; cc < 4; ++cc) { const int e0 = (wh * 4 + cc) * 16 + 4 * fq;
            const f32x4 y = oacc[cc] * rstd * sg[cc];
            *(v2u*)(YMIX + m * D + h * 128 + e0) = pack4(y); }
    }
    lds_barrier();
}
__device__ __forceinline__ void phase4(const Args& a, const Frame& F) {
    for (int rep_ = 0; rep_ < NREP(21); ++rep_)
    for (int t = F.blk * NWAVES + F.wave; t < 128 * 32; t += F.G * NWAVES) { const Frame F1 = mkframe(F.lds, F.wave); rwkv_y_task(a, F1, t); }
    __syncthreads();
    for (int rep_ = 0; rep_ < NREP(22); ++rep_) {
        constexpr int NU = NB * 4 * 32;
        const int h = (F.blk >> 5) & 3;
        G3Const K;
        { const int d = F.tid & 63, wh = F.wave >> 2, fq = F.lane >> 4;
#pragma unroll
          for (int r = 0; r < 16; ++r) K.wc[r] = a.in[I_GKW2][r * 256 + h * 64 + d];
          K.gb = a.in[I_GKB][h * 64 + d];
#pragma unroll
          for (int cc = 0; cc < 4; ++cc) K.ng[cc] = *(const f32x4*)(a.in[I_GNORM] + (wh * 4 + cc) * 16 + 4 * fq); }
        G3Pf pa, pb;
        if (F.blk < NU) g3_fetch(a, F, F.blk >> 7, h, 1 + (F.blk & 31), pa);
        for (int u = F.blk; u < NU; u += 2 * F.G) {
            const int u1 = u + F.G, u2 = u + 2 * F.G;
            { const Frame F1 = mkframe(F.lds, F.wave);
              { const int uf = (u1 < NU) ? u1 : u; g3_fetch(a, F1, uf >> 7, h, 1 + (uf & 31), pb); }
              gla_g3_unit(a, F1, u >> 7, h, 1 + (u & 31), pa, K); }
            if (u1 < NU) { const Frame F1 = mkframe(F.lds, F.wave);
              { const int uf = (u2 < NU) ? u2 : u1; g3_fetch(a, F1, uf >> 7, h, 1 + (uf & 31), pa); }
              gla_g3_unit(a, F1, u1 >> 7, h, 1 + (u1 & 31), pb, K); }
        }
    }
}

__device__ __forceinline__ int eidx_of(int L) { return 16 * (L & 1) + 8 * ((L >> 1) & 1) + 4 * ((L >> 2) & 1) + 2 * ((L >> 3) & 1) + ((L >> 4) & 1); }
__device__ __forceinline__ void p6_row(const Args& a, const Frame& F, int m, const v4u (&a0)[2], const v4u (&mx)[2], const f32x4 (&g1)[4], const f32x4 (&b1)[4]) {
    unsigned char* ws = a.ws; bf16* H1 = (bf16*)(ws + WS_H1);
    float v[16];
#pragma unroll
    for (int j = 0; j < 2; ++j)
#pragma unroll
        for (int k = 0; k < 4; ++k) { v[8 * j + 2 * k] = ALPHA * bflo(a0[j][k]) + bflo(mx[j][k]); v[8 * j + 2 * k + 1] = ALPHA * bfhi(a0[j][k]) + bfhi(mx[j][k]); }
    float s = 0.f;
#pragma unroll
    for (int k = 0; k < 16; ++k) s += v[k];
    const float mean = wave_sum(s, F.lane) * (1.f / D); float s2 = 0.f;
#pragma unroll
    for (int k = 0; k < 16; ++k) { v[k] -= mean; s2 += v[k] * v[k]; }
    const float rstd = __builtin_amdgcn_rsqf(wave_sum(s2, F.lane) * (1.f / D) + 1e-5f);
#pragma unroll
    for (int j = 0; j < 2; ++j) {
#pragma unroll
        for (int k = 0; k < 8; ++k) v[8 * j + k] = v[8 * j + k] * rstd * g1[2 * j + (k >> 2)][k & 3] + b1[2 * j + (k >> 2)][k & 3];
        v4u o; o.x = pk2(v[8 * j], v[8 * j + 1]); o.y = pk2(v[8 * j + 2], v[8 * j + 3]); o.z = pk2(v[8 * j + 4], v[8 * j + 5]); o.w = pk2(v[8 * j + 6], v[8 * j + 7]);
        *(v4u*)(H1 + (size_t)m * D + 8 * F.lane + 512 * j) = o;
        int w0 = __builtin_amdgcn_cvt_pk_fp8_f32(v[8 * j], v[8 * j + 1], 0, false); w0 = __builtin_amdgcn_cvt_pk_fp8_f32(v[8 * j + 2], v[8 * j + 3], w0, true);
        int w1 = __builtin_amdgcn_cvt_pk_fp8_f32(v[8 * j + 4], v[8 * j + 5], 0, false); w1 = __builtin_amdgcn_cvt_pk_fp8_f32(v[8 * j + 6], v[8 * j + 7], w1, true);
        *(v2u*)(ws + WS_H1Q + (size_t)m * D + 8 * F.lane + 512 * j) = (v2u){(unsigned)w0, (unsigned)w1}; }
}
__device__ __forceinline__ void phase6(const Args& a, const Frame& F, int csel) {
    unsigned char* ws = a.ws;
    LAS float* LG = (LAS float*)(F.lds + F.wave * 2560);
    LAS int* hist = (LAS int*)(F.lds + 8 * 2560);
    bf16* H1 = (bf16*)(ws + WS_H1);
    const bf16* RWH = (const bf16*)(ws + WS_RWH); const bf16* RWL = (const bf16*)(ws + WS_RWL);
    int* TOPI = (int*)(ws + WS_TOPI); float* GATE = (float*)(ws + WS_GATE); int* RANK = (int*)(ws + WS_RANK);
    int* BCNT = (int*)(ws + WS_BCNT); (void)csel;
    for (int rb = F.blk; rb < MX / 128; rb += F.G) {
        if (F.tid < 64) hist[F.tid] = 0;
        __syncthreads();
        const int mb = rb * 128 + F.wave * 16; const Frame& Fo = F;
        {
            const bf16* ar0 = (const bf16*)(ws + WS_A0) + (size_t)mb * D + 8 * F.lane;
            const bf16* mr0 = (const bf16*)(ws + WS_MIXB) + (size_t)mb * D + 8 * F.lane;
            constexpr int NS = 6;
            v4u av[NS][2], mv[NS][2];
            f32x4 g1[4], b1[4];
#pragma unroll
            for (int q = 0; q < 4; ++q) { const int col = 8 * F.lane + 512 * (q >> 1) + 4 * (q & 1); g1[q] = *(const f32x4*)(a.in[I_LN1G] + col); b1[q] = *(const f32x4*)(a.in[I_LN1B] + col); }
#define P6_LOAD(ss, ii) do { _Pragma("unroll") for (int j = 0; j < 2; ++j) { av[ss][j] = *(const v4u*)(ar0 + (size_t)(ii) * D + 512 * j); mv[ss][j] = *(const v4u*)(mr0 + (size_t)(ii) * D + 512 * j); } } while (0)
#pragma unroll
            for (int i = 0; i < NS - 1; ++i) P6_LOAD(i, i);
            __builtin_amdgcn_sched_barrier(0);
#pragma unroll
            for (int i = 0; i < 16; ++i) {
                if (i + NS - 1 < 16) P6_LOAD((i + NS - 1) % NS, i + NS - 1);
                __builtin_amdgcn_sched_barrier(0);
                p6_row(a, F, mb + i, av[i % NS], mv[i % NS], g1, b1);
            }
#undef P6_LOAD
        }
        asm volatile("s_waitcnt vmcnt(0)" ::: "memory");
        for (int rep2_ = 0; rep2_ < NREP(24); ++rep2_)
        {
            const int fr = F.lane & 15, fq = F.lane >> 4;
            const bf16* ap = H1 + (size_t)(mb + fr) * D + 8 * fq;
            const bf16* bh = RWH + (size_t)fr * D + 8 * fq; const bf16* bl = RWL + (size_t)fr * D + 8 * fq;
            f32x4 acc0 = {0.f, 0.f, 0.f, 0.f}, acc1 = acc0;
#pragma unroll 8
            for (int ks = 0; ks < 32; ++ks) { const bf16x8 af = *(const bf16x8*)(ap + ks * 32);
                acc0 = mfma16(*(const bf16x8*)(bh + ks * 32), af, acc0); acc0 = mfma16(*(const bf16x8*)(bl + ks * 32), af, acc0);
                acc1 = mfma16(*(const bf16x8*)(bh + 16 * D + ks * 32), af, acc1); acc1 = mfma16(*(const bf16x8*)(bl + 16 * D + ks * 32), af, acc1); }
            const f32x4 rb0 = *(const f32x4*)(a.in[I_RTB] + 4 * fq), rb1 = *(const f32x4*)(a.in[I_RTB] + 16 + 4 * fq);
#pragma unroll
            for (int q = 0; q < 4; ++q) { LG[fr * 33 + 4 * fq + q] = acc0[q] + rb0[q]; LG[fr * 33 + 16 + 4 * fq + q] = acc1[q] + rb1[q]; }
        }
        asm volatile("s_waitcnt lgkmcnt(0)" ::: "memory");
        LAS int* EK = (LAS int*)(LG + 528);
        if (F.lane < 16) {
            float lv[32];
#pragma unroll
            for (int e = 0; e < 32; ++e) lv[e] = LG[F.lane * 33 + e];
            int ek[4]; float lk[4];
#pragma unroll
            for (int k = 0; k < 4; ++k) { float best = -3.0e38f; int bi = 0;
#pragma unroll
                for (int e = 0; e < 32; ++e) { const bool tk = lv[e] > best; best = tk ? lv[e] : best; bi = tk ? e : bi; }
                ek[k] = bi; lk[k] = best;
#pragma unroll
                for (int e = 0; e < 32; ++e) lv[e] = (e == bi) ? -3.0e38f : lv[e]; }
            const float e1 = expf(lk[1] - lk[0]), e2 = expf(lk[2] - lk[0]), e3 = expf(lk[3] - lk[0]);
            const float inv = 1.f / (1.f + e1 + e2 + e3);
            const size_t m = (size_t)(mb + F.lane);
            *(i32x4g*)(TOPI + m * 4) = (i32x4g){ek[0], ek[1], ek[2], ek[3]};
            *(f32x4*)(GATE + m * 4) = (f32x4){inv, e1 * inv, e2 * inv, e3 * inv};
#pragma unroll
            for (int k = 0; k < 4; ++k) EK[F.lane * 4 + k] = ek[k];
        }
        asm volatile("s_waitcnt lgkmcnt(0)" ::: "memory");
        const int my_e = EK[F.lane];
        const int lrank = __hip_atomic_fetch_add(&hist[my_e], 1, __ATOMIC_RELAXED, __HIP_MEMORY_SCOPE_WORKGROUP);
        __syncthreads();
        if (F.tid < 32) BCNT[rb * 32 + F.tid] = hist[F.tid];
        RANK[((size_t)rb * 128 + F.wave * 16 + (F.lane >> 2)) * 4 + (F.lane & 3)] = lrank;
        __syncthreads();
    }
}

__device__ __forceinline__ void phase7(const Args& a, const Frame& F) {
    unsigned char* ws = a.ws;
    LAS int* starts = (LAS int*)F.lds;
    LAS int* part = (LAS int*)(F.lds + 1024);
    const int* BCNT = (const int*)(ws + WS_BCNT);
    int* TILEE = (int*)(ws + WS_TILEE); int* SLOTTOK = (int*)(ws + WS_SLOTTOK);
    { const int e = F.tid & 31, pt = F.tid >> 5; int tot = 0, below = 0;
#pragma unroll
      for (int i = 0; i < 16; ++i) { const int bb = 16 * pt + i; const int v = BCNT[bb * 32 + e]; tot += v; below += (bb < F.blk) ? v : 0; }
      part[pt * 64 + e] = tot; part[pt * 64 + 32 + e] = below; }
    __syncthreads();
    if (F.tid < 32) { int cnt = 0, bb = 0;
#pragma unroll
        for (int pt = 0; pt < 16; ++pt) { cnt += part[pt * 64 + F.tid]; bb += part[pt * 64 + 32 + F.tid]; }
        starts[64 + F.tid] = cnt; starts[32 + F.tid] = (cnt + 255) & ~255; starts[96 + F.tid] = bb; }
    __syncthreads();
    if (F.tid == 0) { int run = 0; for (int e = 0; e < 32; ++e) { starts[e] = run; run += starts[32 + e]; }
        if (F.blk == 0) { TILEE[1023] = run >> 8; for (int e = 0; e < 32; ++e) for (int tl = starts[e] >> 8; tl < (starts[e] + starts[32 + e]) >> 8; ++tl) TILEE[tl] = e; } }
    __syncthreads();
    if (F.blk == 0) { for (int e = 0; e < 32; ++e) for (int s = starts[e] + starts[64 + e] + F.tid; s < starts[e] + starts[32 + e]; s += NTHR) SLOTTOK[s] = 0; }
    const int* TOPI = (const int*)(ws + WS_TOPI); const int* RANK = (const int*)(ws + WS_RANK); int* TSLOT = (int*)(ws + WS_TSLOT);
    static_assert(MX * 4 == 256 * NTHR, "one (token, k) pair per thread; the tokens of workgroup b are row block b of P6");
    { const int q = F.blk * NTHR + F.tid; const int e = TOPI[q];
      const int slot = starts[e] + starts[96 + e] + RANK[q];
      TSLOT[q] = slot; SLOTTOK[slot] = q >> 2; }
}
__device__ __forceinline__ int moe_fill_table(const Args& a, const Frame& F, int nN, int RM) {
    LAS int* tab = (LAS int*)(F.lds + TAB_OFF);
    const unsigned* TILEE = (const unsigned*)(a.ws + WS_TILEE);
    if (F.tid == 0) {
        const int NT = (int)ld_agent(TILEE + 1023);
        const int x = F.blk & 7, j = F.blk >> 3; int n = 0;
        for (int i = 0; i < 64; ++i) { const int s = i * 8 + x, pm = s * RM + j / nN; if (pm >= NT) break;
            const int e = (int)ld_agent(TILEE + pm); tab[2 * n] = pm; tab[2 * n + 1] = e * nN + (j % nN); ++n; }
        tab[128] = n;
    }
    __syncthreads();
    return __builtin_amdgcn_readfirstlane(tab[128]);
}

__device__ __forceinline__ void p10_acc(float (&s)[16], int j, const v4u w, float g) {
    s[8 * j + 0] += g * bflo(w.x); s[8 * j + 1] += g * bfhi(w.x); s[8 * j + 2] += g * bflo(w.y); s[8 * j + 3] += g * bfhi(w.y);
    s[8 * j + 4] += g * bflo(w.z); s[8 * j + 5] += g * bfhi(w.z); s[8 * j + 6] += g * bflo(w.w); s[8 * j + 7] += g * bfhi(w.w);
}
typedef float f32x2 __attribute__((ext_vector_type(2)));
__device__ __forceinline__ void p10_acc8(float (&s)[16], int j, const v2u w, float g) {
    const f32x2 a0 = __builtin_amdgcn_cvt_pk_f32_fp8((int)w.x, false), a1 = __builtin_amdgcn_cvt_pk_f32_fp8((int)w.x, true);
    const f32x2 a2 = __builtin_amdgcn_cvt_pk_f32_fp8((int)w.y, false), a3 = __builtin_amdgcn_cvt_pk_f32_fp8((int)w.y, true);
    s[8 * j + 0] += g * a0.x; s[8 * j + 1] += g * a0.y; s[8 * j + 2] += g * a1.x; s[8 * j + 3] += g * a1.y;
    s[8 * j + 4] += g * a2.x; s[8 * j + 5] += g * a2.y; s[8 * j + 6] += g * a3.x; s[8 * j + 7] += g * a3.y;
}
__device__ __forceinline__ void phase10(const Args& a, const Frame& F) {
    unsigned char* ws = a.ws;
    const bf16* H1 = (const bf16*)(ws + WS_H1); const unsigned char* YS = ws + WS_YS;
    const int* TSLOT = (const int*)(ws + WS_TSLOT); const float* GATE = (const float*)(ws + WS_GATE);
    const int gw = F.blk * NWAVES + F.wave, NGW = F.G * NWAVES;
    f32x4 gv[4], bv[4];
#pragma unroll
    for (int q = 0; q < 4; ++q) { const int col = 8 * F.lane + 512 * (q >> 1) + 4 * (q & 1); gv[q] = *(const f32x4*)(a.in[I_LN2G] + col); bv[q] = *(const f32x4*)(a.in[I_LN2B] + col); }
    for (int m0 = gw; m0 < MX; m0 += 2 * NGW) {
        int mm[2]; mm[0] = m0; mm[1] = (m0 + NGW < MX) ? m0 + NGW : m0;
        int slot[2][4]; float gt[2][4]; v4u hw[2][2]; v2u yw[2][4][2];
#pragma unroll
        for (int r = 0; r < 2; ++r) {
#pragma unroll
            for (int k = 0; k < 4; ++k) { slot[r][k] = TSLOT[(size_t)mm[r] * 4 + k]; gt[r][k] = GATE[(size_t)mm[r] * 4 + k]; }
#pragma unroll
            for (int j = 0; j < 2; ++j) hw[r][j] = *(const v4u*)(H1 + (size_t)mm[r] * D + 8 * F.lane + 512 * j); }
#pragma unroll
        for (int r = 0; r < 2; ++r)
#pragma unroll
            for (int k = 0; k < 4; ++k)
#pragma unroll
                for (int j = 0; j < 2; ++j) yw[r][k][j] = *(const v2u*)(YS + (size_t)slot[r][k] * D + 8 * F.lane + 512 * j);
#pragma unroll
        for (int r = 0; r < 2; ++r) {
            float s[16];
#pragma unroll
            for (int i = 0; i < 16; ++i) s[i] = 0.f;
#pragma unroll
            for (int j = 0; j < 2; ++j) p10_acc(s, j, hw[r][j], ALPHA);
#pragma unroll
            for (int k = 0; k < 4; ++k)
#pragma unroll
                for (int j = 0; j < 2; ++j) p10_acc8(s, j, yw[r][k][j], gt[r][k]);
            float t = 0.f;
#pragma unroll
            for (int i = 0; i < 16; ++i) t += s[i];
            const float mean = wave_sum(t, F.lane) * (1.f / D); float q = 0.f;
#pragma unroll
            for (int i = 0; i < 16; ++i) { s[i] -= mean; q += s[i] * s[i]; }
            const float rstd = __builtin_amdgcn_rsqf(wave_sum(q, F.lane) * (1.f / D) + 1e-5f);
            if (r == 0 || mm[1] != mm[0]) {
#pragma unroll
                for (int q4 = 0; q4 < 4; ++q4) { const int col = 8 * F.lane + 512 * (q4 >> 1) + 4 * (q4 & 1);
                    f32x4 o; o.x = s[4 * q4 + 0] * rstd * gv[q4].x + bv[q4].x; o.y = s[4 * q4 + 1] * rstd * gv[q4].y + bv[q4].y; o.z = s[4 * q4 + 2] * rstd * gv[q4].z + bv[q4].z; o.w = s[4 * q4 + 3] * rstd * gv[q4].w + bv[q4].w;
                    *(f32x4*)(a.out + (size_t)mm[r] * D + col) = o; } }
        }
    }
}

template <int LO, int HI>
__global__ void __launch_bounds__(NTHR, 2) fwd(Args a) {
    extern __shared__ __attribute__((aligned(16))) unsigned char lds_raw[];
    LAS unsigned char* lds = (LAS unsigned char*)lds_raw;
    const int wave = __builtin_amdgcn_readfirstlane((int)(threadIdx.x >> 6));
    volatile LAS unsigned* MISC = (volatile LAS unsigned*)(lds + MISC_OFF);
    if (wave == 0) MISC[lane_id()] = 0u;
    __syncthreads();
    unsigned* ctl = (unsigned*)(a.ws + WS_CTL);
    XcdBarrier bar; bar.bar = ctl + CW_BAR; bar.x = 0; bar.st = nullptr;
    if constexpr (HI - LO > 1) bar = xcd_barrier_post(ctl + CW_BAR, MISC + 8, wave == 0 && lane_id() == 0);
#define PH(k) if constexpr (LO <= (k) && (k) < HI)
#define SEAM(k) if constexpr (LO <= (k) && (k) + 1 < HI) xcd_barrier(bar, wave == 0 && lane_id() == 0)
    PH(0) for (int rep_ = 0; rep_ < NREP(0); ++rep_) { const Frame F = mkframe(lds, wave); phase0(a, F); } SEAM(0);
    PH(1) if constexpr (((REP_MASK >> 25) & 1) != 0) { const Frame F = mkframe(lds, wave);
            struct FakeOrder { pg8::StaticOrder S; __device__ bool next(int i, pg8::Unit& u) const { const bool ok = S.next(i, u); u.pm = 0; u.pn = 0; return ok; }
                               __device__ void a_ready(const pg8::Unit&) const {} __device__ void done(const pg8::Unit&) const {} };
            pg8::Gemm g{(const pg8::bf16_t*)(a.ws + WS_A0), (const pg8::bf16_t*)(a.ws + WS_WIN), MX, PW, D}; FakeOrder S; S.S.init(MX, PW, F.G, F.blk);
            pg8::EpiBf16Plain E{(pg8::bf16_t*)(a.ws + WS_PROJ), PW};
            pg8::gemm_phase<pg8::EpiBf16Plain, FakeOrder, true, true>(F.lds, g, S, E, F.tid); }
    PH(1) for (int rep_ = 0; rep_ < NREP(1); ++rep_) { const Frame F = mkframe(lds, wave);
            pg8::Gemm g{(const pg8::bf16_t*)(a.ws + WS_A0), (const pg8::bf16_t*)(a.ws + WS_WIN), MX, PW, D}; pg8::StaticOrder S; S.init(MX, PW, F.G, F.blk);
            pg8::EpiBf16Plain E{(pg8::bf16_t*)(a.ws + WS_PROJ), PW};
            pg8::gemm_phase<pg8::EpiBf16Plain, pg8::StaticOrder, true, true>(F.lds, g, S, E, F.tid); } SEAM(1);
    PH(2) for (int rep_ = 0; rep_ < NREP(2); ++rep_) { const Frame F = mkframe(lds, wave); phase2(a, F); } SEAM(2);
    PH(3) { const Frame F = mkframe(lds, wave); phase3(a, F); } SEAM(3);
    PH(4) for (int rep_ = 0; rep_ < NREP(4); ++rep_) { const Frame F = mkframe(lds, wave); phase4(a, F); } SEAM(4);
    PH(5) for (int rep_ = 0; rep_ < NREP(5); ++rep_) { const Frame F = mkframe(lds, wave);
            pg8::Gemm g{(const pg8::bf16_t*)(a.ws + WS_YMIX), (const pg8::bf16_t*)(a.ws + WS_WOUT), MX, D, D}; pg8::StaticOrder S; S.init(MX, D, F.G, F.blk);
            pg8::EpiBf16Plain E{(pg8::bf16_t*)(a.ws + WS_MIXB), D};
            pg8::gemm_phase<pg8::EpiBf16Plain, pg8::StaticOrder, true, true>(F.lds, g, S, E, F.tid); } SEAM(5);
    PH(6) for (int rep_ = 0; rep_ < NREP(6); ++rep_) { const Frame F = mkframe(lds, wave); phase6(a, F, rep_); } SEAM(6);
    PH(7) for (int rep_ = 0; rep_ < NREP(7); ++rep_) { const Frame F = mkframe(lds, wave); phase7(a, F); } SEAM(7);
    PH(8) for (int rep_ = 0; rep_ < NREP(8); ++rep_) { const Frame F = mkframe(lds, wave); const int n = moe_fill_table(a, F, 8, 4);
            pg8::Gemm g{(const pg8::bf16_t*)(a.ws + WS_H1Q), (const pg8::bf16_t*)(a.ws + WS_WUP), 0, 0, D / 2}; pg8::TableOrder S{(const LAS int*)(F.lds + TAB_OFF), n};
            pg8::EpiSwiglu8 E{a.ws + WS_ACT, a.in[I_BUP]};
            pg8::gemm_phase_g<pg8::EpiSwiglu8, pg8::TableOrder, true, true, 121>(F.lds, g, S, E, F.tid, (const int*)(a.ws + WS_SLOTTOK)); } SEAM(8);
    PH(9) for (int rep_ = 0; rep_ < NREP(9); ++rep_) { const Frame F = mkframe(lds, wave); const int n = moe_fill_table(a, F, 4, 8);
            pg8::Gemm g{(const pg8::bf16_t*)(a.ws + WS_ACT), (const pg8::bf16_t*)(a.ws + WS_WDN), 0, 0, D / 2}; pg8::TableOrder S{(const LAS int*)(F.lds + TAB_OFF), n};
            pg8::EpiDown8 E{a.ws + WS_YS, a.in[I_BDN]};
            pg8::gemm_phase<pg8::EpiDown8, pg8::TableOrder, true, true, 120>(F.lds, g, S, E, F.tid); } SEAM(9);
    PH(10) for (int rep_ = 0; rep_ < NREP(10); ++rep_) { const Frame F = mkframe(lds, wave); phase10(a, F); }
#undef PH
#undef SEAM
}

#ifndef MK_SINGLE
#define MK_SINGLE 1
#endif
template <int LO, int HI> static void launch_range(const Args& a, int grid, hipStream_t stream) {
    static bool attr = false;
    if (!attr) { (void)hipFuncSetAttribute((const void*)fwd<LO, HI>, hipFuncAttributeMaxDynamicSharedMemorySize, LDS_BYTES); attr = true; }
    hipLaunchKernelGGL((fwd<LO, HI>), dim3(grid), dim3(NTHR), LDS_BYTES, stream, a);
}
extern "C" void kernel_launch(void* const* d_in, const int* in_sizes, int n_in, void* d_out, int out_size, void* d_ws, size_t ws_size, hipStream_t stream) {
    if (n_in != 30 || ws_size < WS_END) { fprintf(stderr, "kernel_launch: unexpected inputs (n_in %d, ws %zu)\n", n_in, ws_size); return; }
    const int grid = 256;
    (void)hipMemsetAsync((char*)d_ws + WS_CTL, 0, CTL_ZERO_BYTES, stream);
    Args a{};
    for (int i = 0; i < 30; ++i) a.in[i] = (const float*)d_in[i];
    a.out = (float*)d_out; a.ws = (unsigned char*)d_ws;
#if MK_SINGLE
    launch_range<0, 11>(a, grid, stream);
#else
    launch_range<0, 1>(a, grid, stream); launch_range<1, 2>(a, grid, stream); launch_range<2, 3>(a, grid, stream); launch_range<3, 4>(a, grid, stream);
    launch_range<4, 5>(a, grid, stream); launch_range<5, 6>(a, grid, stream); launch_range<6, 7>(a, grid, stream); launch_range<7, 8>(a, grid, stream);
    launch_range<8, 9>(a, grid, stream); launch_range<9, 10>(a, grid, stream); launch_range<10, 11>(a, grid, stream);
#endif
}
```

```cpp
#include <hip/hip_runtime.h>
#include <cstdio>
#include <cstdint>
#include <cmath>
namespace pg8 {
#define PG8_LAS __attribute__((address_space(3)))
typedef unsigned short bf16_t;
typedef short bf16x8 __attribute__((ext_vector_type(8)));
typedef float f32x4 __attribute__((ext_vector_type(4)));
typedef unsigned u32x4 __attribute__((ext_vector_type(4)));
constexpr int BM = 256, BK = 64, HALF = 128, HTB = HALF * BK * 2  , STAGE_BYTES = 8 * HTB, NXCD = 8, WGM = 8;

__host__ __device__ __forceinline__ int lds_byte(int r, int c) { const int ob = c * 2, rr = r & 7; return (r >> 3) * 1024 + rr * 128 + ((((ob >> 4) ^ rr) & 7) << 4) + (ob & 15); }
__host__ __device__ __forceinline__ void stage_rc(int b, int& R, int& C) { const int P = b / 1024, sb = b % 1024, rr = sb >> 7, ch = (sb >> 4) & 7; R = P * 8 + rr; C = (((ch ^ rr) << 4) + (sb & 15)) >> 1; }
__host__ __device__ __forceinline__ int perm32(int rho) { const int n = rho >> 4, i = rho & 15; return 8 * (i >> 2) + 4 * n + (i & 3); }

struct Unit { int pm, pn; };
struct Gemm { const bf16_t* A; const bf16_t* Bt; int M, N, K; };

struct StaticOrder {
    int nM, nN, nwg, G, c;
    __host__ __device__ void init(int M, int N, int G_, int c_) { nM = M / BM; nN = N / BM; nwg = nM * nN; G = G_; c = c_; }
    __host__ __device__ bool next(int i, Unit& u) const {
        const long L = (long)i * G + c; if (L >= nwg) return false;
        int wgid = (int)L; { const int q = nwg / NXCD, r = nwg % NXCD, xcd = wgid % NXCD, off = wgid / NXCD; wgid = (xcd < r ? xcd * (q + 1) : r * (q + 1) + (xcd - r) * q) + off; }
        const int nig = WGM * nN, gid = wgid / nig, fm = gid * WGM, gsz = (nM - fm) < WGM ? (nM - fm) : WGM;
        u.pm = fm + ((wgid % nig) % gsz); u.pn = (wgid % nig) / gsz; return true;
    }
    __device__ __forceinline__ void a_ready(const Unit&) const {}
    __device__ __forceinline__ void done(const Unit&) const {}
};


__device__ __forceinline__ unsigned cvt_pk_bf16(float lo, float hi) { unsigned r; asm volatile("v_cvt_pk_bf16_f32 %0, %1, %2" : "=v"(r) : "v"(lo), "v"(hi)); return r; }
typedef unsigned u32x2 __attribute__((ext_vector_type(2)));
typedef int i32x8 __attribute__((ext_vector_type(8))); typedef int i32x4 __attribute__((ext_vector_type(4)));
__device__ __forceinline__ void mfma_f8(f32x4& acc, i32x8 a, i32x8 b, int sa, int sb) {
    asm volatile("s_nop 1\n\tv_mfma_scale_f32_16x16x128_f8f6f4 %0, %1, %2, %0, %3, %4 op_sel_hi:[0,0,0]" : "+v"(acc) : "v"(a), "v"(b), "v"(sa), "v"(sb));
}
__device__ __forceinline__ i32x8 cat8(bf16x8 lo, bf16x8 hi) { const i32x4 a = __builtin_bit_cast(i32x4, lo), b = __builtin_bit_cast(i32x4, hi); return __builtin_shufflevector(a, b, 0, 1, 2, 3, 4, 5, 6, 7); }

struct EpiBf16Plain {
    static constexpr bool PERM = true, AFTER_DRAIN = false, HAS_BIAS = false;
    bf16_t* O; int ldc;
    __device__ __forceinline__ const float* bias_ptr(const Unit&) const { return nullptr; }
    __device__ __forceinline__ void operator()(const f32x4 (&acc)[2][2][4][2], const Unit& u, int wr, int wc, int fr, int fq, const PG8_LAS float*) const {
        const int row0 = u.pm * BM + wr * 64 + fr, col0 = u.pn * BM + wc * 32 + 8 * fq;
#pragma unroll
        for (int ai = 0; ai < 2; ++ai)
#pragma unroll
            for (int m = 0; m < 4; ++m) { bf16_t* rowp = O + (size_t)(row0 + ai * HALF + m * 16) * ldc + col0;
#pragma unroll
                for (int bj = 0; bj < 2; ++bj) { const f32x4 v0 = acc[ai][bj][m][0], v1 = acc[ai][bj][m][1];
                    u32x4 w; w.x = cvt_pk_bf16(v0[0], v0[1]); w.y = cvt_pk_bf16(v0[2], v0[3]); w.z = cvt_pk_bf16(v1[0], v1[1]); w.w = cvt_pk_bf16(v1[2], v1[3]);
                    *(u32x4*)(rowp + bj * HALF) = w; } }
    }
};

__device__ __forceinline__ float swiglu1(float glu, float lin) {
    const float xg = fminf(glu, 7.0f), xl = fminf(fmaxf(lin, -7.0f), 7.0f);
    const float sg = __builtin_amdgcn_rcpf(1.0f + __expf(-1.702f * xg));
    return xg * sg * (xl + 1.0f);
}
struct EpiSwiglu8 {
    static constexpr bool PERM = true, AFTER_DRAIN = false, HAS_BIAS = true;
    unsigned char* ACT; const float* bup;
    __device__ __forceinline__ const float* bias_ptr(const Unit& u) const { return bup + (size_t)(u.pn >> 3) * 2048 + (u.pn & 7) * BM; }
    __device__ __forceinline__ void operator()(const f32x4 (&acc)[2][2][4][2], const Unit& u, int wr, int wc, int fr, int fq, const PG8_LAS float* bl) const {
        const int pn = u.pn & 7;
        const int row0 = u.pm * BM + wr * 64 + fr, ucol0 = pn * BM + wc * 32 + 8 * fq, acol0 = ucol0 >> 1;
        f32x4 bv[2][2];
#pragma unroll
        for (int bj = 0; bj < 2; ++bj)
#pragma unroll
            for (int n = 0; n < 2; ++n) bv[bj][n] = *(const PG8_LAS f32x4*)(bl + wc * 32 + 8 * fq + bj * HALF + 4 * n);
#pragma unroll
        for (int ai = 0; ai < 2; ++ai)
#pragma unroll
            for (int m = 0; m < 4; ++m) { unsigned char* rowp = ACT + (size_t)(row0 + ai * HALF + m * 16) * 1024 + acol0;
#pragma unroll
                for (int bj = 0; bj < 2; ++bj) { const f32x4 v0 = acc[ai][bj][m][0] + bv[bj][0], v1 = acc[ai][bj][m][1] + bv[bj][1];
                    int w = __builtin_amdgcn_cvt_pk_fp8_f32(swiglu1(v0[0], v0[1]), swiglu1(v0[2], v0[3]), 0, false);
                    w = __builtin_amdgcn_cvt_pk_fp8_f32(swiglu1(v1[0], v1[1]), swiglu1(v1[2], v1[3]), w, true);
                    *(int*)(rowp + bj * (HALF / 2)) = w; } }
    }
};
struct EpiDown8 {
    static constexpr bool PERM = true, AFTER_DRAIN = false, HAS_BIAS = true;
    unsigned char* YS; const float* bdn;
    __device__ __forceinline__ const float* bias_ptr(const Unit& u) const { return bdn + (size_t)(u.pn >> 2) * 1024 + (u.pn & 3) * BM; }
    __device__ __forceinline__ void operator()(const f32x4 (&acc)[2][2][4][2], const Unit& u, int wr, int wc, int fr, int fq, const PG8_LAS float* bl) const {
        const int pn = u.pn & 3;
        const int row0 = u.pm * BM + wr * 64 + fr, col0 = pn * BM + wc * 32 + 8 * fq;
        f32x4 bv[2][2];
#pragma unroll
        for (int bj = 0; bj < 2; ++bj)
#pragma unroll
            for (int n = 0; n < 2; ++n) bv[bj][n] = *(const PG8_LAS f32x4*)(bl + wc * 32 + 8 * fq + bj * HALF + 4 * n);
#pragma unroll
        for (int ai = 0; ai < 2; ++ai)
#pragma unroll
            for (int m = 0; m < 4; ++m) { unsigned char* rowp = YS + (size_t)(row0 + ai * HALF + m * 16) * 1024 + col0;
#pragma unroll
                for (int bj = 0; bj < 2; ++bj) { const f32x4 v0 = acc[ai][bj][m][0] + bv[bj][0], v1 = acc[ai][bj][m][1] + bv[bj][1];
                    int w0 = __builtin_amdgcn_cvt_pk_fp8_f32(v0[0], v0[1], 0, false); w0 = __builtin_amdgcn_cvt_pk_fp8_f32(v0[2], v0[3], w0, true);
                    int w1 = __builtin_amdgcn_cvt_pk_fp8_f32(v1[0], v1[1], 0, false); w1 = __builtin_amdgcn_cvt_pk_fp8_f32(v1[2], v1[3], w1, true);
                    u32x2 w; w.x = (unsigned)w0; w.y = (unsigned)w1;
                    *(u32x2*)(rowp + bj * HALF) = w; } }
    }
};
struct TableOrder {
    const PG8_LAS int* tab; int n;
    __device__ __forceinline__ bool next(int i, Unit& u) const {
        if (i >= n) return false;
        u.pm = __builtin_amdgcn_readfirstlane(tab[2 * i]); u.pn = __builtin_amdgcn_readfirstlane(tab[2 * i + 1]); return true;
    }
    __device__ __forceinline__ void a_ready(const Unit&) const {}
    __device__ __forceinline__ void done(const Unit&) const {}
};

constexpr int ROWS_LDS = 131072;
constexpr int BIAS_LDS = 133120;
template <class Epi, class Sched, bool ALIGN_EPI = false, bool SP2 = false, int SCW = 0>
__device__ __forceinline__ void gemm_phase(PG8_LAS unsigned char* lds, const Gemm g, const Sched& S, const Epi& E, const int tid) {
    static_assert(SP2, "two-super-phase form only");
    const int wid = __builtin_amdgcn_readfirstlane(tid >> 6), lane = tid & 63, wr = wid >> 2, wc = wid & 3, fr = lane & 15, fq = lane >> 4;
    int K_ = g.K; asm volatile("" : "+s"(K_));
    const int K = K_, nt = K / BK;
    constexpr int EXTRA = 16 + (Epi::HAS_BIAS ? 1 : 0);
    unsigned voffA, voffB;
    { int R, C; stage_rc(tid * 16, R, C); const int Rb = Epi::PERM ? ((R & ~31) + perm32(R & 31)) : R;
      voffA = (unsigned)(R * K + C) * 2u; voffB = (unsigned)(Rb * K + C) * 2u; }
    const size_t qstep = (size_t)64 * K * 2;
    const size_t kstep = (size_t)(BK * 2);
    const size_t hstep = (size_t)HALF * K * 2;
    const size_t tstep = 2 * hstep;
    const unsigned ldsw = (unsigned)wid * 1024u;
    const int aoff = lds_byte(wr * 64 + fr, fq * 8), boff = lds_byte(wc * 32 + fr, fq * 8);
#define PG8_SA(b, h) (((b) * 2 + (h)) * HTB)
#define PG8_SB(b, h) ((4 + (b) * 2 + (h)) * HTB)
#define PG8_STAGE(bufoff, gbase, voff) do { _Pragma("unroll") for (int _i = 0; _i < 2; ++_i) { const char* _g = (const char*)(gbase) + (size_t)_i * qstep; asm volatile("" : "+s"(_g)); \
        __builtin_amdgcn_global_load_lds((const unsigned*)(_g + (voff)), (PG8_LAS unsigned*)(lds + (bufoff) + ldsw + _i * 8192), 16, 0, 0); } } while (0)
#define PG8_STAGE2(bufoff, gbase, voff) do { const char* _g = (const char*)(gbase); asm volatile("" : "+s"(_g)); _Pragma("unroll") for (int _i = 0; _i < 2; ++_i) \
        __builtin_amdgcn_global_load_lds((const unsigned*)(_g + (voff)[_i]), (PG8_LAS unsigned*)(lds + (bufoff) + ldsw + _i * 8192), 16, 0, 0); } while (0)
#define PG8_LDA(dst, b, h) do { int _x; asm volatile("v_xor_b32 %0, 64, %1" : "=v"(_x) : "v"(aoff)); _Pragma("unroll") for (int m = 0; m < 4; ++m) _Pragma("unroll") for (int k = 0; k < 2; ++k) dst[m][k] = *(const PG8_LAS bf16x8*)(lds + PG8_SA(b, h) + (k ? _x : aoff) + m * 2048); } while (0)
#define PG8_LDB(dst, b, h) do { int _x; asm volatile("v_xor_b32 %0, 64, %1" : "=v"(_x) : "v"(boff)); _Pragma("unroll") for (int n = 0; n < 2; ++n) _Pragma("unroll") for (int k = 0; k < 2; ++k) dst[n][k] = *(const PG8_LAS bf16x8*)(lds + PG8_SB(b, h) + (k ? _x : boff) + n * 2048); } while (0)
#define PG8_MMA(ai, bj, At, Bt) do { __builtin_amdgcn_s_setprio(1); _Pragma("unroll") for (int m = 0; m < 4; ++m) _Pragma("unroll") for (int n = 0; n < 2; ++n) { \
        if constexpr (SCW != 0) mfma_f8(acc[ai][bj][m][n], cat8(Bt[n][0], Bt[n][1]), cat8(At[m][0], At[m][1]), SCW * 0x01010101, 0x7f7f7f7f); \
        else { _Pragma("unroll") for (int k = 0; k < 2; ++k) acc[ai][bj][m][n] = __builtin_amdgcn_mfma_f32_16x16x32_bf16(Bt[n][k], At[m][k], acc[ai][bj][m][n], 0, 0, 0); } } __builtin_amdgcn_s_setprio(0); } while (0)
#define PG8_WAIT_V(n) asm volatile("s_waitcnt vmcnt(" #n ")" ::: "memory")
#define PG8_WAIT_VX(aft_) do { if (aft_) asm volatile("s_waitcnt vmcnt(%0)" :: "i"(8 + EXTRA) : "memory"); else asm volatile("s_waitcnt vmcnt(8)" ::: "memory"); } while (0)
#define PG8_WAIT_L(n) asm volatile("s_waitcnt lgkmcnt(" #n ")" ::: "memory")
#define PG8_BAR __builtin_amdgcn_s_barrier()
#define PG8_SCHED __builtin_amdgcn_sched_barrier(0)
#define PG8_BIAS(u_) do { if constexpr (Epi::HAS_BIAS) __builtin_amdgcn_global_load_lds((const unsigned*)(E.bias_ptr(u_) + 4 * lane), (PG8_LAS unsigned*)(lds + BIAS_LDS + wid * 1024), 16, 0, 0); } while (0)
    Unit cur, nxt; int ui = 0;
    if (!S.next(0, cur)) return;
    f32x4 acc[2][2][4][2];
#pragma unroll
    for (int a = 0; a < 2; ++a)
#pragma unroll
        for (int b = 0; b < 2; ++b)
#pragma unroll
            for (int m = 0; m < 4; ++m)
#pragma unroll
                for (int n = 0; n < 2; ++n) acc[a][b][m][n] = (f32x4){0.f, 0.f, 0.f, 0.f};
    bf16x8 At[4][2], B0[2][2], B1[2][2];
    const PG8_LAS float* biasl = (const PG8_LAS float*)(lds + BIAS_LDS + wid * 1024);
    PG8_BIAS(cur);
    const char* cA = (const char*)g.A + (size_t)cur.pm * tstep; const char* cB = (const char*)g.Bt + (size_t)cur.pn * tstep;
    S.a_ready(cur);
    PG8_STAGE(PG8_SB(0, 0), cB, voffB); PG8_STAGE(PG8_SB(0, 1), cB + hstep, voffB); PG8_STAGE(PG8_SA(0, 0), cA, voffA); PG8_STAGE(PG8_SA(0, 1), cA + hstep, voffA);
    if (wr == 1) PG8_BAR;
    PG8_WAIT_V(2); PG8_BAR;
    PG8_STAGE(PG8_SB(1, 0), cB + kstep, voffB); PG8_STAGE(PG8_SA(1, 0), cA + kstep, voffA); PG8_STAGE(PG8_SB(1, 1), cB + hstep + kstep, voffB); PG8_STAGE(PG8_SA(1, 1), cA + hstep + kstep, voffA);
    PG8_WAIT_V(8); PG8_BAR;
    for (;;) {
        const bool has_next = S.next(ui + 1, nxt);
        const char* nA = has_next ? (const char*)g.A + (size_t)nxt.pm * tstep : cA; const char* nB = has_next ? (const char*)g.Bt + (size_t)nxt.pn * tstep : cB;
        for (int t = 0; t < nt; t += 2) {
            const bool last = (t == nt - 2);
            const bool aft = (t == 0) && (ui > 0);
            const char* a1 = cA + (size_t)(t + 1) * kstep;
            const char* a2 = last ? nA : cA + (size_t)(t + 2) * kstep; const char* b2 = last ? nB : cB + (size_t)(t + 2) * kstep;
            const char* a3 = a2 + kstep; const char* b3 = b2 + kstep;
            if (last && has_next) S.a_ready(nxt);
            PG8_LDB(B0, 0, 0); PG8_LDB(B1, 0, 1); PG8_SCHED; PG8_LDA(At, 0, 0); if (t > 0) PG8_STAGE(PG8_SA(1, 1), a1 + hstep, voffA);
            PG8_WAIT_VX(aft); PG8_WAIT_L(0); PG8_BAR; PG8_MMA(0, 0, At, B0); PG8_MMA(0, 1, At, B1); PG8_BAR; PG8_SCHED;
            PG8_LDA(At, 0, 1); PG8_STAGE(PG8_SB(0, 0), b2, voffB); PG8_STAGE(PG8_SB(0, 1), b2 + hstep, voffB); PG8_STAGE(PG8_SA(0, 0), a2, voffA);
            PG8_WAIT_VX(aft); PG8_WAIT_L(0); PG8_BAR; PG8_MMA(1, 0, At, B0); PG8_MMA(1, 1, At, B1); PG8_BAR; PG8_SCHED;
            PG8_LDB(B0, 1, 0); PG8_LDB(B1, 1, 1); PG8_SCHED; PG8_LDA(At, 1, 0); PG8_STAGE(PG8_SA(0, 1), a2 + hstep, voffA);
            PG8_WAIT_VX(aft); PG8_WAIT_L(0); PG8_BAR; PG8_MMA(0, 0, At, B0); PG8_MMA(0, 1, At, B1); PG8_BAR; PG8_SCHED;
            PG8_LDA(At, 1, 1); PG8_STAGE(PG8_SB(1, 0), b3, voffB); PG8_STAGE(PG8_SB(1, 1), b3 + hstep, voffB); PG8_STAGE(PG8_SA(1, 0), a3, voffA);
            PG8_WAIT_V(8); PG8_WAIT_L(0); PG8_BAR; PG8_MMA(1, 0, At, B0); PG8_MMA(1, 1, At, B1); PG8_BAR; PG8_SCHED;
        }
        if (has_next) { PG8_STAGE(PG8_SA(1, 1), nA + hstep + kstep, voffA); }
        asm volatile("" ::: "memory"); PG8_SCHED;
        if constexpr (SCW != 0) asm volatile("s_nop 15\n\ts_nop 15" ::: "memory");
        if constexpr (ALIGN_EPI) { if (wr == 0) PG8_BAR; }
        E(acc, cur, wr, wc, fr, fq, biasl); S.done(cur);
        if (!has_next) break;
#pragma unroll
            for (int a = 0; a < 2; ++a)
#pragma unroll
            for (int b = 0; b < 2; ++b)
#pragma unroll
                for (int m = 0; m < 4; ++m)
#pragma unroll
                    for (int n = 0; n < 2; ++n) acc[a][b][m][n] = (f32x4){0.f, 0.f, 0.f, 0.f};
        cur = nxt; cA = nA; cB = nB; ++ui;
        asm volatile("s_waitcnt lgkmcnt(0)" ::: "memory");
        PG8_BIAS(cur);
        if constexpr (ALIGN_EPI) { if (wr == 1) PG8_BAR; }
    }
    PG8_WAIT_V(0);
    if constexpr (!ALIGN_EPI) { if (wr == 0) PG8_BAR; }
    PG8_BAR;
#undef PG8_SA
#undef PG8_SB
#undef PG8_STAGE
#undef PG8_STAGE2
#undef PG8_LDA
#undef PG8_LDB
#undef PG8_MMA
#undef PG8_WAIT_V
#undef PG8_WAIT_VX
#undef PG8_WAIT_L
#undef PG8_BAR
#undef PG8_SCHED
#undef PG8_BIAS
}
template <class Epi, class Sched, bool ALIGN_EPI = false, bool SP2 = false, int SCW = 0>
__device__ __forceinline__ void gemm_phase_g(PG8_LAS unsigned char* lds, const Gemm g, const Sched& S, const Epi& E, const int tid, const int* rowmap) {
    static_assert(SP2, "two-super-phase form only");
    const int wid = __builtin_amdgcn_readfirstlane(tid >> 6), lane = tid & 63, wr = wid >> 2, wc = wid & 3, fr = lane & 15, fq = lane >> 4;
    int K_ = g.K; asm volatile("" : "+s"(K_));
    const int K = K_, nt = K / BK;
    constexpr int EXTRA = 16 + (Epi::HAS_BIAS ? 1 : 0) + 1;
    unsigned voffB, cv0[2], cv1[2]; int RA0, CA0;
    { int R, C; stage_rc(tid * 16, R, C); const int Rb = Epi::PERM ? ((R & ~31) + perm32(R & 31)) : R;
      RA0 = R; CA0 = C; voffB = (unsigned)(Rb * K + C) * 2u; }
    const size_t qstep = (size_t)64 * K * 2;
    const size_t kstep = (size_t)(BK * 2);
    const size_t hstep = (size_t)HALF * K * 2;
    const size_t tstep = 2 * hstep;
    const unsigned ldsw = (unsigned)wid * 1024u;
    const int aoff = lds_byte(wr * 64 + fr, fq * 8), boff = lds_byte(wc * 32 + fr, fq * 8);
#define PG8_SA(b, h) (((b) * 2 + (h)) * HTB)
#define PG8_SB(b, h) ((4 + (b) * 2 + (h)) * HTB)
#define PG8_STAGE(bufoff, gbase, voff) do { _Pragma("unroll") for (int _i = 0; _i < 2; ++_i) { const char* _g = (const char*)(gbase) + (size_t)_i * qstep; asm volatile("" : "+s"(_g)); \
        __builtin_amdgcn_global_load_lds((const unsigned*)(_g + (voff)), (PG8_LAS unsigned*)(lds + (bufoff) + ldsw + _i * 8192), 16, 0, 0); } } while (0)
#define PG8_STAGE2(bufoff, gbase, voff) do { const char* _g = (const char*)(gbase); asm volatile("" : "+s"(_g)); _Pragma("unroll") for (int _i = 0; _i < 2; ++_i) \
        __builtin_amdgcn_global_load_lds((const unsigned*)(_g + (voff)[_i]), (PG8_LAS unsigned*)(lds + (bufoff) + ldsw + _i * 8192), 16, 0, 0); } while (0)
#define PG8_LDA(dst, b, h) do { int _x; asm volatile("v_xor_b32 %0, 64, %1" : "=v"(_x) : "v"(aoff)); _Pragma("unroll") for (int m = 0; m < 4; ++m) _Pragma("unroll") for (int k = 0; k < 2; ++k) dst[m][k] = *(const PG8_LAS bf16x8*)(lds + PG8_SA(b, h) + (k ? _x : aoff) + m * 2048); } while (0)
#define PG8_LDB(dst, b, h) do { int _x; asm volatile("v_xor_b32 %0, 64, %1" : "=v"(_x) : "v"(boff)); _Pragma("unroll") for (int n = 0; n < 2; ++n) _Pragma("unroll") for (int k = 0; k < 2; ++k) dst[n][k] = *(const PG8_LAS bf16x8*)(lds + PG8_SB(b, h) + (k ? _x : boff) + n * 2048); } while (0)
#define PG8_MMA(ai, bj, At, Bt) do { __builtin_amdgcn_s_setprio(1); _Pragma("unroll") for (int m = 0; m < 4; ++m) _Pragma("unroll") for (int n = 0; n < 2; ++n) { \
        if constexpr (SCW != 0) mfma_f8(acc[ai][bj][m][n], cat8(Bt[n][0], Bt[n][1]), cat8(At[m][0], At[m][1]), SCW * 0x01010101, 0x7f7f7f7f); \
        else { _Pragma("unroll") for (int k = 0; k < 2; ++k) acc[ai][bj][m][n] = __builtin_amdgcn_mfma_f32_16x16x32_bf16(Bt[n][k], At[m][k], acc[ai][bj][m][n], 0, 0, 0); } } __builtin_amdgcn_s_setprio(0); } while (0)
#define PG8_WAIT_V(n) asm volatile("s_waitcnt vmcnt(" #n ")" ::: "memory")
#define PG8_WAIT_VX(aft_) do { if (aft_) asm volatile("s_waitcnt vmcnt(%0)" :: "i"(8 + EXTRA) : "memory"); else asm volatile("s_waitcnt vmcnt(8)" ::: "memory"); } while (0)
#define PG8_WAIT_L(n) asm volatile("s_waitcnt lgkmcnt(" #n ")" ::: "memory")
#define PG8_BAR __builtin_amdgcn_s_barrier()
#define PG8_SCHED __builtin_amdgcn_sched_barrier(0)
#define PG8_BIAS(u_) do { if constexpr (Epi::HAS_BIAS) __builtin_amdgcn_global_load_lds((const unsigned*)(E.bias_ptr(u_) + 4 * lane), (PG8_LAS unsigned*)(lds + BIAS_LDS + wid * 1024), 16, 0, 0); } while (0)
    Unit cur, nxt; int ui = 0;
    if (!S.next(0, cur)) return;
    f32x4 acc[2][2][4][2];
#pragma unroll
    for (int a = 0; a < 2; ++a)
#pragma unroll
        for (int b = 0; b < 2; ++b)
#pragma unroll
            for (int m = 0; m < 4; ++m)
#pragma unroll
                for (int n = 0; n < 2; ++n) acc[a][b][m][n] = (f32x4){0.f, 0.f, 0.f, 0.f};
    bf16x8 At[4][2], B0[2][2], B1[2][2];
    const PG8_LAS float* biasl = (const PG8_LAS float*)(lds + BIAS_LDS + wid * 1024);
    PG8_BIAS(cur);
    const char* gA = (const char*)g.A; const char* cB = (const char*)g.Bt + (size_t)cur.pn * tstep;
    const PG8_LAS int* rowsl = (const PG8_LAS int*)(lds + ROWS_LDS);
#define PG8_ROWDMA(pm_) __builtin_amdgcn_global_load_lds((const unsigned*)(rowmap + (pm_) * BM + 4 * lane), (PG8_LAS unsigned*)(lds + ROWS_LDS), 16, 0, 0)
#define PG8_ROWS(v0_, v1_) do { _Pragma("unroll") for (int _i = 0; _i < 2; ++_i) { v0_[_i] = (unsigned)(rowsl[RA0 + 64 * _i] * K + CA0) * 2u; v1_[_i] = (unsigned)(rowsl[HALF + RA0 + 64 * _i] * K + CA0) * 2u; } } while (0)
    PG8_ROWDMA(cur.pm); PG8_WAIT_V(0);
    PG8_ROWS(cv0, cv1); PG8_WAIT_L(0);
    S.a_ready(cur);
    PG8_STAGE(PG8_SB(0, 0), cB, voffB); PG8_STAGE(PG8_SB(0, 1), cB + hstep, voffB); PG8_STAGE2(PG8_SA(0, 0), gA, cv0); PG8_STAGE2(PG8_SA(0, 1), gA, cv1);
    if (wr == 1) PG8_BAR;
    PG8_WAIT_V(2); PG8_BAR;
    PG8_STAGE(PG8_SB(1, 0), cB + kstep, voffB); PG8_STAGE2(PG8_SA(1, 0), gA + kstep, cv0); PG8_STAGE(PG8_SB(1, 1), cB + hstep + kstep, voffB); PG8_STAGE2(PG8_SA(1, 1), gA + kstep, cv1);
    PG8_WAIT_V(8); PG8_BAR;
    for (;;) {
        const bool has_next = S.next(ui + 1, nxt);
        const char* nB = has_next ? (const char*)g.Bt + (size_t)nxt.pn * tstep : cB;
        PG8_ROWDMA(has_next ? nxt.pm : cur.pm);
        unsigned w0[2] = {cv0[0], cv0[1]}, w1[2] = {cv1[0], cv1[1]};
        for (int t = 0; t < nt; t += 2) {
            const bool last = (t == nt - 2);
            const bool aft = (t == 0) && (ui > 0);
            const char* a1 = gA + (size_t)(t + 1) * kstep;
            const char* a2 = last ? gA : gA + (size_t)(t + 2) * kstep; const char* b2 = last ? nB : cB + (size_t)(t + 2) * kstep;
            const char* a3 = a2 + kstep; const char* b3 = b2 + kstep;
            if (last && has_next) S.a_ready(nxt);
            PG8_LDB(B0, 0, 0); PG8_LDB(B1, 0, 1); PG8_SCHED; PG8_LDA(At, 0, 0); if (t > 0) PG8_STAGE2(PG8_SA(1, 1), a1, cv1);
            PG8_WAIT_VX(aft); PG8_WAIT_L(0); PG8_BAR; PG8_MMA(0, 0, At, B0); PG8_MMA(0, 1, At, B1); PG8_BAR; PG8_SCHED;
            PG8_LDA(At, 0, 1); PG8_STAGE(PG8_SB(0, 0), b2, voffB); PG8_STAGE(PG8_SB(0, 1), b2 + hstep, voffB); PG8_STAGE2(PG8_SA(0, 0), a2, w0);
            PG8_WAIT_VX(aft); PG8_WAIT_L(0); PG8_BAR; PG8_MMA(1, 0, At, B0); PG8_MMA(1, 1, At, B1); PG8_BAR; PG8_SCHED;
            PG8_LDB(B0, 1, 0); PG8_LDB(B1, 1, 1); PG8_SCHED; PG8_LDA(At, 1, 0); PG8_STAGE2(PG8_SA(0, 1), a2, w1);
            PG8_WAIT_VX(aft); PG8_WAIT_L(0); PG8_BAR; PG8_MMA(0, 0, At, B0); PG8_MMA(0, 1, At, B1); PG8_BAR; PG8_SCHED;
            PG8_LDA(At, 1, 1); PG8_STAGE(PG8_SB(1, 0), b3, voffB); PG8_STAGE(PG8_SB(1, 1), b3 + hstep, voffB); PG8_STAGE2(PG8_SA(1, 0), a3, w0);
            PG8_WAIT_V(8); PG8_WAIT_L(0); PG8_BAR; PG8_MMA(1, 0, At, B0); PG8_MMA(1, 1, At, B1); PG8_BAR; PG8_SCHED;
            if (t + 4 == nt) { PG8_ROWS(w0, w1); }
        }
        if (has_next) { PG8_STAGE2(PG8_SA(1, 1), gA + kstep, w1); }
        asm volatile("" ::: "memory"); PG8_SCHED;
        if constexpr (SCW != 0) asm volatile("s_nop 15\n\ts_nop 15" ::: "memory");
        if constexpr (ALIGN_EPI) { if (wr == 0) PG8_BAR; }
        E(acc, cur, wr, wc, fr, fq, biasl); S.done(cur);
        if (!has_next) break;
#pragma unroll
            for (int a = 0; a < 2; ++a)
#pragma unroll
            for (int b = 0; b < 2; ++b)
#pragma unroll
                for (int m = 0; m < 4; ++m)
#pragma unroll
                    for (int n = 0; n < 2; ++n) acc[a][b][m][n] = (f32x4){0.f, 0.f, 0.f, 0.f};
        cur = nxt; cB = nB; ++ui; cv0[0] = w0[0]; cv0[1] = w0[1]; cv1[0] = w1[0]; cv1[1] = w1[1];
        asm volatile("s_waitcnt lgkmcnt(0)" ::: "memory");
        PG8_BIAS(cur);
        if constexpr (ALIGN_EPI) { if (wr == 1) PG8_BAR; }
    }
    PG8_WAIT_V(0);
    if constexpr (!ALIGN_EPI) { if (wr == 0) PG8_BAR; }
    PG8_BAR;
#undef PG8_ROWS
#undef PG8_ROWDMA
#undef PG8_SA
#undef PG8_SB
#undef PG8_STAGE
#undef PG8_STAGE2
#undef PG8_LDA
#undef PG8_LDB
#undef PG8_MMA
#undef PG8_WAIT_V
#undef PG8_WAIT_VX
#undef PG8_WAIT_L
#undef PG8_BAR
#undef PG8_SCHED
#undef PG8_BIAS
}
}

#ifndef REP_MASK
#define REP_MASK 0
#endif
#define NREP(k) (1 + ((REP_MASK >> (k)) & 1))

constexpr int NB = 16, SEQ = 2048, D = 1024, NMETA = 16;
constexpr int MX = NB * SEQ;
constexpr int INW = 3344, PW = 3584;
constexpr int GQ = 0, GK = 256, GV = 512, GG = 1024, GKL = 1536;
constexpr int RW0 = 1552;
constexpr int RR = RW0, RK = RW0 + 512, RV = RW0 + 1024, RWL = RW0 + 1536, RAL = RW0 + 1600, RGL = RW0 + 1664;
constexpr int NE = 32, TOPK = 4;
constexpr int NCH = 33;
constexpr float ALPHA = 1.189207115002721f;
constexpr int NWAVES = 8, NTHR = 512;

constexpr size_t MiB = 1u << 20;
constexpr size_t WS_CTL = 0, CTL_ZERO_BYTES = 1 * MiB;
constexpr size_t WS_STATS = 1 * MiB;
constexpr size_t WS_TOPI  = WS_STATS + 256 * 1024;
constexpr size_t WS_GATE  = WS_TOPI + 512 * 1024;
constexpr size_t WS_RANK  = WS_GATE + 512 * 1024;
constexpr size_t WS_TSLOT = WS_RANK + 512 * 1024;
constexpr size_t WS_BON   = WS_TSLOT + 512 * 1024;
constexpr size_t WS_BCNT  = WS_BON;
constexpr size_t WS_PROJM = WS_BON + 1 * MiB;
constexpr size_t WS_OPSM  = WS_PROJM + 256 * 1024;
constexpr size_t WS_DL    = WS_OPSM + 256 * 1024;
constexpr size_t WS_W2T   = WS_DL + 1 * MiB;
constexpr size_t WS_A2T   = WS_W2T + 64 * 1024;
constexpr size_t WS_G2T   = WS_A2T + 64 * 1024;
constexpr size_t WS_RWH   = WS_G2T + 128 * 1024;
constexpr size_t WS_RWL   = WS_RWH + 64 * 1024;
constexpr size_t WS_TILEE = WS_RWL + 64 * 1024;
constexpr size_t WS_SLOTTOK = WS_TILEE + 4096;
constexpr size_t WS_WIN   = 8 * MiB;
constexpr size_t WS_WOUT  = 15 * MiB;
static_assert(WS_SLOTTOK + 139264 * 4 <= WS_WIN, "table region");
constexpr size_t WS_A0    = 20 * MiB;
constexpr size_t WS_YMIX  = 560 * MiB;
constexpr size_t WS_PROJ  = 84 * MiB;
constexpr size_t WS_R1    = 308 * MiB;
constexpr size_t WS_GAM   = 520 * MiB;
constexpr size_t WS_SST   = 524 * MiB;
constexpr size_t WS_GUS   = 692 * MiB;
constexpr size_t WS_H1    = WS_A0;
constexpr size_t WS_XS    = 84 * MiB;
constexpr size_t WS_YS    = WS_XS;
constexpr size_t WS_ACT   = 356 * MiB;
constexpr size_t WS_MIXB  = 628 * MiB;
constexpr size_t WS_WUP   = 758 * MiB;
constexpr size_t WS_WDN   = 822 * MiB;
constexpr size_t WS_H1Q   = 854 * MiB;
constexpr size_t WS_END   = 886 * MiB;
constexpr int CW_BAR = 4096;
constexpr int CW_CNT = 16384;
constexpr int CW_QH = 20480;

constexpr int RING_BYTES = 131072;
constexpr int LDS_BYTES = 147456;
constexpr int TAB_OFF = 132096;
constexpr int MISC_OFF = LDS_BYTES - 512;

#define LAS __attribute__((address_space(3)))
typedef unsigned short bf16;
typedef unsigned v4u __attribute__((ext_vector_type(4)));
typedef unsigned v2u __attribute__((ext_vector_type(2)));
typedef float f32x4 __attribute__((ext_vector_type(4)));
typedef short bf16x8 __attribute__((ext_vector_type(8)));
typedef int i32x4g __attribute__((ext_vector_type(4)));
#define LDS_WAIT() asm volatile("s_waitcnt lgkmcnt(0)" ::: "memory")
__device__ __forceinline__ float bflo(unsigned w) { return __uint_as_float(w << 16); }
__device__ __forceinline__ float bfhi(unsigned w) { return __uint_as_float(w & 0xffff0000u); }
typedef float f32x2_t __attribute__((ext_vector_type(2))); typedef __bf16 bf16x2_t __attribute__((ext_vector_type(2)));
__device__ __forceinline__ unsigned pk2(float lo, float hi) { const f32x2_t v = {lo, hi}; const bf16x2_t b = __builtin_convertvector(v, bf16x2_t); return __builtin_bit_cast(unsigned, b); }
__device__ __forceinline__ unsigned f2bf(float f) { return pk2(f, 0.f) & 0xffffu; }
#define CYC() ((unsigned)__builtin_amdgcn_s_getreg((19 << 11) | 29))
__device__ __forceinline__ void lds_barrier() { asm volatile("s_waitcnt lgkmcnt(0)" ::: "memory"); __builtin_amdgcn_s_barrier(); asm volatile("" ::: "memory"); }
__device__ __forceinline__ float shx(float v, int mask, int lane) { return __int_as_float(__builtin_amdgcn_ds_bpermute((lane ^ mask) << 2, __float_as_int(v))); }
template <int CTRL> __device__ __forceinline__ float dppf0(float x) { return __int_as_float(__builtin_amdgcn_update_dpp(0, __float_as_int(x), CTRL, 0xF, 0xF, true)); }
__device__ __forceinline__ float wave_sum(float v, int lane) {
    v += dppf0<0xB1>(v); v += dppf0<0x4E>(v); v += dppf0<0x141>(v); v += dppf0<0x140>(v);
    v += shx(v, 16, lane); v += shx(v, 32, lane);
    return v;
}
__device__ __forceinline__ float softplus_f(float x) { return fmaxf(x, 0.f) + log1pf(expf(-fabsf(x))); }
__device__ __forceinline__ float logsigmoid_f(float x) { return fminf(x, 0.f) - log1pf(expf(-fabsf(x))); }
__device__ __forceinline__ float sigmoid_f(float x) { return 1.f / (1.f + expf(-x)); }
__device__ __forceinline__ float fexp(float x) { return __builtin_amdgcn_exp2f(x * 1.4426950408889634f); }
__device__ __forceinline__ float flog(float x) { return __builtin_amdgcn_logf(x) * 0.6931471805599453f; }
__device__ __forceinline__ float fsigmoid(float x) { return __builtin_amdgcn_rcpf(1.f + fexp(-x)); }
__device__ __forceinline__ float ftanh(float x) { return 2.f * fsigmoid(2.f * x) - 1.f; }
__device__ __forceinline__ float fsoftplus(float x) { return fmaxf(x, 0.f) + flog(1.f + fexp(-fabsf(x))); }
__device__ __forceinline__ float flogsigmoid(float x) { return fminf(x, 0.f) - flog(1.f + fexp(-fabsf(x))); }
template <int CTRL> __device__ __forceinline__ float dppf(float x) { return __int_as_float(__builtin_amdgcn_update_dpp(0, __float_as_int(x), CTRL, 0xF, 0xF, true)); }
__device__ __forceinline__ float red8(float x) {
    x += dppf<0xB1>(x); x += dppf<0x4E>(x); x += dppf<0x141>(x); return x;
}
__device__ __forceinline__ f32x4 mfma16(bf16x8 a, bf16x8 b, f32x4 c) { return __builtin_amdgcn_mfma_f32_16x16x32_bf16(a, b, c, 0, 0, 0); }
__device__ __forceinline__ unsigned ld_agent(const unsigned* p) { return __hip_atomic_load(p, __ATOMIC_RELAXED, __HIP_MEMORY_SCOPE_AGENT); }

#define XB_TMO      128
#define XB_XCNT(j)  (256  + 64 * (j))
#define XB_XSUB(j)  (1280 + 64 * (j))
#define XB_XGEN(j)  (2304 + 64 * (j))
#define XB_TOP      3328
#define XB_TOPGEN   3392
#define XCD_BAR_WORDS 3456
#define XB_SPIN_CAP (1u << 18)
__device__ __forceinline__ unsigned xb_ld(unsigned* p)              { return __hip_atomic_load(p, __ATOMIC_RELAXED, __HIP_MEMORY_SCOPE_AGENT); }
__device__ __forceinline__ unsigned xb_add(unsigned* p, unsigned v) { return __hip_atomic_fetch_add(p, v, __ATOMIC_RELAXED, __HIP_MEMORY_SCOPE_AGENT); }
__device__ __forceinline__ unsigned xb_xcc_id() { return (unsigned)__builtin_amdgcn_s_getreg((3 << 11) | 20) & 0xFu; }
#define XB_SPIN(cond, bar) do { unsigned _sp = 0; while (cond) { __builtin_amdgcn_s_sleep(1); \
    if ((++_sp & 255u) == 0u) { if (xb_ld(&(bar)[XB_TMO])) break; if (_sp > XB_SPIN_CAP) { atomicAdd(&(bar)[XB_TMO], 1u); break; } } } } while (0)
struct XcdBarrier { unsigned* bar; unsigned x; volatile LAS unsigned* st; };
__device__ __forceinline__ XcdBarrier xcd_barrier_post(unsigned* bar, volatile LAS unsigned* st, bool leader) {
    XcdBarrier b; b.bar = bar; b.x = xb_xcc_id(); b.st = st;
    if (leader) (void)xb_add(&bar[XB_XCNT(b.x)], 1u);
    return b;
}
__device__ __forceinline__ void xcd_barrier_complete(unsigned* bar, unsigned x, unsigned& nloc, unsigned& nx) {
    const unsigned G = gridDim.x * gridDim.y * gridDim.z;
    unsigned sum, cnt, mine, sp = 0u;
    for (;;) {
        sum = 0u; cnt = 0u; mine = 0u;
#pragma unroll
        for (unsigned j = 0; j < 16; ++j) { const unsigned c = xb_ld(&bar[XB_XCNT(j)]); sum += c; cnt += (c > 0u) ? 1u : 0u; mine = (j == x) ? c : mine; }
        if (sum == G) break;
        __builtin_amdgcn_s_sleep(1);
        if ((++sp & 255u) == 0u) { if (xb_ld(&bar[XB_TMO])) break; if (sp > XB_SPIN_CAP) { atomicAdd(&bar[XB_TMO], 1u); break; } }
    }
    nloc = mine > 0u ? mine : 1u; nx = cnt > 0u ? cnt : 1u;
}
__device__ __forceinline__ void xcd_barrier(const XcdBarrier& b, bool leader) {
    asm volatile("s_waitcnt vmcnt(0)" ::: "memory");
    __syncthreads();
    if (leader) {
        unsigned* bar = b.bar;
        __builtin_amdgcn_s_waitcnt(0);
        unsigned nloc = b.st[0], nx = b.st[1];
        if (nloc == 0u) { xcd_barrier_complete(bar, b.x, nloc, nx); b.st[0] = nloc; b.st[1] = nx; }
        const unsigned old = xb_add(&bar[XB_XSUB(b.x)], 1u);
        const unsigned gen = old / nloc;
        if (old + 1u == (gen + 1u) * nloc) {
            __builtin_amdgcn_fence(__ATOMIC_RELEASE, "agent");
            asm volatile("s_waitcnt vmcnt(0)" ::: "memory");
            const unsigned og = xb_add(&bar[XB_TOP], 1u);
            const unsigned tg = og / nx;
            if (og + 1u == (tg + 1u) * nx) xb_add(&bar[XB_TOPGEN], 1u);
            else XB_SPIN(xb_ld(&bar[XB_TOPGEN]) == tg, bar);
            __builtin_amdgcn_fence(__ATOMIC_ACQUIRE, "agent");
            xb_add(&bar[XB_XGEN(b.x)], 1u);
            asm volatile("s_waitcnt vmcnt(0)" ::: "memory");
        } else {
            XB_SPIN(xb_ld(&bar[XB_XGEN(b.x)]) == gen, bar);
            __builtin_amdgcn_fence(__ATOMIC_ACQUIRE, "agent");
            asm volatile("s_waitcnt vmcnt(0)" ::: "memory");
        }
    }
    __syncthreads();
}

struct Args { const float* in[30]; float* out; unsigned char* ws; };
enum { I_X = 0, I_META, I_LNIN_G, I_LNIN_B, I_WIN, I_GKW2, I_GKB, I_GNORM, I_MU, I_W0, I_W2, I_A0, I_A2, I_G2, I_KK, I_KA, I_RK, I_RLNG, I_RLNB, I_WOUT,
       I_LN1G, I_LN1B, I_RTW, I_RTB, I_WUP, I_BUP, I_WDN, I_BDN, I_LN2G, I_LN2B };
struct Frame { LAS unsigned char* lds; int tid, lane, wave, blk, G; };
__device__ __forceinline__ int lane_id() { int l; asm volatile("v_mbcnt_lo_u32_b32 %0, -1, 0\n\tv_mbcnt_hi_u32_b32 %0, -1, %0" : "=v"(l)); return l; }
__device__ __forceinline__ Frame mkframe(LAS unsigned char* lds, int wave) { Frame F; F.lds = lds; F.wave = wave; F.lane = lane_id(); F.tid = wave * 64 + F.lane; F.blk = blockIdx.x; F.G = gridDim.x; return F; }

__device__ __forceinline__ void transpose_item(const float* W, int K, int N, int nblk, bf16* WT, LAS float* scr, int item, int lane) {
    const int kb = item / nblk, nb = item - kb * nblk, k0 = 64 * kb, n0 = 32 * nb;
    const int nn = n0 + (lane & 31); const bool ok = nn < N;
#pragma unroll 8
    for (int i = 0; i < 32; ++i) { const int kk = 2 * i + (lane >> 5); scr[kk * 33 + (lane & 31)] = ok ? W[(size_t)(k0 + kk) * N + nn] : 0.f; }
    LDS_WAIT();
    const int c = lane & 7;
#pragma unroll
    for (int j = 0; j < 4; ++j) { const int n = (lane >> 3) + 8 * j; const LAS float* s = scr + (8 * c) * 33 + n;
        v4u o; o.x = pk2(s[0 * 33], s[1 * 33]); o.y = pk2(s[2 * 33], s[3 * 33]); o.z = pk2(s[4 * 33], s[5 * 33]); o.w = pk2(s[6 * 33], s[7 * 33]);
        *(v4u*)(WT + (size_t)(n0 + n) * K + k0 + 8 * c) = o; }
    LDS_WAIT();
}

constexpr int CV_UP = 16 * 32, CV_DN = 16 * 16, CV_NIT = NE * (CV_UP + CV_DN);
__device__ __forceinline__ void cv_load(const Args& a, int it, int lane, f32x4 (&v)[16]) {
    const bool up = it < NE * CV_UP; const int it2 = up ? it : it - NE * CV_UP, per = up ? CV_UP : CV_DN, e = it2 / per, r = it2 - e * per;
    const int N = up ? 2048 : D, nblk = N >> 6, kb = r / nblk, nb = r - kb * nblk;
    const float* W = (up ? a.in[I_WUP] : a.in[I_WDN]) + (size_t)e * D * N + (size_t)(64 * kb + (lane >> 4)) * N + 64 * nb + 4 * (lane & 15);
#pragma unroll
    for (int i = 0; i < 16; ++i) v[i] = *(const f32x4*)(W + (size_t)(4 * i) * N);
}
__device__ __forceinline__ void cv_store(const Args& a, int it, int lane, const f32x4 (&v)[16], LAS float* scr) {
    const bool up = it < NE * CV_UP; const int it2 = up ? it : it - NE * CV_UP, per = up ? CV_UP : CV_DN, e = it2 / per, r = it2 - e * per;
    const int N = up ? 2048 : D, nblk = N >> 6, kb = r / nblk, nb = r - kb * nblk;
    const float scale = up ? 64.f : 128.f;
    const int r4 = lane >> 4, c4 = lane & 15;
#pragma unroll
    for (int i = 0; i < 16; ++i) *(LAS f32x4*)(scr + (4 * i + r4) * 68 + 4 * c4) = v[i];
    LDS_WAIT();
    unsigned char* orow = a.ws + (up ? WS_WUP : WS_WDN) + (size_t)e * N * D + (size_t)(64 * nb + lane) * D + 64 * kb;
#pragma unroll
    for (int g = 0; g < 4; ++g) { const LAS float* s = scr + (16 * g) * 68 + lane; v4u o;
#pragma unroll
        for (int q = 0; q < 4; ++q) { int w = __builtin_amdgcn_cvt_pk_fp8_f32(s[(4 * q + 0) * 68] * scale, s[(4 * q + 1) * 68] * scale, 0, false);
            w = __builtin_amdgcn_cvt_pk_fp8_f32(s[(4 * q + 2) * 68] * scale, s[(4 * q + 3) * 68] * scale, w, true); o[q] = (unsigned)w; }
        *(v4u*)(orow + 16 * g) = o; }
    LDS_WAIT();
}
__device__ __forceinline__ void convert_expert_weights(const Args& a, const Frame& F, int qsel) {
    LAS float* scr = (LAS float*)(F.lds + F.wave * 17408);
    unsigned* QH = (unsigned*)(a.ws + WS_CTL) + CW_QH + 64 * qsel;
    unsigned base = 0;
    if (F.lane == 0) base = __hip_atomic_fetch_add(QH, 4u, __ATOMIC_RELAXED, __HIP_MEMORY_SCOPE_AGENT);
    base = (unsigned)__builtin_amdgcn_readfirstlane((int)base);
    if (base >= (unsigned)CV_NIT) return;
    f32x4 va[16], vb[16];
    cv_load(a, (int)base, F.lane, va);
    for (;;) {
        unsigned nbase = 0;
        if (F.lane == 0) nbase = __hip_atomic_fetch_add(QH, 4u, __ATOMIC_RELAXED, __HIP_MEMORY_SCOPE_AGENT);
        nbase = (unsigned)__builtin_amdgcn_readfirstlane((int)nbase);
        const bool more = nbase < (unsigned)CV_NIT;
        cv_load(a, (int)base + 1, F.lane, vb); cv_store(a, (int)base, F.lane, va, scr);
        cv_load(a, (int)base + 2, F.lane, va); cv_store(a, (int)base + 1, F.lane, vb, scr);
        cv_load(a, (int)base + 3, F.lane, vb); cv_store(a, (int)base + 2, F.lane, va, scr);
        if (more) cv_load(a, (int)nbase, F.lane, va);
        cv_store(a, (int)base + 3, F.lane, vb, scr);
        if (!more) break;
        base = nbase;
    }
}

__device__ __forceinline__ void phase0(const Args& a, const Frame& F) {
    unsigned char* ws = a.ws;
    const int gw = F.blk * NWAVES + F.wave, NGW = F.G * NWAVES;
    for (int cgp = F.blk; cgp < 53; cgp += F.G) {
        LAS float* HM = (LAS float*)F.lds;
        LAS float* PART = (LAS float*)(F.lds + 65536);
        for (int rr = 0; rr < 2; ++rr) {
            const int row = 2 * F.wave + rr; const f32x4* xr = (const f32x4*)(a.in[I_META] + row * D) + F.lane;
            f32x4 v[4]; float s = 0.f;
#pragma unroll
            for (int j = 0; j < 4; ++j) { v[j] = xr[64 * j]; s += (v[j].x + v[j].y) + (v[j].z + v[j].w); }
            const float mean = wave_sum(s, F.lane) * (1.f / D); float s2 = 0.f;
#pragma unroll
            for (int j = 0; j < 4; ++j) { v[j] = v[j] - mean; s2 += (v[j].x * v[j].x + v[j].y * v[j].y) + (v[j].z * v[j].z + v[j].w * v[j].w); }
            const float rstd = 1.f / sqrtf(wave_sum(s2, F.lane) * (1.f / D) + 1e-5f);
#pragma unroll
            for (int j = 0; j < 4; ++j) { const int col = 4 * (F.lane + 64 * j);
                const f32x4 gv = *(const f32x4*)(a.in[I_LNIN_G] + col), bv = *(const f32x4*)(a.in[I_LNIN_B] + col);
                const f32x4 y = v[j] * rstd * gv + bv;
                HM[(col + 0) * 16 + row] = y.x; HM[(col + 1) * 16 + row] = y.y; HM[(col + 2) * 16 + row] = y.z; HM[(col + 3) * 16 + row] = y.w; }
        }
        __syncthreads();
        const int col = cgp * 64 + F.lane; const bool ok = col < INW;
        float acc[16];
#pragma unroll
        for (int r = 0; r < 16; ++r) acc[r] = 0.f;
        const float* wp = a.in[I_WIN];
        for (int k = F.wave * 128; k < F.wave * 128 + 128; ++k) {
            const float wv = ok ? wp[(size_t)k * INW + col] : 0.f;
            const LAS f32x4* h = (const LAS f32x4*)(HM + k * 16);
#pragma unroll
            for (int q = 0; q < 4; ++q) { const f32x4 hv = h[q]; acc[4 * q + 0] += hv.x * wv; acc[4 * q + 1] += hv.y * wv; acc[4 * q + 2] += hv.z * wv; acc[4 * q + 3] += hv.w * wv; }
        }
#pragma unroll
        for (int r = 0; r < 16; ++r) PART[(F.wave * 16 + r) * 64 + F.lane] = acc[r];
        __syncthreads();
        bf16* PROJM = (bf16*)(ws + WS_PROJM);
        for (int o = F.tid; o < 1024; o += NTHR) { const int r = o >> 6, l = o & 63; float s = 0.f;
#pragma unroll
            for (int w = 0; w < 8; ++w) s += PART[(w * 16 + r) * 64 + l];
            PROJM[r * PW + cgp * 64 + l] = (bf16)f2bf(s); }
        if (F.tid < 64) PROJM[NMETA * PW + cgp * 64 + F.tid] = 0;
        __syncthreads();
    }
    {
        LAS float* scr = (LAS float*)(F.lds + F.wave * 16384);
        constexpr int I_IN = 16 * (PW / 32), I_OUT = 16 * 32;
        for (int it = gw; it < I_IN + I_OUT; it += NGW) {
            if (it < I_IN) transpose_item(a.in[I_WIN], D, INW, PW / 32, (bf16*)(ws + WS_WIN), scr, it, F.lane);
            else transpose_item(a.in[I_WOUT], D, D, 32, (bf16*)(ws + WS_WOUT), scr, it - I_IN, F.lane);
        }
    }
    {
        bf16* W2T = (bf16*)(ws + WS_W2T); bf16* A2T = (bf16*)(ws + WS_A2T); bf16* G2T = (bf16*)(ws + WS_G2T);
        for (int i = F.blk * NTHR + F.tid; i < 131072; i += F.G * NTHR) {
            if (i < 32768) { const int n = i >> 6, k = i & 63; W2T[i] = (bf16)f2bf(a.in[I_W2][k * 512 + n]); }
            else if (i < 65536) { const int j = i - 32768, n = j >> 6, k = j & 63; A2T[j] = (bf16)f2bf(a.in[I_A2][k * 512 + n]); }
            else { const int j = i - 65536, n = j >> 7, k = j & 127; G2T[j] = (bf16)f2bf(a.in[I_G2][k * 512 + n]); }
        }
    }
    {
        bf16* RWH = (bf16*)(ws + WS_RWH); bf16* RWL = (bf16*)(ws + WS_RWL);
        for (int i = F.blk * NTHR + F.tid; i < D * NE; i += F.G * NTHR) { const int c = i >> 5, e = i & 31; const float w = a.in[I_RTW][i];
            const unsigned hi = f2bf(w); const float lo = w - __uint_as_float(hi << 16);
            RWH[e * D + c] = (bf16)hi; RWL[e * D + c] = (bf16)f2bf(lo); }
    }
    {
        bf16* A0 = (bf16*)(ws + WS_A0);
        for (int m0 = gw; m0 < MX; m0 += 2 * NGW) {
            f32x4 v[2][4];
#pragma unroll
            for (int r = 0; r < 2; ++r) { const f32x4* xr = (const f32x4*)(a.in[I_X] + (size_t)(m0 + r * NGW) * D) + F.lane;
#pragma unroll
                for (int j = 0; j < 4; ++j) v[r][j] = xr[64 * j]; }
#pragma unroll
            for (int r = 0; r < 2; ++r) { const int m = m0 + r * NGW; float s = 0.f;
#pragma unroll
                for (int j = 0; j < 4; ++j) s += (v[r][j].x + v[r][j].y) + (v[r][j].z + v[r][j].w);
                const float mean = wave_sum(s, F.lane) * (1.f / D); float s2 = 0.f;
#pragma unroll
                for (int j = 0; j < 4; ++j) { v[r][j] = v[r][j] - mean; s2 += (v[r][j].x * v[r][j].x + v[r][j].y * v[r][j].y) + (v[r][j].z * v[r][j].z + v[r][j].w * v[r][j].w); }
                const float rstd = __builtin_amdgcn_rsqf(wave_sum(s2, F.lane) * (1.f / D) + 1e-5f);
#pragma unroll
                for (int j = 0; j < 4; ++j) { const int col = 4 * (F.lane + 64 * j);
                    const f32x4 gv = *(const f32x4*)(a.in[I_LNIN_G] + col), bv = *(const f32x4*)(a.in[I_LNIN_B] + col);
                    const f32x4 y = v[r][j] * rstd * gv + bv;
                    v2u o; o.x = pk2(y.x, y.y); o.y = pk2(y.z, y.w);
                    *(v2u*)(A0 + (size_t)m * D + col) = o; }
                }
        }
    }
    __syncthreads();
    for (int rep_ = 0; rep_ < NREP(14); ++rep_) convert_expert_weights(a, F, rep_);
}

__device__ __forceinline__ const bf16* prow(const bf16* PROJ, const bf16* PROJM, int b, int vp) {
    const bf16* px = PROJ + (size_t)(b * SEQ + (vp >= NMETA ? vp - NMETA : 0)) * PW;
    const bf16* pm = PROJM + (size_t)(vp < 0 ? NMETA : (vp < NMETA ? vp : 0)) * PW;
    return vp >= NMETA ? px : pm;
}
__device__ __forceinline__ f32x4 ldp4(const bf16* PROJ, const bf16* PROJM, int b, int vp, int col) {
    const v2u w = *(const v2u*)(prow(PROJ, PROJM, b, vp) + col);
    return (f32x4){bflo(w.x), bfhi(w.x), bflo(w.y), bfhi(w.y)};
}

constexpr int R1_STRIDE = 49152;
constexpr int TP = 80;
constexpr int L1_SLOT = 64 * TP * 2;
constexpr int L1_LC = 12 * L1_SLOT;
constexpr int L1_XCH = L1_LC + 64 * 65 * 4;
constexpr int L1_LR = 8 * L1_SLOT;
constexpr int RKP = 72;
__device__ __forceinline__ v2u pack4(f32x4 v) { v2u o; o.x = pk2(v[0], v[1]); o.y = pk2(v[2], v[3]); return o; }
__device__ __forceinline__ f32x4 tile_mm(const LAS bf16* A, const LAS bf16* Bt, int rt, int ct, int fr, int fq, f32x4 acc) {
#pragma unroll
    for (int ks = 0; ks < 2; ++ks)
        acc = mfma16(*(const LAS bf16x8*)(Bt + (ct * 16 + fr) * TP + ks * 32 + 8 * fq), *(const LAS bf16x8*)(A + (rt * 16 + fr) * TP + ks * 32 + 8 * fq), acc);
    return acc;
}
__device__ __forceinline__ void tile_st(LAS bf16* O, int rt, int ct, int fr, int fq, f32x4 v) { *(LAS v2u*)(O + (rt * 16 + fr) * TP + ct * 16 + 4 * fq) = pack4(v); }
#define L1S(n) ((LAS bf16*)(F.lds + (n) * L1_SLOT))

struct L1Pf { v4u sa[5]; v4u rkv[3], ex; v4u w[4]; };
__device__ __forceinline__ void l1_fetch(const Args& a, const Frame& F, int b, int h, int c, L1Pf& pf, bool need_sa) {
    const bf16* PROJ = (const bf16*)(a.ws + WS_PROJ); const bf16* PROJM = (const bf16*)(a.ws + WS_PROJM);
    const int vp0 = (c == 0) ? -48 : NMETA + 64 * (c - 1);
    if (need_sa) { const int cg = F.tid & 31, tr = F.tid >> 5;
#pragma unroll
      for (int i = 0; i < 5; ++i) pf.sa[i] = *(const v4u*)(prow(PROJ, PROJM, b, vp0 + 4 * tr - 1 + i) + RWL + 8 * cg); }
    {
        const int rr = F.tid >> 3, ch = F.tid & 7; const bf16* pr = prow(PROJ, PROJM, b, vp0 - 1 + rr) + h * 64 + 8 * ch;
        pf.rkv[0] = *(const v4u*)(pr + RR); pf.rkv[1] = *(const v4u*)(pr + RK); pf.rkv[2] = *(const v4u*)(pr + RV);
        const int ar = ((F.tid >> 3) & 3) > 2 ? 2 : ((F.tid >> 3) & 3);
        pf.ex = *(const v4u*)(prow(PROJ, PROJM, b, vp0 + 63) + (ar == 0 ? RR : ar == 1 ? RK : RV) + h * 64 + 8 * ch); }
    {
        const bf16* W2T = (const bf16*)(a.ws + WS_W2T); const bf16* A2T = (const bf16*)(a.ws + WS_A2T); const bf16* G2T = (const bf16*)(a.ws + WS_G2T);
        const int r = F.tid >> 3, ch = F.tid & 7;
        pf.w[0] = *(const v4u*)(W2T + (size_t)(h * 64 + r) * 64 + 8 * ch); pf.w[1] = *(const v4u*)(A2T + (size_t)(h * 64 + r) * 64 + 8 * ch);
#pragma unroll
        for (int i = 0; i < 2; ++i) { const int q = F.tid + 512 * i, r2 = q >> 4, c2 = q & 15; pf.w[2 + i] = *(const v4u*)(G2T + (size_t)(h * 64 + r2) * 128 + 8 * c2); }
    }
}
__device__ __forceinline__ f32x4 unpk4(v2u w) { return (f32x4){bflo(w.x), bfhi(w.x), bflo(w.y), bfhi(w.y)}; }

__device__ __forceinline__ void rwkv_l1_front(const Args& a, const Frame& F, int b, int h, int c, const L1Pf& pf, f32x4 (&rtil)[2], bool newgrp, bf16x8 (&lrf)[8]) {
    unsigned char* ws = a.ws;
    const int unit = (b * 8 + h) * NCH + c;
    unsigned char* r1 = ws + WS_R1 + (size_t)unit * R1_STRIDE;
    float* GAM = (float*)(ws + WS_GAM) + (size_t)unit * 64;
    const float* mu = a.in[I_MU];
    const int vp0 = (c == 0) ? -48 : NMETA + 64 * (c - 1);
    constexpr int LRP = 264;
    LAS bf16* LR = (LAS bf16*)(F.lds + L1_LR);
    LAS float* LC = (LAS float*)(F.lds + L1_LC);
    LAS float* XCH = (LAS float*)(F.lds + L1_XCH);
    const int rt = F.wave & 3, cp = F.wave >> 2, fr = F.lane & 15, fq = F.lane >> 4;
    {
        const int r = F.tid >> 3, ch = F.tid & 7;
        *(LAS v4u*)(L1S(0) + r * TP + 8 * ch) = pf.w[0]; *(LAS v4u*)(L1S(1) + r * TP + 8 * ch) = pf.w[1];
#pragma unroll
        for (int i = 0; i < 2; ++i) { const int q = F.tid + 512 * i, r2 = q >> 4, c2 = q & 15; *(LAS v4u*)(L1S(2 + (c2 >> 3)) + r2 * TP + 8 * (c2 & 7)) = pf.w[2 + i]; }
#pragma unroll
        for (int q = 0; q < 3; ++q) *(LAS v4u*)(L1S(4 + q) + r * RKP + 8 * ch) = pf.rkv[q];
        if (F.tid < 24) *(LAS v4u*)(L1S(4 + (F.tid >> 3)) + 64 * RKP + 8 * ch) = pf.ex;
    }
    if (newgrp) {
        const int cg = F.tid & 31, tr = F.tid >> 5;
        const f32x4 m0 = *(const f32x4*)(mu + 1536 + 8 * cg), m1 = *(const f32x4*)(mu + 1536 + 8 * cg + 4);
#pragma unroll
        for (int i = 0; i < 4; ++i) {
            const int row = 4 * tr + i;
            const v4u cw = pf.sa[i + 1], pw = pf.sa[i];
            const f32x4 c0 = unpk4((v2u){cw.x, cw.y}), c1 = unpk4((v2u){cw.z, cw.w}), p0 = unpk4((v2u){pw.x, pw.y}), p1 = unpk4((v2u){pw.z, pw.w});
            float v[8];
            v[0] = c0.x + (p0.x - c0.x) * m0.x; v[1] = c0.y + (p0.y - c0.y) * m0.y; v[2] = c0.z + (p0.z - c0.z) * m0.z; v[3] = c0.w + (p0.w - c0.w) * m0.w;
            v[4] = c1.x + (p1.x - c1.x) * m1.x; v[5] = c1.y + (p1.y - c1.y) * m1.y; v[6] = c1.z + (p1.z - c1.z) * m1.z; v[7] = c1.w + (p1.w - c1.w) * m1.w;
#pragma unroll
            for (int q = 0; q < 8; ++q) { if (cg < 8) v[q] = ftanh(v[q]); else if (cg >= 16) v[q] = fsigmoid(v[q]); }
            v4u o; o.x = pk2(v[0], v[1]); o.y = pk2(v[2], v[3]); o.z = pk2(v[4], v[5]); o.w = pk2(v[6], v[7]);
            *(LAS v4u*)(LR + row * LRP + 8 * cg) = o;
        }
    }
    const int t = rt * 16 + fr, vp = vp0 + t;
    const bool valid = vp >= 0;
    lds_barrier();
    if (newgrp) {
        const LAS bf16* lrow = LR + t * LRP + 8 * fq;
#pragma unroll
        for (int q = 0; q < 8; ++q) lrf[q] = *(const LAS bf16x8*)(lrow + q * 32); }
    float lwv[2][4], asg[2][4], kkr[2][4], kmd[2][4], rrv[2][4], vvv[2][4];
    float ssq = 0.f, bon = 0.f;
    {
#pragma unroll
        for (int cc = 0; cc < 2; ++cc) {
            const int ct = 2 * cp + cc, j = ct * 16 + 4 * fq, jc = h * 64 + j;
            f32x4 mr[2], mk[2], mv[2], w0v[2], a0v[2], kkw[2], kaw[2], rkw[2];
            mr[cc] = *(const f32x4*)(mu + jc); mk[cc] = *(const f32x4*)(mu + 512 + jc); mv[cc] = *(const f32x4*)(mu + 1024 + jc);
            w0v[cc] = *(const f32x4*)(a.in[I_W0] + jc); a0v[cc] = *(const f32x4*)(a.in[I_A0] + jc);
            kkw[cc] = *(const f32x4*)(a.in[I_KK] + jc); kaw[cc] = *(const f32x4*)(a.in[I_KA] + jc); rkw[cc] = *(const f32x4*)(a.in[I_RK] + jc);
            f32x4 aw = {0.f, 0.f, 0.f, 0.f}, aa = aw, ag = aw;
#pragma unroll
            for (int ks = 0; ks < 2; ++ks) {
                aw = mfma16(*(const LAS bf16x8*)(L1S(0) + (ct * 16 + fr) * TP + ks * 32 + 8 * fq), lrf[ks], aw);
                aa = mfma16(*(const LAS bf16x8*)(L1S(1) + (ct * 16 + fr) * TP + ks * 32 + 8 * fq), lrf[2 + ks], aa);
            }
#pragma unroll
            for (int ks = 0; ks < 4; ++ks) ag = mfma16(*(const LAS bf16x8*)(L1S(2 + (ks >> 1)) + (ct * 16 + fr) * TP + (ks & 1) * 32 + 8 * fq), lrf[4 + ks], ag);
            const f32x4 rc = unpk4(*(const LAS v2u*)(L1S(4) + (t + 1) * RKP + j)), rp = unpk4(*(const LAS v2u*)(L1S(4) + t * RKP + j));
            const f32x4 kc = unpk4(*(const LAS v2u*)(L1S(5) + (t + 1) * RKP + j)), kp = unpk4(*(const LAS v2u*)(L1S(5) + t * RKP + j));
            const f32x4 vc = unpk4(*(const LAS v2u*)(L1S(6) + (t + 1) * RKP + j)), vpv = unpk4(*(const LAS v2u*)(L1S(6) + t * RKP + j));
            const f32x4 rs = rc + (rp - rc) * mr[cc], ks_ = kc + (kp - kc) * mk[cc], vs = vc + (vpv - vc) * mv[cc];
#pragma unroll
            for (int i = 0; i < 4; ++i) {
                const float u = w0v[cc][i] + aw[i];
                const float wl = -fsoftplus(-u) - 0.5f;
                lwv[cc][i] = valid ? -fexp(wl) : 0.f;
                const float as_ = fsigmoid(a0v[cc][i] + aa[i]);
                asg[cc][i] = as_;
                const float kraw = ks_[i], kk = kraw * kkw[cc][i];
                kkr[cc][i] = kk; ssq += kk * kk;
                const float km = kraw * (1.f + (as_ - 1.f) * kaw[cc][i]);
                kmd[cc][i] = km; rrv[cc][i] = rs[i]; vvv[cc][i] = vs[i];
                bon += rs[i] * km * rkw[cc][i];
            }
            *(v2u*)(r1 + 4 * 8192 + (size_t)(t * 64 + j) * 2) = pack4(ag);
            __builtin_amdgcn_sched_barrier(0);
        }
#pragma unroll
        for (int cc = 0; cc < 2; ++cc)
#pragma unroll
            for (int i = 0; i < 4; ++i) LC[t * 65 + (2 * cp + cc) * 16 + 4 * fq + i] = lwv[cc][i];
        ssq += shx(ssq, 16, F.lane); ssq += shx(ssq, 32, F.lane);
        bon += shx(bon, 16, F.lane); bon += shx(bon, 32, F.lane);
        if (fq == 0) { XCH[(cp * 64 + t) * 2] = ssq; XCH[(cp * 64 + t) * 2 + 1] = bon; }
    }
    lds_barrier();
    const float ssq_t = XCH[t * 2] + XCH[(64 + t) * 2], bon_t = XCH[t * 2 + 1] + XCH[(64 + t) * 2 + 1];
    const float inv = 1.f / fmaxf(sqrtf(ssq_t), 1e-12f);
    {
        LAS float* SEG = XCH + 256;
        const int jj = F.tid & 63, sg = F.tid >> 6;
        float cv[8];
#pragma unroll
        for (int i = 0; i < 8; ++i) cv[i] = LC[(sg * 8 + i) * 65 + jj];
#pragma unroll
        for (int i = 1; i < 8; ++i) cv[i] += cv[i - 1];
        SEG[sg * 64 + jj] = cv[7];
        lds_barrier();
        float pre = 0.f;
#pragma unroll
        for (int s2 = 0; s2 < 7; ++s2) pre += (s2 < sg) ? SEG[s2 * 64 + jj] : 0.f;
#pragma unroll
        for (int i = 0; i < 8; ++i) LC[(sg * 8 + i) * 65 + jj] = cv[i] + pre;
    }
    lds_barrier();
    {
#pragma unroll
        for (int cc = 0; cc < 2; ++cc) {
            const int j = (2 * cp + cc) * 16 + 4 * fq;
            f32x4 At, Bt, Kt, Bh, Kh, bvv;
#pragma unroll
            for (int i = 0; i < 4; ++i) {
                const float Lc = LC[t * 65 + j + i], LcC = LC[63 * 65 + j + i];
                const float kn = kkr[cc][i] * inv, av = -kn, bv = kn * asg[cc][i], km = kmd[cc][i];
                const float eA = fexp(Lc - lwv[cc][i]), eR = fexp(Lc), eB = fexp(-Lc), eH = fexp(LcC - Lc);
                At[i] = av * eA; rtil[cc][i] = rrv[cc][i] * eR; Bt[i] = bv * eB; Kt[i] = km * eB; Bh[i] = bv * eH; Kh[i] = km * eH;
                bvv[i] = bon_t * vvv[cc][i];
                if (t == 63) GAM[j + i] = fexp(LcC);
            }
            *(LAS v2u*)(L1S(0) + t * TP + j) = pack4(Bt); *(LAS v2u*)(L1S(1) + t * TP + j) = pack4(Kt);
            *(LAS v2u*)(L1S(2) + t * TP + j) = pack4(At); *(LAS v2u*)(L1S(3) + t * TP + j) = pack4(rtil[cc]);
#pragma unroll
            for (int i = 0; i < 4; ++i) {
                L1S(4)[(j + i) * TP + t] = (bf16)f2bf(At[i]); L1S(5)[(j + i) * TP + t] = (bf16)f2bf(Bh[i]);
                L1S(6)[(j + i) * TP + t] = (bf16)f2bf(Kh[i]); L1S(7)[(j + i) * TP + t] = (bf16)f2bf(vvv[cc][i]);
            }
            *(v2u*)(r1 + 5 * 8192 + (size_t)(t * 64 + j) * 2) = pack4(bvv);
        }
    }
    lds_barrier();
}
__device__ __forceinline__ void rwkv_l1_back(const Args& a, const Frame& F, int b, int h, int c, const f32x4 (&rtil)[2]) {
    unsigned char* r1 = a.ws + WS_R1 + (size_t)((b * 8 + h) * NCH + c) * R1_STRIDE;
    const int rt = F.wave & 3, cp = F.wave >> 2, fr = F.lane & 15, fq = F.lane >> 4;
    f32x4 Pt[2];
    const int mrow = rt * 16 + fr;
    const f32x4 z = {0.f, 0.f, 0.f, 0.f};
    {
        f32x4 Lv[2], Nv[2], Mv[2], Bv[2], Kv[2];
#pragma unroll
        for (int cc = 0; cc < 2; ++cc) { const int ct = 2 * cp + cc;
            Lv[cc] = tile_mm(L1S(2), L1S(0), rt, ct, fr, fq, z); Nv[cc] = tile_mm(L1S(0), L1S(2), rt, ct, fr, fq, z); Mv[cc] = tile_mm(L1S(2), L1S(1), rt, ct, fr, fq, z);
            Bv[cc] = tile_mm(L1S(3), L1S(0), rt, ct, fr, fq, z); Kv[cc] = tile_mm(L1S(3), L1S(1), rt, ct, fr, fq, z); }
#pragma unroll
        for (int cc = 0; cc < 2; ++cc) { const int ct = 2 * cp + cc, n0 = ct * 16 + 4 * fq;
#pragma unroll
            for (int i = 0; i < 4; ++i) { const int n = n0 + i;
                if (!(n < mrow)) { Lv[cc][i] = 0.f; Mv[cc][i] = 0.f; } if (!(mrow < n)) Nv[cc][i] = 0.f; if (!(n <= mrow)) { Bv[cc][i] = 0.f; Kv[cc][i] = 0.f; }
                Pt[cc][i] = Lv[cc][i] + ((n == mrow) ? 1.f : 0.f); }
            tile_st(L1S(8), rt, ct, fr, fq, Lv[cc]); tile_st(L1S(9), rt, ct, fr, fq, Nv[cc]); tile_st(L1S(10), rt, ct, fr, fq, Mv[cc]);
            tile_st(L1S(11), rt, ct, fr, fq, Bv[cc]); tile_st(L1S(12), rt, ct, fr, fq, Kv[cc]); }
    }
    lds_barrier();
    f32x4 Xv[2];
#pragma unroll
    for (int st = 1; st <= 6; ++st) {
        LAS bf16* Xl = (st & 1) ? L1S(8) : L1S(0); LAS bf16* Xn = (st & 1) ? L1S(9) : L1S(1);
        LAS bf16* Yl = (st & 1) ? L1S(0) : L1S(8); LAS bf16* Yn = (st & 1) ? L1S(1) : L1S(9);
        LAS bf16* Pr = (st & 1) ? L1S(2) : L1S(3); LAS bf16* Pw = (st & 1) ? L1S(3) : L1S(2);
        f32x4 l2[2], n2[2];
#pragma unroll
        for (int cc = 0; cc < 2; ++cc) { const int ct = 2 * cp + cc;
            if (st <= 5) { l2[cc] = tile_mm(Xl, Xn, rt, ct, fr, fq, z); n2[cc] = tile_mm(Xn, Xl, rt, ct, fr, fq, z); }
            if (st >= 2) Pt[cc] = tile_mm(Pr, Xn, rt, ct, fr, fq, Pt[cc]);
            if (st == 1) Xv[cc] = tile_mm(L1S(7), L1S(10), rt, ct, fr, fq, z); }
#pragma unroll
        for (int cc = 0; cc < 2; ++cc) { const int ct = 2 * cp + cc;
            if (st <= 5) { tile_st(Yl, rt, ct, fr, fq, l2[cc]); tile_st(Yn, rt, ct, fr, fq, n2[cc]); }
            tile_st(Pw, rt, ct, fr, fq, Pt[cc]); }
        if (st == 1) { lds_barrier();
#pragma unroll
            for (int cc = 0; cc < 2; ++cc) tile_st(L1S(10), rt, 2 * cp + cc, fr, fq, Xv[cc]); }
        lds_barrier();
    }
    {
        f32x4 u[2], w[2];
#pragma unroll
        for (int cc = 0; cc < 2; ++cc) { const int ct = 2 * cp + cc; u[cc] = tile_mm(L1S(10), L1S(2), rt, ct, fr, fq, z); w[cc] = tile_mm(L1S(4), L1S(2), rt, ct, fr, fq, z); }
#pragma unroll
        for (int cc = 0; cc < 2; ++cc) { const int ct = 2 * cp + cc; tile_st(L1S(8), rt, ct, fr, fq, u[cc]); tile_st(L1S(9), rt, ct, fr, fq, w[cc]); }
    }
    lds_barrier();
    {
#pragma unroll
        for (int cc = 0; cc < 2; ++cc) { const int ct = 2 * cp + cc; const size_t eo = (size_t)(mrow * 64 + ct * 16 + 4 * fq) * 2;
            const f32x4 gp = tile_mm(L1S(5), L1S(9), rt, ct, fr, fq, z);
            const f32x4 hh = tile_mm(L1S(7), L1S(6), rt, ct, fr, fq, tile_mm(L1S(8), L1S(5), rt, ct, fr, fq, z));
            const f32x4 rh = tile_mm(L1S(11), L1S(9), rt, ct, fr, fq, rtil[cc]);
            const f32x4 yl = tile_mm(L1S(12), L1S(7), rt, ct, fr, fq, tile_mm(L1S(11), L1S(8), rt, ct, fr, fq, z));
            *(v2u*)(r1 + 0 * 8192 + eo) = pack4(gp); *(v2u*)(r1 + 1 * 8192 + eo) = pack4(hh);
            *(v2u*)(r1 + 2 * 8192 + eo) = pack4(rh); *(v2u*)(r1 + 3 * 8192 + eo) = pack4(yl); }
    }
    lds_barrier();
}

constexpr int BCP = 65;
__device__ __forceinline__ void gla_bc(const Args& a, const Frame& F, int b, int h, int vp0, int ntok) {
    const bf16* PROJ = (const bf16*)(a.ws + WS_PROJ); const bf16* PROJM = (const bf16*)(a.ws + WS_PROJM);
    LAS float* GKLs = (LAS float*)F.lds; LAS float* BC = (LAS float*)(F.lds + 4096);
    if (F.tid < 256) { const int t = F.tid >> 2, q = F.tid & 3;
        const f32x4 v = ldp4(PROJ, PROJM, b, (t < ntok) ? vp0 + t : -1, GKL + 4 * q);
        *(LAS f32x4*)(GKLs + t * 16 + 4 * q) = v; }
    lds_barrier();
    {
        const int d = F.tid & 63, tg = F.tid >> 6;
        float wc[16];
#pragma unroll
        for (int r = 0; r < 16; ++r) wc[r] = a.in[I_GKW2][r * 256 + h * 64 + d];
        const float gb = a.in[I_GKB][h * 64 + d];
        float lgv[8];
#pragma unroll
        for (int i = 0; i < 8; ++i) { const int t = tg * 8 + i; float z = gb;
            const LAS f32x4* g4 = (const LAS f32x4*)(GKLs + t * 16);
#pragma unroll
            for (int q = 0; q < 4; ++q) { const f32x4 gv = g4[q]; z += gv.x * wc[4 * q] + gv.y * wc[4 * q + 1] + gv.z * wc[4 * q + 2] + gv.w * wc[4 * q + 3]; }
            lgv[i] = (t < ntok) ? flogsigmoid(z) * (1.f / 16.f) : 0.f; }
        LAS float* SEG = (LAS float*)(F.lds + 20736);
#pragma unroll
        for (int i = 1; i < 8; ++i) lgv[i] += lgv[i - 1];
        SEG[tg * 64 + d] = lgv[7];
        lds_barrier();
        float pre = 0.f;
#pragma unroll
        for (int s2 = 0; s2 < 7; ++s2) pre += (s2 < tg) ? SEG[s2 * 64 + d] : 0.f;
#pragma unroll
        for (int i = 0; i < 8; ++i) BC[(tg * 8 + i) * BCP + d] = lgv[i] + pre;
    }
    lds_barrier();
}

__device__ __forceinline__ void gla_g1_unit(const Args& a, const Frame& F, int b, int h, int c) {
    const bf16* PROJ = (const bf16*)(a.ws + WS_PROJ); const bf16* PROJM = (const bf16*)(a.ws + WS_PROJM);
    float* GUS = (float*)(a.ws + WS_GUS); float* DL = (float*)(a.ws + WS_DL);
    const int ntok = (c == 0) ? NMETA : 64, vp0 = (c == 0) ? 0 : NMETA + 64 * (c - 1);
    gla_bc(a, F, b, h, vp0, ntok);
    LAS float* BC = (LAS float*)(F.lds + 4096);
    LAS bf16* KT = (LAS bf16*)(F.lds + 24576);
    LAS bf16* VT = (LAS bf16*)(F.lds + 24576 + 64 * TP * 2);
    {
        const int t = F.tid >> 3, q = F.tid & 7;
        const float* bl = nullptr; (void)bl;
#pragma unroll
        for (int half = 0; half < 2; ++half) {
            const int d0 = 8 * q + 4 * half;
            const f32x4 kv = ldp4(PROJ, PROJM, b, (t < ntok) ? vp0 + t : -1, GK + h * 64 + d0);
#pragma unroll
            for (int i = 0; i < 4; ++i) { const int d = d0 + i; const float e = (t < ntok) ? fexp(BC[(ntok - 1) * BCP + d] - BC[t * BCP + d]) : 0.f;
                KT[d * TP + t] = (bf16)f2bf(kv[i] * e); }
        }
#pragma unroll
        for (int qq = 0; qq < 4; ++qq) {
            const int e0 = 16 * q + 4 * qq;
            const f32x4 vv = ldp4(PROJ, PROJM, b, (t < ntok) ? vp0 + t : -1, GV + h * 128 + e0);
#pragma unroll
            for (int i = 0; i < 4; ++i) VT[(e0 + i) * TP + t] = (bf16)f2bf(vv[i]);
        }
    }
    lds_barrier();
    {
        const int rt = F.wave & 3, ch = F.wave >> 2, fr = F.lane & 15, fq = F.lane >> 4;
        float* up = GUS + ((size_t)((b * 4 + h) * NCH + c) * 64 + rt * 16 + fr) * 128;
#pragma unroll
        for (int cc = 0; cc < 4; ++cc) { const int ct = ch * 4 + cc;
            f32x4 acc = {0.f, 0.f, 0.f, 0.f};
#pragma unroll
            for (int ks = 0; ks < 2; ++ks)
                acc = mfma16(*(const LAS bf16x8*)(VT + (ct * 16 + fr) * TP + ks * 32 + 8 * fq), *(const LAS bf16x8*)(KT + (rt * 16 + fr) * TP + ks * 32 + 8 * fq), acc);
            *(f32x4*)(up + ct * 16 + 4 * fq) = acc; }
        if (F.tid < 64) DL[(size_t)((b * 4 + h) * NCH + c) * 64 + F.tid] = fexp(BC[(ntok - 1) * BCP + F.tid]);
    }
    lds_barrier();
}

template <bool BACK>
__device__ __forceinline__ void rwkv_l1_loop(const Args& a, const Frame& F) {
    constexpr int NU = NB * 8 * NCH;
    const int u0 = (int)((long)F.blk * NU / F.G), u1 = (int)((long)(F.blk + 1) * NU / F.G);
    L1Pf pf;
    bf16x8 lrf[8];
    if (u0 < u1) l1_fetch(a, F, (u0 >> 3) / NCH, u0 & 7, (u0 >> 3) % NCH, pf, true);
    for (int u = u0; u < u1; ++u) {
        const int h = u & 7, c = (u >> 3) % NCH, b = (u >> 3) / NCH; f32x4 rtil[2];
        const bool newgrp = (u == u0) || (h == 0);
        { const Frame F1 = mkframe(F.lds, F.wave); rwkv_l1_front(a, F1, b, h, c, pf, rtil, newgrp, lrf); }
        { const Frame F2 = mkframe(F.lds, F.wave);
          if (u + 1 < u1) l1_fetch(a, F2, ((u + 1) >> 3) / NCH, (u + 1) & 7, ((u + 1) >> 3) % NCH, pf, ((u + 1) & 7) == 0);
          if constexpr (BACK) rwkv_l1_back(a, F2, b, h, c, rtil); }
    }
}
__device__ __forceinline__ void phase2(const Args& a, const Frame& F) {
    if constexpr (((REP_MASK >> 19) & 1) != 0) { const Frame F0 = mkframe(F.lds, F.wave); rwkv_l1_loop<false>(a, F0); }
    { const Frame F0 = mkframe(F.lds, F.wave); rwkv_l1_loop<true>(a, F0); }
    for (int rep_ = 0; rep_ < NREP(12); ++rep_)
    for (int u = F.blk; u < NB * 4 * 32; u += F.G) { const int c = u & 31, bh = u >> 5; const Frame F1 = mkframe(F.lds, F.wave); gla_g1_unit(a, F1, bh >> 2, bh & 3, c); }
}

struct L2S { v4u g, h; f32x4 gm; };
__device__ __forceinline__ void l2s_fetch(L2S& r, const unsigned char* src, const float* gam) {
    r.g = *(const v4u*)src; r.h = *(const v4u*)(src + 8192); r.gm = *(const f32x4*)gam;
}
__device__ __forceinline__ void l2s_stage(const L2S& r, LAS bf16* Gt, LAS bf16* Ht, LAS float* Gm, int tid) {
    const int r_ = tid >> 3, c8 = tid & 7;
    *(LAS v4u*)(Gt + r_ * TP + 8 * c8) = r.g; *(LAS v4u*)(Ht + r_ * TP + 8 * c8) = r.h;
    if (tid < 16) *(LAS f32x4*)(Gm + 4 * tid) = r.gm;
}
__device__ __forceinline__ void l2s_step(const LAS bf16* Gt, const LAS bf16* Ht, const LAS float* Gm, const LAS bf16* Sc, LAS bf16* Sn, f32x4 (&Sm)[2], int row, int cp, int fr, int fq, bf16* gout, int tid) {
    {
        const int r_ = tid >> 3, c8 = tid & 7;
        *(v4u*)(gout + r_ * 64 + 8 * c8) = *(const LAS v4u*)(Sc + r_ * TP + 8 * c8);
    }
    const int col0 = cp * 32 + 4 * fq;
    const bf16x8 af0 = *(const LAS bf16x8*)(Sc + row * TP + 8 * fq), af1 = *(const LAS bf16x8*)(Sc + row * TP + 32 + 8 * fq);
    bf16x8 fg[4]; v2u hq[2]; f32x4 gm[2];
#pragma unroll
    for (int cc = 0; cc < 2; ++cc) { const LAS bf16* gr = Gt + (cp * 32 + cc * 16 + fr) * TP + 8 * fq;
        fg[2 * cc] = *(const LAS bf16x8*)gr; fg[2 * cc + 1] = *(const LAS bf16x8*)(gr + 32);
        hq[cc] = *(const LAS v2u*)(Ht + row * TP + col0 + cc * 16); gm[cc] = *(const LAS f32x4*)(Gm + col0 + cc * 16); }
#pragma unroll
    for (int cc = 0; cc < 2; ++cc) {
        f32x4 acc = {bflo(hq[cc].x), bfhi(hq[cc].x), bflo(hq[cc].y), bfhi(hq[cc].y)};
        acc = mfma16(fg[2 * cc], af0, acc);
        acc = mfma16(fg[2 * cc + 1], af1, acc);
        Sm[cc] = Sm[cc] * gm[cc] + acc; }
#pragma unroll
    for (int cc = 0; cc < 2; ++cc) *(LAS v2u*)(Sn + row * TP + col0 + cc * 16) = pack4(Sm[cc]);
}
template <bool FAKE>
__device__ __forceinline__ void rwkv_l2_unit(const Args& a, const Frame& F, int bh) {
    unsigned char* ws = a.ws;
    LAS bf16* Sb0 = (LAS bf16*)F.lds; LAS bf16* Sb1 = Sb0 + 64 * TP;
    LAS bf16* G0 = Sb0 + 2 * 64 * TP; LAS bf16* G1 = Sb0 + 3 * 64 * TP; LAS bf16* H0 = Sb0 + 4 * 64 * TP; LAS bf16* H1 = Sb0 + 5 * 64 * TP;
    LAS float* M0 = (LAS float*)(Sb0 + 6 * 64 * TP); LAS float* M1 = M0 + 64;
    const int fr = F.lane & 15, fq = F.lane >> 4, rt = F.wave & 3, cp = F.wave >> 2;
    const int row = rt * 16 + fr, col0 = cp * 32 + 4 * fq;
    const unsigned char* srcb = ws + WS_R1 + (size_t)bh * NCH * R1_STRIDE + (size_t)((F.tid >> 3) * 64 + 8 * (F.tid & 7)) * 2;
    const float* gamb = (const float*)(ws + WS_GAM) + (size_t)bh * NCH * 64 + 4 * (F.lane & 15);
    bf16* sst = (bf16*)(ws + WS_SST) + (size_t)bh * NCH * 4096;
    f32x4 Sm[2];
#pragma unroll
    for (int cc = 0; cc < 2; ++cc) { Sm[cc] = (f32x4){0.f, 0.f, 0.f, 0.f}; *(LAS v2u*)(Sb0 + row * TP + col0 + cc * 16) = (v2u){0u, 0u}; }
    L2S r0, r1, r2, r3;
#define L2F(rr, cn) do { const int cn_ = FAKE ? 0 : (((cn) < NCH - 1) ? (cn) : NCH - 2); l2s_fetch(rr, srcb + (size_t)cn_ * R1_STRIDE, gamb + (size_t)cn_ * 64); } while (0)
    L2F(r0, 0); L2F(r1, 1); L2F(r2, 2); L2F(r3, 3);
    l2s_stage(r0, G0, H0, M0, F.tid);
    lds_barrier(); __builtin_amdgcn_sched_barrier(0);
#pragma nounroll
    for (int c = 0; c < NCH - 1; c += 4) {
        l2s_stage(r1, G1, H1, M1, F.tid); L2F(r0, c + 4);
        l2s_step(G0, H0, M0, Sb0, Sb1, Sm, row, cp, fr, fq, sst + (size_t)c * 4096, F.tid); lds_barrier(); __builtin_amdgcn_sched_barrier(0);
        l2s_stage(r2, G0, H0, M0, F.tid); L2F(r1, c + 5);
        l2s_step(G1, H1, M1, Sb1, Sb0, Sm, row, cp, fr, fq, sst + (size_t)(c + 1) * 4096, F.tid); lds_barrier(); __builtin_amdgcn_sched_barrier(0);
        l2s_stage(r3, G1, H1, M1, F.tid); L2F(r2, c + 6);
        l2s_step(G0, H0, M0, Sb0, Sb1, Sm, row, cp, fr, fq, sst + (size_t)(c + 2) * 4096, F.tid); lds_barrier(); __builtin_amdgcn_sched_barrier(0);
        l2s_stage(r0, G0, H0, M0, F.tid); L2F(r3, c + 7);
        l2s_step(G1, H1, M1, Sb1, Sb0, Sm, row, cp, fr, fq, sst + (size_t)(c + 3) * 4096, F.tid); lds_barrier(); __builtin_amdgcn_sched_barrier(0);
    }
#undef L2F
    { const int r_ = F.tid >> 3, c8 = F.tid & 7;
      *(v4u*)(sst + (size_t)(NCH - 1) * 4096 + r_ * 64 + 8 * c8) = *(const LAS v4u*)(Sb0 + r_ * TP + 8 * c8); }
    lds_barrier();
}
__device__ __forceinline__ void rwkv_y_task(const Args& a, const Frame& F, int task) {
    unsigned char* ws = a.ws;
    const int c = 1 + (task & 31), bh = task >> 5, b = bh >> 3, h = bh & 7;
    const int fr = F.lane & 15, fq = F.lane >> 4;
    const bf16* Sg = (const bf16*)(ws + WS_SST) + (size_t)(bh * NCH + c) * 4096 + fr * 64 + 8 * fq;
    bf16x8 sf[8];
#pragma unroll
    for (int ct = 0; ct < 4; ++ct) { sf[2 * ct] = *(const bf16x8*)(Sg + ct * 1024); sf[2 * ct + 1] = *(const bf16x8*)(Sg + ct * 1024 + 32); }
    f32x4 lg[4], lb[4];
#pragma unroll
    for (int ct = 0; ct < 4; ++ct) { const int i0 = h * 64 + ct * 16 + 4 * fq; lg[ct] = *(const f32x4*)(a.in[I_RLNG] + i0); lb[ct] = *(const f32x4*)(a.in[I_RLNB] + i0); }
    LAS bf16* ost = (LAS bf16*)(F.lds + 102400 + F.wave * 2304);
    const unsigned char* r1u = ws + WS_R1 + (size_t)(bh * NCH + c) * R1_STRIDE + (size_t)(fr * 64 + 4 * fq) * 2;
    bf16x8 fa0[4], fa1[4]; v2u q0[4][4];
#pragma unroll
    for (int rt = 0; rt < 4; ++rt) { const unsigned char* r1 = r1u + rt * 2048;
        fa0[rt] = *(const bf16x8*)(r1 + 2 * 8192 + 8 * fq); fa1[rt] = *(const bf16x8*)(r1 + 2 * 8192 + 64 + 8 * fq);
#pragma unroll
        for (int ct = 0; ct < 4; ++ct) q0[rt][ct] = *(const v2u*)(r1 + 3 * 8192 + ct * 32); }
#pragma unroll
    for (int rt = 0; rt < 4; ++rt) {
        const unsigned char* r1 = r1u + rt * 2048;
        v2u q1[4], q2[4];
#pragma unroll
        for (int ct = 0; ct < 4; ++ct) { q1[ct] = *(const v2u*)(r1 + 4 * 8192 + ct * 32); q2[ct] = *(const v2u*)(r1 + 5 * 8192 + ct * 32); }
        f32x4 y[4]; float s = 0.f;
#pragma unroll
        for (int ct = 0; ct < 4; ++ct) {
            f32x4 acc = {bflo(q0[rt][ct].x), bfhi(q0[rt][ct].x), bflo(q0[rt][ct].y), bfhi(q0[rt][ct].y)};
            acc = mfma16(sf[2 * ct], fa0[rt], acc); acc = mfma16(sf[2 * ct + 1], fa1[rt], acc);
            y[ct] = acc; s += (acc[0] + acc[1]) + (acc[2] + acc[3]); }
        s += shx(s, 16, F.lane); s += shx(s, 32, F.lane);
        const float mean = s * (1.f / 64.f); float q = 0.f;
#pragma unroll
        for (int ct = 0; ct < 4; ++ct) { y[ct] = y[ct] - mean; q += (y[ct][0] * y[ct][0] + y[ct][1] * y[ct][1]) + (y[ct][2] * y[ct][2] + y[ct][3] * y[ct][3]); }
        q += shx(q, 16, F.lane); q += shx(q, 32, F.lane);
        const float rstd = __builtin_amdgcn_rsqf(q * (1.f / 64.f) + 64e-5f);
#pragma unroll
        for (int ct = 0; ct < 4; ++ct) {
            const f32x4 g = {bflo(q1[ct].x), bfhi(q1[ct].x), bflo(q1[ct].y), bfhi(q1[ct].y)}, bv = {bflo(q2[ct].x), bfhi(q2[ct].x), bflo(q2[ct].y), bfhi(q2[ct].y)};
            const f32x4 o = (y[ct] * rstd * lg[ct] + lb[ct] + bv) * g;
            *(LAS v2u*)(ost + fr * 72 + ct * 16 + 4 * fq) = pack4(o); }
        asm volatile("s_waitcnt lgkmcnt(0)" ::: "memory");
        bf16* yout = (bf16*)(ws + WS_YMIX) + ((size_t)b * SEQ + 64 * (c - 1) + rt * 16) * D + 512 + h * 64;
#pragma unroll
        for (int hh = 0; hh < 2; ++hh) { const int tr = (F.lane >> 3) + 8 * hh, c8 = F.lane & 7;
            *(v4u*)(yout + (size_t)tr * D + 8 * c8) = *(const LAS v4u*)(ost + tr * 72 + 8 * c8); }
        asm volatile("s_waitcnt lgkmcnt(0)" ::: "memory");
    }
}
__device__ __forceinline__ void gla_scan_unit(const Args& a, const Frame& F, int j) {
    float* GUS = (float*)(a.ws + WS_GUS); const float* DL = (const float*)(a.ws + WS_DL);
    const int bh = j >> 1, half = j & 1;
    const int d = 32 * half + (F.tid >> 4), e0 = (F.tid & 15) * 4;
    float* base = GUS + (size_t)bh * NCH * 8192 + d * 128 + e0;
    const float* dl = DL + (size_t)bh * NCH * 64 + d;
    f32x4 s0 = {0.f, 0.f, 0.f, 0.f}, s1 = s0;
    f32x4 ua[8], ub[8]; float dq[8];
#pragma unroll
    for (int q = 0; q < 7; ++q) { ua[q] = *(const f32x4*)(base + (size_t)q * 8192); ub[q] = *(const f32x4*)(base + (size_t)q * 8192 + 64); dq[q] = dl[q * 64]; }
#pragma unroll 8
    for (int c = 0; c < NCH - 1; ++c) {
        const int cn = (c + 7 < NCH - 1) ? c + 7 : NCH - 2;
        ua[(c + 7) & 7] = *(const f32x4*)(base + (size_t)cn * 8192); ub[(c + 7) & 7] = *(const f32x4*)(base + (size_t)cn * 8192 + 64); dq[(c + 7) & 7] = dl[cn * 64];
        *(f32x4*)(base + (size_t)c * 8192) = s0; *(f32x4*)(base + (size_t)c * 8192 + 64) = s1;
        s0 = s0 * dq[c & 7] + ua[c & 7]; s1 = s1 * dq[c & 7] + ub[c & 7];
    }
    *(f32x4*)(base + (size_t)(NCH - 1) * 8192) = s0; *(f32x4*)(base + (size_t)(NCH - 1) * 8192 + 64) = s1;
}
__device__ __forceinline__ void phase3(const Args& a, const Frame& F) {
    for (int u = F.blk; u < 256; u += F.G) {
        if (u < 128) { if constexpr (((REP_MASK >> 20) & 1) != 0) rwkv_l2_unit<true>(a, F, u); for (int rep_ = 0; rep_ < NREP(3); ++rep_) rwkv_l2_unit<false>(a, F, u); }
        else gla_scan_unit(a, F, u - 128);
    }
}

struct G3Pf { v2u gkl, q[2], k[2], v[4], gg[4]; f32x4 s[4]; };
struct G3Const { float wc[16], gb; f32x4 ng[4]; };
__device__ __forceinline__ void g3_fetch(const Args& a, const Frame& F, int b, int h, int c, G3Pf& pf) {
    const bf16* PROJ = (const bf16*)(a.ws + WS_PROJ); const bf16* PROJM = (const bf16*)(a.ws + WS_PROJM);
    const float* GUS = (const float*)(a.ws + WS_GUS);
    const int vp0 = NMETA + 64 * (c - 1);
    { const int t = (F.tid >> 2) & 63, q = F.tid & 3; pf.gkl = *(const v2u*)(prow(PROJ, PROJM, b, vp0 + t) + GKL + 4 * q); }
    const int t = F.tid >> 3, q = F.tid & 7; const bf16* pr = prow(PROJ, PROJM, b, vp0 + t);
#pragma unroll
    for (int i = 0; i < 2; ++i) { pf.q[i] = *(const v2u*)(pr + GQ + h * 64 + 8 * q + 4 * i); pf.k[i] = *(const v2u*)(pr + GK + h * 64 + 8 * q + 4 * i); }
#pragma unroll
    for (int qq = 0; qq < 4; ++qq) { pf.v[qq] = *(const v2u*)(pr + GV + h * 128 + 16 * q + 4 * qq);
        pf.s[qq] = *(const f32x4*)(GUS + ((size_t)((b * 4 + h) * NCH + c) * 64 + t) * 128 + 16 * q + 4 * qq); }
    const int rt = F.wave & 3, wh = F.wave >> 2, fr = F.lane & 15, fq = F.lane >> 4;
    const bf16* pg = prow(PROJ, PROJM, b, vp0 + rt * 16 + fr);
#pragma unroll
    for (int cc = 0; cc < 4; ++cc) pf.gg[cc] = *(const v2u*)(pg + GG + h * 128 + (wh * 4 + cc) * 16 + 4 * fq);
}
__device__ __forceinline__ void gla_g3_unit(const Args& a, const Frame& F, int b, int h, int c, const G3Pf& pf, const G3Const& K) {
    bf16* YMIX = (bf16*)(a.ws + WS_YMIX);
    const int vp0 = NMETA + 64 * (c - 1);
    LAS float* GKLs = (LAS float*)F.lds; LAS float* BC = (LAS float*)(F.lds + 4096);
    LAS bf16* QT = (LAS bf16*)(F.lds + 24576);
    LAS bf16* KL = QT + 64 * TP;
    LAS bf16* AT = KL + 64 * TP;
    LAS bf16* VT = AT + 64 * TP;
    LAS bf16* ST = VT + 128 * TP;
    LAS float* RS = (LAS float*)(ST + 128 * TP);
    if (F.tid < 256) { const int t = F.tid >> 2, q = F.tid & 3; *(LAS f32x4*)(GKLs + t * 16 + 4 * q) = unpk4(pf.gkl); }
    lds_barrier();
    {
        const int d = F.tid & 63, tg = F.tid >> 6;
        float lgv[8];
#pragma unroll
        for (int i = 0; i < 8; ++i) { const int t = tg * 8 + i; float z = K.gb;
            const LAS f32x4* g4 = (const LAS f32x4*)(GKLs + t * 16);
#pragma unroll
            for (int q = 0; q < 4; ++q) { const f32x4 gv = g4[q]; z += gv.x * K.wc[4 * q] + gv.y * K.wc[4 * q + 1] + gv.z * K.wc[4 * q + 2] + gv.w * K.wc[4 * q + 3]; }
            lgv[i] = flogsigmoid(z) * (1.f / 16.f); }
        LAS float* SEG = (LAS float*)(F.lds + 20736);
#pragma unroll
        for (int i = 1; i < 8; ++i) lgv[i] += lgv[i - 1];
        SEG[tg * 64 + d] = lgv[7];
        lds_barrier();
        float pre = 0.f;
#pragma unroll
        for (int s2 = 0; s2 < 7; ++s2) pre += (s2 < tg) ? SEG[s2 * 64 + d] : 0.f;
#pragma unroll
        for (int i = 0; i < 8; ++i) BC[(tg * 8 + i) * BCP + d] = lgv[i] + pre;
    }
    lds_barrier();
    const int rt = F.wave & 3, wh = F.wave >> 2, fr = F.lane & 15, fq = F.lane >> 4;
    const int trow = rt * 16 + fr;
    f32x4 sg[4];
#pragma unroll
    for (int cc = 0; cc < 4; ++cc) { const f32x4 gv = unpk4(pf.gg[cc]);
#pragma unroll
        for (int i = 0; i < 4; ++i) sg[cc][i] = K.ng[cc][i] * (gv[i] * fsigmoid(gv[i])); }
    {
        const int t = F.tid >> 3, q = F.tid & 7;
        const f32x4 q0 = unpk4(pf.q[0]), q1 = unpk4(pf.q[1]), k0 = unpk4(pf.k[0]), k1 = unpk4(pf.k[1]);
        float qv[8] = {q0.x, q0.y, q0.z, q0.w, q1.x, q1.y, q1.z, q1.w}, kv[8] = {k0.x, k0.y, k0.z, k0.w, k1.x, k1.y, k1.z, k1.w};
#pragma unroll
        for (int i = 0; i < 8; ++i) { const float bcv = BC[t * BCP + 8 * q + i]; qv[i] *= fexp(bcv) * 0.125f; kv[i] *= fexp(-bcv); }
        v4u o; o.x = pk2(qv[0], qv[1]); o.y = pk2(qv[2], qv[3]); o.z = pk2(qv[4], qv[5]); o.w = pk2(qv[6], qv[7]);
        *(LAS v4u*)(QT + t * TP + 8 * q) = o;
        o.x = pk2(kv[0], kv[1]); o.y = pk2(kv[2], kv[3]); o.z = pk2(kv[4], kv[5]); o.w = pk2(kv[6], kv[7]);
        *(LAS v4u*)(KL + t * TP + 8 * q) = o;
#pragma unroll
        for (int qq = 0; qq < 4; ++qq) {
            const int e0 = 16 * q + 4 * qq;
            const unsigned vx = pf.v[qq].x, vy = pf.v[qq].y;
            VT[(e0 + 0) * TP + t] = (bf16)(vx & 0xffffu); VT[(e0 + 1) * TP + t] = (bf16)(vx >> 16); VT[(e0 + 2) * TP + t] = (bf16)(vy & 0xffffu); VT[(e0 + 3) * TP + t] = (bf16)(vy >> 16);
#pragma unroll
            for (int i = 0; i < 4; ++i) ST[(e0 + i) * TP + t] = (bf16)f2bf(pf.s[qq][i]);
        }
    }
    lds_barrier();
    {
        f32x4 av[2];
#pragma unroll
        for (int cc = 0; cc < 2; ++cc) { const int ct = 2 * wh + cc;
            f32x4 acc = {0.f, 0.f, 0.f, 0.f};
#pragma unroll
            for (int ks = 0; ks < 2; ++ks)
                acc = mfma16(*(const LAS bf16x8*)(KL + (ct * 16 + fr) * TP + ks * 32 + 8 * fq), *(const LAS bf16x8*)(QT + trow * TP + ks * 32 + 8 * fq), acc);
            const int s0 = ct * 16 + 4 * fq;
#pragma unroll
            for (int i = 0; i < 4; ++i) if (s0 + i > trow) acc[i] = 0.f;
            av[cc] = acc; }
#pragma unroll
        for (int cc = 0; cc < 2; ++cc) *(LAS v2u*)(AT + trow * TP + (2 * wh + cc) * 16 + 4 * fq) = pack4(av[cc]);
    }
    lds_barrier();
    f32x4 oacc[4]; float ssq = 0.f;
#pragma unroll
    for (int cc = 0; cc < 4; ++cc) { const int ct = wh * 4 + cc;
        f32x4 acc = {0.f, 0.f, 0.f, 0.f};
#pragma unroll
        for (int ks = 0; ks < 2; ++ks) {
            acc = mfma16(*(const LAS bf16x8*)(VT + (ct * 16 + fr) * TP + ks * 32 + 8 * fq), *(const LAS bf16x8*)(AT + trow * TP + ks * 32 + 8 * fq), acc);
            acc = mfma16(*(const LAS bf16x8*)(ST + (ct * 16 + fr) * TP + ks * 32 + 8 * fq), *(const LAS bf16x8*)(QT + trow * TP + ks * 32 + 8 * fq), acc);
        }
        oacc[cc] = acc; ssq += (acc[0] * acc[0] + acc[1] * acc[1]) + (acc[2] * acc[2] + acc[3] * acc[3]); }
    ssq += shx(ssq, 16, F.lane); ssq += shx(ssq, 32, F.lane);
    if (fq == 0) RS[wh * 64 + trow] = ssq;
    lds_barrier();
    {
        const float tot = RS[trow] + RS[64 + trow];
        const float rstd = 1.f / sqrtf(tot * (1.f / 128.f) + 1e-6f);
        const size_t m = (size_t)b * SEQ + (vp0 - NMETA) + trow;
#pragma unroll
        for (int cc = 0; cc < 4; ++cc) { const int e0 = (wh * 4 + cc) * 16 + 4 * fq;
            const f32x4 y = oacc[cc] * rstd * sg[cc];
            *(v2u*)(YMIX + m * D + h * 128 + e0) = pack4(y); }
    }
    lds_barrier();
}
__device__ __forceinline__ void phase4(const Args& a, const Frame& F) {
    for (int rep_ = 0; rep_ < NREP(21); ++rep_)
    for (int t = F.blk * NWAVES + F.wave; t < 128 * 32; t += F.G * NWAVES) { const Frame F1 = mkframe(F.lds, F.wave); rwkv_y_task(a, F1, t); }
    __syncthreads();
    for (int rep_ = 0; rep_ < NREP(22); ++rep_) {
        constexpr int NU = NB * 4 * 32;
        const int h = (F.blk >> 5) & 3;
        G3Const K;
        { const int d = F.tid & 63, wh = F.wave >> 2, fq = F.lane >> 4;
#pragma unroll
          for (int r = 0; r < 16; ++r) K.wc[r] = a.in[I_GKW2][r * 256 + h * 64 + d];
          K.gb = a.in[I_GKB][h * 64 + d];
#pragma unroll
          for (int cc = 0; cc < 4; ++cc) K.ng[cc] = *(const f32x4*)(a.in[I_GNORM] + (wh * 4 + cc) * 16 + 4 * fq); }
        G3Pf pa, pb;
        if (F.blk < NU) g3_fetch(a, F, F.blk >> 7, h, 1 + (F.blk & 31), pa);
        for (int u = F.blk; u < NU; u += 2 * F.G) {
            const int u1 = u + F.G, u2 = u + 2 * F.G;
            { const Frame F1 = mkframe(F.lds, F.wave);
              { const int uf = (u1 < NU) ? u1 : u; g3_fetch(a, F1, uf >> 7, h, 1 + (uf & 31), pb); }
              gla_g3_unit(a, F1, u >> 7, h, 1 + (u & 31), pa, K); }
            if (u1 < NU) { const Frame F1 = mkframe(F.lds, F.wave);
              { const int uf = (u2 < NU) ? u2 : u1; g3_fetch(a, F1, uf >> 7, h, 1 + (uf & 31), pa); }
              gla_g3_unit(a, F1, u1 >> 7, h, 1 + (u1 & 31), pb, K); }
        }
    }
}

__device__ __forceinline__ int eidx_of(int L) { return 16 * (L & 1) + 8 * ((L >> 1) & 1) + 4 * ((L >> 2) & 1) + 2 * ((L >> 3) & 1) + ((L >> 4) & 1); }
__device__ __forceinline__ void p6_row(const Args& a, const Frame& F, int m, const v4u (&a0)[2], const v4u (&mx)[2], const f32x4 (&g1)[4], const f32x4 (&b1)[4]) {
    unsigned char* ws = a.ws; bf16* H1 = (bf16*)(ws + WS_H1);
    float v[16];
#pragma unroll
    for (int j = 0; j < 2; ++j)
#pragma unroll
        for (int k = 0; k < 4; ++k) { v[8 * j + 2 * k] = ALPHA * bflo(a0[j][k]) + bflo(mx[j][k]); v[8 * j + 2 * k + 1] = ALPHA * bfhi(a0[j][k]) + bfhi(mx[j][k]); }
    float s = 0.f;
#pragma unroll
    for (int k = 0; k < 16; ++k) s += v[k];
    const float mean = wave_sum(s, F.lane) * (1.f / D); float s2 = 0.f;
#pragma unroll
    for (int k = 0; k < 16; ++k) { v[k] -= mean; s2 += v[k] * v[k]; }
    const float rstd = __builtin_amdgcn_rsqf(wave_sum(s2, F.lane) * (1.f / D) + 1e-5f);
#pragma unroll
    for (int j = 0; j < 2; ++j) {
#pragma unroll
        for (int k = 0; k < 8; ++k) v[8 * j + k] = v[8 * j + k] * rstd * g1[2 * j + (k >> 2)][k & 3] + b1[2 * j + (k >> 2)][k & 3];
        v4u o; o.x = pk2(v[8 * j], v[8 * j + 1]); o.y = pk2(v[8 * j + 2], v[8 * j + 3]); o.z = pk2(v[8 * j + 4], v[8 * j + 5]); o.w = pk2(v[8 * j + 6], v[8 * j + 7]);
        *(v4u*)(H1 + (size_t)m * D + 8 * F.lane + 512 * j) = o;
        int w0 = __builtin_amdgcn_cvt_pk_fp8_f32(v[8 * j], v[8 * j + 1], 0, false); w0 = __builtin_amdgcn_cvt_pk_fp8_f32(v[8 * j + 2], v[8 * j + 3], w0, true);
        int w1 = __builtin_amdgcn_cvt_pk_fp8_f32(v[8 * j + 4], v[8 * j + 5], 0, false); w1 = __builtin_amdgcn_cvt_pk_fp8_f32(v[8 * j + 6], v[8 * j + 7], w1, true);
        *(v2u*)(ws + WS_H1Q + (size_t)m * D + 8 * F.lane + 512 * j) = (v2u){(unsigned)w0, (unsigned)w1}; }
}
__device__ __forceinline__ void phase6(const Args& a, const Frame& F, int csel) {
    unsigned char* ws = a.ws;
    LAS float* LG = (LAS float*)(F.lds + F.wave * 2560);
    LAS int* hist = (LAS int*)(F.lds + 8 * 2560);
    bf16* H1 = (bf16*)(ws + WS_H1);
    const bf16* RWH = (const bf16*)(ws + WS_RWH); const bf16* RWL = (const bf16*)(ws + WS_RWL);
    int* TOPI = (int*)(ws + WS_TOPI); float* GATE = (float*)(ws + WS_GATE); int* RANK = (int*)(ws + WS_RANK);
    int* BCNT = (int*)(ws + WS_BCNT); (void)csel;
    for (int rb = F.blk; rb < MX / 128; rb += F.G) {
        if (F.tid < 64) hist[F.tid] = 0;
        __syncthreads();
        const int mb = rb * 128 + F.wave * 16; const Frame& Fo = F;
        {
            const bf16* ar0 = (const bf16*)(ws + WS_A0) + (size_t)mb * D + 8 * F.lane;
            const bf16* mr0 = (const bf16*)(ws + WS_MIXB) + (size_t)mb * D + 8 * F.lane;
            constexpr int NS = 6;
            v4u av[NS][2], mv[NS][2];
            f32x4 g1[4], b1[4];
#pragma unroll
            for (int q = 0; q < 4; ++q) { const int col = 8 * F.lane + 512 * (q >> 1) + 4 * (q & 1); g1[q] = *(const f32x4*)(a.in[I_LN1G] + col); b1[q] = *(const f32x4*)(a.in[I_LN1B] + col); }
#define P6_LOAD(ss, ii) do { _Pragma("unroll") for (int j = 0; j < 2; ++j) { av[ss][j] = *(const v4u*)(ar0 + (size_t)(ii) * D + 512 * j); mv[ss][j] = *(const v4u*)(mr0 + (size_t)(ii) * D + 512 * j); } } while (0)
#pragma unroll
            for (int i = 0; i < NS - 1; ++i) P6_LOAD(i, i);
            __builtin_amdgcn_sched_barrier(0);
#pragma unroll
            for (int i = 0; i < 16; ++i) {
                if (i + NS - 1 < 16) P6_LOAD((i + NS - 1) % NS, i + NS - 1);
                __builtin_amdgcn_sched_barrier(0);
                p6_row(a, F, mb + i, av[i % NS], mv[i % NS], g1, b1);
            }
#undef P6_LOAD
        }
        asm volatile("s_waitcnt vmcnt(0)" ::: "memory");
        for (int rep2_ = 0; rep2_ < NREP(24); ++rep2_)
        {
            const int fr = F.lane & 15, fq = F.lane >> 4;
            const bf16* ap = H1 + (size_t)(mb + fr) * D + 8 * fq;
            const bf16* bh = RWH + (size_t)fr * D + 8 * fq; const bf16* bl = RWL + (size_t)fr * D + 8 * fq;
            f32x4 acc0 = {0.f, 0.f, 0.f, 0.f}, acc1 = acc0;
#pragma unroll 8
            for (int ks = 0; ks < 32; ++ks) { const bf16x8 af = *(const bf16x8*)(ap + ks * 32);
                acc0 = mfma16(*(const bf16x8*)(bh + ks * 32), af, acc0); acc0 = mfma16(*(const bf16x8*)(bl + ks * 32), af, acc0);
                acc1 = mfma16(*(const bf16x8*)(bh + 16 * D + ks * 32), af, acc1); acc1 = mfma16(*(const bf16x8*)(bl + 16 * D + ks * 32), af, acc1); }
            const f32x4 rb0 = *(const f32x4*)(a.in[I_RTB] + 4 * fq), rb1 = *(const f32x4*)(a.in[I_RTB] + 16 + 4 * fq);
#pragma unroll
            for (int q = 0; q < 4; ++q) { LG[fr * 33 + 4 * fq + q] = acc0[q] + rb0[q]; LG[fr * 33 + 16 + 4 * fq + q] = acc1[q] + rb1[q]; }
        }
        asm volatile("s_waitcnt lgkmcnt(0)" ::: "memory");
        LAS int* EK = (LAS int*)(LG + 528);
        if (F.lane < 16) {
            float lv[32];
#pragma unroll
            for (int e = 0; e < 32; ++e) lv[e] = LG[F.lane * 33 + e];
            int ek[4]; float lk[4];
#pragma unroll
            for (int k = 0; k < 4; ++k) { float best = -3.0e38f; int bi = 0;
#pragma unroll
                for (int e = 0; e < 32; ++e) { const bool tk = lv[e] > best; best = tk ? lv[e] : best; bi = tk ? e : bi; }
                ek[k] = bi; lk[k] = best;
#pragma unroll
                for (int e = 0; e < 32; ++e) lv[e] = (e == bi) ? -3.0e38f : lv[e]; }
            const float e1 = expf(lk[1] - lk[0]), e2 = expf(lk[2] - lk[0]), e3 = expf(lk[3] - lk[0]);
            const float inv = 1.f / (1.f + e1 + e2 + e3);
            const size_t m = (size_t)(mb + F.lane);
            *(i32x4g*)(TOPI + m * 4) = (i32x4g){ek[0], ek[1], ek[2], ek[3]};
            *(f32x4*)(GATE + m * 4) = (f32x4){inv, e1 * inv, e2 * inv, e3 * inv};
#pragma unroll
            for (int k = 0; k < 4; ++k) EK[F.lane * 4 + k] = ek[k];
        }
        asm volatile("s_waitcnt lgkmcnt(0)" ::: "memory");
        const int my_e = EK[F.lane];
        const int lrank = __hip_atomic_fetch_add(&hist[my_e], 1, __ATOMIC_RELAXED, __HIP_MEMORY_SCOPE_WORKGROUP);
        __syncthreads();
        if (F.tid < 32) BCNT[rb * 32 + F.tid] = hist[F.tid];
        RANK[((size_t)rb * 128 + F.wave * 16 + (F.lane >> 2)) * 4 + (F.lane & 3)] = lrank;
        __syncthreads();
    }
}

__device__ __forceinline__ void phase7(const Args& a, const Frame& F) {
    unsigned char* ws = a.ws;
    LAS int* starts = (LAS int*)F.lds;
    LAS int* part = (LAS int*)(F.lds + 1024);
    const int* BCNT = (const int*)(ws + WS_BCNT);
    int* TILEE = (int*)(ws + WS_TILEE); int* SLOTTOK = (int*)(ws + WS_SLOTTOK);
    { const int e = F.tid & 31, pt = F.tid >> 5; int tot = 0, below = 0;
#pragma unroll
      for (int i = 0; i < 16; ++i) { const int bb = 16 * pt + i; const int v = BCNT[bb * 32 + e]; tot += v; below += (bb < F.blk) ? v : 0; }
      part[pt * 64 + e] = tot; part[pt * 64 + 32 + e] = below; }
    __syncthreads();
    if (F.tid < 32) { int cnt = 0, bb = 0;
#pragma unroll
        for (int pt = 0; pt < 16; ++pt) { cnt += part[pt * 64 + F.tid]; bb += part[pt * 64 + 32 + F.tid]; }
        starts[64 + F.tid] = cnt; starts[32 + F.tid] = (cnt + 255) & ~255; starts[96 + F.tid] = bb; }
    __syncthreads();
    if (F.tid == 0) { int run = 0; for (int e = 0; e < 32; ++e) { starts[e] = run; run += starts[32 + e]; }
        if (F.blk == 0) { TILEE[1023] = run >> 8; for (int e = 0; e < 32; ++e) for (int tl = starts[e] >> 8; tl < (starts[e] + starts[32 + e]) >> 8; ++tl) TILEE[tl] = e; } }
    __syncthreads();
    if (F.blk == 0) { for (int e = 0; e < 32; ++e) for (int s = starts[e] + starts[64 + e] + F.tid; s < starts[e] + starts[32 + e]; s += NTHR) SLOTTOK[s] = 0; }
    const int* TOPI = (const int*)(ws + WS_TOPI); const int* RANK = (const int*)(ws + WS_RANK); int* TSLOT = (int*)(ws + WS_TSLOT);
    static_assert(MX * 4 == 256 * NTHR, "one (token, k) pair per thread; the tokens of workgroup b are row block b of P6");
    { const int q = F.blk * NTHR + F.tid; const int e = TOPI[q];
      const int slot = starts[e] + starts[96 + e] + RANK[q];
      TSLOT[q] = slot; SLOTTOK[slot] = q >> 2; }
}
__device__ __forceinline__ int moe_fill_table(const Args& a, const Frame& F, int nN, int RM) {
    LAS int* tab = (LAS int*)(F.lds + TAB_OFF);
    const unsigned* TILEE = (const unsigned*)(a.ws + WS_TILEE);
    if (F.tid == 0) {
        const int NT = (int)ld_agent(TILEE + 1023);
        const int x = F.blk & 7, j = F.blk >> 3; int n = 0;
        for (int i = 0; i < 64; ++i) { const int s = i * 8 + x, pm = s * RM + j / nN; if (pm >= NT) break;
            const int e = (int)ld_agent(TILEE + pm); tab[2 * n] = pm; tab[2 * n + 1] = e * nN + (j % nN); ++n; }
        tab[128] = n;
    }
    __syncthreads();
    return __builtin_amdgcn_readfirstlane(tab[128]);
}

__device__ __forceinline__ void p10_acc(float (&s)[16], int j, const v4u w, float g) {
    s[8 * j + 0] += g * bflo(w.x); s[8 * j + 1] += g * bfhi(w.x); s[8 * j + 2] += g * bflo(w.y); s[8 * j + 3] += g * bfhi(w.y);
    s[8 * j + 4] += g * bflo(w.z); s[8 * j + 5] += g * bfhi(w.z); s[8 * j + 6] += g * bflo(w.w); s[8 * j + 7] += g * bfhi(w.w);
}
typedef float f32x2 __attribute__((ext_vector_type(2)));
__device__ __forceinline__ void p10_acc8(float (&s)[16], int j, const v2u w, float g) {
    const f32x2 a0 = __builtin_amdgcn_cvt_pk_f32_fp8((int)w.x, false), a1 = __builtin_amdgcn_cvt_pk_f32_fp8((int)w.x, true);
    const f32x2 a2 = __builtin_amdgcn_cvt_pk_f32_fp8((int)w.y, false), a3 = __builtin_amdgcn_cvt_pk_f32_fp8((int)w.y, true);
    s[8 * j + 0] += g * a0.x; s[8 * j + 1] += g * a0.y; s[8 * j + 2] += g * a1.x; s[8 * j + 3] += g * a1.y;
    s[8 * j + 4] += g * a2.x; s[8 * j + 5] += g * a2.y; s[8 * j + 6] += g * a3.x; s[8 * j + 7] += g * a3.y;
}
__device__ __forceinline__ void phase10(const Args& a, const Frame& F) {
    unsigned char* ws = a.ws;
    const bf16* H1 = (const bf16*)(ws + WS_H1); const unsigned char* YS = ws + WS_YS;
    const int* TSLOT = (const int*)(ws + WS_TSLOT); const float* GATE = (const float*)(ws + WS_GATE);
    const int gw = F.blk * NWAVES + F.wave, NGW = F.G * NWAVES;
    f32x4 gv[4], bv[4];
#pragma unroll
    for (int q = 0; q < 4; ++q) { const int col = 8 * F.lane + 512 * (q >> 1) + 4 * (q & 1); gv[q] = *(const f32x4*)(a.in[I_LN2G] + col); bv[q] = *(const f32x4*)(a.in[I_LN2B] + col); }
    for (int m0 = gw; m0 < MX; m0 += 2 * NGW) {
        int mm[2]; mm[0] = m0; mm[1] = (m0 + NGW < MX) ? m0 + NGW : m0;
        int slot[2][4]; float gt[2][4]; v4u hw[2][2]; v2u yw[2][4][2];
#pragma unroll
        for (int r = 0; r < 2; ++r) {
#pragma unroll
            for (int k = 0; k < 4; ++k) { slot[r][k] = TSLOT[(size_t)mm[r] * 4 + k]; gt[r][k] = GATE[(size_t)mm[r] * 4 + k]; }
#pragma unroll
            for (int j = 0; j < 2; ++j) hw[r][j] = *(const v4u*)(H1 + (size_t)mm[r] * D + 8 * F.lane + 512 * j); }
#pragma unroll
        for (int r = 0; r < 2; ++r)
#pragma unroll
            for (int k = 0; k < 4; ++k)
#pragma unroll
                for (int j = 0; j < 2; ++j) yw[r][k][j] = *(const v2u*)(YS + (size_t)slot[r][k] * D + 8 * F.lane + 512 * j);
#pragma unroll
        for (int r = 0; r < 2; ++r) {
            float s[16];
#pragma unroll
            for (int i = 0; i < 16; ++i) s[i] = 0.f;
#pragma unroll
            for (int j = 0; j < 2; ++j) p10_acc(s, j, hw[r][j], ALPHA);
#pragma unroll
            for (int k = 0; k < 4; ++k)
#pragma unroll
                for (int j = 0; j < 2; ++j) p10_acc8(s, j, yw[r][k][j], gt[r][k]);
            float t = 0.f;
#pragma unroll
            for (int i = 0; i < 16; ++i) t += s[i];
            const float mean = wave_sum(t, F.lane) * (1.f / D); float q = 0.f;
#pragma unroll
            for (int i = 0; i < 16; ++i) { s[i] -= mean; q += s[i] * s[i]; }
            const float rstd = __builtin_amdgcn_rsqf(wave_sum(q, F.lane) * (1.f / D) + 1e-5f);
            if (r == 0 || mm[1] != mm[0]) {
#pragma unroll
                for (int q4 = 0; q4 < 4; ++q4) { const int col = 8 * F.lane + 512 * (q4 >> 1) + 4 * (q4 & 1);
                    f32x4 o; o.x = s[4 * q4 + 0] * rstd * gv[q4].x + bv[q4].x; o.y = s[4 * q4 + 1] * rstd * gv[q4].y + bv[q4].y; o.z = s[4 * q4 + 2] * rstd * gv[q4].z + bv[q4].z; o.w = s[4 * q4 + 3] * rstd * gv[q4].w + bv[q4].w;
                    *(f32x4*)(a.out + (size_t)mm[r] * D + col) = o; } }
        }
    }
}

template <int LO, int HI>
__global__ void __launch_bounds__(NTHR, 2) fwd(Args a) {
    extern __shared__ __attribute__((aligned(16))) unsigned char lds_raw[];
    LAS unsigned char* lds = (LAS unsigned char*)lds_raw;
    const int wave = __builtin_amdgcn_readfirstlane((int)(threadIdx.x >> 6));
    volatile LAS unsigned* MISC = (volatile LAS unsigned*)(lds + MISC_OFF);
    if (wave == 0) MISC[lane_id()] = 0u;
    __syncthreads();
    unsigned* ctl = (unsigned*)(a.ws + WS_CTL);
    XcdBarrier bar; bar.bar = ctl + CW_BAR; bar.x = 0; bar.st = nullptr;
    if constexpr (HI - LO > 1) bar = xcd_barrier_post(ctl + CW_BAR, MISC + 8, wave == 0 && lane_id() == 0);
#define PH(k) if constexpr (LO <= (k) && (k) < HI)
#define SEAM(k) if constexpr (LO <= (k) && (k) + 1 < HI) xcd_barrier(bar, wave == 0 && lane_id() == 0)
    PH(0) for (int rep_ = 0; rep_ < NREP(0); ++rep_) { const Frame F = mkframe(lds, wave); phase0(a, F); } SEAM(0);
    PH(1) if constexpr (((REP_MASK >> 25) & 1) != 0) { const Frame F = mkframe(lds, wave);
            struct FakeOrder { pg8::StaticOrder S; __device__ bool next(int i, pg8::Unit& u) const { const bool ok = S.next(i, u); u.pm = 0; u.pn = 0; return ok; }
                               __device__ void a_ready(const pg8::Unit&) const {} __device__ void done(const pg8::Unit&) const {} };
            pg8::Gemm g{(const pg8::bf16_t*)(a.ws + WS_A0), (const pg8::bf16_t*)(a.ws + WS_WIN), MX, PW, D}; FakeOrder S; S.S.init(MX, PW, F.G, F.blk);
            pg8::EpiBf16Plain E{(pg8::bf16_t*)(a.ws + WS_PROJ), PW};
            pg8::gemm_phase<pg8::EpiBf16Plain, FakeOrder, true, true>(F.lds, g, S, E, F.tid); }
    PH(1) for (int rep_ = 0; rep_ < NREP(1); ++rep_) { const Frame F = mkframe(lds, wave);
            pg8::Gemm g{(const pg8::bf16_t*)(a.ws + WS_A0), (const pg8::bf16_t*)(a.ws + WS_WIN), MX, PW, D}; pg8::StaticOrder S; S.init(MX, PW, F.G, F.blk);
            pg8::EpiBf16Plain E{(pg8::bf16_t*)(a.ws + WS_PROJ), PW};
            pg8::gemm_phase<pg8::EpiBf16Plain, pg8::StaticOrder, true, true>(F.lds, g, S, E, F.tid); } SEAM(1);
    PH(2) for (int rep_ = 0; rep_ < NREP(2); ++rep_) { const Frame F = mkframe(lds, wave); phase2(a, F); } SEAM(2);
    PH(3) { const Frame F = mkframe(lds, wave); phase3(a, F); } SEAM(3);
    PH(4) for (int rep_ = 0; rep_ < NREP(4); ++rep_) { const Frame F = mkframe(lds, wave); phase4(a, F); } SEAM(4);
    PH(5) for (int rep_ = 0; rep_ < NREP(5); ++rep_) { const Frame F = mkframe(lds, wave);
            pg8::Gemm g{(const pg8::bf16_t*)(a.ws + WS_YMIX), (const pg8::bf16_t*)(a.ws + WS_WOUT), MX, D, D}; pg8::StaticOrder S; S.init(MX, D, F.G, F.blk);
            pg8::EpiBf16Plain E{(pg8::bf16_t*)(a.ws + WS_MIXB), D};
            pg8::gemm_phase<pg8::EpiBf16Plain, pg8::StaticOrder, true, true>(F.lds, g, S, E, F.tid); } SEAM(5);
    PH(6) for (int rep_ = 0; rep_ < NREP(6); ++rep_) { const Frame F = mkframe(lds, wave); phase6(a, F, rep_); } SEAM(6);
    PH(7) for (int rep_ = 0; rep_ < NREP(7); ++rep_) { const Frame F = mkframe(lds, wave); phase7(a, F); } SEAM(7);
    PH(8) for (int rep_ = 0; rep_ < NREP(8); ++rep_) { const Frame F = mkframe(lds, wave); const int n = moe_fill_table(a, F, 8, 4);
            pg8::Gemm g{(const pg8::bf16_t*)(a.ws + WS_H1Q), (const pg8::bf16_t*)(a.ws + WS_WUP), 0, 0, D / 2}; pg8::TableOrder S{(const LAS int*)(F.lds + TAB_OFF), n};
            pg8::EpiSwiglu8 E{a.ws + WS_ACT, a.in[I_BUP]};
            pg8::gemm_phase_g<pg8::EpiSwiglu8, pg8::TableOrder, true, true, 121>(F.lds, g, S, E, F.tid, (const int*)(a.ws + WS_SLOTTOK)); } SEAM(8);
    PH(9) for (int rep_ = 0; rep_ < NREP(9); ++rep_) { const Frame F = mkframe(lds, wave); const int n = moe_fill_table(a, F, 4, 8);
            pg8::Gemm g{(const pg8::bf16_t*)(a.ws + WS_ACT), (const pg8::bf16_t*)(a.ws + WS_WDN), 0, 0, D / 2}; pg8::TableOrder S{(const LAS int*)(F.lds + TAB_OFF), n};
            pg8::EpiDown8 E{a.ws + WS_YS, a.in[I_BDN]};
            pg8::gemm_phase<pg8::EpiDown8, pg8::TableOrder, true, true, 120>(F.lds, g, S, E, F.tid); } SEAM(9);
    PH(10) for (int rep_ = 0; rep_ < NREP(10); ++rep_) { const Frame F = mkframe(lds, wave); phase10(a, F); }
#undef PH
#undef SEAM
}

#ifndef MK_SINGLE
#define MK_SINGLE 1
#endif
template <int LO, int HI> static void launch_range(const Args& a, int grid, hipStream_t stream) {
    static bool attr = false;
    if (!attr) { (void)hipFuncSetAttribute((const void*)fwd<LO, HI>, hipFuncAttributeMaxDynamicSharedMemorySize, LDS_BYTES); attr = true; }
    hipLaunchKernelGGL((fwd<LO, HI>), dim3(grid), dim3(NTHR), LDS_BYTES, stream, a);
}
extern "C" void kernel_launch(void* const* d_in, const int* in_sizes, int n_in, void* d_out, int out_size, void* d_ws, size_t ws_size, hipStream_t stream) {
    if (n_in != 30 || ws_size < WS_END) { fprintf(stderr, "kernel_launch: unexpected inputs (n_in %d, ws %zu)\n", n_in, ws_size); return; }
    const int grid = 256;
    (void)hipMemsetAsync((char*)d_ws + WS_CTL, 0, CTL_ZERO_BYTES, stream);
    Args a{};
    for (int i = 0; i < 30; ++i) a.in[i] = (const float*)d_in[i];
    a.out = (float*)d_out; a.ws = (unsigned char*)d_ws;
#if MK_SINGLE
    launch_range<0, 11>(a, grid, stream);
#else
    launch_range<0, 1>(a, grid, stream); launch_range<1, 2>(a, grid, stream); launch_range<2, 3>(a, grid, stream); launch_range<3, 4>(a, grid, stream);
    launch_range<4, 5>(a, grid, stream); launch_range<5, 6>(a, grid, stream); launch_range<6, 7>(a, grid, stream); launch_range<7, 8>(a, grid, stream);
    launch_range<8, 9>(a, grid, stream); launch_range<9, 10>(a, grid, stream); launch_range<10, 11>(a, grid, stream);
#endif
}
```

```cpp
#include <hip/hip_runtime.h>
#include <cstdio>
#include <cstdint>
#include <cmath>
namespace pg8 {
#define PG8_LAS __attribute__((address_space(3)))
typedef unsigned short bf16_t;
typedef short bf16x8 __attribute__((ext_vector_type(8)));
typedef float f32x4 __attribute__((ext_vector_type(4)));
typedef unsigned u32x4 __attribute__((ext_vector_type(4)));
constexpr int BM = 256, BK = 64, HALF = 128, HTB = HALF * BK * 2  , STAGE_BYTES = 8 * HTB, NXCD = 8, WGM = 8;

__host__ __device__ __forceinline__ int lds_byte(int r, int c) { const int ob = c * 2, rr = r & 7; return (r >> 3) * 1024 + rr * 128 + ((((ob >> 4) ^ rr) & 7) << 4) + (ob & 15); }
__host__ __device__ __forceinline__ void stage_rc(int b, int& R, int& C) { const int P = b / 1024, sb = b % 1024, rr = sb >> 7, ch = (sb >> 4) & 7; R = P * 8 + rr; C = (((ch ^ rr) << 4) + (sb & 15)) >> 1; }
__host__ __device__ __forceinline__ int perm32(int rho) { const int n = rho >> 4, i = rho & 15; return 8 * (i >> 2) + 4 * n + (i & 3); }

struct Unit { int pm, pn; };
struct Gemm { const bf16_t* A; const bf16_t* Bt; int M, N, K; };

struct StaticOrder {
    int nM, nN, nwg, G, c;
    __host__ __device__ void init(int M, int N, int G_, int c_) { nM = M / BM; nN = N / BM; nwg = nM * nN; G = G_; c = c_; }
    __host__ __device__ bool next(int i, Unit& u) const {
        const long L = (long)i * G + c; if (L >= nwg) return false;
        int wgid = (int)L; { const int q = nwg / NXCD, r = nwg % NXCD, xcd = wgid % NXCD, off = wgid / NXCD; wgid = (xcd < r ? xcd * (q + 1) : r * (q + 1) + (xcd - r) * q) + off; }
        const int nig = WGM * nN, gid = wgid / nig, fm = gid * WGM, gsz = (nM - fm) < WGM ? (nM - fm) : WGM;
        u.pm = fm + ((wgid % nig) % gsz); u.pn = (wgid % nig) / gsz; return true;
    }
    __device__ __forceinline__ void a_ready(const Unit&) const {}
    __device__ __forceinline__ void done(const Unit&) const {}
};


__device__ __forceinline__ unsigned cvt_pk_bf16(float lo, float hi) { unsigned r; asm volatile("v_cvt_pk_bf16_f32 %0, %1, %2" : "=v"(r) : "v"(lo), "v"(hi)); return r; }
typedef unsigned u32x2 __attribute__((ext_vector_type(2)));
typedef int i32x8 __attribute__((ext_vector_type(8))); typedef int i32x4 __attribute__((ext_vector_type(4)));
__device__ __forceinline__ void mfma_f8(f32x4& acc, i32x8 a, i32x8 b, int sa, int sb) {
    asm volatile("s_nop 1\n\tv_mfma_scale_f32_16x16x128_f8f6f4 %0, %1, %2, %0, %3, %4 op_sel_hi:[0,0,0]" : "+v"(acc) : "v"(a), "v"(b), "v"(sa), "v"(sb));
}
__device__ __forceinline__ i32x8 cat8(bf16x8 lo, bf16x8 hi) { const i32x4 a = __builtin_bit_cast(i32x4, lo), b = __builtin_bit_cast(i32x4, hi); return __builtin_shufflevector(a, b, 0, 1, 2, 3, 4, 5, 6, 7); }

struct EpiBf16Plain {
    static constexpr bool PERM = true, AFTER_DRAIN = false, HAS_BIAS = false; static constexpr int NSTORE = 16;
    bf16_t* O; int ldc;
    __device__ __forceinline__ const float* bias_ptr(const Unit&) const { return nullptr; }
    __device__ __forceinline__ void operator()(const f32x4 (&acc)[2][2][4][2], const Unit& u, int wr, int wc, int fr, int fq, const PG8_LAS float* patch) const {
        PG8_LAS bf16_t* P = (PG8_LAS bf16_t*)patch;
        const int lane = fr + 16 * fq, prow = lane >> 3, pc = lane & 7;
        const int row0 = u.pm * BM + wr * 64, col0 = u.pn * BM + wc * 64;
#pragma unroll
        for (int ai = 0; ai < 2; ++ai)
#pragma unroll
            for (int m = 0; m < 4; ++m) {
#pragma unroll
                for (int bj = 0; bj < 2; ++bj) { const f32x4 v0 = acc[ai][bj][m][0], v1 = acc[ai][bj][m][1];
                    u32x4 w; w.x = cvt_pk_bf16(v0[0], v0[1]); w.y = cvt_pk_bf16(v0[2], v0[3]); w.z = cvt_pk_bf16(v1[0], v1[1]); w.w = cvt_pk_bf16(v1[2], v1[3]);
                    *(PG8_LAS u32x4*)(P + fr * 72 + 16 * fq + 8 * bj) = w; }
                asm volatile("s_waitcnt lgkmcnt(0)" ::: "memory");
                bf16_t* rowp = O + (size_t)(row0 + ai * HALF + m * 16 + prow) * ldc + col0 + 8 * pc;
                const u32x4 o0 = *(const PG8_LAS u32x4*)(P + prow * 72 + 8 * pc), o1 = *(const PG8_LAS u32x4*)(P + (prow + 8) * 72 + 8 * pc);
                *(u32x4*)rowp = o0; *(u32x4*)(rowp + (size_t)8 * ldc) = o1;
                asm volatile("s_waitcnt lgkmcnt(0)" ::: "memory"); }
    }
};

__device__ __forceinline__ float swiglu1(float glu, float lin) {
    const float xg = fminf(glu, 7.0f), xl = fminf(fmaxf(lin, -7.0f), 7.0f);
    const float sg = __builtin_amdgcn_rcpf(1.0f + __builtin_amdgcn_exp2f(xg * (-1.702f * 1.4426950408889634f)));
    const float tg = xg * sg;
    return __builtin_fmaf(tg, xl, tg);
}
typedef float f32x2_p __attribute__((ext_vector_type(2)));
__device__ __forceinline__ f32x2_p swiglu2(float g0, float l0, float g1, float l1) {
    const f32x2_p xg = {fminf(g0, 7.0f), fminf(g1, 7.0f)}, xl = {fminf(fmaxf(l0, -7.0f), 7.0f), fminf(fmaxf(l1, -7.0f), 7.0f)};
    const f32x2_p ea = xg * (-1.702f * 1.4426950408889634f);
    f32x2_p den = {__builtin_amdgcn_exp2f(ea.x), __builtin_amdgcn_exp2f(ea.y)};
    den = den + 1.0f;
    const f32x2_p sg = {__builtin_amdgcn_rcpf(den.x), __builtin_amdgcn_rcpf(den.y)};
    const f32x2_p tg = xg * sg;
    return tg * xl + tg;
}
struct EpiSwiglu8 {
    static constexpr bool PERM = true, AFTER_DRAIN = false, HAS_BIAS = true; static constexpr int NSTORE = 8;
    unsigned char* ACT; const float* bup;
    __device__ __forceinline__ const float* bias_ptr(const Unit& u) const { return bup + (size_t)(u.pn >> 3) * 2048 + (u.pn & 7) * BM; }
    __device__ __forceinline__ void operator()(const f32x4 (&acc)[2][2][4][2], const Unit& u, int wr, int wc, int fr, int fq, const PG8_LAS float* bl) const {
        const int pn = u.pn & 7;
        const int row0 = u.pm * BM + wr * 64 + fr, ucol0 = pn * BM + wc * 64 + 16 * fq, acol0 = ucol0 >> 1;
        f32x4 bv[2][2];
#pragma unroll
        for (int bj = 0; bj < 2; ++bj)
#pragma unroll
            for (int n = 0; n < 2; ++n) bv[bj][n] = *(const PG8_LAS f32x4*)(bl + wc * 64 + 16 * fq + 8 * bj + 4 * n);
#pragma unroll
        for (int ai = 0; ai < 2; ++ai)
#pragma unroll
            for (int m = 0; m < 4; ++m) { unsigned char* rowp = ACT + (size_t)(row0 + ai * HALF + m * 16) * 1024 + acol0;
                u32x2 wo;
#pragma unroll
                for (int bj = 0; bj < 2; ++bj) { const f32x4 v0 = acc[ai][bj][m][0] + bv[bj][0], v1 = acc[ai][bj][m][1] + bv[bj][1];
                    const f32x2_p s0 = swiglu2(v0[0], v0[1], v0[2], v0[3]), s1 = swiglu2(v1[0], v1[1], v1[2], v1[3]);
                    int w = __builtin_amdgcn_cvt_pk_fp8_f32(s0.x, s0.y, 0, false);
                    w = __builtin_amdgcn_cvt_pk_fp8_f32(s1.x, s1.y, w, true);
                    wo[bj] = (unsigned)w; }
                *(u32x2*)rowp = wo; }
    }
};
struct EpiDown8 {
    static constexpr bool PERM = true, AFTER_DRAIN = false, HAS_BIAS = true; static constexpr int NSTORE = 8;
    unsigned char* YS; const float* bdn;
    __device__ __forceinline__ const float* bias_ptr(const Unit& u) const { return bdn + (size_t)(u.pn >> 2) * 1024 + (u.pn & 3) * BM; }
    __device__ __forceinline__ void operator()(const f32x4 (&acc)[2][2][4][2], const Unit& u, int wr, int wc, int fr, int fq, const PG8_LAS float* bl) const {
        const int pn = u.pn & 3;
        const int row0 = u.pm * BM + wr * 64 + fr, col0 = pn * BM + wc * 64 + 16 * fq;
        f32x4 bv[2][2];
#pragma unroll
        for (int bj = 0; bj < 2; ++bj)
#pragma unroll
            for (int n = 0; n < 2; ++n) bv[bj][n] = *(const PG8_LAS f32x4*)(bl + wc * 64 + 16 * fq + 8 * bj + 4 * n);
#pragma unroll
        for (int ai = 0; ai < 2; ++ai)
#pragma unroll
            for (int m = 0; m < 4; ++m) { unsigned char* rowp = YS + (size_t)(row0 + ai * HALF + m * 16) * 1024 + col0;
                u32x4 wo;
#pragma unroll
                for (int bj = 0; bj < 2; ++bj) { const f32x4 v0 = acc[ai][bj][m][0] + bv[bj][0], v1 = acc[ai][bj][m][1] + bv[bj][1];
                    int w0 = __builtin_amdgcn_cvt_pk_fp8_f32(v0[0], v0[1], 0, false); w0 = __builtin_amdgcn_cvt_pk_fp8_f32(v0[2], v0[3], w0, true);
                    int w1 = __builtin_amdgcn_cvt_pk_fp8_f32(v1[0], v1[1], 0, false); w1 = __builtin_amdgcn_cvt_pk_fp8_f32(v1[2], v1[3], w1, true);
                    wo[2 * bj] = (unsigned)w0; wo[2 * bj + 1] = (unsigned)w1; }
                *(u32x4*)rowp = wo; }
    }
};
struct TableOrder {
    const PG8_LAS int* tab; int n;
    __device__ __forceinline__ bool next(int i, Unit& u) const {
        if (i >= n) return false;
        u.pm = __builtin_amdgcn_readfirstlane(tab[2 * i]); u.pn = __builtin_amdgcn_readfirstlane(tab[2 * i + 1]); return true;
    }
    __device__ __forceinline__ void a_ready(const Unit&) const {}
    __device__ __forceinline__ void done(const Unit&) const {}
};

constexpr int ROWS_LDS = 131072;
constexpr int BIAS_LDS = 133120, WPATCH = 2304;
template <class Epi, class Sched, bool ALIGN_EPI = false, bool SP2 = false, int SCW = 0>
__device__ __forceinline__ void gemm_phase(PG8_LAS unsigned char* lds, const Gemm g, const Sched& S, const Epi& E, const int tid) {
    static_assert(SP2, "two-super-phase form only");
    const int wid = __builtin_amdgcn_readfirstlane(tid >> 6), lane = tid & 63, wr = wid >> 2, wc = wid & 3, fr = lane & 15, fq = lane >> 4;
    int K_ = g.K; asm volatile("" : "+s"(K_));
    const int K = K_, nt = K / BK;
    constexpr int EXTRA = Epi::NSTORE + (Epi::HAS_BIAS ? 1 : 0);
    unsigned voffA, voffB;
    { int R, C; stage_rc(tid * 16, R, C); const int Rb = Epi::PERM ? (64 * (R >> 5) + 16 * ((R & 15) >> 2) + 4 * ((R >> 4) & 1) + (R & 3)) : R;
      voffA = (unsigned)(R * K + C) * 2u; voffB = (unsigned)(Rb * K + C) * 2u; }
    const size_t qstep = (size_t)64 * K * 2;
    const size_t qstepB = Epi::PERM ? (size_t)128 * K * 2 : qstep, halfB = Epi::PERM ? (size_t)8 * K * 2 : (size_t)HALF * K * 2;
    const size_t kstep = (size_t)(BK * 2);
    const size_t hstep = (size_t)HALF * K * 2;
    const size_t tstep = 2 * hstep;
    const unsigned ldsw = (unsigned)wid * 1024u;
    const int aoff = lds_byte(wr * 64 + fr, fq * 8), boff = lds_byte(wc * 32 + fr, fq * 8);
#define PG8_SA(b, h) (((b) * 2 + (h)) * HTB)
#define PG8_SB(b, h) ((4 + (b) * 2 + (h)) * HTB)
#define PG8_STAGEQ(bufoff, gbase, voff, qst) do { _Pragma("unroll") for (int _i = 0; _i < 2; ++_i) { const char* _g = (const char*)(gbase) + (size_t)_i * (qst); asm volatile("" : "+s"(_g)); \
        __builtin_amdgcn_global_load_lds((const unsigned*)(_g + (voff)), (PG8_LAS unsigned*)(lds + (bufoff) + ldsw + _i * 8192), 16, 0, 0); } } while (0)
#define PG8_STAGE(bufoff, gbase, voff) PG8_STAGEQ(bufoff, gbase, voff, qstep)
#define PG8_STAGEB(bufoff, gbase, voff) PG8_STAGEQ(bufoff, gbase, voff, qstepB)
#define PG8_STAGE2(bufoff, gbase, voff) do { const char* _g = (const char*)(gbase); asm volatile("" : "+s"(_g)); _Pragma("unroll") for (int _i = 0; _i < 2; ++_i) \
        __builtin_amdgcn_global_load_lds((const unsigned*)(_g + (voff)[_i]), (PG8_LAS unsigned*)(lds + (bufoff) + ldsw + _i * 8192), 16, 0, 0); } while (0)
#define PG8_LDA(dst, b, h) do { int _x; asm volatile("v_xor_b32 %0, 64, %1" : "=v"(_x) : "v"(aoff)); _Pragma("unroll") for (int m = 0; m < 4; ++m) _Pragma("unroll") for (int k = 0; k < 2; ++k) dst[m][k] = *(const PG8_LAS bf16x8*)(lds + PG8_SA(b, h) + (k ? _x : aoff) + m * 2048); } while (0)
#define PG8_LDB(dst, b, h) do { int _x; asm volatile("v_xor_b32 %0, 64, %1" : "=v"(_x) : "v"(boff)); _Pragma("unroll") for (int n = 0; n < 2; ++n) _Pragma("unroll") for (int k = 0; k < 2; ++k) dst[n][k] = *(const PG8_LAS bf16x8*)(lds + PG8_SB(b, h) + (k ? _x : boff) + n * 2048); } while (0)
#define PG8_MMA(ai, bj, At, Bt) do { __builtin_amdgcn_s_setprio(1); _Pragma("unroll") for (int m = 0; m < 4; ++m) _Pragma("unroll") for (int n = 0; n < 2; ++n) { \
        if constexpr (SCW != 0) mfma_f8(acc[ai][bj][m][n], cat8(Bt[n][0], Bt[n][1]), cat8(At[m][0], At[m][1]), SCW * 0x01010101, 0x7f7f7f7f); \
        else { _Pragma("unroll") for (int k = 0; k < 2; ++k) acc[ai][bj][m][n] = __builtin_amdgcn_mfma_f32_16x16x32_bf16(Bt[n][k], At[m][k], acc[ai][bj][m][n], 0, 0, 0); } } __builtin_amdgcn_s_setprio(0); } while (0)
#define PG8_WAIT_V(n) asm volatile("s_waitcnt vmcnt(" #n ")" ::: "memory")
#define PG8_WAIT_VX(aft_) do { if (aft_) asm volatile("s_waitcnt vmcnt(%0)" :: "i"(8 + EXTRA) : "memory"); else asm volatile("s_waitcnt vmcnt(8)" ::: "memory"); } while (0)
#define PG8_WAIT_L(n) asm volatile("s_waitcnt lgkmcnt(" #n ")" ::: "memory")
#define PG8_BAR __builtin_amdgcn_s_barrier()
#define PG8_SCHED __builtin_amdgcn_sched_barrier(0)
#define PG8_BIAS(u_) do { if constexpr (Epi::HAS_BIAS) __builtin_amdgcn_global_load_lds((const unsigned*)(E.bias_ptr(u_) + 4 * lane), (PG8_LAS unsigned*)(lds + BIAS_LDS + wid * WPATCH), 16, 0, 0); } while (0)
    Unit cur, nxt; int ui = 0;
    if (!S.next(0, cur)) return;
    f32x4 acc[2][2][4][2];
#pragma unroll
    for (int a = 0; a < 2; ++a)
#pragma unroll
        for (int b = 0; b < 2; ++b)
#pragma unroll
            for (int m = 0; m < 4; ++m)
#pragma unroll
                for (int n = 0; n < 2; ++n) acc[a][b][m][n] = (f32x4){0.f, 0.f, 0.f, 0.f};
    bf16x8 At[4][2], B0[2][2], B1[2][2];
    const PG8_LAS float* biasl = (const PG8_LAS float*)(lds + BIAS_LDS + wid * WPATCH);
    PG8_BIAS(cur);
    const char* cA = (const char*)g.A + (size_t)cur.pm * tstep; const char* cB = (const char*)g.Bt + (size_t)cur.pn * tstep;
    S.a_ready(cur);
    PG8_STAGEB(PG8_SB(0, 0), cB, voffB); PG8_STAGEB(PG8_SB(0, 1), cB + halfB, voffB); PG8_STAGE(PG8_SA(0, 0), cA, voffA); PG8_STAGE(PG8_SA(0, 1), cA + hstep, voffA);
    if (wr == 1) PG8_BAR;
    PG8_WAIT_V(2); PG8_BAR;
    PG8_STAGEB(PG8_SB(1, 0), cB + kstep, voffB); PG8_STAGE(PG8_SA(1, 0), cA + kstep, voffA); PG8_STAGEB(PG8_SB(1, 1), cB + kstep + halfB, voffB); PG8_STAGE(PG8_SA(1, 1), cA + hstep + kstep, voffA);
    PG8_WAIT_V(8); PG8_BAR;
    for (;;) {
        const bool has_next = S.next(ui + 1, nxt);
        const char* nA = has_next ? (const char*)g.A + (size_t)nxt.pm * tstep : cA; const char* nB = has_next ? (const char*)g.Bt + (size_t)nxt.pn * tstep : cB;
        for (int t = 0; t < nt; t += 2) {
            const bool last = (t == nt - 2);
            const bool aft = (t == 0) && (ui > 0);
            const char* a1 = cA + (size_t)(t + 1) * kstep;
            const char* a2 = last ? nA : cA + (size_t)(t + 2) * kstep; const char* b2 = last ? nB : cB + (size_t)(t + 2) * kstep;
            const char* a3 = a2 + kstep; const char* b3 = b2 + kstep;
            if (last && has_next) S.a_ready(nxt);
            PG8_LDB(B0, 0, 0); PG8_LDB(B1, 0, 1); PG8_SCHED; PG8_LDA(At, 0, 0); if (t > 0) PG8_STAGE(PG8_SA(1, 1), a1 + hstep, voffA);
            PG8_WAIT_VX(aft); PG8_WAIT_L(0); PG8_BAR; PG8_MMA(0, 0, At, B0); PG8_MMA(0, 1, At, B1); PG8_BAR; PG8_SCHED;
            PG8_LDA(At, 0, 1); PG8_STAGEB(PG8_SB(0, 0), b2, voffB); PG8_STAGEB(PG8_SB(0, 1), b2 + halfB, voffB); PG8_STAGE(PG8_SA(0, 0), a2, voffA);
            PG8_WAIT_VX(aft); PG8_WAIT_L(0); PG8_BAR; PG8_MMA(1, 0, At, B0); PG8_MMA(1, 1, At, B1); PG8_BAR; PG8_SCHED;
            PG8_LDB(B0, 1, 0); PG8_LDB(B1, 1, 1); PG8_SCHED; PG8_LDA(At, 1, 0); PG8_STAGE(PG8_SA(0, 1), a2 + hstep, voffA);
            PG8_WAIT_VX(aft); PG8_WAIT_L(0); PG8_BAR; PG8_MMA(0, 0, At, B0); PG8_MMA(0, 1, At, B1); PG8_BAR; PG8_SCHED;
            PG8_LDA(At, 1, 1); PG8_STAGEB(PG8_SB(1, 0), b3, voffB); PG8_STAGEB(PG8_SB(1, 1), b3 + halfB, voffB); PG8_STAGE(PG8_SA(1, 0), a3, voffA);
            PG8_WAIT_V(8); PG8_WAIT_L(0); PG8_BAR; PG8_MMA(1, 0, At, B0); PG8_MMA(1, 1, At, B1); PG8_BAR; PG8_SCHED;
        }
        if (has_next) { PG8_STAGE(PG8_SA(1, 1), nA + hstep + kstep, voffA); }
        asm volatile("" ::: "memory"); PG8_SCHED;
        if constexpr (SCW != 0) asm volatile("s_nop 15\n\ts_nop 15" ::: "memory");
        if constexpr (ALIGN_EPI) { if (wr == 0) PG8_BAR; }
        E(acc, cur, wr, wc, fr, fq, biasl); S.done(cur);
        if (!has_next) break;
#pragma unroll
            for (int a = 0; a < 2; ++a)
#pragma unroll
            for (int b = 0; b < 2; ++b)
#pragma unroll
                for (int m = 0; m < 4; ++m)
#pragma unroll
                    for (int n = 0; n < 2; ++n) acc[a][b][m][n] = (f32x4){0.f, 0.f, 0.f, 0.f};
        cur = nxt; cA = nA; cB = nB; ++ui;
        asm volatile("s_waitcnt lgkmcnt(0)" ::: "memory");
        PG8_BIAS(cur);
        if constexpr (ALIGN_EPI) { if (wr == 1) PG8_BAR; }
    }
    PG8_WAIT_V(0);
    if constexpr (!ALIGN_EPI) { if (wr == 0) PG8_BAR; }
    PG8_BAR;
#undef PG8_SA
#undef PG8_SB
#undef PG8_STAGE
#undef PG8_STAGEB
#undef PG8_STAGEQ
#undef PG8_STAGE2
#undef PG8_LDA
#undef PG8_LDB
#undef PG8_MMA
#undef PG8_WAIT_V
#undef PG8_WAIT_VX
#undef PG8_WAIT_L
#undef PG8_BAR
#undef PG8_SCHED
#undef PG8_BIAS
}
template <class Epi, class Sched, bool ALIGN_EPI = false, bool SP2 = false, int SCW = 0>
__device__ __forceinline__ void gemm_phase_g(PG8_LAS unsigned char* lds, const Gemm g, const Sched& S, const Epi& E, const int tid, const int* rowmap) {
    static_assert(SP2, "two-super-phase form only");
    const int wid = __builtin_amdgcn_readfirstlane(tid >> 6), lane = tid & 63, wr = wid >> 2, wc = wid & 3, fr = lane & 15, fq = lane >> 4;
    int K_ = g.K; asm volatile("" : "+s"(K_));
    const int K = K_, nt = K / BK;
    constexpr int EXTRA = Epi::NSTORE + (Epi::HAS_BIAS ? 1 : 0) + 1;
    unsigned voffB, cv0[2], cv1[2]; int RA0, CA0;
    { int R, C; stage_rc(tid * 16, R, C); const int Rb = Epi::PERM ? (64 * (R >> 5) + 16 * ((R & 15) >> 2) + 4 * ((R >> 4) & 1) + (R & 3)) : R;
      RA0 = R; CA0 = C; voffB = (unsigned)(Rb * K + C) * 2u; }
    const size_t qstepB = Epi::PERM ? (size_t)128 * K * 2 : (size_t)64 * K * 2, halfB = Epi::PERM ? (size_t)8 * K * 2 : (size_t)HALF * K * 2;
    const size_t kstep = (size_t)(BK * 2);
    const size_t hstep = (size_t)HALF * K * 2;
    const size_t tstep = 2 * hstep;
    const unsigned ldsw = (unsigned)wid * 1024u;
    const int aoff = lds_byte(wr * 64 + fr, fq * 8), boff = lds_byte(wc * 32 + fr, fq * 8);
#define PG8_SA(b, h) (((b) * 2 + (h)) * HTB)
#define PG8_SB(b, h) ((4 + (b) * 2 + (h)) * HTB)
#define PG8_STAGEQ(bufoff, gbase, voff, qst) do { _Pragma("unroll") for (int _i = 0; _i < 2; ++_i) { const char* _g = (const char*)(gbase) + (size_t)_i * (qst); asm volatile("" : "+s"(_g)); \
        __builtin_amdgcn_global_load_lds((const unsigned*)(_g + (voff)), (PG8_LAS unsigned*)(lds + (bufoff) + ldsw + _i * 8192), 16, 0, 0); } } while (0)
#define PG8_STAGE(bufoff, gbase, voff) PG8_STAGEQ(bufoff, gbase, voff, qstep)
#define PG8_STAGEB(bufoff, gbase, voff) PG8_STAGEQ(bufoff, gbase, voff, qstepB)
#define PG8_STAGE2(bufoff, gbase, voff) do { const char* _g = (const char*)(gbase); asm volatile("" : "+s"(_g)); _Pragma("unroll") for (int _i = 0; _i < 2; ++_i) \
        __builtin_amdgcn_global_load_lds((const unsigned*)(_g + (voff)[_i]), (PG8_LAS unsigned*)(lds + (bufoff) + ldsw + _i * 8192), 16, 0, 0); } while (0)
#define PG8_LDA(dst, b, h) do { int _x; asm volatile("v_xor_b32 %0, 64, %1" : "=v"(_x) : "v"(aoff)); _Pragma("unroll") for (int m = 0; m < 4; ++m) _Pragma("unroll") for (int k = 0; k < 2; ++k) dst[m][k] = *(const PG8_LAS bf16x8*)(lds + PG8_SA(b, h) + (k ? _x : aoff) + m * 2048); } while (0)
#define PG8_LDB(dst, b, h) do { int _x; asm volatile("v_xor_b32 %0, 64, %1" : "=v"(_x) : "v"(boff)); _Pragma("unroll") for (int n = 0; n < 2; ++n) _Pragma("unroll") for (int k = 0; k < 2; ++k) dst[n][k] = *(const PG8_LAS bf16x8*)(lds + PG8_SB(b, h) + (k ? _x : boff) + n * 2048); } while (0)
#define PG8_MMA(ai, bj, At, Bt) do { __builtin_amdgcn_s_setprio(1); _Pragma("unroll") for (int m = 0; m < 4; ++m) _Pragma("unroll") for (int n = 0; n < 2; ++n) { \
        if constexpr (SCW != 0) mfma_f8(acc[ai][bj][m][n], cat8(Bt[n][0], Bt[n][1]), cat8(At[m][0], At[m][1]), SCW * 0x01010101, 0x7f7f7f7f); \
        else { _Pragma("unroll") for (int k = 0; k < 2; ++k) acc[ai][bj][m][n] = __builtin_amdgcn_mfma_f32_16x16x32_bf16(Bt[n][k], At[m][k], acc[ai][bj][m][n], 0, 0, 0); } } __builtin_amdgcn_s_setprio(0); } while (0)
#define PG8_WAIT_V(n) asm volatile("s_waitcnt vmcnt(" #n ")" ::: "memory")
#define PG8_WAIT_VX(aft_) do { if (aft_) asm volatile("s_waitcnt vmcnt(%0)" :: "i"(8 + EXTRA) : "memory"); else asm volatile("s_waitcnt vmcnt(8)" ::: "memory"); } while (0)
#define PG8_WAIT_L(n) asm volatile("s_waitcnt lgkmcnt(" #n ")" ::: "memory")
#define PG8_BAR __builtin_amdgcn_s_barrier()
#define PG8_SCHED __builtin_amdgcn_sched_barrier(0)
#define PG8_BIAS(u_) do { if constexpr (Epi::HAS_BIAS) __builtin_amdgcn_global_load_lds((const unsigned*)(E.bias_ptr(u_) + 4 * lane), (PG8_LAS unsigned*)(lds + BIAS_LDS + wid * WPATCH), 16, 0, 0); } while (0)
    Unit cur, nxt; int ui = 0;
    if (!S.next(0, cur)) return;
    f32x4 acc[2][2][4][2];
#pragma unroll
    for (int a = 0; a < 2; ++a)
#pragma unroll
        for (int b = 0; b < 2; ++b)
#pragma unroll
            for (int m = 0; m < 4; ++m)
#pragma unroll
                for (int n = 0; n < 2; ++n) acc[a][b][m][n] = (f32x4){0.f, 0.f, 0.f, 0.f};
    bf16x8 At[4][2], B0[2][2], B1[2][2];
    const PG8_LAS float* biasl = (const PG8_LAS float*)(lds + BIAS_LDS + wid * WPATCH);
    PG8_BIAS(cur);
    const char* gA = (const char*)g.A; const char* cB = (const char*)g.Bt + (size_t)cur.pn * tstep;
    const PG8_LAS int* rowsl = (const PG8_LAS int*)(lds + ROWS_LDS);
#define PG8_ROWDMA(pm_) __builtin_amdgcn_global_load_lds((const unsigned*)(rowmap + (pm_) * BM + 4 * lane), (PG8_LAS unsigned*)(lds + ROWS_LDS), 16, 0, 0)
#define PG8_ROWS(v0_, v1_) do { _Pragma("unroll") for (int _i = 0; _i < 2; ++_i) { v0_[_i] = (unsigned)(rowsl[RA0 + 64 * _i] * K + CA0) * 2u; v1_[_i] = (unsigned)(rowsl[HALF + RA0 + 64 * _i] * K + CA0) * 2u; } } while (0)
    PG8_ROWDMA(cur.pm); PG8_WAIT_V(0);
    PG8_ROWS(cv0, cv1); PG8_WAIT_L(0);
    S.a_ready(cur);
    PG8_STAGEB(PG8_SB(0, 0), cB, voffB); PG8_STAGEB(PG8_SB(0, 1), cB + halfB, voffB); PG8_STAGE2(PG8_SA(0, 0), gA, cv0); PG8_STAGE2(PG8_SA(0, 1), gA, cv1);
    if (wr == 1) PG8_BAR;
    PG8_WAIT_V(2); PG8_BAR;
    PG8_STAGEB(PG8_SB(1, 0), cB + kstep, voffB); PG8_STAGE2(PG8_SA(1, 0), gA + kstep, cv0); PG8_STAGEB(PG8_SB(1, 1), cB + kstep + halfB, voffB); PG8_STAGE2(PG8_SA(1, 1), gA + kstep, cv1);
    PG8_WAIT_V(8); PG8_BAR;
    for (;;) {
        const bool has_next = S.next(ui + 1, nxt);
        const char* nB = has_next ? (const char*)g.Bt + (size_t)nxt.pn * tstep : cB;
        PG8_ROWDMA(has_next ? nxt.pm : cur.pm);
        unsigned w0[2] = {cv0[0], cv0[1]}, w1[2] = {cv1[0], cv1[1]};
        for (int t = 0; t < nt; t += 2) {
            const bool last = (t == nt - 2);
            const bool aft = (t == 0) && (ui > 0);
            const char* a1 = gA + (size_t)(t + 1) * kstep;
            const char* a2 = last ? gA : gA + (size_t)(t + 2) * kstep; const char* b2 = last ? nB : cB + (size_t)(t + 2) * kstep;
            const char* a3 = a2 + kstep; const char* b3 = b2 + kstep;
            if (last && has_next) S.a_ready(nxt);
            PG8_LDB(B0, 0, 0); PG8_LDB(B1, 0, 1); PG8_SCHED; PG8_LDA(At, 0, 0); if (t > 0) PG8_STAGE2(PG8_SA(1, 1), a1, cv1);
            PG8_WAIT_VX(aft); PG8_WAIT_L(0); PG8_BAR; PG8_MMA(0, 0, At, B0); PG8_MMA(0, 1, At, B1); PG8_BAR; PG8_SCHED;
            PG8_LDA(At, 0, 1); PG8_STAGEB(PG8_SB(0, 0), b2, voffB); PG8_STAGEB(PG8_SB(0, 1), b2 + halfB, voffB); PG8_STAGE2(PG8_SA(0, 0), a2, w0);
            PG8_WAIT_VX(aft); PG8_WAIT_L(0); PG8_BAR; PG8_MMA(1, 0, At, B0); PG8_MMA(1, 1, At, B1); PG8_BAR; PG8_SCHED;
            PG8_LDB(B0, 1, 0); PG8_LDB(B1, 1, 1); PG8_SCHED; PG8_LDA(At, 1, 0); PG8_STAGE2(PG8_SA(0, 1), a2, w1);
            PG8_WAIT_VX(aft); PG8_WAIT_L(0); PG8_BAR; PG8_MMA(0, 0, At, B0); PG8_MMA(0, 1, At, B1); PG8_BAR; PG8_SCHED;
            PG8_LDA(At, 1, 1); PG8_STAGEB(PG8_SB(1, 0), b3, voffB); PG8_STAGEB(PG8_SB(1, 1), b3 + halfB, voffB); PG8_STAGE2(PG8_SA(1, 0), a3, w0);
            PG8_WAIT_V(8); PG8_WAIT_L(0); PG8_BAR; PG8_MMA(1, 0, At, B0); PG8_MMA(1, 1, At, B1); PG8_BAR; PG8_SCHED;
            if (t + 4 == nt) { PG8_ROWS(w0, w1); }
        }
        if (has_next) { PG8_STAGE2(PG8_SA(1, 1), gA + kstep, w1); }
        asm volatile("" ::: "memory"); PG8_SCHED;
        if constexpr (SCW != 0) asm volatile("s_nop 15\n\ts_nop 15" ::: "memory");
        if constexpr (ALIGN_EPI) { if (wr == 0) PG8_BAR; }
        E(acc, cur, wr, wc, fr, fq, biasl); S.done(cur);
        if (!has_next) break;
#pragma unroll
            for (int a = 0; a < 2; ++a)
#pragma unroll
            for (int b = 0; b < 2; ++b)
#pragma unroll
                for (int m = 0; m < 4; ++m)
#pragma unroll
                    for (int n = 0; n < 2; ++n) acc[a][b][m][n] = (f32x4){0.f, 0.f, 0.f, 0.f};
        cur = nxt; cB = nB; ++ui; cv0[0] = w0[0]; cv0[1] = w0[1]; cv1[0] = w1[0]; cv1[1] = w1[1];
        asm volatile("s_waitcnt lgkmcnt(0)" ::: "memory");
        PG8_BIAS(cur);
        if constexpr (ALIGN_EPI) { if (wr == 1) PG8_BAR; }
    }
    PG8_WAIT_V(0);
    if constexpr (!ALIGN_EPI) { if (wr == 0) PG8_BAR; }
    PG8_BAR;
#undef PG8_ROWS
#undef PG8_ROWDMA
#undef PG8_SA
#undef PG8_SB
#undef PG8_STAGE
#undef PG8_STAGEB
#undef PG8_STAGEQ
#undef PG8_STAGE2
#undef PG8_LDA
#undef PG8_LDB
#undef PG8_MMA
#undef PG8_WAIT_V
#undef PG8_WAIT_VX
#undef PG8_WAIT_L
#undef PG8_BAR
#undef PG8_SCHED
#undef PG8_BIAS
}
}

#ifndef REP_MASK
#define REP_MASK 0
#endif
#define NREP(k) (1 + ((REP_MASK >> (k)) & 1))

constexpr int NB = 16, SEQ = 2048, D = 1024, NMETA = 16;
constexpr int MX = NB * SEQ;
constexpr int INW = 3344, PW = 3584;
constexpr int GQ = 0, GK = 256, GV = 512, GG = 1024, GKL = 1536;
constexpr int RW0 = 1552;
constexpr int RR = RW0, RK = RW0 + 512, RV = RW0 + 1024, RWL = RW0 + 1536, RAL = RW0 + 1600, RGL = RW0 + 1664;
constexpr int NE = 32, TOPK = 4;
constexpr int NCH = 33;
constexpr float ALPHA = 1.189207115002721f;
constexpr int NWAVES = 8, NTHR = 512;

constexpr size_t MiB = 1u << 20;
constexpr size_t WS_CTL = 0, CTL_ZERO_BYTES = 1 * MiB;
constexpr size_t WS_STATS = 1 * MiB;
constexpr size_t WS_TOPI  = WS_STATS + 256 * 1024;
constexpr size_t WS_GATE  = WS_TOPI + 512 * 1024;
constexpr size_t WS_RANK  = WS_GATE + 512 * 1024;
constexpr size_t WS_TSLOT = WS_RANK + 512 * 1024;
constexpr size_t WS_BON   = WS_TSLOT + 512 * 1024;
constexpr size_t WS_BCNT  = WS_BON;
constexpr size_t WS_PROJM = WS_BON + 1 * MiB;
constexpr size_t WS_OPSM  = WS_PROJM + 256 * 1024;
constexpr size_t WS_DL    = WS_OPSM + 256 * 1024;
constexpr size_t WS_W2T   = WS_DL + 1 * MiB;
constexpr size_t WS_A2T   = WS_W2T + 64 * 1024;
constexpr size_t WS_G2T   = WS_A2T + 64 * 1024;
constexpr size_t WS_RWH   = WS_G2T + 128 * 1024;
constexpr size_t WS_RWL   = WS_RWH + 64 * 1024;
constexpr size_t WS_TILEE = WS_RWL + 64 * 1024;
constexpr size_t WS_SLOTTOK = WS_TILEE + 4096;
constexpr size_t WS_WIN   = 8 * MiB;
constexpr size_t WS_WOUT  = 15 * MiB;
static_assert(WS_SLOTTOK + 139264 * 4 <= WS_WIN, "table region");
constexpr size_t WS_A0    = 20 * MiB;
constexpr size_t WS_YMIX  = 560 * MiB;
constexpr size_t WS_PROJ  = 84 * MiB;
constexpr size_t WS_R1    = 308 * MiB;
constexpr size_t WS_GAM   = 520 * MiB;
constexpr size_t WS_SST   = 524 * MiB;
constexpr size_t WS_GUS   = 692 * MiB;
constexpr size_t WS_H1    = WS_A0;
constexpr size_t WS_XS    = 84 * MiB;
constexpr size_t WS_YS    = WS_XS;
constexpr size_t WS_ACT   = 356 * MiB;
constexpr size_t WS_BCG   = 628 * MiB;
constexpr size_t WS_MIXB  = 628 * MiB;
constexpr size_t WS_WUP   = 758 * MiB;
constexpr size_t WS_WDN   = 822 * MiB;
constexpr size_t WS_SCB   = 854 * MiB;
constexpr size_t WS_H1Q   = 854 * MiB;
constexpr size_t WS_END   = 886 * MiB;
constexpr int CW_BAR = 4096;
constexpr int CW_CNT = 16384;
constexpr int CW_QH = 20480;

constexpr int RING_BYTES = 131072;
constexpr int LDS_BYTES = 163840;
constexpr int TAB_OFF = 132096;
constexpr int TAB2_OFF = 152064;
constexpr int MISC_OFF = LDS_BYTES - 512;

#define LAS __attribute__((address_space(3)))
typedef unsigned short bf16;
typedef unsigned v4u __attribute__((ext_vector_type(4)));
typedef unsigned v2u __attribute__((ext_vector_type(2)));
typedef float f32x4 __attribute__((ext_vector_type(4)));
typedef short bf16x8 __attribute__((ext_vector_type(8)));
typedef int i32x4g __attribute__((ext_vector_type(4)));
#define LDS_WAIT() asm volatile("s_waitcnt lgkmcnt(0)" ::: "memory")
__device__ __forceinline__ float bflo(unsigned w) { return __uint_as_float(w << 16); }
__device__ __forceinline__ float bfhi(unsigned w) { return __uint_as_float(w & 0xffff0000u); }
typedef float f32x2_t __attribute__((ext_vector_type(2))); typedef __bf16 bf16x2_t __attribute__((ext_vector_type(2)));
__device__ __forceinline__ unsigned pk2(float lo, float hi) { const f32x2_t v = {lo, hi}; const bf16x2_t b = __builtin_convertvector(v, bf16x2_t); return __builtin_bit_cast(unsigned, b); }
__device__ __forceinline__ unsigned f2bf(float f) { return pk2(f, 0.f) & 0xffffu; }
#define CYC() ((unsigned)__builtin_amdgcn_s_getreg((19 << 11) | 29))
__device__ __forceinline__ void lds_barrier() { asm volatile("s_waitcnt lgkmcnt(0)" ::: "memory"); __builtin_amdgcn_s_barrier(); asm volatile("" ::: "memory"); }
__device__ __forceinline__ float shx(float v, int mask, int lane) { return __int_as_float(__builtin_amdgcn_ds_bpermute((lane ^ mask) << 2, __float_as_int(v))); }
template <int CTRL> __device__ __forceinline__ float dppf0(float x) { return __int_as_float(__builtin_amdgcn_update_dpp(0, __float_as_int(x), CTRL, 0xF, 0xF, true)); }
__device__ __forceinline__ float row_prefix16(float x) {
    x += dppf0<0x111>(x); x += dppf0<0x112>(x); x += dppf0<0x114>(x); x += dppf0<0x118>(x);
    return x;
}
__device__ __forceinline__ float wave_sum(float v, int lane) {
    v += dppf0<0xB1>(v); v += dppf0<0x4E>(v); v += dppf0<0x141>(v); v += dppf0<0x140>(v);
    v += shx(v, 16, lane); v += shx(v, 32, lane);
    return v;
}
__device__ __forceinline__ float softplus_f(float x) { return fmaxf(x, 0.f) + log1pf(expf(-fabsf(x))); }
__device__ __forceinline__ float logsigmoid_f(float x) { return fminf(x, 0.f) - log1pf(expf(-fabsf(x))); }
__device__ __forceinline__ float sigmoid_f(float x) { return 1.f / (1.f + expf(-x)); }
__device__ __forceinline__ float fexp(float x) { return __builtin_amdgcn_exp2f(x * 1.4426950408889634f); }
__device__ __forceinline__ float flog(float x) { return __builtin_amdgcn_logf(x) * 0.6931471805599453f; }
__device__ __forceinline__ float fsigmoid(float x) { return __builtin_amdgcn_rcpf(1.f + fexp(-x)); }
__device__ __forceinline__ float ftanh(float x) { return 2.f * fsigmoid(2.f * x) - 1.f; }
__device__ __forceinline__ float fsoftplus(float x) { return fmaxf(x, 0.f) + flog(1.f + fexp(-fabsf(x))); }
__device__ __forceinline__ float flogsigmoid(float x) { return fminf(x, 0.f) - flog(1.f + fexp(-fabsf(x))); }
template <int CTRL> __device__ __forceinline__ float dppf(float x) { return __int_as_float(__builtin_amdgcn_update_dpp(0, __float_as_int(x), CTRL, 0xF, 0xF, true)); }
__device__ __forceinline__ float red8(float x) {
    x += dppf<0xB1>(x); x += dppf<0x4E>(x); x += dppf<0x141>(x); return x;
}
__device__ __forceinline__ f32x4 mfma16(bf16x8 a, bf16x8 b, f32x4 c) { return __builtin_amdgcn_mfma_f32_16x16x32_bf16(a, b, c, 0, 0, 0); }
__device__ __forceinline__ unsigned ld_agent(const unsigned* p) { return __hip_atomic_load(p, __ATOMIC_RELAXED, __HIP_MEMORY_SCOPE_AGENT); }

#define XB_TMO      128
#define XB_XCNT(j)  (256  + 64 * (j))
#define XB_XSUB(j)  (1280 + 64 * (j))
#define XB_XGEN(j)  (2304 + 64 * (j))
#define XB_TOP      3328
#define XB_TOPGEN   3392
#define XCD_BAR_WORDS 3456
#define XB_SPIN_CAP (1u << 18)
__device__ __forceinline__ unsigned xb_ld(unsigned* p)              { return __hip_atomic_load(p, __ATOMIC_RELAXED, __HIP_MEMORY_SCOPE_AGENT); }
__device__ __forceinline__ unsigned xb_add(unsigned* p, unsigned v) { return __hip_atomic_fetch_add(p, v, __ATOMIC_RELAXED, __HIP_MEMORY_SCOPE_AGENT); }
__device__ __forceinline__ unsigned xb_xcc_id() { return (unsigned)__builtin_amdgcn_s_getreg((3 << 11) | 20) & 0xFu; }
#define XB_SPIN(cond, bar) do { unsigned _sp = 0; while (cond) { __builtin_amdgcn_s_sleep(1); \
    if ((++_sp & 255u) == 0u) { if (xb_ld(&(bar)[XB_TMO])) break; if (_sp > XB_SPIN_CAP) { atomicAdd(&(bar)[XB_TMO], 1u); break; } } } } while (0)
struct XcdBarrier { unsigned* bar; unsigned x; volatile LAS unsigned* st; };
__device__ __forceinline__ XcdBarrier xcd_barrier_post(unsigned* bar, volatile LAS unsigned* st, bool leader) {
    XcdBarrier b; b.bar = bar; b.x = xb_xcc_id(); b.st = st;
    if (leader) (void)xb_add(&bar[XB_XCNT(b.x)], 1u);
    return b;
}
__device__ __forceinline__ void xcd_barrier_complete(unsigned* bar, unsigned x, unsigned& nloc, unsigned& nx) {
    const unsigned G = gridDim.x * gridDim.y * gridDim.z;
    unsigned sum, cnt, mine, sp = 0u;
    for (;;) {
        sum = 0u; cnt = 0u; mine = 0u;
#pragma unroll
        for (unsigned j = 0; j < 16; ++j) { const unsigned c = xb_ld(&bar[XB_XCNT(j)]); sum += c; cnt += (c > 0u) ? 1u : 0u; mine = (j == x) ? c : mine; }
        if (sum == G) break;
        __builtin_amdgcn_s_sleep(1);
        if ((++sp & 255u) == 0u) { if (xb_ld(&bar[XB_TMO])) break; if (sp > XB_SPIN_CAP) { atomicAdd(&bar[XB_TMO], 1u); break; } }
    }
    nloc = mine > 0u ? mine : 1u; nx = cnt > 0u ? cnt : 1u;
}
__device__ __forceinline__ void xcd_barrier(const XcdBarrier& b, bool leader) {
    asm volatile("s_waitcnt vmcnt(0)" ::: "memory");
    __syncthreads();
    if (leader) {
        unsigned* bar = b.bar;
        __builtin_amdgcn_s_waitcnt(0);
        unsigned nloc = b.st[0], nx = b.st[1];
        if (nloc == 0u) { xcd_barrier_complete(bar, b.x, nloc, nx); b.st[0] = nloc; b.st[1] = nx; }
        const unsigned old = xb_add(&bar[XB_XSUB(b.x)], 1u);
        const unsigned gen = old / nloc;
        if (old + 1u == (gen + 1u) * nloc) {
            __builtin_amdgcn_fence(__ATOMIC_RELEASE, "agent");
            asm volatile("s_waitcnt vmcnt(0)" ::: "memory");
            const unsigned og = xb_add(&bar[XB_TOP], 1u);
            const unsigned tg = og / nx;
            if (og + 1u == (tg + 1u) * nx) xb_add(&bar[XB_TOPGEN], 1u);
            else XB_SPIN(xb_ld(&bar[XB_TOPGEN]) == tg, bar);
            __builtin_amdgcn_fence(__ATOMIC_ACQUIRE, "agent");
            xb_add(&bar[XB_XGEN(b.x)], 1u);
            asm volatile("s_waitcnt vmcnt(0)" ::: "memory");
        } else {
            XB_SPIN(xb_ld(&bar[XB_XGEN(b.x)]) == gen, bar);
            __builtin_amdgcn_fence(__ATOMIC_ACQUIRE, "agent");
            asm volatile("s_waitcnt vmcnt(0)" ::: "memory");
        }
    }
    __syncthreads();
}

struct Args { const float* in[30]; float* out; unsigned char* ws; };
enum { I_X = 0, I_META, I_LNIN_G, I_LNIN_B, I_WIN, I_GKW2, I_GKB, I_GNORM, I_MU, I_W0, I_W2, I_A0, I_A2, I_G2, I_KK, I_KA, I_RK, I_RLNG, I_RLNB, I_WOUT,
       I_LN1G, I_LN1B, I_RTW, I_RTB, I_WUP, I_BUP, I_WDN, I_BDN, I_LN2G, I_LN2B };
struct Frame { LAS unsigned char* lds; int tid, lane, wave, blk, G; };
__device__ __forceinline__ int lane_id() { int l; asm volatile("v_mbcnt_lo_u32_b32 %0, -1, 0\n\tv_mbcnt_hi_u32_b32 %0, -1, %0" : "=v"(l)); return l; }
__device__ __forceinline__ Frame mkframe(LAS unsigned char* lds, int wave) { Frame F; F.lds = lds; F.wave = wave; F.lane = lane_id(); F.tid = wave * 64 + F.lane; F.blk = blockIdx.x; F.G = gridDim.x; return F; }

__device__ __forceinline__ void transpose_item(const float* W, int K, int N, int nblk, bf16* WT, LAS float* scr, int item, int lane) {
    const int kb = item / nblk, nb = item - kb * nblk, k0 = 64 * kb, n0 = 32 * nb;
    const int nn = n0 + (lane & 31); const bool ok = nn < N;
    float wv[32]; const float okf = ok ? 1.f : 0.f; const int nc = ok ? nn : N - 1;
#pragma unroll
    for (int i = 0; i < 32; ++i) wv[i] = W[(size_t)(k0 + 2 * i + (lane >> 5)) * N + nc];
#pragma unroll
    for (int i = 0; i < 32; ++i) { const int kk = 2 * i + (lane >> 5); scr[kk * 33 + (lane & 31)] = wv[i] * okf; }
    LDS_WAIT();
    const int c = lane & 7;
#pragma unroll
    for (int j = 0; j < 4; ++j) { const int n = (lane >> 3) + 8 * j; const LAS float* s = scr + (8 * c) * 33 + n;
        v4u o; o.x = pk2(s[0 * 33], s[1 * 33]); o.y = pk2(s[2 * 33], s[3 * 33]); o.z = pk2(s[4 * 33], s[5 * 33]); o.w = pk2(s[6 * 33], s[7 * 33]);
        *(v4u*)(WT + (size_t)(n0 + n) * K + k0 + 8 * c) = o; }
    LDS_WAIT();
}

constexpr int CV_UP = 16 * 32, CV_DN = 16 * 16, CV_NIT = NE * (CV_UP + CV_DN);
__device__ __forceinline__ void cv_load(const Args& a, int it, int lane, f32x4 (&v)[16]) {
    const bool up = it < NE * CV_UP; const int it2 = up ? it : it - NE * CV_UP, per = up ? CV_UP : CV_DN, e = it2 / per, r = it2 - e * per;
    const int N = up ? 2048 : D, nblk = N >> 6, kb = r / nblk, nb = r - kb * nblk;
    const float* W = (up ? a.in[I_WUP] : a.in[I_WDN]) + (size_t)e * D * N + (size_t)(64 * kb + (lane >> 4)) * N + 64 * nb + 4 * (lane & 15);
#pragma unroll
    for (int i = 0; i < 16; ++i) v[i] = *(const f32x4*)(W + (size_t)(4 * i) * N);
}
__device__ __forceinline__ void cv_store(const Args& a, int it, int lane, const f32x4 (&v)[16], LAS float* scr) {
    const bool up = it < NE * CV_UP; const int it2 = up ? it : it - NE * CV_UP, per = up ? CV_UP : CV_DN, e = it2 / per, r = it2 - e * per;
    const int N = up ? 2048 : D, nblk = N >> 6, kb = r / nblk, nb = r - kb * nblk;
    const float scale = up ? 64.f : 128.f;
    const int r4 = lane >> 4, c4 = lane & 15;
#pragma unroll
    for (int i = 0; i < 16; ++i) *(LAS f32x4*)(scr + (4 * i + r4) * 68 + 4 * c4) = v[i];
    LDS_WAIT();
    unsigned char* orow = a.ws + (up ? WS_WUP : WS_WDN) + (size_t)e * N * D + (size_t)(64 * nb + lane) * D + 64 * kb;
#pragma unroll
    for (int g = 0; g < 4; ++g) { const LAS float* s = scr + (16 * g) * 68 + lane; v4u o;
#pragma unroll
        for (int q = 0; q < 4; ++q) { int w = __builtin_amdgcn_cvt_pk_fp8_f32(s[(4 * q + 0) * 68] * scale, s[(4 * q + 1) * 68] * scale, 0, false);
            w = __builtin_amdgcn_cvt_pk_fp8_f32(s[(4 * q + 2) * 68] * scale, s[(4 * q + 3) * 68] * scale, w, true); o[q] = (unsigned)w; }
        *(v4u*)(orow + 16 * g) = o; }
    LDS_WAIT();
}
__device__ __forceinline__ void convert_expert_weights(const Args& a, const Frame& F, int qsel) {
    LAS float* scr = (LAS float*)(F.lds + F.wave * 17408);
    unsigned* QH = (unsigned*)(a.ws + WS_CTL) + CW_QH + 64 * qsel;
    unsigned base = 0;
    if (F.lane == 0) base = __hip_atomic_fetch_add(QH, 4u, __ATOMIC_RELAXED, __HIP_MEMORY_SCOPE_AGENT);
    base = (unsigned)__builtin_amdgcn_readfirstlane((int)base);
    if (base >= (unsigned)CV_NIT) return;
    f32x4 va[16], vb[16];
    cv_load(a, (int)base, F.lane, va);
    for (;;) {
        unsigned nbase = 0;
        if (F.lane == 0) nbase = __hip_atomic_fetch_add(QH, 4u, __ATOMIC_RELAXED, __HIP_MEMORY_SCOPE_AGENT);
        nbase = (unsigned)__builtin_amdgcn_readfirstlane((int)nbase);
        const bool more = nbase < (unsigned)CV_NIT;
        cv_load(a, (int)base + 1, F.lane, vb); cv_store(a, (int)base, F.lane, va, scr);
        cv_load(a, (int)base + 2, F.lane, va); cv_store(a, (int)base + 1, F.lane, vb, scr);
        cv_load(a, (int)base + 3, F.lane, vb); cv_store(a, (int)base + 2, F.lane, va, scr);
        if (more) cv_load(a, (int)nbase, F.lane, va);
        cv_store(a, (int)base + 3, F.lane, vb, scr);
        if (!more) break;
        base = nbase;
    }
}

__device__ __forceinline__ void phase0(const Args& a, const Frame& F) {
    unsigned char* ws = a.ws;
    const int gw = F.blk * NWAVES + F.wave, NGW = F.G * NWAVES;
    for (int cgp = F.blk; cgp < INW / 16; cgp += F.G) {
        LAS float* HM = (LAS float*)F.lds;
        LAS float* PART = (LAS float*)(F.lds + 65536);
        for (int rr = 0; rr < 2; ++rr) {
            const int row = 2 * F.wave + rr; const f32x4* xr = (const f32x4*)(a.in[I_META] + row * D) + F.lane;
            f32x4 v[4]; float s = 0.f;
#pragma unroll
            for (int j = 0; j < 4; ++j) { v[j] = xr[64 * j]; s += (v[j].x + v[j].y) + (v[j].z + v[j].w); }
            const float mean = wave_sum(s, F.lane) * (1.f / D); float s2 = 0.f;
#pragma unroll
            for (int j = 0; j < 4; ++j) { v[j] = v[j] - mean; s2 += (v[j].x * v[j].x + v[j].y * v[j].y) + (v[j].z * v[j].z + v[j].w * v[j].w); }
            const float rstd = 1.f / sqrtf(wave_sum(s2, F.lane) * (1.f / D) + 1e-5f);
#pragma unroll
            for (int j = 0; j < 4; ++j) { const int col = 4 * (F.lane + 64 * j);
                const f32x4 gv = *(const f32x4*)(a.in[I_LNIN_G] + col), bv = *(const f32x4*)(a.in[I_LNIN_B] + col);
                const f32x4 y = v[j] * rstd * gv + bv;
                HM[(col + 0) * 16 + row] = y.x; HM[(col + 1) * 16 + row] = y.y; HM[(col + 2) * 16 + row] = y.z; HM[(col + 3) * 16 + row] = y.w; }
        }
        __syncthreads();
        static_assert(INW % 16 == 0, "column groups of 16");
        const int cl = F.tid & 15, kp = F.tid >> 4;
        const float* wp = a.in[I_WIN] + (size_t)(32 * kp) * INW + cgp * 16 + cl;
        float acc[16];
#pragma unroll
        for (int r = 0; r < 16; ++r) acc[r] = 0.f;
#pragma unroll
        for (int k0 = 0; k0 < 32; k0 += 16) {
            float wv[16];
#pragma unroll
            for (int i = 0; i < 16; ++i) wv[i] = wp[(size_t)(k0 + i) * INW];
#pragma unroll
            for (int i = 0; i < 16; ++i) { const LAS f32x4* h = (const LAS f32x4*)(HM + (32 * kp + k0 + i) * 16);
#pragma unroll
                for (int q = 0; q < 4; ++q) { const f32x4 hv = h[q]; acc[4 * q + 0] += hv.x * wv[i]; acc[4 * q + 1] += hv.y * wv[i]; acc[4 * q + 2] += hv.z * wv[i]; acc[4 * q + 3] += hv.w * wv[i]; } }
        }
#pragma unroll
        for (int r = 0; r < 16; ++r) PART[(kp * 16 + r) * 16 + cl] = acc[r];
        __syncthreads();
        bf16* PROJM = (bf16*)(ws + WS_PROJM);
        if (F.tid < 256) { const int r = F.tid >> 4, c = F.tid & 15; float s = 0.f;
#pragma unroll
            for (int w = 0; w < 32; ++w) s += PART[(w * 16 + r) * 16 + c];
            PROJM[r * PW + cgp * 16 + c] = (bf16)f2bf(s); }
        if (F.tid < 16) PROJM[NMETA * PW + cgp * 16 + F.tid] = 0;
        __syncthreads();
    }
    constexpr int NS = 6;
    f32x4 xv[NS][4];
#define P0_LOAD(ss, ii) do { const f32x4* xr = (const f32x4*)(a.in[I_X] + (size_t)(gw + (ii) * NGW) * D) + F.lane; _Pragma("unroll") for (int j = 0; j < 4; ++j) xv[ss][j] = __builtin_nontemporal_load(xr + 64 * j); } while (0)
#pragma unroll
    for (int i = 0; i < NS - 1; ++i) P0_LOAD(i, i);
    __builtin_amdgcn_sched_barrier(0);
    {
        LAS float* scr = (LAS float*)(F.lds + F.wave * 16384);
        constexpr int I_IN = 16 * (PW / 32), I_OUT = 16 * 64;
        (void)I_OUT;
        for (int it = gw; it < I_IN; it += NGW) {
            if (it < I_IN) transpose_item(a.in[I_WIN], D, INW, PW / 32, (bf16*)(ws + WS_WIN), scr, it, F.lane);
            else { const int idx = it - I_IN, kb = idx >> 6, nb = idx & 63;
                const float* W = a.in[I_WOUT] + (size_t)(64 * kb + 4 * (F.lane >> 2)) * D + 16 * nb + 4 * (F.lane & 3);
                f32x4 v[4];
#pragma unroll
                for (int j = 0; j < 4; ++j) v[j] = *(const f32x4*)(W + (size_t)j * D);
                unsigned char* WT = ws + WS_WOUT + (size_t)(16 * nb + 4 * (F.lane & 3)) * D + 64 * kb + 4 * (F.lane >> 2);
#pragma unroll
                for (int i = 0; i < 4; ++i) { int w = __builtin_amdgcn_cvt_pk_fp8_f32(v[0][i] * 1024.f, v[1][i] * 1024.f, 0, false);
                    w = __builtin_amdgcn_cvt_pk_fp8_f32(v[2][i] * 1024.f, v[3][i] * 1024.f, w, true);
                    *(int*)(WT + (size_t)i * D) = w; } }
        }
    }
    {
        bf16* W2T = (bf16*)(ws + WS_W2T); bf16* A2T = (bf16*)(ws + WS_A2T); bf16* G2T = (bf16*)(ws + WS_G2T);
        for (int i = F.blk * NTHR + F.tid; i < 131072; i += F.G * NTHR) {
            if (i < 32768) { const int n = i >> 6, k = i & 63; W2T[i] = (bf16)f2bf(a.in[I_W2][k * 512 + n]); }
            else if (i < 65536) { const int j = i - 32768, n = j >> 6, k = j & 63; A2T[j] = (bf16)f2bf(a.in[I_A2][k * 512 + n]); }
            else { const int j = i - 65536, n = j >> 7, k = j & 127; G2T[j] = (bf16)f2bf(a.in[I_G2][k * 512 + n]); }
        }
    }
    {
        bf16* RWH = (bf16*)(ws + WS_RWH); bf16* RWL = (bf16*)(ws + WS_RWL);
        for (int i = D * NE + F.blk * NTHR + F.tid; i < D * NE; i += F.G * NTHR) { const int c = i >> 5, e = i & 31; const float w = a.in[I_RTW][i];
            const unsigned hi = f2bf(w); const float lo = w - __uint_as_float(hi << 16);
            RWH[e * D + c] = (bf16)hi; RWL[e * D + c] = (bf16)f2bf(lo); }
    }
    {
        bf16* A0 = (bf16*)(ws + WS_A0);
        static_assert(MX == 16 * 256 * NWAVES, "sixteen rows per wave");
        f32x4 gq[4], bq[4];
#pragma unroll
        for (int j = 0; j < 4; ++j) { const int col = 4 * (F.lane + 64 * j); gq[j] = *(const f32x4*)(a.in[I_LNIN_G] + col); bq[j] = *(const f32x4*)(a.in[I_LNIN_B] + col); }
        __builtin_amdgcn_sched_barrier(0);
#pragma unroll
        for (int i = 0; i < 16; ++i) {
            if (i + NS - 1 < 16) P0_LOAD((i + NS - 1) % NS, i + NS - 1);
            __builtin_amdgcn_sched_barrier(0);
            const int m = gw + i * NGW; float s = 0.f;
#pragma unroll
            for (int j = 0; j < 4; ++j) s += (xv[i % NS][j].x + xv[i % NS][j].y) + (xv[i % NS][j].z + xv[i % NS][j].w);
            const float mean = wave_sum(s, F.lane) * (1.f / D); float s2 = 0.f;
#pragma unroll
            for (int j = 0; j < 4; ++j) { xv[i % NS][j] = xv[i % NS][j] - mean; s2 += (xv[i % NS][j].x * xv[i % NS][j].x + xv[i % NS][j].y * xv[i % NS][j].y) + (xv[i % NS][j].z * xv[i % NS][j].z + xv[i % NS][j].w * xv[i % NS][j].w); }
            const float rstd = __builtin_amdgcn_rsqf(wave_sum(s2, F.lane) * (1.f / D) + 1e-5f);
#pragma unroll
            for (int j = 0; j < 4; ++j) { const int col = 4 * (F.lane + 64 * j);
                const f32x4 y = xv[i % NS][j] * rstd * gq[j] + bq[j];
                v2u o; o.x = pk2(y.x, y.y); o.y = pk2(y.z, y.w);
                *(v2u*)(A0 + (size_t)m * D + col) = o; }
        }
#undef P0_LOAD
    }
    __syncthreads();
}

__device__ __forceinline__ const bf16* prow(const bf16* PROJ, const bf16* PROJM, int b, int vp) {
    const bf16* px = PROJ + (size_t)(b * SEQ + (vp >= NMETA ? vp - NMETA : 0)) * PW;
    const bf16* pm = PROJM + (size_t)(vp < 0 ? NMETA : (vp < NMETA ? vp : 0)) * PW;
    return vp >= NMETA ? px : pm;
}
__device__ __forceinline__ f32x4 ldp4(const bf16* PROJ, const bf16* PROJM, int b, int vp, int col) {
    const v2u w = *(const v2u*)(prow(PROJ, PROJM, b, vp) + col);
    return (f32x4){bflo(w.x), bfhi(w.x), bflo(w.y), bfhi(w.y)};
}

constexpr int R1_STRIDE = 49152;
constexpr int TP = 80;
constexpr int L1_SLOT = 64 * TP * 2;
constexpr int L1_LC = 12 * L1_SLOT;
constexpr int L1_XCH = L1_LC + 64 * 65 * 4;
constexpr int L1_LR = 8 * L1_SLOT;
constexpr int RKP = 72;
__device__ __forceinline__ v2u pack4(f32x4 v) { v2u o; o.x = pk2(v[0], v[1]); o.y = pk2(v[2], v[3]); return o; }
__device__ __forceinline__ unsigned pack4_f8y(f32x4 v) {
    const float a0 = __builtin_amdgcn_fmed3f(v[0] * 8.f, -448.f, 448.f), a1 = __builtin_amdgcn_fmed3f(v[1] * 8.f, -448.f, 448.f), a2 = __builtin_amdgcn_fmed3f(v[2] * 8.f, -448.f, 448.f), a3 = __builtin_amdgcn_fmed3f(v[3] * 8.f, -448.f, 448.f);
    int w = __builtin_amdgcn_cvt_pk_fp8_f32(a0, a1, 0, false); w = __builtin_amdgcn_cvt_pk_fp8_f32(a2, a3, w, true); return (unsigned)w; }
typedef short s16x4 __attribute__((ext_vector_type(4)));
__device__ __forceinline__ bf16x8 tr_frag(const LAS bf16* tile, int pitch, int row0, int col0, int fr, int fq) {
    const LAS bf16* a0 = tile + (row0 + 8 * fq + (fr >> 2)) * pitch + col0 + 4 * (fr & 3);
    const s16x4 lo = __builtin_amdgcn_ds_read_tr16_b64_v4i16((LAS s16x4*)a0);
    const s16x4 hi = __builtin_amdgcn_ds_read_tr16_b64_v4i16((LAS s16x4*)(a0 + 4 * pitch));
    return __builtin_shufflevector(lo, hi, 0, 1, 2, 3, 4, 5, 6, 7);
}
template <bool TA, bool TB>
__device__ __forceinline__ f32x4 tile_mm_x(const LAS bf16* A, const LAS bf16* Bt, int rt, int ct, int fr, int fq, f32x4 acc) {
#pragma unroll
    for (int ks = 0; ks < 2; ++ks) {
        const bf16x8 af = TA ? tr_frag(A, TP, ks * 32, rt * 16, fr, fq) : *(const LAS bf16x8*)(A + (rt * 16 + fr) * TP + ks * 32 + 8 * fq);
        const bf16x8 bf = TB ? tr_frag(Bt, TP, ks * 32, ct * 16, fr, fq) : *(const LAS bf16x8*)(Bt + (ct * 16 + fr) * TP + ks * 32 + 8 * fq);
        acc = mfma16(bf, af, acc); }
    return acc;
}
__device__ __forceinline__ f32x4 tile_mm(const LAS bf16* A, const LAS bf16* Bt, int rt, int ct, int fr, int fq, f32x4 acc) {
#pragma unroll
    for (int ks = 0; ks < 2; ++ks)
        acc = mfma16(*(const LAS bf16x8*)(Bt + (ct * 16 + fr) * TP + ks * 32 + 8 * fq), *(const LAS bf16x8*)(A + (rt * 16 + fr) * TP + ks * 32 + 8 * fq), acc);
    return acc;
}
__device__ __forceinline__ void tile_st(LAS bf16* O, int rt, int ct, int fr, int fq, f32x4 v) { *(LAS v2u*)(O + (rt * 16 + fr) * TP + ct * 16 + 4 * fq) = pack4(v); }
#define L1S(n) ((LAS bf16*)(F.lds + (n) * L1_SLOT))

struct L1Pf { v4u sa[5]; v4u rkv[3], ex; v4u w[4]; };
__device__ __forceinline__ void l1_fetch(const Args& a, const Frame& F, int b, int h, int c, L1Pf& pf, bool need_sa) {
    const bf16* PROJ = (const bf16*)(a.ws + WS_PROJ); const bf16* PROJM = (const bf16*)(a.ws + WS_PROJM);
    const int vp0 = (c == 0) ? -48 : NMETA + 64 * (c - 1);
    if (need_sa) { const int cg = F.tid & 31, tr = F.tid >> 5;
#pragma unroll
      for (int i = 0; i < 5; ++i) pf.sa[i] = __builtin_nontemporal_load((const v4u*)(prow(PROJ, PROJM, b, vp0 + 4 * tr - 1 + i) + RWL + 8 * cg)); }
    {
        const int rr = F.tid >> 3, ch = F.tid & 7; const bf16* pr = prow(PROJ, PROJM, b, vp0 - 1 + rr) + h * 64 + 8 * ch;
        pf.rkv[0] = __builtin_nontemporal_load((const v4u*)(pr + RR)); pf.rkv[1] = __builtin_nontemporal_load((const v4u*)(pr + RK)); pf.rkv[2] = __builtin_nontemporal_load((const v4u*)(pr + RV));
        const int ar = ((F.tid >> 3) & 3) > 2 ? 2 : ((F.tid >> 3) & 3);
        pf.ex = *(const v4u*)(prow(PROJ, PROJM, b, vp0 + 63) + (ar == 0 ? RR : ar == 1 ? RK : RV) + h * 64 + 8 * ch); }
    {
        const bf16* W2T = (const bf16*)(a.ws + WS_W2T); const bf16* A2T = (const bf16*)(a.ws + WS_A2T); const bf16* G2T = (const bf16*)(a.ws + WS_G2T);
        const int r = F.tid >> 3, ch = F.tid & 7;
        pf.w[0] = *(const v4u*)(W2T + (size_t)(h * 64 + r) * 64 + 8 * ch); pf.w[1] = *(const v4u*)(A2T + (size_t)(h * 64 + r) * 64 + 8 * ch);
#pragma unroll
        for (int i = 0; i < 2; ++i) { const int q = F.tid + 512 * i, r2 = q >> 4, c2 = q & 15; pf.w[2 + i] = *(const v4u*)(G2T + (size_t)(h * 64 + r2) * 128 + 8 * c2); }
    }
}
__device__ __forceinline__ f32x4 unpk4(v2u w) { return (f32x4){bflo(w.x), bfhi(w.x), bflo(w.y), bfhi(w.y)}; }

constexpr int CVM_PER_WAVE = 48;
struct CvM { f32x4 v[4]; };
__device__ __forceinline__ void cvm_locate(int idx, bool& up, int& e, int& kb, int& nb) {
    up = idx < NE * 2048;
    const int i2 = up ? idx : idx - NE * 2048;
    e = up ? (i2 >> 11) : (i2 >> 10); const int r = up ? (i2 & 2047) : (i2 & 1023);
    kb = up ? (r >> 7) : (r >> 6); nb = up ? (r & 127) : (r & 63);
}
__device__ __forceinline__ void cvm_load(const Args& a, int idx, int lane, CvM& m) {
    bool up; int e, kb, nb; cvm_locate(idx, up, e, kb, nb);
    const int N = up ? 2048 : D;
    const float* W = (up ? a.in[I_WUP] : a.in[I_WDN]) + (size_t)e * D * N + (size_t)(64 * kb + 4 * (lane >> 2)) * N + 16 * nb + 4 * (lane & 3);
#pragma unroll
    for (int j = 0; j < 4; ++j) m.v[j] = __builtin_nontemporal_load((const f32x4*)(W + (size_t)j * N));
}
__device__ __forceinline__ void cvm_store(const Args& a, int idx, int lane, const CvM& m) {
    bool up; int e, kb, nb; cvm_locate(idx, up, e, kb, nb);
    const int N = up ? 2048 : D; const float scale = up ? 64.f : 128.f;
    unsigned char* WT = a.ws + (up ? WS_WUP : WS_WDN) + (size_t)e * N * D + (size_t)(16 * nb + 4 * (lane & 3)) * D + 64 * kb + 4 * (lane >> 2);
#pragma unroll
    for (int i = 0; i < 4; ++i) { int w = __builtin_amdgcn_cvt_pk_fp8_f32(m.v[0][i] * scale, m.v[1][i] * scale, 0, false);
        w = __builtin_amdgcn_cvt_pk_fp8_f32(m.v[2][i] * scale, m.v[3][i] * scale, w, true);
        __builtin_nontemporal_store(w, (int*)(WT + (size_t)i * D)); }
}
__device__ __forceinline__ void rwkv_l1_front(const Args& a, const Frame& F, int b, int h, int c, const L1Pf& pf, f32x4 (&rtil)[2], bool newgrp, bf16x8 (&lrf)[8], int cvi) {
    CvM cvm; if (cvi >= 0) cvm_load(a, cvi, F.lane, cvm);
    unsigned char* ws = a.ws;
    const int unit = (b * 8 + h) * NCH + c;
    unsigned char* r1 = ws + WS_R1 + (size_t)unit * R1_STRIDE;
    float* GAM = (float*)(ws + WS_GAM) + (size_t)unit * 64;
    const float* mu = a.in[I_MU];
    const int vp0 = (c == 0) ? -48 : NMETA + 64 * (c - 1);
    constexpr int LRP = 264;
    LAS bf16* LR = (LAS bf16*)(F.lds + L1_LR);
    LAS float* TOT = (LAS float*)(F.lds + L1_XCH) + 256;
    LAS float* XCH = (LAS float*)(F.lds + L1_XCH);
    const int rt = F.wave & 3, cp = F.wave >> 2, fr = F.lane & 15, fq = F.lane >> 4;
    {
        const int r = F.tid >> 3, ch = F.tid & 7;
        *(LAS v4u*)(L1S(0) + r * TP + 8 * ch) = pf.w[0]; *(LAS v4u*)(L1S(1) + r * TP + 8 * ch) = pf.w[1];
#pragma unroll
        for (int i = 0; i < 2; ++i) { const int q = F.tid + 512 * i, r2 = q >> 4, c2 = q & 15; *(LAS v4u*)(L1S(2 + (c2 >> 3)) + r2 * TP + 8 * (c2 & 7)) = pf.w[2 + i]; }
#pragma unroll
        for (int q = 0; q < 3; ++q) *(LAS v4u*)(L1S(4 + q) + r * RKP + 8 * ch) = pf.rkv[q];
        if (F.tid < 24) *(LAS v4u*)(L1S(4 + (F.tid >> 3)) + 64 * RKP + 8 * ch) = pf.ex;
    }
    if (newgrp) {
        const int cg = F.tid & 31, tr = F.tid >> 5;
        const f32x4 m0 = *(const f32x4*)(mu + 1536 + 8 * cg), m1 = *(const f32x4*)(mu + 1536 + 8 * cg + 4);
        const float sa_k = (cg < 8) ? 2.f : 1.f, sa_a = (cg < 8) ? 2.f : 1.f, sa_b = (cg < 8) ? -1.f : 0.f;
#pragma unroll
        for (int i = 0; i < 4; ++i) {
            const int row = 4 * tr + i;
            const v4u cw = pf.sa[i + 1], pw = pf.sa[i];
            const f32x4 c0 = unpk4((v2u){cw.x, cw.y}), c1 = unpk4((v2u){cw.z, cw.w}), p0 = unpk4((v2u){pw.x, pw.y}), p1 = unpk4((v2u){pw.z, pw.w});
            float v[8];
            v[0] = c0.x + (p0.x - c0.x) * m0.x; v[1] = c0.y + (p0.y - c0.y) * m0.y; v[2] = c0.z + (p0.z - c0.z) * m0.z; v[3] = c0.w + (p0.w - c0.w) * m0.w;
            v[4] = c1.x + (p1.x - c1.x) * m1.x; v[5] = c1.y + (p1.y - c1.y) * m1.y; v[6] = c1.z + (p1.z - c1.z) * m1.z; v[7] = c1.w + (p1.w - c1.w) * m1.w;
#pragma unroll
            for (int q = 0; q < 8; ++q) {
                const float s = fsigmoid(v[q] * sa_k); const float r = s * sa_a + sa_b; v[q] = (cg >= 8 && cg < 16) ? v[q] : r; }
            v4u o; o.x = pk2(v[0], v[1]); o.y = pk2(v[2], v[3]); o.z = pk2(v[4], v[5]); o.w = pk2(v[6], v[7]);
            *(LAS v4u*)(LR + row * LRP + 8 * cg) = o;
        }
    }
    const int t = rt * 16 + fr, vp = vp0 + t;
    const bool valid = vp >= 0;
    lds_barrier();
    if (newgrp) {
        const LAS bf16* lrow = LR + t * LRP + 8 * fq;
#pragma unroll
        for (int q = 0; q < 8; ++q) lrf[q] = *(const LAS bf16x8*)(lrow + q * 32); }
    float lwv[2][4], asg[2][4], kkr[2][4], kmd[2][4], rrv[2][4], vvv[2][4]; f32x4 lcp[2];
    float ssq = 0.f, bon = 0.f;
    {
#pragma unroll
        for (int cc = 0; cc < 2; ++cc) {
            const int ct = 2 * cp + cc, j = ct * 16 + 4 * fq, jc = h * 64 + j;
            f32x4 mr[2], mk[2], mv[2], w0v[2], a0v[2], kkw[2], kaw[2], rkw[2];
            mr[cc] = *(const f32x4*)(mu + jc); mk[cc] = *(const f32x4*)(mu + 512 + jc); mv[cc] = *(const f32x4*)(mu + 1024 + jc);
            w0v[cc] = *(const f32x4*)(a.in[I_W0] + jc); a0v[cc] = *(const f32x4*)(a.in[I_A0] + jc);
            kkw[cc] = *(const f32x4*)(a.in[I_KK] + jc); kaw[cc] = *(const f32x4*)(a.in[I_KA] + jc); rkw[cc] = *(const f32x4*)(a.in[I_RK] + jc);
            f32x4 aw = {0.f, 0.f, 0.f, 0.f}, aa = aw, ag = aw;
#pragma unroll
            for (int ks = 0; ks < 2; ++ks) {
                aw = mfma16(*(const LAS bf16x8*)(L1S(0) + (ct * 16 + fr) * TP + ks * 32 + 8 * fq), lrf[ks], aw);
                aa = mfma16(*(const LAS bf16x8*)(L1S(1) + (ct * 16 + fr) * TP + ks * 32 + 8 * fq), lrf[2 + ks], aa);
            }
#pragma unroll
            for (int ks = 0; ks < 4; ++ks) ag = mfma16(*(const LAS bf16x8*)(L1S(2 + (ks >> 1)) + (ct * 16 + fr) * TP + (ks & 1) * 32 + 8 * fq), lrf[4 + ks], ag);
            const f32x4 rc = unpk4(*(const LAS v2u*)(L1S(4) + (t + 1) * RKP + j)), rp = unpk4(*(const LAS v2u*)(L1S(4) + t * RKP + j));
            const f32x4 kc = unpk4(*(const LAS v2u*)(L1S(5) + (t + 1) * RKP + j)), kp = unpk4(*(const LAS v2u*)(L1S(5) + t * RKP + j));
            const f32x4 vc = unpk4(*(const LAS v2u*)(L1S(6) + (t + 1) * RKP + j)), vpv = unpk4(*(const LAS v2u*)(L1S(6) + t * RKP + j));
            const f32x4 rs = rc + (rp - rc) * mr[cc], ks_ = kc + (kp - kc) * mk[cc], vs = vc + (vpv - vc) * mv[cc];
#pragma unroll
            for (int i = 0; i < 4; ++i) {
                const float u = w0v[cc][i] + aw[i];
                lwv[cc][i] = valid ? -0.6065306597126334f * fsigmoid(u) : 0.f;
                const float as_ = fsigmoid(a0v[cc][i] + aa[i]);
                asg[cc][i] = as_;
                const float kraw = ks_[i], kk = kraw * kkw[cc][i];
                kkr[cc][i] = kk; ssq += kk * kk;
                const float km = kraw * (1.f + (as_ - 1.f) * kaw[cc][i]);
                kmd[cc][i] = km; rrv[cc][i] = rs[i]; vvv[cc][i] = vs[i];
                bon += rs[i] * km * rkw[cc][i];
            }
            *(v2u*)(r1 + 4 * 8192 + (size_t)(((rt * 4 + ct) * 64 + F.lane) * 8)) = pack4(ag);
            __builtin_amdgcn_sched_barrier(0);
        }
#pragma unroll
        for (int cc = 0; cc < 2; ++cc) { f32x4 pre;
#pragma unroll
            for (int i = 0; i < 4; ++i) pre[i] = row_prefix16(lwv[cc][i]);
            lcp[cc] = pre;
            if (fr == 15) *(LAS f32x4*)(TOT + rt * 64 + (2 * cp + cc) * 16 + 4 * fq) = pre; }
        ssq += shx(ssq, 16, F.lane); ssq += shx(ssq, 32, F.lane);
        bon += shx(bon, 16, F.lane); bon += shx(bon, 32, F.lane);
        if (fq == 0) { XCH[(cp * 64 + t) * 2] = ssq; XCH[(cp * 64 + t) * 2 + 1] = bon; }
    }
    lds_barrier();
    const float ssq_t = XCH[t * 2] + XCH[(64 + t) * 2], bon_t = XCH[t * 2 + 1] + XCH[(64 + t) * 2 + 1];
    const float inv = 1.f / fmaxf(sqrtf(ssq_t), 1e-12f);
    f32x4 Lcv[2], LcCv[2];
#pragma unroll
    for (int cc = 0; cc < 2; ++cc) { const int j = (2 * cp + cc) * 16 + 4 * fq;
        f32x4 off = {0.f, 0.f, 0.f, 0.f}, tot = off;
#pragma unroll
        for (int r = 0; r < 4; ++r) { const f32x4 tv = *(const LAS f32x4*)(TOT + r * 64 + j); tot += tv; if (r < rt) off += tv; }
        Lcv[cc] = lcp[cc] + off; LcCv[cc] = tot; }
    {
#pragma unroll
        for (int cc = 0; cc < 2; ++cc) {
            const int j = (2 * cp + cc) * 16 + 4 * fq;
            f32x4 At, Bt, Kt, Bh, Kh, bvv;
#pragma unroll
            for (int i = 0; i < 4; ++i) {
                const float Lc = Lcv[cc][i], LcC = LcCv[cc][i];
                const float kn = kkr[cc][i] * inv, av = -kn, bv = kn * asg[cc][i], km = kmd[cc][i];
                const float eA = fexp(Lc - lwv[cc][i]), eR = fexp(Lc), eB = fexp(-Lc), eH = fexp(LcC - Lc);
                At[i] = av * eA; rtil[cc][i] = rrv[cc][i] * eR; Bt[i] = bv * eB; Kt[i] = km * eB; Bh[i] = bv * eH; Kh[i] = km * eH;
                bvv[i] = bon_t * vvv[cc][i];
            }
            if (t == 63) *(f32x4*)(GAM + j) = (f32x4){fexp(LcCv[cc][0]), fexp(LcCv[cc][1]), fexp(LcCv[cc][2]), fexp(LcCv[cc][3])};
            *(LAS v2u*)(L1S(0) + t * TP + j) = pack4(Bt); *(LAS v2u*)(L1S(1) + t * TP + j) = pack4(Kt);
            *(LAS v2u*)(L1S(2) + t * TP + j) = pack4(At); *(LAS v2u*)(L1S(3) + t * TP + j) = pack4(rtil[cc]);
            *(LAS v2u*)(L1S(4) + t * TP + j) = pack4(At); *(LAS v2u*)(L1S(5) + t * TP + j) = pack4(Bh);
            *(LAS v2u*)(L1S(6) + t * TP + j) = pack4(Kh); *(LAS v2u*)(L1S(7) + t * TP + j) = pack4((f32x4){vvv[cc][0], vvv[cc][1], vvv[cc][2], vvv[cc][3]});
            *(v2u*)(r1 + 5 * 8192 + (size_t)(((rt * 4 + 2 * cp + cc) * 64 + F.lane) * 8)) = pack4(bvv);
        }
    }
    if (cvi >= 0) cvm_store(a, cvi, F.lane, cvm);
    lds_barrier();
}
__device__ __forceinline__ void rwkv_l1_back(const Args& a, const Frame& F, int b, int h, int c, const f32x4 (&rtil)[2], int cvi) {
    CvM cvm, cvn; const bool cv = cvi >= 0;
    if (cv) { cvm_load(a, cvi, F.lane, cvm); cvm_load(a, cvi + 2048, F.lane, cvn); }
    unsigned char* r1 = a.ws + WS_R1 + (size_t)((b * 8 + h) * NCH + c) * R1_STRIDE;
    const int rt = F.wave & 3, cp = F.wave >> 2, fr = F.lane & 15, fq = F.lane >> 4;
    f32x4 Pt[2];
    const int mrow = rt * 16 + fr;
    const f32x4 z = {0.f, 0.f, 0.f, 0.f};
    {
        f32x4 Lv[2], Mv[2], Bv[2], Kv[2];
#pragma unroll
        for (int cc = 0; cc < 2; ++cc) { const int ct = 2 * cp + cc;
            Lv[cc] = tile_mm(L1S(2), L1S(0), rt, ct, fr, fq, z); Mv[cc] = tile_mm(L1S(2), L1S(1), rt, ct, fr, fq, z);
            Bv[cc] = tile_mm(L1S(3), L1S(0), rt, ct, fr, fq, z); Kv[cc] = tile_mm(L1S(3), L1S(1), rt, ct, fr, fq, z); }
#pragma unroll
        for (int cc = 0; cc < 2; ++cc) { const int ct = 2 * cp + cc, n0 = ct * 16 + 4 * fq;
#pragma unroll
            for (int i = 0; i < 4; ++i) { const int n = n0 + i;
                if (!(n < mrow)) { Lv[cc][i] = 0.f; Mv[cc][i] = 0.f; } if (!(n <= mrow)) { Bv[cc][i] = 0.f; Kv[cc][i] = 0.f; }
                Pt[cc][i] = Lv[cc][i] + ((n == mrow) ? 1.f : 0.f); }
            tile_st(L1S(8), rt, ct, fr, fq, Lv[cc]); tile_st(L1S(10), rt, ct, fr, fq, Mv[cc]);
            tile_st(L1S(11), rt, ct, fr, fq, Bv[cc]); tile_st(L1S(12), rt, ct, fr, fq, Kv[cc]); }
    }
    lds_barrier();
    f32x4 Xv[2];
#pragma unroll
    for (int st = 1; st <= 6; ++st) {
        LAS bf16* Xl = (st & 1) ? L1S(8) : L1S(0);
        LAS bf16* Yl = (st & 1) ? L1S(0) : L1S(8);
        LAS bf16* Pr = (st & 1) ? L1S(2) : L1S(3); LAS bf16* Pw = (st & 1) ? L1S(3) : L1S(2);
        f32x4 l2[2];
#pragma unroll
        for (int cc = 0; cc < 2; ++cc) { const int ct = 2 * cp + cc;
            if (st <= 5) l2[cc] = tile_mm_x<false, true>(Xl, Xl, rt, ct, fr, fq, z);
            if (st >= 2) Pt[cc] = tile_mm_x<false, true>(Pr, Xl, rt, ct, fr, fq, Pt[cc]);
            if (st == 1) Xv[cc] = tile_mm_x<true, false>(L1S(7), L1S(10), rt, ct, fr, fq, z); }
#pragma unroll
        for (int cc = 0; cc < 2; ++cc) { const int ct = 2 * cp + cc;
            if (st <= 5) tile_st(Yl, rt, ct, fr, fq, l2[cc]);
            tile_st(Pw, rt, ct, fr, fq, Pt[cc]); }
        if (st == 2) {
#pragma unroll
            for (int cc = 0; cc < 2; ++cc) tile_st(L1S(10), rt, 2 * cp + cc, fr, fq, Xv[cc]); }
        lds_barrier();
    }
    {
        f32x4 u[2], w[2];
#pragma unroll
        for (int cc = 0; cc < 2; ++cc) { const int ct = 2 * cp + cc; u[cc] = tile_mm(L1S(10), L1S(2), rt, ct, fr, fq, z); w[cc] = tile_mm_x<true, false>(L1S(4), L1S(2), rt, ct, fr, fq, z); }
#pragma unroll
        for (int cc = 0; cc < 2; ++cc) { const int ct = 2 * cp + cc; tile_st(L1S(8), rt, ct, fr, fq, u[cc]); tile_st(L1S(9), rt, ct, fr, fq, w[cc]); }
    }
    lds_barrier();
    {
#pragma unroll
        for (int cc = 0; cc < 2; ++cc) { const int ct = 2 * cp + cc; const size_t eo = (size_t)(mrow * 64 + ct * 16 + 4 * fq) * 2;
            const f32x4 gp = tile_mm_x<true, false>(L1S(5), L1S(9), rt, ct, fr, fq, z);
            const f32x4 hh = tile_mm_x<true, true>(L1S(7), L1S(6), rt, ct, fr, fq, tile_mm_x<false, true>(L1S(8), L1S(5), rt, ct, fr, fq, z));
            const f32x4 rh = tile_mm(L1S(11), L1S(9), rt, ct, fr, fq, rtil[cc]);
            const f32x4 yl = tile_mm_x<false, true>(L1S(12), L1S(7), rt, ct, fr, fq, tile_mm(L1S(11), L1S(8), rt, ct, fr, fq, z));
            const size_t ao = (size_t)(((rt * 4 + ct) * 64 + F.lane) * 8);
            *(v2u*)(r1 + 0 * 8192 + ao) = pack4(gp); *(v2u*)(r1 + 1 * 8192 + ao) = pack4(hh);
            *(v2u*)(r1 + 2 * 8192 + ao) = pack4(rh); *(v2u*)(r1 + 3 * 8192 + ao) = pack4(yl); (void)eo; }
    }
    if (cv) { cvm_store(a, cvi, F.lane, cvm); cvm_store(a, cvi + 2048, F.lane, cvn); }
    lds_barrier();
}

constexpr int BCP = 65;
__device__ __forceinline__ void gla_bc(const Args& a, const Frame& F, int b, int h, int vp0, int ntok) {
    const bf16* PROJ = (const bf16*)(a.ws + WS_PROJ); const bf16* PROJM = (const bf16*)(a.ws + WS_PROJM);
    LAS float* GKLs = (LAS float*)F.lds; LAS float* BC = (LAS float*)(F.lds + 4096);
    if (F.tid < 256) { const int t = F.tid >> 2, q = F.tid & 3;
        const f32x4 v = ldp4(PROJ, PROJM, b, (t < ntok) ? vp0 + t : -1, GKL + 4 * q);
        *(LAS f32x4*)(GKLs + t * 16 + 4 * q) = v; }
    lds_barrier();
    {
        const int d = F.tid & 63, tg = F.tid >> 6;
        float wc[16];
#pragma unroll
        for (int r = 0; r < 16; ++r) wc[r] = a.in[I_GKW2][r * 256 + h * 64 + d];
        const float gb = a.in[I_GKB][h * 64 + d];
        float lgv[8];
#pragma unroll
        for (int i = 0; i < 8; ++i) { const int t = tg * 8 + i; float z = gb;
            const LAS f32x4* g4 = (const LAS f32x4*)(GKLs + t * 16);
#pragma unroll
            for (int q = 0; q < 4; ++q) { const f32x4 gv = g4[q]; z += gv.x * wc[4 * q] + gv.y * wc[4 * q + 1] + gv.z * wc[4 * q + 2] + gv.w * wc[4 * q + 3]; }
            lgv[i] = (t < ntok) ? flogsigmoid(z) * (1.f / 16.f) : 0.f; }
        LAS float* SEG = (LAS float*)(F.lds + 20736);
#pragma unroll
        for (int i = 1; i < 8; ++i) lgv[i] += lgv[i - 1];
        SEG[tg * 64 + d] = lgv[7];
        lds_barrier();
        float pre = 0.f;
#pragma unroll
        for (int s2 = 0; s2 < 7; ++s2) pre += (s2 < tg) ? SEG[s2 * 64 + d] : 0.f;
#pragma unroll
        for (int i = 0; i < 8; ++i) BC[(tg * 8 + i) * BCP + d] = lgv[i] + pre;
    }
    lds_barrier();
}

constexpr int GVP = 144, GKP = 72;
__device__ __forceinline__ void gla_bc_store(const Args& a, const Frame& F, int b, int h, int c) {
    const LAS float* src = (const LAS float*)(F.lds + 4096) + (F.tid >> 3) * BCP + 4 * (F.tid & 7);
    float* bcg = (float*)(a.ws + WS_BCG) + (size_t)((b * 4 + h) * 32 + (c - 1)) * 4096 + (F.tid >> 3) * 64 + 4 * (F.tid & 7);
    *(f32x4*)bcg = (f32x4){src[0], src[1], src[2], src[3]}; *(f32x4*)(bcg + 32) = (f32x4){src[32], src[33], src[34], src[35]};
}
__device__ __forceinline__ void gla_g1_unit(const Args& a, const Frame& F, int b, int h, int c) {
    const bf16* PROJ = (const bf16*)(a.ws + WS_PROJ); const bf16* PROJM = (const bf16*)(a.ws + WS_PROJM);
    float* GUS = (float*)(a.ws + WS_GUS); float* DL = (float*)(a.ws + WS_DL);
    const int ntok = (c == 0) ? NMETA : 64, vp0 = (c == 0) ? 0 : NMETA + 64 * (c - 1);
    gla_bc(a, F, b, h, vp0, ntok);
    LAS float* BC = (LAS float*)(F.lds + 4096);
    if (c >= 1) gla_bc_store(a, F, b, h, c);
    LAS bf16* KR = (LAS bf16*)(F.lds + 24576);
    LAS bf16* VR = (LAS bf16*)(F.lds + 24576 + 64 * TP * 2);
    {
        const int t = F.tid >> 3, q = F.tid & 7;
        const float* bl = nullptr; (void)bl;
        const bf16* pr = prow(PROJ, PROJM, b, (t < ntok) ? vp0 + t : -1);
        const v4u kw = *(const v4u*)(pr + GK + h * 64 + 8 * q);
        const v4u v0 = *(const v4u*)(pr + GV + h * 128 + 8 * q), v1 = *(const v4u*)(pr + GV + h * 128 + 64 + 8 * q);
        float kh[8];
#pragma unroll
        for (int i = 0; i < 4; ++i) { kh[2 * i] = bflo(kw[i]); kh[2 * i + 1] = bfhi(kw[i]); }
#pragma unroll
        for (int i = 0; i < 8; ++i) { const int d = 8 * q + i; const float e = (t < ntok) ? fexp(BC[(ntok - 1) * BCP + d] - BC[t * BCP + d]) : 0.f; kh[i] *= e; }
        *(LAS v4u*)(KR + t * GKP + 8 * q) = (v4u){pk2(kh[0], kh[1]), pk2(kh[2], kh[3]), pk2(kh[4], kh[5]), pk2(kh[6], kh[7])};
        *(LAS v4u*)(VR + t * GVP + 8 * q) = v0; *(LAS v4u*)(VR + t * GVP + 64 + 8 * q) = v1;
    }
    lds_barrier();
    {
        const int rt = F.wave & 3, ch = F.wave >> 2, fr = F.lane & 15, fq = F.lane >> 4;
        float* up = GUS + (size_t)((b * 4 + h) * NCH + c) * 8192 + (size_t)F.lane * 4;
#pragma unroll
        for (int cc = 0; cc < 4; ++cc) { const int ct = ch * 4 + cc;
            f32x4 acc = {0.f, 0.f, 0.f, 0.f};
#pragma unroll
            for (int ks = 0; ks < 2; ++ks)
                acc = mfma16(tr_frag(VR, GVP, ks * 32, ct * 16, fr, fq), tr_frag(KR, GKP, ks * 32, rt * 16, fr, fq), acc);
            *(v2u*)((unsigned char*)GUS + ((size_t)(up - GUS) + (rt * 8 + ct) * 256) * 2) = pack4(acc); }
        if (F.tid < 64) DL[(size_t)((b * 4 + h) * NCH + c) * 64 + F.tid] = fexp(BC[(ntok - 1) * BCP + F.tid]);
    }
    lds_barrier();
}

template <bool BACK>
__device__ __forceinline__ void rwkv_l1_loop(const Args& a, const Frame& F) {
    constexpr int NU = NB * 8 * NCH;
    const int u0 = (int)((long)F.blk * NU / F.G), u1 = (int)((long)(F.blk + 1) * NU / F.G);
    L1Pf pf;
    bf16x8 lrf[8];
    if (u0 < u1) l1_fetch(a, F, (u0 >> 3) / NCH, u0 & 7, (u0 >> 3) % NCH, pf, true);
    for (int u = u0; u < u1; ++u) {
        const int h = u & 7, c = (u >> 3) % NCH, b = (u >> 3) / NCH; f32x4 rtil[2];
        const bool newgrp = (u == u0) || (h == 0);
        const int k0 = (u - u0) * 3, gwc = F.blk * NWAVES + F.wave;
        { const Frame F1 = mkframe(F.lds, F.wave); rwkv_l1_front(a, F1, b, h, c, pf, rtil, newgrp, lrf, (BACK && k0 < CVM_PER_WAVE) ? gwc + 2048 * (k0 + 2) : -1); }
        { const Frame F2 = mkframe(F.lds, F.wave);
          if (u + 1 < u1) l1_fetch(a, F2, ((u + 1) >> 3) / NCH, (u + 1) & 7, ((u + 1) >> 3) % NCH, pf, ((u + 1) & 7) == 0);
          if constexpr (BACK) {
              rwkv_l1_back(a, F2, b, h, c, rtil, (k0 < CVM_PER_WAVE) ? gwc + 2048 * k0 : -1);
          } }
    }
    if constexpr (BACK) {
        static_assert((NB * 8 * NCH) / 256 >= 16, "micro-item schedule");
    }
}
__device__ __forceinline__ void phase2(const Args& a, const Frame& F) {
    if constexpr (((REP_MASK >> 19) & 1) != 0) { const Frame F0 = mkframe(F.lds, F.wave); rwkv_l1_loop<false>(a, F0); }
    { const Frame F0 = mkframe(F.lds, F.wave); rwkv_l1_loop<true>(a, F0); }
    for (int rep_ = 0; rep_ < NREP(12); ++rep_)
    for (int u = F.blk; u < NB * 4 * 32; u += F.G) { const int c = u & 31, bh = u >> 5; const Frame F1 = mkframe(F.lds, F.wave); gla_g1_unit(a, F1, bh >> 2, bh & 3, c); }
}

struct L2S { v4u g; v2u h[2]; f32x4 gm; };
__device__ __forceinline__ void l2s_fetch(L2S& r, const unsigned char* src, const unsigned char* hsrc, const float* gam) {
    r.g = __builtin_nontemporal_load((const v4u*)src); r.h[0] = __builtin_nontemporal_load((const v2u*)hsrc); r.h[1] = __builtin_nontemporal_load((const v2u*)(hsrc + 512)); r.gm = *(const f32x4*)gam;
}
__device__ __forceinline__ void l2s_stage(const L2S& r, LAS bf16* Gt, LAS float* Gm, int tid) {
    const int T = tid >> 5, l0 = 2 * (tid & 31), rw = (T >> 2) * 16 + (l0 & 15), cl = (T & 3) * 16 + 4 * (l0 >> 4);
    *(LAS v2u*)(Gt + rw * TP + cl) = (v2u){r.g.x, r.g.y}; *(LAS v2u*)(Gt + (rw + 1) * TP + cl) = (v2u){r.g.z, r.g.w};
    if (tid < 16) *(LAS f32x4*)(Gm + 4 * tid) = r.gm;
}
__device__ __forceinline__ void l2s_step(const LAS bf16* Gt, const v2u (&hq)[2], const LAS float* Gm, const LAS bf16* Sc, LAS bf16* Sn, f32x4 (&Sm)[2], int row, int cp, int fr, int fq, bf16* gout, int tid) {
    {
        const int r_ = tid >> 3, c8 = tid & 7;
        (void)r_; (void)c8;
        *(v4u*)(gout + tid * 8) = *(const LAS v4u*)(Sc + (16 * (tid >> 7) + (tid & 15)) * TP + 32 * ((tid >> 6) & 1) + 8 * ((tid >> 4) & 3));
    }
    const int col0 = cp * 32 + 4 * fq;
    const bf16x8 af0 = *(const LAS bf16x8*)(Sc + row * TP + 8 * fq), af1 = *(const LAS bf16x8*)(Sc + row * TP + 32 + 8 * fq);
    bf16x8 fg[4]; f32x4 gm[2];
#pragma unroll
    for (int cc = 0; cc < 2; ++cc) { const LAS bf16* gr = Gt + (cp * 32 + cc * 16 + fr) * TP + 8 * fq;
        fg[2 * cc] = *(const LAS bf16x8*)gr; fg[2 * cc + 1] = *(const LAS bf16x8*)(gr + 32);
        gm[cc] = *(const LAS f32x4*)(Gm + col0 + cc * 16); }
#pragma unroll
    for (int cc = 0; cc < 2; ++cc) {
        f32x4 acc = {bflo(hq[cc].x), bfhi(hq[cc].x), bflo(hq[cc].y), bfhi(hq[cc].y)};
        acc = mfma16(fg[2 * cc], af0, acc);
        acc = mfma16(fg[2 * cc + 1], af1, acc);
        Sm[cc] = Sm[cc] * gm[cc] + acc; }
#pragma unroll
    for (int cc = 0; cc < 2; ++cc) *(LAS v2u*)(Sn + row * TP + col0 + cc * 16) = pack4(Sm[cc]);
}
template <bool FAKE>
__device__ __forceinline__ void rwkv_l2_unit(const Args& a, const Frame& F, int bh) {
    unsigned char* ws = a.ws;
    LAS bf16* Sb0 = (LAS bf16*)F.lds; LAS bf16* Sb1 = Sb0 + 64 * TP;
    LAS bf16* G0 = Sb0 + 2 * 64 * TP; LAS bf16* G1 = Sb0 + 3 * 64 * TP;
    LAS float* M0 = (LAS float*)(Sb0 + 4 * 64 * TP); LAS float* M1 = M0 + 64;
    const int fr = F.lane & 15, fq = F.lane >> 4, rt = F.wave & 3, cp = F.wave >> 2;
    const int row = rt * 16 + fr, col0 = cp * 32 + 4 * fq;
    const unsigned char* srcb = ws + WS_R1 + (size_t)bh * NCH * R1_STRIDE + (size_t)F.tid * 16;
    const unsigned char* hsrb = ws + WS_R1 + (size_t)bh * NCH * R1_STRIDE + 8192 + (size_t)(((rt * 4 + 2 * cp) * 64 + F.lane) * 8);
    const float* gamb = (const float*)(ws + WS_GAM) + (size_t)bh * NCH * 64 + 4 * (F.lane & 15);
    bf16* sst = (bf16*)(ws + WS_SST) + (size_t)bh * NCH * 4096;
    f32x4 Sm[2];
#pragma unroll
    for (int cc = 0; cc < 2; ++cc) { Sm[cc] = (f32x4){0.f, 0.f, 0.f, 0.f}; *(LAS v2u*)(Sb0 + row * TP + col0 + cc * 16) = (v2u){0u, 0u}; }
    L2S r0, r1, r2, r3;
#define L2F(rr, cn) do { const int cn_ = FAKE ? 0 : (((cn) < NCH - 1) ? (cn) : NCH - 2); l2s_fetch(rr, srcb + (size_t)cn_ * R1_STRIDE, hsrb + (size_t)cn_ * R1_STRIDE, gamb + (size_t)cn_ * 64); } while (0)
    L2F(r0, 0); L2F(r1, 1); L2F(r2, 2); L2F(r3, 3);
    l2s_stage(r0, G0, M0, F.tid);
    lds_barrier(); __builtin_amdgcn_sched_barrier(0);
#pragma nounroll
    for (int c = 0; c < NCH - 1; c += 4) {
        l2s_stage(r1, G1, M1, F.tid);
        l2s_step(G0, r0.h, M0, Sb0, Sb1, Sm, row, cp, fr, fq, sst + (size_t)c * 4096, F.tid); L2F(r0, c + 4); lds_barrier(); __builtin_amdgcn_sched_barrier(0);
        l2s_stage(r2, G0, M0, F.tid);
        l2s_step(G1, r1.h, M1, Sb1, Sb0, Sm, row, cp, fr, fq, sst + (size_t)(c + 1) * 4096, F.tid); L2F(r1, c + 5); lds_barrier(); __builtin_amdgcn_sched_barrier(0);
        l2s_stage(r3, G1, M1, F.tid);
        l2s_step(G0, r2.h, M0, Sb0, Sb1, Sm, row, cp, fr, fq, sst + (size_t)(c + 2) * 4096, F.tid); L2F(r2, c + 6); lds_barrier(); __builtin_amdgcn_sched_barrier(0);
        l2s_stage(r0, G0, M0, F.tid);
        l2s_step(G1, r3.h, M1, Sb1, Sb0, Sm, row, cp, fr, fq, sst + (size_t)(c + 3) * 4096, F.tid); L2F(r3, c + 7); lds_barrier(); __builtin_amdgcn_sched_barrier(0);
    }
#undef L2F
    { const int r_ = F.tid >> 3, c8 = F.tid & 7;
      (void)r_; (void)c8;
      *(v4u*)(sst + (size_t)(NCH - 1) * 4096 + F.tid * 8) = *(const LAS v4u*)(Sb0 + (16 * (F.tid >> 7) + (F.tid & 15)) * TP + 32 * ((F.tid >> 6) & 1) + 8 * ((F.tid >> 4) & 3)); }
    lds_barrier();
}
__device__ __forceinline__ void rwkv_y_task(const Args& a, const Frame& F, int task) {
    unsigned char* ws = a.ws;
    const int c = 1 + (task & 31), bh = task >> 5, b = bh >> 3, h = bh & 7;
    const int fr = F.lane & 15, fq = F.lane >> 4;
    const bf16* Sg = (const bf16*)(ws + WS_SST) + (size_t)(bh * NCH + c) * 4096 + F.lane * 8;
    bf16x8 sf[8];
#pragma unroll
    for (int ct = 0; ct < 4; ++ct) { sf[2 * ct] = __builtin_nontemporal_load((const bf16x8*)(Sg + (2 * ct) * 512)); sf[2 * ct + 1] = __builtin_nontemporal_load((const bf16x8*)(Sg + (2 * ct + 1) * 512)); }
    f32x4 lg[4], lb[4];
#pragma unroll
    for (int ct = 0; ct < 4; ++ct) { const int i0 = h * 64 + ct * 16 + 4 * fq; lg[ct] = *(const f32x4*)(a.in[I_RLNG] + i0); lb[ct] = *(const f32x4*)(a.in[I_RLNB] + i0); }
    LAS bf16* ost = (LAS bf16*)(F.lds + 102400 + F.wave * 2304);
    const unsigned char* r1u = ws + WS_R1 + (size_t)(bh * NCH + c) * R1_STRIDE + (size_t)(fr * 64 + 4 * fq) * 2;
    const unsigned char* racc = ws + WS_R1 + (size_t)(bh * NCH + c) * R1_STRIDE + (size_t)F.lane * 8;
    const unsigned char* racc0 = ws + WS_R1 + (size_t)(bh * NCH + c) * R1_STRIDE;
    bf16x8 fa0[4], fa1[4]; v2u q0[4][4];
#pragma unroll
    for (int rt = 0; rt < 4; ++rt) { const unsigned char* r1 = r1u + rt * 2048;
        { const unsigned char* rh = racc0 + 2 * 8192 + (size_t)((rt * 4 + (fq >> 1)) * 64 + fr + 32 * (fq & 1)) * 8;
          const v2u a0 = __builtin_nontemporal_load((const v2u*)rh), a1 = __builtin_nontemporal_load((const v2u*)(rh + 128)), b0 = __builtin_nontemporal_load((const v2u*)(rh + 1024)), b1 = __builtin_nontemporal_load((const v2u*)(rh + 1024 + 128));
          fa0[rt] = __builtin_bit_cast(bf16x8, (v4u){a0.x, a0.y, a1.x, a1.y}); fa1[rt] = __builtin_bit_cast(bf16x8, (v4u){b0.x, b0.y, b1.x, b1.y}); }
#pragma unroll
        for (int ct = 0; ct < 4; ++ct) q0[rt][ct] = __builtin_nontemporal_load((const v2u*)(racc + 3 * 8192 + (rt * 4 + ct) * 512)); }
#pragma unroll
    for (int rt = 0; rt < 4; ++rt) {
        const unsigned char* r1 = r1u + rt * 2048;
        v2u q1[4], q2[4];
#pragma unroll
        for (int ct = 0; ct < 4; ++ct) { q1[ct] = __builtin_nontemporal_load((const v2u*)(racc + 4 * 8192 + (rt * 4 + ct) * 512)); q2[ct] = __builtin_nontemporal_load((const v2u*)(racc + 5 * 8192 + (rt * 4 + ct) * 512)); }
        f32x4 y[4]; float s = 0.f;
#pragma unroll
        for (int ct = 0; ct < 4; ++ct) {
            f32x4 acc = {bflo(q0[rt][ct].x), bfhi(q0[rt][ct].x), bflo(q0[rt][ct].y), bfhi(q0[rt][ct].y)};
            acc = mfma16(sf[2 * ct], fa0[rt], acc); acc = mfma16(sf[2 * ct + 1], fa1[rt], acc);
            y[ct] = acc; s += (acc[0] + acc[1]) + (acc[2] + acc[3]); }
        s += shx(s, 16, F.lane); s += shx(s, 32, F.lane);
        const float mean = s * (1.f / 64.f); float q = 0.f;
#pragma unroll
        for (int ct = 0; ct < 4; ++ct) { y[ct] = y[ct] - mean; q += (y[ct][0] * y[ct][0] + y[ct][1] * y[ct][1]) + (y[ct][2] * y[ct][2] + y[ct][3] * y[ct][3]); }
        q += shx(q, 16, F.lane); q += shx(q, 32, F.lane);
        const float rstd = __builtin_amdgcn_rsqf(q * (1.f / 64.f) + 64e-5f);
#pragma unroll
        for (int ct = 0; ct < 4; ++ct) {
            const f32x4 g = {bflo(q1[ct].x), bfhi(q1[ct].x), bflo(q1[ct].y), bfhi(q1[ct].y)}, bv = {bflo(q2[ct].x), bfhi(q2[ct].x), bflo(q2[ct].y), bfhi(q2[ct].y)};
            const f32x4 o = (y[ct] * rstd * lg[ct] + lb[ct] + bv) * g;
            *(LAS unsigned*)((LAS unsigned char*)ost + fr * 80 + ct * 16 + 4 * fq) = pack4_f8y(o); }
        asm volatile("s_waitcnt lgkmcnt(0)" ::: "memory");
        unsigned char* yout = ws + WS_YMIX + ((size_t)b * SEQ + 64 * (c - 1) + rt * 16) * D + 512 + h * 64;
        { const int tr = F.lane >> 2, c4 = F.lane & 3;
            *(v4u*)(yout + (size_t)tr * D + 16 * c4) = *(const LAS v4u*)((const LAS unsigned char*)ost + tr * 80 + 16 * c4); }
        asm volatile("s_waitcnt lgkmcnt(0)" ::: "memory");
    }
}
__device__ __forceinline__ void gla_scan_unit(const Args& a, const Frame& F, int j) {
    const float* GUS = (const float*)(a.ws + WS_GUS); const float* DL = (const float*)(a.ws + WS_DL);
    const int bh = j >> 1, half = j & 1;
    const unsigned char* base = (const unsigned char*)GUS + ((size_t)bh * NCH * 8192 + (size_t)(half * 1024 + F.tid) * 4) * 2;
    unsigned char* sb = a.ws + WS_SCB + (size_t)bh * 32 * 16384 + (size_t)(half * 1024 + F.tid) * 8;
    const float* dl = DL + (size_t)bh * NCH * 64 + 32 * half + (F.tid & 15);
    f32x4 s0 = {0.f, 0.f, 0.f, 0.f}, s1 = s0;
    v2u ua[16], ub[16]; float dq0[16], dq1[16];
#pragma unroll
    for (int q = 0; q < 15; ++q) { ua[q] = __builtin_nontemporal_load((const v2u*)(base + (size_t)q * 16384)); ub[q] = __builtin_nontemporal_load((const v2u*)(base + (size_t)q * 16384 + 4096)); dq0[q] = dl[q * 64]; dq1[q] = dl[q * 64 + 16]; }
#pragma unroll 16
    for (int c = 0; c < NCH - 1; ++c) {
        const int cn = (c + 15 < NCH - 1) ? c + 15 : NCH - 2;
        ua[(c + 15) & 15] = __builtin_nontemporal_load((const v2u*)(base + (size_t)cn * 16384)); ub[(c + 15) & 15] = __builtin_nontemporal_load((const v2u*)(base + (size_t)cn * 16384 + 4096)); dq0[(c + 15) & 15] = dl[cn * 64]; dq1[(c + 15) & 15] = dl[cn * 64 + 16];
        s0 = s0 * dq0[c & 15] + unpk4(ua[c & 15]); s1 = s1 * dq1[c & 15] + unpk4(ub[c & 15]);
        *(v2u*)(sb + (size_t)c * 16384) = pack4(s0); *(v2u*)(sb + (size_t)c * 16384 + 4096) = pack4(s1);
    }
}
__device__ __forceinline__ void phase3(const Args& a, const Frame& F) {
    for (int u = F.blk; u < 256; u += F.G) {
        if (u < 128) { if constexpr (((REP_MASK >> 20) & 1) != 0) rwkv_l2_unit<true>(a, F, u); for (int rep_ = 0; rep_ < NREP(3); ++rep_) rwkv_l2_unit<false>(a, F, u); }
        else { gla_scan_unit(a, F, u - 128);
            const Frame F1 = mkframe(F.lds, F.wave); unsigned char* ws = a.ws;
            for (int idx = (u - 128) * NWAVES + F1.wave; idx < 16 * 64; idx += 128 * NWAVES) {
                const int kb = idx >> 6, nb = idx & 63;
                const float* W = a.in[I_WOUT] + (size_t)(64 * kb + 4 * (F1.lane >> 2)) * D + 16 * nb + 4 * (F1.lane & 3);
                f32x4 v[4];
#pragma unroll
                for (int j = 0; j < 4; ++j) v[j] = *(const f32x4*)(W + (size_t)j * D);
                unsigned char* WT = ws + WS_WOUT + (size_t)(16 * nb + 4 * (F1.lane & 3)) * D + 64 * kb + 4 * (F1.lane >> 2);
#pragma unroll
                for (int i = 0; i < 4; ++i) { int w = __builtin_amdgcn_cvt_pk_fp8_f32(v[0][i] * 1024.f, v[1][i] * 1024.f, 0, false);
                    w = __builtin_amdgcn_cvt_pk_fp8_f32(v[2][i] * 1024.f, v[3][i] * 1024.f, w, true);
                    *(int*)(WT + (size_t)i * D) = w; } }
            bf16* RWH = (bf16*)(ws + WS_RWH); bf16* RWL = (bf16*)(ws + WS_RWL);
            for (int i = (u - 128) * NTHR + F1.tid; i < D * NE; i += 128 * NTHR) { const int c = i >> 5, e = i & 31; const float w = a.in[I_RTW][i];
                const unsigned hi = f2bf(w); const float lo = w - __uint_as_float(hi << 16);
                RWH[e * D + c] = (bf16)hi; RWL[e * D + c] = (bf16)f2bf(lo); }
            for (int bh = u - 128; bh < NB * 4; bh += 128) { const Frame F2 = mkframe(F.lds, F.wave);
                gla_bc(a, F2, bh >> 2, bh & 3, NMETA + 64 * 31, 64); gla_bc_store(a, F2, bh >> 2, bh & 3, 32); lds_barrier(); }
        }
    }
}

struct G3Pf { v4u q, k, v[2]; v2u gg[4], s[4]; f32x4 bc[2]; };
struct G3Const { f32x4 ng[4]; };
__device__ __forceinline__ void g3_fetch(const Args& a, const Frame& F, int b, int h, int c, G3Pf& pf, bool live = true) {
    const bf16* PROJ = (const bf16*)(a.ws + WS_PROJ); const bf16* PROJM = (const bf16*)(a.ws + WS_PROJM);
    const int vp0 = NMETA + 64 * (c - 1);
    const int t = F.tid >> 3, q = live ? (F.tid & 7) : 0; const bf16* pr = live ? prow(PROJ, PROJM, b, vp0 + t) : PROJ;
    pf.q = __builtin_nontemporal_load((const v4u*)(pr + GQ + h * 64 + 8 * q)); pf.k = __builtin_nontemporal_load((const v4u*)(pr + GK + h * 64 + 8 * q));
    pf.v[0] = __builtin_nontemporal_load((const v4u*)(pr + GV + h * 128 + 8 * q)); pf.v[1] = __builtin_nontemporal_load((const v4u*)(pr + GV + h * 128 + 64 + 8 * q));
#pragma unroll
    for (int qq = 0; qq < 4; ++qq) {
        pf.s[qq] = __builtin_nontemporal_load((const v2u*)(a.ws + WS_SCB + (size_t)((b * 4 + h) * 32 + (c - 1)) * 16384 + (live ? (size_t)((qq * 8 + F.wave) * 64 + F.lane) * 8 : (size_t)0))); }
    { const float* bcg = (const float*)(a.ws + WS_BCG) + (size_t)((b * 4 + h) * 32 + (c - 1)) * 4096 + (live ? t * 64 + 8 * q : 0);
      pf.bc[0] = __builtin_nontemporal_load((const f32x4*)bcg); pf.bc[1] = __builtin_nontemporal_load((const f32x4*)(bcg + 4)); }
    const int rt = F.wave & 3, wh = F.wave >> 2, fr = F.lane & 15, fq = F.lane >> 4;
    const bf16* pg = live ? prow(PROJ, PROJM, b, vp0 + rt * 16 + fr) + 4 * fq : PROJ;
#pragma unroll
    for (int cc = 0; cc < 4; ++cc) pf.gg[cc] = __builtin_nontemporal_load((const v2u*)(pg + GG + h * 128 + (wh * 4 + cc) * 16));
}
__device__ __forceinline__ void gla_g3_unit(const Args& a, const Frame& F, int b, int h, int c, const G3Pf& pf, const G3Const& K) {
    bf16* YMIX = (bf16*)(a.ws + WS_YMIX);
    const int vp0 = NMETA + 64 * (c - 1);
    LAS bf16* QT = (LAS bf16*)(F.lds + 24576);
    LAS bf16* KL = QT + 64 * TP;
    LAS bf16* AT = KL + 64 * TP;
    LAS bf16* VR = AT + 64 * TP;
    LAS bf16* SR = VR + 64 * GVP;
    LAS float* RS = (LAS float*)(SR + 64 * GVP);
    const int rt = F.wave & 3, wh = F.wave >> 2, fr = F.lane & 15, fq = F.lane >> 4;
    const int trow = rt * 16 + fr;
    f32x4 sg[4];
#pragma unroll
    for (int cc = 0; cc < 4; ++cc) { const f32x4 gv = unpk4(pf.gg[cc]);
#pragma unroll
        for (int i = 0; i < 4; ++i) sg[cc][i] = K.ng[cc][i] * (gv[i] * fsigmoid(gv[i])); }
    {
        const int t = F.tid >> 3, q = F.tid & 7;
        const f32x4 q0 = unpk4((v2u){pf.q.x, pf.q.y}), q1 = unpk4((v2u){pf.q.z, pf.q.w}), k0 = unpk4((v2u){pf.k.x, pf.k.y}), k1 = unpk4((v2u){pf.k.z, pf.k.w});
        float qv[8] = {q0.x, q0.y, q0.z, q0.w, q1.x, q1.y, q1.z, q1.w}, kv[8] = {k0.x, k0.y, k0.z, k0.w, k1.x, k1.y, k1.z, k1.w};
#pragma unroll
        for (int i = 0; i < 8; ++i) { const float bcv = pf.bc[i >> 2][i & 3]; qv[i] *= fexp(bcv) * 0.125f; kv[i] *= fexp(-bcv); }
        v4u o; o.x = pk2(qv[0], qv[1]); o.y = pk2(qv[2], qv[3]); o.z = pk2(qv[4], qv[5]); o.w = pk2(qv[6], qv[7]);
        *(LAS v4u*)(QT + t * TP + 8 * q) = o;
        o.x = pk2(kv[0], kv[1]); o.y = pk2(kv[2], kv[3]); o.z = pk2(kv[4], kv[5]); o.w = pk2(kv[6], kv[7]);
        *(LAS v4u*)(KL + t * TP + 8 * q) = o;
#pragma unroll
        for (int hf = 0; hf < 2; ++hf) {
            *(LAS v4u*)(VR + t * GVP + 64 * hf + 8 * q) = pf.v[hf];
        }
#pragma unroll
        for (int qq = 0; qq < 4; ++qq) *(LAS v2u*)(SR + (16 * qq + (F.lane & 15)) * GVP + 16 * F.wave + 4 * (F.lane >> 4)) = pf.s[qq];
    }
    lds_barrier();
    {
        f32x4 av[2];
#pragma unroll
        for (int cc = 0; cc < 2; ++cc) { const int ct = 2 * wh + cc;
            f32x4 acc = {0.f, 0.f, 0.f, 0.f};
#pragma unroll
            for (int ks = 0; ks < 2; ++ks)
                acc = mfma16(*(const LAS bf16x8*)(KL + (ct * 16 + fr) * TP + ks * 32 + 8 * fq), *(const LAS bf16x8*)(QT + trow * TP + ks * 32 + 8 * fq), acc);
            const int s0 = ct * 16 + 4 * fq;
#pragma unroll
            for (int i = 0; i < 4; ++i) if (s0 + i > trow) acc[i] = 0.f;
            av[cc] = acc; }
#pragma unroll
        for (int cc = 0; cc < 2; ++cc) *(LAS v2u*)(AT + trow * TP + (2 * wh + cc) * 16 + 4 * fq) = pack4(av[cc]);
    }
    lds_barrier();
    f32x4 oacc[4]; float ssq = 0.f;
#pragma unroll
    for (int cc = 0; cc < 4; ++cc) { const int ct = wh * 4 + cc;
        f32x4 acc = {0.f, 0.f, 0.f, 0.f};
#pragma unroll
        for (int ks = 0; ks < 2; ++ks) {
            acc = mfma16(tr_frag(VR, GVP, ks * 32, ct * 16, fr, fq), *(const LAS bf16x8*)(AT + trow * TP + ks * 32 + 8 * fq), acc);
            acc = mfma16(tr_frag(SR, GVP, ks * 32, ct * 16, fr, fq), *(const LAS bf16x8*)(QT + trow * TP + ks * 32 + 8 * fq), acc);
        }
        oacc[cc] = acc; ssq += (acc[0] * acc[0] + acc[1] * acc[1]) + (acc[2] * acc[2] + acc[3] * acc[3]); }
    ssq += shx(ssq, 16, F.lane); ssq += shx(ssq, 32, F.lane);
    if (fq == 0) RS[wh * 64 + trow] = ssq;
    lds_barrier();
    {
        const float tot = RS[trow] + RS[64 + trow];
        const float rstd = 1.f / sqrtf(tot * (1.f / 128.f) + 1e-6f);
        const size_t m = (size_t)b * SEQ + (vp0 - NMETA) + trow;
#pragma unroll
        for (int cc = 0; cc < 4; ++cc) { const int e0 = (wh * 4 + cc) * 16 + 4 * fq;
            const f32x4 y = oacc[cc] * rstd * sg[cc];
            *(unsigned*)((unsigned char*)YMIX + m * D + h * 128 + e0) = pack4_f8y(y); }
    }
    lds_barrier();
}
__device__ __forceinline__ void phase4(const Args& a, const Frame& F) {
    const bool y_first = ((F.blk >> 3) & 1) == 0;
#pragma nounroll
    for (int pass = 0; pass < 2; ++pass) {
    if ((pass == 0) == y_first) {
    for (int rep_ = 0; rep_ < NREP(21); ++rep_)
    for (int t = F.blk * NWAVES + F.wave; t < 128 * 32; t += F.G * NWAVES) { const Frame F1 = mkframe(F.lds, F.wave); rwkv_y_task(a, F1, t); }
    } else
    for (int rep_ = 0; rep_ < NREP(22); ++rep_) {
        constexpr int NU = NB * 4 * 32;
        const int h = (F.blk >> 5) & 3;
        G3Const K;
        { const int wh = F.wave >> 2, fq = F.lane >> 4;
#pragma unroll
          for (int cc = 0; cc < 4; ++cc) K.ng[cc] = *(const f32x4*)(a.in[I_GNORM] + (wh * 4 + cc) * 16 + 4 * fq); }
        G3Pf pa, pb;
        if (F.blk < NU) g3_fetch(a, F, F.blk >> 7, h, 1 + (F.blk & 31), pa);
        for (int u = F.blk; u < NU; u += 2 * F.G) {
            const int u1 = u + F.G, u2 = u + 2 * F.G;
            { const Frame F1 = mkframe(F.lds, F.wave);
              { const int uf = (u1 < NU) ? u1 : u; g3_fetch(a, F1, uf >> 7, h, 1 + (uf & 31), pb, u1 < NU); }
              gla_g3_unit(a, F1, u >> 7, h, 1 + (u & 31), pa, K); }
            if (u1 < NU) { const Frame F1 = mkframe(F.lds, F.wave);
              { const int uf = (u2 < NU) ? u2 : u1; g3_fetch(a, F1, uf >> 7, h, 1 + (uf & 31), pa, u2 < NU); }
              gla_g3_unit(a, F1, u1 >> 7, h, 1 + (u1 & 31), pb, K); }
        }
    }
    __syncthreads();
    }
}

__device__ __forceinline__ int eidx_of(int L) { return 16 * (L & 1) + 8 * ((L >> 1) & 1) + 4 * ((L >> 2) & 1) + 2 * ((L >> 3) & 1) + ((L >> 4) & 1); }
__device__ __forceinline__ void p6_row(const Args& a, const Frame& F, int m, const v4u (&a0)[2], const v4u (&mx)[2], const f32x4 (&g1)[4], const f32x4 (&b1)[4]) {
    unsigned char* ws = a.ws; bf16* H1 = (bf16*)(ws + WS_H1);
    float v[16];
#pragma unroll
    for (int j = 0; j < 2; ++j)
#pragma unroll
        for (int k = 0; k < 4; ++k) { v[8 * j + 2 * k] = ALPHA * bflo(a0[j][k]) + bflo(mx[j][k]); v[8 * j + 2 * k + 1] = ALPHA * bfhi(a0[j][k]) + bfhi(mx[j][k]); }
    float s = 0.f;
#pragma unroll
    for (int k = 0; k < 16; ++k) s += v[k];
    const float mean = wave_sum(s, F.lane) * (1.f / D); float s2 = 0.f;
#pragma unroll
    for (int k = 0; k < 16; ++k) { v[k] -= mean; s2 += v[k] * v[k]; }
    const float rstd = __builtin_amdgcn_rsqf(wave_sum(s2, F.lane) * (1.f / D) + 1e-5f);
#pragma unroll
    for (int j = 0; j < 2; ++j) {
#pragma unroll
        for (int k = 0; k < 8; ++k) v[8 * j + k] = v[8 * j + k] * rstd * g1[2 * j + (k >> 2)][k & 3] + b1[2 * j + (k >> 2)][k & 3];
        v4u o; o.x = pk2(v[8 * j], v[8 * j + 1]); o.y = pk2(v[8 * j + 2], v[8 * j + 3]); o.z = pk2(v[8 * j + 4], v[8 * j + 5]); o.w = pk2(v[8 * j + 6], v[8 * j + 7]);
        *(v4u*)(H1 + (size_t)m * D + 8 * F.lane + 512 * j) = o;
        int w0 = __builtin_amdgcn_cvt_pk_fp8_f32(v[8 * j], v[8 * j + 1], 0, false); w0 = __builtin_amdgcn_cvt_pk_fp8_f32(v[8 * j + 2], v[8 * j + 3], w0, true);
        int w1 = __builtin_amdgcn_cvt_pk_fp8_f32(v[8 * j + 4], v[8 * j + 5], 0, false); w1 = __builtin_amdgcn_cvt_pk_fp8_f32(v[8 * j + 6], v[8 * j + 7], w1, true);
        *(v2u*)(ws + WS_H1Q + (size_t)m * D + 8 * F.lane + 512 * j) = (v2u){(unsigned)w0, (unsigned)w1}; }
}
__device__ __forceinline__ void phase6(const Args& a, const Frame& F, int csel) {
    unsigned char* ws = a.ws;
    LAS float* LG = (LAS float*)(F.lds + F.wave * 2560);
    LAS int* hist = (LAS int*)(F.lds + 8 * 2560);
    bf16* H1 = (bf16*)(ws + WS_H1);
    const bf16* RWH = (const bf16*)(ws + WS_RWH); const bf16* RWL = (const bf16*)(ws + WS_RWL);
    int* TOPI = (int*)(ws + WS_TOPI); float* GATE = (float*)(ws + WS_GATE); int* RANK = (int*)(ws + WS_RANK);
    int* BCNT = (int*)(ws + WS_BCNT); (void)csel;
    constexpr int RWP = 1040; LAS bf16* RWS = (LAS bf16*)(F.lds + 24576);
    {
#pragma unroll
        for (int hf = 0; hf < 2; ++hf) { v4u w[8];
#pragma unroll
            for (int i = 0; i < 8; ++i) w[i] = *(const v4u*)(RWH + (size_t)(F.tid + 512 * (8 * hf + i)) * 8);
#pragma unroll
            for (int i = 0; i < 8; ++i) { const int idx = F.tid + 512 * (8 * hf + i); *(LAS v4u*)(RWS + (idx >> 7) * RWP + 8 * (idx & 127)) = w[i]; } }
    }
    for (int rb = F.blk; rb < MX / 128; rb += F.G) {
        if (F.tid < 64) hist[F.tid] = 0;
        __syncthreads();
        const int mb = rb * 128 + F.wave * 16; const Frame& Fo = F;
        {
            const bf16* ar0 = (const bf16*)(ws + WS_A0) + (size_t)mb * D + 8 * F.lane;
            const bf16* mr0 = (const bf16*)(ws + WS_MIXB) + (size_t)mb * D + 8 * F.lane;
            constexpr int NS = 6;
            v4u av[NS][2], mv[NS][2];
            f32x4 g1[4], b1[4];
#pragma unroll
            for (int q = 0; q < 4; ++q) { const int col = 8 * F.lane + 512 * (q >> 1) + 4 * (q & 1); g1[q] = *(const f32x4*)(a.in[I_LN1G] + col); b1[q] = *(const f32x4*)(a.in[I_LN1B] + col); }
#define P6_LOAD(ss, ii) do { _Pragma("unroll") for (int j = 0; j < 2; ++j) { av[ss][j] = *(const v4u*)(ar0 + (size_t)(ii) * D + 512 * j); mv[ss][j] = *(const v4u*)(mr0 + (size_t)(ii) * D + 512 * j); } } while (0)
#pragma unroll
            for (int i = 0; i < NS - 1; ++i) P6_LOAD(i, i);
            __builtin_amdgcn_sched_barrier(0);
#pragma unroll
            for (int i = 0; i < 16; ++i) {
                if (i + NS - 1 < 16) P6_LOAD((i + NS - 1) % NS, i + NS - 1);
                __builtin_amdgcn_sched_barrier(0);
                p6_row(a, F, mb + i, av[i % NS], mv[i % NS], g1, b1);
            }
#undef P6_LOAD
        }
        asm volatile("s_waitcnt vmcnt(0)" ::: "memory");
        for (int rep2_ = 0; rep2_ < NREP(24); ++rep2_)
        {
            const int fr = F.lane & 15, fq = F.lane >> 4;
            const bf16* ap = H1 + (size_t)(mb + fr) * D + 8 * fq;
            const LAS bf16* bh = RWS + fr * RWP + 8 * fq; const LAS bf16* bl = RWS + (32 + fr) * RWP + 8 * fq;
            f32x4 acc0 = {0.f, 0.f, 0.f, 0.f}, acc1 = acc0;
            bf16x8 af[32];
#pragma unroll
            for (int ks = 0; ks < 32; ++ks) af[ks] = *(const bf16x8*)(ap + ks * 32);
            __builtin_amdgcn_sched_barrier(0);
#pragma unroll
            for (int ks = 0; ks < 32; ++ks) {
                acc0 = mfma16(*(const LAS bf16x8*)(bh + ks * 32), af[ks], acc0); acc0 = mfma16(*(const LAS bf16x8*)(bl + ks * 32), af[ks], acc0);
                acc1 = mfma16(*(const LAS bf16x8*)(bh + 16 * RWP + ks * 32), af[ks], acc1); acc1 = mfma16(*(const LAS bf16x8*)(bl + 16 * RWP + ks * 32), af[ks], acc1); }
            const f32x4 rb0 = *(const f32x4*)(a.in[I_RTB] + 4 * fq), rb1 = *(const f32x4*)(a.in[I_RTB] + 16 + 4 * fq);
#pragma unroll
            for (int q = 0; q < 4; ++q) { LG[fr * 33 + 4 * fq + q] = acc0[q] + rb0[q]; LG[fr * 33 + 16 + 4 * fq + q] = acc1[q] + rb1[q]; }
        }
        asm volatile("s_waitcnt lgkmcnt(0)" ::: "memory");
        LAS int* EK = (LAS int*)(LG + 528);
        if (F.lane < 16) {
            float lv[32];
#pragma unroll
            for (int e = 0; e < 32; ++e) lv[e] = LG[F.lane * 33 + e];
            int ek[4]; float lk[4];
#pragma unroll
            for (int k = 0; k < 4; ++k) { float best = -3.0e38f; int bi = 0;
#pragma unroll
                for (int e = 0; e < 32; ++e) { const bool tk = lv[e] > best; best = tk ? lv[e] : best; bi = tk ? e : bi; }
                ek[k] = bi; lk[k] = best;
#pragma unroll
                for (int e = 0; e < 32; ++e) lv[e] = (e == bi) ? -3.0e38f : lv[e]; }
            const float e1 = expf(lk[1] - lk[0]), e2 = expf(lk[2] - lk[0]), e3 = expf(lk[3] - lk[0]);
            const float inv = 1.f / (1.f + e1 + e2 + e3);
            const size_t m = (size_t)(mb + F.lane);
            *(i32x4g*)(TOPI + m * 4) = (i32x4g){ek[0], ek[1], ek[2], ek[3]};
            *(f32x4*)(GATE + m * 4) = (f32x4){inv, e1 * inv, e2 * inv, e3 * inv};
#pragma unroll
            for (int k = 0; k < 4; ++k) EK[F.lane * 4 + k] = ek[k];
        }
        asm volatile("s_waitcnt lgkmcnt(0)" ::: "memory");
        const int my_e = EK[F.lane];
        const int lrank = __hip_atomic_fetch_add(&hist[my_e], 1, __ATOMIC_RELAXED, __HIP_MEMORY_SCOPE_WORKGROUP);
        __syncthreads();
        if (F.tid < 32) BCNT[rb * 32 + F.tid] = hist[F.tid];
        RANK[((size_t)rb * 128 + F.wave * 16 + (F.lane >> 2)) * 4 + (F.lane & 3)] = lrank;
        __syncthreads();
    }
}

__device__ __forceinline__ void phase7(const Args& a, const Frame& F) {
    unsigned char* ws = a.ws;
    LAS int* starts = (LAS int*)F.lds;
    LAS int* part = (LAS int*)(F.lds + 1024);
    const int* BCNT = (const int*)(ws + WS_BCNT);
    int* TILEE = (int*)(ws + WS_TILEE); int* SLOTTOK = (int*)(ws + WS_SLOTTOK);
    const int q7 = F.blk * NTHR + F.tid; const int e7 = ((const int*)(ws + WS_TOPI))[q7], r7 = ((const int*)(ws + WS_RANK))[q7];
    { const int e = F.tid & 31, pt = F.tid >> 5; int tot = 0, below = 0;
#pragma unroll
      for (int i = 0; i < 16; ++i) { const int bb = 16 * pt + i; const int v = BCNT[bb * 32 + e]; tot += v; below += (bb < F.blk) ? v : 0; }
      part[pt * 64 + e] = tot; part[pt * 64 + 32 + e] = below; }
    __syncthreads();
    if (F.tid < 32) { int cnt = 0, bb = 0;
#pragma unroll
        for (int pt = 0; pt < 16; ++pt) { cnt += part[pt * 64 + F.tid]; bb += part[pt * 64 + 32 + F.tid]; }
        starts[64 + F.tid] = cnt; starts[32 + F.tid] = (cnt + 255) & ~255; starts[96 + F.tid] = bb; }
    __syncthreads();
    if (F.tid < 33) { int run = 0;
#pragma unroll
        for (int e = 0; e < 32; ++e) run += (e < F.tid) ? starts[32 + e] : 0;
        starts[128 + F.tid] = run; }
    __syncthreads();
    if (F.tid < 32) starts[F.tid] = starts[128 + F.tid];
    (void)TILEE;
    if (F.tid < 128) {
        const int which = F.tid >> 6, t = F.tid & 63, nN = which ? 4 : 8, RM = which ? 8 : 4;
        LAS int* tab = (LAS int*)(F.lds + (which ? TAB2_OFF : TAB_OFF));
        const int NT = starts[160] >> 8;
        const int x = F.blk & 7, j = F.blk >> 3, pm = (t * 8 + x) * RM + j / nN;
        const bool ok = pm < NT; int e = 0;
#pragma unroll
        for (int k = 1; k < 32; ++k) e += ((starts[128 + k] >> 8) <= pm) ? 1 : 0;
        if (ok) { tab[2 * t] = pm; tab[2 * t + 1] = e * nN + (j % nN); }
        const unsigned long long m = __ballot(ok);
        if (t == 0) tab[128] = __popcll(m);
    }
    __syncthreads();
    if (F.blk == F.G - 1) { for (int e = 0; e < 32; ++e) for (int s = starts[e] + starts[64 + e] + F.tid; s < starts[e] + starts[32 + e]; s += NTHR) SLOTTOK[s] = 0; }
    const int* TOPI = (const int*)(ws + WS_TOPI); const int* RANK = (const int*)(ws + WS_RANK); int* TSLOT = (int*)(ws + WS_TSLOT);
    static_assert(MX * 4 == 256 * NTHR, "one (token, k) pair per thread; the tokens of workgroup b are row block b of P6");
    { const int q = q7; const int e = e7; (void)TOPI; (void)RANK;
      const int slot = starts[e] + starts[96 + e] + r7;
      TSLOT[q] = slot; SLOTTOK[slot] = q >> 2; }
}
__device__ __forceinline__ int moe_fill_table(const Args& a, const Frame& F, int nN, int RM) {
    LAS int* tab = (LAS int*)(F.lds + TAB_OFF);
    const unsigned* TILEE = (const unsigned*)(a.ws + WS_TILEE);
    if (F.tid < 64) {
        const int NT = (int)ld_agent(TILEE + 1023);
        const int x = F.blk & 7, j = F.blk >> 3;
        const int s = F.tid * 8 + x, pm = s * RM + j / nN;
        const bool ok = pm < NT;
        const int e = ok ? (int)ld_agent(TILEE + pm) : 0;
        if (ok) { tab[2 * F.tid] = pm; tab[2 * F.tid + 1] = e * nN + (j % nN); }
        const unsigned long long m = __ballot(ok);
        if (F.tid == 0) tab[128] = __popcll(m);
    }
    __syncthreads();
    return __builtin_amdgcn_readfirstlane(tab[128]);
}

__device__ __forceinline__ void p10_acc(float (&s)[16], int j, const v4u w, float g) {
    s[8 * j + 0] += g * bflo(w.x); s[8 * j + 1] += g * bfhi(w.x); s[8 * j + 2] += g * bflo(w.y); s[8 * j + 3] += g * bfhi(w.y);
    s[8 * j + 4] += g * bflo(w.z); s[8 * j + 5] += g * bfhi(w.z); s[8 * j + 6] += g * bflo(w.w); s[8 * j + 7] += g * bfhi(w.w);
}
typedef float f32x2 __attribute__((ext_vector_type(2)));
__device__ __forceinline__ void p10_acc8(float (&s)[16], int j, const v2u w, float g) {
    const f32x2 a0 = __builtin_amdgcn_cvt_pk_f32_fp8((int)w.x, false), a1 = __builtin_amdgcn_cvt_pk_f32_fp8((int)w.x, true);
    const f32x2 a2 = __builtin_amdgcn_cvt_pk_f32_fp8((int)w.y, false), a3 = __builtin_amdgcn_cvt_pk_f32_fp8((int)w.y, true);
    s[8 * j + 0] += g * a0.x; s[8 * j + 1] += g * a0.y; s[8 * j + 2] += g * a1.x; s[8 * j + 3] += g * a1.y;
    s[8 * j + 4] += g * a2.x; s[8 * j + 5] += g * a2.y; s[8 * j + 6] += g * a3.x; s[8 * j + 7] += g * a3.y;
}
__device__ __forceinline__ void phase10(const Args& a, const Frame& F) {
    unsigned char* ws = a.ws;
    const bf16* H1 = (const bf16*)(ws + WS_H1); const unsigned char* YS = ws + WS_YS;
    const int* TSLOT = (const int*)(ws + WS_TSLOT); const float* GATE = (const float*)(ws + WS_GATE);
    const int gw = F.blk * NWAVES + F.wave, NGW = F.G * NWAVES;
    f32x4 gv[4], bv[4];
#pragma unroll
    for (int q = 0; q < 4; ++q) { const int col = 8 * F.lane + 512 * (q >> 1) + 4 * (q & 1); gv[q] = *(const f32x4*)(a.in[I_LN2G] + col); bv[q] = *(const f32x4*)(a.in[I_LN2B] + col); }
    for (int m0 = gw; m0 < MX; m0 += 2 * NGW) {
        int mm[2]; mm[0] = m0; mm[1] = (m0 + NGW < MX) ? m0 + NGW : m0;
        int slot[2][4]; float gt[2][4]; v4u hw[2][2]; v2u yw[2][4][2];
#pragma unroll
        for (int r = 0; r < 2; ++r) {
#pragma unroll
            for (int k = 0; k < 4; ++k) { slot[r][k] = TSLOT[(size_t)mm[r] * 4 + k]; gt[r][k] = GATE[(size_t)mm[r] * 4 + k]; }
#pragma unroll
            for (int j = 0; j < 2; ++j) hw[r][j] = *(const v4u*)(H1 + (size_t)mm[r] * D + 8 * F.lane + 512 * j); }
#pragma unroll
        for (int r = 0; r < 2; ++r)
#pragma unroll
            for (int k = 0; k < 4; ++k)
#pragma unroll
                for (int j = 0; j < 2; ++j) yw[r][k][j] = *(const v2u*)(YS + (size_t)slot[r][k] * D + 8 * F.lane + 512 * j);
#pragma unroll
        for (int r = 0; r < 2; ++r) {
            float s[16];
#pragma unroll
            for (int i = 0; i < 16; ++i) s[i] = 0.f;
#pragma unroll
            for (int j = 0; j < 2; ++j) p10_acc(s, j, hw[r][j], ALPHA);
#pragma unroll
            for (int k = 0; k < 4; ++k)
#pragma unroll
                for (int j = 0; j < 2; ++j) p10_acc8(s, j, yw[r][k][j], gt[r][k]);
            float t = 0.f;
#pragma unroll
            for (int i = 0; i < 16; ++i) t += s[i];
            const float mean = wave_sum(t, F.lane) * (1.f / D); float q = 0.f;
#pragma unroll
            for (int i = 0; i < 16; ++i) { s[i] -= mean; q += s[i] * s[i]; }
            const float rstd = __builtin_amdgcn_rsqf(wave_sum(q, F.lane) * (1.f / D) + 1e-5f);
            if (r == 0 || mm[1] != mm[0]) {
                LAS float* RB = (LAS float*)(F.lds + F.wave * 8192 + r * 4096);
#pragma unroll
                for (int q4 = 0; q4 < 4; ++q4) { const int col = 8 * F.lane + 512 * (q4 >> 1) + 4 * (q4 & 1);
                    f32x4 o; o.x = s[4 * q4 + 0] * rstd * gv[q4].x + bv[q4].x; o.y = s[4 * q4 + 1] * rstd * gv[q4].y + bv[q4].y; o.z = s[4 * q4 + 2] * rstd * gv[q4].z + bv[q4].z; o.w = s[4 * q4 + 3] * rstd * gv[q4].w + bv[q4].w;
                    *(LAS f32x4*)(RB + col) = o; }
                asm volatile("s_waitcnt lgkmcnt(0)" ::: "memory");
#pragma unroll
                for (int q4 = 0; q4 < 4; ++q4) __builtin_nontemporal_store(*(const LAS f32x4*)(RB + 4 * F.lane + 256 * q4), (f32x4*)(a.out + (size_t)mm[r] * D + 4 * F.lane + 256 * q4)); }
        }
    }
}

template <int LO, int HI>
__global__ void __launch_bounds__(NTHR, 2) fwd(Args a) {
    extern __shared__ __attribute__((aligned(16))) unsigned char lds_raw[];
    LAS unsigned char* lds = (LAS unsigned char*)lds_raw;
    const int wave = __builtin_amdgcn_readfirstlane((int)(threadIdx.x >> 6));
    volatile LAS unsigned* MISC = (volatile LAS unsigned*)(lds + MISC_OFF);
    if (wave == 0) MISC[lane_id()] = 0u;
    __syncthreads();
    unsigned* ctl = (unsigned*)(a.ws + WS_CTL);
    XcdBarrier bar; bar.bar = ctl + CW_BAR; bar.x = 0; bar.st = nullptr;
    if constexpr (HI - LO > 1) bar = xcd_barrier_post(ctl + CW_BAR, MISC + 8, wave == 0 && lane_id() == 0);
#define PH(k) if constexpr (LO <= (k) && (k) < HI)
#define SEAM(k) if constexpr (LO <= (k) && (k) + 1 < HI) xcd_barrier(bar, wave == 0 && lane_id() == 0)
    PH(0) for (int rep_ = 0; rep_ < NREP(0); ++rep_) { const Frame F = mkframe(lds, wave); phase0(a, F); } SEAM(0);
    PH(1) if constexpr (((REP_MASK >> 25) & 1) != 0) { const Frame F = mkframe(lds, wave);
            struct FakeOrder { pg8::StaticOrder S; __device__ bool next(int i, pg8::Unit& u) const { const bool ok = S.next(i, u); u.pm = 0; u.pn = 0; return ok; }
                               __device__ void a_ready(const pg8::Unit&) const {} __device__ void done(const pg8::Unit&) const {} };
            pg8::Gemm g{(const pg8::bf16_t*)(a.ws + WS_A0), (const pg8::bf16_t*)(a.ws + WS_WIN), MX, PW, D}; FakeOrder S; S.S.init(MX, PW, F.G, F.blk);
            pg8::EpiBf16Plain E{(pg8::bf16_t*)(a.ws + WS_PROJ), PW};
            pg8::gemm_phase<pg8::EpiBf16Plain, FakeOrder, true, true>(F.lds, g, S, E, F.tid); }
    PH(1) for (int rep_ = 0; rep_ < NREP(1); ++rep_) { const Frame F = mkframe(lds, wave);
            pg8::Gemm g{(const pg8::bf16_t*)(a.ws + WS_A0), (const pg8::bf16_t*)(a.ws + WS_WIN), MX, PW, D}; pg8::StaticOrder S; S.init(MX, PW, F.G, F.blk);
            pg8::EpiBf16Plain E{(pg8::bf16_t*)(a.ws + WS_PROJ), PW};
            pg8::gemm_phase<pg8::EpiBf16Plain, pg8::StaticOrder, true, true>(F.lds, g, S, E, F.tid); } SEAM(1);
    PH(2) for (int rep_ = 0; rep_ < NREP(2); ++rep_) { const Frame F = mkframe(lds, wave); phase2(a, F); } SEAM(2);
    PH(3) { const Frame F = mkframe(lds, wave); phase3(a, F); } SEAM(3);
    PH(4) for (int rep_ = 0; rep_ < NREP(4); ++rep_) { const Frame F = mkframe(lds, wave); phase4(a, F); } SEAM(4);
    PH(5) for (int rep_ = 0; rep_ < NREP(5); ++rep_) { const Frame F = mkframe(lds, wave);
            pg8::Gemm g{(const pg8::bf16_t*)(a.ws + WS_YMIX), (const pg8::bf16_t*)(a.ws + WS_WOUT), MX, D, D / 2}; pg8::StaticOrder S; S.init(MX, D, F.G, F.blk);
            pg8::EpiBf16Plain E{(pg8::bf16_t*)(a.ws + WS_MIXB), D};
            pg8::gemm_phase<pg8::EpiBf16Plain, pg8::StaticOrder, true, true, 114>(F.lds, g, S, E, F.tid); } SEAM(5);
    PH(6) for (int rep_ = 0; rep_ < NREP(6); ++rep_) { const Frame F = mkframe(lds, wave); phase6(a, F, rep_); } SEAM(6);
    PH(7) for (int rep_ = 0; rep_ < NREP(7); ++rep_) { const Frame F = mkframe(lds, wave); phase7(a, F); } SEAM(7);
    if constexpr (((REP_MASK >> 26) & 1) != 0 && HI - LO > 1) { for (int i = 0; i < 10; ++i) xcd_barrier(bar, wave == 0 && lane_id() == 0); }
    PH(8) for (int rep_ = 0; rep_ < NREP(8); ++rep_) { const Frame F = mkframe(lds, wave); const int n = __builtin_amdgcn_readfirstlane(((const LAS int*)(F.lds + TAB_OFF))[128]);
            pg8::Gemm g{(const pg8::bf16_t*)(a.ws + WS_H1Q), (const pg8::bf16_t*)(a.ws + WS_WUP), 0, 0, D / 2}; pg8::TableOrder S{(const LAS int*)(F.lds + TAB_OFF), n};
            pg8::EpiSwiglu8 E{a.ws + WS_ACT, a.in[I_BUP]};
            pg8::gemm_phase_g<pg8::EpiSwiglu8, pg8::TableOrder, true, true, 121>(F.lds, g, S, E, F.tid, (const int*)(a.ws + WS_SLOTTOK)); } SEAM(8);
    PH(9) for (int rep_ = 0; rep_ < NREP(9); ++rep_) { const Frame F = mkframe(lds, wave); const int n = __builtin_amdgcn_readfirstlane(((const LAS int*)(F.lds + TAB2_OFF))[128]);
            pg8::Gemm g{(const pg8::bf16_t*)(a.ws + WS_ACT), (const pg8::bf16_t*)(a.ws + WS_WDN), 0, 0, D / 2}; pg8::TableOrder S{(const LAS int*)(F.lds + TAB2_OFF), n};
            pg8::EpiDown8 E{a.ws + WS_YS, a.in[I_BDN]};
            pg8::gemm_phase<pg8::EpiDown8, pg8::TableOrder, true, true, 120>(F.lds, g, S, E, F.tid); } SEAM(9);
    PH(10) for (int rep_ = 0; rep_ < NREP(10); ++rep_) { const Frame F = mkframe(lds, wave); phase10(a, F); }
#undef PH
#undef SEAM
}

#ifndef MK_SINGLE
#define MK_SINGLE 1
#endif
template <int LO, int HI> static void launch_range(const Args& a, int grid, hipStream_t stream) {
    static bool attr = false;
    if (!attr) { (void)hipFuncSetAttribute((const void*)fwd<LO, HI>, hipFuncAttributeMaxDynamicSharedMemorySize, LDS_BYTES); attr = true; }
    hipLaunchKernelGGL((fwd<LO, HI>), dim3(grid), dim3(NTHR), LDS_BYTES, stream, a);
}
extern "C" void kernel_launch(void* const* d_in, const int* in_sizes, int n_in, void* d_out, int out_size, void* d_ws, size_t ws_size, hipStream_t stream) {
    if (n_in != 30 || ws_size < WS_END) { fprintf(stderr, "kernel_launch: unexpected inputs (n_in %d, ws %zu)\n", n_in, ws_size); return; }
    const int grid = 256;
    (void)hipMemsetAsync((char*)d_ws + WS_CTL, 0, CTL_ZERO_BYTES, stream);
    Args a{};
    for (int i = 0; i < 30; ++i) a.in[i] = (const float*)d_in[i];
    a.out = (float*)d_out; a.ws = (unsigned char*)d_ws;
#if MK_SINGLE
    launch_range<0, 11>(a, grid, stream);
#else
    launch_range<0, 1>(a, grid, stream); launch_range<1, 2>(a, grid, stream); launch_range<2, 3>(a, grid, stream); launch_range<3, 4>(a, grid, stream);
    launch_range<4, 5>(a, grid, stream); launch_range<5, 6>(a, grid, stream); launch_range<6, 7>(a, grid, stream); launch_range<7, 8>(a, grid, stream);
    launch_range<8, 9>(a, grid, stream); launch_range<9, 10>(a, grid, stream); launch_range<10, 11>(a, grid, stream);
#endif
}
```
